# Optimizing an MI355X kernel written in HIP

```python
import math
import jax, jax.numpy as jnp
from jax import lax
import numpy as np

D_MODEL = 2048
BATCH = 4
SEQ = 4096
DEPTH = 2

HEAD_DIM = 128
Q_BLOCK = 128
NEG_INF = -1e30
RMS_EPS = 1e-6
N_EVEN = (DEPTH + 1) // 2
N_ODD = DEPTH // 2

NUM_BUCKETS = 32
T5_MAX_DIST = 2048
BIAS_HEADS = 8

NSA_HEADS = 8
NSA_KV_HEADS = 2
NSA_GROUP = NSA_HEADS // NSA_KV_HEADS
CMP_LEN = 32
CMP_STRIDE = 16
CMP_HIDDEN = HEAD_DIM
SLC_LEN = 64
N_SEL = 16
WIN = 512
SEL_QB = 64
FORCE_SCORE = 1e9

MLA_HEADS = 8
Q_LORA = 512
KV_LORA = 512
QK_NOPE = 128
QK_ROPE = 64
V_DIM = 128
ROPE_THETA = 10000.0

DIL_PATTERNS = ((128, 1), (512, 4), (2048, 16))
DIL_HEADS = 8

NSA_Q_W = NSA_HEADS * HEAD_DIM
NSA_KV_W = 6 * NSA_KV_HEADS * HEAD_DIM
NSA_G_W = 3 * NSA_HEADS
AB_IN_W = NSA_Q_W + NSA_KV_W + NSA_G_W + Q_LORA + KV_LORA + QK_ROPE
AB_OUT_W = NSA_HEADS * HEAD_DIM + MLA_HEADS * V_DIM
C_IN_W = len(DIL_PATTERNS) * 3 * DIL_HEADS * HEAD_DIM
C_OUT_W = DIL_HEADS * HEAD_DIM

D_FF = 5632
N_EXPERTS = 8
MOE_TOP_K = 2
D_FF_EXPERT = 7168
MOE_BLOCK = 256

kernel_name = 'hybrid_nsa_mla_dilated_moe_adaln'

F32 = jnp.float32


def rms_norm(x, g):
    xf = x.astype(F32)
    y = xf * lax.rsqrt(jnp.mean(xf * xf, axis=-1, keepdims=True) + RMS_EPS)
    return (y * g.astype(F32)).astype(x.dtype)


def t5_bucket(dist):
    n = jnp.maximum(dist, 0)
    max_exact = NUM_BUCKETS // 2
    nf = jnp.maximum(n, 1).astype(F32)
    large = max_exact + (jnp.log(nf / max_exact) / math.log(T5_MAX_DIST / max_exact)
                         * (NUM_BUCKETS - max_exact)).astype(jnp.int32)
    large = jnp.minimum(large, NUM_BUCKETS - 1)
    return jnp.where(n < max_exact, n, large)


def swiglu(x, w_gate, w_up, w_down):
    return jnp.dot(jax.nn.silu(jnp.dot(x, w_gate)) * jnp.dot(x, w_up), w_down)


def banded_attention(q, k, v, max_back, dist_scale, bias_tab):
    B, L, G, R, D = q.shape
    nb = -(-max_back // Q_BLOCK)
    nq = -(-L // Q_BLOCK)
    pad = nq * Q_BLOCK - L
    kw = (nb + 1) * Q_BLOCK
    qp = jnp.pad(q, ((0, 0), (0, pad), (0, 0), (0, 0), (0, 0))).reshape(B, nq, Q_BLOCK, G, R, D)
    kp = jnp.pad(k, ((0, 0), (nb * Q_BLOCK, pad), (0, 0), (0, 0)))
    vp = jnp.pad(v, ((0, 0), (nb * Q_BLOCK, pad), (0, 0), (0, 0)))
    kidx = jnp.arange(nq)[:, None] * Q_BLOCK + jnp.arange(kw)[None, :]
    kb = kp[:, kidx]
    vb = vp[:, kidx]
    rel = jnp.arange(Q_BLOCK)[:, None] + nb * Q_BLOCK - jnp.arange(kw)[None, :]
    mask = ((rel >= 0) & (rel <= max_back))[None] & ((kidx - nb * Q_BLOCK) >= 0)[:, None, :]
    bias = bias_tab[t5_bucket(rel * dist_scale)].astype(F32).reshape(Q_BLOCK, kw, G, R).transpose(2, 3, 0, 1)
    s = jnp.einsum('bnqgrd,bnkgd->bngrqk', qp, kb, preferred_element_type=F32) * (D ** -0.5) + bias
    s = jnp.where(mask[None, :, None, None], s, NEG_INF)
    m = jnp.max(s, axis=-1, keepdims=True)
    p = jnp.exp(s - m)
    l = jnp.sum(p, axis=-1, keepdims=True)
    o = jnp.einsum('bngrqk,bnkgd->bnqgrd', p / l, vb.astype(F32))
    lse = (m + jnp.log(l))[..., 0].transpose(0, 1, 4, 2, 3)
    o = o.reshape(B, nq * Q_BLOCK, G, R, D)[:, :L]
    lse = lse.reshape(B, nq * Q_BLOCK, G, R)[:, :L]
    return o, lse


def nsa_compress(blocks, pos, w1, w2):
    w1 = w1.reshape(CMP_LEN, HEAD_DIM, CMP_HIDDEN)
    hid = jax.nn.gelu(jnp.einsum('bnlgd,lde->bnge', blocks + pos[None, None, :, None, :], w1))
    return jnp.dot(hid, w2)


def nsa_mixer(q, kv, gate_logits, rel_bias, pos_k, w1_k, w2_k, pos_v, w1_v, w2_v):
    B, S, _ = q.shape
    G, R, D = NSA_KV_HEADS, NSA_GROUP, HEAD_DIM
    q = q.reshape(B, S, G, R, D)
    kv = kv.reshape(B, S, 6, G, D)
    k_cmp, v_cmp, k_slc, v_slc, k_win, v_win = (kv[:, :, i] for i in range(6))
    scale = D ** -0.5
    tpos = jnp.arange(S)

    n_cmp = (S - CMP_LEN) // CMP_STRIDE + 1
    cidx = jnp.arange(n_cmp)[:, None] * CMP_STRIDE + jnp.arange(CMP_LEN)[None, :]
    kc = nsa_compress(k_cmp[:, cidx], pos_k, w1_k, w2_k)
    vc = nsa_compress(v_cmp[:, cidx], pos_v, w1_v, w2_v)
    rel_c = tpos[:, None] - (jnp.arange(n_cmp) * CMP_STRIDE + CMP_LEN - 1)[None, :]
    bias_c = rel_bias[t5_bucket(rel_c)].astype(F32).reshape(S, n_cmp, G, R).transpose(0, 2, 3, 1)
    s_c = jnp.einsum('bsgrd,bngd->bsgrn', q, kc, preferred_element_type=F32) * scale + bias_c
    s_c = jnp.where((rel_c >= 0)[:, None, None, :], s_c, NEG_INF)
    has_c = (tpos >= CMP_LEN - 1)[None, :, None, None, None]
    p_c = jnp.where(has_c, jax.nn.softmax(s_c, axis=-1), 0.0)
    o_cmp = jnp.einsum('bsgrn,bngd->bsgrd', p_c, vc.astype(F32))

    n_slc = S // SLC_LEN
    ratio = SLC_LEN // CMP_STRIDE
    span = CMP_LEN // CMP_STRIDE
    imp_c = jnp.sum(p_c, axis=3)
    pad_front = span - 1
    pad_back = max(0, ratio * n_slc + ratio - pad_front - n_cmp)
    P = jnp.pad(imp_c, ((0, 0), (0, 0), (0, 0), (pad_front, pad_back)))
    imp_s = sum(P[..., (m - n + pad_front):(m - n + pad_front) + ratio * n_slc:ratio]
                for m in range(ratio) for n in range(span))
    blk_t = tpos // SLC_LEN
    jb = jnp.arange(n_slc)
    valid_s = jb[None, :] <= blk_t[:, None]
    forced = (jb[None, :] == 0) | (jb[None, :] == blk_t[:, None]) | (jb[None, :] == blk_t[:, None] - 1)
    score = jnp.where(forced[None, :, None, :], FORCE_SCORE,
                      jnp.where(valid_s[None, :, None, :], imp_s, -1.0))
    n_top = min(N_SEL, n_slc)
    top_v, top_i = lax.top_k(score, n_top)
    sel_ok = top_v > -0.5

    kb = k_slc.reshape(B, n_slc, SLC_LEN, G, D).transpose(0, 3, 1, 2, 4)
    vb = v_slc.reshape(B, n_slc, SLC_LEN, G, D).transpose(0, 3, 1, 2, 4)
    nqb = S // SEL_QB
    tbl = rel_bias.reshape(NUM_BUCKETS, G, R).transpose(1, 0, 2)
    bi = jnp.arange(B)[:, None, None, None]
    gi = jnp.arange(G)[None, None, :, None]

    def split_q(a):
        return a.reshape((B, nqb, SEL_QB) + a.shape[2:]).swapaxes(0, 1)

    def sel_block(args):
        qb, ib, okb, tb = args
        ks = kb[bi, gi, ib]
        vs = vb[bi, gi, ib]
        kpos = ib[..., None] * SLC_LEN + jnp.arange(SLC_LEN)
        rel = tb[None, :, None, None, None] - kpos
        mask = (rel >= 0) & okb[..., None]
        bias = tbl[gi[..., None], t5_bucket(rel)].astype(F32).transpose(0, 1, 2, 5, 3, 4)
        s = jnp.einsum('bqgrd,bqgnkd->bqgrnk', qb, ks, preferred_element_type=F32) * scale + bias
        s = jnp.where(mask[:, :, :, None], s, NEG_INF)
        shp = s.shape
        p = jax.nn.softmax(s.reshape(shp[:4] + (shp[4] * shp[5],)), axis=-1).reshape(shp)
        return jnp.einsum('bqgrnk,bqgnkd->bqgrd', p, vs.astype(F32))

    o_slc = lax.map(sel_block, (split_q(q), split_q(top_i), split_q(sel_ok), tpos.reshape(nqb, SEL_QB)))
    o_slc = o_slc.swapaxes(0, 1).reshape(B, S, G, R, D)

    o_win, _ = banded_attention(q, k_win, v_win, WIN - 1, 1, rel_bias)

    gates = jax.nn.sigmoid(gate_logits.astype(F32)).reshape(B, S, G, R, 3)
    o = gates[..., 0:1] * o_cmp + gates[..., 1:2] * o_slc + gates[..., 2:3] * o_win
    return o.reshape(B, S, G * R * D).astype(q.dtype)


def apply_rope(x, cos, sin):
    half = x.shape[-1] // 2
    x1, x2 = x[..., :half].astype(F32), x[..., half:].astype(F32)
    return jnp.concatenate([x1 * cos - x2 * sin, x2 * cos + x1 * sin], axis=-1).astype(x.dtype)


def mla_mixer(q_lat, kv_lat, k_pe, positions, q_norm_g, kv_norm_g, w_uq, w_ukv):
    B, S, _ = q_lat.shape
    q = jnp.dot(rms_norm(q_lat, q_norm_g), w_uq).reshape(B, S, MLA_HEADS, QK_NOPE + QK_ROPE)
    q_nope, q_pe = q[..., :QK_NOPE], q[..., QK_NOPE:]
    kvu = jnp.dot(rms_norm(kv_lat, kv_norm_g), w_ukv).reshape(B, S, MLA_HEADS, QK_NOPE + V_DIM)
    k_nope, v = kvu[..., :QK_NOPE], kvu[..., QK_NOPE:]
    inv_freq = ROPE_THETA ** (-jnp.arange(0, QK_ROPE, 2, dtype=F32) / QK_ROPE)
    ang = positions.astype(F32)[..., None] * inv_freq
    cos, sin = jnp.cos(ang), jnp.sin(ang)
    q_pe = apply_rope(q_pe, cos[:, :, None, :], sin[:, :, None, :])
    k_pe = apply_rope(k_pe, cos, sin)
    scale = (QK_NOPE + QK_ROPE) ** -0.5
    nqb = S // Q_BLOCK
    tpos = jnp.arange(S)

    def split_q(a):
        return a.reshape((B, nqb, Q_BLOCK) + a.shape[2:]).swapaxes(0, 1)

    def blk(args):
        qn, qp, tb = args
        s = (jnp.einsum('bqhd,bkhd->bhqk', qn, k_nope, preferred_element_type=F32)
             + jnp.einsum('bqhd,bkd->bhqk', qp, k_pe, preferred_element_type=F32)) * scale
        s = jnp.where(tpos[None, :] <= tb[:, None], s, NEG_INF)
        p = jax.nn.softmax(s, axis=-1)
        return jnp.einsum('bhqk,bkhd->bqhd', p, v.astype(F32))

    o = lax.map(blk, (split_q(q_nope), split_q(q_pe), tpos.reshape(nqb, Q_BLOCK)))
    return o.swapaxes(0, 1).reshape(B, S, MLA_HEADS * V_DIM).astype(q_lat.dtype)


def mixer_ab(h, positions, rel_bias, w_in, w_out, pos_k, w1_k, w2_k, pos_v, w1_v, w2_v,
             q_norm_g, kv_norm_g, w_uq, w_ukv):
    z = jnp.dot(h, w_in)
    cuts = np.cumsum([NSA_Q_W, NSA_KV_W, NSA_G_W, Q_LORA, KV_LORA]).tolist()
    nsa_q, nsa_kv, nsa_g, q_lat, kv_lat, k_pe = jnp.split(z, cuts, axis=-1)
    o_a = nsa_mixer(nsa_q, nsa_kv, nsa_g, rel_bias, pos_k, w1_k, w2_k, pos_v, w1_v, w2_v)
    o_b = mla_mixer(q_lat, kv_lat, k_pe, positions, q_norm_g, kv_norm_g, w_uq, w_ukv)
    return jnp.dot(jnp.concatenate([o_a, o_b], axis=-1), w_out)


def mixer_c(h, rel_bias, w_in, w_out):
    B, S, _ = h.shape
    z = jnp.dot(h, w_in).reshape(B, S, len(DIL_PATTERNS), 3, DIL_HEADS, HEAD_DIM)
    outs, lses = [], []
    for g, (win, dil) in enumerate(DIL_PATTERNS):
        L = S // dil

        def to_sub(a):
            return a.reshape(B, L, dil, DIL_HEADS, HEAD_DIM).swapaxes(1, 2).reshape(B * dil, L, DIL_HEADS, HEAD_DIM)

        o, lse = banded_attention(to_sub(z[:, :, g, 0])[:, :, :, None], to_sub(z[:, :, g, 1]),
                                  to_sub(z[:, :, g, 2]), win // dil, dil, rel_bias)
        outs.append(o.reshape(B, dil, L, DIL_HEADS, HEAD_DIM).swapaxes(1, 2).reshape(B, S, DIL_HEADS, HEAD_DIM))
        lses.append(lse.reshape(B, dil, L, DIL_HEADS).swapaxes(1, 2).reshape(B, S, DIL_HEADS))
    w = jax.nn.softmax(jnp.stack(lses, axis=0), axis=0)
    o = jnp.sum(w[..., None] * jnp.stack(outs, axis=0), axis=0)
    return jnp.dot(o.reshape(B, S, C_OUT_W).astype(h.dtype), w_out)


def moe_swiglu(h, w_router, w_gate, w_up, w_down):
    B, S, D = h.shape
    N = B * S
    A = N * MOE_TOP_K
    hf = h.reshape(N, D)
    logits = jnp.dot(hf, w_router, preferred_element_type=F32)
    top_v, top_e = lax.top_k(logits, MOE_TOP_K)
    gates = jax.nn.softmax(top_v, axis=-1)
    flat_e = top_e.reshape(A)
    flat_tok = jnp.repeat(jnp.arange(N, dtype=jnp.int32), MOE_TOP_K)
    order = jnp.argsort(flat_e)
    se, st, sg = flat_e[order], flat_tok[order], gates.reshape(A)[order]
    counts = jnp.bincount(flat_e, length=N_EXPERTS)
    starts = jnp.cumsum(counts) - counts
    pcounts = (counts + MOE_BLOCK - 1) // MOE_BLOCK * MOE_BLOCK
    pends = jnp.cumsum(pcounts)
    pstarts = pends - pcounts
    dest = pstarts[se] + jnp.arange(A) - starts[se]
    n_blocks = -(-A // MOE_BLOCK) + N_EXPERTS
    slot_tok = jnp.full((n_blocks * MOE_BLOCK,), N, jnp.int32).at[dest].set(st)
    block_e = jnp.minimum(jnp.searchsorted(pends, jnp.arange(n_blocks) * MOE_BLOCK, side='right'), N_EXPERTS - 1)
    xpad = jnp.concatenate([hf, jnp.zeros((1, D), hf.dtype)], axis=0)
    xb = xpad[slot_tok].reshape(n_blocks, MOE_BLOCK, D)

    def expert_block(args):
        xblk, e = args
        return swiglu(xblk, w_gate[e], w_up[e], w_down[e])

    yb = lax.map(expert_block, (xb, block_e)).reshape(n_blocks * MOE_BLOCK, D)
    y = jnp.zeros((N, D), yb.dtype).at[st].add(yb[dest] * sg[:, None].astype(yb.dtype))
    return y.reshape(B, S, D)


def setup_inputs(seed: int = 0) -> dict:
    key = jax.random.key(seed)
    ks = jax.random.split(key, 32)

    def nrm(i, shape, scale):
        return jax.random.normal(ks[i], shape, F32) * scale

    def gain(i, shape):
        return 1.0 + nrm(i, shape, 0.05)

    D = D_MODEL
    offs = jax.random.randint(ks[2], (BATCH, 1), 0, 1024)
    return {
        'x': nrm(0, (BATCH, SEQ, D), 1.0),
        'c': nrm(1, (BATCH, D), 1.0),
        'positions': (offs + jnp.arange(SEQ)[None, :]).astype(jnp.int32),
        'rel_bias': nrm(3, (NUM_BUCKETS, BIAS_HEADS), 0.2),
        'ada_w': nrm(4, (DEPTH, D, 6 * D), D ** -0.5),
        'ada_b': nrm(5, (DEPTH, 6 * D), 0.02),
        'mix_norm_g': gain(6, (DEPTH, D)),
        'ffn_norm_g': gain(7, (DEPTH, D)),
        'ab_w_in': nrm(8, (N_EVEN, D, AB_IN_W), D ** -0.5),
        'ab_w_out': nrm(9, (N_EVEN, AB_OUT_W, D), AB_OUT_W ** -0.5),
        'nsa_cmp_pos_k': nrm(10, (N_EVEN, CMP_LEN, HEAD_DIM), 0.1),
        'nsa_cmp_w1_k': nrm(11, (N_EVEN, CMP_LEN * HEAD_DIM, CMP_HIDDEN), (CMP_LEN * HEAD_DIM) ** -0.5),
        'nsa_cmp_w2_k': nrm(12, (N_EVEN, CMP_HIDDEN, HEAD_DIM), CMP_HIDDEN ** -0.5),
        'nsa_cmp_pos_v': nrm(13, (N_EVEN, CMP_LEN, HEAD_DIM), 0.1),
        'nsa_cmp_w1_v': nrm(14, (N_EVEN, CMP_LEN * HEAD_DIM, CMP_HIDDEN), (CMP_LEN * HEAD_DIM) ** -0.5),
        'nsa_cmp_w2_v': nrm(15, (N_EVEN, CMP_HIDDEN, HEAD_DIM), CMP_HIDDEN ** -0.5),
        'mla_q_norm_g': gain(16, (N_EVEN, Q_LORA)),
        'mla_kv_norm_g': gain(17, (N_EVEN, KV_LORA)),
        'mla_w_uq': nrm(18, (N_EVEN, Q_LORA, MLA_HEADS * (QK_NOPE + QK_ROPE)), Q_LORA ** -0.5),
        'mla_w_ukv': nrm(19, (N_EVEN, KV_LORA, MLA_HEADS * (QK_NOPE + V_DIM)), KV_LORA ** -0.5),
        'ffn_w_gate': nrm(20, (N_EVEN, D, D_FF), D ** -0.5),
        'ffn_w_up': nrm(21, (N_EVEN, D, D_FF), D ** -0.5),
        'ffn_w_down': nrm(22, (N_EVEN, D_FF, D), D_FF ** -0.5),
        'c_w_in': nrm(23, (N_ODD, D, C_IN_W), D ** -0.5),
        'c_w_out': nrm(24, (N_ODD, C_OUT_W, D), C_OUT_W ** -0.5),
        'moe_w_router': nrm(25, (N_ODD, D, N_EXPERTS), D ** -0.5),
        'moe_w_gate': nrm(26, (N_ODD, N_EXPERTS, D, D_FF_EXPERT), D ** -0.5),
        'moe_w_up': nrm(27, (N_ODD, N_EXPERTS, D, D_FF_EXPERT), D ** -0.5),
        'moe_w_down': nrm(28, (N_ODD, N_EXPERTS, D_FF_EXPERT, D), D_FF_EXPERT ** -0.5),
        'final_norm_g': gain(29, (D,)),
    }


def reference(x, c, positions, rel_bias, ada_w, ada_b, mix_norm_g, ffn_norm_g, ab_w_in, ab_w_out,
              nsa_cmp_pos_k, nsa_cmp_w1_k, nsa_cmp_w2_k, nsa_cmp_pos_v, nsa_cmp_w1_v, nsa_cmp_w2_v,
              mla_q_norm_g, mla_kv_norm_g, mla_w_uq, mla_w_ukv, ffn_w_gate, ffn_w_up, ffn_w_down,
              c_w_in, c_w_out, moe_w_router, moe_w_gate, moe_w_up, moe_w_down, final_norm_g):
    cs = jax.nn.silu(c)
    for i in range(DEPTH):
        j = i // 2
        mod = jnp.dot(cs, ada_w[i]) + ada_b[i]
        sh_m, sc_m, g_m, sh_f, sc_f, g_f = (t[:, None, :] for t in jnp.split(mod, 6, axis=-1))
        h = rms_norm(x, mix_norm_g[i]) * (1.0 + sc_m) + sh_m
        if i % 2 == 0:
            y = mixer_ab(h, positions, rel_bias, ab_w_in[j], ab_w_out[j],
                         nsa_cmp_pos_k[j], nsa_cmp_w1_k[j], nsa_cmp_w2_k[j],
                         nsa_cmp_pos_v[j], nsa_cmp_w1_v[j], nsa_cmp_w2_v[j],
                         mla_q_norm_g[j], mla_kv_norm_g[j], mla_w_uq[j], mla_w_ukv[j])
        else:
            y = mixer_c(h, rel_bias, c_w_in[j], c_w_out[j])
        x = x + g_m * y
        h = rms_norm(x, ffn_norm_g[i]) * (1.0 + sc_f) + sh_f
        if i % 2 == 0:
            y = swiglu(h, ffn_w_gate[j], ffn_w_up[j], ffn_w_down[j])
        else:
            y = moe_swiglu(h, moe_w_router[j], moe_w_gate[j], moe_w_up[j], moe_w_down[j])
        x = x + g_f * y
    return rms_norm(x, final_norm_g)
```

```cpp
#include <hip/hip_runtime.h>
#include <cstdio>
#include <cstdint>

#ifndef MK_N_LAUNCHES
#define MK_N_LAUNCHES 1
#endif

namespace pg8 {
#define PG8_LAS __attribute__((address_space(3)))
typedef unsigned short bf16_t;
typedef short bf16x8 __attribute__((ext_vector_type(8)));
typedef float f32x4 __attribute__((ext_vector_type(4)));
typedef float f32x2 __attribute__((ext_vector_type(2)));
typedef unsigned u32x4 __attribute__((ext_vector_type(4)));
typedef unsigned u32x2 __attribute__((ext_vector_type(2)));
constexpr int BM = 256, BK = 64, HALF = 128, HTB = HALF * BK * 2  , STAGE_BYTES = 8 * HTB, NXCD = 8, WGM = 8;

__host__ __device__ __forceinline__ int lds_byte(int r, int c) { const int st = (r >> 4) * 2 + (c >> 5), rr = r & 15, cc = c & 31, ob = rr * 64 + cc * 2; return st * 1024 + (ob ^ (((ob >> 9) & 1) << 5)); }
__host__ __device__ __forceinline__ void stage_rc(int b, int& R, int& C) { const int st = b / 1024, sb = b % 1024, swz = sb ^ (((sb >> 9) & 1) << 5); R = (st >> 1) * 16 + swz / 64; C = (st & 1) * 32 + (swz % 64) / 2; }
__host__ __device__ __forceinline__ int perm32(int rho) { const int n = rho >> 4, i = rho & 15; return 8 * (i >> 2) + 4 * n + (i & 3); }

struct Unit { int pm, pn, pb; };
struct Gemm { const bf16_t* A; const bf16_t* Bt; int lda, ldb, K; };

struct StaticOrder {
    int nM, nN, nwg, G, c;
    __host__ __device__ void init(int M, int N, int G_, int c_) { nM = M / BM; nN = N / BM; nwg = nM * nN; G = G_; c = c_; }
    __host__ __device__ bool next(int i, Unit& u) const {
        const long L = (long)i * G + c; if (L >= nwg) return false;
        int wgid = (int)L; { const int q = nwg / NXCD, r = nwg % NXCD, xcd = wgid % NXCD, off = wgid / NXCD; wgid = (xcd < r ? xcd * (q + 1) : r * (q + 1) + (xcd - r) * q) + off; }
        const int nig = WGM * nN, gid = wgid / nig, fm = gid * WGM, gsz = (nM - fm) < WGM ? (nM - fm) : WGM;
        u.pm = fm + ((wgid % nig) % gsz); u.pn = (wgid % nig) / gsz; u.pb = u.pn; return true;
    }
    __device__ __forceinline__ void a_ready(const Unit&) const {}
    __device__ __forceinline__ void done(const Unit&) const {}
};
struct GroupedOrder {
    int nN, G, c; int ts[9];
    __device__ __forceinline__ void init(const unsigned* tstart, int nN_, int G_, int c_) { nN = nN_; G = G_; c = c_;
#pragma unroll
        for (int e = 0; e < 9; ++e) ts[e] = (int)tstart[e]; }
    __device__ __forceinline__ bool next(int i, Unit& u) const {
        const long L = (long)i * G + c; if (L >= (long)ts[8] * nN) return false;
        int e = 0, us = 0, te = ts[1] - ts[0], t0 = ts[0];
#pragma unroll
        for (int k = 1; k < 8; ++k) { const int s = ts[k] * nN; if (L >= s) { e = k; us = s; te = ts[k + 1] - ts[k]; t0 = ts[k]; } }
        const int r = (int)L - us; if (te <= 0) return false;
        u.pm = t0 + r % te; u.pn = r / te; u.pb = e * nN + u.pn; return true;
    }
    __device__ __forceinline__ void a_ready(const Unit&) const {}
    __device__ __forceinline__ void done(const Unit&) const {}
};

__device__ __forceinline__ unsigned cvt_pk_bf16(float lo, float hi) { unsigned r; asm volatile("v_cvt_pk_bf16_f32 %0, %1, %2" : "=v"(r) : "v"(lo), "v"(hi)); return r; }

struct EpiBf16 {
    static constexpr bool PERM = true, AFTER_DRAIN = false;
    bf16_t* O; int ldc; const float* rowscale;
    __device__ __forceinline__ void operator()(const f32x4 (&acc)[2][2][4][2], const Unit& u, int wr, int wc, int fr, int fq) const {
        const int row0 = u.pm * BM + wr * 64 + fr; const int col0 = u.pn * BM + wc * 32 + 8 * fq;
#pragma unroll
        for (int ai = 0; ai < 2; ++ai)
#pragma unroll
            for (int m = 0; m < 4; ++m) { const int row = row0 + ai * HALF + m * 16; bf16_t* rowp = O + (size_t)row * ldc + col0; const float sc = rowscale ? rowscale[row] : 1.f;
#pragma unroll
                for (int bj = 0; bj < 2; ++bj) { f32x4 v0 = acc[ai][bj][m][0] * sc, v1 = acc[ai][bj][m][1] * sc;
                    u32x4 w; w.x = cvt_pk_bf16(v0[0], v0[1]); w.y = cvt_pk_bf16(v0[2], v0[3]); w.z = cvt_pk_bf16(v1[0], v1[1]); w.w = cvt_pk_bf16(v1[2], v1[3]);
                    *(u32x4*)(rowp + bj * HALF) = w; } }
    }
};
struct EpiResid {
    static constexpr bool PERM = false, AFTER_DRAIN = false;
    const float* xin; float* xout; int ldc; const float* gate; int gstride; int tiles_per_b;
    __device__ __forceinline__ void operator()(const f32x4 (&acc)[2][2][4][2], const Unit& u, int wr, int wc, int fr, int fq) const {
        const int row0 = u.pm * BM + wr * 64 + fr, col0 = u.pn * BM + wc * 32 + 4 * fq;
        const float* gp = gate + (size_t)(u.pm / tiles_per_b) * gstride + col0;
        f32x4 gv[2][2];
#pragma unroll
        for (int bj = 0; bj < 2; ++bj)
#pragma unroll
            for (int n = 0; n < 2; ++n) gv[bj][n] = *(const f32x4*)(gp + bj * HALF + n * 16);
#pragma unroll
        for (int ai = 0; ai < 2; ++ai)
#pragma unroll
            for (int m = 0; m < 4; ++m) { const size_t off = (size_t)(row0 + ai * HALF + m * 16) * ldc + col0;
#pragma unroll
                for (int bj = 0; bj < 2; ++bj)
#pragma unroll
                    for (int n = 0; n < 2; ++n) { const f32x4 xi = *(const f32x4*)(xin + off + bj * HALF + n * 16);
                        *(f32x4*)(xout + off + bj * HALF + n * 16) = xi + gv[bj][n] * acc[ai][bj][m][n]; }
                asm volatile("" ::: "memory"); }
    }
};
__device__ __forceinline__ float silu_f(float g) { return g * __builtin_amdgcn_rcpf(1.0f + __builtin_amdgcn_exp2f(-1.4426950408889634f * g)); }
struct EpiSwiGLU {
    static constexpr bool PERM = false, AFTER_DRAIN = false;
    bf16_t* O; int ldo;
    __device__ __forceinline__ void operator()(const f32x4 (&acc)[2][2][4][2], const Unit& u, int wr, int wc, int fr, int fq) const {
        const int row0 = u.pm * BM + wr * 64 + fr, col0 = u.pn * HALF + wc * 16 + 4 * fq;
#pragma unroll
        for (int ai = 0; ai < 2; ++ai)
#pragma unroll
            for (int m = 0; m < 4; ++m) { bf16_t* rowp = O + (size_t)(row0 + ai * HALF + m * 16) * ldo + col0;
#pragma unroll
                for (int bj = 0; bj < 2; ++bj) { const f32x4 g = acc[ai][bj][m][0], up = acc[ai][bj][m][1];
                    u32x2 w; w.x = cvt_pk_bf16(silu_f(g[0]) * up[0], silu_f(g[1]) * up[1]); w.y = cvt_pk_bf16(silu_f(g[2]) * up[2], silu_f(g[3]) * up[3]);
                    *(u32x2*)(rowp + bj * 64) = w; } }
    }
};

template <class Epi, class Sched, bool ALIGN_EPI = false, bool SP2 = false>
__device__ __forceinline__ void gemm_phase(PG8_LAS unsigned char* lds, const Gemm g, const Sched& S, const Epi& E) {
    const int tid = threadIdx.x, wid = __builtin_amdgcn_readfirstlane(tid >> 6), lane = tid & 63, wr = wid >> 2, wc = wid & 3, fr = lane & 15, fq = lane >> 4;
    const int K = g.K, nt = K / BK;
    unsigned voffA[2], voffB[2];
#pragma unroll
    for (int i = 0; i < 2; ++i) { int R, C; stage_rc(tid * 16 + i * 8192, R, C); const int Rb = Epi::PERM ? ((R & ~31) + perm32(R & 31)) : R;
        voffA[i] = (unsigned)(R * g.lda + C) * 2u; voffB[i] = (unsigned)(Rb * g.ldb + C) * 2u; }
    const size_t kstep = (size_t)(BK * 2);
    const size_t hstepA = (size_t)HALF * g.lda * 2, hstepB = (size_t)HALF * g.ldb * 2;
    const size_t tstepA = 2 * hstepA, tstepB = 2 * hstepB;
    const unsigned ldsw = (unsigned)wid * 1024u;
    const int aoff = lds_byte(wr * 64 + fr, fq * 8), boff = lds_byte(wc * 32 + fr, fq * 8);
#define PG8_SA(b, h) (((b) * 2 + (h)) * HTB)
#define PG8_SB(b, h) ((4 + (b) * 2 + (h)) * HTB)
#define PG8_STAGE(bufoff, gbase, voff) do { _Pragma("unroll") for (int _i = 0; _i < 2; ++_i) \
        __builtin_amdgcn_global_load_lds((const unsigned*)((const char*)(gbase) + (voff)[_i]), (PG8_LAS unsigned*)(lds + (bufoff) + ldsw + _i * 8192), 16, 0, 0); } while (0)
#define PG8_LDA(dst, b, h) do { _Pragma("unroll") for (int m = 0; m < 4; ++m) _Pragma("unroll") for (int k = 0; k < 2; ++k) dst[m][k] = *(const PG8_LAS bf16x8*)(lds + PG8_SA(b, h) + aoff + m * 2048 + k * 1024); } while (0)
#define PG8_LDB(dst, b, h) do { _Pragma("unroll") for (int n = 0; n < 2; ++n) _Pragma("unroll") for (int k = 0; k < 2; ++k) dst[n][k] = *(const PG8_LAS bf16x8*)(lds + PG8_SB(b, h) + boff + n * 2048 + k * 1024); } while (0)
#define PG8_MMA(ai, bj, At, Bt) do { __builtin_amdgcn_s_setprio(1); _Pragma("unroll") for (int m = 0; m < 4; ++m) _Pragma("unroll") for (int n = 0; n < 2; ++n) _Pragma("unroll") for (int k = 0; k < 2; ++k) \
        acc[ai][bj][m][n] = __builtin_amdgcn_mfma_f32_16x16x32_bf16(Bt[n][k], At[m][k], acc[ai][bj][m][n], 0, 0, 0); __builtin_amdgcn_s_setprio(0); } while (0)
#define PG8_WAIT_V(n) asm volatile("s_waitcnt vmcnt(" #n ")" ::: "memory")
#define PG8_WAIT_L(n) asm volatile("s_waitcnt lgkmcnt(" #n ")" ::: "memory")
#define PG8_BAR __builtin_amdgcn_s_barrier()
#define PG8_SCHED __builtin_amdgcn_sched_barrier(0)
    Unit cur, nxt; int ui = 0;
    if (!S.next(0, cur)) return;
    f32x4 acc[2][2][4][2];
#pragma unroll
    for (int a = 0; a < 2; ++a)
#pragma unroll
        for (int b = 0; b < 2; ++b)
#pragma unroll
            for (int m = 0; m < 4; ++m)
#pragma unroll
                for (int n = 0; n < 2; ++n) acc[a][b][m][n] = (f32x4){0.f, 0.f, 0.f, 0.f};
    bf16x8 At[4][2], B0[2][2], B1[2][2];
    const char* cA = (const char*)g.A + (size_t)cur.pm * tstepA; const char* cB = (const char*)g.Bt + (size_t)cur.pb * tstepB;
    S.a_ready(cur);
    if constexpr (SP2) {
        PG8_STAGE(PG8_SB(0, 0), cB, voffB); PG8_STAGE(PG8_SB(0, 1), cB + hstepB, voffB); PG8_STAGE(PG8_SA(0, 0), cA, voffA); PG8_STAGE(PG8_SA(0, 1), cA + hstepA, voffA);
        if (wr == 1) PG8_BAR;
        PG8_WAIT_V(2); PG8_BAR;
        PG8_STAGE(PG8_SB(1, 0), cB + kstep, voffB); PG8_STAGE(PG8_SA(1, 0), cA + kstep, voffA); PG8_STAGE(PG8_SB(1, 1), cB + hstepB + kstep, voffB);
        PG8_WAIT_V(6); PG8_BAR;
    } else {
        PG8_STAGE(PG8_SB(0, 0), cB, voffB); PG8_STAGE(PG8_SA(0, 0), cA, voffA); PG8_STAGE(PG8_SB(0, 1), cB + hstepB, voffB); PG8_STAGE(PG8_SA(0, 1), cA + hstepA, voffA);
        if (wr == 1) PG8_BAR;
        PG8_WAIT_V(4); PG8_BAR;
        PG8_STAGE(PG8_SB(1, 0), cB + kstep, voffB); PG8_STAGE(PG8_SA(1, 0), cA + kstep, voffA); PG8_STAGE(PG8_SB(1, 1), cB + hstepB + kstep, voffB);
        PG8_WAIT_V(6); PG8_BAR;
    }
    for (;;) {
        const bool has_next = S.next(ui + 1, nxt);
        const char* nA = has_next ? (const char*)g.A + (size_t)nxt.pm * tstepA : cA; const char* nB = has_next ? (const char*)g.Bt + (size_t)nxt.pb * tstepB : cB;
        for (int t = 0; t < nt; t += 2) {
            const bool last = (t == nt - 2);
            const char* a1 = cA + (size_t)(t + 1) * kstep;
            const char* a2 = last ? nA : cA + (size_t)(t + 2) * kstep; const char* b2 = last ? nB : cB + (size_t)(t + 2) * kstep;
            const char* a3 = a2 + kstep; const char* b3 = b2 + kstep;
            if (last && has_next) S.a_ready(nxt);
            if constexpr (SP2) {
            PG8_LDB(B0, 0, 0); PG8_LDB(B1, 0, 1); PG8_SCHED; PG8_LDA(At, 0, 0); PG8_STAGE(PG8_SA(1, 1), a1 + hstepA, voffA);
            PG8_WAIT_V(8); PG8_WAIT_L(0); PG8_BAR; PG8_MMA(0, 0, At, B0); PG8_MMA(0, 1, At, B1); PG8_BAR; PG8_SCHED;
            PG8_LDA(At, 0, 1); PG8_STAGE(PG8_SB(0, 0), b2, voffB); PG8_STAGE(PG8_SB(0, 1), b2 + hstepB, voffB); PG8_STAGE(PG8_SA(0, 0), a2, voffA);
            PG8_WAIT_V(8); PG8_WAIT_L(0); PG8_BAR; PG8_MMA(1, 0, At, B0); PG8_MMA(1, 1, At, B1); PG8_BAR; PG8_SCHED;
            PG8_LDB(B0, 1, 0); PG8_LDB(B1, 1, 1); PG8_SCHED; PG8_LDA(At, 1, 0); PG8_STAGE(PG8_SA(0, 1), a2 + hstepA, voffA);
            PG8_WAIT_V(8); PG8_WAIT_L(0); PG8_BAR; PG8_MMA(0, 0, At, B0); PG8_MMA(0, 1, At, B1); PG8_BAR; PG8_SCHED;
            PG8_LDA(At, 1, 1); PG8_STAGE(PG8_SB(1, 0), b3, voffB); PG8_STAGE(PG8_SB(1, 1), b3 + hstepB, voffB); PG8_STAGE(PG8_SA(1, 0), a3, voffA);
            PG8_WAIT_V(8); PG8_WAIT_L(0); PG8_BAR; PG8_MMA(1, 0, At, B0); PG8_MMA(1, 1, At, B1); PG8_BAR; PG8_SCHED;
            } else {
            PG8_LDB(B0, 0, 0); PG8_SCHED; PG8_LDA(At, 0, 0); PG8_STAGE(PG8_SA(1, 1), a1 + hstepA, voffA);
            PG8_WAIT_L(8); PG8_BAR; PG8_WAIT_L(0); PG8_MMA(0, 0, At, B0); PG8_BAR; PG8_SCHED;
            PG8_LDB(B1, 0, 1); PG8_STAGE(PG8_SB(0, 0), b2, voffB);
            PG8_BAR; PG8_WAIT_L(0); PG8_MMA(0, 1, At, B1); PG8_BAR;
            PG8_LDA(At, 0, 1); PG8_STAGE(PG8_SA(0, 0), a2, voffA);
            PG8_BAR; PG8_WAIT_L(0); PG8_MMA(1, 0, At, B0); PG8_BAR; PG8_SCHED;
            PG8_STAGE(PG8_SB(0, 1), b2 + hstepB, voffB);
            PG8_WAIT_V(6); PG8_BAR; PG8_MMA(1, 1, At, B1); PG8_BAR;
            PG8_LDB(B0, 1, 0); PG8_SCHED; PG8_LDA(At, 1, 0); PG8_STAGE(PG8_SA(0, 1), a2 + hstepA, voffA);
            PG8_WAIT_L(8); PG8_BAR; PG8_WAIT_L(0); PG8_MMA(0, 0, At, B0); PG8_BAR; PG8_SCHED;
            PG8_LDB(B1, 1, 1); PG8_STAGE(PG8_SB(1, 0), b3, voffB);
            PG8_BAR; PG8_WAIT_L(0); PG8_MMA(0, 1, At, B1); PG8_BAR;
            PG8_LDA(At, 1, 1); PG8_STAGE(PG8_SA(1, 0), a3, voffA);
            PG8_BAR; PG8_WAIT_L(0); PG8_MMA(1, 0, At, B0); PG8_BAR; PG8_SCHED;
            PG8_STAGE(PG8_SB(1, 1), b3 + hstepB, voffB);
            PG8_WAIT_V(6); PG8_BAR; PG8_MMA(1, 1, At, B1); PG8_BAR;
            }
        }
        if constexpr (ALIGN_EPI) { if (wr == 0) PG8_BAR; }
        if constexpr (!Epi::AFTER_DRAIN) { E(acc, cur, wr, wc, fr, fq); S.done(cur); }
        if (!has_next) break;
#pragma unroll
        for (int a = 0; a < 2; ++a)
#pragma unroll
            for (int b = 0; b < 2; ++b)
#pragma unroll
                for (int m = 0; m < 4; ++m)
#pragma unroll
                    for (int n = 0; n < 2; ++n) acc[a][b][m][n] = (f32x4){0.f, 0.f, 0.f, 0.f};
        cur = nxt; cA = nA; cB = nB; ++ui;
        if constexpr (ALIGN_EPI) { if (wr == 1) PG8_BAR; }
    }
    PG8_WAIT_V(0);
    if constexpr (!ALIGN_EPI) { if (wr == 0) PG8_BAR; }
    PG8_BAR;
    if constexpr (Epi::AFTER_DRAIN) { E.fused(acc, cur, wr, wc, fr, fq, lds, wid, lane); S.done(cur); }
#undef PG8_SA
#undef PG8_SB
#undef PG8_STAGE
#undef PG8_LDA
#undef PG8_LDB
#undef PG8_MMA
#undef PG8_WAIT_V
#undef PG8_WAIT_L
#undef PG8_BAR
#undef PG8_SCHED
}

}

constexpr int D = 2048, NB = 4, S = 4096, M = NB * S;
constexpr int HD = 128;
constexpr int Z0W = 3840;
constexpr int Z_NQ = 0, Z_NKV = 1024, Z_QLAT = 2560, Z_KVLAT = 3072, Z_KPE = 3584, Z_NG = 3648;
constexpr int QMW = 1536, KVMW = 2048;
constexpr int FF = 5632, FFE = 7168, NE = 8;
constexpr int Z1W = 9216;
constexpr int NSLOT = (2 * M / 256 + NE) * 256;
constexpr float RMS_EPS = 1e-6f;

constexpr size_t MiB = 1u << 20;
constexpr size_t WS_CTL = 0, CTL_ZERO_BYTES = 1 * MiB;
constexpr size_t WS_MOD = 1 * MiB;
constexpr size_t WS_BIAS = 2 * MiB;
constexpr int BIAS_LD = 4096 + 64;
constexpr size_t WS_ROPE = 3 * MiB;
constexpr size_t WS_RINV = 8 * MiB;
constexpr size_t WS_SEL = 9 * MiB;
constexpr size_t WS_KC = 10 * MiB;
constexpr size_t WS_VC = 11 * MiB;
constexpr size_t WS_ROUTE = 12 * MiB;
constexpr size_t WS_KPE = 15 * MiB;
constexpr size_t WS_WIN0 = 21 * MiB, WS_WUQ = 36 * MiB, WS_WUKV = 38 * MiB, WS_WOUT0 = 40 * MiB, WS_WGU0 = 48 * MiB, WS_WDN0 = 92 * MiB;
constexpr size_t WS_WIN1 = 114 * MiB, WS_WOUT1 = 150 * MiB, WS_WMGU = 154 * MiB, WS_WMDN = 602 * MiB;
constexpr size_t WS_X = 826 * MiB;
constexpr size_t WS_H = 954 * MiB;
constexpr size_t WS_R = 1018 * MiB;
constexpr size_t WS_Z0 = WS_R, WS_QM = WS_R + 120 * MiB, WS_KVM = WS_R + 168 * MiB, WS_OCMP = WS_R + 232 * MiB, WS_OWIN = WS_R + 264 * MiB, WS_CAT = WS_R + 328 * MiB;
constexpr size_t WS_ACT = WS_R;
constexpr size_t WS_Z1 = WS_R, WS_OM = WS_R + 384 * MiB;
constexpr size_t WS_XB = WS_R, WS_ACTB = WS_R + 136 * MiB, WS_YB = WS_R;
constexpr size_t WS_END = WS_R + 612 * MiB;
static_assert(WS_Z0 + (size_t)M * Z0W * 2 <= WS_QM && WS_QM + (size_t)M * QMW * 2 <= WS_KVM && WS_KVM + (size_t)M * KVMW * 2 <= WS_OCMP && WS_CAT + (size_t)M * 2048 * 2 <= WS_END, "L0 map");
static_assert(WS_Z1 + (size_t)M * Z1W * 2 <= WS_OM && WS_XB + (size_t)NSLOT * D * 2 <= WS_ACTB && WS_ACTB + (size_t)NSLOT * FFE * 2 <= WS_END, "L1 map");
static_assert(WS_WMDN + (size_t)NE * D * FFE * 2 <= WS_X && WS_WMGU + (size_t)NE * 2 * FFE * D * 2 <= WS_WMDN, "weights map");
constexpr int CW_BAR = 4096;
constexpr int CW_CNT = 64;
constexpr int CW_TS = 128;

constexpr int RING_BYTES = 131072;
constexpr int SMALL_OFF = RING_BYTES;
constexpr int LDSCTL_OFF = RING_BYTES + 16384, MISC_OFF = LDSCTL_OFF;
constexpr int LDS_BYTES = LDSCTL_OFF + 256;
constexpr int NWAVES = 8;

#define GAS __attribute__((address_space(1)))
#define LAS __attribute__((address_space(3)))
typedef unsigned short bf16;
typedef unsigned v4u __attribute__((ext_vector_type(4)));
typedef unsigned v2u __attribute__((ext_vector_type(2)));
typedef float f32x4 __attribute__((ext_vector_type(4)));
typedef float f32x2 __attribute__((ext_vector_type(2)));
#define LDS_WAIT() asm volatile("s_waitcnt lgkmcnt(0)" ::: "memory")
__device__ __forceinline__ unsigned f2bf(float f) { unsigned u = __builtin_bit_cast(unsigned, f); return (u + 0x7fffu + ((u >> 16) & 1u)) >> 16; }
__device__ __forceinline__ unsigned pk2(float lo, float hi) { return f2bf(lo) | (f2bf(hi) << 16); }
__device__ __forceinline__ float bf2f(unsigned short b) { return __builtin_bit_cast(float, (unsigned)b << 16); }
__device__ __forceinline__ float bflo(unsigned w) { return __builtin_bit_cast(float, w << 16); }
__device__ __forceinline__ float bfhi(unsigned w) { return __builtin_bit_cast(float, w & 0xffff0000u); }
__device__ __forceinline__ float wave_sum(float v) {
#pragma unroll
    for (int o = 1; o < 64; o <<= 1) v += __shfl_xor(v, o);
    return v;
}
__device__ __forceinline__ float wave_max(float v) {
#pragma unroll
    for (int o = 1; o < 64; o <<= 1) v = fmaxf(v, __shfl_xor(v, o));
    return v;
}

#define XB_TMO      128
#define XB_XCNT(j)  (256  + 64 * (j))
#define XB_XSUB(j)  (1280 + 64 * (j))
#define XB_XGEN(j)  (2304 + 64 * (j))
#define XB_TOP      3328
#define XB_TOPGEN   3392
#define XCD_BAR_WORDS 3456
#define XB_SPIN_CAP (1u << 22)

__device__ __forceinline__ unsigned xb_ld(unsigned* p)              { return __hip_atomic_load(p, __ATOMIC_RELAXED, __HIP_MEMORY_SCOPE_AGENT); }
__device__ __forceinline__ unsigned xb_add(unsigned* p, unsigned v) { return __hip_atomic_fetch_add(p, v, __ATOMIC_RELAXED, __HIP_MEMORY_SCOPE_AGENT); }
__device__ __forceinline__ unsigned xb_xcc_id() { return (unsigned)__builtin_amdgcn_s_getreg((3 << 11) | 20) & 0xFu; }
#define XB_SPIN(cond, bar) do { unsigned _sp = 0; while (cond) { __builtin_amdgcn_s_sleep(1); \
    if ((++_sp & 255u) == 0u) { if (xb_ld(&(bar)[XB_TMO])) break; if (_sp > XB_SPIN_CAP) { atomicAdd(&(bar)[XB_TMO], 1u); break; } } } } while (0)

struct XcdBarrier {
    unsigned* bar; unsigned x;
    volatile LAS unsigned* st;
};

__device__ __forceinline__ XcdBarrier xcd_barrier_post(unsigned* bar, volatile LAS unsigned* st) {
    XcdBarrier b; b.bar = bar; b.x = xb_xcc_id(); b.st = st;
    if (threadIdx.x == 0) (void)xb_add(&bar[XB_XCNT(b.x)], 1u);
    return b;
}
__device__ __forceinline__ void xcd_barrier_complete(unsigned* bar, unsigned x, unsigned& nloc, unsigned& nx) {
    const unsigned G = gridDim.x * gridDim.y * gridDim.z;
    unsigned sum, cnt, mine, sp = 0u;
    for (;;) {
        sum = 0u; cnt = 0u; mine = 0u;
#pragma unroll
        for (unsigned j = 0; j < 16; ++j) { const unsigned c = xb_ld(&bar[XB_XCNT(j)]); sum += c; cnt += (c > 0u) ? 1u : 0u; mine = (j == x) ? c : mine; }
        if (sum == G) break;
        __builtin_amdgcn_s_sleep(1);
        if ((++sp & 255u) == 0u) { if (xb_ld(&bar[XB_TMO])) break; if (sp > XB_SPIN_CAP) { atomicAdd(&bar[XB_TMO], 1u); break; } }
    }
    nloc = mine > 0u ? mine : 1u; nx = cnt > 0u ? cnt : 1u;
}

__device__ __forceinline__ void xcd_barrier(const XcdBarrier& b) {
    asm volatile("s_waitcnt vmcnt(0)" ::: "memory");
    __syncthreads();
    if (threadIdx.x == 0) {
        unsigned* bar = b.bar;
        __builtin_amdgcn_s_waitcnt(0);
        unsigned nloc = b.st[0], nx = b.st[1];
        if (nloc == 0u) { xcd_barrier_complete(bar, b.x, nloc, nx); b.st[0] = nloc; b.st[1] = nx; }
        const unsigned old = xb_add(&bar[XB_XSUB(b.x)], 1u);
        const unsigned gen = old / nloc;
        if (old + 1u == (gen + 1u) * nloc) {
            __builtin_amdgcn_fence(__ATOMIC_RELEASE, "agent");
            asm volatile("s_waitcnt vmcnt(0)" ::: "memory");
            const unsigned og = xb_add(&bar[XB_TOP], 1u);
            const unsigned tg = og / nx;
            if (og + 1u == (tg + 1u) * nx) xb_add(&bar[XB_TOPGEN], 1u);
            else XB_SPIN(xb_ld(&bar[XB_TOPGEN]) == tg, bar);
            __builtin_amdgcn_fence(__ATOMIC_ACQUIRE, "agent");
            xb_add(&bar[XB_XGEN(b.x)], 1u);
            asm volatile("s_waitcnt vmcnt(0)" ::: "memory");
        } else {
            XB_SPIN(xb_ld(&bar[XB_XGEN(b.x)]) == gen, bar);
            __builtin_amdgcn_fence(__ATOMIC_ACQUIRE, "agent");
            asm volatile("s_waitcnt vmcnt(0)" ::: "memory");
        }
    }
    __syncthreads();
}


struct Args { const void* in[30]; float* out; unsigned char* ws; int ph_lo, ph_hi; };
struct Frame {
    unsigned char* lds;
    int tid, lane, wave, vcu, G, gw, NGW;
    unsigned char* ws;
};

__device__ __forceinline__ int t5_bucket(int n) {
    if (n < 16) return n < 0 ? 0 : n;
    int b = 16;
    b += (n >= 22); b += (n >= 30); b += (n >= 40); b += (n >= 54); b += (n >= 73); b += (n >= 99); b += (n >= 134); b += (n >= 182);
    b += (n >= 246); b += (n >= 332); b += (n >= 450); b += (n >= 609); b += (n >= 825); b += (n >= 1117); b += (n >= 1513);
    return b;
}

template <int MAP>
__device__ __forceinline__ void p0_transpose_item(const float* W, const float* W2, int K, int Nsrc, int Ndst, bf16* WT, const float* kscale, float* scr, int item, int lane) {
    const int nblk = Ndst / 32, kb = item / nblk, nb = item % nblk, k0 = 64 * kb, n0 = 32 * nb;
    const int n = n0 + (lane & 31);
    const float* src = W; int sc = n; bool ok = true;
    if (MAP == 1) { if (n < Z_QLAT) sc = n; else if (n < Z_NG) sc = n + 24; else if (n < Z_NG + 24) sc = n - Z_NG + 2560; else ok = false; }
    if (MAP == 2) { const int g32 = n >> 5, w = n & 31; src = (w < 16) ? W : W2; sc = g32 * 16 + (w & 15); }
#pragma unroll 8
    for (int i = 0; i < 32; ++i) { const int kk = 2 * i + (lane >> 5); float v = ok ? src[(size_t)(k0 + kk) * Nsrc + sc] : 0.f; if (kscale) v *= kscale[k0 + kk]; scr[kk * 33 + (lane & 31)] = v; }
    LDS_WAIT(); asm volatile("" ::: "memory");
    const int c = lane & 7;
#pragma unroll
    for (int j = 0; j < 4; ++j) { const int nn = (lane >> 3) + 8 * j; const float* s = scr + (8 * c) * 33 + nn;
        v4u o; o.x = pk2(s[0 * 33], s[1 * 33]); o.y = pk2(s[2 * 33], s[3 * 33]); o.z = pk2(s[4 * 33], s[5 * 33]); o.w = pk2(s[6 * 33], s[7 * 33]);
        *(v4u*)(WT + (size_t)(n0 + nn) * K + k0 + 8 * c) = o; }
    LDS_WAIT(); asm volatile("" ::: "memory");
}
template <int MAP>
__device__ __forceinline__ void p0_transpose(Frame& F, const float* W, const float* W2, int K, int Nsrc, int Ndst, bf16* WT, const float* kscale) {
    float* scr = (float*)(F.lds + F.wave * 16384);
    const int nitems = (K / 64) * (Ndst / 32);
    for (int it = F.gw; it < nitems; it += F.NGW) p0_transpose_item<MAP>(W, W2, K, Nsrc, Ndst, WT, kscale, scr, it, F.lane);
}

__device__ __forceinline__ void modnorm_row(const float* xrow, const float* g, const float* sc, const float* sh, bf16* orow, int lane, f32x4 (&v)[8]) {
    const f32x4* xr = (const f32x4*)xrow + lane; float s = 0.f;
#pragma unroll
    for (int j = 0; j < 8; ++j) { v[j] = xr[64 * j]; s += (v[j].x * v[j].x + v[j].y * v[j].y) + (v[j].z * v[j].z + v[j].w * v[j].w); }
    const float rinv = 1.0f / sqrtf(wave_sum(s) * (1.f / D) + RMS_EPS);
    unsigned long long* o8 = (unsigned long long*)orow + lane;
#pragma unroll
    for (int j = 0; j < 8; ++j) { const f32x4 gg = ((const f32x4*)g)[lane + 64 * j], cc = ((const f32x4*)sc)[lane + 64 * j], hh = ((const f32x4*)sh)[lane + 64 * j];
        v[j] = (v[j] * rinv) * gg * (cc + 1.0f) + hh;
        o8[64 * j] = (unsigned long long)pk2(v[j].x, v[j].y) | ((unsigned long long)pk2(v[j].z, v[j].w) << 32); }
}
__device__ __forceinline__ void modnorm_phase(Frame& F, const float* x, const float* g, const float* mod  , int sh_idx, bf16* H) {
    for (int m = F.gw; m < M; m += F.NGW) { const int b = m / S; const float* mb = mod + (size_t)b * 6 * D; f32x4 v[8];
        modnorm_row(x + (size_t)m * D, g, mb + (size_t)(sh_idx + 1) * D, mb + (size_t)sh_idx * D, H + (size_t)m * D, F.lane, v); }
}

struct NA { const bf16* k; long kstride; const bf16* k2; long k2stride; int dq, dq2; const bf16* v; long vstride; int t0, tstep, nk; const float* bias; int brel0, bstep; float scale; unsigned long long cmask; int use_sel; };
__device__ __forceinline__ void na_run(const NA& a, const float* qs, float* sc, int lane, float& mx, float& sum, float& o0, float& o1) {
    float lmax = -3.0e38f;
    for (int c = 0; c * 64 < a.nk; ++c) {
        const int kk = c * 64 + lane; float s = -__builtin_inff();
        const bool chunk_ok = !a.use_sel || ((a.cmask >> ((a.t0 + c * 64 * a.tstep) >> 6)) & 1ull);
        if (chunk_ok && kk < a.nk) {
            const long t = a.t0 + (long)kk * a.tstep; const bf16* kr = a.k + t * a.kstride; float acc = 0.f;
            for (int d = 0; d < a.dq; d += 8) { const v4u w = *(const v4u*)(kr + d); const float* q = qs + d;
                acc += bflo(w.x) * q[0] + bfhi(w.x) * q[1] + bflo(w.y) * q[2] + bfhi(w.y) * q[3] + bflo(w.z) * q[4] + bfhi(w.z) * q[5] + bflo(w.w) * q[6] + bfhi(w.w) * q[7]; }
            if (a.dq2) { const bf16* k2r = a.k2 + t * a.k2stride;
                for (int d = 0; d < a.dq2; d += 8) { const v4u w = *(const v4u*)(k2r + d); const float* q = qs + a.dq + d;
                    acc += bflo(w.x) * q[0] + bfhi(w.x) * q[1] + bflo(w.y) * q[2] + bfhi(w.y) * q[3] + bflo(w.z) * q[4] + bfhi(w.z) * q[5] + bflo(w.w) * q[6] + bfhi(w.w) * q[7]; } }
            s = acc * a.scale; if (a.bias) s += a.bias[a.brel0 - kk * a.bstep];
        }
        if (kk < a.nk) sc[kk] = s;
        lmax = fmaxf(lmax, s);
    }
    mx = wave_max(lmax);
    float ls = 0.f;
    for (int kk = lane; kk < a.nk; kk += 64) { const float p = __expf(sc[kk] - mx); sc[kk] = p; ls += p; }
    sum = wave_sum(ls);
    LDS_WAIT(); asm volatile("" ::: "memory");
    float a0 = 0.f, a1 = 0.f;
    for (int kk = 0; kk < a.nk; ++kk) { const float p = sc[kk]; if (p != 0.f) { const unsigned w = *(const unsigned*)(a.v + (long)(a.t0 + (long)kk * a.tstep) * a.vstride + 2 * lane); a0 += p * bflo(w); a1 += p * bfhi(w); } }
    o0 = a0; o1 = a1;
    asm volatile("" ::: "memory");
}
__device__ __forceinline__ float gelu_tanh(float x) { const float u = 0.7978845608028654f * (x + 0.044715f * x * x * x); return 0.5f * x * (1.0f + tanhf(u)); }
__device__ __forceinline__ float sigmoid_f(float x) { return 1.0f / (1.0f + __expf(-x)); }

__global__ void __launch_bounds__(NWAVES * 64, 2) fwd(Args args) {
    extern __shared__ __attribute__((aligned(16))) unsigned char lds[];
    Frame F;
    F.lds = lds; F.ws = args.ws;
    F.tid = threadIdx.x; F.lane = F.tid & 63; F.wave = __builtin_amdgcn_readfirstlane(F.tid >> 6);
    F.G = gridDim.x; { const int bx = blockIdx.x; F.vcu = (F.G % 8 == 0) ? (bx % 8) * (F.G / 8) + bx / 8 : bx; }
    F.gw = F.vcu * NWAVES + F.wave; F.NGW = F.G * NWAVES;
    unsigned char* ws = args.ws;
    unsigned* ctl = (unsigned*)(ws + WS_CTL);
    volatile LAS unsigned* MISC = (volatile LAS unsigned*)((LAS unsigned char*)lds + MISC_OFF);
    for (int u = F.tid; u < 64; u += NWAVES * 64) MISC[u] = 0u;
    __syncthreads();
    XcdBarrier bar; bar.bar = ctl + CW_BAR; bar.x = 0; bar.st = nullptr;
    if (MK_N_LAUNCHES == 1) bar = xcd_barrier_post(ctl + CW_BAR, MISC + 8);
    const int lo = args.ph_lo, hi = args.ph_hi;
#define IN(k) (lo <= (k) && (k) < hi)
#define SEAM(k) do { if (IN(k) && IN((k) + 1)) xcd_barrier(bar); } while (0)

    const float* x_in = (const float*)args.in[0]; const float* c_in = (const float*)args.in[1]; const int* positions = (const int*)args.in[2];
    const float* rel_bias = (const float*)args.in[3]; const float* ada_w = (const float*)args.in[4]; const float* ada_b = (const float*)args.in[5];
    const float* mix_norm_g = (const float*)args.in[6]; const float* ffn_norm_g = (const float*)args.in[7];
    const float* ab_w_in = (const float*)args.in[8]; const float* ab_w_out = (const float*)args.in[9];
    const float* cmp_pos_k = (const float*)args.in[10]; const float* cmp_w1_k = (const float*)args.in[11]; const float* cmp_w2_k = (const float*)args.in[12];
    const float* cmp_pos_v = (const float*)args.in[13]; const float* cmp_w1_v = (const float*)args.in[14]; const float* cmp_w2_v = (const float*)args.in[15];
    const float* q_norm_g = (const float*)args.in[16]; const float* kv_norm_g = (const float*)args.in[17]; const float* w_uq = (const float*)args.in[18]; const float* w_ukv = (const float*)args.in[19];
    const float* ffn_wg = (const float*)args.in[20]; const float* ffn_wu = (const float*)args.in[21]; const float* ffn_wd = (const float*)args.in[22];
    const float* c_w_in = (const float*)args.in[23]; const float* c_w_out = (const float*)args.in[24]; const float* w_router = (const float*)args.in[25];
    const float* moe_wg = (const float*)args.in[26]; const float* moe_wu = (const float*)args.in[27]; const float* moe_wd = (const float*)args.in[28]; const float* final_g = (const float*)args.in[29];
    float* MOD = (float*)(ws + WS_MOD); float* BIAS = (float*)(ws + WS_BIAS); float* ROPE = (float*)(ws + WS_ROPE); float* RINV = (float*)(ws + WS_RINV);
    unsigned long long* SEL = (unsigned long long*)(ws + WS_SEL); bf16* KC = (bf16*)(ws + WS_KC); bf16* VC = (bf16*)(ws + WS_VC); int* ROUTE = (int*)(ws + WS_ROUTE); bf16* KPE = (bf16*)(ws + WS_KPE);
    bf16* W_IN0 = (bf16*)(ws + WS_WIN0); bf16* W_UQ = (bf16*)(ws + WS_WUQ); bf16* W_UKV = (bf16*)(ws + WS_WUKV); bf16* W_OUT0 = (bf16*)(ws + WS_WOUT0); bf16* W_GU0 = (bf16*)(ws + WS_WGU0); bf16* W_DN0 = (bf16*)(ws + WS_WDN0);
    bf16* W_IN1 = (bf16*)(ws + WS_WIN1); bf16* W_OUT1 = (bf16*)(ws + WS_WOUT1); bf16* W_MGU = (bf16*)(ws + WS_WMGU); bf16* W_MDN = (bf16*)(ws + WS_WMDN);
    float* X = (float*)(ws + WS_X); bf16* H = (bf16*)(ws + WS_H);
    bf16* Z0 = (bf16*)(ws + WS_Z0); bf16* QM = (bf16*)(ws + WS_QM); bf16* KVM = (bf16*)(ws + WS_KVM); bf16* OCMP = (bf16*)(ws + WS_OCMP); bf16* OWIN = (bf16*)(ws + WS_OWIN); bf16* CAT = (bf16*)(ws + WS_CAT);
    bf16* ACT = (bf16*)(ws + WS_ACT); bf16* Z1 = (bf16*)(ws + WS_Z1); bf16* OM = (bf16*)(ws + WS_OM); bf16* XB = (bf16*)(ws + WS_XB); bf16* ACTB = (bf16*)(ws + WS_ACTB); bf16* YB = (bf16*)(ws + WS_YB);
    float* wsc = (float*)(lds + F.wave * 16384);
    float* wsm = (float*)(lds + SMALL_OFF + F.wave * 2048);
    PG8_LAS unsigned char* ring = (PG8_LAS unsigned char*)lds;

    if (IN(0)) {
        p0_transpose<1>(F, ab_w_in, nullptr, D, 3672, Z0W, W_IN0, nullptr);
        p0_transpose<0>(F, w_uq, nullptr, 512, QMW, QMW, W_UQ, q_norm_g);
        p0_transpose<0>(F, w_ukv, nullptr, 512, KVMW, KVMW, W_UKV, kv_norm_g);
        p0_transpose<0>(F, ab_w_out, nullptr, D, D, D, W_OUT0, nullptr);
        p0_transpose<2>(F, ffn_wg, ffn_wu, D, FF, 2 * FF, W_GU0, nullptr);
        p0_transpose<0>(F, ffn_wd, nullptr, FF, D, D, W_DN0, nullptr);
        p0_transpose<0>(F, c_w_in, nullptr, D, Z1W, Z1W, W_IN1, nullptr);
        p0_transpose<0>(F, c_w_out, nullptr, 1024, D, D, W_OUT1, nullptr);
        for (int e = 0; e < NE; ++e) {
            p0_transpose<2>(F, moe_wg + (size_t)e * D * FFE, moe_wu + (size_t)e * D * FFE, D, FFE, 2 * FFE, W_MGU + (size_t)e * 2 * FFE * D, nullptr);
            p0_transpose<0>(F, moe_wd + (size_t)e * FFE * D, nullptr, FFE, D, D, W_MDN + (size_t)e * D * FFE, nullptr);
        }
        for (int i = F.gw * 64 + F.lane; i < 8 * BIAS_LD; i += F.NGW * 64) { const int h = i / BIAS_LD, r = i % BIAS_LD - 64; BIAS[i] = rel_bias[t5_bucket(r) * 8 + h]; }
        for (int i = F.gw * 64 + F.lane; i < M * 32; i += F.NGW * 64) { const int m = i >> 5, f = i & 31;
            const float inv_freq = powf(10000.0f, -(float)(2 * f) / 64.0f); const float ang = (float)positions[m] * inv_freq;
            ROPE[(size_t)m * 64 + f] = cosf(ang); ROPE[(size_t)m * 64 + 32 + f] = sinf(ang); }
        __syncthreads();
        for (int job = blockIdx.x; job < 192; job += F.G) {
            float* cs = (float*)lds; float* red = (float*)(lds + 32768);
            for (int i = F.tid; i < 4 * D; i += 512) { const float cv = c_in[i]; cs[i] = cv / (1.0f + __expf(-cv)); }
            __syncthreads();
            const int l = job / 96, col0 = (job % 96) * 128;
            float acc[4][2] = {};
            const float* wp = ada_w + ((size_t)l * D + (size_t)F.wave * 256) * 12288 + col0 + 2 * F.lane;
#pragma unroll 8
            for (int k = 0; k < 256; ++k) { const f32x2 wv = *(const f32x2*)(wp + (size_t)k * 12288); const int kk = F.wave * 256 + k;
#pragma unroll
                for (int b = 0; b < 4; ++b) { const float cv = cs[b * D + kk]; acc[b][0] += cv * wv.x; acc[b][1] += cv * wv.y; } }
#pragma unroll
            for (int b = 0; b < 4; ++b) { red[(F.wave * 4 + b) * 128 + 2 * F.lane] = acc[b][0]; red[(F.wave * 4 + b) * 128 + 2 * F.lane + 1] = acc[b][1]; }
            __syncthreads();
            { const int b = F.tid >> 7, cc = F.tid & 127; float s = 0.f;
#pragma unroll
              for (int w = 0; w < 8; ++w) s += red[(w * 4 + b) * 128 + cc];
              MOD[((size_t)l * 4 + b) * 12288 + col0 + cc] = s + ada_b[(size_t)l * 12288 + col0 + cc]; }
            __syncthreads();
        }
    }
    SEAM(0);
    if (IN(1)) modnorm_phase(F, x_in, mix_norm_g, MOD, 0, H);
    SEAM(1);
    if (IN(2)) { pg8::Gemm g{H, W_IN0, D, D, D}; pg8::StaticOrder So; So.init(M, Z0W, F.G, (int)blockIdx.x); pg8::EpiBf16 E{Z0, Z0W, nullptr};
        pg8::gemm_phase<pg8::EpiBf16, pg8::StaticOrder, true, true>(ring, g, So, E); }
    SEAM(2);
    if (IN(3)) {
        for (int m = F.gw; m < M; m += F.NGW) {
            const bf16* zr = Z0 + (size_t)m * Z0W;
#pragma unroll
            for (int w = 0; w < 2; ++w) { const v4u a = *(const v4u*)(zr + (w ? Z_KVLAT : Z_QLAT) + 8 * F.lane);
                float s = bflo(a.x) * bflo(a.x) + bfhi(a.x) * bfhi(a.x) + bflo(a.y) * bflo(a.y) + bfhi(a.y) * bfhi(a.y) + bflo(a.z) * bflo(a.z) + bfhi(a.z) * bfhi(a.z) + bflo(a.w) * bflo(a.w) + bfhi(a.w) * bfhi(a.w);
                s = wave_sum(s); if (F.lane == 0) RINV[(size_t)w * M + m] = 1.0f / sqrtf(s * (1.f / 512.f) + RMS_EPS); }
            if (F.lane < 32) { const float x1 = bf2f(zr[Z_KPE + F.lane]), x2 = bf2f(zr[Z_KPE + 32 + F.lane]); const float cs = ROPE[(size_t)m * 64 + F.lane], sn = ROPE[(size_t)m * 64 + 32 + F.lane];
                KPE[(size_t)m * 64 + F.lane] = (bf16)f2bf(x1 * cs - x2 * sn); KPE[(size_t)m * 64 + 32 + F.lane] = (bf16)f2bf(x2 * cs + x1 * sn); }
        }
        for (int it = F.gw; it < 2 * NB * 255 * 2; it += F.NGW) {
            const int g = it & 1, n = (it >> 1) % 255, b = ((it >> 1) / 255) % NB, c = (it >> 1) / (255 * NB);
            const float* pos = c ? cmp_pos_v : cmp_pos_k; const float* w1 = c ? cmp_w1_v : cmp_w1_k; const float* w2 = c ? cmp_w2_v : cmp_w2_k;
            const bf16* zb = Z0 + ((size_t)b * S + 16 * n) * Z0W + Z_NKV + c * 256 + g * 128;
            float h0 = 0.f, h1 = 0.f;
            for (int l = 0; l < 32; ++l) {
                const float av = bf2f(zb[(size_t)l * Z0W + 2 * F.lane]) + pos[l * 128 + 2 * F.lane], aw = bf2f(zb[(size_t)l * Z0W + 2 * F.lane + 1]) + pos[l * 128 + 2 * F.lane + 1];
                wsm[2 * F.lane] = av; wsm[2 * F.lane + 1] = aw; LDS_WAIT(); asm volatile("" ::: "memory");
#pragma unroll 8
                for (int d = 0; d < 128; ++d) { const f32x2 wv = *(const f32x2*)(w1 + (size_t)(l * 128 + d) * 128 + 2 * F.lane); const float a = wsm[d]; h0 += a * wv.x; h1 += a * wv.y; }
                asm volatile("" ::: "memory");
            }
            wsm[128 + 2 * F.lane] = gelu_tanh(h0); wsm[128 + 2 * F.lane + 1] = gelu_tanh(h1); LDS_WAIT(); asm volatile("" ::: "memory");
            float o0 = 0.f, o1 = 0.f;
#pragma unroll 8
            for (int e = 0; e < 128; ++e) { const f32x2 wv = *(const f32x2*)(w2 + (size_t)e * 128 + 2 * F.lane); const float a = wsm[128 + e]; o0 += a * wv.x; o1 += a * wv.y; }
            asm volatile("" ::: "memory");
            *(unsigned*)((c ? VC : KC) + (((size_t)b * 2 + g) * 256 + n) * 128 + 2 * F.lane) = pk2(o0, o1);
        }
        for (int it = F.gw; it < M * 8; it += F.NGW) {
            const int h = it & 7, m = it >> 3, b = m / S, s = m % S, g = h >> 2;
            const bf16* qr = Z0 + (size_t)m * Z0W + Z_NQ + h * 128; wsm[2 * F.lane] = bf2f(qr[2 * F.lane]); wsm[2 * F.lane + 1] = bf2f(qr[2 * F.lane + 1]); LDS_WAIT(); asm volatile("" ::: "memory");
            const int t0 = s - 511 < 0 ? 0 : s - 511; NA a;
            a.k = Z0 + (size_t)b * S * Z0W + Z_NKV + 4 * 256 + g * 128; a.kstride = Z0W; a.k2 = nullptr; a.k2stride = 0; a.dq = 128; a.dq2 = 0;
            a.v = Z0 + (size_t)b * S * Z0W + Z_NKV + 5 * 256 + g * 128; a.vstride = Z0W; a.t0 = t0; a.tstep = 1; a.nk = s - t0 + 1;
            a.bias = BIAS + (size_t)h * BIAS_LD + 64; a.brel0 = s - t0; a.bstep = 1; a.scale = 0.08838834764831845f; a.cmask = 0; a.use_sel = 0;
            float mx, sum, o0, o1; na_run(a, wsm, wsc, F.lane, mx, sum, o0, o1);
            *(unsigned*)(OWIN + (size_t)m * 1024 + h * 128 + 2 * F.lane) = pk2(o0 / sum, o1 / sum);
        }
    }
    SEAM(3);
    if (IN(4)) {
        { pg8::Gemm g{Z0 + Z_QLAT, W_UQ, Z0W, 512, 512}; pg8::StaticOrder So; So.init(M, QMW, F.G, (int)blockIdx.x); pg8::EpiBf16 E{QM, QMW, RINV};
          pg8::gemm_phase<pg8::EpiBf16, pg8::StaticOrder, true, true>(ring, g, So, E); }
        __syncthreads();
        { pg8::Gemm g{Z0 + Z_KVLAT, W_UKV, Z0W, 512, 512}; pg8::StaticOrder So; So.init(M, KVMW, F.G, (int)blockIdx.x); pg8::EpiBf16 E{KVM, KVMW, RINV + M};
          pg8::gemm_phase<pg8::EpiBf16, pg8::StaticOrder, true, true>(ring, g, So, E); }
        __syncthreads();
        for (int it = F.gw; it < M * 2; it += F.NGW) {
            const int g = it & 1, m = it >> 1, b = m / S, s = m % S;
            const int nk = s >= 31 ? (s - 31) / 16 + 1 : 0;
            float* imp = wsm + 256;
            for (int i = F.lane; i < 256; i += 64) imp[i] = 0.f;
            for (int r = 0; r < 4; ++r) { const int h = g * 4 + r;
                const bf16* qr = Z0 + (size_t)m * Z0W + Z_NQ + h * 128; wsm[2 * F.lane] = bf2f(qr[2 * F.lane]); wsm[2 * F.lane + 1] = bf2f(qr[2 * F.lane + 1]); LDS_WAIT(); asm volatile("" ::: "memory");
                float o0 = 0.f, o1 = 0.f;
                if (nk > 0) { NA a; a.k = KC + ((size_t)b * 2 + g) * 256 * 128; a.kstride = 128; a.k2 = nullptr; a.k2stride = 0; a.dq = 128; a.dq2 = 0; a.v = VC + ((size_t)b * 2 + g) * 256 * 128; a.vstride = 128;
                    a.t0 = 0; a.tstep = 1; a.nk = nk; a.bias = BIAS + (size_t)h * BIAS_LD + 64; a.brel0 = s - 31; a.bstep = 16; a.scale = 0.08838834764831845f; a.cmask = 0; a.use_sel = 0;
                    float mx, sum; na_run(a, wsm, wsc, F.lane, mx, sum, o0, o1); const float inv = 1.0f / sum; o0 *= inv; o1 *= inv;
                    for (int i = F.lane; i < nk; i += 64) imp[i] += wsc[i] * inv; LDS_WAIT(); asm volatile("" ::: "memory"); }
                *(unsigned*)(OCMP + (size_t)m * 1024 + h * 128 + 2 * F.lane) = pk2(o0, o1);
            }
            const int j = F.lane, blk_t = s >> 6;
            float sc;
            { const float pm1 = (4 * j - 1 >= 0) ? imp[4 * j - 1] : 0.f, p0 = imp[4 * j], p1 = imp[4 * j + 1], p2 = imp[4 * j + 2], p3 = (4 * j + 3 < 255) ? imp[4 * j + 3] : 0.f;
              const float is = ((((((p0 + pm1) + p1) + p0) + p2) + p1) + p3) + p2;
              const bool forced = (j == 0) || (j == blk_t) || (j == blk_t - 1), valid = j <= blk_t;
              sc = forced ? 1e9f : (valid ? is : -1.0f); }
            int rank = 0;
            for (int k = 0; k < 64; ++k) { const float vk = __shfl(sc, k); rank += (vk > sc || (vk == sc && k < j)) ? 1 : 0; }
            const unsigned long long msk = __ballot(rank < 16 && sc > -0.5f);
            if (F.lane == 0) SEL[(size_t)m * 2 + g] = msk;
            asm volatile("" ::: "memory");
        }
    }
    SEAM(4);
    if (IN(5)) {
        for (int it = F.gw; it < M * 8; it += F.NGW) {
            const int h = it & 7, m = it >> 3, b = m / S, s = m % S, g = h >> 2;
            const bf16* zr = Z0 + (size_t)m * Z0W; const bf16* qr = zr + Z_NQ + h * 128; wsm[2 * F.lane] = bf2f(qr[2 * F.lane]); wsm[2 * F.lane + 1] = bf2f(qr[2 * F.lane + 1]); LDS_WAIT(); asm volatile("" ::: "memory");
            NA a; a.k = Z0 + (size_t)b * S * Z0W + Z_NKV + 2 * 256 + g * 128; a.kstride = Z0W; a.k2 = nullptr; a.k2stride = 0; a.dq = 128; a.dq2 = 0;
            a.v = Z0 + (size_t)b * S * Z0W + Z_NKV + 3 * 256 + g * 128; a.vstride = Z0W; a.t0 = 0; a.tstep = 1; a.nk = s + 1;
            a.bias = BIAS + (size_t)h * BIAS_LD + 64; a.brel0 = s; a.bstep = 1; a.scale = 0.08838834764831845f; a.cmask = SEL[(size_t)m * 2 + g]; a.use_sel = 1;
            float mx, sum, o0, o1; na_run(a, wsm, wsc, F.lane, mx, sum, o0, o1); o0 /= sum; o1 /= sum;
            const float g0 = sigmoid_f(bf2f(zr[Z_NG + h * 3 + 0])), g1 = sigmoid_f(bf2f(zr[Z_NG + h * 3 + 1])), g2 = sigmoid_f(bf2f(zr[Z_NG + h * 3 + 2]));
            const unsigned wc_ = *(const unsigned*)(OCMP + (size_t)m * 1024 + h * 128 + 2 * F.lane), ww_ = *(const unsigned*)(OWIN + (size_t)m * 1024 + h * 128 + 2 * F.lane);
            *(unsigned*)(CAT + (size_t)m * 2048 + h * 128 + 2 * F.lane) = pk2(g0 * bflo(wc_) + g1 * o0 + g2 * bflo(ww_), g0 * bfhi(wc_) + g1 * o1 + g2 * bfhi(ww_));
        }
        for (int it = F.gw; it < M * 8; it += F.NGW) {
            const int h = it & 7, m = it >> 3, b = m / S, s = m % S;
            const bf16* qr = QM + (size_t)m * QMW + h * 192;
            wsm[2 * F.lane] = bf2f(qr[2 * F.lane]); wsm[2 * F.lane + 1] = bf2f(qr[2 * F.lane + 1]);
            if (F.lane < 32) { const float x1 = bf2f(qr[128 + F.lane]), x2 = bf2f(qr[160 + F.lane]); const float cs = ROPE[(size_t)m * 64 + F.lane], sn = ROPE[(size_t)m * 64 + 32 + F.lane];
                wsm[128 + F.lane] = x1 * cs - x2 * sn; wsm[160 + F.lane] = x2 * cs + x1 * sn; }
            LDS_WAIT(); asm volatile("" ::: "memory");
            NA a; a.k = KVM + (size_t)b * S * KVMW + h * 256; a.kstride = KVMW; a.k2 = KPE + (size_t)b * S * 64; a.k2stride = 64; a.dq = 128; a.dq2 = 64;
            a.v = KVM + (size_t)b * S * KVMW + h * 256 + 128; a.vstride = KVMW; a.t0 = 0; a.tstep = 1; a.nk = s + 1; a.bias = nullptr; a.brel0 = 0; a.bstep = 0; a.scale = 0.07216878364870322f; a.cmask = 0; a.use_sel = 0;
            float mx, sum, o0, o1; na_run(a, wsm, wsc, F.lane, mx, sum, o0, o1);
            *(unsigned*)(CAT + (size_t)m * 2048 + 1024 + h * 128 + 2 * F.lane) = pk2(o0 / sum, o1 / sum);
        }
    }
    SEAM(5);
    if (IN(6)) { pg8::Gemm g{CAT, W_OUT0, 2048, 2048, 2048}; pg8::StaticOrder So; So.init(M, D, F.G, (int)blockIdx.x); pg8::EpiResid E{x_in, X, D, MOD + 2 * D, 6 * D, S / 256};
        pg8::gemm_phase<pg8::EpiResid, pg8::StaticOrder, true, true>(ring, g, So, E); }
    SEAM(6);
    if (IN(7)) modnorm_phase(F, X, ffn_norm_g, MOD, 3, H);
    SEAM(7);
    if (IN(8)) { pg8::Gemm g{H, W_GU0, D, D, D}; pg8::StaticOrder So; So.init(M, 2 * FF, F.G, (int)blockIdx.x); pg8::EpiSwiGLU E{ACT, FF};
        pg8::gemm_phase<pg8::EpiSwiGLU, pg8::StaticOrder, true, true>(ring, g, So, E); }
    SEAM(8);
    if (IN(9)) { pg8::Gemm g{ACT, W_DN0, FF, FF, FF}; pg8::StaticOrder So; So.init(M, D, F.G, (int)blockIdx.x); pg8::EpiResid E{X, X, D, MOD + 5 * D, 6 * D, S / 256};
        pg8::gemm_phase<pg8::EpiResid, pg8::StaticOrder, true, true>(ring, g, So, E); }
    SEAM(9);
    if (IN(10)) modnorm_phase(F, X, mix_norm_g + D, MOD + 4 * 12288, 0, H);
    SEAM(10);
    if (IN(11)) { pg8::Gemm g{H, W_IN1, D, D, D}; pg8::StaticOrder So; So.init(M, Z1W, F.G, (int)blockIdx.x); pg8::EpiBf16 E{Z1, Z1W, nullptr};
        pg8::gemm_phase<pg8::EpiBf16, pg8::StaticOrder, true, true>(ring, g, So, E); }
    SEAM(11);
    if (IN(12)) {
        for (int it = F.gw; it < M * 8; it += F.NGW) {
            const int h = it & 7, m = it >> 3, b = m / S, s = m % S;
            float om0 = 0.f, om1 = 0.f, lm = -3.0e38f, wsum = 0.f;
#pragma unroll
            for (int p = 0; p < 3; ++p) { const int dil = p == 0 ? 1 : (p == 1 ? 4 : 16);
                const bf16* qr = Z1 + (size_t)m * Z1W + p * 3072 + h * 128; wsm[2 * F.lane] = bf2f(qr[2 * F.lane]); wsm[2 * F.lane + 1] = bf2f(qr[2 * F.lane + 1]); LDS_WAIT(); asm volatile("" ::: "memory");
                const int mq = s / dil, r = s % dil, m0 = mq - 128 < 0 ? 0 : mq - 128;
                NA a; a.k = Z1 + (size_t)b * S * Z1W + p * 3072 + 1024 + h * 128; a.kstride = Z1W; a.k2 = nullptr; a.k2stride = 0; a.dq = 128; a.dq2 = 0;
                a.v = Z1 + (size_t)b * S * Z1W + p * 3072 + 2048 + h * 128; a.vstride = Z1W; a.t0 = m0 * dil + r; a.tstep = dil; a.nk = mq - m0 + 1;
                a.bias = BIAS + (size_t)h * BIAS_LD + 64; a.brel0 = (mq - m0) * dil; a.bstep = dil; a.scale = 0.08838834764831845f; a.cmask = 0; a.use_sel = 0;
                float mx, sum, o0, o1; na_run(a, wsm, wsc, F.lane, mx, sum, o0, o1);
                const float lse = mx + __logf(sum); o0 /= sum; o1 /= sum;
                const float nm = fmaxf(lm, lse), ea = __expf(lm - nm), eb = __expf(lse - nm);
                om0 = om0 * ea + o0 * eb; om1 = om1 * ea + o1 * eb; wsum = wsum * ea + eb; lm = nm; }
            *(unsigned*)(OM + (size_t)m * 1024 + h * 128 + 2 * F.lane) = pk2(om0 / wsum, om1 / wsum);
        }
    }
    SEAM(12);
    if (IN(13)) { pg8::Gemm g{OM, W_OUT1, 1024, 1024, 1024}; pg8::StaticOrder So; So.init(M, D, F.G, (int)blockIdx.x); pg8::EpiResid E{X, X, D, MOD + 4 * 12288 + 2 * D, 6 * D, S / 256};
        pg8::gemm_phase<pg8::EpiResid, pg8::StaticOrder, true, true>(ring, g, So, E); }
    SEAM(13);
    if (IN(14)) {
        for (int m = F.gw; m < M; m += F.NGW) { const int b = m / S; const float* mb = MOD + 4 * 12288 + (size_t)b * 6 * D; f32x4 v[8];
            modnorm_row(X + (size_t)m * D, ffn_norm_g + D, mb + 4 * D, mb + 3 * D, H + (size_t)m * D, F.lane, v);
            float lg[8] = {};
#pragma unroll
            for (int j = 0; j < 8; ++j) { const float* wr_ = w_router + (size_t)(4 * F.lane + 256 * j) * 8;
#pragma unroll
                for (int q = 0; q < 4; ++q) { const f32x4 wa = *(const f32x4*)(wr_ + q * 8), wb = *(const f32x4*)(wr_ + q * 8 + 4); const float hv = v[j][q];
                    lg[0] += hv * wa.x; lg[1] += hv * wa.y; lg[2] += hv * wa.z; lg[3] += hv * wa.w; lg[4] += hv * wb.x; lg[5] += hv * wb.y; lg[6] += hv * wb.z; lg[7] += hv * wb.w; } }
#pragma unroll
            for (int e = 0; e < 8; ++e) lg[e] = wave_sum(lg[e]);
            int e1 = 0; float v1 = lg[0];
#pragma unroll
            for (int e = 1; e < 8; ++e) if (lg[e] > v1) { v1 = lg[e]; e1 = e; }
            int e2 = -1; float v2 = -3.0e38f;
#pragma unroll
            for (int e = 0; e < 8; ++e) if (e != e1 && lg[e] > v2) { v2 = lg[e]; e2 = e; }
            if (F.lane == 0) { const float g1 = 1.0f / (1.0f + __expf(v2 - v1)), g2 = 1.0f - g1;
                const unsigned r1 = atomicAdd(ctl + CW_CNT + e1, 1u), r2 = atomicAdd(ctl + CW_CNT + e2, 1u);
                int* rt = ROUTE + (size_t)m * 8; rt[0] = e1; rt[1] = e2; rt[2] = (int)r1; rt[3] = (int)r2; rt[4] = __float_as_int(g1); rt[5] = __float_as_int(g2); }
        }
    }
    SEAM(14);
    if (IN(15)) {
        unsigned ts[9]; ts[0] = 0;
#pragma unroll
        for (int e = 0; e < 8; ++e) ts[e + 1] = ts[e] + (__hip_atomic_load(ctl + CW_CNT + e, __ATOMIC_RELAXED, __HIP_MEMORY_SCOPE_AGENT) + 255u) / 256u;
        if (blockIdx.x == 0 && F.tid < 9) { unsigned v = ts[0];
#pragma unroll
            for (int e = 1; e < 9; ++e) v = (F.tid == e) ? ts[e] : v;
            ctl[CW_TS + F.tid] = v; }
        for (int m = F.gw; m < M; m += F.NGW) { const int* rt = ROUTE + (size_t)m * 8; const int e1 = rt[0], e2 = rt[1]; unsigned t1 = 0, t2 = 0;
#pragma unroll
            for (int e = 0; e < 8; ++e) { t1 = (e == e1) ? ts[e] : t1; t2 = (e == e2) ? ts[e] : t2; }
            const size_t d1 = (size_t)t1 * 256 + rt[2], d2 = (size_t)t2 * 256 + rt[3];
            const v4u* src = (const v4u*)(H + (size_t)m * D) + F.lane; v4u* o1 = (v4u*)(XB + d1 * D) + F.lane; v4u* o2 = (v4u*)(XB + d2 * D) + F.lane;
#pragma unroll
            for (int j = 0; j < 4; ++j) { const v4u w = src[64 * j]; o1[64 * j] = w; o2[64 * j] = w; } }
    }
    SEAM(15);
    if (IN(16)) { pg8::Gemm g{XB, W_MGU, D, D, D}; pg8::GroupedOrder So; So.init(ctl + CW_TS, 2 * FFE / 256, F.G, (int)blockIdx.x); pg8::EpiSwiGLU E{ACTB, FFE};
        pg8::gemm_phase<pg8::EpiSwiGLU, pg8::GroupedOrder, true, true>(ring, g, So, E); }
    SEAM(16);
    if (IN(17)) { pg8::Gemm g{ACTB, W_MDN, FFE, FFE, FFE}; pg8::GroupedOrder So; So.init(ctl + CW_TS, D / 256, F.G, (int)blockIdx.x); pg8::EpiBf16 E{YB, D, nullptr};
        pg8::gemm_phase<pg8::EpiBf16, pg8::GroupedOrder, true, true>(ring, g, So, E); }
    SEAM(17);
    if (IN(18)) {
        unsigned ts[9]; ts[0] = 0;
#pragma unroll
        for (int e = 0; e < 8; ++e) ts[e + 1] = ctl[CW_TS + e + 1];
        for (int m = F.gw; m < M; m += F.NGW) { const int b = m / S; const int* rt = ROUTE + (size_t)m * 8; const int e1 = rt[0], e2 = rt[1]; unsigned t1 = 0, t2 = 0;
#pragma unroll
            for (int e = 0; e < 8; ++e) { t1 = (e == e1) ? ts[e] : t1; t2 = (e == e2) ? ts[e] : t2; }
            const size_t d1 = (size_t)t1 * 256 + rt[2], d2 = (size_t)t2 * 256 + rt[3]; const float g1 = __int_as_float(rt[4]), g2 = __int_as_float(rt[5]);
            const float* gf = MOD + 4 * 12288 + (size_t)b * 6 * D + 5 * D;
            const f32x4* xr = (const f32x4*)(X + (size_t)m * D) + F.lane; const v2u* y1 = (const v2u*)(YB + d1 * D) + F.lane; const v2u* y2 = (const v2u*)(YB + d2 * D) + F.lane;
            f32x4 v[8]; float ss = 0.f;
#pragma unroll
            for (int j = 0; j < 8; ++j) { const v2u a = y1[64 * j], c2 = y2[64 * j]; const f32x4 gg = ((const f32x4*)gf)[F.lane + 64 * j];
                f32x4 y; y.x = g1 * bflo(a.x) + g2 * bflo(c2.x); y.y = g1 * bfhi(a.x) + g2 * bfhi(c2.x); y.z = g1 * bflo(a.y) + g2 * bflo(c2.y); y.w = g1 * bfhi(a.y) + g2 * bfhi(c2.y);
                v[j] = xr[64 * j] + gg * y; ss += (v[j].x * v[j].x + v[j].y * v[j].y) + (v[j].z * v[j].z + v[j].w * v[j].w); }
            const float rinv = 1.0f / sqrtf(wave_sum(ss) * (1.f / D) + RMS_EPS);
            f32x4* orow = (f32x4*)(args.out + (size_t)m * D) + F.lane;
#pragma unroll
            for (int j = 0; j < 8; ++j) orow[64 * j] = (v[j] * rinv) * ((const f32x4*)final_g)[F.lane + 64 * j]; }
    }
#undef IN
#undef SEAM
}

constexpr int N_PHASES = 19;
extern "C" void kernel_launch(void* const* d_in, const int* in_sizes, int n_in, void* d_out, int out_size, void* d_ws, size_t ws_size, hipStream_t stream) {
    static int grid = 0;
    if (grid == 0) {
        if (n_in != 30 || in_sizes[0] != M * D || out_size != M * D || ws_size < WS_END) { fprintf(stderr, "kernel_launch: shape/workspace mismatch: n_in %d in0 %d out %d ws %zu (need %zu)\n", n_in, n_in > 0 ? in_sizes[0] : -1, out_size, ws_size, (size_t)WS_END); grid = -1; return; }
        int dev = 0, cus = 0, per_cu = 0;
        if (hipGetDevice(&dev) != hipSuccess || hipDeviceGetAttribute(&cus, hipDeviceAttributeMultiprocessorCount, dev) != hipSuccess) { grid = -1; return; }
        if (hipFuncSetAttribute((const void*)fwd, hipFuncAttributeMaxDynamicSharedMemorySize, LDS_BYTES) != hipSuccess) { fprintf(stderr, "kernel_launch: hipFuncSetAttribute failed\n"); grid = -1; return; }
        if (hipOccupancyMaxActiveBlocksPerMultiprocessor(&per_cu, (const void*)fwd, NWAVES * 64, LDS_BYTES) != hipSuccess || per_cu < 1) fprintf(stderr, "kernel_launch: occupancy query reports %d\n", per_cu);
        (void)hipGetLastError();
        grid = cus;
    }
    if (grid < 0) return;
    if (hipMemsetAsync((char*)d_ws + WS_CTL, 0, CTL_ZERO_BYTES, stream) != hipSuccess) return;
    Args a{};
    for (int i = 0; i < 30; ++i) a.in[i] = d_in[i];
    a.out = (float*)d_out; a.ws = (unsigned char*)d_ws;
    if (MK_N_LAUNCHES == 1) { a.ph_lo = 0; a.ph_hi = N_PHASES; hipLaunchKernelGGL(fwd, dim3(grid), dim3(NWAVES * 64), LDS_BYTES, stream, a); }
    else { for (int p = 0; p < N_PHASES; ++p) { a.ph_lo = p; a.ph_hi = p + 1; hipLaunchKernelGGL(fwd, dim3(grid), dim3(NWAVES * 64), LDS_BYTES, stream, a); } }
    const hipError_t le = hipPeekAtLastError();
    if (le != hipSuccess) fprintf(stderr, "kernel_launch: launch failed: %s\n", hipGetErrorName(le));
}
```

```cpp
#include <hip/hip_runtime.h>
#include <cstdio>
#include <cstdint>

#define FLASH_WIN 1
#define FLASH_SLC 1
#define FLASH_MLA 1
#define FLASH_DIL 1
#ifndef MK_N_LAUNCHES
#define MK_N_LAUNCHES 1
#endif

namespace pg8 {
#define PG8_LAS __attribute__((address_space(3)))
typedef unsigned short bf16_t;
typedef short bf16x8 __attribute__((ext_vector_type(8)));
typedef float f32x4 __attribute__((ext_vector_type(4)));
typedef float f32x2 __attribute__((ext_vector_type(2)));
typedef unsigned u32x4 __attribute__((ext_vector_type(4)));
typedef unsigned u32x2 __attribute__((ext_vector_type(2)));
constexpr int BM = 256, BK = 64, HALF = 128, HTB = HALF * BK * 2  , STAGE_BYTES = 8 * HTB, NXCD = 8, WGM = 8;

__host__ __device__ __forceinline__ int lds_byte(int r, int c) { const int st = (r >> 4) * 2 + (c >> 5), rr = r & 15, cc = c & 31, ob = rr * 64 + cc * 2; return st * 1024 + (ob ^ (((ob >> 9) & 1) << 5)); }
__host__ __device__ __forceinline__ void stage_rc(int b, int& R, int& C) { const int st = b / 1024, sb = b % 1024, swz = sb ^ (((sb >> 9) & 1) << 5); R = (st >> 1) * 16 + swz / 64; C = (st & 1) * 32 + (swz % 64) / 2; }
__host__ __device__ __forceinline__ int perm32(int rho) { const int n = rho >> 4, i = rho & 15; return 8 * (i >> 2) + 4 * n + (i & 3); }

struct Unit { int pm, pn, pb; };
struct Gemm { const bf16_t* A; const bf16_t* Bt; int lda, ldb, K; };

struct StaticOrder {
    int nM, nN, nwg, G, c;
    __host__ __device__ void init(int M, int N, int G_, int c_) { nM = M / BM; nN = N / BM; nwg = nM * nN; G = G_; c = c_; }
    __host__ __device__ bool next(int i, Unit& u) const {
        const long L = (long)i * G + c; if (L >= nwg) return false;
        int wgid = (int)L; { const int q = nwg / NXCD, r = nwg % NXCD, xcd = wgid % NXCD, off = wgid / NXCD; wgid = (xcd < r ? xcd * (q + 1) : r * (q + 1) + (xcd - r) * q) + off; }
        const int nig = WGM * nN, gid = wgid / nig, fm = gid * WGM, gsz = (nM - fm) < WGM ? (nM - fm) : WGM;
        u.pm = fm + ((wgid % nig) % gsz); u.pn = (wgid % nig) / gsz; u.pb = u.pn; return true;
    }
    __device__ __forceinline__ void a_ready(const Unit&) const {}
    __device__ __forceinline__ void done(const Unit&) const {}
};
struct GroupedOrder {
    int nN, G, c; int ts[9];
    __device__ __forceinline__ void init(const unsigned* tstart, int nN_, int G_, int c_) { nN = nN_; G = G_; c = c_;
#pragma unroll
        for (int e = 0; e < 9; ++e) ts[e] = (int)tstart[e]; }
    __device__ __forceinline__ bool next(int i, Unit& u) const {
        const long L = (long)i * G + c; if (L >= (long)ts[8] * nN) return false;
        int e = 0, us = 0, te = ts[1] - ts[0], t0 = ts[0];
#pragma unroll
        for (int k = 1; k < 8; ++k) { const int s = ts[k] * nN; if (L >= s) { e = k; us = s; te = ts[k + 1] - ts[k]; t0 = ts[k]; } }
        const int r = (int)L - us; if (te <= 0) return false;
        u.pm = t0 + r % te; u.pn = r / te; u.pb = e * nN + u.pn; return true;
    }
    __device__ __forceinline__ void a_ready(const Unit&) const {}
    __device__ __forceinline__ void done(const Unit&) const {}
};

__device__ __forceinline__ unsigned cvt_pk_bf16(float lo, float hi) { unsigned r; asm volatile("v_cvt_pk_bf16_f32 %0, %1, %2" : "=v"(r) : "v"(lo), "v"(hi)); return r; }

struct EpiBf16 {
    static constexpr bool PERM = true, AFTER_DRAIN = false;
    bf16_t* O; int ldc; const float* rowscale;
    __device__ __forceinline__ void operator()(const f32x4 (&acc)[2][2][4][2], const Unit& u, int wr, int wc, int fr, int fq) const {
        const int row0 = u.pm * BM + wr * 64 + fr; const int col0 = u.pn * BM + wc * 32 + 8 * fq;
#pragma unroll
        for (int ai = 0; ai < 2; ++ai)
#pragma unroll
            for (int m = 0; m < 4; ++m) { const int row = row0 + ai * HALF + m * 16; bf16_t* rowp = O + (size_t)row * ldc + col0; const float sc = rowscale ? rowscale[row] : 1.f;
#pragma unroll
                for (int bj = 0; bj < 2; ++bj) { f32x4 v0 = acc[ai][bj][m][0] * sc, v1 = acc[ai][bj][m][1] * sc;
                    u32x4 w; w.x = cvt_pk_bf16(v0[0], v0[1]); w.y = cvt_pk_bf16(v0[2], v0[3]); w.z = cvt_pk_bf16(v1[0], v1[1]); w.w = cvt_pk_bf16(v1[2], v1[3]);
                    *(u32x4*)(rowp + bj * HALF) = w; } }
    }
};
struct EpiResid {
    static constexpr bool PERM = false, AFTER_DRAIN = false;
    const float* xin; float* xout; int ldc; const float* gate; int gstride; int tiles_per_b;
    __device__ __forceinline__ void operator()(const f32x4 (&acc)[2][2][4][2], const Unit& u, int wr, int wc, int fr, int fq) const {
        const int row0 = u.pm * BM + wr * 64 + fr, col0 = u.pn * BM + wc * 32 + 4 * fq;
        const float* gp = gate + (size_t)(u.pm / tiles_per_b) * gstride + col0;
        f32x4 gv[2][2];
#pragma unroll
        for (int bj = 0; bj < 2; ++bj)
#pragma unroll
            for (int n = 0; n < 2; ++n) gv[bj][n] = *(const f32x4*)(gp + bj * HALF + n * 16);
#pragma unroll
        for (int ai = 0; ai < 2; ++ai)
#pragma unroll
            for (int m = 0; m < 4; ++m) { const size_t off = (size_t)(row0 + ai * HALF + m * 16) * ldc + col0;
#pragma unroll
                for (int bj = 0; bj < 2; ++bj)
#pragma unroll
                    for (int n = 0; n < 2; ++n) { const f32x4 xi = *(const f32x4*)(xin + off + bj * HALF + n * 16);
                        *(f32x4*)(xout + off + bj * HALF + n * 16) = xi + gv[bj][n] * acc[ai][bj][m][n]; }
                asm volatile("" ::: "memory"); }
    }
};
__device__ __forceinline__ float silu_f(float g) { return g * __builtin_amdgcn_rcpf(1.0f + __builtin_amdgcn_exp2f(-1.4426950408889634f * g)); }
struct EpiSwiGLU {
    static constexpr bool PERM = false, AFTER_DRAIN = false;
    bf16_t* O; int ldo;
    __device__ __forceinline__ void operator()(const f32x4 (&acc)[2][2][4][2], const Unit& u, int wr, int wc, int fr, int fq) const {
        const int row0 = u.pm * BM + wr * 64 + fr, col0 = u.pn * HALF + wc * 16 + 4 * fq;
#pragma unroll
        for (int ai = 0; ai < 2; ++ai)
#pragma unroll
            for (int m = 0; m < 4; ++m) { bf16_t* rowp = O + (size_t)(row0 + ai * HALF + m * 16) * ldo + col0;
#pragma unroll
                for (int bj = 0; bj < 2; ++bj) { const f32x4 g = acc[ai][bj][m][0], up = acc[ai][bj][m][1];
                    u32x2 w; w.x = cvt_pk_bf16(silu_f(g[0]) * up[0], silu_f(g[1]) * up[1]); w.y = cvt_pk_bf16(silu_f(g[2]) * up[2], silu_f(g[3]) * up[3]);
                    *(u32x2*)(rowp + bj * 64) = w; } }
    }
};

template <class Epi, class Sched, bool ALIGN_EPI = false, bool SP2 = false>
__device__ __forceinline__ void gemm_phase(PG8_LAS unsigned char* lds, const Gemm g, const Sched& S, const Epi& E) {
    const int tid = threadIdx.x, wid = __builtin_amdgcn_readfirstlane(tid >> 6), lane = tid & 63, wr = wid >> 2, wc = wid & 3, fr = lane & 15, fq = lane >> 4;
    const int K = g.K, nt = K / BK;
    unsigned voffA[2], voffB[2];
#pragma unroll
    for (int i = 0; i < 2; ++i) { int R, C; stage_rc(tid * 16 + i * 8192, R, C); const int Rb = Epi::PERM ? ((R & ~31) + perm32(R & 31)) : R;
        voffA[i] = (unsigned)(R * g.lda + C) * 2u; voffB[i] = (unsigned)(Rb * g.ldb + C) * 2u; }
    const size_t kstep = (size_t)(BK * 2);
    const size_t hstepA = (size_t)HALF * g.lda * 2, hstepB = (size_t)HALF * g.ldb * 2;
    const size_t tstepA = 2 * hstepA, tstepB = 2 * hstepB;
    const unsigned ldsw = (unsigned)wid * 1024u;
    const int aoff = lds_byte(wr * 64 + fr, fq * 8), boff = lds_byte(wc * 32 + fr, fq * 8);
#define PG8_SA(b, h) (((b) * 2 + (h)) * HTB)
#define PG8_SB(b, h) ((4 + (b) * 2 + (h)) * HTB)
#define PG8_STAGE(bufoff, gbase, voff) do { _Pragma("unroll") for (int _i = 0; _i < 2; ++_i) \
        __builtin_amdgcn_global_load_lds((const unsigned*)((const char*)(gbase) + (voff)[_i]), (PG8_LAS unsigned*)(lds + (bufoff) + ldsw + _i * 8192), 16, 0, 0); } while (0)
#define PG8_LDA(dst, b, h) do { _Pragma("unroll") for (int m = 0; m < 4; ++m) _Pragma("unroll") for (int k = 0; k < 2; ++k) dst[m][k] = *(const PG8_LAS bf16x8*)(lds + PG8_SA(b, h) + aoff + m * 2048 + k * 1024); } while (0)
#define PG8_LDB(dst, b, h) do { _Pragma("unroll") for (int n = 0; n < 2; ++n) _Pragma("unroll") for (int k = 0; k < 2; ++k) dst[n][k] = *(const PG8_LAS bf16x8*)(lds + PG8_SB(b, h) + boff + n * 2048 + k * 1024); } while (0)
#define PG8_MMA(ai, bj, At, Bt) do { __builtin_amdgcn_s_setprio(1); _Pragma("unroll") for (int m = 0; m < 4; ++m) _Pragma("unroll") for (int n = 0; n < 2; ++n) _Pragma("unroll") for (int k = 0; k < 2; ++k) \
        acc[ai][bj][m][n] = __builtin_amdgcn_mfma_f32_16x16x32_bf16(Bt[n][k], At[m][k], acc[ai][bj][m][n], 0, 0, 0); __builtin_amdgcn_s_setprio(0); } while (0)
#define PG8_WAIT_V(n) asm volatile("s_waitcnt vmcnt(" #n ")" ::: "memory")
#define PG8_WAIT_L(n) asm volatile("s_waitcnt lgkmcnt(" #n ")" ::: "memory")
#define PG8_BAR __builtin_amdgcn_s_barrier()
#define PG8_SCHED __builtin_amdgcn_sched_barrier(0)
    Unit cur, nxt; int ui = 0;
    if (!S.next(0, cur)) return;
    f32x4 acc[2][2][4][2];
#pragma unroll
    for (int a = 0; a < 2; ++a)
#pragma unroll
        for (int b = 0; b < 2; ++b)
#pragma unroll
            for (int m = 0; m < 4; ++m)
#pragma unroll
                for (int n = 0; n < 2; ++n) acc[a][b][m][n] = (f32x4){0.f, 0.f, 0.f, 0.f};
    bf16x8 At[4][2], B0[2][2], B1[2][2];
    const char* cA = (const char*)g.A + (size_t)cur.pm * tstepA; const char* cB = (const char*)g.Bt + (size_t)cur.pb * tstepB;
    S.a_ready(cur);
    if constexpr (SP2) {
        PG8_STAGE(PG8_SB(0, 0), cB, voffB); PG8_STAGE(PG8_SB(0, 1), cB + hstepB, voffB); PG8_STAGE(PG8_SA(0, 0), cA, voffA); PG8_STAGE(PG8_SA(0, 1), cA + hstepA, voffA);
        if (wr == 1) PG8_BAR;
        PG8_WAIT_V(2); PG8_BAR;
        PG8_STAGE(PG8_SB(1, 0), cB + kstep, voffB); PG8_STAGE(PG8_SA(1, 0), cA + kstep, voffA); PG8_STAGE(PG8_SB(1, 1), cB + hstepB + kstep, voffB);
        PG8_WAIT_V(6); PG8_BAR;
    } else {
        PG8_STAGE(PG8_SB(0, 0), cB, voffB); PG8_STAGE(PG8_SA(0, 0), cA, voffA); PG8_STAGE(PG8_SB(0, 1), cB + hstepB, voffB); PG8_STAGE(PG8_SA(0, 1), cA + hstepA, voffA);
        if (wr == 1) PG8_BAR;
        PG8_WAIT_V(4); PG8_BAR;
        PG8_STAGE(PG8_SB(1, 0), cB + kstep, voffB); PG8_STAGE(PG8_SA(1, 0), cA + kstep, voffA); PG8_STAGE(PG8_SB(1, 1), cB + hstepB + kstep, voffB);
        PG8_WAIT_V(6); PG8_BAR;
    }
    for (;;) {
        const bool has_next = S.next(ui + 1, nxt);
        const char* nA = has_next ? (const char*)g.A + (size_t)nxt.pm * tstepA : cA; const char* nB = has_next ? (const char*)g.Bt + (size_t)nxt.pb * tstepB : cB;
        for (int t = 0; t < nt; t += 2) {
            const bool last = (t == nt - 2);
            const char* a1 = cA + (size_t)(t + 1) * kstep;
            const char* a2 = last ? nA : cA + (size_t)(t + 2) * kstep; const char* b2 = last ? nB : cB + (size_t)(t + 2) * kstep;
            const char* a3 = a2 + kstep; const char* b3 = b2 + kstep;
            if (last && has_next) S.a_ready(nxt);
            if constexpr (SP2) {
            PG8_LDB(B0, 0, 0); PG8_LDB(B1, 0, 1); PG8_SCHED; PG8_LDA(At, 0, 0); PG8_STAGE(PG8_SA(1, 1), a1 + hstepA, voffA);
            PG8_WAIT_V(8); PG8_WAIT_L(0); PG8_BAR; PG8_MMA(0, 0, At, B0); PG8_MMA(0, 1, At, B1); PG8_BAR; PG8_SCHED;
            PG8_LDA(At, 0, 1); PG8_STAGE(PG8_SB(0, 0), b2, voffB); PG8_STAGE(PG8_SB(0, 1), b2 + hstepB, voffB); PG8_STAGE(PG8_SA(0, 0), a2, voffA);
            PG8_WAIT_V(8); PG8_WAIT_L(0); PG8_BAR; PG8_MMA(1, 0, At, B0); PG8_MMA(1, 1, At, B1); PG8_BAR; PG8_SCHED;
            PG8_LDB(B0, 1, 0); PG8_LDB(B1, 1, 1); PG8_SCHED; PG8_LDA(At, 1, 0); PG8_STAGE(PG8_SA(0, 1), a2 + hstepA, voffA);
            PG8_WAIT_V(8); PG8_WAIT_L(0); PG8_BAR; PG8_MMA(0, 0, At, B0); PG8_MMA(0, 1, At, B1); PG8_BAR; PG8_SCHED;
            PG8_LDA(At, 1, 1); PG8_STAGE(PG8_SB(1, 0), b3, voffB); PG8_STAGE(PG8_SB(1, 1), b3 + hstepB, voffB); PG8_STAGE(PG8_SA(1, 0), a3, voffA);
            PG8_WAIT_V(8); PG8_WAIT_L(0); PG8_BAR; PG8_MMA(1, 0, At, B0); PG8_MMA(1, 1, At, B1); PG8_BAR; PG8_SCHED;
            } else {
            PG8_LDB(B0, 0, 0); PG8_SCHED; PG8_LDA(At, 0, 0); PG8_STAGE(PG8_SA(1, 1), a1 + hstepA, voffA);
            PG8_WAIT_L(8); PG8_BAR; PG8_WAIT_L(0); PG8_MMA(0, 0, At, B0); PG8_BAR; PG8_SCHED;
            PG8_LDB(B1, 0, 1); PG8_STAGE(PG8_SB(0, 0), b2, voffB);
            PG8_BAR; PG8_WAIT_L(0); PG8_MMA(0, 1, At, B1); PG8_BAR;
            PG8_LDA(At, 0, 1); PG8_STAGE(PG8_SA(0, 0), a2, voffA);
            PG8_BAR; PG8_WAIT_L(0); PG8_MMA(1, 0, At, B0); PG8_BAR; PG8_SCHED;
            PG8_STAGE(PG8_SB(0, 1), b2 + hstepB, voffB);
            PG8_WAIT_V(6); PG8_BAR; PG8_MMA(1, 1, At, B1); PG8_BAR;
            PG8_LDB(B0, 1, 0); PG8_SCHED; PG8_LDA(At, 1, 0); PG8_STAGE(PG8_SA(0, 1), a2 + hstepA, voffA);
            PG8_WAIT_L(8); PG8_BAR; PG8_WAIT_L(0); PG8_MMA(0, 0, At, B0); PG8_BAR; PG8_SCHED;
            PG8_LDB(B1, 1, 1); PG8_STAGE(PG8_SB(1, 0), b3, voffB);
            PG8_BAR; PG8_WAIT_L(0); PG8_MMA(0, 1, At, B1); PG8_BAR;
            PG8_LDA(At, 1, 1); PG8_STAGE(PG8_SA(1, 0), a3, voffA);
            PG8_BAR; PG8_WAIT_L(0); PG8_MMA(1, 0, At, B0); PG8_BAR; PG8_SCHED;
            PG8_STAGE(PG8_SB(1, 1), b3 + hstepB, voffB);
            PG8_WAIT_V(6); PG8_BAR; PG8_MMA(1, 1, At, B1); PG8_BAR;
            }
        }
        if constexpr (ALIGN_EPI) { if (wr == 0) PG8_BAR; }
        if constexpr (!Epi::AFTER_DRAIN) { E(acc, cur, wr, wc, fr, fq); S.done(cur); }
        if (!has_next) break;
#pragma unroll
        for (int a = 0; a < 2; ++a)
#pragma unroll
            for (int b = 0; b < 2; ++b)
#pragma unroll
                for (int m = 0; m < 4; ++m)
#pragma unroll
                    for (int n = 0; n < 2; ++n) acc[a][b][m][n] = (f32x4){0.f, 0.f, 0.f, 0.f};
        cur = nxt; cA = nA; cB = nB; ++ui;
        if constexpr (ALIGN_EPI) { if (wr == 1) PG8_BAR; }
    }
    PG8_WAIT_V(0);
    if constexpr (!ALIGN_EPI) { if (wr == 0) PG8_BAR; }
    PG8_BAR;
    if constexpr (Epi::AFTER_DRAIN) { E.fused(acc, cur, wr, wc, fr, fq, lds, wid, lane); S.done(cur); }
#undef PG8_SA
#undef PG8_SB
#undef PG8_STAGE
#undef PG8_LDA
#undef PG8_LDB
#undef PG8_MMA
#undef PG8_WAIT_V
#undef PG8_WAIT_L
#undef PG8_BAR
#undef PG8_SCHED
}

}

#ifndef FA_DBG_NOSEL
#define FA_DBG_NOSEL 0
#endif
#ifndef FA_DBG_NOMERGE
#define FA_DBG_NOMERGE 0
#endif
#ifndef FA_SEL_SKIP
#define FA_SEL_SKIP 0
#endif
namespace fa {
#define FA_LAS __attribute__((address_space(3)))
typedef unsigned short bf16;
typedef short bf16x8 __attribute__((ext_vector_type(8)));
typedef short s16x4 __attribute__((ext_vector_type(4)));
typedef float f32x16 __attribute__((ext_vector_type(16)));
typedef float f32x4 __attribute__((ext_vector_type(4)));
typedef unsigned u32x4 __attribute__((ext_vector_type(4)));
constexpr int QB = 256, QBLK = 32, KVBLK = 64;
constexpr int SHM_K = 16384, SHM_V = 16384, SHM_K2 = 8192;
constexpr int OFF_V = 0, OFF_K = 2 * SHM_V, OFF_K2 = OFF_K + 2 * SHM_K, OFF_WS = OFF_K2 + 2 * SHM_K2, WS_PER_WAVE = 1024, OFF_TAB = OFF_WS + 8 * WS_PER_WAVE;
constexpr int TAB_PAD = 320, TAB_MAX = 4096 + TAB_PAD;
constexpr int LDS_END = OFF_TAB + TAB_MAX * 4;
constexpr int OSTG = 272;
static_assert(LDS_END <= 131072 && 8 * 32 * OSTG <= OFF_WS, "attention LDS map");
#define KSWZ(row, colB) ((row) * 256 + ((colB) ^ (((row) & 7) << 4)))
#define K2SWZ(row, colB) ((row) * 128 + ((colB) ^ (((row) & 7) << 4)))
#define SBAR() __builtin_amdgcn_sched_barrier(0)
__device__ __forceinline__ int v_st(int k, int c) { const int kk = (k & ~0xC) | ((k & 4) << 1) | ((k & 8) >> 1); return ((kk >> 3) * 4 + (c >> 5)) * 512 + ((kk & 7) * 32 + (c & 31)) * 2; }
__device__ __forceinline__ int v_rd_base(int lane) { return ((lane & 3) << 3) | (((lane >> 2) & 3) << 6) | (((lane >> 4) & 1) << 5) | (((lane >> 5) & 1) << 8); }
constexpr int v_rd_off(int d0, int ks, int half) { return d0 * 512 + ks * 4096 + half * 2048; }
__device__ __forceinline__ int crow(int r, int hi) { return (r & 3) + 8 * (r >> 2) + 4 * hi; }
__device__ __forceinline__ unsigned cvtpk(float lo, float hi) { unsigned r; asm volatile("v_cvt_pk_bf16_f32 %0, %1, %2" : "=v"(r) : "v"(lo), "v"(hi)); return r; }

struct Item {
    const bf16* Q; long qs;
    const float* rope; long ropes;
    const bf16* K; long ks; const bf16* K2; long k2s; const bf16* V; long vs;
    int P0, skv, W;
    const float* bias; int bstep;
    const unsigned long long* sel; long sels;
    bf16* O; long os;
    float* LSE; long lses;
    const bf16* M0; const bf16* M1; long ms; const bf16* G; long gs;
};

template <int VAR>
__device__ __forceinline__ void attn_block(const Item& it, unsigned char* lds_g) {
    constexpr bool HAS_BIAS = VAR != 2, HAS_SEL = VAR == 1, HAS_K2 = VAR == 2;
    constexpr float SCALE = HAS_K2 ? 0.07216878364870322f : 0.08838834764831845f, C2 = 1.4426950408889634f * SCALE, THR = 8.f;
    FA_LAS unsigned char* L = (FA_LAS unsigned char*)lds_g;
    const int tid = threadIdx.x, wid = __builtin_amdgcn_readfirstlane(tid >> 6), lane = tid & 63, r32 = lane & 31, hi = lane >> 5;
    const int W = it.W;
    const int j_lo = (it.P0 - W + 1 > 0) ? (it.P0 - W + 1) / KVBLK : 0;
    int j_hi = (it.P0 + QB - 1) / KVBLK + 1; if (j_hi > it.skv / KVBLK) j_hi = it.skv / KVBLK;
    const int NT = j_hi - j_lo;
    const int qlo = it.P0 + wid * QBLK, qm = qlo + r32 - 4 * hi;
    FA_LAS float* wsl = (FA_LAS float*)(L + OFF_WS + wid * WS_PER_WAVE); FA_LAS float* li_l = wsl; FA_LAS float* al_l = wsl + 32;
    FA_LAS float* tab = (FA_LAS float*)(L + OFF_TAB);
    const int sr = tid >> 4, sc = (tid & 15) * 8, vst0 = v_st(sr, sc), vst1 = v_st(32 + sr, sc), kws = KSWZ(sr, sc * 2);
    const int k2r = tid >> 3, k2c = (tid & 7) * 8, k2ws = K2SWZ(k2r, k2c * 2);
    const int vb0 = OFF_V + v_rd_base(lane);
    bf16x8 qr[8]; bf16x8 qr2[4];
    { const bf16* qp = it.Q + (long)(qlo + r32) * it.qs + hi * 8;
#pragma unroll
      for (int d0 = 0; d0 < 8; ++d0) qr[d0] = *(const bf16x8*)(qp + d0 * 16);
      if constexpr (HAS_K2) {
          const float* rp = it.rope + (long)(qlo + r32) * it.ropes + hi * 8;
          bf16x8 raw[4];
#pragma unroll
          for (int d0 = 0; d0 < 4; ++d0) raw[d0] = *(const bf16x8*)(qp + 128 + d0 * 16);
#pragma unroll
          for (int d0 = 0; d0 < 2; ++d0) { const f32x4 c0 = *(const f32x4*)(rp + d0 * 16), c1 = *(const f32x4*)(rp + d0 * 16 + 4), s0 = *(const f32x4*)(rp + 32 + d0 * 16), s1 = *(const f32x4*)(rp + 32 + d0 * 16 + 4);
              float o1[8], o2[8];
#pragma unroll
              for (int j = 0; j < 8; ++j) { const float x1 = __builtin_bit_cast(float, (unsigned)(unsigned short)raw[d0][j] << 16), x2 = __builtin_bit_cast(float, (unsigned)(unsigned short)raw[d0 + 2][j] << 16);
                  const float cs = j < 4 ? c0[j & 3] : c1[j & 3], sn = j < 4 ? s0[j & 3] : s1[j & 3]; o1[j] = x1 * cs - x2 * sn; o2[j] = x2 * cs + x1 * sn; }
              u32x4 w1 = {cvtpk(o1[0], o1[1]), cvtpk(o1[2], o1[3]), cvtpk(o1[4], o1[5]), cvtpk(o1[6], o1[7])}, w2 = {cvtpk(o2[0], o2[1]), cvtpk(o2[2], o2[3]), cvtpk(o2[4], o2[5]), cvtpk(o2[6], o2[7])};
              qr2[d0] = __builtin_bit_cast(bf16x8, w1); qr2[d0 + 2] = __builtin_bit_cast(bf16x8, w2); }
      }
    }
    unsigned long long selm = ~0ull;
    if constexpr (HAS_SEL) selm = __hip_atomic_load(it.sel + (long)(qlo + r32) * it.sels, __ATOMIC_RELAXED, __HIP_MEMORY_SCOPE_AGENT);
    if constexpr (HAS_BIAS) {
        int rmax = W + 320; if (rmax > 4096) rmax = 4096;
        for (int i = tid; i < rmax + TAB_PAD; i += 512) { int r = i - TAB_PAD; r = r < -64 ? -64 : r; long gi = (long)r * it.bstep; gi = gi > 4095 ? 4095 : gi; tab[i] = it.bias[gi] * (1.0f / SCALE); }
    }
    bf16x8 st_k0, st_k1, st_v0, st_v1, st_k2;
#define FA_LOAD(kb_) do { const long r0_ = (long)((kb_) + sr), r1_ = r0_ + 32; \
        st_v0 = *(const bf16x8*)(it.V + r0_ * it.vs + sc); st_v1 = *(const bf16x8*)(it.V + r1_ * it.vs + sc); \
        st_k0 = *(const bf16x8*)(it.K + r0_ * it.ks + sc); st_k1 = *(const bf16x8*)(it.K + r1_ * it.ks + sc); \
        if constexpr (HAS_K2) st_k2 = *(const bf16x8*)(it.K2 + (long)((kb_) + k2r) * it.k2s + k2c); } while (0)
#define FA_WRITE(bf_) do { *(FA_LAS bf16x8*)(L + OFF_V + (bf_) * SHM_V + vst0) = st_v0; *(FA_LAS bf16x8*)(L + OFF_V + (bf_) * SHM_V + vst1) = st_v1; \
        *(FA_LAS bf16x8*)(L + OFF_K + (bf_) * SHM_K + kws) = st_k0; *(FA_LAS bf16x8*)(L + OFF_K + (bf_) * SHM_K + kws + 32 * 256) = st_k1; \
        if constexpr (HAS_K2) *(FA_LAS bf16x8*)(L + OFF_K2 + (bf_) * SHM_K2 + k2ws) = st_k2; } while (0)
    FA_LOAD(j_lo * KVBLK);
    asm volatile("s_waitcnt vmcnt(0)" ::: "memory");
    FA_WRITE(0);
    __syncthreads();
    float m_reg = -1e30f, l_reg = 0.f; f32x16 o[4] = {};
#define FA_KBASE(t) ((j_lo + (t)) * KVBLK)
#define FA_STEP(BUF, t) do { \
        const int kb_ = FA_KBASE(t); \
        if ((t) + 1 < NT) FA_LOAD(FA_KBASE((t) + 1)); \
        bool act_ = (kb_ <= qlo + QBLK - 1) && (kb_ + KVBLK - 1 >= qlo - W + 1); \
        bool allow_ = true; \
        if constexpr (HAS_SEL) { allow_ = FA_DBG_NOSEL ? true : (bool)((selm >> (kb_ >> 6)) & 1ull); if (FA_SEL_SKIP) act_ = act_ && __any(allow_); } \
        if (act_) { \
            f32x16 p0 = {}, p1 = {}; \
            { const int ka_ = OFF_K + (BUF) * SHM_K; \
              _Pragma("unroll") for (int d0 = 0; d0 < 8; ++d0) { \
                const bf16x8 b0 = *(const FA_LAS bf16x8*)(L + ka_ + KSWZ(r32, (d0 * 16 + hi * 8) * 2)); \
                const bf16x8 b1 = *(const FA_LAS bf16x8*)(L + ka_ + 32 * 256 + KSWZ(r32, (d0 * 16 + hi * 8) * 2)); \
                p0 = __builtin_amdgcn_mfma_f32_32x32x16_bf16(b0, qr[d0], p0, 0, 0, 0); p1 = __builtin_amdgcn_mfma_f32_32x32x16_bf16(b1, qr[d0], p1, 0, 0, 0); } \
              if constexpr (HAS_K2) { const int k2a_ = OFF_K2 + (BUF) * SHM_K2; \
                _Pragma("unroll") for (int d0 = 0; d0 < 4; ++d0) { \
                  const bf16x8 b0 = *(const FA_LAS bf16x8*)(L + k2a_ + K2SWZ(r32, (d0 * 16 + hi * 8) * 2)); \
                  const bf16x8 b1 = *(const FA_LAS bf16x8*)(L + k2a_ + 32 * 128 + K2SWZ(r32, (d0 * 16 + hi * 8) * 2)); \
                  p0 = __builtin_amdgcn_mfma_f32_32x32x16_bf16(b0, qr2[d0], p0, 0, 0, 0); p1 = __builtin_amdgcn_mfma_f32_32x32x16_bf16(b1, qr2[d0], p1, 0, 0, 0); } } } \
            const int dq_ = qm - kb_; \
            if constexpr (HAS_BIAS) { const FA_LAS float* tb_ = tab + (TAB_PAD + dq_ - 63); \
                _Pragma("unroll") for (int r = 0; r < 16; ++r) { const int c_ = (r & 3) + 8 * (r >> 2); p0[r] += tb_[63 - c_]; p1[r] += tb_[31 - c_]; } } \
            if (HAS_SEL || kb_ + KVBLK - 1 > qlo || kb_ <= qlo + QBLK - 1 - W) { const float NEG_ = -__builtin_inff(); const int dqm_ = allow_ ? dq_ : -0x40000000; \
                _Pragma("unroll") for (int r = 0; r < 16; ++r) { const int c_ = (r & 3) + 8 * (r >> 2); \
                    if ((unsigned)(dqm_ - c_) >= (unsigned)W) p0[r] = NEG_; if ((unsigned)(dqm_ - c_ - 32) >= (unsigned)W) p1[r] = NEG_; } } \
              \
            float pmax_ = p0[0]; _Pragma("unroll") for (int r = 1; r < 16; ++r) pmax_ = fmaxf(pmax_, p0[r]); _Pragma("unroll") for (int r = 0; r < 16; ++r) pmax_ = fmaxf(pmax_, p1[r]); \
            { auto rr_ = __builtin_amdgcn_permlane32_swap(__float_as_uint(pmax_), __float_as_uint(pmax_), false, false); pmax_ = fmaxf(__uint_as_float(rr_[0]), __uint_as_float(rr_[1])); } \
            float mn_, alpha_; \
            if (__all((pmax_ - m_reg) * SCALE <= THR)) { mn_ = m_reg; alpha_ = 1.f; } \
            else { mn_ = fmaxf(m_reg, pmax_); alpha_ = __builtin_amdgcn_exp2f((m_reg - mn_) * C2); m_reg = mn_; } \
            const float mnL_ = -mn_ * C2; float ps_ = 0.f; \
            _Pragma("unroll") for (int r = 0; r < 16; ++r) { p0[r] = __builtin_amdgcn_exp2f(fmaf(p0[r], C2, mnL_)); p1[r] = __builtin_amdgcn_exp2f(fmaf(p1[r], C2, mnL_)); ps_ += p0[r] + p1[r]; } \
            { auto rr_ = __builtin_amdgcn_permlane32_swap(__float_as_uint(ps_), __float_as_uint(ps_), false, false); ps_ = __uint_as_float(rr_[0]) + __uint_as_float(rr_[1]); } \
            l_reg = l_reg * alpha_ + ps_; \
            bf16x8 pa0, pa1, pa2, pa3; \
            FA_PK4(p0, 0, pa0); FA_PK4(p0, 8, pa1); FA_PK4(p1, 0, pa2); FA_PK4(p1, 8, pa3); \
            if (__any(alpha_ < 1.f)) { if (hi == 0) al_l[r32] = alpha_; asm volatile("s_waitcnt lgkmcnt(0)" ::: "memory"); \
                _Pragma("unroll") for (int d_ = 0; d_ < 4; ++d_) _Pragma("unroll") for (int r = 0; r < 16; ++r) o[d_][r] *= al_l[crow(r, hi)]; } \
            FA_PV_D0(BUF, 0); FA_PV_D0(BUF, 1); FA_PV_D0(BUF, 2); FA_PV_D0(BUF, 3); \
        } \
        if ((t) + 1 < NT) { asm volatile("s_waitcnt vmcnt(0)" ::: "memory"); FA_WRITE(1 - (BUF)); } \
        __syncthreads(); } while (0)
#define FA_PK4(P, B_, OUT) do { unsigned a0 = cvtpk(P[B_+0], P[B_+1]), a1 = cvtpk(P[B_+2], P[B_+3]); unsigned b0 = cvtpk(P[B_+4], P[B_+5]), b1 = cvtpk(P[B_+6], P[B_+7]); \
        auto r0 = __builtin_amdgcn_permlane32_swap(a0, b0, false, false); auto r1 = __builtin_amdgcn_permlane32_swap(a1, b1, false, false); \
        u32x4 w = {r0[0], r1[0], r0[1], r1[1]}; OUT = __builtin_bit_cast(bf16x8, w); } while (0)
#define FA_TRRD(dst, off) asm volatile("ds_read_b64_tr_b16 %0, %1 offset:%2" : "=&v"(dst) : "v"(vb0), "i"(off) : "memory")
#define FA_PV_D0(VB, d0) do { s16x4 l0, l1, l2, l3, h0, h1, h2, h3; constexpr int b_ = (VB) * SHM_V + v_rd_off(d0, 0, 0); \
        FA_TRRD(l0, b_); FA_TRRD(h0, b_ + 2048); FA_TRRD(l1, b_ + 4096); FA_TRRD(h1, b_ + 6144); FA_TRRD(l2, b_ + 8192); FA_TRRD(h2, b_ + 10240); FA_TRRD(l3, b_ + 12288); FA_TRRD(h3, b_ + 14336); \
        asm volatile("s_waitcnt lgkmcnt(0)" ::: "memory"); SBAR(); \
        o[d0] = __builtin_amdgcn_mfma_f32_32x32x16_bf16(pa0, (bf16x8){l0[0], l0[1], l0[2], l0[3], h0[0], h0[1], h0[2], h0[3]}, o[d0], 0, 0, 0); \
        o[d0] = __builtin_amdgcn_mfma_f32_32x32x16_bf16(pa1, (bf16x8){l1[0], l1[1], l1[2], l1[3], h1[0], h1[1], h1[2], h1[3]}, o[d0], 0, 0, 0); \
        o[d0] = __builtin_amdgcn_mfma_f32_32x32x16_bf16(pa2, (bf16x8){l2[0], l2[1], l2[2], l2[3], h2[0], h2[1], h2[2], h2[3]}, o[d0], 0, 0, 0); \
        o[d0] = __builtin_amdgcn_mfma_f32_32x32x16_bf16(pa3, (bf16x8){l3[0], l3[1], l3[2], l3[3], h3[0], h3[1], h3[2], h3[3]}, o[d0], 0, 0, 0); } while (0)
    for (int t = 0; t < NT; t += 2) { FA_STEP(0, t); if (t + 1 < NT) FA_STEP(1, t + 1); }
    li_l[r32] = l_reg;
    if constexpr (VAR == 1) { const bf16* gp = it.G + (long)(qlo + r32) * it.gs;
#pragma unroll
        for (int k = 0; k < 3; ++k) { const float gl = __builtin_bit_cast(float, (unsigned)gp[k] << 16); wsl[64 + 32 * k + r32] = 1.0f / (1.0f + __expf(-gl)); } }
    asm volatile("s_waitcnt lgkmcnt(0)" ::: "memory");
    if (it.LSE && hi == 0) it.LSE[(long)(qlo + r32) * it.lses] = m_reg * SCALE + __logf(l_reg);
    FA_LAS unsigned char* stg = L + wid * (32 * OSTG);
#pragma unroll
    for (int r = 0; r < 16; ++r) { const int orow = crow(r, hi); const float lv_ = li_l[orow]; float rl = lv_ > 0.f ? __builtin_amdgcn_rcpf(lv_) : 0.f; if constexpr (VAR == 1 && !FA_DBG_NOMERGE) rl *= wsl[64 + 32 + orow];
#pragma unroll
        for (int d0 = 0; d0 < 4; ++d0) { const float v = o[d0][r] * rl; const unsigned u = __builtin_bit_cast(unsigned, v); *(FA_LAS unsigned short*)(stg + orow * OSTG + (d0 * 32 + r32) * 2) = (unsigned short)((u + 0x7fffu + ((u >> 16) & 1u)) >> 16); } }
    asm volatile("s_waitcnt lgkmcnt(0)" ::: "memory");
#pragma unroll
    for (int i = 0; i < 8; ++i) { const int id = lane + 64 * i, row = id >> 4, ch = id & 15; const long qi = (long)(qlo + row);
        u32x4 w = *(const FA_LAS u32x4*)(stg + row * OSTG + ch * 16);
        if constexpr (VAR == 1 && !FA_DBG_NOMERGE) { const float g0 = wsl[64 + row], g2 = wsl[64 + 64 + row];
            const u32x4 a = *(const u32x4*)(it.M0 + qi * it.ms + ch * 8), c = *(const u32x4*)(it.M1 + qi * it.ms + ch * 8);
#pragma unroll
            for (int k = 0; k < 4; ++k) { const float lo = __builtin_bit_cast(float, w[k] << 16) + g0 * __builtin_bit_cast(float, a[k] << 16) + g2 * __builtin_bit_cast(float, c[k] << 16);
                const float hi_ = __builtin_bit_cast(float, w[k] & 0xffff0000u) + g0 * __builtin_bit_cast(float, a[k] & 0xffff0000u) + g2 * __builtin_bit_cast(float, c[k] & 0xffff0000u); w[k] = cvtpk(lo, hi_); } }
        *(u32x4*)(it.O + qi * it.os + ch * 8) = w; }
    __syncthreads();
#undef FA_LOAD
#undef FA_WRITE
#undef FA_KBASE
#undef FA_STEP
#undef FA_PK4
#undef FA_TRRD
#undef FA_PV_D0
}
}

constexpr int D = 2048, NB = 4, S = 4096, M = NB * S;
constexpr int HD = 128;
constexpr int Z0W = 3840;
constexpr int Z_NQ = 0, Z_NKV = 1024, Z_QLAT = 2560, Z_KVLAT = 3072, Z_KPE = 3584, Z_NG = 3648;
constexpr int QMW = 1536, KVMW = 2048;
constexpr int FF = 5632, FFE = 7168, NE = 8;
constexpr int Z1W = 9216;
constexpr int NSLOT = (2 * M / 256 + NE) * 256;
constexpr float RMS_EPS = 1e-6f;

constexpr size_t MiB = 1u << 20;
constexpr size_t WS_CTL = 0, CTL_ZERO_BYTES = 1 * MiB;
constexpr size_t WS_MOD = 1 * MiB;
constexpr size_t WS_BIAS = 2 * MiB;
constexpr int BIAS_LD = 4096 + 64;
constexpr size_t WS_ROPE = 3 * MiB;
constexpr size_t WS_RINV = 8 * MiB;
constexpr size_t WS_SEL = 9 * MiB;
constexpr size_t WS_KC = 10 * MiB;
constexpr size_t WS_VC = 11 * MiB;
constexpr size_t WS_ROUTE = 12 * MiB;
constexpr size_t WS_LSE = 13 * MiB;
constexpr size_t WS_KPE = 15 * MiB;
constexpr size_t WS_WIN0 = 21 * MiB, WS_WUQ = 36 * MiB, WS_WUKV = 38 * MiB, WS_WOUT0 = 40 * MiB, WS_WGU0 = 48 * MiB, WS_WDN0 = 92 * MiB;
constexpr size_t WS_WIN1 = 114 * MiB, WS_WOUT1 = 150 * MiB, WS_WMGU = 154 * MiB, WS_WMDN = 602 * MiB;
constexpr size_t WS_X = 826 * MiB;
constexpr size_t WS_H = 954 * MiB;
constexpr size_t WS_R = 1018 * MiB;
constexpr size_t WS_Z0 = WS_R, WS_QM = WS_R + 120 * MiB, WS_KVM = WS_R + 168 * MiB, WS_OCMP = WS_R + 232 * MiB, WS_OWIN = WS_R + 264 * MiB, WS_CAT = WS_R + 328 * MiB;
constexpr size_t WS_ACT = WS_R;
constexpr size_t WS_Z1 = WS_R, WS_OP = WS_R + 288 * MiB, WS_OM = WS_R + 384 * MiB;
constexpr size_t WS_XB = WS_R, WS_ACTB = WS_R + 136 * MiB, WS_YB = WS_R;
constexpr size_t WS_END = WS_R + 612 * MiB;
static_assert(WS_Z0 + (size_t)M * Z0W * 2 <= WS_QM && WS_QM + (size_t)M * QMW * 2 <= WS_KVM && WS_KVM + (size_t)M * KVMW * 2 <= WS_OCMP && WS_CAT + (size_t)M * 2048 * 2 <= WS_END, "L0 map");
static_assert(WS_Z1 + (size_t)M * Z1W * 2 <= WS_OM && WS_XB + (size_t)NSLOT * D * 2 <= WS_ACTB && WS_ACTB + (size_t)NSLOT * FFE * 2 <= WS_END, "L1 map");
static_assert(WS_WMDN + (size_t)NE * D * FFE * 2 <= WS_X && WS_WMGU + (size_t)NE * 2 * FFE * D * 2 <= WS_WMDN, "weights map");
constexpr int CW_BAR = 4096;
constexpr int CW_CNT = 64;
constexpr int CW_TS = 128;

constexpr int RING_BYTES = 131072;
constexpr int SMALL_OFF = RING_BYTES;
constexpr int LDSCTL_OFF = RING_BYTES + 16384, MISC_OFF = LDSCTL_OFF;
constexpr int LDS_BYTES = LDSCTL_OFF + 256;
constexpr int NWAVES = 8;

#define GAS __attribute__((address_space(1)))
#define LAS __attribute__((address_space(3)))
typedef unsigned short bf16;
typedef unsigned v4u __attribute__((ext_vector_type(4)));
typedef unsigned v2u __attribute__((ext_vector_type(2)));
typedef float f32x4 __attribute__((ext_vector_type(4)));
typedef float f32x2 __attribute__((ext_vector_type(2)));
#define LDS_WAIT() asm volatile("s_waitcnt lgkmcnt(0)" ::: "memory")
__device__ __forceinline__ unsigned f2bf(float f) { unsigned u = __builtin_bit_cast(unsigned, f); return (u + 0x7fffu + ((u >> 16) & 1u)) >> 16; }
__device__ __forceinline__ unsigned pk2(float lo, float hi) { return f2bf(lo) | (f2bf(hi) << 16); }
__device__ __forceinline__ float bf2f(unsigned short b) { return __builtin_bit_cast(float, (unsigned)b << 16); }
__device__ __forceinline__ float bflo(unsigned w) { return __builtin_bit_cast(float, w << 16); }
__device__ __forceinline__ float bfhi(unsigned w) { return __builtin_bit_cast(float, w & 0xffff0000u); }
__device__ __forceinline__ float wave_sum(float v) {
#pragma unroll
    for (int o = 1; o < 64; o <<= 1) v += __shfl_xor(v, o);
    return v;
}
__device__ __forceinline__ float wave_max(float v) {
#pragma unroll
    for (int o = 1; o < 64; o <<= 1) v = fmaxf(v, __shfl_xor(v, o));
    return v;
}

#define XB_TMO      128
#define XB_XCNT(j)  (256  + 64 * (j))
#define XB_XSUB(j)  (1280 + 64 * (j))
#define XB_XGEN(j)  (2304 + 64 * (j))
#define XB_TOP      3328
#define XB_TOPGEN   3392
#define XCD_BAR_WORDS 3456
#define XB_SPIN_CAP (1u << 22)

__device__ __forceinline__ unsigned xb_ld(unsigned* p)              { return __hip_atomic_load(p, __ATOMIC_RELAXED, __HIP_MEMORY_SCOPE_AGENT); }
__device__ __forceinline__ unsigned xb_add(unsigned* p, unsigned v) { return __hip_atomic_fetch_add(p, v, __ATOMIC_RELAXED, __HIP_MEMORY_SCOPE_AGENT); }
__device__ __forceinline__ unsigned xb_xcc_id() { return (unsigned)__builtin_amdgcn_s_getreg((3 << 11) | 20) & 0xFu; }
#define XB_SPIN(cond, bar) do { unsigned _sp = 0; while (cond) { __builtin_amdgcn_s_sleep(1); \
    if ((++_sp & 255u) == 0u) { if (xb_ld(&(bar)[XB_TMO])) break; if (_sp > XB_SPIN_CAP) { atomicAdd(&(bar)[XB_TMO], 1u); break; } } } } while (0)

struct XcdBarrier {
    unsigned* bar; unsigned x;
    volatile LAS unsigned* st;
};

__device__ __forceinline__ XcdBarrier xcd_barrier_post(unsigned* bar, volatile LAS unsigned* st) {
    XcdBarrier b; b.bar = bar; b.x = xb_xcc_id(); b.st = st;
    if (threadIdx.x == 0) (void)xb_add(&bar[XB_XCNT(b.x)], 1u);
    return b;
}
__device__ __forceinline__ void xcd_barrier_complete(unsigned* bar, unsigned x, unsigned& nloc, unsigned& nx) {
    const unsigned G = gridDim.x * gridDim.y * gridDim.z;
    unsigned sum, cnt, mine, sp = 0u;
    for (;;) {
        sum = 0u; cnt = 0u; mine = 0u;
#pragma unroll
        for (unsigned j = 0; j < 16; ++j) { const unsigned c = xb_ld(&bar[XB_XCNT(j)]); sum += c; cnt += (c > 0u) ? 1u : 0u; mine = (j == x) ? c : mine; }
        if (sum == G) break;
        __builtin_amdgcn_s_sleep(1);
        if ((++sp & 255u) == 0u) { if (xb_ld(&bar[XB_TMO])) break; if (sp > XB_SPIN_CAP) { atomicAdd(&bar[XB_TMO], 1u); break; } }
    }
    nloc = mine > 0u ? mine : 1u; nx = cnt > 0u ? cnt : 1u;
}

__device__ __forceinline__ void xcd_barrier(const XcdBarrier& b) {
    asm volatile("s_waitcnt vmcnt(0)" ::: "memory");
    __syncthreads();
    if (threadIdx.x == 0) {
        unsigned* bar = b.bar;
        __builtin_amdgcn_s_waitcnt(0);
        unsigned nloc = b.st[0], nx = b.st[1];
        if (nloc == 0u) { xcd_barrier_complete(bar, b.x, nloc, nx); b.st[0] = nloc; b.st[1] = nx; }
        const unsigned old = xb_add(&bar[XB_XSUB(b.x)], 1u);
        const unsigned gen = old / nloc;
        if (old + 1u == (gen + 1u) * nloc) {
            __builtin_amdgcn_fence(__ATOMIC_RELEASE, "agent");
            asm volatile("s_waitcnt vmcnt(0)" ::: "memory");
            const unsigned og = xb_add(&bar[XB_TOP], 1u);
            const unsigned tg = og / nx;
            if (og + 1u == (tg + 1u) * nx) xb_add(&bar[XB_TOPGEN], 1u);
            else XB_SPIN(xb_ld(&bar[XB_TOPGEN]) == tg, bar);
            __builtin_amdgcn_fence(__ATOMIC_ACQUIRE, "agent");
            xb_add(&bar[XB_XGEN(b.x)], 1u);
            asm volatile("s_waitcnt vmcnt(0)" ::: "memory");
        } else {
            XB_SPIN(xb_ld(&bar[XB_XGEN(b.x)]) == gen, bar);
            __builtin_amdgcn_fence(__ATOMIC_ACQUIRE, "agent");
            asm volatile("s_waitcnt vmcnt(0)" ::: "memory");
        }
    }
    __syncthreads();
}


struct Args { const void* in[30]; float* out; unsigned char* ws; int ph_lo, ph_hi; };
struct Frame {
    unsigned char* lds;
    int tid, lane, wave, vcu, G, gw, NGW;
    unsigned char* ws;
};

__device__ __forceinline__ int t5_bucket(int n) {
    if (n < 16) return n < 0 ? 0 : n;
    int b = 16;
    b += (n >= 22); b += (n >= 30); b += (n >= 40); b += (n >= 54); b += (n >= 73); b += (n >= 99); b += (n >= 134); b += (n >= 182);
    b += (n >= 246); b += (n >= 332); b += (n >= 450); b += (n >= 609); b += (n >= 825); b += (n >= 1117); b += (n >= 1513);
    return b;
}

template <int MAP>
__device__ __forceinline__ void p0_transpose_item(const float* W, const float* W2, int K, int Nsrc, int Ndst, bf16* WT, const float* kscale, float* scr, int item, int lane) {
    const int nblk = Ndst / 32, kb = item / nblk, nb = item % nblk, k0 = 64 * kb, n0 = 32 * nb;
    const int n = n0 + (lane & 31);
    const float* src = W; int sc = n; bool ok = true;
    if (MAP == 1) { if (n < Z_QLAT) sc = n; else if (n < Z_NG) sc = n + 24; else if (n < Z_NG + 24) sc = n - Z_NG + 2560; else ok = false; }
    if (MAP == 2) { const int g32 = n >> 5, w = n & 31; src = (w < 16) ? W : W2; sc = g32 * 16 + (w & 15); }
#pragma unroll 8
    for (int i = 0; i < 32; ++i) { const int kk = 2 * i + (lane >> 5); float v = ok ? src[(size_t)(k0 + kk) * Nsrc + sc] : 0.f; if (kscale) v *= kscale[k0 + kk]; scr[kk * 33 + (lane & 31)] = v; }
    LDS_WAIT(); asm volatile("" ::: "memory");
    const int c = lane & 7;
#pragma unroll
    for (int j = 0; j < 4; ++j) { const int nn = (lane >> 3) + 8 * j; const float* s = scr + (8 * c) * 33 + nn;
        v4u o; o.x = pk2(s[0 * 33], s[1 * 33]); o.y = pk2(s[2 * 33], s[3 * 33]); o.z = pk2(s[4 * 33], s[5 * 33]); o.w = pk2(s[6 * 33], s[7 * 33]);
        *(v4u*)(WT + (size_t)(n0 + nn) * K + k0 + 8 * c) = o; }
    LDS_WAIT(); asm volatile("" ::: "memory");
}
template <int MAP>
__device__ __forceinline__ void p0_transpose(Frame& F, const float* W, const float* W2, int K, int Nsrc, int Ndst, bf16* WT, const float* kscale) {
    float* scr = (float*)(F.lds + F.wave * 16384);
    const int nitems = (K / 64) * (Ndst / 32);
    for (int it = F.gw; it < nitems; it += F.NGW) p0_transpose_item<MAP>(W, W2, K, Nsrc, Ndst, WT, kscale, scr, it, F.lane);
}

__device__ __forceinline__ void modnorm_row(const float* xrow, const float* g, const float* sc, const float* sh, bf16* orow, int lane, f32x4 (&v)[8]) {
    const f32x4* xr = (const f32x4*)xrow + lane; float s = 0.f;
#pragma unroll
    for (int j = 0; j < 8; ++j) { v[j] = xr[64 * j]; s += (v[j].x * v[j].x + v[j].y * v[j].y) + (v[j].z * v[j].z + v[j].w * v[j].w); }
    const float rinv = 1.0f / sqrtf(wave_sum(s) * (1.f / D) + RMS_EPS);
    unsigned long long* o8 = (unsigned long long*)orow + lane;
#pragma unroll
    for (int j = 0; j < 8; ++j) { const f32x4 gg = ((const f32x4*)g)[lane + 64 * j], cc = ((const f32x4*)sc)[lane + 64 * j], hh = ((const f32x4*)sh)[lane + 64 * j];
        v[j] = (v[j] * rinv) * gg * (cc + 1.0f) + hh;
        o8[64 * j] = (unsigned long long)pk2(v[j].x, v[j].y) | ((unsigned long long)pk2(v[j].z, v[j].w) << 32); }
}
__device__ __forceinline__ void modnorm_phase(Frame& F, const float* x, const float* g, const float* mod  , int sh_idx, bf16* H) {
    for (int m = F.gw; m < M; m += F.NGW) { const int b = m / S; const float* mb = mod + (size_t)b * 6 * D; f32x4 v[8];
        modnorm_row(x + (size_t)m * D, g, mb + (size_t)(sh_idx + 1) * D, mb + (size_t)sh_idx * D, H + (size_t)m * D, F.lane, v); }
}

struct NA { const bf16* k; long kstride; const bf16* k2; long k2stride; int dq, dq2; const bf16* v; long vstride; int t0, tstep, nk; const float* bias; int brel0, bstep; float scale; unsigned long long cmask; int use_sel; };
__device__ __forceinline__ void na_run(const NA& a, const float* qs, float* sc, int lane, float& mx, float& sum, float& o0, float& o1) {
    float lmax = -3.0e38f;
    for (int c = 0; c * 64 < a.nk; ++c) {
        const int kk = c * 64 + lane; float s = -__builtin_inff();
        const bool chunk_ok = !a.use_sel || ((a.cmask >> ((a.t0 + c * 64 * a.tstep) >> 6)) & 1ull);
        if (chunk_ok && kk < a.nk) {
            const long t = a.t0 + (long)kk * a.tstep; const bf16* kr = a.k + t * a.kstride; float acc = 0.f;
            for (int d = 0; d < a.dq; d += 8) { const v4u w = *(const v4u*)(kr + d); const float* q = qs + d;
                acc += bflo(w.x) * q[0] + bfhi(w.x) * q[1] + bflo(w.y) * q[2] + bfhi(w.y) * q[3] + bflo(w.z) * q[4] + bfhi(w.z) * q[5] + bflo(w.w) * q[6] + bfhi(w.w) * q[7]; }
            if (a.dq2) { const bf16* k2r = a.k2 + t * a.k2stride;
                for (int d = 0; d < a.dq2; d += 8) { const v4u w = *(const v4u*)(k2r + d); const float* q = qs + a.dq + d;
                    acc += bflo(w.x) * q[0] + bfhi(w.x) * q[1] + bflo(w.y) * q[2] + bfhi(w.y) * q[3] + bflo(w.z) * q[4] + bfhi(w.z) * q[5] + bflo(w.w) * q[6] + bfhi(w.w) * q[7]; } }
            s = acc * a.scale; if (a.bias) s += a.bias[a.brel0 - kk * a.bstep];
        }
        if (kk < a.nk) sc[kk] = s;
        lmax = fmaxf(lmax, s);
    }
    mx = wave_max(lmax);
    float ls = 0.f;
    for (int kk = lane; kk < a.nk; kk += 64) { const float p = __expf(sc[kk] - mx); sc[kk] = p; ls += p; }
    sum = wave_sum(ls);
    LDS_WAIT(); asm volatile("" ::: "memory");
    float a0 = 0.f, a1 = 0.f;
    for (int kk = 0; kk < a.nk; ++kk) { const float p = sc[kk]; if (p != 0.f) { const unsigned w = *(const unsigned*)(a.v + (long)(a.t0 + (long)kk * a.tstep) * a.vstride + 2 * lane); a0 += p * bflo(w); a1 += p * bfhi(w); } }
    o0 = a0; o1 = a1;
    asm volatile("" ::: "memory");
}
__device__ __forceinline__ float gelu_tanh(float x) { const float u = 0.7978845608028654f * (x + 0.044715f * x * x * x); return 0.5f * x * (1.0f + tanhf(u)); }
__device__ __forceinline__ float sigmoid_f(float x) { return 1.0f / (1.0f + __expf(-x)); }

__global__ void __launch_bounds__(NWAVES * 64, 2) fwd(Args args) {
    extern __shared__ __attribute__((aligned(16))) unsigned char lds[];
    Frame F;
    F.lds = lds; F.ws = args.ws;
    F.tid = threadIdx.x; F.lane = F.tid & 63; F.wave = __builtin_amdgcn_readfirstlane(F.tid >> 6);
    F.G = gridDim.x; { const int bx = blockIdx.x; F.vcu = (F.G % 8 == 0) ? (bx % 8) * (F.G / 8) + bx / 8 : bx; }
    F.gw = F.vcu * NWAVES + F.wave; F.NGW = F.G * NWAVES;
    unsigned char* ws = args.ws;
    unsigned* ctl = (unsigned*)(ws + WS_CTL);
    volatile LAS unsigned* MISC = (volatile LAS unsigned*)((LAS unsigned char*)lds + MISC_OFF);
    for (int u = F.tid; u < 64; u += NWAVES * 64) MISC[u] = 0u;
    __syncthreads();
    XcdBarrier bar; bar.bar = ctl + CW_BAR; bar.x = 0; bar.st = nullptr;
    if (MK_N_LAUNCHES == 1) bar = xcd_barrier_post(ctl + CW_BAR, MISC + 8);
    const int lo = args.ph_lo, hi = args.ph_hi;
#define IN(k) (lo <= (k) && (k) < hi)
#define SEAM(k) do { if (IN(k) && IN((k) + 1)) xcd_barrier(bar); } while (0)

    const float* x_in = (const float*)args.in[0]; const float* c_in = (const float*)args.in[1]; const int* positions = (const int*)args.in[2];
    const float* rel_bias = (const float*)args.in[3]; const float* ada_w = (const float*)args.in[4]; const float* ada_b = (const float*)args.in[5];
    const float* mix_norm_g = (const float*)args.in[6]; const float* ffn_norm_g = (const float*)args.in[7];
    const float* ab_w_in = (const float*)args.in[8]; const float* ab_w_out = (const float*)args.in[9];
    const float* cmp_pos_k = (const float*)args.in[10]; const float* cmp_w1_k = (const float*)args.in[11]; const float* cmp_w2_k = (const float*)args.in[12];
    const float* cmp_pos_v = (const float*)args.in[13]; const float* cmp_w1_v = (const float*)args.in[14]; const float* cmp_w2_v = (const float*)args.in[15];
    const float* q_norm_g = (const float*)args.in[16]; const float* kv_norm_g = (const float*)args.in[17]; const float* w_uq = (const float*)args.in[18]; const float* w_ukv = (const float*)args.in[19];
    const float* ffn_wg = (const float*)args.in[20]; const float* ffn_wu = (const float*)args.in[21]; const float* ffn_wd = (const float*)args.in[22];
    const float* c_w_in = (const float*)args.in[23]; const float* c_w_out = (const float*)args.in[24]; const float* w_router = (const float*)args.in[25];
    const float* moe_wg = (const float*)args.in[26]; const float* moe_wu = (const float*)args.in[27]; const float* moe_wd = (const float*)args.in[28]; const float* final_g = (const float*)args.in[29];
    float* MOD = (float*)(ws + WS_MOD); float* BIAS = (float*)(ws + WS_BIAS); float* ROPE = (float*)(ws + WS_ROPE); float* RINV = (float*)(ws + WS_RINV);
    unsigned long long* SEL = (unsigned long long*)(ws + WS_SEL); bf16* KC = (bf16*)(ws + WS_KC); bf16* VC = (bf16*)(ws + WS_VC); int* ROUTE = (int*)(ws + WS_ROUTE); bf16* KPE = (bf16*)(ws + WS_KPE);
    bf16* W_IN0 = (bf16*)(ws + WS_WIN0); bf16* W_UQ = (bf16*)(ws + WS_WUQ); bf16* W_UKV = (bf16*)(ws + WS_WUKV); bf16* W_OUT0 = (bf16*)(ws + WS_WOUT0); bf16* W_GU0 = (bf16*)(ws + WS_WGU0); bf16* W_DN0 = (bf16*)(ws + WS_WDN0);
    bf16* W_IN1 = (bf16*)(ws + WS_WIN1); bf16* W_OUT1 = (bf16*)(ws + WS_WOUT1); bf16* W_MGU = (bf16*)(ws + WS_WMGU); bf16* W_MDN = (bf16*)(ws + WS_WMDN);
    float* X = (float*)(ws + WS_X); bf16* H = (bf16*)(ws + WS_H);
    bf16* Z0 = (bf16*)(ws + WS_Z0); bf16* QM = (bf16*)(ws + WS_QM); bf16* KVM = (bf16*)(ws + WS_KVM); bf16* OCMP = (bf16*)(ws + WS_OCMP); bf16* OWIN = (bf16*)(ws + WS_OWIN); bf16* CAT = (bf16*)(ws + WS_CAT);
    float* LSEB = (float*)(ws + WS_LSE); bf16* OP = (bf16*)(ws + WS_OP);
    bf16* ACT = (bf16*)(ws + WS_ACT); bf16* Z1 = (bf16*)(ws + WS_Z1); bf16* OM = (bf16*)(ws + WS_OM); bf16* XB = (bf16*)(ws + WS_XB); bf16* ACTB = (bf16*)(ws + WS_ACTB); bf16* YB = (bf16*)(ws + WS_YB);
    float* wsc = (float*)(lds + F.wave * 16384);
    float* wsm = (float*)(lds + SMALL_OFF + F.wave * 2048);
    PG8_LAS unsigned char* ring = (PG8_LAS unsigned char*)lds;

    if (IN(0)) {
        p0_transpose<1>(F, ab_w_in, nullptr, D, 3672, Z0W, W_IN0, nullptr);
        p0_transpose<0>(F, w_uq, nullptr, 512, QMW, QMW, W_UQ, q_norm_g);
        p0_transpose<0>(F, w_ukv, nullptr, 512, KVMW, KVMW, W_UKV, kv_norm_g);
        p0_transpose<0>(F, ab_w_out, nullptr, D, D, D, W_OUT0, nullptr);
        p0_transpose<2>(F, ffn_wg, ffn_wu, D, FF, 2 * FF, W_GU0, nullptr);
        p0_transpose<0>(F, ffn_wd, nullptr, FF, D, D, W_DN0, nullptr);
        p0_transpose<0>(F, c_w_in, nullptr, D, Z1W, Z1W, W_IN1, nullptr);
        p0_transpose<0>(F, c_w_out, nullptr, 1024, D, D, W_OUT1, nullptr);
        for (int e = 0; e < NE; ++e) {
            p0_transpose<2>(F, moe_wg + (size_t)e * D * FFE, moe_wu + (size_t)e * D * FFE, D, FFE, 2 * FFE, W_MGU + (size_t)e * 2 * FFE * D, nullptr);
            p0_transpose<0>(F, moe_wd + (size_t)e * FFE * D, nullptr, FFE, D, D, W_MDN + (size_t)e * D * FFE, nullptr);
        }
        for (int i = F.gw * 64 + F.lane; i < 8 * BIAS_LD; i += F.NGW * 64) { const int h = i / BIAS_LD, r = i % BIAS_LD - 64; BIAS[i] = rel_bias[t5_bucket(r) * 8 + h]; }
        for (int i = F.gw * 64 + F.lane; i < M * 32; i += F.NGW * 64) { const int m = i >> 5, f = i & 31;
            const float inv_freq = powf(10000.0f, -(float)(2 * f) / 64.0f); const float ang = (float)positions[m] * inv_freq;
            ROPE[(size_t)m * 64 + f] = cosf(ang); ROPE[(size_t)m * 64 + 32 + f] = sinf(ang); }
        __syncthreads();
        for (int job = blockIdx.x; job < 192; job += F.G) {
            float* cs = (float*)lds; float* red = (float*)(lds + 32768);
            for (int i = F.tid; i < 4 * D; i += 512) { const float cv = c_in[i]; cs[i] = cv / (1.0f + __expf(-cv)); }
            __syncthreads();
            const int l = job / 96, col0 = (job % 96) * 128;
            float acc[4][2] = {};
            const float* wp = ada_w + ((size_t)l * D + (size_t)F.wave * 256) * 12288 + col0 + 2 * F.lane;
#pragma unroll 8
            for (int k = 0; k < 256; ++k) { const f32x2 wv = *(const f32x2*)(wp + (size_t)k * 12288); const int kk = F.wave * 256 + k;
#pragma unroll
                for (int b = 0; b < 4; ++b) { const float cv = cs[b * D + kk]; acc[b][0] += cv * wv.x; acc[b][1] += cv * wv.y; } }
#pragma unroll
            for (int b = 0; b < 4; ++b) { red[(F.wave * 4 + b) * 128 + 2 * F.lane] = acc[b][0]; red[(F.wave * 4 + b) * 128 + 2 * F.lane + 1] = acc[b][1]; }
            __syncthreads();
            { const int b = F.tid >> 7, cc = F.tid & 127; float s = 0.f;
#pragma unroll
              for (int w = 0; w < 8; ++w) s += red[(w * 4 + b) * 128 + cc];
              MOD[((size_t)l * 4 + b) * 12288 + col0 + cc] = s + ada_b[(size_t)l * 12288 + col0 + cc]; }
            __syncthreads();
        }
    }
    SEAM(0);
    if (IN(1)) modnorm_phase(F, x_in, mix_norm_g, MOD, 0, H);
    SEAM(1);
    if (IN(2)) { pg8::Gemm g{H, W_IN0, D, D, D}; pg8::StaticOrder So; So.init(M, Z0W, F.G, (int)blockIdx.x); pg8::EpiBf16 E{Z0, Z0W, nullptr};
        pg8::gemm_phase<pg8::EpiBf16, pg8::StaticOrder, true, true>(ring, g, So, E); }
    SEAM(2);
    if (IN(3)) {
        for (int m = F.gw; m < M; m += F.NGW) {
            const bf16* zr = Z0 + (size_t)m * Z0W;
#pragma unroll
            for (int w = 0; w < 2; ++w) { const v4u a = *(const v4u*)(zr + (w ? Z_KVLAT : Z_QLAT) + 8 * F.lane);
                float s = bflo(a.x) * bflo(a.x) + bfhi(a.x) * bfhi(a.x) + bflo(a.y) * bflo(a.y) + bfhi(a.y) * bfhi(a.y) + bflo(a.z) * bflo(a.z) + bfhi(a.z) * bfhi(a.z) + bflo(a.w) * bflo(a.w) + bfhi(a.w) * bfhi(a.w);
                s = wave_sum(s); if (F.lane == 0) RINV[(size_t)w * M + m] = 1.0f / sqrtf(s * (1.f / 512.f) + RMS_EPS); }
            if (F.lane < 32) { const float x1 = bf2f(zr[Z_KPE + F.lane]), x2 = bf2f(zr[Z_KPE + 32 + F.lane]); const float cs = ROPE[(size_t)m * 64 + F.lane], sn = ROPE[(size_t)m * 64 + 32 + F.lane];
                KPE[(size_t)m * 64 + F.lane] = (bf16)f2bf(x1 * cs - x2 * sn); KPE[(size_t)m * 64 + 32 + F.lane] = (bf16)f2bf(x2 * cs + x1 * sn); }
        }
        for (int it = F.gw; it < 2 * NB * 255 * 2; it += F.NGW) {
            const int g = it & 1, n = (it >> 1) % 255, b = ((it >> 1) / 255) % NB, c = (it >> 1) / (255 * NB);
            const float* pos = c ? cmp_pos_v : cmp_pos_k; const float* w1 = c ? cmp_w1_v : cmp_w1_k; const float* w2 = c ? cmp_w2_v : cmp_w2_k;
            const bf16* zb = Z0 + ((size_t)b * S + 16 * n) * Z0W + Z_NKV + c * 256 + g * 128;
            float h0 = 0.f, h1 = 0.f;
            for (int l = 0; l < 32; ++l) {
                const float av = bf2f(zb[(size_t)l * Z0W + 2 * F.lane]) + pos[l * 128 + 2 * F.lane], aw = bf2f(zb[(size_t)l * Z0W + 2 * F.lane + 1]) + pos[l * 128 + 2 * F.lane + 1];
                wsm[2 * F.lane] = av; wsm[2 * F.lane + 1] = aw; LDS_WAIT(); asm volatile("" ::: "memory");
#pragma unroll 8
                for (int d = 0; d < 128; ++d) { const f32x2 wv = *(const f32x2*)(w1 + (size_t)(l * 128 + d) * 128 + 2 * F.lane); const float a = wsm[d]; h0 += a * wv.x; h1 += a * wv.y; }
                asm volatile("" ::: "memory");
            }
            wsm[128 + 2 * F.lane] = gelu_tanh(h0); wsm[128 + 2 * F.lane + 1] = gelu_tanh(h1); LDS_WAIT(); asm volatile("" ::: "memory");
            float o0 = 0.f, o1 = 0.f;
#pragma unroll 8
            for (int e = 0; e < 128; ++e) { const f32x2 wv = *(const f32x2*)(w2 + (size_t)e * 128 + 2 * F.lane); const float a = wsm[128 + e]; o0 += a * wv.x; o1 += a * wv.y; }
            asm volatile("" ::: "memory");
            *(unsigned*)((c ? VC : KC) + (((size_t)b * 2 + g) * 256 + n) * 128 + 2 * F.lane) = pk2(o0, o1);
        }
#if FLASH_WIN
        __syncthreads();
        for (int Lx = blockIdx.x; Lx < 512; Lx += F.G) {
            const int qb = 15 - Lx / 32, bh = Lx % 32, b = bh >> 3, h = bh & 7, g = h >> 2; const bf16* zb = Z0 + (size_t)b * S * Z0W;
            fa::Item it{}; it.Q = zb + Z_NQ + h * 128; it.qs = Z0W; it.K = zb + Z_NKV + 4 * 256 + g * 128; it.ks = Z0W; it.V = zb + Z_NKV + 5 * 256 + g * 128; it.vs = Z0W;
            it.P0 = qb * 256; it.skv = S; it.W = 512; it.bias = BIAS + (size_t)h * BIAS_LD + 64; it.bstep = 1; it.O = OWIN + (size_t)b * S * 1024 + h * 128; it.os = 1024;
            fa::attn_block<0>(it, lds);
        }
#else
        __syncthreads();
        for (int it = F.gw; it < M * 8; it += F.NGW) {
            const int h = it & 7, m = it >> 3, b = m / S, s = m % S, g = h >> 2;
            const bf16* qr = Z0 + (size_t)m * Z0W + Z_NQ + h * 128; wsm[2 * F.lane] = bf2f(qr[2 * F.lane]); wsm[2 * F.lane + 1] = bf2f(qr[2 * F.lane + 1]); LDS_WAIT(); asm volatile("" ::: "memory");
            const int t0 = s - 511 < 0 ? 0 : s - 511; NA a;
            a.k = Z0 + (size_t)b * S * Z0W + Z_NKV + 4 * 256 + g * 128; a.kstride = Z0W; a.k2 = nullptr; a.k2stride = 0; a.dq = 128; a.dq2 = 0;
            a.v = Z0 + (size_t)b * S * Z0W + Z_NKV + 5 * 256 + g * 128; a.vstride = Z0W; a.t0 = t0; a.tstep = 1; a.nk = s - t0 + 1;
            a.bias = BIAS + (size_t)h * BIAS_LD + 64; a.brel0 = s - t0; a.bstep = 1; a.scale = 0.08838834764831845f; a.cmask = 0; a.use_sel = 0;
            float mx, sum, o0, o1; na_run(a, wsm, wsc, F.lane, mx, sum, o0, o1);
            *(unsigned*)(OWIN + (size_t)m * 1024 + h * 128 + 2 * F.lane) = pk2(o0 / sum, o1 / sum);
        }
#endif
    }
    SEAM(3);
    if (IN(4)) {
        { pg8::Gemm g{Z0 + Z_QLAT, W_UQ, Z0W, 512, 512}; pg8::StaticOrder So; So.init(M, QMW, F.G, (int)blockIdx.x); pg8::EpiBf16 E{QM, QMW, RINV};
          pg8::gemm_phase<pg8::EpiBf16, pg8::StaticOrder, true, true>(ring, g, So, E); }
        __syncthreads();
        { pg8::Gemm g{Z0 + Z_KVLAT, W_UKV, Z0W, 512, 512}; pg8::StaticOrder So; So.init(M, KVMW, F.G, (int)blockIdx.x); pg8::EpiBf16 E{KVM, KVMW, RINV + M};
          pg8::gemm_phase<pg8::EpiBf16, pg8::StaticOrder, true, true>(ring, g, So, E); }
        __syncthreads();
        for (int it = F.gw; it < M * 2; it += F.NGW) {
            const int g = it & 1, m = it >> 1, b = m / S, s = m % S;
            const int nk = s >= 31 ? (s - 31) / 16 + 1 : 0;
            float* imp = wsm + 256;
            for (int i = F.lane; i < 256; i += 64) imp[i] = 0.f;
            for (int r = 0; r < 4; ++r) { const int h = g * 4 + r;
                const bf16* qr = Z0 + (size_t)m * Z0W + Z_NQ + h * 128; wsm[2 * F.lane] = bf2f(qr[2 * F.lane]); wsm[2 * F.lane + 1] = bf2f(qr[2 * F.lane + 1]); LDS_WAIT(); asm volatile("" ::: "memory");
                float o0 = 0.f, o1 = 0.f;
                if (nk > 0) { NA a; a.k = KC + ((size_t)b * 2 + g) * 256 * 128; a.kstride = 128; a.k2 = nullptr; a.k2stride = 0; a.dq = 128; a.dq2 = 0; a.v = VC + ((size_t)b * 2 + g) * 256 * 128; a.vstride = 128;
                    a.t0 = 0; a.tstep = 1; a.nk = nk; a.bias = BIAS + (size_t)h * BIAS_LD + 64; a.brel0 = s - 31; a.bstep = 16; a.scale = 0.08838834764831845f; a.cmask = 0; a.use_sel = 0;
                    float mx, sum; na_run(a, wsm, wsc, F.lane, mx, sum, o0, o1); const float inv = 1.0f / sum; o0 *= inv; o1 *= inv;
                    for (int i = F.lane; i < nk; i += 64) imp[i] += wsc[i] * inv; LDS_WAIT(); asm volatile("" ::: "memory"); }
                *(unsigned*)(OCMP + (size_t)m * 1024 + h * 128 + 2 * F.lane) = pk2(o0, o1);
            }
            const int j = F.lane, blk_t = s >> 6;
            float sc;
            { const float pm1 = (4 * j - 1 >= 0) ? imp[4 * j - 1] : 0.f, p0 = imp[4 * j], p1 = imp[4 * j + 1], p2 = imp[4 * j + 2], p3 = (4 * j + 3 < 255) ? imp[4 * j + 3] : 0.f;
              const float is = ((((((p0 + pm1) + p1) + p0) + p2) + p1) + p3) + p2;
              const bool forced = (j == 0) || (j == blk_t) || (j == blk_t - 1), valid = j <= blk_t;
              sc = forced ? 1e9f : (valid ? is : -1.0f); }
            int rank = 0;
            for (int k = 0; k < 64; ++k) { const float vk = __shfl(sc, k); rank += (vk > sc || (vk == sc && k < j)) ? 1 : 0; }
            const unsigned long long msk = __ballot(rank < 16 && sc > -0.5f);
            if (F.lane == 0) SEL[(size_t)m * 2 + g] = msk;
            asm volatile("" ::: "memory");
        }
    }
    SEAM(4);
    if (IN(5)) {
#if FLASH_SLC != 1
        for (int it = F.gw; it < M * 8; it += F.NGW) {
            const int h = it & 7, m = it >> 3, b = m / S, s = m % S, g = h >> 2;
            const bf16* zr = Z0 + (size_t)m * Z0W; const bf16* qr = zr + Z_NQ + h * 128; wsm[2 * F.lane] = bf2f(qr[2 * F.lane]); wsm[2 * F.lane + 1] = bf2f(qr[2 * F.lane + 1]); LDS_WAIT(); asm volatile("" ::: "memory");
            NA a; a.k = Z0 + (size_t)b * S * Z0W + Z_NKV + 2 * 256 + g * 128; a.kstride = Z0W; a.k2 = nullptr; a.k2stride = 0; a.dq = 128; a.dq2 = 0;
            a.v = Z0 + (size_t)b * S * Z0W + Z_NKV + 3 * 256 + g * 128; a.vstride = Z0W; a.t0 = 0; a.tstep = 1; a.nk = s + 1;
            a.bias = BIAS + (size_t)h * BIAS_LD + 64; a.brel0 = s; a.bstep = 1; a.scale = 0.08838834764831845f; a.cmask = SEL[(size_t)m * 2 + g]; a.use_sel = FA_DBG_NOSEL ? 0 : 1;
            float mx, sum, o0, o1; na_run(a, wsm, wsc, F.lane, mx, sum, o0, o1); o0 /= sum; o1 /= sum;
            const float g0 = sigmoid_f(bf2f(zr[Z_NG + h * 3 + 0])), g1 = sigmoid_f(bf2f(zr[Z_NG + h * 3 + 1])), g2 = sigmoid_f(bf2f(zr[Z_NG + h * 3 + 2]));
            const unsigned wc_ = *(const unsigned*)(OCMP + (size_t)m * 1024 + h * 128 + 2 * F.lane), ww_ = *(const unsigned*)(OWIN + (size_t)m * 1024 + h * 128 + 2 * F.lane);
            *(unsigned*)(CAT + (size_t)m * 2048 + h * 128 + 2 * F.lane) = FA_DBG_NOMERGE ? pk2(o0, o1) : pk2(g0 * bflo(wc_) + g1 * o0 + g2 * bflo(ww_), g0 * bfhi(wc_) + g1 * o1 + g2 * bfhi(ww_));
        }
        __syncthreads();
#endif
#if FLASH_SLC == 2
        __syncthreads();
#endif
#if FLASH_SLC
        for (int Lx = blockIdx.x; Lx < 256; Lx += F.G) {
            const int x = Lx / 32, bh = Lx % 32, b = bh >> 3, h = bh & 7, g = h >> 2; const bf16* zb = Z0 + (size_t)b * S * Z0W;
            for (int pass = 0; pass < 2; ++pass) { const int qb = pass ? 15 - x : x;
                fa::Item it{}; it.Q = zb + Z_NQ + h * 128; it.qs = Z0W; it.K = zb + Z_NKV + 2 * 256 + g * 128; it.ks = Z0W; it.V = zb + Z_NKV + 3 * 256 + g * 128; it.vs = Z0W;
                it.P0 = qb * 256; it.skv = S; it.W = 1 << 20; it.bias = BIAS + (size_t)h * BIAS_LD + 64; it.bstep = 1; it.sel = SEL + (size_t)b * S * 2 + g; it.sels = 2;
                it.O = CAT + (size_t)b * S * 2048 + h * 128; it.os = 2048;
#if FLASH_SLC == 2
                it.O = (bf16*)(ws + WS_R + 296 * MiB) + (size_t)b * S * 1024 + h * 128; it.os = 1024;
#endif
                it.M0 = OCMP + (size_t)b * S * 1024 + h * 128; it.M1 = OWIN + (size_t)b * S * 1024 + h * 128; it.ms = 1024; it.G = zb + Z_NG + h * 3; it.gs = Z0W;
                fa::attn_block<1>(it, lds); }
        }
#endif
#if FLASH_MLA
        for (int Lx = blockIdx.x; Lx < 256; Lx += F.G) {
            const int x = Lx / 32, bh = Lx % 32, b = bh >> 3, h = bh & 7;
            for (int pass = 0; pass < 2; ++pass) { const int qb = pass ? 15 - x : x;
                fa::Item it{}; it.Q = QM + (size_t)b * S * QMW + h * 192; it.qs = QMW; it.rope = ROPE + (size_t)b * S * 64; it.ropes = 64;
                it.K = KVM + (size_t)b * S * KVMW + h * 256; it.ks = KVMW; it.K2 = KPE + (size_t)b * S * 64; it.k2s = 64; it.V = KVM + (size_t)b * S * KVMW + h * 256 + 128; it.vs = KVMW;
                it.P0 = qb * 256; it.skv = S; it.W = 1 << 20; it.O = CAT + (size_t)b * S * 2048 + 1024 + h * 128; it.os = 2048;
                fa::attn_block<2>(it, lds); }
        }
#else
        for (int it = F.gw; it < M * 8; it += F.NGW) {
            const int h = it & 7, m = it >> 3, b = m / S, s = m % S;
            const bf16* qr = QM + (size_t)m * QMW + h * 192;
            wsm[2 * F.lane] = bf2f(qr[2 * F.lane]); wsm[2 * F.lane + 1] = bf2f(qr[2 * F.lane + 1]);
            if (F.lane < 32) { const float x1 = bf2f(qr[128 + F.lane]), x2 = bf2f(qr[160 + F.lane]); const float cs = ROPE[(size_t)m * 64 + F.lane], sn = ROPE[(size_t)m * 64 + 32 + F.lane];
                wsm[128 + F.lane] = x1 * cs - x2 * sn; wsm[160 + F.lane] = x2 * cs + x1 * sn; }
            LDS_WAIT(); asm volatile("" ::: "memory");
            NA a; a.k = KVM + (size_t)b * S * KVMW + h * 256; a.kstride = KVMW; a.k2 = KPE + (size_t)b * S * 64; a.k2stride = 64; a.dq = 128; a.dq2 = 64;
            a.v = KVM + (size_t)b * S * KVMW + h * 256 + 128; a.vstride = KVMW; a.t0 = 0; a.tstep = 1; a.nk = s + 1; a.bias = nullptr; a.brel0 = 0; a.bstep = 0; a.scale = 0.07216878364870322f; a.cmask = 0; a.use_sel = 0;
            float mx, sum, o0, o1; na_run(a, wsm, wsc, F.lane, mx, sum, o0, o1);
            *(unsigned*)(CAT + (size_t)m * 2048 + 1024 + h * 128 + 2 * F.lane) = pk2(o0 / sum, o1 / sum);
        }
#endif
    }
    SEAM(5);
    if (IN(6)) { pg8::Gemm g{CAT, W_OUT0, 2048, 2048, 2048}; pg8::StaticOrder So; So.init(M, D, F.G, (int)blockIdx.x); pg8::EpiResid E{x_in, X, D, MOD + 2 * D, 6 * D, S / 256};
        pg8::gemm_phase<pg8::EpiResid, pg8::StaticOrder, true, true>(ring, g, So, E); }
    SEAM(6);
    if (IN(7)) modnorm_phase(F, X, ffn_norm_g, MOD, 3, H);
    SEAM(7);
    if (IN(8)) { pg8::Gemm g{H, W_GU0, D, D, D}; pg8::StaticOrder So; So.init(M, 2 * FF, F.G, (int)blockIdx.x); pg8::EpiSwiGLU E{ACT, FF};
        pg8::gemm_phase<pg8::EpiSwiGLU, pg8::StaticOrder, true, true>(ring, g, So, E); }
    SEAM(8);
    if (IN(9)) { pg8::Gemm g{ACT, W_DN0, FF, FF, FF}; pg8::StaticOrder So; So.init(M, D, F.G, (int)blockIdx.x); pg8::EpiResid E{X, X, D, MOD + 5 * D, 6 * D, S / 256};
        pg8::gemm_phase<pg8::EpiResid, pg8::StaticOrder, true, true>(ring, g, So, E); }
    SEAM(9);
    if (IN(10)) modnorm_phase(F, X, mix_norm_g + D, MOD + 4 * 12288, 0, H);
    SEAM(10);
    if (IN(11)) { pg8::Gemm g{H, W_IN1, D, D, D}; pg8::StaticOrder So; So.init(M, Z1W, F.G, (int)blockIdx.x); pg8::EpiBf16 E{Z1, Z1W, nullptr};
        pg8::gemm_phase<pg8::EpiBf16, pg8::StaticOrder, true, true>(ring, g, So, E); }
    SEAM(11);
#if FLASH_DIL
    if (IN(12)) {
        for (int Lx = blockIdx.x; Lx < 1536; Lx += F.G) {
            const int p = Lx % 3, r_ = Lx / 3, bh = r_ % 32, sub = r_ / 32, b = bh >> 3, h = bh & 7;
            const int dil = p == 0 ? 1 : (p == 1 ? 4 : 16), res = p == 0 ? 0 : (p == 1 ? (sub & 3) : sub), qb = p == 0 ? sub : (p == 1 ? (sub >> 2) : 0);
            fa::Item it{}; it.Q = Z1 + ((size_t)b * S + res) * Z1W + p * 3072 + h * 128; it.qs = (long)dil * Z1W; it.K = it.Q + 1024; it.ks = it.qs; it.V = it.Q + 2048; it.vs = it.qs;
            it.P0 = qb * 256; it.skv = S / dil; it.W = 129; it.bias = BIAS + (size_t)h * BIAS_LD + 64; it.bstep = dil;
            it.O = OP + (size_t)p * M * 1024 + ((size_t)b * S + res) * 1024 + h * 128; it.os = (long)dil * 1024; it.LSE = LSEB + (size_t)p * M * 8 + ((size_t)b * S + res) * 8 + h; it.lses = (long)dil * 8;
            fa::attn_block<0>(it, lds);
        }
    }
#else
    if (IN(12)) {
        for (int it = F.gw; it < M * 8; it += F.NGW) {
            const int h = it & 7, m = it >> 3, b = m / S, s = m % S;
            float om0 = 0.f, om1 = 0.f, lm = -3.0e38f, wsum = 0.f;
#pragma unroll
            for (int p = 0; p < 3; ++p) { const int dil = p == 0 ? 1 : (p == 1 ? 4 : 16);
                const bf16* qr = Z1 + (size_t)m * Z1W + p * 3072 + h * 128; wsm[2 * F.lane] = bf2f(qr[2 * F.lane]); wsm[2 * F.lane + 1] = bf2f(qr[2 * F.lane + 1]); LDS_WAIT(); asm volatile("" ::: "memory");
                const int mq = s / dil, r = s % dil, m0 = mq - 128 < 0 ? 0 : mq - 128;
                NA a; a.k = Z1 + (size_t)b * S * Z1W + p * 3072 + 1024 + h * 128; a.kstride = Z1W; a.k2 = nullptr; a.k2stride = 0; a.dq = 128; a.dq2 = 0;
                a.v = Z1 + (size_t)b * S * Z1W + p * 3072 + 2048 + h * 128; a.vstride = Z1W; a.t0 = m0 * dil + r; a.tstep = dil; a.nk = mq - m0 + 1;
                a.bias = BIAS + (size_t)h * BIAS_LD + 64; a.brel0 = (mq - m0) * dil; a.bstep = dil; a.scale = 0.08838834764831845f; a.cmask = 0; a.use_sel = 0;
                float mx, sum, o0, o1; na_run(a, wsm, wsc, F.lane, mx, sum, o0, o1);
                const float lse = mx + __logf(sum); o0 /= sum; o1 /= sum;
                const float nm = fmaxf(lm, lse), ea = __expf(lm - nm), eb = __expf(lse - nm);
                om0 = om0 * ea + o0 * eb; om1 = om1 * ea + o1 * eb; wsum = wsum * ea + eb; lm = nm; }
            *(unsigned*)(OM + (size_t)m * 1024 + h * 128 + 2 * F.lane) = pk2(om0 / wsum, om1 / wsum);
        }
    }
#endif
    SEAM(12);
    if (IN(13) && FLASH_DIL) {
        for (int m = F.gw; m < M; m += F.NGW) {
#pragma unroll 2
            for (int h = 0; h < 8; ++h) { const float l0 = LSEB[(size_t)m * 8 + h], l1 = LSEB[(size_t)(M + m) * 8 + h], l2 = LSEB[(size_t)(2 * M + m) * 8 + h];
                const float mx = fmaxf(l0, fmaxf(l1, l2)), e0 = __expf(l0 - mx), e1 = __expf(l1 - mx), e2 = __expf(l2 - mx), inv = 1.0f / (e0 + e1 + e2);
                const unsigned a0 = *(const unsigned*)(OP + (size_t)m * 1024 + h * 128 + 2 * F.lane), a1 = *(const unsigned*)(OP + (size_t)(M + m) * 1024 + h * 128 + 2 * F.lane), a2 = *(const unsigned*)(OP + (size_t)(2 * M + m) * 1024 + h * 128 + 2 * F.lane);
                *(unsigned*)(OM + (size_t)m * 1024 + h * 128 + 2 * F.lane) = pk2((e0 * bflo(a0) + e1 * bflo(a1) + e2 * bflo(a2)) * inv, (e0 * bfhi(a0) + e1 * bfhi(a1) + e2 * bfhi(a2)) * inv); }
        }
    }
    SEAM(13);
    if (IN(14)) { pg8::Gemm g{OM, W_OUT1, 1024, 1024, 1024}; pg8::StaticOrder So; So.init(M, D, F.G, (int)blockIdx.x); pg8::EpiResid E{X, X, D, MOD + 4 * 12288 + 2 * D, 6 * D, S / 256};
        pg8::gemm_phase<pg8::EpiResid, pg8::StaticOrder, true, true>(ring, g, So, E); }
    SEAM(14);
    if (IN(15)) {
        for (int m = F.gw; m < M; m += F.NGW) { const int b = m / S; const float* mb = MOD + 4 * 12288 + (size_t)b * 6 * D; f32x4 v[8];
            modnorm_row(X + (size_t)m * D, ffn_norm_g + D, mb + 4 * D, mb + 3 * D, H + (size_t)m * D, F.lane, v);
            float lg[8] = {};
#pragma unroll
            for (int j = 0; j < 8; ++j) { const float* wr_ = w_router + (size_t)(4 * F.lane + 256 * j) * 8;
#pragma unroll
                for (int q = 0; q < 4; ++q) { const f32x4 wa = *(const f32x4*)(wr_ + q * 8), wb = *(const f32x4*)(wr_ + q * 8 + 4); const float hv = v[j][q];
                    lg[0] += hv * wa.x; lg[1] += hv * wa.y; lg[2] += hv * wa.z; lg[3] += hv * wa.w; lg[4] += hv * wb.x; lg[5] += hv * wb.y; lg[6] += hv * wb.z; lg[7] += hv * wb.w; } }
#pragma unroll
            for (int e = 0; e < 8; ++e) lg[e] = wave_sum(lg[e]);
            int e1 = 0; float v1 = lg[0];
#pragma unroll
            for (int e = 1; e < 8; ++e) if (lg[e] > v1) { v1 = lg[e]; e1 = e; }
            int e2 = -1; float v2 = -3.0e38f;
#pragma unroll
            for (int e = 0; e < 8; ++e) if (e != e1 && lg[e] > v2) { v2 = lg[e]; e2 = e; }
            if (F.lane == 0) { const float g1 = 1.0f / (1.0f + __expf(v2 - v1)), g2 = 1.0f - g1;
                const unsigned r1 = atomicAdd(ctl + CW_CNT + e1, 1u), r2 = atomicAdd(ctl + CW_CNT + e2, 1u);
                int* rt = ROUTE + (size_t)m * 8; rt[0] = e1; rt[1] = e2; rt[2] = (int)r1; rt[3] = (int)r2; rt[4] = __float_as_int(g1); rt[5] = __float_as_int(g2); }
        }
    }
    SEAM(15);
    if (IN(16)) {
        unsigned ts[9]; ts[0] = 0;
#pragma unroll
        for (int e = 0; e < 8; ++e) ts[e + 1] = ts[e] + (__hip_atomic_load(ctl + CW_CNT + e, __ATOMIC_RELAXED, __HIP_MEMORY_SCOPE_AGENT) + 255u) / 256u;
        if (blockIdx.x == 0 && F.tid < 9) { unsigned v = ts[0];
#pragma unroll
            for (int e = 1; e < 9; ++e) v = (F.tid == e) ? ts[e] : v;
            ctl[CW_TS + F.tid] = v; }
        for (int m = F.gw; m < M; m += F.NGW) { const int* rt = ROUTE + (size_t)m * 8; const int e1 = rt[0], e2 = rt[1]; unsigned t1 = 0, t2 = 0;
#pragma unroll
            for (int e = 0; e < 8; ++e) { t1 = (e == e1) ? ts[e] : t1; t2 = (e == e2) ? ts[e] : t2; }
            const size_t d1 = (size_t)t1 * 256 + rt[2], d2 = (size_t)t2 * 256 + rt[3];
            const v4u* src = (const v4u*)(H + (size_t)m * D) + F.lane; v4u* o1 = (v4u*)(XB + d1 * D) + F.lane; v4u* o2 = (v4u*)(XB + d2 * D) + F.lane;
#pragma unroll
            for (int j = 0; j < 4; ++j) { const v4u w = src[64 * j]; o1[64 * j] = w; o2[64 * j] = w; } }
    }
    SEAM(16);
    if (IN(17)) { pg8::Gemm g{XB, W_MGU, D, D, D}; pg8::GroupedOrder So; So.init(ctl + CW_TS, 2 * FFE / 256, F.G, (int)blockIdx.x); pg8::EpiSwiGLU E{ACTB, FFE};
        pg8::gemm_phase<pg8::EpiSwiGLU, pg8::GroupedOrder, true, true>(ring, g, So, E); }
    SEAM(17);
    if (IN(18)) { pg8::Gemm g{ACTB, W_MDN, FFE, FFE, FFE}; pg8::GroupedOrder So; So.init(ctl + CW_TS, D / 256, F.G, (int)blockIdx.x); pg8::EpiBf16 E{YB, D, nullptr};
        pg8::gemm_phase<pg8::EpiBf16, pg8::GroupedOrder, true, true>(ring, g, So, E); }
    SEAM(18);
    if (IN(19)) {
        unsigned ts[9]; ts[0] = 0;
#pragma unroll
        for (int e = 0; e < 8; ++e) ts[e + 1] = ctl[CW_TS + e + 1];
        for (int m = F.gw; m < M; m += F.NGW) { const int b = m / S; const int* rt = ROUTE + (size_t)m * 8; const int e1 = rt[0], e2 = rt[1]; unsigned t1 = 0, t2 = 0;
#pragma unroll
            for (int e = 0; e < 8; ++e) { t1 = (e == e1) ? ts[e] : t1; t2 = (e == e2) ? ts[e] : t2; }
            const size_t d1 = (size_t)t1 * 256 + rt[2], d2 = (size_t)t2 * 256 + rt[3]; const float g1 = __int_as_float(rt[4]), g2 = __int_as_float(rt[5]);
            const float* gf = MOD + 4 * 12288 + (size_t)b * 6 * D + 5 * D;
            const f32x4* xr = (const f32x4*)(X + (size_t)m * D) + F.lane; const v2u* y1 = (const v2u*)(YB + d1 * D) + F.lane; const v2u* y2 = (const v2u*)(YB + d2 * D) + F.lane;
            f32x4 v[8]; float ss = 0.f;
#pragma unroll
            for (int j = 0; j < 8; ++j) { const v2u a = y1[64 * j], c2 = y2[64 * j]; const f32x4 gg = ((const f32x4*)gf)[F.lane + 64 * j];
                f32x4 y; y.x = g1 * bflo(a.x) + g2 * bflo(c2.x); y.y = g1 * bfhi(a.x) + g2 * bfhi(c2.x); y.z = g1 * bflo(a.y) + g2 * bflo(c2.y); y.w = g1 * bfhi(a.y) + g2 * bfhi(c2.y);
                v[j] = xr[64 * j] + gg * y; ss += (v[j].x * v[j].x + v[j].y * v[j].y) + (v[j].z * v[j].z + v[j].w * v[j].w); }
            const float rinv = 1.0f / sqrtf(wave_sum(ss) * (1.f / D) + RMS_EPS);
            f32x4* orow = (f32x4*)(args.out + (size_t)m * D) + F.lane;
#pragma unroll
            for (int j = 0; j < 8; ++j) orow[64 * j] = (v[j] * rinv) * ((const f32x4*)final_g)[F.lane + 64 * j]; }
    }
#undef IN
#undef SEAM
}

constexpr int N_PHASES = 20;
extern "C" void kernel_launch(void* const* d_in, const int* in_sizes, int n_in, void* d_out, int out_size, void* d_ws, size_t ws_size, hipStream_t stream) {
    static int grid = 0;
    if (grid == 0) {
        if (n_in != 30 || in_sizes[0] != M * D || out_size != M * D || ws_size < WS_END) { fprintf(stderr, "kernel_launch: shape/workspace mismatch: n_in %d in0 %d out %d ws %zu (need %zu)\n", n_in, n_in > 0 ? in_sizes[0] : -1, out_size, ws_size, (size_t)WS_END); grid = -1; return; }
        int dev = 0, cus = 0, per_cu = 0;
        if (hipGetDevice(&dev) != hipSuccess || hipDeviceGetAttribute(&cus, hipDeviceAttributeMultiprocessorCount, dev) != hipSuccess) { grid = -1; return; }
        if (hipFuncSetAttribute((const void*)fwd, hipFuncAttributeMaxDynamicSharedMemorySize, LDS_BYTES) != hipSuccess) { fprintf(stderr, "kernel_launch: hipFuncSetAttribute failed\n"); grid = -1; return; }
        if (hipOccupancyMaxActiveBlocksPerMultiprocessor(&per_cu, (const void*)fwd, NWAVES * 64, LDS_BYTES) != hipSuccess || per_cu < 1) fprintf(stderr, "kernel_launch: occupancy query reports %d\n", per_cu);
        (void)hipGetLastError();
        grid = cus;
    }
    if (grid < 0) return;
    if (hipMemsetAsync((char*)d_ws + WS_CTL, 0, CTL_ZERO_BYTES, stream) != hipSuccess) return;
    Args a{};
    for (int i = 0; i < 30; ++i) a.in[i] = d_in[i];
    a.out = (float*)d_out; a.ws = (unsigned char*)d_ws;
    if (MK_N_LAUNCHES == 1) { a.ph_lo = 0; a.ph_hi = N_PHASES; hipLaunchKernelGGL(fwd, dim3(grid), dim3(NWAVES * 64), LDS_BYTES, stream, a); }
    else { for (int p = 0; p < N_PHASES; ++p) { a.ph_lo = p; a.ph_hi = p + 1; hipLaunchKernelGGL(fwd, dim3(grid), dim3(NWAVES * 64), LDS_BYTES, stream, a); } }
    const hipError_t le = hipPeekAtLastError();
    if (le != hipSuccess) fprintf(stderr, "kernel_launch: launch failed: %s\n", hipGetErrorName(le));
}
```

```cpp
#include <hip/hip_runtime.h>
#include <cstdio>
#include <cstdint>

#define FLASH_WIN 1
#define FLASH_SLC 1
#define FLASH_MLA 1
#define FLASH_DIL 1
#define PROBE_MASK 0
#ifndef MK_N_LAUNCHES
#define MK_N_LAUNCHES 1
#endif

namespace pg8 {
#define PG8_LAS __attribute__((address_space(3)))
typedef unsigned short bf16_t;
typedef short bf16x8 __attribute__((ext_vector_type(8)));
typedef float f32x4 __attribute__((ext_vector_type(4)));
typedef float f32x2 __attribute__((ext_vector_type(2)));
typedef unsigned u32x4 __attribute__((ext_vector_type(4)));
typedef unsigned u32x2 __attribute__((ext_vector_type(2)));
constexpr int BM = 256, BK = 64, HALF = 128, HTB = HALF * BK * 2  , STAGE_BYTES = 8 * HTB, NXCD = 8, WGM = 8;

__host__ __device__ __forceinline__ int lds_byte(int r, int c) { const int st = (r >> 4) * 2 + (c >> 5), rr = r & 15, cc = c & 31, ob = rr * 64 + cc * 2; return st * 1024 + (ob ^ (((ob >> 9) & 1) << 5)); }
__host__ __device__ __forceinline__ void stage_rc(int b, int& R, int& C) { const int st = b / 1024, sb = b % 1024, swz = sb ^ (((sb >> 9) & 1) << 5); R = (st >> 1) * 16 + swz / 64; C = (st & 1) * 32 + (swz % 64) / 2; }
__host__ __device__ __forceinline__ int perm32(int rho) { const int n = rho >> 4, i = rho & 15; return 8 * (i >> 2) + 4 * n + (i & 3); }

struct Unit { int pm, pn, pb; };
struct Gemm { const bf16_t* A; const bf16_t* Bt; int lda, ldb, K; };

struct StaticOrder {
    int nM, nN, nwg, G, c;
    __host__ __device__ void init(int M, int N, int G_, int c_) { nM = M / BM; nN = N / BM; nwg = nM * nN; G = G_; c = c_; }
    __host__ __device__ bool next(int i, Unit& u) const {
        const long L = (long)i * G + c; if (L >= nwg) return false;
        int wgid = (int)L; { const int q = nwg / NXCD, r = nwg % NXCD, xcd = wgid % NXCD, off = wgid / NXCD; wgid = (xcd < r ? xcd * (q + 1) : r * (q + 1) + (xcd - r) * q) + off; }
        const int nig = WGM * nN, gid = wgid / nig, fm = gid * WGM, gsz = (nM - fm) < WGM ? (nM - fm) : WGM;
        u.pm = fm + ((wgid % nig) % gsz); u.pn = (wgid % nig) / gsz; u.pb = u.pn; return true;
    }
    __device__ __forceinline__ void a_ready(const Unit&) const {}
    __device__ __forceinline__ void done(const Unit&) const {}
};
struct GroupedOrder {
    int nN, G, c; int ts[9];
    __device__ __forceinline__ void init(const unsigned* tstart, int nN_, int G_, int c_) { nN = nN_; G = G_; c = c_;
#pragma unroll
        for (int e = 0; e < 9; ++e) ts[e] = (int)tstart[e]; }
    __device__ __forceinline__ bool next(int i, Unit& u) const {
        const long L = (long)i * G + c; if (L >= (long)ts[8] * nN) return false;
        int e = 0, us = 0, te = ts[1] - ts[0], t0 = ts[0];
#pragma unroll
        for (int k = 1; k < 8; ++k) { const int s = ts[k] * nN; if (L >= s) { e = k; us = s; te = ts[k + 1] - ts[k]; t0 = ts[k]; } }
        const int r = (int)L - us; if (te <= 0) return false;
        u.pm = t0 + r % te; u.pn = r / te; u.pb = e * nN + u.pn; return true;
    }
    __device__ __forceinline__ void a_ready(const Unit&) const {}
    __device__ __forceinline__ void done(const Unit&) const {}
};

__device__ __forceinline__ unsigned cvt_pk_bf16(float lo, float hi) { unsigned r; asm volatile("v_cvt_pk_bf16_f32 %0, %1, %2" : "=v"(r) : "v"(lo), "v"(hi)); return r; }

struct EpiBf16 {
    static constexpr bool PERM = true, AFTER_DRAIN = false;
    bf16_t* O; int ldc; const float* rowscale;
    __device__ __forceinline__ void operator()(const f32x4 (&acc)[2][2][4][2], const Unit& u, int wr, int wc, int fr, int fq) const {
        const int row0 = u.pm * BM + wr * 64 + fr; const int col0 = u.pn * BM + wc * 32 + 8 * fq;
#pragma unroll
        for (int ai = 0; ai < 2; ++ai)
#pragma unroll
            for (int m = 0; m < 4; ++m) { const int row = row0 + ai * HALF + m * 16; bf16_t* rowp = O + (size_t)row * ldc + col0; const float sc = rowscale ? rowscale[row] : 1.f;
#pragma unroll
                for (int bj = 0; bj < 2; ++bj) { f32x4 v0 = acc[ai][bj][m][0] * sc, v1 = acc[ai][bj][m][1] * sc;
                    u32x4 w; w.x = cvt_pk_bf16(v0[0], v0[1]); w.y = cvt_pk_bf16(v0[2], v0[3]); w.z = cvt_pk_bf16(v1[0], v1[1]); w.w = cvt_pk_bf16(v1[2], v1[3]);
                    *(u32x4*)(rowp + bj * HALF) = w; } }
    }
};
struct EpiResid {
    static constexpr bool PERM = false, AFTER_DRAIN = false;
    const float* xin; float* xout; int ldc; const float* gate; int gstride; int tiles_per_b;
    __device__ __forceinline__ void operator()(const f32x4 (&acc)[2][2][4][2], const Unit& u, int wr, int wc, int fr, int fq) const {
        const int row0 = u.pm * BM + wr * 64 + fr, col0 = u.pn * BM + wc * 32 + 4 * fq;
        const float* gp = gate + (size_t)(u.pm / tiles_per_b) * gstride + col0;
        f32x4 gv[2][2];
#pragma unroll
        for (int bj = 0; bj < 2; ++bj)
#pragma unroll
            for (int n = 0; n < 2; ++n) gv[bj][n] = *(const f32x4*)(gp + bj * HALF + n * 16);
#pragma unroll
        for (int ai = 0; ai < 2; ++ai)
#pragma unroll
            for (int m = 0; m < 4; ++m) { const size_t off = (size_t)(row0 + ai * HALF + m * 16) * ldc + col0;
#pragma unroll
                for (int bj = 0; bj < 2; ++bj)
#pragma unroll
                    for (int n = 0; n < 2; ++n) { const f32x4 xi = *(const f32x4*)(xin + off + bj * HALF + n * 16);
                        *(f32x4*)(xout + off + bj * HALF + n * 16) = xi + gv[bj][n] * acc[ai][bj][m][n]; }
                asm volatile("" ::: "memory"); }
    }
};
__device__ __forceinline__ float silu_f(float g) { return g * __builtin_amdgcn_rcpf(1.0f + __builtin_amdgcn_exp2f(-1.4426950408889634f * g)); }
struct EpiSwiGLU {
    static constexpr bool PERM = false, AFTER_DRAIN = false;
    bf16_t* O; int ldo;
    __device__ __forceinline__ void operator()(const f32x4 (&acc)[2][2][4][2], const Unit& u, int wr, int wc, int fr, int fq) const {
        const int row0 = u.pm * BM + wr * 64 + fr, col0 = u.pn * HALF + wc * 16 + 4 * fq;
#pragma unroll
        for (int ai = 0; ai < 2; ++ai)
#pragma unroll
            for (int m = 0; m < 4; ++m) { bf16_t* rowp = O + (size_t)(row0 + ai * HALF + m * 16) * ldo + col0;
#pragma unroll
                for (int bj = 0; bj < 2; ++bj) { const f32x4 g = acc[ai][bj][m][0], up = acc[ai][bj][m][1];
                    u32x2 w; w.x = cvt_pk_bf16(silu_f(g[0]) * up[0], silu_f(g[1]) * up[1]); w.y = cvt_pk_bf16(silu_f(g[2]) * up[2], silu_f(g[3]) * up[3]);
                    *(u32x2*)(rowp + bj * 64) = w; } }
    }
};

template <class Epi, class Sched, bool ALIGN_EPI = false, bool SP2 = false>
__device__ __forceinline__ void gemm_phase(PG8_LAS unsigned char* lds, const Gemm g, const Sched& S, const Epi& E) {
    const int tid = threadIdx.x, wid = __builtin_amdgcn_readfirstlane(tid >> 6), lane = tid & 63, wr = wid >> 2, wc = wid & 3, fr = lane & 15, fq = lane >> 4;
    const int K = g.K, nt = K / BK;
    unsigned voffA[2], voffB[2];
#pragma unroll
    for (int i = 0; i < 2; ++i) { int R, C; stage_rc(tid * 16 + i * 8192, R, C); const int Rb = Epi::PERM ? ((R & ~31) + perm32(R & 31)) : R;
        voffA[i] = (unsigned)(R * g.lda + C) * 2u; voffB[i] = (unsigned)(Rb * g.ldb + C) * 2u; }
    const size_t kstep = (size_t)(BK * 2);
    const size_t hstepA = (size_t)HALF * g.lda * 2, hstepB = (size_t)HALF * g.ldb * 2;
    const size_t tstepA = 2 * hstepA, tstepB = 2 * hstepB;
    const unsigned ldsw = (unsigned)wid * 1024u;
    const int aoff = lds_byte(wr * 64 + fr, fq * 8), boff = lds_byte(wc * 32 + fr, fq * 8);
#define PG8_SA(b, h) (((b) * 2 + (h)) * HTB)
#define PG8_SB(b, h) ((4 + (b) * 2 + (h)) * HTB)
#define PG8_STAGE(bufoff, gbase, voff) do { _Pragma("unroll") for (int _i = 0; _i < 2; ++_i) \
        __builtin_amdgcn_global_load_lds((const unsigned*)((const char*)(gbase) + (voff)[_i]), (PG8_LAS unsigned*)(lds + (bufoff) + ldsw + _i * 8192), 16, 0, 0); } while (0)
#define PG8_LDA(dst, b, h) do { _Pragma("unroll") for (int m = 0; m < 4; ++m) _Pragma("unroll") for (int k = 0; k < 2; ++k) dst[m][k] = *(const PG8_LAS bf16x8*)(lds + PG8_SA(b, h) + aoff + m * 2048 + k * 1024); } while (0)
#define PG8_LDB(dst, b, h) do { _Pragma("unroll") for (int n = 0; n < 2; ++n) _Pragma("unroll") for (int k = 0; k < 2; ++k) dst[n][k] = *(const PG8_LAS bf16x8*)(lds + PG8_SB(b, h) + boff + n * 2048 + k * 1024); } while (0)
#define PG8_MMA(ai, bj, At, Bt) do { __builtin_amdgcn_s_setprio(1); _Pragma("unroll") for (int m = 0; m < 4; ++m) _Pragma("unroll") for (int n = 0; n < 2; ++n) _Pragma("unroll") for (int k = 0; k < 2; ++k) \
        acc[ai][bj][m][n] = __builtin_amdgcn_mfma_f32_16x16x32_bf16(Bt[n][k], At[m][k], acc[ai][bj][m][n], 0, 0, 0); __builtin_amdgcn_s_setprio(0); } while (0)
#define PG8_WAIT_V(n) asm volatile("s_waitcnt vmcnt(" #n ")" ::: "memory")
#define PG8_WAIT_L(n) asm volatile("s_waitcnt lgkmcnt(" #n ")" ::: "memory")
#define PG8_BAR __builtin_amdgcn_s_barrier()
#define PG8_SCHED __builtin_amdgcn_sched_barrier(0)
    Unit cur, nxt; int ui = 0;
    if (!S.next(0, cur)) return;
    f32x4 acc[2][2][4][2];
#pragma unroll
    for (int a = 0; a < 2; ++a)
#pragma unroll
        for (int b = 0; b < 2; ++b)
#pragma unroll
            for (int m = 0; m < 4; ++m)
#pragma unroll
                for (int n = 0; n < 2; ++n) acc[a][b][m][n] = (f32x4){0.f, 0.f, 0.f, 0.f};
    bf16x8 At[4][2], B0[2][2], B1[2][2];
    const char* cA = (const char*)g.A + (size_t)cur.pm * tstepA; const char* cB = (const char*)g.Bt + (size_t)cur.pb * tstepB;
    S.a_ready(cur);
    if constexpr (SP2) {
        PG8_STAGE(PG8_SB(0, 0), cB, voffB); PG8_STAGE(PG8_SB(0, 1), cB + hstepB, voffB); PG8_STAGE(PG8_SA(0, 0), cA, voffA); PG8_STAGE(PG8_SA(0, 1), cA + hstepA, voffA);
        if (wr == 1) PG8_BAR;
        PG8_WAIT_V(2); PG8_BAR;
        PG8_STAGE(PG8_SB(1, 0), cB + kstep, voffB); PG8_STAGE(PG8_SA(1, 0), cA + kstep, voffA); PG8_STAGE(PG8_SB(1, 1), cB + hstepB + kstep, voffB);
        PG8_WAIT_V(6); PG8_BAR;
    } else {
        PG8_STAGE(PG8_SB(0, 0), cB, voffB); PG8_STAGE(PG8_SA(0, 0), cA, voffA); PG8_STAGE(PG8_SB(0, 1), cB + hstepB, voffB); PG8_STAGE(PG8_SA(0, 1), cA + hstepA, voffA);
        if (wr == 1) PG8_BAR;
        PG8_WAIT_V(4); PG8_BAR;
        PG8_STAGE(PG8_SB(1, 0), cB + kstep, voffB); PG8_STAGE(PG8_SA(1, 0), cA + kstep, voffA); PG8_STAGE(PG8_SB(1, 1), cB + hstepB + kstep, voffB);
        PG8_WAIT_V(6); PG8_BAR;
    }
    for (;;) {
        const bool has_next = S.next(ui + 1, nxt);
        const char* nA = has_next ? (const char*)g.A + (size_t)nxt.pm * tstepA : cA; const char* nB = has_next ? (const char*)g.Bt + (size_t)nxt.pb * tstepB : cB;
        for (int t = 0; t < nt; t += 2) {
            const bool last = (t == nt - 2);
            const char* a1 = cA + (size_t)(t + 1) * kstep;
            const char* a2 = last ? nA : cA + (size_t)(t + 2) * kstep; const char* b2 = last ? nB : cB + (size_t)(t + 2) * kstep;
            const char* a3 = a2 + kstep; const char* b3 = b2 + kstep;
            if (last && has_next) S.a_ready(nxt);
            if constexpr (SP2) {
            PG8_LDB(B0, 0, 0); PG8_LDB(B1, 0, 1); PG8_SCHED; PG8_LDA(At, 0, 0); PG8_STAGE(PG8_SA(1, 1), a1 + hstepA, voffA);
            PG8_WAIT_V(8); PG8_WAIT_L(0); PG8_BAR; PG8_MMA(0, 0, At, B0); PG8_MMA(0, 1, At, B1); PG8_BAR; PG8_SCHED;
            PG8_LDA(At, 0, 1); PG8_STAGE(PG8_SB(0, 0), b2, voffB); PG8_STAGE(PG8_SB(0, 1), b2 + hstepB, voffB); PG8_STAGE(PG8_SA(0, 0), a2, voffA);
            PG8_WAIT_V(8); PG8_WAIT_L(0); PG8_BAR; PG8_MMA(1, 0, At, B0); PG8_MMA(1, 1, At, B1); PG8_BAR; PG8_SCHED;
            PG8_LDB(B0, 1, 0); PG8_LDB(B1, 1, 1); PG8_SCHED; PG8_LDA(At, 1, 0); PG8_STAGE(PG8_SA(0, 1), a2 + hstepA, voffA);
            PG8_WAIT_V(8); PG8_WAIT_L(0); PG8_BAR; PG8_MMA(0, 0, At, B0); PG8_MMA(0, 1, At, B1); PG8_BAR; PG8_SCHED;
            PG8_LDA(At, 1, 1); PG8_STAGE(PG8_SB(1, 0), b3, voffB); PG8_STAGE(PG8_SB(1, 1), b3 + hstepB, voffB); PG8_STAGE(PG8_SA(1, 0), a3, voffA);
            PG8_WAIT_V(8); PG8_WAIT_L(0); PG8_BAR; PG8_MMA(1, 0, At, B0); PG8_MMA(1, 1, At, B1); PG8_BAR; PG8_SCHED;
            } else {
            PG8_LDB(B0, 0, 0); PG8_SCHED; PG8_LDA(At, 0, 0); PG8_STAGE(PG8_SA(1, 1), a1 + hstepA, voffA);
            PG8_WAIT_L(8); PG8_BAR; PG8_WAIT_L(0); PG8_MMA(0, 0, At, B0); PG8_BAR; PG8_SCHED;
            PG8_LDB(B1, 0, 1); PG8_STAGE(PG8_SB(0, 0), b2, voffB);
            PG8_BAR; PG8_WAIT_L(0); PG8_MMA(0, 1, At, B1); PG8_BAR;
            PG8_LDA(At, 0, 1); PG8_STAGE(PG8_SA(0, 0), a2, voffA);
            PG8_BAR; PG8_WAIT_L(0); PG8_MMA(1, 0, At, B0); PG8_BAR; PG8_SCHED;
            PG8_STAGE(PG8_SB(0, 1), b2 + hstepB, voffB);
            PG8_WAIT_V(6); PG8_BAR; PG8_MMA(1, 1, At, B1); PG8_BAR;
            PG8_LDB(B0, 1, 0); PG8_SCHED; PG8_LDA(At, 1, 0); PG8_STAGE(PG8_SA(0, 1), a2 + hstepA, voffA);
            PG8_WAIT_L(8); PG8_BAR; PG8_WAIT_L(0); PG8_MMA(0, 0, At, B0); PG8_BAR; PG8_SCHED;
            PG8_LDB(B1, 1, 1); PG8_STAGE(PG8_SB(1, 0), b3, voffB);
            PG8_BAR; PG8_WAIT_L(0); PG8_MMA(0, 1, At, B1); PG8_BAR;
            PG8_LDA(At, 1, 1); PG8_STAGE(PG8_SA(1, 0), a3, voffA);
            PG8_BAR; PG8_WAIT_L(0); PG8_MMA(1, 0, At, B0); PG8_BAR; PG8_SCHED;
            PG8_STAGE(PG8_SB(1, 1), b3 + hstepB, voffB);
            PG8_WAIT_V(6); PG8_BAR; PG8_MMA(1, 1, At, B1); PG8_BAR;
            }
        }
        if constexpr (ALIGN_EPI) { if (wr == 0) PG8_BAR; }
        if constexpr (!Epi::AFTER_DRAIN) { E(acc, cur, wr, wc, fr, fq); S.done(cur); }
        if (!has_next) break;
#pragma unroll
        for (int a = 0; a < 2; ++a)
#pragma unroll
            for (int b = 0; b < 2; ++b)
#pragma unroll
                for (int m = 0; m < 4; ++m)
#pragma unroll
                    for (int n = 0; n < 2; ++n) acc[a][b][m][n] = (f32x4){0.f, 0.f, 0.f, 0.f};
        cur = nxt; cA = nA; cB = nB; ++ui;
        if constexpr (ALIGN_EPI) { if (wr == 1) PG8_BAR; }
    }
    PG8_WAIT_V(0);
    if constexpr (!ALIGN_EPI) { if (wr == 0) PG8_BAR; }
    PG8_BAR;
    if constexpr (Epi::AFTER_DRAIN) { E.fused(acc, cur, wr, wc, fr, fq, lds, wid, lane); S.done(cur); }
#undef PG8_SA
#undef PG8_SB
#undef PG8_STAGE
#undef PG8_LDA
#undef PG8_LDB
#undef PG8_MMA
#undef PG8_WAIT_V
#undef PG8_WAIT_L
#undef PG8_BAR
#undef PG8_SCHED
}

}

#ifndef FA_DBG_NOSEL
#define FA_DBG_NOSEL 0
#endif
#ifndef FA_DBG_NOMERGE
#define FA_DBG_NOMERGE 0
#endif
#ifndef FA_SEL_SKIP
#define FA_SEL_SKIP 0
#endif
namespace fa {
#define FA_LAS __attribute__((address_space(3)))
typedef unsigned short bf16;
typedef short bf16x8 __attribute__((ext_vector_type(8)));
typedef short s16x4 __attribute__((ext_vector_type(4)));
typedef float f32x16 __attribute__((ext_vector_type(16)));
typedef float f32x4 __attribute__((ext_vector_type(4)));
typedef unsigned u32x4 __attribute__((ext_vector_type(4)));
constexpr int QB = 256, QBLK = 32, KVBLK = 64;
constexpr int SHM_K = 16384, SHM_V = 16384, SHM_K2 = 8192;
constexpr int OFF_V = 0, OFF_K = 2 * SHM_V, OFF_K2 = OFF_K + 2 * SHM_K, OFF_WS = OFF_K2 + 2 * SHM_K2, WS_PER_WAVE = 1024, OFF_TAB = OFF_WS + 8 * WS_PER_WAVE;
constexpr int TAB_PAD = 320, TAB_MAX = 4096 + TAB_PAD;
constexpr int LDS_END = OFF_TAB + TAB_MAX * 4;
constexpr int OSTG = 272;
static_assert(LDS_END <= 131072 && 8 * 32 * OSTG <= OFF_WS, "attention LDS map");
#define KSWZ(row, colB) ((row) * 256 + ((colB) ^ (((row) & 7) << 4)))
#define K2SWZ(row, colB) ((row) * 128 + ((colB) ^ (((row) & 7) << 4)))
#define SBAR() __builtin_amdgcn_sched_barrier(0)
__device__ __forceinline__ int v_st(int k, int c) { const int kk = (k & ~0xC) | ((k & 4) << 1) | ((k & 8) >> 1); return ((kk >> 3) * 4 + (c >> 5)) * 512 + ((kk & 7) * 32 + (c & 31)) * 2; }
__device__ __forceinline__ int v_rd_base(int lane) { return ((lane & 3) << 3) | (((lane >> 2) & 3) << 6) | (((lane >> 4) & 1) << 5) | (((lane >> 5) & 1) << 8); }
constexpr int v_rd_off(int d0, int ks, int half) { return d0 * 512 + ks * 4096 + half * 2048; }
__device__ __forceinline__ int crow(int r, int hi) { return (r & 3) + 8 * (r >> 2) + 4 * hi; }
__device__ __forceinline__ unsigned cvtpk(float lo, float hi) { unsigned r; asm volatile("v_cvt_pk_bf16_f32 %0, %1, %2" : "=v"(r) : "v"(lo), "v"(hi)); return r; }

struct Item {
    const bf16* Q; long qs;
    const float* rope; long ropes;
    const bf16* K; long ks; const bf16* K2; long k2s; const bf16* V; long vs;
    int P0, skv, W;
    const float* bias; int bstep;
    const unsigned long long* sel; long sels;
    bf16* O; long os;
    float* LSE; long lses;
    const bf16* M0; const bf16* M1; long ms; const bf16* G; long gs;
};

template <int VAR>
__device__ __forceinline__ void attn_block(const Item& it, unsigned char* lds_g) {
    constexpr bool HAS_BIAS = VAR != 2, HAS_SEL = VAR == 1, HAS_K2 = VAR == 2;
    constexpr float SCALE = HAS_K2 ? 0.07216878364870322f : 0.08838834764831845f, C2 = 1.4426950408889634f * SCALE, THR = 8.f;
    FA_LAS unsigned char* L = (FA_LAS unsigned char*)lds_g;
    const int tid = threadIdx.x, wid = __builtin_amdgcn_readfirstlane(tid >> 6), lane = tid & 63, r32 = lane & 31, hi = lane >> 5;
    const int W = it.W;
    const int j_lo = (it.P0 - W + 1 > 0) ? (it.P0 - W + 1) / KVBLK : 0;
    int j_hi = (it.P0 + QB - 1) / KVBLK + 1; if (j_hi > it.skv / KVBLK) j_hi = it.skv / KVBLK;
    const int NT = j_hi - j_lo;
    const int qlo = it.P0 + wid * QBLK, qm = qlo + r32 - 4 * hi;
    FA_LAS float* wsl = (FA_LAS float*)(L + OFF_WS + wid * WS_PER_WAVE); FA_LAS float* li_l = wsl; FA_LAS float* al_l = wsl + 32;
    FA_LAS float* tab = (FA_LAS float*)(L + OFF_TAB);
    const int sr = tid >> 4, sc = (tid & 15) * 8, vst0 = v_st(sr, sc), vst1 = v_st(32 + sr, sc), kws = KSWZ(sr, sc * 2);
    const int k2r = tid >> 3, k2c = (tid & 7) * 8, k2ws = K2SWZ(k2r, k2c * 2);
    const int vb0 = OFF_V + v_rd_base(lane);
    bf16x8 qr[8]; bf16x8 qr2[4];
    { const bf16* qp = it.Q + (long)(qlo + r32) * it.qs + hi * 8;
#pragma unroll
      for (int d0 = 0; d0 < 8; ++d0) qr[d0] = *(const bf16x8*)(qp + d0 * 16);
      if constexpr (HAS_K2) {
          const float* rp = it.rope + (long)(qlo + r32) * it.ropes + hi * 8;
          bf16x8 raw[4];
#pragma unroll
          for (int d0 = 0; d0 < 4; ++d0) raw[d0] = *(const bf16x8*)(qp + 128 + d0 * 16);
#pragma unroll
          for (int d0 = 0; d0 < 2; ++d0) { const f32x4 c0 = *(const f32x4*)(rp + d0 * 16), c1 = *(const f32x4*)(rp + d0 * 16 + 4), s0 = *(const f32x4*)(rp + 32 + d0 * 16), s1 = *(const f32x4*)(rp + 32 + d0 * 16 + 4);
              float o1[8], o2[8];
#pragma unroll
              for (int j = 0; j < 8; ++j) { const float x1 = __builtin_bit_cast(float, (unsigned)(unsigned short)raw[d0][j] << 16), x2 = __builtin_bit_cast(float, (unsigned)(unsigned short)raw[d0 + 2][j] << 16);
                  const float cs = j < 4 ? c0[j & 3] : c1[j & 3], sn = j < 4 ? s0[j & 3] : s1[j & 3]; o1[j] = x1 * cs - x2 * sn; o2[j] = x2 * cs + x1 * sn; }
              u32x4 w1 = {cvtpk(o1[0], o1[1]), cvtpk(o1[2], o1[3]), cvtpk(o1[4], o1[5]), cvtpk(o1[6], o1[7])}, w2 = {cvtpk(o2[0], o2[1]), cvtpk(o2[2], o2[3]), cvtpk(o2[4], o2[5]), cvtpk(o2[6], o2[7])};
              qr2[d0] = __builtin_bit_cast(bf16x8, w1); qr2[d0 + 2] = __builtin_bit_cast(bf16x8, w2); }
      }
    }
    unsigned long long selm = ~0ull;
    if constexpr (HAS_SEL) selm = __hip_atomic_load(it.sel + (long)(qlo + r32) * it.sels, __ATOMIC_RELAXED, __HIP_MEMORY_SCOPE_AGENT);
    if constexpr (HAS_BIAS) {
        int rmax = W + 320; if (rmax > 4096) rmax = 4096;
        for (int i = tid; i < rmax + TAB_PAD; i += 512) { int r = i - TAB_PAD; r = r < -64 ? -64 : r; long gi = (long)r * it.bstep; gi = gi > 4095 ? 4095 : gi; tab[i] = it.bias[gi] * (1.0f / SCALE); }
    }
    bf16x8 st_k0, st_k1, st_v0, st_v1, st_k2;
#define FA_LOAD(kb_) do { const long r0_ = (long)((kb_) + sr), r1_ = r0_ + 32; \
        st_v0 = *(const bf16x8*)(it.V + r0_ * it.vs + sc); st_v1 = *(const bf16x8*)(it.V + r1_ * it.vs + sc); \
        st_k0 = *(const bf16x8*)(it.K + r0_ * it.ks + sc); st_k1 = *(const bf16x8*)(it.K + r1_ * it.ks + sc); \
        if constexpr (HAS_K2) st_k2 = *(const bf16x8*)(it.K2 + (long)((kb_) + k2r) * it.k2s + k2c); } while (0)
#define FA_WRITE(bf_) do { *(FA_LAS bf16x8*)(L + OFF_V + (bf_) * SHM_V + vst0) = st_v0; *(FA_LAS bf16x8*)(L + OFF_V + (bf_) * SHM_V + vst1) = st_v1; \
        *(FA_LAS bf16x8*)(L + OFF_K + (bf_) * SHM_K + kws) = st_k0; *(FA_LAS bf16x8*)(L + OFF_K + (bf_) * SHM_K + kws + 32 * 256) = st_k1; \
        if constexpr (HAS_K2) *(FA_LAS bf16x8*)(L + OFF_K2 + (bf_) * SHM_K2 + k2ws) = st_k2; } while (0)
    FA_LOAD(j_lo * KVBLK);
    asm volatile("s_waitcnt vmcnt(0)" ::: "memory");
    FA_WRITE(0);
    __syncthreads();
    float m_reg = -1e30f, l_reg = 0.f; f32x16 o[4] = {};
#define FA_KBASE(t) ((j_lo + (t)) * KVBLK)
#define FA_STEP(BUF, t) do { \
        const int kb_ = FA_KBASE(t); \
        if ((t) + 1 < NT) FA_LOAD(FA_KBASE((t) + 1)); \
        bool act_ = (kb_ <= qlo + QBLK - 1) && (kb_ + KVBLK - 1 >= qlo - W + 1); \
        bool allow_ = true; \
        if constexpr (HAS_SEL) { allow_ = FA_DBG_NOSEL ? true : (bool)((selm >> (kb_ >> 6)) & 1ull); if (FA_SEL_SKIP) act_ = act_ && __any(allow_); } \
        if (act_) { \
            f32x16 p0 = {}, p1 = {}; \
            { const int ka_ = OFF_K + (BUF) * SHM_K; \
              _Pragma("unroll") for (int d0 = 0; d0 < 8; ++d0) { \
                const bf16x8 b0 = *(const FA_LAS bf16x8*)(L + ka_ + KSWZ(r32, (d0 * 16 + hi * 8) * 2)); \
                const bf16x8 b1 = *(const FA_LAS bf16x8*)(L + ka_ + 32 * 256 + KSWZ(r32, (d0 * 16 + hi * 8) * 2)); \
                p0 = __builtin_amdgcn_mfma_f32_32x32x16_bf16(b0, qr[d0], p0, 0, 0, 0); p1 = __builtin_amdgcn_mfma_f32_32x32x16_bf16(b1, qr[d0], p1, 0, 0, 0); } \
              if constexpr (HAS_K2) { const int k2a_ = OFF_K2 + (BUF) * SHM_K2; \
                _Pragma("unroll") for (int d0 = 0; d0 < 4; ++d0) { \
                  const bf16x8 b0 = *(const FA_LAS bf16x8*)(L + k2a_ + K2SWZ(r32, (d0 * 16 + hi * 8) * 2)); \
                  const bf16x8 b1 = *(const FA_LAS bf16x8*)(L + k2a_ + 32 * 128 + K2SWZ(r32, (d0 * 16 + hi * 8) * 2)); \
                  p0 = __builtin_amdgcn_mfma_f32_32x32x16_bf16(b0, qr2[d0], p0, 0, 0, 0); p1 = __builtin_amdgcn_mfma_f32_32x32x16_bf16(b1, qr2[d0], p1, 0, 0, 0); } } } \
            const int dq_ = qm - kb_; \
            if constexpr (HAS_BIAS) { const FA_LAS float* tb_ = tab + (TAB_PAD + dq_ - 63); \
                _Pragma("unroll") for (int r = 0; r < 16; ++r) { const int c_ = (r & 3) + 8 * (r >> 2); p0[r] += tb_[63 - c_]; p1[r] += tb_[31 - c_]; } } \
            if (HAS_SEL || kb_ + KVBLK - 1 > qlo || kb_ <= qlo + QBLK - 1 - W) { const float NEG_ = -__builtin_inff(); const int dqm_ = allow_ ? dq_ : -0x40000000; \
                _Pragma("unroll") for (int r = 0; r < 16; ++r) { const int c_ = (r & 3) + 8 * (r >> 2); \
                    if ((unsigned)(dqm_ - c_) >= (unsigned)W) p0[r] = NEG_; if ((unsigned)(dqm_ - c_ - 32) >= (unsigned)W) p1[r] = NEG_; } } \
              \
            float pmax_ = p0[0]; _Pragma("unroll") for (int r = 1; r < 16; ++r) pmax_ = fmaxf(pmax_, p0[r]); _Pragma("unroll") for (int r = 0; r < 16; ++r) pmax_ = fmaxf(pmax_, p1[r]); \
            { auto rr_ = __builtin_amdgcn_permlane32_swap(__float_as_uint(pmax_), __float_as_uint(pmax_), false, false); pmax_ = fmaxf(__uint_as_float(rr_[0]), __uint_as_float(rr_[1])); } \
            float mn_, alpha_; \
            if (__all((pmax_ - m_reg) * SCALE <= THR)) { mn_ = m_reg; alpha_ = 1.f; } \
            else { mn_ = fmaxf(m_reg, pmax_); alpha_ = __builtin_amdgcn_exp2f((m_reg - mn_) * C2); m_reg = mn_; } \
            const float mnL_ = -mn_ * C2; float ps_ = 0.f; \
            _Pragma("unroll") for (int r = 0; r < 16; ++r) { p0[r] = __builtin_amdgcn_exp2f(fmaf(p0[r], C2, mnL_)); p1[r] = __builtin_amdgcn_exp2f(fmaf(p1[r], C2, mnL_)); ps_ += p0[r] + p1[r]; } \
            { auto rr_ = __builtin_amdgcn_permlane32_swap(__float_as_uint(ps_), __float_as_uint(ps_), false, false); ps_ = __uint_as_float(rr_[0]) + __uint_as_float(rr_[1]); } \
            l_reg = l_reg * alpha_ + ps_; \
            bf16x8 pa0, pa1, pa2, pa3; \
            FA_PK4(p0, 0, pa0); FA_PK4(p0, 8, pa1); FA_PK4(p1, 0, pa2); FA_PK4(p1, 8, pa3); \
            if (__any(alpha_ < 1.f)) { if (hi == 0) al_l[r32] = alpha_; asm volatile("s_waitcnt lgkmcnt(0)" ::: "memory"); \
                _Pragma("unroll") for (int d_ = 0; d_ < 4; ++d_) _Pragma("unroll") for (int r = 0; r < 16; ++r) o[d_][r] *= al_l[crow(r, hi)]; } \
            FA_PV_D0(BUF, 0); FA_PV_D0(BUF, 1); FA_PV_D0(BUF, 2); FA_PV_D0(BUF, 3); \
        } \
        if ((t) + 1 < NT) { asm volatile("s_waitcnt vmcnt(0)" ::: "memory"); FA_WRITE(1 - (BUF)); } \
        __syncthreads(); } while (0)
#define FA_PK4(P, B_, OUT) do { unsigned a0 = cvtpk(P[B_+0], P[B_+1]), a1 = cvtpk(P[B_+2], P[B_+3]); unsigned b0 = cvtpk(P[B_+4], P[B_+5]), b1 = cvtpk(P[B_+6], P[B_+7]); \
        auto r0 = __builtin_amdgcn_permlane32_swap(a0, b0, false, false); auto r1 = __builtin_amdgcn_permlane32_swap(a1, b1, false, false); \
        u32x4 w = {r0[0], r1[0], r0[1], r1[1]}; OUT = __builtin_bit_cast(bf16x8, w); } while (0)
#define FA_TRRD(dst, off) asm volatile("ds_read_b64_tr_b16 %0, %1 offset:%2" : "=&v"(dst) : "v"(vb0), "i"(off) : "memory")
#define FA_PV_D0(VB, d0) do { s16x4 l0, l1, l2, l3, h0, h1, h2, h3; constexpr int b_ = (VB) * SHM_V + v_rd_off(d0, 0, 0); \
        FA_TRRD(l0, b_); FA_TRRD(h0, b_ + 2048); FA_TRRD(l1, b_ + 4096); FA_TRRD(h1, b_ + 6144); FA_TRRD(l2, b_ + 8192); FA_TRRD(h2, b_ + 10240); FA_TRRD(l3, b_ + 12288); FA_TRRD(h3, b_ + 14336); \
        asm volatile("s_waitcnt lgkmcnt(0)" ::: "memory"); SBAR(); \
        o[d0] = __builtin_amdgcn_mfma_f32_32x32x16_bf16(pa0, (bf16x8){l0[0], l0[1], l0[2], l0[3], h0[0], h0[1], h0[2], h0[3]}, o[d0], 0, 0, 0); \
        o[d0] = __builtin_amdgcn_mfma_f32_32x32x16_bf16(pa1, (bf16x8){l1[0], l1[1], l1[2], l1[3], h1[0], h1[1], h1[2], h1[3]}, o[d0], 0, 0, 0); \
        o[d0] = __builtin_amdgcn_mfma_f32_32x32x16_bf16(pa2, (bf16x8){l2[0], l2[1], l2[2], l2[3], h2[0], h2[1], h2[2], h2[3]}, o[d0], 0, 0, 0); \
        o[d0] = __builtin_amdgcn_mfma_f32_32x32x16_bf16(pa3, (bf16x8){l3[0], l3[1], l3[2], l3[3], h3[0], h3[1], h3[2], h3[3]}, o[d0], 0, 0, 0); } while (0)
    for (int t = 0; t < NT; t += 2) { FA_STEP(0, t); if (t + 1 < NT) FA_STEP(1, t + 1); }
    li_l[r32] = l_reg;
    if constexpr (VAR == 1) { const bf16* gp = it.G + (long)(qlo + r32) * it.gs;
#pragma unroll
        for (int k = 0; k < 3; ++k) { const float gl = __builtin_bit_cast(float, (unsigned)gp[k] << 16); wsl[64 + 32 * k + r32] = 1.0f / (1.0f + __expf(-gl)); } }
    asm volatile("s_waitcnt lgkmcnt(0)" ::: "memory");
    if (it.LSE && hi == 0) it.LSE[(long)(qlo + r32) * it.lses] = m_reg * SCALE + __logf(l_reg);
    FA_LAS unsigned char* stg = L + wid * (32 * OSTG);
#pragma unroll
    for (int r = 0; r < 16; ++r) { const int orow = crow(r, hi); const float lv_ = li_l[orow]; float rl = lv_ > 0.f ? __builtin_amdgcn_rcpf(lv_) : 0.f; if constexpr (VAR == 1 && !FA_DBG_NOMERGE) rl *= wsl[64 + 32 + orow];
#pragma unroll
        for (int d0 = 0; d0 < 4; ++d0) { const float v = o[d0][r] * rl; const unsigned u = __builtin_bit_cast(unsigned, v); *(FA_LAS unsigned short*)(stg + orow * OSTG + (d0 * 32 + r32) * 2) = (unsigned short)((u + 0x7fffu + ((u >> 16) & 1u)) >> 16); } }
    asm volatile("s_waitcnt lgkmcnt(0)" ::: "memory");
#pragma unroll
    for (int i = 0; i < 8; ++i) { const int id = lane + 64 * i, row = id >> 4, ch = id & 15; const long qi = (long)(qlo + row);
        u32x4 w = *(const FA_LAS u32x4*)(stg + row * OSTG + ch * 16);
        if constexpr (VAR == 1 && !FA_DBG_NOMERGE) { const float g0 = wsl[64 + row], g2 = wsl[64 + 64 + row];
            const u32x4 a = *(const u32x4*)(it.M0 + qi * it.ms + ch * 8), c = *(const u32x4*)(it.M1 + qi * it.ms + ch * 8);
#pragma unroll
            for (int k = 0; k < 4; ++k) { const float lo = __builtin_bit_cast(float, w[k] << 16) + g0 * __builtin_bit_cast(float, a[k] << 16) + g2 * __builtin_bit_cast(float, c[k] << 16);
                const float hi_ = __builtin_bit_cast(float, w[k] & 0xffff0000u) + g0 * __builtin_bit_cast(float, a[k] & 0xffff0000u) + g2 * __builtin_bit_cast(float, c[k] & 0xffff0000u); w[k] = cvtpk(lo, hi_); } }
        *(u32x4*)(it.O + qi * it.os + ch * 8) = w; }
    __syncthreads();
#undef FA_LOAD
#undef FA_WRITE
#undef FA_KBASE
#undef FA_STEP
#undef FA_PK4
#undef FA_TRRD
#undef FA_PV_D0
}
}

constexpr int D = 2048, NB = 4, S = 4096, M = NB * S;
constexpr int HD = 128;
constexpr int Z0W = 3840;
constexpr int Z_NQ = 0, Z_NKV = 1024, Z_QLAT = 2560, Z_KVLAT = 3072, Z_KPE = 3584, Z_NG = 3648;
constexpr int QMW = 1536, KVMW = 2048;
constexpr int FF = 5632, FFE = 7168, NE = 8;
constexpr int Z1W = 9216;
constexpr int NSLOT = (2 * M / 256 + NE) * 256;
constexpr float RMS_EPS = 1e-6f;

constexpr size_t MiB = 1u << 20;
constexpr size_t WS_CTL = 0, CTL_ZERO_BYTES = 1 * MiB;
constexpr size_t WS_MOD = 1 * MiB;
constexpr size_t WS_BIAS = 2 * MiB;
constexpr int BIAS_LD = 4096 + 64;
constexpr size_t WS_ROPE = 3 * MiB;
constexpr size_t WS_RINV = 8 * MiB;
constexpr size_t WS_SEL = 9 * MiB;
constexpr size_t WS_KC = 10 * MiB;
constexpr size_t WS_VC = 11 * MiB;
constexpr size_t WS_ROUTE = 12 * MiB;
constexpr size_t WS_LSE = 13 * MiB;
constexpr size_t WS_KPE = 15 * MiB;
constexpr size_t WS_W1T = 17 * MiB, WS_W2T = 19 * MiB, WS_CB1 = 20 * MiB;
constexpr size_t WS_WIN0 = 21 * MiB, WS_WUQ = 36 * MiB, WS_WUKV = 38 * MiB, WS_WOUT0 = 40 * MiB, WS_WGU0 = 48 * MiB, WS_WDN0 = 92 * MiB;
constexpr size_t WS_WIN1 = 114 * MiB, WS_WOUT1 = 150 * MiB, WS_WMGU = 154 * MiB, WS_WMDN = 602 * MiB;
constexpr size_t WS_X = 826 * MiB;
constexpr size_t WS_H = 954 * MiB;
constexpr size_t WS_R = 1018 * MiB;
constexpr size_t WS_Z0 = WS_R, WS_QM = WS_R + 120 * MiB, WS_KVM = WS_R + 168 * MiB, WS_OCMP = WS_R + 232 * MiB, WS_OWIN = WS_R + 264 * MiB, WS_CAT = WS_R + 328 * MiB;
constexpr size_t WS_ACT = WS_R;
constexpr size_t WS_Z1 = WS_R, WS_OP = WS_R + 288 * MiB, WS_OM = WS_R + 384 * MiB;
constexpr size_t WS_XB = WS_R, WS_ACTB = WS_R + 136 * MiB, WS_YB = WS_R;
constexpr size_t WS_END = WS_R + 612 * MiB;
static_assert(WS_Z0 + (size_t)M * Z0W * 2 <= WS_QM && WS_QM + (size_t)M * QMW * 2 <= WS_KVM && WS_KVM + (size_t)M * KVMW * 2 <= WS_OCMP && WS_CAT + (size_t)M * 2048 * 2 <= WS_END, "L0 map");
static_assert(WS_Z1 + (size_t)M * Z1W * 2 <= WS_OM && WS_XB + (size_t)NSLOT * D * 2 <= WS_ACTB && WS_ACTB + (size_t)NSLOT * FFE * 2 <= WS_END, "L1 map");
static_assert(WS_WMDN + (size_t)NE * D * FFE * 2 <= WS_X && WS_WMGU + (size_t)NE * 2 * FFE * D * 2 <= WS_WMDN, "weights map");
constexpr int CW_BAR = 4096;
constexpr int CW_CNT = 64;
constexpr int CW_TS = 128;

constexpr int RING_BYTES = 131072;
constexpr int SMALL_OFF = RING_BYTES;
constexpr int LDSCTL_OFF = RING_BYTES + 16384, MISC_OFF = LDSCTL_OFF;
constexpr int LDS_BYTES = LDSCTL_OFF + 256;
constexpr int NWAVES = 8;

#define GAS __attribute__((address_space(1)))
#define LAS __attribute__((address_space(3)))
typedef unsigned short bf16;
typedef unsigned v4u __attribute__((ext_vector_type(4)));
typedef unsigned v2u __attribute__((ext_vector_type(2)));
typedef float f32x4 __attribute__((ext_vector_type(4)));
typedef float f32x2 __attribute__((ext_vector_type(2)));
#define LDS_WAIT() asm volatile("s_waitcnt lgkmcnt(0)" ::: "memory")
__device__ __forceinline__ unsigned f2bf(float f) { unsigned u = __builtin_bit_cast(unsigned, f); return (u + 0x7fffu + ((u >> 16) & 1u)) >> 16; }
__device__ __forceinline__ unsigned pk2(float lo, float hi) { return f2bf(lo) | (f2bf(hi) << 16); }
__device__ __forceinline__ float bf2f(unsigned short b) { return __builtin_bit_cast(float, (unsigned)b << 16); }
__device__ __forceinline__ float bflo(unsigned w) { return __builtin_bit_cast(float, w << 16); }
__device__ __forceinline__ float bfhi(unsigned w) { return __builtin_bit_cast(float, w & 0xffff0000u); }
__device__ __forceinline__ float wave_sum(float v) {
#pragma unroll
    for (int o = 1; o < 64; o <<= 1) v += __shfl_xor(v, o);
    return v;
}
__device__ __forceinline__ float wave_max(float v) {
#pragma unroll
    for (int o = 1; o < 64; o <<= 1) v = fmaxf(v, __shfl_xor(v, o));
    return v;
}

#define XB_TMO      128
#define XB_XCNT(j)  (256  + 64 * (j))
#define XB_XSUB(j)  (1280 + 64 * (j))
#define XB_XGEN(j)  (2304 + 64 * (j))
#define XB_TOP      3328
#define XB_TOPGEN   3392
#define XCD_BAR_WORDS 3456
#define XB_SPIN_CAP (1u << 22)

__device__ __forceinline__ unsigned xb_ld(unsigned* p)              { return __hip_atomic_load(p, __ATOMIC_RELAXED, __HIP_MEMORY_SCOPE_AGENT); }
__device__ __forceinline__ unsigned xb_add(unsigned* p, unsigned v) { return __hip_atomic_fetch_add(p, v, __ATOMIC_RELAXED, __HIP_MEMORY_SCOPE_AGENT); }
__device__ __forceinline__ unsigned xb_xcc_id() { return (unsigned)__builtin_amdgcn_s_getreg((3 << 11) | 20) & 0xFu; }
#define XB_SPIN(cond, bar) do { unsigned _sp = 0; while (cond) { __builtin_amdgcn_s_sleep(1); \
    if ((++_sp & 255u) == 0u) { if (xb_ld(&(bar)[XB_TMO])) break; if (_sp > XB_SPIN_CAP) { atomicAdd(&(bar)[XB_TMO], 1u); break; } } } } while (0)

struct XcdBarrier {
    unsigned* bar; unsigned x;
    volatile LAS unsigned* st;
};

__device__ __forceinline__ XcdBarrier xcd_barrier_post(unsigned* bar, volatile LAS unsigned* st) {
    XcdBarrier b; b.bar = bar; b.x = xb_xcc_id(); b.st = st;
    if (threadIdx.x == 0) (void)xb_add(&bar[XB_XCNT(b.x)], 1u);
    return b;
}
__device__ __forceinline__ void xcd_barrier_complete(unsigned* bar, unsigned x, unsigned& nloc, unsigned& nx) {
    const unsigned G = gridDim.x * gridDim.y * gridDim.z;
    unsigned sum, cnt, mine, sp = 0u;
    for (;;) {
        sum = 0u; cnt = 0u; mine = 0u;
#pragma unroll
        for (unsigned j = 0; j < 16; ++j) { const unsigned c = xb_ld(&bar[XB_XCNT(j)]); sum += c; cnt += (c > 0u) ? 1u : 0u; mine = (j == x) ? c : mine; }
        if (sum == G) break;
        __builtin_amdgcn_s_sleep(1);
        if ((++sp & 255u) == 0u) { if (xb_ld(&bar[XB_TMO])) break; if (sp > XB_SPIN_CAP) { atomicAdd(&bar[XB_TMO], 1u); break; } }
    }
    nloc = mine > 0u ? mine : 1u; nx = cnt > 0u ? cnt : 1u;
}

__device__ __forceinline__ void xcd_barrier(const XcdBarrier& b) {
    asm volatile("s_waitcnt vmcnt(0)" ::: "memory");
    __syncthreads();
    if (threadIdx.x == 0) {
        unsigned* bar = b.bar;
        __builtin_amdgcn_s_waitcnt(0);
        unsigned nloc = b.st[0], nx = b.st[1];
        if (nloc == 0u) { xcd_barrier_complete(bar, b.x, nloc, nx); b.st[0] = nloc; b.st[1] = nx; }
        const unsigned old = xb_add(&bar[XB_XSUB(b.x)], 1u);
        const unsigned gen = old / nloc;
        if (old + 1u == (gen + 1u) * nloc) {
            __builtin_amdgcn_fence(__ATOMIC_RELEASE, "agent");
            asm volatile("s_waitcnt vmcnt(0)" ::: "memory");
            const unsigned og = xb_add(&bar[XB_TOP], 1u);
            const unsigned tg = og / nx;
            if (og + 1u == (tg + 1u) * nx) xb_add(&bar[XB_TOPGEN], 1u);
            else XB_SPIN(xb_ld(&bar[XB_TOPGEN]) == tg, bar);
            __builtin_amdgcn_fence(__ATOMIC_ACQUIRE, "agent");
            xb_add(&bar[XB_XGEN(b.x)], 1u);
            asm volatile("s_waitcnt vmcnt(0)" ::: "memory");
        } else {
            XB_SPIN(xb_ld(&bar[XB_XGEN(b.x)]) == gen, bar);
            __builtin_amdgcn_fence(__ATOMIC_ACQUIRE, "agent");
            asm volatile("s_waitcnt vmcnt(0)" ::: "memory");
        }
    }
    __syncthreads();
}


struct Args { const void* in[30]; float* out; unsigned char* ws; int ph_lo, ph_hi; };
struct Frame {
    unsigned char* lds;
    int tid, lane, wave, vcu, G, gw, NGW;
    unsigned char* ws;
};

__device__ __forceinline__ int t5_bucket(int n) {
    if (n < 16) return n < 0 ? 0 : n;
    int b = 16;
    b += (n >= 22); b += (n >= 30); b += (n >= 40); b += (n >= 54); b += (n >= 73); b += (n >= 99); b += (n >= 134); b += (n >= 182);
    b += (n >= 246); b += (n >= 332); b += (n >= 450); b += (n >= 609); b += (n >= 825); b += (n >= 1117); b += (n >= 1513);
    return b;
}

template <int MAP>
__device__ __forceinline__ void p0_transpose_item(const float* W, const float* W2, int K, int Nsrc, int Ndst, bf16* WT, const float* kscale, float* scr, int item, int lane) {
    const int nblk = Ndst / 32, kb = item / nblk, nb = item % nblk, k0 = 64 * kb, n0 = 32 * nb;
    const int n = n0 + (lane & 31);
    const float* src = W; int sc = n; bool ok = true;
    if (MAP == 1) { if (n < Z_QLAT) sc = n; else if (n < Z_NG) sc = n + 24; else if (n < Z_NG + 24) sc = n - Z_NG + 2560; else ok = false; }
    if (MAP == 2) { const int g32 = n >> 5, w = n & 31; src = (w < 16) ? W : W2; sc = g32 * 16 + (w & 15); }
#pragma unroll 8
    for (int i = 0; i < 32; ++i) { const int kk = 2 * i + (lane >> 5); float v = ok ? src[(size_t)(k0 + kk) * Nsrc + sc] : 0.f; if (kscale) v *= kscale[k0 + kk]; scr[kk * 33 + (lane & 31)] = v; }
    LDS_WAIT(); asm volatile("" ::: "memory");
    const int c = lane & 7;
#pragma unroll
    for (int j = 0; j < 4; ++j) { const int nn = (lane >> 3) + 8 * j; const float* s = scr + (8 * c) * 33 + nn;
        v4u o; o.x = pk2(s[0 * 33], s[1 * 33]); o.y = pk2(s[2 * 33], s[3 * 33]); o.z = pk2(s[4 * 33], s[5 * 33]); o.w = pk2(s[6 * 33], s[7 * 33]);
        *(v4u*)(WT + (size_t)(n0 + nn) * K + k0 + 8 * c) = o; }
    LDS_WAIT(); asm volatile("" ::: "memory");
}
template <int MAP>
__device__ __forceinline__ void p0_transpose(Frame& F, const float* W, const float* W2, int K, int Nsrc, int Ndst, bf16* WT, const float* kscale) {
    float* scr = (float*)(F.lds + F.wave * 16384);
    const int nitems = (K / 64) * (Ndst / 32);
    for (int it = F.gw; it < nitems; it += F.NGW) p0_transpose_item<MAP>(W, W2, K, Nsrc, Ndst, WT, kscale, scr, it, F.lane);
}

__device__ __forceinline__ void modnorm_row(const float* xrow, const float* g, const float* sc, const float* sh, bf16* orow, int lane, f32x4 (&v)[8]) {
    const f32x4* xr = (const f32x4*)xrow + lane; float s = 0.f;
#pragma unroll
    for (int j = 0; j < 8; ++j) { v[j] = xr[64 * j]; s += (v[j].x * v[j].x + v[j].y * v[j].y) + (v[j].z * v[j].z + v[j].w * v[j].w); }
    const float rinv = 1.0f / sqrtf(wave_sum(s) * (1.f / D) + RMS_EPS);
    unsigned long long* o8 = (unsigned long long*)orow + lane;
#pragma unroll
    for (int j = 0; j < 8; ++j) { const f32x4 gg = ((const f32x4*)g)[lane + 64 * j], cc = ((const f32x4*)sc)[lane + 64 * j], hh = ((const f32x4*)sh)[lane + 64 * j];
        v[j] = (v[j] * rinv) * gg * (cc + 1.0f) + hh;
        o8[64 * j] = (unsigned long long)pk2(v[j].x, v[j].y) | ((unsigned long long)pk2(v[j].z, v[j].w) << 32); }
}
__device__ __forceinline__ void modnorm_phase(Frame& F, const float* x, const float* g, const float* mod  , int sh_idx, bf16* H) {
    for (int m = F.gw; m < M; m += F.NGW) { const int b = m / S; const float* mb = mod + (size_t)b * 6 * D; f32x4 v[8];
        modnorm_row(x + (size_t)m * D, g, mb + (size_t)(sh_idx + 1) * D, mb + (size_t)sh_idx * D, H + (size_t)m * D, F.lane, v); }
}

struct NA { const bf16* k; long kstride; const bf16* k2; long k2stride; int dq, dq2; const bf16* v; long vstride; int t0, tstep, nk; const float* bias; int brel0, bstep; float scale; unsigned long long cmask; int use_sel; };
__device__ __forceinline__ void na_run(const NA& a, const float* qs, float* sc, int lane, float& mx, float& sum, float& o0, float& o1) {
    float lmax = -3.0e38f;
    for (int c = 0; c * 64 < a.nk; ++c) {
        const int kk = c * 64 + lane; float s = -__builtin_inff();
        const bool chunk_ok = !a.use_sel || ((a.cmask >> ((a.t0 + c * 64 * a.tstep) >> 6)) & 1ull);
        if (chunk_ok && kk < a.nk) {
            const long t = a.t0 + (long)kk * a.tstep; const bf16* kr = a.k + t * a.kstride; float acc = 0.f;
            for (int d = 0; d < a.dq; d += 8) { const v4u w = *(const v4u*)(kr + d); const float* q = qs + d;
                acc += bflo(w.x) * q[0] + bfhi(w.x) * q[1] + bflo(w.y) * q[2] + bfhi(w.y) * q[3] + bflo(w.z) * q[4] + bfhi(w.z) * q[5] + bflo(w.w) * q[6] + bfhi(w.w) * q[7]; }
            if (a.dq2) { const bf16* k2r = a.k2 + t * a.k2stride;
                for (int d = 0; d < a.dq2; d += 8) { const v4u w = *(const v4u*)(k2r + d); const float* q = qs + a.dq + d;
                    acc += bflo(w.x) * q[0] + bfhi(w.x) * q[1] + bflo(w.y) * q[2] + bfhi(w.y) * q[3] + bflo(w.z) * q[4] + bfhi(w.z) * q[5] + bflo(w.w) * q[6] + bfhi(w.w) * q[7]; } }
            s = acc * a.scale; if (a.bias) s += a.bias[a.brel0 - kk * a.bstep];
        }
        if (kk < a.nk) sc[kk] = s;
        lmax = fmaxf(lmax, s);
    }
    mx = wave_max(lmax);
    float ls = 0.f;
    for (int kk = lane; kk < a.nk; kk += 64) { const float p = __expf(sc[kk] - mx); sc[kk] = p; ls += p; }
    sum = wave_sum(ls);
    LDS_WAIT(); asm volatile("" ::: "memory");
    float a0 = 0.f, a1 = 0.f;
    for (int kk = 0; kk < a.nk; ++kk) { const float p = sc[kk]; if (p != 0.f) { const unsigned w = *(const unsigned*)(a.v + (long)(a.t0 + (long)kk * a.tstep) * a.vstride + 2 * lane); a0 += p * bflo(w); a1 += p * bfhi(w); } }
    o0 = a0; o1 = a1;
    asm volatile("" ::: "memory");
}
__device__ __forceinline__ float gelu_tanh(float x) { const float u = 0.7978845608028654f * (x + 0.044715f * x * x * x); return 0.5f * x * (1.0f + tanhf(u)); }
__device__ __forceinline__ float sigmoid_f(float x) { return 1.0f / (1.0f + __expf(-x)); }

__global__ void __launch_bounds__(NWAVES * 64, 2) fwd(Args args) {
    extern __shared__ __attribute__((aligned(16))) unsigned char lds[];
    Frame F;
    F.lds = lds; F.ws = args.ws;
    F.tid = threadIdx.x; F.lane = F.tid & 63; F.wave = __builtin_amdgcn_readfirstlane(F.tid >> 6);
    F.G = gridDim.x; { const int bx = blockIdx.x; F.vcu = (F.G % 8 == 0) ? (bx % 8) * (F.G / 8) + bx / 8 : bx; }
    F.gw = F.vcu * NWAVES + F.wave; F.NGW = F.G * NWAVES;
    unsigned char* ws = args.ws;
    unsigned* ctl = (unsigned*)(ws + WS_CTL);
    volatile LAS unsigned* MISC = (volatile LAS unsigned*)((LAS unsigned char*)lds + MISC_OFF);
    for (int u = F.tid; u < 64; u += NWAVES * 64) MISC[u] = 0u;
    __syncthreads();
    XcdBarrier bar; bar.bar = ctl + CW_BAR; bar.x = 0; bar.st = nullptr;
    if (MK_N_LAUNCHES == 1) bar = xcd_barrier_post(ctl + CW_BAR, MISC + 8);
    const int lo = args.ph_lo, hi = args.ph_hi;
#define IN(k) (lo <= (k) && (k) < hi)
#ifndef PROBE_MASK
#define PROBE_MASK 0
#endif
#define REPK(k)
#define SEAM(k) do { if (IN(k) && IN((k) + 1)) xcd_barrier(bar); } while (0)

    const float* x_in = (const float*)args.in[0]; const float* c_in = (const float*)args.in[1]; const int* positions = (const int*)args.in[2];
    const float* rel_bias = (const float*)args.in[3]; const float* ada_w = (const float*)args.in[4]; const float* ada_b = (const float*)args.in[5];
    const float* mix_norm_g = (const float*)args.in[6]; const float* ffn_norm_g = (const float*)args.in[7];
    const float* ab_w_in = (const float*)args.in[8]; const float* ab_w_out = (const float*)args.in[9];
    const float* cmp_pos_k = (const float*)args.in[10]; const float* cmp_w1_k = (const float*)args.in[11]; const float* cmp_w2_k = (const float*)args.in[12];
    const float* cmp_pos_v = (const float*)args.in[13]; const float* cmp_w1_v = (const float*)args.in[14]; const float* cmp_w2_v = (const float*)args.in[15];
    const float* q_norm_g = (const float*)args.in[16]; const float* kv_norm_g = (const float*)args.in[17]; const float* w_uq = (const float*)args.in[18]; const float* w_ukv = (const float*)args.in[19];
    const float* ffn_wg = (const float*)args.in[20]; const float* ffn_wu = (const float*)args.in[21]; const float* ffn_wd = (const float*)args.in[22];
    const float* c_w_in = (const float*)args.in[23]; const float* c_w_out = (const float*)args.in[24]; const float* w_router = (const float*)args.in[25];
    const float* moe_wg = (const float*)args.in[26]; const float* moe_wu = (const float*)args.in[27]; const float* moe_wd = (const float*)args.in[28]; const float* final_g = (const float*)args.in[29];
    float* MOD = (float*)(ws + WS_MOD); float* BIAS = (float*)(ws + WS_BIAS); float* ROPE = (float*)(ws + WS_ROPE); float* RINV = (float*)(ws + WS_RINV);
    unsigned long long* SEL = (unsigned long long*)(ws + WS_SEL); bf16* KC = (bf16*)(ws + WS_KC); bf16* VC = (bf16*)(ws + WS_VC); int* ROUTE = (int*)(ws + WS_ROUTE); bf16* KPE = (bf16*)(ws + WS_KPE);
    bf16* W_IN0 = (bf16*)(ws + WS_WIN0); bf16* W_UQ = (bf16*)(ws + WS_WUQ); bf16* W_UKV = (bf16*)(ws + WS_WUKV); bf16* W_OUT0 = (bf16*)(ws + WS_WOUT0); bf16* W_GU0 = (bf16*)(ws + WS_WGU0); bf16* W_DN0 = (bf16*)(ws + WS_WDN0);
    bf16* W_IN1 = (bf16*)(ws + WS_WIN1); bf16* W_OUT1 = (bf16*)(ws + WS_WOUT1); bf16* W_MGU = (bf16*)(ws + WS_WMGU); bf16* W_MDN = (bf16*)(ws + WS_WMDN);
    float* X = (float*)(ws + WS_X); bf16* H = (bf16*)(ws + WS_H);
    bf16* Z0 = (bf16*)(ws + WS_Z0); bf16* QM = (bf16*)(ws + WS_QM); bf16* KVM = (bf16*)(ws + WS_KVM); bf16* OCMP = (bf16*)(ws + WS_OCMP); bf16* OWIN = (bf16*)(ws + WS_OWIN); bf16* CAT = (bf16*)(ws + WS_CAT);
    bf16* W1T = (bf16*)(ws + WS_W1T); bf16* W2T = (bf16*)(ws + WS_W2T); float* CB1 = (float*)(ws + WS_CB1);
    float* LSEB = (float*)(ws + WS_LSE); bf16* OP = (bf16*)(ws + WS_OP);
    bf16* ACT = (bf16*)(ws + WS_ACT); bf16* Z1 = (bf16*)(ws + WS_Z1); bf16* OM = (bf16*)(ws + WS_OM); bf16* XB = (bf16*)(ws + WS_XB); bf16* ACTB = (bf16*)(ws + WS_ACTB); bf16* YB = (bf16*)(ws + WS_YB);
    float* wsc = (float*)(lds + F.wave * 16384);
    float* wsm = (float*)(lds + SMALL_OFF + F.wave * 2048);
    PG8_LAS unsigned char* ring = (PG8_LAS unsigned char*)lds;

    REPK(0) if (IN(0)) {
        p0_transpose<1>(F, ab_w_in, nullptr, D, 3672, Z0W, W_IN0, nullptr);
        p0_transpose<0>(F, w_uq, nullptr, 512, QMW, QMW, W_UQ, q_norm_g);
        p0_transpose<0>(F, w_ukv, nullptr, 512, KVMW, KVMW, W_UKV, kv_norm_g);
        p0_transpose<0>(F, ab_w_out, nullptr, D, D, D, W_OUT0, nullptr);
        p0_transpose<2>(F, ffn_wg, ffn_wu, D, FF, 2 * FF, W_GU0, nullptr);
        p0_transpose<0>(F, ffn_wd, nullptr, FF, D, D, W_DN0, nullptr);
        p0_transpose<0>(F, c_w_in, nullptr, D, Z1W, Z1W, W_IN1, nullptr);
        p0_transpose<0>(F, c_w_out, nullptr, 1024, D, D, W_OUT1, nullptr);
        p0_transpose<0>(F, cmp_w1_k, nullptr, 4096, 128, 128, W1T, nullptr); p0_transpose<0>(F, cmp_w1_v, nullptr, 4096, 128, 128, W1T + 128 * 4096, nullptr);
        p0_transpose<0>(F, cmp_w2_k, nullptr, 128, 128, 128, W2T, nullptr); p0_transpose<0>(F, cmp_w2_v, nullptr, 128, 128, 128, W2T + 128 * 128, nullptr);
        for (int e = 0; e < NE; ++e) {
            p0_transpose<2>(F, moe_wg + (size_t)e * D * FFE, moe_wu + (size_t)e * D * FFE, D, FFE, 2 * FFE, W_MGU + (size_t)e * 2 * FFE * D, nullptr);
            p0_transpose<0>(F, moe_wd + (size_t)e * FFE * D, nullptr, FFE, D, D, W_MDN + (size_t)e * D * FFE, nullptr);
        }
        for (int i = F.gw * 64 + F.lane; i < 8 * BIAS_LD; i += F.NGW * 64) { const int h = i / BIAS_LD, r = i % BIAS_LD - 64; BIAS[i] = rel_bias[t5_bucket(r) * 8 + h]; }
        for (int i = F.gw * 64 + F.lane; i < M * 32; i += F.NGW * 64) { const int m = i >> 5, f = i & 31;
            const float inv_freq = powf(10000.0f, -(float)(2 * f) / 64.0f); const float ang = (float)positions[m] * inv_freq;
            ROPE[(size_t)m * 64 + f] = cosf(ang); ROPE[(size_t)m * 64 + 32 + f] = sinf(ang); }
        __syncthreads();
        for (int job = 192 + (int)blockIdx.x; job < 194; job += F.G) {
            float* red = (float*)(lds + 32768); const int c = job - 192; const float* pos = c ? cmp_pos_v : cmp_pos_k; const float* w1 = c ? cmp_w1_v : cmp_w1_k;
            float a0 = 0.f, a1 = 0.f;
#pragma unroll 8
            for (int k = 0; k < 512; ++k) { const int kk = F.wave * 512 + k; const f32x2 wv = *(const f32x2*)(w1 + (size_t)kk * 128 + 2 * F.lane); const float pv = pos[kk]; a0 += pv * wv.x; a1 += pv * wv.y; }
            red[F.wave * 128 + 2 * F.lane] = a0; red[F.wave * 128 + 2 * F.lane + 1] = a1;
            __syncthreads();
            if (F.tid < 128) { float s = 0.f;
#pragma unroll
                for (int w = 0; w < 8; ++w) s += red[w * 128 + F.tid];
                CB1[c * 128 + F.tid] = s; }
            __syncthreads();
        }
        for (int job = blockIdx.x; job < 192; job += F.G) {
            float* cs = (float*)lds; float* red = (float*)(lds + 32768);
            for (int i = F.tid; i < 4 * D; i += 512) { const float cv = c_in[i]; cs[i] = cv / (1.0f + __expf(-cv)); }
            __syncthreads();
            const int l = job / 96, col0 = (job % 96) * 128;
            float acc[4][2] = {};
            const float* wp = ada_w + ((size_t)l * D + (size_t)F.wave * 256) * 12288 + col0 + 2 * F.lane;
#pragma unroll 8
            for (int k = 0; k < 256; ++k) { const f32x2 wv = *(const f32x2*)(wp + (size_t)k * 12288); const int kk = F.wave * 256 + k;
#pragma unroll
                for (int b = 0; b < 4; ++b) { const float cv = cs[b * D + kk]; acc[b][0] += cv * wv.x; acc[b][1] += cv * wv.y; } }
#pragma unroll
            for (int b = 0; b < 4; ++b) { red[(F.wave * 4 + b) * 128 + 2 * F.lane] = acc[b][0]; red[(F.wave * 4 + b) * 128 + 2 * F.lane + 1] = acc[b][1]; }
            __syncthreads();
            { const int b = F.tid >> 7, cc = F.tid & 127; float s = 0.f;
#pragma unroll
              for (int w = 0; w < 8; ++w) s += red[(w * 4 + b) * 128 + cc];
              MOD[((size_t)l * 4 + b) * 12288 + col0 + cc] = s + ada_b[(size_t)l * 12288 + col0 + cc]; }
            __syncthreads();
        }
    }
    SEAM(0);
    REPK(1) if (IN(1)) modnorm_phase(F, x_in, mix_norm_g, MOD, 0, H);
    SEAM(1);
    REPK(2) if (IN(2)) { pg8::Gemm g{H, W_IN0, D, D, D}; pg8::StaticOrder So; So.init(M, Z0W, F.G, (int)blockIdx.x); pg8::EpiBf16 E{Z0, Z0W, nullptr};
        pg8::gemm_phase<pg8::EpiBf16, pg8::StaticOrder, true, true>(ring, g, So, E); }
    SEAM(2);
    REPK(3) if (IN(3)) {
        for (int m = F.gw; m < M; m += F.NGW) {
            const bf16* zr = Z0 + (size_t)m * Z0W;
#pragma unroll
            for (int w = 0; w < 2; ++w) { const v4u a = *(const v4u*)(zr + (w ? Z_KVLAT : Z_QLAT) + 8 * F.lane);
                float s = bflo(a.x) * bflo(a.x) + bfhi(a.x) * bfhi(a.x) + bflo(a.y) * bflo(a.y) + bfhi(a.y) * bfhi(a.y) + bflo(a.z) * bflo(a.z) + bfhi(a.z) * bfhi(a.z) + bflo(a.w) * bflo(a.w) + bfhi(a.w) * bfhi(a.w);
                s = wave_sum(s); if (F.lane == 0) RINV[(size_t)w * M + m] = 1.0f / sqrtf(s * (1.f / 512.f) + RMS_EPS); }
            if (F.lane < 32) { const float x1 = bf2f(zr[Z_KPE + F.lane]), x2 = bf2f(zr[Z_KPE + 32 + F.lane]); const float cs = ROPE[(size_t)m * 64 + F.lane], sn = ROPE[(size_t)m * 64 + 32 + F.lane];
                KPE[(size_t)m * 64 + F.lane] = (bf16)f2bf(x1 * cs - x2 * sn); KPE[(size_t)m * 64 + 32 + F.lane] = (bf16)f2bf(x2 * cs + x1 * sn); }
        }
        __syncthreads();
        for (int job = blockIdx.x; job < 256; job += F.G) {
            typedef short bfx8 __attribute__((ext_vector_type(8)));
            const int nt = job & 15, g = (job >> 4) & 1, b = (job >> 5) & 3, c = job >> 7, n0 = nt * 16;
            const int fr = F.lane & 15, fq = F.lane >> 4; int nrow = n0 + fr; if (nrow > 254) nrow = 254;
            const bf16* arow = Z0 + ((size_t)b * S + 16 * nrow) * Z0W + Z_NKV + c * 256 + g * 128 + fq * 8;
            const bf16* w1t = W1T + (size_t)c * 128 * 4096 + (size_t)fr * 4096 + fq * 8;
            f32x4 acc[8];
#pragma unroll
            for (int i = 0; i < 8; ++i) acc[i] = (f32x4){0.f, 0.f, 0.f, 0.f};
#pragma unroll 2
            for (int ks = 0; ks < 16; ++ks) { const int kk = F.wave * 512 + ks * 32, l = kk >> 7, d0 = kk & 127;
                const bfx8 af = *(const bfx8*)(arow + (size_t)l * Z0W + d0);
#pragma unroll
                for (int i = 0; i < 8; ++i) { const bfx8 bfr = *(const bfx8*)(w1t + (size_t)i * 16 * 4096 + kk); acc[i] = __builtin_amdgcn_mfma_f32_16x16x32_bf16(af, bfr, acc[i], 0, 0, 0); } }
            float* part = (float*)lds;
#pragma unroll
            for (int i = 0; i < 8; ++i)
#pragma unroll
                for (int j = 0; j < 4; ++j) part[(F.wave * 16 + fq * 4 + j) * 128 + i * 16 + fr] = acc[i][j];
            __syncthreads();
            bf16* hid = (bf16*)(lds + 65536);
            { const int row = F.tid >> 5, c4 = (F.tid & 31) * 4; f32x4 s = *(const f32x4*)(CB1 + c * 128 + c4);
#pragma unroll
              for (int w = 0; w < 8; ++w) s += *(const f32x4*)(part + (w * 16 + row) * 128 + c4);
              *(v2u*)(hid + row * 128 + c4) = (v2u){pk2(gelu_tanh(s.x), gelu_tanh(s.y)), pk2(gelu_tanh(s.z), gelu_tanh(s.w))}; }
            __syncthreads();
            { f32x4 o4 = {0.f, 0.f, 0.f, 0.f}; const bf16* w2t = W2T + (size_t)c * 128 * 128 + (size_t)(F.wave * 16 + fr) * 128 + fq * 8;
#pragma unroll
              for (int ks = 0; ks < 4; ++ks) { const bfx8 af = *(const bfx8*)(hid + fr * 128 + ks * 32 + fq * 8); const bfx8 bfr = *(const bfx8*)(w2t + ks * 32); o4 = __builtin_amdgcn_mfma_f32_16x16x32_bf16(af, bfr, o4, 0, 0, 0); }
              bf16* outp = (c ? VC : KC) + (((size_t)b * 2 + g) * 256) * 128 + F.wave * 16 + fr;
#pragma unroll
              for (int j = 0; j < 4; ++j) { const int n = n0 + fq * 4 + j; if (n < 255) outp[(size_t)n * 128] = (bf16)f2bf(o4[j]); } }
            __syncthreads();
        }
#if FLASH_WIN
        __syncthreads();
        for (int Lx = blockIdx.x; Lx < 512; Lx += F.G) {
            const int qb = 15 - Lx / 32, bh = Lx % 32, b = bh >> 3, h = bh & 7, g = h >> 2; const bf16* zb = Z0 + (size_t)b * S * Z0W;
            fa::Item it{}; it.Q = zb + Z_NQ + h * 128; it.qs = Z0W; it.K = zb + Z_NKV + 4 * 256 + g * 128; it.ks = Z0W; it.V = zb + Z_NKV + 5 * 256 + g * 128; it.vs = Z0W;
            it.P0 = qb * 256; it.skv = S; it.W = 512; it.bias = BIAS + (size_t)h * BIAS_LD + 64; it.bstep = 1; it.O = OWIN + (size_t)b * S * 1024 + h * 128; it.os = 1024;
            fa::attn_block<0>(it, lds);
        }
#else
        __syncthreads();
        for (int it = F.gw; it < M * 8; it += F.NGW) {
            const int h = it & 7, m = it >> 3, b = m / S, s = m % S, g = h >> 2;
            const bf16* qr = Z0 + (size_t)m * Z0W + Z_NQ + h * 128; wsm[2 * F.lane] = bf2f(qr[2 * F.lane]); wsm[2 * F.lane + 1] = bf2f(qr[2 * F.lane + 1]); LDS_WAIT(); asm volatile("" ::: "memory");
            const int t0 = s - 511 < 0 ? 0 : s - 511; NA a;
            a.k = Z0 + (size_t)b * S * Z0W + Z_NKV + 4 * 256 + g * 128; a.kstride = Z0W; a.k2 = nullptr; a.k2stride = 0; a.dq = 128; a.dq2 = 0;
            a.v = Z0 + (size_t)b * S * Z0W + Z_NKV + 5 * 256 + g * 128; a.vstride = Z0W; a.t0 = t0; a.tstep = 1; a.nk = s - t0 + 1;
            a.bias = BIAS + (size_t)h * BIAS_LD + 64; a.brel0 = s - t0; a.bstep = 1; a.scale = 0.08838834764831845f; a.cmask = 0; a.use_sel = 0;
            float mx, sum, o0, o1; na_run(a, wsm, wsc, F.lane, mx, sum, o0, o1);
            *(unsigned*)(OWIN + (size_t)m * 1024 + h * 128 + 2 * F.lane) = pk2(o0 / sum, o1 / sum);
        }
#endif
    }
    SEAM(3);
    REPK(4) if (IN(4)) {
        { pg8::Gemm g{Z0 + Z_QLAT, W_UQ, Z0W, 512, 512}; pg8::StaticOrder So; So.init(M, QMW, F.G, (int)blockIdx.x); pg8::EpiBf16 E{QM, QMW, RINV};
          pg8::gemm_phase<pg8::EpiBf16, pg8::StaticOrder, true, true>(ring, g, So, E); }
        __syncthreads();
        { pg8::Gemm g{Z0 + Z_KVLAT, W_UKV, Z0W, 512, 512}; pg8::StaticOrder So; So.init(M, KVMW, F.G, (int)blockIdx.x); pg8::EpiBf16 E{KVM, KVMW, RINV + M};
          pg8::gemm_phase<pg8::EpiBf16, pg8::StaticOrder, true, true>(ring, g, So, E); }
        __syncthreads();
        for (int it = F.gw; it < M * 2; it += F.NGW) {
            const int g = it & 1, m = it >> 1, b = m / S, s = m % S;
            const int nk = s >= 31 ? (s - 31) / 16 + 1 : 0;
            float* imp = wsm + 256;
            for (int i = F.lane; i < 256; i += 64) imp[i] = 0.f;
            for (int r = 0; r < 4; ++r) { const int h = g * 4 + r;
                const bf16* qr = Z0 + (size_t)m * Z0W + Z_NQ + h * 128; wsm[2 * F.lane] = bf2f(qr[2 * F.lane]); wsm[2 * F.lane + 1] = bf2f(qr[2 * F.lane + 1]); LDS_WAIT(); asm volatile("" ::: "memory");
                float o0 = 0.f, o1 = 0.f;
                if (nk > 0) { NA a; a.k = KC + ((size_t)b * 2 + g) * 256 * 128; a.kstride = 128; a.k2 = nullptr; a.k2stride = 0; a.dq = 128; a.dq2 = 0; a.v = VC + ((size_t)b * 2 + g) * 256 * 128; a.vstride = 128;
                    a.t0 = 0; a.tstep = 1; a.nk = nk; a.bias = BIAS + (size_t)h * BIAS_LD + 64; a.brel0 = s - 31; a.bstep = 16; a.scale = 0.08838834764831845f; a.cmask = 0; a.use_sel = 0;
                    float mx, sum; na_run(a, wsm, wsc, F.lane, mx, sum, o0, o1); const float inv = 1.0f / sum; o0 *= inv; o1 *= inv;
                    for (int i = F.lane; i < nk; i += 64) imp[i] += wsc[i] * inv; LDS_WAIT(); asm volatile("" ::: "memory"); }
                *(unsigned*)(OCMP + (size_t)m * 1024 + h * 128 + 2 * F.lane) = pk2(o0, o1);
            }
            const int j = F.lane, blk_t = s >> 6;
            float sc;
            { const float pm1 = (4 * j - 1 >= 0) ? imp[4 * j - 1] : 0.f, p0 = imp[4 * j], p1 = imp[4 * j + 1], p2 = imp[4 * j + 2], p3 = (4 * j + 3 < 255) ? imp[4 * j + 3] : 0.f;
              const float is = ((((((p0 + pm1) + p1) + p0) + p2) + p1) + p3) + p2;
              const bool forced = (j == 0) || (j == blk_t) || (j == blk_t - 1), valid = j <= blk_t;
              sc = forced ? 1e9f : (valid ? is : -1.0f); }
            int rank = 0;
            for (int k = 0; k < 64; ++k) { const float vk = __shfl(sc, k); rank += (vk > sc || (vk == sc && k < j)) ? 1 : 0; }
            const unsigned long long msk = __ballot(rank < 16 && sc > -0.5f);
            if (F.lane == 0) SEL[(size_t)m * 2 + g] = msk;
            asm volatile("" ::: "memory");
        }
    }
    SEAM(4);
    REPK(5) if (IN(5)) {
#if FLASH_SLC != 1
        for (int it = F.gw; it < M * 8; it += F.NGW) {
            const int h = it & 7, m = it >> 3, b = m / S, s = m % S, g = h >> 2;
            const bf16* zr = Z0 + (size_t)m * Z0W; const bf16* qr = zr + Z_NQ + h * 128; wsm[2 * F.lane] = bf2f(qr[2 * F.lane]); wsm[2 * F.lane + 1] = bf2f(qr[2 * F.lane + 1]); LDS_WAIT(); asm volatile("" ::: "memory");
            NA a; a.k = Z0 + (size_t)b * S * Z0W + Z_NKV + 2 * 256 + g * 128; a.kstride = Z0W; a.k2 = nullptr; a.k2stride = 0; a.dq = 128; a.dq2 = 0;
            a.v = Z0 + (size_t)b * S * Z0W + Z_NKV + 3 * 256 + g * 128; a.vstride = Z0W; a.t0 = 0; a.tstep = 1; a.nk = s + 1;
            a.bias = BIAS + (size_t)h * BIAS_LD + 64; a.brel0 = s; a.bstep = 1; a.scale = 0.08838834764831845f; a.cmask = SEL[(size_t)m * 2 + g]; a.use_sel = FA_DBG_NOSEL ? 0 : 1;
            float mx, sum, o0, o1; na_run(a, wsm, wsc, F.lane, mx, sum, o0, o1); o0 /= sum; o1 /= sum;
            const float g0 = sigmoid_f(bf2f(zr[Z_NG + h * 3 + 0])), g1 = sigmoid_f(bf2f(zr[Z_NG + h * 3 + 1])), g2 = sigmoid_f(bf2f(zr[Z_NG + h * 3 + 2]));
            const unsigned wc_ = *(const unsigned*)(OCMP + (size_t)m * 1024 + h * 128 + 2 * F.lane), ww_ = *(const unsigned*)(OWIN + (size_t)m * 1024 + h * 128 + 2 * F.lane);
            *(unsigned*)(CAT + (size_t)m * 2048 + h * 128 + 2 * F.lane) = FA_DBG_NOMERGE ? pk2(o0, o1) : pk2(g0 * bflo(wc_) + g1 * o0 + g2 * bflo(ww_), g0 * bfhi(wc_) + g1 * o1 + g2 * bfhi(ww_));
        }
        __syncthreads();
#endif
#if FLASH_SLC == 2
        __syncthreads();
#endif
#if FLASH_SLC
        for (int Lx = blockIdx.x; Lx < 256; Lx += F.G) {
            const int x = Lx / 32, bh = Lx % 32, b = bh >> 3, h = bh & 7, g = h >> 2; const bf16* zb = Z0 + (size_t)b * S * Z0W;
            for (int pass = 0; pass < 2; ++pass) { const int qb = pass ? 15 - x : x;
                fa::Item it{}; it.Q = zb + Z_NQ + h * 128; it.qs = Z0W; it.K = zb + Z_NKV + 2 * 256 + g * 128; it.ks = Z0W; it.V = zb + Z_NKV + 3 * 256 + g * 128; it.vs = Z0W;
                it.P0 = qb * 256; it.skv = S; it.W = 1 << 20; it.bias = BIAS + (size_t)h * BIAS_LD + 64; it.bstep = 1; it.sel = SEL + (size_t)b * S * 2 + g; it.sels = 2;
                it.O = CAT + (size_t)b * S * 2048 + h * 128; it.os = 2048;
#if FLASH_SLC == 2
                it.O = (bf16*)(ws + WS_R + 296 * MiB) + (size_t)b * S * 1024 + h * 128; it.os = 1024;
#endif
                it.M0 = OCMP + (size_t)b * S * 1024 + h * 128; it.M1 = OWIN + (size_t)b * S * 1024 + h * 128; it.ms = 1024; it.G = zb + Z_NG + h * 3; it.gs = Z0W;
                fa::attn_block<1>(it, lds); }
        }
#endif
#if FLASH_MLA
        for (int Lx = blockIdx.x; Lx < 256; Lx += F.G) {
            const int x = Lx / 32, bh = Lx % 32, b = bh >> 3, h = bh & 7;
            for (int pass = 0; pass < 2; ++pass) { const int qb = pass ? 15 - x : x;
                fa::Item it{}; it.Q = QM + (size_t)b * S * QMW + h * 192; it.qs = QMW; it.rope = ROPE + (size_t)b * S * 64; it.ropes = 64;
                it.K = KVM + (size_t)b * S * KVMW + h * 256; it.ks = KVMW; it.K2 = KPE + (size_t)b * S * 64; it.k2s = 64; it.V = KVM + (size_t)b * S * KVMW + h * 256 + 128; it.vs = KVMW;
                it.P0 = qb * 256; it.skv = S; it.W = 1 << 20; it.O = CAT + (size_t)b * S * 2048 + 1024 + h * 128; it.os = 2048;
                fa::attn_block<2>(it, lds); }
        }
#else
        for (int it = F.gw; it < M * 8; it += F.NGW) {
            const int h = it & 7, m = it >> 3, b = m / S, s = m % S;
            const bf16* qr = QM + (size_t)m * QMW + h * 192;
            wsm[2 * F.lane] = bf2f(qr[2 * F.lane]); wsm[2 * F.lane + 1] = bf2f(qr[2 * F.lane + 1]);
            if (F.lane < 32) { const float x1 = bf2f(qr[128 + F.lane]), x2 = bf2f(qr[160 + F.lane]); const float cs = ROPE[(size_t)m * 64 + F.lane], sn = ROPE[(size_t)m * 64 + 32 + F.lane];
                wsm[128 + F.lane] = x1 * cs - x2 * sn; wsm[160 + F.lane] = x2 * cs + x1 * sn; }
            LDS_WAIT(); asm volatile("" ::: "memory");
            NA a; a.k = KVM + (size_t)b * S * KVMW + h * 256; a.kstride = KVMW; a.k2 = KPE + (size_t)b * S * 64; a.k2stride = 64; a.dq = 128; a.dq2 = 64;
            a.v = KVM + (size_t)b * S * KVMW + h * 256 + 128; a.vstride = KVMW; a.t0 = 0; a.tstep = 1; a.nk = s + 1; a.bias = nullptr; a.brel0 = 0; a.bstep = 0; a.scale = 0.07216878364870322f; a.cmask = 0; a.use_sel = 0;
            float mx, sum, o0, o1; na_run(a, wsm, wsc, F.lane, mx, sum, o0, o1);
            *(unsigned*)(CAT + (size_t)m * 2048 + 1024 + h * 128 + 2 * F.lane) = pk2(o0 / sum, o1 / sum);
        }
#endif
    }
    SEAM(5);
    REPK(6) if (IN(6)) { pg8::Gemm g{CAT, W_OUT0, 2048, 2048, 2048}; pg8::StaticOrder So; So.init(M, D, F.G, (int)blockIdx.x); pg8::EpiResid E{x_in, X, D, MOD + 2 * D, 6 * D, S / 256};
        pg8::gemm_phase<pg8::EpiResid, pg8::StaticOrder, true, true>(ring, g, So, E); }
    SEAM(6);
    REPK(7) if (IN(7)) modnorm_phase(F, X, ffn_norm_g, MOD, 3, H);
    SEAM(7);
    REPK(8) if (IN(8)) { pg8::Gemm g{H, W_GU0, D, D, D}; pg8::StaticOrder So; So.init(M, 2 * FF, F.G, (int)blockIdx.x); pg8::EpiSwiGLU E{ACT, FF};
        pg8::gemm_phase<pg8::EpiSwiGLU, pg8::StaticOrder, true, true>(ring, g, So, E); }
    SEAM(8);
    REPK(9) if (IN(9)) { pg8::Gemm g{ACT, W_DN0, FF, FF, FF}; pg8::StaticOrder So; So.init(M, D, F.G, (int)blockIdx.x); pg8::EpiResid E{X, X, D, MOD + 5 * D, 6 * D, S / 256};
        pg8::gemm_phase<pg8::EpiResid, pg8::StaticOrder, true, true>(ring, g, So, E); }
    SEAM(9);
    REPK(10) if (IN(10)) modnorm_phase(F, X, mix_norm_g + D, MOD + 4 * 12288, 0, H);
    SEAM(10);
    REPK(11) if (IN(11)) { pg8::Gemm g{H, W_IN1, D, D, D}; pg8::StaticOrder So; So.init(M, Z1W, F.G, (int)blockIdx.x); pg8::EpiBf16 E{Z1, Z1W, nullptr};
        pg8::gemm_phase<pg8::EpiBf16, pg8::StaticOrder, true, true>(ring, g, So, E); }
    SEAM(11);
#if FLASH_DIL
    REPK(12) if (IN(12)) {
        for (int Lx = blockIdx.x; Lx < 1536; Lx += F.G) {
            const int p = Lx % 3, r_ = Lx / 3, bh = r_ % 32, sub = r_ / 32, b = bh >> 3, h = bh & 7;
            const int dil = p == 0 ? 1 : (p == 1 ? 4 : 16), res = p == 0 ? 0 : (p == 1 ? (sub & 3) : sub), qb = p == 0 ? sub : (p == 1 ? (sub >> 2) : 0);
            fa::Item it{}; it.Q = Z1 + ((size_t)b * S + res) * Z1W + p * 3072 + h * 128; it.qs = (long)dil * Z1W; it.K = it.Q + 1024; it.ks = it.qs; it.V = it.Q + 2048; it.vs = it.qs;
            it.P0 = qb * 256; it.skv = S / dil; it.W = 129; it.bias = BIAS + (size_t)h * BIAS_LD + 64; it.bstep = dil;
            it.O = OP + (size_t)p * M * 1024 + ((size_t)b * S + res) * 1024 + h * 128; it.os = (long)dil * 1024; it.LSE = LSEB + (size_t)p * M * 8 + ((size_t)b * S + res) * 8 + h; it.lses = (long)dil * 8;
            fa::attn_block<0>(it, lds);
        }
    }
#else
    REPK(12) if (IN(12)) {
        for (int it = F.gw; it < M * 8; it += F.NGW) {
            const int h = it & 7, m = it >> 3, b = m / S, s = m % S;
            float om0 = 0.f, om1 = 0.f, lm = -3.0e38f, wsum = 0.f;
#pragma unroll
            for (int p = 0; p < 3; ++p) { const int dil = p == 0 ? 1 : (p == 1 ? 4 : 16);
                const bf16* qr = Z1 + (size_t)m * Z1W + p * 3072 + h * 128; wsm[2 * F.lane] = bf2f(qr[2 * F.lane]); wsm[2 * F.lane + 1] = bf2f(qr[2 * F.lane + 1]); LDS_WAIT(); asm volatile("" ::: "memory");
                const int mq = s / dil, r = s % dil, m0 = mq - 128 < 0 ? 0 : mq - 128;
                NA a; a.k = Z1 + (size_t)b * S * Z1W + p * 3072 + 1024 + h * 128; a.kstride = Z1W; a.k2 = nullptr; a.k2stride = 0; a.dq = 128; a.dq2 = 0;
                a.v = Z1 + (size_t)b * S * Z1W + p * 3072 + 2048 + h * 128; a.vstride = Z1W; a.t0 = m0 * dil + r; a.tstep = dil; a.nk = mq - m0 + 1;
                a.bias = BIAS + (size_t)h * BIAS_LD + 64; a.brel0 = (mq - m0) * dil; a.bstep = dil; a.scale = 0.08838834764831845f; a.cmask = 0; a.use_sel = 0;
                float mx, sum, o0, o1; na_run(a, wsm, wsc, F.lane, mx, sum, o0, o1);
                const float lse = mx + __logf(sum); o0 /= sum; o1 /= sum;
                const float nm = fmaxf(lm, lse), ea = __expf(lm - nm), eb = __expf(lse - nm);
                om0 = om0 * ea + o0 * eb; om1 = om1 * ea + o1 * eb; wsum = wsum * ea + eb; lm = nm; }
            *(unsigned*)(OM + (size_t)m * 1024 + h * 128 + 2 * F.lane) = pk2(om0 / wsum, om1 / wsum);
        }
    }
#endif
    SEAM(12);
    REPK(13) if (IN(13) && FLASH_DIL) {
        for (int m = F.gw; m < M; m += F.NGW) {
#pragma unroll 2
            for (int h = 0; h < 8; ++h) { const float l0 = LSEB[(size_t)m * 8 + h], l1 = LSEB[(size_t)(M + m) * 8 + h], l2 = LSEB[(size_t)(2 * M + m) * 8 + h];
                const float mx = fmaxf(l0, fmaxf(l1, l2)), e0 = __expf(l0 - mx), e1 = __expf(l1 - mx), e2 = __expf(l2 - mx), inv = 1.0f / (e0 + e1 + e2);
                const unsigned a0 = *(const unsigned*)(OP + (size_t)m * 1024 + h * 128 + 2 * F.lane), a1 = *(const unsigned*)(OP + (size_t)(M + m) * 1024 + h * 128 + 2 * F.lane), a2 = *(const unsigned*)(OP + (size_t)(2 * M + m) * 1024 + h * 128 + 2 * F.lane);
                *(unsigned*)(OM + (size_t)m * 1024 + h * 128 + 2 * F.lane) = pk2((e0 * bflo(a0) + e1 * bflo(a1) + e2 * bflo(a2)) * inv, (e0 * bfhi(a0) + e1 * bfhi(a1) + e2 * bfhi(a2)) * inv); }
        }
    }
    SEAM(13);
    REPK(14) if (IN(14)) { pg8::Gemm g{OM, W_OUT1, 1024, 1024, 1024}; pg8::StaticOrder So; So.init(M, D, F.G, (int)blockIdx.x); pg8::EpiResid E{X, X, D, MOD + 4 * 12288 + 2 * D, 6 * D, S / 256};
        pg8::gemm_phase<pg8::EpiResid, pg8::StaticOrder, true, true>(ring, g, So, E); }
    SEAM(14);
    REPK(15) if (IN(15)) {
        for (int m = F.gw; m < M; m += F.NGW) { const int b = m / S; const float* mb = MOD + 4 * 12288 + (size_t)b * 6 * D; f32x4 v[8];
            modnorm_row(X + (size_t)m * D, ffn_norm_g + D, mb + 4 * D, mb + 3 * D, H + (size_t)m * D, F.lane, v);
            float lg[8] = {};
#pragma unroll
            for (int j = 0; j < 8; ++j) { const float* wr_ = w_router + (size_t)(4 * F.lane + 256 * j) * 8;
#pragma unroll
                for (int q = 0; q < 4; ++q) { const f32x4 wa = *(const f32x4*)(wr_ + q * 8), wb = *(const f32x4*)(wr_ + q * 8 + 4); const float hv = v[j][q];
                    lg[0] += hv * wa.x; lg[1] += hv * wa.y; lg[2] += hv * wa.z; lg[3] += hv * wa.w; lg[4] += hv * wb.x; lg[5] += hv * wb.y; lg[6] += hv * wb.z; lg[7] += hv * wb.w; } }
#pragma unroll
            for (int e = 0; e < 8; ++e) lg[e] = wave_sum(lg[e]);
            int e1 = 0; float v1 = lg[0];
#pragma unroll
            for (int e = 1; e < 8; ++e) if (lg[e] > v1) { v1 = lg[e]; e1 = e; }
            int e2 = -1; float v2 = -3.0e38f;
#pragma unroll
            for (int e = 0; e < 8; ++e) if (e != e1 && lg[e] > v2) { v2 = lg[e]; e2 = e; }
            if (F.lane == 0) { const float g1 = 1.0f / (1.0f + __expf(v2 - v1)), g2 = 1.0f - g1;
                const unsigned r1 = atomicAdd(ctl + CW_CNT + e1, 1u), r2 = atomicAdd(ctl + CW_CNT + e2, 1u);
                int* rt = ROUTE + (size_t)m * 8; rt[0] = e1; rt[1] = e2; rt[2] = (int)r1; rt[3] = (int)r2; rt[4] = __float_as_int(g1); rt[5] = __float_as_int(g2); }
        }
    }
    SEAM(15);
    REPK(16) if (IN(16)) {
        unsigned ts[9]; ts[0] = 0;
#pragma unroll
        for (int e = 0; e < 8; ++e) ts[e + 1] = ts[e] + (__hip_atomic_load(ctl + CW_CNT + e, __ATOMIC_RELAXED, __HIP_MEMORY_SCOPE_AGENT) + 255u) / 256u;
        if (blockIdx.x == 0 && F.tid < 9) { unsigned v = ts[0];
#pragma unroll
            for (int e = 1; e < 9; ++e) v = (F.tid == e) ? ts[e] : v;
            ctl[CW_TS + F.tid] = v; }
        for (int m = F.gw; m < M; m += F.NGW) { const int* rt = ROUTE + (size_t)m * 8; const int e1 = rt[0], e2 = rt[1]; unsigned t1 = 0, t2 = 0;
#pragma unroll
            for (int e = 0; e < 8; ++e) { t1 = (e == e1) ? ts[e] : t1; t2 = (e == e2) ? ts[e] : t2; }
            const size_t d1 = (size_t)t1 * 256 + rt[2], d2 = (size_t)t2 * 256 + rt[3];
            const v4u* src = (const v4u*)(H + (size_t)m * D) + F.lane; v4u* o1 = (v4u*)(XB + d1 * D) + F.lane; v4u* o2 = (v4u*)(XB + d2 * D) + F.lane;
#pragma unroll
            for (int j = 0; j < 4; ++j) { const v4u w = src[64 * j]; o1[64 * j] = w; o2[64 * j] = w; } }
    }
    SEAM(16);
    REPK(17) if (IN(17)) { pg8::Gemm g{XB, W_MGU, D, D, D}; pg8::GroupedOrder So; So.init(ctl + CW_TS, 2 * FFE / 256, F.G, (int)blockIdx.x); pg8::EpiSwiGLU E{ACTB, FFE};
        pg8::gemm_phase<pg8::EpiSwiGLU, pg8::GroupedOrder, true, true>(ring, g, So, E); }
    SEAM(17);
    REPK(18) if (IN(18)) { pg8::Gemm g{ACTB, W_MDN, FFE, FFE, FFE}; pg8::GroupedOrder So; So.init(ctl + CW_TS, D / 256, F.G, (int)blockIdx.x); pg8::EpiBf16 E{YB, D, nullptr};
        pg8::gemm_phase<pg8::EpiBf16, pg8::GroupedOrder, true, true>(ring, g, So, E); }
    SEAM(18);
    REPK(19) if (IN(19)) {
        unsigned ts[9]; ts[0] = 0;
#pragma unroll
        for (int e = 0; e < 8; ++e) ts[e + 1] = ctl[CW_TS + e + 1];
        for (int m = F.gw; m < M; m += F.NGW) { const int b = m / S; const int* rt = ROUTE + (size_t)m * 8; const int e1 = rt[0], e2 = rt[1]; unsigned t1 = 0, t2 = 0;
#pragma unroll
            for (int e = 0; e < 8; ++e) { t1 = (e == e1) ? ts[e] : t1; t2 = (e == e2) ? ts[e] : t2; }
            const size_t d1 = (size_t)t1 * 256 + rt[2], d2 = (size_t)t2 * 256 + rt[3]; const float g1 = __int_as_float(rt[4]), g2 = __int_as_float(rt[5]);
            const float* gf = MOD + 4 * 12288 + (size_t)b * 6 * D + 5 * D;
            const f32x4* xr = (const f32x4*)(X + (size_t)m * D) + F.lane; const v2u* y1 = (const v2u*)(YB + d1 * D) + F.lane; const v2u* y2 = (const v2u*)(YB + d2 * D) + F.lane;
            f32x4 v[8]; float ss = 0.f;
#pragma unroll
            for (int j = 0; j < 8; ++j) { const v2u a = y1[64 * j], c2 = y2[64 * j]; const f32x4 gg = ((const f32x4*)gf)[F.lane + 64 * j];
                f32x4 y; y.x = g1 * bflo(a.x) + g2 * bflo(c2.x); y.y = g1 * bfhi(a.x) + g2 * bfhi(c2.x); y.z = g1 * bflo(a.y) + g2 * bflo(c2.y); y.w = g1 * bfhi(a.y) + g2 * bfhi(c2.y);
                v[j] = xr[64 * j] + gg * y; ss += (v[j].x * v[j].x + v[j].y * v[j].y) + (v[j].z * v[j].z + v[j].w * v[j].w); }
            const float rinv = 1.0f / sqrtf(wave_sum(ss) * (1.f / D) + RMS_EPS);
            f32x4* orow = (f32x4*)(args.out + (size_t)m * D) + F.lane;
#pragma unroll
            for (int j = 0; j < 8; ++j) orow[64 * j] = (v[j] * rinv) * ((const f32x4*)final_g)[F.lane + 64 * j]; }
    }
#undef IN
#undef SEAM
}

constexpr int N_PHASES = 20;
extern "C" void kernel_launch(void* const* d_in, const int* in_sizes, int n_in, void* d_out, int out_size, void* d_ws, size_t ws_size, hipStream_t stream) {
    static int grid = 0;
    if (grid == 0) {
        if (n_in != 30 || in_sizes[0] != M * D || out_size != M * D || ws_size < WS_END) { fprintf(stderr, "kernel_launch: shape/workspace mismatch: n_in %d in0 %d out %d ws %zu (need %zu)\n", n_in, n_in > 0 ? in_sizes[0] : -1, out_size, ws_size, (size_t)WS_END); grid = -1; return; }
        int dev = 0, cus = 0, per_cu = 0;
        if (hipGetDevice(&dev) != hipSuccess || hipDeviceGetAttribute(&cus, hipDeviceAttributeMultiprocessorCount, dev) != hipSuccess) { grid = -1; return; }
        if (hipFuncSetAttribute((const void*)fwd, hipFuncAttributeMaxDynamicSharedMemorySize, LDS_BYTES) != hipSuccess) { fprintf(stderr, "kernel_launch: hipFuncSetAttribute failed\n"); grid = -1; return; }
        if (hipOccupancyMaxActiveBlocksPerMultiprocessor(&per_cu, (const void*)fwd, NWAVES * 64, LDS_BYTES) != hipSuccess || per_cu < 1) fprintf(stderr, "kernel_launch: occupancy query reports %d\n", per_cu);
        (void)hipGetLastError();
        grid = cus;
    }
    if (grid < 0) return;
    if (hipMemsetAsync((char*)d_ws + WS_CTL, 0, CTL_ZERO_BYTES, stream) != hipSuccess) return;
    Args a{};
    for (int i = 0; i < 30; ++i) a.in[i] = d_in[i];
    a.out = (float*)d_out; a.ws = (unsigned char*)d_ws;
    if (MK_N_LAUNCHES == 1) { a.ph_lo = 0; a.ph_hi = N_PHASES; hipLaunchKernelGGL(fwd, dim3(grid), dim3(NWAVES * 64), LDS_BYTES, stream, a); }
    else { for (int p = 0; p < N_PHASES; ++p) { a.ph_lo = p; a.ph_hi = p + 1; hipLaunchKernelGGL(fwd, dim3(grid), dim3(NWAVES * 64), LDS_BYTES, stream, a); } }
    const hipError_t le = hipPeekAtLastError();
    if (le != hipSuccess) fprintf(stderr, "kernel_launch: launch failed: %s\n", hipGetErrorName(le));
}
```

```cpp
#include <hip/hip_runtime.h>
#include <cstdio>
#include <cstdint>

#define WGM_G 4
#define PG_ALIGN true
#define PG_SP2 true
#ifndef MK_N_LAUNCHES
#define MK_N_LAUNCHES 1
#endif

namespace pg8 {
#define PG8_LAS __attribute__((address_space(3)))
typedef unsigned short bf16_t;
typedef short bf16x8 __attribute__((ext_vector_type(8)));
typedef float f32x4 __attribute__((ext_vector_type(4)));
typedef float f32x2 __attribute__((ext_vector_type(2)));
typedef unsigned u32x4 __attribute__((ext_vector_type(4)));
typedef unsigned u32x2 __attribute__((ext_vector_type(2)));
constexpr int BM = 256, BK = 64, HALF = 128, HTB = HALF * BK * 2  , STAGE_BYTES = 8 * HTB, NXCD = 8, WGM = 8;

__host__ __device__ __forceinline__ int lds_byte(int r, int c) { const int st = (r >> 4) * 2 + (c >> 5), rr = r & 15, cc = c & 31, ob = rr * 64 + cc * 2; return st * 1024 + (ob ^ (((ob >> 9) & 1) << 5)); }
__host__ __device__ __forceinline__ void stage_rc(int b, int& R, int& C) { const int st = b / 1024, sb = b % 1024, swz = sb ^ (((sb >> 9) & 1) << 5); R = (st >> 1) * 16 + swz / 64; C = (st & 1) * 32 + (swz % 64) / 2; }
__host__ __device__ __forceinline__ int perm32(int rho) { const int n = rho >> 4, i = rho & 15; return 8 * (i >> 2) + 4 * n + (i & 3); }

struct Unit { int pm, pn, pb; };
struct Gemm { const bf16_t* A; const bf16_t* Bt; int lda, ldb, K; };

struct StaticOrder {
    int nM, nN, nwg, G, c;
    __host__ __device__ void init(int M, int N, int G_, int c_) { nM = M / BM; nN = N / BM; nwg = nM * nN; G = G_; c = c_; }
    __host__ __device__ bool next(int i, Unit& u) const {
        const long L = (long)i * G + c; if (L >= nwg) return false;
        int wgid = (int)L; { const int q = nwg / NXCD, r = nwg % NXCD, xcd = wgid % NXCD, off = wgid / NXCD; wgid = (xcd < r ? xcd * (q + 1) : r * (q + 1) + (xcd - r) * q) + off; }
        const int nig = WGM * nN, gid = wgid / nig, fm = gid * WGM, gsz = (nM - fm) < WGM ? (nM - fm) : WGM;
        u.pm = fm + ((wgid % nig) % gsz); u.pn = (wgid % nig) / gsz; u.pb = u.pn; return true;
    }
    __device__ __forceinline__ void a_ready(const Unit&) const {}
    __device__ __forceinline__ void done(const Unit&) const {}
};
#ifndef WGM_G
#endif
struct GroupedOrder {
    int nN, G, c; int ts[9];
    __device__ __forceinline__ void init(const unsigned* tstart, int nN_, int G_, int c_) { nN = nN_; G = G_; c = c_;
#pragma unroll
        for (int e = 0; e < 9; ++e) ts[e] = (int)tstart[e]; }
    __device__ __forceinline__ bool next(int i, Unit& u) const {
        const long L = (long)i * G + c; if (L >= (long)ts[8] * nN) return false;
        int e = 0, us = 0, te = ts[1] - ts[0], t0 = ts[0];
#pragma unroll
        for (int k = 1; k < 8; ++k) { const int s = ts[k] * nN; if (L >= s) { e = k; us = s; te = ts[k + 1] - ts[k]; t0 = ts[k]; } }
        if (te <= 0) return false;
        int wgid = (int)L - us; { const int nwg = te * nN, q = nwg / NXCD, rr = nwg % NXCD, xcd = wgid % NXCD, off = wgid / NXCD; wgid = (xcd < rr ? xcd * (q + 1) : rr * (q + 1) + (xcd - rr) * q) + off; }
        const int nig = WGM_G * nN, gid = wgid / nig, fm = gid * WGM_G, gsz = (te - fm) < WGM_G ? (te - fm) : WGM_G;
        u.pm = t0 + fm + ((wgid % nig) % gsz); u.pn = (wgid % nig) / gsz; u.pb = e * nN + u.pn; return true;
    }
    __device__ __forceinline__ void a_ready(const Unit&) const {}
    __device__ __forceinline__ void done(const Unit&) const {}
};

typedef __bf16 bf16x2c __attribute__((ext_vector_type(2)));
__device__ __forceinline__ unsigned cvt_pk_bf16(float lo, float hi) { const f32x2 v = {lo, hi}; return __builtin_bit_cast(unsigned, __builtin_convertvector(v, bf16x2c)); }

struct EpiBf16 {
    static constexpr bool PERM = true, AFTER_DRAIN = false;
    bf16_t* O; int ldc; const float* rowscale;
    __device__ __forceinline__ void operator()(const f32x4 (&acc)[2][2][4][2], const Unit& u, int wr, int wc, int fr, int fq) const {
        const int row0 = u.pm * BM + wr * 64 + fr; const int col0 = u.pn * BM + wc * 32 + 8 * fq;
#pragma unroll
        for (int ai = 0; ai < 2; ++ai)
#pragma unroll
            for (int m = 0; m < 4; ++m) { const int row = row0 + ai * HALF + m * 16; bf16_t* rowp = O + (size_t)row * ldc + col0; const float sc = rowscale ? rowscale[row] : 1.f;
#pragma unroll
                for (int bj = 0; bj < 2; ++bj) { f32x4 v0 = acc[ai][bj][m][0] * sc, v1 = acc[ai][bj][m][1] * sc;
                    u32x4 w; w.x = cvt_pk_bf16(v0[0], v0[1]); w.y = cvt_pk_bf16(v0[2], v0[3]); w.z = cvt_pk_bf16(v1[0], v1[1]); w.w = cvt_pk_bf16(v1[2], v1[3]);
                    *(u32x4*)(rowp + bj * HALF) = w; } }
    }
};
struct EpiResid {
    static constexpr bool PERM = false, AFTER_DRAIN = false;
    const float* xin; float* xout; int ldc; const float* gate; int gstride; int tiles_per_b;
    __device__ __forceinline__ void operator()(const f32x4 (&acc)[2][2][4][2], const Unit& u, int wr, int wc, int fr, int fq) const {
        const int row0 = u.pm * BM + wr * 64 + fr, col0 = u.pn * BM + wc * 32 + 4 * fq;
        const float* gp = gate + (size_t)(u.pm / tiles_per_b) * gstride + col0;
        f32x4 gv[2][2];
#pragma unroll
        for (int bj = 0; bj < 2; ++bj)
#pragma unroll
            for (int n = 0; n < 2; ++n) gv[bj][n] = *(const f32x4*)(gp + bj * HALF + n * 16);
#pragma unroll
        for (int ai = 0; ai < 2; ++ai)
#pragma unroll
            for (int m = 0; m < 4; ++m) { const size_t off = (size_t)(row0 + ai * HALF + m * 16) * ldc + col0;
#pragma unroll
                for (int bj = 0; bj < 2; ++bj)
#pragma unroll
                    for (int n = 0; n < 2; ++n) { const f32x4 xi = *(const f32x4*)(xin + off + bj * HALF + n * 16);
                        *(f32x4*)(xout + off + bj * HALF + n * 16) = xi + gv[bj][n] * acc[ai][bj][m][n]; }
                asm volatile("" ::: "memory"); }
    }
};
__device__ __forceinline__ float silu_f(float g) { return g * __builtin_amdgcn_rcpf(1.0f + __builtin_amdgcn_exp2f(-1.4426950408889634f * g)); }
struct EpiSwiGLU {
    static constexpr bool PERM = false, AFTER_DRAIN = false;
    bf16_t* O; int ldo;
    __device__ __forceinline__ void operator()(const f32x4 (&acc)[2][2][4][2], const Unit& u, int wr, int wc, int fr, int fq) const {
        const int row0 = u.pm * BM + wr * 64 + fr, col0 = u.pn * HALF + wc * 16 + 4 * fq;
#pragma unroll
        for (int ai = 0; ai < 2; ++ai)
#pragma unroll
            for (int m = 0; m < 4; ++m) { bf16_t* rowp = O + (size_t)(row0 + ai * HALF + m * 16) * ldo + col0;
#pragma unroll
                for (int bj = 0; bj < 2; ++bj) { const f32x4 g = acc[ai][bj][m][0], up = acc[ai][bj][m][1];
                    u32x2 w; w.x = cvt_pk_bf16(silu_f(g[0]) * up[0], silu_f(g[1]) * up[1]); w.y = cvt_pk_bf16(silu_f(g[2]) * up[2], silu_f(g[3]) * up[3]);
                    *(u32x2*)(rowp + bj * 64) = w; } }
    }
};

template <class Epi, class Sched, bool ALIGN_EPI = false, bool SP2 = false>
__device__ __forceinline__ void gemm_phase(PG8_LAS unsigned char* lds, const Gemm g, const Sched& S, const Epi& E) {
    const int tid = threadIdx.x, wid = __builtin_amdgcn_readfirstlane(tid >> 6), lane = tid & 63, wr = wid >> 2, wc = wid & 3, fr = lane & 15, fq = lane >> 4;
    const int K = g.K, nt = K / BK;
    unsigned voffA[2], voffB[2];
#pragma unroll
    for (int i = 0; i < 2; ++i) { int R, C; stage_rc(tid * 16 + i * 8192, R, C); const int Rb = Epi::PERM ? ((R & ~31) + perm32(R & 31)) : R;
        voffA[i] = (unsigned)(R * g.lda + C) * 2u; voffB[i] = (unsigned)(Rb * g.ldb + C) * 2u; }
    const size_t kstep = (size_t)(BK * 2);
    const size_t hstepA = (size_t)HALF * g.lda * 2, hstepB = (size_t)HALF * g.ldb * 2;
    const size_t tstepA = 2 * hstepA, tstepB = 2 * hstepB;
    const unsigned ldsw = (unsigned)wid * 1024u;
    const int aoff = lds_byte(wr * 64 + fr, fq * 8), boff = lds_byte(wc * 32 + fr, fq * 8);
#define PG8_SA(b, h) (((b) * 2 + (h)) * HTB)
#define PG8_SB(b, h) ((4 + (b) * 2 + (h)) * HTB)
#define PG8_STAGE(bufoff, gbase, voff) do { _Pragma("unroll") for (int _i = 0; _i < 2; ++_i) \
        __builtin_amdgcn_global_load_lds((const unsigned*)((const char*)(gbase) + (voff)[_i]), (PG8_LAS unsigned*)(lds + (bufoff) + ldsw + _i * 8192), 16, 0, 0); } while (0)
#define PG8_LDA(dst, b, h) do { _Pragma("unroll") for (int m = 0; m < 4; ++m) _Pragma("unroll") for (int k = 0; k < 2; ++k) dst[m][k] = *(const PG8_LAS bf16x8*)(lds + PG8_SA(b, h) + aoff + m * 2048 + k * 1024); } while (0)
#define PG8_LDB(dst, b, h) do { _Pragma("unroll") for (int n = 0; n < 2; ++n) _Pragma("unroll") for (int k = 0; k < 2; ++k) dst[n][k] = *(const PG8_LAS bf16x8*)(lds + PG8_SB(b, h) + boff + n * 2048 + k * 1024); } while (0)
#define PG8_MMA(ai, bj, At, Bt) do { __builtin_amdgcn_s_setprio(1); _Pragma("unroll") for (int m = 0; m < 4; ++m) _Pragma("unroll") for (int n = 0; n < 2; ++n) _Pragma("unroll") for (int k = 0; k < 2; ++k) \
        acc[ai][bj][m][n] = __builtin_amdgcn_mfma_f32_16x16x32_bf16(Bt[n][k], At[m][k], acc[ai][bj][m][n], 0, 0, 0); __builtin_amdgcn_s_setprio(0); } while (0)
#define PG8_WAIT_V(n) asm volatile("s_waitcnt vmcnt(" #n ")" ::: "memory")
#define PG8_WAIT_L(n) asm volatile("s_waitcnt lgkmcnt(" #n ")" ::: "memory")
#define PG8_BAR __builtin_amdgcn_s_barrier()
#define PG8_SCHED __builtin_amdgcn_sched_barrier(0)
    Unit cur, nxt; int ui = 0;
    if (!S.next(0, cur)) return;
    f32x4 acc[2][2][4][2];
#pragma unroll
    for (int a = 0; a < 2; ++a)
#pragma unroll
        for (int b = 0; b < 2; ++b)
#pragma unroll
            for (int m = 0; m < 4; ++m)
#pragma unroll
                for (int n = 0; n < 2; ++n) acc[a][b][m][n] = (f32x4){0.f, 0.f, 0.f, 0.f};
    bf16x8 At[4][2], B0[2][2], B1[2][2];
    const char* cA = (const char*)g.A + (size_t)cur.pm * tstepA; const char* cB = (const char*)g.Bt + (size_t)cur.pb * tstepB;
    S.a_ready(cur);
    if constexpr (SP2) {
        PG8_STAGE(PG8_SB(0, 0), cB, voffB); PG8_STAGE(PG8_SB(0, 1), cB + hstepB, voffB); PG8_STAGE(PG8_SA(0, 0), cA, voffA); PG8_STAGE(PG8_SA(0, 1), cA + hstepA, voffA);
        if (wr == 1) PG8_BAR;
        PG8_WAIT_V(2); PG8_BAR;
        PG8_STAGE(PG8_SB(1, 0), cB + kstep, voffB); PG8_STAGE(PG8_SA(1, 0), cA + kstep, voffA); PG8_STAGE(PG8_SB(1, 1), cB + hstepB + kstep, voffB);
        PG8_WAIT_V(6); PG8_BAR;
    } else {
        PG8_STAGE(PG8_SB(0, 0), cB, voffB); PG8_STAGE(PG8_SA(0, 0), cA, voffA); PG8_STAGE(PG8_SB(0, 1), cB + hstepB, voffB); PG8_STAGE(PG8_SA(0, 1), cA + hstepA, voffA);
        if (wr == 1) PG8_BAR;
        PG8_WAIT_V(4); PG8_BAR;
        PG8_STAGE(PG8_SB(1, 0), cB + kstep, voffB); PG8_STAGE(PG8_SA(1, 0), cA + kstep, voffA); PG8_STAGE(PG8_SB(1, 1), cB + hstepB + kstep, voffB);
        PG8_WAIT_V(6); PG8_BAR;
    }
    for (;;) {
        const bool has_next = S.next(ui + 1, nxt);
        const char* nA = has_next ? (const char*)g.A + (size_t)nxt.pm * tstepA : cA; const char* nB = has_next ? (const char*)g.Bt + (size_t)nxt.pb * tstepB : cB;
        for (int t = 0; t < nt; t += 2) {
            const bool last = (t == nt - 2);
            const char* a1 = cA + (size_t)(t + 1) * kstep;
            const char* a2 = last ? nA : cA + (size_t)(t + 2) * kstep; const char* b2 = last ? nB : cB + (size_t)(t + 2) * kstep;
            const char* a3 = a2 + kstep; const char* b3 = b2 + kstep;
            if (last && has_next) S.a_ready(nxt);
            if constexpr (SP2) {
            PG8_LDB(B0, 0, 0); PG8_LDB(B1, 0, 1); PG8_SCHED; PG8_LDA(At, 0, 0); PG8_STAGE(PG8_SA(1, 1), a1 + hstepA, voffA);
            PG8_WAIT_V(8); PG8_WAIT_L(0); PG8_BAR; PG8_MMA(0, 0, At, B0); PG8_MMA(0, 1, At, B1); PG8_BAR; PG8_SCHED;
            PG8_LDA(At, 0, 1); PG8_STAGE(PG8_SB(0, 0), b2, voffB); PG8_STAGE(PG8_SB(0, 1), b2 + hstepB, voffB); PG8_STAGE(PG8_SA(0, 0), a2, voffA);
            PG8_WAIT_V(8); PG8_WAIT_L(0); PG8_BAR; PG8_MMA(1, 0, At, B0); PG8_MMA(1, 1, At, B1); PG8_BAR; PG8_SCHED;
            PG8_LDB(B0, 1, 0); PG8_LDB(B1, 1, 1); PG8_SCHED; PG8_LDA(At, 1, 0); PG8_STAGE(PG8_SA(0, 1), a2 + hstepA, voffA);
            PG8_WAIT_V(8); PG8_WAIT_L(0); PG8_BAR; PG8_MMA(0, 0, At, B0); PG8_MMA(0, 1, At, B1); PG8_BAR; PG8_SCHED;
            PG8_LDA(At, 1, 1); PG8_STAGE(PG8_SB(1, 0), b3, voffB); PG8_STAGE(PG8_SB(1, 1), b3 + hstepB, voffB); PG8_STAGE(PG8_SA(1, 0), a3, voffA);
            PG8_WAIT_V(8); PG8_WAIT_L(0); PG8_BAR; PG8_MMA(1, 0, At, B0); PG8_MMA(1, 1, At, B1); PG8_BAR; PG8_SCHED;
            } else {
            PG8_LDB(B0, 0, 0); PG8_SCHED; PG8_LDA(At, 0, 0); PG8_STAGE(PG8_SA(1, 1), a1 + hstepA, voffA);
            PG8_WAIT_L(8); PG8_BAR; PG8_WAIT_L(0); PG8_MMA(0, 0, At, B0); PG8_BAR; PG8_SCHED;
            PG8_LDB(B1, 0, 1); PG8_STAGE(PG8_SB(0, 0), b2, voffB);
            PG8_BAR; PG8_WAIT_L(0); PG8_MMA(0, 1, At, B1); PG8_BAR;
            PG8_LDA(At, 0, 1); PG8_STAGE(PG8_SA(0, 0), a2, voffA);
            PG8_BAR; PG8_WAIT_L(0); PG8_MMA(1, 0, At, B0); PG8_BAR; PG8_SCHED;
            PG8_STAGE(PG8_SB(0, 1), b2 + hstepB, voffB);
            PG8_WAIT_V(6); PG8_BAR; PG8_MMA(1, 1, At, B1); PG8_BAR;
            PG8_LDB(B0, 1, 0); PG8_SCHED; PG8_LDA(At, 1, 0); PG8_STAGE(PG8_SA(0, 1), a2 + hstepA, voffA);
            PG8_WAIT_L(8); PG8_BAR; PG8_WAIT_L(0); PG8_MMA(0, 0, At, B0); PG8_BAR; PG8_SCHED;
            PG8_LDB(B1, 1, 1); PG8_STAGE(PG8_SB(1, 0), b3, voffB);
            PG8_BAR; PG8_WAIT_L(0); PG8_MMA(0, 1, At, B1); PG8_BAR;
            PG8_LDA(At, 1, 1); PG8_STAGE(PG8_SA(1, 0), a3, voffA);
            PG8_BAR; PG8_WAIT_L(0); PG8_MMA(1, 0, At, B0); PG8_BAR; PG8_SCHED;
            PG8_STAGE(PG8_SB(1, 1), b3 + hstepB, voffB);
            PG8_WAIT_V(6); PG8_BAR; PG8_MMA(1, 1, At, B1); PG8_BAR;
            }
        }
        if constexpr (ALIGN_EPI) { if (wr == 0) PG8_BAR; }
        if constexpr (!Epi::AFTER_DRAIN) { E(acc, cur, wr, wc, fr, fq); S.done(cur); }
        if (!has_next) break;
#pragma unroll
        for (int a = 0; a < 2; ++a)
#pragma unroll
            for (int b = 0; b < 2; ++b)
#pragma unroll
                for (int m = 0; m < 4; ++m)
#pragma unroll
                    for (int n = 0; n < 2; ++n) acc[a][b][m][n] = (f32x4){0.f, 0.f, 0.f, 0.f};
        cur = nxt; cA = nA; cB = nB; ++ui;
        if constexpr (ALIGN_EPI) { if (wr == 1) PG8_BAR; }
    }
    PG8_WAIT_V(0);
    if constexpr (!ALIGN_EPI) { if (wr == 0) PG8_BAR; }
    PG8_BAR;
    if constexpr (Epi::AFTER_DRAIN) { E.fused(acc, cur, wr, wc, fr, fq, lds, wid, lane); S.done(cur); }
#undef PG8_SA
#undef PG8_SB
#undef PG8_STAGE
#undef PG8_LDA
#undef PG8_LDB
#undef PG8_MMA
#undef PG8_WAIT_V
#undef PG8_WAIT_L
#undef PG8_BAR
#undef PG8_SCHED
}

}

namespace fa {
#define FA_LAS __attribute__((address_space(3)))
typedef unsigned short bf16;
typedef short bf16x8 __attribute__((ext_vector_type(8)));
typedef short s16x4 __attribute__((ext_vector_type(4)));
typedef float f32x16 __attribute__((ext_vector_type(16)));
typedef float f32x4 __attribute__((ext_vector_type(4)));
typedef unsigned u32x4 __attribute__((ext_vector_type(4)));
constexpr int QB = 256, QBLK = 32, KVBLK = 64;
constexpr int SHM_K = 16384, SHM_V = 16384, SHM_K2 = 8192;
constexpr int OFF_V = 0, OFF_K = 2 * SHM_V, OFF_K2 = OFF_K + 2 * SHM_K, OFF_WS = OFF_K2 + 2 * SHM_K2, WS_PER_WAVE = 1024, OFF_TAB = OFF_WS + 8 * WS_PER_WAVE;
constexpr int TAB_PAD = 320, TAB_MAX = 4096 + TAB_PAD;
constexpr int LDS_END = OFF_TAB + TAB_MAX * 4;
constexpr int OSTG = 272;
static_assert(LDS_END <= 131072 && 8 * 32 * OSTG <= OFF_WS, "attention LDS map");
#define KSWZ(row, colB) ((row) * 256 + ((colB) ^ (((row) & 7) << 4)))
#define K2SWZ(row, colB) ((row) * 128 + ((colB) ^ (((row) & 7) << 4)))
#define SBAR() __builtin_amdgcn_sched_barrier(0)
__device__ __forceinline__ int v_st(int k, int c) { const int kk = (k & ~0xC) | ((k & 4) << 1) | ((k & 8) >> 1); return ((kk >> 3) * 4 + (c >> 5)) * 512 + ((kk & 7) * 32 + (c & 31)) * 2; }
__device__ __forceinline__ int v_rd_base(int lane) { return ((lane & 3) << 3) | (((lane >> 2) & 3) << 6) | (((lane >> 4) & 1) << 5) | (((lane >> 5) & 1) << 8); }
constexpr int v_rd_off(int d0, int ks, int half) { return d0 * 512 + ks * 4096 + half * 2048; }
__device__ __forceinline__ int crow(int r, int hi) { return (r & 3) + 8 * (r >> 2) + 4 * hi; }
typedef float f32x2c __attribute__((ext_vector_type(2)));
typedef __bf16 bf16x2c __attribute__((ext_vector_type(2)));
__device__ __forceinline__ unsigned cvtpk(float lo, float hi) { const f32x2c v = {lo, hi}; return __builtin_bit_cast(unsigned, __builtin_convertvector(v, bf16x2c)); }

struct Item {
    const bf16* Q; long qs;
    const float* rope; long ropes;
    const bf16* K; long ks; const bf16* K2; long k2s; const bf16* V; long vs;
    int P0, skv, W;
    const float* bias; int bstep;
    const unsigned long long* sel; long sels;
    bf16* O; long os;
    float* LSE; long lses;
    const bf16* M0; const bf16* M1; long ms; const bf16* G; long gs;
};

template <int VAR>
__device__ __forceinline__ void attn_block(const Item& it, unsigned char* lds_g) {
    constexpr bool HAS_BIAS = VAR != 2, HAS_SEL = VAR == 1, HAS_K2 = VAR == 2;
    constexpr float SCALE = HAS_K2 ? 0.07216878364870322f : 0.08838834764831845f, C2 = 1.4426950408889634f * SCALE, THR = 8.f;
    FA_LAS unsigned char* L = (FA_LAS unsigned char*)lds_g;
    const int tid = threadIdx.x, wid = __builtin_amdgcn_readfirstlane(tid >> 6), lane = tid & 63, r32 = lane & 31, hi = lane >> 5;
    const int W = it.W;
    const int j_lo = (it.P0 - W + 1 > 0) ? (it.P0 - W + 1) / KVBLK : 0;
    int j_hi = (it.P0 + QB - 1) / KVBLK + 1; if (j_hi > it.skv / KVBLK) j_hi = it.skv / KVBLK;
    const int NT = j_hi - j_lo;
    const int qlo = it.P0 + wid * QBLK, qm = qlo + r32 - 4 * hi;
    FA_LAS float* wsl = (FA_LAS float*)(L + OFF_WS + wid * WS_PER_WAVE); FA_LAS float* li_l = wsl; FA_LAS float* al_l = wsl + 32;
    FA_LAS float* tab = (FA_LAS float*)(L + OFF_TAB);
    const int sr = tid >> 4, sc = (tid & 15) * 8, vst0 = v_st(sr, sc), vst1 = v_st(32 + sr, sc), kws = KSWZ(sr, sc * 2);
    const int k2r = tid >> 3, k2c = (tid & 7) * 8, k2ws = K2SWZ(k2r, k2c * 2);
    const int vb0 = OFF_V + v_rd_base(lane);
    bf16x8 qr[8]; bf16x8 qr2[4];
    { const bf16* qp = it.Q + (long)(qlo + r32) * it.qs + hi * 8;
#pragma unroll
      for (int d0 = 0; d0 < 8; ++d0) qr[d0] = *(const bf16x8*)(qp + d0 * 16);
      if constexpr (HAS_K2) {
          const float* rp = it.rope + (long)(qlo + r32) * it.ropes + hi * 8;
          bf16x8 raw[4];
#pragma unroll
          for (int d0 = 0; d0 < 4; ++d0) raw[d0] = *(const bf16x8*)(qp + 128 + d0 * 16);
#pragma unroll
          for (int d0 = 0; d0 < 2; ++d0) { const f32x4 c0 = *(const f32x4*)(rp + d0 * 16), c1 = *(const f32x4*)(rp + d0 * 16 + 4), s0 = *(const f32x4*)(rp + 32 + d0 * 16), s1 = *(const f32x4*)(rp + 32 + d0 * 16 + 4);
              float o1[8], o2[8];
#pragma unroll
              for (int j = 0; j < 8; ++j) { const float x1 = __builtin_bit_cast(float, (unsigned)(unsigned short)raw[d0][j] << 16), x2 = __builtin_bit_cast(float, (unsigned)(unsigned short)raw[d0 + 2][j] << 16);
                  const float cs = j < 4 ? c0[j & 3] : c1[j & 3], sn = j < 4 ? s0[j & 3] : s1[j & 3]; o1[j] = x1 * cs - x2 * sn; o2[j] = x2 * cs + x1 * sn; }
              u32x4 w1 = {cvtpk(o1[0], o1[1]), cvtpk(o1[2], o1[3]), cvtpk(o1[4], o1[5]), cvtpk(o1[6], o1[7])}, w2 = {cvtpk(o2[0], o2[1]), cvtpk(o2[2], o2[3]), cvtpk(o2[4], o2[5]), cvtpk(o2[6], o2[7])};
              qr2[d0] = __builtin_bit_cast(bf16x8, w1); qr2[d0 + 2] = __builtin_bit_cast(bf16x8, w2); }
      }
    }
    unsigned long long selm = ~0ull;
    if constexpr (HAS_SEL) selm = __hip_atomic_load(it.sel + (long)(qlo + r32) * it.sels, __ATOMIC_RELAXED, __HIP_MEMORY_SCOPE_AGENT);
    if constexpr (HAS_BIAS) {
        int rmax = W + 320; if (rmax > 4096) rmax = 4096;
        for (int i = tid; i < rmax + TAB_PAD; i += 512) { int r = i - TAB_PAD; r = r < -64 ? -64 : r; long gi = (long)r * it.bstep; gi = gi > 4095 ? 4095 : gi; tab[i] = it.bias[gi] * (1.0f / SCALE); }
    }
    bf16x8 st_k0, st_k1, st_v0, st_v1, st_k2;
#define FA_LOAD(kb_) do { const long r0_ = (long)((kb_) + sr), r1_ = r0_ + 32; \
        st_v0 = *(const bf16x8*)(it.V + r0_ * it.vs + sc); st_v1 = *(const bf16x8*)(it.V + r1_ * it.vs + sc); \
        st_k0 = *(const bf16x8*)(it.K + r0_ * it.ks + sc); st_k1 = *(const bf16x8*)(it.K + r1_ * it.ks + sc); \
        if constexpr (HAS_K2) st_k2 = *(const bf16x8*)(it.K2 + (long)((kb_) + k2r) * it.k2s + k2c); } while (0)
#define FA_WRITE(bf_) do { *(FA_LAS bf16x8*)(L + OFF_V + (bf_) * SHM_V + vst0) = st_v0; *(FA_LAS bf16x8*)(L + OFF_V + (bf_) * SHM_V + vst1) = st_v1; \
        *(FA_LAS bf16x8*)(L + OFF_K + (bf_) * SHM_K + kws) = st_k0; *(FA_LAS bf16x8*)(L + OFF_K + (bf_) * SHM_K + kws + 32 * 256) = st_k1; \
        if constexpr (HAS_K2) *(FA_LAS bf16x8*)(L + OFF_K2 + (bf_) * SHM_K2 + k2ws) = st_k2; } while (0)
    FA_LOAD(j_lo * KVBLK);
    asm volatile("s_waitcnt vmcnt(0)" ::: "memory");
    FA_WRITE(0);
    __syncthreads();
    float m_reg = -1e30f, l_reg = 0.f; f32x16 o[4] = {};
#define FA_KBASE(t) ((j_lo + (t)) * KVBLK)
#define FA_STEP(BUF, t) do { \
        const int kb_ = FA_KBASE(t); \
        if ((t) + 1 < NT) FA_LOAD(FA_KBASE((t) + 1)); \
        bool act_ = (kb_ <= qlo + QBLK - 1) && (kb_ + KVBLK - 1 >= qlo - W + 1); \
        bool allow_ = true; \
        if constexpr (HAS_SEL) { allow_ = (bool)((selm >> (kb_ >> 6)) & 1ull); } \
        if (act_) { \
            f32x16 p0 = {}, p1 = {}; \
            { const int ka_ = OFF_K + (BUF) * SHM_K; \
              _Pragma("unroll") for (int d0 = 0; d0 < 8; ++d0) { \
                const bf16x8 b0 = *(const FA_LAS bf16x8*)(L + ka_ + KSWZ(r32, (d0 * 16 + hi * 8) * 2)); \
                const bf16x8 b1 = *(const FA_LAS bf16x8*)(L + ka_ + 32 * 256 + KSWZ(r32, (d0 * 16 + hi * 8) * 2)); \
                p0 = __builtin_amdgcn_mfma_f32_32x32x16_bf16(b0, qr[d0], p0, 0, 0, 0); p1 = __builtin_amdgcn_mfma_f32_32x32x16_bf16(b1, qr[d0], p1, 0, 0, 0); } \
              if constexpr (HAS_K2) { const int k2a_ = OFF_K2 + (BUF) * SHM_K2; \
                _Pragma("unroll") for (int d0 = 0; d0 < 4; ++d0) { \
                  const bf16x8 b0 = *(const FA_LAS bf16x8*)(L + k2a_ + K2SWZ(r32, (d0 * 16 + hi * 8) * 2)); \
                  const bf16x8 b1 = *(const FA_LAS bf16x8*)(L + k2a_ + 32 * 128 + K2SWZ(r32, (d0 * 16 + hi * 8) * 2)); \
                  p0 = __builtin_amdgcn_mfma_f32_32x32x16_bf16(b0, qr2[d0], p0, 0, 0, 0); p1 = __builtin_amdgcn_mfma_f32_32x32x16_bf16(b1, qr2[d0], p1, 0, 0, 0); } } } \
            const int dq_ = qm - kb_; \
            if constexpr (HAS_BIAS) { const FA_LAS float* tb_ = tab + (TAB_PAD + dq_ - 63); \
                _Pragma("unroll") for (int r = 0; r < 16; ++r) { const int c_ = (r & 3) + 8 * (r >> 2); p0[r] += tb_[63 - c_]; p1[r] += tb_[31 - c_]; } } \
            if (HAS_SEL || kb_ + KVBLK - 1 > qlo || kb_ <= qlo + QBLK - 1 - W) { const float NEG_ = -__builtin_inff(); const int dqm_ = allow_ ? dq_ : -0x40000000; \
                _Pragma("unroll") for (int r = 0; r < 16; ++r) { const int c_ = (r & 3) + 8 * (r >> 2); \
                    if ((unsigned)(dqm_ - c_) >= (unsigned)W) p0[r] = NEG_; if ((unsigned)(dqm_ - c_ - 32) >= (unsigned)W) p1[r] = NEG_; } } \
              \
            float pmax_ = p0[0]; _Pragma("unroll") for (int r = 1; r < 16; ++r) pmax_ = fmaxf(pmax_, p0[r]); _Pragma("unroll") for (int r = 0; r < 16; ++r) pmax_ = fmaxf(pmax_, p1[r]); \
            { auto rr_ = __builtin_amdgcn_permlane32_swap(__float_as_uint(pmax_), __float_as_uint(pmax_), false, false); pmax_ = fmaxf(__uint_as_float(rr_[0]), __uint_as_float(rr_[1])); } \
            float mn_, alpha_; \
            if (__all((pmax_ - m_reg) * SCALE <= THR)) { mn_ = m_reg; alpha_ = 1.f; } \
            else { mn_ = fmaxf(m_reg, pmax_); alpha_ = __builtin_amdgcn_exp2f((m_reg - mn_) * C2); m_reg = mn_; } \
            const float mnL_ = -mn_ * C2; float ps_ = 0.f; \
            _Pragma("unroll") for (int r = 0; r < 16; ++r) { p0[r] = __builtin_amdgcn_exp2f(fmaf(p0[r], C2, mnL_)); p1[r] = __builtin_amdgcn_exp2f(fmaf(p1[r], C2, mnL_)); ps_ += p0[r] + p1[r]; } \
            { auto rr_ = __builtin_amdgcn_permlane32_swap(__float_as_uint(ps_), __float_as_uint(ps_), false, false); ps_ = __uint_as_float(rr_[0]) + __uint_as_float(rr_[1]); } \
            l_reg = l_reg * alpha_ + ps_; \
            bf16x8 pa0, pa1, pa2, pa3; \
            FA_PK4(p0, 0, pa0); FA_PK4(p0, 8, pa1); FA_PK4(p1, 0, pa2); FA_PK4(p1, 8, pa3); \
            if (__any(alpha_ < 1.f)) { if (hi == 0) al_l[r32] = alpha_; asm volatile("s_waitcnt lgkmcnt(0)" ::: "memory"); \
                _Pragma("unroll") for (int d_ = 0; d_ < 4; ++d_) _Pragma("unroll") for (int r = 0; r < 16; ++r) o[d_][r] *= al_l[crow(r, hi)]; } \
            FA_PV_D0(BUF, 0); FA_PV_D0(BUF, 1); FA_PV_D0(BUF, 2); FA_PV_D0(BUF, 3); \
        } \
        if ((t) + 1 < NT) { asm volatile("s_waitcnt vmcnt(0)" ::: "memory"); FA_WRITE(1 - (BUF)); } \
        __syncthreads(); } while (0)
#define FA_PK4(P, B_, OUT) do { unsigned a0 = cvtpk(P[B_+0], P[B_+1]), a1 = cvtpk(P[B_+2], P[B_+3]); unsigned b0 = cvtpk(P[B_+4], P[B_+5]), b1 = cvtpk(P[B_+6], P[B_+7]); \
        auto r0 = __builtin_amdgcn_permlane32_swap(a0, b0, false, false); auto r1 = __builtin_amdgcn_permlane32_swap(a1, b1, false, false); \
        u32x4 w = {r0[0], r1[0], r0[1], r1[1]}; OUT = __builtin_bit_cast(bf16x8, w); } while (0)
#define FA_TRRD(dst, off) asm volatile("ds_read_b64_tr_b16 %0, %1 offset:%2" : "=&v"(dst) : "v"(vb0), "i"(off) : "memory")
#define FA_PV_D0(VB, d0) do { s16x4 l0, l1, l2, l3, h0, h1, h2, h3; constexpr int b_ = (VB) * SHM_V + v_rd_off(d0, 0, 0); \
        FA_TRRD(l0, b_); FA_TRRD(h0, b_ + 2048); FA_TRRD(l1, b_ + 4096); FA_TRRD(h1, b_ + 6144); FA_TRRD(l2, b_ + 8192); FA_TRRD(h2, b_ + 10240); FA_TRRD(l3, b_ + 12288); FA_TRRD(h3, b_ + 14336); \
        asm volatile("s_waitcnt lgkmcnt(0)" ::: "memory"); SBAR(); \
        o[d0] = __builtin_amdgcn_mfma_f32_32x32x16_bf16(pa0, (bf16x8){l0[0], l0[1], l0[2], l0[3], h0[0], h0[1], h0[2], h0[3]}, o[d0], 0, 0, 0); \
        o[d0] = __builtin_amdgcn_mfma_f32_32x32x16_bf16(pa1, (bf16x8){l1[0], l1[1], l1[2], l1[3], h1[0], h1[1], h1[2], h1[3]}, o[d0], 0, 0, 0); \
        o[d0] = __builtin_amdgcn_mfma_f32_32x32x16_bf16(pa2, (bf16x8){l2[0], l2[1], l2[2], l2[3], h2[0], h2[1], h2[2], h2[3]}, o[d0], 0, 0, 0); \
        o[d0] = __builtin_amdgcn_mfma_f32_32x32x16_bf16(pa3, (bf16x8){l3[0], l3[1], l3[2], l3[3], h3[0], h3[1], h3[2], h3[3]}, o[d0], 0, 0, 0); } while (0)
    for (int t = 0; t < NT; t += 2) { FA_STEP(0, t); if (t + 1 < NT) FA_STEP(1, t + 1); }
    li_l[r32] = l_reg;
    if constexpr (VAR == 1) { const bf16* gp = it.G + (long)(qlo + r32) * it.gs;
#pragma unroll
        for (int k = 0; k < 3; ++k) { const float gl = __builtin_bit_cast(float, (unsigned)gp[k] << 16); wsl[64 + 32 * k + r32] = 1.0f / (1.0f + __expf(-gl)); } }
    asm volatile("s_waitcnt lgkmcnt(0)" ::: "memory");
    if (it.LSE && hi == 0) it.LSE[(long)(qlo + r32) * it.lses] = m_reg * SCALE + __logf(l_reg);
    FA_LAS unsigned char* stg = L + wid * (32 * OSTG);
#pragma unroll
    for (int r = 0; r < 16; ++r) { const int orow = crow(r, hi); const float lv_ = li_l[orow]; float rl = lv_ > 0.f ? __builtin_amdgcn_rcpf(lv_) : 0.f; if constexpr (VAR == 1) rl *= wsl[64 + 32 + orow];
#pragma unroll
        for (int d0 = 0; d0 < 4; ++d0) { const float v = o[d0][r] * rl; const unsigned u = __builtin_bit_cast(unsigned, v); *(FA_LAS unsigned short*)(stg + orow * OSTG + (d0 * 32 + r32) * 2) = (unsigned short)((u + 0x7fffu + ((u >> 16) & 1u)) >> 16); } }
    asm volatile("s_waitcnt lgkmcnt(0)" ::: "memory");
#pragma unroll
    for (int i = 0; i < 8; ++i) { const int id = lane + 64 * i, row = id >> 4, ch = id & 15; const long qi = (long)(qlo + row);
        u32x4 w = *(const FA_LAS u32x4*)(stg + row * OSTG + ch * 16);
        if constexpr (VAR == 1) { const float g0 = wsl[64 + row], g2 = wsl[64 + 64 + row];
            const u32x4 a = *(const u32x4*)(it.M0 + qi * it.ms + ch * 8), c = *(const u32x4*)(it.M1 + qi * it.ms + ch * 8);
#pragma unroll
            for (int k = 0; k < 4; ++k) { const float lo = __builtin_bit_cast(float, w[k] << 16) + g0 * __builtin_bit_cast(float, a[k] << 16) + g2 * __builtin_bit_cast(float, c[k] << 16);
                const float hi_ = __builtin_bit_cast(float, w[k] & 0xffff0000u) + g0 * __builtin_bit_cast(float, a[k] & 0xffff0000u) + g2 * __builtin_bit_cast(float, c[k] & 0xffff0000u); w[k] = cvtpk(lo, hi_); } }
        *(u32x4*)(it.O + qi * it.os + ch * 8) = w; }
    __syncthreads();
#undef FA_LOAD
#undef FA_WRITE
#undef FA_KBASE
#undef FA_STEP
#undef FA_PK4
#undef FA_TRRD
#undef FA_PV_D0
}

struct CmpItem { const bf16* Q; long qs; const bf16* K; const bf16* V; const float* bias; int bld; int s0; bf16* O; long os; unsigned long long* sel; };
__device__ __forceinline__ void cmp_block(const CmpItem& it, unsigned char* lds_g, int imps_off) {
    constexpr float SCALE = 0.08838834764831845f, C2 = 1.4426950408889634f * SCALE;
    constexpr int OFF_TABC = 65536;
    FA_LAS unsigned char* L = (FA_LAS unsigned char*)lds_g;
    const int tid = threadIdx.x, wid = __builtin_amdgcn_readfirstlane(tid >> 6), lane = tid & 63, r32 = lane & 31, hi = lane >> 5;
    FA_LAS float* tabc = (FA_LAS float*)(L + OFF_TABC); FA_LAS float* imps = (FA_LAS float*)(L + imps_off);
    const int tokl = wid * 8 + (r32 >> 2), rh = r32 & 3, s = it.s0 + tokl;
    const int nvis = (it.s0 + 63 - 31) / 16 + 1 > 255 ? 255 : (it.s0 + 63 - 31) / 16 + 1;
    const int NT = (nvis + 63) / 64;
    const int nlim = (s - 31) >> 4;
    const int sr = tid >> 4, sc = (tid & 15) * 8, vst0 = v_st(sr, sc), vst1 = v_st(32 + sr, sc), kws = KSWZ(sr, sc * 2);
    const int vb0 = OFF_V + v_rd_base(lane);
    bf16x8 qr[8];
    { const bf16* qp = it.Q + (long)tokl * it.qs + rh * 128 + hi * 8;
#pragma unroll
      for (int d0 = 0; d0 < 8; ++d0) qr[d0] = *(const bf16x8*)(qp + d0 * 16); }
    for (int i = tid; i < 4 * 4096; i += 512) tabc[i] = it.bias[(long)(i >> 12) * it.bld + (i & 4095)] * (1.0f / SCALE);
    for (int i = tid; i < 64 * 64; i += 512) imps[i] = 0.f;
    bf16x8 st_k0, st_k1, st_v0, st_v1;
#define CM_LOADK(kb_) do { st_k0 = *(const bf16x8*)(it.K + (long)((kb_) + sr) * 128 + sc); st_k1 = *(const bf16x8*)(it.K + (long)((kb_) + 32 + sr) * 128 + sc); } while (0)
#define CM_LOADV(kb_) do { st_v0 = *(const bf16x8*)(it.V + (long)((kb_) + sr) * 128 + sc); st_v1 = *(const bf16x8*)(it.V + (long)((kb_) + 32 + sr) * 128 + sc); } while (0)
#define CM_WRITEK(bf_) do { *(FA_LAS bf16x8*)(L + OFF_K + (bf_) * SHM_K + kws) = st_k0; *(FA_LAS bf16x8*)(L + OFF_K + (bf_) * SHM_K + kws + 32 * 256) = st_k1; } while (0)
#define CM_WRITEV(bf_) do { *(FA_LAS bf16x8*)(L + OFF_V + (bf_) * SHM_V + vst0) = st_v0; *(FA_LAS bf16x8*)(L + OFF_V + (bf_) * SHM_V + vst1) = st_v1; } while (0)
#define CM_SCORES(BUF, kb_) \
        f32x16 p0 = {}, p1 = {}; \
        { const int ka_ = OFF_K + (BUF) * SHM_K; \
          _Pragma("unroll") for (int d0 = 0; d0 < 8; ++d0) { \
            const bf16x8 b0 = *(const FA_LAS bf16x8*)(L + ka_ + KSWZ(r32, (d0 * 16 + hi * 8) * 2)); \
            const bf16x8 b1 = *(const FA_LAS bf16x8*)(L + ka_ + 32 * 256 + KSWZ(r32, (d0 * 16 + hi * 8) * 2)); \
            p0 = __builtin_amdgcn_mfma_f32_32x32x16_bf16(b0, qr[d0], p0, 0, 0, 0); p1 = __builtin_amdgcn_mfma_f32_32x32x16_bf16(b1, qr[d0], p1, 0, 0, 0); } } \
        { const int nb_ = (kb_) + 4 * hi, relb_ = s - 31 - 16 * nb_; const float NEG_ = -__builtin_inff(); \
          _Pragma("unroll") for (int r = 0; r < 16; ++r) { const int c_ = (r & 3) + 8 * (r >> 2); \
            { const int rel_ = relb_ - 16 * c_; const int ix_ = rel_ < 0 ? 0 : rel_; const float bv_ = tabc[rh * 4096 + ix_]; p0[r] = (nb_ + c_ <= nlim) ? p0[r] + bv_ : NEG_; } \
            { const int rel_ = relb_ - 16 * (c_ + 32); const int ix_ = rel_ < 0 ? 0 : rel_; const float bv_ = tabc[rh * 4096 + ix_]; p1[r] = (nb_ + c_ + 32 <= nlim) ? p1[r] + bv_ : NEG_; } } }
    CM_LOADK(0); asm volatile("s_waitcnt vmcnt(0)" ::: "memory"); CM_WRITEK(0); __syncthreads();
    float m_reg = -1e30f, l_reg = 0.f;
#define CM_P1(BUF, t) do { if ((t) + 1 < NT) CM_LOADK(((t) + 1) * 64); \
        { CM_SCORES(BUF, (t) * 64) \
          float pmax_ = p0[0]; _Pragma("unroll") for (int r = 1; r < 16; ++r) pmax_ = fmaxf(pmax_, p0[r]); _Pragma("unroll") for (int r = 0; r < 16; ++r) pmax_ = fmaxf(pmax_, p1[r]); \
          { auto rr_ = __builtin_amdgcn_permlane32_swap(__float_as_uint(pmax_), __float_as_uint(pmax_), false, false); pmax_ = fmaxf(__uint_as_float(rr_[0]), __uint_as_float(rr_[1])); } \
          const float mn_ = fmaxf(m_reg, pmax_), alpha_ = __builtin_amdgcn_exp2f((m_reg - mn_) * C2), mnL_ = -mn_ * C2; float ps_ = 0.f; \
          _Pragma("unroll") for (int r = 0; r < 16; ++r) ps_ += __builtin_amdgcn_exp2f(fmaf(p0[r], C2, mnL_)) + __builtin_amdgcn_exp2f(fmaf(p1[r], C2, mnL_)); \
          { auto rr_ = __builtin_amdgcn_permlane32_swap(__float_as_uint(ps_), __float_as_uint(ps_), false, false); ps_ = __uint_as_float(rr_[0]) + __uint_as_float(rr_[1]); } \
          l_reg = l_reg * alpha_ + ps_; m_reg = mn_; } \
        if ((t) + 1 < NT) { asm volatile("s_waitcnt vmcnt(0)" ::: "memory"); CM_WRITEK(1 - (BUF)); } \
        __syncthreads(); } while (0)
    for (int t = 0; t < NT; t += 2) { CM_P1(0, t); if (t + 1 < NT) CM_P1(1, t + 1); }
    const float inv_l = l_reg > 0.f ? 1.0f / l_reg : 0.f, mL = -m_reg * C2;
    CM_LOADK(0); CM_LOADV(0); asm volatile("s_waitcnt vmcnt(0)" ::: "memory"); CM_WRITEK(0); CM_WRITEV(0); __syncthreads();
    f32x16 o[4] = {};
#define FA_PK4(P, B_, OUT) do { unsigned a0 = cvtpk(P[B_+0], P[B_+1]), a1 = cvtpk(P[B_+2], P[B_+3]); unsigned b0 = cvtpk(P[B_+4], P[B_+5]), b1 = cvtpk(P[B_+6], P[B_+7]); \
        auto r0 = __builtin_amdgcn_permlane32_swap(a0, b0, false, false); auto r1 = __builtin_amdgcn_permlane32_swap(a1, b1, false, false); \
        u32x4 w = {r0[0], r1[0], r0[1], r1[1]}; OUT = __builtin_bit_cast(bf16x8, w); } while (0)
#define FA_TRRD(dst, off) asm volatile("ds_read_b64_tr_b16 %0, %1 offset:%2" : "=&v"(dst) : "v"(vb0), "i"(off) : "memory")
#define FA_PV_D0(VB, d0) do { s16x4 l0, l1, l2, l3, h0, h1, h2, h3; constexpr int b_ = (VB) * SHM_V + v_rd_off(d0, 0, 0); \
        FA_TRRD(l0, b_); FA_TRRD(h0, b_ + 2048); FA_TRRD(l1, b_ + 4096); FA_TRRD(h1, b_ + 6144); FA_TRRD(l2, b_ + 8192); FA_TRRD(h2, b_ + 10240); FA_TRRD(l3, b_ + 12288); FA_TRRD(h3, b_ + 14336); \
        asm volatile("s_waitcnt lgkmcnt(0)" ::: "memory"); SBAR(); \
        o[d0] = __builtin_amdgcn_mfma_f32_32x32x16_bf16(pa0, (bf16x8){l0[0], l0[1], l0[2], l0[3], h0[0], h0[1], h0[2], h0[3]}, o[d0], 0, 0, 0); \
        o[d0] = __builtin_amdgcn_mfma_f32_32x32x16_bf16(pa1, (bf16x8){l1[0], l1[1], l1[2], l1[3], h1[0], h1[1], h1[2], h1[3]}, o[d0], 0, 0, 0); \
        o[d0] = __builtin_amdgcn_mfma_f32_32x32x16_bf16(pa2, (bf16x8){l2[0], l2[1], l2[2], l2[3], h2[0], h2[1], h2[2], h2[3]}, o[d0], 0, 0, 0); \
        o[d0] = __builtin_amdgcn_mfma_f32_32x32x16_bf16(pa3, (bf16x8){l3[0], l3[1], l3[2], l3[3], h3[0], h3[1], h3[2], h3[3]}, o[d0], 0, 0, 0); } while (0)
#define CM_IMP(P, half_, t) do { _Pragma("unroll") for (int q4 = 0; q4 < 4; ++q4) { \
            float A_ = (2.0f * ((P[4 * q4] + P[4 * q4 + 1]) + P[4 * q4 + 2]) + P[4 * q4 + 3]) * inv_l, B_ = P[4 * q4 + 3] * inv_l; \
            A_ += __shfl_xor(A_, 1); A_ += __shfl_xor(A_, 2); B_ += __shfl_xor(B_, 1); B_ += __shfl_xor(B_, 2); \
            const int j_ = 2 * q4 + hi + 8 * (half_) + 16 * (t); \
            if (rh == 0) { __hip_atomic_fetch_add(&imps[tokl * 64 + j_], A_, __ATOMIC_RELAXED, __HIP_MEMORY_SCOPE_WORKGROUP); \
                if (j_ + 1 < 64) __hip_atomic_fetch_add(&imps[tokl * 64 + j_ + 1], B_, __ATOMIC_RELAXED, __HIP_MEMORY_SCOPE_WORKGROUP); } } } while (0)
#define CM_P2(BUF, t) do { if ((t) + 1 < NT) { CM_LOADK(((t) + 1) * 64); CM_LOADV(((t) + 1) * 64); } \
        { CM_SCORES(BUF, (t) * 64) \
          _Pragma("unroll") for (int r = 0; r < 16; ++r) { p0[r] = __builtin_amdgcn_exp2f(fmaf(p0[r], C2, mL)); p1[r] = __builtin_amdgcn_exp2f(fmaf(p1[r], C2, mL)); } \
          CM_IMP(p0, 0, t); CM_IMP(p1, 1, t); \
          bf16x8 pa0, pa1, pa2, pa3; FA_PK4(p0, 0, pa0); FA_PK4(p0, 8, pa1); FA_PK4(p1, 0, pa2); FA_PK4(p1, 8, pa3); \
          FA_PV_D0(BUF, 0); FA_PV_D0(BUF, 1); FA_PV_D0(BUF, 2); FA_PV_D0(BUF, 3); } \
        if ((t) + 1 < NT) { asm volatile("s_waitcnt vmcnt(0)" ::: "memory"); CM_WRITEK(1 - (BUF)); CM_WRITEV(1 - (BUF)); } \
        __syncthreads(); } while (0)
    for (int t = 0; t < NT; t += 2) { CM_P2(0, t); if (t + 1 < NT) CM_P2(1, t + 1); }
    asm volatile("s_waitcnt lgkmcnt(0)" ::: "memory");
    for (int tk = 0; tk < 8; ++tk) { const int sp = it.s0 + wid * 8 + tk, blk_t = sp >> 6, j = lane;
        const float is = imps[(wid * 8 + tk) * 64 + j];
        const bool forced = (j == 0) || (j == blk_t) || (j == blk_t - 1), valid = j <= blk_t;
        const float scv = forced ? 1e9f : (valid ? is : -1.0f);
        int rank = 0;
        for (int k = 0; k < 64; ++k) { const float vk = __shfl(scv, k); rank += (vk > scv || (vk == scv && k < j)) ? 1 : 0; }
        const unsigned long long msk = __ballot(rank < 16 && scv > -0.5f);
        if (lane == 0) it.sel[(long)(wid * 8 + tk) * 2] = msk; }
    FA_LAS unsigned char* stg = L + wid * (32 * OSTG);
    FA_LAS float* li_c = imps + wid * 512;
    li_c[r32] = inv_l; asm volatile("s_waitcnt lgkmcnt(0)" ::: "memory");
#pragma unroll
    for (int r = 0; r < 16; ++r) { const int orow = crow(r, hi); const float rl = li_c[orow];
#pragma unroll
        for (int d0 = 0; d0 < 4; ++d0) { const unsigned u = __builtin_bit_cast(unsigned, o[d0][r] * rl); *(FA_LAS unsigned short*)(stg + orow * OSTG + (d0 * 32 + r32) * 2) = (unsigned short)((u + 0x7fffu + ((u >> 16) & 1u)) >> 16); } }
    asm volatile("s_waitcnt lgkmcnt(0)" ::: "memory");
#pragma unroll
    for (int i = 0; i < 8; ++i) { const int id = lane + 64 * i, row = id >> 4, ch = id & 15;
        const u32x4 w = *(const FA_LAS u32x4*)(stg + row * OSTG + ch * 16);
        *(u32x4*)(it.O + (long)(wid * 8 + (row >> 2)) * it.os + (row & 3) * 128 + ch * 8) = w; }
    __syncthreads();
#undef CM_LOADK
#undef CM_LOADV
#undef CM_WRITEK
#undef CM_WRITEV
#undef CM_SCORES
#undef CM_P1
#undef CM_P2
#undef CM_IMP
#undef FA_PK4
#undef FA_TRRD
#undef FA_PV_D0
}
}

constexpr int D = 2048, NB = 4, S = 4096, M = NB * S;
constexpr int HD = 128;
constexpr int Z0W = 3840;
constexpr int Z_NQ = 0, Z_NKV = 1024, Z_QLAT = 2560, Z_KVLAT = 3072, Z_KPE = 3584, Z_NG = 3648;
constexpr int QMW = 1536, KVMW = 2048;
constexpr int FF = 5632, FFE = 7168, NE = 8;
constexpr int Z1W = 9216;
constexpr int NSLOT = (2 * M / 256 + NE) * 256;
constexpr float RMS_EPS = 1e-6f;

constexpr size_t MiB = 1u << 20;
constexpr size_t WS_CTL = 0, CTL_ZERO_BYTES = 1 * MiB;
constexpr size_t WS_MOD = 1 * MiB;
constexpr size_t WS_BIAS = 2 * MiB;
constexpr int BIAS_LD = 4096 + 64;
constexpr size_t WS_ROPE = 3 * MiB;
constexpr size_t WS_RINV = 8 * MiB;
constexpr size_t WS_SEL = 9 * MiB;
constexpr size_t WS_KC = 10 * MiB;
constexpr size_t WS_VC = 11 * MiB;
constexpr size_t WS_ROUTE = 12 * MiB;
constexpr size_t WS_LSE = 13 * MiB;
constexpr size_t WS_KPE = 15 * MiB;
constexpr size_t WS_W1T = 17 * MiB, WS_W2T = 19 * MiB, WS_CB1 = 20 * MiB;
constexpr size_t WS_WIN0 = 21 * MiB, WS_WUQ = 36 * MiB, WS_WUKV = 38 * MiB, WS_WOUT0 = 40 * MiB, WS_WGU0 = 48 * MiB, WS_WDN0 = 92 * MiB;
constexpr size_t WS_WIN1 = 114 * MiB, WS_WOUT1 = 150 * MiB, WS_WMGU = 154 * MiB, WS_WMDN = 602 * MiB;
constexpr size_t WS_X = 826 * MiB;
constexpr size_t WS_H = 954 * MiB;
constexpr size_t WS_R = 1018 * MiB;
constexpr size_t WS_Z0 = WS_R, WS_QM = WS_R + 120 * MiB, WS_KVM = WS_R + 168 * MiB, WS_OCMP = WS_R + 232 * MiB, WS_OWIN = WS_R + 264 * MiB, WS_CAT = WS_R + 328 * MiB;
constexpr size_t WS_ACT = WS_R;
constexpr size_t WS_Z1 = WS_R, WS_OP = WS_R + 288 * MiB, WS_OM = WS_R + 384 * MiB;
constexpr size_t WS_XB = WS_R, WS_ACTB = WS_R + 136 * MiB, WS_YB = WS_R;
constexpr size_t WS_END = WS_R + 612 * MiB;
static_assert(WS_Z0 + (size_t)M * Z0W * 2 <= WS_QM && WS_QM + (size_t)M * QMW * 2 <= WS_KVM && WS_KVM + (size_t)M * KVMW * 2 <= WS_OCMP && WS_CAT + (size_t)M * 2048 * 2 <= WS_END, "L0 map");
static_assert(WS_Z1 + (size_t)M * Z1W * 2 <= WS_OM && WS_XB + (size_t)NSLOT * D * 2 <= WS_ACTB && WS_ACTB + (size_t)NSLOT * FFE * 2 <= WS_END, "L1 map");
static_assert(WS_WMDN + (size_t)NE * D * FFE * 2 <= WS_X && WS_WMGU + (size_t)NE * 2 * FFE * D * 2 <= WS_WMDN, "weights map");
constexpr int CW_BAR = 4096;
constexpr int CW_CNT = 64;
constexpr int CW_TS = 128;
constexpr int CW_Q = 8192;

constexpr int RING_BYTES = 131072;
constexpr int SMALL_OFF = RING_BYTES;
constexpr int LDSCTL_OFF = RING_BYTES + 16384, MISC_OFF = LDSCTL_OFF;
constexpr int LDS_BYTES = LDSCTL_OFF + 256;
constexpr int NWAVES = 8;

#define GAS __attribute__((address_space(1)))
#define LAS __attribute__((address_space(3)))
typedef unsigned short bf16;
typedef unsigned v4u __attribute__((ext_vector_type(4)));
typedef unsigned v2u __attribute__((ext_vector_type(2)));
typedef float f32x4 __attribute__((ext_vector_type(4)));
typedef float f32x2 __attribute__((ext_vector_type(2)));
#define LDS_WAIT() asm volatile("s_waitcnt lgkmcnt(0)" ::: "memory")
__device__ __forceinline__ unsigned f2bf(float f) { unsigned u = __builtin_bit_cast(unsigned, f); return (u + 0x7fffu + ((u >> 16) & 1u)) >> 16; }
__device__ __forceinline__ unsigned pk2(float lo, float hi) { return f2bf(lo) | (f2bf(hi) << 16); }
__device__ __forceinline__ float bf2f(unsigned short b) { return __builtin_bit_cast(float, (unsigned)b << 16); }
__device__ __forceinline__ float bflo(unsigned w) { return __builtin_bit_cast(float, w << 16); }
__device__ __forceinline__ float bfhi(unsigned w) { return __builtin_bit_cast(float, w & 0xffff0000u); }
__device__ __forceinline__ float wave_sum(float v) {
#pragma unroll
    for (int o = 1; o < 64; o <<= 1) v += __shfl_xor(v, o);
    return v;
}
__device__ __forceinline__ float wave_max(float v) {
#pragma unroll
    for (int o = 1; o < 64; o <<= 1) v = fmaxf(v, __shfl_xor(v, o));
    return v;
}

#define XB_TMO      128
#define XB_XCNT(j)  (256  + 64 * (j))
#define XB_XSUB(j)  (1280 + 64 * (j))
#define XB_XGEN(j)  (2304 + 64 * (j))
#define XB_TOP      3328
#define XB_TOPGEN   3392
#define XCD_BAR_WORDS 3456
#define XB_SPIN_CAP (1u << 22)

__device__ __forceinline__ unsigned xb_ld(unsigned* p)              { return __hip_atomic_load(p, __ATOMIC_RELAXED, __HIP_MEMORY_SCOPE_AGENT); }
__device__ __forceinline__ unsigned xb_add(unsigned* p, unsigned v) { return __hip_atomic_fetch_add(p, v, __ATOMIC_RELAXED, __HIP_MEMORY_SCOPE_AGENT); }
__device__ __forceinline__ unsigned xb_xcc_id() { return (unsigned)__builtin_amdgcn_s_getreg((3 << 11) | 20) & 0xFu; }
#define XB_SPIN(cond, bar) do { unsigned _sp = 0; while (cond) { __builtin_amdgcn_s_sleep(1); \
    if ((++_sp & 255u) == 0u) { if (xb_ld(&(bar)[XB_TMO])) break; if (_sp > XB_SPIN_CAP) { atomicAdd(&(bar)[XB_TMO], 1u); break; } } } } while (0)

struct XcdBarrier {
    unsigned* bar; unsigned x;
    volatile LAS unsigned* st;
};

__device__ __forceinline__ XcdBarrier xcd_barrier_post(unsigned* bar, volatile LAS unsigned* st) {
    XcdBarrier b; b.bar = bar; b.x = xb_xcc_id(); b.st = st;
    if (threadIdx.x == 0) (void)xb_add(&bar[XB_XCNT(b.x)], 1u);
    return b;
}
__device__ __forceinline__ void xcd_barrier_complete(unsigned* bar, unsigned x, unsigned& nloc, unsigned& nx) {
    const unsigned G = gridDim.x * gridDim.y * gridDim.z;
    unsigned sum, cnt, mine, sp = 0u;
    for (;;) {
        sum = 0u; cnt = 0u; mine = 0u;
#pragma unroll
        for (unsigned j = 0; j < 16; ++j) { const unsigned c = xb_ld(&bar[XB_XCNT(j)]); sum += c; cnt += (c > 0u) ? 1u : 0u; mine = (j == x) ? c : mine; }
        if (sum == G) break;
        __builtin_amdgcn_s_sleep(1);
        if ((++sp & 255u) == 0u) { if (xb_ld(&bar[XB_TMO])) break; if (sp > XB_SPIN_CAP) { atomicAdd(&bar[XB_TMO], 1u); break; } }
    }
    nloc = mine > 0u ? mine : 1u; nx = cnt > 0u ? cnt : 1u;
}

__device__ __forceinline__ void xcd_barrier(const XcdBarrier& b) {
    asm volatile("s_waitcnt vmcnt(0)" ::: "memory");
    __syncthreads();
    if (threadIdx.x == 0) {
        unsigned* bar = b.bar;
        __builtin_amdgcn_s_waitcnt(0);
        unsigned nloc = b.st[0], nx = b.st[1];
        if (nloc == 0u) { xcd_barrier_complete(bar, b.x, nloc, nx); b.st[0] = nloc; b.st[1] = nx; }
        const unsigned old = xb_add(&bar[XB_XSUB(b.x)], 1u);
        const unsigned gen = old / nloc;
        if (old + 1u == (gen + 1u) * nloc) {
            __builtin_amdgcn_fence(__ATOMIC_RELEASE, "agent");
            asm volatile("s_waitcnt vmcnt(0)" ::: "memory");
            const unsigned og = xb_add(&bar[XB_TOP], 1u);
            const unsigned tg = og / nx;
            if (og + 1u == (tg + 1u) * nx) xb_add(&bar[XB_TOPGEN], 1u);
            else XB_SPIN(xb_ld(&bar[XB_TOPGEN]) == tg, bar);
            __builtin_amdgcn_fence(__ATOMIC_ACQUIRE, "agent");
            xb_add(&bar[XB_XGEN(b.x)], 1u);
            asm volatile("s_waitcnt vmcnt(0)" ::: "memory");
        } else {
            XB_SPIN(xb_ld(&bar[XB_XGEN(b.x)]) == gen, bar);
            __builtin_amdgcn_fence(__ATOMIC_ACQUIRE, "agent");
            asm volatile("s_waitcnt vmcnt(0)" ::: "memory");
        }
    }
    __syncthreads();
}


struct Args { const void* in[30]; float* out; unsigned char* ws; int ph_lo, ph_hi; };
struct Frame {
    unsigned char* lds;
    int tid, lane, wave, vcu, G, gw, NGW;
    unsigned char* ws;
};

__device__ __forceinline__ int t5_bucket(int n) {
    if (n < 16) return n < 0 ? 0 : n;
    int b = 16;
    b += (n >= 22); b += (n >= 30); b += (n >= 40); b += (n >= 54); b += (n >= 73); b += (n >= 99); b += (n >= 134); b += (n >= 182);
    b += (n >= 246); b += (n >= 332); b += (n >= 450); b += (n >= 609); b += (n >= 825); b += (n >= 1117); b += (n >= 1513);
    return b;
}

template <int MAP>
__device__ __forceinline__ void p0_transpose_item(const float* W, const float* W2, int K, int Nsrc, int Ndst, bf16* WT, const float* kscale, float* scr, int item, int lane) {
    const int nblk = Ndst / 64, kb = item / nblk, nb = item % nblk, k0 = 64 * kb, n0 = 64 * nb;
    const int n4 = (lane & 15) * 4, n = n0 + n4, kr = lane >> 4;
    const float* src = W; int sc = n; bool ok = true;
    if (MAP == 1) { if (n < Z_QLAT) sc = n; else if (n < Z_NG) sc = n + 24; else if (n < Z_NG + 24) sc = n - Z_NG + 2560; else ok = false; }
    if (MAP == 2) { const int g32 = n >> 5, w = n & 31; src = (w < 16) ? W : W2; sc = g32 * 16 + (w & 15); }
    f32x4 v[16];
#pragma unroll
    for (int i = 0; i < 16; ++i) v[i] = ok ? __builtin_nontemporal_load((const f32x4*)(src + (size_t)(k0 + 4 * i + kr) * Nsrc + sc)) : (f32x4){0.f, 0.f, 0.f, 0.f};
#pragma unroll
    for (int i = 0; i < 16; ++i) { const int kk = 4 * i + kr; f32x4 t = v[i]; if (kscale) t = t * kscale[k0 + kk]; float* d = scr + kk * 65 + n4; d[0] = t.x; d[1] = t.y; d[2] = t.z; d[3] = t.w; }
    LDS_WAIT(); asm volatile("" ::: "memory");
    const int kg = lane & 7;
#pragma unroll
    for (int p = 0; p < 8; ++p) { const int nn = 8 * p + (lane >> 3); const float* s = scr + (8 * kg) * 65 + nn;
        v4u o; o.x = pk2(s[0 * 65], s[1 * 65]); o.y = pk2(s[2 * 65], s[3 * 65]); o.z = pk2(s[4 * 65], s[5 * 65]); o.w = pk2(s[6 * 65], s[7 * 65]);
        *(v4u*)(WT + (size_t)(n0 + nn) * K + k0 + 8 * kg) = o; }
    LDS_WAIT(); asm volatile("" ::: "memory");
}
template <int MAP>
__device__ __forceinline__ void p0_transpose(Frame& F, const float* W, const float* W2, int K, int Nsrc, int Ndst, bf16* WT, const float* kscale) {
    float* scr = (float*)(F.lds + F.wave * 16640);
    const int nitems = (K / 64) * (Ndst / 64);
    for (int it = F.gw; it < nitems; it += F.NGW) p0_transpose_item<MAP>(W, W2, K, Nsrc, Ndst, WT, kscale, scr, it, F.lane);
}

__device__ __forceinline__ void modnorm_row(const float* xrow, const float* g, const float* sc, const float* sh, bf16* orow, int lane, f32x4 (&v)[8]) {
    const f32x4* xr = (const f32x4*)xrow + lane; float s = 0.f;
#pragma unroll
    for (int j = 0; j < 8; ++j) { v[j] = xr[64 * j]; s += (v[j].x * v[j].x + v[j].y * v[j].y) + (v[j].z * v[j].z + v[j].w * v[j].w); }
    const float rinv = 1.0f / sqrtf(wave_sum(s) * (1.f / D) + RMS_EPS);
    unsigned long long* o8 = (unsigned long long*)orow + lane;
#pragma unroll
    for (int j = 0; j < 8; ++j) { const f32x4 gg = ((const f32x4*)g)[lane + 64 * j], cc = ((const f32x4*)sc)[lane + 64 * j], hh = ((const f32x4*)sh)[lane + 64 * j];
        v[j] = (v[j] * rinv) * gg * (cc + 1.0f) + hh;
        o8[64 * j] = (unsigned long long)pk2(v[j].x, v[j].y) | ((unsigned long long)pk2(v[j].z, v[j].w) << 32); }
}
__device__ __forceinline__ void modnorm_phase(Frame& F, const float* x, const float* g, const float* mod  , int sh_idx, bf16* H) {
    for (int b = 0; b < NB; ++b) { const float* mb = mod + (size_t)b * 6 * D; const float* sc = mb + (size_t)(sh_idx + 1) * D; const float* sh = mb + (size_t)sh_idx * D;
        const int s0 = F.gw, s1 = F.gw + F.NGW;
        const f32x4* x0 = (const f32x4*)(x + ((size_t)b * S + s0) * D) + F.lane; const f32x4* x1 = (const f32x4*)(x + ((size_t)b * S + s1) * D) + F.lane;
        f32x4 v0[8], v1[8], ca[8], cc[8];
#pragma unroll
        for (int j = 0; j < 8; ++j) { v0[j] = x0[64 * j]; v1[j] = x1[64 * j]; }
#pragma unroll
        for (int j = 0; j < 8; ++j) { ca[j] = ((const f32x4*)g)[F.lane + 64 * j] * (((const f32x4*)sc)[F.lane + 64 * j] + 1.0f); cc[j] = ((const f32x4*)sh)[F.lane + 64 * j]; }
        float q0 = 0.f, q1 = 0.f;
#pragma unroll
        for (int j = 0; j < 8; ++j) { q0 += (v0[j].x * v0[j].x + v0[j].y * v0[j].y) + (v0[j].z * v0[j].z + v0[j].w * v0[j].w); q1 += (v1[j].x * v1[j].x + v1[j].y * v1[j].y) + (v1[j].z * v1[j].z + v1[j].w * v1[j].w); }
        const float r0 = 1.0f / sqrtf(wave_sum(q0) * (1.f / D) + RMS_EPS), r1 = 1.0f / sqrtf(wave_sum(q1) * (1.f / D) + RMS_EPS);
        unsigned long long* o0 = (unsigned long long*)(H + ((size_t)b * S + s0) * D) + F.lane; unsigned long long* o1 = (unsigned long long*)(H + ((size_t)b * S + s1) * D) + F.lane;
#pragma unroll
        for (int j = 0; j < 8; ++j) { const f32x4 a = (v0[j] * r0) * ca[j] + cc[j], c2 = (v1[j] * r1) * ca[j] + cc[j];
            o0[64 * j] = (unsigned long long)pk2(a.x, a.y) | ((unsigned long long)pk2(a.z, a.w) << 32); o1[64 * j] = (unsigned long long)pk2(c2.x, c2.y) | ((unsigned long long)pk2(c2.z, c2.w) << 32); }
    }
}

__device__ __forceinline__ float gelu_tanh(float x) { const float u = 0.7978845608028654f * (x + 0.044715f * x * x * x); return 0.5f * x * (1.0f + tanhf(u)); }

__global__ void __launch_bounds__(NWAVES * 64, 2) fwd(Args args) {
    extern __shared__ __attribute__((aligned(16))) unsigned char lds[];
    Frame F;
    F.lds = lds; F.ws = args.ws;
    F.tid = threadIdx.x; F.lane = F.tid & 63; F.wave = __builtin_amdgcn_readfirstlane(F.tid >> 6);
    F.G = gridDim.x; { const int bx = blockIdx.x; F.vcu = (F.G % 8 == 0) ? (bx % 8) * (F.G / 8) + bx / 8 : bx; }
    F.gw = F.vcu * NWAVES + F.wave; F.NGW = F.G * NWAVES;
    unsigned char* ws = args.ws;
    unsigned* ctl = (unsigned*)(ws + WS_CTL);
    volatile LAS unsigned* MISC = (volatile LAS unsigned*)((LAS unsigned char*)lds + MISC_OFF);
    for (int u = F.tid; u < 64; u += NWAVES * 64) MISC[u] = 0u;
    __syncthreads();
    XcdBarrier bar; bar.bar = ctl + CW_BAR; bar.x = 0; bar.st = nullptr;
    if (MK_N_LAUNCHES == 1) bar = xcd_barrier_post(ctl + CW_BAR, MISC + 8);
    const int lo = args.ph_lo, hi = args.ph_hi;
#define IN(k) (lo <= (k) && (k) < hi)
#define SEAM(k) do { if (IN(k) && IN((k) + 1)) xcd_barrier(bar); } while (0)

    const float* x_in = (const float*)args.in[0]; const float* c_in = (const float*)args.in[1]; const int* positions = (const int*)args.in[2];
    const float* rel_bias = (const float*)args.in[3]; const float* ada_w = (const float*)args.in[4]; const float* ada_b = (const float*)args.in[5];
    const float* mix_norm_g = (const float*)args.in[6]; const float* ffn_norm_g = (const float*)args.in[7];
    const float* ab_w_in = (const float*)args.in[8]; const float* ab_w_out = (const float*)args.in[9];
    const float* cmp_pos_k = (const float*)args.in[10]; const float* cmp_w1_k = (const float*)args.in[11]; const float* cmp_w2_k = (const float*)args.in[12];
    const float* cmp_pos_v = (const float*)args.in[13]; const float* cmp_w1_v = (const float*)args.in[14]; const float* cmp_w2_v = (const float*)args.in[15];
    const float* q_norm_g = (const float*)args.in[16]; const float* kv_norm_g = (const float*)args.in[17]; const float* w_uq = (const float*)args.in[18]; const float* w_ukv = (const float*)args.in[19];
    const float* ffn_wg = (const float*)args.in[20]; const float* ffn_wu = (const float*)args.in[21]; const float* ffn_wd = (const float*)args.in[22];
    const float* c_w_in = (const float*)args.in[23]; const float* c_w_out = (const float*)args.in[24]; const float* w_router = (const float*)args.in[25];
    const float* moe_wg = (const float*)args.in[26]; const float* moe_wu = (const float*)args.in[27]; const float* moe_wd = (const float*)args.in[28]; const float* final_g = (const float*)args.in[29];
    float* MOD = (float*)(ws + WS_MOD); float* BIAS = (float*)(ws + WS_BIAS); float* ROPE = (float*)(ws + WS_ROPE); float* RINV = (float*)(ws + WS_RINV);
    unsigned long long* SEL = (unsigned long long*)(ws + WS_SEL); bf16* KC = (bf16*)(ws + WS_KC); bf16* VC = (bf16*)(ws + WS_VC); int* ROUTE = (int*)(ws + WS_ROUTE); bf16* KPE = (bf16*)(ws + WS_KPE);
    bf16* W_IN0 = (bf16*)(ws + WS_WIN0); bf16* W_UQ = (bf16*)(ws + WS_WUQ); bf16* W_UKV = (bf16*)(ws + WS_WUKV); bf16* W_OUT0 = (bf16*)(ws + WS_WOUT0); bf16* W_GU0 = (bf16*)(ws + WS_WGU0); bf16* W_DN0 = (bf16*)(ws + WS_WDN0);
    bf16* W_IN1 = (bf16*)(ws + WS_WIN1); bf16* W_OUT1 = (bf16*)(ws + WS_WOUT1); bf16* W_MGU = (bf16*)(ws + WS_WMGU); bf16* W_MDN = (bf16*)(ws + WS_WMDN);
    float* X = (float*)(ws + WS_X); bf16* H = (bf16*)(ws + WS_H);
    bf16* Z0 = (bf16*)(ws + WS_Z0); bf16* QM = (bf16*)(ws + WS_QM); bf16* KVM = (bf16*)(ws + WS_KVM); bf16* OCMP = (bf16*)(ws + WS_OCMP); bf16* OWIN = (bf16*)(ws + WS_OWIN); bf16* CAT = (bf16*)(ws + WS_CAT);
    bf16* W1T = (bf16*)(ws + WS_W1T); bf16* W2T = (bf16*)(ws + WS_W2T); float* CB1 = (float*)(ws + WS_CB1);
    float* LSEB = (float*)(ws + WS_LSE); bf16* OP = (bf16*)(ws + WS_OP);
    bf16* ACT = (bf16*)(ws + WS_ACT); bf16* Z1 = (bf16*)(ws + WS_Z1); bf16* OM = (bf16*)(ws + WS_OM); bf16* XB = (bf16*)(ws + WS_XB); bf16* ACTB = (bf16*)(ws + WS_ACTB); bf16* YB = (bf16*)(ws + WS_YB);
    PG8_LAS unsigned char* ring = (PG8_LAS unsigned char*)lds;

    if (IN(0)) {
        for (int job = 192 + (int)blockIdx.x; job < 194; job += F.G) {
            float* red = (float*)(lds + 32768); const int c = job - 192; const float* pos = c ? cmp_pos_v : cmp_pos_k; const float* w1 = c ? cmp_w1_v : cmp_w1_k;
            float a0 = 0.f, a1 = 0.f;
#pragma unroll 8
            for (int k = 0; k < 512; ++k) { const int kk = F.wave * 512 + k; const f32x2 wv = *(const f32x2*)(w1 + (size_t)kk * 128 + 2 * F.lane); const float pv = pos[kk]; a0 += pv * wv.x; a1 += pv * wv.y; }
            red[F.wave * 128 + 2 * F.lane] = a0; red[F.wave * 128 + 2 * F.lane + 1] = a1;
            __syncthreads();
            if (F.tid < 128) { float s = 0.f;
#pragma unroll
                for (int w = 0; w < 8; ++w) s += red[w * 128 + F.tid];
                CB1[c * 128 + F.tid] = s; }
            __syncthreads();
        }
        for (int job = blockIdx.x; job < 256; job += F.G) {
            float* cs = (float*)lds; float* red = (float*)(lds + 32768);
            for (int i = F.tid; i < 4 * D; i += 512) { const float cv = c_in[i]; cs[i] = cv / (1.0f + __expf(-cv)); }
            __syncthreads();
            const int l = job >> 7, col0 = (job & 127) * 96; const bool act = F.lane < 48;
            float acc[4][2] = {};
            const float* wp = ada_w + ((size_t)l * D + (size_t)F.wave * 256) * 12288 + col0 + 2 * (act ? F.lane : 0);
#pragma unroll 8
            for (int k = 0; k < 256; ++k) { const f32x2 wv = *(const f32x2*)(wp + (size_t)k * 12288); const int kk = F.wave * 256 + k;
#pragma unroll
                for (int b = 0; b < 4; ++b) { const float cv = cs[b * D + kk]; acc[b][0] += cv * wv.x; acc[b][1] += cv * wv.y; } }
            if (act) {
#pragma unroll
                for (int b = 0; b < 4; ++b) { red[(F.wave * 4 + b) * 96 + 2 * F.lane] = acc[b][0]; red[(F.wave * 4 + b) * 96 + 2 * F.lane + 1] = acc[b][1]; } }
            __syncthreads();
            if (F.tid < 384) { const int b = F.tid / 96, cc = F.tid % 96; float s = 0.f;
#pragma unroll
              for (int w = 0; w < 8; ++w) s += red[(w * 4 + b) * 96 + cc];
              MOD[((size_t)l * 4 + b) * 12288 + col0 + cc] = s + ada_b[(size_t)l * 12288 + col0 + cc]; }
            __syncthreads();
        }
        __syncthreads();
        p0_transpose<1>(F, ab_w_in, nullptr, D, 3672, Z0W, W_IN0, nullptr);
        p0_transpose<0>(F, w_uq, nullptr, 512, QMW, QMW, W_UQ, q_norm_g);
        p0_transpose<0>(F, w_ukv, nullptr, 512, KVMW, KVMW, W_UKV, kv_norm_g);
        p0_transpose<0>(F, ab_w_out, nullptr, D, D, D, W_OUT0, nullptr);
        p0_transpose<2>(F, ffn_wg, ffn_wu, D, FF, 2 * FF, W_GU0, nullptr);
        p0_transpose<0>(F, ffn_wd, nullptr, FF, D, D, W_DN0, nullptr);
        p0_transpose<0>(F, c_w_in, nullptr, D, Z1W, Z1W, W_IN1, nullptr);
        p0_transpose<0>(F, c_w_out, nullptr, 1024, D, D, W_OUT1, nullptr);
        p0_transpose<0>(F, cmp_w1_k, nullptr, 4096, 128, 128, W1T, nullptr); p0_transpose<0>(F, cmp_w1_v, nullptr, 4096, 128, 128, W1T + 128 * 4096, nullptr);
        p0_transpose<0>(F, cmp_w2_k, nullptr, 128, 128, 128, W2T, nullptr); p0_transpose<0>(F, cmp_w2_v, nullptr, 128, 128, 128, W2T + 128 * 128, nullptr);
        for (int e = 0; e < NE; ++e) {
            p0_transpose<2>(F, moe_wg + (size_t)e * D * FFE, moe_wu + (size_t)e * D * FFE, D, FFE, 2 * FFE, W_MGU + (size_t)e * 2 * FFE * D, nullptr);
            p0_transpose<0>(F, moe_wd + (size_t)e * FFE * D, nullptr, FFE, D, D, W_MDN + (size_t)e * D * FFE, nullptr);
        }
        for (int i = F.gw * 64 + F.lane; i < 8 * BIAS_LD; i += F.NGW * 64) { const int h = i / BIAS_LD, r = i % BIAS_LD - 64; BIAS[i] = rel_bias[t5_bucket(r) * 8 + h]; }
        for (int i = F.gw * 64 + F.lane; i < M * 32; i += F.NGW * 64) { const int m = i >> 5, f = i & 31;
            const float inv_freq = powf(10000.0f, -(float)(2 * f) / 64.0f); const float ang = (float)positions[m] * inv_freq;
            ROPE[(size_t)m * 64 + f] = cosf(ang); ROPE[(size_t)m * 64 + 32 + f] = sinf(ang); }
    }
    SEAM(0);
    if (IN(1)) modnorm_phase(F, x_in, mix_norm_g, MOD, 0, H);
    SEAM(1);
    if (IN(2)) { pg8::Gemm g{H, W_IN0, D, D, D}; pg8::StaticOrder So; So.init(M, Z0W, F.G, (int)blockIdx.x); pg8::EpiBf16 E{Z0, Z0W, nullptr};
        pg8::gemm_phase<pg8::EpiBf16, pg8::StaticOrder, PG_ALIGN, PG_SP2>(ring, g, So, E); }
    SEAM(2);
    if (IN(3)) {
        for (int m = F.gw; m < M; m += F.NGW) {
            const bf16* zr = Z0 + (size_t)m * Z0W;
#pragma unroll
            for (int w = 0; w < 2; ++w) { const v4u a = *(const v4u*)(zr + (w ? Z_KVLAT : Z_QLAT) + 8 * F.lane);
                float s = bflo(a.x) * bflo(a.x) + bfhi(a.x) * bfhi(a.x) + bflo(a.y) * bflo(a.y) + bfhi(a.y) * bfhi(a.y) + bflo(a.z) * bflo(a.z) + bfhi(a.z) * bfhi(a.z) + bflo(a.w) * bflo(a.w) + bfhi(a.w) * bfhi(a.w);
                s = wave_sum(s); if (F.lane == 0) RINV[(size_t)w * M + m] = 1.0f / sqrtf(s * (1.f / 512.f) + RMS_EPS); }
            if (F.lane < 32) { const float x1 = bf2f(zr[Z_KPE + F.lane]), x2 = bf2f(zr[Z_KPE + 32 + F.lane]); const float cs = ROPE[(size_t)m * 64 + F.lane], sn = ROPE[(size_t)m * 64 + 32 + F.lane];
                KPE[(size_t)m * 64 + F.lane] = (bf16)f2bf(x1 * cs - x2 * sn); KPE[(size_t)m * 64 + 32 + F.lane] = (bf16)f2bf(x2 * cs + x1 * sn); }
        }
        __syncthreads();
        for (int job = blockIdx.x; job < 256; job += F.G) {
            typedef short bfx8 __attribute__((ext_vector_type(8)));
            const int nt = job & 15, g = (job >> 4) & 1, b = (job >> 5) & 3, c = job >> 7, n0 = nt * 16;
            const int fr = F.lane & 15, fq = F.lane >> 4; int nrow = n0 + fr; if (nrow > 254) nrow = 254;
            const bf16* arow = Z0 + ((size_t)b * S + 16 * nrow) * Z0W + Z_NKV + c * 256 + g * 128 + fq * 8;
            const bf16* w1t = W1T + (size_t)c * 128 * 4096 + (size_t)fr * 4096 + fq * 8;
            f32x4 acc[8];
#pragma unroll
            for (int i = 0; i < 8; ++i) acc[i] = (f32x4){0.f, 0.f, 0.f, 0.f};
#pragma unroll 2
            for (int ks = 0; ks < 16; ++ks) { const int kk = F.wave * 512 + ks * 32, l = kk >> 7, d0 = kk & 127;
                const bfx8 af = *(const bfx8*)(arow + (size_t)l * Z0W + d0);
#pragma unroll
                for (int i = 0; i < 8; ++i) { const bfx8 bfr = *(const bfx8*)(w1t + (size_t)i * 16 * 4096 + kk); acc[i] = __builtin_amdgcn_mfma_f32_16x16x32_bf16(af, bfr, acc[i], 0, 0, 0); } }
            float* part = (float*)lds;
#pragma unroll
            for (int i = 0; i < 8; ++i)
#pragma unroll
                for (int j = 0; j < 4; ++j) part[(F.wave * 16 + fq * 4 + j) * 128 + i * 16 + fr] = acc[i][j];
            __syncthreads();
            bf16* hid = (bf16*)(lds + 65536);
            { const int row = F.tid >> 5, c4 = (F.tid & 31) * 4; f32x4 s = *(const f32x4*)(CB1 + c * 128 + c4);
#pragma unroll
              for (int w = 0; w < 8; ++w) s += *(const f32x4*)(part + (w * 16 + row) * 128 + c4);
              *(v2u*)(hid + row * 128 + c4) = (v2u){pk2(gelu_tanh(s.x), gelu_tanh(s.y)), pk2(gelu_tanh(s.z), gelu_tanh(s.w))}; }
            __syncthreads();
            { f32x4 o4 = {0.f, 0.f, 0.f, 0.f}; const bf16* w2t = W2T + (size_t)c * 128 * 128 + (size_t)(F.wave * 16 + fr) * 128 + fq * 8;
#pragma unroll
              for (int ks = 0; ks < 4; ++ks) { const bfx8 af = *(const bfx8*)(hid + fr * 128 + ks * 32 + fq * 8); const bfx8 bfr = *(const bfx8*)(w2t + ks * 32); o4 = __builtin_amdgcn_mfma_f32_16x16x32_bf16(af, bfr, o4, 0, 0, 0); }
              bf16* outp = (c ? VC : KC) + (((size_t)b * 2 + g) * 256) * 128 + F.wave * 16 + fr;
#pragma unroll
              for (int j = 0; j < 4; ++j) { const int n = n0 + fq * 4 + j; outp[(size_t)n * 128] = n < 255 ? (bf16)f2bf(o4[j]) : (bf16)0; } }
            __syncthreads();
        }
        __syncthreads();
        for (int Lx = blockIdx.x; Lx < 512; Lx += F.G) {
            const int qb = 15 - Lx / 32, bh = Lx % 32, b = bh >> 3, h = bh & 7, g = h >> 2; const bf16* zb = Z0 + (size_t)b * S * Z0W;
            fa::Item it{}; it.Q = zb + Z_NQ + h * 128; it.qs = Z0W; it.K = zb + Z_NKV + 4 * 256 + g * 128; it.ks = Z0W; it.V = zb + Z_NKV + 5 * 256 + g * 128; it.vs = Z0W;
            it.P0 = qb * 256; it.skv = S; it.W = 512; it.bias = BIAS + (size_t)h * BIAS_LD + 64; it.bstep = 1; it.O = OWIN + (size_t)b * S * 1024 + h * 128; it.os = 1024;
            fa::attn_block<0>(it, lds);
        }
    }
    SEAM(3);
    if (IN(4)) {
        { pg8::Gemm g{Z0 + Z_QLAT, W_UQ, Z0W, 512, 512}; pg8::StaticOrder So; So.init(M, QMW, F.G, (int)blockIdx.x); pg8::EpiBf16 E{QM, QMW, RINV};
          pg8::gemm_phase<pg8::EpiBf16, pg8::StaticOrder, PG_ALIGN, PG_SP2>(ring, g, So, E); }
        __syncthreads();
        { pg8::Gemm g{Z0 + Z_KVLAT, W_UKV, Z0W, 512, 512}; pg8::StaticOrder So; So.init(M, KVMW, F.G, (int)blockIdx.x); pg8::EpiBf16 E{KVM, KVMW, RINV + M};
          pg8::gemm_phase<pg8::EpiBf16, pg8::StaticOrder, PG_ALIGN, PG_SP2>(ring, g, So, E); }
        __syncthreads();
        for (int Lx = blockIdx.x; Lx < 512; Lx += F.G) { const int tb = 63 - Lx / 8, bg = Lx % 8, b = bg >> 1, g = bg & 1;
            fa::CmpItem it; it.Q = Z0 + ((size_t)b * S + tb * 64) * Z0W + Z_NQ + g * 512; it.qs = Z0W; it.K = KC + ((size_t)b * 2 + g) * 256 * 128; it.V = VC + ((size_t)b * 2 + g) * 256 * 128;
            it.bias = BIAS + (size_t)(g * 4) * BIAS_LD + 64; it.bld = BIAS_LD; it.s0 = tb * 64; it.O = OCMP + ((size_t)b * S + tb * 64) * 1024 + g * 512; it.os = 1024; it.sel = SEL + ((size_t)b * S + tb * 64) * 2 + g;

            fa::cmp_block(it, lds, SMALL_OFF); }
    }
    SEAM(4);
    if (IN(5)) {
        for (int Lx = blockIdx.x; Lx < 256; Lx += F.G) {
            const int x = Lx / 32, bh = Lx % 32, b = bh >> 3, h = bh & 7, g = h >> 2; const bf16* zb = Z0 + (size_t)b * S * Z0W;
            for (int pass = 0; pass < 2; ++pass) { const int qb = pass ? 15 - x : x;
                fa::Item it{}; it.Q = zb + Z_NQ + h * 128; it.qs = Z0W; it.K = zb + Z_NKV + 2 * 256 + g * 128; it.ks = Z0W; it.V = zb + Z_NKV + 3 * 256 + g * 128; it.vs = Z0W;
                it.P0 = qb * 256; it.skv = S; it.W = 1 << 20; it.bias = BIAS + (size_t)h * BIAS_LD + 64; it.bstep = 1; it.sel = SEL + (size_t)b * S * 2 + g; it.sels = 2;
                it.O = CAT + (size_t)b * S * 2048 + h * 128; it.os = 2048;
                it.M0 = OCMP + (size_t)b * S * 1024 + h * 128; it.M1 = OWIN + (size_t)b * S * 1024 + h * 128; it.ms = 1024; it.G = zb + Z_NG + h * 3; it.gs = Z0W;
                fa::attn_block<1>(it, lds); }
        }
        for (int Lx = blockIdx.x; Lx < 256; Lx += F.G) {
            const int x = Lx / 32, bh = Lx % 32, b = bh >> 3, h = bh & 7;
            for (int pass = 0; pass < 2; ++pass) { const int qb = pass ? 15 - x : x;
                fa::Item it{}; it.Q = QM + (size_t)b * S * QMW + h * 192; it.qs = QMW; it.rope = ROPE + (size_t)b * S * 64; it.ropes = 64;
                it.K = KVM + (size_t)b * S * KVMW + h * 256; it.ks = KVMW; it.K2 = KPE + (size_t)b * S * 64; it.k2s = 64; it.V = KVM + (size_t)b * S * KVMW + h * 256 + 128; it.vs = KVMW;
                it.P0 = qb * 256; it.skv = S; it.W = 1 << 20; it.O = CAT + (size_t)b * S * 2048 + 1024 + h * 128; it.os = 2048;
                fa::attn_block<2>(it, lds); }
        }
    }
    SEAM(5);
    if (IN(6)) { pg8::Gemm g{CAT, W_OUT0, 2048, 2048, 2048}; pg8::StaticOrder So; So.init(M, D, F.G, (int)blockIdx.x); pg8::EpiResid E{x_in, X, D, MOD + 2 * D, 6 * D, S / 256};
        pg8::gemm_phase<pg8::EpiResid, pg8::StaticOrder, PG_ALIGN, PG_SP2>(ring, g, So, E); }
    SEAM(6);
    if (IN(7)) modnorm_phase(F, X, ffn_norm_g, MOD, 3, H);
    SEAM(7);
    if (IN(8)) { pg8::Gemm g{H, W_GU0, D, D, D}; pg8::StaticOrder So; So.init(M, 2 * FF, F.G, (int)blockIdx.x); pg8::EpiSwiGLU E{ACT, FF};
        pg8::gemm_phase<pg8::EpiSwiGLU, pg8::StaticOrder, PG_ALIGN, PG_SP2>(ring, g, So, E); }
    SEAM(8);
    if (IN(9)) { pg8::Gemm g{ACT, W_DN0, FF, FF, FF}; pg8::StaticOrder So; So.init(M, D, F.G, (int)blockIdx.x); pg8::EpiResid E{X, X, D, MOD + 5 * D, 6 * D, S / 256};
        pg8::gemm_phase<pg8::EpiResid, pg8::StaticOrder, PG_ALIGN, PG_SP2>(ring, g, So, E); }
    SEAM(9);
    if (IN(10)) modnorm_phase(F, X, mix_norm_g + D, MOD + 4 * 12288, 0, H);
    SEAM(10);
    if (IN(11)) { pg8::Gemm g{H, W_IN1, D, D, D}; pg8::StaticOrder So; So.init(M, Z1W, F.G, (int)blockIdx.x); pg8::EpiBf16 E{Z1, Z1W, nullptr};
        pg8::gemm_phase<pg8::EpiBf16, pg8::StaticOrder, PG_ALIGN, PG_SP2>(ring, g, So, E); }
    SEAM(11);
    if (IN(12)) {
        for (int Lx = blockIdx.x; Lx < 1536; Lx += F.G) {
            const int p = Lx % 3, r_ = Lx / 3, bh = r_ % 32, sub = r_ / 32, b = bh >> 3, h = bh & 7;
            const int dil = p == 0 ? 1 : (p == 1 ? 4 : 16), res = p == 0 ? 0 : (p == 1 ? (sub & 3) : sub), qb = p == 0 ? sub : (p == 1 ? (sub >> 2) : 0);
            fa::Item it{}; it.Q = Z1 + ((size_t)b * S + res) * Z1W + p * 3072 + h * 128; it.qs = (long)dil * Z1W; it.K = it.Q + 1024; it.ks = it.qs; it.V = it.Q + 2048; it.vs = it.qs;
            it.P0 = qb * 256; it.skv = S / dil; it.W = 129; it.bias = BIAS + (size_t)h * BIAS_LD + 64; it.bstep = dil;
            it.O = OP + (size_t)p * M * 1024 + ((size_t)b * S + res) * 1024 + h * 128; it.os = (long)dil * 1024; it.LSE = LSEB + (size_t)p * M * 8 + ((size_t)b * S + res) * 8 + h; it.lses = (long)dil * 8;
            fa::attn_block<0>(it, lds);
        }
    }
    SEAM(12);
    if (IN(13)) {
        for (int m = F.gw; m < M; m += F.NGW) {
#pragma unroll 2
            for (int h = 0; h < 8; ++h) { const float l0 = LSEB[(size_t)m * 8 + h], l1 = LSEB[(size_t)(M + m) * 8 + h], l2 = LSEB[(size_t)(2 * M + m) * 8 + h];
                const float mx = fmaxf(l0, fmaxf(l1, l2)), e0 = __expf(l0 - mx), e1 = __expf(l1 - mx), e2 = __expf(l2 - mx), inv = 1.0f / (e0 + e1 + e2);
                const unsigned a0 = *(const unsigned*)(OP + (size_t)m * 1024 + h * 128 + 2 * F.lane), a1 = *(const unsigned*)(OP + (size_t)(M + m) * 1024 + h * 128 + 2 * F.lane), a2 = *(const unsigned*)(OP + (size_t)(2 * M + m) * 1024 + h * 128 + 2 * F.lane);
                *(unsigned*)(OM + (size_t)m * 1024 + h * 128 + 2 * F.lane) = pk2((e0 * bflo(a0) + e1 * bflo(a1) + e2 * bflo(a2)) * inv, (e0 * bfhi(a0) + e1 * bfhi(a1) + e2 * bfhi(a2)) * inv); }
        }
    }
    SEAM(13);
    if (IN(14)) { pg8::Gemm g{OM, W_OUT1, 1024, 1024, 1024}; pg8::StaticOrder So; So.init(M, D, F.G, (int)blockIdx.x); pg8::EpiResid E{X, X, D, MOD + 4 * 12288 + 2 * D, 6 * D, S / 256};
        pg8::gemm_phase<pg8::EpiResid, pg8::StaticOrder, PG_ALIGN, PG_SP2>(ring, g, So, E); }
    SEAM(14);
    if (IN(15)) {
        for (int m = F.gw; m < M; m += F.NGW) { const int b = m / S; const float* mb = MOD + 4 * 12288 + (size_t)b * 6 * D; f32x4 v[8];
            modnorm_row(X + (size_t)m * D, ffn_norm_g + D, mb + 4 * D, mb + 3 * D, H + (size_t)m * D, F.lane, v);
            float lg[8] = {};
#pragma unroll
            for (int j = 0; j < 8; ++j) { const float* wr_ = w_router + (size_t)(4 * F.lane + 256 * j) * 8;
#pragma unroll
                for (int q = 0; q < 4; ++q) { const f32x4 wa = *(const f32x4*)(wr_ + q * 8), wb = *(const f32x4*)(wr_ + q * 8 + 4); const float hv = v[j][q];
                    lg[0] += hv * wa.x; lg[1] += hv * wa.y; lg[2] += hv * wa.z; lg[3] += hv * wa.w; lg[4] += hv * wb.x; lg[5] += hv * wb.y; lg[6] += hv * wb.z; lg[7] += hv * wb.w; } }
#pragma unroll
            for (int e = 0; e < 8; ++e) lg[e] = wave_sum(lg[e]);
            int e1 = 0; float v1 = lg[0];
#pragma unroll
            for (int e = 1; e < 8; ++e) if (lg[e] > v1) { v1 = lg[e]; e1 = e; }
            int e2 = -1; float v2 = -3.0e38f;
#pragma unroll
            for (int e = 0; e < 8; ++e) if (e != e1 && lg[e] > v2) { v2 = lg[e]; e2 = e; }
            if (F.lane == 0) { const float g1 = 1.0f / (1.0f + __expf(v2 - v1)), g2 = 1.0f - g1;
                const unsigned r1 = atomicAdd(ctl + CW_CNT + e1, 1u), r2 = atomicAdd(ctl + CW_CNT + e2, 1u);
                int* rt = ROUTE + (size_t)m * 8; rt[0] = e1; rt[1] = e2; rt[2] = (int)r1; rt[3] = (int)r2; rt[4] = __float_as_int(g1); rt[5] = __float_as_int(g2); }
        }
    }
    SEAM(15);
    if (IN(16)) {
        unsigned ts[9]; ts[0] = 0;
#pragma unroll
        for (int e = 0; e < 8; ++e) ts[e + 1] = ts[e] + (__hip_atomic_load(ctl + CW_CNT + e, __ATOMIC_RELAXED, __HIP_MEMORY_SCOPE_AGENT) + 255u) / 256u;
        if (blockIdx.x == 0 && F.tid < 9) { unsigned v = ts[0];
#pragma unroll
            for (int e = 1; e < 9; ++e) v = (F.tid == e) ? ts[e] : v;
            ctl[CW_TS + F.tid] = v; }
        for (int m = F.gw; m < M; m += F.NGW) { const int* rt = ROUTE + (size_t)m * 8; const int e1 = rt[0], e2 = rt[1]; unsigned t1 = 0, t2 = 0;
#pragma unroll
            for (int e = 0; e < 8; ++e) { t1 = (e == e1) ? ts[e] : t1; t2 = (e == e2) ? ts[e] : t2; }
            const size_t d1 = (size_t)t1 * 256 + rt[2], d2 = (size_t)t2 * 256 + rt[3];
            const v4u* src = (const v4u*)(H + (size_t)m * D) + F.lane; v4u* o1 = (v4u*)(XB + d1 * D) + F.lane; v4u* o2 = (v4u*)(XB + d2 * D) + F.lane;
#pragma unroll
            for (int j = 0; j < 4; ++j) { const v4u w = src[64 * j]; o1[64 * j] = w; o2[64 * j] = w; } }
    }
    SEAM(16);
    if (IN(17)) { pg8::Gemm g{XB, W_MGU, D, D, D}; pg8::GroupedOrder So; So.init(ctl + CW_TS, 2 * FFE / 256, F.G, (int)blockIdx.x); pg8::EpiSwiGLU E{ACTB, FFE};
        pg8::gemm_phase<pg8::EpiSwiGLU, pg8::GroupedOrder, PG_ALIGN, PG_SP2>(ring, g, So, E); }
    SEAM(17);
    if (IN(18)) { pg8::Gemm g{ACTB, W_MDN, FFE, FFE, FFE}; pg8::GroupedOrder So; So.init(ctl + CW_TS, D / 256, F.G, (int)blockIdx.x); pg8::EpiBf16 E{YB, D, nullptr};
        pg8::gemm_phase<pg8::EpiBf16, pg8::GroupedOrder, PG_ALIGN, PG_SP2>(ring, g, So, E); }
    SEAM(18);
    if (IN(19)) {
        unsigned ts[9]; ts[0] = 0;
#pragma unroll
        for (int e = 0; e < 8; ++e) ts[e + 1] = ctl[CW_TS + e + 1];
#pragma unroll
        for (int b = 0; b < NB; ++b) {
            const float* gf = MOD + 4 * 12288 + (size_t)b * 6 * D + 5 * D;
            const int m0 = b * S + F.gw, m1 = m0 + F.NGW;
            const int* rt0 = ROUTE + (size_t)m0 * 8; const int* rt1 = ROUTE + (size_t)m1 * 8;
            const int e10 = rt0[0], e20 = rt0[1], r10 = rt0[2], r20 = rt0[3], e11 = rt1[0], e21 = rt1[1], r11 = rt1[2], r21 = rt1[3];
            const float g10 = __int_as_float(rt0[4]), g20 = __int_as_float(rt0[5]), g11 = __int_as_float(rt1[4]), g21 = __int_as_float(rt1[5]);
            unsigned t10 = 0, t20 = 0, t11 = 0, t21 = 0;
#pragma unroll
            for (int e = 0; e < 8; ++e) { t10 = (e == e10) ? ts[e] : t10; t20 = (e == e20) ? ts[e] : t20; t11 = (e == e11) ? ts[e] : t11; t21 = (e == e21) ? ts[e] : t21; }
            const v2u* ya0 = (const v2u*)(YB + ((size_t)t10 * 256 + r10) * D) + F.lane; const v2u* yb0 = (const v2u*)(YB + ((size_t)t20 * 256 + r20) * D) + F.lane;
            const v2u* ya1 = (const v2u*)(YB + ((size_t)t11 * 256 + r11) * D) + F.lane; const v2u* yb1 = (const v2u*)(YB + ((size_t)t21 * 256 + r21) * D) + F.lane;
            const f32x4* x0 = (const f32x4*)(X + (size_t)m0 * D) + F.lane; const f32x4* x1 = (const f32x4*)(X + (size_t)m1 * D) + F.lane;
            f32x4 v0[8], v1[8]; v2u a0[8], c0[8], a1[8], c1[8];
#pragma unroll
            for (int j = 0; j < 8; ++j) { v0[j] = x0[64 * j]; v1[j] = x1[64 * j]; a0[j] = ya0[64 * j]; c0[j] = yb0[64 * j]; a1[j] = ya1[64 * j]; c1[j] = yb1[64 * j]; }
            float q0 = 0.f, q1 = 0.f;
#pragma unroll
            for (int j = 0; j < 8; ++j) { const f32x4 gg = ((const f32x4*)gf)[F.lane + 64 * j]; f32x4 y;
                y.x = g10 * bflo(a0[j].x) + g20 * bflo(c0[j].x); y.y = g10 * bfhi(a0[j].x) + g20 * bfhi(c0[j].x); y.z = g10 * bflo(a0[j].y) + g20 * bflo(c0[j].y); y.w = g10 * bfhi(a0[j].y) + g20 * bfhi(c0[j].y);
                v0[j] = v0[j] + gg * y; q0 += (v0[j].x * v0[j].x + v0[j].y * v0[j].y) + (v0[j].z * v0[j].z + v0[j].w * v0[j].w);
                y.x = g11 * bflo(a1[j].x) + g21 * bflo(c1[j].x); y.y = g11 * bfhi(a1[j].x) + g21 * bfhi(c1[j].x); y.z = g11 * bflo(a1[j].y) + g21 * bflo(c1[j].y); y.w = g11 * bfhi(a1[j].y) + g21 * bfhi(c1[j].y);
                v1[j] = v1[j] + gg * y; q1 += (v1[j].x * v1[j].x + v1[j].y * v1[j].y) + (v1[j].z * v1[j].z + v1[j].w * v1[j].w); }
            const float ri0 = 1.0f / sqrtf(wave_sum(q0) * (1.f / D) + RMS_EPS), ri1 = 1.0f / sqrtf(wave_sum(q1) * (1.f / D) + RMS_EPS);
            f32x4* o0 = (f32x4*)(args.out + (size_t)m0 * D) + F.lane; f32x4* o1 = (f32x4*)(args.out + (size_t)m1 * D) + F.lane;
#pragma unroll
            for (int j = 0; j < 8; ++j) { const f32x4 fg = ((const f32x4*)final_g)[F.lane + 64 * j]; o0[64 * j] = (v0[j] * ri0) * fg; o1[64 * j] = (v1[j] * ri1) * fg; }
        }
    }
#undef IN
#undef SEAM
}

constexpr int N_PHASES = 20;
extern "C" void kernel_launch(void* const* d_in, const int* in_sizes, int n_in, void* d_out, int out_size, void* d_ws, size_t ws_size, hipStream_t stream) {
    static int grid = 0;
    if (grid == 0) {
        if (n_in != 30 || in_sizes[0] != M * D || out_size != M * D || ws_size < WS_END) { fprintf(stderr, "kernel_launch: shape/workspace mismatch: n_in %d in0 %d out %d ws %zu (need %zu)\n", n_in, n_in > 0 ? in_sizes[0] : -1, out_size, ws_size, (size_t)WS_END); grid = -1; return; }
        int dev = 0, cus = 0, per_cu = 0;
        if (hipGetDevice(&dev) != hipSuccess || hipDeviceGetAttribute(&cus, hipDeviceAttributeMultiprocessorCount, dev) != hipSuccess) { grid = -1; return; }
        if (hipFuncSetAttribute((const void*)fwd, hipFuncAttributeMaxDynamicSharedMemorySize, LDS_BYTES) != hipSuccess) { fprintf(stderr, "kernel_launch: hipFuncSetAttribute failed\n"); grid = -1; return; }
        if (hipOccupancyMaxActiveBlocksPerMultiprocessor(&per_cu, (const void*)fwd, NWAVES * 64, LDS_BYTES) != hipSuccess || per_cu < 1) fprintf(stderr, "kernel_launch: occupancy query reports %d\n", per_cu);
        (void)hipGetLastError();
        grid = cus;
        if (grid != 256) { fprintf(stderr, "kernel_launch: built for a 256-CU device (got %d)\n", cus); grid = -1; return; }
    }
    if (grid < 0) return;
    if (hipMemsetAsync((char*)d_ws + WS_CTL, 0, CTL_ZERO_BYTES, stream) != hipSuccess) return;
    Args a{};
    for (int i = 0; i < 30; ++i) a.in[i] = d_in[i];
    a.out = (float*)d_out; a.ws = (unsigned char*)d_ws;
    if (MK_N_LAUNCHES == 1) { a.ph_lo = 0; a.ph_hi = N_PHASES; hipLaunchKernelGGL(fwd, dim3(grid), dim3(NWAVES * 64), LDS_BYTES, stream, a); }
    else { for (int p = 0; p < N_PHASES; ++p) { a.ph_lo = p; a.ph_hi = p + 1; hipLaunchKernelGGL(fwd, dim3(grid), dim3(NWAVES * 64), LDS_BYTES, stream, a); } }
    const hipError_t le = hipPeekAtLastError();
    if (le != hipSuccess) fprintf(stderr, "kernel_launch: launch failed: %s\n", hipGetErrorName(le));
}
```

```cpp
#include <hip/hip_runtime.h>
#include <cstdio>
#include <cstdint>

#define FLASH_WIN 1
#define FLASH_SLC 1
#define FLASH_MLA 1
#define FLASH_DIL 1
#define PROBE_MASK 0
#define FLASH_CMP 1
#define WGM_G 4
#define PG_ALIGN true
#define PG_SP2 true
#define MOE_F8 1
#ifndef MK_N_LAUNCHES
#define MK_N_LAUNCHES 1
#endif

namespace pg8 {
#define PG8_LAS __attribute__((address_space(3)))
typedef unsigned short bf16_t;
typedef short bf16x8 __attribute__((ext_vector_type(8)));
typedef float f32x4 __attribute__((ext_vector_type(4)));
typedef float f32x2 __attribute__((ext_vector_type(2)));
typedef unsigned u32x4 __attribute__((ext_vector_type(4)));
typedef unsigned u32x2 __attribute__((ext_vector_type(2)));
constexpr int BM = 256, BK = 64, HALF = 128, HTB = HALF * BK * 2  , STAGE_BYTES = 8 * HTB, NXCD = 8, WGM = 8;

__host__ __device__ __forceinline__ int lds_byte(int r, int c) { const int st = (r >> 4) * 2 + (c >> 5), rr = r & 15, cc = c & 31, ob = rr * 64 + cc * 2; return st * 1024 + (ob ^ (((ob >> 9) & 1) << 5)); }
__host__ __device__ __forceinline__ void stage_rc(int b, int& R, int& C) { const int st = b / 1024, sb = b % 1024, swz = sb ^ (((sb >> 9) & 1) << 5); R = (st >> 1) * 16 + swz / 64; C = (st & 1) * 32 + (swz % 64) / 2; }
__host__ __device__ __forceinline__ int perm32(int rho) { const int n = rho >> 4, i = rho & 15; return 8 * (i >> 2) + 4 * n + (i & 3); }

struct Unit { int pm, pn, pb; };
struct Gemm { const bf16_t* A; const bf16_t* Bt; int lda, ldb, K; };

struct StaticOrder {
    int nM, nN, nwg, G, c;
    __host__ __device__ void init(int M, int N, int G_, int c_) { nM = M / BM; nN = N / BM; nwg = nM * nN; G = G_; c = c_; }
    __host__ __device__ bool next(int i, Unit& u) const {
        const long L = (long)i * G + c; if (L >= nwg) return false;
        int wgid = (int)L; { const int q = nwg / NXCD, r = nwg % NXCD, xcd = wgid % NXCD, off = wgid / NXCD; wgid = (xcd < r ? xcd * (q + 1) : r * (q + 1) + (xcd - r) * q) + off; }
        const int nig = WGM * nN, gid = wgid / nig, fm = gid * WGM, gsz = (nM - fm) < WGM ? (nM - fm) : WGM;
        u.pm = fm + ((wgid % nig) % gsz); u.pn = (wgid % nig) / gsz; u.pb = u.pn; return true;
    }
    __device__ __forceinline__ void a_ready(const Unit&) const {}
    __device__ __forceinline__ void done(const Unit&) const {}
};
#ifndef WGM_G
#define WGM_G 8
#endif
struct GroupedOrder {
    int nN, G, c; int ts[9];
    __device__ __forceinline__ void init(const unsigned* tstart, int nN_, int G_, int c_) { nN = nN_; G = G_; c = c_;
#pragma unroll
        for (int e = 0; e < 9; ++e) ts[e] = (int)tstart[e]; }
    __device__ __forceinline__ bool next(int i, Unit& u) const {
        const long L = (long)i * G + c; if (L >= (long)ts[8] * nN) return false;
        int e = 0, us = 0, te = ts[1] - ts[0], t0 = ts[0];
#pragma unroll
        for (int k = 1; k < 8; ++k) { const int s = ts[k] * nN; if (L >= s) { e = k; us = s; te = ts[k + 1] - ts[k]; t0 = ts[k]; } }
        if (te <= 0) return false;
        int wgid = (int)L - us; { const int nwg = te * nN, q = nwg / NXCD, rr = nwg % NXCD, xcd = wgid % NXCD, off = wgid / NXCD; wgid = (xcd < rr ? xcd * (q + 1) : rr * (q + 1) + (xcd - rr) * q) + off; }
        const int nig = WGM_G * nN, gid = wgid / nig, fm = gid * WGM_G, gsz = (te - fm) < WGM_G ? (te - fm) : WGM_G;
        u.pm = t0 + fm + ((wgid % nig) % gsz); u.pn = (wgid % nig) / gsz; u.pb = e * nN + u.pn; return true;
    }
    __device__ __forceinline__ void a_ready(const Unit&) const {}
    __device__ __forceinline__ void done(const Unit&) const {}
};

typedef __bf16 bf16x2c __attribute__((ext_vector_type(2)));
__device__ __forceinline__ unsigned cvt_pk_bf16(float lo, float hi) { const f32x2 v = {lo, hi}; return __builtin_bit_cast(unsigned, __builtin_convertvector(v, bf16x2c)); }

struct EpiBf16 {
    static constexpr bool PERM = true, AFTER_DRAIN = false;
    bf16_t* O; int ldc; const float* rowscale;
    __device__ __forceinline__ void operator()(const f32x4 (&acc)[2][2][4][2], const Unit& u, int wr, int wc, int fr, int fq) const {
        const int row0 = u.pm * BM + wr * 64 + fr; const int col0 = u.pn * BM + wc * 32 + 8 * fq;
#pragma unroll
        for (int ai = 0; ai < 2; ++ai)
#pragma unroll
            for (int m = 0; m < 4; ++m) { const int row = row0 + ai * HALF + m * 16; bf16_t* rowp = O + (size_t)row * ldc + col0; const float sc = rowscale ? rowscale[row] : 1.f;
#pragma unroll
                for (int bj = 0; bj < 2; ++bj) { f32x4 v0 = acc[ai][bj][m][0] * sc, v1 = acc[ai][bj][m][1] * sc;
                    u32x4 w; w.x = cvt_pk_bf16(v0[0], v0[1]); w.y = cvt_pk_bf16(v0[2], v0[3]); w.z = cvt_pk_bf16(v1[0], v1[1]); w.w = cvt_pk_bf16(v1[2], v1[3]);
                    *(u32x4*)(rowp + bj * HALF) = w; } }
    }
};
struct EpiResid {
    static constexpr bool PERM = false, AFTER_DRAIN = false;
    const float* xin; float* xout; int ldc; const float* gate; int gstride; int tiles_per_b;
    __device__ __forceinline__ void operator()(const f32x4 (&acc)[2][2][4][2], const Unit& u, int wr, int wc, int fr, int fq) const {
        const int row0 = u.pm * BM + wr * 64 + fr, col0 = u.pn * BM + wc * 32 + 4 * fq;
        const float* gp = gate + (size_t)(u.pm / tiles_per_b) * gstride + col0;
        f32x4 gv[2][2];
#pragma unroll
        for (int bj = 0; bj < 2; ++bj)
#pragma unroll
            for (int n = 0; n < 2; ++n) gv[bj][n] = *(const f32x4*)(gp + bj * HALF + n * 16);
#pragma unroll
        for (int ai = 0; ai < 2; ++ai)
#pragma unroll
            for (int m = 0; m < 4; ++m) { const size_t off = (size_t)(row0 + ai * HALF + m * 16) * ldc + col0;
#pragma unroll
                for (int bj = 0; bj < 2; ++bj)
#pragma unroll
                    for (int n = 0; n < 2; ++n) { const f32x4 xi = *(const f32x4*)(xin + off + bj * HALF + n * 16);
                        *(f32x4*)(xout + off + bj * HALF + n * 16) = xi + gv[bj][n] * acc[ai][bj][m][n]; }
                asm volatile("" ::: "memory"); }
    }
};
__device__ __forceinline__ float silu_f(float g) { return g * __builtin_amdgcn_rcpf(1.0f + __builtin_amdgcn_exp2f(-1.4426950408889634f * g)); }
struct EpiSwiGLU {
    static constexpr bool PERM = false, AFTER_DRAIN = false;
    bf16_t* O; int ldo;
    __device__ __forceinline__ void operator()(const f32x4 (&acc)[2][2][4][2], const Unit& u, int wr, int wc, int fr, int fq) const {
        const int row0 = u.pm * BM + wr * 64 + fr, col0 = u.pn * HALF + wc * 16 + 4 * fq;
#pragma unroll
        for (int ai = 0; ai < 2; ++ai)
#pragma unroll
            for (int m = 0; m < 4; ++m) { bf16_t* rowp = O + (size_t)(row0 + ai * HALF + m * 16) * ldo + col0;
#pragma unroll
                for (int bj = 0; bj < 2; ++bj) { const f32x4 g = acc[ai][bj][m][0], up = acc[ai][bj][m][1];
                    u32x2 w; w.x = cvt_pk_bf16(silu_f(g[0]) * up[0], silu_f(g[1]) * up[1]); w.y = cvt_pk_bf16(silu_f(g[2]) * up[2], silu_f(g[3]) * up[3]);
                    *(u32x2*)(rowp + bj * 64) = w; } }
    }
};
struct EpiSwiGLUH {
    static constexpr bool PERM = false, AFTER_DRAIN = false;
    bf16_t* O; int ldo; float s;
    __device__ __forceinline__ void operator()(const f32x4 (&acc)[2][2][4][2], const Unit& u, int wr, int wc, int fr, int fq) const {
        const int row0 = u.pm * BM + wr * 64 + fr, col0 = u.pn * 64 + wc * 16 + 4 * fq;
#pragma unroll
        for (int ai = 0; ai < 2; ++ai)
#pragma unroll
            for (int m = 0; m < 4; ++m) { bf16_t* rowp = O + (size_t)(row0 + ai * HALF + m * 16) * ldo + col0;
#pragma unroll
                for (int bj = 0; bj < 1; ++bj) { const f32x4 g = acc[ai][bj][m][0] * s, up = acc[ai][bj][m][1] * s;
                    u32x2 w; w.x = cvt_pk_bf16(silu_f(g[0]) * up[0], silu_f(g[1]) * up[1]); w.y = cvt_pk_bf16(silu_f(g[2]) * up[2], silu_f(g[3]) * up[3]);
                    *(u32x2*)(rowp + bj * 64) = w; } }
    }
};

template <class Epi, class Sched, bool ALIGN_EPI = false, bool SP2 = false, bool F8 = false>
__device__ __forceinline__ void gemm_phase(PG8_LAS unsigned char* lds, const Gemm g, const Sched& S, const Epi& E) {
    const int tid = threadIdx.x, wid = __builtin_amdgcn_readfirstlane(tid >> 6), lane = tid & 63, wr = wid >> 2, wc = wid & 3, fr = lane & 15, fq = lane >> 4;
    const int K = g.K, nt = K / BK;
    unsigned voffA[2], voffB[2];
#pragma unroll
    for (int i = 0; i < 2; ++i) { int R, C; stage_rc(tid * 16 + i * 8192, R, C); const int Rb = Epi::PERM ? ((R & ~31) + perm32(R & 31)) : R;
        voffA[i] = (unsigned)(R * g.lda + C) * 2u; voffB[i] = (unsigned)(Rb * g.ldb + C) * 2u; }
    const size_t kstep = (size_t)(BK * 2);
    const size_t hstepA = (size_t)HALF * g.lda * 2, hstepB = (size_t)HALF * g.ldb * 2;
    const size_t tstepA = 2 * hstepA, tstepB = F8 ? hstepB : 2 * hstepB;
    const unsigned ldsw = (unsigned)wid * 1024u;
    const int aoff = lds_byte(wr * 64 + fr, fq * 8), boff = lds_byte(wc * 32 + fr, fq * 8);
#define PG8_SA(b, h) (((b) * 2 + (h)) * HTB)
#define PG8_SB(b, h) ((4 + (b) * 2 + (h)) * HTB)
#define PG8_STAGE(bufoff, gbase, voff) do { _Pragma("unroll") for (int _i = 0; _i < 2; ++_i) \
        __builtin_amdgcn_global_load_lds((const unsigned*)((const char*)(gbase) + (voff)[_i]), (PG8_LAS unsigned*)(lds + (bufoff) + ldsw + _i * 8192), 16, 0, 0); } while (0)
#define PG8_LDA(dst, b, h) do { _Pragma("unroll") for (int m = 0; m < 4; ++m) _Pragma("unroll") for (int k = 0; k < 2; ++k) dst[m][k] = *(const PG8_LAS bf16x8*)(lds + PG8_SA(b, h) + aoff + m * 2048 + k * 1024); } while (0)
#define PG8_LDB(dst, b, h) do { if constexpr (!F8 || (h) == 0) { _Pragma("unroll") for (int n = 0; n < 2; ++n) _Pragma("unroll") for (int k = 0; k < 2; ++k) dst[n][k] = *(const PG8_LAS bf16x8*)(lds + PG8_SB(b, h) + boff + n * 2048 + k * 1024); } } while (0)
#define PG8_CAT(x, y) __builtin_shufflevector(x, y, 0, 1, 2, 3, 4, 5, 6, 7, 8, 9, 10, 11, 12, 13, 14, 15)
#define PG8_MMA(ai, bj, At, Bt) do { if constexpr (!F8 || (bj) == 0) { __builtin_amdgcn_s_setprio(1); \
        if constexpr (F8) { _Pragma("unroll") for (int m = 0; m < 4; ++m) _Pragma("unroll") for (int n = 0; n < 2; ++n) \
            acc[ai][bj][m][n] = __builtin_amdgcn_mfma_scale_f32_16x16x128_f8f6f4(__builtin_bit_cast(v8i_, PG8_CAT(Bt[n][0], Bt[n][1])), __builtin_bit_cast(v8i_, PG8_CAT(At[m][0], At[m][1])), acc[ai][bj][m][n], 0, 0, 0, 0x7f7f7f7f, 0, 0x7f7f7f7f); } \
        else { _Pragma("unroll") for (int m = 0; m < 4; ++m) _Pragma("unroll") for (int n = 0; n < 2; ++n) _Pragma("unroll") for (int k = 0; k < 2; ++k) \
            acc[ai][bj][m][n] = __builtin_amdgcn_mfma_f32_16x16x32_bf16(Bt[n][k], At[m][k], acc[ai][bj][m][n], 0, 0, 0); } \
        __builtin_amdgcn_s_setprio(0); } } while (0)
#define PG8_WAIT_V(n) asm volatile("s_waitcnt vmcnt(" #n ")" ::: "memory")
#define PG8_WAIT_L(n) asm volatile("s_waitcnt lgkmcnt(" #n ")" ::: "memory")
#define PG8_BAR __builtin_amdgcn_s_barrier()
#define PG8_SCHED __builtin_amdgcn_sched_barrier(0)
    Unit cur, nxt; int ui = 0;
    if (!S.next(0, cur)) return;
    f32x4 acc[2][2][4][2];
#pragma unroll
    for (int a = 0; a < 2; ++a)
#pragma unroll
        for (int b = 0; b < 2; ++b)
#pragma unroll
            for (int m = 0; m < 4; ++m)
#pragma unroll
                for (int n = 0; n < 2; ++n) acc[a][b][m][n] = (f32x4){0.f, 0.f, 0.f, 0.f};
    bf16x8 At[4][2], B0[2][2], B1[2][2];
    typedef int v8i_ __attribute__((ext_vector_type(8))); typedef short bf16x16_ __attribute__((ext_vector_type(16)));
    const char* cA = (const char*)g.A + (size_t)cur.pm * tstepA; const char* cB = (const char*)g.Bt + (size_t)cur.pb * tstepB;
    S.a_ready(cur);
    if constexpr (SP2) {
        PG8_STAGE(PG8_SB(0, 0), cB, voffB); PG8_STAGE(PG8_SB(0, 1), cB + hstepB, voffB); PG8_STAGE(PG8_SA(0, 0), cA, voffA); PG8_STAGE(PG8_SA(0, 1), cA + hstepA, voffA);
        if (wr == 1) PG8_BAR;
        PG8_WAIT_V(2); PG8_BAR;
        PG8_STAGE(PG8_SB(1, 0), cB + kstep, voffB); PG8_STAGE(PG8_SA(1, 0), cA + kstep, voffA); PG8_STAGE(PG8_SB(1, 1), cB + hstepB + kstep, voffB);
        PG8_WAIT_V(6); PG8_BAR;
    } else {
        PG8_STAGE(PG8_SB(0, 0), cB, voffB); PG8_STAGE(PG8_SA(0, 0), cA, voffA); PG8_STAGE(PG8_SB(0, 1), cB + hstepB, voffB); PG8_STAGE(PG8_SA(0, 1), cA + hstepA, voffA);
        if (wr == 1) PG8_BAR;
        PG8_WAIT_V(4); PG8_BAR;
        PG8_STAGE(PG8_SB(1, 0), cB + kstep, voffB); PG8_STAGE(PG8_SA(1, 0), cA + kstep, voffA); PG8_STAGE(PG8_SB(1, 1), cB + hstepB + kstep, voffB);
        PG8_WAIT_V(6); PG8_BAR;
    }
    for (;;) {
        const bool has_next = S.next(ui + 1, nxt);
        const char* nA = has_next ? (const char*)g.A + (size_t)nxt.pm * tstepA : cA; const char* nB = has_next ? (const char*)g.Bt + (size_t)nxt.pb * tstepB : cB;
        for (int t = 0; t < nt; t += 2) {
            const bool last = (t == nt - 2);
            const char* a1 = cA + (size_t)(t + 1) * kstep;
            const char* a2 = last ? nA : cA + (size_t)(t + 2) * kstep; const char* b2 = last ? nB : cB + (size_t)(t + 2) * kstep;
            const char* a3 = a2 + kstep; const char* b3 = b2 + kstep;
            if (last && has_next) S.a_ready(nxt);
            if constexpr (SP2) {
            PG8_LDB(B0, 0, 0); PG8_LDB(B1, 0, 1); PG8_SCHED; PG8_LDA(At, 0, 0); PG8_STAGE(PG8_SA(1, 1), a1 + hstepA, voffA);
            PG8_WAIT_V(8); PG8_WAIT_L(0); PG8_BAR; PG8_MMA(0, 0, At, B0); PG8_MMA(0, 1, At, B1); PG8_BAR; PG8_SCHED;
            PG8_LDA(At, 0, 1); PG8_STAGE(PG8_SB(0, 0), b2, voffB); PG8_STAGE(PG8_SB(0, 1), b2 + hstepB, voffB); PG8_STAGE(PG8_SA(0, 0), a2, voffA);
            PG8_WAIT_V(8); PG8_WAIT_L(0); PG8_BAR; PG8_MMA(1, 0, At, B0); PG8_MMA(1, 1, At, B1); PG8_BAR; PG8_SCHED;
            PG8_LDB(B0, 1, 0); PG8_LDB(B1, 1, 1); PG8_SCHED; PG8_LDA(At, 1, 0); PG8_STAGE(PG8_SA(0, 1), a2 + hstepA, voffA);
            PG8_WAIT_V(8); PG8_WAIT_L(0); PG8_BAR; PG8_MMA(0, 0, At, B0); PG8_MMA(0, 1, At, B1); PG8_BAR; PG8_SCHED;
            PG8_LDA(At, 1, 1); PG8_STAGE(PG8_SB(1, 0), b3, voffB); PG8_STAGE(PG8_SB(1, 1), b3 + hstepB, voffB); PG8_STAGE(PG8_SA(1, 0), a3, voffA);
            PG8_WAIT_V(8); PG8_WAIT_L(0); PG8_BAR; PG8_MMA(1, 0, At, B0); PG8_MMA(1, 1, At, B1); PG8_BAR; PG8_SCHED;
            } else {
            PG8_LDB(B0, 0, 0); PG8_SCHED; PG8_LDA(At, 0, 0); PG8_STAGE(PG8_SA(1, 1), a1 + hstepA, voffA);
            PG8_WAIT_L(8); PG8_BAR; PG8_WAIT_L(0); PG8_MMA(0, 0, At, B0); PG8_BAR; PG8_SCHED;
            PG8_LDB(B1, 0, 1); PG8_STAGE(PG8_SB(0, 0), b2, voffB);
            PG8_BAR; PG8_WAIT_L(0); PG8_MMA(0, 1, At, B1); PG8_BAR;
            PG8_LDA(At, 0, 1); PG8_STAGE(PG8_SA(0, 0), a2, voffA);
            PG8_BAR; PG8_WAIT_L(0); PG8_MMA(1, 0, At, B0); PG8_BAR; PG8_SCHED;
            PG8_STAGE(PG8_SB(0, 1), b2 + hstepB, voffB);
            PG8_WAIT_V(6); PG8_BAR; PG8_MMA(1, 1, At, B1); PG8_BAR;
            PG8_LDB(B0, 1, 0); PG8_SCHED; PG8_LDA(At, 1, 0); PG8_STAGE(PG8_SA(0, 1), a2 + hstepA, voffA);
            PG8_WAIT_L(8); PG8_BAR; PG8_WAIT_L(0); PG8_MMA(0, 0, At, B0); PG8_BAR; PG8_SCHED;
            PG8_LDB(B1, 1, 1); PG8_STAGE(PG8_SB(1, 0), b3, voffB);
            PG8_BAR; PG8_WAIT_L(0); PG8_MMA(0, 1, At, B1); PG8_BAR;
            PG8_LDA(At, 1, 1); PG8_STAGE(PG8_SA(1, 0), a3, voffA);
            PG8_BAR; PG8_WAIT_L(0); PG8_MMA(1, 0, At, B0); PG8_BAR; PG8_SCHED;
            PG8_STAGE(PG8_SB(1, 1), b3 + hstepB, voffB);
            PG8_WAIT_V(6); PG8_BAR; PG8_MMA(1, 1, At, B1); PG8_BAR;
            }
        }
        if constexpr (ALIGN_EPI) { if (wr == 0) PG8_BAR; }
        if constexpr (!Epi::AFTER_DRAIN) { E(acc, cur, wr, wc, fr, fq); S.done(cur); }
        if (!has_next) break;
#pragma unroll
        for (int a = 0; a < 2; ++a)
#pragma unroll
            for (int b = 0; b < 2; ++b)
#pragma unroll
                for (int m = 0; m < 4; ++m)
#pragma unroll
                    for (int n = 0; n < 2; ++n) acc[a][b][m][n] = (f32x4){0.f, 0.f, 0.f, 0.f};
        cur = nxt; cA = nA; cB = nB; ++ui;
        if constexpr (ALIGN_EPI) { if (wr == 1) PG8_BAR; }
    }
    PG8_WAIT_V(0);
    if constexpr (!ALIGN_EPI) { if (wr == 0) PG8_BAR; }
    PG8_BAR;
    if constexpr (Epi::AFTER_DRAIN) { E.fused(acc, cur, wr, wc, fr, fq, lds, wid, lane); S.done(cur); }
#undef PG8_SA
#undef PG8_SB
#undef PG8_STAGE
#undef PG8_CAT
#undef PG8_LDA
#undef PG8_LDB
#undef PG8_MMA
#undef PG8_WAIT_V
#undef PG8_WAIT_L
#undef PG8_BAR
#undef PG8_SCHED
}

}

#ifndef FA_DBG_NOSEL
#define FA_DBG_NOSEL 0
#endif
#ifndef FA_DBG_NOMERGE
#define FA_DBG_NOMERGE 0
#endif
#ifndef FA_SEL_SKIP
#define FA_SEL_SKIP 0
#endif
namespace fa {
#define FA_LAS __attribute__((address_space(3)))
typedef unsigned short bf16;
typedef short bf16x8 __attribute__((ext_vector_type(8)));
typedef short s16x4 __attribute__((ext_vector_type(4)));
typedef float f32x16 __attribute__((ext_vector_type(16)));
typedef float f32x4 __attribute__((ext_vector_type(4)));
typedef unsigned u32x4 __attribute__((ext_vector_type(4)));
constexpr int QB = 256, QBLK = 32, KVBLK = 64;
constexpr int SHM_K = 16384, SHM_V = 16384, SHM_K2 = 8192;
constexpr int OFF_V = 0, OFF_K = 2 * SHM_V, OFF_K2 = OFF_K + 2 * SHM_K, OFF_WS = OFF_K2 + 2 * SHM_K2, WS_PER_WAVE = 1024, OFF_TAB = OFF_WS + 8 * WS_PER_WAVE;
constexpr int TAB_PAD = 320, TAB_MAX = 4096 + TAB_PAD;
constexpr int LDS_END = OFF_TAB + TAB_MAX * 4;
constexpr int OSTG = 272;
static_assert(LDS_END <= 131072 && 8 * 32 * OSTG <= OFF_WS, "attention LDS map");
#define KSWZ(row, colB) ((row) * 256 + ((colB) ^ (((row) & 7) << 4)))
#define K2SWZ(row, colB) ((row) * 128 + ((colB) ^ (((row) & 7) << 4)))
#define SBAR() __builtin_amdgcn_sched_barrier(0)
__device__ __forceinline__ int v_st(int k, int c) { const int kk = (k & ~0xC) | ((k & 4) << 1) | ((k & 8) >> 1); return ((kk >> 3) * 4 + (c >> 5)) * 512 + ((kk & 7) * 32 + (c & 31)) * 2; }
__device__ __forceinline__ int v_rd_base(int lane) { return ((lane & 3) << 3) | (((lane >> 2) & 3) << 6) | (((lane >> 4) & 1) << 5) | (((lane >> 5) & 1) << 8); }
constexpr int v_rd_off(int d0, int ks, int half) { return d0 * 512 + ks * 4096 + half * 2048; }
__device__ __forceinline__ int crow(int r, int hi) { return (r & 3) + 8 * (r >> 2) + 4 * hi; }
typedef float f32x2c __attribute__((ext_vector_type(2)));
typedef __bf16 bf16x2c __attribute__((ext_vector_type(2)));
__device__ __forceinline__ unsigned cvtpk(float lo, float hi) { const f32x2c v = {lo, hi}; return __builtin_bit_cast(unsigned, __builtin_convertvector(v, bf16x2c)); }

struct Item {
    const bf16* Q; long qs;
    const float* rope; long ropes;
    const bf16* K; long ks; const bf16* K2; long k2s; const bf16* V; long vs;
    int P0, skv, W;
    const float* bias; int bstep;
    const unsigned long long* sel; long sels;
    bf16* O; long os;
    float* LSE; long lses;
    const bf16* M0; const bf16* M1; long ms; const bf16* G; long gs;
};

template <int VAR>
__device__ __forceinline__ void attn_block(const Item& it, unsigned char* lds_g) {
    constexpr bool HAS_BIAS = VAR != 2, HAS_SEL = VAR == 1, HAS_K2 = VAR == 2;
    constexpr float SCALE = HAS_K2 ? 0.07216878364870322f : 0.08838834764831845f, C2 = 1.4426950408889634f * SCALE, THR = 8.f;
    FA_LAS unsigned char* L = (FA_LAS unsigned char*)lds_g;
    const int tid = threadIdx.x, wid = __builtin_amdgcn_readfirstlane(tid >> 6), lane = tid & 63, r32 = lane & 31, hi = lane >> 5;
    const int W = it.W;
    const int j_lo = (it.P0 - W + 1 > 0) ? (it.P0 - W + 1) / KVBLK : 0;
    int j_hi = (it.P0 + QB - 1) / KVBLK + 1; if (j_hi > it.skv / KVBLK) j_hi = it.skv / KVBLK;
    const int NT = j_hi - j_lo;
    const int qlo = it.P0 + wid * QBLK, qm = qlo + r32 - 4 * hi;
    FA_LAS float* wsl = (FA_LAS float*)(L + OFF_WS + wid * WS_PER_WAVE); FA_LAS float* li_l = wsl; FA_LAS float* al_l = wsl + 32;
    FA_LAS float* tab = (FA_LAS float*)(L + OFF_TAB);
    const int sr = tid >> 4, sc = (tid & 15) * 8, vst0 = v_st(sr, sc), vst1 = v_st(32 + sr, sc), kws = KSWZ(sr, sc * 2);
    const int k2r = tid >> 3, k2c = (tid & 7) * 8, k2ws = K2SWZ(k2r, k2c * 2);
    const int vb0 = OFF_V + v_rd_base(lane);
    bf16x8 qr[8]; bf16x8 qr2[4];
    { const bf16* qp = it.Q + (long)(qlo + r32) * it.qs + hi * 8;
#pragma unroll
      for (int d0 = 0; d0 < 8; ++d0) qr[d0] = *(const bf16x8*)(qp + d0 * 16);
      if constexpr (HAS_K2) {
          const float* rp = it.rope + (long)(qlo + r32) * it.ropes + hi * 8;
          bf16x8 raw[4];
#pragma unroll
          for (int d0 = 0; d0 < 4; ++d0) raw[d0] = *(const bf16x8*)(qp + 128 + d0 * 16);
#pragma unroll
          for (int d0 = 0; d0 < 2; ++d0) { const f32x4 c0 = *(const f32x4*)(rp + d0 * 16), c1 = *(const f32x4*)(rp + d0 * 16 + 4), s0 = *(const f32x4*)(rp + 32 + d0 * 16), s1 = *(const f32x4*)(rp + 32 + d0 * 16 + 4);
              float o1[8], o2[8];
#pragma unroll
              for (int j = 0; j < 8; ++j) { const float x1 = __builtin_bit_cast(float, (unsigned)(unsigned short)raw[d0][j] << 16), x2 = __builtin_bit_cast(float, (unsigned)(unsigned short)raw[d0 + 2][j] << 16);
                  const float cs = j < 4 ? c0[j & 3] : c1[j & 3], sn = j < 4 ? s0[j & 3] : s1[j & 3]; o1[j] = x1 * cs - x2 * sn; o2[j] = x2 * cs + x1 * sn; }
              u32x4 w1 = {cvtpk(o1[0], o1[1]), cvtpk(o1[2], o1[3]), cvtpk(o1[4], o1[5]), cvtpk(o1[6], o1[7])}, w2 = {cvtpk(o2[0], o2[1]), cvtpk(o2[2], o2[3]), cvtpk(o2[4], o2[5]), cvtpk(o2[6], o2[7])};
              qr2[d0] = __builtin_bit_cast(bf16x8, w1); qr2[d0 + 2] = __builtin_bit_cast(bf16x8, w2); }
      }
    }
    unsigned long long selm = ~0ull;
    if constexpr (HAS_SEL) selm = __hip_atomic_load(it.sel + (long)(qlo + r32) * it.sels, __ATOMIC_RELAXED, __HIP_MEMORY_SCOPE_AGENT);
    if constexpr (HAS_BIAS) {
        int rmax = W + 320; if (rmax > 4096) rmax = 4096;
        for (int i = tid; i < rmax + TAB_PAD; i += 512) { int r = i - TAB_PAD; r = r < -64 ? -64 : r; long gi = (long)r * it.bstep; gi = gi > 4095 ? 4095 : gi; tab[i] = it.bias[gi] * (1.0f / SCALE); }
    }
    bf16x8 st_k0, st_k1, st_v0, st_v1, st_k2;
#define FA_LOAD(kb_) do { const long r0_ = (long)((kb_) + sr), r1_ = r0_ + 32; \
        st_v0 = *(const bf16x8*)(it.V + r0_ * it.vs + sc); st_v1 = *(const bf16x8*)(it.V + r1_ * it.vs + sc); \
        st_k0 = *(const bf16x8*)(it.K + r0_ * it.ks + sc); st_k1 = *(const bf16x8*)(it.K + r1_ * it.ks + sc); \
        if constexpr (HAS_K2) st_k2 = *(const bf16x8*)(it.K2 + (long)((kb_) + k2r) * it.k2s + k2c); } while (0)
#define FA_WRITE(bf_) do { *(FA_LAS bf16x8*)(L + OFF_V + (bf_) * SHM_V + vst0) = st_v0; *(FA_LAS bf16x8*)(L + OFF_V + (bf_) * SHM_V + vst1) = st_v1; \
        *(FA_LAS bf16x8*)(L + OFF_K + (bf_) * SHM_K + kws) = st_k0; *(FA_LAS bf16x8*)(L + OFF_K + (bf_) * SHM_K + kws + 32 * 256) = st_k1; \
        if constexpr (HAS_K2) *(FA_LAS bf16x8*)(L + OFF_K2 + (bf_) * SHM_K2 + k2ws) = st_k2; } while (0)
    FA_LOAD(j_lo * KVBLK);
    asm volatile("s_waitcnt vmcnt(0)" ::: "memory");
    FA_WRITE(0);
    __syncthreads();
    float m_reg = -1e30f, l_reg = 0.f; f32x16 o[4] = {};
#define FA_KBASE(t) ((j_lo + (t)) * KVBLK)
#define FA_STEP(BUF, t) do { \
        const int kb_ = FA_KBASE(t); \
        if ((t) + 1 < NT) FA_LOAD(FA_KBASE((t) + 1)); \
        bool act_ = (kb_ <= qlo + QBLK - 1) && (kb_ + KVBLK - 1 >= qlo - W + 1); \
        bool allow_ = true; \
        if constexpr (HAS_SEL) { allow_ = FA_DBG_NOSEL ? true : (bool)((selm >> (kb_ >> 6)) & 1ull); if (FA_SEL_SKIP) act_ = act_ && __any(allow_); } \
        if (act_) { \
            f32x16 p0 = {}, p1 = {}; \
            { const int ka_ = OFF_K + (BUF) * SHM_K; \
              _Pragma("unroll") for (int d0 = 0; d0 < 8; ++d0) { \
                const bf16x8 b0 = *(const FA_LAS bf16x8*)(L + ka_ + KSWZ(r32, (d0 * 16 + hi * 8) * 2)); \
                const bf16x8 b1 = *(const FA_LAS bf16x8*)(L + ka_ + 32 * 256 + KSWZ(r32, (d0 * 16 + hi * 8) * 2)); \
                p0 = __builtin_amdgcn_mfma_f32_32x32x16_bf16(b0, qr[d0], p0, 0, 0, 0); p1 = __builtin_amdgcn_mfma_f32_32x32x16_bf16(b1, qr[d0], p1, 0, 0, 0); } \
              if constexpr (HAS_K2) { const int k2a_ = OFF_K2 + (BUF) * SHM_K2; \
                _Pragma("unroll") for (int d0 = 0; d0 < 4; ++d0) { \
                  const bf16x8 b0 = *(const FA_LAS bf16x8*)(L + k2a_ + K2SWZ(r32, (d0 * 16 + hi * 8) * 2)); \
                  const bf16x8 b1 = *(const FA_LAS bf16x8*)(L + k2a_ + 32 * 128 + K2SWZ(r32, (d0 * 16 + hi * 8) * 2)); \
                  p0 = __builtin_amdgcn_mfma_f32_32x32x16_bf16(b0, qr2[d0], p0, 0, 0, 0); p1 = __builtin_amdgcn_mfma_f32_32x32x16_bf16(b1, qr2[d0], p1, 0, 0, 0); } } } \
            const int dq_ = qm - kb_; \
            if constexpr (HAS_BIAS) { const FA_LAS float* tb_ = tab + (TAB_PAD + dq_ - 63); \
                _Pragma("unroll") for (int r = 0; r < 16; ++r) { const int c_ = (r & 3) + 8 * (r >> 2); p0[r] += tb_[63 - c_]; p1[r] += tb_[31 - c_]; } } \
            if (HAS_SEL || kb_ + KVBLK - 1 > qlo || kb_ <= qlo + QBLK - 1 - W) { const float NEG_ = -__builtin_inff(); const int dqm_ = allow_ ? dq_ : -0x40000000; \
                _Pragma("unroll") for (int r = 0; r < 16; ++r) { const int c_ = (r & 3) + 8 * (r >> 2); \
                    if ((unsigned)(dqm_ - c_) >= (unsigned)W) p0[r] = NEG_; if ((unsigned)(dqm_ - c_ - 32) >= (unsigned)W) p1[r] = NEG_; } } \
              \
            float pmax_ = p0[0]; _Pragma("unroll") for (int r = 1; r < 16; ++r) pmax_ = fmaxf(pmax_, p0[r]); _Pragma("unroll") for (int r = 0; r < 16; ++r) pmax_ = fmaxf(pmax_, p1[r]); \
            { auto rr_ = __builtin_amdgcn_permlane32_swap(__float_as_uint(pmax_), __float_as_uint(pmax_), false, false); pmax_ = fmaxf(__uint_as_float(rr_[0]), __uint_as_float(rr_[1])); } \
            float mn_, alpha_; \
            if (__all((pmax_ - m_reg) * SCALE <= THR)) { mn_ = m_reg; alpha_ = 1.f; } \
            else { mn_ = fmaxf(m_reg, pmax_); alpha_ = __builtin_amdgcn_exp2f((m_reg - mn_) * C2); m_reg = mn_; } \
            const float mnL_ = -mn_ * C2; float ps_ = 0.f; \
            _Pragma("unroll") for (int r = 0; r < 16; ++r) { p0[r] = __builtin_amdgcn_exp2f(fmaf(p0[r], C2, mnL_)); p1[r] = __builtin_amdgcn_exp2f(fmaf(p1[r], C2, mnL_)); ps_ += p0[r] + p1[r]; } \
            { auto rr_ = __builtin_amdgcn_permlane32_swap(__float_as_uint(ps_), __float_as_uint(ps_), false, false); ps_ = __uint_as_float(rr_[0]) + __uint_as_float(rr_[1]); } \
            l_reg = l_reg * alpha_ + ps_; \
            bf16x8 pa0, pa1, pa2, pa3; \
            FA_PK4(p0, 0, pa0); FA_PK4(p0, 8, pa1); FA_PK4(p1, 0, pa2); FA_PK4(p1, 8, pa3); \
            if (__any(alpha_ < 1.f)) { if (hi == 0) al_l[r32] = alpha_; asm volatile("s_waitcnt lgkmcnt(0)" ::: "memory"); \
                _Pragma("unroll") for (int d_ = 0; d_ < 4; ++d_) _Pragma("unroll") for (int r = 0; r < 16; ++r) o[d_][r] *= al_l[crow(r, hi)]; } \
            FA_PV_D0(BUF, 0); FA_PV_D0(BUF, 1); FA_PV_D0(BUF, 2); FA_PV_D0(BUF, 3); \
        } \
        if ((t) + 1 < NT) { asm volatile("s_waitcnt vmcnt(0)" ::: "memory"); FA_WRITE(1 - (BUF)); } \
        __syncthreads(); } while (0)
#define FA_PK4(P, B_, OUT) do { unsigned a0 = cvtpk(P[B_+0], P[B_+1]), a1 = cvtpk(P[B_+2], P[B_+3]); unsigned b0 = cvtpk(P[B_+4], P[B_+5]), b1 = cvtpk(P[B_+6], P[B_+7]); \
        auto r0 = __builtin_amdgcn_permlane32_swap(a0, b0, false, false); auto r1 = __builtin_amdgcn_permlane32_swap(a1, b1, false, false); \
        u32x4 w = {r0[0], r1[0], r0[1], r1[1]}; OUT = __builtin_bit_cast(bf16x8, w); } while (0)
#define FA_TRRD(dst, off) asm volatile("ds_read_b64_tr_b16 %0, %1 offset:%2" : "=&v"(dst) : "v"(vb0), "i"(off) : "memory")
#define FA_PV_D0(VB, d0) do { s16x4 l0, l1, l2, l3, h0, h1, h2, h3; constexpr int b_ = (VB) * SHM_V + v_rd_off(d0, 0, 0); \
        FA_TRRD(l0, b_); FA_TRRD(h0, b_ + 2048); FA_TRRD(l1, b_ + 4096); FA_TRRD(h1, b_ + 6144); FA_TRRD(l2, b_ + 8192); FA_TRRD(h2, b_ + 10240); FA_TRRD(l3, b_ + 12288); FA_TRRD(h3, b_ + 14336); \
        asm volatile("s_waitcnt lgkmcnt(0)" ::: "memory"); SBAR(); \
        o[d0] = __builtin_amdgcn_mfma_f32_32x32x16_bf16(pa0, (bf16x8){l0[0], l0[1], l0[2], l0[3], h0[0], h0[1], h0[2], h0[3]}, o[d0], 0, 0, 0); \
        o[d0] = __builtin_amdgcn_mfma_f32_32x32x16_bf16(pa1, (bf16x8){l1[0], l1[1], l1[2], l1[3], h1[0], h1[1], h1[2], h1[3]}, o[d0], 0, 0, 0); \
        o[d0] = __builtin_amdgcn_mfma_f32_32x32x16_bf16(pa2, (bf16x8){l2[0], l2[1], l2[2], l2[3], h2[0], h2[1], h2[2], h2[3]}, o[d0], 0, 0, 0); \
        o[d0] = __builtin_amdgcn_mfma_f32_32x32x16_bf16(pa3, (bf16x8){l3[0], l3[1], l3[2], l3[3], h3[0], h3[1], h3[2], h3[3]}, o[d0], 0, 0, 0); } while (0)
    for (int t = 0; t < NT; t += 2) { FA_STEP(0, t); if (t + 1 < NT) FA_STEP(1, t + 1); }
    li_l[r32] = l_reg;
    if constexpr (VAR == 1) { const bf16* gp = it.G + (long)(qlo + r32) * it.gs;
#pragma unroll
        for (int k = 0; k < 3; ++k) { const float gl = __builtin_bit_cast(float, (unsigned)gp[k] << 16); wsl[64 + 32 * k + r32] = 1.0f / (1.0f + __expf(-gl)); } }
    asm volatile("s_waitcnt lgkmcnt(0)" ::: "memory");
    if (it.LSE && hi == 0) it.LSE[(long)(qlo + r32) * it.lses] = m_reg * SCALE + __logf(l_reg);
    FA_LAS unsigned char* stg = L + wid * (32 * OSTG);
#pragma unroll
    for (int r = 0; r < 16; ++r) { const int orow = crow(r, hi); const float lv_ = li_l[orow]; float rl = lv_ > 0.f ? __builtin_amdgcn_rcpf(lv_) : 0.f; if constexpr (VAR == 1 && !FA_DBG_NOMERGE) rl *= wsl[64 + 32 + orow];
#pragma unroll
        for (int d0 = 0; d0 < 4; ++d0) { const float v = o[d0][r] * rl; const unsigned u = __builtin_bit_cast(unsigned, v); *(FA_LAS unsigned short*)(stg + orow * OSTG + (d0 * 32 + r32) * 2) = (unsigned short)((u + 0x7fffu + ((u >> 16) & 1u)) >> 16); } }
    asm volatile("s_waitcnt lgkmcnt(0)" ::: "memory");
#pragma unroll
    for (int i = 0; i < 8; ++i) { const int id = lane + 64 * i, row = id >> 4, ch = id & 15; const long qi = (long)(qlo + row);
        u32x4 w = *(const FA_LAS u32x4*)(stg + row * OSTG + ch * 16);
        if constexpr (VAR == 1 && !FA_DBG_NOMERGE) { const float g0 = wsl[64 + row], g2 = wsl[64 + 64 + row];
            const u32x4 a = *(const u32x4*)(it.M0 + qi * it.ms + ch * 8), c = *(const u32x4*)(it.M1 + qi * it.ms + ch * 8);
#pragma unroll
            for (int k = 0; k < 4; ++k) { const float lo = __builtin_bit_cast(float, w[k] << 16) + g0 * __builtin_bit_cast(float, a[k] << 16) + g2 * __builtin_bit_cast(float, c[k] << 16);
                const float hi_ = __builtin_bit_cast(float, w[k] & 0xffff0000u) + g0 * __builtin_bit_cast(float, a[k] & 0xffff0000u) + g2 * __builtin_bit_cast(float, c[k] & 0xffff0000u); w[k] = cvtpk(lo, hi_); } }
        *(u32x4*)(it.O + qi * it.os + ch * 8) = w; }
    __syncthreads();
#undef FA_LOAD
#undef FA_WRITE
#undef FA_KBASE
#undef FA_STEP
#undef FA_PK4
#undef FA_TRRD
#undef FA_PV_D0
}

struct CmpItem { const bf16* Q; long qs; const bf16* K; const bf16* V; const float* bias; int bld; int s0; bf16* O; long os; unsigned long long* sel; };
__device__ __forceinline__ void cmp_block(const CmpItem& it, unsigned char* lds_g, int imps_off) {
    constexpr float SCALE = 0.08838834764831845f, C2 = 1.4426950408889634f * SCALE;
    constexpr int OFF_TABC = 65536;
    FA_LAS unsigned char* L = (FA_LAS unsigned char*)lds_g;
    const int tid = threadIdx.x, wid = __builtin_amdgcn_readfirstlane(tid >> 6), lane = tid & 63, r32 = lane & 31, hi = lane >> 5;
    FA_LAS float* tabc = (FA_LAS float*)(L + OFF_TABC); FA_LAS float* imps = (FA_LAS float*)(L + imps_off);
    const int tokl = wid * 8 + (r32 >> 2), rh = r32 & 3, s = it.s0 + tokl;
    const int nvis = (it.s0 + 63 - 31) / 16 + 1 > 255 ? 255 : (it.s0 + 63 - 31) / 16 + 1;
    const int NT = (nvis + 63) / 64;
    const int nlim = (s - 31) >> 4;
    const int sr = tid >> 4, sc = (tid & 15) * 8, vst0 = v_st(sr, sc), vst1 = v_st(32 + sr, sc), kws = KSWZ(sr, sc * 2);
    const int vb0 = OFF_V + v_rd_base(lane);
    bf16x8 qr[8];
    { const bf16* qp = it.Q + (long)tokl * it.qs + rh * 128 + hi * 8;
#pragma unroll
      for (int d0 = 0; d0 < 8; ++d0) qr[d0] = *(const bf16x8*)(qp + d0 * 16); }
    for (int i = tid; i < 4 * 4096; i += 512) tabc[i] = it.bias[(long)(i >> 12) * it.bld + (i & 4095)] * (1.0f / SCALE);
    for (int i = tid; i < 64 * 64; i += 512) imps[i] = 0.f;
    bf16x8 st_k0, st_k1, st_v0, st_v1;
#define CM_LOADK(kb_) do { st_k0 = *(const bf16x8*)(it.K + (long)((kb_) + sr) * 128 + sc); st_k1 = *(const bf16x8*)(it.K + (long)((kb_) + 32 + sr) * 128 + sc); } while (0)
#define CM_LOADV(kb_) do { st_v0 = *(const bf16x8*)(it.V + (long)((kb_) + sr) * 128 + sc); st_v1 = *(const bf16x8*)(it.V + (long)((kb_) + 32 + sr) * 128 + sc); } while (0)
#define CM_WRITEK(bf_) do { *(FA_LAS bf16x8*)(L + OFF_K + (bf_) * SHM_K + kws) = st_k0; *(FA_LAS bf16x8*)(L + OFF_K + (bf_) * SHM_K + kws + 32 * 256) = st_k1; } while (0)
#define CM_WRITEV(bf_) do { *(FA_LAS bf16x8*)(L + OFF_V + (bf_) * SHM_V + vst0) = st_v0; *(FA_LAS bf16x8*)(L + OFF_V + (bf_) * SHM_V + vst1) = st_v1; } while (0)
#define CM_SCORES(BUF, kb_) \
        f32x16 p0 = {}, p1 = {}; \
        { const int ka_ = OFF_K + (BUF) * SHM_K; \
          _Pragma("unroll") for (int d0 = 0; d0 < 8; ++d0) { \
            const bf16x8 b0 = *(const FA_LAS bf16x8*)(L + ka_ + KSWZ(r32, (d0 * 16 + hi * 8) * 2)); \
            const bf16x8 b1 = *(const FA_LAS bf16x8*)(L + ka_ + 32 * 256 + KSWZ(r32, (d0 * 16 + hi * 8) * 2)); \
            p0 = __builtin_amdgcn_mfma_f32_32x32x16_bf16(b0, qr[d0], p0, 0, 0, 0); p1 = __builtin_amdgcn_mfma_f32_32x32x16_bf16(b1, qr[d0], p1, 0, 0, 0); } } \
        { const int nb_ = (kb_) + 4 * hi, relb_ = s - 31 - 16 * nb_; const float NEG_ = -__builtin_inff(); \
          _Pragma("unroll") for (int r = 0; r < 16; ++r) { const int c_ = (r & 3) + 8 * (r >> 2); \
            { const int rel_ = relb_ - 16 * c_; const int ix_ = rel_ < 0 ? 0 : rel_; const float bv_ = tabc[rh * 4096 + ix_]; p0[r] = (nb_ + c_ <= nlim) ? p0[r] + bv_ : NEG_; } \
            { const int rel_ = relb_ - 16 * (c_ + 32); const int ix_ = rel_ < 0 ? 0 : rel_; const float bv_ = tabc[rh * 4096 + ix_]; p1[r] = (nb_ + c_ + 32 <= nlim) ? p1[r] + bv_ : NEG_; } } }
    CM_LOADK(0); asm volatile("s_waitcnt vmcnt(0)" ::: "memory"); CM_WRITEK(0); __syncthreads();
    float m_reg = -1e30f, l_reg = 0.f;
#define CM_P1(BUF, t) do { if ((t) + 1 < NT) CM_LOADK(((t) + 1) * 64); \
        { CM_SCORES(BUF, (t) * 64) \
          float pmax_ = p0[0]; _Pragma("unroll") for (int r = 1; r < 16; ++r) pmax_ = fmaxf(pmax_, p0[r]); _Pragma("unroll") for (int r = 0; r < 16; ++r) pmax_ = fmaxf(pmax_, p1[r]); \
          { auto rr_ = __builtin_amdgcn_permlane32_swap(__float_as_uint(pmax_), __float_as_uint(pmax_), false, false); pmax_ = fmaxf(__uint_as_float(rr_[0]), __uint_as_float(rr_[1])); } \
          const float mn_ = fmaxf(m_reg, pmax_), alpha_ = __builtin_amdgcn_exp2f((m_reg - mn_) * C2), mnL_ = -mn_ * C2; float ps_ = 0.f; \
          _Pragma("unroll") for (int r = 0; r < 16; ++r) ps_ += __builtin_amdgcn_exp2f(fmaf(p0[r], C2, mnL_)) + __builtin_amdgcn_exp2f(fmaf(p1[r], C2, mnL_)); \
          { auto rr_ = __builtin_amdgcn_permlane32_swap(__float_as_uint(ps_), __float_as_uint(ps_), false, false); ps_ = __uint_as_float(rr_[0]) + __uint_as_float(rr_[1]); } \
          l_reg = l_reg * alpha_ + ps_; m_reg = mn_; } \
        if ((t) + 1 < NT) { asm volatile("s_waitcnt vmcnt(0)" ::: "memory"); CM_WRITEK(1 - (BUF)); } \
        __syncthreads(); } while (0)
    for (int t = 0; t < NT; t += 2) { CM_P1(0, t); if (t + 1 < NT) CM_P1(1, t + 1); }
    const float inv_l = l_reg > 0.f ? 1.0f / l_reg : 0.f, mL = -m_reg * C2;
    CM_LOADK(0); CM_LOADV(0); asm volatile("s_waitcnt vmcnt(0)" ::: "memory"); CM_WRITEK(0); CM_WRITEV(0); __syncthreads();
    f32x16 o[4] = {};
#define FA_PK4(P, B_, OUT) do { unsigned a0 = cvtpk(P[B_+0], P[B_+1]), a1 = cvtpk(P[B_+2], P[B_+3]); unsigned b0 = cvtpk(P[B_+4], P[B_+5]), b1 = cvtpk(P[B_+6], P[B_+7]); \
        auto r0 = __builtin_amdgcn_permlane32_swap(a0, b0, false, false); auto r1 = __builtin_amdgcn_permlane32_swap(a1, b1, false, false); \
        u32x4 w = {r0[0], r1[0], r0[1], r1[1]}; OUT = __builtin_bit_cast(bf16x8, w); } while (0)
#define FA_TRRD(dst, off) asm volatile("ds_read_b64_tr_b16 %0, %1 offset:%2" : "=&v"(dst) : "v"(vb0), "i"(off) : "memory")
#define FA_PV_D0(VB, d0) do { s16x4 l0, l1, l2, l3, h0, h1, h2, h3; constexpr int b_ = (VB) * SHM_V + v_rd_off(d0, 0, 0); \
        FA_TRRD(l0, b_); FA_TRRD(h0, b_ + 2048); FA_TRRD(l1, b_ + 4096); FA_TRRD(h1, b_ + 6144); FA_TRRD(l2, b_ + 8192); FA_TRRD(h2, b_ + 10240); FA_TRRD(l3, b_ + 12288); FA_TRRD(h3, b_ + 14336); \
        asm volatile("s_waitcnt lgkmcnt(0)" ::: "memory"); SBAR(); \
        o[d0] = __builtin_amdgcn_mfma_f32_32x32x16_bf16(pa0, (bf16x8){l0[0], l0[1], l0[2], l0[3], h0[0], h0[1], h0[2], h0[3]}, o[d0], 0, 0, 0); \
        o[d0] = __builtin_amdgcn_mfma_f32_32x32x16_bf16(pa1, (bf16x8){l1[0], l1[1], l1[2], l1[3], h1[0], h1[1], h1[2], h1[3]}, o[d0], 0, 0, 0); \
        o[d0] = __builtin_amdgcn_mfma_f32_32x32x16_bf16(pa2, (bf16x8){l2[0], l2[1], l2[2], l2[3], h2[0], h2[1], h2[2], h2[3]}, o[d0], 0, 0, 0); \
        o[d0] = __builtin_amdgcn_mfma_f32_32x32x16_bf16(pa3, (bf16x8){l3[0], l3[1], l3[2], l3[3], h3[0], h3[1], h3[2], h3[3]}, o[d0], 0, 0, 0); } while (0)
#define CM_IMP(P, half_, t) do { _Pragma("unroll") for (int q4 = 0; q4 < 4; ++q4) { \
            float A_ = (2.0f * ((P[4 * q4] + P[4 * q4 + 1]) + P[4 * q4 + 2]) + P[4 * q4 + 3]) * inv_l, B_ = P[4 * q4 + 3] * inv_l; \
            A_ += __shfl_xor(A_, 1); A_ += __shfl_xor(A_, 2); B_ += __shfl_xor(B_, 1); B_ += __shfl_xor(B_, 2); \
            const int j_ = 2 * q4 + hi + 8 * (half_) + 16 * (t); \
            if (rh == 0) { __hip_atomic_fetch_add(&imps[tokl * 64 + j_], A_, __ATOMIC_RELAXED, __HIP_MEMORY_SCOPE_WORKGROUP); \
                if (j_ + 1 < 64) __hip_atomic_fetch_add(&imps[tokl * 64 + j_ + 1], B_, __ATOMIC_RELAXED, __HIP_MEMORY_SCOPE_WORKGROUP); } } } while (0)
#define CM_P2(BUF, t) do { if ((t) + 1 < NT) { CM_LOADK(((t) + 1) * 64); CM_LOADV(((t) + 1) * 64); } \
        { CM_SCORES(BUF, (t) * 64) \
          _Pragma("unroll") for (int r = 0; r < 16; ++r) { p0[r] = __builtin_amdgcn_exp2f(fmaf(p0[r], C2, mL)); p1[r] = __builtin_amdgcn_exp2f(fmaf(p1[r], C2, mL)); } \
          CM_IMP(p0, 0, t); CM_IMP(p1, 1, t); \
          bf16x8 pa0, pa1, pa2, pa3; FA_PK4(p0, 0, pa0); FA_PK4(p0, 8, pa1); FA_PK4(p1, 0, pa2); FA_PK4(p1, 8, pa3); \
          FA_PV_D0(BUF, 0); FA_PV_D0(BUF, 1); FA_PV_D0(BUF, 2); FA_PV_D0(BUF, 3); } \
        if ((t) + 1 < NT) { asm volatile("s_waitcnt vmcnt(0)" ::: "memory"); CM_WRITEK(1 - (BUF)); CM_WRITEV(1 - (BUF)); } \
        __syncthreads(); } while (0)
    for (int t = 0; t < NT; t += 2) { CM_P2(0, t); if (t + 1 < NT) CM_P2(1, t + 1); }
    asm volatile("s_waitcnt lgkmcnt(0)" ::: "memory");
    for (int tk = 0; tk < 8; ++tk) { const int sp = it.s0 + wid * 8 + tk, blk_t = sp >> 6, j = lane;
        const float is = imps[(wid * 8 + tk) * 64 + j];
        const bool forced = (j == 0) || (j == blk_t) || (j == blk_t - 1), valid = j <= blk_t;
        const float scv = forced ? 1e9f : (valid ? is : -1.0f);
        int rank = 0;
        for (int k = 0; k < 64; ++k) { const float vk = __shfl(scv, k); rank += (vk > scv || (vk == scv && k < j)) ? 1 : 0; }
        const unsigned long long msk = __ballot(rank < 16 && scv > -0.5f);
        if (lane == 0) it.sel[(long)(wid * 8 + tk) * 2] = msk; }
    FA_LAS unsigned char* stg = L + wid * (32 * OSTG);
    FA_LAS float* li_c = imps + wid * 512;
    li_c[r32] = inv_l; asm volatile("s_waitcnt lgkmcnt(0)" ::: "memory");
#pragma unroll
    for (int r = 0; r < 16; ++r) { const int orow = crow(r, hi); const float rl = li_c[orow];
#pragma unroll
        for (int d0 = 0; d0 < 4; ++d0) { const unsigned u = __builtin_bit_cast(unsigned, o[d0][r] * rl); *(FA_LAS unsigned short*)(stg + orow * OSTG + (d0 * 32 + r32) * 2) = (unsigned short)((u + 0x7fffu + ((u >> 16) & 1u)) >> 16); } }
    asm volatile("s_waitcnt lgkmcnt(0)" ::: "memory");
#pragma unroll
    for (int i = 0; i < 8; ++i) { const int id = lane + 64 * i, row = id >> 4, ch = id & 15;
        const u32x4 w = *(const FA_LAS u32x4*)(stg + row * OSTG + ch * 16);
        *(u32x4*)(it.O + (long)(wid * 8 + (row >> 2)) * it.os + (row & 3) * 128 + ch * 8) = w; }
    __syncthreads();
#undef CM_LOADK
#undef CM_LOADV
#undef CM_WRITEK
#undef CM_WRITEV
#undef CM_SCORES
#undef CM_P1
#undef CM_P2
#undef CM_IMP
#undef FA_PK4
#undef FA_TRRD
#undef FA_PV_D0
}
}

constexpr int D = 2048, NB = 4, S = 4096, M = NB * S;
constexpr int HD = 128;
constexpr int Z0W = 3840;
constexpr int Z_NQ = 0, Z_NKV = 1024, Z_QLAT = 2560, Z_KVLAT = 3072, Z_KPE = 3584, Z_NG = 3648;
constexpr int QMW = 1536, KVMW = 2048;
constexpr int FF = 5632, FFE = 7168, NE = 8;
constexpr int Z1W = 9216;
constexpr int NSLOT = (2 * M / 256 + NE) * 256;
constexpr float RMS_EPS = 1e-6f;

constexpr size_t MiB = 1u << 20;
constexpr size_t WS_CTL = 0, CTL_ZERO_BYTES = 1 * MiB;
constexpr size_t WS_MOD = 1 * MiB;
constexpr size_t WS_BIAS = 2 * MiB;
constexpr int BIAS_LD = 4096 + 64;
constexpr size_t WS_ROPE = 3 * MiB;
constexpr size_t WS_RINV = 8 * MiB;
constexpr size_t WS_SEL = 9 * MiB;
constexpr size_t WS_KC = 10 * MiB;
constexpr size_t WS_VC = 11 * MiB;
constexpr size_t WS_ROUTE = 12 * MiB;
constexpr size_t WS_LSE = 13 * MiB;
constexpr size_t WS_KPE = 15 * MiB;
constexpr size_t WS_W1T = 17 * MiB, WS_W2T = 19 * MiB, WS_CB1 = 20 * MiB;
constexpr size_t WS_WIN0 = 21 * MiB, WS_WUQ = 36 * MiB, WS_WUKV = 38 * MiB, WS_WOUT0 = 40 * MiB, WS_WGU0 = 48 * MiB, WS_WDN0 = 92 * MiB;
constexpr size_t WS_WIN1 = 114 * MiB, WS_WOUT1 = 150 * MiB, WS_WMGU = 154 * MiB, WS_WMDN = 602 * MiB;
constexpr size_t WS_X = 826 * MiB;
constexpr size_t WS_H = 954 * MiB;
constexpr size_t WS_R = 1018 * MiB;
constexpr size_t WS_Z0 = WS_R, WS_QM = WS_R + 120 * MiB, WS_KVM = WS_R + 168 * MiB, WS_OCMP = WS_R + 232 * MiB, WS_OWIN = WS_R + 264 * MiB, WS_CAT = WS_R + 328 * MiB;
constexpr size_t WS_ACT = WS_R;
constexpr size_t WS_Z1 = WS_R, WS_OP = WS_R + 288 * MiB, WS_OM = WS_R + 384 * MiB;
constexpr size_t WS_XB = WS_R, WS_ACTB = WS_R + 136 * MiB, WS_YB = WS_R;
constexpr size_t WS_END = WS_R + 612 * MiB;
static_assert(WS_Z0 + (size_t)M * Z0W * 2 <= WS_QM && WS_QM + (size_t)M * QMW * 2 <= WS_KVM && WS_KVM + (size_t)M * KVMW * 2 <= WS_OCMP && WS_CAT + (size_t)M * 2048 * 2 <= WS_END, "L0 map");
static_assert(WS_Z1 + (size_t)M * Z1W * 2 <= WS_OM && WS_XB + (size_t)NSLOT * D * 2 <= WS_ACTB && WS_ACTB + (size_t)NSLOT * FFE * 2 <= WS_END, "L1 map");
static_assert(WS_WMDN + (size_t)NE * D * FFE * 2 <= WS_X && WS_WMGU + (size_t)NE * 2 * FFE * D * 2 <= WS_WMDN, "weights map");
constexpr int CW_BAR = 4096;
constexpr int CW_CNT = 64;
constexpr int CW_TS = 128;
constexpr int CW_Q = 8192;

constexpr int RING_BYTES = 131072;
constexpr int SMALL_OFF = RING_BYTES;
constexpr int LDSCTL_OFF = RING_BYTES + 16384, MISC_OFF = LDSCTL_OFF;
constexpr int LDS_BYTES = LDSCTL_OFF + 256;
constexpr int NWAVES = 8;

#define GAS __attribute__((address_space(1)))
#define LAS __attribute__((address_space(3)))
typedef unsigned short bf16;
typedef unsigned v4u __attribute__((ext_vector_type(4)));
typedef unsigned v2u __attribute__((ext_vector_type(2)));
typedef float f32x4 __attribute__((ext_vector_type(4)));
typedef float f32x2 __attribute__((ext_vector_type(2)));
#define LDS_WAIT() asm volatile("s_waitcnt lgkmcnt(0)" ::: "memory")
__device__ __forceinline__ unsigned f2bf(float f) { unsigned u = __builtin_bit_cast(unsigned, f); return (u + 0x7fffu + ((u >> 16) & 1u)) >> 16; }
__device__ __forceinline__ unsigned pk2(float lo, float hi) { return f2bf(lo) | (f2bf(hi) << 16); }
__device__ __forceinline__ float bf2f(unsigned short b) { return __builtin_bit_cast(float, (unsigned)b << 16); }
__device__ __forceinline__ float bflo(unsigned w) { return __builtin_bit_cast(float, w << 16); }
__device__ __forceinline__ float bfhi(unsigned w) { return __builtin_bit_cast(float, w & 0xffff0000u); }
__device__ __forceinline__ float wave_sum(float v) {
#pragma unroll
    for (int o = 1; o < 64; o <<= 1) v += __shfl_xor(v, o);
    return v;
}
__device__ __forceinline__ float wave_max(float v) {
#pragma unroll
    for (int o = 1; o < 64; o <<= 1) v = fmaxf(v, __shfl_xor(v, o));
    return v;
}

#define XB_TMO      128
#define XB_XCNT(j)  (256  + 64 * (j))
#define XB_XSUB(j)  (1280 + 64 * (j))
#define XB_XGEN(j)  (2304 + 64 * (j))
#define XB_TOP      3328
#define XB_TOPGEN   3392
#define XCD_BAR_WORDS 3456
#define XB_SPIN_CAP (1u << 22)

__device__ __forceinline__ unsigned xb_ld(unsigned* p)              { return __hip_atomic_load(p, __ATOMIC_RELAXED, __HIP_MEMORY_SCOPE_AGENT); }
__device__ __forceinline__ unsigned xb_add(unsigned* p, unsigned v) { return __hip_atomic_fetch_add(p, v, __ATOMIC_RELAXED, __HIP_MEMORY_SCOPE_AGENT); }
__device__ __forceinline__ unsigned xb_xcc_id() { return (unsigned)__builtin_amdgcn_s_getreg((3 << 11) | 20) & 0xFu; }
#define XB_SPIN(cond, bar) do { unsigned _sp = 0; while (cond) { __builtin_amdgcn_s_sleep(1); \
    if ((++_sp & 255u) == 0u) { if (xb_ld(&(bar)[XB_TMO])) break; if (_sp > XB_SPIN_CAP) { atomicAdd(&(bar)[XB_TMO], 1u); break; } } } } while (0)

struct XcdBarrier {
    unsigned* bar; unsigned x;
    volatile LAS unsigned* st;
};

__device__ __forceinline__ XcdBarrier xcd_barrier_post(unsigned* bar, volatile LAS unsigned* st) {
    XcdBarrier b; b.bar = bar; b.x = xb_xcc_id(); b.st = st;
    if (threadIdx.x == 0) (void)xb_add(&bar[XB_XCNT(b.x)], 1u);
    return b;
}
__device__ __forceinline__ void xcd_barrier_complete(unsigned* bar, unsigned x, unsigned& nloc, unsigned& nx) {
    const unsigned G = gridDim.x * gridDim.y * gridDim.z;
    unsigned sum, cnt, mine, sp = 0u;
    for (;;) {
        sum = 0u; cnt = 0u; mine = 0u;
#pragma unroll
        for (unsigned j = 0; j < 16; ++j) { const unsigned c = xb_ld(&bar[XB_XCNT(j)]); sum += c; cnt += (c > 0u) ? 1u : 0u; mine = (j == x) ? c : mine; }
        if (sum == G) break;
        __builtin_amdgcn_s_sleep(1);
        if ((++sp & 255u) == 0u) { if (xb_ld(&bar[XB_TMO])) break; if (sp > XB_SPIN_CAP) { atomicAdd(&bar[XB_TMO], 1u); break; } }
    }
    nloc = mine > 0u ? mine : 1u; nx = cnt > 0u ? cnt : 1u;
}

__device__ __forceinline__ void xcd_barrier(const XcdBarrier& b) {
    asm volatile("s_waitcnt vmcnt(0)" ::: "memory");
    __syncthreads();
    if (threadIdx.x == 0) {
        unsigned* bar = b.bar;
        __builtin_amdgcn_s_waitcnt(0);
        unsigned nloc = b.st[0], nx = b.st[1];
        if (nloc == 0u) { xcd_barrier_complete(bar, b.x, nloc, nx); b.st[0] = nloc; b.st[1] = nx; }
        const unsigned old = xb_add(&bar[XB_XSUB(b.x)], 1u);
        const unsigned gen = old / nloc;
        if (old + 1u == (gen + 1u) * nloc) {
            __builtin_amdgcn_fence(__ATOMIC_RELEASE, "agent");
            asm volatile("s_waitcnt vmcnt(0)" ::: "memory");
            const unsigned og = xb_add(&bar[XB_TOP], 1u);
            const unsigned tg = og / nx;
            if (og + 1u == (tg + 1u) * nx) xb_add(&bar[XB_TOPGEN], 1u);
            else XB_SPIN(xb_ld(&bar[XB_TOPGEN]) == tg, bar);
            __builtin_amdgcn_fence(__ATOMIC_ACQUIRE, "agent");
            xb_add(&bar[XB_XGEN(b.x)], 1u);
            asm volatile("s_waitcnt vmcnt(0)" ::: "memory");
        } else {
            XB_SPIN(xb_ld(&bar[XB_XGEN(b.x)]) == gen, bar);
            __builtin_amdgcn_fence(__ATOMIC_ACQUIRE, "agent");
            asm volatile("s_waitcnt vmcnt(0)" ::: "memory");
        }
    }
    __syncthreads();
}


struct Args { const void* in[30]; float* out; unsigned char* ws; int ph_lo, ph_hi; };
struct Frame {
    unsigned char* lds;
    int tid, lane, wave, vcu, G, gw, NGW;
    unsigned char* ws;
};

__device__ __forceinline__ int t5_bucket(int n) {
    if (n < 16) return n < 0 ? 0 : n;
    int b = 16;
    b += (n >= 22); b += (n >= 30); b += (n >= 40); b += (n >= 54); b += (n >= 73); b += (n >= 99); b += (n >= 134); b += (n >= 182);
    b += (n >= 246); b += (n >= 332); b += (n >= 450); b += (n >= 609); b += (n >= 825); b += (n >= 1117); b += (n >= 1513);
    return b;
}

__device__ __forceinline__ unsigned pk4_fp8(float a, float b, float c, float d) { int w = 0; w = __builtin_amdgcn_cvt_pk_fp8_f32(a, b, w, false); w = __builtin_amdgcn_cvt_pk_fp8_f32(c, d, w, true); return (unsigned)w; }
template <int MAP, bool OUT8 = false>
__device__ __forceinline__ void p0_transpose_item(const float* W, const float* W2, int K, int Nsrc, int Ndst, bf16* WT, const float* kscale, float* scr, int item, int lane, float oscale = 1.0f) {
    const int nblk = Ndst / 64, kb = item / nblk, nb = item % nblk, k0 = 64 * kb, n0 = 64 * nb;
    const int n4 = (lane & 15) * 4, n = n0 + n4, kr = lane >> 4;
    const float* src = W; int sc = n; bool ok = true;
    if (MAP == 1) { if (n < Z_QLAT) sc = n; else if (n < Z_NG) sc = n + 24; else if (n < Z_NG + 24) sc = n - Z_NG + 2560; else ok = false; }
    if (MAP == 2) { const int g32 = n >> 5, w = n & 31; src = (w < 16) ? W : W2; sc = g32 * 16 + (w & 15); }
    f32x4 v[16];
#pragma unroll
    for (int i = 0; i < 16; ++i) v[i] = ok ? __builtin_nontemporal_load((const f32x4*)(src + (size_t)(k0 + 4 * i + kr) * Nsrc + sc)) : (f32x4){0.f, 0.f, 0.f, 0.f};
#pragma unroll
    for (int i = 0; i < 16; ++i) { const int kk = 4 * i + kr; f32x4 t = v[i]; if (kscale) t = t * kscale[k0 + kk]; float* d = scr + kk * 65 + n4; d[0] = t.x; d[1] = t.y; d[2] = t.z; d[3] = t.w; }
    LDS_WAIT(); asm volatile("" ::: "memory");
    if constexpr (OUT8) {
        const int kg = lane & 3;
#pragma unroll
        for (int p = 0; p < 4; ++p) { const int nn = 16 * p + (lane >> 2); const float* s = scr + (16 * kg) * 65 + nn;
            v4u o; o.x = pk4_fp8(s[0 * 65] * oscale, s[1 * 65] * oscale, s[2 * 65] * oscale, s[3 * 65] * oscale); o.y = pk4_fp8(s[4 * 65] * oscale, s[5 * 65] * oscale, s[6 * 65] * oscale, s[7 * 65] * oscale);
            o.z = pk4_fp8(s[8 * 65] * oscale, s[9 * 65] * oscale, s[10 * 65] * oscale, s[11 * 65] * oscale); o.w = pk4_fp8(s[12 * 65] * oscale, s[13 * 65] * oscale, s[14 * 65] * oscale, s[15 * 65] * oscale);
            *(v4u*)((unsigned char*)WT + (size_t)(n0 + nn) * K + k0 + 16 * kg) = o; }
    } else {
    const int kg = lane & 7;
#pragma unroll
    for (int p = 0; p < 8; ++p) { const int nn = 8 * p + (lane >> 3); const float* s = scr + (8 * kg) * 65 + nn;
        v4u o; o.x = pk2(s[0 * 65], s[1 * 65]); o.y = pk2(s[2 * 65], s[3 * 65]); o.z = pk2(s[4 * 65], s[5 * 65]); o.w = pk2(s[6 * 65], s[7 * 65]);
        *(v4u*)(WT + (size_t)(n0 + nn) * K + k0 + 8 * kg) = o; }
    }
    LDS_WAIT(); asm volatile("" ::: "memory");
}
template <int MAP, bool OUT8 = false>
__device__ __forceinline__ void p0_transpose(Frame& F, const float* W, const float* W2, int K, int Nsrc, int Ndst, bf16* WT, const float* kscale, float oscale = 1.0f) {
    float* scr = (float*)(F.lds + F.wave * 16640);
    const int nitems = (K / 64) * (Ndst / 64);
    for (int it = F.gw; it < nitems; it += F.NGW) p0_transpose_item<MAP, OUT8>(W, W2, K, Nsrc, Ndst, WT, kscale, scr, it, F.lane, oscale);
}

__device__ __forceinline__ void modnorm_row(const float* xrow, const float* g, const float* sc, const float* sh, bf16* orow, int lane, f32x4 (&v)[8]) {
    const f32x4* xr = (const f32x4*)xrow + lane; float s = 0.f;
#pragma unroll
    for (int j = 0; j < 8; ++j) { v[j] = xr[64 * j]; s += (v[j].x * v[j].x + v[j].y * v[j].y) + (v[j].z * v[j].z + v[j].w * v[j].w); }
    const float rinv = 1.0f / sqrtf(wave_sum(s) * (1.f / D) + RMS_EPS);
    unsigned long long* o8 = (unsigned long long*)orow + lane;
#pragma unroll
    for (int j = 0; j < 8; ++j) { const f32x4 gg = ((const f32x4*)g)[lane + 64 * j], cc = ((const f32x4*)sc)[lane + 64 * j], hh = ((const f32x4*)sh)[lane + 64 * j];
        v[j] = (v[j] * rinv) * gg * (cc + 1.0f) + hh;
        o8[64 * j] = (unsigned long long)pk2(v[j].x, v[j].y) | ((unsigned long long)pk2(v[j].z, v[j].w) << 32); }
}
__device__ __forceinline__ void modnorm_phase(Frame& F, const float* x, const float* g, const float* mod  , int sh_idx, bf16* H) {
    for (int b = 0; b < NB; ++b) { const float* mb = mod + (size_t)b * 6 * D; const float* sc = mb + (size_t)(sh_idx + 1) * D; const float* sh = mb + (size_t)sh_idx * D;
        const int s0 = F.gw, s1 = F.gw + F.NGW;
        const f32x4* x0 = (const f32x4*)(x + ((size_t)b * S + s0) * D) + F.lane; const f32x4* x1 = (const f32x4*)(x + ((size_t)b * S + s1) * D) + F.lane;
        f32x4 v0[8], v1[8], ca[8], cc[8];
#pragma unroll
        for (int j = 0; j < 8; ++j) { v0[j] = x0[64 * j]; v1[j] = x1[64 * j]; }
#pragma unroll
        for (int j = 0; j < 8; ++j) { ca[j] = ((const f32x4*)g)[F.lane + 64 * j] * (((const f32x4*)sc)[F.lane + 64 * j] + 1.0f); cc[j] = ((const f32x4*)sh)[F.lane + 64 * j]; }
        float q0 = 0.f, q1 = 0.f;
#pragma unroll
        for (int j = 0; j < 8; ++j) { q0 += (v0[j].x * v0[j].x + v0[j].y * v0[j].y) + (v0[j].z * v0[j].z + v0[j].w * v0[j].w); q1 += (v1[j].x * v1[j].x + v1[j].y * v1[j].y) + (v1[j].z * v1[j].z + v1[j].w * v1[j].w); }
        const float r0 = 1.0f / sqrtf(wave_sum(q0) * (1.f / D) + RMS_EPS), r1 = 1.0f / sqrtf(wave_sum(q1) * (1.f / D) + RMS_EPS);
        unsigned long long* o0 = (unsigned long long*)(H + ((size_t)b * S + s0) * D) + F.lane; unsigned long long* o1 = (unsigned long long*)(H + ((size_t)b * S + s1) * D) + F.lane;
#pragma unroll
        for (int j = 0; j < 8; ++j) { const f32x4 a = (v0[j] * r0) * ca[j] + cc[j], c2 = (v1[j] * r1) * ca[j] + cc[j];
            o0[64 * j] = (unsigned long long)pk2(a.x, a.y) | ((unsigned long long)pk2(a.z, a.w) << 32); o1[64 * j] = (unsigned long long)pk2(c2.x, c2.y) | ((unsigned long long)pk2(c2.z, c2.w) << 32); }
    }
}

struct NA { const bf16* k; long kstride; const bf16* k2; long k2stride; int dq, dq2; const bf16* v; long vstride; int t0, tstep, nk; const float* bias; int brel0, bstep; float scale; unsigned long long cmask; int use_sel; };
__device__ __forceinline__ void na_run(const NA& a, const float* qs, float* sc, int lane, float& mx, float& sum, float& o0, float& o1) {
    float lmax = -3.0e38f;
    for (int c = 0; c * 64 < a.nk; ++c) {
        const int kk = c * 64 + lane; float s = -__builtin_inff();
        const bool chunk_ok = !a.use_sel || ((a.cmask >> ((a.t0 + c * 64 * a.tstep) >> 6)) & 1ull);
        if (chunk_ok && kk < a.nk) {
            const long t = a.t0 + (long)kk * a.tstep; const bf16* kr = a.k + t * a.kstride; float acc = 0.f;
            for (int d = 0; d < a.dq; d += 8) { const v4u w = *(const v4u*)(kr + d); const float* q = qs + d;
                acc += bflo(w.x) * q[0] + bfhi(w.x) * q[1] + bflo(w.y) * q[2] + bfhi(w.y) * q[3] + bflo(w.z) * q[4] + bfhi(w.z) * q[5] + bflo(w.w) * q[6] + bfhi(w.w) * q[7]; }
            if (a.dq2) { const bf16* k2r = a.k2 + t * a.k2stride;
                for (int d = 0; d < a.dq2; d += 8) { const v4u w = *(const v4u*)(k2r + d); const float* q = qs + a.dq + d;
                    acc += bflo(w.x) * q[0] + bfhi(w.x) * q[1] + bflo(w.y) * q[2] + bfhi(w.y) * q[3] + bflo(w.z) * q[4] + bfhi(w.z) * q[5] + bflo(w.w) * q[6] + bfhi(w.w) * q[7]; } }
            s = acc * a.scale; if (a.bias) s += a.bias[a.brel0 - kk * a.bstep];
        }
        if (kk < a.nk) sc[kk] = s;
        lmax = fmaxf(lmax, s);
    }
    mx = wave_max(lmax);
    float ls = 0.f;
    for (int kk = lane; kk < a.nk; kk += 64) { const float p = __expf(sc[kk] - mx); sc[kk] = p; ls += p; }
    sum = wave_sum(ls);
    LDS_WAIT(); asm volatile("" ::: "memory");
    float a0 = 0.f, a1 = 0.f;
    for (int kk = 0; kk < a.nk; ++kk) { const float p = sc[kk]; if (p != 0.f) { const unsigned w = *(const unsigned*)(a.v + (long)(a.t0 + (long)kk * a.tstep) * a.vstride + 2 * lane); a0 += p * bflo(w); a1 += p * bfhi(w); } }
    o0 = a0; o1 = a1;
    asm volatile("" ::: "memory");
}
__device__ __forceinline__ float gelu_tanh(float x) { const float u = 0.7978845608028654f * (x + 0.044715f * x * x * x); return 0.5f * x * (1.0f + tanhf(u)); }
__device__ __forceinline__ float sigmoid_f(float x) { return 1.0f / (1.0f + __expf(-x)); }

__global__ void __launch_bounds__(NWAVES * 64, 2) fwd(Args args) {
    extern __shared__ __attribute__((aligned(16))) unsigned char lds[];
    Frame F;
    F.lds = lds; F.ws = args.ws;
    F.tid = threadIdx.x; F.lane = F.tid & 63; F.wave = __builtin_amdgcn_readfirstlane(F.tid >> 6);
    F.G = gridDim.x; { const int bx = blockIdx.x; F.vcu = (F.G % 8 == 0) ? (bx % 8) * (F.G / 8) + bx / 8 : bx; }
    F.gw = F.vcu * NWAVES + F.wave; F.NGW = F.G * NWAVES;
    unsigned char* ws = args.ws;
    unsigned* ctl = (unsigned*)(ws + WS_CTL);
    volatile LAS unsigned* MISC = (volatile LAS unsigned*)((LAS unsigned char*)lds + MISC_OFF);
    for (int u = F.tid; u < 64; u += NWAVES * 64) MISC[u] = 0u;
    __syncthreads();
    XcdBarrier bar; bar.bar = ctl + CW_BAR; bar.x = 0; bar.st = nullptr;
    if (MK_N_LAUNCHES == 1) bar = xcd_barrier_post(ctl + CW_BAR, MISC + 8);
    const int lo = args.ph_lo, hi = args.ph_hi;
    unsigned long long tprev_ = PROBE_MASK ? wall_clock64() : 0ull;
#define IN(k) (lo <= (k) && (k) < hi)
#ifndef PROBE_MASK
#define PROBE_MASK 0
#endif
#ifndef MOE_F8
#define MOE_F8 0
#endif
#define MOE_WSCALE 64.0f
#ifndef PROBE_IDLE_AT
#define PROBE_IDLE_AT (-1)
#endif
#define REPK(k)
#define SEAM(k) do { if (IN(k) && IN((k) + 1)) { xcd_barrier(bar); \
        if ((PROBE_MASK >> (k)) & 1) { const unsigned long long t1_ = wall_clock64(); while (wall_clock64() < t1_ + (t1_ - tprev_)) __builtin_amdgcn_s_sleep(8); __syncthreads(); } \
        if (PROBE_IDLE_AT == (k)) { const unsigned long long t1_ = wall_clock64(); while (wall_clock64() < t1_ + 100000ull) __builtin_amdgcn_s_sleep(8); __syncthreads(); } \
        if (PROBE_MASK) tprev_ = wall_clock64(); } } while (0)

    const float* x_in = (const float*)args.in[0]; const float* c_in = (const float*)args.in[1]; const int* positions = (const int*)args.in[2];
    const float* rel_bias = (const float*)args.in[3]; const float* ada_w = (const float*)args.in[4]; const float* ada_b = (const float*)args.in[5];
    const float* mix_norm_g = (const float*)args.in[6]; const float* ffn_norm_g = (const float*)args.in[7];
    const float* ab_w_in = (const float*)args.in[8]; const float* ab_w_out = (const float*)args.in[9];
    const float* cmp_pos_k = (const float*)args.in[10]; const float* cmp_w1_k = (const float*)args.in[11]; const float* cmp_w2_k = (const float*)args.in[12];
    const float* cmp_pos_v = (const float*)args.in[13]; const float* cmp_w1_v = (const float*)args.in[14]; const float* cmp_w2_v = (const float*)args.in[15];
    const float* q_norm_g = (const float*)args.in[16]; const float* kv_norm_g = (const float*)args.in[17]; const float* w_uq = (const float*)args.in[18]; const float* w_ukv = (const float*)args.in[19];
    const float* ffn_wg = (const float*)args.in[20]; const float* ffn_wu = (const float*)args.in[21]; const float* ffn_wd = (const float*)args.in[22];
    const float* c_w_in = (const float*)args.in[23]; const float* c_w_out = (const float*)args.in[24]; const float* w_router = (const float*)args.in[25];
    const float* moe_wg = (const float*)args.in[26]; const float* moe_wu = (const float*)args.in[27]; const float* moe_wd = (const float*)args.in[28]; const float* final_g = (const float*)args.in[29];
    float* MOD = (float*)(ws + WS_MOD); float* BIAS = (float*)(ws + WS_BIAS); float* ROPE = (float*)(ws + WS_ROPE); float* RINV = (float*)(ws + WS_RINV);
    unsigned long long* SEL = (unsigned long long*)(ws + WS_SEL); bf16* KC = (bf16*)(ws + WS_KC); bf16* VC = (bf16*)(ws + WS_VC); int* ROUTE = (int*)(ws + WS_ROUTE); bf16* KPE = (bf16*)(ws + WS_KPE);
    bf16* W_IN0 = (bf16*)(ws + WS_WIN0); bf16* W_UQ = (bf16*)(ws + WS_WUQ); bf16* W_UKV = (bf16*)(ws + WS_WUKV); bf16* W_OUT0 = (bf16*)(ws + WS_WOUT0); bf16* W_GU0 = (bf16*)(ws + WS_WGU0); bf16* W_DN0 = (bf16*)(ws + WS_WDN0);
    bf16* W_IN1 = (bf16*)(ws + WS_WIN1); bf16* W_OUT1 = (bf16*)(ws + WS_WOUT1); bf16* W_MGU = (bf16*)(ws + WS_WMGU); bf16* W_MDN = (bf16*)(ws + WS_WMDN);
    float* X = (float*)(ws + WS_X); bf16* H = (bf16*)(ws + WS_H);
    bf16* Z0 = (bf16*)(ws + WS_Z0); bf16* QM = (bf16*)(ws + WS_QM); bf16* KVM = (bf16*)(ws + WS_KVM); bf16* OCMP = (bf16*)(ws + WS_OCMP); bf16* OWIN = (bf16*)(ws + WS_OWIN); bf16* CAT = (bf16*)(ws + WS_CAT);
    bf16* W1T = (bf16*)(ws + WS_W1T); bf16* W2T = (bf16*)(ws + WS_W2T); float* CB1 = (float*)(ws + WS_CB1);
    float* LSEB = (float*)(ws + WS_LSE); bf16* OP = (bf16*)(ws + WS_OP);
    bf16* ACT = (bf16*)(ws + WS_ACT); bf16* Z1 = (bf16*)(ws + WS_Z1); bf16* OM = (bf16*)(ws + WS_OM); bf16* XB = (bf16*)(ws + WS_XB); bf16* ACTB = (bf16*)(ws + WS_ACTB); bf16* YB = (bf16*)(ws + WS_YB);
    float* wsc = (float*)(lds + F.wave * 16384);
    float* wsm = (float*)(lds + SMALL_OFF + F.wave * 2048);
    PG8_LAS unsigned char* ring = (PG8_LAS unsigned char*)lds;

    REPK(0) if (IN(0)) {
        for (int job = 192 + (int)blockIdx.x; job < 194; job += F.G) {
            float* red = (float*)(lds + 32768); const int c = job - 192; const float* pos = c ? cmp_pos_v : cmp_pos_k; const float* w1 = c ? cmp_w1_v : cmp_w1_k;
            float a0 = 0.f, a1 = 0.f;
#pragma unroll 8
            for (int k = 0; k < 512; ++k) { const int kk = F.wave * 512 + k; const f32x2 wv = *(const f32x2*)(w1 + (size_t)kk * 128 + 2 * F.lane); const float pv = pos[kk]; a0 += pv * wv.x; a1 += pv * wv.y; }
            red[F.wave * 128 + 2 * F.lane] = a0; red[F.wave * 128 + 2 * F.lane + 1] = a1;
            __syncthreads();
            if (F.tid < 128) { float s = 0.f;
#pragma unroll
                for (int w = 0; w < 8; ++w) s += red[w * 128 + F.tid];
                CB1[c * 128 + F.tid] = s; }
            __syncthreads();
        }
        for (int job = blockIdx.x; job < 256; job += F.G) {
            float* cs = (float*)lds; float* red = (float*)(lds + 32768);
            for (int i = F.tid; i < 4 * D; i += 512) { const float cv = c_in[i]; cs[i] = cv / (1.0f + __expf(-cv)); }
            __syncthreads();
            const int l = job >> 7, col0 = (job & 127) * 96; const bool act = F.lane < 48;
            float acc[4][2] = {};
            const float* wp = ada_w + ((size_t)l * D + (size_t)F.wave * 256) * 12288 + col0 + 2 * (act ? F.lane : 0);
#pragma unroll 8
            for (int k = 0; k < 256; ++k) { const f32x2 wv = *(const f32x2*)(wp + (size_t)k * 12288); const int kk = F.wave * 256 + k;
#pragma unroll
                for (int b = 0; b < 4; ++b) { const float cv = cs[b * D + kk]; acc[b][0] += cv * wv.x; acc[b][1] += cv * wv.y; } }
            if (act) {
#pragma unroll
                for (int b = 0; b < 4; ++b) { red[(F.wave * 4 + b) * 96 + 2 * F.lane] = acc[b][0]; red[(F.wave * 4 + b) * 96 + 2 * F.lane + 1] = acc[b][1]; } }
            __syncthreads();
            if (F.tid < 384) { const int b = F.tid / 96, cc = F.tid % 96; float s = 0.f;
#pragma unroll
              for (int w = 0; w < 8; ++w) s += red[(w * 4 + b) * 96 + cc];
              MOD[((size_t)l * 4 + b) * 12288 + col0 + cc] = s + ada_b[(size_t)l * 12288 + col0 + cc]; }
            __syncthreads();
        }
        __syncthreads();
        p0_transpose<1>(F, ab_w_in, nullptr, D, 3672, Z0W, W_IN0, nullptr);
        p0_transpose<0>(F, w_uq, nullptr, 512, QMW, QMW, W_UQ, q_norm_g);
        p0_transpose<0>(F, w_ukv, nullptr, 512, KVMW, KVMW, W_UKV, kv_norm_g);
        p0_transpose<0>(F, ab_w_out, nullptr, D, D, D, W_OUT0, nullptr);
        p0_transpose<2>(F, ffn_wg, ffn_wu, D, FF, 2 * FF, W_GU0, nullptr);
        p0_transpose<0>(F, ffn_wd, nullptr, FF, D, D, W_DN0, nullptr);
        p0_transpose<0>(F, c_w_in, nullptr, D, Z1W, Z1W, W_IN1, nullptr);
        p0_transpose<0>(F, c_w_out, nullptr, 1024, D, D, W_OUT1, nullptr);
        p0_transpose<0>(F, cmp_w1_k, nullptr, 4096, 128, 128, W1T, nullptr); p0_transpose<0>(F, cmp_w1_v, nullptr, 4096, 128, 128, W1T + 128 * 4096, nullptr);
        p0_transpose<0>(F, cmp_w2_k, nullptr, 128, 128, 128, W2T, nullptr); p0_transpose<0>(F, cmp_w2_v, nullptr, 128, 128, 128, W2T + 128 * 128, nullptr);
        for (int e = 0; e < NE; ++e) {
#if MOE_F8
            p0_transpose<2, true>(F, moe_wg + (size_t)e * D * FFE, moe_wu + (size_t)e * D * FFE, D, FFE, 2 * FFE, (bf16*)((unsigned char*)W_MGU + (size_t)e * 2 * FFE * D), nullptr, MOE_WSCALE);
#else
            p0_transpose<2>(F, moe_wg + (size_t)e * D * FFE, moe_wu + (size_t)e * D * FFE, D, FFE, 2 * FFE, W_MGU + (size_t)e * 2 * FFE * D, nullptr);
#endif
            p0_transpose<0>(F, moe_wd + (size_t)e * FFE * D, nullptr, FFE, D, D, W_MDN + (size_t)e * D * FFE, nullptr);
        }
        for (int i = F.gw * 64 + F.lane; i < 8 * BIAS_LD; i += F.NGW * 64) { const int h = i / BIAS_LD, r = i % BIAS_LD - 64; BIAS[i] = rel_bias[t5_bucket(r) * 8 + h]; }
        for (int i = F.gw * 64 + F.lane; i < M * 32; i += F.NGW * 64) { const int m = i >> 5, f = i & 31;
            const float inv_freq = powf(10000.0f, -(float)(2 * f) / 64.0f); const float ang = (float)positions[m] * inv_freq;
            ROPE[(size_t)m * 64 + f] = cosf(ang); ROPE[(size_t)m * 64 + 32 + f] = sinf(ang); }
    }
    SEAM(0);
    REPK(1) if (IN(1)) modnorm_phase(F, x_in, mix_norm_g, MOD, 0, H);
    SEAM(1);
    REPK(2) if (IN(2)) { pg8::Gemm g{H, W_IN0, D, D, D}; pg8::StaticOrder So; So.init(M, Z0W, F.G, (int)blockIdx.x); pg8::EpiBf16 E{Z0, Z0W, nullptr};
        pg8::gemm_phase<pg8::EpiBf16, pg8::StaticOrder, PG_ALIGN, PG_SP2>(ring, g, So, E); }
    SEAM(2);
    REPK(3) if (IN(3)) {
        for (int m = F.gw; m < M; m += F.NGW) {
            const bf16* zr = Z0 + (size_t)m * Z0W;
#pragma unroll
            for (int w = 0; w < 2; ++w) { const v4u a = *(const v4u*)(zr + (w ? Z_KVLAT : Z_QLAT) + 8 * F.lane);
                float s = bflo(a.x) * bflo(a.x) + bfhi(a.x) * bfhi(a.x) + bflo(a.y) * bflo(a.y) + bfhi(a.y) * bfhi(a.y) + bflo(a.z) * bflo(a.z) + bfhi(a.z) * bfhi(a.z) + bflo(a.w) * bflo(a.w) + bfhi(a.w) * bfhi(a.w);
                s = wave_sum(s); if (F.lane == 0) RINV[(size_t)w * M + m] = 1.0f / sqrtf(s * (1.f / 512.f) + RMS_EPS); }
            if (F.lane < 32) { const float x1 = bf2f(zr[Z_KPE + F.lane]), x2 = bf2f(zr[Z_KPE + 32 + F.lane]); const float cs = ROPE[(size_t)m * 64 + F.lane], sn = ROPE[(size_t)m * 64 + 32 + F.lane];
                KPE[(size_t)m * 64 + F.lane] = (bf16)f2bf(x1 * cs - x2 * sn); KPE[(size_t)m * 64 + 32 + F.lane] = (bf16)f2bf(x2 * cs + x1 * sn); }
        }
        __syncthreads();
        for (int job = blockIdx.x; job < 256; job += F.G) {
            typedef short bfx8 __attribute__((ext_vector_type(8)));
            const int nt = job & 15, g = (job >> 4) & 1, b = (job >> 5) & 3, c = job >> 7, n0 = nt * 16;
            const int fr = F.lane & 15, fq = F.lane >> 4; int nrow = n0 + fr; if (nrow > 254) nrow = 254;
            const bf16* arow = Z0 + ((size_t)b * S + 16 * nrow) * Z0W + Z_NKV + c * 256 + g * 128 + fq * 8;
            const bf16* w1t = W1T + (size_t)c * 128 * 4096 + (size_t)fr * 4096 + fq * 8;
            f32x4 acc[8];
#pragma unroll
            for (int i = 0; i < 8; ++i) acc[i] = (f32x4){0.f, 0.f, 0.f, 0.f};
#pragma unroll 2
            for (int ks = 0; ks < 16; ++ks) { const int kk = F.wave * 512 + ks * 32, l = kk >> 7, d0 = kk & 127;
                const bfx8 af = *(const bfx8*)(arow + (size_t)l * Z0W + d0);
#pragma unroll
                for (int i = 0; i < 8; ++i) { const bfx8 bfr = *(const bfx8*)(w1t + (size_t)i * 16 * 4096 + kk); acc[i] = __builtin_amdgcn_mfma_f32_16x16x32_bf16(af, bfr, acc[i], 0, 0, 0); } }
            float* part = (float*)lds;
#pragma unroll
            for (int i = 0; i < 8; ++i)
#pragma unroll
                for (int j = 0; j < 4; ++j) part[(F.wave * 16 + fq * 4 + j) * 128 + i * 16 + fr] = acc[i][j];
            __syncthreads();
            bf16* hid = (bf16*)(lds + 65536);
            { const int row = F.tid >> 5, c4 = (F.tid & 31) * 4; f32x4 s = *(const f32x4*)(CB1 + c * 128 + c4);
#pragma unroll
              for (int w = 0; w < 8; ++w) s += *(const f32x4*)(part + (w * 16 + row) * 128 + c4);
              *(v2u*)(hid + row * 128 + c4) = (v2u){pk2(gelu_tanh(s.x), gelu_tanh(s.y)), pk2(gelu_tanh(s.z), gelu_tanh(s.w))}; }
            __syncthreads();
            { f32x4 o4 = {0.f, 0.f, 0.f, 0.f}; const bf16* w2t = W2T + (size_t)c * 128 * 128 + (size_t)(F.wave * 16 + fr) * 128 + fq * 8;
#pragma unroll
              for (int ks = 0; ks < 4; ++ks) { const bfx8 af = *(const bfx8*)(hid + fr * 128 + ks * 32 + fq * 8); const bfx8 bfr = *(const bfx8*)(w2t + ks * 32); o4 = __builtin_amdgcn_mfma_f32_16x16x32_bf16(af, bfr, o4, 0, 0, 0); }
              bf16* outp = (c ? VC : KC) + (((size_t)b * 2 + g) * 256) * 128 + F.wave * 16 + fr;
#pragma unroll
              for (int j = 0; j < 4; ++j) { const int n = n0 + fq * 4 + j; outp[(size_t)n * 128] = n < 255 ? (bf16)f2bf(o4[j]) : (bf16)0; } }
            __syncthreads();
        }
#if FLASH_WIN
        __syncthreads();
        for (int Lx = blockIdx.x; Lx < 512; Lx += F.G) {
            const int qb = 15 - Lx / 32, bh = Lx % 32, b = bh >> 3, h = bh & 7, g = h >> 2; const bf16* zb = Z0 + (size_t)b * S * Z0W;
            fa::Item it{}; it.Q = zb + Z_NQ + h * 128; it.qs = Z0W; it.K = zb + Z_NKV + 4 * 256 + g * 128; it.ks = Z0W; it.V = zb + Z_NKV + 5 * 256 + g * 128; it.vs = Z0W;
            it.P0 = qb * 256; it.skv = S; it.W = 512; it.bias = BIAS + (size_t)h * BIAS_LD + 64; it.bstep = 1; it.O = OWIN + (size_t)b * S * 1024 + h * 128; it.os = 1024;
            fa::attn_block<0>(it, lds);
        }
#else
        __syncthreads();
        for (int it = F.gw; it < M * 8; it += F.NGW) {
            const int h = it & 7, m = it >> 3, b = m / S, s = m % S, g = h >> 2;
            const bf16* qr = Z0 + (size_t)m * Z0W + Z_NQ + h * 128; wsm[2 * F.lane] = bf2f(qr[2 * F.lane]); wsm[2 * F.lane + 1] = bf2f(qr[2 * F.lane + 1]); LDS_WAIT(); asm volatile("" ::: "memory");
            const int t0 = s - 511 < 0 ? 0 : s - 511; NA a;
            a.k = Z0 + (size_t)b * S * Z0W + Z_NKV + 4 * 256 + g * 128; a.kstride = Z0W; a.k2 = nullptr; a.k2stride = 0; a.dq = 128; a.dq2 = 0;
            a.v = Z0 + (size_t)b * S * Z0W + Z_NKV + 5 * 256 + g * 128; a.vstride = Z0W; a.t0 = t0; a.tstep = 1; a.nk = s - t0 + 1;
            a.bias = BIAS + (size_t)h * BIAS_LD + 64; a.brel0 = s - t0; a.bstep = 1; a.scale = 0.08838834764831845f; a.cmask = 0; a.use_sel = 0;
            float mx, sum, o0, o1; na_run(a, wsm, wsc, F.lane, mx, sum, o0, o1);
            *(unsigned*)(OWIN + (size_t)m * 1024 + h * 128 + 2 * F.lane) = pk2(o0 / sum, o1 / sum);
        }
#endif
    }
    SEAM(3);
    REPK(4) if (IN(4)) {
        { pg8::Gemm g{Z0 + Z_QLAT, W_UQ, Z0W, 512, 512}; pg8::StaticOrder So; So.init(M, QMW, F.G, (int)blockIdx.x); pg8::EpiBf16 E{QM, QMW, RINV};
          pg8::gemm_phase<pg8::EpiBf16, pg8::StaticOrder, PG_ALIGN, PG_SP2>(ring, g, So, E); }
        __syncthreads();
        { pg8::Gemm g{Z0 + Z_KVLAT, W_UKV, Z0W, 512, 512}; pg8::StaticOrder So; So.init(M, KVMW, F.G, (int)blockIdx.x); pg8::EpiBf16 E{KVM, KVMW, RINV + M};
          pg8::gemm_phase<pg8::EpiBf16, pg8::StaticOrder, PG_ALIGN, PG_SP2>(ring, g, So, E); }
        __syncthreads();
#if FLASH_CMP != 1
        for (int it = F.gw; it < M * 2; it += F.NGW) {
            const int g = it & 1, m = it >> 1, b = m / S, s = m % S;
            const int nk = s >= 31 ? (s - 31) / 16 + 1 : 0;
            float* imp = wsm + 256;
            for (int i = F.lane; i < 256; i += 64) imp[i] = 0.f;
            for (int r = 0; r < 4; ++r) { const int h = g * 4 + r;
                const bf16* qr = Z0 + (size_t)m * Z0W + Z_NQ + h * 128; wsm[2 * F.lane] = bf2f(qr[2 * F.lane]); wsm[2 * F.lane + 1] = bf2f(qr[2 * F.lane + 1]); LDS_WAIT(); asm volatile("" ::: "memory");
                float o0 = 0.f, o1 = 0.f;
                if (nk > 0) { NA a; a.k = KC + ((size_t)b * 2 + g) * 256 * 128; a.kstride = 128; a.k2 = nullptr; a.k2stride = 0; a.dq = 128; a.dq2 = 0; a.v = VC + ((size_t)b * 2 + g) * 256 * 128; a.vstride = 128;
                    a.t0 = 0; a.tstep = 1; a.nk = nk; a.bias = BIAS + (size_t)h * BIAS_LD + 64; a.brel0 = s - 31; a.bstep = 16; a.scale = 0.08838834764831845f; a.cmask = 0; a.use_sel = 0;
                    float mx, sum; na_run(a, wsm, wsc, F.lane, mx, sum, o0, o1); const float inv = 1.0f / sum; o0 *= inv; o1 *= inv;
                    for (int i = F.lane; i < nk; i += 64) imp[i] += wsc[i] * inv; LDS_WAIT(); asm volatile("" ::: "memory"); }
                *(unsigned*)(OCMP + (size_t)m * 1024 + h * 128 + 2 * F.lane) = pk2(o0, o1);
            }
            const int j = F.lane, blk_t = s >> 6;
            float sc;
            { const float pm1 = (4 * j - 1 >= 0) ? imp[4 * j - 1] : 0.f, p0 = imp[4 * j], p1 = imp[4 * j + 1], p2 = imp[4 * j + 2], p3 = (4 * j + 3 < 255) ? imp[4 * j + 3] : 0.f;
              const float is = ((((((p0 + pm1) + p1) + p0) + p2) + p1) + p3) + p2;
              const bool forced = (j == 0) || (j == blk_t) || (j == blk_t - 1), valid = j <= blk_t;
              sc = forced ? 1e9f : (valid ? is : -1.0f); }
            int rank = 0;
            for (int k = 0; k < 64; ++k) { const float vk = __shfl(sc, k); rank += (vk > sc || (vk == sc && k < j)) ? 1 : 0; }
            const unsigned long long msk = __ballot(rank < 16 && sc > -0.5f);
            if (F.lane == 0) SEL[(size_t)m * 2 + g] = msk;
            asm volatile("" ::: "memory");
        }
        __syncthreads();
#endif
#if FLASH_CMP
        for (int Lx = blockIdx.x; Lx < 512; Lx += F.G) { const int tb = 63 - Lx / 8, bg = Lx % 8, b = bg >> 1, g = bg & 1;
            fa::CmpItem it; it.Q = Z0 + ((size_t)b * S + tb * 64) * Z0W + Z_NQ + g * 512; it.qs = Z0W; it.K = KC + ((size_t)b * 2 + g) * 256 * 128; it.V = VC + ((size_t)b * 2 + g) * 256 * 128;
            it.bias = BIAS + (size_t)(g * 4) * BIAS_LD + 64; it.bld = BIAS_LD; it.s0 = tb * 64; it.O = OCMP + ((size_t)b * S + tb * 64) * 1024 + g * 512; it.os = 1024; it.sel = SEL + ((size_t)b * S + tb * 64) * 2 + g;

            fa::cmp_block(it, lds, SMALL_OFF); }
#endif
    }
    SEAM(4);
    REPK(5) if (IN(5)) {
#if FLASH_SLC != 1
        for (int it = F.gw; it < M * 8; it += F.NGW) {
            const int h = it & 7, m = it >> 3, b = m / S, s = m % S, g = h >> 2;
            const bf16* zr = Z0 + (size_t)m * Z0W; const bf16* qr = zr + Z_NQ + h * 128; wsm[2 * F.lane] = bf2f(qr[2 * F.lane]); wsm[2 * F.lane + 1] = bf2f(qr[2 * F.lane + 1]); LDS_WAIT(); asm volatile("" ::: "memory");
            NA a; a.k = Z0 + (size_t)b * S * Z0W + Z_NKV + 2 * 256 + g * 128; a.kstride = Z0W; a.k2 = nullptr; a.k2stride = 0; a.dq = 128; a.dq2 = 0;
            a.v = Z0 + (size_t)b * S * Z0W + Z_NKV + 3 * 256 + g * 128; a.vstride = Z0W; a.t0 = 0; a.tstep = 1; a.nk = s + 1;
            a.bias = BIAS + (size_t)h * BIAS_LD + 64; a.brel0 = s; a.bstep = 1; a.scale = 0.08838834764831845f; a.cmask = SEL[(size_t)m * 2 + g]; a.use_sel = FA_DBG_NOSEL ? 0 : 1;
            float mx, sum, o0, o1; na_run(a, wsm, wsc, F.lane, mx, sum, o0, o1); o0 /= sum; o1 /= sum;
            const float g0 = sigmoid_f(bf2f(zr[Z_NG + h * 3 + 0])), g1 = sigmoid_f(bf2f(zr[Z_NG + h * 3 + 1])), g2 = sigmoid_f(bf2f(zr[Z_NG + h * 3 + 2]));
            const unsigned wc_ = *(const unsigned*)(OCMP + (size_t)m * 1024 + h * 128 + 2 * F.lane), ww_ = *(const unsigned*)(OWIN + (size_t)m * 1024 + h * 128 + 2 * F.lane);
            *(unsigned*)(CAT + (size_t)m * 2048 + h * 128 + 2 * F.lane) = FA_DBG_NOMERGE ? pk2(o0, o1) : pk2(g0 * bflo(wc_) + g1 * o0 + g2 * bflo(ww_), g0 * bfhi(wc_) + g1 * o1 + g2 * bfhi(ww_));
        }
        __syncthreads();
#endif
#if FLASH_SLC == 2
        __syncthreads();
#endif
#if FLASH_SLC
        for (int Lx = blockIdx.x; Lx < 256; Lx += F.G) {
            const int x = Lx / 32, bh = Lx % 32, b = bh >> 3, h = bh & 7, g = h >> 2; const bf16* zb = Z0 + (size_t)b * S * Z0W;
            for (int pass = 0; pass < 2; ++pass) { const int qb = pass ? 15 - x : x;
                fa::Item it{}; it.Q = zb + Z_NQ + h * 128; it.qs = Z0W; it.K = zb + Z_NKV + 2 * 256 + g * 128; it.ks = Z0W; it.V = zb + Z_NKV + 3 * 256 + g * 128; it.vs = Z0W;
                it.P0 = qb * 256; it.skv = S; it.W = 1 << 20; it.bias = BIAS + (size_t)h * BIAS_LD + 64; it.bstep = 1; it.sel = SEL + (size_t)b * S * 2 + g; it.sels = 2;
                it.O = CAT + (size_t)b * S * 2048 + h * 128; it.os = 2048;
#if FLASH_SLC == 2
                it.O = (bf16*)(ws + WS_R + 296 * MiB) + (size_t)b * S * 1024 + h * 128; it.os = 1024;
#endif
                it.M0 = OCMP + (size_t)b * S * 1024 + h * 128; it.M1 = OWIN + (size_t)b * S * 1024 + h * 128; it.ms = 1024; it.G = zb + Z_NG + h * 3; it.gs = Z0W;
                fa::attn_block<1>(it, lds); }
        }
#endif
#if FLASH_MLA
        for (int Lx = blockIdx.x; Lx < 256; Lx += F.G) {
            const int x = Lx / 32, bh = Lx % 32, b = bh >> 3, h = bh & 7;
            for (int pass = 0; pass < 2; ++pass) { const int qb = pass ? 15 - x : x;
                fa::Item it{}; it.Q = QM + (size_t)b * S * QMW + h * 192; it.qs = QMW; it.rope = ROPE + (size_t)b * S * 64; it.ropes = 64;
                it.K = KVM + (size_t)b * S * KVMW + h * 256; it.ks = KVMW; it.K2 = KPE + (size_t)b * S * 64; it.k2s = 64; it.V = KVM + (size_t)b * S * KVMW + h * 256 + 128; it.vs = KVMW;
                it.P0 = qb * 256; it.skv = S; it.W = 1 << 20; it.O = CAT + (size_t)b * S * 2048 + 1024 + h * 128; it.os = 2048;
                fa::attn_block<2>(it, lds); }
        }
#else
        for (int it = F.gw; it < M * 8; it += F.NGW) {
            const int h = it & 7, m = it >> 3, b = m / S, s = m % S;
            const bf16* qr = QM + (size_t)m * QMW + h * 192;
            wsm[2 * F.lane] = bf2f(qr[2 * F.lane]); wsm[2 * F.lane + 1] = bf2f(qr[2 * F.lane + 1]);
            if (F.lane < 32) { const float x1 = bf2f(qr[128 + F.lane]), x2 = bf2f(qr[160 + F.lane]); const float cs = ROPE[(size_t)m * 64 + F.lane], sn = ROPE[(size_t)m * 64 + 32 + F.lane];
                wsm[128 + F.lane] = x1 * cs - x2 * sn; wsm[160 + F.lane] = x2 * cs + x1 * sn; }
            LDS_WAIT(); asm volatile("" ::: "memory");
            NA a; a.k = KVM + (size_t)b * S * KVMW + h * 256; a.kstride = KVMW; a.k2 = KPE + (size_t)b * S * 64; a.k2stride = 64; a.dq = 128; a.dq2 = 64;
            a.v = KVM + (size_t)b * S * KVMW + h * 256 + 128; a.vstride = KVMW; a.t0 = 0; a.tstep = 1; a.nk = s + 1; a.bias = nullptr; a.brel0 = 0; a.bstep = 0; a.scale = 0.07216878364870322f; a.cmask = 0; a.use_sel = 0;
            float mx, sum, o0, o1; na_run(a, wsm, wsc, F.lane, mx, sum, o0, o1);
            *(unsigned*)(CAT + (size_t)m * 2048 + 1024 + h * 128 + 2 * F.lane) = pk2(o0 / sum, o1 / sum);
        }
#endif
    }
    SEAM(5);
    REPK(6) if (IN(6)) { pg8::Gemm g{CAT, W_OUT0, 2048, 2048, 2048}; pg8::StaticOrder So; So.init(M, D, F.G, (int)blockIdx.x); pg8::EpiResid E{x_in, X, D, MOD + 2 * D, 6 * D, S / 256};
        pg8::gemm_phase<pg8::EpiResid, pg8::StaticOrder, PG_ALIGN, PG_SP2>(ring, g, So, E); }
    SEAM(6);
    REPK(7) if (IN(7)) modnorm_phase(F, X, ffn_norm_g, MOD, 3, H);
    SEAM(7);
    REPK(8) if (IN(8)) { pg8::Gemm g{H, W_GU0, D, D, D}; pg8::StaticOrder So; So.init(M, 2 * FF, F.G, (int)blockIdx.x); pg8::EpiSwiGLU E{ACT, FF};
        pg8::gemm_phase<pg8::EpiSwiGLU, pg8::StaticOrder, PG_ALIGN, PG_SP2>(ring, g, So, E); }
    SEAM(8);
    REPK(9) if (IN(9)) { pg8::Gemm g{ACT, W_DN0, FF, FF, FF}; pg8::StaticOrder So; So.init(M, D, F.G, (int)blockIdx.x); pg8::EpiResid E{X, X, D, MOD + 5 * D, 6 * D, S / 256};
        pg8::gemm_phase<pg8::EpiResid, pg8::StaticOrder, PG_ALIGN, PG_SP2>(ring, g, So, E); }
    SEAM(9);
    REPK(10) if (IN(10)) modnorm_phase(F, X, mix_norm_g + D, MOD + 4 * 12288, 0, H);
    SEAM(10);
    REPK(11) if (IN(11)) { pg8::Gemm g{H, W_IN1, D, D, D}; pg8::StaticOrder So; So.init(M, Z1W, F.G, (int)blockIdx.x); pg8::EpiBf16 E{Z1, Z1W, nullptr};
        pg8::gemm_phase<pg8::EpiBf16, pg8::StaticOrder, PG_ALIGN, PG_SP2>(ring, g, So, E); }
    SEAM(11);
#if FLASH_DIL
    REPK(12) if (IN(12)) {
        for (int Lx = blockIdx.x; Lx < 1536; Lx += F.G) {
            const int p = Lx % 3, r_ = Lx / 3, bh = r_ % 32, sub = r_ / 32, b = bh >> 3, h = bh & 7;
            const int dil = p == 0 ? 1 : (p == 1 ? 4 : 16), res = p == 0 ? 0 : (p == 1 ? (sub & 3) : sub), qb = p == 0 ? sub : (p == 1 ? (sub >> 2) : 0);
            fa::Item it{}; it.Q = Z1 + ((size_t)b * S + res) * Z1W + p * 3072 + h * 128; it.qs = (long)dil * Z1W; it.K = it.Q + 1024; it.ks = it.qs; it.V = it.Q + 2048; it.vs = it.qs;
            it.P0 = qb * 256; it.skv = S / dil; it.W = 129; it.bias = BIAS + (size_t)h * BIAS_LD + 64; it.bstep = dil;
            it.O = OP + (size_t)p * M * 1024 + ((size_t)b * S + res) * 1024 + h * 128; it.os = (long)dil * 1024; it.LSE = LSEB + (size_t)p * M * 8 + ((size_t)b * S + res) * 8 + h; it.lses = (long)dil * 8;
            fa::attn_block<0>(it, lds);
        }
    }
#else
    REPK(12) if (IN(12)) {
        for (int it = F.gw; it < M * 8; it += F.NGW) {
            const int h = it & 7, m = it >> 3, b = m / S, s = m % S;
            float om0 = 0.f, om1 = 0.f, lm = -3.0e38f, wsum = 0.f;
#pragma unroll
            for (int p = 0; p < 3; ++p) { const int dil = p == 0 ? 1 : (p == 1 ? 4 : 16);
                const bf16* qr = Z1 + (size_t)m * Z1W + p * 3072 + h * 128; wsm[2 * F.lane] = bf2f(qr[2 * F.lane]); wsm[2 * F.lane + 1] = bf2f(qr[2 * F.lane + 1]); LDS_WAIT(); asm volatile("" ::: "memory");
                const int mq = s / dil, r = s % dil, m0 = mq - 128 < 0 ? 0 : mq - 128;
                NA a; a.k = Z1 + (size_t)b * S * Z1W + p * 3072 + 1024 + h * 128; a.kstride = Z1W; a.k2 = nullptr; a.k2stride = 0; a.dq = 128; a.dq2 = 0;
                a.v = Z1 + (size_t)b * S * Z1W + p * 3072 + 2048 + h * 128; a.vstride = Z1W; a.t0 = m0 * dil + r; a.tstep = dil; a.nk = mq - m0 + 1;
                a.bias = BIAS + (size_t)h * BIAS_LD + 64; a.brel0 = (mq - m0) * dil; a.bstep = dil; a.scale = 0.08838834764831845f; a.cmask = 0; a.use_sel = 0;
                float mx, sum, o0, o1; na_run(a, wsm, wsc, F.lane, mx, sum, o0, o1);
                const float lse = mx + __logf(sum); o0 /= sum; o1 /= sum;
                const float nm = fmaxf(lm, lse), ea = __expf(lm - nm), eb = __expf(lse - nm);
                om0 = om0 * ea + o0 * eb; om1 = om1 * ea + o1 * eb; wsum = wsum * ea + eb; lm = nm; }
            *(unsigned*)(OM + (size_t)m * 1024 + h * 128 + 2 * F.lane) = pk2(om0 / wsum, om1 / wsum);
        }
    }
#endif
    SEAM(12);
    REPK(13) if (IN(13) && FLASH_DIL) {
        for (int m = F.gw; m < M; m += F.NGW) {
#pragma unroll 2
            for (int h = 0; h < 8; ++h) { const float l0 = LSEB[(size_t)m * 8 + h], l1 = LSEB[(size_t)(M + m) * 8 + h], l2 = LSEB[(size_t)(2 * M + m) * 8 + h];
                const float mx = fmaxf(l0, fmaxf(l1, l2)), e0 = __expf(l0 - mx), e1 = __expf(l1 - mx), e2 = __expf(l2 - mx), inv = 1.0f / (e0 + e1 + e2);
                const unsigned a0 = *(const unsigned*)(OP + (size_t)m * 1024 + h * 128 + 2 * F.lane), a1 = *(const unsigned*)(OP + (size_t)(M + m) * 1024 + h * 128 + 2 * F.lane), a2 = *(const unsigned*)(OP + (size_t)(2 * M + m) * 1024 + h * 128 + 2 * F.lane);
                *(unsigned*)(OM + (size_t)m * 1024 + h * 128 + 2 * F.lane) = pk2((e0 * bflo(a0) + e1 * bflo(a1) + e2 * bflo(a2)) * inv, (e0 * bfhi(a0) + e1 * bfhi(a1) + e2 * bfhi(a2)) * inv); }
        }
    }
    SEAM(13);
    REPK(14) if (IN(14)) { pg8::Gemm g{OM, W_OUT1, 1024, 1024, 1024}; pg8::StaticOrder So; So.init(M, D, F.G, (int)blockIdx.x); pg8::EpiResid E{X, X, D, MOD + 4 * 12288 + 2 * D, 6 * D, S / 256};
        pg8::gemm_phase<pg8::EpiResid, pg8::StaticOrder, PG_ALIGN, PG_SP2>(ring, g, So, E); }
    SEAM(14);
    REPK(15) if (IN(15)) {
        for (int m = F.gw; m < M; m += F.NGW) { const int b = m / S; const float* mb = MOD + 4 * 12288 + (size_t)b * 6 * D; f32x4 v[8];
            modnorm_row(X + (size_t)m * D, ffn_norm_g + D, mb + 4 * D, mb + 3 * D, H + (size_t)m * D, F.lane, v);
            float lg[8] = {};
#pragma unroll
            for (int j = 0; j < 8; ++j) { const float* wr_ = w_router + (size_t)(4 * F.lane + 256 * j) * 8;
#pragma unroll
                for (int q = 0; q < 4; ++q) { const f32x4 wa = *(const f32x4*)(wr_ + q * 8), wb = *(const f32x4*)(wr_ + q * 8 + 4); const float hv = v[j][q];
                    lg[0] += hv * wa.x; lg[1] += hv * wa.y; lg[2] += hv * wa.z; lg[3] += hv * wa.w; lg[4] += hv * wb.x; lg[5] += hv * wb.y; lg[6] += hv * wb.z; lg[7] += hv * wb.w; } }
#pragma unroll
            for (int e = 0; e < 8; ++e) lg[e] = wave_sum(lg[e]);
            int e1 = 0; float v1 = lg[0];
#pragma unroll
            for (int e = 1; e < 8; ++e) if (lg[e] > v1) { v1 = lg[e]; e1 = e; }
            int e2 = -1; float v2 = -3.0e38f;
#pragma unroll
            for (int e = 0; e < 8; ++e) if (e != e1 && lg[e] > v2) { v2 = lg[e]; e2 = e; }
            if (F.lane == 0) { const float g1 = 1.0f / (1.0f + __expf(v2 - v1)), g2 = 1.0f - g1;
                const unsigned r1 = atomicAdd(ctl + CW_CNT + e1, 1u), r2 = atomicAdd(ctl + CW_CNT + e2, 1u);
                int* rt = ROUTE + (size_t)m * 8; rt[0] = e1; rt[1] = e2; rt[2] = (int)r1; rt[3] = (int)r2; rt[4] = __float_as_int(g1); rt[5] = __float_as_int(g2); }
        }
    }
    SEAM(15);
    REPK(16) if (IN(16)) {
        unsigned ts[9]; ts[0] = 0;
#pragma unroll
        for (int e = 0; e < 8; ++e) ts[e + 1] = ts[e] + (__hip_atomic_load(ctl + CW_CNT + e, __ATOMIC_RELAXED, __HIP_MEMORY_SCOPE_AGENT) + 255u) / 256u;
        if (blockIdx.x == 0 && F.tid < 9) { unsigned v = ts[0];
#pragma unroll
            for (int e = 1; e < 9; ++e) v = (F.tid == e) ? ts[e] : v;
            ctl[CW_TS + F.tid] = v; }
        for (int m = F.gw; m < M; m += F.NGW) { const int* rt = ROUTE + (size_t)m * 8; const int e1 = rt[0], e2 = rt[1]; unsigned t1 = 0, t2 = 0;
#pragma unroll
            for (int e = 0; e < 8; ++e) { t1 = (e == e1) ? ts[e] : t1; t2 = (e == e2) ? ts[e] : t2; }
            const size_t d1 = (size_t)t1 * 256 + rt[2], d2 = (size_t)t2 * 256 + rt[3];
            const v4u* src = (const v4u*)(H + (size_t)m * D) + F.lane;
#if MOE_F8
            v2u* o1 = (v2u*)((unsigned char*)XB + d1 * D) + F.lane; v2u* o2 = (v2u*)((unsigned char*)XB + d2 * D) + F.lane;
#pragma unroll
            for (int j = 0; j < 4; ++j) { const v4u w = src[64 * j]; v2u q; q.x = pk4_fp8(bflo(w.x), bfhi(w.x), bflo(w.y), bfhi(w.y)); q.y = pk4_fp8(bflo(w.z), bfhi(w.z), bflo(w.w), bfhi(w.w)); o1[64 * j] = q; o2[64 * j] = q; } }
#else
            v4u* o1 = (v4u*)(XB + d1 * D) + F.lane; v4u* o2 = (v4u*)(XB + d2 * D) + F.lane;
#pragma unroll
            for (int j = 0; j < 4; ++j) { const v4u w = src[64 * j]; o1[64 * j] = w; o2[64 * j] = w; } }
#endif
    }
    SEAM(16);
#if MOE_F8
    REPK(17) if (IN(17)) { pg8::Gemm g{XB, W_MGU, D / 2, D / 2, D / 2}; pg8::GroupedOrder So; So.init(ctl + CW_TS, 2 * FFE / 128, F.G, (int)blockIdx.x); pg8::EpiSwiGLUH E{ACTB, FFE, 1.0f / MOE_WSCALE};
        pg8::gemm_phase<pg8::EpiSwiGLUH, pg8::GroupedOrder, PG_ALIGN, PG_SP2, true>(ring, g, So, E); }
#else
    REPK(17) if (IN(17)) { pg8::Gemm g{XB, W_MGU, D, D, D}; pg8::GroupedOrder So; So.init(ctl + CW_TS, 2 * FFE / 256, F.G, (int)blockIdx.x); pg8::EpiSwiGLU E{ACTB, FFE};
        pg8::gemm_phase<pg8::EpiSwiGLU, pg8::GroupedOrder, PG_ALIGN, PG_SP2>(ring, g, So, E); }
#endif
    SEAM(17);
    REPK(18) if (IN(18)) { pg8::Gemm g{ACTB, W_MDN, FFE, FFE, FFE}; pg8::GroupedOrder So; So.init(ctl + CW_TS, D / 256, F.G, (int)blockIdx.x); pg8::EpiBf16 E{YB, D, nullptr};
        pg8::gemm_phase<pg8::EpiBf16, pg8::GroupedOrder, PG_ALIGN, PG_SP2>(ring, g, So, E); }
    SEAM(18);
    REPK(19) if (IN(19)) {
        unsigned ts[9]; ts[0] = 0;
#pragma unroll
        for (int e = 0; e < 8; ++e) ts[e + 1] = ctl[CW_TS + e + 1];
#pragma unroll
        for (int b = 0; b < NB; ++b) {
            const float* gf = MOD + 4 * 12288 + (size_t)b * 6 * D + 5 * D;
            const int m0 = b * S + F.gw, m1 = m0 + F.NGW;
            const int* rt0 = ROUTE + (size_t)m0 * 8; const int* rt1 = ROUTE + (size_t)m1 * 8;
            const int e10 = rt0[0], e20 = rt0[1], r10 = rt0[2], r20 = rt0[3], e11 = rt1[0], e21 = rt1[1], r11 = rt1[2], r21 = rt1[3];
            const float g10 = __int_as_float(rt0[4]), g20 = __int_as_float(rt0[5]), g11 = __int_as_float(rt1[4]), g21 = __int_as_float(rt1[5]);
            unsigned t10 = 0, t20 = 0, t11 = 0, t21 = 0;
#pragma unroll
            for (int e = 0; e < 8; ++e) { t10 = (e == e10) ? ts[e] : t10; t20 = (e == e20) ? ts[e] : t20; t11 = (e == e11) ? ts[e] : t11; t21 = (e == e21) ? ts[e] : t21; }
            const v2u* ya0 = (const v2u*)(YB + ((size_t)t10 * 256 + r10) * D) + F.lane; const v2u* yb0 = (const v2u*)(YB + ((size_t)t20 * 256 + r20) * D) + F.lane;
            const v2u* ya1 = (const v2u*)(YB + ((size_t)t11 * 256 + r11) * D) + F.lane; const v2u* yb1 = (const v2u*)(YB + ((size_t)t21 * 256 + r21) * D) + F.lane;
            const f32x4* x0 = (const f32x4*)(X + (size_t)m0 * D) + F.lane; const f32x4* x1 = (const f32x4*)(X + (size_t)m1 * D) + F.lane;
            f32x4 v0[8], v1[8]; v2u a0[8], c0[8], a1[8], c1[8];
#pragma unroll
            for (int j = 0; j < 8; ++j) { v0[j] = x0[64 * j]; v1[j] = x1[64 * j]; a0[j] = ya0[64 * j]; c0[j] = yb0[64 * j]; a1[j] = ya1[64 * j]; c1[j] = yb1[64 * j]; }
            float q0 = 0.f, q1 = 0.f;
#pragma unroll
            for (int j = 0; j < 8; ++j) { const f32x4 gg = ((const f32x4*)gf)[F.lane + 64 * j]; f32x4 y;
                y.x = g10 * bflo(a0[j].x) + g20 * bflo(c0[j].x); y.y = g10 * bfhi(a0[j].x) + g20 * bfhi(c0[j].x); y.z = g10 * bflo(a0[j].y) + g20 * bflo(c0[j].y); y.w = g10 * bfhi(a0[j].y) + g20 * bfhi(c0[j].y);
                v0[j] = v0[j] + gg * y; q0 += (v0[j].x * v0[j].x + v0[j].y * v0[j].y) + (v0[j].z * v0[j].z + v0[j].w * v0[j].w);
                y.x = g11 * bflo(a1[j].x) + g21 * bflo(c1[j].x); y.y = g11 * bfhi(a1[j].x) + g21 * bfhi(c1[j].x); y.z = g11 * bflo(a1[j].y) + g21 * bflo(c1[j].y); y.w = g11 * bfhi(a1[j].y) + g21 * bfhi(c1[j].y);
                v1[j] = v1[j] + gg * y; q1 += (v1[j].x * v1[j].x + v1[j].y * v1[j].y) + (v1[j].z * v1[j].z + v1[j].w * v1[j].w); }
            const float ri0 = 1.0f / sqrtf(wave_sum(q0) * (1.f / D) + RMS_EPS), ri1 = 1.0f / sqrtf(wave_sum(q1) * (1.f / D) + RMS_EPS);
            f32x4* o0 = (f32x4*)(args.out + (size_t)m0 * D) + F.lane; f32x4* o1 = (f32x4*)(args.out + (size_t)m1 * D) + F.lane;
#pragma unroll
            for (int j = 0; j < 8; ++j) { const f32x4 fg = ((const f32x4*)final_g)[F.lane + 64 * j]; o0[64 * j] = (v0[j] * ri0) * fg; o1[64 * j] = (v1[j] * ri1) * fg; }
        }
    }
    if ((PROBE_MASK >> 19) & 1) { __syncthreads(); const unsigned long long t1_ = wall_clock64(); while (wall_clock64() < t1_ + (t1_ - tprev_)) __builtin_amdgcn_s_sleep(8); }
#undef IN
#undef SEAM
}

constexpr int N_PHASES = 20;
extern "C" void kernel_launch(void* const* d_in, const int* in_sizes, int n_in, void* d_out, int out_size, void* d_ws, size_t ws_size, hipStream_t stream) {
    static int grid = 0;
    if (grid == 0) {
        if (n_in != 30 || in_sizes[0] != M * D || out_size != M * D || ws_size < WS_END) { fprintf(stderr, "kernel_launch: shape/workspace mismatch: n_in %d in0 %d out %d ws %zu (need %zu)\n", n_in, n_in > 0 ? in_sizes[0] : -1, out_size, ws_size, (size_t)WS_END); grid = -1; return; }
        int dev = 0, cus = 0, per_cu = 0;
        if (hipGetDevice(&dev) != hipSuccess || hipDeviceGetAttribute(&cus, hipDeviceAttributeMultiprocessorCount, dev) != hipSuccess) { grid = -1; return; }
        if (hipFuncSetAttribute((const void*)fwd, hipFuncAttributeMaxDynamicSharedMemorySize, LDS_BYTES) != hipSuccess) { fprintf(stderr, "kernel_launch: hipFuncSetAttribute failed\n"); grid = -1; return; }
        if (hipOccupancyMaxActiveBlocksPerMultiprocessor(&per_cu, (const void*)fwd, NWAVES * 64, LDS_BYTES) != hipSuccess || per_cu < 1) fprintf(stderr, "kernel_launch: occupancy query reports %d\n", per_cu);
        (void)hipGetLastError();
        grid = cus;
        if (grid != 256) { fprintf(stderr, "kernel_launch: built for a 256-CU device (got %d)\n", cus); grid = -1; return; }
    }
    if (grid < 0) return;
    if (hipMemsetAsync((char*)d_ws + WS_CTL, 0, CTL_ZERO_BYTES, stream) != hipSuccess) return;
    Args a{};
    for (int i = 0; i < 30; ++i) a.in[i] = d_in[i];
    a.out = (float*)d_out; a.ws = (unsigned char*)d_ws;
    if (MK_N_LAUNCHES == 1) { a.ph_lo = 0; a.ph_hi = N_PHASES; hipLaunchKernelGGL(fwd, dim3(grid), dim3(NWAVES * 64), LDS_BYTES, stream, a); }
    else { for (int p = 0; p < N_PHASES; ++p) { a.ph_lo = p; a.ph_hi = p + 1; hipLaunchKernelGGL(fwd, dim3(grid), dim3(NWAVES * 64), LDS_BYTES, stream, a); } }
    const hipError_t le = hipPeekAtLastError();
    if (le != hipSuccess) fprintf(stderr, "kernel_launch: launch failed: %s\n", hipGetErrorName(le));
}
```

```cpp
#include <hip/hip_runtime.h>
#include <cstdio>
#include <cstdint>

#define FLASH_WIN 1
#define FLASH_SLC 1
#define FLASH_MLA 1
#define FLASH_DIL 1
#define PROBE_MASK 0
#define FLASH_CMP 1
#define WGM_G 4
#define PG_ALIGN true
#define PG_SP2 true
#define MOE_F8 2
#ifndef MK_N_LAUNCHES
#define MK_N_LAUNCHES 1
#endif

namespace pg8 {
#define PG8_LAS __attribute__((address_space(3)))
typedef unsigned short bf16_t;
typedef short bf16x8 __attribute__((ext_vector_type(8)));
typedef float f32x4 __attribute__((ext_vector_type(4)));
typedef float f32x2 __attribute__((ext_vector_type(2)));
typedef unsigned u32x4 __attribute__((ext_vector_type(4)));
typedef unsigned u32x2 __attribute__((ext_vector_type(2)));
constexpr int BM = 256, BK = 64, HALF = 128, HTB = HALF * BK * 2  , STAGE_BYTES = 8 * HTB, NXCD = 8, WGM = 8;

__host__ __device__ __forceinline__ int lds_byte(int r, int c) { const int st = (r >> 4) * 2 + (c >> 5), rr = r & 15, cc = c & 31, ob = rr * 64 + cc * 2; return st * 1024 + (ob ^ (((ob >> 9) & 1) << 5)); }
__host__ __device__ __forceinline__ void stage_rc(int b, int& R, int& C) { const int st = b / 1024, sb = b % 1024, swz = sb ^ (((sb >> 9) & 1) << 5); R = (st >> 1) * 16 + swz / 64; C = (st & 1) * 32 + (swz % 64) / 2; }
__host__ __device__ __forceinline__ int perm32(int rho) { const int n = rho >> 4, i = rho & 15; return 8 * (i >> 2) + 4 * n + (i & 3); }

struct Unit { int pm, pn, pb; };
struct Gemm { const bf16_t* A; const bf16_t* Bt; int lda, ldb, K; };

struct StaticOrder {
    int nM, nN, nwg, G, c;
    __host__ __device__ void init(int M, int N, int G_, int c_) { nM = M / BM; nN = N / BM; nwg = nM * nN; G = G_; c = c_; }
    __host__ __device__ bool next(int i, Unit& u) const {
        const long L = (long)i * G + c; if (L >= nwg) return false;
        int wgid = (int)L; { const int q = nwg / NXCD, r = nwg % NXCD, xcd = wgid % NXCD, off = wgid / NXCD; wgid = (xcd < r ? xcd * (q + 1) : r * (q + 1) + (xcd - r) * q) + off; }
        const int nig = WGM * nN, gid = wgid / nig, fm = gid * WGM, gsz = (nM - fm) < WGM ? (nM - fm) : WGM;
        u.pm = fm + ((wgid % nig) % gsz); u.pn = (wgid % nig) / gsz; u.pb = u.pn; return true;
    }
    __device__ __forceinline__ void a_ready(const Unit&) const {}
    __device__ __forceinline__ void done(const Unit&) const {}
};
#ifndef WGM_G
#define WGM_G 8
#endif
struct GroupedOrder {
    int nN, G, c; int ts[9];
    __device__ __forceinline__ void init(const unsigned* tstart, int nN_, int G_, int c_) { nN = nN_; G = G_; c = c_;
#pragma unroll
        for (int e = 0; e < 9; ++e) ts[e] = (int)tstart[e]; }
    __device__ __forceinline__ bool next(int i, Unit& u) const {
        const long L = (long)i * G + c; if (L >= (long)ts[8] * nN) return false;
        int e = 0, us = 0, te = ts[1] - ts[0], t0 = ts[0];
#pragma unroll
        for (int k = 1; k < 8; ++k) { const int s = ts[k] * nN; if (L >= s) { e = k; us = s; te = ts[k + 1] - ts[k]; t0 = ts[k]; } }
        if (te <= 0) return false;
        int wgid = (int)L - us; { const int nwg = te * nN, q = nwg / NXCD, rr = nwg % NXCD, xcd = wgid % NXCD, off = wgid / NXCD; wgid = (xcd < rr ? xcd * (q + 1) : rr * (q + 1) + (xcd - rr) * q) + off; }
        const int nig = WGM_G * nN, gid = wgid / nig, fm = gid * WGM_G, gsz = (te - fm) < WGM_G ? (te - fm) : WGM_G;
        u.pm = t0 + fm + ((wgid % nig) % gsz); u.pn = (wgid % nig) / gsz; u.pb = e * nN + u.pn; return true;
    }
    __device__ __forceinline__ void a_ready(const Unit&) const {}
    __device__ __forceinline__ void done(const Unit&) const {}
};

typedef __bf16 bf16x2c __attribute__((ext_vector_type(2)));
__device__ __forceinline__ unsigned cvt_pk_bf16(float lo, float hi) { const f32x2 v = {lo, hi}; return __builtin_bit_cast(unsigned, __builtin_convertvector(v, bf16x2c)); }

struct EpiBf16 {
    static constexpr bool PERM = true, AFTER_DRAIN = false;
    bf16_t* O; int ldc; const float* rowscale;
    __device__ __forceinline__ void operator()(const f32x4 (&acc)[2][2][4][2], const Unit& u, int wr, int wc, int fr, int fq) const {
        const int row0 = u.pm * BM + wr * 64 + fr; const int col0 = u.pn * BM + wc * 32 + 8 * fq;
#pragma unroll
        for (int ai = 0; ai < 2; ++ai)
#pragma unroll
            for (int m = 0; m < 4; ++m) { const int row = row0 + ai * HALF + m * 16; bf16_t* rowp = O + (size_t)row * ldc + col0; const float sc = rowscale ? rowscale[row] : 1.f;
#pragma unroll
                for (int bj = 0; bj < 2; ++bj) { f32x4 v0 = acc[ai][bj][m][0] * sc, v1 = acc[ai][bj][m][1] * sc;
                    u32x4 w; w.x = cvt_pk_bf16(v0[0], v0[1]); w.y = cvt_pk_bf16(v0[2], v0[3]); w.z = cvt_pk_bf16(v1[0], v1[1]); w.w = cvt_pk_bf16(v1[2], v1[3]);
                    *(u32x4*)(rowp + bj * HALF) = w; } }
    }
};
struct EpiResid {
    static constexpr bool PERM = false, AFTER_DRAIN = false;
    const float* xin; float* xout; int ldc; const float* gate; int gstride; int tiles_per_b;
    __device__ __forceinline__ void operator()(const f32x4 (&acc)[2][2][4][2], const Unit& u, int wr, int wc, int fr, int fq) const {
        const int row0 = u.pm * BM + wr * 64 + fr, col0 = u.pn * BM + wc * 32 + 4 * fq;
        const float* gp = gate + (size_t)(u.pm / tiles_per_b) * gstride + col0;
        f32x4 gv[2][2];
#pragma unroll
        for (int bj = 0; bj < 2; ++bj)
#pragma unroll
            for (int n = 0; n < 2; ++n) gv[bj][n] = *(const f32x4*)(gp + bj * HALF + n * 16);
#pragma unroll
        for (int ai = 0; ai < 2; ++ai)
#pragma unroll
            for (int m = 0; m < 4; ++m) { const size_t off = (size_t)(row0 + ai * HALF + m * 16) * ldc + col0;
#pragma unroll
                for (int bj = 0; bj < 2; ++bj)
#pragma unroll
                    for (int n = 0; n < 2; ++n) { const f32x4 xi = *(const f32x4*)(xin + off + bj * HALF + n * 16);
                        *(f32x4*)(xout + off + bj * HALF + n * 16) = xi + gv[bj][n] * acc[ai][bj][m][n]; }
                asm volatile("" ::: "memory"); }
    }
};
__device__ __forceinline__ float silu_f(float g) { return g * __builtin_amdgcn_rcpf(1.0f + __builtin_amdgcn_exp2f(-1.4426950408889634f * g)); }
struct EpiSwiGLU {
    static constexpr bool PERM = false, AFTER_DRAIN = false;
    bf16_t* O; int ldo;
    __device__ __forceinline__ void operator()(const f32x4 (&acc)[2][2][4][2], const Unit& u, int wr, int wc, int fr, int fq) const {
        const int row0 = u.pm * BM + wr * 64 + fr, col0 = u.pn * HALF + wc * 16 + 4 * fq;
#pragma unroll
        for (int ai = 0; ai < 2; ++ai)
#pragma unroll
            for (int m = 0; m < 4; ++m) { bf16_t* rowp = O + (size_t)(row0 + ai * HALF + m * 16) * ldo + col0;
#pragma unroll
                for (int bj = 0; bj < 2; ++bj) { const f32x4 g = acc[ai][bj][m][0], up = acc[ai][bj][m][1];
                    u32x2 w; w.x = cvt_pk_bf16(silu_f(g[0]) * up[0], silu_f(g[1]) * up[1]); w.y = cvt_pk_bf16(silu_f(g[2]) * up[2], silu_f(g[3]) * up[3]);
                    *(u32x2*)(rowp + bj * 64) = w; } }
    }
};
struct EpiSwiGLUH {
    static constexpr bool PERM = false, AFTER_DRAIN = false;
    bf16_t* O; unsigned char* O8; int ldo; float s, so;
    __device__ __forceinline__ void operator()(const f32x4 (&acc)[2][2][4][2], const Unit& u, int wr, int wc, int fr, int fq) const {
        const int row0 = u.pm * BM + wr * 64 + fr, col0 = u.pn * 64 + wc * 16 + 4 * fq;
#pragma unroll
        for (int ai = 0; ai < 2; ++ai)
#pragma unroll
            for (int m = 0; m < 4; ++m) { const size_t off = (size_t)(row0 + ai * HALF + m * 16) * ldo + col0;
                const f32x4 g = acc[ai][0][m][0] * s, up = acc[ai][0][m][1] * s;
                const float v0 = silu_f(g[0]) * up[0], v1 = silu_f(g[1]) * up[1], v2 = silu_f(g[2]) * up[2], v3 = silu_f(g[3]) * up[3];
                if (O8) { int w = 0; w = __builtin_amdgcn_cvt_pk_fp8_f32(__builtin_amdgcn_fmed3f(v0 * so, -440.f, 440.f), __builtin_amdgcn_fmed3f(v1 * so, -440.f, 440.f), w, false);
                    w = __builtin_amdgcn_cvt_pk_fp8_f32(__builtin_amdgcn_fmed3f(v2 * so, -440.f, 440.f), __builtin_amdgcn_fmed3f(v3 * so, -440.f, 440.f), w, true); *(int*)(O8 + off) = w; }
                else { u32x2 w; w.x = cvt_pk_bf16(v0, v1); w.y = cvt_pk_bf16(v2, v3); *(u32x2*)(O + off) = w; } }
    }
};
struct EpiBf16H {
    static constexpr bool PERM = true, AFTER_DRAIN = false;
    bf16_t* O; int ldc; float s;
    __device__ __forceinline__ void operator()(const f32x4 (&acc)[2][2][4][2], const Unit& u, int wr, int wc, int fr, int fq) const {
        const int row0 = u.pm * BM + wr * 64 + fr; const int col0 = u.pn * HALF + wc * 32 + 8 * fq;
#pragma unroll
        for (int ai = 0; ai < 2; ++ai)
#pragma unroll
            for (int m = 0; m < 4; ++m) { bf16_t* rowp = O + (size_t)(row0 + ai * HALF + m * 16) * ldc + col0;
                const f32x4 v0 = acc[ai][0][m][0] * s, v1 = acc[ai][0][m][1] * s;
                u32x4 w; w.x = cvt_pk_bf16(v0[0], v0[1]); w.y = cvt_pk_bf16(v0[2], v0[3]); w.z = cvt_pk_bf16(v1[0], v1[1]); w.w = cvt_pk_bf16(v1[2], v1[3]);
                *(u32x4*)rowp = w; }
    }
};

template <class Epi, class Sched, bool ALIGN_EPI = false, bool SP2 = false, bool F8 = false>
__device__ __forceinline__ void gemm_phase(PG8_LAS unsigned char* lds, const Gemm g, const Sched& S, const Epi& E) {
    const int tid = threadIdx.x, wid = __builtin_amdgcn_readfirstlane(tid >> 6), lane = tid & 63, wr = wid >> 2, wc = wid & 3, fr = lane & 15, fq = lane >> 4;
    const int K = g.K, nt = K / BK;
    unsigned voffA[2], voffB[2];
#pragma unroll
    for (int i = 0; i < 2; ++i) { int R, C; stage_rc(tid * 16 + i * 8192, R, C); const int Rb = Epi::PERM ? ((R & ~31) + perm32(R & 31)) : R;
        voffA[i] = (unsigned)(R * g.lda + C) * 2u; voffB[i] = (unsigned)(Rb * g.ldb + C) * 2u; }
    const size_t kstep = (size_t)(BK * 2);
    const size_t hstepA = (size_t)HALF * g.lda * 2, hstepB = (size_t)HALF * g.ldb * 2;
    const size_t tstepA = 2 * hstepA, tstepB = F8 ? hstepB : 2 * hstepB;
    const unsigned ldsw = (unsigned)wid * 1024u;
    const int aoff = lds_byte(wr * 64 + fr, fq * 8), boff = lds_byte(wc * 32 + fr, fq * 8);
#define PG8_SA(b, h) (((b) * 2 + (h)) * HTB)
#define PG8_SB(b, h) ((4 + (b) * 2 + (h)) * HTB)
#define PG8_STAGE(bufoff, gbase, voff) do { _Pragma("unroll") for (int _i = 0; _i < 2; ++_i) \
        __builtin_amdgcn_global_load_lds((const unsigned*)((const char*)(gbase) + (voff)[_i]), (PG8_LAS unsigned*)(lds + (bufoff) + ldsw + _i * 8192), 16, 0, 0); } while (0)
#define PG8_LDA(dst, b, h) do { _Pragma("unroll") for (int m = 0; m < 4; ++m) _Pragma("unroll") for (int k = 0; k < 2; ++k) dst[m][k] = *(const PG8_LAS bf16x8*)(lds + PG8_SA(b, h) + aoff + m * 2048 + k * 1024); } while (0)
#define PG8_LDB(dst, b, h) do { if constexpr (!F8 || (h) == 0) { _Pragma("unroll") for (int n = 0; n < 2; ++n) _Pragma("unroll") for (int k = 0; k < 2; ++k) dst[n][k] = *(const PG8_LAS bf16x8*)(lds + PG8_SB(b, h) + boff + n * 2048 + k * 1024); } } while (0)
#define PG8_CAT(x, y) __builtin_shufflevector(x, y, 0, 1, 2, 3, 4, 5, 6, 7, 8, 9, 10, 11, 12, 13, 14, 15)
#define PG8_MMA(ai, bj, At, Bt) do { if constexpr (!F8 || (bj) == 0) { __builtin_amdgcn_s_setprio(1); \
        if constexpr (F8) { _Pragma("unroll") for (int m = 0; m < 4; ++m) _Pragma("unroll") for (int n = 0; n < 2; ++n) \
            acc[ai][bj][m][n] = __builtin_amdgcn_mfma_scale_f32_16x16x128_f8f6f4(__builtin_bit_cast(v8i_, PG8_CAT(Bt[n][0], Bt[n][1])), __builtin_bit_cast(v8i_, PG8_CAT(At[m][0], At[m][1])), acc[ai][bj][m][n], 0, 0, 0, 0x7f7f7f7f, 0, 0x7f7f7f7f); } \
        else { _Pragma("unroll") for (int m = 0; m < 4; ++m) _Pragma("unroll") for (int n = 0; n < 2; ++n) _Pragma("unroll") for (int k = 0; k < 2; ++k) \
            acc[ai][bj][m][n] = __builtin_amdgcn_mfma_f32_16x16x32_bf16(Bt[n][k], At[m][k], acc[ai][bj][m][n], 0, 0, 0); } \
        __builtin_amdgcn_s_setprio(0); } } while (0)
#define PG8_WAIT_V(n) asm volatile("s_waitcnt vmcnt(" #n ")" ::: "memory")
#define PG8_WAIT_L(n) asm volatile("s_waitcnt lgkmcnt(" #n ")" ::: "memory")
#define PG8_BAR __builtin_amdgcn_s_barrier()
#define PG8_SCHED __builtin_amdgcn_sched_barrier(0)
    Unit cur, nxt; int ui = 0;
    if (!S.next(0, cur)) return;
    f32x4 acc[2][2][4][2];
#pragma unroll
    for (int a = 0; a < 2; ++a)
#pragma unroll
        for (int b = 0; b < 2; ++b)
#pragma unroll
            for (int m = 0; m < 4; ++m)
#pragma unroll
                for (int n = 0; n < 2; ++n) acc[a][b][m][n] = (f32x4){0.f, 0.f, 0.f, 0.f};
    bf16x8 At[4][2], B0[2][2], B1[2][2];
    typedef int v8i_ __attribute__((ext_vector_type(8))); typedef short bf16x16_ __attribute__((ext_vector_type(16)));
    const char* cA = (const char*)g.A + (size_t)cur.pm * tstepA; const char* cB = (const char*)g.Bt + (size_t)cur.pb * tstepB;
    S.a_ready(cur);
    if constexpr (SP2) {
        PG8_STAGE(PG8_SB(0, 0), cB, voffB); PG8_STAGE(PG8_SB(0, 1), cB + hstepB, voffB); PG8_STAGE(PG8_SA(0, 0), cA, voffA); PG8_STAGE(PG8_SA(0, 1), cA + hstepA, voffA);
        if (wr == 1) PG8_BAR;
        PG8_WAIT_V(2); PG8_BAR;
        PG8_STAGE(PG8_SB(1, 0), cB + kstep, voffB); PG8_STAGE(PG8_SA(1, 0), cA + kstep, voffA); PG8_STAGE(PG8_SB(1, 1), cB + hstepB + kstep, voffB);
        PG8_WAIT_V(6); PG8_BAR;
    } else {
        PG8_STAGE(PG8_SB(0, 0), cB, voffB); PG8_STAGE(PG8_SA(0, 0), cA, voffA); PG8_STAGE(PG8_SB(0, 1), cB + hstepB, voffB); PG8_STAGE(PG8_SA(0, 1), cA + hstepA, voffA);
        if (wr == 1) PG8_BAR;
        PG8_WAIT_V(4); PG8_BAR;
        PG8_STAGE(PG8_SB(1, 0), cB + kstep, voffB); PG8_STAGE(PG8_SA(1, 0), cA + kstep, voffA); PG8_STAGE(PG8_SB(1, 1), cB + hstepB + kstep, voffB);
        PG8_WAIT_V(6); PG8_BAR;
    }
    for (;;) {
        const bool has_next = S.next(ui + 1, nxt);
        const char* nA = has_next ? (const char*)g.A + (size_t)nxt.pm * tstepA : cA; const char* nB = has_next ? (const char*)g.Bt + (size_t)nxt.pb * tstepB : cB;
        for (int t = 0; t < nt; t += 2) {
            const bool last = (t == nt - 2);
            const char* a1 = cA + (size_t)(t + 1) * kstep;
            const char* a2 = last ? nA : cA + (size_t)(t + 2) * kstep; const char* b2 = last ? nB : cB + (size_t)(t + 2) * kstep;
            const char* a3 = a2 + kstep; const char* b3 = b2 + kstep;
            if (last && has_next) S.a_ready(nxt);
            if constexpr (SP2) {
            PG8_LDB(B0, 0, 0); PG8_LDB(B1, 0, 1); PG8_SCHED; PG8_LDA(At, 0, 0); PG8_STAGE(PG8_SA(1, 1), a1 + hstepA, voffA);
            PG8_WAIT_V(8); PG8_WAIT_L(0); PG8_BAR; PG8_MMA(0, 0, At, B0); PG8_MMA(0, 1, At, B1); PG8_BAR; PG8_SCHED;
            PG8_LDA(At, 0, 1); PG8_STAGE(PG8_SB(0, 0), b2, voffB); PG8_STAGE(PG8_SB(0, 1), b2 + hstepB, voffB); PG8_STAGE(PG8_SA(0, 0), a2, voffA);
            PG8_WAIT_V(8); PG8_WAIT_L(0); PG8_BAR; PG8_MMA(1, 0, At, B0); PG8_MMA(1, 1, At, B1); PG8_BAR; PG8_SCHED;
            PG8_LDB(B0, 1, 0); PG8_LDB(B1, 1, 1); PG8_SCHED; PG8_LDA(At, 1, 0); PG8_STAGE(PG8_SA(0, 1), a2 + hstepA, voffA);
            PG8_WAIT_V(8); PG8_WAIT_L(0); PG8_BAR; PG8_MMA(0, 0, At, B0); PG8_MMA(0, 1, At, B1); PG8_BAR; PG8_SCHED;
            PG8_LDA(At, 1, 1); PG8_STAGE(PG8_SB(1, 0), b3, voffB); PG8_STAGE(PG8_SB(1, 1), b3 + hstepB, voffB); PG8_STAGE(PG8_SA(1, 0), a3, voffA);
            PG8_WAIT_V(8); PG8_WAIT_L(0); PG8_BAR; PG8_MMA(1, 0, At, B0); PG8_MMA(1, 1, At, B1); PG8_BAR; PG8_SCHED;
            } else {
            PG8_LDB(B0, 0, 0); PG8_SCHED; PG8_LDA(At, 0, 0); PG8_STAGE(PG8_SA(1, 1), a1 + hstepA, voffA);
            PG8_WAIT_L(8); PG8_BAR; PG8_WAIT_L(0); PG8_MMA(0, 0, At, B0); PG8_BAR; PG8_SCHED;
            PG8_LDB(B1, 0, 1); PG8_STAGE(PG8_SB(0, 0), b2, voffB);
            PG8_BAR; PG8_WAIT_L(0); PG8_MMA(0, 1, At, B1); PG8_BAR;
            PG8_LDA(At, 0, 1); PG8_STAGE(PG8_SA(0, 0), a2, voffA);
            PG8_BAR; PG8_WAIT_L(0); PG8_MMA(1, 0, At, B0); PG8_BAR; PG8_SCHED;
            PG8_STAGE(PG8_SB(0, 1), b2 + hstepB, voffB);
            PG8_WAIT_V(6); PG8_BAR; PG8_MMA(1, 1, At, B1); PG8_BAR;
            PG8_LDB(B0, 1, 0); PG8_SCHED; PG8_LDA(At, 1, 0); PG8_STAGE(PG8_SA(0, 1), a2 + hstepA, voffA);
            PG8_WAIT_L(8); PG8_BAR; PG8_WAIT_L(0); PG8_MMA(0, 0, At, B0); PG8_BAR; PG8_SCHED;
            PG8_LDB(B1, 1, 1); PG8_STAGE(PG8_SB(1, 0), b3, voffB);
            PG8_BAR; PG8_WAIT_L(0); PG8_MMA(0, 1, At, B1); PG8_BAR;
            PG8_LDA(At, 1, 1); PG8_STAGE(PG8_SA(1, 0), a3, voffA);
            PG8_BAR; PG8_WAIT_L(0); PG8_MMA(1, 0, At, B0); PG8_BAR; PG8_SCHED;
            PG8_STAGE(PG8_SB(1, 1), b3 + hstepB, voffB);
            PG8_WAIT_V(6); PG8_BAR; PG8_MMA(1, 1, At, B1); PG8_BAR;
            }
        }
        if constexpr (ALIGN_EPI) { if (wr == 0) PG8_BAR; }
        if constexpr (!Epi::AFTER_DRAIN) { E(acc, cur, wr, wc, fr, fq); S.done(cur); }
        if (!has_next) break;
#pragma unroll
        for (int a = 0; a < 2; ++a)
#pragma unroll
            for (int b = 0; b < 2; ++b)
#pragma unroll
                for (int m = 0; m < 4; ++m)
#pragma unroll
                    for (int n = 0; n < 2; ++n) acc[a][b][m][n] = (f32x4){0.f, 0.f, 0.f, 0.f};
        cur = nxt; cA = nA; cB = nB; ++ui;
        if constexpr (ALIGN_EPI) { if (wr == 1) PG8_BAR; }
    }
    PG8_WAIT_V(0);
    if constexpr (!ALIGN_EPI) { if (wr == 0) PG8_BAR; }
    PG8_BAR;
    if constexpr (Epi::AFTER_DRAIN) { E.fused(acc, cur, wr, wc, fr, fq, lds, wid, lane); S.done(cur); }
#undef PG8_SA
#undef PG8_SB
#undef PG8_STAGE
#undef PG8_CAT
#undef PG8_LDA
#undef PG8_LDB
#undef PG8_MMA
#undef PG8_WAIT_V
#undef PG8_WAIT_L
#undef PG8_BAR
#undef PG8_SCHED
}

}

#ifndef FA_DBG_NOSEL
#define FA_DBG_NOSEL 0
#endif
#ifndef FA_DBG_NOMERGE
#define FA_DBG_NOMERGE 0
#endif
#ifndef FA_SEL_SKIP
#define FA_SEL_SKIP 0
#endif
namespace fa {
#define FA_LAS __attribute__((address_space(3)))
typedef unsigned short bf16;
typedef short bf16x8 __attribute__((ext_vector_type(8)));
typedef short s16x4 __attribute__((ext_vector_type(4)));
typedef float f32x16 __attribute__((ext_vector_type(16)));
typedef float f32x4 __attribute__((ext_vector_type(4)));
typedef unsigned u32x4 __attribute__((ext_vector_type(4)));
constexpr int QB = 256, QBLK = 32, KVBLK = 64;
constexpr int SHM_K = 16384, SHM_V = 16384, SHM_K2 = 8192;
constexpr int OFF_V = 0, OFF_K = 2 * SHM_V, OFF_K2 = OFF_K + 2 * SHM_K, OFF_WS = OFF_K2 + 2 * SHM_K2, WS_PER_WAVE = 1024, OFF_TAB = OFF_WS + 8 * WS_PER_WAVE;
constexpr int TAB_PAD = 320, TAB_MAX = 4096 + TAB_PAD;
constexpr int LDS_END = OFF_TAB + TAB_MAX * 4;
constexpr int OSTG = 272;
static_assert(LDS_END <= 131072 && 8 * 32 * OSTG <= OFF_WS, "attention LDS map");
#define KSWZ(row, colB) ((row) * 256 + ((colB) ^ (((row) & 7) << 4)))
#define K2SWZ(row, colB) ((row) * 128 + ((colB) ^ (((row) & 7) << 4)))
#define SBAR() __builtin_amdgcn_sched_barrier(0)
__device__ __forceinline__ int v_st(int k, int c) { const int kk = (k & ~0xC) | ((k & 4) << 1) | ((k & 8) >> 1); return ((kk >> 3) * 4 + (c >> 5)) * 512 + ((kk & 7) * 32 + (c & 31)) * 2; }
__device__ __forceinline__ int v_rd_base(int lane) { return ((lane & 3) << 3) | (((lane >> 2) & 3) << 6) | (((lane >> 4) & 1) << 5) | (((lane >> 5) & 1) << 8); }
constexpr int v_rd_off(int d0, int ks, int half) { return d0 * 512 + ks * 4096 + half * 2048; }
__device__ __forceinline__ int crow(int r, int hi) { return (r & 3) + 8 * (r >> 2) + 4 * hi; }
typedef float f32x2c __attribute__((ext_vector_type(2)));
typedef __bf16 bf16x2c __attribute__((ext_vector_type(2)));
__device__ __forceinline__ unsigned cvtpk(float lo, float hi) { const f32x2c v = {lo, hi}; return __builtin_bit_cast(unsigned, __builtin_convertvector(v, bf16x2c)); }

struct Item {
    const bf16* Q; long qs;
    const float* rope; long ropes;
    const bf16* K; long ks; const bf16* K2; long k2s; const bf16* V; long vs;
    int P0, skv, W;
    const float* bias; int bstep;
    const unsigned long long* sel; long sels;
    bf16* O; long os;
    float* LSE; long lses;
    const bf16* M0; const bf16* M1; long ms; const bf16* G; long gs;
};

template <int VAR>
__device__ __forceinline__ void attn_block(const Item& it, unsigned char* lds_g) {
    constexpr bool HAS_BIAS = VAR != 2, HAS_SEL = VAR == 1, HAS_K2 = VAR == 2;
    constexpr float SCALE = HAS_K2 ? 0.07216878364870322f : 0.08838834764831845f, C2 = 1.4426950408889634f * SCALE, THR = 8.f;
    FA_LAS unsigned char* L = (FA_LAS unsigned char*)lds_g;
    const int tid = threadIdx.x, wid = __builtin_amdgcn_readfirstlane(tid >> 6), lane = tid & 63, r32 = lane & 31, hi = lane >> 5;
    const int W = it.W;
    const int j_lo = (it.P0 - W + 1 > 0) ? (it.P0 - W + 1) / KVBLK : 0;
    int j_hi = (it.P0 + QB - 1) / KVBLK + 1; if (j_hi > it.skv / KVBLK) j_hi = it.skv / KVBLK;
    const int NT = j_hi - j_lo;
    const int qlo = it.P0 + wid * QBLK, qm = qlo + r32 - 4 * hi;
    FA_LAS float* wsl = (FA_LAS float*)(L + OFF_WS + wid * WS_PER_WAVE); FA_LAS float* li_l = wsl; FA_LAS float* al_l = wsl + 32;
    FA_LAS float* tab = (FA_LAS float*)(L + OFF_TAB);
    const int sr = tid >> 4, sc = (tid & 15) * 8, vst0 = v_st(sr, sc), vst1 = v_st(32 + sr, sc), kws = KSWZ(sr, sc * 2);
    const int k2r = tid >> 3, k2c = (tid & 7) * 8, k2ws = K2SWZ(k2r, k2c * 2);
    const int vb0 = OFF_V + v_rd_base(lane);
    bf16x8 qr[8]; bf16x8 qr2[4];
    { const bf16* qp = it.Q + (long)(qlo + r32) * it.qs + hi * 8;
#pragma unroll
      for (int d0 = 0; d0 < 8; ++d0) qr[d0] = *(const bf16x8*)(qp + d0 * 16);
      if constexpr (HAS_K2) {
          const float* rp = it.rope + (long)(qlo + r32) * it.ropes + hi * 8;
          bf16x8 raw[4];
#pragma unroll
          for (int d0 = 0; d0 < 4; ++d0) raw[d0] = *(const bf16x8*)(qp + 128 + d0 * 16);
#pragma unroll
          for (int d0 = 0; d0 < 2; ++d0) { const f32x4 c0 = *(const f32x4*)(rp + d0 * 16), c1 = *(const f32x4*)(rp + d0 * 16 + 4), s0 = *(const f32x4*)(rp + 32 + d0 * 16), s1 = *(const f32x4*)(rp + 32 + d0 * 16 + 4);
              float o1[8], o2[8];
#pragma unroll
              for (int j = 0; j < 8; ++j) { const float x1 = __builtin_bit_cast(float, (unsigned)(unsigned short)raw[d0][j] << 16), x2 = __builtin_bit_cast(float, (unsigned)(unsigned short)raw[d0 + 2][j] << 16);
                  const float cs = j < 4 ? c0[j & 3] : c1[j & 3], sn = j < 4 ? s0[j & 3] : s1[j & 3]; o1[j] = x1 * cs - x2 * sn; o2[j] = x2 * cs + x1 * sn; }
              u32x4 w1 = {cvtpk(o1[0], o1[1]), cvtpk(o1[2], o1[3]), cvtpk(o1[4], o1[5]), cvtpk(o1[6], o1[7])}, w2 = {cvtpk(o2[0], o2[1]), cvtpk(o2[2], o2[3]), cvtpk(o2[4], o2[5]), cvtpk(o2[6], o2[7])};
              qr2[d0] = __builtin_bit_cast(bf16x8, w1); qr2[d0 + 2] = __builtin_bit_cast(bf16x8, w2); }
      }
    }
    unsigned long long selm = ~0ull;
    if constexpr (HAS_SEL) selm = __hip_atomic_load(it.sel + (long)(qlo + r32) * it.sels, __ATOMIC_RELAXED, __HIP_MEMORY_SCOPE_AGENT);
    if constexpr (HAS_BIAS) {
        int rmax = W + 320; if (rmax > 4096) rmax = 4096;
        for (int i = tid; i < rmax + TAB_PAD; i += 512) { int r = i - TAB_PAD; r = r < -64 ? -64 : r; long gi = (long)r * it.bstep; gi = gi > 4095 ? 4095 : gi; tab[i] = it.bias[gi] * (1.0f / SCALE); }
    }
    bf16x8 st_k0, st_k1, st_v0, st_v1, st_k2;
#define FA_LOAD(kb_) do { const long r0_ = (long)((kb_) + sr), r1_ = r0_ + 32; \
        st_v0 = *(const bf16x8*)(it.V + r0_ * it.vs + sc); st_v1 = *(const bf16x8*)(it.V + r1_ * it.vs + sc); \
        st_k0 = *(const bf16x8*)(it.K + r0_ * it.ks + sc); st_k1 = *(const bf16x8*)(it.K + r1_ * it.ks + sc); \
        if constexpr (HAS_K2) st_k2 = *(const bf16x8*)(it.K2 + (long)((kb_) + k2r) * it.k2s + k2c); } while (0)
#define FA_WRITE(bf_) do { *(FA_LAS bf16x8*)(L + OFF_V + (bf_) * SHM_V + vst0) = st_v0; *(FA_LAS bf16x8*)(L + OFF_V + (bf_) * SHM_V + vst1) = st_v1; \
        *(FA_LAS bf16x8*)(L + OFF_K + (bf_) * SHM_K + kws) = st_k0; *(FA_LAS bf16x8*)(L + OFF_K + (bf_) * SHM_K + kws + 32 * 256) = st_k1; \
        if constexpr (HAS_K2) *(FA_LAS bf16x8*)(L + OFF_K2 + (bf_) * SHM_K2 + k2ws) = st_k2; } while (0)
    FA_LOAD(j_lo * KVBLK);
    asm volatile("s_waitcnt vmcnt(0)" ::: "memory");
    FA_WRITE(0);
    __syncthreads();
    float m_reg = -1e30f, l_reg = 0.f; f32x16 o[4] = {};
#define FA_KBASE(t) ((j_lo + (t)) * KVBLK)
#define FA_STEP(BUF, t) do { \
        const int kb_ = FA_KBASE(t); \
        if ((t) + 1 < NT) FA_LOAD(FA_KBASE((t) + 1)); \
        bool act_ = (kb_ <= qlo + QBLK - 1) && (kb_ + KVBLK - 1 >= qlo - W + 1); \
        bool allow_ = true; \
        if constexpr (HAS_SEL) { allow_ = FA_DBG_NOSEL ? true : (bool)((selm >> (kb_ >> 6)) & 1ull); if (FA_SEL_SKIP) act_ = act_ && __any(allow_); } \
        if (act_) { \
            f32x16 p0 = {}, p1 = {}; \
            { const int ka_ = OFF_K + (BUF) * SHM_K; \
              _Pragma("unroll") for (int d0 = 0; d0 < 8; ++d0) { \
                const bf16x8 b0 = *(const FA_LAS bf16x8*)(L + ka_ + KSWZ(r32, (d0 * 16 + hi * 8) * 2)); \
                const bf16x8 b1 = *(const FA_LAS bf16x8*)(L + ka_ + 32 * 256 + KSWZ(r32, (d0 * 16 + hi * 8) * 2)); \
                p0 = __builtin_amdgcn_mfma_f32_32x32x16_bf16(b0, qr[d0], p0, 0, 0, 0); p1 = __builtin_amdgcn_mfma_f32_32x32x16_bf16(b1, qr[d0], p1, 0, 0, 0); } \
              if constexpr (HAS_K2) { const int k2a_ = OFF_K2 + (BUF) * SHM_K2; \
                _Pragma("unroll") for (int d0 = 0; d0 < 4; ++d0) { \
                  const bf16x8 b0 = *(const FA_LAS bf16x8*)(L + k2a_ + K2SWZ(r32, (d0 * 16 + hi * 8) * 2)); \
                  const bf16x8 b1 = *(const FA_LAS bf16x8*)(L + k2a_ + 32 * 128 + K2SWZ(r32, (d0 * 16 + hi * 8) * 2)); \
                  p0 = __builtin_amdgcn_mfma_f32_32x32x16_bf16(b0, qr2[d0], p0, 0, 0, 0); p1 = __builtin_amdgcn_mfma_f32_32x32x16_bf16(b1, qr2[d0], p1, 0, 0, 0); } } } \
            const int dq_ = qm - kb_; \
            if constexpr (HAS_BIAS) { const FA_LAS float* tb_ = tab + (TAB_PAD + dq_ - 63); \
                _Pragma("unroll") for (int r = 0; r < 16; ++r) { const int c_ = (r & 3) + 8 * (r >> 2); p0[r] += tb_[63 - c_]; p1[r] += tb_[31 - c_]; } } \
            if (HAS_SEL || kb_ + KVBLK - 1 > qlo || kb_ <= qlo + QBLK - 1 - W) { const float NEG_ = -__builtin_inff(); const int dqm_ = allow_ ? dq_ : -0x40000000; \
                _Pragma("unroll") for (int r = 0; r < 16; ++r) { const int c_ = (r & 3) + 8 * (r >> 2); \
                    if ((unsigned)(dqm_ - c_) >= (unsigned)W) p0[r] = NEG_; if ((unsigned)(dqm_ - c_ - 32) >= (unsigned)W) p1[r] = NEG_; } } \
              \
            float pmax_ = p0[0]; _Pragma("unroll") for (int r = 1; r < 16; ++r) pmax_ = fmaxf(pmax_, p0[r]); _Pragma("unroll") for (int r = 0; r < 16; ++r) pmax_ = fmaxf(pmax_, p1[r]); \
            { auto rr_ = __builtin_amdgcn_permlane32_swap(__float_as_uint(pmax_), __float_as_uint(pmax_), false, false); pmax_ = fmaxf(__uint_as_float(rr_[0]), __uint_as_float(rr_[1])); } \
            float mn_, alpha_; \
            if (__all((pmax_ - m_reg) * SCALE <= THR)) { mn_ = m_reg; alpha_ = 1.f; } \
            else { mn_ = fmaxf(m_reg, pmax_); alpha_ = __builtin_amdgcn_exp2f((m_reg - mn_) * C2); m_reg = mn_; } \
            const float mnL_ = -mn_ * C2; float ps_ = 0.f; \
            _Pragma("unroll") for (int r = 0; r < 16; ++r) { p0[r] = __builtin_amdgcn_exp2f(fmaf(p0[r], C2, mnL_)); p1[r] = __builtin_amdgcn_exp2f(fmaf(p1[r], C2, mnL_)); ps_ += p0[r] + p1[r]; } \
            { auto rr_ = __builtin_amdgcn_permlane32_swap(__float_as_uint(ps_), __float_as_uint(ps_), false, false); ps_ = __uint_as_float(rr_[0]) + __uint_as_float(rr_[1]); } \
            l_reg = l_reg * alpha_ + ps_; \
            bf16x8 pa0, pa1, pa2, pa3; \
            FA_PK4(p0, 0, pa0); FA_PK4(p0, 8, pa1); FA_PK4(p1, 0, pa2); FA_PK4(p1, 8, pa3); \
            if (__any(alpha_ < 1.f)) { if (hi == 0) al_l[r32] = alpha_; asm volatile("s_waitcnt lgkmcnt(0)" ::: "memory"); \
                _Pragma("unroll") for (int d_ = 0; d_ < 4; ++d_) _Pragma("unroll") for (int r = 0; r < 16; ++r) o[d_][r] *= al_l[crow(r, hi)]; } \
            FA_PV_D0(BUF, 0); FA_PV_D0(BUF, 1); FA_PV_D0(BUF, 2); FA_PV_D0(BUF, 3); \
        } \
        if ((t) + 1 < NT) { asm volatile("s_waitcnt vmcnt(0)" ::: "memory"); FA_WRITE(1 - (BUF)); } \
        __syncthreads(); } while (0)
#define FA_PK4(P, B_, OUT) do { unsigned a0 = cvtpk(P[B_+0], P[B_+1]), a1 = cvtpk(P[B_+2], P[B_+3]); unsigned b0 = cvtpk(P[B_+4], P[B_+5]), b1 = cvtpk(P[B_+6], P[B_+7]); \
        auto r0 = __builtin_amdgcn_permlane32_swap(a0, b0, false, false); auto r1 = __builtin_amdgcn_permlane32_swap(a1, b1, false, false); \
        u32x4 w = {r0[0], r1[0], r0[1], r1[1]}; OUT = __builtin_bit_cast(bf16x8, w); } while (0)
#define FA_TRRD(dst, off) asm volatile("ds_read_b64_tr_b16 %0, %1 offset:%2" : "=&v"(dst) : "v"(vb0), "i"(off) : "memory")
#define FA_PV_D0(VB, d0) do { s16x4 l0, l1, l2, l3, h0, h1, h2, h3; constexpr int b_ = (VB) * SHM_V + v_rd_off(d0, 0, 0); \
        FA_TRRD(l0, b_); FA_TRRD(h0, b_ + 2048); FA_TRRD(l1, b_ + 4096); FA_TRRD(h1, b_ + 6144); FA_TRRD(l2, b_ + 8192); FA_TRRD(h2, b_ + 10240); FA_TRRD(l3, b_ + 12288); FA_TRRD(h3, b_ + 14336); \
        asm volatile("s_waitcnt lgkmcnt(0)" ::: "memory"); SBAR(); \
        o[d0] = __builtin_amdgcn_mfma_f32_32x32x16_bf16(pa0, (bf16x8){l0[0], l0[1], l0[2], l0[3], h0[0], h0[1], h0[2], h0[3]}, o[d0], 0, 0, 0); \
        o[d0] = __builtin_amdgcn_mfma_f32_32x32x16_bf16(pa1, (bf16x8){l1[0], l1[1], l1[2], l1[3], h1[0], h1[1], h1[2], h1[3]}, o[d0], 0, 0, 0); \
        o[d0] = __builtin_amdgcn_mfma_f32_32x32x16_bf16(pa2, (bf16x8){l2[0], l2[1], l2[2], l2[3], h2[0], h2[1], h2[2], h2[3]}, o[d0], 0, 0, 0); \
        o[d0] = __builtin_amdgcn_mfma_f32_32x32x16_bf16(pa3, (bf16x8){l3[0], l3[1], l3[2], l3[3], h3[0], h3[1], h3[2], h3[3]}, o[d0], 0, 0, 0); } while (0)
    for (int t = 0; t < NT; t += 2) { FA_STEP(0, t); if (t + 1 < NT) FA_STEP(1, t + 1); }
    li_l[r32] = l_reg;
    if constexpr (VAR == 1) { const bf16* gp = it.G + (long)(qlo + r32) * it.gs;
#pragma unroll
        for (int k = 0; k < 3; ++k) { const float gl = __builtin_bit_cast(float, (unsigned)gp[k] << 16); wsl[64 + 32 * k + r32] = 1.0f / (1.0f + __expf(-gl)); } }
    asm volatile("s_waitcnt lgkmcnt(0)" ::: "memory");
    if (it.LSE && hi == 0) it.LSE[(long)(qlo + r32) * it.lses] = m_reg * SCALE + __logf(l_reg);
    FA_LAS unsigned char* stg = L + wid * (32 * OSTG);
#pragma unroll
    for (int r = 0; r < 16; ++r) { const int orow = crow(r, hi); const float lv_ = li_l[orow]; float rl = lv_ > 0.f ? __builtin_amdgcn_rcpf(lv_) : 0.f; if constexpr (VAR == 1 && !FA_DBG_NOMERGE) rl *= wsl[64 + 32 + orow];
#pragma unroll
        for (int d0 = 0; d0 < 4; ++d0) { const float v = o[d0][r] * rl; const unsigned u = __builtin_bit_cast(unsigned, v); *(FA_LAS unsigned short*)(stg + orow * OSTG + (d0 * 32 + r32) * 2) = (unsigned short)((u + 0x7fffu + ((u >> 16) & 1u)) >> 16); } }
    asm volatile("s_waitcnt lgkmcnt(0)" ::: "memory");
#pragma unroll
    for (int i = 0; i < 8; ++i) { const int id = lane + 64 * i, row = id >> 4, ch = id & 15; const long qi = (long)(qlo + row);
        u32x4 w = *(const FA_LAS u32x4*)(stg + row * OSTG + ch * 16);
        if constexpr (VAR == 1 && !FA_DBG_NOMERGE) { const float g0 = wsl[64 + row], g2 = wsl[64 + 64 + row];
            const u32x4 a = *(const u32x4*)(it.M0 + qi * it.ms + ch * 8), c = *(const u32x4*)(it.M1 + qi * it.ms + ch * 8);
#pragma unroll
            for (int k = 0; k < 4; ++k) { const float lo = __builtin_bit_cast(float, w[k] << 16) + g0 * __builtin_bit_cast(float, a[k] << 16) + g2 * __builtin_bit_cast(float, c[k] << 16);
                const float hi_ = __builtin_bit_cast(float, w[k] & 0xffff0000u) + g0 * __builtin_bit_cast(float, a[k] & 0xffff0000u) + g2 * __builtin_bit_cast(float, c[k] & 0xffff0000u); w[k] = cvtpk(lo, hi_); } }
        *(u32x4*)(it.O + qi * it.os + ch * 8) = w; }
    __syncthreads();
#undef FA_LOAD
#undef FA_WRITE
#undef FA_KBASE
#undef FA_STEP
#undef FA_PK4
#undef FA_TRRD
#undef FA_PV_D0
}

struct CmpItem { const bf16* Q; long qs; const bf16* K; const bf16* V; const float* bias; int bld; int s0; bf16* O; long os; unsigned long long* sel; };
__device__ __forceinline__ void cmp_block(const CmpItem& it, unsigned char* lds_g, int imps_off) {
    constexpr float SCALE = 0.08838834764831845f, C2 = 1.4426950408889634f * SCALE;
    constexpr int OFF_TABC = 65536;
    FA_LAS unsigned char* L = (FA_LAS unsigned char*)lds_g;
    const int tid = threadIdx.x, wid = __builtin_amdgcn_readfirstlane(tid >> 6), lane = tid & 63, r32 = lane & 31, hi = lane >> 5;
    FA_LAS float* tabc = (FA_LAS float*)(L + OFF_TABC); FA_LAS float* imps = (FA_LAS float*)(L + imps_off);
    const int tokl = wid * 8 + (r32 >> 2), rh = r32 & 3, s = it.s0 + tokl;
    const int nvis = (it.s0 + 63 - 31) / 16 + 1 > 255 ? 255 : (it.s0 + 63 - 31) / 16 + 1;
    const int NT = (nvis + 63) / 64;
    const int nlim = (s - 31) >> 4;
    const int sr = tid >> 4, sc = (tid & 15) * 8, vst0 = v_st(sr, sc), vst1 = v_st(32 + sr, sc), kws = KSWZ(sr, sc * 2);
    const int vb0 = OFF_V + v_rd_base(lane);
    bf16x8 qr[8];
    { const bf16* qp = it.Q + (long)tokl * it.qs + rh * 128 + hi * 8;
#pragma unroll
      for (int d0 = 0; d0 < 8; ++d0) qr[d0] = *(const bf16x8*)(qp + d0 * 16); }
    for (int i = tid; i < 4 * 4096; i += 512) tabc[i] = it.bias[(long)(i >> 12) * it.bld + (i & 4095)] * (1.0f / SCALE);
    for (int i = tid; i < 64 * 64; i += 512) imps[i] = 0.f;
    bf16x8 st_k0, st_k1, st_v0, st_v1;
#define CM_LOADK(kb_) do { st_k0 = *(const bf16x8*)(it.K + (long)((kb_) + sr) * 128 + sc); st_k1 = *(const bf16x8*)(it.K + (long)((kb_) + 32 + sr) * 128 + sc); } while (0)
#define CM_LOADV(kb_) do { st_v0 = *(const bf16x8*)(it.V + (long)((kb_) + sr) * 128 + sc); st_v1 = *(const bf16x8*)(it.V + (long)((kb_) + 32 + sr) * 128 + sc); } while (0)
#define CM_WRITEK(bf_) do { *(FA_LAS bf16x8*)(L + OFF_K + (bf_) * SHM_K + kws) = st_k0; *(FA_LAS bf16x8*)(L + OFF_K + (bf_) * SHM_K + kws + 32 * 256) = st_k1; } while (0)
#define CM_WRITEV(bf_) do { *(FA_LAS bf16x8*)(L + OFF_V + (bf_) * SHM_V + vst0) = st_v0; *(FA_LAS bf16x8*)(L + OFF_V + (bf_) * SHM_V + vst1) = st_v1; } while (0)
#define CM_SCORES(BUF, kb_) \
        f32x16 p0 = {}, p1 = {}; \
        { const int ka_ = OFF_K + (BUF) * SHM_K; \
          _Pragma("unroll") for (int d0 = 0; d0 < 8; ++d0) { \
            const bf16x8 b0 = *(const FA_LAS bf16x8*)(L + ka_ + KSWZ(r32, (d0 * 16 + hi * 8) * 2)); \
            const bf16x8 b1 = *(const FA_LAS bf16x8*)(L + ka_ + 32 * 256 + KSWZ(r32, (d0 * 16 + hi * 8) * 2)); \
            p0 = __builtin_amdgcn_mfma_f32_32x32x16_bf16(b0, qr[d0], p0, 0, 0, 0); p1 = __builtin_amdgcn_mfma_f32_32x32x16_bf16(b1, qr[d0], p1, 0, 0, 0); } } \
        { const int nb_ = (kb_) + 4 * hi, relb_ = s - 31 - 16 * nb_; const float NEG_ = -__builtin_inff(); \
          _Pragma("unroll") for (int r = 0; r < 16; ++r) { const int c_ = (r & 3) + 8 * (r >> 2); \
            { const int rel_ = relb_ - 16 * c_; const int ix_ = rel_ < 0 ? 0 : rel_; const float bv_ = tabc[rh * 4096 + ix_]; p0[r] = (nb_ + c_ <= nlim) ? p0[r] + bv_ : NEG_; } \
            { const int rel_ = relb_ - 16 * (c_ + 32); const int ix_ = rel_ < 0 ? 0 : rel_; const float bv_ = tabc[rh * 4096 + ix_]; p1[r] = (nb_ + c_ + 32 <= nlim) ? p1[r] + bv_ : NEG_; } } }
    CM_LOADK(0); asm volatile("s_waitcnt vmcnt(0)" ::: "memory"); CM_WRITEK(0); __syncthreads();
    float m_reg = -1e30f, l_reg = 0.f;
#define CM_P1(BUF, t) do { if ((t) + 1 < NT) CM_LOADK(((t) + 1) * 64); \
        { CM_SCORES(BUF, (t) * 64) \
          float pmax_ = p0[0]; _Pragma("unroll") for (int r = 1; r < 16; ++r) pmax_ = fmaxf(pmax_, p0[r]); _Pragma("unroll") for (int r = 0; r < 16; ++r) pmax_ = fmaxf(pmax_, p1[r]); \
          { auto rr_ = __builtin_amdgcn_permlane32_swap(__float_as_uint(pmax_), __float_as_uint(pmax_), false, false); pmax_ = fmaxf(__uint_as_float(rr_[0]), __uint_as_float(rr_[1])); } \
          const float mn_ = fmaxf(m_reg, pmax_), alpha_ = __builtin_amdgcn_exp2f((m_reg - mn_) * C2), mnL_ = -mn_ * C2; float ps_ = 0.f; \
          _Pragma("unroll") for (int r = 0; r < 16; ++r) ps_ += __builtin_amdgcn_exp2f(fmaf(p0[r], C2, mnL_)) + __builtin_amdgcn_exp2f(fmaf(p1[r], C2, mnL_)); \
          { auto rr_ = __builtin_amdgcn_permlane32_swap(__float_as_uint(ps_), __float_as_uint(ps_), false, false); ps_ = __uint_as_float(rr_[0]) + __uint_as_float(rr_[1]); } \
          l_reg = l_reg * alpha_ + ps_; m_reg = mn_; } \
        if ((t) + 1 < NT) { asm volatile("s_waitcnt vmcnt(0)" ::: "memory"); CM_WRITEK(1 - (BUF)); } \
        __syncthreads(); } while (0)
    for (int t = 0; t < NT; t += 2) { CM_P1(0, t); if (t + 1 < NT) CM_P1(1, t + 1); }
    const float inv_l = l_reg > 0.f ? 1.0f / l_reg : 0.f, mL = -m_reg * C2;
    CM_LOADK(0); CM_LOADV(0); asm volatile("s_waitcnt vmcnt(0)" ::: "memory"); CM_WRITEK(0); CM_WRITEV(0); __syncthreads();
    f32x16 o[4] = {};
#define FA_PK4(P, B_, OUT) do { unsigned a0 = cvtpk(P[B_+0], P[B_+1]), a1 = cvtpk(P[B_+2], P[B_+3]); unsigned b0 = cvtpk(P[B_+4], P[B_+5]), b1 = cvtpk(P[B_+6], P[B_+7]); \
        auto r0 = __builtin_amdgcn_permlane32_swap(a0, b0, false, false); auto r1 = __builtin_amdgcn_permlane32_swap(a1, b1, false, false); \
        u32x4 w = {r0[0], r1[0], r0[1], r1[1]}; OUT = __builtin_bit_cast(bf16x8, w); } while (0)
#define FA_TRRD(dst, off) asm volatile("ds_read_b64_tr_b16 %0, %1 offset:%2" : "=&v"(dst) : "v"(vb0), "i"(off) : "memory")
#define FA_PV_D0(VB, d0) do { s16x4 l0, l1, l2, l3, h0, h1, h2, h3; constexpr int b_ = (VB) * SHM_V + v_rd_off(d0, 0, 0); \
        FA_TRRD(l0, b_); FA_TRRD(h0, b_ + 2048); FA_TRRD(l1, b_ + 4096); FA_TRRD(h1, b_ + 6144); FA_TRRD(l2, b_ + 8192); FA_TRRD(h2, b_ + 10240); FA_TRRD(l3, b_ + 12288); FA_TRRD(h3, b_ + 14336); \
        asm volatile("s_waitcnt lgkmcnt(0)" ::: "memory"); SBAR(); \
        o[d0] = __builtin_amdgcn_mfma_f32_32x32x16_bf16(pa0, (bf16x8){l0[0], l0[1], l0[2], l0[3], h0[0], h0[1], h0[2], h0[3]}, o[d0], 0, 0, 0); \
        o[d0] = __builtin_amdgcn_mfma_f32_32x32x16_bf16(pa1, (bf16x8){l1[0], l1[1], l1[2], l1[3], h1[0], h1[1], h1[2], h1[3]}, o[d0], 0, 0, 0); \
        o[d0] = __builtin_amdgcn_mfma_f32_32x32x16_bf16(pa2, (bf16x8){l2[0], l2[1], l2[2], l2[3], h2[0], h2[1], h2[2], h2[3]}, o[d0], 0, 0, 0); \
        o[d0] = __builtin_amdgcn_mfma_f32_32x32x16_bf16(pa3, (bf16x8){l3[0], l3[1], l3[2], l3[3], h3[0], h3[1], h3[2], h3[3]}, o[d0], 0, 0, 0); } while (0)
#define CM_IMP(P, half_, t) do { _Pragma("unroll") for (int q4 = 0; q4 < 4; ++q4) { \
            float A_ = (2.0f * ((P[4 * q4] + P[4 * q4 + 1]) + P[4 * q4 + 2]) + P[4 * q4 + 3]) * inv_l, B_ = P[4 * q4 + 3] * inv_l; \
            A_ += __shfl_xor(A_, 1); A_ += __shfl_xor(A_, 2); B_ += __shfl_xor(B_, 1); B_ += __shfl_xor(B_, 2); \
            const int j_ = 2 * q4 + hi + 8 * (half_) + 16 * (t); \
            if (rh == 0) { __hip_atomic_fetch_add(&imps[tokl * 64 + j_], A_, __ATOMIC_RELAXED, __HIP_MEMORY_SCOPE_WORKGROUP); \
                if (j_ + 1 < 64) __hip_atomic_fetch_add(&imps[tokl * 64 + j_ + 1], B_, __ATOMIC_RELAXED, __HIP_MEMORY_SCOPE_WORKGROUP); } } } while (0)
#define CM_P2(BUF, t) do { if ((t) + 1 < NT) { CM_LOADK(((t) + 1) * 64); CM_LOADV(((t) + 1) * 64); } \
        { CM_SCORES(BUF, (t) * 64) \
          _Pragma("unroll") for (int r = 0; r < 16; ++r) { p0[r] = __builtin_amdgcn_exp2f(fmaf(p0[r], C2, mL)); p1[r] = __builtin_amdgcn_exp2f(fmaf(p1[r], C2, mL)); } \
          CM_IMP(p0, 0, t); CM_IMP(p1, 1, t); \
          bf16x8 pa0, pa1, pa2, pa3; FA_PK4(p0, 0, pa0); FA_PK4(p0, 8, pa1); FA_PK4(p1, 0, pa2); FA_PK4(p1, 8, pa3); \
          FA_PV_D0(BUF, 0); FA_PV_D0(BUF, 1); FA_PV_D0(BUF, 2); FA_PV_D0(BUF, 3); } \
        if ((t) + 1 < NT) { asm volatile("s_waitcnt vmcnt(0)" ::: "memory"); CM_WRITEK(1 - (BUF)); CM_WRITEV(1 - (BUF)); } \
        __syncthreads(); } while (0)
    for (int t = 0; t < NT; t += 2) { CM_P2(0, t); if (t + 1 < NT) CM_P2(1, t + 1); }
    asm volatile("s_waitcnt lgkmcnt(0)" ::: "memory");
    for (int tk = 0; tk < 8; ++tk) { const int sp = it.s0 + wid * 8 + tk, blk_t = sp >> 6, j = lane;
        const float is = imps[(wid * 8 + tk) * 64 + j];
        const bool forced = (j == 0) || (j == blk_t) || (j == blk_t - 1), valid = j <= blk_t;
        const float scv = forced ? 1e9f : (valid ? is : -1.0f);
        int rank = 0;
        for (int k = 0; k < 64; ++k) { const float vk = __shfl(scv, k); rank += (vk > scv || (vk == scv && k < j)) ? 1 : 0; }
        const unsigned long long msk = __ballot(rank < 16 && scv > -0.5f);
        if (lane == 0) it.sel[(long)(wid * 8 + tk) * 2] = msk; }
    FA_LAS unsigned char* stg = L + wid * (32 * OSTG);
    FA_LAS float* li_c = imps + wid * 512;
    li_c[r32] = inv_l; asm volatile("s_waitcnt lgkmcnt(0)" ::: "memory");
#pragma unroll
    for (int r = 0; r < 16; ++r) { const int orow = crow(r, hi); const float rl = li_c[orow];
#pragma unroll
        for (int d0 = 0; d0 < 4; ++d0) { const unsigned u = __builtin_bit_cast(unsigned, o[d0][r] * rl); *(FA_LAS unsigned short*)(stg + orow * OSTG + (d0 * 32 + r32) * 2) = (unsigned short)((u + 0x7fffu + ((u >> 16) & 1u)) >> 16); } }
    asm volatile("s_waitcnt lgkmcnt(0)" ::: "memory");
#pragma unroll
    for (int i = 0; i < 8; ++i) { const int id = lane + 64 * i, row = id >> 4, ch = id & 15;
        const u32x4 w = *(const FA_LAS u32x4*)(stg + row * OSTG + ch * 16);
        *(u32x4*)(it.O + (long)(wid * 8 + (row >> 2)) * it.os + (row & 3) * 128 + ch * 8) = w; }
    __syncthreads();
#undef CM_LOADK
#undef CM_LOADV
#undef CM_WRITEK
#undef CM_WRITEV
#undef CM_SCORES
#undef CM_P1
#undef CM_P2
#undef CM_IMP
#undef FA_PK4
#undef FA_TRRD
#undef FA_PV_D0
}
}

constexpr int D = 2048, NB = 4, S = 4096, M = NB * S;
constexpr int HD = 128;
constexpr int Z0W = 3840;
constexpr int Z_NQ = 0, Z_NKV = 1024, Z_QLAT = 2560, Z_KVLAT = 3072, Z_KPE = 3584, Z_NG = 3648;
constexpr int QMW = 1536, KVMW = 2048;
constexpr int FF = 5632, FFE = 7168, NE = 8;
constexpr int Z1W = 9216;
constexpr int NSLOT = (2 * M / 256 + NE) * 256;
constexpr float RMS_EPS = 1e-6f;

constexpr size_t MiB = 1u << 20;
constexpr size_t WS_CTL = 0, CTL_ZERO_BYTES = 1 * MiB;
constexpr size_t WS_MOD = 1 * MiB;
constexpr size_t WS_BIAS = 2 * MiB;
constexpr int BIAS_LD = 4096 + 64;
constexpr size_t WS_ROPE = 3 * MiB;
constexpr size_t WS_RINV = 8 * MiB;
constexpr size_t WS_SEL = 9 * MiB;
constexpr size_t WS_KC = 10 * MiB;
constexpr size_t WS_VC = 11 * MiB;
constexpr size_t WS_ROUTE = 12 * MiB;
constexpr size_t WS_LSE = 13 * MiB;
constexpr size_t WS_KPE = 15 * MiB;
constexpr size_t WS_W1T = 17 * MiB, WS_W2T = 19 * MiB, WS_CB1 = 20 * MiB;
constexpr size_t WS_WIN0 = 21 * MiB, WS_WUQ = 36 * MiB, WS_WUKV = 38 * MiB, WS_WOUT0 = 40 * MiB, WS_WGU0 = 48 * MiB, WS_WDN0 = 92 * MiB;
constexpr size_t WS_WIN1 = 114 * MiB, WS_WOUT1 = 150 * MiB, WS_WMGU = 154 * MiB, WS_WMDN = 602 * MiB;
constexpr size_t WS_X = 826 * MiB;
constexpr size_t WS_H = 954 * MiB;
constexpr size_t WS_R = 1018 * MiB;
constexpr size_t WS_Z0 = WS_R, WS_QM = WS_R + 120 * MiB, WS_KVM = WS_R + 168 * MiB, WS_OCMP = WS_R + 232 * MiB, WS_OWIN = WS_R + 264 * MiB, WS_CAT = WS_R + 328 * MiB;
constexpr size_t WS_ACT = WS_R;
constexpr size_t WS_Z1 = WS_R, WS_OP = WS_R + 288 * MiB, WS_OM = WS_R + 384 * MiB;
constexpr size_t WS_XB = WS_R, WS_ACTB = WS_R + 136 * MiB, WS_YB = WS_R;
constexpr size_t WS_END = WS_R + 612 * MiB;
static_assert(WS_Z0 + (size_t)M * Z0W * 2 <= WS_QM && WS_QM + (size_t)M * QMW * 2 <= WS_KVM && WS_KVM + (size_t)M * KVMW * 2 <= WS_OCMP && WS_CAT + (size_t)M * 2048 * 2 <= WS_END, "L0 map");
static_assert(WS_Z1 + (size_t)M * Z1W * 2 <= WS_OM && WS_XB + (size_t)NSLOT * D * 2 <= WS_ACTB && WS_ACTB + (size_t)NSLOT * FFE * 2 <= WS_END, "L1 map");
static_assert(WS_WMDN + (size_t)NE * D * FFE * 2 <= WS_X && WS_WMGU + (size_t)NE * 2 * FFE * D * 2 <= WS_WMDN, "weights map");
constexpr int CW_BAR = 4096;
constexpr int CW_CNT = 64;
constexpr int CW_TS = 128;
constexpr int CW_Q = 8192;

constexpr int RING_BYTES = 131072;
constexpr int SMALL_OFF = RING_BYTES;
constexpr int LDSCTL_OFF = RING_BYTES + 16384, MISC_OFF = LDSCTL_OFF;
constexpr int LDS_BYTES = LDSCTL_OFF + 256;
constexpr int NWAVES = 8;

#define GAS __attribute__((address_space(1)))
#define LAS __attribute__((address_space(3)))
typedef unsigned short bf16;
typedef unsigned v4u __attribute__((ext_vector_type(4)));
typedef unsigned v2u __attribute__((ext_vector_type(2)));
typedef float f32x4 __attribute__((ext_vector_type(4)));
typedef float f32x2 __attribute__((ext_vector_type(2)));
#define LDS_WAIT() asm volatile("s_waitcnt lgkmcnt(0)" ::: "memory")
__device__ __forceinline__ unsigned f2bf(float f) { unsigned u = __builtin_bit_cast(unsigned, f); return (u + 0x7fffu + ((u >> 16) & 1u)) >> 16; }
__device__ __forceinline__ unsigned pk2(float lo, float hi) { return f2bf(lo) | (f2bf(hi) << 16); }
__device__ __forceinline__ float bf2f(unsigned short b) { return __builtin_bit_cast(float, (unsigned)b << 16); }
__device__ __forceinline__ float bflo(unsigned w) { return __builtin_bit_cast(float, w << 16); }
__device__ __forceinline__ float bfhi(unsigned w) { return __builtin_bit_cast(float, w & 0xffff0000u); }
__device__ __forceinline__ float wave_sum(float v) {
#pragma unroll
    for (int o = 1; o < 64; o <<= 1) v += __shfl_xor(v, o);
    return v;
}
__device__ __forceinline__ float wave_max(float v) {
#pragma unroll
    for (int o = 1; o < 64; o <<= 1) v = fmaxf(v, __shfl_xor(v, o));
    return v;
}

#define XB_TMO      128
#define XB_XCNT(j)  (256  + 64 * (j))
#define XB_XSUB(j)  (1280 + 64 * (j))
#define XB_XGEN(j)  (2304 + 64 * (j))
#define XB_TOP      3328
#define XB_TOPGEN   3392
#define XCD_BAR_WORDS 3456
#define XB_SPIN_CAP (1u << 22)

__device__ __forceinline__ unsigned xb_ld(unsigned* p)              { return __hip_atomic_load(p, __ATOMIC_RELAXED, __HIP_MEMORY_SCOPE_AGENT); }
__device__ __forceinline__ unsigned xb_add(unsigned* p, unsigned v) { return __hip_atomic_fetch_add(p, v, __ATOMIC_RELAXED, __HIP_MEMORY_SCOPE_AGENT); }
__device__ __forceinline__ unsigned xb_xcc_id() { return (unsigned)__builtin_amdgcn_s_getreg((3 << 11) | 20) & 0xFu; }
#define XB_SPIN(cond, bar) do { unsigned _sp = 0; while (cond) { __builtin_amdgcn_s_sleep(1); \
    if ((++_sp & 255u) == 0u) { if (xb_ld(&(bar)[XB_TMO])) break; if (_sp > XB_SPIN_CAP) { atomicAdd(&(bar)[XB_TMO], 1u); break; } } } } while (0)

struct XcdBarrier {
    unsigned* bar; unsigned x;
    volatile LAS unsigned* st;
};

__device__ __forceinline__ XcdBarrier xcd_barrier_post(unsigned* bar, volatile LAS unsigned* st) {
    XcdBarrier b; b.bar = bar; b.x = xb_xcc_id(); b.st = st;
    if (threadIdx.x == 0) (void)xb_add(&bar[XB_XCNT(b.x)], 1u);
    return b;
}
__device__ __forceinline__ void xcd_barrier_complete(unsigned* bar, unsigned x, unsigned& nloc, unsigned& nx) {
    const unsigned G = gridDim.x * gridDim.y * gridDim.z;
    unsigned sum, cnt, mine, sp = 0u;
    for (;;) {
        sum = 0u; cnt = 0u; mine = 0u;
#pragma unroll
        for (unsigned j = 0; j < 16; ++j) { const unsigned c = xb_ld(&bar[XB_XCNT(j)]); sum += c; cnt += (c > 0u) ? 1u : 0u; mine = (j == x) ? c : mine; }
        if (sum == G) break;
        __builtin_amdgcn_s_sleep(1);
        if ((++sp & 255u) == 0u) { if (xb_ld(&bar[XB_TMO])) break; if (sp > XB_SPIN_CAP) { atomicAdd(&bar[XB_TMO], 1u); break; } }
    }
    nloc = mine > 0u ? mine : 1u; nx = cnt > 0u ? cnt : 1u;
}

__device__ __forceinline__ void xcd_barrier(const XcdBarrier& b) {
    asm volatile("s_waitcnt vmcnt(0)" ::: "memory");
    __syncthreads();
    if (threadIdx.x == 0) {
        unsigned* bar = b.bar;
        __builtin_amdgcn_s_waitcnt(0);
        unsigned nloc = b.st[0], nx = b.st[1];
        if (nloc == 0u) { xcd_barrier_complete(bar, b.x, nloc, nx); b.st[0] = nloc; b.st[1] = nx; }
        const unsigned old = xb_add(&bar[XB_XSUB(b.x)], 1u);
        const unsigned gen = old / nloc;
        if (old + 1u == (gen + 1u) * nloc) {
            __builtin_amdgcn_fence(__ATOMIC_RELEASE, "agent");
            asm volatile("s_waitcnt vmcnt(0)" ::: "memory");
            const unsigned og = xb_add(&bar[XB_TOP], 1u);
            const unsigned tg = og / nx;
            if (og + 1u == (tg + 1u) * nx) xb_add(&bar[XB_TOPGEN], 1u);
            else XB_SPIN(xb_ld(&bar[XB_TOPGEN]) == tg, bar);
            __builtin_amdgcn_fence(__ATOMIC_ACQUIRE, "agent");
            xb_add(&bar[XB_XGEN(b.x)], 1u);
            asm volatile("s_waitcnt vmcnt(0)" ::: "memory");
        } else {
            XB_SPIN(xb_ld(&bar[XB_XGEN(b.x)]) == gen, bar);
            __builtin_amdgcn_fence(__ATOMIC_ACQUIRE, "agent");
            asm volatile("s_waitcnt vmcnt(0)" ::: "memory");
        }
    }
    __syncthreads();
}


struct Args { const void* in[30]; float* out; unsigned char* ws; int ph_lo, ph_hi; };
struct Frame {
    unsigned char* lds;
    int tid, lane, wave, vcu, G, gw, NGW;
    unsigned char* ws;
};

__device__ __forceinline__ int t5_bucket(int n) {
    if (n < 16) return n < 0 ? 0 : n;
    int b = 16;
    b += (n >= 22); b += (n >= 30); b += (n >= 40); b += (n >= 54); b += (n >= 73); b += (n >= 99); b += (n >= 134); b += (n >= 182);
    b += (n >= 246); b += (n >= 332); b += (n >= 450); b += (n >= 609); b += (n >= 825); b += (n >= 1117); b += (n >= 1513);
    return b;
}

__device__ __forceinline__ unsigned pk4_fp8(float a, float b, float c, float d) { int w = 0; w = __builtin_amdgcn_cvt_pk_fp8_f32(a, b, w, false); w = __builtin_amdgcn_cvt_pk_fp8_f32(c, d, w, true); return (unsigned)w; }
template <int MAP, bool OUT8 = false>
__device__ __forceinline__ void p0_transpose_item(const float* W, const float* W2, int K, int Nsrc, int Ndst, bf16* WT, const float* kscale, float* scr, int item, int lane, float oscale = 1.0f) {
    const int nblk = Ndst / 64, kb = item / nblk, nb = item % nblk, k0 = 64 * kb, n0 = 64 * nb;
    const int n4 = (lane & 15) * 4, n = n0 + n4, kr = lane >> 4;
    const float* src = W; int sc = n; bool ok = true;
    if (MAP == 1) { if (n < Z_QLAT) sc = n; else if (n < Z_NG) sc = n + 24; else if (n < Z_NG + 24) sc = n - Z_NG + 2560; else ok = false; }
    if (MAP == 2) { const int g32 = n >> 5, w = n & 31; src = (w < 16) ? W : W2; sc = g32 * 16 + (w & 15); }
    f32x4 v[16];
#pragma unroll
    for (int i = 0; i < 16; ++i) v[i] = ok ? __builtin_nontemporal_load((const f32x4*)(src + (size_t)(k0 + 4 * i + kr) * Nsrc + sc)) : (f32x4){0.f, 0.f, 0.f, 0.f};
#pragma unroll
    for (int i = 0; i < 16; ++i) { const int kk = 4 * i + kr; f32x4 t = v[i]; if (kscale) t = t * kscale[k0 + kk]; float* d = scr + kk * 65 + n4; d[0] = t.x; d[1] = t.y; d[2] = t.z; d[3] = t.w; }
    LDS_WAIT(); asm volatile("" ::: "memory");
    if constexpr (OUT8) {
        const int kg = lane & 3;
#pragma unroll
        for (int p = 0; p < 4; ++p) { const int nn = 16 * p + (lane >> 2); const float* s = scr + (16 * kg) * 65 + nn;
            v4u o; o.x = pk4_fp8(s[0 * 65] * oscale, s[1 * 65] * oscale, s[2 * 65] * oscale, s[3 * 65] * oscale); o.y = pk4_fp8(s[4 * 65] * oscale, s[5 * 65] * oscale, s[6 * 65] * oscale, s[7 * 65] * oscale);
            o.z = pk4_fp8(s[8 * 65] * oscale, s[9 * 65] * oscale, s[10 * 65] * oscale, s[11 * 65] * oscale); o.w = pk4_fp8(s[12 * 65] * oscale, s[13 * 65] * oscale, s[14 * 65] * oscale, s[15 * 65] * oscale);
            *(v4u*)((unsigned char*)WT + (size_t)(n0 + nn) * K + k0 + 16 * kg) = o; }
    } else {
    const int kg = lane & 7;
#pragma unroll
    for (int p = 0; p < 8; ++p) { const int nn = 8 * p + (lane >> 3); const float* s = scr + (8 * kg) * 65 + nn;
        v4u o; o.x = pk2(s[0 * 65], s[1 * 65]); o.y = pk2(s[2 * 65], s[3 * 65]); o.z = pk2(s[4 * 65], s[5 * 65]); o.w = pk2(s[6 * 65], s[7 * 65]);
        *(v4u*)(WT + (size_t)(n0 + nn) * K + k0 + 8 * kg) = o; }
    }
    LDS_WAIT(); asm volatile("" ::: "memory");
}
template <int MAP, bool OUT8 = false>
__device__ __forceinline__ void p0_transpose(Frame& F, const float* W, const float* W2, int K, int Nsrc, int Ndst, bf16* WT, const float* kscale, float oscale = 1.0f) {
    float* scr = (float*)(F.lds + F.wave * 16640);
    const int nitems = (K / 64) * (Ndst / 64);
    for (int it = F.gw; it < nitems; it += F.NGW) p0_transpose_item<MAP, OUT8>(W, W2, K, Nsrc, Ndst, WT, kscale, scr, it, F.lane, oscale);
}

__device__ __forceinline__ void modnorm_row(const float* xrow, const float* g, const float* sc, const float* sh, bf16* orow, int lane, f32x4 (&v)[8]) {
    const f32x4* xr = (const f32x4*)xrow + lane; float s = 0.f;
#pragma unroll
    for (int j = 0; j < 8; ++j) { v[j] = xr[64 * j]; s += (v[j].x * v[j].x + v[j].y * v[j].y) + (v[j].z * v[j].z + v[j].w * v[j].w); }
    const float rinv = 1.0f / sqrtf(wave_sum(s) * (1.f / D) + RMS_EPS);
    unsigned long long* o8 = (unsigned long long*)orow + lane;
#pragma unroll
    for (int j = 0; j < 8; ++j) { const f32x4 gg = ((const f32x4*)g)[lane + 64 * j], cc = ((const f32x4*)sc)[lane + 64 * j], hh = ((const f32x4*)sh)[lane + 64 * j];
        v[j] = (v[j] * rinv) * gg * (cc + 1.0f) + hh;
        o8[64 * j] = (unsigned long long)pk2(v[j].x, v[j].y) | ((unsigned long long)pk2(v[j].z, v[j].w) << 32); }
}
__device__ __forceinline__ void modnorm_phase(Frame& F, const float* x, const float* g, const float* mod  , int sh_idx, bf16* H) {
    for (int b = 0; b < NB; ++b) { const float* mb = mod + (size_t)b * 6 * D; const float* sc = mb + (size_t)(sh_idx + 1) * D; const float* sh = mb + (size_t)sh_idx * D;
        const int s0 = F.gw, s1 = F.gw + F.NGW;
        const f32x4* x0 = (const f32x4*)(x + ((size_t)b * S + s0) * D) + F.lane; const f32x4* x1 = (const f32x4*)(x + ((size_t)b * S + s1) * D) + F.lane;
        f32x4 v0[8], v1[8], ca[8], cc[8];
#pragma unroll
        for (int j = 0; j < 8; ++j) { v0[j] = x0[64 * j]; v1[j] = x1[64 * j]; }
#pragma unroll
        for (int j = 0; j < 8; ++j) { ca[j] = ((const f32x4*)g)[F.lane + 64 * j] * (((const f32x4*)sc)[F.lane + 64 * j] + 1.0f); cc[j] = ((const f32x4*)sh)[F.lane + 64 * j]; }
        float q0 = 0.f, q1 = 0.f;
#pragma unroll
        for (int j = 0; j < 8; ++j) { q0 += (v0[j].x * v0[j].x + v0[j].y * v0[j].y) + (v0[j].z * v0[j].z + v0[j].w * v0[j].w); q1 += (v1[j].x * v1[j].x + v1[j].y * v1[j].y) + (v1[j].z * v1[j].z + v1[j].w * v1[j].w); }
        const float r0 = 1.0f / sqrtf(wave_sum(q0) * (1.f / D) + RMS_EPS), r1 = 1.0f / sqrtf(wave_sum(q1) * (1.f / D) + RMS_EPS);
        unsigned long long* o0 = (unsigned long long*)(H + ((size_t)b * S + s0) * D) + F.lane; unsigned long long* o1 = (unsigned long long*)(H + ((size_t)b * S + s1) * D) + F.lane;
#pragma unroll
        for (int j = 0; j < 8; ++j) { const f32x4 a = (v0[j] * r0) * ca[j] + cc[j], c2 = (v1[j] * r1) * ca[j] + cc[j];
            o0[64 * j] = (unsigned long long)pk2(a.x, a.y) | ((unsigned long long)pk2(a.z, a.w) << 32); o1[64 * j] = (unsigned long long)pk2(c2.x, c2.y) | ((unsigned long long)pk2(c2.z, c2.w) << 32); }
    }
}

struct NA { const bf16* k; long kstride; const bf16* k2; long k2stride; int dq, dq2; const bf16* v; long vstride; int t0, tstep, nk; const float* bias; int brel0, bstep; float scale; unsigned long long cmask; int use_sel; };
__device__ __forceinline__ void na_run(const NA& a, const float* qs, float* sc, int lane, float& mx, float& sum, float& o0, float& o1) {
    float lmax = -3.0e38f;
    for (int c = 0; c * 64 < a.nk; ++c) {
        const int kk = c * 64 + lane; float s = -__builtin_inff();
        const bool chunk_ok = !a.use_sel || ((a.cmask >> ((a.t0 + c * 64 * a.tstep) >> 6)) & 1ull);
        if (chunk_ok && kk < a.nk) {
            const long t = a.t0 + (long)kk * a.tstep; const bf16* kr = a.k + t * a.kstride; float acc = 0.f;
            for (int d = 0; d < a.dq; d += 8) { const v4u w = *(const v4u*)(kr + d); const float* q = qs + d;
                acc += bflo(w.x) * q[0] + bfhi(w.x) * q[1] + bflo(w.y) * q[2] + bfhi(w.y) * q[3] + bflo(w.z) * q[4] + bfhi(w.z) * q[5] + bflo(w.w) * q[6] + bfhi(w.w) * q[7]; }
            if (a.dq2) { const bf16* k2r = a.k2 + t * a.k2stride;
                for (int d = 0; d < a.dq2; d += 8) { const v4u w = *(const v4u*)(k2r + d); const float* q = qs + a.dq + d;
                    acc += bflo(w.x) * q[0] + bfhi(w.x) * q[1] + bflo(w.y) * q[2] + bfhi(w.y) * q[3] + bflo(w.z) * q[4] + bfhi(w.z) * q[5] + bflo(w.w) * q[6] + bfhi(w.w) * q[7]; } }
            s = acc * a.scale; if (a.bias) s += a.bias[a.brel0 - kk * a.bstep];
        }
        if (kk < a.nk) sc[kk] = s;
        lmax = fmaxf(lmax, s);
    }
    mx = wave_max(lmax);
    float ls = 0.f;
    for (int kk = lane; kk < a.nk; kk += 64) { const float p = __expf(sc[kk] - mx); sc[kk] = p; ls += p; }
    sum = wave_sum(ls);
    LDS_WAIT(); asm volatile("" ::: "memory");
    float a0 = 0.f, a1 = 0.f;
    for (int kk = 0; kk < a.nk; ++kk) { const float p = sc[kk]; if (p != 0.f) { const unsigned w = *(const unsigned*)(a.v + (long)(a.t0 + (long)kk * a.tstep) * a.vstride + 2 * lane); a0 += p * bflo(w); a1 += p * bfhi(w); } }
    o0 = a0; o1 = a1;
    asm volatile("" ::: "memory");
}
__device__ __forceinline__ float gelu_tanh(float x) { const float u = 0.7978845608028654f * (x + 0.044715f * x * x * x); return 0.5f * x * (1.0f + tanhf(u)); }
__device__ __forceinline__ float sigmoid_f(float x) { return 1.0f / (1.0f + __expf(-x)); }

__global__ void __launch_bounds__(NWAVES * 64, 2) fwd(Args args) {
    extern __shared__ __attribute__((aligned(16))) unsigned char lds[];
    Frame F;
    F.lds = lds; F.ws = args.ws;
    F.tid = threadIdx.x; F.lane = F.tid & 63; F.wave = __builtin_amdgcn_readfirstlane(F.tid >> 6);
    F.G = gridDim.x; { const int bx = blockIdx.x; F.vcu = (F.G % 8 == 0) ? (bx % 8) * (F.G / 8) + bx / 8 : bx; }
    F.gw = F.vcu * NWAVES + F.wave; F.NGW = F.G * NWAVES;
    unsigned char* ws = args.ws;
    unsigned* ctl = (unsigned*)(ws + WS_CTL);
    volatile LAS unsigned* MISC = (volatile LAS unsigned*)((LAS unsigned char*)lds + MISC_OFF);
    for (int u = F.tid; u < 64; u += NWAVES * 64) MISC[u] = 0u;
    __syncthreads();
    XcdBarrier bar; bar.bar = ctl + CW_BAR; bar.x = 0; bar.st = nullptr;
    if (MK_N_LAUNCHES == 1) bar = xcd_barrier_post(ctl + CW_BAR, MISC + 8);
    const int lo = args.ph_lo, hi = args.ph_hi;
    unsigned long long tprev_ = PROBE_MASK ? wall_clock64() : 0ull;
#define IN(k) (lo <= (k) && (k) < hi)
#ifndef PROBE_MASK
#define PROBE_MASK 0
#endif
#ifndef MOE_F8
#define MOE_F8 0
#endif
#define MOE_WSCALE 64.0f
#define MOE_ASCALE 8.0f
#ifndef PROBE_IDLE_AT
#define PROBE_IDLE_AT (-1)
#endif
#define REPK(k)
#define SEAM(k) do { if (IN(k) && IN((k) + 1)) { xcd_barrier(bar); \
        if ((PROBE_MASK >> (k)) & 1) { const unsigned long long t1_ = wall_clock64(); while (wall_clock64() < t1_ + (t1_ - tprev_)) __builtin_amdgcn_s_sleep(8); __syncthreads(); } \
        if (PROBE_IDLE_AT == (k)) { const unsigned long long t1_ = wall_clock64(); while (wall_clock64() < t1_ + 100000ull) __builtin_amdgcn_s_sleep(8); __syncthreads(); } \
        if (PROBE_MASK) tprev_ = wall_clock64(); } } while (0)

    const float* x_in = (const float*)args.in[0]; const float* c_in = (const float*)args.in[1]; const int* positions = (const int*)args.in[2];
    const float* rel_bias = (const float*)args.in[3]; const float* ada_w = (const float*)args.in[4]; const float* ada_b = (const float*)args.in[5];
    const float* mix_norm_g = (const float*)args.in[6]; const float* ffn_norm_g = (const float*)args.in[7];
    const float* ab_w_in = (const float*)args.in[8]; const float* ab_w_out = (const float*)args.in[9];
    const float* cmp_pos_k = (const float*)args.in[10]; const float* cmp_w1_k = (const float*)args.in[11]; const float* cmp_w2_k = (const float*)args.in[12];
    const float* cmp_pos_v = (const float*)args.in[13]; const float* cmp_w1_v = (const float*)args.in[14]; const float* cmp_w2_v = (const float*)args.in[15];
    const float* q_norm_g = (const float*)args.in[16]; const float* kv_norm_g = (const float*)args.in[17]; const float* w_uq = (const float*)args.in[18]; const float* w_ukv = (const float*)args.in[19];
    const float* ffn_wg = (const float*)args.in[20]; const float* ffn_wu = (const float*)args.in[21]; const float* ffn_wd = (const float*)args.in[22];
    const float* c_w_in = (const float*)args.in[23]; const float* c_w_out = (const float*)args.in[24]; const float* w_router = (const float*)args.in[25];
    const float* moe_wg = (const float*)args.in[26]; const float* moe_wu = (const float*)args.in[27]; const float* moe_wd = (const float*)args.in[28]; const float* final_g = (const float*)args.in[29];
    float* MOD = (float*)(ws + WS_MOD); float* BIAS = (float*)(ws + WS_BIAS); float* ROPE = (float*)(ws + WS_ROPE); float* RINV = (float*)(ws + WS_RINV);
    unsigned long long* SEL = (unsigned long long*)(ws + WS_SEL); bf16* KC = (bf16*)(ws + WS_KC); bf16* VC = (bf16*)(ws + WS_VC); int* ROUTE = (int*)(ws + WS_ROUTE); bf16* KPE = (bf16*)(ws + WS_KPE);
    bf16* W_IN0 = (bf16*)(ws + WS_WIN0); bf16* W_UQ = (bf16*)(ws + WS_WUQ); bf16* W_UKV = (bf16*)(ws + WS_WUKV); bf16* W_OUT0 = (bf16*)(ws + WS_WOUT0); bf16* W_GU0 = (bf16*)(ws + WS_WGU0); bf16* W_DN0 = (bf16*)(ws + WS_WDN0);
    bf16* W_IN1 = (bf16*)(ws + WS_WIN1); bf16* W_OUT1 = (bf16*)(ws + WS_WOUT1); bf16* W_MGU = (bf16*)(ws + WS_WMGU); bf16* W_MDN = (bf16*)(ws + WS_WMDN);
    float* X = (float*)(ws + WS_X); bf16* H = (bf16*)(ws + WS_H);
    bf16* Z0 = (bf16*)(ws + WS_Z0); bf16* QM = (bf16*)(ws + WS_QM); bf16* KVM = (bf16*)(ws + WS_KVM); bf16* OCMP = (bf16*)(ws + WS_OCMP); bf16* OWIN = (bf16*)(ws + WS_OWIN); bf16* CAT = (bf16*)(ws + WS_CAT);
    bf16* W1T = (bf16*)(ws + WS_W1T); bf16* W2T = (bf16*)(ws + WS_W2T); float* CB1 = (float*)(ws + WS_CB1);
    float* LSEB = (float*)(ws + WS_LSE); bf16* OP = (bf16*)(ws + WS_OP);
    bf16* ACT = (bf16*)(ws + WS_ACT); bf16* Z1 = (bf16*)(ws + WS_Z1); bf16* OM = (bf16*)(ws + WS_OM); bf16* XB = (bf16*)(ws + WS_XB); bf16* ACTB = (bf16*)(ws + WS_ACTB); bf16* YB = (bf16*)(ws + WS_YB);
    float* wsc = (float*)(lds + F.wave * 16384);
    float* wsm = (float*)(lds + SMALL_OFF + F.wave * 2048);
    PG8_LAS unsigned char* ring = (PG8_LAS unsigned char*)lds;

    REPK(0) if (IN(0)) {
        for (int job = 192 + (int)blockIdx.x; job < 194; job += F.G) {
            float* red = (float*)(lds + 32768); const int c = job - 192; const float* pos = c ? cmp_pos_v : cmp_pos_k; const float* w1 = c ? cmp_w1_v : cmp_w1_k;
            float a0 = 0.f, a1 = 0.f;
#pragma unroll 8
            for (int k = 0; k < 512; ++k) { const int kk = F.wave * 512 + k; const f32x2 wv = *(const f32x2*)(w1 + (size_t)kk * 128 + 2 * F.lane); const float pv = pos[kk]; a0 += pv * wv.x; a1 += pv * wv.y; }
            red[F.wave * 128 + 2 * F.lane] = a0; red[F.wave * 128 + 2 * F.lane + 1] = a1;
            __syncthreads();
            if (F.tid < 128) { float s = 0.f;
#pragma unroll
                for (int w = 0; w < 8; ++w) s += red[w * 128 + F.tid];
                CB1[c * 128 + F.tid] = s; }
            __syncthreads();
        }
        for (int job = blockIdx.x; job < 256; job += F.G) {
            float* cs = (float*)lds; float* red = (float*)(lds + 32768);
            for (int i = F.tid; i < 4 * D; i += 512) { const float cv = c_in[i]; cs[i] = cv / (1.0f + __expf(-cv)); }
            __syncthreads();
            const int l = job >> 7, col0 = (job & 127) * 96; const bool act = F.lane < 48;
            float acc[4][2] = {};
            const float* wp = ada_w + ((size_t)l * D + (size_t)F.wave * 256) * 12288 + col0 + 2 * (act ? F.lane : 0);
#pragma unroll 8
            for (int k = 0; k < 256; ++k) { const f32x2 wv = *(const f32x2*)(wp + (size_t)k * 12288); const int kk = F.wave * 256 + k;
#pragma unroll
                for (int b = 0; b < 4; ++b) { const float cv = cs[b * D + kk]; acc[b][0] += cv * wv.x; acc[b][1] += cv * wv.y; } }
            if (act) {
#pragma unroll
                for (int b = 0; b < 4; ++b) { red[(F.wave * 4 + b) * 96 + 2 * F.lane] = acc[b][0]; red[(F.wave * 4 + b) * 96 + 2 * F.lane + 1] = acc[b][1]; } }
            __syncthreads();
            if (F.tid < 384) { const int b = F.tid / 96, cc = F.tid % 96; float s = 0.f;
#pragma unroll
              for (int w = 0; w < 8; ++w) s += red[(w * 4 + b) * 96 + cc];
              MOD[((size_t)l * 4 + b) * 12288 + col0 + cc] = s + ada_b[(size_t)l * 12288 + col0 + cc]; }
            __syncthreads();
        }
        __syncthreads();
        p0_transpose<1>(F, ab_w_in, nullptr, D, 3672, Z0W, W_IN0, nullptr);
        p0_transpose<0>(F, w_uq, nullptr, 512, QMW, QMW, W_UQ, q_norm_g);
        p0_transpose<0>(F, w_ukv, nullptr, 512, KVMW, KVMW, W_UKV, kv_norm_g);
        p0_transpose<0>(F, ab_w_out, nullptr, D, D, D, W_OUT0, nullptr);
        p0_transpose<2>(F, ffn_wg, ffn_wu, D, FF, 2 * FF, W_GU0, nullptr);
        p0_transpose<0>(F, ffn_wd, nullptr, FF, D, D, W_DN0, nullptr);
        p0_transpose<0>(F, c_w_in, nullptr, D, Z1W, Z1W, W_IN1, nullptr);
        p0_transpose<0>(F, c_w_out, nullptr, 1024, D, D, W_OUT1, nullptr);
        p0_transpose<0>(F, cmp_w1_k, nullptr, 4096, 128, 128, W1T, nullptr); p0_transpose<0>(F, cmp_w1_v, nullptr, 4096, 128, 128, W1T + 128 * 4096, nullptr);
        p0_transpose<0>(F, cmp_w2_k, nullptr, 128, 128, 128, W2T, nullptr); p0_transpose<0>(F, cmp_w2_v, nullptr, 128, 128, 128, W2T + 128 * 128, nullptr);
        for (int e = 0; e < NE; ++e) {
#if MOE_F8
            p0_transpose<2, true>(F, moe_wg + (size_t)e * D * FFE, moe_wu + (size_t)e * D * FFE, D, FFE, 2 * FFE, (bf16*)((unsigned char*)W_MGU + (size_t)e * 2 * FFE * D), nullptr, MOE_WSCALE);
#else
            p0_transpose<2>(F, moe_wg + (size_t)e * D * FFE, moe_wu + (size_t)e * D * FFE, D, FFE, 2 * FFE, W_MGU + (size_t)e * 2 * FFE * D, nullptr);
#endif
#if MOE_F8 >= 2
            p0_transpose<0, true>(F, moe_wd + (size_t)e * FFE * D, nullptr, FFE, D, D, (bf16*)((unsigned char*)W_MDN + (size_t)e * D * FFE), nullptr, MOE_WSCALE);
#else
            p0_transpose<0>(F, moe_wd + (size_t)e * FFE * D, nullptr, FFE, D, D, W_MDN + (size_t)e * D * FFE, nullptr);
#endif
        }
        for (int i = F.gw * 64 + F.lane; i < 8 * BIAS_LD; i += F.NGW * 64) { const int h = i / BIAS_LD, r = i % BIAS_LD - 64; BIAS[i] = rel_bias[t5_bucket(r) * 8 + h]; }
        for (int i = F.gw * 64 + F.lane; i < M * 32; i += F.NGW * 64) { const int m = i >> 5, f = i & 31;
            const float inv_freq = powf(10000.0f, -(float)(2 * f) / 64.0f); const float ang = (float)positions[m] * inv_freq;
            ROPE[(size_t)m * 64 + f] = cosf(ang); ROPE[(size_t)m * 64 + 32 + f] = sinf(ang); }
    }
    SEAM(0);
    REPK(1) if (IN(1)) modnorm_phase(F, x_in, mix_norm_g, MOD, 0, H);
    SEAM(1);
    REPK(2) if (IN(2)) { pg8::Gemm g{H, W_IN0, D, D, D}; pg8::StaticOrder So; So.init(M, Z0W, F.G, (int)blockIdx.x); pg8::EpiBf16 E{Z0, Z0W, nullptr};
        pg8::gemm_phase<pg8::EpiBf16, pg8::StaticOrder, PG_ALIGN, PG_SP2>(ring, g, So, E); }
    SEAM(2);
    REPK(3) if (IN(3)) {
        for (int m = F.gw; m < M; m += F.NGW) {
            const bf16* zr = Z0 + (size_t)m * Z0W;
#pragma unroll
            for (int w = 0; w < 2; ++w) { const v4u a = *(const v4u*)(zr + (w ? Z_KVLAT : Z_QLAT) + 8 * F.lane);
                float s = bflo(a.x) * bflo(a.x) + bfhi(a.x) * bfhi(a.x) + bflo(a.y) * bflo(a.y) + bfhi(a.y) * bfhi(a.y) + bflo(a.z) * bflo(a.z) + bfhi(a.z) * bfhi(a.z) + bflo(a.w) * bflo(a.w) + bfhi(a.w) * bfhi(a.w);
                s = wave_sum(s); if (F.lane == 0) RINV[(size_t)w * M + m] = 1.0f / sqrtf(s * (1.f / 512.f) + RMS_EPS); }
            if (F.lane < 32) { const float x1 = bf2f(zr[Z_KPE + F.lane]), x2 = bf2f(zr[Z_KPE + 32 + F.lane]); const float cs = ROPE[(size_t)m * 64 + F.lane], sn = ROPE[(size_t)m * 64 + 32 + F.lane];
                KPE[(size_t)m * 64 + F.lane] = (bf16)f2bf(x1 * cs - x2 * sn); KPE[(size_t)m * 64 + 32 + F.lane] = (bf16)f2bf(x2 * cs + x1 * sn); }
        }
        __syncthreads();
        for (int job = blockIdx.x; job < 256; job += F.G) {
            typedef short bfx8 __attribute__((ext_vector_type(8)));
            const int nt = job & 15, g = (job >> 4) & 1, b = (job >> 5) & 3, c = job >> 7, n0 = nt * 16;
            const int fr = F.lane & 15, fq = F.lane >> 4; int nrow = n0 + fr; if (nrow > 254) nrow = 254;
            const bf16* arow = Z0 + ((size_t)b * S + 16 * nrow) * Z0W + Z_NKV + c * 256 + g * 128 + fq * 8;
            const bf16* w1t = W1T + (size_t)c * 128 * 4096 + (size_t)fr * 4096 + fq * 8;
            f32x4 acc[8];
#pragma unroll
            for (int i = 0; i < 8; ++i) acc[i] = (f32x4){0.f, 0.f, 0.f, 0.f};
#pragma unroll 2
            for (int ks = 0; ks < 16; ++ks) { const int kk = F.wave * 512 + ks * 32, l = kk >> 7, d0 = kk & 127;
                const bfx8 af = *(const bfx8*)(arow + (size_t)l * Z0W + d0);
#pragma unroll
                for (int i = 0; i < 8; ++i) { const bfx8 bfr = *(const bfx8*)(w1t + (size_t)i * 16 * 4096 + kk); acc[i] = __builtin_amdgcn_mfma_f32_16x16x32_bf16(af, bfr, acc[i], 0, 0, 0); } }
            float* part = (float*)lds;
#pragma unroll
            for (int i = 0; i < 8; ++i)
#pragma unroll
                for (int j = 0; j < 4; ++j) part[(F.wave * 16 + fq * 4 + j) * 128 + i * 16 + fr] = acc[i][j];
            __syncthreads();
            bf16* hid = (bf16*)(lds + 65536);
            { const int row = F.tid >> 5, c4 = (F.tid & 31) * 4; f32x4 s = *(const f32x4*)(CB1 + c * 128 + c4);
#pragma unroll
              for (int w = 0; w < 8; ++w) s += *(const f32x4*)(part + (w * 16 + row) * 128 + c4);
              *(v2u*)(hid + row * 128 + c4) = (v2u){pk2(gelu_tanh(s.x), gelu_tanh(s.y)), pk2(gelu_tanh(s.z), gelu_tanh(s.w))}; }
            __syncthreads();
            { f32x4 o4 = {0.f, 0.f, 0.f, 0.f}; const bf16* w2t = W2T + (size_t)c * 128 * 128 + (size_t)(F.wave * 16 + fr) * 128 + fq * 8;
#pragma unroll
              for (int ks = 0; ks < 4; ++ks) { const bfx8 af = *(const bfx8*)(hid + fr * 128 + ks * 32 + fq * 8); const bfx8 bfr = *(const bfx8*)(w2t + ks * 32); o4 = __builtin_amdgcn_mfma_f32_16x16x32_bf16(af, bfr, o4, 0, 0, 0); }
              bf16* outp = (c ? VC : KC) + (((size_t)b * 2 + g) * 256) * 128 + F.wave * 16 + fr;
#pragma unroll
              for (int j = 0; j < 4; ++j) { const int n = n0 + fq * 4 + j; outp[(size_t)n * 128] = n < 255 ? (bf16)f2bf(o4[j]) : (bf16)0; } }
            __syncthreads();
        }
#if FLASH_WIN
        __syncthreads();
        for (int Lx = blockIdx.x; Lx < 512; Lx += F.G) {
            const int qb = 15 - Lx / 32, bh = Lx % 32, b = bh >> 3, h = bh & 7, g = h >> 2; const bf16* zb = Z0 + (size_t)b * S * Z0W;
            fa::Item it{}; it.Q = zb + Z_NQ + h * 128; it.qs = Z0W; it.K = zb + Z_NKV + 4 * 256 + g * 128; it.ks = Z0W; it.V = zb + Z_NKV + 5 * 256 + g * 128; it.vs = Z0W;
            it.P0 = qb * 256; it.skv = S; it.W = 512; it.bias = BIAS + (size_t)h * BIAS_LD + 64; it.bstep = 1; it.O = OWIN + (size_t)b * S * 1024 + h * 128; it.os = 1024;
            fa::attn_block<0>(it, lds);
        }
#else
        __syncthreads();
        for (int it = F.gw; it < M * 8; it += F.NGW) {
            const int h = it & 7, m = it >> 3, b = m / S, s = m % S, g = h >> 2;
            const bf16* qr = Z0 + (size_t)m * Z0W + Z_NQ + h * 128; wsm[2 * F.lane] = bf2f(qr[2 * F.lane]); wsm[2 * F.lane + 1] = bf2f(qr[2 * F.lane + 1]); LDS_WAIT(); asm volatile("" ::: "memory");
            const int t0 = s - 511 < 0 ? 0 : s - 511; NA a;
            a.k = Z0 + (size_t)b * S * Z0W + Z_NKV + 4 * 256 + g * 128; a.kstride = Z0W; a.k2 = nullptr; a.k2stride = 0; a.dq = 128; a.dq2 = 0;
            a.v = Z0 + (size_t)b * S * Z0W + Z_NKV + 5 * 256 + g * 128; a.vstride = Z0W; a.t0 = t0; a.tstep = 1; a.nk = s - t0 + 1;
            a.bias = BIAS + (size_t)h * BIAS_LD + 64; a.brel0 = s - t0; a.bstep = 1; a.scale = 0.08838834764831845f; a.cmask = 0; a.use_sel = 0;
            float mx, sum, o0, o1; na_run(a, wsm, wsc, F.lane, mx, sum, o0, o1);
            *(unsigned*)(OWIN + (size_t)m * 1024 + h * 128 + 2 * F.lane) = pk2(o0 / sum, o1 / sum);
        }
#endif
    }
    SEAM(3);
    REPK(4) if (IN(4)) {
        { pg8::Gemm g{Z0 + Z_QLAT, W_UQ, Z0W, 512, 512}; pg8::StaticOrder So; So.init(M, QMW, F.G, (int)blockIdx.x); pg8::EpiBf16 E{QM, QMW, RINV};
          pg8::gemm_phase<pg8::EpiBf16, pg8::StaticOrder, PG_ALIGN, PG_SP2>(ring, g, So, E); }
        __syncthreads();
        { pg8::Gemm g{Z0 + Z_KVLAT, W_UKV, Z0W, 512, 512}; pg8::StaticOrder So; So.init(M, KVMW, F.G, (int)blockIdx.x); pg8::EpiBf16 E{KVM, KVMW, RINV + M};
          pg8::gemm_phase<pg8::EpiBf16, pg8::StaticOrder, PG_ALIGN, PG_SP2>(ring, g, So, E); }
        __syncthreads();
#if FLASH_CMP != 1
        for (int it = F.gw; it < M * 2; it += F.NGW) {
            const int g = it & 1, m = it >> 1, b = m / S, s = m % S;
            const int nk = s >= 31 ? (s - 31) / 16 + 1 : 0;
            float* imp = wsm + 256;
            for (int i = F.lane; i < 256; i += 64) imp[i] = 0.f;
            for (int r = 0; r < 4; ++r) { const int h = g * 4 + r;
                const bf16* qr = Z0 + (size_t)m * Z0W + Z_NQ + h * 128; wsm[2 * F.lane] = bf2f(qr[2 * F.lane]); wsm[2 * F.lane + 1] = bf2f(qr[2 * F.lane + 1]); LDS_WAIT(); asm volatile("" ::: "memory");
                float o0 = 0.f, o1 = 0.f;
                if (nk > 0) { NA a; a.k = KC + ((size_t)b * 2 + g) * 256 * 128; a.kstride = 128; a.k2 = nullptr; a.k2stride = 0; a.dq = 128; a.dq2 = 0; a.v = VC + ((size_t)b * 2 + g) * 256 * 128; a.vstride = 128;
                    a.t0 = 0; a.tstep = 1; a.nk = nk; a.bias = BIAS + (size_t)h * BIAS_LD + 64; a.brel0 = s - 31; a.bstep = 16; a.scale = 0.08838834764831845f; a.cmask = 0; a.use_sel = 0;
                    float mx, sum; na_run(a, wsm, wsc, F.lane, mx, sum, o0, o1); const float inv = 1.0f / sum; o0 *= inv; o1 *= inv;
                    for (int i = F.lane; i < nk; i += 64) imp[i] += wsc[i] * inv; LDS_WAIT(); asm volatile("" ::: "memory"); }
                *(unsigned*)(OCMP + (size_t)m * 1024 + h * 128 + 2 * F.lane) = pk2(o0, o1);
            }
            const int j = F.lane, blk_t = s >> 6;
            float sc;
            { const float pm1 = (4 * j - 1 >= 0) ? imp[4 * j - 1] : 0.f, p0 = imp[4 * j], p1 = imp[4 * j + 1], p2 = imp[4 * j + 2], p3 = (4 * j + 3 < 255) ? imp[4 * j + 3] : 0.f;
              const float is = ((((((p0 + pm1) + p1) + p0) + p2) + p1) + p3) + p2;
              const bool forced = (j == 0) || (j == blk_t) || (j == blk_t - 1), valid = j <= blk_t;
              sc = forced ? 1e9f : (valid ? is : -1.0f); }
            int rank = 0;
            for (int k = 0; k < 64; ++k) { const float vk = __shfl(sc, k); rank += (vk > sc || (vk == sc && k < j)) ? 1 : 0; }
            const unsigned long long msk = __ballot(rank < 16 && sc > -0.5f);
            if (F.lane == 0) SEL[(size_t)m * 2 + g] = msk;
            asm volatile("" ::: "memory");
        }
        __syncthreads();
#endif
#if FLASH_CMP
        for (int Lx = blockIdx.x; Lx < 512; Lx += F.G) { const int tb = 63 - Lx / 8, bg = Lx % 8, b = bg >> 1, g = bg & 1;
            fa::CmpItem it; it.Q = Z0 + ((size_t)b * S + tb * 64) * Z0W + Z_NQ + g * 512; it.qs = Z0W; it.K = KC + ((size_t)b * 2 + g) * 256 * 128; it.V = VC + ((size_t)b * 2 + g) * 256 * 128;
            it.bias = BIAS + (size_t)(g * 4) * BIAS_LD + 64; it.bld = BIAS_LD; it.s0 = tb * 64; it.O = OCMP + ((size_t)b * S + tb * 64) * 1024 + g * 512; it.os = 1024; it.sel = SEL + ((size_t)b * S + tb * 64) * 2 + g;

            fa::cmp_block(it, lds, SMALL_OFF); }
#endif
    }
    SEAM(4);
    REPK(5) if (IN(5)) {
#if FLASH_SLC != 1
        for (int it = F.gw; it < M * 8; it += F.NGW) {
            const int h = it & 7, m = it >> 3, b = m / S, s = m % S, g = h >> 2;
            const bf16* zr = Z0 + (size_t)m * Z0W; const bf16* qr = zr + Z_NQ + h * 128; wsm[2 * F.lane] = bf2f(qr[2 * F.lane]); wsm[2 * F.lane + 1] = bf2f(qr[2 * F.lane + 1]); LDS_WAIT(); asm volatile("" ::: "memory");
            NA a; a.k = Z0 + (size_t)b * S * Z0W + Z_NKV + 2 * 256 + g * 128; a.kstride = Z0W; a.k2 = nullptr; a.k2stride = 0; a.dq = 128; a.dq2 = 0;
            a.v = Z0 + (size_t)b * S * Z0W + Z_NKV + 3 * 256 + g * 128; a.vstride = Z0W; a.t0 = 0; a.tstep = 1; a.nk = s + 1;
            a.bias = BIAS + (size_t)h * BIAS_LD + 64; a.brel0 = s; a.bstep = 1; a.scale = 0.08838834764831845f; a.cmask = SEL[(size_t)m * 2 + g]; a.use_sel = FA_DBG_NOSEL ? 0 : 1;
            float mx, sum, o0, o1; na_run(a, wsm, wsc, F.lane, mx, sum, o0, o1); o0 /= sum; o1 /= sum;
            const float g0 = sigmoid_f(bf2f(zr[Z_NG + h * 3 + 0])), g1 = sigmoid_f(bf2f(zr[Z_NG + h * 3 + 1])), g2 = sigmoid_f(bf2f(zr[Z_NG + h * 3 + 2]));
            const unsigned wc_ = *(const unsigned*)(OCMP + (size_t)m * 1024 + h * 128 + 2 * F.lane), ww_ = *(const unsigned*)(OWIN + (size_t)m * 1024 + h * 128 + 2 * F.lane);
            *(unsigned*)(CAT + (size_t)m * 2048 + h * 128 + 2 * F.lane) = FA_DBG_NOMERGE ? pk2(o0, o1) : pk2(g0 * bflo(wc_) + g1 * o0 + g2 * bflo(ww_), g0 * bfhi(wc_) + g1 * o1 + g2 * bfhi(ww_));
        }
        __syncthreads();
#endif
#if FLASH_SLC == 2
        __syncthreads();
#endif
#if FLASH_SLC
        for (int Lx = blockIdx.x; Lx < 256; Lx += F.G) {
            const int x = Lx / 32, bh = Lx % 32, b = bh >> 3, h = bh & 7, g = h >> 2; const bf16* zb = Z0 + (size_t)b * S * Z0W;
            for (int pass = 0; pass < 2; ++pass) { const int qb = pass ? 15 - x : x;
                fa::Item it{}; it.Q = zb + Z_NQ + h * 128; it.qs = Z0W; it.K = zb + Z_NKV + 2 * 256 + g * 128; it.ks = Z0W; it.V = zb + Z_NKV + 3 * 256 + g * 128; it.vs = Z0W;
                it.P0 = qb * 256; it.skv = S; it.W = 1 << 20; it.bias = BIAS + (size_t)h * BIAS_LD + 64; it.bstep = 1; it.sel = SEL + (size_t)b * S * 2 + g; it.sels = 2;
                it.O = CAT + (size_t)b * S * 2048 + h * 128; it.os = 2048;
#if FLASH_SLC == 2
                it.O = (bf16*)(ws + WS_R + 296 * MiB) + (size_t)b * S * 1024 + h * 128; it.os = 1024;
#endif
                it.M0 = OCMP + (size_t)b * S * 1024 + h * 128; it.M1 = OWIN + (size_t)b * S * 1024 + h * 128; it.ms = 1024; it.G = zb + Z_NG + h * 3; it.gs = Z0W;
                fa::attn_block<1>(it, lds); }
        }
#endif
#if FLASH_MLA
        for (int Lx = blockIdx.x; Lx < 256; Lx += F.G) {
            const int x = Lx / 32, bh = Lx % 32, b = bh >> 3, h = bh & 7;
            for (int pass = 0; pass < 2; ++pass) { const int qb = pass ? 15 - x : x;
                fa::Item it{}; it.Q = QM + (size_t)b * S * QMW + h * 192; it.qs = QMW; it.rope = ROPE + (size_t)b * S * 64; it.ropes = 64;
                it.K = KVM + (size_t)b * S * KVMW + h * 256; it.ks = KVMW; it.K2 = KPE + (size_t)b * S * 64; it.k2s = 64; it.V = KVM + (size_t)b * S * KVMW + h * 256 + 128; it.vs = KVMW;
                it.P0 = qb * 256; it.skv = S; it.W = 1 << 20; it.O = CAT + (size_t)b * S * 2048 + 1024 + h * 128; it.os = 2048;
                fa::attn_block<2>(it, lds); }
        }
#else
        for (int it = F.gw; it < M * 8; it += F.NGW) {
            const int h = it & 7, m = it >> 3, b = m / S, s = m % S;
            const bf16* qr = QM + (size_t)m * QMW + h * 192;
            wsm[2 * F.lane] = bf2f(qr[2 * F.lane]); wsm[2 * F.lane + 1] = bf2f(qr[2 * F.lane + 1]);
            if (F.lane < 32) { const float x1 = bf2f(qr[128 + F.lane]), x2 = bf2f(qr[160 + F.lane]); const float cs = ROPE[(size_t)m * 64 + F.lane], sn = ROPE[(size_t)m * 64 + 32 + F.lane];
                wsm[128 + F.lane] = x1 * cs - x2 * sn; wsm[160 + F.lane] = x2 * cs + x1 * sn; }
            LDS_WAIT(); asm volatile("" ::: "memory");
            NA a; a.k = KVM + (size_t)b * S * KVMW + h * 256; a.kstride = KVMW; a.k2 = KPE + (size_t)b * S * 64; a.k2stride = 64; a.dq = 128; a.dq2 = 64;
            a.v = KVM + (size_t)b * S * KVMW + h * 256 + 128; a.vstride = KVMW; a.t0 = 0; a.tstep = 1; a.nk = s + 1; a.bias = nullptr; a.brel0 = 0; a.bstep = 0; a.scale = 0.07216878364870322f; a.cmask = 0; a.use_sel = 0;
            float mx, sum, o0, o1; na_run(a, wsm, wsc, F.lane, mx, sum, o0, o1);
            *(unsigned*)(CAT + (size_t)m * 2048 + 1024 + h * 128 + 2 * F.lane) = pk2(o0 / sum, o1 / sum);
        }
#endif
    }
    SEAM(5);
    REPK(6) if (IN(6)) { pg8::Gemm g{CAT, W_OUT0, 2048, 2048, 2048}; pg8::StaticOrder So; So.init(M, D, F.G, (int)blockIdx.x); pg8::EpiResid E{x_in, X, D, MOD + 2 * D, 6 * D, S / 256};
        pg8::gemm_phase<pg8::EpiResid, pg8::StaticOrder, PG_ALIGN, PG_SP2>(ring, g, So, E); }
    SEAM(6);
    REPK(7) if (IN(7)) modnorm_phase(F, X, ffn_norm_g, MOD, 3, H);
    SEAM(7);
    REPK(8) if (IN(8)) { pg8::Gemm g{H, W_GU0, D, D, D}; pg8::StaticOrder So; So.init(M, 2 * FF, F.G, (int)blockIdx.x); pg8::EpiSwiGLU E{ACT, FF};
        pg8::gemm_phase<pg8::EpiSwiGLU, pg8::StaticOrder, PG_ALIGN, PG_SP2>(ring, g, So, E); }
    SEAM(8);
    REPK(9) if (IN(9)) { pg8::Gemm g{ACT, W_DN0, FF, FF, FF}; pg8::StaticOrder So; So.init(M, D, F.G, (int)blockIdx.x); pg8::EpiResid E{X, X, D, MOD + 5 * D, 6 * D, S / 256};
        pg8::gemm_phase<pg8::EpiResid, pg8::StaticOrder, PG_ALIGN, PG_SP2>(ring, g, So, E); }
    SEAM(9);
    REPK(10) if (IN(10)) modnorm_phase(F, X, mix_norm_g + D, MOD + 4 * 12288, 0, H);
    SEAM(10);
    REPK(11) if (IN(11)) { pg8::Gemm g{H, W_IN1, D, D, D}; pg8::StaticOrder So; So.init(M, Z1W, F.G, (int)blockIdx.x); pg8::EpiBf16 E{Z1, Z1W, nullptr};
        pg8::gemm_phase<pg8::EpiBf16, pg8::StaticOrder, PG_ALIGN, PG_SP2>(ring, g, So, E); }
    SEAM(11);
#if FLASH_DIL
    REPK(12) if (IN(12)) {
        for (int Lx = blockIdx.x; Lx < 1536; Lx += F.G) {
            const int p = Lx % 3, r_ = Lx / 3, bh = r_ % 32, sub = r_ / 32, b = bh >> 3, h = bh & 7;
            const int dil = p == 0 ? 1 : (p == 1 ? 4 : 16), res = p == 0 ? 0 : (p == 1 ? (sub & 3) : sub), qb = p == 0 ? sub : (p == 1 ? (sub >> 2) : 0);
            fa::Item it{}; it.Q = Z1 + ((size_t)b * S + res) * Z1W + p * 3072 + h * 128; it.qs = (long)dil * Z1W; it.K = it.Q + 1024; it.ks = it.qs; it.V = it.Q + 2048; it.vs = it.qs;
            it.P0 = qb * 256; it.skv = S / dil; it.W = 129; it.bias = BIAS + (size_t)h * BIAS_LD + 64; it.bstep = dil;
            it.O = OP + (size_t)p * M * 1024 + ((size_t)b * S + res) * 1024 + h * 128; it.os = (long)dil * 1024; it.LSE = LSEB + (size_t)p * M * 8 + ((size_t)b * S + res) * 8 + h; it.lses = (long)dil * 8;
            fa::attn_block<0>(it, lds);
        }
    }
#else
    REPK(12) if (IN(12)) {
        for (int it = F.gw; it < M * 8; it += F.NGW) {
            const int h = it & 7, m = it >> 3, b = m / S, s = m % S;
            float om0 = 0.f, om1 = 0.f, lm = -3.0e38f, wsum = 0.f;
#pragma unroll
            for (int p = 0; p < 3; ++p) { const int dil = p == 0 ? 1 : (p == 1 ? 4 : 16);
                const bf16* qr = Z1 + (size_t)m * Z1W + p * 3072 + h * 128; wsm[2 * F.lane] = bf2f(qr[2 * F.lane]); wsm[2 * F.lane + 1] = bf2f(qr[2 * F.lane + 1]); LDS_WAIT(); asm volatile("" ::: "memory");
                const int mq = s / dil, r = s % dil, m0 = mq - 128 < 0 ? 0 : mq - 128;
                NA a; a.k = Z1 + (size_t)b * S * Z1W + p * 3072 + 1024 + h * 128; a.kstride = Z1W; a.k2 = nullptr; a.k2stride = 0; a.dq = 128; a.dq2 = 0;
                a.v = Z1 + (size_t)b * S * Z1W + p * 3072 + 2048 + h * 128; a.vstride = Z1W; a.t0 = m0 * dil + r; a.tstep = dil; a.nk = mq - m0 + 1;
                a.bias = BIAS + (size_t)h * BIAS_LD + 64; a.brel0 = (mq - m0) * dil; a.bstep = dil; a.scale = 0.08838834764831845f; a.cmask = 0; a.use_sel = 0;
                float mx, sum, o0, o1; na_run(a, wsm, wsc, F.lane, mx, sum, o0, o1);
                const float lse = mx + __logf(sum); o0 /= sum; o1 /= sum;
                const float nm = fmaxf(lm, lse), ea = __expf(lm - nm), eb = __expf(lse - nm);
                om0 = om0 * ea + o0 * eb; om1 = om1 * ea + o1 * eb; wsum = wsum * ea + eb; lm = nm; }
            *(unsigned*)(OM + (size_t)m * 1024 + h * 128 + 2 * F.lane) = pk2(om0 / wsum, om1 / wsum);
        }
    }
#endif
    SEAM(12);
    REPK(13) if (IN(13) && FLASH_DIL) {
        for (int m = F.gw; m < M; m += F.NGW) {
#pragma unroll 2
            for (int h = 0; h < 8; ++h) { const float l0 = LSEB[(size_t)m * 8 + h], l1 = LSEB[(size_t)(M + m) * 8 + h], l2 = LSEB[(size_t)(2 * M + m) * 8 + h];
                const float mx = fmaxf(l0, fmaxf(l1, l2)), e0 = __expf(l0 - mx), e1 = __expf(l1 - mx), e2 = __expf(l2 - mx), inv = 1.0f / (e0 + e1 + e2);
                const unsigned a0 = *(const unsigned*)(OP + (size_t)m * 1024 + h * 128 + 2 * F.lane), a1 = *(const unsigned*)(OP + (size_t)(M + m) * 1024 + h * 128 + 2 * F.lane), a2 = *(const unsigned*)(OP + (size_t)(2 * M + m) * 1024 + h * 128 + 2 * F.lane);
                *(unsigned*)(OM + (size_t)m * 1024 + h * 128 + 2 * F.lane) = pk2((e0 * bflo(a0) + e1 * bflo(a1) + e2 * bflo(a2)) * inv, (e0 * bfhi(a0) + e1 * bfhi(a1) + e2 * bfhi(a2)) * inv); }
        }
    }
    SEAM(13);
    REPK(14) if (IN(14)) { pg8::Gemm g{OM, W_OUT1, 1024, 1024, 1024}; pg8::StaticOrder So; So.init(M, D, F.G, (int)blockIdx.x); pg8::EpiResid E{X, X, D, MOD + 4 * 12288 + 2 * D, 6 * D, S / 256};
        pg8::gemm_phase<pg8::EpiResid, pg8::StaticOrder, PG_ALIGN, PG_SP2>(ring, g, So, E); }
    SEAM(14);
    REPK(15) if (IN(15)) {
        for (int m = F.gw; m < M; m += F.NGW) { const int b = m / S; const float* mb = MOD + 4 * 12288 + (size_t)b * 6 * D; f32x4 v[8];
            modnorm_row(X + (size_t)m * D, ffn_norm_g + D, mb + 4 * D, mb + 3 * D, H + (size_t)m * D, F.lane, v);
            float lg[8] = {};
#pragma unroll
            for (int j = 0; j < 8; ++j) { const float* wr_ = w_router + (size_t)(4 * F.lane + 256 * j) * 8;
#pragma unroll
                for (int q = 0; q < 4; ++q) { const f32x4 wa = *(const f32x4*)(wr_ + q * 8), wb = *(const f32x4*)(wr_ + q * 8 + 4); const float hv = v[j][q];
                    lg[0] += hv * wa.x; lg[1] += hv * wa.y; lg[2] += hv * wa.z; lg[3] += hv * wa.w; lg[4] += hv * wb.x; lg[5] += hv * wb.y; lg[6] += hv * wb.z; lg[7] += hv * wb.w; } }
#pragma unroll
            for (int e = 0; e < 8; ++e) lg[e] = wave_sum(lg[e]);
            int e1 = 0; float v1 = lg[0];
#pragma unroll
            for (int e = 1; e < 8; ++e) if (lg[e] > v1) { v1 = lg[e]; e1 = e; }
            int e2 = -1; float v2 = -3.0e38f;
#pragma unroll
            for (int e = 0; e < 8; ++e) if (e != e1 && lg[e] > v2) { v2 = lg[e]; e2 = e; }
            if (F.lane == 0) { const float g1 = 1.0f / (1.0f + __expf(v2 - v1)), g2 = 1.0f - g1;
                const unsigned r1 = atomicAdd(ctl + CW_CNT + e1, 1u), r2 = atomicAdd(ctl + CW_CNT + e2, 1u);
                int* rt = ROUTE + (size_t)m * 8; rt[0] = e1; rt[1] = e2; rt[2] = (int)r1; rt[3] = (int)r2; rt[4] = __float_as_int(g1); rt[5] = __float_as_int(g2); }
        }
    }
    SEAM(15);
    REPK(16) if (IN(16)) {
        unsigned ts[9]; ts[0] = 0;
#pragma unroll
        for (int e = 0; e < 8; ++e) ts[e + 1] = ts[e] + (__hip_atomic_load(ctl + CW_CNT + e, __ATOMIC_RELAXED, __HIP_MEMORY_SCOPE_AGENT) + 255u) / 256u;
        if (blockIdx.x == 0 && F.tid < 9) { unsigned v = ts[0];
#pragma unroll
            for (int e = 1; e < 9; ++e) v = (F.tid == e) ? ts[e] : v;
            ctl[CW_TS + F.tid] = v; }
        for (int m = F.gw; m < M; m += F.NGW) { const int* rt = ROUTE + (size_t)m * 8; const int e1 = rt[0], e2 = rt[1]; unsigned t1 = 0, t2 = 0;
#pragma unroll
            for (int e = 0; e < 8; ++e) { t1 = (e == e1) ? ts[e] : t1; t2 = (e == e2) ? ts[e] : t2; }
            const size_t d1 = (size_t)t1 * 256 + rt[2], d2 = (size_t)t2 * 256 + rt[3];
            const v4u* src = (const v4u*)(H + (size_t)m * D) + F.lane;
#if MOE_F8
            v2u* o1 = (v2u*)((unsigned char*)XB + d1 * D) + F.lane; v2u* o2 = (v2u*)((unsigned char*)XB + d2 * D) + F.lane;
#pragma unroll
            for (int j = 0; j < 4; ++j) { const v4u w = src[64 * j]; v2u q; q.x = pk4_fp8(bflo(w.x), bfhi(w.x), bflo(w.y), bfhi(w.y)); q.y = pk4_fp8(bflo(w.z), bfhi(w.z), bflo(w.w), bfhi(w.w)); o1[64 * j] = q; o2[64 * j] = q; } }
#else
            v4u* o1 = (v4u*)(XB + d1 * D) + F.lane; v4u* o2 = (v4u*)(XB + d2 * D) + F.lane;
#pragma unroll
            for (int j = 0; j < 4; ++j) { const v4u w = src[64 * j]; o1[64 * j] = w; o2[64 * j] = w; } }
#endif
    }
    SEAM(16);
#if MOE_F8
    REPK(17) if (IN(17)) { pg8::Gemm g{XB, W_MGU, D / 2, D / 2, D / 2}; pg8::GroupedOrder So; So.init(ctl + CW_TS, 2 * FFE / 128, F.G, (int)blockIdx.x); pg8::EpiSwiGLUH E{ACTB, (MOE_F8 >= 2) ? (unsigned char*)ACTB : nullptr, FFE, 1.0f / MOE_WSCALE, MOE_ASCALE};
        pg8::gemm_phase<pg8::EpiSwiGLUH, pg8::GroupedOrder, PG_ALIGN, PG_SP2, true>(ring, g, So, E); }
#else
    REPK(17) if (IN(17)) { pg8::Gemm g{XB, W_MGU, D, D, D}; pg8::GroupedOrder So; So.init(ctl + CW_TS, 2 * FFE / 256, F.G, (int)blockIdx.x); pg8::EpiSwiGLU E{ACTB, FFE};
        pg8::gemm_phase<pg8::EpiSwiGLU, pg8::GroupedOrder, PG_ALIGN, PG_SP2>(ring, g, So, E); }
#endif
    SEAM(17);
#if MOE_F8 >= 2
    REPK(18) if (IN(18)) { pg8::Gemm g{ACTB, W_MDN, FFE / 2, FFE / 2, FFE / 2}; pg8::GroupedOrder So; So.init(ctl + CW_TS, D / 128, F.G, (int)blockIdx.x); pg8::EpiBf16H E{YB, D, 1.0f / (MOE_WSCALE * MOE_ASCALE)};
        pg8::gemm_phase<pg8::EpiBf16H, pg8::GroupedOrder, PG_ALIGN, PG_SP2, true>(ring, g, So, E); }
#else
    REPK(18) if (IN(18)) { pg8::Gemm g{ACTB, W_MDN, FFE, FFE, FFE}; pg8::GroupedOrder So; So.init(ctl + CW_TS, D / 256, F.G, (int)blockIdx.x); pg8::EpiBf16 E{YB, D, nullptr};
        pg8::gemm_phase<pg8::EpiBf16, pg8::GroupedOrder, PG_ALIGN, PG_SP2>(ring, g, So, E); }
#endif
    SEAM(18);
    REPK(19) if (IN(19)) {
        unsigned ts[9]; ts[0] = 0;
#pragma unroll
        for (int e = 0; e < 8; ++e) ts[e + 1] = ctl[CW_TS + e + 1];
#pragma unroll
        for (int b = 0; b < NB; ++b) {
            const float* gf = MOD + 4 * 12288 + (size_t)b * 6 * D + 5 * D;
            const int m0 = b * S + F.gw, m1 = m0 + F.NGW;
            const int* rt0 = ROUTE + (size_t)m0 * 8; const int* rt1 = ROUTE + (size_t)m1 * 8;
            const int e10 = rt0[0], e20 = rt0[1], r10 = rt0[2], r20 = rt0[3], e11 = rt1[0], e21 = rt1[1], r11 = rt1[2], r21 = rt1[3];
            const float g10 = __int_as_float(rt0[4]), g20 = __int_as_float(rt0[5]), g11 = __int_as_float(rt1[4]), g21 = __int_as_float(rt1[5]);
            unsigned t10 = 0, t20 = 0, t11 = 0, t21 = 0;
#pragma unroll
            for (int e = 0; e < 8; ++e) { t10 = (e == e10) ? ts[e] : t10; t20 = (e == e20) ? ts[e] : t20; t11 = (e == e11) ? ts[e] : t11; t21 = (e == e21) ? ts[e] : t21; }
            const v2u* ya0 = (const v2u*)(YB + ((size_t)t10 * 256 + r10) * D) + F.lane; const v2u* yb0 = (const v2u*)(YB + ((size_t)t20 * 256 + r20) * D) + F.lane;
            const v2u* ya1 = (const v2u*)(YB + ((size_t)t11 * 256 + r11) * D) + F.lane; const v2u* yb1 = (const v2u*)(YB + ((size_t)t21 * 256 + r21) * D) + F.lane;
            const f32x4* x0 = (const f32x4*)(X + (size_t)m0 * D) + F.lane; const f32x4* x1 = (const f32x4*)(X + (size_t)m1 * D) + F.lane;
            f32x4 v0[8], v1[8]; v2u a0[8], c0[8], a1[8], c1[8];
#pragma unroll
            for (int j = 0; j < 8; ++j) { v0[j] = x0[64 * j]; v1[j] = x1[64 * j]; a0[j] = ya0[64 * j]; c0[j] = yb0[64 * j]; a1[j] = ya1[64 * j]; c1[j] = yb1[64 * j]; }
            float q0 = 0.f, q1 = 0.f;
#pragma unroll
            for (int j = 0; j < 8; ++j) { const f32x4 gg = ((const f32x4*)gf)[F.lane + 64 * j]; f32x4 y;
                y.x = g10 * bflo(a0[j].x) + g20 * bflo(c0[j].x); y.y = g10 * bfhi(a0[j].x) + g20 * bfhi(c0[j].x); y.z = g10 * bflo(a0[j].y) + g20 * bflo(c0[j].y); y.w = g10 * bfhi(a0[j].y) + g20 * bfhi(c0[j].y);
                v0[j] = v0[j] + gg * y; q0 += (v0[j].x * v0[j].x + v0[j].y * v0[j].y) + (v0[j].z * v0[j].z + v0[j].w * v0[j].w);
                y.x = g11 * bflo(a1[j].x) + g21 * bflo(c1[j].x); y.y = g11 * bfhi(a1[j].x) + g21 * bfhi(c1[j].x); y.z = g11 * bflo(a1[j].y) + g21 * bflo(c1[j].y); y.w = g11 * bfhi(a1[j].y) + g21 * bfhi(c1[j].y);
                v1[j] = v1[j] + gg * y; q1 += (v1[j].x * v1[j].x + v1[j].y * v1[j].y) + (v1[j].z * v1[j].z + v1[j].w * v1[j].w); }
            const float ri0 = 1.0f / sqrtf(wave_sum(q0) * (1.f / D) + RMS_EPS), ri1 = 1.0f / sqrtf(wave_sum(q1) * (1.f / D) + RMS_EPS);
            f32x4* o0 = (f32x4*)(args.out + (size_t)m0 * D) + F.lane; f32x4* o1 = (f32x4*)(args.out + (size_t)m1 * D) + F.lane;
#pragma unroll
            for (int j = 0; j < 8; ++j) { const f32x4 fg = ((const f32x4*)final_g)[F.lane + 64 * j]; o0[64 * j] = (v0[j] * ri0) * fg; o1[64 * j] = (v1[j] * ri1) * fg; }
        }
    }
    if ((PROBE_MASK >> 19) & 1) { __syncthreads(); const unsigned long long t1_ = wall_clock64(); while (wall_clock64() < t1_ + (t1_ - tprev_)) __builtin_amdgcn_s_sleep(8); }
#undef IN
#undef SEAM
}

constexpr int N_PHASES = 20;
extern "C" void kernel_launch(void* const* d_in, const int* in_sizes, int n_in, void* d_out, int out_size, void* d_ws, size_t ws_size, hipStream_t stream) {
    static int grid = 0;
    if (grid == 0) {
        if (n_in != 30 || in_sizes[0] != M * D || out_size != M * D || ws_size < WS_END) { fprintf(stderr, "kernel_launch: shape/workspace mismatch: n_in %d in0 %d out %d ws %zu (need %zu)\n", n_in, n_in > 0 ? in_sizes[0] : -1, out_size, ws_size, (size_t)WS_END); grid = -1; return; }
        int dev = 0, cus = 0, per_cu = 0;
        if (hipGetDevice(&dev) != hipSuccess || hipDeviceGetAttribute(&cus, hipDeviceAttributeMultiprocessorCount, dev) != hipSuccess) { grid = -1; return; }
        if (hipFuncSetAttribute((const void*)fwd, hipFuncAttributeMaxDynamicSharedMemorySize, LDS_BYTES) != hipSuccess) { fprintf(stderr, "kernel_launch: hipFuncSetAttribute failed\n"); grid = -1; return; }
        if (hipOccupancyMaxActiveBlocksPerMultiprocessor(&per_cu, (const void*)fwd, NWAVES * 64, LDS_BYTES) != hipSuccess || per_cu < 1) fprintf(stderr, "kernel_launch: occupancy query reports %d\n", per_cu);
        (void)hipGetLastError();
        grid = cus;
        if (grid != 256) { fprintf(stderr, "kernel_launch: built for a 256-CU device (got %d)\n", cus); grid = -1; return; }
    }
    if (grid < 0) return;
    if (hipMemsetAsync((char*)d_ws + WS_CTL, 0, CTL_ZERO_BYTES, stream) != hipSuccess) return;
    Args a{};
    for (int i = 0; i < 30; ++i) a.in[i] = d_in[i];
    a.out = (float*)d_out; a.ws = (unsigned char*)d_ws;
    if (MK_N_LAUNCHES == 1) { a.ph_lo = 0; a.ph_hi = N_PHASES; hipLaunchKernelGGL(fwd, dim3(grid), dim3(NWAVES * 64), LDS_BYTES, stream, a); }
    else { for (int p = 0; p < N_PHASES; ++p) { a.ph_lo = p; a.ph_hi = p + 1; hipLaunchKernelGGL(fwd, dim3(grid), dim3(NWAVES * 64), LDS_BYTES, stream, a); } }
    const hipError_t le = hipPeekAtLastError();
    if (le != hipSuccess) fprintf(stderr, "kernel_launch: launch failed: %s\n", hipGetErrorName(le));
}
```

```cpp
#include <hip/hip_runtime.h>
#include <cstdio>
#include <cstdint>

#define FLASH_WIN 1
#define FLASH_SLC 1
#define FLASH_MLA 1
#define FLASH_DIL 1
#define PROBE_MASK 0
#define FLASH_CMP 1
#define WGM_G 4
#define PG_ALIGN true
#define PG_SP2 true
#define MOE_F8 2
#ifndef MK_N_LAUNCHES
#define MK_N_LAUNCHES 1
#endif

namespace pg8 {
#define PG8_LAS __attribute__((address_space(3)))
typedef unsigned short bf16_t;
typedef short bf16x8 __attribute__((ext_vector_type(8)));
typedef float f32x4 __attribute__((ext_vector_type(4)));
typedef float f32x2 __attribute__((ext_vector_type(2)));
typedef unsigned u32x4 __attribute__((ext_vector_type(4)));
typedef unsigned u32x2 __attribute__((ext_vector_type(2)));
constexpr int BM = 256, BK = 64, HALF = 128, HTB = HALF * BK * 2  , STAGE_BYTES = 8 * HTB, NXCD = 8, WGM = 8;

__host__ __device__ __forceinline__ int lds_byte(int r, int c) { const int st = (r >> 4) * 2 + (c >> 5), rr = r & 15, cc = c & 31, ob = rr * 64 + cc * 2; return st * 1024 + (ob ^ (((ob >> 9) & 1) << 5)); }
__host__ __device__ __forceinline__ void stage_rc(int b, int& R, int& C) { const int st = b / 1024, sb = b % 1024, swz = sb ^ (((sb >> 9) & 1) << 5); R = (st >> 1) * 16 + swz / 64; C = (st & 1) * 32 + (swz % 64) / 2; }
__host__ __device__ __forceinline__ int perm32(int rho) { const int n = rho >> 4, i = rho & 15; return 8 * (i >> 2) + 4 * n + (i & 3); }

struct Unit { int pm, pn, pb; };
struct Gemm { const bf16_t* A; const bf16_t* Bt; int lda, ldb, K; };

struct StaticOrder {
    int nM, nN, nwg, G, c;
    __host__ __device__ void init(int M, int N, int G_, int c_) { nM = M / BM; nN = N / BM; nwg = nM * nN; G = G_; c = c_; }
    __host__ __device__ bool next(int i, Unit& u) const {
        const long L = (long)i * G + c; if (L >= nwg) return false;
        int wgid = (int)L; { const int q = nwg / NXCD, r = nwg % NXCD, xcd = wgid % NXCD, off = wgid / NXCD; wgid = (xcd < r ? xcd * (q + 1) : r * (q + 1) + (xcd - r) * q) + off; }
        const int nig = WGM * nN, gid = wgid / nig, fm = gid * WGM, gsz = (nM - fm) < WGM ? (nM - fm) : WGM;
        u.pm = fm + ((wgid % nig) % gsz); u.pn = (wgid % nig) / gsz; u.pb = u.pn; return true;
    }
    __device__ __forceinline__ void a_ready(const Unit&) const {}
    __device__ __forceinline__ void done(const Unit&) const {}
};
#ifndef WGM_G
#define WGM_G 8
#endif
struct GroupedOrder {
    int nN, G, c; int ts[9];
    __device__ __forceinline__ void init(const unsigned* tstart, int nN_, int G_, int c_) { nN = nN_; G = G_; c = c_;
#pragma unroll
        for (int e = 0; e < 9; ++e) ts[e] = (int)tstart[e]; }
    __device__ __forceinline__ bool next(int i, Unit& u) const {
        const long L = (long)i * G + c; if (L >= (long)ts[8] * nN) return false;
        int e = 0, us = 0, te = ts[1] - ts[0], t0 = ts[0];
#pragma unroll
        for (int k = 1; k < 8; ++k) { const int s = ts[k] * nN; if (L >= s) { e = k; us = s; te = ts[k + 1] - ts[k]; t0 = ts[k]; } }
        if (te <= 0) return false;
        int wgid = (int)L - us; { const int nwg = te * nN, q = nwg / NXCD, rr = nwg % NXCD, xcd = wgid % NXCD, off = wgid / NXCD; wgid = (xcd < rr ? xcd * (q + 1) : rr * (q + 1) + (xcd - rr) * q) + off; }
        const int nig = WGM_G * nN, gid = wgid / nig, fm = gid * WGM_G, gsz = (te - fm) < WGM_G ? (te - fm) : WGM_G;
        u.pm = t0 + fm + ((wgid % nig) % gsz); u.pn = (wgid % nig) / gsz; u.pb = e * nN + u.pn; return true;
    }
    __device__ __forceinline__ void a_ready(const Unit&) const {}
    __device__ __forceinline__ void done(const Unit&) const {}
};

typedef __bf16 bf16x2c __attribute__((ext_vector_type(2)));
__device__ __forceinline__ unsigned cvt_pk_bf16(float lo, float hi) { const f32x2 v = {lo, hi}; return __builtin_bit_cast(unsigned, __builtin_convertvector(v, bf16x2c)); }

struct EpiBf16 {
    static constexpr bool PERM = true, AFTER_DRAIN = false;
    bf16_t* O; int ldc; const float* rowscale;
    __device__ __forceinline__ void operator()(const f32x4 (&acc)[2][2][4][2], const Unit& u, int wr, int wc, int fr, int fq) const {
        const int row0 = u.pm * BM + wr * 64 + fr; const int col0 = u.pn * BM + wc * 32 + 8 * fq;
#pragma unroll
        for (int ai = 0; ai < 2; ++ai)
#pragma unroll
            for (int m = 0; m < 4; ++m) { const int row = row0 + ai * HALF + m * 16; bf16_t* rowp = O + (size_t)row * ldc + col0; const float sc = rowscale ? rowscale[row] : 1.f;
#pragma unroll
                for (int bj = 0; bj < 2; ++bj) { f32x4 v0 = acc[ai][bj][m][0] * sc, v1 = acc[ai][bj][m][1] * sc;
                    u32x4 w; w.x = cvt_pk_bf16(v0[0], v0[1]); w.y = cvt_pk_bf16(v0[2], v0[3]); w.z = cvt_pk_bf16(v1[0], v1[1]); w.w = cvt_pk_bf16(v1[2], v1[3]);
                    *(u32x4*)(rowp + bj * HALF) = w; } }
    }
};
struct EpiResid {
    static constexpr bool PERM = false, AFTER_DRAIN = false;
    const float* xin; float* xout; int ldc; const float* gate; int gstride; int tiles_per_b;
    __device__ __forceinline__ void operator()(const f32x4 (&acc)[2][2][4][2], const Unit& u, int wr, int wc, int fr, int fq) const {
        const int row0 = u.pm * BM + wr * 64 + fr, col0 = u.pn * BM + wc * 32 + 4 * fq;
        const float* gp = gate + (size_t)(u.pm / tiles_per_b) * gstride + col0;
        f32x4 gv[2][2];
#pragma unroll
        for (int bj = 0; bj < 2; ++bj)
#pragma unroll
            for (int n = 0; n < 2; ++n) gv[bj][n] = *(const f32x4*)(gp + bj * HALF + n * 16);
#pragma unroll
        for (int ai = 0; ai < 2; ++ai)
#pragma unroll
            for (int m = 0; m < 4; ++m) { const size_t off = (size_t)(row0 + ai * HALF + m * 16) * ldc + col0;
#pragma unroll
                for (int bj = 0; bj < 2; ++bj)
#pragma unroll
                    for (int n = 0; n < 2; ++n) { const f32x4 xi = *(const f32x4*)(xin + off + bj * HALF + n * 16);
                        *(f32x4*)(xout + off + bj * HALF + n * 16) = xi + gv[bj][n] * acc[ai][bj][m][n]; }
                asm volatile("" ::: "memory"); }
    }
};
__device__ __forceinline__ float silu_f(float g) { return g * __builtin_amdgcn_rcpf(1.0f + __builtin_amdgcn_exp2f(-1.4426950408889634f * g)); }
struct EpiSwiGLU {
    static constexpr bool PERM = false, AFTER_DRAIN = false;
    bf16_t* O; int ldo;
    __device__ __forceinline__ void operator()(const f32x4 (&acc)[2][2][4][2], const Unit& u, int wr, int wc, int fr, int fq) const {
        const int row0 = u.pm * BM + wr * 64 + fr, col0 = u.pn * HALF + wc * 16 + 4 * fq;
#pragma unroll
        for (int ai = 0; ai < 2; ++ai)
#pragma unroll
            for (int m = 0; m < 4; ++m) { bf16_t* rowp = O + (size_t)(row0 + ai * HALF + m * 16) * ldo + col0;
#pragma unroll
                for (int bj = 0; bj < 2; ++bj) { const f32x4 g = acc[ai][bj][m][0], up = acc[ai][bj][m][1];
                    u32x2 w; w.x = cvt_pk_bf16(silu_f(g[0]) * up[0], silu_f(g[1]) * up[1]); w.y = cvt_pk_bf16(silu_f(g[2]) * up[2], silu_f(g[3]) * up[3]);
                    *(u32x2*)(rowp + bj * 64) = w; } }
    }
};
struct EpiSwiGLUH {
    static constexpr bool PERM = false, AFTER_DRAIN = false;
    bf16_t* O; unsigned char* O8; int ldo; float s, so;
    __device__ __forceinline__ void operator()(const f32x4 (&acc)[2][2][4][2], const Unit& u, int wr, int wc, int fr, int fq) const {
        const int row0 = u.pm * BM + wr * 64 + fr, col0 = u.pn * 64 + wc * 16 + 4 * fq;
#pragma unroll
        for (int ai = 0; ai < 2; ++ai)
#pragma unroll
            for (int m = 0; m < 4; ++m) { const size_t off = (size_t)(row0 + ai * HALF + m * 16) * ldo + col0;
                const f32x4 g = acc[ai][0][m][0] * s, up = acc[ai][0][m][1] * s;
                const float v0 = silu_f(g[0]) * up[0], v1 = silu_f(g[1]) * up[1], v2 = silu_f(g[2]) * up[2], v3 = silu_f(g[3]) * up[3];
                if (O8) { int w = 0; w = __builtin_amdgcn_cvt_pk_fp8_f32(__builtin_amdgcn_fmed3f(v0 * so, -440.f, 440.f), __builtin_amdgcn_fmed3f(v1 * so, -440.f, 440.f), w, false);
                    w = __builtin_amdgcn_cvt_pk_fp8_f32(__builtin_amdgcn_fmed3f(v2 * so, -440.f, 440.f), __builtin_amdgcn_fmed3f(v3 * so, -440.f, 440.f), w, true); *(int*)(O8 + off) = w; }
                else { u32x2 w; w.x = cvt_pk_bf16(v0, v1); w.y = cvt_pk_bf16(v2, v3); *(u32x2*)(O + off) = w; } }
    }
};
struct EpiBf16H {
    static constexpr bool PERM = true, AFTER_DRAIN = false;
    bf16_t* O; int ldc; float s;
    __device__ __forceinline__ void operator()(const f32x4 (&acc)[2][2][4][2], const Unit& u, int wr, int wc, int fr, int fq) const {
        const int row0 = u.pm * BM + wr * 64 + fr; const int col0 = u.pn * HALF + wc * 32 + 8 * fq;
#pragma unroll
        for (int ai = 0; ai < 2; ++ai)
#pragma unroll
            for (int m = 0; m < 4; ++m) { bf16_t* rowp = O + (size_t)(row0 + ai * HALF + m * 16) * ldc + col0;
                const f32x4 v0 = acc[ai][0][m][0] * s, v1 = acc[ai][0][m][1] * s;
                u32x4 w; w.x = cvt_pk_bf16(v0[0], v0[1]); w.y = cvt_pk_bf16(v0[2], v0[3]); w.z = cvt_pk_bf16(v1[0], v1[1]); w.w = cvt_pk_bf16(v1[2], v1[3]);
                *(u32x4*)rowp = w; }
    }
};

template <class Epi, class Sched, bool ALIGN_EPI = false, bool SP2 = false, bool F8 = false>
__device__ __forceinline__ void gemm_phase(PG8_LAS unsigned char* lds, const Gemm g, const Sched& S, const Epi& E) {
    const int tid = threadIdx.x, wid = __builtin_amdgcn_readfirstlane(tid >> 6), lane = tid & 63, wr = wid >> 2, wc = wid & 3, fr = lane & 15, fq = lane >> 4;
    const int K = g.K, nt = K / BK;
    unsigned voffA[2], voffB[2];
#pragma unroll
    for (int i = 0; i < 2; ++i) { int R, C; stage_rc(tid * 16 + i * 8192, R, C); const int Rb = Epi::PERM ? ((R & ~31) + perm32(R & 31)) : R;
        voffA[i] = (unsigned)(R * g.lda + C) * 2u; voffB[i] = (unsigned)(Rb * g.ldb + C) * 2u; }
    const size_t kstep = (size_t)(BK * 2);
    const size_t hstepA = (size_t)HALF * g.lda * 2, hstepB = (size_t)HALF * g.ldb * 2;
    const size_t tstepA = 2 * hstepA, tstepB = F8 ? hstepB : 2 * hstepB;
    const unsigned ldsw = (unsigned)wid * 1024u;
    const int aoff = lds_byte(wr * 64 + fr, fq * 8), boff = lds_byte(wc * 32 + fr, fq * 8);
#define PG8_SA(b, h) (((b) * 2 + (h)) * HTB)
#define PG8_SB(b, h) ((4 + (b) * 2 + (h)) * HTB)
#define PG8_STAGE(bufoff, gbase, voff) do { _Pragma("unroll") for (int _i = 0; _i < 2; ++_i) \
        __builtin_amdgcn_global_load_lds((const unsigned*)((const char*)(gbase) + (voff)[_i]), (PG8_LAS unsigned*)(lds + (bufoff) + ldsw + _i * 8192), 16, 0, 0); } while (0)
#define PG8_LDA(dst, b, h) do { _Pragma("unroll") for (int m = 0; m < 4; ++m) _Pragma("unroll") for (int k = 0; k < 2; ++k) dst[m][k] = *(const PG8_LAS bf16x8*)(lds + PG8_SA(b, h) + aoff + m * 2048 + k * 1024); } while (0)
#define PG8_LDB(dst, b, h) do { if constexpr (!F8 || (h) == 0) { _Pragma("unroll") for (int n = 0; n < 2; ++n) _Pragma("unroll") for (int k = 0; k < 2; ++k) dst[n][k] = *(const PG8_LAS bf16x8*)(lds + PG8_SB(b, h) + boff + n * 2048 + k * 1024); } } while (0)
#define PG8_CAT(x, y) __builtin_shufflevector(x, y, 0, 1, 2, 3, 4, 5, 6, 7, 8, 9, 10, 11, 12, 13, 14, 15)
#define PG8_MMA(ai, bj, At, Bt) do { if constexpr (!F8 || (bj) == 0) { __builtin_amdgcn_s_setprio(1); \
        if constexpr (F8) { _Pragma("unroll") for (int m = 0; m < 4; ++m) _Pragma("unroll") for (int n = 0; n < 2; ++n) \
            acc[ai][bj][m][n] = __builtin_amdgcn_mfma_scale_f32_16x16x128_f8f6f4(__builtin_bit_cast(v8i_, PG8_CAT(Bt[n][0], Bt[n][1])), __builtin_bit_cast(v8i_, PG8_CAT(At[m][0], At[m][1])), acc[ai][bj][m][n], 0, 0, 0, 0x7f7f7f7f, 0, 0x7f7f7f7f); } \
        else { _Pragma("unroll") for (int m = 0; m < 4; ++m) _Pragma("unroll") for (int n = 0; n < 2; ++n) _Pragma("unroll") for (int k = 0; k < 2; ++k) \
            acc[ai][bj][m][n] = __builtin_amdgcn_mfma_f32_16x16x32_bf16(Bt[n][k], At[m][k], acc[ai][bj][m][n], 0, 0, 0); } \
        __builtin_amdgcn_s_setprio(0); } } while (0)
#define PG8_WAIT_V(n) asm volatile("s_waitcnt vmcnt(" #n ")" ::: "memory")
#define PG8_WAIT_L(n) asm volatile("s_waitcnt lgkmcnt(" #n ")" ::: "memory")
#define PG8_BAR __builtin_amdgcn_s_barrier()
#define PG8_SCHED __builtin_amdgcn_sched_barrier(0)
    Unit cur, nxt; int ui = 0;
    if (!S.next(0, cur)) return;
    f32x4 acc[2][2][4][2];
#pragma unroll
    for (int a = 0; a < 2; ++a)
#pragma unroll
        for (int b = 0; b < 2; ++b)
#pragma unroll
            for (int m = 0; m < 4; ++m)
#pragma unroll
                for (int n = 0; n < 2; ++n) acc[a][b][m][n] = (f32x4){0.f, 0.f, 0.f, 0.f};
    bf16x8 At[4][2], B0[2][2], B1[2][2];
    typedef int v8i_ __attribute__((ext_vector_type(8))); typedef short bf16x16_ __attribute__((ext_vector_type(16)));
    const char* cA = (const char*)g.A + (size_t)cur.pm * tstepA; const char* cB = (const char*)g.Bt + (size_t)cur.pb * tstepB;
    S.a_ready(cur);
    if constexpr (SP2) {
        PG8_STAGE(PG8_SB(0, 0), cB, voffB); if constexpr (!F8) PG8_STAGE(PG8_SB(0, 1), cB + hstepB, voffB); PG8_STAGE(PG8_SA(0, 0), cA, voffA); PG8_STAGE(PG8_SA(0, 1), cA + hstepA, voffA);
        if (wr == 1) PG8_BAR;
        PG8_WAIT_V(2); PG8_BAR;
        PG8_STAGE(PG8_SB(1, 0), cB + kstep, voffB); PG8_STAGE(PG8_SA(1, 0), cA + kstep, voffA); if constexpr (!F8) PG8_STAGE(PG8_SB(1, 1), cB + hstepB + kstep, voffB);
        if constexpr (F8) PG8_WAIT_V(4); else PG8_WAIT_V(6); PG8_BAR;
    } else {
        PG8_STAGE(PG8_SB(0, 0), cB, voffB); PG8_STAGE(PG8_SA(0, 0), cA, voffA); PG8_STAGE(PG8_SB(0, 1), cB + hstepB, voffB); PG8_STAGE(PG8_SA(0, 1), cA + hstepA, voffA);
        if (wr == 1) PG8_BAR;
        PG8_WAIT_V(4); PG8_BAR;
        PG8_STAGE(PG8_SB(1, 0), cB + kstep, voffB); PG8_STAGE(PG8_SA(1, 0), cA + kstep, voffA); PG8_STAGE(PG8_SB(1, 1), cB + hstepB + kstep, voffB);
        PG8_WAIT_V(6); PG8_BAR;
    }
    for (;;) {
        const bool has_next = S.next(ui + 1, nxt);
        const char* nA = has_next ? (const char*)g.A + (size_t)nxt.pm * tstepA : cA; const char* nB = has_next ? (const char*)g.Bt + (size_t)nxt.pb * tstepB : cB;
        for (int t = 0; t < nt; t += 2) {
            const bool last = (t == nt - 2);
            const char* a1 = cA + (size_t)(t + 1) * kstep;
            const char* a2 = last ? nA : cA + (size_t)(t + 2) * kstep; const char* b2 = last ? nB : cB + (size_t)(t + 2) * kstep;
            const char* a3 = a2 + kstep; const char* b3 = b2 + kstep;
            if (last && has_next) S.a_ready(nxt);
            if constexpr (SP2) {
            PG8_LDB(B0, 0, 0); PG8_LDB(B1, 0, 1); PG8_SCHED; PG8_LDA(At, 0, 0); PG8_STAGE(PG8_SA(1, 1), a1 + hstepA, voffA);
            if constexpr (F8) PG8_WAIT_V(6); else PG8_WAIT_V(8); PG8_WAIT_L(0); PG8_BAR; PG8_MMA(0, 0, At, B0); PG8_MMA(0, 1, At, B1); PG8_BAR; PG8_SCHED;
            PG8_LDA(At, 0, 1); PG8_STAGE(PG8_SB(0, 0), b2, voffB); if constexpr (!F8) PG8_STAGE(PG8_SB(0, 1), b2 + hstepB, voffB); PG8_STAGE(PG8_SA(0, 0), a2, voffA);
            if constexpr (F8) PG8_WAIT_V(6); else PG8_WAIT_V(8); PG8_WAIT_L(0); PG8_BAR; PG8_MMA(1, 0, At, B0); PG8_MMA(1, 1, At, B1); PG8_BAR; PG8_SCHED;
            PG8_LDB(B0, 1, 0); PG8_LDB(B1, 1, 1); PG8_SCHED; PG8_LDA(At, 1, 0); PG8_STAGE(PG8_SA(0, 1), a2 + hstepA, voffA);
            if constexpr (F8) PG8_WAIT_V(6); else PG8_WAIT_V(8); PG8_WAIT_L(0); PG8_BAR; PG8_MMA(0, 0, At, B0); PG8_MMA(0, 1, At, B1); PG8_BAR; PG8_SCHED;
            PG8_LDA(At, 1, 1); PG8_STAGE(PG8_SB(1, 0), b3, voffB); if constexpr (!F8) PG8_STAGE(PG8_SB(1, 1), b3 + hstepB, voffB); PG8_STAGE(PG8_SA(1, 0), a3, voffA);
            if constexpr (F8) PG8_WAIT_V(6); else PG8_WAIT_V(8); PG8_WAIT_L(0); PG8_BAR; PG8_MMA(1, 0, At, B0); PG8_MMA(1, 1, At, B1); PG8_BAR; PG8_SCHED;
            } else {
            PG8_LDB(B0, 0, 0); PG8_SCHED; PG8_LDA(At, 0, 0); PG8_STAGE(PG8_SA(1, 1), a1 + hstepA, voffA);
            PG8_WAIT_L(8); PG8_BAR; PG8_WAIT_L(0); PG8_MMA(0, 0, At, B0); PG8_BAR; PG8_SCHED;
            PG8_LDB(B1, 0, 1); PG8_STAGE(PG8_SB(0, 0), b2, voffB);
            PG8_BAR; PG8_WAIT_L(0); PG8_MMA(0, 1, At, B1); PG8_BAR;
            PG8_LDA(At, 0, 1); PG8_STAGE(PG8_SA(0, 0), a2, voffA);
            PG8_BAR; PG8_WAIT_L(0); PG8_MMA(1, 0, At, B0); PG8_BAR; PG8_SCHED;
            PG8_STAGE(PG8_SB(0, 1), b2 + hstepB, voffB);
            PG8_WAIT_V(6); PG8_BAR; PG8_MMA(1, 1, At, B1); PG8_BAR;
            PG8_LDB(B0, 1, 0); PG8_SCHED; PG8_LDA(At, 1, 0); PG8_STAGE(PG8_SA(0, 1), a2 + hstepA, voffA);
            PG8_WAIT_L(8); PG8_BAR; PG8_WAIT_L(0); PG8_MMA(0, 0, At, B0); PG8_BAR; PG8_SCHED;
            PG8_LDB(B1, 1, 1); PG8_STAGE(PG8_SB(1, 0), b3, voffB);
            PG8_BAR; PG8_WAIT_L(0); PG8_MMA(0, 1, At, B1); PG8_BAR;
            PG8_LDA(At, 1, 1); PG8_STAGE(PG8_SA(1, 0), a3, voffA);
            PG8_BAR; PG8_WAIT_L(0); PG8_MMA(1, 0, At, B0); PG8_BAR; PG8_SCHED;
            PG8_STAGE(PG8_SB(1, 1), b3 + hstepB, voffB);
            PG8_WAIT_V(6); PG8_BAR; PG8_MMA(1, 1, At, B1); PG8_BAR;
            }
        }
        if constexpr (ALIGN_EPI) { if (wr == 0) PG8_BAR; }
        if constexpr (!Epi::AFTER_DRAIN) { E(acc, cur, wr, wc, fr, fq); S.done(cur); }
        if (!has_next) break;
#pragma unroll
        for (int a = 0; a < 2; ++a)
#pragma unroll
            for (int b = 0; b < 2; ++b)
#pragma unroll
                for (int m = 0; m < 4; ++m)
#pragma unroll
                    for (int n = 0; n < 2; ++n) acc[a][b][m][n] = (f32x4){0.f, 0.f, 0.f, 0.f};
        cur = nxt; cA = nA; cB = nB; ++ui;
        if constexpr (ALIGN_EPI) { if (wr == 1) PG8_BAR; }
    }
    PG8_WAIT_V(0);
    if constexpr (!ALIGN_EPI) { if (wr == 0) PG8_BAR; }
    PG8_BAR;
    if constexpr (Epi::AFTER_DRAIN) { E.fused(acc, cur, wr, wc, fr, fq, lds, wid, lane); S.done(cur); }
#undef PG8_SA
#undef PG8_SB
#undef PG8_STAGE
#undef PG8_CAT
#undef PG8_LDA
#undef PG8_LDB
#undef PG8_MMA
#undef PG8_WAIT_V
#undef PG8_WAIT_L
#undef PG8_BAR
#undef PG8_SCHED
}

}

#ifndef FA_DBG_NOSEL
#define FA_DBG_NOSEL 0
#endif
#ifndef FA_DBG_NOMERGE
#define FA_DBG_NOMERGE 0
#endif
#ifndef FA_SEL_SKIP
#define FA_SEL_SKIP 0
#endif
namespace fa {
#define FA_LAS __attribute__((address_space(3)))
typedef unsigned short bf16;
typedef short bf16x8 __attribute__((ext_vector_type(8)));
typedef short s16x4 __attribute__((ext_vector_type(4)));
typedef float f32x16 __attribute__((ext_vector_type(16)));
typedef float f32x4 __attribute__((ext_vector_type(4)));
typedef unsigned u32x4 __attribute__((ext_vector_type(4)));
constexpr int QB = 256, QBLK = 32, KVBLK = 64;
constexpr int SHM_K = 16384, SHM_V = 16384, SHM_K2 = 8192;
constexpr int OFF_V = 0, OFF_K = 2 * SHM_V, OFF_K2 = OFF_K + 2 * SHM_K, OFF_WS = OFF_K2 + 2 * SHM_K2, WS_PER_WAVE = 1024, OFF_TAB = OFF_WS + 8 * WS_PER_WAVE;
constexpr int TAB_PAD = 320, TAB_MAX = 4096 + TAB_PAD;
constexpr int LDS_END = OFF_TAB + TAB_MAX * 4;
constexpr int OSTG = 272;
static_assert(LDS_END <= 131072 && 8 * 32 * OSTG <= OFF_WS, "attention LDS map");
#define KSWZ(row, colB) ((row) * 256 + ((colB) ^ (((row) & 7) << 4)))
#define K2SWZ(row, colB) ((row) * 128 + ((colB) ^ (((row) & 7) << 4)))
#define SBAR() __builtin_amdgcn_sched_barrier(0)
__device__ __forceinline__ int v_st(int k, int c) { const int kk = (k & ~0xC) | ((k & 4) << 1) | ((k & 8) >> 1); return ((kk >> 3) * 4 + (c >> 5)) * 512 + ((kk & 7) * 32 + (c & 31)) * 2; }
__device__ __forceinline__ int v_rd_base(int lane) { return ((lane & 3) << 3) | (((lane >> 2) & 3) << 6) | (((lane >> 4) & 1) << 5) | (((lane >> 5) & 1) << 8); }
constexpr int v_rd_off(int d0, int ks, int half) { return d0 * 512 + ks * 4096 + half * 2048; }
__device__ __forceinline__ int crow(int r, int hi) { return (r & 3) + 8 * (r >> 2) + 4 * hi; }
typedef float f32x2c __attribute__((ext_vector_type(2)));
typedef __bf16 bf16x2c __attribute__((ext_vector_type(2)));
__device__ __forceinline__ unsigned cvtpk(float lo, float hi) { const f32x2c v = {lo, hi}; return __builtin_bit_cast(unsigned, __builtin_convertvector(v, bf16x2c)); }

struct Item {
    const bf16* Q; long qs;
    const float* rope; long ropes;
    const bf16* K; long ks; const bf16* K2; long k2s; const bf16* V; long vs;
    int P0, skv, W;
    const float* bias; int bstep;
    const unsigned long long* sel; long sels;
    bf16* O; long os;
    float* LSE; long lses;
    const bf16* M0; const bf16* M1; long ms; const bf16* G; long gs;
};

template <int VAR>
__device__ __forceinline__ void attn_block(const Item& it, unsigned char* lds_g) {
    constexpr bool HAS_BIAS = VAR != 2, HAS_SEL = VAR == 1, HAS_K2 = VAR == 2;
    constexpr float SCALE = HAS_K2 ? 0.07216878364870322f : 0.08838834764831845f, C2 = 1.4426950408889634f * SCALE, THR = 8.f;
    FA_LAS unsigned char* L = (FA_LAS unsigned char*)lds_g;
    const int tid = threadIdx.x, wid = __builtin_amdgcn_readfirstlane(tid >> 6), lane = tid & 63, r32 = lane & 31, hi = lane >> 5;
    const int W = it.W;
    const int j_lo = (it.P0 - W + 1 > 0) ? (it.P0 - W + 1) / KVBLK : 0;
    int j_hi = (it.P0 + QB - 1) / KVBLK + 1; if (j_hi > it.skv / KVBLK) j_hi = it.skv / KVBLK;
    const int NT = j_hi - j_lo;
    const int qlo = it.P0 + wid * QBLK, qm = qlo + r32 - 4 * hi;
    FA_LAS float* wsl = (FA_LAS float*)(L + OFF_WS + wid * WS_PER_WAVE); FA_LAS float* li_l = wsl; FA_LAS float* al_l = wsl + 32;
    FA_LAS float* tab = (FA_LAS float*)(L + OFF_TAB);
    const int sr = tid >> 4, sc = (tid & 15) * 8, vst0 = v_st(sr, sc), vst1 = v_st(32 + sr, sc), kws = KSWZ(sr, sc * 2);
    const int k2r = tid >> 3, k2c = (tid & 7) * 8, k2ws = K2SWZ(k2r, k2c * 2);
    const int vb0 = OFF_V + v_rd_base(lane);
    bf16x8 qr[8]; bf16x8 qr2[4];
    { const bf16* qp = it.Q + (long)(qlo + r32) * it.qs + hi * 8;
#pragma unroll
      for (int d0 = 0; d0 < 8; ++d0) qr[d0] = *(const bf16x8*)(qp + d0 * 16);
      if constexpr (HAS_K2) {
          const float* rp = it.rope + (long)(qlo + r32) * it.ropes + hi * 8;
          bf16x8 raw[4];
#pragma unroll
          for (int d0 = 0; d0 < 4; ++d0) raw[d0] = *(const bf16x8*)(qp + 128 + d0 * 16);
#pragma unroll
          for (int d0 = 0; d0 < 2; ++d0) { const f32x4 c0 = *(const f32x4*)(rp + d0 * 16), c1 = *(const f32x4*)(rp + d0 * 16 + 4), s0 = *(const f32x4*)(rp + 32 + d0 * 16), s1 = *(const f32x4*)(rp + 32 + d0 * 16 + 4);
              float o1[8], o2[8];
#pragma unroll
              for (int j = 0; j < 8; ++j) { const float x1 = __builtin_bit_cast(float, (unsigned)(unsigned short)raw[d0][j] << 16), x2 = __builtin_bit_cast(float, (unsigned)(unsigned short)raw[d0 + 2][j] << 16);
                  const float cs = j < 4 ? c0[j & 3] : c1[j & 3], sn = j < 4 ? s0[j & 3] : s1[j & 3]; o1[j] = x1 * cs - x2 * sn; o2[j] = x2 * cs + x1 * sn; }
              u32x4 w1 = {cvtpk(o1[0], o1[1]), cvtpk(o1[2], o1[3]), cvtpk(o1[4], o1[5]), cvtpk(o1[6], o1[7])}, w2 = {cvtpk(o2[0], o2[1]), cvtpk(o2[2], o2[3]), cvtpk(o2[4], o2[5]), cvtpk(o2[6], o2[7])};
              qr2[d0] = __builtin_bit_cast(bf16x8, w1); qr2[d0 + 2] = __builtin_bit_cast(bf16x8, w2); }
      }
    }
    unsigned long long selm = ~0ull;
    if constexpr (HAS_SEL) selm = __hip_atomic_load(it.sel + (long)(qlo + r32) * it.sels, __ATOMIC_RELAXED, __HIP_MEMORY_SCOPE_AGENT);
    if constexpr (HAS_BIAS) {
        int rmax = W + 320; if (rmax > 4096) rmax = 4096;
        for (int i = tid; i < rmax + TAB_PAD; i += 512) { int r = i - TAB_PAD; r = r < -64 ? -64 : r; long gi = (long)r * it.bstep; gi = gi > 4095 ? 4095 : gi; tab[i] = it.bias[gi] * (1.0f / SCALE); }
    }
    bf16x8 st_k0, st_k1, st_v0, st_v1, st_k2;
#define FA_LOAD(kb_) do { const long r0_ = (long)((kb_) + sr), r1_ = r0_ + 32; \
        st_v0 = *(const bf16x8*)(it.V + r0_ * it.vs + sc); st_v1 = *(const bf16x8*)(it.V + r1_ * it.vs + sc); \
        st_k0 = *(const bf16x8*)(it.K + r0_ * it.ks + sc); st_k1 = *(const bf16x8*)(it.K + r1_ * it.ks + sc); \
        if constexpr (HAS_K2) st_k2 = *(const bf16x8*)(it.K2 + (long)((kb_) + k2r) * it.k2s + k2c); } while (0)
#define FA_WRITE(bf_) do { *(FA_LAS bf16x8*)(L + OFF_V + (bf_) * SHM_V + vst0) = st_v0; *(FA_LAS bf16x8*)(L + OFF_V + (bf_) * SHM_V + vst1) = st_v1; \
        *(FA_LAS bf16x8*)(L + OFF_K + (bf_) * SHM_K + kws) = st_k0; *(FA_LAS bf16x8*)(L + OFF_K + (bf_) * SHM_K + kws + 32 * 256) = st_k1; \
        if constexpr (HAS_K2) *(FA_LAS bf16x8*)(L + OFF_K2 + (bf_) * SHM_K2 + k2ws) = st_k2; } while (0)
    FA_LOAD(j_lo * KVBLK);
    asm volatile("s_waitcnt vmcnt(0)" ::: "memory");
    FA_WRITE(0);
    __syncthreads();
    float m_reg = -1e30f, l_reg = 0.f; f32x16 o[4] = {};
#define FA_KBASE(t) ((j_lo + (t)) * KVBLK)
#define FA_STEP(BUF, t) do { \
        const int kb_ = FA_KBASE(t); \
        if ((t) + 1 < NT) FA_LOAD(FA_KBASE((t) + 1)); \
        bool act_ = (kb_ <= qlo + QBLK - 1) && (kb_ + KVBLK - 1 >= qlo - W + 1); \
        bool allow_ = true; \
        if constexpr (HAS_SEL) { allow_ = FA_DBG_NOSEL ? true : (bool)((selm >> (kb_ >> 6)) & 1ull); if (FA_SEL_SKIP) act_ = act_ && __any(allow_); } \
        if (act_) { \
            f32x16 p0 = {}, p1 = {}; \
            { const int ka_ = OFF_K + (BUF) * SHM_K; \
              _Pragma("unroll") for (int d0 = 0; d0 < 8; ++d0) { \
                const bf16x8 b0 = *(const FA_LAS bf16x8*)(L + ka_ + KSWZ(r32, (d0 * 16 + hi * 8) * 2)); \
                const bf16x8 b1 = *(const FA_LAS bf16x8*)(L + ka_ + 32 * 256 + KSWZ(r32, (d0 * 16 + hi * 8) * 2)); \
                p0 = __builtin_amdgcn_mfma_f32_32x32x16_bf16(b0, qr[d0], p0, 0, 0, 0); p1 = __builtin_amdgcn_mfma_f32_32x32x16_bf16(b1, qr[d0], p1, 0, 0, 0); } \
              if constexpr (HAS_K2) { const int k2a_ = OFF_K2 + (BUF) * SHM_K2; \
                _Pragma("unroll") for (int d0 = 0; d0 < 4; ++d0) { \
                  const bf16x8 b0 = *(const FA_LAS bf16x8*)(L + k2a_ + K2SWZ(r32, (d0 * 16 + hi * 8) * 2)); \
                  const bf16x8 b1 = *(const FA_LAS bf16x8*)(L + k2a_ + 32 * 128 + K2SWZ(r32, (d0 * 16 + hi * 8) * 2)); \
                  p0 = __builtin_amdgcn_mfma_f32_32x32x16_bf16(b0, qr2[d0], p0, 0, 0, 0); p1 = __builtin_amdgcn_mfma_f32_32x32x16_bf16(b1, qr2[d0], p1, 0, 0, 0); } } } \
            const int dq_ = qm - kb_; \
            if constexpr (HAS_BIAS) { const FA_LAS float* tb_ = tab + (TAB_PAD + dq_ - 63); \
                _Pragma("unroll") for (int r = 0; r < 16; ++r) { const int c_ = (r & 3) + 8 * (r >> 2); p0[r] += tb_[63 - c_]; p1[r] += tb_[31 - c_]; } } \
            if (HAS_SEL || kb_ + KVBLK - 1 > qlo || kb_ <= qlo + QBLK - 1 - W) { const float NEG_ = -__builtin_inff(); const int dqm_ = allow_ ? dq_ : -0x40000000; \
                _Pragma("unroll") for (int r = 0; r < 16; ++r) { const int c_ = (r & 3) + 8 * (r >> 2); \
                    if ((unsigned)(dqm_ - c_) >= (unsigned)W) p0[r] = NEG_; if ((unsigned)(dqm_ - c_ - 32) >= (unsigned)W) p1[r] = NEG_; } } \
              \
            float pmax_ = p0[0]; _Pragma("unroll") for (int r = 1; r < 16; ++r) pmax_ = fmaxf(pmax_, p0[r]); _Pragma("unroll") for (int r = 0; r < 16; ++r) pmax_ = fmaxf(pmax_, p1[r]); \
            { auto rr_ = __builtin_amdgcn_permlane32_swap(__float_as_uint(pmax_), __float_as_uint(pmax_), false, false); pmax_ = fmaxf(__uint_as_float(rr_[0]), __uint_as_float(rr_[1])); } \
            float mn_, alpha_; \
            if (__all((pmax_ - m_reg) * SCALE <= THR)) { mn_ = m_reg; alpha_ = 1.f; } \
            else { mn_ = fmaxf(m_reg, pmax_); alpha_ = __builtin_amdgcn_exp2f((m_reg - mn_) * C2); m_reg = mn_; } \
            const float mnL_ = -mn_ * C2; float ps_ = 0.f; \
            _Pragma("unroll") for (int r = 0; r < 16; ++r) { p0[r] = __builtin_amdgcn_exp2f(fmaf(p0[r], C2, mnL_)); p1[r] = __builtin_amdgcn_exp2f(fmaf(p1[r], C2, mnL_)); ps_ += p0[r] + p1[r]; } \
            { auto rr_ = __builtin_amdgcn_permlane32_swap(__float_as_uint(ps_), __float_as_uint(ps_), false, false); ps_ = __uint_as_float(rr_[0]) + __uint_as_float(rr_[1]); } \
            l_reg = l_reg * alpha_ + ps_; \
            bf16x8 pa0, pa1, pa2, pa3; \
            FA_PK4(p0, 0, pa0); FA_PK4(p0, 8, pa1); FA_PK4(p1, 0, pa2); FA_PK4(p1, 8, pa3); \
            if (__any(alpha_ < 1.f)) { if (hi == 0) al_l[r32] = alpha_; asm volatile("s_waitcnt lgkmcnt(0)" ::: "memory"); \
                _Pragma("unroll") for (int d_ = 0; d_ < 4; ++d_) _Pragma("unroll") for (int r = 0; r < 16; ++r) o[d_][r] *= al_l[crow(r, hi)]; } \
            FA_PV_D0(BUF, 0); FA_PV_D0(BUF, 1); FA_PV_D0(BUF, 2); FA_PV_D0(BUF, 3); \
        } \
        if ((t) + 1 < NT) { asm volatile("s_waitcnt vmcnt(0)" ::: "memory"); FA_WRITE(1 - (BUF)); } \
        __syncthreads(); } while (0)
#define FA_PK4(P, B_, OUT) do { unsigned a0 = cvtpk(P[B_+0], P[B_+1]), a1 = cvtpk(P[B_+2], P[B_+3]); unsigned b0 = cvtpk(P[B_+4], P[B_+5]), b1 = cvtpk(P[B_+6], P[B_+7]); \
        auto r0 = __builtin_amdgcn_permlane32_swap(a0, b0, false, false); auto r1 = __builtin_amdgcn_permlane32_swap(a1, b1, false, false); \
        u32x4 w = {r0[0], r1[0], r0[1], r1[1]}; OUT = __builtin_bit_cast(bf16x8, w); } while (0)
#define FA_TRRD(dst, off) asm volatile("ds_read_b64_tr_b16 %0, %1 offset:%2" : "=&v"(dst) : "v"(vb0), "i"(off) : "memory")
#define FA_PV_D0(VB, d0) do { s16x4 l0, l1, l2, l3, h0, h1, h2, h3; constexpr int b_ = (VB) * SHM_V + v_rd_off(d0, 0, 0); \
        FA_TRRD(l0, b_); FA_TRRD(h0, b_ + 2048); FA_TRRD(l1, b_ + 4096); FA_TRRD(h1, b_ + 6144); FA_TRRD(l2, b_ + 8192); FA_TRRD(h2, b_ + 10240); FA_TRRD(l3, b_ + 12288); FA_TRRD(h3, b_ + 14336); \
        asm volatile("s_waitcnt lgkmcnt(0)" ::: "memory"); SBAR(); \
        o[d0] = __builtin_amdgcn_mfma_f32_32x32x16_bf16(pa0, (bf16x8){l0[0], l0[1], l0[2], l0[3], h0[0], h0[1], h0[2], h0[3]}, o[d0], 0, 0, 0); \
        o[d0] = __builtin_amdgcn_mfma_f32_32x32x16_bf16(pa1, (bf16x8){l1[0], l1[1], l1[2], l1[3], h1[0], h1[1], h1[2], h1[3]}, o[d0], 0, 0, 0); \
        o[d0] = __builtin_amdgcn_mfma_f32_32x32x16_bf16(pa2, (bf16x8){l2[0], l2[1], l2[2], l2[3], h2[0], h2[1], h2[2], h2[3]}, o[d0], 0, 0, 0); \
        o[d0] = __builtin_amdgcn_mfma_f32_32x32x16_bf16(pa3, (bf16x8){l3[0], l3[1], l3[2], l3[3], h3[0], h3[1], h3[2], h3[3]}, o[d0], 0, 0, 0); } while (0)
    for (int t = 0; t < NT; t += 2) { FA_STEP(0, t); if (t + 1 < NT) FA_STEP(1, t + 1); }
    li_l[r32] = l_reg;
    if constexpr (VAR == 1) { const bf16* gp = it.G + (long)(qlo + r32) * it.gs;
#pragma unroll
        for (int k = 0; k < 3; ++k) { const float gl = __builtin_bit_cast(float, (unsigned)gp[k] << 16); wsl[64 + 32 * k + r32] = 1.0f / (1.0f + __expf(-gl)); } }
    asm volatile("s_waitcnt lgkmcnt(0)" ::: "memory");
    if (it.LSE && hi == 0) it.LSE[(long)(qlo + r32) * it.lses] = m_reg * SCALE + __logf(l_reg);
    FA_LAS unsigned char* stg = L + wid * (32 * OSTG);
#pragma unroll
    for (int r = 0; r < 16; ++r) { const int orow = crow(r, hi); const float lv_ = li_l[orow]; float rl = lv_ > 0.f ? __builtin_amdgcn_rcpf(lv_) : 0.f; if constexpr (VAR == 1 && !FA_DBG_NOMERGE) rl *= wsl[64 + 32 + orow];
#pragma unroll
        for (int d0 = 0; d0 < 4; ++d0) { const float v = o[d0][r] * rl; const unsigned u = __builtin_bit_cast(unsigned, v); *(FA_LAS unsigned short*)(stg + orow * OSTG + (d0 * 32 + r32) * 2) = (unsigned short)((u + 0x7fffu + ((u >> 16) & 1u)) >> 16); } }
    asm volatile("s_waitcnt lgkmcnt(0)" ::: "memory");
#pragma unroll
    for (int i = 0; i < 8; ++i) { const int id = lane + 64 * i, row = id >> 4, ch = id & 15; const long qi = (long)(qlo + row);
        u32x4 w = *(const FA_LAS u32x4*)(stg + row * OSTG + ch * 16);
        if constexpr (VAR == 1 && !FA_DBG_NOMERGE) { const float g0 = wsl[64 + row], g2 = wsl[64 + 64 + row];
            const u32x4 a = *(const u32x4*)(it.M0 + qi * it.ms + ch * 8), c = *(const u32x4*)(it.M1 + qi * it.ms + ch * 8);
#pragma unroll
            for (int k = 0; k < 4; ++k) { const float lo = __builtin_bit_cast(float, w[k] << 16) + g0 * __builtin_bit_cast(float, a[k] << 16) + g2 * __builtin_bit_cast(float, c[k] << 16);
                const float hi_ = __builtin_bit_cast(float, w[k] & 0xffff0000u) + g0 * __builtin_bit_cast(float, a[k] & 0xffff0000u) + g2 * __builtin_bit_cast(float, c[k] & 0xffff0000u); w[k] = cvtpk(lo, hi_); } }
        *(u32x4*)(it.O + qi * it.os + ch * 8) = w; }
    __syncthreads();
#undef FA_LOAD
#undef FA_WRITE
#undef FA_KBASE
#undef FA_STEP
#undef FA_PK4
#undef FA_TRRD
#undef FA_PV_D0
}

struct CmpItem { const bf16* Q; long qs; const bf16* K; const bf16* V; const float* bias; int bld; int s0; bf16* O; long os; unsigned long long* sel; };
__device__ __forceinline__ void cmp_block(const CmpItem& it, unsigned char* lds_g, int imps_off) {
    constexpr float SCALE = 0.08838834764831845f, C2 = 1.4426950408889634f * SCALE;
    constexpr int OFF_TABC = 65536;
    FA_LAS unsigned char* L = (FA_LAS unsigned char*)lds_g;
    const int tid = threadIdx.x, wid = __builtin_amdgcn_readfirstlane(tid >> 6), lane = tid & 63, r32 = lane & 31, hi = lane >> 5;
    FA_LAS float* tabc = (FA_LAS float*)(L + OFF_TABC); FA_LAS float* imps = (FA_LAS float*)(L + imps_off);
    const int tokl = wid * 8 + (r32 >> 2), rh = r32 & 3, s = it.s0 + tokl;
    const int nvis = (it.s0 + 63 - 31) / 16 + 1 > 255 ? 255 : (it.s0 + 63 - 31) / 16 + 1;
    const int NT = (nvis + 63) / 64;
    const int nlim = (s - 31) >> 4;
    const int sr = tid >> 4, sc = (tid & 15) * 8, vst0 = v_st(sr, sc), vst1 = v_st(32 + sr, sc), kws = KSWZ(sr, sc * 2);
    const int vb0 = OFF_V + v_rd_base(lane);
    bf16x8 qr[8];
    { const bf16* qp = it.Q + (long)tokl * it.qs + rh * 128 + hi * 8;
#pragma unroll
      for (int d0 = 0; d0 < 8; ++d0) qr[d0] = *(const bf16x8*)(qp + d0 * 16); }
    for (int i = tid; i < 4 * 4096; i += 512) tabc[i] = it.bias[(long)(i >> 12) * it.bld + (i & 4095)] * (1.0f / SCALE);
    for (int i = tid; i < 64 * 64; i += 512) imps[i] = 0.f;
    bf16x8 st_k0, st_k1, st_v0, st_v1;
#define CM_LOADK(kb_) do { st_k0 = *(const bf16x8*)(it.K + (long)((kb_) + sr) * 128 + sc); st_k1 = *(const bf16x8*)(it.K + (long)((kb_) + 32 + sr) * 128 + sc); } while (0)
#define CM_LOADV(kb_) do { st_v0 = *(const bf16x8*)(it.V + (long)((kb_) + sr) * 128 + sc); st_v1 = *(const bf16x8*)(it.V + (long)((kb_) + 32 + sr) * 128 + sc); } while (0)
#define CM_WRITEK(bf_) do { *(FA_LAS bf16x8*)(L + OFF_K + (bf_) * SHM_K + kws) = st_k0; *(FA_LAS bf16x8*)(L + OFF_K + (bf_) * SHM_K + kws + 32 * 256) = st_k1; } while (0)
#define CM_WRITEV(bf_) do { *(FA_LAS bf16x8*)(L + OFF_V + (bf_) * SHM_V + vst0) = st_v0; *(FA_LAS bf16x8*)(L + OFF_V + (bf_) * SHM_V + vst1) = st_v1; } while (0)
#define CM_SCORES(BUF, kb_) \
        f32x16 p0 = {}, p1 = {}; \
        { const int ka_ = OFF_K + (BUF) * SHM_K; \
          _Pragma("unroll") for (int d0 = 0; d0 < 8; ++d0) { \
            const bf16x8 b0 = *(const FA_LAS bf16x8*)(L + ka_ + KSWZ(r32, (d0 * 16 + hi * 8) * 2)); \
            const bf16x8 b1 = *(const FA_LAS bf16x8*)(L + ka_ + 32 * 256 + KSWZ(r32, (d0 * 16 + hi * 8) * 2)); \
            p0 = __builtin_amdgcn_mfma_f32_32x32x16_bf16(b0, qr[d0], p0, 0, 0, 0); p1 = __builtin_amdgcn_mfma_f32_32x32x16_bf16(b1, qr[d0], p1, 0, 0, 0); } } \
        { const int nb_ = (kb_) + 4 * hi, relb_ = s - 31 - 16 * nb_; const float NEG_ = -__builtin_inff(); \
          _Pragma("unroll") for (int r = 0; r < 16; ++r) { const int c_ = (r & 3) + 8 * (r >> 2); \
            { const int rel_ = relb_ - 16 * c_; const int ix_ = rel_ < 0 ? 0 : rel_; const float bv_ = tabc[rh * 4096 + ix_]; p0[r] = (nb_ + c_ <= nlim) ? p0[r] + bv_ : NEG_; } \
            { const int rel_ = relb_ - 16 * (c_ + 32); const int ix_ = rel_ < 0 ? 0 : rel_; const float bv_ = tabc[rh * 4096 + ix_]; p1[r] = (nb_ + c_ + 32 <= nlim) ? p1[r] + bv_ : NEG_; } } }
    CM_LOADK(0); asm volatile("s_waitcnt vmcnt(0)" ::: "memory"); CM_WRITEK(0); __syncthreads();
    float m_reg = -1e30f, l_reg = 0.f;
#define CM_P1(BUF, t) do { if ((t) + 1 < NT) CM_LOADK(((t) + 1) * 64); \
        { CM_SCORES(BUF, (t) * 64) \
          float pmax_ = p0[0]; _Pragma("unroll") for (int r = 1; r < 16; ++r) pmax_ = fmaxf(pmax_, p0[r]); _Pragma("unroll") for (int r = 0; r < 16; ++r) pmax_ = fmaxf(pmax_, p1[r]); \
          { auto rr_ = __builtin_amdgcn_permlane32_swap(__float_as_uint(pmax_), __float_as_uint(pmax_), false, false); pmax_ = fmaxf(__uint_as_float(rr_[0]), __uint_as_float(rr_[1])); } \
          const float mn_ = fmaxf(m_reg, pmax_), alpha_ = __builtin_amdgcn_exp2f((m_reg - mn_) * C2), mnL_ = -mn_ * C2; float ps_ = 0.f; \
          _Pragma("unroll") for (int r = 0; r < 16; ++r) ps_ += __builtin_amdgcn_exp2f(fmaf(p0[r], C2, mnL_)) + __builtin_amdgcn_exp2f(fmaf(p1[r], C2, mnL_)); \
          { auto rr_ = __builtin_amdgcn_permlane32_swap(__float_as_uint(ps_), __float_as_uint(ps_), false, false); ps_ = __uint_as_float(rr_[0]) + __uint_as_float(rr_[1]); } \
          l_reg = l_reg * alpha_ + ps_; m_reg = mn_; } \
        if ((t) + 1 < NT) { asm volatile("s_waitcnt vmcnt(0)" ::: "memory"); CM_WRITEK(1 - (BUF)); } \
        __syncthreads(); } while (0)
    for (int t = 0; t < NT; t += 2) { CM_P1(0, t); if (t + 1 < NT) CM_P1(1, t + 1); }
    const float inv_l = l_reg > 0.f ? 1.0f / l_reg : 0.f, mL = -m_reg * C2;
    CM_LOADK(0); CM_LOADV(0); asm volatile("s_waitcnt vmcnt(0)" ::: "memory"); CM_WRITEK(0); CM_WRITEV(0); __syncthreads();
    f32x16 o[4] = {};
#define FA_PK4(P, B_, OUT) do { unsigned a0 = cvtpk(P[B_+0], P[B_+1]), a1 = cvtpk(P[B_+2], P[B_+3]); unsigned b0 = cvtpk(P[B_+4], P[B_+5]), b1 = cvtpk(P[B_+6], P[B_+7]); \
        auto r0 = __builtin_amdgcn_permlane32_swap(a0, b0, false, false); auto r1 = __builtin_amdgcn_permlane32_swap(a1, b1, false, false); \
        u32x4 w = {r0[0], r1[0], r0[1], r1[1]}; OUT = __builtin_bit_cast(bf16x8, w); } while (0)
#define FA_TRRD(dst, off) asm volatile("ds_read_b64_tr_b16 %0, %1 offset:%2" : "=&v"(dst) : "v"(vb0), "i"(off) : "memory")
#define FA_PV_D0(VB, d0) do { s16x4 l0, l1, l2, l3, h0, h1, h2, h3; constexpr int b_ = (VB) * SHM_V + v_rd_off(d0, 0, 0); \
        FA_TRRD(l0, b_); FA_TRRD(h0, b_ + 2048); FA_TRRD(l1, b_ + 4096); FA_TRRD(h1, b_ + 6144); FA_TRRD(l2, b_ + 8192); FA_TRRD(h2, b_ + 10240); FA_TRRD(l3, b_ + 12288); FA_TRRD(h3, b_ + 14336); \
        asm volatile("s_waitcnt lgkmcnt(0)" ::: "memory"); SBAR(); \
        o[d0] = __builtin_amdgcn_mfma_f32_32x32x16_bf16(pa0, (bf16x8){l0[0], l0[1], l0[2], l0[3], h0[0], h0[1], h0[2], h0[3]}, o[d0], 0, 0, 0); \
        o[d0] = __builtin_amdgcn_mfma_f32_32x32x16_bf16(pa1, (bf16x8){l1[0], l1[1], l1[2], l1[3], h1[0], h1[1], h1[2], h1[3]}, o[d0], 0, 0, 0); \
        o[d0] = __builtin_amdgcn_mfma_f32_32x32x16_bf16(pa2, (bf16x8){l2[0], l2[1], l2[2], l2[3], h2[0], h2[1], h2[2], h2[3]}, o[d0], 0, 0, 0); \
        o[d0] = __builtin_amdgcn_mfma_f32_32x32x16_bf16(pa3, (bf16x8){l3[0], l3[1], l3[2], l3[3], h3[0], h3[1], h3[2], h3[3]}, o[d0], 0, 0, 0); } while (0)
#define CM_IMP(P, half_, t) do { _Pragma("unroll") for (int q4 = 0; q4 < 4; ++q4) { \
            float A_ = (2.0f * ((P[4 * q4] + P[4 * q4 + 1]) + P[4 * q4 + 2]) + P[4 * q4 + 3]) * inv_l, B_ = P[4 * q4 + 3] * inv_l; \
            A_ += __shfl_xor(A_, 1); A_ += __shfl_xor(A_, 2); B_ += __shfl_xor(B_, 1); B_ += __shfl_xor(B_, 2); \
            const int j_ = 2 * q4 + hi + 8 * (half_) + 16 * (t); \
            if (rh == 0) { __hip_atomic_fetch_add(&imps[tokl * 64 + j_], A_, __ATOMIC_RELAXED, __HIP_MEMORY_SCOPE_WORKGROUP); \
                if (j_ + 1 < 64) __hip_atomic_fetch_add(&imps[tokl * 64 + j_ + 1], B_, __ATOMIC_RELAXED, __HIP_MEMORY_SCOPE_WORKGROUP); } } } while (0)
#define CM_P2(BUF, t) do { if ((t) + 1 < NT) { CM_LOADK(((t) + 1) * 64); CM_LOADV(((t) + 1) * 64); } \
        { CM_SCORES(BUF, (t) * 64) \
          _Pragma("unroll") for (int r = 0; r < 16; ++r) { p0[r] = __builtin_amdgcn_exp2f(fmaf(p0[r], C2, mL)); p1[r] = __builtin_amdgcn_exp2f(fmaf(p1[r], C2, mL)); } \
          CM_IMP(p0, 0, t); CM_IMP(p1, 1, t); \
          bf16x8 pa0, pa1, pa2, pa3; FA_PK4(p0, 0, pa0); FA_PK4(p0, 8, pa1); FA_PK4(p1, 0, pa2); FA_PK4(p1, 8, pa3); \
          FA_PV_D0(BUF, 0); FA_PV_D0(BUF, 1); FA_PV_D0(BUF, 2); FA_PV_D0(BUF, 3); } \
        if ((t) + 1 < NT) { asm volatile("s_waitcnt vmcnt(0)" ::: "memory"); CM_WRITEK(1 - (BUF)); CM_WRITEV(1 - (BUF)); } \
        __syncthreads(); } while (0)
    for (int t = 0; t < NT; t += 2) { CM_P2(0, t); if (t + 1 < NT) CM_P2(1, t + 1); }
    asm volatile("s_waitcnt lgkmcnt(0)" ::: "memory");
    for (int tk = 0; tk < 8; ++tk) { const int sp = it.s0 + wid * 8 + tk, blk_t = sp >> 6, j = lane;
        const float is = imps[(wid * 8 + tk) * 64 + j];
        const bool forced = (j == 0) || (j == blk_t) || (j == blk_t - 1), valid = j <= blk_t;
        const float scv = forced ? 1e9f : (valid ? is : -1.0f);
        int rank = 0;
        for (int k = 0; k < 64; ++k) { const float vk = __shfl(scv, k); rank += (vk > scv || (vk == scv && k < j)) ? 1 : 0; }
        const unsigned long long msk = __ballot(rank < 16 && scv > -0.5f);
        if (lane == 0) it.sel[(long)(wid * 8 + tk) * 2] = msk; }
    FA_LAS unsigned char* stg = L + wid * (32 * OSTG);
    FA_LAS float* li_c = imps + wid * 512;
    li_c[r32] = inv_l; asm volatile("s_waitcnt lgkmcnt(0)" ::: "memory");
#pragma unroll
    for (int r = 0; r < 16; ++r) { const int orow = crow(r, hi); const float rl = li_c[orow];
#pragma unroll
        for (int d0 = 0; d0 < 4; ++d0) { const unsigned u = __builtin_bit_cast(unsigned, o[d0][r] * rl); *(FA_LAS unsigned short*)(stg + orow * OSTG + (d0 * 32 + r32) * 2) = (unsigned short)((u + 0x7fffu + ((u >> 16) & 1u)) >> 16); } }
    asm volatile("s_waitcnt lgkmcnt(0)" ::: "memory");
#pragma unroll
    for (int i = 0; i < 8; ++i) { const int id = lane + 64 * i, row = id >> 4, ch = id & 15;
        const u32x4 w = *(const FA_LAS u32x4*)(stg + row * OSTG + ch * 16);
        *(u32x4*)(it.O + (long)(wid * 8 + (row >> 2)) * it.os + (row & 3) * 128 + ch * 8) = w; }
    __syncthreads();
#undef CM_LOADK
#undef CM_LOADV
#undef CM_WRITEK
#undef CM_WRITEV
#undef CM_SCORES
#undef CM_P1
#undef CM_P2
#undef CM_IMP
#undef FA_PK4
#undef FA_TRRD
#undef FA_PV_D0
}
}

constexpr int D = 2048, NB = 4, S = 4096, M = NB * S;
constexpr int HD = 128;
constexpr int Z0W = 3840;
constexpr int Z_NQ = 0, Z_NKV = 1024, Z_QLAT = 2560, Z_KVLAT = 3072, Z_KPE = 3584, Z_NG = 3648;
constexpr int QMW = 1536, KVMW = 2048;
constexpr int FF = 5632, FFE = 7168, NE = 8;
constexpr int Z1W = 9216;
constexpr int NSLOT = (2 * M / 256 + NE) * 256;
constexpr float RMS_EPS = 1e-6f;

constexpr size_t MiB = 1u << 20;
constexpr size_t WS_CTL = 0, CTL_ZERO_BYTES = 1 * MiB;
constexpr size_t WS_MOD = 1 * MiB;
constexpr size_t WS_BIAS = 2 * MiB;
constexpr int BIAS_LD = 4096 + 64;
constexpr size_t WS_ROPE = 3 * MiB;
constexpr size_t WS_RINV = 8 * MiB;
constexpr size_t WS_SEL = 9 * MiB;
constexpr size_t WS_KC = 10 * MiB;
constexpr size_t WS_VC = 11 * MiB;
constexpr size_t WS_ROUTE = 12 * MiB;
constexpr size_t WS_LSE = 13 * MiB;
constexpr size_t WS_KPE = 15 * MiB;
constexpr size_t WS_W1T = 17 * MiB, WS_W2T = 19 * MiB, WS_CB1 = 20 * MiB;
constexpr size_t WS_WIN0 = 21 * MiB, WS_WUQ = 36 * MiB, WS_WUKV = 38 * MiB, WS_WOUT0 = 40 * MiB, WS_WGU0 = 48 * MiB, WS_WDN0 = 92 * MiB;
constexpr size_t WS_WIN1 = 114 * MiB, WS_WOUT1 = 150 * MiB, WS_WMGU = 154 * MiB, WS_WMDN = 602 * MiB;
constexpr size_t WS_X = 826 * MiB;
constexpr size_t WS_H = 954 * MiB;
constexpr size_t WS_R = 1018 * MiB;
constexpr size_t WS_Z0 = WS_R, WS_QM = WS_R + 120 * MiB, WS_KVM = WS_R + 168 * MiB, WS_OCMP = WS_R + 232 * MiB, WS_OWIN = WS_R + 264 * MiB, WS_CAT = WS_R + 328 * MiB;
constexpr size_t WS_ACT = WS_R;
constexpr size_t WS_Z1 = WS_R, WS_OP = WS_R + 288 * MiB, WS_OM = WS_R + 384 * MiB;
constexpr size_t WS_XB = WS_R, WS_ACTB = WS_R + 136 * MiB, WS_YB = WS_R;
constexpr size_t WS_END = WS_R + 612 * MiB;
static_assert(WS_Z0 + (size_t)M * Z0W * 2 <= WS_QM && WS_QM + (size_t)M * QMW * 2 <= WS_KVM && WS_KVM + (size_t)M * KVMW * 2 <= WS_OCMP && WS_CAT + (size_t)M * 2048 * 2 <= WS_END, "L0 map");
static_assert(WS_Z1 + (size_t)M * Z1W * 2 <= WS_OM && WS_XB + (size_t)NSLOT * D * 2 <= WS_ACTB && WS_ACTB + (size_t)NSLOT * FFE * 2 <= WS_END, "L1 map");
static_assert(WS_WMDN + (size_t)NE * D * FFE * 2 <= WS_X && WS_WMGU + (size_t)NE * 2 * FFE * D * 2 <= WS_WMDN, "weights map");
constexpr int CW_BAR = 4096;
constexpr int CW_CNT = 64;
constexpr int CW_TS = 128;
constexpr int CW_Q = 8192;

constexpr int RING_BYTES = 131072;
constexpr int SMALL_OFF = RING_BYTES;
constexpr int LDSCTL_OFF = RING_BYTES + 16384, MISC_OFF = LDSCTL_OFF;
constexpr int LDS_BYTES = LDSCTL_OFF + 256;
constexpr int NWAVES = 8;

#define GAS __attribute__((address_space(1)))
#define LAS __attribute__((address_space(3)))
typedef unsigned short bf16;
typedef unsigned v4u __attribute__((ext_vector_type(4)));
typedef unsigned v2u __attribute__((ext_vector_type(2)));
typedef float f32x4 __attribute__((ext_vector_type(4)));
typedef float f32x2 __attribute__((ext_vector_type(2)));
#define LDS_WAIT() asm volatile("s_waitcnt lgkmcnt(0)" ::: "memory")
__device__ __forceinline__ unsigned f2bf(float f) { unsigned u = __builtin_bit_cast(unsigned, f); return (u + 0x7fffu + ((u >> 16) & 1u)) >> 16; }
__device__ __forceinline__ unsigned pk2(float lo, float hi) { return f2bf(lo) | (f2bf(hi) << 16); }
__device__ __forceinline__ float bf2f(unsigned short b) { return __builtin_bit_cast(float, (unsigned)b << 16); }
__device__ __forceinline__ float bflo(unsigned w) { return __builtin_bit_cast(float, w << 16); }
__device__ __forceinline__ float bfhi(unsigned w) { return __builtin_bit_cast(float, w & 0xffff0000u); }
__device__ __forceinline__ float wave_sum(float v) {
#pragma unroll
    for (int o = 1; o < 64; o <<= 1) v += __shfl_xor(v, o);
    return v;
}
__device__ __forceinline__ float wave_max(float v) {
#pragma unroll
    for (int o = 1; o < 64; o <<= 1) v = fmaxf(v, __shfl_xor(v, o));
    return v;
}

#define XB_TMO      128
#define XB_XCNT(j)  (256  + 64 * (j))
#define XB_XSUB(j)  (1280 + 64 * (j))
#define XB_XGEN(j)  (2304 + 64 * (j))
#define XB_TOP      3328
#define XB_TOPGEN   3392
#define XCD_BAR_WORDS 3456
#define XB_SPIN_CAP (1u << 22)

__device__ __forceinline__ unsigned xb_ld(unsigned* p)              { return __hip_atomic_load(p, __ATOMIC_RELAXED, __HIP_MEMORY_SCOPE_AGENT); }
__device__ __forceinline__ unsigned xb_add(unsigned* p, unsigned v) { return __hip_atomic_fetch_add(p, v, __ATOMIC_RELAXED, __HIP_MEMORY_SCOPE_AGENT); }
__device__ __forceinline__ unsigned xb_xcc_id() { return (unsigned)__builtin_amdgcn_s_getreg((3 << 11) | 20) & 0xFu; }
#define XB_SPIN(cond, bar) do { unsigned _sp = 0; while (cond) { __builtin_amdgcn_s_sleep(1); \
    if ((++_sp & 255u) == 0u) { if (xb_ld(&(bar)[XB_TMO])) break; if (_sp > XB_SPIN_CAP) { atomicAdd(&(bar)[XB_TMO], 1u); break; } } } } while (0)

struct XcdBarrier {
    unsigned* bar; unsigned x;
    volatile LAS unsigned* st;
};

__device__ __forceinline__ XcdBarrier xcd_barrier_post(unsigned* bar, volatile LAS unsigned* st) {
    XcdBarrier b; b.bar = bar; b.x = xb_xcc_id(); b.st = st;
    if (threadIdx.x == 0) (void)xb_add(&bar[XB_XCNT(b.x)], 1u);
    return b;
}
__device__ __forceinline__ void xcd_barrier_complete(unsigned* bar, unsigned x, unsigned& nloc, unsigned& nx) {
    const unsigned G = gridDim.x * gridDim.y * gridDim.z;
    unsigned sum, cnt, mine, sp = 0u;
    for (;;) {
        sum = 0u; cnt = 0u; mine = 0u;
#pragma unroll
        for (unsigned j = 0; j < 16; ++j) { const unsigned c = xb_ld(&bar[XB_XCNT(j)]); sum += c; cnt += (c > 0u) ? 1u : 0u; mine = (j == x) ? c : mine; }
        if (sum == G) break;
        __builtin_amdgcn_s_sleep(1);
        if ((++sp & 255u) == 0u) { if (xb_ld(&bar[XB_TMO])) break; if (sp > XB_SPIN_CAP) { atomicAdd(&bar[XB_TMO], 1u); break; } }
    }
    nloc = mine > 0u ? mine : 1u; nx = cnt > 0u ? cnt : 1u;
}

__device__ __forceinline__ void xcd_barrier(const XcdBarrier& b) {
    asm volatile("s_waitcnt vmcnt(0)" ::: "memory");
    __syncthreads();
    if (threadIdx.x == 0) {
        unsigned* bar = b.bar;
        __builtin_amdgcn_s_waitcnt(0);
        unsigned nloc = b.st[0], nx = b.st[1];
        if (nloc == 0u) { xcd_barrier_complete(bar, b.x, nloc, nx); b.st[0] = nloc; b.st[1] = nx; }
        const unsigned old = xb_add(&bar[XB_XSUB(b.x)], 1u);
        const unsigned gen = old / nloc;
        if (old + 1u == (gen + 1u) * nloc) {
            __builtin_amdgcn_fence(__ATOMIC_RELEASE, "agent");
            asm volatile("s_waitcnt vmcnt(0)" ::: "memory");
            const unsigned og = xb_add(&bar[XB_TOP], 1u);
            const unsigned tg = og / nx;
            if (og + 1u == (tg + 1u) * nx) xb_add(&bar[XB_TOPGEN], 1u);
            else XB_SPIN(xb_ld(&bar[XB_TOPGEN]) == tg, bar);
            __builtin_amdgcn_fence(__ATOMIC_ACQUIRE, "agent");
            xb_add(&bar[XB_XGEN(b.x)], 1u);
            asm volatile("s_waitcnt vmcnt(0)" ::: "memory");
        } else {
            XB_SPIN(xb_ld(&bar[XB_XGEN(b.x)]) == gen, bar);
            __builtin_amdgcn_fence(__ATOMIC_ACQUIRE, "agent");
            asm volatile("s_waitcnt vmcnt(0)" ::: "memory");
        }
    }
    __syncthreads();
}


struct Args { const void* in[30]; float* out; unsigned char* ws; int ph_lo, ph_hi; };
struct Frame {
    unsigned char* lds;
    int tid, lane, wave, vcu, G, gw, NGW;
    unsigned char* ws;
};

__device__ __forceinline__ int t5_bucket(int n) {
    if (n < 16) return n < 0 ? 0 : n;
    int b = 16;
    b += (n >= 22); b += (n >= 30); b += (n >= 40); b += (n >= 54); b += (n >= 73); b += (n >= 99); b += (n >= 134); b += (n >= 182);
    b += (n >= 246); b += (n >= 332); b += (n >= 450); b += (n >= 609); b += (n >= 825); b += (n >= 1117); b += (n >= 1513);
    return b;
}

__device__ __forceinline__ unsigned pk4_fp8(float a, float b, float c, float d) { int w = 0; w = __builtin_amdgcn_cvt_pk_fp8_f32(a, b, w, false); w = __builtin_amdgcn_cvt_pk_fp8_f32(c, d, w, true); return (unsigned)w; }
template <int MAP, bool OUT8 = false>
__device__ __forceinline__ void p0_transpose_item(const float* W, const float* W2, int K, int Nsrc, int Ndst, bf16* WT, const float* kscale, float* scr, int item, int lane, float oscale = 1.0f) {
    const int nblk = Ndst / 64, kb = item / nblk, nb = item % nblk, k0 = 64 * kb, n0 = 64 * nb;
    const int n4 = (lane & 15) * 4, n = n0 + n4, kr = lane >> 4;
    const float* src = W; int sc = n; bool ok = true;
    if (MAP == 1) { if (n < Z_QLAT) sc = n; else if (n < Z_NG) sc = n + 24; else if (n < Z_NG + 24) sc = n - Z_NG + 2560; else ok = false; }
    if (MAP == 2) { const int g32 = n >> 5, w = n & 31; src = (w < 16) ? W : W2; sc = g32 * 16 + (w & 15); }
    f32x4 v[16];
#pragma unroll
    for (int i = 0; i < 16; ++i) v[i] = ok ? __builtin_nontemporal_load((const f32x4*)(src + (size_t)(k0 + 4 * i + kr) * Nsrc + sc)) : (f32x4){0.f, 0.f, 0.f, 0.f};
#pragma unroll
    for (int i = 0; i < 16; ++i) { const int kk = 4 * i + kr; f32x4 t = v[i]; if (kscale) t = t * kscale[k0 + kk]; float* d = scr + kk * 65 + n4; d[0] = t.x; d[1] = t.y; d[2] = t.z; d[3] = t.w; }
    LDS_WAIT(); asm volatile("" ::: "memory");
    if constexpr (OUT8) {
        const int kg = lane & 3;
#pragma unroll
        for (int p = 0; p < 4; ++p) { const int nn = 16 * p + (lane >> 2); const float* s = scr + (16 * kg) * 65 + nn;
            v4u o; o.x = pk4_fp8(s[0 * 65] * oscale, s[1 * 65] * oscale, s[2 * 65] * oscale, s[3 * 65] * oscale); o.y = pk4_fp8(s[4 * 65] * oscale, s[5 * 65] * oscale, s[6 * 65] * oscale, s[7 * 65] * oscale);
            o.z = pk4_fp8(s[8 * 65] * oscale, s[9 * 65] * oscale, s[10 * 65] * oscale, s[11 * 65] * oscale); o.w = pk4_fp8(s[12 * 65] * oscale, s[13 * 65] * oscale, s[14 * 65] * oscale, s[15 * 65] * oscale);
            *(v4u*)((unsigned char*)WT + (size_t)(n0 + nn) * K + k0 + 16 * kg) = o; }
    } else {
    const int kg = lane & 7;
#pragma unroll
    for (int p = 0; p < 8; ++p) { const int nn = 8 * p + (lane >> 3); const float* s = scr + (8 * kg) * 65 + nn;
        v4u o; o.x = pk2(s[0 * 65], s[1 * 65]); o.y = pk2(s[2 * 65], s[3 * 65]); o.z = pk2(s[4 * 65], s[5 * 65]); o.w = pk2(s[6 * 65], s[7 * 65]);
        *(v4u*)(WT + (size_t)(n0 + nn) * K + k0 + 8 * kg) = o; }
    }
    LDS_WAIT(); asm volatile("" ::: "memory");
}
template <int MAP, bool OUT8 = false>
__device__ __forceinline__ void p0_transpose(Frame& F, const float* W, const float* W2, int K, int Nsrc, int Ndst, bf16* WT, const float* kscale, float oscale = 1.0f) {
    float* scr = (float*)(F.lds + F.wave * 16640);
    const int nitems = (K / 64) * (Ndst / 64);
    for (int it = F.gw; it < nitems; it += F.NGW) p0_transpose_item<MAP, OUT8>(W, W2, K, Nsrc, Ndst, WT, kscale, scr, it, F.lane, oscale);
}

__device__ __forceinline__ void modnorm_row(const float* xrow, const float* g, const float* sc, const float* sh, bf16* orow, int lane, f32x4 (&v)[8]) {
    const f32x4* xr = (const f32x4*)xrow + lane; float s = 0.f;
#pragma unroll
    for (int j = 0; j < 8; ++j) { v[j] = xr[64 * j]; s += (v[j].x * v[j].x + v[j].y * v[j].y) + (v[j].z * v[j].z + v[j].w * v[j].w); }
    const float rinv = 1.0f / sqrtf(wave_sum(s) * (1.f / D) + RMS_EPS);
    unsigned long long* o8 = (unsigned long long*)orow + lane;
#pragma unroll
    for (int j = 0; j < 8; ++j) { const f32x4 gg = ((const f32x4*)g)[lane + 64 * j], cc = ((const f32x4*)sc)[lane + 64 * j], hh = ((const f32x4*)sh)[lane + 64 * j];
        v[j] = (v[j] * rinv) * gg * (cc + 1.0f) + hh;
        o8[64 * j] = (unsigned long long)pk2(v[j].x, v[j].y) | ((unsigned long long)pk2(v[j].z, v[j].w) << 32); }
}
__device__ __forceinline__ void modnorm_phase(Frame& F, const float* x, const float* g, const float* mod  , int sh_idx, bf16* H) {
    for (int b = 0; b < NB; ++b) { const float* mb = mod + (size_t)b * 6 * D; const float* sc = mb + (size_t)(sh_idx + 1) * D; const float* sh = mb + (size_t)sh_idx * D;
        const int s0 = F.gw, s1 = F.gw + F.NGW;
        const f32x4* x0 = (const f32x4*)(x + ((size_t)b * S + s0) * D) + F.lane; const f32x4* x1 = (const f32x4*)(x + ((size_t)b * S + s1) * D) + F.lane;
        f32x4 v0[8], v1[8], ca[8], cc[8];
#pragma unroll
        for (int j = 0; j < 8; ++j) { v0[j] = x0[64 * j]; v1[j] = x1[64 * j]; }
#pragma unroll
        for (int j = 0; j < 8; ++j) { ca[j] = ((const f32x4*)g)[F.lane + 64 * j] * (((const f32x4*)sc)[F.lane + 64 * j] + 1.0f); cc[j] = ((const f32x4*)sh)[F.lane + 64 * j]; }
        float q0 = 0.f, q1 = 0.f;
#pragma unroll
        for (int j = 0; j < 8; ++j) { q0 += (v0[j].x * v0[j].x + v0[j].y * v0[j].y) + (v0[j].z * v0[j].z + v0[j].w * v0[j].w); q1 += (v1[j].x * v1[j].x + v1[j].y * v1[j].y) + (v1[j].z * v1[j].z + v1[j].w * v1[j].w); }
        const float r0 = 1.0f / sqrtf(wave_sum(q0) * (1.f / D) + RMS_EPS), r1 = 1.0f / sqrtf(wave_sum(q1) * (1.f / D) + RMS_EPS);
        unsigned long long* o0 = (unsigned long long*)(H + ((size_t)b * S + s0) * D) + F.lane; unsigned long long* o1 = (unsigned long long*)(H + ((size_t)b * S + s1) * D) + F.lane;
#pragma unroll
        for (int j = 0; j < 8; ++j) { const f32x4 a = (v0[j] * r0) * ca[j] + cc[j], c2 = (v1[j] * r1) * ca[j] + cc[j];
            o0[64 * j] = (unsigned long long)pk2(a.x, a.y) | ((unsigned long long)pk2(a.z, a.w) << 32); o1[64 * j] = (unsigned long long)pk2(c2.x, c2.y) | ((unsigned long long)pk2(c2.z, c2.w) << 32); }
    }
}

struct NA { const bf16* k; long kstride; const bf16* k2; long k2stride; int dq, dq2; const bf16* v; long vstride; int t0, tstep, nk; const float* bias; int brel0, bstep; float scale; unsigned long long cmask; int use_sel; };
__device__ __forceinline__ void na_run(const NA& a, const float* qs, float* sc, int lane, float& mx, float& sum, float& o0, float& o1) {
    float lmax = -3.0e38f;
    for (int c = 0; c * 64 < a.nk; ++c) {
        const int kk = c * 64 + lane; float s = -__builtin_inff();
        const bool chunk_ok = !a.use_sel || ((a.cmask >> ((a.t0 + c * 64 * a.tstep) >> 6)) & 1ull);
        if (chunk_ok && kk < a.nk) {
            const long t = a.t0 + (long)kk * a.tstep; const bf16* kr = a.k + t * a.kstride; float acc = 0.f;
            for (int d = 0; d < a.dq; d += 8) { const v4u w = *(const v4u*)(kr + d); const float* q = qs + d;
                acc += bflo(w.x) * q[0] + bfhi(w.x) * q[1] + bflo(w.y) * q[2] + bfhi(w.y) * q[3] + bflo(w.z) * q[4] + bfhi(w.z) * q[5] + bflo(w.w) * q[6] + bfhi(w.w) * q[7]; }
            if (a.dq2) { const bf16* k2r = a.k2 + t * a.k2stride;
                for (int d = 0; d < a.dq2; d += 8) { const v4u w = *(const v4u*)(k2r + d); const float* q = qs + a.dq + d;
                    acc += bflo(w.x) * q[0] + bfhi(w.x) * q[1] + bflo(w.y) * q[2] + bfhi(w.y) * q[3] + bflo(w.z) * q[4] + bfhi(w.z) * q[5] + bflo(w.w) * q[6] + bfhi(w.w) * q[7]; } }
            s = acc * a.scale; if (a.bias) s += a.bias[a.brel0 - kk * a.bstep];
        }
        if (kk < a.nk) sc[kk] = s;
        lmax = fmaxf(lmax, s);
    }
    mx = wave_max(lmax);
    float ls = 0.f;
    for (int kk = lane; kk < a.nk; kk += 64) { const float p = __expf(sc[kk] - mx); sc[kk] = p; ls += p; }
    sum = wave_sum(ls);
    LDS_WAIT(); asm volatile("" ::: "memory");
    float a0 = 0.f, a1 = 0.f;
    for (int kk = 0; kk < a.nk; ++kk) { const float p = sc[kk]; if (p != 0.f) { const unsigned w = *(const unsigned*)(a.v + (long)(a.t0 + (long)kk * a.tstep) * a.vstride + 2 * lane); a0 += p * bflo(w); a1 += p * bfhi(w); } }
    o0 = a0; o1 = a1;
    asm volatile("" ::: "memory");
}
__device__ __forceinline__ float gelu_tanh(float x) { const float u = 0.7978845608028654f * (x + 0.044715f * x * x * x); return 0.5f * x * (1.0f + tanhf(u)); }
__device__ __forceinline__ float sigmoid_f(float x) { return 1.0f / (1.0f + __expf(-x)); }

__global__ void __launch_bounds__(NWAVES * 64, 2) fwd(Args args) {
    extern __shared__ __attribute__((aligned(16))) unsigned char lds[];
    Frame F;
    F.lds = lds; F.ws = args.ws;
    F.tid = threadIdx.x; F.lane = F.tid & 63; F.wave = __builtin_amdgcn_readfirstlane(F.tid >> 6);
    F.G = gridDim.x; { const int bx = blockIdx.x; F.vcu = (F.G % 8 == 0) ? (bx % 8) * (F.G / 8) + bx / 8 : bx; }
    F.gw = F.vcu * NWAVES + F.wave; F.NGW = F.G * NWAVES;
    unsigned char* ws = args.ws;
    unsigned* ctl = (unsigned*)(ws + WS_CTL);
    volatile LAS unsigned* MISC = (volatile LAS unsigned*)((LAS unsigned char*)lds + MISC_OFF);
    for (int u = F.tid; u < 64; u += NWAVES * 64) MISC[u] = 0u;
    __syncthreads();
    XcdBarrier bar; bar.bar = ctl + CW_BAR; bar.x = 0; bar.st = nullptr;
    if (MK_N_LAUNCHES == 1) bar = xcd_barrier_post(ctl + CW_BAR, MISC + 8);
    const int lo = args.ph_lo, hi = args.ph_hi;
    unsigned long long tprev_ = PROBE_MASK ? wall_clock64() : 0ull;
#define IN(k) (lo <= (k) && (k) < hi)
#ifndef PROBE_MASK
#define PROBE_MASK 0
#endif
#ifndef MOE_F8
#define MOE_F8 0
#endif
#define MOE_WSCALE 64.0f
#define MOE_ASCALE 8.0f
#ifndef PROBE_IDLE_AT
#define PROBE_IDLE_AT (-1)
#endif
#define REPK(k)
#define SEAM(k) do { if (IN(k) && IN((k) + 1)) { xcd_barrier(bar); \
        if ((PROBE_MASK >> (k)) & 1) { const unsigned long long t1_ = wall_clock64(); while (wall_clock64() < t1_ + (t1_ - tprev_)) __builtin_amdgcn_s_sleep(8); __syncthreads(); } \
        if (PROBE_IDLE_AT == (k)) { const unsigned long long t1_ = wall_clock64(); while (wall_clock64() < t1_ + 100000ull) __builtin_amdgcn_s_sleep(8); __syncthreads(); } \
        if (PROBE_MASK) tprev_ = wall_clock64(); } } while (0)

    const float* x_in = (const float*)args.in[0]; const float* c_in = (const float*)args.in[1]; const int* positions = (const int*)args.in[2];
    const float* rel_bias = (const float*)args.in[3]; const float* ada_w = (const float*)args.in[4]; const float* ada_b = (const float*)args.in[5];
    const float* mix_norm_g = (const float*)args.in[6]; const float* ffn_norm_g = (const float*)args.in[7];
    const float* ab_w_in = (const float*)args.in[8]; const float* ab_w_out = (const float*)args.in[9];
    const float* cmp_pos_k = (const float*)args.in[10]; const float* cmp_w1_k = (const float*)args.in[11]; const float* cmp_w2_k = (const float*)args.in[12];
    const float* cmp_pos_v = (const float*)args.in[13]; const float* cmp_w1_v = (const float*)args.in[14]; const float* cmp_w2_v = (const float*)args.in[15];
    const float* q_norm_g = (const float*)args.in[16]; const float* kv_norm_g = (const float*)args.in[17]; const float* w_uq = (const float*)args.in[18]; const float* w_ukv = (const float*)args.in[19];
    const float* ffn_wg = (const float*)args.in[20]; const float* ffn_wu = (const float*)args.in[21]; const float* ffn_wd = (const float*)args.in[22];
    const float* c_w_in = (const float*)args.in[23]; const float* c_w_out = (const float*)args.in[24]; const float* w_router = (const float*)args.in[25];
    const float* moe_wg = (const float*)args.in[26]; const float* moe_wu = (const float*)args.in[27]; const float* moe_wd = (const float*)args.in[28]; const float* final_g = (const float*)args.in[29];
    float* MOD = (float*)(ws + WS_MOD); float* BIAS = (float*)(ws + WS_BIAS); float* ROPE = (float*)(ws + WS_ROPE); float* RINV = (float*)(ws + WS_RINV);
    unsigned long long* SEL = (unsigned long long*)(ws + WS_SEL); bf16* KC = (bf16*)(ws + WS_KC); bf16* VC = (bf16*)(ws + WS_VC); int* ROUTE = (int*)(ws + WS_ROUTE); bf16* KPE = (bf16*)(ws + WS_KPE);
    bf16* W_IN0 = (bf16*)(ws + WS_WIN0); bf16* W_UQ = (bf16*)(ws + WS_WUQ); bf16* W_UKV = (bf16*)(ws + WS_WUKV); bf16* W_OUT0 = (bf16*)(ws + WS_WOUT0); bf16* W_GU0 = (bf16*)(ws + WS_WGU0); bf16* W_DN0 = (bf16*)(ws + WS_WDN0);
    bf16* W_IN1 = (bf16*)(ws + WS_WIN1); bf16* W_OUT1 = (bf16*)(ws + WS_WOUT1); bf16* W_MGU = (bf16*)(ws + WS_WMGU); bf16* W_MDN = (bf16*)(ws + WS_WMDN);
    float* X = (float*)(ws + WS_X); bf16* H = (bf16*)(ws + WS_H);
    bf16* Z0 = (bf16*)(ws + WS_Z0); bf16* QM = (bf16*)(ws + WS_QM); bf16* KVM = (bf16*)(ws + WS_KVM); bf16* OCMP = (bf16*)(ws + WS_OCMP); bf16* OWIN = (bf16*)(ws + WS_OWIN); bf16* CAT = (bf16*)(ws + WS_CAT);
    bf16* W1T = (bf16*)(ws + WS_W1T); bf16* W2T = (bf16*)(ws + WS_W2T); float* CB1 = (float*)(ws + WS_CB1);
    float* LSEB = (float*)(ws + WS_LSE); bf16* OP = (bf16*)(ws + WS_OP);
    bf16* ACT = (bf16*)(ws + WS_ACT); bf16* Z1 = (bf16*)(ws + WS_Z1); bf16* OM = (bf16*)(ws + WS_OM); bf16* XB = (bf16*)(ws + WS_XB); bf16* ACTB = (bf16*)(ws + WS_ACTB); bf16* YB = (bf16*)(ws + WS_YB);
    float* wsc = (float*)(lds + F.wave * 16384);
    float* wsm = (float*)(lds + SMALL_OFF + F.wave * 2048);
    PG8_LAS unsigned char* ring = (PG8_LAS unsigned char*)lds;

    REPK(0) if (IN(0)) {
        for (int job = 192 + (int)blockIdx.x; job < 194; job += F.G) {
            float* red = (float*)(lds + 32768); const int c = job - 192; const float* pos = c ? cmp_pos_v : cmp_pos_k; const float* w1 = c ? cmp_w1_v : cmp_w1_k;
            float a0 = 0.f, a1 = 0.f;
#pragma unroll 8
            for (int k = 0; k < 512; ++k) { const int kk = F.wave * 512 + k; const f32x2 wv = *(const f32x2*)(w1 + (size_t)kk * 128 + 2 * F.lane); const float pv = pos[kk]; a0 += pv * wv.x; a1 += pv * wv.y; }
            red[F.wave * 128 + 2 * F.lane] = a0; red[F.wave * 128 + 2 * F.lane + 1] = a1;
            __syncthreads();
            if (F.tid < 128) { float s = 0.f;
#pragma unroll
                for (int w = 0; w < 8; ++w) s += red[w * 128 + F.tid];
                CB1[c * 128 + F.tid] = s; }
            __syncthreads();
        }
        for (int job = blockIdx.x; job < 256; job += F.G) {
            float* cs = (float*)lds; float* red = (float*)(lds + 32768);
            for (int i = F.tid; i < 4 * D; i += 512) { const float cv = c_in[i]; cs[i] = cv / (1.0f + __expf(-cv)); }
            __syncthreads();
            const int l = job >> 7, col0 = (job & 127) * 96; const bool act = F.lane < 48;
            float acc[4][2] = {};
            const float* wp = ada_w + ((size_t)l * D + (size_t)F.wave * 256) * 12288 + col0 + 2 * (act ? F.lane : 0);
#pragma unroll 8
            for (int k = 0; k < 256; ++k) { const f32x2 wv = *(const f32x2*)(wp + (size_t)k * 12288); const int kk = F.wave * 256 + k;
#pragma unroll
                for (int b = 0; b < 4; ++b) { const float cv = cs[b * D + kk]; acc[b][0] += cv * wv.x; acc[b][1] += cv * wv.y; } }
            if (act) {
#pragma unroll
                for (int b = 0; b < 4; ++b) { red[(F.wave * 4 + b) * 96 + 2 * F.lane] = acc[b][0]; red[(F.wave * 4 + b) * 96 + 2 * F.lane + 1] = acc[b][1]; } }
            __syncthreads();
            if (F.tid < 384) { const int b = F.tid / 96, cc = F.tid % 96; float s = 0.f;
#pragma unroll
              for (int w = 0; w < 8; ++w) s += red[(w * 4 + b) * 96 + cc];
              MOD[((size_t)l * 4 + b) * 12288 + col0 + cc] = s + ada_b[(size_t)l * 12288 + col0 + cc]; }
            __syncthreads();
        }
        __syncthreads();
        p0_transpose<1>(F, ab_w_in, nullptr, D, 3672, Z0W, W_IN0, nullptr);
        p0_transpose<0>(F, w_uq, nullptr, 512, QMW, QMW, W_UQ, q_norm_g);
        p0_transpose<0>(F, w_ukv, nullptr, 512, KVMW, KVMW, W_UKV, kv_norm_g);
        p0_transpose<0>(F, ab_w_out, nullptr, D, D, D, W_OUT0, nullptr);
        p0_transpose<2>(F, ffn_wg, ffn_wu, D, FF, 2 * FF, W_GU0, nullptr);
        p0_transpose<0>(F, ffn_wd, nullptr, FF, D, D, W_DN0, nullptr);
        p0_transpose<0>(F, c_w_in, nullptr, D, Z1W, Z1W, W_IN1, nullptr);
        p0_transpose<0>(F, c_w_out, nullptr, 1024, D, D, W_OUT1, nullptr);
        p0_transpose<0>(F, cmp_w1_k, nullptr, 4096, 128, 128, W1T, nullptr); p0_transpose<0>(F, cmp_w1_v, nullptr, 4096, 128, 128, W1T + 128 * 4096, nullptr);
        p0_transpose<0>(F, cmp_w2_k, nullptr, 128, 128, 128, W2T, nullptr); p0_transpose<0>(F, cmp_w2_v, nullptr, 128, 128, 128, W2T + 128 * 128, nullptr);
        for (int e = 0; e < NE; ++e) {
#if MOE_F8
            p0_transpose<2, true>(F, moe_wg + (size_t)e * D * FFE, moe_wu + (size_t)e * D * FFE, D, FFE, 2 * FFE, (bf16*)((unsigned char*)W_MGU + (size_t)e * 2 * FFE * D), nullptr, MOE_WSCALE);
#else
            p0_transpose<2>(F, moe_wg + (size_t)e * D * FFE, moe_wu + (size_t)e * D * FFE, D, FFE, 2 * FFE, W_MGU + (size_t)e * 2 * FFE * D, nullptr);
#endif
#if MOE_F8 >= 2
            p0_transpose<0, true>(F, moe_wd + (size_t)e * FFE * D, nullptr, FFE, D, D, (bf16*)((unsigned char*)W_MDN + (size_t)e * D * FFE), nullptr, MOE_WSCALE);
#else
            p0_transpose<0>(F, moe_wd + (size_t)e * FFE * D, nullptr, FFE, D, D, W_MDN + (size_t)e * D * FFE, nullptr);
#endif
        }
        for (int i = F.gw * 64 + F.lane; i < 8 * BIAS_LD; i += F.NGW * 64) { const int h = i / BIAS_LD, r = i % BIAS_LD - 64; BIAS[i] = rel_bias[t5_bucket(r) * 8 + h]; }
        for (int i = F.gw * 64 + F.lane; i < M * 32; i += F.NGW * 64) { const int m = i >> 5, f = i & 31;
            const float inv_freq = powf(10000.0f, -(float)(2 * f) / 64.0f); const float ang = (float)positions[m] * inv_freq;
            ROPE[(size_t)m * 64 + f] = cosf(ang); ROPE[(size_t)m * 64 + 32 + f] = sinf(ang); }
    }
    SEAM(0);
    REPK(1) if (IN(1)) modnorm_phase(F, x_in, mix_norm_g, MOD, 0, H);
    SEAM(1);
    REPK(2) if (IN(2)) { pg8::Gemm g{H, W_IN0, D, D, D}; pg8::StaticOrder So; So.init(M, Z0W, F.G, (int)blockIdx.x); pg8::EpiBf16 E{Z0, Z0W, nullptr};
        pg8::gemm_phase<pg8::EpiBf16, pg8::StaticOrder, PG_ALIGN, PG_SP2>(ring, g, So, E); }
    SEAM(2);
    REPK(3) if (IN(3)) {
        for (int m = F.gw; m < M; m += F.NGW) {
            const bf16* zr = Z0 + (size_t)m * Z0W;
#pragma unroll
            for (int w = 0; w < 2; ++w) { const v4u a = *(const v4u*)(zr + (w ? Z_KVLAT : Z_QLAT) + 8 * F.lane);
                float s = bflo(a.x) * bflo(a.x) + bfhi(a.x) * bfhi(a.x) + bflo(a.y) * bflo(a.y) + bfhi(a.y) * bfhi(a.y) + bflo(a.z) * bflo(a.z) + bfhi(a.z) * bfhi(a.z) + bflo(a.w) * bflo(a.w) + bfhi(a.w) * bfhi(a.w);
                s = wave_sum(s); if (F.lane == 0) RINV[(size_t)w * M + m] = 1.0f / sqrtf(s * (1.f / 512.f) + RMS_EPS); }
            if (F.lane < 32) { const float x1 = bf2f(zr[Z_KPE + F.lane]), x2 = bf2f(zr[Z_KPE + 32 + F.lane]); const float cs = ROPE[(size_t)m * 64 + F.lane], sn = ROPE[(size_t)m * 64 + 32 + F.lane];
                KPE[(size_t)m * 64 + F.lane] = (bf16)f2bf(x1 * cs - x2 * sn); KPE[(size_t)m * 64 + 32 + F.lane] = (bf16)f2bf(x2 * cs + x1 * sn); }
        }
        __syncthreads();
        for (int job = blockIdx.x; job < 256; job += F.G) {
            typedef short bfx8 __attribute__((ext_vector_type(8)));
            const int nt = job & 15, g = (job >> 4) & 1, b = (job >> 5) & 3, c = job >> 7, n0 = nt * 16;
            const int fr = F.lane & 15, fq = F.lane >> 4; int nrow = n0 + fr; if (nrow > 254) nrow = 254;
            const bf16* arow = Z0 + ((size_t)b * S + 16 * nrow) * Z0W + Z_NKV + c * 256 + g * 128 + fq * 8;
            const bf16* w1t = W1T + (size_t)c * 128 * 4096 + (size_t)fr * 4096 + fq * 8;
            f32x4 acc[8];
#pragma unroll
            for (int i = 0; i < 8; ++i) acc[i] = (f32x4){0.f, 0.f, 0.f, 0.f};
#pragma unroll 2
            for (int ks = 0; ks < 16; ++ks) { const int kk = F.wave * 512 + ks * 32, l = kk >> 7, d0 = kk & 127;
                const bfx8 af = *(const bfx8*)(arow + (size_t)l * Z0W + d0);
#pragma unroll
                for (int i = 0; i < 8; ++i) { const bfx8 bfr = *(const bfx8*)(w1t + (size_t)i * 16 * 4096 + kk); acc[i] = __builtin_amdgcn_mfma_f32_16x16x32_bf16(af, bfr, acc[i], 0, 0, 0); } }
            float* part = (float*)lds;
#pragma unroll
            for (int i = 0; i < 8; ++i)
#pragma unroll
                for (int j = 0; j < 4; ++j) part[(F.wave * 16 + fq * 4 + j) * 128 + i * 16 + fr] = acc[i][j];
            __syncthreads();
            bf16* hid = (bf16*)(lds + 65536);
            { const int row = F.tid >> 5, c4 = (F.tid & 31) * 4; f32x4 s = *(const f32x4*)(CB1 + c * 128 + c4);
#pragma unroll
              for (int w = 0; w < 8; ++w) s += *(const f32x4*)(part + (w * 16 + row) * 128 + c4);
              *(v2u*)(hid + row * 128 + c4) = (v2u){pk2(gelu_tanh(s.x), gelu_tanh(s.y)), pk2(gelu_tanh(s.z), gelu_tanh(s.w))}; }
            __syncthreads();
            { f32x4 o4 = {0.f, 0.f, 0.f, 0.f}; const bf16* w2t = W2T + (size_t)c * 128 * 128 + (size_t)(F.wave * 16 + fr) * 128 + fq * 8;
#pragma unroll
              for (int ks = 0; ks < 4; ++ks) { const bfx8 af = *(const bfx8*)(hid + fr * 128 + ks * 32 + fq * 8); const bfx8 bfr = *(const bfx8*)(w2t + ks * 32); o4 = __builtin_amdgcn_mfma_f32_16x16x32_bf16(af, bfr, o4, 0, 0, 0); }
              bf16* outp = (c ? VC : KC) + (((size_t)b * 2 + g) * 256) * 128 + F.wave * 16 + fr;
#pragma unroll
              for (int j = 0; j < 4; ++j) { const int n = n0 + fq * 4 + j; outp[(size_t)n * 128] = n < 255 ? (bf16)f2bf(o4[j]) : (bf16)0; } }
            __syncthreads();
        }
#if FLASH_WIN
        __syncthreads();
        for (int Lx = blockIdx.x; Lx < 512; Lx += F.G) {
            const int qb = 15 - Lx / 32, bh = Lx % 32, b = bh >> 3, h = bh & 7, g = h >> 2; const bf16* zb = Z0 + (size_t)b * S * Z0W;
            fa::Item it{}; it.Q = zb + Z_NQ + h * 128; it.qs = Z0W; it.K = zb + Z_NKV + 4 * 256 + g * 128; it.ks = Z0W; it.V = zb + Z_NKV + 5 * 256 + g * 128; it.vs = Z0W;
            it.P0 = qb * 256; it.skv = S; it.W = 512; it.bias = BIAS + (size_t)h * BIAS_LD + 64; it.bstep = 1; it.O = OWIN + (size_t)b * S * 1024 + h * 128; it.os = 1024;
            fa::attn_block<0>(it, lds);
        }
#else
        __syncthreads();
        for (int it = F.gw; it < M * 8; it += F.NGW) {
            const int h = it & 7, m = it >> 3, b = m / S, s = m % S, g = h >> 2;
            const bf16* qr = Z0 + (size_t)m * Z0W + Z_NQ + h * 128; wsm[2 * F.lane] = bf2f(qr[2 * F.lane]); wsm[2 * F.lane + 1] = bf2f(qr[2 * F.lane + 1]); LDS_WAIT(); asm volatile("" ::: "memory");
            const int t0 = s - 511 < 0 ? 0 : s - 511; NA a;
            a.k = Z0 + (size_t)b * S * Z0W + Z_NKV + 4 * 256 + g * 128; a.kstride = Z0W; a.k2 = nullptr; a.k2stride = 0; a.dq = 128; a.dq2 = 0;
            a.v = Z0 + (size_t)b * S * Z0W + Z_NKV + 5 * 256 + g * 128; a.vstride = Z0W; a.t0 = t0; a.tstep = 1; a.nk = s - t0 + 1;
            a.bias = BIAS + (size_t)h * BIAS_LD + 64; a.brel0 = s - t0; a.bstep = 1; a.scale = 0.08838834764831845f; a.cmask = 0; a.use_sel = 0;
            float mx, sum, o0, o1; na_run(a, wsm, wsc, F.lane, mx, sum, o0, o1);
            *(unsigned*)(OWIN + (size_t)m * 1024 + h * 128 + 2 * F.lane) = pk2(o0 / sum, o1 / sum);
        }
#endif
    }
    SEAM(3);
    REPK(4) if (IN(4)) {
        { pg8::Gemm g{Z0 + Z_QLAT, W_UQ, Z0W, 512, 512}; pg8::StaticOrder So; So.init(M, QMW, F.G, (int)blockIdx.x); pg8::EpiBf16 E{QM, QMW, RINV};
          pg8::gemm_phase<pg8::EpiBf16, pg8::StaticOrder, PG_ALIGN, PG_SP2>(ring, g, So, E); }
        __syncthreads();
        { pg8::Gemm g{Z0 + Z_KVLAT, W_UKV, Z0W, 512, 512}; pg8::StaticOrder So; So.init(M, KVMW, F.G, (int)blockIdx.x); pg8::EpiBf16 E{KVM, KVMW, RINV + M};
          pg8::gemm_phase<pg8::EpiBf16, pg8::StaticOrder, PG_ALIGN, PG_SP2>(ring, g, So, E); }
        __syncthreads();
#if FLASH_CMP != 1
        for (int it = F.gw; it < M * 2; it += F.NGW) {
            const int g = it & 1, m = it >> 1, b = m / S, s = m % S;
            const int nk = s >= 31 ? (s - 31) / 16 + 1 : 0;
            float* imp = wsm + 256;
            for (int i = F.lane; i < 256; i += 64) imp[i] = 0.f;
            for (int r = 0; r < 4; ++r) { const int h = g * 4 + r;
                const bf16* qr = Z0 + (size_t)m * Z0W + Z_NQ + h * 128; wsm[2 * F.lane] = bf2f(qr[2 * F.lane]); wsm[2 * F.lane + 1] = bf2f(qr[2 * F.lane + 1]); LDS_WAIT(); asm volatile("" ::: "memory");
                float o0 = 0.f, o1 = 0.f;
                if (nk > 0) { NA a; a.k = KC + ((size_t)b * 2 + g) * 256 * 128; a.kstride = 128; a.k2 = nullptr; a.k2stride = 0; a.dq = 128; a.dq2 = 0; a.v = VC + ((size_t)b * 2 + g) * 256 * 128; a.vstride = 128;
                    a.t0 = 0; a.tstep = 1; a.nk = nk; a.bias = BIAS + (size_t)h * BIAS_LD + 64; a.brel0 = s - 31; a.bstep = 16; a.scale = 0.08838834764831845f; a.cmask = 0; a.use_sel = 0;
                    float mx, sum; na_run(a, wsm, wsc, F.lane, mx, sum, o0, o1); const float inv = 1.0f / sum; o0 *= inv; o1 *= inv;
                    for (int i = F.lane; i < nk; i += 64) imp[i] += wsc[i] * inv; LDS_WAIT(); asm volatile("" ::: "memory"); }
                *(unsigned*)(OCMP + (size_t)m * 1024 + h * 128 + 2 * F.lane) = pk2(o0, o1);
            }
            const int j = F.lane, blk_t = s >> 6;
            float sc;
            { const float pm1 = (4 * j - 1 >= 0) ? imp[4 * j - 1] : 0.f, p0 = imp[4 * j], p1 = imp[4 * j + 1], p2 = imp[4 * j + 2], p3 = (4 * j + 3 < 255) ? imp[4 * j + 3] : 0.f;
              const float is = ((((((p0 + pm1) + p1) + p0) + p2) + p1) + p3) + p2;
              const bool forced = (j == 0) || (j == blk_t) || (j == blk_t - 1), valid = j <= blk_t;
              sc = forced ? 1e9f : (valid ? is : -1.0f); }
            int rank = 0;
            for (int k = 0; k < 64; ++k) { const float vk = __shfl(sc, k); rank += (vk > sc || (vk == sc && k < j)) ? 1 : 0; }
            const unsigned long long msk = __ballot(rank < 16 && sc > -0.5f);
            if (F.lane == 0) SEL[(size_t)m * 2 + g] = msk;
            asm volatile("" ::: "memory");
        }
        __syncthreads();
#endif
#if FLASH_CMP
        for (int Lx = blockIdx.x; Lx < 512; Lx += F.G) { const int tb = 63 - Lx / 8, bg = Lx % 8, b = bg >> 1, g = bg & 1;
            fa::CmpItem it; it.Q = Z0 + ((size_t)b * S + tb * 64) * Z0W + Z_NQ + g * 512; it.qs = Z0W; it.K = KC + ((size_t)b * 2 + g) * 256 * 128; it.V = VC + ((size_t)b * 2 + g) * 256 * 128;
            it.bias = BIAS + (size_t)(g * 4) * BIAS_LD + 64; it.bld = BIAS_LD; it.s0 = tb * 64; it.O = OCMP + ((size_t)b * S + tb * 64) * 1024 + g * 512; it.os = 1024; it.sel = SEL + ((size_t)b * S + tb * 64) * 2 + g;

            fa::cmp_block(it, lds, SMALL_OFF); }
#endif
    }
    SEAM(4);
    REPK(5) if (IN(5)) {
#if FLASH_SLC != 1
        for (int it = F.gw; it < M * 8; it += F.NGW) {
            const int h = it & 7, m = it >> 3, b = m / S, s = m % S, g = h >> 2;
            const bf16* zr = Z0 + (size_t)m * Z0W; const bf16* qr = zr + Z_NQ + h * 128; wsm[2 * F.lane] = bf2f(qr[2 * F.lane]); wsm[2 * F.lane + 1] = bf2f(qr[2 * F.lane + 1]); LDS_WAIT(); asm volatile("" ::: "memory");
            NA a; a.k = Z0 + (size_t)b * S * Z0W + Z_NKV + 2 * 256 + g * 128; a.kstride = Z0W; a.k2 = nullptr; a.k2stride = 0; a.dq = 128; a.dq2 = 0;
            a.v = Z0 + (size_t)b * S * Z0W + Z_NKV + 3 * 256 + g * 128; a.vstride = Z0W; a.t0 = 0; a.tstep = 1; a.nk = s + 1;
            a.bias = BIAS + (size_t)h * BIAS_LD + 64; a.brel0 = s; a.bstep = 1; a.scale = 0.08838834764831845f; a.cmask = SEL[(size_t)m * 2 + g]; a.use_sel = FA_DBG_NOSEL ? 0 : 1;
            float mx, sum, o0, o1; na_run(a, wsm, wsc, F.lane, mx, sum, o0, o1); o0 /= sum; o1 /= sum;
            const float g0 = sigmoid_f(bf2f(zr[Z_NG + h * 3 + 0])), g1 = sigmoid_f(bf2f(zr[Z_NG + h * 3 + 1])), g2 = sigmoid_f(bf2f(zr[Z_NG + h * 3 + 2]));
            const unsigned wc_ = *(const unsigned*)(OCMP + (size_t)m * 1024 + h * 128 + 2 * F.lane), ww_ = *(const unsigned*)(OWIN + (size_t)m * 1024 + h * 128 + 2 * F.lane);
            *(unsigned*)(CAT + (size_t)m * 2048 + h * 128 + 2 * F.lane) = FA_DBG_NOMERGE ? pk2(o0, o1) : pk2(g0 * bflo(wc_) + g1 * o0 + g2 * bflo(ww_), g0 * bfhi(wc_) + g1 * o1 + g2 * bfhi(ww_));
        }
        __syncthreads();
#endif
#if FLASH_SLC == 2
        __syncthreads();
#endif
#if FLASH_SLC
        for (int Lx = blockIdx.x; Lx < 256; Lx += F.G) {
            const int x = Lx / 32, bh = Lx % 32, b = bh >> 3, h = bh & 7, g = h >> 2; const bf16* zb = Z0 + (size_t)b * S * Z0W;
            for (int pass = 0; pass < 2; ++pass) { const int qb = pass ? 15 - x : x;
                fa::Item it{}; it.Q = zb + Z_NQ + h * 128; it.qs = Z0W; it.K = zb + Z_NKV + 2 * 256 + g * 128; it.ks = Z0W; it.V = zb + Z_NKV + 3 * 256 + g * 128; it.vs = Z0W;
                it.P0 = qb * 256; it.skv = S; it.W = 1 << 20; it.bias = BIAS + (size_t)h * BIAS_LD + 64; it.bstep = 1; it.sel = SEL + (size_t)b * S * 2 + g; it.sels = 2;
                it.O = CAT + (size_t)b * S * 2048 + h * 128; it.os = 2048;
#if FLASH_SLC == 2
                it.O = (bf16*)(ws + WS_R + 296 * MiB) + (size_t)b * S * 1024 + h * 128; it.os = 1024;
#endif
                it.M0 = OCMP + (size_t)b * S * 1024 + h * 128; it.M1 = OWIN + (size_t)b * S * 1024 + h * 128; it.ms = 1024; it.G = zb + Z_NG + h * 3; it.gs = Z0W;
                fa::attn_block<1>(it, lds); }
        }
#endif
#if FLASH_MLA
        for (int Lx = blockIdx.x; Lx < 256; Lx += F.G) {
            const int x = Lx / 32, bh = Lx % 32, b = bh >> 3, h = bh & 7;
            for (int pass = 0; pass < 2; ++pass) { const int qb = pass ? 15 - x : x;
                fa::Item it{}; it.Q = QM + (size_t)b * S * QMW + h * 192; it.qs = QMW; it.rope = ROPE + (size_t)b * S * 64; it.ropes = 64;
                it.K = KVM + (size_t)b * S * KVMW + h * 256; it.ks = KVMW; it.K2 = KPE + (size_t)b * S * 64; it.k2s = 64; it.V = KVM + (size_t)b * S * KVMW + h * 256 + 128; it.vs = KVMW;
                it.P0 = qb * 256; it.skv = S; it.W = 1 << 20; it.O = CAT + (size_t)b * S * 2048 + 1024 + h * 128; it.os = 2048;
                fa::attn_block<2>(it, lds); }
        }
#else
        for (int it = F.gw; it < M * 8; it += F.NGW) {
            const int h = it & 7, m = it >> 3, b = m / S, s = m % S;
            const bf16* qr = QM + (size_t)m * QMW + h * 192;
            wsm[2 * F.lane] = bf2f(qr[2 * F.lane]); wsm[2 * F.lane + 1] = bf2f(qr[2 * F.lane + 1]);
            if (F.lane < 32) { const float x1 = bf2f(qr[128 + F.lane]), x2 = bf2f(qr[160 + F.lane]); const float cs = ROPE[(size_t)m * 64 + F.lane], sn = ROPE[(size_t)m * 64 + 32 + F.lane];
                wsm[128 + F.lane] = x1 * cs - x2 * sn; wsm[160 + F.lane] = x2 * cs + x1 * sn; }
            LDS_WAIT(); asm volatile("" ::: "memory");
            NA a; a.k = KVM + (size_t)b * S * KVMW + h * 256; a.kstride = KVMW; a.k2 = KPE + (size_t)b * S * 64; a.k2stride = 64; a.dq = 128; a.dq2 = 64;
            a.v = KVM + (size_t)b * S * KVMW + h * 256 + 128; a.vstride = KVMW; a.t0 = 0; a.tstep = 1; a.nk = s + 1; a.bias = nullptr; a.brel0 = 0; a.bstep = 0; a.scale = 0.07216878364870322f; a.cmask = 0; a.use_sel = 0;
            float mx, sum, o0, o1; na_run(a, wsm, wsc, F.lane, mx, sum, o0, o1);
            *(unsigned*)(CAT + (size_t)m * 2048 + 1024 + h * 128 + 2 * F.lane) = pk2(o0 / sum, o1 / sum);
        }
#endif
    }
    SEAM(5);
    REPK(6) if (IN(6)) { pg8::Gemm g{CAT, W_OUT0, 2048, 2048, 2048}; pg8::StaticOrder So; So.init(M, D, F.G, (int)blockIdx.x); pg8::EpiResid E{x_in, X, D, MOD + 2 * D, 6 * D, S / 256};
        pg8::gemm_phase<pg8::EpiResid, pg8::StaticOrder, PG_ALIGN, PG_SP2>(ring, g, So, E); }
    SEAM(6);
    REPK(7) if (IN(7)) modnorm_phase(F, X, ffn_norm_g, MOD, 3, H);
    SEAM(7);
    REPK(8) if (IN(8)) { pg8::Gemm g{H, W_GU0, D, D, D}; pg8::StaticOrder So; So.init(M, 2 * FF, F.G, (int)blockIdx.x); pg8::EpiSwiGLU E{ACT, FF};
        pg8::gemm_phase<pg8::EpiSwiGLU, pg8::StaticOrder, PG_ALIGN, PG_SP2>(ring, g, So, E); }
    SEAM(8);
    REPK(9) if (IN(9)) { pg8::Gemm g{ACT, W_DN0, FF, FF, FF}; pg8::StaticOrder So; So.init(M, D, F.G, (int)blockIdx.x); pg8::EpiResid E{X, X, D, MOD + 5 * D, 6 * D, S / 256};
        pg8::gemm_phase<pg8::EpiResid, pg8::StaticOrder, PG_ALIGN, PG_SP2>(ring, g, So, E); }
    SEAM(9);
    REPK(10) if (IN(10)) modnorm_phase(F, X, mix_norm_g + D, MOD + 4 * 12288, 0, H);
    SEAM(10);
    REPK(11) if (IN(11)) { pg8::Gemm g{H, W_IN1, D, D, D}; pg8::StaticOrder So; So.init(M, Z1W, F.G, (int)blockIdx.x); pg8::EpiBf16 E{Z1, Z1W, nullptr};
        pg8::gemm_phase<pg8::EpiBf16, pg8::StaticOrder, PG_ALIGN, PG_SP2>(ring, g, So, E); }
    SEAM(11);
#if FLASH_DIL
    REPK(12) if (IN(12)) {
        for (int Lx = blockIdx.x; Lx < 1536; Lx += F.G) {
            const int p = Lx % 3, r_ = Lx / 3, bh = r_ % 32, sub = r_ / 32, b = bh >> 3, h = bh & 7;
            const int dil = p == 0 ? 1 : (p == 1 ? 4 : 16), res = p == 0 ? 0 : (p == 1 ? (sub & 3) : sub), qb = p == 0 ? sub : (p == 1 ? (sub >> 2) : 0);
            fa::Item it{}; it.Q = Z1 + ((size_t)b * S + res) * Z1W + p * 3072 + h * 128; it.qs = (long)dil * Z1W; it.K = it.Q + 1024; it.ks = it.qs; it.V = it.Q + 2048; it.vs = it.qs;
            it.P0 = qb * 256; it.skv = S / dil; it.W = 129; it.bias = BIAS + (size_t)h * BIAS_LD + 64; it.bstep = dil;
            it.O = OP + (size_t)p * M * 1024 + ((size_t)b * S + res) * 1024 + h * 128; it.os = (long)dil * 1024; it.LSE = LSEB + (size_t)p * M * 8 + ((size_t)b * S + res) * 8 + h; it.lses = (long)dil * 8;
            fa::attn_block<0>(it, lds);
        }
    }
#else
    REPK(12) if (IN(12)) {
        for (int it = F.gw; it < M * 8; it += F.NGW) {
            const int h = it & 7, m = it >> 3, b = m / S, s = m % S;
            float om0 = 0.f, om1 = 0.f, lm = -3.0e38f, wsum = 0.f;
#pragma unroll
            for (int p = 0; p < 3; ++p) { const int dil = p == 0 ? 1 : (p == 1 ? 4 : 16);
                const bf16* qr = Z1 + (size_t)m * Z1W + p * 3072 + h * 128; wsm[2 * F.lane] = bf2f(qr[2 * F.lane]); wsm[2 * F.lane + 1] = bf2f(qr[2 * F.lane + 1]); LDS_WAIT(); asm volatile("" ::: "memory");
                const int mq = s / dil, r = s % dil, m0 = mq - 128 < 0 ? 0 : mq - 128;
                NA a; a.k = Z1 + (size_t)b * S * Z1W + p * 3072 + 1024 + h * 128; a.kstride = Z1W; a.k2 = nullptr; a.k2stride = 0; a.dq = 128; a.dq2 = 0;
                a.v = Z1 + (size_t)b * S * Z1W + p * 3072 + 2048 + h * 128; a.vstride = Z1W; a.t0 = m0 * dil + r; a.tstep = dil; a.nk = mq - m0 + 1;
                a.bias = BIAS + (size_t)h * BIAS_LD + 64; a.brel0 = (mq - m0) * dil; a.bstep = dil; a.scale = 0.08838834764831845f; a.cmask = 0; a.use_sel = 0;
                float mx, sum, o0, o1; na_run(a, wsm, wsc, F.lane, mx, sum, o0, o1);
                const float lse = mx + __logf(sum); o0 /= sum; o1 /= sum;
                const float nm = fmaxf(lm, lse), ea = __expf(lm - nm), eb = __expf(lse - nm);
                om0 = om0 * ea + o0 * eb; om1 = om1 * ea + o1 * eb; wsum = wsum * ea + eb; lm = nm; }
            *(unsigned*)(OM + (size_t)m * 1024 + h * 128 + 2 * F.lane) = pk2(om0 / wsum, om1 / wsum);
        }
    }
#endif
    SEAM(12);
    REPK(13) if (IN(13) && FLASH_DIL) {
        for (int m = F.gw; m < M; m += F.NGW) {
#pragma unroll 2
            for (int h = 0; h < 8; ++h) { const float l0 = LSEB[(size_t)m * 8 + h], l1 = LSEB[(size_t)(M + m) * 8 + h], l2 = LSEB[(size_t)(2 * M + m) * 8 + h];
                const float mx = fmaxf(l0, fmaxf(l1, l2)), e0 = __expf(l0 - mx), e1 = __expf(l1 - mx), e2 = __expf(l2 - mx), inv = 1.0f / (e0 + e1 + e2);
                const unsigned a0 = *(const unsigned*)(OP + (size_t)m * 1024 + h * 128 + 2 * F.lane), a1 = *(const unsigned*)(OP + (size_t)(M + m) * 1024 + h * 128 + 2 * F.lane), a2 = *(const unsigned*)(OP + (size_t)(2 * M + m) * 1024 + h * 128 + 2 * F.lane);
                *(unsigned*)(OM + (size_t)m * 1024 + h * 128 + 2 * F.lane) = pk2((e0 * bflo(a0) + e1 * bflo(a1) + e2 * bflo(a2)) * inv, (e0 * bfhi(a0) + e1 * bfhi(a1) + e2 * bfhi(a2)) * inv); }
        }
    }
    SEAM(13);
    REPK(14) if (IN(14)) { pg8::Gemm g{OM, W_OUT1, 1024, 1024, 1024}; pg8::StaticOrder So; So.init(M, D, F.G, (int)blockIdx.x); pg8::EpiResid E{X, X, D, MOD + 4 * 12288 + 2 * D, 6 * D, S / 256};
        pg8::gemm_phase<pg8::EpiResid, pg8::StaticOrder, PG_ALIGN, PG_SP2>(ring, g, So, E); }
    SEAM(14);
    REPK(15) if (IN(15)) {
        for (int m = F.gw; m < M; m += F.NGW) { const int b = m / S; const float* mb = MOD + 4 * 12288 + (size_t)b * 6 * D; f32x4 v[8];
            modnorm_row(X + (size_t)m * D, ffn_norm_g + D, mb + 4 * D, mb + 3 * D, H + (size_t)m * D, F.lane, v);
            float lg[8] = {};
#pragma unroll
            for (int j = 0; j < 8; ++j) { const float* wr_ = w_router + (size_t)(4 * F.lane + 256 * j) * 8;
#pragma unroll
                for (int q = 0; q < 4; ++q) { const f32x4 wa = *(const f32x4*)(wr_ + q * 8), wb = *(const f32x4*)(wr_ + q * 8 + 4); const float hv = v[j][q];
                    lg[0] += hv * wa.x; lg[1] += hv * wa.y; lg[2] += hv * wa.z; lg[3] += hv * wa.w; lg[4] += hv * wb.x; lg[5] += hv * wb.y; lg[6] += hv * wb.z; lg[7] += hv * wb.w; } }
#pragma unroll
            for (int e = 0; e < 8; ++e) lg[e] = wave_sum(lg[e]);
            int e1 = 0; float v1 = lg[0];
#pragma unroll
            for (int e = 1; e < 8; ++e) if (lg[e] > v1) { v1 = lg[e]; e1 = e; }
            int e2 = -1; float v2 = -3.0e38f;
#pragma unroll
            for (int e = 0; e < 8; ++e) if (e != e1 && lg[e] > v2) { v2 = lg[e]; e2 = e; }
            if (F.lane == 0) { const float g1 = 1.0f / (1.0f + __expf(v2 - v1)), g2 = 1.0f - g1;
                const unsigned r1 = atomicAdd(ctl + CW_CNT + e1, 1u), r2 = atomicAdd(ctl + CW_CNT + e2, 1u);
                int* rt = ROUTE + (size_t)m * 8; rt[0] = e1; rt[1] = e2; rt[2] = (int)r1; rt[3] = (int)r2; rt[4] = __float_as_int(g1); rt[5] = __float_as_int(g2); }
        }
    }
    SEAM(15);
    REPK(16) if (IN(16)) {
        unsigned ts[9]; ts[0] = 0;
#pragma unroll
        for (int e = 0; e < 8; ++e) ts[e + 1] = ts[e] + (__hip_atomic_load(ctl + CW_CNT + e, __ATOMIC_RELAXED, __HIP_MEMORY_SCOPE_AGENT) + 255u) / 256u;
        if (blockIdx.x == 0 && F.tid < 9) { unsigned v = ts[0];
#pragma unroll
            for (int e = 1; e < 9; ++e) v = (F.tid == e) ? ts[e] : v;
            ctl[CW_TS + F.tid] = v; }
        for (int m = F.gw; m < M; m += F.NGW) { const int* rt = ROUTE + (size_t)m * 8; const int e1 = rt[0], e2 = rt[1]; unsigned t1 = 0, t2 = 0;
#pragma unroll
            for (int e = 0; e < 8; ++e) { t1 = (e == e1) ? ts[e] : t1; t2 = (e == e2) ? ts[e] : t2; }
            const size_t d1 = (size_t)t1 * 256 + rt[2], d2 = (size_t)t2 * 256 + rt[3];
            const v4u* src = (const v4u*)(H + (size_t)m * D) + F.lane;
#if MOE_F8
            v2u* o1 = (v2u*)((unsigned char*)XB + d1 * D) + F.lane; v2u* o2 = (v2u*)((unsigned char*)XB + d2 * D) + F.lane;
#pragma unroll
            for (int j = 0; j < 4; ++j) { const v4u w = src[64 * j]; v2u q; q.x = pk4_fp8(bflo(w.x), bfhi(w.x), bflo(w.y), bfhi(w.y)); q.y = pk4_fp8(bflo(w.z), bfhi(w.z), bflo(w.w), bfhi(w.w)); o1[64 * j] = q; o2[64 * j] = q; } }
#else
            v4u* o1 = (v4u*)(XB + d1 * D) + F.lane; v4u* o2 = (v4u*)(XB + d2 * D) + F.lane;
#pragma unroll
            for (int j = 0; j < 4; ++j) { const v4u w = src[64 * j]; o1[64 * j] = w; o2[64 * j] = w; } }
#endif
    }
    SEAM(16);
#if MOE_F8
    REPK(17) if (IN(17)) { pg8::Gemm g{XB, W_MGU, D / 2, D / 2, D / 2}; pg8::GroupedOrder So; So.init(ctl + CW_TS, 2 * FFE / 128, F.G, (int)blockIdx.x); pg8::EpiSwiGLUH E{ACTB, (MOE_F8 >= 2) ? (unsigned char*)ACTB : nullptr, FFE, 1.0f / MOE_WSCALE, MOE_ASCALE};
        pg8::gemm_phase<pg8::EpiSwiGLUH, pg8::GroupedOrder, PG_ALIGN, PG_SP2, true>(ring, g, So, E); }
#else
    REPK(17) if (IN(17)) { pg8::Gemm g{XB, W_MGU, D, D, D}; pg8::GroupedOrder So; So.init(ctl + CW_TS, 2 * FFE / 256, F.G, (int)blockIdx.x); pg8::EpiSwiGLU E{ACTB, FFE};
        pg8::gemm_phase<pg8::EpiSwiGLU, pg8::GroupedOrder, PG_ALIGN, PG_SP2>(ring, g, So, E); }
#endif
    SEAM(17);
#if MOE_F8 >= 2
    REPK(18) if (IN(18)) { pg8::Gemm g{ACTB, W_MDN, FFE / 2, FFE / 2, FFE / 2}; pg8::GroupedOrder So; So.init(ctl + CW_TS, D / 128, F.G, (int)blockIdx.x); pg8::EpiBf16H E{YB, D, 1.0f / (MOE_WSCALE * MOE_ASCALE)};
        pg8::gemm_phase<pg8::EpiBf16H, pg8::GroupedOrder, PG_ALIGN, PG_SP2, true>(ring, g, So, E); }
#else
    REPK(18) if (IN(18)) { pg8::Gemm g{ACTB, W_MDN, FFE, FFE, FFE}; pg8::GroupedOrder So; So.init(ctl + CW_TS, D / 256, F.G, (int)blockIdx.x); pg8::EpiBf16 E{YB, D, nullptr};
        pg8::gemm_phase<pg8::EpiBf16, pg8::GroupedOrder, PG_ALIGN, PG_SP2>(ring, g, So, E); }
#endif
    SEAM(18);
    REPK(19) if (IN(19)) {
        unsigned ts[9]; ts[0] = 0;
#pragma unroll
        for (int e = 0; e < 8; ++e) ts[e + 1] = ctl[CW_TS + e + 1];
#pragma unroll
        for (int b = 0; b < NB; ++b) {
            const float* gf = MOD + 4 * 12288 + (size_t)b * 6 * D + 5 * D;
            const int m0 = b * S + F.gw, m1 = m0 + F.NGW;
            const int* rt0 = ROUTE + (size_t)m0 * 8; const int* rt1 = ROUTE + (size_t)m1 * 8;
            const int e10 = rt0[0], e20 = rt0[1], r10 = rt0[2], r20 = rt0[3], e11 = rt1[0], e21 = rt1[1], r11 = rt1[2], r21 = rt1[3];
            const float g10 = __int_as_float(rt0[4]), g20 = __int_as_float(rt0[5]), g11 = __int_as_float(rt1[4]), g21 = __int_as_float(rt1[5]);
            unsigned t10 = 0, t20 = 0, t11 = 0, t21 = 0;
#pragma unroll
            for (int e = 0; e < 8; ++e) { t10 = (e == e10) ? ts[e] : t10; t20 = (e == e20) ? ts[e] : t20; t11 = (e == e11) ? ts[e] : t11; t21 = (e == e21) ? ts[e] : t21; }
            const v2u* ya0 = (const v2u*)(YB + ((size_t)t10 * 256 + r10) * D) + F.lane; const v2u* yb0 = (const v2u*)(YB + ((size_t)t20 * 256 + r20) * D) + F.lane;
            const v2u* ya1 = (const v2u*)(YB + ((size_t)t11 * 256 + r11) * D) + F.lane; const v2u* yb1 = (const v2u*)(YB + ((size_t)t21 * 256 + r21) * D) + F.lane;
            const f32x4* x0 = (const f32x4*)(X + (size_t)m0 * D) + F.lane; const f32x4* x1 = (const f32x4*)(X + (size_t)m1 * D) + F.lane;
            f32x4 v0[8], v1[8]; v2u a0[8], c0[8], a1[8], c1[8];
#pragma unroll
            for (int j = 0; j < 8; ++j) { v0[j] = x0[64 * j]; v1[j] = x1[64 * j]; a0[j] = ya0[64 * j]; c0[j] = yb0[64 * j]; a1[j] = ya1[64 * j]; c1[j] = yb1[64 * j]; }
            float q0 = 0.f, q1 = 0.f;
#pragma unroll
            for (int j = 0; j < 8; ++j) { const f32x4 gg = ((const f32x4*)gf)[F.lane + 64 * j]; f32x4 y;
                y.x = g10 * bflo(a0[j].x) + g20 * bflo(c0[j].x); y.y = g10 * bfhi(a0[j].x) + g20 * bfhi(c0[j].x); y.z = g10 * bflo(a0[j].y) + g20 * bflo(c0[j].y); y.w = g10 * bfhi(a0[j].y) + g20 * bfhi(c0[j].y);
                v0[j] = v0[j] + gg * y; q0 += (v0[j].x * v0[j].x + v0[j].y * v0[j].y) + (v0[j].z * v0[j].z + v0[j].w * v0[j].w);
                y.x = g11 * bflo(a1[j].x) + g21 * bflo(c1[j].x); y.y = g11 * bfhi(a1[j].x) + g21 * bfhi(c1[j].x); y.z = g11 * bflo(a1[j].y) + g21 * bflo(c1[j].y); y.w = g11 * bfhi(a1[j].y) + g21 * bfhi(c1[j].y);
                v1[j] = v1[j] + gg * y; q1 += (v1[j].x * v1[j].x + v1[j].y * v1[j].y) + (v1[j].z * v1[j].z + v1[j].w * v1[j].w); }
            const float ri0 = 1.0f / sqrtf(wave_sum(q0) * (1.f / D) + RMS_EPS), ri1 = 1.0f / sqrtf(wave_sum(q1) * (1.f / D) + RMS_EPS);
            f32x4* o0 = (f32x4*)(args.out + (size_t)m0 * D) + F.lane; f32x4* o1 = (f32x4*)(args.out + (size_t)m1 * D) + F.lane;
#pragma unroll
            for (int j = 0; j < 8; ++j) { const f32x4 fg = ((const f32x4*)final_g)[F.lane + 64 * j]; o0[64 * j] = (v0[j] * ri0) * fg; o1[64 * j] = (v1[j] * ri1) * fg; }
        }
    }
    if ((PROBE_MASK >> 19) & 1) { __syncthreads(); const unsigned long long t1_ = wall_clock64(); while (wall_clock64() < t1_ + (t1_ - tprev_)) __builtin_amdgcn_s_sleep(8); }
#undef IN
#undef SEAM
}

constexpr int N_PHASES = 20;
extern "C" void kernel_launch(void* const* d_in, const int* in_sizes, int n_in, void* d_out, int out_size, void* d_ws, size_t ws_size, hipStream_t stream) {
    static int grid = 0;
    if (grid == 0) {
        if (n_in != 30 || in_sizes[0] != M * D || out_size != M * D || ws_size < WS_END) { fprintf(stderr, "kernel_launch: shape/workspace mismatch: n_in %d in0 %d out %d ws %zu (need %zu)\n", n_in, n_in > 0 ? in_sizes[0] : -1, out_size, ws_size, (size_t)WS_END); grid = -1; return; }
        int dev = 0, cus = 0, per_cu = 0;
        if (hipGetDevice(&dev) != hipSuccess || hipDeviceGetAttribute(&cus, hipDeviceAttributeMultiprocessorCount, dev) != hipSuccess) { grid = -1; return; }
        if (hipFuncSetAttribute((const void*)fwd, hipFuncAttributeMaxDynamicSharedMemorySize, LDS_BYTES) != hipSuccess) { fprintf(stderr, "kernel_launch: hipFuncSetAttribute failed\n"); grid = -1; return; }
        if (hipOccupancyMaxActiveBlocksPerMultiprocessor(&per_cu, (const void*)fwd, NWAVES * 64, LDS_BYTES) != hipSuccess || per_cu < 1) fprintf(stderr, "kernel_launch: occupancy query reports %d\n", per_cu);
        (void)hipGetLastError();
        grid = cus;
        if (grid != 256) { fprintf(stderr, "kernel_launch: built for a 256-CU device (got %d)\n", cus); grid = -1; return; }
    }
    if (grid < 0) return;
    if (hipMemsetAsync((char*)d_ws + WS_CTL, 0, CTL_ZERO_BYTES, stream) != hipSuccess) return;
    Args a{};
    for (int i = 0; i < 30; ++i) a.in[i] = d_in[i];
    a.out = (float*)d_out; a.ws = (unsigned char*)d_ws;
    if (MK_N_LAUNCHES == 1) { a.ph_lo = 0; a.ph_hi = N_PHASES; hipLaunchKernelGGL(fwd, dim3(grid), dim3(NWAVES * 64), LDS_BYTES, stream, a); }
    else { for (int p = 0; p < N_PHASES; ++p) { a.ph_lo = p; a.ph_hi = p + 1; hipLaunchKernelGGL(fwd, dim3(grid), dim3(NWAVES * 64), LDS_BYTES, stream, a); } }
    const hipError_t le = hipPeekAtLastError();
    if (le != hipSuccess) fprintf(stderr, "kernel_launch: launch failed: %s\n", hipGetErrorName(le));
}
```

```cpp
#include <hip/hip_runtime.h>
#include <cstdio>
#include <cstdint>

#define FLASH_WIN 1
#define FLASH_SLC 1
#define FLASH_MLA 1
#define FLASH_DIL 1
#define PROBE_MASK 0
#define FLASH_CMP 1
#define WGM_G 4
#define PG_ALIGN true
#define PG_SP2 true
#define MOE_F8 2
#ifndef MK_N_LAUNCHES
#define MK_N_LAUNCHES 1
#endif

namespace pg8 {
#define PG8_LAS __attribute__((address_space(3)))
typedef unsigned short bf16_t;
typedef short bf16x8 __attribute__((ext_vector_type(8)));
typedef float f32x4 __attribute__((ext_vector_type(4)));
typedef float f32x2 __attribute__((ext_vector_type(2)));
typedef unsigned u32x4 __attribute__((ext_vector_type(4)));
typedef unsigned u32x2 __attribute__((ext_vector_type(2)));
constexpr int BM = 256, BK = 64, HALF = 128, HTB = HALF * BK * 2  , STAGE_BYTES = 8 * HTB, NXCD = 8, WGM = 8;

__host__ __device__ __forceinline__ int lds_byte(int r, int c) { const int st = (r >> 4) * 2 + (c >> 5), rr = r & 15, cc = c & 31, ob = rr * 64 + cc * 2; return st * 1024 + (ob ^ (((ob >> 9) & 1) << 5)); }
__host__ __device__ __forceinline__ void stage_rc(int b, int& R, int& C) { const int st = b / 1024, sb = b % 1024, swz = sb ^ (((sb >> 9) & 1) << 5); R = (st >> 1) * 16 + swz / 64; C = (st & 1) * 32 + (swz % 64) / 2; }
__host__ __device__ __forceinline__ int perm32(int rho) { const int n = rho >> 4, i = rho & 15; return 8 * (i >> 2) + 4 * n + (i & 3); }

struct Unit { int pm, pn, pb; };
struct Gemm { const bf16_t* A; const bf16_t* Bt; int lda, ldb, K; };

struct StaticOrder {
    int nM, nN, nwg, G, c;
    __host__ __device__ void init(int M, int N, int G_, int c_) { nM = M / BM; nN = N / BM; nwg = nM * nN; G = G_; c = c_; }
    __host__ __device__ bool next(int i, Unit& u) const {
        const long L = (long)i * G + c; if (L >= nwg) return false;
        int wgid = (int)L; { const int q = nwg / NXCD, r = nwg % NXCD, xcd = wgid % NXCD, off = wgid / NXCD; wgid = (xcd < r ? xcd * (q + 1) : r * (q + 1) + (xcd - r) * q) + off; }
        const int nig = WGM * nN, gid = wgid / nig, fm = gid * WGM, gsz = (nM - fm) < WGM ? (nM - fm) : WGM;
        u.pm = fm + ((wgid % nig) % gsz); u.pn = (wgid % nig) / gsz; u.pb = u.pn; return true;
    }
    __device__ __forceinline__ void a_ready(const Unit&) const {}
    __device__ __forceinline__ void done(const Unit&) const {}
};
#ifndef WGM_G
#define WGM_G 8
#endif
struct GroupedOrder {
    int nN, G, c; int ts[9];
    __device__ __forceinline__ void init(const unsigned* tstart, int nN_, int G_, int c_) { nN = nN_; G = G_; c = c_;
#pragma unroll
        for (int e = 0; e < 9; ++e) ts[e] = (int)tstart[e]; }
    __device__ __forceinline__ bool next(int i, Unit& u) const {
        const long L = (long)i * G + c; if (L >= (long)ts[8] * nN) return false;
        int e = 0, us = 0, te = ts[1] - ts[0], t0 = ts[0];
#pragma unroll
        for (int k = 1; k < 8; ++k) { const int s = ts[k] * nN; if (L >= s) { e = k; us = s; te = ts[k + 1] - ts[k]; t0 = ts[k]; } }
        if (te <= 0) return false;
        int wgid = (int)L - us; { const int nwg = te * nN, q = nwg / NXCD, rr = nwg % NXCD, xcd = wgid % NXCD, off = wgid / NXCD; wgid = (xcd < rr ? xcd * (q + 1) : rr * (q + 1) + (xcd - rr) * q) + off; }
        const int nig = WGM_G * nN, gid = wgid / nig, fm = gid * WGM_G, gsz = (te - fm) < WGM_G ? (te - fm) : WGM_G;
        u.pm = t0 + fm + ((wgid % nig) % gsz); u.pn = (wgid % nig) / gsz; u.pb = e * nN + u.pn; return true;
    }
    __device__ __forceinline__ void a_ready(const Unit&) const {}
    __device__ __forceinline__ void done(const Unit&) const {}
};

typedef __bf16 bf16x2c __attribute__((ext_vector_type(2)));
__device__ __forceinline__ unsigned cvt_pk_bf16(float lo, float hi) { const f32x2 v = {lo, hi}; return __builtin_bit_cast(unsigned, __builtin_convertvector(v, bf16x2c)); }

struct EpiBf16 {
    static constexpr bool PERM = true, AFTER_DRAIN = false;
    bf16_t* O; int ldc; const float* rowscale;
    __device__ __forceinline__ void operator()(const f32x4 (&acc)[2][2][4][2], const Unit& u, int wr, int wc, int fr, int fq) const {
        const int row0 = u.pm * BM + wr * 64 + fr; const int col0 = u.pn * BM + wc * 32 + 8 * fq;
#pragma unroll
        for (int ai = 0; ai < 2; ++ai)
#pragma unroll
            for (int m = 0; m < 4; ++m) { const int row = row0 + ai * HALF + m * 16; bf16_t* rowp = O + (size_t)row * ldc + col0; const float sc = rowscale ? rowscale[row] : 1.f;
#pragma unroll
                for (int bj = 0; bj < 2; ++bj) { f32x4 v0 = acc[ai][bj][m][0] * sc, v1 = acc[ai][bj][m][1] * sc;
                    u32x4 w; w.x = cvt_pk_bf16(v0[0], v0[1]); w.y = cvt_pk_bf16(v0[2], v0[3]); w.z = cvt_pk_bf16(v1[0], v1[1]); w.w = cvt_pk_bf16(v1[2], v1[3]);
                    *(u32x4*)(rowp + bj * HALF) = w; } }
    }
};
struct EpiResid {
    static constexpr bool PERM = false, AFTER_DRAIN = false;
    const float* xin; float* xout; int ldc; const float* gate; int gstride; int tiles_per_b;
    __device__ __forceinline__ void operator()(const f32x4 (&acc)[2][2][4][2], const Unit& u, int wr, int wc, int fr, int fq) const {
        const int row0 = u.pm * BM + wr * 64 + fr, col0 = u.pn * BM + wc * 32 + 4 * fq;
        const float* gp = gate + (size_t)(u.pm / tiles_per_b) * gstride + col0;
        f32x4 gv[2][2];
#pragma unroll
        for (int bj = 0; bj < 2; ++bj)
#pragma unroll
            for (int n = 0; n < 2; ++n) gv[bj][n] = *(const f32x4*)(gp + bj * HALF + n * 16);
#pragma unroll
        for (int ai = 0; ai < 2; ++ai)
#pragma unroll
            for (int m = 0; m < 4; ++m) { const size_t off = (size_t)(row0 + ai * HALF + m * 16) * ldc + col0;
#pragma unroll
                for (int bj = 0; bj < 2; ++bj)
#pragma unroll
                    for (int n = 0; n < 2; ++n) { const f32x4 xi = *(const f32x4*)(xin + off + bj * HALF + n * 16);
                        *(f32x4*)(xout + off + bj * HALF + n * 16) = xi + gv[bj][n] * acc[ai][bj][m][n]; }
                asm volatile("" ::: "memory"); }
    }
};
__device__ __forceinline__ float silu_f(float g) { return g * __builtin_amdgcn_rcpf(1.0f + __builtin_amdgcn_exp2f(-1.4426950408889634f * g)); }
struct EpiSwiGLU {
    static constexpr bool PERM = false, AFTER_DRAIN = false;
    bf16_t* O; int ldo;
    __device__ __forceinline__ void operator()(const f32x4 (&acc)[2][2][4][2], const Unit& u, int wr, int wc, int fr, int fq) const {
        const int row0 = u.pm * BM + wr * 64 + fr, col0 = u.pn * HALF + wc * 16 + 4 * fq;
#pragma unroll
        for (int ai = 0; ai < 2; ++ai)
#pragma unroll
            for (int m = 0; m < 4; ++m) { bf16_t* rowp = O + (size_t)(row0 + ai * HALF + m * 16) * ldo + col0;
#pragma unroll
                for (int bj = 0; bj < 2; ++bj) { const f32x4 g = acc[ai][bj][m][0], up = acc[ai][bj][m][1];
                    u32x2 w; w.x = cvt_pk_bf16(silu_f(g[0]) * up[0], silu_f(g[1]) * up[1]); w.y = cvt_pk_bf16(silu_f(g[2]) * up[2], silu_f(g[3]) * up[3]);
                    *(u32x2*)(rowp + bj * 64) = w; } }
    }
};
struct EpiSwiGLUH {
    static constexpr bool PERM = false, AFTER_DRAIN = false;
    bf16_t* O; unsigned char* O8; int ldo; float s, so;
    __device__ __forceinline__ void operator()(const f32x4 (&acc)[2][2][4][2], const Unit& u, int wr, int wc, int fr, int fq) const {
        const int row0 = u.pm * BM + wr * 64 + fr, col0 = u.pn * 64 + wc * 16 + 4 * fq;
#pragma unroll
        for (int ai = 0; ai < 2; ++ai)
#pragma unroll
            for (int m = 0; m < 4; ++m) { const size_t off = (size_t)(row0 + ai * HALF + m * 16) * ldo + col0;
                const f32x4 g = acc[ai][0][m][0] * s, up = acc[ai][0][m][1] * s;
                const float v0 = silu_f(g[0]) * up[0], v1 = silu_f(g[1]) * up[1], v2 = silu_f(g[2]) * up[2], v3 = silu_f(g[3]) * up[3];
                if (O8) { int w = 0; w = __builtin_amdgcn_cvt_pk_fp8_f32(__builtin_amdgcn_fmed3f(v0 * so, -440.f, 440.f), __builtin_amdgcn_fmed3f(v1 * so, -440.f, 440.f), w, false);
                    w = __builtin_amdgcn_cvt_pk_fp8_f32(__builtin_amdgcn_fmed3f(v2 * so, -440.f, 440.f), __builtin_amdgcn_fmed3f(v3 * so, -440.f, 440.f), w, true); *(int*)(O8 + off) = w; }
                else { u32x2 w; w.x = cvt_pk_bf16(v0, v1); w.y = cvt_pk_bf16(v2, v3); *(u32x2*)(O + off) = w; } }
    }
};
struct EpiBf16H {
    static constexpr bool PERM = true, AFTER_DRAIN = false;
    bf16_t* O; int ldc; float s;
    __device__ __forceinline__ void operator()(const f32x4 (&acc)[2][2][4][2], const Unit& u, int wr, int wc, int fr, int fq) const {
        const int row0 = u.pm * BM + wr * 64 + fr; const int col0 = u.pn * HALF + wc * 32 + 8 * fq;
#pragma unroll
        for (int ai = 0; ai < 2; ++ai)
#pragma unroll
            for (int m = 0; m < 4; ++m) { bf16_t* rowp = O + (size_t)(row0 + ai * HALF + m * 16) * ldc + col0;
                const f32x4 v0 = acc[ai][0][m][0] * s, v1 = acc[ai][0][m][1] * s;
                u32x4 w; w.x = cvt_pk_bf16(v0[0], v0[1]); w.y = cvt_pk_bf16(v0[2], v0[3]); w.z = cvt_pk_bf16(v1[0], v1[1]); w.w = cvt_pk_bf16(v1[2], v1[3]);
                *(u32x4*)rowp = w; }
    }
};

template <class Epi, class Sched, bool ALIGN_EPI = false, bool SP2 = false, bool F8 = false>
__device__ __forceinline__ void gemm_phase(PG8_LAS unsigned char* lds, const Gemm g, const Sched& S, const Epi& E) {
    const int tid = threadIdx.x, wid = __builtin_amdgcn_readfirstlane(tid >> 6), lane = tid & 63, wr = wid >> 2, wc = wid & 3, fr = lane & 15, fq = lane >> 4;
    const int K = g.K, nt = K / BK;
    unsigned voffA[2], voffB[2];
#pragma unroll
    for (int i = 0; i < 2; ++i) { int R, C; stage_rc(tid * 16 + i * 8192, R, C); const int Rb = Epi::PERM ? ((R & ~31) + perm32(R & 31)) : R;
        voffA[i] = (unsigned)(R * g.lda + C) * 2u; voffB[i] = (unsigned)(Rb * g.ldb + C) * 2u; }
    const size_t kstep = (size_t)(BK * 2);
    const size_t hstepA = (size_t)HALF * g.lda * 2, hstepB = (size_t)HALF * g.ldb * 2;
    const size_t tstepA = 2 * hstepA, tstepB = F8 ? hstepB : 2 * hstepB;
    const unsigned ldsw = (unsigned)wid * 1024u;
    const int aoff = lds_byte(wr * 64 + fr, fq * 8), boff = lds_byte(wc * 32 + fr, fq * 8);
#define PG8_SA(b, h) (((b) * 2 + (h)) * HTB)
#define PG8_SB(b, h) ((4 + (b) * 2 + (h)) * HTB)
#define PG8_STAGE(bufoff, gbase, voff) do { _Pragma("unroll") for (int _i = 0; _i < 2; ++_i) \
        __builtin_amdgcn_global_load_lds((const unsigned*)((const char*)(gbase) + (voff)[_i]), (PG8_LAS unsigned*)(lds + (bufoff) + ldsw + _i * 8192), 16, 0, 0); } while (0)
#define PG8_LDA(dst, b, h) do { _Pragma("unroll") for (int m = 0; m < 4; ++m) _Pragma("unroll") for (int k = 0; k < 2; ++k) dst[m][k] = *(const PG8_LAS bf16x8*)(lds + PG8_SA(b, h) + aoff + m * 2048 + k * 1024); } while (0)
#define PG8_LDB(dst, b, h) do { if constexpr (!F8 || (h) == 0) { _Pragma("unroll") for (int n = 0; n < 2; ++n) _Pragma("unroll") for (int k = 0; k < 2; ++k) dst[n][k] = *(const PG8_LAS bf16x8*)(lds + PG8_SB(b, h) + boff + n * 2048 + k * 1024); } } while (0)
#define PG8_CAT(x, y) __builtin_shufflevector(x, y, 0, 1, 2, 3, 4, 5, 6, 7, 8, 9, 10, 11, 12, 13, 14, 15)
#define PG8_MMA(ai, bj, At, Bt) do { if constexpr (!F8 || (bj) == 0) { __builtin_amdgcn_s_setprio(1); \
        if constexpr (F8) { _Pragma("unroll") for (int m = 0; m < 4; ++m) _Pragma("unroll") for (int n = 0; n < 2; ++n) \
            acc[ai][bj][m][n] = __builtin_amdgcn_mfma_scale_f32_16x16x128_f8f6f4(__builtin_bit_cast(v8i_, PG8_CAT(Bt[n][0], Bt[n][1])), __builtin_bit_cast(v8i_, PG8_CAT(At[m][0], At[m][1])), acc[ai][bj][m][n], 0, 0, 0, 0x7f7f7f7f, 0, 0x7f7f7f7f); } \
        else { _Pragma("unroll") for (int m = 0; m < 4; ++m) _Pragma("unroll") for (int n = 0; n < 2; ++n) _Pragma("unroll") for (int k = 0; k < 2; ++k) \
            acc[ai][bj][m][n] = __builtin_amdgcn_mfma_f32_16x16x32_bf16(Bt[n][k], At[m][k], acc[ai][bj][m][n], 0, 0, 0); } \
        __builtin_amdgcn_s_setprio(0); } } while (0)
#define PG8_WAIT_V(n) asm volatile("s_waitcnt vmcnt(" #n ")" ::: "memory")
#define PG8_WAIT_L(n) asm volatile("s_waitcnt lgkmcnt(" #n ")" ::: "memory")
#define PG8_BAR __builtin_amdgcn_s_barrier()
#define PG8_SCHED __builtin_amdgcn_sched_barrier(0)
    Unit cur, nxt; int ui = 0;
    if (!S.next(0, cur)) return;
    f32x4 acc[2][2][4][2];
#pragma unroll
    for (int a = 0; a < 2; ++a)
#pragma unroll
        for (int b = 0; b < 2; ++b)
#pragma unroll
            for (int m = 0; m < 4; ++m)
#pragma unroll
                for (int n = 0; n < 2; ++n) acc[a][b][m][n] = (f32x4){0.f, 0.f, 0.f, 0.f};
    bf16x8 At[4][2], B0[2][2], B1[2][2];
    typedef int v8i_ __attribute__((ext_vector_type(8))); typedef short bf16x16_ __attribute__((ext_vector_type(16)));
    const char* cA = (const char*)g.A + (size_t)cur.pm * tstepA; const char* cB = (const char*)g.Bt + (size_t)cur.pb * tstepB;
    S.a_ready(cur);
    if constexpr (SP2) {
        PG8_STAGE(PG8_SB(0, 0), cB, voffB); if constexpr (!F8) PG8_STAGE(PG8_SB(0, 1), cB + hstepB, voffB); PG8_STAGE(PG8_SA(0, 0), cA, voffA); PG8_STAGE(PG8_SA(0, 1), cA + hstepA, voffA);
        if (wr == 1) PG8_BAR;
        PG8_WAIT_V(2); PG8_BAR;
        PG8_STAGE(PG8_SB(1, 0), cB + kstep, voffB); PG8_STAGE(PG8_SA(1, 0), cA + kstep, voffA); if constexpr (!F8) PG8_STAGE(PG8_SB(1, 1), cB + hstepB + kstep, voffB);
        if constexpr (F8) PG8_WAIT_V(4); else PG8_WAIT_V(6); PG8_BAR;
    } else {
        PG8_STAGE(PG8_SB(0, 0), cB, voffB); PG8_STAGE(PG8_SA(0, 0), cA, voffA); PG8_STAGE(PG8_SB(0, 1), cB + hstepB, voffB); PG8_STAGE(PG8_SA(0, 1), cA + hstepA, voffA);
        if (wr == 1) PG8_BAR;
        PG8_WAIT_V(4); PG8_BAR;
        PG8_STAGE(PG8_SB(1, 0), cB + kstep, voffB); PG8_STAGE(PG8_SA(1, 0), cA + kstep, voffA); PG8_STAGE(PG8_SB(1, 1), cB + hstepB + kstep, voffB);
        PG8_WAIT_V(6); PG8_BAR;
    }
    for (;;) {
        const bool has_next = S.next(ui + 1, nxt);
        const char* nA = has_next ? (const char*)g.A + (size_t)nxt.pm * tstepA : cA; const char* nB = has_next ? (const char*)g.Bt + (size_t)nxt.pb * tstepB : cB;
        for (int t = 0; t < nt; t += 2) {
            const bool last = (t == nt - 2);
            const char* a1 = cA + (size_t)(t + 1) * kstep;
            const char* a2 = last ? nA : cA + (size_t)(t + 2) * kstep; const char* b2 = last ? nB : cB + (size_t)(t + 2) * kstep;
            const char* a3 = a2 + kstep; const char* b3 = b2 + kstep;
            if (last && has_next) S.a_ready(nxt);
            if constexpr (SP2) {
            PG8_LDB(B0, 0, 0); PG8_LDB(B1, 0, 1); PG8_SCHED; PG8_LDA(At, 0, 0); PG8_STAGE(PG8_SA(1, 1), a1 + hstepA, voffA);
            if constexpr (F8) PG8_WAIT_V(6); else PG8_WAIT_V(8); PG8_WAIT_L(0); PG8_BAR; PG8_MMA(0, 0, At, B0); PG8_MMA(0, 1, At, B1); PG8_BAR; PG8_SCHED;
            PG8_LDA(At, 0, 1); PG8_STAGE(PG8_SB(0, 0), b2, voffB); if constexpr (!F8) PG8_STAGE(PG8_SB(0, 1), b2 + hstepB, voffB); PG8_STAGE(PG8_SA(0, 0), a2, voffA);
            if constexpr (F8) PG8_WAIT_V(6); else PG8_WAIT_V(8); PG8_WAIT_L(0); PG8_BAR; PG8_MMA(1, 0, At, B0); PG8_MMA(1, 1, At, B1); PG8_BAR; PG8_SCHED;
            PG8_LDB(B0, 1, 0); PG8_LDB(B1, 1, 1); PG8_SCHED; PG8_LDA(At, 1, 0); PG8_STAGE(PG8_SA(0, 1), a2 + hstepA, voffA);
            if constexpr (F8) PG8_WAIT_V(6); else PG8_WAIT_V(8); PG8_WAIT_L(0); PG8_BAR; PG8_MMA(0, 0, At, B0); PG8_MMA(0, 1, At, B1); PG8_BAR; PG8_SCHED;
            PG8_LDA(At, 1, 1); PG8_STAGE(PG8_SB(1, 0), b3, voffB); if constexpr (!F8) PG8_STAGE(PG8_SB(1, 1), b3 + hstepB, voffB); PG8_STAGE(PG8_SA(1, 0), a3, voffA);
            if constexpr (F8) PG8_WAIT_V(6); else PG8_WAIT_V(8); PG8_WAIT_L(0); PG8_BAR; PG8_MMA(1, 0, At, B0); PG8_MMA(1, 1, At, B1); PG8_BAR; PG8_SCHED;
            } else {
            PG8_LDB(B0, 0, 0); PG8_SCHED; PG8_LDA(At, 0, 0); PG8_STAGE(PG8_SA(1, 1), a1 + hstepA, voffA);
            PG8_WAIT_L(8); PG8_BAR; PG8_WAIT_L(0); PG8_MMA(0, 0, At, B0); PG8_BAR; PG8_SCHED;
            PG8_LDB(B1, 0, 1); PG8_STAGE(PG8_SB(0, 0), b2, voffB);
            PG8_BAR; PG8_WAIT_L(0); PG8_MMA(0, 1, At, B1); PG8_BAR;
            PG8_LDA(At, 0, 1); PG8_STAGE(PG8_SA(0, 0), a2, voffA);
            PG8_BAR; PG8_WAIT_L(0); PG8_MMA(1, 0, At, B0); PG8_BAR; PG8_SCHED;
            PG8_STAGE(PG8_SB(0, 1), b2 + hstepB, voffB);
            PG8_WAIT_V(6); PG8_BAR; PG8_MMA(1, 1, At, B1); PG8_BAR;
            PG8_LDB(B0, 1, 0); PG8_SCHED; PG8_LDA(At, 1, 0); PG8_STAGE(PG8_SA(0, 1), a2 + hstepA, voffA);
            PG8_WAIT_L(8); PG8_BAR; PG8_WAIT_L(0); PG8_MMA(0, 0, At, B0); PG8_BAR; PG8_SCHED;
            PG8_LDB(B1, 1, 1); PG8_STAGE(PG8_SB(1, 0), b3, voffB);
            PG8_BAR; PG8_WAIT_L(0); PG8_MMA(0, 1, At, B1); PG8_BAR;
            PG8_LDA(At, 1, 1); PG8_STAGE(PG8_SA(1, 0), a3, voffA);
            PG8_BAR; PG8_WAIT_L(0); PG8_MMA(1, 0, At, B0); PG8_BAR; PG8_SCHED;
            PG8_STAGE(PG8_SB(1, 1), b3 + hstepB, voffB);
            PG8_WAIT_V(6); PG8_BAR; PG8_MMA(1, 1, At, B1); PG8_BAR;
            }
        }
        if constexpr (ALIGN_EPI) { if (wr == 0) PG8_BAR; }
        if constexpr (!Epi::AFTER_DRAIN) { E(acc, cur, wr, wc, fr, fq); S.done(cur); }
        if (!has_next) break;
#pragma unroll
        for (int a = 0; a < 2; ++a)
#pragma unroll
            for (int b = 0; b < 2; ++b)
#pragma unroll
                for (int m = 0; m < 4; ++m)
#pragma unroll
                    for (int n = 0; n < 2; ++n) acc[a][b][m][n] = (f32x4){0.f, 0.f, 0.f, 0.f};
        cur = nxt; cA = nA; cB = nB; ++ui;
        if constexpr (ALIGN_EPI) { if (wr == 1) PG8_BAR; }
    }
    PG8_WAIT_V(0);
    if constexpr (!ALIGN_EPI) { if (wr == 0) PG8_BAR; }
    PG8_BAR;
    if constexpr (Epi::AFTER_DRAIN) { E.fused(acc, cur, wr, wc, fr, fq, lds, wid, lane); S.done(cur); }
#undef PG8_SA
#undef PG8_SB
#undef PG8_STAGE
#undef PG8_CAT
#undef PG8_LDA
#undef PG8_LDB
#undef PG8_MMA
#undef PG8_WAIT_V
#undef PG8_WAIT_L
#undef PG8_BAR
#undef PG8_SCHED
}

}

#ifndef FA_DBG_NOSEL
#define FA_DBG_NOSEL 0
#endif
#ifndef FA_DBG_NOMERGE
#define FA_DBG_NOMERGE 0
#endif
#ifndef FA_SEL_SKIP
#define FA_SEL_SKIP 0
#endif
namespace fa {
#define FA_LAS __attribute__((address_space(3)))
typedef unsigned short bf16;
typedef short bf16x8 __attribute__((ext_vector_type(8)));
typedef short s16x4 __attribute__((ext_vector_type(4)));
typedef float f32x16 __attribute__((ext_vector_type(16)));
typedef float f32x4 __attribute__((ext_vector_type(4)));
typedef unsigned u32x4 __attribute__((ext_vector_type(4)));
constexpr int QB = 256, QBLK = 32, KVBLK = 64;
constexpr int SHM_K = 16384, SHM_V = 16384, SHM_K2 = 8192;
constexpr int OFF_V = 0, OFF_K = 2 * SHM_V, OFF_K2 = OFF_K + 2 * SHM_K, OFF_WS = OFF_K2 + 2 * SHM_K2, WS_PER_WAVE = 1024, OFF_TAB = OFF_WS + 8 * WS_PER_WAVE;
constexpr int TAB_PAD = 320, TAB_MAX = 4096 + TAB_PAD;
constexpr int LDS_END = OFF_TAB + TAB_MAX * 4;
constexpr int OSTG = 272;
static_assert(LDS_END <= 131072 && 8 * 32 * OSTG <= OFF_WS, "attention LDS map");
#define KSWZ(row, colB) ((row) * 256 + ((colB) ^ (((row) & 7) << 4)))
#define K2SWZ(row, colB) ((row) * 128 + ((colB) ^ (((row) & 7) << 4)))
#define SBAR() __builtin_amdgcn_sched_barrier(0)
__device__ __forceinline__ int v_st(int k, int c) { const int kk = (k & ~0xC) | ((k & 4) << 1) | ((k & 8) >> 1); return ((kk >> 3) * 4 + (c >> 5)) * 512 + ((kk & 7) * 32 + (c & 31)) * 2; }
__device__ __forceinline__ int v_rd_base(int lane) { return ((lane & 3) << 3) | (((lane >> 2) & 3) << 6) | (((lane >> 4) & 1) << 5) | (((lane >> 5) & 1) << 8); }
constexpr int v_rd_off(int d0, int ks, int half) { return d0 * 512 + ks * 4096 + half * 2048; }
__device__ __forceinline__ int crow(int r, int hi) { return (r & 3) + 8 * (r >> 2) + 4 * hi; }
typedef float f32x2c __attribute__((ext_vector_type(2)));
typedef __bf16 bf16x2c __attribute__((ext_vector_type(2)));
__device__ __forceinline__ unsigned cvtpk(float lo, float hi) { const f32x2c v = {lo, hi}; return __builtin_bit_cast(unsigned, __builtin_convertvector(v, bf16x2c)); }

struct Item {
    const bf16* Q; long qs;
    const float* rope; long ropes;
    const bf16* K; long ks; const bf16* K2; long k2s; const bf16* V; long vs;
    int P0, skv, W;
    const float* bias; int bstep;
    const unsigned long long* sel; long sels;
    bf16* O; long os;
    float* LSE; long lses;
    const bf16* M0; const bf16* M1; long ms; const bf16* G; long gs;
};

template <int VAR>
__device__ __forceinline__ void attn_block(const Item& it, unsigned char* lds_g) {
    constexpr bool HAS_BIAS = VAR != 2, HAS_SEL = VAR == 1, HAS_K2 = VAR == 2;
    constexpr float SCALE = HAS_K2 ? 0.07216878364870322f : 0.08838834764831845f, C2 = 1.4426950408889634f * SCALE, THR = 8.f;
    FA_LAS unsigned char* L = (FA_LAS unsigned char*)lds_g;
    const int tid = threadIdx.x, wid = __builtin_amdgcn_readfirstlane(tid >> 6), lane = tid & 63, r32 = lane & 31, hi = lane >> 5;
    const int W = it.W;
    const int j_lo = (it.P0 - W + 1 > 0) ? (it.P0 - W + 1) / KVBLK : 0;
    int j_hi = (it.P0 + QB - 1) / KVBLK + 1; if (j_hi > it.skv / KVBLK) j_hi = it.skv / KVBLK;
    const int NT = j_hi - j_lo;
    const int qlo = it.P0 + wid * QBLK, qm = qlo + r32 - 4 * hi;
    FA_LAS float* wsl = (FA_LAS float*)(L + OFF_WS + wid * WS_PER_WAVE); FA_LAS float* li_l = wsl; FA_LAS float* al_l = wsl + 32;
    FA_LAS float* tab = (FA_LAS float*)(L + OFF_TAB);
    const int sr = tid >> 4, sc = (tid & 15) * 8, vst0 = v_st(sr, sc), vst1 = v_st(32 + sr, sc), kws = KSWZ(sr, sc * 2);
    const int k2r = tid >> 3, k2c = (tid & 7) * 8, k2ws = K2SWZ(k2r, k2c * 2);
    const int vb0 = OFF_V + v_rd_base(lane);
    bf16x8 qr[8]; bf16x8 qr2[4];
    { const bf16* qp = it.Q + (long)(qlo + r32) * it.qs + hi * 8;
#pragma unroll
      for (int d0 = 0; d0 < 8; ++d0) qr[d0] = *(const bf16x8*)(qp + d0 * 16);
      if constexpr (HAS_K2) {
          const float* rp = it.rope + (long)(qlo + r32) * it.ropes + hi * 8;
          bf16x8 raw[4];
#pragma unroll
          for (int d0 = 0; d0 < 4; ++d0) raw[d0] = *(const bf16x8*)(qp + 128 + d0 * 16);
#pragma unroll
          for (int d0 = 0; d0 < 2; ++d0) { const f32x4 c0 = *(const f32x4*)(rp + d0 * 16), c1 = *(const f32x4*)(rp + d0 * 16 + 4), s0 = *(const f32x4*)(rp + 32 + d0 * 16), s1 = *(const f32x4*)(rp + 32 + d0 * 16 + 4);
              float o1[8], o2[8];
#pragma unroll
              for (int j = 0; j < 8; ++j) { const float x1 = __builtin_bit_cast(float, (unsigned)(unsigned short)raw[d0][j] << 16), x2 = __builtin_bit_cast(float, (unsigned)(unsigned short)raw[d0 + 2][j] << 16);
                  const float cs = j < 4 ? c0[j & 3] : c1[j & 3], sn = j < 4 ? s0[j & 3] : s1[j & 3]; o1[j] = x1 * cs - x2 * sn; o2[j] = x2 * cs + x1 * sn; }
              u32x4 w1 = {cvtpk(o1[0], o1[1]), cvtpk(o1[2], o1[3]), cvtpk(o1[4], o1[5]), cvtpk(o1[6], o1[7])}, w2 = {cvtpk(o2[0], o2[1]), cvtpk(o2[2], o2[3]), cvtpk(o2[4], o2[5]), cvtpk(o2[6], o2[7])};
              qr2[d0] = __builtin_bit_cast(bf16x8, w1); qr2[d0 + 2] = __builtin_bit_cast(bf16x8, w2); }
      }
    }
    unsigned long long selm = ~0ull;
    if constexpr (HAS_SEL) selm = __hip_atomic_load(it.sel + (long)(qlo + r32) * it.sels, __ATOMIC_RELAXED, __HIP_MEMORY_SCOPE_AGENT);
    if constexpr (HAS_BIAS) {
        int rmax = W + 320; if (rmax > 4096) rmax = 4096;
        for (int i = tid; i < rmax + TAB_PAD; i += 512) { int r = i - TAB_PAD; r = r < -64 ? -64 : r; long gi = (long)r * it.bstep; gi = gi > 4095 ? 4095 : gi; tab[i] = it.bias[gi] * (1.0f / SCALE); }
    }
    bf16x8 st_k0, st_k1, st_v0, st_v1, st_k2;
#define FA_LOAD(kb_) do { const long r0_ = (long)((kb_) + sr), r1_ = r0_ + 32; \
        st_v0 = *(const bf16x8*)(it.V + r0_ * it.vs + sc); st_v1 = *(const bf16x8*)(it.V + r1_ * it.vs + sc); \
        st_k0 = *(const bf16x8*)(it.K + r0_ * it.ks + sc); st_k1 = *(const bf16x8*)(it.K + r1_ * it.ks + sc); \
        if constexpr (HAS_K2) st_k2 = *(const bf16x8*)(it.K2 + (long)((kb_) + k2r) * it.k2s + k2c); } while (0)
#define FA_WRITE(bf_) do { *(FA_LAS bf16x8*)(L + OFF_V + (bf_) * SHM_V + vst0) = st_v0; *(FA_LAS bf16x8*)(L + OFF_V + (bf_) * SHM_V + vst1) = st_v1; \
        *(FA_LAS bf16x8*)(L + OFF_K + (bf_) * SHM_K + kws) = st_k0; *(FA_LAS bf16x8*)(L + OFF_K + (bf_) * SHM_K + kws + 32 * 256) = st_k1; \
        if constexpr (HAS_K2) *(FA_LAS bf16x8*)(L + OFF_K2 + (bf_) * SHM_K2 + k2ws) = st_k2; } while (0)
    FA_LOAD(j_lo * KVBLK);
    asm volatile("s_waitcnt vmcnt(0)" ::: "memory");
    FA_WRITE(0);
    __syncthreads();
    float m_reg = -1e30f, l_reg = 0.f; f32x16 o[4] = {};
#define FA_KBASE(t) ((j_lo + (t)) * KVBLK)
#define FA_STEP(BUF, t) do { \
        const int kb_ = FA_KBASE(t); \
        if ((t) + 1 < NT) FA_LOAD(FA_KBASE((t) + 1)); \
        bool act_ = (kb_ <= qlo + QBLK - 1) && (kb_ + KVBLK - 1 >= qlo - W + 1); \
        bool allow_ = true; \
        if constexpr (HAS_SEL) { allow_ = FA_DBG_NOSEL ? true : (bool)((selm >> (kb_ >> 6)) & 1ull); if (FA_SEL_SKIP) act_ = act_ && __any(allow_); } \
        if (act_) { \
            f32x16 p0 = {}, p1 = {}; \
            { const int ka_ = OFF_K + (BUF) * SHM_K; \
              _Pragma("unroll") for (int d0 = 0; d0 < 8; ++d0) { \
                const bf16x8 b0 = *(const FA_LAS bf16x8*)(L + ka_ + KSWZ(r32, (d0 * 16 + hi * 8) * 2)); \
                const bf16x8 b1 = *(const FA_LAS bf16x8*)(L + ka_ + 32 * 256 + KSWZ(r32, (d0 * 16 + hi * 8) * 2)); \
                p0 = __builtin_amdgcn_mfma_f32_32x32x16_bf16(b0, qr[d0], p0, 0, 0, 0); p1 = __builtin_amdgcn_mfma_f32_32x32x16_bf16(b1, qr[d0], p1, 0, 0, 0); } \
              if constexpr (HAS_K2) { const int k2a_ = OFF_K2 + (BUF) * SHM_K2; \
                _Pragma("unroll") for (int d0 = 0; d0 < 4; ++d0) { \
                  const bf16x8 b0 = *(const FA_LAS bf16x8*)(L + k2a_ + K2SWZ(r32, (d0 * 16 + hi * 8) * 2)); \
                  const bf16x8 b1 = *(const FA_LAS bf16x8*)(L + k2a_ + 32 * 128 + K2SWZ(r32, (d0 * 16 + hi * 8) * 2)); \
                  p0 = __builtin_amdgcn_mfma_f32_32x32x16_bf16(b0, qr2[d0], p0, 0, 0, 0); p1 = __builtin_amdgcn_mfma_f32_32x32x16_bf16(b1, qr2[d0], p1, 0, 0, 0); } } } \
            const int dq_ = qm - kb_; \
            if constexpr (HAS_BIAS) { const FA_LAS float* tb_ = tab + (TAB_PAD + dq_ - 63); \
                _Pragma("unroll") for (int r = 0; r < 16; ++r) { const int c_ = (r & 3) + 8 * (r >> 2); p0[r] += tb_[63 - c_]; p1[r] += tb_[31 - c_]; } } \
            if (HAS_SEL || kb_ + KVBLK - 1 > qlo || kb_ <= qlo + QBLK - 1 - W) { const float NEG_ = -__builtin_inff(); const int dqm_ = allow_ ? dq_ : -0x40000000; \
                _Pragma("unroll") for (int r = 0; r < 16; ++r) { const int c_ = (r & 3) + 8 * (r >> 2); \
                    if ((unsigned)(dqm_ - c_) >= (unsigned)W) p0[r] = NEG_; if ((unsigned)(dqm_ - c_ - 32) >= (unsigned)W) p1[r] = NEG_; } } \
              \
            float pmax_ = p0[0]; _Pragma("unroll") for (int r = 1; r < 16; ++r) pmax_ = fmaxf(pmax_, p0[r]); _Pragma("unroll") for (int r = 0; r < 16; ++r) pmax_ = fmaxf(pmax_, p1[r]); \
            { auto rr_ = __builtin_amdgcn_permlane32_swap(__float_as_uint(pmax_), __float_as_uint(pmax_), false, false); pmax_ = fmaxf(__uint_as_float(rr_[0]), __uint_as_float(rr_[1])); } \
            float mn_, alpha_; \
            if (__all((pmax_ - m_reg) * SCALE <= THR)) { mn_ = m_reg; alpha_ = 1.f; } \
            else { mn_ = fmaxf(m_reg, pmax_); alpha_ = __builtin_amdgcn_exp2f((m_reg - mn_) * C2); m_reg = mn_; } \
            const float mnL_ = -mn_ * C2; float ps_ = 0.f; \
            _Pragma("unroll") for (int r = 0; r < 16; ++r) { p0[r] = __builtin_amdgcn_exp2f(fmaf(p0[r], C2, mnL_)); p1[r] = __builtin_amdgcn_exp2f(fmaf(p1[r], C2, mnL_)); ps_ += p0[r] + p1[r]; } \
            { auto rr_ = __builtin_amdgcn_permlane32_swap(__float_as_uint(ps_), __float_as_uint(ps_), false, false); ps_ = __uint_as_float(rr_[0]) + __uint_as_float(rr_[1]); } \
            l_reg = l_reg * alpha_ + ps_; \
            bf16x8 pa0, pa1, pa2, pa3; \
            FA_PK4(p0, 0, pa0); FA_PK4(p0, 8, pa1); FA_PK4(p1, 0, pa2); FA_PK4(p1, 8, pa3); \
            if (__any(alpha_ < 1.f)) { if (hi == 0) al_l[r32] = alpha_; asm volatile("s_waitcnt lgkmcnt(0)" ::: "memory"); \
                _Pragma("unroll") for (int d_ = 0; d_ < 4; ++d_) _Pragma("unroll") for (int r = 0; r < 16; ++r) o[d_][r] *= al_l[crow(r, hi)]; } \
            FA_PV_D0(BUF, 0); FA_PV_D0(BUF, 1); FA_PV_D0(BUF, 2); FA_PV_D0(BUF, 3); \
        } \
        if ((t) + 1 < NT) { asm volatile("s_waitcnt vmcnt(0)" ::: "memory"); FA_WRITE(1 - (BUF)); } \
        __syncthreads(); } while (0)
#define FA_PK4(P, B_, OUT) do { unsigned a0 = cvtpk(P[B_+0], P[B_+1]), a1 = cvtpk(P[B_+2], P[B_+3]); unsigned b0 = cvtpk(P[B_+4], P[B_+5]), b1 = cvtpk(P[B_+6], P[B_+7]); \
        auto r0 = __builtin_amdgcn_permlane32_swap(a0, b0, false, false); auto r1 = __builtin_amdgcn_permlane32_swap(a1, b1, false, false); \
        u32x4 w = {r0[0], r1[0], r0[1], r1[1]}; OUT = __builtin_bit_cast(bf16x8, w); } while (0)
#define FA_TRRD(dst, off) asm volatile("ds_read_b64_tr_b16 %0, %1 offset:%2" : "=&v"(dst) : "v"(vb0), "i"(off) : "memory")
#define FA_PV_D0(VB, d0) do { s16x4 l0, l1, l2, l3, h0, h1, h2, h3; constexpr int b_ = (VB) * SHM_V + v_rd_off(d0, 0, 0); \
        FA_TRRD(l0, b_); FA_TRRD(h0, b_ + 2048); FA_TRRD(l1, b_ + 4096); FA_TRRD(h1, b_ + 6144); FA_TRRD(l2, b_ + 8192); FA_TRRD(h2, b_ + 10240); FA_TRRD(l3, b_ + 12288); FA_TRRD(h3, b_ + 14336); \
        asm volatile("s_waitcnt lgkmcnt(0)" ::: "memory"); SBAR(); \
        o[d0] = __builtin_amdgcn_mfma_f32_32x32x16_bf16(pa0, (bf16x8){l0[0], l0[1], l0[2], l0[3], h0[0], h0[1], h0[2], h0[3]}, o[d0], 0, 0, 0); \
        o[d0] = __builtin_amdgcn_mfma_f32_32x32x16_bf16(pa1, (bf16x8){l1[0], l1[1], l1[2], l1[3], h1[0], h1[1], h1[2], h1[3]}, o[d0], 0, 0, 0); \
        o[d0] = __builtin_amdgcn_mfma_f32_32x32x16_bf16(pa2, (bf16x8){l2[0], l2[1], l2[2], l2[3], h2[0], h2[1], h2[2], h2[3]}, o[d0], 0, 0, 0); \
        o[d0] = __builtin_amdgcn_mfma_f32_32x32x16_bf16(pa3, (bf16x8){l3[0], l3[1], l3[2], l3[3], h3[0], h3[1], h3[2], h3[3]}, o[d0], 0, 0, 0); } while (0)
    for (int t = 0; t < NT; t += 2) { FA_STEP(0, t); if (t + 1 < NT) FA_STEP(1, t + 1); }
    li_l[r32] = l_reg;
    if constexpr (VAR == 1) { const bf16* gp = it.G + (long)(qlo + r32) * it.gs;
#pragma unroll
        for (int k = 0; k < 3; ++k) { const float gl = __builtin_bit_cast(float, (unsigned)gp[k] << 16); wsl[64 + 32 * k + r32] = 1.0f / (1.0f + __expf(-gl)); } }
    asm volatile("s_waitcnt lgkmcnt(0)" ::: "memory");
    if (it.LSE && hi == 0) it.LSE[(long)(qlo + r32) * it.lses] = m_reg * SCALE + __logf(l_reg);
    FA_LAS unsigned char* stg = L + wid * (32 * OSTG);
#pragma unroll
    for (int r = 0; r < 16; ++r) { const int orow = crow(r, hi); const float lv_ = li_l[orow]; float rl = lv_ > 0.f ? __builtin_amdgcn_rcpf(lv_) : 0.f; if constexpr (VAR == 1 && !FA_DBG_NOMERGE) rl *= wsl[64 + 32 + orow];
#pragma unroll
        for (int d0 = 0; d0 < 4; ++d0) { const float v = o[d0][r] * rl; const unsigned u = __builtin_bit_cast(unsigned, v); *(FA_LAS unsigned short*)(stg + orow * OSTG + (d0 * 32 + r32) * 2) = (unsigned short)((u + 0x7fffu + ((u >> 16) & 1u)) >> 16); } }
    asm volatile("s_waitcnt lgkmcnt(0)" ::: "memory");
#pragma unroll
    for (int i = 0; i < 8; ++i) { const int id = lane + 64 * i, row = id >> 4, ch = id & 15; const long qi = (long)(qlo + row);
        u32x4 w = *(const FA_LAS u32x4*)(stg + row * OSTG + ch * 16);
        if constexpr (VAR == 1 && !FA_DBG_NOMERGE) { const float g0 = wsl[64 + row], g2 = wsl[64 + 64 + row];
            const u32x4 a = *(const u32x4*)(it.M0 + qi * it.ms + ch * 8), c = *(const u32x4*)(it.M1 + qi * it.ms + ch * 8);
#pragma unroll
            for (int k = 0; k < 4; ++k) { const float lo = __builtin_bit_cast(float, w[k] << 16) + g0 * __builtin_bit_cast(float, a[k] << 16) + g2 * __builtin_bit_cast(float, c[k] << 16);
                const float hi_ = __builtin_bit_cast(float, w[k] & 0xffff0000u) + g0 * __builtin_bit_cast(float, a[k] & 0xffff0000u) + g2 * __builtin_bit_cast(float, c[k] & 0xffff0000u); w[k] = cvtpk(lo, hi_); } }
        *(u32x4*)(it.O + qi * it.os + ch * 8) = w; }
    __syncthreads();
#undef FA_LOAD
#undef FA_WRITE
#undef FA_KBASE
#undef FA_STEP
#undef FA_PK4
#undef FA_TRRD
#undef FA_PV_D0
}

struct CmpItem { const bf16* Q; long qs; const bf16* K; const bf16* V; const float* bias; int bld; int s0; bf16* O; long os; unsigned long long* sel; };
__device__ __forceinline__ void cmp_block(const CmpItem& it, unsigned char* lds_g, int imps_off) {
    constexpr float SCALE = 0.08838834764831845f, C2 = 1.4426950408889634f * SCALE;
    constexpr int OFF_TABC = 65536;
    FA_LAS unsigned char* L = (FA_LAS unsigned char*)lds_g;
    const int tid = threadIdx.x, wid = __builtin_amdgcn_readfirstlane(tid >> 6), lane = tid & 63, r32 = lane & 31, hi = lane >> 5;
    FA_LAS float* tabc = (FA_LAS float*)(L + OFF_TABC); FA_LAS float* imps = (FA_LAS float*)(L + imps_off);
    const int tokl = wid * 8 + (r32 >> 2), rh = r32 & 3, s = it.s0 + tokl;
    const int nvis = (it.s0 + 63 - 31) / 16 + 1 > 255 ? 255 : (it.s0 + 63 - 31) / 16 + 1;
    const int NT = (nvis + 63) / 64;
    const int nlim = (s - 31) >> 4;
    const int sr = tid >> 4, sc = (tid & 15) * 8, vst0 = v_st(sr, sc), vst1 = v_st(32 + sr, sc), kws = KSWZ(sr, sc * 2);
    const int vb0 = OFF_V + v_rd_base(lane);
    bf16x8 qr[8];
    { const bf16* qp = it.Q + (long)tokl * it.qs + rh * 128 + hi * 8;
#pragma unroll
      for (int d0 = 0; d0 < 8; ++d0) qr[d0] = *(const bf16x8*)(qp + d0 * 16); }
    for (int i = tid; i < 4 * 4096; i += 512) tabc[i] = it.bias[(long)(i >> 12) * it.bld + (i & 4095)] * (1.0f / SCALE);
    for (int i = tid; i < 64 * 64; i += 512) imps[i] = 0.f;
    bf16x8 st_k0, st_k1, st_v0, st_v1;
#define CM_LOADK(kb_) do { st_k0 = *(const bf16x8*)(it.K + (long)((kb_) + sr) * 128 + sc); st_k1 = *(const bf16x8*)(it.K + (long)((kb_) + 32 + sr) * 128 + sc); } while (0)
#define CM_LOADV(kb_) do { st_v0 = *(const bf16x8*)(it.V + (long)((kb_) + sr) * 128 + sc); st_v1 = *(const bf16x8*)(it.V + (long)((kb_) + 32 + sr) * 128 + sc); } while (0)
#define CM_WRITEK(bf_) do { *(FA_LAS bf16x8*)(L + OFF_K + (bf_) * SHM_K + kws) = st_k0; *(FA_LAS bf16x8*)(L + OFF_K + (bf_) * SHM_K + kws + 32 * 256) = st_k1; } while (0)
#define CM_WRITEV(bf_) do { *(FA_LAS bf16x8*)(L + OFF_V + (bf_) * SHM_V + vst0) = st_v0; *(FA_LAS bf16x8*)(L + OFF_V + (bf_) * SHM_V + vst1) = st_v1; } while (0)
#define CM_SCORES(BUF, kb_) \
        f32x16 p0 = {}, p1 = {}; \
        { const int ka_ = OFF_K + (BUF) * SHM_K; \
          _Pragma("unroll") for (int d0 = 0; d0 < 8; ++d0) { \
            const bf16x8 b0 = *(const FA_LAS bf16x8*)(L + ka_ + KSWZ(r32, (d0 * 16 + hi * 8) * 2)); \
            const bf16x8 b1 = *(const FA_LAS bf16x8*)(L + ka_ + 32 * 256 + KSWZ(r32, (d0 * 16 + hi * 8) * 2)); \
            p0 = __builtin_amdgcn_mfma_f32_32x32x16_bf16(b0, qr[d0], p0, 0, 0, 0); p1 = __builtin_amdgcn_mfma_f32_32x32x16_bf16(b1, qr[d0], p1, 0, 0, 0); } } \
        { const int nb_ = (kb_) + 4 * hi, relb_ = s - 31 - 16 * nb_; const float NEG_ = -__builtin_inff(); \
          _Pragma("unroll") for (int r = 0; r < 16; ++r) { const int c_ = (r & 3) + 8 * (r >> 2); \
            { const int rel_ = relb_ - 16 * c_; const int ix_ = rel_ < 0 ? 0 : rel_; const float bv_ = tabc[rh * 4096 + ix_]; p0[r] = (nb_ + c_ <= nlim) ? p0[r] + bv_ : NEG_; } \
            { const int rel_ = relb_ - 16 * (c_ + 32); const int ix_ = rel_ < 0 ? 0 : rel_; const float bv_ = tabc[rh * 4096 + ix_]; p1[r] = (nb_ + c_ + 32 <= nlim) ? p1[r] + bv_ : NEG_; } } }
    CM_LOADK(0); asm volatile("s_waitcnt vmcnt(0)" ::: "memory"); CM_WRITEK(0); __syncthreads();
    float m_reg = -1e30f, l_reg = 0.f;
#define CM_P1(BUF, t) do { if ((t) + 1 < NT) CM_LOADK(((t) + 1) * 64); \
        { CM_SCORES(BUF, (t) * 64) \
          float pmax_ = p0[0]; _Pragma("unroll") for (int r = 1; r < 16; ++r) pmax_ = fmaxf(pmax_, p0[r]); _Pragma("unroll") for (int r = 0; r < 16; ++r) pmax_ = fmaxf(pmax_, p1[r]); \
          { auto rr_ = __builtin_amdgcn_permlane32_swap(__float_as_uint(pmax_), __float_as_uint(pmax_), false, false); pmax_ = fmaxf(__uint_as_float(rr_[0]), __uint_as_float(rr_[1])); } \
          const float mn_ = fmaxf(m_reg, pmax_), alpha_ = __builtin_amdgcn_exp2f((m_reg - mn_) * C2), mnL_ = -mn_ * C2; float ps_ = 0.f; \
          _Pragma("unroll") for (int r = 0; r < 16; ++r) ps_ += __builtin_amdgcn_exp2f(fmaf(p0[r], C2, mnL_)) + __builtin_amdgcn_exp2f(fmaf(p1[r], C2, mnL_)); \
          { auto rr_ = __builtin_amdgcn_permlane32_swap(__float_as_uint(ps_), __float_as_uint(ps_), false, false); ps_ = __uint_as_float(rr_[0]) + __uint_as_float(rr_[1]); } \
          l_reg = l_reg * alpha_ + ps_; m_reg = mn_; } \
        if ((t) + 1 < NT) { asm volatile("s_waitcnt vmcnt(0)" ::: "memory"); CM_WRITEK(1 - (BUF)); } \
        __syncthreads(); } while (0)
    for (int t = 0; t < NT; t += 2) { CM_P1(0, t); if (t + 1 < NT) CM_P1(1, t + 1); }
    const float inv_l = l_reg > 0.f ? 1.0f / l_reg : 0.f, mL = -m_reg * C2;
    CM_LOADK(0); CM_LOADV(0); asm volatile("s_waitcnt vmcnt(0)" ::: "memory"); CM_WRITEK(0); CM_WRITEV(0); __syncthreads();
    f32x16 o[4] = {};
#define FA_PK4(P, B_, OUT) do { unsigned a0 = cvtpk(P[B_+0], P[B_+1]), a1 = cvtpk(P[B_+2], P[B_+3]); unsigned b0 = cvtpk(P[B_+4], P[B_+5]), b1 = cvtpk(P[B_+6], P[B_+7]); \
        auto r0 = __builtin_amdgcn_permlane32_swap(a0, b0, false, false); auto r1 = __builtin_amdgcn_permlane32_swap(a1, b1, false, false); \
        u32x4 w = {r0[0], r1[0], r0[1], r1[1]}; OUT = __builtin_bit_cast(bf16x8, w); } while (0)
#define FA_TRRD(dst, off) asm volatile("ds_read_b64_tr_b16 %0, %1 offset:%2" : "=&v"(dst) : "v"(vb0), "i"(off) : "memory")
#define FA_PV_D0(VB, d0) do { s16x4 l0, l1, l2, l3, h0, h1, h2, h3; constexpr int b_ = (VB) * SHM_V + v_rd_off(d0, 0, 0); \
        FA_TRRD(l0, b_); FA_TRRD(h0, b_ + 2048); FA_TRRD(l1, b_ + 4096); FA_TRRD(h1, b_ + 6144); FA_TRRD(l2, b_ + 8192); FA_TRRD(h2, b_ + 10240); FA_TRRD(l3, b_ + 12288); FA_TRRD(h3, b_ + 14336); \
        asm volatile("s_waitcnt lgkmcnt(0)" ::: "memory"); SBAR(); \
        o[d0] = __builtin_amdgcn_mfma_f32_32x32x16_bf16(pa0, (bf16x8){l0[0], l0[1], l0[2], l0[3], h0[0], h0[1], h0[2], h0[3]}, o[d0], 0, 0, 0); \
        o[d0] = __builtin_amdgcn_mfma_f32_32x32x16_bf16(pa1, (bf16x8){l1[0], l1[1], l1[2], l1[3], h1[0], h1[1], h1[2], h1[3]}, o[d0], 0, 0, 0); \
        o[d0] = __builtin_amdgcn_mfma_f32_32x32x16_bf16(pa2, (bf16x8){l2[0], l2[1], l2[2], l2[3], h2[0], h2[1], h2[2], h2[3]}, o[d0], 0, 0, 0); \
        o[d0] = __builtin_amdgcn_mfma_f32_32x32x16_bf16(pa3, (bf16x8){l3[0], l3[1], l3[2], l3[3], h3[0], h3[1], h3[2], h3[3]}, o[d0], 0, 0, 0); } while (0)
#define CM_IMP(P, half_, t) do { _Pragma("unroll") for (int q4 = 0; q4 < 4; ++q4) { \
            float A_ = (2.0f * ((P[4 * q4] + P[4 * q4 + 1]) + P[4 * q4 + 2]) + P[4 * q4 + 3]) * inv_l, B_ = P[4 * q4 + 3] * inv_l; \
            A_ += __shfl_xor(A_, 1); A_ += __shfl_xor(A_, 2); B_ += __shfl_xor(B_, 1); B_ += __shfl_xor(B_, 2); \
            const int j_ = 2 * q4 + hi + 8 * (half_) + 16 * (t); \
            if (rh == 0) { __hip_atomic_fetch_add(&imps[tokl * 64 + j_], A_, __ATOMIC_RELAXED, __HIP_MEMORY_SCOPE_WORKGROUP); \
                if (j_ + 1 < 64) __hip_atomic_fetch_add(&imps[tokl * 64 + j_ + 1], B_, __ATOMIC_RELAXED, __HIP_MEMORY_SCOPE_WORKGROUP); } } } while (0)
#define CM_P2(BUF, t) do { if ((t) + 1 < NT) { CM_LOADK(((t) + 1) * 64); CM_LOADV(((t) + 1) * 64); } \
        { CM_SCORES(BUF, (t) * 64) \
          _Pragma("unroll") for (int r = 0; r < 16; ++r) { p0[r] = __builtin_amdgcn_exp2f(fmaf(p0[r], C2, mL)); p1[r] = __builtin_amdgcn_exp2f(fmaf(p1[r], C2, mL)); } \
          CM_IMP(p0, 0, t); CM_IMP(p1, 1, t); \
          bf16x8 pa0, pa1, pa2, pa3; FA_PK4(p0, 0, pa0); FA_PK4(p0, 8, pa1); FA_PK4(p1, 0, pa2); FA_PK4(p1, 8, pa3); \
          FA_PV_D0(BUF, 0); FA_PV_D0(BUF, 1); FA_PV_D0(BUF, 2); FA_PV_D0(BUF, 3); } \
        if ((t) + 1 < NT) { asm volatile("s_waitcnt vmcnt(0)" ::: "memory"); CM_WRITEK(1 - (BUF)); CM_WRITEV(1 - (BUF)); } \
        __syncthreads(); } while (0)
    for (int t = 0; t < NT; t += 2) { CM_P2(0, t); if (t + 1 < NT) CM_P2(1, t + 1); }
    asm volatile("s_waitcnt lgkmcnt(0)" ::: "memory");
    for (int tk = 0; tk < 8; ++tk) { const int sp = it.s0 + wid * 8 + tk, blk_t = sp >> 6, j = lane;
        const float is = imps[(wid * 8 + tk) * 64 + j];
        const bool forced = (j == 0) || (j == blk_t) || (j == blk_t - 1), valid = j <= blk_t;
        const float scv = forced ? 1e9f : (valid ? is : -1.0f);
        int rank = 0;
        for (int k = 0; k < 64; ++k) { const float vk = __shfl(scv, k); rank += (vk > scv || (vk == scv && k < j)) ? 1 : 0; }
        const unsigned long long msk = __ballot(rank < 16 && scv > -0.5f);
        if (lane == 0) it.sel[(long)(wid * 8 + tk) * 2] = msk; }
    FA_LAS unsigned char* stg = L + wid * (32 * OSTG);
    FA_LAS float* li_c = imps + wid * 512;
    li_c[r32] = inv_l; asm volatile("s_waitcnt lgkmcnt(0)" ::: "memory");
#pragma unroll
    for (int r = 0; r < 16; ++r) { const int orow = crow(r, hi); const float rl = li_c[orow];
#pragma unroll
        for (int d0 = 0; d0 < 4; ++d0) { const unsigned u = __builtin_bit_cast(unsigned, o[d0][r] * rl); *(FA_LAS unsigned short*)(stg + orow * OSTG + (d0 * 32 + r32) * 2) = (unsigned short)((u + 0x7fffu + ((u >> 16) & 1u)) >> 16); } }
    asm volatile("s_waitcnt lgkmcnt(0)" ::: "memory");
#pragma unroll
    for (int i = 0; i < 8; ++i) { const int id = lane + 64 * i, row = id >> 4, ch = id & 15;
        const u32x4 w = *(const FA_LAS u32x4*)(stg + row * OSTG + ch * 16);
        *(u32x4*)(it.O + (long)(wid * 8 + (row >> 2)) * it.os + (row & 3) * 128 + ch * 8) = w; }
    __syncthreads();
#undef CM_LOADK
#undef CM_LOADV
#undef CM_WRITEK
#undef CM_WRITEV
#undef CM_SCORES
#undef CM_P1
#undef CM_P2
#undef CM_IMP
#undef FA_PK4
#undef FA_TRRD
#undef FA_PV_D0
}
}

constexpr int D = 2048, NB = 4, S = 4096, M = NB * S;
constexpr int HD = 128;
constexpr int Z0W = 3840;
constexpr int Z_NQ = 0, Z_NKV = 1024, Z_QLAT = 2560, Z_KVLAT = 3072, Z_KPE = 3584, Z_NG = 3648;
constexpr int QMW = 1536, KVMW = 2048;
constexpr int FF = 5632, FFE = 7168, NE = 8;
constexpr int Z1W = 9216;
constexpr int NSLOT = (2 * M / 256 + NE) * 256;
constexpr float RMS_EPS = 1e-6f;

constexpr size_t MiB = 1u << 20;
constexpr size_t WS_CTL = 0, CTL_ZERO_BYTES = 1 * MiB;
constexpr size_t WS_MOD = 1 * MiB;
constexpr size_t WS_BIAS = 2 * MiB;
constexpr int BIAS_LD = 4096 + 64;
constexpr size_t WS_ROPE = 3 * MiB;
constexpr size_t WS_RINV = 8 * MiB;
constexpr size_t WS_SEL = 9 * MiB;
constexpr size_t WS_KC = 10 * MiB;
constexpr size_t WS_VC = 11 * MiB;
constexpr size_t WS_ROUTE = 12 * MiB;
constexpr size_t WS_LSE = 13 * MiB;
constexpr size_t WS_KPE = 15 * MiB;
constexpr size_t WS_W1T = 17 * MiB, WS_W2T = 19 * MiB, WS_CB1 = 20 * MiB;
constexpr size_t WS_WIN0 = 21 * MiB, WS_WUQ = 36 * MiB, WS_WUKV = 38 * MiB, WS_WOUT0 = 40 * MiB, WS_WGU0 = 48 * MiB, WS_WDN0 = 92 * MiB;
constexpr size_t WS_WIN1 = 114 * MiB, WS_WOUT1 = 150 * MiB, WS_WMGU = 154 * MiB, WS_WMDN = 602 * MiB;
constexpr size_t WS_X = 826 * MiB;
constexpr size_t WS_H = 954 * MiB;
constexpr size_t WS_R = 1018 * MiB;
constexpr size_t WS_Z0 = WS_R, WS_QM = WS_R + 120 * MiB, WS_KVM = WS_R + 168 * MiB, WS_OCMP = WS_R + 232 * MiB, WS_OWIN = WS_R + 264 * MiB, WS_CAT = WS_R + 328 * MiB;
constexpr size_t WS_ACT = WS_R;
constexpr size_t WS_Z1 = WS_R, WS_OP = WS_R + 288 * MiB, WS_OM = WS_R + 384 * MiB;
constexpr size_t WS_XB = WS_R, WS_ACTB = WS_R + 136 * MiB, WS_YB = WS_R;
constexpr size_t WS_END = WS_R + 612 * MiB;
static_assert(WS_Z0 + (size_t)M * Z0W * 2 <= WS_QM && WS_QM + (size_t)M * QMW * 2 <= WS_KVM && WS_KVM + (size_t)M * KVMW * 2 <= WS_OCMP && WS_CAT + (size_t)M * 2048 * 2 <= WS_END, "L0 map");
static_assert(WS_Z1 + (size_t)M * Z1W * 2 <= WS_OM && WS_XB + (size_t)NSLOT * D * 2 <= WS_ACTB && WS_ACTB + (size_t)NSLOT * FFE * 2 <= WS_END, "L1 map");
static_assert(WS_WMDN + (size_t)NE * D * FFE * 2 <= WS_X && WS_WMGU + (size_t)NE * 2 * FFE * D * 2 <= WS_WMDN, "weights map");
constexpr int CW_BAR = 4096;
constexpr int CW_CNT = 64;
constexpr int CW_TS = 128;
constexpr int CW_Q = 8192;

constexpr int RING_BYTES = 131072;
constexpr int SMALL_OFF = RING_BYTES;
constexpr int LDSCTL_OFF = RING_BYTES + 16384, MISC_OFF = LDSCTL_OFF;
constexpr int LDS_BYTES = LDSCTL_OFF + 256;
constexpr int NWAVES = 8;

#define GAS __attribute__((address_space(1)))
#define LAS __attribute__((address_space(3)))
typedef unsigned short bf16;
typedef unsigned v4u __attribute__((ext_vector_type(4)));
typedef unsigned v2u __attribute__((ext_vector_type(2)));
typedef float f32x4 __attribute__((ext_vector_type(4)));
typedef float f32x2 __attribute__((ext_vector_type(2)));
#define LDS_WAIT() asm volatile("s_waitcnt lgkmcnt(0)" ::: "memory")
__device__ __forceinline__ unsigned f2bf(float f) { unsigned u = __builtin_bit_cast(unsigned, f); return (u + 0x7fffu + ((u >> 16) & 1u)) >> 16; }
__device__ __forceinline__ unsigned pk2(float lo, float hi) { return f2bf(lo) | (f2bf(hi) << 16); }
__device__ __forceinline__ float bf2f(unsigned short b) { return __builtin_bit_cast(float, (unsigned)b << 16); }
__device__ __forceinline__ float bflo(unsigned w) { return __builtin_bit_cast(float, w << 16); }
__device__ __forceinline__ float bfhi(unsigned w) { return __builtin_bit_cast(float, w & 0xffff0000u); }
__device__ __forceinline__ float wave_sum(float v) {
#pragma unroll
    for (int o = 1; o < 64; o <<= 1) v += __shfl_xor(v, o);
    return v;
}
__device__ __forceinline__ float wave_max(float v) {
#pragma unroll
    for (int o = 1; o < 64; o <<= 1) v = fmaxf(v, __shfl_xor(v, o));
    return v;
}

#define XB_TMO      128
#define XB_XCNT(j)  (256  + 64 * (j))
#define XB_XSUB(j)  (1280 + 64 * (j))
#define XB_XGEN(j)  (2304 + 64 * (j))
#define XB_TOP      3328
#define XB_TOPGEN   3392
#define XCD_BAR_WORDS 3456
#define XB_SPIN_CAP (1u << 22)

__device__ __forceinline__ unsigned xb_ld(unsigned* p)              { return __hip_atomic_load(p, __ATOMIC_RELAXED, __HIP_MEMORY_SCOPE_AGENT); }
__device__ __forceinline__ unsigned xb_add(unsigned* p, unsigned v) { return __hip_atomic_fetch_add(p, v, __ATOMIC_RELAXED, __HIP_MEMORY_SCOPE_AGENT); }
__device__ __forceinline__ unsigned xb_xcc_id() { return (unsigned)__builtin_amdgcn_s_getreg((3 << 11) | 20) & 0xFu; }
#define XB_SPIN(cond, bar) do { unsigned _sp = 0; while (cond) { __builtin_amdgcn_s_sleep(1); \
    if ((++_sp & 255u) == 0u) { if (xb_ld(&(bar)[XB_TMO])) break; if (_sp > XB_SPIN_CAP) { atomicAdd(&(bar)[XB_TMO], 1u); break; } } } } while (0)

struct XcdBarrier {
    unsigned* bar; unsigned x;
    volatile LAS unsigned* st;
};

__device__ __forceinline__ XcdBarrier xcd_barrier_post(unsigned* bar, volatile LAS unsigned* st) {
    XcdBarrier b; b.bar = bar; b.x = xb_xcc_id(); b.st = st;
    if (threadIdx.x == 0) (void)xb_add(&bar[XB_XCNT(b.x)], 1u);
    return b;
}
__device__ __forceinline__ void xcd_barrier_complete(unsigned* bar, unsigned x, unsigned& nloc, unsigned& nx) {
    const unsigned G = gridDim.x * gridDim.y * gridDim.z;
    unsigned sum, cnt, mine, sp = 0u;
    for (;;) {
        sum = 0u; cnt = 0u; mine = 0u;
#pragma unroll
        for (unsigned j = 0; j < 16; ++j) { const unsigned c = xb_ld(&bar[XB_XCNT(j)]); sum += c; cnt += (c > 0u) ? 1u : 0u; mine = (j == x) ? c : mine; }
        if (sum == G) break;
        __builtin_amdgcn_s_sleep(1);
        if ((++sp & 255u) == 0u) { if (xb_ld(&bar[XB_TMO])) break; if (sp > XB_SPIN_CAP) { atomicAdd(&bar[XB_TMO], 1u); break; } }
    }
    nloc = mine > 0u ? mine : 1u; nx = cnt > 0u ? cnt : 1u;
}

__device__ __forceinline__ void xcd_barrier(const XcdBarrier& b) {
    asm volatile("s_waitcnt vmcnt(0)" ::: "memory");
    __syncthreads();
    if (threadIdx.x == 0) {
        unsigned* bar = b.bar;
        __builtin_amdgcn_s_waitcnt(0);
        unsigned nloc = b.st[0], nx = b.st[1];
        if (nloc == 0u) { xcd_barrier_complete(bar, b.x, nloc, nx); b.st[0] = nloc; b.st[1] = nx; }
        const unsigned old = xb_add(&bar[XB_XSUB(b.x)], 1u);
        const unsigned gen = old / nloc;
        if (old + 1u == (gen + 1u) * nloc) {
            __builtin_amdgcn_fence(__ATOMIC_RELEASE, "agent");
            asm volatile("s_waitcnt vmcnt(0)" ::: "memory");
            const unsigned og = xb_add(&bar[XB_TOP], 1u);
            const unsigned tg = og / nx;
            if (og + 1u == (tg + 1u) * nx) xb_add(&bar[XB_TOPGEN], 1u);
            else XB_SPIN(xb_ld(&bar[XB_TOPGEN]) == tg, bar);
            __builtin_amdgcn_fence(__ATOMIC_ACQUIRE, "agent");
            xb_add(&bar[XB_XGEN(b.x)], 1u);
            asm volatile("s_waitcnt vmcnt(0)" ::: "memory");
        } else {
            XB_SPIN(xb_ld(&bar[XB_XGEN(b.x)]) == gen, bar);
            __builtin_amdgcn_fence(__ATOMIC_ACQUIRE, "agent");
            asm volatile("s_waitcnt vmcnt(0)" ::: "memory");
        }
    }
    __syncthreads();
}


struct Args { const void* in[30]; float* out; unsigned char* ws; int ph_lo, ph_hi; };
struct Frame {
    unsigned char* lds;
    int tid, lane, wave, vcu, G, gw, NGW;
    unsigned char* ws;
};

__device__ __forceinline__ int t5_bucket(int n) {
    if (n < 16) return n < 0 ? 0 : n;
    int b = 16;
    b += (n >= 22); b += (n >= 30); b += (n >= 40); b += (n >= 54); b += (n >= 73); b += (n >= 99); b += (n >= 134); b += (n >= 182);
    b += (n >= 246); b += (n >= 332); b += (n >= 450); b += (n >= 609); b += (n >= 825); b += (n >= 1117); b += (n >= 1513);
    return b;
}

__device__ __forceinline__ unsigned pk4_fp8(float a, float b, float c, float d) { int w = 0; w = __builtin_amdgcn_cvt_pk_fp8_f32(a, b, w, false); w = __builtin_amdgcn_cvt_pk_fp8_f32(c, d, w, true); return (unsigned)w; }
template <int MAP, bool OUT8 = false>
__device__ __forceinline__ void p0_transpose_item(const float* W, const float* W2, int K, int Nsrc, int Ndst, bf16* WT, const float* kscale, float* scr, int item, int lane, float oscale = 1.0f) {
    const int nblk = Ndst / 64, kb = item / nblk, nb = item % nblk, k0 = 64 * kb, n0 = 64 * nb;
    const int n4 = (lane & 15) * 4, n = n0 + n4, kr = lane >> 4;
    const float* src = W; int sc = n; bool ok = true;
    if (MAP == 1) { if (n < Z_QLAT) sc = n; else if (n < Z_NG) sc = n + 24; else if (n < Z_NG + 24) sc = n - Z_NG + 2560; else ok = false; }
    if (MAP == 2) { const int g32 = n >> 5, w = n & 31; src = (w < 16) ? W : W2; sc = g32 * 16 + (w & 15); }
    f32x4 v[16];
#pragma unroll
    for (int i = 0; i < 16; ++i) v[i] = ok ? __builtin_nontemporal_load((const f32x4*)(src + (size_t)(k0 + 4 * i + kr) * Nsrc + sc)) : (f32x4){0.f, 0.f, 0.f, 0.f};
#pragma unroll
    for (int i = 0; i < 16; ++i) { const int kk = 4 * i + kr; f32x4 t = v[i]; if (kscale) t = t * kscale[k0 + kk]; float* d = scr + kk * 65 + n4; d[0] = t.x; d[1] = t.y; d[2] = t.z; d[3] = t.w; }
    LDS_WAIT(); asm volatile("" ::: "memory");
    if constexpr (OUT8) {
        const int kg = lane & 3;
#pragma unroll
        for (int p = 0; p < 4; ++p) { const int nn = 16 * p + (lane >> 2); const float* s = scr + (16 * kg) * 65 + nn;
            v4u o; o.x = pk4_fp8(s[0 * 65] * oscale, s[1 * 65] * oscale, s[2 * 65] * oscale, s[3 * 65] * oscale); o.y = pk4_fp8(s[4 * 65] * oscale, s[5 * 65] * oscale, s[6 * 65] * oscale, s[7 * 65] * oscale);
            o.z = pk4_fp8(s[8 * 65] * oscale, s[9 * 65] * oscale, s[10 * 65] * oscale, s[11 * 65] * oscale); o.w = pk4_fp8(s[12 * 65] * oscale, s[13 * 65] * oscale, s[14 * 65] * oscale, s[15 * 65] * oscale);
            *(v4u*)((unsigned char*)WT + (size_t)(n0 + nn) * K + k0 + 16 * kg) = o; }
    } else {
    const int kg = lane & 7;
#pragma unroll
    for (int p = 0; p < 8; ++p) { const int nn = 8 * p + (lane >> 3); const float* s = scr + (8 * kg) * 65 + nn;
        v4u o; o.x = pk2(s[0 * 65], s[1 * 65]); o.y = pk2(s[2 * 65], s[3 * 65]); o.z = pk2(s[4 * 65], s[5 * 65]); o.w = pk2(s[6 * 65], s[7 * 65]);
        *(v4u*)(WT + (size_t)(n0 + nn) * K + k0 + 8 * kg) = o; }
    }
    LDS_WAIT(); asm volatile("" ::: "memory");
}
template <int MAP, bool OUT8 = false>
__device__ __forceinline__ void p0_transpose(Frame& F, const float* W, const float* W2, int K, int Nsrc, int Ndst, bf16* WT, const float* kscale, float oscale = 1.0f) {
    float* scr = (float*)(F.lds + F.wave * 16640);
    const int nitems = (K / 64) * (Ndst / 64);
    for (int it = F.gw; it < nitems; it += F.NGW) p0_transpose_item<MAP, OUT8>(W, W2, K, Nsrc, Ndst, WT, kscale, scr, it, F.lane, oscale);
}

__device__ __forceinline__ void modnorm_row(const float* xrow, const float* g, const float* sc, const float* sh, bf16* orow, int lane, f32x4 (&v)[8]) {
    const f32x4* xr = (const f32x4*)xrow + lane; float s = 0.f;
#pragma unroll
    for (int j = 0; j < 8; ++j) { v[j] = xr[64 * j]; s += (v[j].x * v[j].x + v[j].y * v[j].y) + (v[j].z * v[j].z + v[j].w * v[j].w); }
    const float rinv = 1.0f / sqrtf(wave_sum(s) * (1.f / D) + RMS_EPS);
    unsigned long long* o8 = (unsigned long long*)orow + lane;
#pragma unroll
    for (int j = 0; j < 8; ++j) { const f32x4 gg = ((const f32x4*)g)[lane + 64 * j], cc = ((const f32x4*)sc)[lane + 64 * j], hh = ((const f32x4*)sh)[lane + 64 * j];
        v[j] = (v[j] * rinv) * gg * (cc + 1.0f) + hh;
        o8[64 * j] = (unsigned long long)pk2(v[j].x, v[j].y) | ((unsigned long long)pk2(v[j].z, v[j].w) << 32); }
}
__device__ __forceinline__ void modnorm_phase(Frame& F, const float* x, const float* g, const float* mod  , int sh_idx, bf16* H) {
    for (int b = 0; b < NB; ++b) { const float* mb = mod + (size_t)b * 6 * D; const float* sc = mb + (size_t)(sh_idx + 1) * D; const float* sh = mb + (size_t)sh_idx * D;
        const int s0 = F.gw, s1 = F.gw + F.NGW;
        const f32x4* x0 = (const f32x4*)(x + ((size_t)b * S + s0) * D) + F.lane; const f32x4* x1 = (const f32x4*)(x + ((size_t)b * S + s1) * D) + F.lane;
        f32x4 v0[8], v1[8], ca[8], cc[8];
#pragma unroll
        for (int j = 0; j < 8; ++j) { v0[j] = x0[64 * j]; v1[j] = x1[64 * j]; }
#pragma unroll
        for (int j = 0; j < 8; ++j) { ca[j] = ((const f32x4*)g)[F.lane + 64 * j] * (((const f32x4*)sc)[F.lane + 64 * j] + 1.0f); cc[j] = ((const f32x4*)sh)[F.lane + 64 * j]; }
        float q0 = 0.f, q1 = 0.f;
#pragma unroll
        for (int j = 0; j < 8; ++j) { q0 += (v0[j].x * v0[j].x + v0[j].y * v0[j].y) + (v0[j].z * v0[j].z + v0[j].w * v0[j].w); q1 += (v1[j].x * v1[j].x + v1[j].y * v1[j].y) + (v1[j].z * v1[j].z + v1[j].w * v1[j].w); }
        const float r0 = 1.0f / sqrtf(wave_sum(q0) * (1.f / D) + RMS_EPS), r1 = 1.0f / sqrtf(wave_sum(q1) * (1.f / D) + RMS_EPS);
        unsigned long long* o0 = (unsigned long long*)(H + ((size_t)b * S + s0) * D) + F.lane; unsigned long long* o1 = (unsigned long long*)(H + ((size_t)b * S + s1) * D) + F.lane;
#pragma unroll
        for (int j = 0; j < 8; ++j) { const f32x4 a = (v0[j] * r0) * ca[j] + cc[j], c2 = (v1[j] * r1) * ca[j] + cc[j];
            o0[64 * j] = (unsigned long long)pk2(a.x, a.y) | ((unsigned long long)pk2(a.z, a.w) << 32); o1[64 * j] = (unsigned long long)pk2(c2.x, c2.y) | ((unsigned long long)pk2(c2.z, c2.w) << 32); }
    }
}

struct NA { const bf16* k; long kstride; const bf16* k2; long k2stride; int dq, dq2; const bf16* v; long vstride; int t0, tstep, nk; const float* bias; int brel0, bstep; float scale; unsigned long long cmask; int use_sel; };
__device__ __forceinline__ void na_run(const NA& a, const float* qs, float* sc, int lane, float& mx, float& sum, float& o0, float& o1) {
    float lmax = -3.0e38f;
    for (int c = 0; c * 64 < a.nk; ++c) {
        const int kk = c * 64 + lane; float s = -__builtin_inff();
        const bool chunk_ok = !a.use_sel || ((a.cmask >> ((a.t0 + c * 64 * a.tstep) >> 6)) & 1ull);
        if (chunk_ok && kk < a.nk) {
            const long t = a.t0 + (long)kk * a.tstep; const bf16* kr = a.k + t * a.kstride; float acc = 0.f;
            for (int d = 0; d < a.dq; d += 8) { const v4u w = *(const v4u*)(kr + d); const float* q = qs + d;
                acc += bflo(w.x) * q[0] + bfhi(w.x) * q[1] + bflo(w.y) * q[2] + bfhi(w.y) * q[3] + bflo(w.z) * q[4] + bfhi(w.z) * q[5] + bflo(w.w) * q[6] + bfhi(w.w) * q[7]; }
            if (a.dq2) { const bf16* k2r = a.k2 + t * a.k2stride;
                for (int d = 0; d < a.dq2; d += 8) { const v4u w = *(const v4u*)(k2r + d); const float* q = qs + a.dq + d;
                    acc += bflo(w.x) * q[0] + bfhi(w.x) * q[1] + bflo(w.y) * q[2] + bfhi(w.y) * q[3] + bflo(w.z) * q[4] + bfhi(w.z) * q[5] + bflo(w.w) * q[6] + bfhi(w.w) * q[7]; } }
            s = acc * a.scale; if (a.bias) s += a.bias[a.brel0 - kk * a.bstep];
        }
        if (kk < a.nk) sc[kk] = s;
        lmax = fmaxf(lmax, s);
    }
    mx = wave_max(lmax);
    float ls = 0.f;
    for (int kk = lane; kk < a.nk; kk += 64) { const float p = __expf(sc[kk] - mx); sc[kk] = p; ls += p; }
    sum = wave_sum(ls);
    LDS_WAIT(); asm volatile("" ::: "memory");
    float a0 = 0.f, a1 = 0.f;
    for (int kk = 0; kk < a.nk; ++kk) { const float p = sc[kk]; if (p != 0.f) { const unsigned w = *(const unsigned*)(a.v + (long)(a.t0 + (long)kk * a.tstep) * a.vstride + 2 * lane); a0 += p * bflo(w); a1 += p * bfhi(w); } }
    o0 = a0; o1 = a1;
    asm volatile("" ::: "memory");
}
__device__ __forceinline__ float gelu_tanh(float x) { const float u = 0.7978845608028654f * (x + 0.044715f * x * x * x); return 0.5f * x * (1.0f + tanhf(u)); }
__device__ __forceinline__ float sigmoid_f(float x) { return 1.0f / (1.0f + __expf(-x)); }

__global__ void __launch_bounds__(NWAVES * 64, 2) fwd(Args args) {
    extern __shared__ __attribute__((aligned(16))) unsigned char lds[];
    Frame F;
    F.lds = lds; F.ws = args.ws;
    F.tid = threadIdx.x; F.lane = F.tid & 63; F.wave = __builtin_amdgcn_readfirstlane(F.tid >> 6);
    F.G = gridDim.x; { const int bx = blockIdx.x; F.vcu = (F.G % 8 == 0) ? (bx % 8) * (F.G / 8) + bx / 8 : bx; }
    F.gw = F.vcu * NWAVES + F.wave; F.NGW = F.G * NWAVES;
    unsigned char* ws = args.ws;
    unsigned* ctl = (unsigned*)(ws + WS_CTL);
    volatile LAS unsigned* MISC = (volatile LAS unsigned*)((LAS unsigned char*)lds + MISC_OFF);
    for (int u = F.tid; u < 64; u += NWAVES * 64) MISC[u] = 0u;
    __syncthreads();
    XcdBarrier bar; bar.bar = ctl + CW_BAR; bar.x = 0; bar.st = nullptr;
    if (MK_N_LAUNCHES == 1) bar = xcd_barrier_post(ctl + CW_BAR, MISC + 8);
    const int lo = args.ph_lo, hi = args.ph_hi;
    unsigned long long tprev_ = PROBE_MASK ? wall_clock64() : 0ull;
#define IN(k) (lo <= (k) && (k) < hi)
#ifndef PROBE_MASK
#define PROBE_MASK 0
#endif
#ifndef MOE_F8
#define MOE_F8 0
#endif
#define MOE_WSCALE 64.0f
#define MOE_ASCALE 8.0f
#ifndef PROBE_IDLE_AT
#define PROBE_IDLE_AT (-1)
#endif
#define REPK(k)
#define SEAM(k) do { if (IN(k) && IN((k) + 1)) { xcd_barrier(bar); \
        if ((PROBE_MASK >> (k)) & 1) { const unsigned long long t1_ = wall_clock64(); while (wall_clock64() < t1_ + (t1_ - tprev_)) __builtin_amdgcn_s_sleep(8); __syncthreads(); } \
        if (PROBE_IDLE_AT == (k)) { const unsigned long long t1_ = wall_clock64(); while (wall_clock64() < t1_ + 100000ull) __builtin_amdgcn_s_sleep(8); __syncthreads(); } \
        if (PROBE_MASK) tprev_ = wall_clock64(); } } while (0)

    const float* x_in = (const float*)args.in[0]; const float* c_in = (const float*)args.in[1]; const int* positions = (const int*)args.in[2];
    const float* rel_bias = (const float*)args.in[3]; const float* ada_w = (const float*)args.in[4]; const float* ada_b = (const float*)args.in[5];
    const float* mix_norm_g = (const float*)args.in[6]; const float* ffn_norm_g = (const float*)args.in[7];
    const float* ab_w_in = (const float*)args.in[8]; const float* ab_w_out = (const float*)args.in[9];
    const float* cmp_pos_k = (const float*)args.in[10]; const float* cmp_w1_k = (const float*)args.in[11]; const float* cmp_w2_k = (const float*)args.in[12];
    const float* cmp_pos_v = (const float*)args.in[13]; const float* cmp_w1_v = (const float*)args.in[14]; const float* cmp_w2_v = (const float*)args.in[15];
    const float* q_norm_g = (const float*)args.in[16]; const float* kv_norm_g = (const float*)args.in[17]; const float* w_uq = (const float*)args.in[18]; const float* w_ukv = (const float*)args.in[19];
    const float* ffn_wg = (const float*)args.in[20]; const float* ffn_wu = (const float*)args.in[21]; const float* ffn_wd = (const float*)args.in[22];
    const float* c_w_in = (const float*)args.in[23]; const float* c_w_out = (const float*)args.in[24]; const float* w_router = (const float*)args.in[25];
    const float* moe_wg = (const float*)args.in[26]; const float* moe_wu = (const float*)args.in[27]; const float* moe_wd = (const float*)args.in[28]; const float* final_g = (const float*)args.in[29];
    float* MOD = (float*)(ws + WS_MOD); float* BIAS = (float*)(ws + WS_BIAS); float* ROPE = (float*)(ws + WS_ROPE); float* RINV = (float*)(ws + WS_RINV);
    unsigned long long* SEL = (unsigned long long*)(ws + WS_SEL); bf16* KC = (bf16*)(ws + WS_KC); bf16* VC = (bf16*)(ws + WS_VC); int* ROUTE = (int*)(ws + WS_ROUTE); bf16* KPE = (bf16*)(ws + WS_KPE);
    bf16* W_IN0 = (bf16*)(ws + WS_WIN0); bf16* W_UQ = (bf16*)(ws + WS_WUQ); bf16* W_UKV = (bf16*)(ws + WS_WUKV); bf16* W_OUT0 = (bf16*)(ws + WS_WOUT0); bf16* W_GU0 = (bf16*)(ws + WS_WGU0); bf16* W_DN0 = (bf16*)(ws + WS_WDN0);
    bf16* W_IN1 = (bf16*)(ws + WS_WIN1); bf16* W_OUT1 = (bf16*)(ws + WS_WOUT1); bf16* W_MGU = (bf16*)(ws + WS_WMGU); bf16* W_MDN = (bf16*)(ws + WS_WMDN);
    float* X = (float*)(ws + WS_X); bf16* H = (bf16*)(ws + WS_H);
    bf16* Z0 = (bf16*)(ws + WS_Z0); bf16* QM = (bf16*)(ws + WS_QM); bf16* KVM = (bf16*)(ws + WS_KVM); bf16* OCMP = (bf16*)(ws + WS_OCMP); bf16* OWIN = (bf16*)(ws + WS_OWIN); bf16* CAT = (bf16*)(ws + WS_CAT);
    bf16* W1T = (bf16*)(ws + WS_W1T); bf16* W2T = (bf16*)(ws + WS_W2T); float* CB1 = (float*)(ws + WS_CB1);
    float* LSEB = (float*)(ws + WS_LSE); bf16* OP = (bf16*)(ws + WS_OP);
    bf16* ACT = (bf16*)(ws + WS_ACT); bf16* Z1 = (bf16*)(ws + WS_Z1); bf16* OM = (bf16*)(ws + WS_OM); bf16* XB = (bf16*)(ws + WS_XB); bf16* ACTB = (bf16*)(ws + WS_ACTB); bf16* YB = (bf16*)(ws + WS_YB);
    float* wsc = (float*)(lds + F.wave * 16384);
    float* wsm = (float*)(lds + SMALL_OFF + F.wave * 2048);
    PG8_LAS unsigned char* ring = (PG8_LAS unsigned char*)lds;

    REPK(0) if (IN(0)) {
        for (int job = 192 + (int)blockIdx.x; job < 194; job += F.G) {
            float* red = (float*)(lds + 32768); const int c = job - 192; const float* pos = c ? cmp_pos_v : cmp_pos_k; const float* w1 = c ? cmp_w1_v : cmp_w1_k;
            float a0 = 0.f, a1 = 0.f;
#pragma unroll 8
            for (int k = 0; k < 512; ++k) { const int kk = F.wave * 512 + k; const f32x2 wv = *(const f32x2*)(w1 + (size_t)kk * 128 + 2 * F.lane); const float pv = pos[kk]; a0 += pv * wv.x; a1 += pv * wv.y; }
            red[F.wave * 128 + 2 * F.lane] = a0; red[F.wave * 128 + 2 * F.lane + 1] = a1;
            __syncthreads();
            if (F.tid < 128) { float s = 0.f;
#pragma unroll
                for (int w = 0; w < 8; ++w) s += red[w * 128 + F.tid];
                CB1[c * 128 + F.tid] = s; }
            __syncthreads();
        }
        for (int job = blockIdx.x; job < 256; job += F.G) {
            float* cs = (float*)lds; float* red = (float*)(lds + 32768);
            for (int i = F.tid; i < 4 * D; i += 512) { const float cv = c_in[i]; cs[i] = cv / (1.0f + __expf(-cv)); }
            __syncthreads();
            const int l = job >> 7, col0 = (job & 127) * 96; const bool act = F.lane < 48;
            float acc[4][2] = {};
            const float* wp = ada_w + ((size_t)l * D + (size_t)F.wave * 256) * 12288 + col0 + 2 * (act ? F.lane : 0);
#pragma unroll 8
            for (int k = 0; k < 256; ++k) { const f32x2 wv = *(const f32x2*)(wp + (size_t)k * 12288); const int kk = F.wave * 256 + k;
#pragma unroll
                for (int b = 0; b < 4; ++b) { const float cv = cs[b * D + kk]; acc[b][0] += cv * wv.x; acc[b][1] += cv * wv.y; } }
            if (act) {
#pragma unroll
                for (int b = 0; b < 4; ++b) { red[(F.wave * 4 + b) * 96 + 2 * F.lane] = acc[b][0]; red[(F.wave * 4 + b) * 96 + 2 * F.lane + 1] = acc[b][1]; } }
            __syncthreads();
            if (F.tid < 384) { const int b = F.tid / 96, cc = F.tid % 96; float s = 0.f;
#pragma unroll
              for (int w = 0; w < 8; ++w) s += red[(w * 4 + b) * 96 + cc];
              MOD[((size_t)l * 4 + b) * 12288 + col0 + cc] = s + ada_b[(size_t)l * 12288 + col0 + cc]; }
            __syncthreads();
        }
        __syncthreads();
        p0_transpose<1>(F, ab_w_in, nullptr, D, 3672, Z0W, W_IN0, nullptr);
        p0_transpose<0>(F, w_uq, nullptr, 512, QMW, QMW, W_UQ, q_norm_g);
        p0_transpose<0>(F, w_ukv, nullptr, 512, KVMW, KVMW, W_UKV, kv_norm_g);
        p0_transpose<0>(F, ab_w_out, nullptr, D, D, D, W_OUT0, nullptr);
        p0_transpose<2>(F, ffn_wg, ffn_wu, D, FF, 2 * FF, W_GU0, nullptr);
        p0_transpose<0>(F, ffn_wd, nullptr, FF, D, D, W_DN0, nullptr);
        p0_transpose<0>(F, c_w_in, nullptr, D, Z1W, Z1W, W_IN1, nullptr);
        p0_transpose<0>(F, c_w_out, nullptr, 1024, D, D, W_OUT1, nullptr);
        p0_transpose<0>(F, cmp_w1_k, nullptr, 4096, 128, 128, W1T, nullptr); p0_transpose<0>(F, cmp_w1_v, nullptr, 4096, 128, 128, W1T + 128 * 4096, nullptr);
        p0_transpose<0>(F, cmp_w2_k, nullptr, 128, 128, 128, W2T, nullptr); p0_transpose<0>(F, cmp_w2_v, nullptr, 128, 128, 128, W2T + 128 * 128, nullptr);
        for (int e = 0; e < NE; ++e) {
#if MOE_F8
            p0_transpose<2, true>(F, moe_wg + (size_t)e * D * FFE, moe_wu + (size_t)e * D * FFE, D, FFE, 2 * FFE, (bf16*)((unsigned char*)W_MGU + (size_t)e * 2 * FFE * D), nullptr, MOE_WSCALE);
#else
            p0_transpose<2>(F, moe_wg + (size_t)e * D * FFE, moe_wu + (size_t)e * D * FFE, D, FFE, 2 * FFE, W_MGU + (size_t)e * 2 * FFE * D, nullptr);
#endif
#if MOE_F8 >= 2
            p0_transpose<0, true>(F, moe_wd + (size_t)e * FFE * D, nullptr, FFE, D, D, (bf16*)((unsigned char*)W_MDN + (size_t)e * D * FFE), nullptr, MOE_WSCALE);
#else
            p0_transpose<0>(F, moe_wd + (size_t)e * FFE * D, nullptr, FFE, D, D, W_MDN + (size_t)e * D * FFE, nullptr);
#endif
        }
        for (int i = F.gw * 64 + F.lane; i < 8 * BIAS_LD; i += F.NGW * 64) { const int h = i / BIAS_LD, r = i % BIAS_LD - 64; BIAS[i] = rel_bias[t5_bucket(r) * 8 + h]; }
        for (int i = F.gw * 64 + F.lane; i < M * 32; i += F.NGW * 64) { const int m = i >> 5, f = i & 31;
            const float inv_freq = powf(10000.0f, -(float)(2 * f) / 64.0f); const float ang = (float)positions[m] * inv_freq;
            ROPE[(size_t)m * 64 + f] = cosf(ang); ROPE[(size_t)m * 64 + 32 + f] = sinf(ang); }
    }
    SEAM(0);
    REPK(1) if (IN(1)) modnorm_phase(F, x_in, mix_norm_g, MOD, 0, H);
    SEAM(1);
    REPK(2) if (IN(2)) { pg8::Gemm g{H, W_IN0, D, D, D}; pg8::StaticOrder So; So.init(M, Z0W, F.G, (int)blockIdx.x); pg8::EpiBf16 E{Z0, Z0W, nullptr};
        pg8::gemm_phase<pg8::EpiBf16, pg8::StaticOrder, PG_ALIGN, PG_SP2>(ring, g, So, E); }
    SEAM(2);
    REPK(3) if (IN(3)) {
        for (int m = F.gw; m < M; m += F.NGW) {
            const bf16* zr = Z0 + (size_t)m * Z0W;
#pragma unroll
            for (int w = 0; w < 2; ++w) { const v4u a = *(const v4u*)(zr + (w ? Z_KVLAT : Z_QLAT) + 8 * F.lane);
                float s = bflo(a.x) * bflo(a.x) + bfhi(a.x) * bfhi(a.x) + bflo(a.y) * bflo(a.y) + bfhi(a.y) * bfhi(a.y) + bflo(a.z) * bflo(a.z) + bfhi(a.z) * bfhi(a.z) + bflo(a.w) * bflo(a.w) + bfhi(a.w) * bfhi(a.w);
                s = wave_sum(s); if (F.lane == 0) RINV[(size_t)w * M + m] = 1.0f / sqrtf(s * (1.f / 512.f) + RMS_EPS); }
            if (F.lane < 32) { const float x1 = bf2f(zr[Z_KPE + F.lane]), x2 = bf2f(zr[Z_KPE + 32 + F.lane]); const float cs = ROPE[(size_t)m * 64 + F.lane], sn = ROPE[(size_t)m * 64 + 32 + F.lane];
                KPE[(size_t)m * 64 + F.lane] = (bf16)f2bf(x1 * cs - x2 * sn); KPE[(size_t)m * 64 + 32 + F.lane] = (bf16)f2bf(x2 * cs + x1 * sn); }
        }
        __syncthreads();
        for (int job = blockIdx.x; job < 256; job += F.G) {
            typedef short bfx8 __attribute__((ext_vector_type(8)));
            const int nt = job & 15, g = (job >> 4) & 1, b = (job >> 5) & 3, c = job >> 7, n0 = nt * 16;
            const int fr = F.lane & 15, fq = F.lane >> 4; int nrow = n0 + fr; if (nrow > 254) nrow = 254;
            const bf16* arow = Z0 + ((size_t)b * S + 16 * nrow) * Z0W + Z_NKV + c * 256 + g * 128 + fq * 8;
            const bf16* w1t = W1T + (size_t)c * 128 * 4096 + (size_t)fr * 4096 + fq * 8;
            f32x4 acc[8];
#pragma unroll
            for (int i = 0; i < 8; ++i) acc[i] = (f32x4){0.f, 0.f, 0.f, 0.f};
#pragma unroll 2
            for (int ks = 0; ks < 16; ++ks) { const int kk = F.wave * 512 + ks * 32, l = kk >> 7, d0 = kk & 127;
                const bfx8 af = *(const bfx8*)(arow + (size_t)l * Z0W + d0);
#pragma unroll
                for (int i = 0; i < 8; ++i) { const bfx8 bfr = *(const bfx8*)(w1t + (size_t)i * 16 * 4096 + kk); acc[i] = __builtin_amdgcn_mfma_f32_16x16x32_bf16(af, bfr, acc[i], 0, 0, 0); } }
            float* part = (float*)lds;
#pragma unroll
            for (int i = 0; i < 8; ++i)
#pragma unroll
                for (int j = 0; j < 4; ++j) part[(F.wave * 16 + fq * 4 + j) * 128 + i * 16 + fr] = acc[i][j];
            __syncthreads();
            bf16* hid = (bf16*)(lds + 65536);
            { const int row = F.tid >> 5, c4 = (F.tid & 31) * 4; f32x4 s = *(const f32x4*)(CB1 + c * 128 + c4);
#pragma unroll
              for (int w = 0; w < 8; ++w) s += *(const f32x4*)(part + (w * 16 + row) * 128 + c4);
              *(v2u*)(hid + row * 128 + c4) = (v2u){pk2(gelu_tanh(s.x), gelu_tanh(s.y)), pk2(gelu_tanh(s.z), gelu_tanh(s.w))}; }
            __syncthreads();
            { f32x4 o4 = {0.f, 0.f, 0.f, 0.f}; const bf16* w2t = W2T + (size_t)c * 128 * 128 + (size_t)(F.wave * 16 + fr) * 128 + fq * 8;
#pragma unroll
              for (int ks = 0; ks < 4; ++ks) { const bfx8 af = *(const bfx8*)(hid + fr * 128 + ks * 32 + fq * 8); const bfx8 bfr = *(const bfx8*)(w2t + ks * 32); o4 = __builtin_amdgcn_mfma_f32_16x16x32_bf16(af, bfr, o4, 0, 0, 0); }
              bf16* outp = (c ? VC : KC) + (((size_t)b * 2 + g) * 256) * 128 + F.wave * 16 + fr;
#pragma unroll
              for (int j = 0; j < 4; ++j) { const int n = n0 + fq * 4 + j; outp[(size_t)n * 128] = n < 255 ? (bf16)f2bf(o4[j]) : (bf16)0; } }
            __syncthreads();
        }
#if FLASH_WIN
        __syncthreads();
        for (int Lx = blockIdx.x; Lx < 512; Lx += F.G) {
            const int qb = 15 - Lx / 32, bh = Lx % 32, b = bh >> 3, h = bh & 7, g = h >> 2; const bf16* zb = Z0 + (size_t)b * S * Z0W;
            fa::Item it{}; it.Q = zb + Z_NQ + h * 128; it.qs = Z0W; it.K = zb + Z_NKV + 4 * 256 + g * 128; it.ks = Z0W; it.V = zb + Z_NKV + 5 * 256 + g * 128; it.vs = Z0W;
            it.P0 = qb * 256; it.skv = S; it.W = 512; it.bias = BIAS + (size_t)h * BIAS_LD + 64; it.bstep = 1; it.O = OWIN + (size_t)b * S * 1024 + h * 128; it.os = 1024;
            fa::attn_block<0>(it, lds);
        }
#else
        __syncthreads();
        for (int it = F.gw; it < M * 8; it += F.NGW) {
            const int h = it & 7, m = it >> 3, b = m / S, s = m % S, g = h >> 2;
            const bf16* qr = Z0 + (size_t)m * Z0W + Z_NQ + h * 128; wsm[2 * F.lane] = bf2f(qr[2 * F.lane]); wsm[2 * F.lane + 1] = bf2f(qr[2 * F.lane + 1]); LDS_WAIT(); asm volatile("" ::: "memory");
            const int t0 = s - 511 < 0 ? 0 : s - 511; NA a;
            a.k = Z0 + (size_t)b * S * Z0W + Z_NKV + 4 * 256 + g * 128; a.kstride = Z0W; a.k2 = nullptr; a.k2stride = 0; a.dq = 128; a.dq2 = 0;
            a.v = Z0 + (size_t)b * S * Z0W + Z_NKV + 5 * 256 + g * 128; a.vstride = Z0W; a.t0 = t0; a.tstep = 1; a.nk = s - t0 + 1;
            a.bias = BIAS + (size_t)h * BIAS_LD + 64; a.brel0 = s - t0; a.bstep = 1; a.scale = 0.08838834764831845f; a.cmask = 0; a.use_sel = 0;
            float mx, sum, o0, o1; na_run(a, wsm, wsc, F.lane, mx, sum, o0, o1);
            *(unsigned*)(OWIN + (size_t)m * 1024 + h * 128 + 2 * F.lane) = pk2(o0 / sum, o1 / sum);
        }
#endif
    }
    SEAM(3);
    REPK(4) if (IN(4)) {
        { pg8::Gemm g{Z0 + Z_QLAT, W_UQ, Z0W, 512, 512}; pg8::StaticOrder So; So.init(M, QMW, F.G, (int)blockIdx.x); pg8::EpiBf16 E{QM, QMW, RINV};
          pg8::gemm_phase<pg8::EpiBf16, pg8::StaticOrder, PG_ALIGN, PG_SP2>(ring, g, So, E); }
        __syncthreads();
        { pg8::Gemm g{Z0 + Z_KVLAT, W_UKV, Z0W, 512, 512}; pg8::StaticOrder So; So.init(M, KVMW, F.G, (int)blockIdx.x); pg8::EpiBf16 E{KVM, KVMW, RINV + M};
          pg8::gemm_phase<pg8::EpiBf16, pg8::StaticOrder, PG_ALIGN, PG_SP2>(ring, g, So, E); }
        __syncthreads();
#if FLASH_CMP != 1
        for (int it = F.gw; it < M * 2; it += F.NGW) {
            const int g = it & 1, m = it >> 1, b = m / S, s = m % S;
            const int nk = s >= 31 ? (s - 31) / 16 + 1 : 0;
            float* imp = wsm + 256;
            for (int i = F.lane; i < 256; i += 64) imp[i] = 0.f;
            for (int r = 0; r < 4; ++r) { const int h = g * 4 + r;
                const bf16* qr = Z0 + (size_t)m * Z0W + Z_NQ + h * 128; wsm[2 * F.lane] = bf2f(qr[2 * F.lane]); wsm[2 * F.lane + 1] = bf2f(qr[2 * F.lane + 1]); LDS_WAIT(); asm volatile("" ::: "memory");
                float o0 = 0.f, o1 = 0.f;
                if (nk > 0) { NA a; a.k = KC + ((size_t)b * 2 + g) * 256 * 128; a.kstride = 128; a.k2 = nullptr; a.k2stride = 0; a.dq = 128; a.dq2 = 0; a.v = VC + ((size_t)b * 2 + g) * 256 * 128; a.vstride = 128;
                    a.t0 = 0; a.tstep = 1; a.nk = nk; a.bias = BIAS + (size_t)h * BIAS_LD + 64; a.brel0 = s - 31; a.bstep = 16; a.scale = 0.08838834764831845f; a.cmask = 0; a.use_sel = 0;
                    float mx, sum; na_run(a, wsm, wsc, F.lane, mx, sum, o0, o1); const float inv = 1.0f / sum; o0 *= inv; o1 *= inv;
                    for (int i = F.lane; i < nk; i += 64) imp[i] += wsc[i] * inv; LDS_WAIT(); asm volatile("" ::: "memory"); }
                *(unsigned*)(OCMP + (size_t)m * 1024 + h * 128 + 2 * F.lane) = pk2(o0, o1);
            }
            const int j = F.lane, blk_t = s >> 6;
            float sc;
            { const float pm1 = (4 * j - 1 >= 0) ? imp[4 * j - 1] : 0.f, p0 = imp[4 * j], p1 = imp[4 * j + 1], p2 = imp[4 * j + 2], p3 = (4 * j + 3 < 255) ? imp[4 * j + 3] : 0.f;
              const float is = ((((((p0 + pm1) + p1) + p0) + p2) + p1) + p3) + p2;
              const bool forced = (j == 0) || (j == blk_t) || (j == blk_t - 1), valid = j <= blk_t;
              sc = forced ? 1e9f : (valid ? is : -1.0f); }
            int rank = 0;
            for (int k = 0; k < 64; ++k) { const float vk = __shfl(sc, k); rank += (vk > sc || (vk == sc && k < j)) ? 1 : 0; }
            const unsigned long long msk = __ballot(rank < 16 && sc > -0.5f);
            if (F.lane == 0) SEL[(size_t)m * 2 + g] = msk;
            asm volatile("" ::: "memory");
        }
        __syncthreads();
#endif
#if FLASH_CMP
        for (int Lx = blockIdx.x; Lx < 512; Lx += F.G) { const int tb = 63 - Lx / 8, bg = Lx % 8, b = bg >> 1, g = bg & 1;
            fa::CmpItem it; it.Q = Z0 + ((size_t)b * S + tb * 64) * Z0W + Z_NQ + g * 512; it.qs = Z0W; it.K = KC + ((size_t)b * 2 + g) * 256 * 128; it.V = VC + ((size_t)b * 2 + g) * 256 * 128;
            it.bias = BIAS + (size_t)(g * 4) * BIAS_LD + 64; it.bld = BIAS_LD; it.s0 = tb * 64; it.O = OCMP + ((size_t)b * S + tb * 64) * 1024 + g * 512; it.os = 1024; it.sel = SEL + ((size_t)b * S + tb * 64) * 2 + g;

            fa::cmp_block(it, lds, SMALL_OFF); }
#endif
    }
    SEAM(4);
    REPK(5) if (IN(5)) {
#if FLASH_SLC != 1
        for (int it = F.gw; it < M * 8; it += F.NGW) {
            const int h = it & 7, m = it >> 3, b = m / S, s = m % S, g = h >> 2;
            const bf16* zr = Z0 + (size_t)m * Z0W; const bf16* qr = zr + Z_NQ + h * 128; wsm[2 * F.lane] = bf2f(qr[2 * F.lane]); wsm[2 * F.lane + 1] = bf2f(qr[2 * F.lane + 1]); LDS_WAIT(); asm volatile("" ::: "memory");
            NA a; a.k = Z0 + (size_t)b * S * Z0W + Z_NKV + 2 * 256 + g * 128; a.kstride = Z0W; a.k2 = nullptr; a.k2stride = 0; a.dq = 128; a.dq2 = 0;
            a.v = Z0 + (size_t)b * S * Z0W + Z_NKV + 3 * 256 + g * 128; a.vstride = Z0W; a.t0 = 0; a.tstep = 1; a.nk = s + 1;
            a.bias = BIAS + (size_t)h * BIAS_LD + 64; a.brel0 = s; a.bstep = 1; a.scale = 0.08838834764831845f; a.cmask = SEL[(size_t)m * 2 + g]; a.use_sel = FA_DBG_NOSEL ? 0 : 1;
            float mx, sum, o0, o1; na_run(a, wsm, wsc, F.lane, mx, sum, o0, o1); o0 /= sum; o1 /= sum;
            const float g0 = sigmoid_f(bf2f(zr[Z_NG + h * 3 + 0])), g1 = sigmoid_f(bf2f(zr[Z_NG + h * 3 + 1])), g2 = sigmoid_f(bf2f(zr[Z_NG + h * 3 + 2]));
            const unsigned wc_ = *(const unsigned*)(OCMP + (size_t)m * 1024 + h * 128 + 2 * F.lane), ww_ = *(const unsigned*)(OWIN + (size_t)m * 1024 + h * 128 + 2 * F.lane);
            *(unsigned*)(CAT + (size_t)m * 2048 + h * 128 + 2 * F.lane) = FA_DBG_NOMERGE ? pk2(o0, o1) : pk2(g0 * bflo(wc_) + g1 * o0 + g2 * bflo(ww_), g0 * bfhi(wc_) + g1 * o1 + g2 * bfhi(ww_));
        }
        __syncthreads();
#endif
#if FLASH_SLC == 2
        __syncthreads();
#endif
#if FLASH_SLC
        for (int Lx = blockIdx.x; Lx < 256; Lx += F.G) {
            const int x = Lx / 32, bh = Lx % 32, b = bh >> 3, h = bh & 7, g = h >> 2; const bf16* zb = Z0 + (size_t)b * S * Z0W;
            for (int pass = 0; pass < 2; ++pass) { const int qb = pass ? 15 - x : x;
                fa::Item it{}; it.Q = zb + Z_NQ + h * 128; it.qs = Z0W; it.K = zb + Z_NKV + 2 * 256 + g * 128; it.ks = Z0W; it.V = zb + Z_NKV + 3 * 256 + g * 128; it.vs = Z0W;
                it.P0 = qb * 256; it.skv = S; it.W = 1 << 20; it.bias = BIAS + (size_t)h * BIAS_LD + 64; it.bstep = 1; it.sel = SEL + (size_t)b * S * 2 + g; it.sels = 2;
                it.O = CAT + (size_t)b * S * 2048 + h * 128; it.os = 2048;
#if FLASH_SLC == 2
                it.O = (bf16*)(ws + WS_R + 296 * MiB) + (size_t)b * S * 1024 + h * 128; it.os = 1024;
#endif
                it.M0 = OCMP + (size_t)b * S * 1024 + h * 128; it.M1 = OWIN + (size_t)b * S * 1024 + h * 128; it.ms = 1024; it.G = zb + Z_NG + h * 3; it.gs = Z0W;
                fa::attn_block<1>(it, lds); }
        }
#endif
#if FLASH_MLA
        for (int Lx = blockIdx.x; Lx < 256; Lx += F.G) {
            const int x = Lx / 32, bh = Lx % 32, b = bh >> 3, h = bh & 7;
            for (int pass = 0; pass < 2; ++pass) { const int qb = pass ? 15 - x : x;
                fa::Item it{}; it.Q = QM + (size_t)b * S * QMW + h * 192; it.qs = QMW; it.rope = ROPE + (size_t)b * S * 64; it.ropes = 64;
                it.K = KVM + (size_t)b * S * KVMW + h * 256; it.ks = KVMW; it.K2 = KPE + (size_t)b * S * 64; it.k2s = 64; it.V = KVM + (size_t)b * S * KVMW + h * 256 + 128; it.vs = KVMW;
                it.P0 = qb * 256; it.skv = S; it.W = 1 << 20; it.O = CAT + (size_t)b * S * 2048 + 1024 + h * 128; it.os = 2048;
                fa::attn_block<2>(it, lds); }
        }
#else
        for (int it = F.gw; it < M * 8; it += F.NGW) {
            const int h = it & 7, m = it >> 3, b = m / S, s = m % S;
            const bf16* qr = QM + (size_t)m * QMW + h * 192;
            wsm[2 * F.lane] = bf2f(qr[2 * F.lane]); wsm[2 * F.lane + 1] = bf2f(qr[2 * F.lane + 1]);
            if (F.lane < 32) { const float x1 = bf2f(qr[128 + F.lane]), x2 = bf2f(qr[160 + F.lane]); const float cs = ROPE[(size_t)m * 64 + F.lane], sn = ROPE[(size_t)m * 64 + 32 + F.lane];
                wsm[128 + F.lane] = x1 * cs - x2 * sn; wsm[160 + F.lane] = x2 * cs + x1 * sn; }
            LDS_WAIT(); asm volatile("" ::: "memory");
            NA a; a.k = KVM + (size_t)b * S * KVMW + h * 256; a.kstride = KVMW; a.k2 = KPE + (size_t)b * S * 64; a.k2stride = 64; a.dq = 128; a.dq2 = 64;
            a.v = KVM + (size_t)b * S * KVMW + h * 256 + 128; a.vstride = KVMW; a.t0 = 0; a.tstep = 1; a.nk = s + 1; a.bias = nullptr; a.brel0 = 0; a.bstep = 0; a.scale = 0.07216878364870322f; a.cmask = 0; a.use_sel = 0;
            float mx, sum, o0, o1; na_run(a, wsm, wsc, F.lane, mx, sum, o0, o1);
            *(unsigned*)(CAT + (size_t)m * 2048 + 1024 + h * 128 + 2 * F.lane) = pk2(o0 / sum, o1 / sum);
        }
#endif
    }
    SEAM(5);
    REPK(6) if (IN(6)) { pg8::Gemm g{CAT, W_OUT0, 2048, 2048, 2048}; pg8::StaticOrder So; So.init(M, D, F.G, (int)blockIdx.x); pg8::EpiResid E{x_in, X, D, MOD + 2 * D, 6 * D, S / 256};
        pg8::gemm_phase<pg8::EpiResid, pg8::StaticOrder, PG_ALIGN, PG_SP2>(ring, g, So, E); }
    SEAM(6);
    REPK(7) if (IN(7)) modnorm_phase(F, X, ffn_norm_g, MOD, 3, H);
    SEAM(7);
    REPK(8) if (IN(8)) { pg8::Gemm g{H, W_GU0, D, D, D}; pg8::StaticOrder So; So.init(M, 2 * FF, F.G, (int)blockIdx.x); pg8::EpiSwiGLU E{ACT, FF};
        pg8::gemm_phase<pg8::EpiSwiGLU, pg8::StaticOrder, PG_ALIGN, PG_SP2>(ring, g, So, E); }
    SEAM(8);
    REPK(9) if (IN(9)) { pg8::Gemm g{ACT, W_DN0, FF, FF, FF}; pg8::StaticOrder So; So.init(M, D, F.G, (int)blockIdx.x); pg8::EpiResid E{X, X, D, MOD + 5 * D, 6 * D, S / 256};
        pg8::gemm_phase<pg8::EpiResid, pg8::StaticOrder, PG_ALIGN, PG_SP2>(ring, g, So, E); }
    SEAM(9);
    REPK(10) if (IN(10)) modnorm_phase(F, X, mix_norm_g + D, MOD + 4 * 12288, 0, H);
    SEAM(10);
    REPK(11) if (IN(11)) { pg8::Gemm g{H, W_IN1, D, D, D}; pg8::StaticOrder So; So.init(M, Z1W, F.G, (int)blockIdx.x); pg8::EpiBf16 E{Z1, Z1W, nullptr};
        pg8::gemm_phase<pg8::EpiBf16, pg8::StaticOrder, PG_ALIGN, PG_SP2>(ring, g, So, E); }
    SEAM(11);
#if FLASH_DIL
    REPK(12) if (IN(12)) {
        for (int Lx = blockIdx.x; Lx < 1536; Lx += F.G) {
            const int p = Lx % 3, r_ = Lx / 3, bh = r_ % 32, sub = r_ / 32, b = bh >> 3, h = bh & 7;
            const int dil = p == 0 ? 1 : (p == 1 ? 4 : 16), res = p == 0 ? 0 : (p == 1 ? (sub & 3) : sub), qb = p == 0 ? sub : (p == 1 ? (sub >> 2) : 0);
            fa::Item it{}; it.Q = Z1 + ((size_t)b * S + res) * Z1W + p * 3072 + h * 128; it.qs = (long)dil * Z1W; it.K = it.Q + 1024; it.ks = it.qs; it.V = it.Q + 2048; it.vs = it.qs;
            it.P0 = qb * 256; it.skv = S / dil; it.W = 129; it.bias = BIAS + (size_t)h * BIAS_LD + 64; it.bstep = dil;
            it.O = OP + (size_t)p * M * 1024 + ((size_t)b * S + res) * 1024 + h * 128; it.os = (long)dil * 1024; it.LSE = LSEB + (size_t)p * M * 8 + ((size_t)b * S + res) * 8 + h; it.lses = (long)dil * 8;
            fa::attn_block<0>(it, lds);
        }
    }
#else
    REPK(12) if (IN(12)) {
        for (int it = F.gw; it < M * 8; it += F.NGW) {
            const int h = it & 7, m = it >> 3, b = m / S, s = m % S;
            float om0 = 0.f, om1 = 0.f, lm = -3.0e38f, wsum = 0.f;
#pragma unroll
            for (int p = 0; p < 3; ++p) { const int dil = p == 0 ? 1 : (p == 1 ? 4 : 16);
                const bf16* qr = Z1 + (size_t)m * Z1W + p * 3072 + h * 128; wsm[2 * F.lane] = bf2f(qr[2 * F.lane]); wsm[2 * F.lane + 1] = bf2f(qr[2 * F.lane + 1]); LDS_WAIT(); asm volatile("" ::: "memory");
                const int mq = s / dil, r = s % dil, m0 = mq - 128 < 0 ? 0 : mq - 128;
                NA a; a.k = Z1 + (size_t)b * S * Z1W + p * 3072 + 1024 + h * 128; a.kstride = Z1W; a.k2 = nullptr; a.k2stride = 0; a.dq = 128; a.dq2 = 0;
                a.v = Z1 + (size_t)b * S * Z1W + p * 3072 + 2048 + h * 128; a.vstride = Z1W; a.t0 = m0 * dil + r; a.tstep = dil; a.nk = mq - m0 + 1;
                a.bias = BIAS + (size_t)h * BIAS_LD + 64; a.brel0 = (mq - m0) * dil; a.bstep = dil; a.scale = 0.08838834764831845f; a.cmask = 0; a.use_sel = 0;
                float mx, sum, o0, o1; na_run(a, wsm, wsc, F.lane, mx, sum, o0, o1);
                const float lse = mx + __logf(sum); o0 /= sum; o1 /= sum;
                const float nm = fmaxf(lm, lse), ea = __expf(lm - nm), eb = __expf(lse - nm);
                om0 = om0 * ea + o0 * eb; om1 = om1 * ea + o1 * eb; wsum = wsum * ea + eb; lm = nm; }
            *(unsigned*)(OM + (size_t)m * 1024 + h * 128 + 2 * F.lane) = pk2(om0 / wsum, om1 / wsum);
        }
    }
#endif
    SEAM(12);
    REPK(13) if (IN(13) && FLASH_DIL) {
        for (int m = F.gw; m < M; m += F.NGW) {
#pragma unroll 2
            for (int h = 0; h < 8; ++h) { const float l0 = LSEB[(size_t)m * 8 + h], l1 = LSEB[(size_t)(M + m) * 8 + h], l2 = LSEB[(size_t)(2 * M + m) * 8 + h];
                const float mx = fmaxf(l0, fmaxf(l1, l2)), e0 = __expf(l0 - mx), e1 = __expf(l1 - mx), e2 = __expf(l2 - mx), inv = 1.0f / (e0 + e1 + e2);
                const unsigned a0 = *(const unsigned*)(OP + (size_t)m * 1024 + h * 128 + 2 * F.lane), a1 = *(const unsigned*)(OP + (size_t)(M + m) * 1024 + h * 128 + 2 * F.lane), a2 = *(const unsigned*)(OP + (size_t)(2 * M + m) * 1024 + h * 128 + 2 * F.lane);
                *(unsigned*)(OM + (size_t)m * 1024 + h * 128 + 2 * F.lane) = pk2((e0 * bflo(a0) + e1 * bflo(a1) + e2 * bflo(a2)) * inv, (e0 * bfhi(a0) + e1 * bfhi(a1) + e2 * bfhi(a2)) * inv); }
        }
    }
    SEAM(13);
    REPK(14) if (IN(14)) { pg8::Gemm g{OM, W_OUT1, 1024, 1024, 1024}; pg8::StaticOrder So; So.init(M, D, F.G, (int)blockIdx.x); pg8::EpiResid E{X, X, D, MOD + 4 * 12288 + 2 * D, 6 * D, S / 256};
        pg8::gemm_phase<pg8::EpiResid, pg8::StaticOrder, PG_ALIGN, PG_SP2>(ring, g, So, E); }
    SEAM(14);
    REPK(15) if (IN(15)) {
        f32x4* wl = (f32x4*)lds; int* lcnt = (int*)(lds + 65536); int* lbase = lcnt + 8; int* rinfo = lcnt + 16;
        for (int i = F.tid; i < 4096; i += 512) { const int slot = i >> 6, l = i & 63, j = slot >> 3, q = (slot >> 1) & 3, half = slot & 1; wl[i] = *(const f32x4*)(w_router + (size_t)(4 * l + 256 * j + q) * 8 + half * 4); }
        if (F.tid < 8) lcnt[F.tid] = 0;
        __syncthreads();
        for (int k = 0; k < M / 2048; ++k) { const int m = F.gw + k * F.NGW; if (m >= M) break; const int b = m / S; const float* mb = MOD + 4 * 12288 + (size_t)b * 6 * D; f32x4 v[8];
            modnorm_row(X + (size_t)m * D, ffn_norm_g + D, mb + 4 * D, mb + 3 * D, H + (size_t)m * D, F.lane, v);
            float lg[8] = {};
#pragma unroll
            for (int j = 0; j < 8; ++j)
#pragma unroll
                for (int q = 0; q < 4; ++q) { const f32x4 wa = wl[((j * 4 + q) * 2 + 0) * 64 + F.lane], wb = wl[((j * 4 + q) * 2 + 1) * 64 + F.lane]; const float hv = v[j][q];
                    lg[0] += hv * wa.x; lg[1] += hv * wa.y; lg[2] += hv * wa.z; lg[3] += hv * wa.w; lg[4] += hv * wb.x; lg[5] += hv * wb.y; lg[6] += hv * wb.z; lg[7] += hv * wb.w; }
#pragma unroll
            for (int e = 0; e < 8; ++e) lg[e] = wave_sum(lg[e]);
            int e1 = 0; float v1 = lg[0];
#pragma unroll
            for (int e = 1; e < 8; ++e) if (lg[e] > v1) { v1 = lg[e]; e1 = e; }
            int e2 = -1; float v2 = -3.0e38f;
#pragma unroll
            for (int e = 0; e < 8; ++e) if (e != e1 && lg[e] > v2) { v2 = lg[e]; e2 = e; }
            if (F.lane == 0) { const float g1 = 1.0f / (1.0f + __expf(v2 - v1)), g2 = 1.0f - g1;
                const int r1 = __hip_atomic_fetch_add(lcnt + e1, 1, __ATOMIC_RELAXED, __HIP_MEMORY_SCOPE_WORKGROUP), r2 = __hip_atomic_fetch_add(lcnt + e2, 1, __ATOMIC_RELAXED, __HIP_MEMORY_SCOPE_WORKGROUP);
                int* ri = rinfo + (F.wave * 8 + k) * 8; ri[0] = e1; ri[1] = e2; ri[2] = r1; ri[3] = r2; ri[4] = __float_as_int(g1); ri[5] = __float_as_int(g2); }
        }
        __syncthreads();
        if (F.tid < 8) lbase[F.tid] = (int)atomicAdd(ctl + CW_CNT + F.tid, (unsigned)lcnt[F.tid]);
        __syncthreads();
        if (F.lane == 0) for (int k = 0; k < M / 2048; ++k) { const int m = F.gw + k * F.NGW; if (m >= M) break; const int* ri = rinfo + (F.wave * 8 + k) * 8; int* rt = ROUTE + (size_t)m * 8;
            rt[0] = ri[0]; rt[1] = ri[1]; rt[2] = ri[2] + lbase[ri[0]]; rt[3] = ri[3] + lbase[ri[1]]; rt[4] = ri[4]; rt[5] = ri[5]; }
    }
    SEAM(15);
    REPK(16) if (IN(16)) {
        unsigned ts[9]; ts[0] = 0;
#pragma unroll
        for (int e = 0; e < 8; ++e) ts[e + 1] = ts[e] + (__hip_atomic_load(ctl + CW_CNT + e, __ATOMIC_RELAXED, __HIP_MEMORY_SCOPE_AGENT) + 255u) / 256u;
        if (blockIdx.x == 0 && F.tid < 9) { unsigned v = ts[0];
#pragma unroll
            for (int e = 1; e < 9; ++e) v = (F.tid == e) ? ts[e] : v;
            ctl[CW_TS + F.tid] = v; }
        for (int m = F.gw; m < M; m += F.NGW) { const int* rt = ROUTE + (size_t)m * 8; const int e1 = rt[0], e2 = rt[1]; unsigned t1 = 0, t2 = 0;
#pragma unroll
            for (int e = 0; e < 8; ++e) { t1 = (e == e1) ? ts[e] : t1; t2 = (e == e2) ? ts[e] : t2; }
            const size_t d1 = (size_t)t1 * 256 + rt[2], d2 = (size_t)t2 * 256 + rt[3];
            const v4u* src = (const v4u*)(H + (size_t)m * D) + F.lane;
#if MOE_F8
            v2u* o1 = (v2u*)((unsigned char*)XB + d1 * D) + F.lane; v2u* o2 = (v2u*)((unsigned char*)XB + d2 * D) + F.lane;
#pragma unroll
            for (int j = 0; j < 4; ++j) { const v4u w = src[64 * j]; v2u q; q.x = pk4_fp8(bflo(w.x), bfhi(w.x), bflo(w.y), bfhi(w.y)); q.y = pk4_fp8(bflo(w.z), bfhi(w.z), bflo(w.w), bfhi(w.w)); o1[64 * j] = q; o2[64 * j] = q; } }
#else
            v4u* o1 = (v4u*)(XB + d1 * D) + F.lane; v4u* o2 = (v4u*)(XB + d2 * D) + F.lane;
#pragma unroll
            for (int j = 0; j < 4; ++j) { const v4u w = src[64 * j]; o1[64 * j] = w; o2[64 * j] = w; } }
#endif
    }
    SEAM(16);
#if MOE_F8
    REPK(17) if (IN(17)) { pg8::Gemm g{XB, W_MGU, D / 2, D / 2, D / 2}; pg8::GroupedOrder So; So.init(ctl + CW_TS, 2 * FFE / 128, F.G, (int)blockIdx.x); pg8::EpiSwiGLUH E{ACTB, (MOE_F8 >= 2) ? (unsigned char*)ACTB : nullptr, FFE, 1.0f / MOE_WSCALE, MOE_ASCALE};
        pg8::gemm_phase<pg8::EpiSwiGLUH, pg8::GroupedOrder, PG_ALIGN, PG_SP2, true>(ring, g, So, E); }
#else
    REPK(17) if (IN(17)) { pg8::Gemm g{XB, W_MGU, D, D, D}; pg8::GroupedOrder So; So.init(ctl + CW_TS, 2 * FFE / 256, F.G, (int)blockIdx.x); pg8::EpiSwiGLU E{ACTB, FFE};
        pg8::gemm_phase<pg8::EpiSwiGLU, pg8::GroupedOrder, PG_ALIGN, PG_SP2>(ring, g, So, E); }
#endif
    SEAM(17);
#if MOE_F8 >= 2
    REPK(18) if (IN(18)) { pg8::Gemm g{ACTB, W_MDN, FFE / 2, FFE / 2, FFE / 2}; pg8::GroupedOrder So; So.init(ctl + CW_TS, D / 128, F.G, (int)blockIdx.x); pg8::EpiBf16H E{YB, D, 1.0f / (MOE_WSCALE * MOE_ASCALE)};
        pg8::gemm_phase<pg8::EpiBf16H, pg8::GroupedOrder, PG_ALIGN, PG_SP2, true>(ring, g, So, E); }
#else
    REPK(18) if (IN(18)) { pg8::Gemm g{ACTB, W_MDN, FFE, FFE, FFE}; pg8::GroupedOrder So; So.init(ctl + CW_TS, D / 256, F.G, (int)blockIdx.x); pg8::EpiBf16 E{YB, D, nullptr};
        pg8::gemm_phase<pg8::EpiBf16, pg8::GroupedOrder, PG_ALIGN, PG_SP2>(ring, g, So, E); }
#endif
    SEAM(18);
    REPK(19) if (IN(19)) {
        unsigned ts[9]; ts[0] = 0;
#pragma unroll
        for (int e = 0; e < 8; ++e) ts[e + 1] = ctl[CW_TS + e + 1];
#pragma unroll
        for (int b = 0; b < NB; ++b) {
            const float* gf = MOD + 4 * 12288 + (size_t)b * 6 * D + 5 * D;
            const int m0 = b * S + F.gw, m1 = m0 + F.NGW;
            const int* rt0 = ROUTE + (size_t)m0 * 8; const int* rt1 = ROUTE + (size_t)m1 * 8;
            const int e10 = rt0[0], e20 = rt0[1], r10 = rt0[2], r20 = rt0[3], e11 = rt1[0], e21 = rt1[1], r11 = rt1[2], r21 = rt1[3];
            const float g10 = __int_as_float(rt0[4]), g20 = __int_as_float(rt0[5]), g11 = __int_as_float(rt1[4]), g21 = __int_as_float(rt1[5]);
            unsigned t10 = 0, t20 = 0, t11 = 0, t21 = 0;
#pragma unroll
            for (int e = 0; e < 8; ++e) { t10 = (e == e10) ? ts[e] : t10; t20 = (e == e20) ? ts[e] : t20; t11 = (e == e11) ? ts[e] : t11; t21 = (e == e21) ? ts[e] : t21; }
            const v2u* ya0 = (const v2u*)(YB + ((size_t)t10 * 256 + r10) * D) + F.lane; const v2u* yb0 = (const v2u*)(YB + ((size_t)t20 * 256 + r20) * D) + F.lane;
            const v2u* ya1 = (const v2u*)(YB + ((size_t)t11 * 256 + r11) * D) + F.lane; const v2u* yb1 = (const v2u*)(YB + ((size_t)t21 * 256 + r21) * D) + F.lane;
            const f32x4* x0 = (const f32x4*)(X + (size_t)m0 * D) + F.lane; const f32x4* x1 = (const f32x4*)(X + (size_t)m1 * D) + F.lane;
            f32x4 v0[8], v1[8]; v2u a0[8], c0[8], a1[8], c1[8];
#pragma unroll
            for (int j = 0; j < 8; ++j) { v0[j] = x0[64 * j]; v1[j] = x1[64 * j]; a0[j] = ya0[64 * j]; c0[j] = yb0[64 * j]; a1[j] = ya1[64 * j]; c1[j] = yb1[64 * j]; }
            float q0 = 0.f, q1 = 0.f;
#pragma unroll
            for (int j = 0; j < 8; ++j) { const f32x4 gg = ((const f32x4*)gf)[F.lane + 64 * j]; f32x4 y;
                y.x = g10 * bflo(a0[j].x) + g20 * bflo(c0[j].x); y.y = g10 * bfhi(a0[j].x) + g20 * bfhi(c0[j].x); y.z = g10 * bflo(a0[j].y) + g20 * bflo(c0[j].y); y.w = g10 * bfhi(a0[j].y) + g20 * bfhi(c0[j].y);
                v0[j] = v0[j] + gg * y; q0 += (v0[j].x * v0[j].x + v0[j].y * v0[j].y) + (v0[j].z * v0[j].z + v0[j].w * v0[j].w);
                y.x = g11 * bflo(a1[j].x) + g21 * bflo(c1[j].x); y.y = g11 * bfhi(a1[j].x) + g21 * bfhi(c1[j].x); y.z = g11 * bflo(a1[j].y) + g21 * bflo(c1[j].y); y.w = g11 * bfhi(a1[j].y) + g21 * bfhi(c1[j].y);
                v1[j] = v1[j] + gg * y; q1 += (v1[j].x * v1[j].x + v1[j].y * v1[j].y) + (v1[j].z * v1[j].z + v1[j].w * v1[j].w); }
            const float ri0 = 1.0f / sqrtf(wave_sum(q0) * (1.f / D) + RMS_EPS), ri1 = 1.0f / sqrtf(wave_sum(q1) * (1.f / D) + RMS_EPS);
            f32x4* o0 = (f32x4*)(args.out + (size_t)m0 * D) + F.lane; f32x4* o1 = (f32x4*)(args.out + (size_t)m1 * D) + F.lane;
#pragma unroll
            for (int j = 0; j < 8; ++j) { const f32x4 fg = ((const f32x4*)final_g)[F.lane + 64 * j]; o0[64 * j] = (v0[j] * ri0) * fg; o1[64 * j] = (v1[j] * ri1) * fg; }
        }
    }
    if ((PROBE_MASK >> 19) & 1) { __syncthreads(); const unsigned long long t1_ = wall_clock64(); while (wall_clock64() < t1_ + (t1_ - tprev_)) __builtin_amdgcn_s_sleep(8); }
#undef IN
#undef SEAM
}

constexpr int N_PHASES = 20;
extern "C" void kernel_launch(void* const* d_in, const int* in_sizes, int n_in, void* d_out, int out_size, void* d_ws, size_t ws_size, hipStream_t stream) {
    static int grid = 0;
    if (grid == 0) {
        if (n_in != 30 || in_sizes[0] != M * D || out_size != M * D || ws_size < WS_END) { fprintf(stderr, "kernel_launch: shape/workspace mismatch: n_in %d in0 %d out %d ws %zu (need %zu)\n", n_in, n_in > 0 ? in_sizes[0] : -1, out_size, ws_size, (size_t)WS_END); grid = -1; return; }
        int dev = 0, cus = 0, per_cu = 0;
        if (hipGetDevice(&dev) != hipSuccess || hipDeviceGetAttribute(&cus, hipDeviceAttributeMultiprocessorCount, dev) != hipSuccess) { grid = -1; return; }
        if (hipFuncSetAttribute((const void*)fwd, hipFuncAttributeMaxDynamicSharedMemorySize, LDS_BYTES) != hipSuccess) { fprintf(stderr, "kernel_launch: hipFuncSetAttribute failed\n"); grid = -1; return; }
        if (hipOccupancyMaxActiveBlocksPerMultiprocessor(&per_cu, (const void*)fwd, NWAVES * 64, LDS_BYTES) != hipSuccess || per_cu < 1) fprintf(stderr, "kernel_launch: occupancy query reports %d\n", per_cu);
        (void)hipGetLastError();
        grid = cus;
        if (grid != 256) { fprintf(stderr, "kernel_launch: built for a 256-CU device (got %d)\n", cus); grid = -1; return; }
    }
    if (grid < 0) return;
    if (hipMemsetAsync((char*)d_ws + WS_CTL, 0, CTL_ZERO_BYTES, stream) != hipSuccess) return;
    Args a{};
    for (int i = 0; i < 30; ++i) a.in[i] = d_in[i];
    a.out = (float*)d_out; a.ws = (unsigned char*)d_ws;
    if (MK_N_LAUNCHES == 1) { a.ph_lo = 0; a.ph_hi = N_PHASES; hipLaunchKernelGGL(fwd, dim3(grid), dim3(NWAVES * 64), LDS_BYTES, stream, a); }
    else { for (int p = 0; p < N_PHASES; ++p) { a.ph_lo = p; a.ph_hi = p + 1; hipLaunchKernelGGL(fwd, dim3(grid), dim3(NWAVES * 64), LDS_BYTES, stream, a); } }
    const hipError_t le = hipPeekAtLastError();
    if (le != hipSuccess) fprintf(stderr, "kernel_launch: launch failed: %s\n", hipGetErrorName(le));
}
```

```cpp
#include <hip/hip_runtime.h>
#include <cstdio>
#include <cstdint>

#define WGM_G 4
#define PG_ALIGN true
#define PG_SP2 true
#ifndef MK_N_LAUNCHES
#define MK_N_LAUNCHES 1
#endif

namespace pg8 {
#define PG8_LAS __attribute__((address_space(3)))
typedef unsigned short bf16_t;
typedef short bf16x8 __attribute__((ext_vector_type(8)));
typedef float f32x4 __attribute__((ext_vector_type(4)));
typedef float f32x2 __attribute__((ext_vector_type(2)));
typedef unsigned u32x4 __attribute__((ext_vector_type(4)));
typedef unsigned u32x2 __attribute__((ext_vector_type(2)));
constexpr int BM = 256, BK = 64, HALF = 128, HTB = HALF * BK * 2  , STAGE_BYTES = 8 * HTB, NXCD = 8, WGM = 8;

__host__ __device__ __forceinline__ int lds_byte(int r, int c) { const int st = (r >> 4) * 2 + (c >> 5), rr = r & 15, cc = c & 31, ob = rr * 64 + cc * 2; return st * 1024 + (ob ^ (((ob >> 9) & 1) << 5)); }
__host__ __device__ __forceinline__ void stage_rc(int b, int& R, int& C) { const int st = b / 1024, sb = b % 1024, swz = sb ^ (((sb >> 9) & 1) << 5); R = (st >> 1) * 16 + swz / 64; C = (st & 1) * 32 + (swz % 64) / 2; }
__host__ __device__ __forceinline__ int perm32(int rho) { const int n = rho >> 4, i = rho & 15; return 8 * (i >> 2) + 4 * n + (i & 3); }

struct Unit { int pm, pn, pb; };
struct Gemm { const bf16_t* A; const bf16_t* Bt; int lda, ldb, K; };

struct StaticOrder {
    int nM, nN, nwg, G, c;
    __host__ __device__ void init(int M, int N, int G_, int c_) { nM = M / BM; nN = N / BM; nwg = nM * nN; G = G_; c = c_; }
    __host__ __device__ bool next(int i, Unit& u) const {
        const long L = (long)i * G + c; if (L >= nwg) return false;
        int wgid = (int)L; { const int q = nwg / NXCD, r = nwg % NXCD, xcd = wgid % NXCD, off = wgid / NXCD; wgid = (xcd < r ? xcd * (q + 1) : r * (q + 1) + (xcd - r) * q) + off; }
        const int nig = WGM * nN, gid = wgid / nig, fm = gid * WGM, gsz = (nM - fm) < WGM ? (nM - fm) : WGM;
        u.pm = fm + ((wgid % nig) % gsz); u.pn = (wgid % nig) / gsz; u.pb = u.pn; return true;
    }
    __device__ __forceinline__ void a_ready(const Unit&) const {}
    __device__ __forceinline__ void done(const Unit&) const {}
};
#ifndef WGM_G
#endif
struct GroupedOrder {
    int nN, G, c; int ts[9];
    __device__ __forceinline__ void init(const unsigned* tstart, int nN_, int G_, int c_) { nN = nN_; G = G_; c = c_;
#pragma unroll
        for (int e = 0; e < 9; ++e) ts[e] = (int)tstart[e]; }
    __device__ __forceinline__ bool next(int i, Unit& u) const {
        const long L = (long)i * G + c; if (L >= (long)ts[8] * nN) return false;
        int e = 0, us = 0, te = ts[1] - ts[0], t0 = ts[0];
#pragma unroll
        for (int k = 1; k < 8; ++k) { const int s = ts[k] * nN; if (L >= s) { e = k; us = s; te = ts[k + 1] - ts[k]; t0 = ts[k]; } }
        if (te <= 0) return false;
        int wgid = (int)L - us; { const int nwg = te * nN, q = nwg / NXCD, rr = nwg % NXCD, xcd = wgid % NXCD, off = wgid / NXCD; wgid = (xcd < rr ? xcd * (q + 1) : rr * (q + 1) + (xcd - rr) * q) + off; }
        const int nig = WGM_G * nN, gid = wgid / nig, fm = gid * WGM_G, gsz = (te - fm) < WGM_G ? (te - fm) : WGM_G;
        u.pm = t0 + fm + ((wgid % nig) % gsz); u.pn = (wgid % nig) / gsz; u.pb = e * nN + u.pn; return true;
    }
    __device__ __forceinline__ void a_ready(const Unit&) const {}
    __device__ __forceinline__ void done(const Unit&) const {}
};

typedef __bf16 bf16x2c __attribute__((ext_vector_type(2)));
__device__ __forceinline__ unsigned cvt_pk_bf16(float lo, float hi) { const f32x2 v = {lo, hi}; return __builtin_bit_cast(unsigned, __builtin_convertvector(v, bf16x2c)); }

struct EpiBf16 {
    static constexpr bool PERM = true, AFTER_DRAIN = false;
    bf16_t* O; int ldc; const float* rowscale;
    __device__ __forceinline__ void operator()(const f32x4 (&acc)[2][2][4][2], const Unit& u, int wr, int wc, int fr, int fq) const {
        const int row0 = u.pm * BM + wr * 64 + fr; const int col0 = u.pn * BM + wc * 32 + 8 * fq;
#pragma unroll
        for (int ai = 0; ai < 2; ++ai)
#pragma unroll
            for (int m = 0; m < 4; ++m) { const int row = row0 + ai * HALF + m * 16; bf16_t* rowp = O + (size_t)row * ldc + col0; const float sc = rowscale ? rowscale[row] : 1.f;
#pragma unroll
                for (int bj = 0; bj < 2; ++bj) { f32x4 v0 = acc[ai][bj][m][0] * sc, v1 = acc[ai][bj][m][1] * sc;
                    u32x4 w; w.x = cvt_pk_bf16(v0[0], v0[1]); w.y = cvt_pk_bf16(v0[2], v0[3]); w.z = cvt_pk_bf16(v1[0], v1[1]); w.w = cvt_pk_bf16(v1[2], v1[3]);
                    *(u32x4*)(rowp + bj * HALF) = w; } }
    }
};
struct EpiResid {
    static constexpr bool PERM = false, AFTER_DRAIN = false;
    const float* xin; float* xout; int ldc; const float* gate; int gstride; int tiles_per_b;
    __device__ __forceinline__ void operator()(const f32x4 (&acc)[2][2][4][2], const Unit& u, int wr, int wc, int fr, int fq) const {
        const int row0 = u.pm * BM + wr * 64 + fr, col0 = u.pn * BM + wc * 32 + 4 * fq;
        const float* gp = gate + (size_t)(u.pm / tiles_per_b) * gstride + col0;
        f32x4 gv[2][2];
#pragma unroll
        for (int bj = 0; bj < 2; ++bj)
#pragma unroll
            for (int n = 0; n < 2; ++n) gv[bj][n] = *(const f32x4*)(gp + bj * HALF + n * 16);
#pragma unroll
        for (int ai = 0; ai < 2; ++ai)
#pragma unroll
            for (int m = 0; m < 4; ++m) { const size_t off = (size_t)(row0 + ai * HALF + m * 16) * ldc + col0;
#pragma unroll
                for (int bj = 0; bj < 2; ++bj)
#pragma unroll
                    for (int n = 0; n < 2; ++n) { const f32x4 xi = *(const f32x4*)(xin + off + bj * HALF + n * 16);
                        *(f32x4*)(xout + off + bj * HALF + n * 16) = xi + gv[bj][n] * acc[ai][bj][m][n]; }
                asm volatile("" ::: "memory"); }
    }
};
__device__ __forceinline__ float silu_f(float g) { return g * __builtin_amdgcn_rcpf(1.0f + __builtin_amdgcn_exp2f(-1.4426950408889634f * g)); }
struct EpiSwiGLU {
    static constexpr bool PERM = false, AFTER_DRAIN = false;
    bf16_t* O; int ldo;
    __device__ __forceinline__ void operator()(const f32x4 (&acc)[2][2][4][2], const Unit& u, int wr, int wc, int fr, int fq) const {
        const int row0 = u.pm * BM + wr * 64 + fr, col0 = u.pn * HALF + wc * 16 + 4 * fq;
#pragma unroll
        for (int ai = 0; ai < 2; ++ai)
#pragma unroll
            for (int m = 0; m < 4; ++m) { bf16_t* rowp = O + (size_t)(row0 + ai * HALF + m * 16) * ldo + col0;
#pragma unroll
                for (int bj = 0; bj < 2; ++bj) { const f32x4 g = acc[ai][bj][m][0], up = acc[ai][bj][m][1];
                    u32x2 w; w.x = cvt_pk_bf16(silu_f(g[0]) * up[0], silu_f(g[1]) * up[1]); w.y = cvt_pk_bf16(silu_f(g[2]) * up[2], silu_f(g[3]) * up[3]);
                    *(u32x2*)(rowp + bj * 64) = w; } }
    }
};
struct EpiSwiGLUH {
    static constexpr bool PERM = false, AFTER_DRAIN = false;
    bf16_t* O; unsigned char* O8; int ldo; float s, so;
    __device__ __forceinline__ void operator()(const f32x4 (&acc)[2][2][4][2], const Unit& u, int wr, int wc, int fr, int fq) const {
        const int row0 = u.pm * BM + wr * 64 + fr, col0 = u.pn * 64 + wc * 16 + 4 * fq;
#pragma unroll
        for (int ai = 0; ai < 2; ++ai)
#pragma unroll
            for (int m = 0; m < 4; ++m) { const size_t off = (size_t)(row0 + ai * HALF + m * 16) * ldo + col0;
                const f32x4 g = acc[ai][0][m][0] * s, up = acc[ai][0][m][1] * s;
                const float v0 = silu_f(g[0]) * up[0], v1 = silu_f(g[1]) * up[1], v2 = silu_f(g[2]) * up[2], v3 = silu_f(g[3]) * up[3];
                if (O8) { int w = 0; w = __builtin_amdgcn_cvt_pk_fp8_f32(__builtin_amdgcn_fmed3f(v0 * so, -440.f, 440.f), __builtin_amdgcn_fmed3f(v1 * so, -440.f, 440.f), w, false);
                    w = __builtin_amdgcn_cvt_pk_fp8_f32(__builtin_amdgcn_fmed3f(v2 * so, -440.f, 440.f), __builtin_amdgcn_fmed3f(v3 * so, -440.f, 440.f), w, true); *(int*)(O8 + off) = w; }
                else { u32x2 w; w.x = cvt_pk_bf16(v0, v1); w.y = cvt_pk_bf16(v2, v3); *(u32x2*)(O + off) = w; } }
    }
};
struct EpiBf16H {
    static constexpr bool PERM = true, AFTER_DRAIN = false;
    bf16_t* O; int ldc; float s;
    __device__ __forceinline__ void operator()(const f32x4 (&acc)[2][2][4][2], const Unit& u, int wr, int wc, int fr, int fq) const {
        const int row0 = u.pm * BM + wr * 64 + fr; const int col0 = u.pn * HALF + wc * 32 + 8 * fq;
#pragma unroll
        for (int ai = 0; ai < 2; ++ai)
#pragma unroll
            for (int m = 0; m < 4; ++m) { bf16_t* rowp = O + (size_t)(row0 + ai * HALF + m * 16) * ldc + col0;
                const f32x4 v0 = acc[ai][0][m][0] * s, v1 = acc[ai][0][m][1] * s;
                u32x4 w; w.x = cvt_pk_bf16(v0[0], v0[1]); w.y = cvt_pk_bf16(v0[2], v0[3]); w.z = cvt_pk_bf16(v1[0], v1[1]); w.w = cvt_pk_bf16(v1[2], v1[3]);
                *(u32x4*)rowp = w; }
    }
};

template <class Epi, class Sched, bool ALIGN_EPI = false, bool SP2 = false, bool F8 = false>
__device__ __forceinline__ void gemm_phase(PG8_LAS unsigned char* lds, const Gemm g, const Sched& S, const Epi& E) {
    const int tid = threadIdx.x, wid = __builtin_amdgcn_readfirstlane(tid >> 6), lane = tid & 63, wr = wid >> 2, wc = wid & 3, fr = lane & 15, fq = lane >> 4;
    const int K = g.K, nt = K / BK;
    unsigned voffA[2], voffB[2];
#pragma unroll
    for (int i = 0; i < 2; ++i) { int R, C; stage_rc(tid * 16 + i * 8192, R, C); const int Rb = Epi::PERM ? ((R & ~31) + perm32(R & 31)) : R;
        voffA[i] = (unsigned)(R * g.lda + C) * 2u; voffB[i] = (unsigned)(Rb * g.ldb + C) * 2u; }
    const size_t kstep = (size_t)(BK * 2);
    const size_t hstepA = (size_t)HALF * g.lda * 2, hstepB = (size_t)HALF * g.ldb * 2;
    const size_t tstepA = 2 * hstepA, tstepB = F8 ? hstepB : 2 * hstepB;
    const unsigned ldsw = (unsigned)wid * 1024u;
    const int aoff = lds_byte(wr * 64 + fr, fq * 8), boff = lds_byte(wc * 32 + fr, fq * 8);
#define PG8_SA(b, h) (((b) * 2 + (h)) * HTB)
#define PG8_SB(b, h) ((4 + (b) * 2 + (h)) * HTB)
#define PG8_STAGE(bufoff, gbase, voff) do { _Pragma("unroll") for (int _i = 0; _i < 2; ++_i) \
        __builtin_amdgcn_global_load_lds((const unsigned*)((const char*)(gbase) + (voff)[_i]), (PG8_LAS unsigned*)(lds + (bufoff) + ldsw + _i * 8192), 16, 0, 0); } while (0)
#define PG8_LDA(dst, b, h) do { _Pragma("unroll") for (int m = 0; m < 4; ++m) _Pragma("unroll") for (int k = 0; k < 2; ++k) dst[m][k] = *(const PG8_LAS bf16x8*)(lds + PG8_SA(b, h) + aoff + m * 2048 + k * 1024); } while (0)
#define PG8_LDB(dst, b, h) do { if constexpr (!F8 || (h) == 0) { _Pragma("unroll") for (int n = 0; n < 2; ++n) _Pragma("unroll") for (int k = 0; k < 2; ++k) dst[n][k] = *(const PG8_LAS bf16x8*)(lds + PG8_SB(b, h) + boff + n * 2048 + k * 1024); } } while (0)
#define PG8_CAT(x, y) __builtin_shufflevector(x, y, 0, 1, 2, 3, 4, 5, 6, 7, 8, 9, 10, 11, 12, 13, 14, 15)
#define PG8_MMA(ai, bj, At, Bt) do { if constexpr (!F8 || (bj) == 0) { __builtin_amdgcn_s_setprio(1); \
        if constexpr (F8) { _Pragma("unroll") for (int m = 0; m < 4; ++m) _Pragma("unroll") for (int n = 0; n < 2; ++n) \
            acc[ai][bj][m][n] = __builtin_amdgcn_mfma_scale_f32_16x16x128_f8f6f4(__builtin_bit_cast(v8i_, PG8_CAT(Bt[n][0], Bt[n][1])), __builtin_bit_cast(v8i_, PG8_CAT(At[m][0], At[m][1])), acc[ai][bj][m][n], 0, 0, 0, 0x7f7f7f7f, 0, 0x7f7f7f7f); } \
        else { _Pragma("unroll") for (int m = 0; m < 4; ++m) _Pragma("unroll") for (int n = 0; n < 2; ++n) _Pragma("unroll") for (int k = 0; k < 2; ++k) \
            acc[ai][bj][m][n] = __builtin_amdgcn_mfma_f32_16x16x32_bf16(Bt[n][k], At[m][k], acc[ai][bj][m][n], 0, 0, 0); } \
        __builtin_amdgcn_s_setprio(0); } } while (0)
#define PG8_WAIT_V(n) asm volatile("s_waitcnt vmcnt(" #n ")" ::: "memory")
#define PG8_WAIT_L(n) asm volatile("s_waitcnt lgkmcnt(" #n ")" ::: "memory")
#define PG8_BAR __builtin_amdgcn_s_barrier()
#define PG8_SCHED __builtin_amdgcn_sched_barrier(0)
    Unit cur, nxt; int ui = 0;
    if (!S.next(0, cur)) return;
    f32x4 acc[2][2][4][2];
#pragma unroll
    for (int a = 0; a < 2; ++a)
#pragma unroll
        for (int b = 0; b < 2; ++b)
#pragma unroll
            for (int m = 0; m < 4; ++m)
#pragma unroll
                for (int n = 0; n < 2; ++n) acc[a][b][m][n] = (f32x4){0.f, 0.f, 0.f, 0.f};
    bf16x8 At[4][2], B0[2][2], B1[2][2];
    typedef int v8i_ __attribute__((ext_vector_type(8))); typedef short bf16x16_ __attribute__((ext_vector_type(16)));
    const char* cA = (const char*)g.A + (size_t)cur.pm * tstepA; const char* cB = (const char*)g.Bt + (size_t)cur.pb * tstepB;
    S.a_ready(cur);
    if constexpr (SP2) {
        PG8_STAGE(PG8_SB(0, 0), cB, voffB); if constexpr (!F8) PG8_STAGE(PG8_SB(0, 1), cB + hstepB, voffB); PG8_STAGE(PG8_SA(0, 0), cA, voffA); PG8_STAGE(PG8_SA(0, 1), cA + hstepA, voffA);
        if (wr == 1) PG8_BAR;
        PG8_WAIT_V(2); PG8_BAR;
        PG8_STAGE(PG8_SB(1, 0), cB + kstep, voffB); PG8_STAGE(PG8_SA(1, 0), cA + kstep, voffA); if constexpr (!F8) PG8_STAGE(PG8_SB(1, 1), cB + hstepB + kstep, voffB);
        if constexpr (F8) PG8_WAIT_V(4); else PG8_WAIT_V(6); PG8_BAR;
    } else {
        PG8_STAGE(PG8_SB(0, 0), cB, voffB); PG8_STAGE(PG8_SA(0, 0), cA, voffA); PG8_STAGE(PG8_SB(0, 1), cB + hstepB, voffB); PG8_STAGE(PG8_SA(0, 1), cA + hstepA, voffA);
        if (wr == 1) PG8_BAR;
        PG8_WAIT_V(4); PG8_BAR;
        PG8_STAGE(PG8_SB(1, 0), cB + kstep, voffB); PG8_STAGE(PG8_SA(1, 0), cA + kstep, voffA); PG8_STAGE(PG8_SB(1, 1), cB + hstepB + kstep, voffB);
        PG8_WAIT_V(6); PG8_BAR;
    }
    for (;;) {
        const bool has_next = S.next(ui + 1, nxt);
        const char* nA = has_next ? (const char*)g.A + (size_t)nxt.pm * tstepA : cA; const char* nB = has_next ? (const char*)g.Bt + (size_t)nxt.pb * tstepB : cB;
        for (int t = 0; t < nt; t += 2) {
            const bool last = (t == nt - 2);
            const char* a1 = cA + (size_t)(t + 1) * kstep;
            const char* a2 = last ? nA : cA + (size_t)(t + 2) * kstep; const char* b2 = last ? nB : cB + (size_t)(t + 2) * kstep;
            const char* a3 = a2 + kstep; const char* b3 = b2 + kstep;
            if (last && has_next) S.a_ready(nxt);
            if constexpr (SP2) {
            PG8_LDB(B0, 0, 0); PG8_LDB(B1, 0, 1); PG8_SCHED; PG8_LDA(At, 0, 0); PG8_STAGE(PG8_SA(1, 1), a1 + hstepA, voffA);
            if constexpr (F8) PG8_WAIT_V(6); else PG8_WAIT_V(8); PG8_WAIT_L(0); PG8_BAR; PG8_MMA(0, 0, At, B0); PG8_MMA(0, 1, At, B1); PG8_BAR; PG8_SCHED;
            PG8_LDA(At, 0, 1); PG8_STAGE(PG8_SB(0, 0), b2, voffB); if constexpr (!F8) PG8_STAGE(PG8_SB(0, 1), b2 + hstepB, voffB); PG8_STAGE(PG8_SA(0, 0), a2, voffA);
            if constexpr (F8) PG8_WAIT_V(6); else PG8_WAIT_V(8); PG8_WAIT_L(0); PG8_BAR; PG8_MMA(1, 0, At, B0); PG8_MMA(1, 1, At, B1); PG8_BAR; PG8_SCHED;
            PG8_LDB(B0, 1, 0); PG8_LDB(B1, 1, 1); PG8_SCHED; PG8_LDA(At, 1, 0); PG8_STAGE(PG8_SA(0, 1), a2 + hstepA, voffA);
            if constexpr (F8) PG8_WAIT_V(6); else PG8_WAIT_V(8); PG8_WAIT_L(0); PG8_BAR; PG8_MMA(0, 0, At, B0); PG8_MMA(0, 1, At, B1); PG8_BAR; PG8_SCHED;
            PG8_LDA(At, 1, 1); PG8_STAGE(PG8_SB(1, 0), b3, voffB); if constexpr (!F8) PG8_STAGE(PG8_SB(1, 1), b3 + hstepB, voffB); PG8_STAGE(PG8_SA(1, 0), a3, voffA);
            if constexpr (F8) PG8_WAIT_V(6); else PG8_WAIT_V(8); PG8_WAIT_L(0); PG8_BAR; PG8_MMA(1, 0, At, B0); PG8_MMA(1, 1, At, B1); PG8_BAR; PG8_SCHED;
            } else {
            PG8_LDB(B0, 0, 0); PG8_SCHED; PG8_LDA(At, 0, 0); PG8_STAGE(PG8_SA(1, 1), a1 + hstepA, voffA);
            PG8_WAIT_L(8); PG8_BAR; PG8_WAIT_L(0); PG8_MMA(0, 0, At, B0); PG8_BAR; PG8_SCHED;
            PG8_LDB(B1, 0, 1); PG8_STAGE(PG8_SB(0, 0), b2, voffB);
            PG8_BAR; PG8_WAIT_L(0); PG8_MMA(0, 1, At, B1); PG8_BAR;
            PG8_LDA(At, 0, 1); PG8_STAGE(PG8_SA(0, 0), a2, voffA);
            PG8_BAR; PG8_WAIT_L(0); PG8_MMA(1, 0, At, B0); PG8_BAR; PG8_SCHED;
            PG8_STAGE(PG8_SB(0, 1), b2 + hstepB, voffB);
            PG8_WAIT_V(6); PG8_BAR; PG8_MMA(1, 1, At, B1); PG8_BAR;
            PG8_LDB(B0, 1, 0); PG8_SCHED; PG8_LDA(At, 1, 0); PG8_STAGE(PG8_SA(0, 1), a2 + hstepA, voffA);
            PG8_WAIT_L(8); PG8_BAR; PG8_WAIT_L(0); PG8_MMA(0, 0, At, B0); PG8_BAR; PG8_SCHED;
            PG8_LDB(B1, 1, 1); PG8_STAGE(PG8_SB(1, 0), b3, voffB);
            PG8_BAR; PG8_WAIT_L(0); PG8_MMA(0, 1, At, B1); PG8_BAR;
            PG8_LDA(At, 1, 1); PG8_STAGE(PG8_SA(1, 0), a3, voffA);
            PG8_BAR; PG8_WAIT_L(0); PG8_MMA(1, 0, At, B0); PG8_BAR; PG8_SCHED;
            PG8_STAGE(PG8_SB(1, 1), b3 + hstepB, voffB);
            PG8_WAIT_V(6); PG8_BAR; PG8_MMA(1, 1, At, B1); PG8_BAR;
            }
        }
        if constexpr (ALIGN_EPI) { if (wr == 0) PG8_BAR; }
        if constexpr (!Epi::AFTER_DRAIN) { E(acc, cur, wr, wc, fr, fq); S.done(cur); }
        if (!has_next) break;
#pragma unroll
        for (int a = 0; a < 2; ++a)
#pragma unroll
            for (int b = 0; b < 2; ++b)
#pragma unroll
                for (int m = 0; m < 4; ++m)
#pragma unroll
                    for (int n = 0; n < 2; ++n) acc[a][b][m][n] = (f32x4){0.f, 0.f, 0.f, 0.f};
        cur = nxt; cA = nA; cB = nB; ++ui;
        if constexpr (ALIGN_EPI) { if (wr == 1) PG8_BAR; }
    }
    PG8_WAIT_V(0);
    if constexpr (!ALIGN_EPI) { if (wr == 0) PG8_BAR; }
    PG8_BAR;
    if constexpr (Epi::AFTER_DRAIN) { E.fused(acc, cur, wr, wc, fr, fq, lds, wid, lane); S.done(cur); }
#undef PG8_SA
#undef PG8_SB
#undef PG8_STAGE
#undef PG8_CAT
#undef PG8_LDA
#undef PG8_LDB
#undef PG8_MMA
#undef PG8_WAIT_V
#undef PG8_WAIT_L
#undef PG8_BAR
#undef PG8_SCHED
}

}

namespace fa {
#define FA_LAS __attribute__((address_space(3)))
typedef unsigned short bf16;
typedef short bf16x8 __attribute__((ext_vector_type(8)));
typedef short s16x4 __attribute__((ext_vector_type(4)));
typedef float f32x16 __attribute__((ext_vector_type(16)));
typedef float f32x4 __attribute__((ext_vector_type(4)));
typedef unsigned u32x4 __attribute__((ext_vector_type(4)));
constexpr int QB = 256, QBLK = 32, KVBLK = 64;
constexpr int SHM_K = 16384, SHM_V = 16384, SHM_K2 = 8192;
constexpr int OFF_V = 0, OFF_K = 2 * SHM_V, OFF_K2 = OFF_K + 2 * SHM_K, OFF_WS = OFF_K2 + 2 * SHM_K2, WS_PER_WAVE = 1024, OFF_TAB = OFF_WS + 8 * WS_PER_WAVE;
constexpr int TAB_PAD = 320, TAB_MAX = 4096 + TAB_PAD;
constexpr int LDS_END = OFF_TAB + TAB_MAX * 4;
constexpr int OSTG = 272;
static_assert(LDS_END <= 131072 && 8 * 32 * OSTG <= OFF_WS, "attention LDS map");
#define KSWZ(row, colB) ((row) * 256 + ((colB) ^ (((row) & 7) << 4)))
#define K2SWZ(row, colB) ((row) * 128 + ((colB) ^ (((row) & 7) << 4)))
#define SBAR() __builtin_amdgcn_sched_barrier(0)
__device__ __forceinline__ int v_st(int k, int c) { const int kk = (k & ~0xC) | ((k & 4) << 1) | ((k & 8) >> 1); return ((kk >> 3) * 4 + (c >> 5)) * 512 + ((kk & 7) * 32 + (c & 31)) * 2; }
__device__ __forceinline__ int v_rd_base(int lane) { return ((lane & 3) << 3) | (((lane >> 2) & 3) << 6) | (((lane >> 4) & 1) << 5) | (((lane >> 5) & 1) << 8); }
constexpr int v_rd_off(int d0, int ks, int half) { return d0 * 512 + ks * 4096 + half * 2048; }
__device__ __forceinline__ int crow(int r, int hi) { return (r & 3) + 8 * (r >> 2) + 4 * hi; }
typedef float f32x2c __attribute__((ext_vector_type(2)));
typedef __bf16 bf16x2c __attribute__((ext_vector_type(2)));
__device__ __forceinline__ unsigned cvtpk(float lo, float hi) { const f32x2c v = {lo, hi}; return __builtin_bit_cast(unsigned, __builtin_convertvector(v, bf16x2c)); }

struct Item {
    const bf16* Q; long qs;
    const float* rope; long ropes;
    const bf16* K; long ks; const bf16* K2; long k2s; const bf16* V; long vs;
    int P0, skv, W;
    const float* bias; int bstep;
    const unsigned long long* sel; long sels;
    bf16* O; long os;
    float* LSE; long lses;
    const bf16* M0; const bf16* M1; long ms; const bf16* G; long gs;
};

template <int VAR>
__device__ __forceinline__ void attn_block(const Item& it, unsigned char* lds_g) {
    constexpr bool HAS_BIAS = VAR != 2, HAS_SEL = VAR == 1, HAS_K2 = VAR == 2;
    constexpr float SCALE = HAS_K2 ? 0.07216878364870322f : 0.08838834764831845f, C2 = 1.4426950408889634f * SCALE, THR = 8.f;
    FA_LAS unsigned char* L = (FA_LAS unsigned char*)lds_g;
    const int tid = threadIdx.x, wid = __builtin_amdgcn_readfirstlane(tid >> 6), lane = tid & 63, r32 = lane & 31, hi = lane >> 5;
    const int W = it.W;
    const int j_lo = (it.P0 - W + 1 > 0) ? (it.P0 - W + 1) / KVBLK : 0;
    int j_hi = (it.P0 + QB - 1) / KVBLK + 1; if (j_hi > it.skv / KVBLK) j_hi = it.skv / KVBLK;
    const int NT = j_hi - j_lo;
    const int qlo = it.P0 + wid * QBLK, qm = qlo + r32 - 4 * hi;
    FA_LAS float* wsl = (FA_LAS float*)(L + OFF_WS + wid * WS_PER_WAVE); FA_LAS float* li_l = wsl; FA_LAS float* al_l = wsl + 32;
    FA_LAS float* tab = (FA_LAS float*)(L + OFF_TAB);
    const int sr = tid >> 4, sc = (tid & 15) * 8, vst0 = v_st(sr, sc), vst1 = v_st(32 + sr, sc), kws = KSWZ(sr, sc * 2);
    const int k2r = tid >> 3, k2c = (tid & 7) * 8, k2ws = K2SWZ(k2r, k2c * 2);
    const int vb0 = OFF_V + v_rd_base(lane);
    bf16x8 qr[8]; bf16x8 qr2[4];
    { const bf16* qp = it.Q + (long)(qlo + r32) * it.qs + hi * 8;
#pragma unroll
      for (int d0 = 0; d0 < 8; ++d0) qr[d0] = *(const bf16x8*)(qp + d0 * 16);
      if constexpr (HAS_K2) {
          const float* rp = it.rope + (long)(qlo + r32) * it.ropes + hi * 8;
          bf16x8 raw[4];
#pragma unroll
          for (int d0 = 0; d0 < 4; ++d0) raw[d0] = *(const bf16x8*)(qp + 128 + d0 * 16);
#pragma unroll
          for (int d0 = 0; d0 < 2; ++d0) { const f32x4 c0 = *(const f32x4*)(rp + d0 * 16), c1 = *(const f32x4*)(rp + d0 * 16 + 4), s0 = *(const f32x4*)(rp + 32 + d0 * 16), s1 = *(const f32x4*)(rp + 32 + d0 * 16 + 4);
              float o1[8], o2[8];
#pragma unroll
              for (int j = 0; j < 8; ++j) { const float x1 = __builtin_bit_cast(float, (unsigned)(unsigned short)raw[d0][j] << 16), x2 = __builtin_bit_cast(float, (unsigned)(unsigned short)raw[d0 + 2][j] << 16);
                  const float cs = j < 4 ? c0[j & 3] : c1[j & 3], sn = j < 4 ? s0[j & 3] : s1[j & 3]; o1[j] = x1 * cs - x2 * sn; o2[j] = x2 * cs + x1 * sn; }
              u32x4 w1 = {cvtpk(o1[0], o1[1]), cvtpk(o1[2], o1[3]), cvtpk(o1[4], o1[5]), cvtpk(o1[6], o1[7])}, w2 = {cvtpk(o2[0], o2[1]), cvtpk(o2[2], o2[3]), cvtpk(o2[4], o2[5]), cvtpk(o2[6], o2[7])};
              qr2[d0] = __builtin_bit_cast(bf16x8, w1); qr2[d0 + 2] = __builtin_bit_cast(bf16x8, w2); }
      }
    }
    unsigned long long selm = ~0ull;
    if constexpr (HAS_SEL) selm = __hip_atomic_load(it.sel + (long)(qlo + r32) * it.sels, __ATOMIC_RELAXED, __HIP_MEMORY_SCOPE_AGENT);
    if constexpr (HAS_BIAS) {
        int rmax = W + 320; if (rmax > 4096) rmax = 4096;
        for (int i = tid; i < rmax + TAB_PAD; i += 512) { int r = i - TAB_PAD; r = r < -64 ? -64 : r; long gi = (long)r * it.bstep; gi = gi > 4095 ? 4095 : gi; tab[i] = it.bias[gi] * (1.0f / SCALE); }
    }
    bf16x8 st_k0, st_k1, st_v0, st_v1, st_k2;
#define FA_LOAD(kb_) do { const long r0_ = (long)((kb_) + sr), r1_ = r0_ + 32; \
        st_v0 = *(const bf16x8*)(it.V + r0_ * it.vs + sc); st_v1 = *(const bf16x8*)(it.V + r1_ * it.vs + sc); \
        st_k0 = *(const bf16x8*)(it.K + r0_ * it.ks + sc); st_k1 = *(const bf16x8*)(it.K + r1_ * it.ks + sc); \
        if constexpr (HAS_K2) st_k2 = *(const bf16x8*)(it.K2 + (long)((kb_) + k2r) * it.k2s + k2c); } while (0)
#define FA_WRITE(bf_) do { *(FA_LAS bf16x8*)(L + OFF_V + (bf_) * SHM_V + vst0) = st_v0; *(FA_LAS bf16x8*)(L + OFF_V + (bf_) * SHM_V + vst1) = st_v1; \
        *(FA_LAS bf16x8*)(L + OFF_K + (bf_) * SHM_K + kws) = st_k0; *(FA_LAS bf16x8*)(L + OFF_K + (bf_) * SHM_K + kws + 32 * 256) = st_k1; \
        if constexpr (HAS_K2) *(FA_LAS bf16x8*)(L + OFF_K2 + (bf_) * SHM_K2 + k2ws) = st_k2; } while (0)
    FA_LOAD(j_lo * KVBLK);
    asm volatile("s_waitcnt vmcnt(0)" ::: "memory");
    FA_WRITE(0);
    __syncthreads();
    float m_reg = -1e30f, l_reg = 0.f; f32x16 o[4] = {};
#define FA_KBASE(t) ((j_lo + (t)) * KVBLK)
#define FA_STEP(BUF, t) do { \
        const int kb_ = FA_KBASE(t); \
        if ((t) + 1 < NT) FA_LOAD(FA_KBASE((t) + 1)); \
        bool act_ = (kb_ <= qlo + QBLK - 1) && (kb_ + KVBLK - 1 >= qlo - W + 1); \
        bool allow_ = true; \
        if constexpr (HAS_SEL) { allow_ = (bool)((selm >> (kb_ >> 6)) & 1ull); } \
        if (act_) { \
            f32x16 p0 = {}, p1 = {}; \
            { const int ka_ = OFF_K + (BUF) * SHM_K; \
              _Pragma("unroll") for (int d0 = 0; d0 < 8; ++d0) { \
                const bf16x8 b0 = *(const FA_LAS bf16x8*)(L + ka_ + KSWZ(r32, (d0 * 16 + hi * 8) * 2)); \
                const bf16x8 b1 = *(const FA_LAS bf16x8*)(L + ka_ + 32 * 256 + KSWZ(r32, (d0 * 16 + hi * 8) * 2)); \
                p0 = __builtin_amdgcn_mfma_f32_32x32x16_bf16(b0, qr[d0], p0, 0, 0, 0); p1 = __builtin_amdgcn_mfma_f32_32x32x16_bf16(b1, qr[d0], p1, 0, 0, 0); } \
              if constexpr (HAS_K2) { const int k2a_ = OFF_K2 + (BUF) * SHM_K2; \
                _Pragma("unroll") for (int d0 = 0; d0 < 4; ++d0) { \
                  const bf16x8 b0 = *(const FA_LAS bf16x8*)(L + k2a_ + K2SWZ(r32, (d0 * 16 + hi * 8) * 2)); \
                  const bf16x8 b1 = *(const FA_LAS bf16x8*)(L + k2a_ + 32 * 128 + K2SWZ(r32, (d0 * 16 + hi * 8) * 2)); \
                  p0 = __builtin_amdgcn_mfma_f32_32x32x16_bf16(b0, qr2[d0], p0, 0, 0, 0); p1 = __builtin_amdgcn_mfma_f32_32x32x16_bf16(b1, qr2[d0], p1, 0, 0, 0); } } } \
            const int dq_ = qm - kb_; \
            if constexpr (HAS_BIAS) { const FA_LAS float* tb_ = tab + (TAB_PAD + dq_ - 63); \
                _Pragma("unroll") for (int r = 0; r < 16; ++r) { const int c_ = (r & 3) + 8 * (r >> 2); p0[r] += tb_[63 - c_]; p1[r] += tb_[31 - c_]; } } \
            if (HAS_SEL || kb_ + KVBLK - 1 > qlo || kb_ <= qlo + QBLK - 1 - W) { const float NEG_ = -__builtin_inff(); const int dqm_ = allow_ ? dq_ : -0x40000000; \
                _Pragma("unroll") for (int r = 0; r < 16; ++r) { const int c_ = (r & 3) + 8 * (r >> 2); \
                    if ((unsigned)(dqm_ - c_) >= (unsigned)W) p0[r] = NEG_; if ((unsigned)(dqm_ - c_ - 32) >= (unsigned)W) p1[r] = NEG_; } } \
              \
            float pmax_ = p0[0]; _Pragma("unroll") for (int r = 1; r < 16; ++r) pmax_ = fmaxf(pmax_, p0[r]); _Pragma("unroll") for (int r = 0; r < 16; ++r) pmax_ = fmaxf(pmax_, p1[r]); \
            { auto rr_ = __builtin_amdgcn_permlane32_swap(__float_as_uint(pmax_), __float_as_uint(pmax_), false, false); pmax_ = fmaxf(__uint_as_float(rr_[0]), __uint_as_float(rr_[1])); } \
            float mn_, alpha_; \
            if (__all((pmax_ - m_reg) * SCALE <= THR)) { mn_ = m_reg; alpha_ = 1.f; } \
            else { mn_ = fmaxf(m_reg, pmax_); alpha_ = __builtin_amdgcn_exp2f((m_reg - mn_) * C2); m_reg = mn_; } \
            const float mnL_ = -mn_ * C2; float ps_ = 0.f; \
            _Pragma("unroll") for (int r = 0; r < 16; ++r) { p0[r] = __builtin_amdgcn_exp2f(fmaf(p0[r], C2, mnL_)); p1[r] = __builtin_amdgcn_exp2f(fmaf(p1[r], C2, mnL_)); ps_ += p0[r] + p1[r]; } \
            { auto rr_ = __builtin_amdgcn_permlane32_swap(__float_as_uint(ps_), __float_as_uint(ps_), false, false); ps_ = __uint_as_float(rr_[0]) + __uint_as_float(rr_[1]); } \
            l_reg = l_reg * alpha_ + ps_; \
            bf16x8 pa0, pa1, pa2, pa3; \
            FA_PK4(p0, 0, pa0); FA_PK4(p0, 8, pa1); FA_PK4(p1, 0, pa2); FA_PK4(p1, 8, pa3); \
            if (__any(alpha_ < 1.f)) { if (hi == 0) al_l[r32] = alpha_; asm volatile("s_waitcnt lgkmcnt(0)" ::: "memory"); \
                _Pragma("unroll") for (int d_ = 0; d_ < 4; ++d_) _Pragma("unroll") for (int r = 0; r < 16; ++r) o[d_][r] *= al_l[crow(r, hi)]; } \
            FA_PV_D0(BUF, 0); FA_PV_D0(BUF, 1); FA_PV_D0(BUF, 2); FA_PV_D0(BUF, 3); \
        } \
        if ((t) + 1 < NT) { asm volatile("s_waitcnt vmcnt(0)" ::: "memory"); FA_WRITE(1 - (BUF)); } \
        __syncthreads(); } while (0)
#define FA_PK4(P, B_, OUT) do { unsigned a0 = cvtpk(P[B_+0], P[B_+1]), a1 = cvtpk(P[B_+2], P[B_+3]); unsigned b0 = cvtpk(P[B_+4], P[B_+5]), b1 = cvtpk(P[B_+6], P[B_+7]); \
        auto r0 = __builtin_amdgcn_permlane32_swap(a0, b0, false, false); auto r1 = __builtin_amdgcn_permlane32_swap(a1, b1, false, false); \
        u32x4 w = {r0[0], r1[0], r0[1], r1[1]}; OUT = __builtin_bit_cast(bf16x8, w); } while (0)
#define FA_TRRD(dst, off) asm volatile("ds_read_b64_tr_b16 %0, %1 offset:%2" : "=&v"(dst) : "v"(vb0), "i"(off) : "memory")
#define FA_PV_D0(VB, d0) do { s16x4 l0, l1, l2, l3, h0, h1, h2, h3; constexpr int b_ = (VB) * SHM_V + v_rd_off(d0, 0, 0); \
        FA_TRRD(l0, b_); FA_TRRD(h0, b_ + 2048); FA_TRRD(l1, b_ + 4096); FA_TRRD(h1, b_ + 6144); FA_TRRD(l2, b_ + 8192); FA_TRRD(h2, b_ + 10240); FA_TRRD(l3, b_ + 12288); FA_TRRD(h3, b_ + 14336); \
        asm volatile("s_waitcnt lgkmcnt(0)" ::: "memory"); SBAR(); \
        o[d0] = __builtin_amdgcn_mfma_f32_32x32x16_bf16(pa0, (bf16x8){l0[0], l0[1], l0[2], l0[3], h0[0], h0[1], h0[2], h0[3]}, o[d0], 0, 0, 0); \
        o[d0] = __builtin_amdgcn_mfma_f32_32x32x16_bf16(pa1, (bf16x8){l1[0], l1[1], l1[2], l1[3], h1[0], h1[1], h1[2], h1[3]}, o[d0], 0, 0, 0); \
        o[d0] = __builtin_amdgcn_mfma_f32_32x32x16_bf16(pa2, (bf16x8){l2[0], l2[1], l2[2], l2[3], h2[0], h2[1], h2[2], h2[3]}, o[d0], 0, 0, 0); \
        o[d0] = __builtin_amdgcn_mfma_f32_32x32x16_bf16(pa3, (bf16x8){l3[0], l3[1], l3[2], l3[3], h3[0], h3[1], h3[2], h3[3]}, o[d0], 0, 0, 0); } while (0)
    for (int t = 0; t < NT; t += 2) { FA_STEP(0, t); if (t + 1 < NT) FA_STEP(1, t + 1); }
    li_l[r32] = l_reg;
    if constexpr (VAR == 1) { const bf16* gp = it.G + (long)(qlo + r32) * it.gs;
#pragma unroll
        for (int k = 0; k < 3; ++k) { const float gl = __builtin_bit_cast(float, (unsigned)gp[k] << 16); wsl[64 + 32 * k + r32] = 1.0f / (1.0f + __expf(-gl)); } }
    asm volatile("s_waitcnt lgkmcnt(0)" ::: "memory");
    if (it.LSE && hi == 0) it.LSE[(long)(qlo + r32) * it.lses] = m_reg * SCALE + __logf(l_reg);
    FA_LAS unsigned char* stg = L + wid * (32 * OSTG);
#pragma unroll
    for (int r = 0; r < 16; ++r) { const int orow = crow(r, hi); const float lv_ = li_l[orow]; float rl = lv_ > 0.f ? __builtin_amdgcn_rcpf(lv_) : 0.f; if constexpr (VAR == 1) rl *= wsl[64 + 32 + orow];
#pragma unroll
        for (int d0 = 0; d0 < 4; ++d0) { const float v = o[d0][r] * rl; const unsigned u = __builtin_bit_cast(unsigned, v); *(FA_LAS unsigned short*)(stg + orow * OSTG + (d0 * 32 + r32) * 2) = (unsigned short)((u + 0x7fffu + ((u >> 16) & 1u)) >> 16); } }
    asm volatile("s_waitcnt lgkmcnt(0)" ::: "memory");
#pragma unroll
    for (int i = 0; i < 8; ++i) { const int id = lane + 64 * i, row = id >> 4, ch = id & 15; const long qi = (long)(qlo + row);
        u32x4 w = *(const FA_LAS u32x4*)(stg + row * OSTG + ch * 16);
        if constexpr (VAR == 1) { const float g0 = wsl[64 + row], g2 = wsl[64 + 64 + row];
            const u32x4 a = *(const u32x4*)(it.M0 + qi * it.ms + ch * 8), c = *(const u32x4*)(it.M1 + qi * it.ms + ch * 8);
#pragma unroll
            for (int k = 0; k < 4; ++k) { const float lo = __builtin_bit_cast(float, w[k] << 16) + g0 * __builtin_bit_cast(float, a[k] << 16) + g2 * __builtin_bit_cast(float, c[k] << 16);
                const float hi_ = __builtin_bit_cast(float, w[k] & 0xffff0000u) + g0 * __builtin_bit_cast(float, a[k] & 0xffff0000u) + g2 * __builtin_bit_cast(float, c[k] & 0xffff0000u); w[k] = cvtpk(lo, hi_); } }
        *(u32x4*)(it.O + qi * it.os + ch * 8) = w; }
    __syncthreads();
#undef FA_LOAD
#undef FA_WRITE
#undef FA_KBASE
#undef FA_STEP
#undef FA_PK4
#undef FA_TRRD
#undef FA_PV_D0
}

struct CmpItem { const bf16* Q; long qs; const bf16* K; const bf16* V; const float* bias; int bld; int s0; bf16* O; long os; unsigned long long* sel; };
__device__ __forceinline__ void cmp_block(const CmpItem& it, unsigned char* lds_g, int imps_off) {
    constexpr float SCALE = 0.08838834764831845f, C2 = 1.4426950408889634f * SCALE;
    constexpr int OFF_TABC = 65536;
    FA_LAS unsigned char* L = (FA_LAS unsigned char*)lds_g;
    const int tid = threadIdx.x, wid = __builtin_amdgcn_readfirstlane(tid >> 6), lane = tid & 63, r32 = lane & 31, hi = lane >> 5;
    FA_LAS float* tabc = (FA_LAS float*)(L + OFF_TABC); FA_LAS float* imps = (FA_LAS float*)(L + imps_off);
    const int tokl = wid * 8 + (r32 >> 2), rh = r32 & 3, s = it.s0 + tokl;
    const int nvis = (it.s0 + 63 - 31) / 16 + 1 > 255 ? 255 : (it.s0 + 63 - 31) / 16 + 1;
    const int NT = (nvis + 63) / 64;
    const int nlim = (s - 31) >> 4;
    const int sr = tid >> 4, sc = (tid & 15) * 8, vst0 = v_st(sr, sc), vst1 = v_st(32 + sr, sc), kws = KSWZ(sr, sc * 2);
    const int vb0 = OFF_V + v_rd_base(lane);
    bf16x8 qr[8];
    { const bf16* qp = it.Q + (long)tokl * it.qs + rh * 128 + hi * 8;
#pragma unroll
      for (int d0 = 0; d0 < 8; ++d0) qr[d0] = *(const bf16x8*)(qp + d0 * 16); }
    for (int i = tid; i < 4 * 4096; i += 512) tabc[i] = it.bias[(long)(i >> 12) * it.bld + (i & 4095)] * (1.0f / SCALE);
    for (int i = tid; i < 64 * 64; i += 512) imps[i] = 0.f;
    bf16x8 st_k0, st_k1, st_v0, st_v1;
#define CM_LOADK(kb_) do { st_k0 = *(const bf16x8*)(it.K + (long)((kb_) + sr) * 128 + sc); st_k1 = *(const bf16x8*)(it.K + (long)((kb_) + 32 + sr) * 128 + sc); } while (0)
#define CM_LOADV(kb_) do { st_v0 = *(const bf16x8*)(it.V + (long)((kb_) + sr) * 128 + sc); st_v1 = *(const bf16x8*)(it.V + (long)((kb_) + 32 + sr) * 128 + sc); } while (0)
#define CM_WRITEK(bf_) do { *(FA_LAS bf16x8*)(L + OFF_K + (bf_) * SHM_K + kws) = st_k0; *(FA_LAS bf16x8*)(L + OFF_K + (bf_) * SHM_K + kws + 32 * 256) = st_k1; } while (0)
#define CM_WRITEV(bf_) do { *(FA_LAS bf16x8*)(L + OFF_V + (bf_) * SHM_V + vst0) = st_v0; *(FA_LAS bf16x8*)(L + OFF_V + (bf_) * SHM_V + vst1) = st_v1; } while (0)
#define CM_SCORES(BUF, kb_) \
        f32x16 p0 = {}, p1 = {}; \
        { const int ka_ = OFF_K + (BUF) * SHM_K; \
          _Pragma("unroll") for (int d0 = 0; d0 < 8; ++d0) { \
            const bf16x8 b0 = *(const FA_LAS bf16x8*)(L + ka_ + KSWZ(r32, (d0 * 16 + hi * 8) * 2)); \
            const bf16x8 b1 = *(const FA_LAS bf16x8*)(L + ka_ + 32 * 256 + KSWZ(r32, (d0 * 16 + hi * 8) * 2)); \
            p0 = __builtin_amdgcn_mfma_f32_32x32x16_bf16(b0, qr[d0], p0, 0, 0, 0); p1 = __builtin_amdgcn_mfma_f32_32x32x16_bf16(b1, qr[d0], p1, 0, 0, 0); } } \
        { const int nb_ = (kb_) + 4 * hi, relb_ = s - 31 - 16 * nb_; const float NEG_ = -__builtin_inff(); \
          _Pragma("unroll") for (int r = 0; r < 16; ++r) { const int c_ = (r & 3) + 8 * (r >> 2); \
            { const int rel_ = relb_ - 16 * c_; const int ix_ = rel_ < 0 ? 0 : rel_; const float bv_ = tabc[rh * 4096 + ix_]; p0[r] = (nb_ + c_ <= nlim) ? p0[r] + bv_ : NEG_; } \
            { const int rel_ = relb_ - 16 * (c_ + 32); const int ix_ = rel_ < 0 ? 0 : rel_; const float bv_ = tabc[rh * 4096 + ix_]; p1[r] = (nb_ + c_ + 32 <= nlim) ? p1[r] + bv_ : NEG_; } } }
    CM_LOADK(0); asm volatile("s_waitcnt vmcnt(0)" ::: "memory"); CM_WRITEK(0); __syncthreads();
    float m_reg = -1e30f, l_reg = 0.f;
#define CM_P1(BUF, t) do { if ((t) + 1 < NT) CM_LOADK(((t) + 1) * 64); \
        { CM_SCORES(BUF, (t) * 64) \
          float pmax_ = p0[0]; _Pragma("unroll") for (int r = 1; r < 16; ++r) pmax_ = fmaxf(pmax_, p0[r]); _Pragma("unroll") for (int r = 0; r < 16; ++r) pmax_ = fmaxf(pmax_, p1[r]); \
          { auto rr_ = __builtin_amdgcn_permlane32_swap(__float_as_uint(pmax_), __float_as_uint(pmax_), false, false); pmax_ = fmaxf(__uint_as_float(rr_[0]), __uint_as_float(rr_[1])); } \
          const float mn_ = fmaxf(m_reg, pmax_), alpha_ = __builtin_amdgcn_exp2f((m_reg - mn_) * C2), mnL_ = -mn_ * C2; float ps_ = 0.f; \
          _Pragma("unroll") for (int r = 0; r < 16; ++r) ps_ += __builtin_amdgcn_exp2f(fmaf(p0[r], C2, mnL_)) + __builtin_amdgcn_exp2f(fmaf(p1[r], C2, mnL_)); \
          { auto rr_ = __builtin_amdgcn_permlane32_swap(__float_as_uint(ps_), __float_as_uint(ps_), false, false); ps_ = __uint_as_float(rr_[0]) + __uint_as_float(rr_[1]); } \
          l_reg = l_reg * alpha_ + ps_; m_reg = mn_; } \
        if ((t) + 1 < NT) { asm volatile("s_waitcnt vmcnt(0)" ::: "memory"); CM_WRITEK(1 - (BUF)); } \
        __syncthreads(); } while (0)
    for (int t = 0; t < NT; t += 2) { CM_P1(0, t); if (t + 1 < NT) CM_P1(1, t + 1); }
    const float inv_l = l_reg > 0.f ? 1.0f / l_reg : 0.f, mL = -m_reg * C2;
    CM_LOADK(0); CM_LOADV(0); asm volatile("s_waitcnt vmcnt(0)" ::: "memory"); CM_WRITEK(0); CM_WRITEV(0); __syncthreads();
    f32x16 o[4] = {};
#define FA_PK4(P, B_, OUT) do { unsigned a0 = cvtpk(P[B_+0], P[B_+1]), a1 = cvtpk(P[B_+2], P[B_+3]); unsigned b0 = cvtpk(P[B_+4], P[B_+5]), b1 = cvtpk(P[B_+6], P[B_+7]); \
        auto r0 = __builtin_amdgcn_permlane32_swap(a0, b0, false, false); auto r1 = __builtin_amdgcn_permlane32_swap(a1, b1, false, false); \
        u32x4 w = {r0[0], r1[0], r0[1], r1[1]}; OUT = __builtin_bit_cast(bf16x8, w); } while (0)
#define FA_TRRD(dst, off) asm volatile("ds_read_b64_tr_b16 %0, %1 offset:%2" : "=&v"(dst) : "v"(vb0), "i"(off) : "memory")
#define FA_PV_D0(VB, d0) do { s16x4 l0, l1, l2, l3, h0, h1, h2, h3; constexpr int b_ = (VB) * SHM_V + v_rd_off(d0, 0, 0); \
        FA_TRRD(l0, b_); FA_TRRD(h0, b_ + 2048); FA_TRRD(l1, b_ + 4096); FA_TRRD(h1, b_ + 6144); FA_TRRD(l2, b_ + 8192); FA_TRRD(h2, b_ + 10240); FA_TRRD(l3, b_ + 12288); FA_TRRD(h3, b_ + 14336); \
        asm volatile("s_waitcnt lgkmcnt(0)" ::: "memory"); SBAR(); \
        o[d0] = __builtin_amdgcn_mfma_f32_32x32x16_bf16(pa0, (bf16x8){l0[0], l0[1], l0[2], l0[3], h0[0], h0[1], h0[2], h0[3]}, o[d0], 0, 0, 0); \
        o[d0] = __builtin_amdgcn_mfma_f32_32x32x16_bf16(pa1, (bf16x8){l1[0], l1[1], l1[2], l1[3], h1[0], h1[1], h1[2], h1[3]}, o[d0], 0, 0, 0); \
        o[d0] = __builtin_amdgcn_mfma_f32_32x32x16_bf16(pa2, (bf16x8){l2[0], l2[1], l2[2], l2[3], h2[0], h2[1], h2[2], h2[3]}, o[d0], 0, 0, 0); \
        o[d0] = __builtin_amdgcn_mfma_f32_32x32x16_bf16(pa3, (bf16x8){l3[0], l3[1], l3[2], l3[3], h3[0], h3[1], h3[2], h3[3]}, o[d0], 0, 0, 0); } while (0)
#define CM_IMP(P, half_, t) do { _Pragma("unroll") for (int q4 = 0; q4 < 4; ++q4) { \
            float A_ = (2.0f * ((P[4 * q4] + P[4 * q4 + 1]) + P[4 * q4 + 2]) + P[4 * q4 + 3]) * inv_l, B_ = P[4 * q4 + 3] * inv_l; \
            A_ += __shfl_xor(A_, 1); A_ += __shfl_xor(A_, 2); B_ += __shfl_xor(B_, 1); B_ += __shfl_xor(B_, 2); \
            const int j_ = 2 * q4 + hi + 8 * (half_) + 16 * (t); \
            if (rh == 0) { __hip_atomic_fetch_add(&imps[tokl * 64 + j_], A_, __ATOMIC_RELAXED, __HIP_MEMORY_SCOPE_WORKGROUP); \
                if (j_ + 1 < 64) __hip_atomic_fetch_add(&imps[tokl * 64 + j_ + 1], B_, __ATOMIC_RELAXED, __HIP_MEMORY_SCOPE_WORKGROUP); } } } while (0)
#define CM_P2(BUF, t) do { if ((t) + 1 < NT) { CM_LOADK(((t) + 1) * 64); CM_LOADV(((t) + 1) * 64); } \
        { CM_SCORES(BUF, (t) * 64) \
          _Pragma("unroll") for (int r = 0; r < 16; ++r) { p0[r] = __builtin_amdgcn_exp2f(fmaf(p0[r], C2, mL)); p1[r] = __builtin_amdgcn_exp2f(fmaf(p1[r], C2, mL)); } \
          CM_IMP(p0, 0, t); CM_IMP(p1, 1, t); \
          bf16x8 pa0, pa1, pa2, pa3; FA_PK4(p0, 0, pa0); FA_PK4(p0, 8, pa1); FA_PK4(p1, 0, pa2); FA_PK4(p1, 8, pa3); \
          FA_PV_D0(BUF, 0); FA_PV_D0(BUF, 1); FA_PV_D0(BUF, 2); FA_PV_D0(BUF, 3); } \
        if ((t) + 1 < NT) { asm volatile("s_waitcnt vmcnt(0)" ::: "memory"); CM_WRITEK(1 - (BUF)); CM_WRITEV(1 - (BUF)); } \
        __syncthreads(); } while (0)
    for (int t = 0; t < NT; t += 2) { CM_P2(0, t); if (t + 1 < NT) CM_P2(1, t + 1); }
    asm volatile("s_waitcnt lgkmcnt(0)" ::: "memory");
    for (int tk = 0; tk < 8; ++tk) { const int sp = it.s0 + wid * 8 + tk, blk_t = sp >> 6, j = lane;
        const float is = imps[(wid * 8 + tk) * 64 + j];
        const bool forced = (j == 0) || (j == blk_t) || (j == blk_t - 1), valid = j <= blk_t;
        const float scv = forced ? 1e9f : (valid ? is : -1.0f);
        int rank = 0;
        for (int k = 0; k < 64; ++k) { const float vk = __shfl(scv, k); rank += (vk > scv || (vk == scv && k < j)) ? 1 : 0; }
        const unsigned long long msk = __ballot(rank < 16 && scv > -0.5f);
        if (lane == 0) it.sel[(long)(wid * 8 + tk) * 2] = msk; }
    FA_LAS unsigned char* stg = L + wid * (32 * OSTG);
    FA_LAS float* li_c = imps + wid * 512;
    li_c[r32] = inv_l; asm volatile("s_waitcnt lgkmcnt(0)" ::: "memory");
#pragma unroll
    for (int r = 0; r < 16; ++r) { const int orow = crow(r, hi); const float rl = li_c[orow];
#pragma unroll
        for (int d0 = 0; d0 < 4; ++d0) { const unsigned u = __builtin_bit_cast(unsigned, o[d0][r] * rl); *(FA_LAS unsigned short*)(stg + orow * OSTG + (d0 * 32 + r32) * 2) = (unsigned short)((u + 0x7fffu + ((u >> 16) & 1u)) >> 16); } }
    asm volatile("s_waitcnt lgkmcnt(0)" ::: "memory");
#pragma unroll
    for (int i = 0; i < 8; ++i) { const int id = lane + 64 * i, row = id >> 4, ch = id & 15;
        const u32x4 w = *(const FA_LAS u32x4*)(stg + row * OSTG + ch * 16);
        *(u32x4*)(it.O + (long)(wid * 8 + (row >> 2)) * it.os + (row & 3) * 128 + ch * 8) = w; }
    __syncthreads();
#undef CM_LOADK
#undef CM_LOADV
#undef CM_WRITEK
#undef CM_WRITEV
#undef CM_SCORES
#undef CM_P1
#undef CM_P2
#undef CM_IMP
#undef FA_PK4
#undef FA_TRRD
#undef FA_PV_D0
}
}

constexpr int D = 2048, NB = 4, S = 4096, M = NB * S;
constexpr int HD = 128;
constexpr int Z0W = 3840;
constexpr int Z_NQ = 0, Z_NKV = 1024, Z_QLAT = 2560, Z_KVLAT = 3072, Z_KPE = 3584, Z_NG = 3648;
constexpr int QMW = 1536, KVMW = 2048;
constexpr int FF = 5632, FFE = 7168, NE = 8;
constexpr int Z1W = 9216;
constexpr int NSLOT = (2 * M / 256 + NE) * 256;
constexpr float RMS_EPS = 1e-6f;

constexpr size_t MiB = 1u << 20;
constexpr size_t WS_CTL = 0, CTL_ZERO_BYTES = 1 * MiB;
constexpr size_t WS_MOD = 1 * MiB;
constexpr size_t WS_BIAS = 2 * MiB;
constexpr int BIAS_LD = 4096 + 64;
constexpr size_t WS_ROPE = 3 * MiB;
constexpr size_t WS_RINV = 8 * MiB;
constexpr size_t WS_SEL = 9 * MiB;
constexpr size_t WS_KC = 10 * MiB;
constexpr size_t WS_VC = 11 * MiB;
constexpr size_t WS_ROUTE = 12 * MiB;
constexpr size_t WS_LSE = 13 * MiB;
constexpr size_t WS_KPE = 15 * MiB;
constexpr size_t WS_W1T = 17 * MiB, WS_W2T = 19 * MiB, WS_CB1 = 20 * MiB;
constexpr size_t WS_WIN0 = 21 * MiB, WS_WUQ = 36 * MiB, WS_WUKV = 38 * MiB, WS_WOUT0 = 40 * MiB, WS_WGU0 = 48 * MiB, WS_WDN0 = 92 * MiB;
constexpr size_t WS_WIN1 = 114 * MiB, WS_WOUT1 = 150 * MiB, WS_WMGU = 154 * MiB, WS_WMDN = 602 * MiB;
constexpr size_t WS_X = 826 * MiB;
constexpr size_t WS_H = 954 * MiB;
constexpr size_t WS_R = 1018 * MiB;
constexpr size_t WS_Z0 = WS_R, WS_QM = WS_R + 120 * MiB, WS_KVM = WS_R + 168 * MiB, WS_OCMP = WS_R + 232 * MiB, WS_OWIN = WS_R + 264 * MiB, WS_CAT = WS_R + 328 * MiB;
constexpr size_t WS_ACT = WS_R;
constexpr size_t WS_Z1 = WS_R, WS_OP = WS_R + 288 * MiB, WS_OM = WS_R + 384 * MiB;
constexpr size_t WS_XB = WS_R, WS_ACTB = WS_R + 136 * MiB, WS_YB = WS_R;
constexpr size_t WS_END = WS_R + 612 * MiB;
static_assert(WS_Z0 + (size_t)M * Z0W * 2 <= WS_QM && WS_QM + (size_t)M * QMW * 2 <= WS_KVM && WS_KVM + (size_t)M * KVMW * 2 <= WS_OCMP && WS_CAT + (size_t)M * 2048 * 2 <= WS_END, "L0 map");
static_assert(WS_Z1 + (size_t)M * Z1W * 2 <= WS_OM && WS_XB + (size_t)NSLOT * D * 2 <= WS_ACTB && WS_ACTB + (size_t)NSLOT * FFE * 2 <= WS_END, "L1 map");
static_assert(WS_WMDN + (size_t)NE * D * FFE * 2 <= WS_X && WS_WMGU + (size_t)NE * 2 * FFE * D * 2 <= WS_WMDN, "weights map");
constexpr int CW_BAR = 4096;
constexpr int CW_CNT = 64;
constexpr int CW_TS = 128;
constexpr int CW_Q = 8192;

constexpr int RING_BYTES = 131072;
constexpr int SMALL_OFF = RING_BYTES;
constexpr int LDSCTL_OFF = RING_BYTES + 16384, MISC_OFF = LDSCTL_OFF;
constexpr int LDS_BYTES = LDSCTL_OFF + 256;
constexpr int NWAVES = 8;

#define GAS __attribute__((address_space(1)))
#define LAS __attribute__((address_space(3)))
typedef unsigned short bf16;
typedef unsigned v4u __attribute__((ext_vector_type(4)));
typedef unsigned v2u __attribute__((ext_vector_type(2)));
typedef float f32x4 __attribute__((ext_vector_type(4)));
typedef float f32x2 __attribute__((ext_vector_type(2)));
#define LDS_WAIT() asm volatile("s_waitcnt lgkmcnt(0)" ::: "memory")
__device__ __forceinline__ unsigned f2bf(float f) { unsigned u = __builtin_bit_cast(unsigned, f); return (u + 0x7fffu + ((u >> 16) & 1u)) >> 16; }
__device__ __forceinline__ unsigned pk2(float lo, float hi) { return f2bf(lo) | (f2bf(hi) << 16); }
__device__ __forceinline__ float bf2f(unsigned short b) { return __builtin_bit_cast(float, (unsigned)b << 16); }
__device__ __forceinline__ float bflo(unsigned w) { return __builtin_bit_cast(float, w << 16); }
__device__ __forceinline__ float bfhi(unsigned w) { return __builtin_bit_cast(float, w & 0xffff0000u); }
__device__ __forceinline__ float wave_sum(float v) {
#pragma unroll
    for (int o = 1; o < 64; o <<= 1) v += __shfl_xor(v, o);
    return v;
}
__device__ __forceinline__ float wave_max(float v) {
#pragma unroll
    for (int o = 1; o < 64; o <<= 1) v = fmaxf(v, __shfl_xor(v, o));
    return v;
}

#define XB_TMO      128
#define XB_XCNT(j)  (256  + 64 * (j))
#define XB_XSUB(j)  (1280 + 64 * (j))
#define XB_XGEN(j)  (2304 + 64 * (j))
#define XB_TOP      3328
#define XB_TOPGEN   3392
#define XCD_BAR_WORDS 3456
#define XB_SPIN_CAP (1u << 22)

__device__ __forceinline__ unsigned xb_ld(unsigned* p)              { return __hip_atomic_load(p, __ATOMIC_RELAXED, __HIP_MEMORY_SCOPE_AGENT); }
__device__ __forceinline__ unsigned xb_add(unsigned* p, unsigned v) { return __hip_atomic_fetch_add(p, v, __ATOMIC_RELAXED, __HIP_MEMORY_SCOPE_AGENT); }
__device__ __forceinline__ unsigned xb_xcc_id() { return (unsigned)__builtin_amdgcn_s_getreg((3 << 11) | 20) & 0xFu; }
#define XB_SPIN(cond, bar) do { unsigned _sp = 0; while (cond) { __builtin_amdgcn_s_sleep(1); \
    if ((++_sp & 255u) == 0u) { if (xb_ld(&(bar)[XB_TMO])) break; if (_sp > XB_SPIN_CAP) { atomicAdd(&(bar)[XB_TMO], 1u); break; } } } } while (0)

struct XcdBarrier {
    unsigned* bar; unsigned x;
    volatile LAS unsigned* st;
};

__device__ __forceinline__ XcdBarrier xcd_barrier_post(unsigned* bar, volatile LAS unsigned* st) {
    XcdBarrier b; b.bar = bar; b.x = xb_xcc_id(); b.st = st;
    if (threadIdx.x == 0) (void)xb_add(&bar[XB_XCNT(b.x)], 1u);
    return b;
}
__device__ __forceinline__ void xcd_barrier_complete(unsigned* bar, unsigned x, unsigned& nloc, unsigned& nx) {
    const unsigned G = gridDim.x * gridDim.y * gridDim.z;
    unsigned sum, cnt, mine, sp = 0u;
    for (;;) {
        sum = 0u; cnt = 0u; mine = 0u;
#pragma unroll
        for (unsigned j = 0; j < 16; ++j) { const unsigned c = xb_ld(&bar[XB_XCNT(j)]); sum += c; cnt += (c > 0u) ? 1u : 0u; mine = (j == x) ? c : mine; }
        if (sum == G) break;
        __builtin_amdgcn_s_sleep(1);
        if ((++sp & 255u) == 0u) { if (xb_ld(&bar[XB_TMO])) break; if (sp > XB_SPIN_CAP) { atomicAdd(&bar[XB_TMO], 1u); break; } }
    }
    nloc = mine > 0u ? mine : 1u; nx = cnt > 0u ? cnt : 1u;
}

__device__ __forceinline__ void xcd_barrier(const XcdBarrier& b) {
    asm volatile("s_waitcnt vmcnt(0)" ::: "memory");
    __syncthreads();
    if (threadIdx.x == 0) {
        unsigned* bar = b.bar;
        __builtin_amdgcn_s_waitcnt(0);
        unsigned nloc = b.st[0], nx = b.st[1];
        if (nloc == 0u) { xcd_barrier_complete(bar, b.x, nloc, nx); b.st[0] = nloc; b.st[1] = nx; }
        const unsigned old = xb_add(&bar[XB_XSUB(b.x)], 1u);
        const unsigned gen = old / nloc;
        if (old + 1u == (gen + 1u) * nloc) {
            __builtin_amdgcn_fence(__ATOMIC_RELEASE, "agent");
            asm volatile("s_waitcnt vmcnt(0)" ::: "memory");
            const unsigned og = xb_add(&bar[XB_TOP], 1u);
            const unsigned tg = og / nx;
            if (og + 1u == (tg + 1u) * nx) xb_add(&bar[XB_TOPGEN], 1u);
            else XB_SPIN(xb_ld(&bar[XB_TOPGEN]) == tg, bar);
            __builtin_amdgcn_fence(__ATOMIC_ACQUIRE, "agent");
            xb_add(&bar[XB_XGEN(b.x)], 1u);
            asm volatile("s_waitcnt vmcnt(0)" ::: "memory");
        } else {
            XB_SPIN(xb_ld(&bar[XB_XGEN(b.x)]) == gen, bar);
            __builtin_amdgcn_fence(__ATOMIC_ACQUIRE, "agent");
            asm volatile("s_waitcnt vmcnt(0)" ::: "memory");
        }
    }
    __syncthreads();
}


struct Args { const void* in[30]; float* out; unsigned char* ws; int ph_lo, ph_hi; };
struct Frame {
    unsigned char* lds;
    int tid, lane, wave, vcu, G, gw, NGW;
    unsigned char* ws;
};

__device__ __forceinline__ int t5_bucket(int n) {
    if (n < 16) return n < 0 ? 0 : n;
    int b = 16;
    b += (n >= 22); b += (n >= 30); b += (n >= 40); b += (n >= 54); b += (n >= 73); b += (n >= 99); b += (n >= 134); b += (n >= 182);
    b += (n >= 246); b += (n >= 332); b += (n >= 450); b += (n >= 609); b += (n >= 825); b += (n >= 1117); b += (n >= 1513);
    return b;
}

__device__ __forceinline__ unsigned pk4_fp8(float a, float b, float c, float d) { int w = 0; w = __builtin_amdgcn_cvt_pk_fp8_f32(a, b, w, false); w = __builtin_amdgcn_cvt_pk_fp8_f32(c, d, w, true); return (unsigned)w; }
template <int MAP, bool OUT8 = false>
__device__ __forceinline__ void p0_transpose_item(const float* W, const float* W2, int K, int Nsrc, int Ndst, bf16* WT, const float* kscale, float* scr, int item, int lane, float oscale = 1.0f) {
    const int nblk = Ndst / 64, kb = item / nblk, nb = item % nblk, k0 = 64 * kb, n0 = 64 * nb;
    const int n4 = (lane & 15) * 4, n = n0 + n4, kr = lane >> 4;
    const float* src = W; int sc = n; bool ok = true;
    if (MAP == 1) { if (n < Z_QLAT) sc = n; else if (n < Z_NG) sc = n + 24; else if (n < Z_NG + 24) sc = n - Z_NG + 2560; else ok = false; }
    if (MAP == 2) { const int g32 = n >> 5, w = n & 31; src = (w < 16) ? W : W2; sc = g32 * 16 + (w & 15); }
    f32x4 v[16];
#pragma unroll
    for (int i = 0; i < 16; ++i) v[i] = ok ? __builtin_nontemporal_load((const f32x4*)(src + (size_t)(k0 + 4 * i + kr) * Nsrc + sc)) : (f32x4){0.f, 0.f, 0.f, 0.f};
#pragma unroll
    for (int i = 0; i < 16; ++i) { const int kk = 4 * i + kr; f32x4 t = v[i]; if (kscale) t = t * kscale[k0 + kk]; float* d = scr + kk * 65 + n4; d[0] = t.x; d[1] = t.y; d[2] = t.z; d[3] = t.w; }
    LDS_WAIT(); asm volatile("" ::: "memory");
    if constexpr (OUT8) {
        const int kg = lane & 3;
#pragma unroll
        for (int p = 0; p < 4; ++p) { const int nn = 16 * p + (lane >> 2); const float* s = scr + (16 * kg) * 65 + nn;
            v4u o; o.x = pk4_fp8(s[0 * 65] * oscale, s[1 * 65] * oscale, s[2 * 65] * oscale, s[3 * 65] * oscale); o.y = pk4_fp8(s[4 * 65] * oscale, s[5 * 65] * oscale, s[6 * 65] * oscale, s[7 * 65] * oscale);
            o.z = pk4_fp8(s[8 * 65] * oscale, s[9 * 65] * oscale, s[10 * 65] * oscale, s[11 * 65] * oscale); o.w = pk4_fp8(s[12 * 65] * oscale, s[13 * 65] * oscale, s[14 * 65] * oscale, s[15 * 65] * oscale);
            *(v4u*)((unsigned char*)WT + (size_t)(n0 + nn) * K + k0 + 16 * kg) = o; }
    } else {
    const int kg = lane & 7;
#pragma unroll
    for (int p = 0; p < 8; ++p) { const int nn = 8 * p + (lane >> 3); const float* s = scr + (8 * kg) * 65 + nn;
        v4u o; o.x = pk2(s[0 * 65], s[1 * 65]); o.y = pk2(s[2 * 65], s[3 * 65]); o.z = pk2(s[4 * 65], s[5 * 65]); o.w = pk2(s[6 * 65], s[7 * 65]);
        *(v4u*)(WT + (size_t)(n0 + nn) * K + k0 + 8 * kg) = o; }
    }
    LDS_WAIT(); asm volatile("" ::: "memory");
}
template <int MAP, bool OUT8 = false>
__device__ __forceinline__ void p0_transpose(Frame& F, const float* W, const float* W2, int K, int Nsrc, int Ndst, bf16* WT, const float* kscale, float oscale = 1.0f) {
    float* scr = (float*)(F.lds + F.wave * 16640);
    const int nitems = (K / 64) * (Ndst / 64);
    for (int it = F.gw; it < nitems; it += F.NGW) p0_transpose_item<MAP, OUT8>(W, W2, K, Nsrc, Ndst, WT, kscale, scr, it, F.lane, oscale);
}

__device__ __forceinline__ void modnorm_row(const float* xrow, const float* g, const float* sc, const float* sh, bf16* orow, int lane, f32x4 (&v)[8]) {
    const f32x4* xr = (const f32x4*)xrow + lane; float s = 0.f;
#pragma unroll
    for (int j = 0; j < 8; ++j) { v[j] = xr[64 * j]; s += (v[j].x * v[j].x + v[j].y * v[j].y) + (v[j].z * v[j].z + v[j].w * v[j].w); }
    const float rinv = 1.0f / sqrtf(wave_sum(s) * (1.f / D) + RMS_EPS);
    unsigned long long* o8 = (unsigned long long*)orow + lane;
#pragma unroll
    for (int j = 0; j < 8; ++j) { const f32x4 gg = ((const f32x4*)g)[lane + 64 * j], cc = ((const f32x4*)sc)[lane + 64 * j], hh = ((const f32x4*)sh)[lane + 64 * j];
        v[j] = (v[j] * rinv) * gg * (cc + 1.0f) + hh;
        o8[64 * j] = (unsigned long long)pk2(v[j].x, v[j].y) | ((unsigned long long)pk2(v[j].z, v[j].w) << 32); }
}
__device__ __forceinline__ void modnorm_phase(Frame& F, const float* x, const float* g, const float* mod  , int sh_idx, bf16* H) {
    for (int b = 0; b < NB; ++b) { const float* mb = mod + (size_t)b * 6 * D; const float* sc = mb + (size_t)(sh_idx + 1) * D; const float* sh = mb + (size_t)sh_idx * D;
        const int s0 = F.gw, s1 = F.gw + F.NGW;
        const f32x4* x0 = (const f32x4*)(x + ((size_t)b * S + s0) * D) + F.lane; const f32x4* x1 = (const f32x4*)(x + ((size_t)b * S + s1) * D) + F.lane;
        f32x4 v0[8], v1[8], ca[8], cc[8];
#pragma unroll
        for (int j = 0; j < 8; ++j) { v0[j] = x0[64 * j]; v1[j] = x1[64 * j]; }
#pragma unroll
        for (int j = 0; j < 8; ++j) { ca[j] = ((const f32x4*)g)[F.lane + 64 * j] * (((const f32x4*)sc)[F.lane + 64 * j] + 1.0f); cc[j] = ((const f32x4*)sh)[F.lane + 64 * j]; }
        float q0 = 0.f, q1 = 0.f;
#pragma unroll
        for (int j = 0; j < 8; ++j) { q0 += (v0[j].x * v0[j].x + v0[j].y * v0[j].y) + (v0[j].z * v0[j].z + v0[j].w * v0[j].w); q1 += (v1[j].x * v1[j].x + v1[j].y * v1[j].y) + (v1[j].z * v1[j].z + v1[j].w * v1[j].w); }
        const float r0 = 1.0f / sqrtf(wave_sum(q0) * (1.f / D) + RMS_EPS), r1 = 1.0f / sqrtf(wave_sum(q1) * (1.f / D) + RMS_EPS);
        unsigned long long* o0 = (unsigned long long*)(H + ((size_t)b * S + s0) * D) + F.lane; unsigned long long* o1 = (unsigned long long*)(H + ((size_t)b * S + s1) * D) + F.lane;
#pragma unroll
        for (int j = 0; j < 8; ++j) { const f32x4 a = (v0[j] * r0) * ca[j] + cc[j], c2 = (v1[j] * r1) * ca[j] + cc[j];
            o0[64 * j] = (unsigned long long)pk2(a.x, a.y) | ((unsigned long long)pk2(a.z, a.w) << 32); o1[64 * j] = (unsigned long long)pk2(c2.x, c2.y) | ((unsigned long long)pk2(c2.z, c2.w) << 32); }
    }
}

__device__ __forceinline__ float gelu_tanh(float x) { const float u = 0.7978845608028654f * (x + 0.044715f * x * x * x); return 0.5f * x * (1.0f + tanhf(u)); }

__global__ void __launch_bounds__(NWAVES * 64, 2) fwd(Args args) {
    extern __shared__ __attribute__((aligned(16))) unsigned char lds[];
    Frame F;
    F.lds = lds; F.ws = args.ws;
    F.tid = threadIdx.x; F.lane = F.tid & 63; F.wave = __builtin_amdgcn_readfirstlane(F.tid >> 6);
    F.G = gridDim.x; { const int bx = blockIdx.x; F.vcu = (F.G % 8 == 0) ? (bx % 8) * (F.G / 8) + bx / 8 : bx; }
    F.gw = F.vcu * NWAVES + F.wave; F.NGW = F.G * NWAVES;
    unsigned char* ws = args.ws;
    unsigned* ctl = (unsigned*)(ws + WS_CTL);
    volatile LAS unsigned* MISC = (volatile LAS unsigned*)((LAS unsigned char*)lds + MISC_OFF);
    for (int u = F.tid; u < 64; u += NWAVES * 64) MISC[u] = 0u;
    __syncthreads();
    XcdBarrier bar; bar.bar = ctl + CW_BAR; bar.x = 0; bar.st = nullptr;
    if (MK_N_LAUNCHES == 1) bar = xcd_barrier_post(ctl + CW_BAR, MISC + 8);
    const int lo = args.ph_lo, hi = args.ph_hi;
#define IN(k) (lo <= (k) && (k) < hi)
#define MOE_WSCALE 64.0f
#define MOE_ASCALE 8.0f
#define SEAM(k) do { if (IN(k) && IN((k) + 1)) xcd_barrier(bar); } while (0)

    const float* x_in = (const float*)args.in[0]; const float* c_in = (const float*)args.in[1]; const int* positions = (const int*)args.in[2];
    const float* rel_bias = (const float*)args.in[3]; const float* ada_w = (const float*)args.in[4]; const float* ada_b = (const float*)args.in[5];
    const float* mix_norm_g = (const float*)args.in[6]; const float* ffn_norm_g = (const float*)args.in[7];
    const float* ab_w_in = (const float*)args.in[8]; const float* ab_w_out = (const float*)args.in[9];
    const float* cmp_pos_k = (const float*)args.in[10]; const float* cmp_w1_k = (const float*)args.in[11]; const float* cmp_w2_k = (const float*)args.in[12];
    const float* cmp_pos_v = (const float*)args.in[13]; const float* cmp_w1_v = (const float*)args.in[14]; const float* cmp_w2_v = (const float*)args.in[15];
    const float* q_norm_g = (const float*)args.in[16]; const float* kv_norm_g = (const float*)args.in[17]; const float* w_uq = (const float*)args.in[18]; const float* w_ukv = (const float*)args.in[19];
    const float* ffn_wg = (const float*)args.in[20]; const float* ffn_wu = (const float*)args.in[21]; const float* ffn_wd = (const float*)args.in[22];
    const float* c_w_in = (const float*)args.in[23]; const float* c_w_out = (const float*)args.in[24]; const float* w_router = (const float*)args.in[25];
    const float* moe_wg = (const float*)args.in[26]; const float* moe_wu = (const float*)args.in[27]; const float* moe_wd = (const float*)args.in[28]; const float* final_g = (const float*)args.in[29];
    float* MOD = (float*)(ws + WS_MOD); float* BIAS = (float*)(ws + WS_BIAS); float* ROPE = (float*)(ws + WS_ROPE); float* RINV = (float*)(ws + WS_RINV);
    unsigned long long* SEL = (unsigned long long*)(ws + WS_SEL); bf16* KC = (bf16*)(ws + WS_KC); bf16* VC = (bf16*)(ws + WS_VC); int* ROUTE = (int*)(ws + WS_ROUTE); bf16* KPE = (bf16*)(ws + WS_KPE);
    bf16* W_IN0 = (bf16*)(ws + WS_WIN0); bf16* W_UQ = (bf16*)(ws + WS_WUQ); bf16* W_UKV = (bf16*)(ws + WS_WUKV); bf16* W_OUT0 = (bf16*)(ws + WS_WOUT0); bf16* W_GU0 = (bf16*)(ws + WS_WGU0); bf16* W_DN0 = (bf16*)(ws + WS_WDN0);
    bf16* W_IN1 = (bf16*)(ws + WS_WIN1); bf16* W_OUT1 = (bf16*)(ws + WS_WOUT1); bf16* W_MGU = (bf16*)(ws + WS_WMGU); bf16* W_MDN = (bf16*)(ws + WS_WMDN);
    float* X = (float*)(ws + WS_X); bf16* H = (bf16*)(ws + WS_H);
    bf16* Z0 = (bf16*)(ws + WS_Z0); bf16* QM = (bf16*)(ws + WS_QM); bf16* KVM = (bf16*)(ws + WS_KVM); bf16* OCMP = (bf16*)(ws + WS_OCMP); bf16* OWIN = (bf16*)(ws + WS_OWIN); bf16* CAT = (bf16*)(ws + WS_CAT);
    bf16* W1T = (bf16*)(ws + WS_W1T); bf16* W2T = (bf16*)(ws + WS_W2T); float* CB1 = (float*)(ws + WS_CB1);
    float* LSEB = (float*)(ws + WS_LSE); bf16* OP = (bf16*)(ws + WS_OP);
    bf16* ACT = (bf16*)(ws + WS_ACT); bf16* Z1 = (bf16*)(ws + WS_Z1); bf16* OM = (bf16*)(ws + WS_OM); bf16* XB = (bf16*)(ws + WS_XB); bf16* ACTB = (bf16*)(ws + WS_ACTB); bf16* YB = (bf16*)(ws + WS_YB);
    PG8_LAS unsigned char* ring = (PG8_LAS unsigned char*)lds;

    if (IN(0)) {
        for (int job = 192 + (int)blockIdx.x; job < 194; job += F.G) {
            float* red = (float*)(lds + 32768); const int c = job - 192; const float* pos = c ? cmp_pos_v : cmp_pos_k; const float* w1 = c ? cmp_w1_v : cmp_w1_k;
            float a0 = 0.f, a1 = 0.f;
#pragma unroll 8
            for (int k = 0; k < 512; ++k) { const int kk = F.wave * 512 + k; const f32x2 wv = *(const f32x2*)(w1 + (size_t)kk * 128 + 2 * F.lane); const float pv = pos[kk]; a0 += pv * wv.x; a1 += pv * wv.y; }
            red[F.wave * 128 + 2 * F.lane] = a0; red[F.wave * 128 + 2 * F.lane + 1] = a1;
            __syncthreads();
            if (F.tid < 128) { float s = 0.f;
#pragma unroll
                for (int w = 0; w < 8; ++w) s += red[w * 128 + F.tid];
                CB1[c * 128 + F.tid] = s; }
            __syncthreads();
        }
        for (int job = blockIdx.x; job < 256; job += F.G) {
            float* cs = (float*)lds; float* red = (float*)(lds + 32768);
            for (int i = F.tid; i < 4 * D; i += 512) { const float cv = c_in[i]; cs[i] = cv / (1.0f + __expf(-cv)); }
            __syncthreads();
            const int l = job >> 7, col0 = (job & 127) * 96; const bool act = F.lane < 48;
            float acc[4][2] = {};
            const float* wp = ada_w + ((size_t)l * D + (size_t)F.wave * 256) * 12288 + col0 + 2 * (act ? F.lane : 0);
#pragma unroll 8
            for (int k = 0; k < 256; ++k) { const f32x2 wv = *(const f32x2*)(wp + (size_t)k * 12288); const int kk = F.wave * 256 + k;
#pragma unroll
                for (int b = 0; b < 4; ++b) { const float cv = cs[b * D + kk]; acc[b][0] += cv * wv.x; acc[b][1] += cv * wv.y; } }
            if (act) {
#pragma unroll
                for (int b = 0; b < 4; ++b) { red[(F.wave * 4 + b) * 96 + 2 * F.lane] = acc[b][0]; red[(F.wave * 4 + b) * 96 + 2 * F.lane + 1] = acc[b][1]; } }
            __syncthreads();
            if (F.tid < 384) { const int b = F.tid / 96, cc = F.tid % 96; float s = 0.f;
#pragma unroll
              for (int w = 0; w < 8; ++w) s += red[(w * 4 + b) * 96 + cc];
              MOD[((size_t)l * 4 + b) * 12288 + col0 + cc] = s + ada_b[(size_t)l * 12288 + col0 + cc]; }
            __syncthreads();
        }
        __syncthreads();
        p0_transpose<1>(F, ab_w_in, nullptr, D, 3672, Z0W, W_IN0, nullptr);
        p0_transpose<0>(F, w_uq, nullptr, 512, QMW, QMW, W_UQ, q_norm_g);
        p0_transpose<0>(F, w_ukv, nullptr, 512, KVMW, KVMW, W_UKV, kv_norm_g);
        p0_transpose<0>(F, ab_w_out, nullptr, D, D, D, W_OUT0, nullptr);
        p0_transpose<2>(F, ffn_wg, ffn_wu, D, FF, 2 * FF, W_GU0, nullptr);
        p0_transpose<0>(F, ffn_wd, nullptr, FF, D, D, W_DN0, nullptr);
        p0_transpose<0>(F, c_w_in, nullptr, D, Z1W, Z1W, W_IN1, nullptr);
        p0_transpose<0>(F, c_w_out, nullptr, 1024, D, D, W_OUT1, nullptr);
        p0_transpose<0>(F, cmp_w1_k, nullptr, 4096, 128, 128, W1T, nullptr); p0_transpose<0>(F, cmp_w1_v, nullptr, 4096, 128, 128, W1T + 128 * 4096, nullptr);
        p0_transpose<0>(F, cmp_w2_k, nullptr, 128, 128, 128, W2T, nullptr); p0_transpose<0>(F, cmp_w2_v, nullptr, 128, 128, 128, W2T + 128 * 128, nullptr);
        for (int e = 0; e < NE; ++e) {
            p0_transpose<2, true>(F, moe_wg + (size_t)e * D * FFE, moe_wu + (size_t)e * D * FFE, D, FFE, 2 * FFE, (bf16*)((unsigned char*)W_MGU + (size_t)e * 2 * FFE * D), nullptr, MOE_WSCALE);
            p0_transpose<0, true>(F, moe_wd + (size_t)e * FFE * D, nullptr, FFE, D, D, (bf16*)((unsigned char*)W_MDN + (size_t)e * D * FFE), nullptr, MOE_WSCALE);
        }
        for (int i = F.gw * 64 + F.lane; i < 8 * BIAS_LD; i += F.NGW * 64) { const int h = i / BIAS_LD, r = i % BIAS_LD - 64; BIAS[i] = rel_bias[t5_bucket(r) * 8 + h]; }
        for (int i = F.gw * 64 + F.lane; i < M * 32; i += F.NGW * 64) { const int m = i >> 5, f = i & 31;
            const float inv_freq = powf(10000.0f, -(float)(2 * f) / 64.0f); const float ang = (float)positions[m] * inv_freq;
            ROPE[(size_t)m * 64 + f] = cosf(ang); ROPE[(size_t)m * 64 + 32 + f] = sinf(ang); }
    }
    SEAM(0);
    if (IN(1)) modnorm_phase(F, x_in, mix_norm_g, MOD, 0, H);
    SEAM(1);
    if (IN(2)) { pg8::Gemm g{H, W_IN0, D, D, D}; pg8::StaticOrder So; So.init(M, Z0W, F.G, (int)blockIdx.x); pg8::EpiBf16 E{Z0, Z0W, nullptr};
        pg8::gemm_phase<pg8::EpiBf16, pg8::StaticOrder, PG_ALIGN, PG_SP2>(ring, g, So, E); }
    SEAM(2);
    if (IN(3)) {
        for (int m = F.gw; m < M; m += F.NGW) {
            const bf16* zr = Z0 + (size_t)m * Z0W;
#pragma unroll
            for (int w = 0; w < 2; ++w) { const v4u a = *(const v4u*)(zr + (w ? Z_KVLAT : Z_QLAT) + 8 * F.lane);
                float s = bflo(a.x) * bflo(a.x) + bfhi(a.x) * bfhi(a.x) + bflo(a.y) * bflo(a.y) + bfhi(a.y) * bfhi(a.y) + bflo(a.z) * bflo(a.z) + bfhi(a.z) * bfhi(a.z) + bflo(a.w) * bflo(a.w) + bfhi(a.w) * bfhi(a.w);
                s = wave_sum(s); if (F.lane == 0) RINV[(size_t)w * M + m] = 1.0f / sqrtf(s * (1.f / 512.f) + RMS_EPS); }
            if (F.lane < 32) { const float x1 = bf2f(zr[Z_KPE + F.lane]), x2 = bf2f(zr[Z_KPE + 32 + F.lane]); const float cs = ROPE[(size_t)m * 64 + F.lane], sn = ROPE[(size_t)m * 64 + 32 + F.lane];
                KPE[(size_t)m * 64 + F.lane] = (bf16)f2bf(x1 * cs - x2 * sn); KPE[(size_t)m * 64 + 32 + F.lane] = (bf16)f2bf(x2 * cs + x1 * sn); }
        }
        __syncthreads();
        for (int job = blockIdx.x; job < 256; job += F.G) {
            typedef short bfx8 __attribute__((ext_vector_type(8)));
            const int nt = job & 15, g = (job >> 4) & 1, b = (job >> 5) & 3, c = job >> 7, n0 = nt * 16;
            const int fr = F.lane & 15, fq = F.lane >> 4; int nrow = n0 + fr; if (nrow > 254) nrow = 254;
            const bf16* arow = Z0 + ((size_t)b * S + 16 * nrow) * Z0W + Z_NKV + c * 256 + g * 128 + fq * 8;
            const bf16* w1t = W1T + (size_t)c * 128 * 4096 + (size_t)fr * 4096 + fq * 8;
            f32x4 acc[8];
#pragma unroll
            for (int i = 0; i < 8; ++i) acc[i] = (f32x4){0.f, 0.f, 0.f, 0.f};
#pragma unroll 2
            for (int ks = 0; ks < 16; ++ks) { const int kk = F.wave * 512 + ks * 32, l = kk >> 7, d0 = kk & 127;
                const bfx8 af = *(const bfx8*)(arow + (size_t)l * Z0W + d0);
#pragma unroll
                for (int i = 0; i < 8; ++i) { const bfx8 bfr = *(const bfx8*)(w1t + (size_t)i * 16 * 4096 + kk); acc[i] = __builtin_amdgcn_mfma_f32_16x16x32_bf16(af, bfr, acc[i], 0, 0, 0); } }
            float* part = (float*)lds;
#pragma unroll
            for (int i = 0; i < 8; ++i)
#pragma unroll
                for (int j = 0; j < 4; ++j) part[(F.wave * 16 + fq * 4 + j) * 128 + i * 16 + fr] = acc[i][j];
            __syncthreads();
            bf16* hid = (bf16*)(lds + 65536);
            { const int row = F.tid >> 5, c4 = (F.tid & 31) * 4; f32x4 s = *(const f32x4*)(CB1 + c * 128 + c4);
#pragma unroll
              for (int w = 0; w < 8; ++w) s += *(const f32x4*)(part + (w * 16 + row) * 128 + c4);
              *(v2u*)(hid + row * 128 + c4) = (v2u){pk2(gelu_tanh(s.x), gelu_tanh(s.y)), pk2(gelu_tanh(s.z), gelu_tanh(s.w))}; }
            __syncthreads();
            { f32x4 o4 = {0.f, 0.f, 0.f, 0.f}; const bf16* w2t = W2T + (size_t)c * 128 * 128 + (size_t)(F.wave * 16 + fr) * 128 + fq * 8;
#pragma unroll
              for (int ks = 0; ks < 4; ++ks) { const bfx8 af = *(const bfx8*)(hid + fr * 128 + ks * 32 + fq * 8); const bfx8 bfr = *(const bfx8*)(w2t + ks * 32); o4 = __builtin_amdgcn_mfma_f32_16x16x32_bf16(af, bfr, o4, 0, 0, 0); }
              bf16* outp = (c ? VC : KC) + (((size_t)b * 2 + g) * 256) * 128 + F.wave * 16 + fr;
#pragma unroll
              for (int j = 0; j < 4; ++j) { const int n = n0 + fq * 4 + j; outp[(size_t)n * 128] = n < 255 ? (bf16)f2bf(o4[j]) : (bf16)0; } }
            __syncthreads();
        }
        __syncthreads();
        for (int Lx = blockIdx.x; Lx < 512; Lx += F.G) {
            const int qb = 15 - Lx / 32, bh = Lx % 32, b = bh >> 3, h = bh & 7, g = h >> 2; const bf16* zb = Z0 + (size_t)b * S * Z0W;
            fa::Item it{}; it.Q = zb + Z_NQ + h * 128; it.qs = Z0W; it.K = zb + Z_NKV + 4 * 256 + g * 128; it.ks = Z0W; it.V = zb + Z_NKV + 5 * 256 + g * 128; it.vs = Z0W;
            it.P0 = qb * 256; it.skv = S; it.W = 512; it.bias = BIAS + (size_t)h * BIAS_LD + 64; it.bstep = 1; it.O = OWIN + (size_t)b * S * 1024 + h * 128; it.os = 1024;
            fa::attn_block<0>(it, lds);
        }
    }
    SEAM(3);
    if (IN(4)) {
        { pg8::Gemm g{Z0 + Z_QLAT, W_UQ, Z0W, 512, 512}; pg8::StaticOrder So; So.init(M, QMW, F.G, (int)blockIdx.x); pg8::EpiBf16 E{QM, QMW, RINV};
          pg8::gemm_phase<pg8::EpiBf16, pg8::StaticOrder, PG_ALIGN, PG_SP2>(ring, g, So, E); }
        __syncthreads();
        { pg8::Gemm g{Z0 + Z_KVLAT, W_UKV, Z0W, 512, 512}; pg8::StaticOrder So; So.init(M, KVMW, F.G, (int)blockIdx.x); pg8::EpiBf16 E{KVM, KVMW, RINV + M};
          pg8::gemm_phase<pg8::EpiBf16, pg8::StaticOrder, PG_ALIGN, PG_SP2>(ring, g, So, E); }
        __syncthreads();
        for (int Lx = blockIdx.x; Lx < 512; Lx += F.G) { const int tb = 63 - Lx / 8, bg = Lx % 8, b = bg >> 1, g = bg & 1;
            fa::CmpItem it; it.Q = Z0 + ((size_t)b * S + tb * 64) * Z0W + Z_NQ + g * 512; it.qs = Z0W; it.K = KC + ((size_t)b * 2 + g) * 256 * 128; it.V = VC + ((size_t)b * 2 + g) * 256 * 128;
            it.bias = BIAS + (size_t)(g * 4) * BIAS_LD + 64; it.bld = BIAS_LD; it.s0 = tb * 64; it.O = OCMP + ((size_t)b * S + tb * 64) * 1024 + g * 512; it.os = 1024; it.sel = SEL + ((size_t)b * S + tb * 64) * 2 + g;

            fa::cmp_block(it, lds, SMALL_OFF); }
    }
    SEAM(4);
    if (IN(5)) {
        for (int Lx = blockIdx.x; Lx < 256; Lx += F.G) {
            const int x = Lx / 32, bh = Lx % 32, b = bh >> 3, h = bh & 7, g = h >> 2; const bf16* zb = Z0 + (size_t)b * S * Z0W;
            for (int pass = 0; pass < 2; ++pass) { const int qb = pass ? 15 - x : x;
                fa::Item it{}; it.Q = zb + Z_NQ + h * 128; it.qs = Z0W; it.K = zb + Z_NKV + 2 * 256 + g * 128; it.ks = Z0W; it.V = zb + Z_NKV + 3 * 256 + g * 128; it.vs = Z0W;
                it.P0 = qb * 256; it.skv = S; it.W = 1 << 20; it.bias = BIAS + (size_t)h * BIAS_LD + 64; it.bstep = 1; it.sel = SEL + (size_t)b * S * 2 + g; it.sels = 2;
                it.O = CAT + (size_t)b * S * 2048 + h * 128; it.os = 2048;
                it.M0 = OCMP + (size_t)b * S * 1024 + h * 128; it.M1 = OWIN + (size_t)b * S * 1024 + h * 128; it.ms = 1024; it.G = zb + Z_NG + h * 3; it.gs = Z0W;
                fa::attn_block<1>(it, lds); }
        }
        for (int Lx = blockIdx.x; Lx < 256; Lx += F.G) {
            const int x = Lx / 32, bh = Lx % 32, b = bh >> 3, h = bh & 7;
            for (int pass = 0; pass < 2; ++pass) { const int qb = pass ? 15 - x : x;
                fa::Item it{}; it.Q = QM + (size_t)b * S * QMW + h * 192; it.qs = QMW; it.rope = ROPE + (size_t)b * S * 64; it.ropes = 64;
                it.K = KVM + (size_t)b * S * KVMW + h * 256; it.ks = KVMW; it.K2 = KPE + (size_t)b * S * 64; it.k2s = 64; it.V = KVM + (size_t)b * S * KVMW + h * 256 + 128; it.vs = KVMW;
                it.P0 = qb * 256; it.skv = S; it.W = 1 << 20; it.O = CAT + (size_t)b * S * 2048 + 1024 + h * 128; it.os = 2048;
                fa::attn_block<2>(it, lds); }
        }
    }
    SEAM(5);
    if (IN(6)) { pg8::Gemm g{CAT, W_OUT0, 2048, 2048, 2048}; pg8::StaticOrder So; So.init(M, D, F.G, (int)blockIdx.x); pg8::EpiResid E{x_in, X, D, MOD + 2 * D, 6 * D, S / 256};
        pg8::gemm_phase<pg8::EpiResid, pg8::StaticOrder, PG_ALIGN, PG_SP2>(ring, g, So, E); }
    SEAM(6);
    if (IN(7)) modnorm_phase(F, X, ffn_norm_g, MOD, 3, H);
    SEAM(7);
    if (IN(8)) { pg8::Gemm g{H, W_GU0, D, D, D}; pg8::StaticOrder So; So.init(M, 2 * FF, F.G, (int)blockIdx.x); pg8::EpiSwiGLU E{ACT, FF};
        pg8::gemm_phase<pg8::EpiSwiGLU, pg8::StaticOrder, PG_ALIGN, PG_SP2>(ring, g, So, E); }
    SEAM(8);
    if (IN(9)) { pg8::Gemm g{ACT, W_DN0, FF, FF, FF}; pg8::StaticOrder So; So.init(M, D, F.G, (int)blockIdx.x); pg8::EpiResid E{X, X, D, MOD + 5 * D, 6 * D, S / 256};
        pg8::gemm_phase<pg8::EpiResid, pg8::StaticOrder, PG_ALIGN, PG_SP2>(ring, g, So, E); }
    SEAM(9);
    if (IN(10)) modnorm_phase(F, X, mix_norm_g + D, MOD + 4 * 12288, 0, H);
    SEAM(10);
    if (IN(11)) { pg8::Gemm g{H, W_IN1, D, D, D}; pg8::StaticOrder So; So.init(M, Z1W, F.G, (int)blockIdx.x); pg8::EpiBf16 E{Z1, Z1W, nullptr};
        pg8::gemm_phase<pg8::EpiBf16, pg8::StaticOrder, PG_ALIGN, PG_SP2>(ring, g, So, E); }
    SEAM(11);
    if (IN(12)) {
        for (int Lx = blockIdx.x; Lx < 1536; Lx += F.G) {
            const int p = Lx % 3, r_ = Lx / 3, bh = r_ % 32, sub = r_ / 32, b = bh >> 3, h = bh & 7;
            const int dil = p == 0 ? 1 : (p == 1 ? 4 : 16), res = p == 0 ? 0 : (p == 1 ? (sub & 3) : sub), qb = p == 0 ? sub : (p == 1 ? (sub >> 2) : 0);
            fa::Item it{}; it.Q = Z1 + ((size_t)b * S + res) * Z1W + p * 3072 + h * 128; it.qs = (long)dil * Z1W; it.K = it.Q + 1024; it.ks = it.qs; it.V = it.Q + 2048; it.vs = it.qs;
            it.P0 = qb * 256; it.skv = S / dil; it.W = 129; it.bias = BIAS + (size_t)h * BIAS_LD + 64; it.bstep = dil;
            it.O = OP + (size_t)p * M * 1024 + ((size_t)b * S + res) * 1024 + h * 128; it.os = (long)dil * 1024; it.LSE = LSEB + (size_t)p * M * 8 + ((size_t)b * S + res) * 8 + h; it.lses = (long)dil * 8;
            fa::attn_block<0>(it, lds);
        }
    }
    SEAM(12);
    if (IN(13)) {
        for (int m = F.gw; m < M; m += F.NGW) {
#pragma unroll 2
            for (int h = 0; h < 8; ++h) { const float l0 = LSEB[(size_t)m * 8 + h], l1 = LSEB[(size_t)(M + m) * 8 + h], l2 = LSEB[(size_t)(2 * M + m) * 8 + h];
                const float mx = fmaxf(l0, fmaxf(l1, l2)), e0 = __expf(l0 - mx), e1 = __expf(l1 - mx), e2 = __expf(l2 - mx), inv = 1.0f / (e0 + e1 + e2);
                const unsigned a0 = *(const unsigned*)(OP + (size_t)m * 1024 + h * 128 + 2 * F.lane), a1 = *(const unsigned*)(OP + (size_t)(M + m) * 1024 + h * 128 + 2 * F.lane), a2 = *(const unsigned*)(OP + (size_t)(2 * M + m) * 1024 + h * 128 + 2 * F.lane);
                *(unsigned*)(OM + (size_t)m * 1024 + h * 128 + 2 * F.lane) = pk2((e0 * bflo(a0) + e1 * bflo(a1) + e2 * bflo(a2)) * inv, (e0 * bfhi(a0) + e1 * bfhi(a1) + e2 * bfhi(a2)) * inv); }
        }
    }
    SEAM(13);
    if (IN(14)) { pg8::Gemm g{OM, W_OUT1, 1024, 1024, 1024}; pg8::StaticOrder So; So.init(M, D, F.G, (int)blockIdx.x); pg8::EpiResid E{X, X, D, MOD + 4 * 12288 + 2 * D, 6 * D, S / 256};
        pg8::gemm_phase<pg8::EpiResid, pg8::StaticOrder, PG_ALIGN, PG_SP2>(ring, g, So, E); }
    SEAM(14);
    if (IN(15)) {
        f32x4* wl = (f32x4*)lds; int* lcnt = (int*)(lds + 65536); int* lbase = lcnt + 8; int* rinfo = lcnt + 16;
        for (int i = F.tid; i < 4096; i += 512) { const int slot = i >> 6, l = i & 63, j = slot >> 3, q = (slot >> 1) & 3, half = slot & 1; wl[i] = *(const f32x4*)(w_router + (size_t)(4 * l + 256 * j + q) * 8 + half * 4); }
        if (F.tid < 8) lcnt[F.tid] = 0;
        __syncthreads();
        for (int k = 0; k < M / 2048; ++k) { const int m = F.gw + k * F.NGW; if (m >= M) break; const int b = m / S; const float* mb = MOD + 4 * 12288 + (size_t)b * 6 * D; f32x4 v[8];
            modnorm_row(X + (size_t)m * D, ffn_norm_g + D, mb + 4 * D, mb + 3 * D, H + (size_t)m * D, F.lane, v);
            float lg[8] = {};
#pragma unroll
            for (int j = 0; j < 8; ++j)
#pragma unroll
                for (int q = 0; q < 4; ++q) { const f32x4 wa = wl[((j * 4 + q) * 2 + 0) * 64 + F.lane], wb = wl[((j * 4 + q) * 2 + 1) * 64 + F.lane]; const float hv = v[j][q];
                    lg[0] += hv * wa.x; lg[1] += hv * wa.y; lg[2] += hv * wa.z; lg[3] += hv * wa.w; lg[4] += hv * wb.x; lg[5] += hv * wb.y; lg[6] += hv * wb.z; lg[7] += hv * wb.w; }
#pragma unroll
            for (int e = 0; e < 8; ++e) lg[e] = wave_sum(lg[e]);
            int e1 = 0; float v1 = lg[0];
#pragma unroll
            for (int e = 1; e < 8; ++e) if (lg[e] > v1) { v1 = lg[e]; e1 = e; }
            int e2 = -1; float v2 = -3.0e38f;
#pragma unroll
            for (int e = 0; e < 8; ++e) if (e != e1 && lg[e] > v2) { v2 = lg[e]; e2 = e; }
            if (F.lane == 0) { const float g1 = 1.0f / (1.0f + __expf(v2 - v1)), g2 = 1.0f - g1;
                const int r1 = __hip_atomic_fetch_add(lcnt + e1, 1, __ATOMIC_RELAXED, __HIP_MEMORY_SCOPE_WORKGROUP), r2 = __hip_atomic_fetch_add(lcnt + e2, 1, __ATOMIC_RELAXED, __HIP_MEMORY_SCOPE_WORKGROUP);
                int* ri = rinfo + (F.wave * 8 + k) * 8; ri[0] = e1; ri[1] = e2; ri[2] = r1; ri[3] = r2; ri[4] = __float_as_int(g1); ri[5] = __float_as_int(g2); }
        }
        __syncthreads();
        if (F.tid < 8) lbase[F.tid] = (int)atomicAdd(ctl + CW_CNT + F.tid, (unsigned)lcnt[F.tid]);
        __syncthreads();
        if (F.lane == 0) for (int k = 0; k < M / 2048; ++k) { const int m = F.gw + k * F.NGW; if (m >= M) break; const int* ri = rinfo + (F.wave * 8 + k) * 8; int* rt = ROUTE + (size_t)m * 8;
            rt[0] = ri[0]; rt[1] = ri[1]; rt[2] = ri[2] + lbase[ri[0]]; rt[3] = ri[3] + lbase[ri[1]]; rt[4] = ri[4]; rt[5] = ri[5]; }
    }
    SEAM(15);
    if (IN(16)) {
        unsigned ts[9]; ts[0] = 0;
#pragma unroll
        for (int e = 0; e < 8; ++e) ts[e + 1] = ts[e] + (__hip_atomic_load(ctl + CW_CNT + e, __ATOMIC_RELAXED, __HIP_MEMORY_SCOPE_AGENT) + 255u) / 256u;
        if (blockIdx.x == 0 && F.tid < 9) { unsigned v = ts[0];
#pragma unroll
            for (int e = 1; e < 9; ++e) v = (F.tid == e) ? ts[e] : v;
            ctl[CW_TS + F.tid] = v; }
        for (int m = F.gw; m < M; m += F.NGW) { const int* rt = ROUTE + (size_t)m * 8; const int e1 = rt[0], e2 = rt[1]; unsigned t1 = 0, t2 = 0;
#pragma unroll
            for (int e = 0; e < 8; ++e) { t1 = (e == e1) ? ts[e] : t1; t2 = (e == e2) ? ts[e] : t2; }
            const size_t d1 = (size_t)t1 * 256 + rt[2], d2 = (size_t)t2 * 256 + rt[3];
            const v4u* src = (const v4u*)(H + (size_t)m * D) + F.lane;
            v2u* o1 = (v2u*)((unsigned char*)XB + d1 * D) + F.lane; v2u* o2 = (v2u*)((unsigned char*)XB + d2 * D) + F.lane;
#pragma unroll
            for (int j = 0; j < 4; ++j) { const v4u w = src[64 * j]; v2u q; q.x = pk4_fp8(bflo(w.x), bfhi(w.x), bflo(w.y), bfhi(w.y)); q.y = pk4_fp8(bflo(w.z), bfhi(w.z), bflo(w.w), bfhi(w.w)); o1[64 * j] = q; o2[64 * j] = q; } }
    }
    SEAM(16);
    if (IN(17)) { pg8::Gemm g{XB, W_MGU, D / 2, D / 2, D / 2}; pg8::GroupedOrder So; So.init(ctl + CW_TS, 2 * FFE / 128, F.G, (int)blockIdx.x); pg8::EpiSwiGLUH E{ACTB, (unsigned char*)ACTB, FFE, 1.0f / MOE_WSCALE, MOE_ASCALE};
        pg8::gemm_phase<pg8::EpiSwiGLUH, pg8::GroupedOrder, PG_ALIGN, PG_SP2, true>(ring, g, So, E); }
    SEAM(17);
    if (IN(18)) { pg8::Gemm g{ACTB, W_MDN, FFE / 2, FFE / 2, FFE / 2}; pg8::GroupedOrder So; So.init(ctl + CW_TS, D / 128, F.G, (int)blockIdx.x); pg8::EpiBf16H E{YB, D, 1.0f / (MOE_WSCALE * MOE_ASCALE)};
        pg8::gemm_phase<pg8::EpiBf16H, pg8::GroupedOrder, PG_ALIGN, PG_SP2, true>(ring, g, So, E); }
    SEAM(18);
    if (IN(19)) {
        unsigned ts[9]; ts[0] = 0;
#pragma unroll
        for (int e = 0; e < 8; ++e) ts[e + 1] = ctl[CW_TS + e + 1];
#pragma unroll
        for (int b = 0; b < NB; ++b) {
            const float* gf = MOD + 4 * 12288 + (size_t)b * 6 * D + 5 * D;
            const int m0 = b * S + F.gw, m1 = m0 + F.NGW;
            const int* rt0 = ROUTE + (size_t)m0 * 8; const int* rt1 = ROUTE + (size_t)m1 * 8;
            const int e10 = rt0[0], e20 = rt0[1], r10 = rt0[2], r20 = rt0[3], e11 = rt1[0], e21 = rt1[1], r11 = rt1[2], r21 = rt1[3];
            const float g10 = __int_as_float(rt0[4]), g20 = __int_as_float(rt0[5]), g11 = __int_as_float(rt1[4]), g21 = __int_as_float(rt1[5]);
            unsigned t10 = 0, t20 = 0, t11 = 0, t21 = 0;
#pragma unroll
            for (int e = 0; e < 8; ++e) { t10 = (e == e10) ? ts[e] : t10; t20 = (e == e20) ? ts[e] : t20; t11 = (e == e11) ? ts[e] : t11; t21 = (e == e21) ? ts[e] : t21; }
            const v2u* ya0 = (const v2u*)(YB + ((size_t)t10 * 256 + r10) * D) + F.lane; const v2u* yb0 = (const v2u*)(YB + ((size_t)t20 * 256 + r20) * D) + F.lane;
            const v2u* ya1 = (const v2u*)(YB + ((size_t)t11 * 256 + r11) * D) + F.lane; const v2u* yb1 = (const v2u*)(YB + ((size_t)t21 * 256 + r21) * D) + F.lane;
            const f32x4* x0 = (const f32x4*)(X + (size_t)m0 * D) + F.lane; const f32x4* x1 = (const f32x4*)(X + (size_t)m1 * D) + F.lane;
            f32x4 v0[8], v1[8]; v2u a0[8], c0[8], a1[8], c1[8];
#pragma unroll
            for (int j = 0; j < 8; ++j) { v0[j] = x0[64 * j]; v1[j] = x1[64 * j]; a0[j] = ya0[64 * j]; c0[j] = yb0[64 * j]; a1[j] = ya1[64 * j]; c1[j] = yb1[64 * j]; }
            float q0 = 0.f, q1 = 0.f;
#pragma unroll
            for (int j = 0; j < 8; ++j) { const f32x4 gg = ((const f32x4*)gf)[F.lane + 64 * j]; f32x4 y;
                y.x = g10 * bflo(a0[j].x) + g20 * bflo(c0[j].x); y.y = g10 * bfhi(a0[j].x) + g20 * bfhi(c0[j].x); y.z = g10 * bflo(a0[j].y) + g20 * bflo(c0[j].y); y.w = g10 * bfhi(a0[j].y) + g20 * bfhi(c0[j].y);
                v0[j] = v0[j] + gg * y; q0 += (v0[j].x * v0[j].x + v0[j].y * v0[j].y) + (v0[j].z * v0[j].z + v0[j].w * v0[j].w);
                y.x = g11 * bflo(a1[j].x) + g21 * bflo(c1[j].x); y.y = g11 * bfhi(a1[j].x) + g21 * bfhi(c1[j].x); y.z = g11 * bflo(a1[j].y) + g21 * bflo(c1[j].y); y.w = g11 * bfhi(a1[j].y) + g21 * bfhi(c1[j].y);
                v1[j] = v1[j] + gg * y; q1 += (v1[j].x * v1[j].x + v1[j].y * v1[j].y) + (v1[j].z * v1[j].z + v1[j].w * v1[j].w); }
            const float ri0 = 1.0f / sqrtf(wave_sum(q0) * (1.f / D) + RMS_EPS), ri1 = 1.0f / sqrtf(wave_sum(q1) * (1.f / D) + RMS_EPS);
            f32x4* o0 = (f32x4*)(args.out + (size_t)m0 * D) + F.lane; f32x4* o1 = (f32x4*)(args.out + (size_t)m1 * D) + F.lane;
#pragma unroll
            for (int j = 0; j < 8; ++j) { const f32x4 fg = ((const f32x4*)final_g)[F.lane + 64 * j]; o0[64 * j] = (v0[j] * ri0) * fg; o1[64 * j] = (v1[j] * ri1) * fg; }
        }
    }
#undef IN
#undef SEAM
}

constexpr int N_PHASES = 20;
extern "C" void kernel_launch(void* const* d_in, const int* in_sizes, int n_in, void* d_out, int out_size, void* d_ws, size_t ws_size, hipStream_t stream) {
    static int grid = 0;
    if (grid == 0) {
        if (n_in != 30 || in_sizes[0] != M * D || out_size != M * D || ws_size < WS_END) { fprintf(stderr, "kernel_launch: shape/workspace mismatch: n_in %d in0 %d out %d ws %zu (need %zu)\n", n_in, n_in > 0 ? in_sizes[0] : -1, out_size, ws_size, (size_t)WS_END); grid = -1; return; }
        int dev = 0, cus = 0, per_cu = 0;
        if (hipGetDevice(&dev) != hipSuccess || hipDeviceGetAttribute(&cus, hipDeviceAttributeMultiprocessorCount, dev) != hipSuccess) { grid = -1; return; }
        if (hipFuncSetAttribute((const void*)fwd, hipFuncAttributeMaxDynamicSharedMemorySize, LDS_BYTES) != hipSuccess) { fprintf(stderr, "kernel_launch: hipFuncSetAttribute failed\n"); grid = -1; return; }
        if (hipOccupancyMaxActiveBlocksPerMultiprocessor(&per_cu, (const void*)fwd, NWAVES * 64, LDS_BYTES) != hipSuccess || per_cu < 1) fprintf(stderr, "kernel_launch: occupancy query reports %d\n", per_cu);
        (void)hipGetLastError();
        grid = cus;
        if (grid != 256) { fprintf(stderr, "kernel_launch: built for a 256-CU device (got %d)\n", cus); grid = -1; return; }
    }
    if (grid < 0) return;
    if (hipMemsetAsync((char*)d_ws + WS_CTL, 0, CTL_ZERO_BYTES, stream) != hipSuccess) return;
    Args a{};
    for (int i = 0; i < 30; ++i) a.in[i] = d_in[i];
    a.out = (float*)d_out; a.ws = (unsigned char*)d_ws;
    if (MK_N_LAUNCHES == 1) { a.ph_lo = 0; a.ph_hi = N_PHASES; hipLaunchKernelGGL(fwd, dim3(grid), dim3(NWAVES * 64), LDS_BYTES, stream, a); }
    else { for (int p = 0; p < N_PHASES; ++p) { a.ph_lo = p; a.ph_hi = p + 1; hipLaunchKernelGGL(fwd, dim3(grid), dim3(NWAVES * 64), LDS_BYTES, stream, a); } }
    const hipError_t le = hipPeekAtLastError();
    if (le != hipSuccess) fprintf(stderr, "kernel_launch: launch failed: %s\n", hipGetErrorName(le));
}
```

```cpp
#include <hip/hip_runtime.h>
#include <cstdio>
#include <cstdint>

#define WGM_G 4
#define PG_ALIGN true
#define PG_SP2 true
#ifndef MK_N_LAUNCHES
#define MK_N_LAUNCHES 1
#endif

namespace pg8 {
#define PG8_LAS __attribute__((address_space(3)))
typedef unsigned short bf16_t;
typedef short bf16x8 __attribute__((ext_vector_type(8)));
typedef float f32x4 __attribute__((ext_vector_type(4)));
typedef float f32x2 __attribute__((ext_vector_type(2)));
typedef unsigned u32x4 __attribute__((ext_vector_type(4)));
typedef unsigned u32x2 __attribute__((ext_vector_type(2)));
constexpr int BM = 256, BK = 64, HALF = 128, HTB = HALF * BK * 2  , STAGE_BYTES = 8 * HTB, NXCD = 8, WGM = 8;

__host__ __device__ __forceinline__ int lds_byte(int r, int c) { const int st = (r >> 4) * 2 + (c >> 5), rr = r & 15, cc = c & 31, ob = rr * 64 + cc * 2; return st * 1024 + (ob ^ (((ob >> 9) & 1) << 5)); }
__host__ __device__ __forceinline__ void stage_rc(int b, int& R, int& C) { const int st = b / 1024, sb = b % 1024, swz = sb ^ (((sb >> 9) & 1) << 5); R = (st >> 1) * 16 + swz / 64; C = (st & 1) * 32 + (swz % 64) / 2; }
__host__ __device__ __forceinline__ int perm32(int rho) { const int n = rho >> 4, i = rho & 15; return 8 * (i >> 2) + 4 * n + (i & 3); }

struct Unit { int pm, pn, pb; };
struct Gemm { const bf16_t* A; const bf16_t* Bt; int lda, ldb, K; };

struct StaticOrder {
    int nM, nN, nwg, G, c;
    __host__ __device__ void init(int M, int N, int G_, int c_) { nM = M / BM; nN = N / BM; nwg = nM * nN; G = G_; c = c_; }
    __host__ __device__ bool next(int i, Unit& u) const {
        const long L = (long)i * G + c; if (L >= nwg) return false;
        int wgid = (int)L; { const int q = nwg / NXCD, r = nwg % NXCD, xcd = wgid % NXCD, off = wgid / NXCD; wgid = (xcd < r ? xcd * (q + 1) : r * (q + 1) + (xcd - r) * q) + off; }
        const int nig = WGM * nN, gid = wgid / nig, fm = gid * WGM, gsz = (nM - fm) < WGM ? (nM - fm) : WGM;
        u.pm = fm + ((wgid % nig) % gsz); u.pn = (wgid % nig) / gsz; u.pb = u.pn; return true;
    }
    __device__ __forceinline__ void a_ready(const Unit&) const {}
    __device__ __forceinline__ void done(const Unit&) const {}
};
#ifndef WGM_G
#endif
struct GroupedOrder {
    int nN, G, c; int ts[9];
    __device__ __forceinline__ void init(const unsigned* tstart, int nN_, int G_, int c_) { nN = nN_; G = G_; c = c_;
#pragma unroll
        for (int e = 0; e < 9; ++e) ts[e] = (int)tstart[e]; }
    __device__ __forceinline__ bool next(int i, Unit& u) const {
        const long L = (long)i * G + c; if (L >= (long)ts[8] * nN) return false;
        int e = 0, us = 0, te = ts[1] - ts[0], t0 = ts[0];
#pragma unroll
        for (int k = 1; k < 8; ++k) { const int s = ts[k] * nN; if (L >= s) { e = k; us = s; te = ts[k + 1] - ts[k]; t0 = ts[k]; } }
        if (te <= 0) return false;
        int wgid = (int)L - us; { const int nwg = te * nN, q = nwg / NXCD, rr = nwg % NXCD, xcd = wgid % NXCD, off = wgid / NXCD; wgid = (xcd < rr ? xcd * (q + 1) : rr * (q + 1) + (xcd - rr) * q) + off; }
        const int nig = WGM_G * nN, gid = wgid / nig, fm = gid * WGM_G, gsz = (te - fm) < WGM_G ? (te - fm) : WGM_G;
        u.pm = t0 + fm + ((wgid % nig) % gsz); u.pn = (wgid % nig) / gsz; u.pb = e * nN + u.pn; return true;
    }
    __device__ __forceinline__ void a_ready(const Unit&) const {}
    __device__ __forceinline__ void done(const Unit&) const {}
};

typedef __bf16 bf16x2c __attribute__((ext_vector_type(2)));
__device__ __forceinline__ unsigned cvt_pk_bf16(float lo, float hi) { const f32x2 v = {lo, hi}; return __builtin_bit_cast(unsigned, __builtin_convertvector(v, bf16x2c)); }

struct EpiBf16 {
    static constexpr bool PERM = true, AFTER_DRAIN = false;
    bf16_t* O; int ldc; const float* rowscale;
    __device__ __forceinline__ void operator()(const f32x4 (&acc)[2][2][4][2], const Unit& u, int wr, int wc, int fr, int fq) const {
        const int row0 = u.pm * BM + wr * 64 + fr; const int col0 = u.pn * BM + wc * 32 + 8 * fq;
#pragma unroll
        for (int ai = 0; ai < 2; ++ai)
#pragma unroll
            for (int m = 0; m < 4; ++m) { const int row = row0 + ai * HALF + m * 16; bf16_t* rowp = O + (size_t)row * ldc + col0; const float sc = rowscale ? rowscale[row] : 1.f;
#pragma unroll
                for (int bj = 0; bj < 2; ++bj) { f32x4 v0 = acc[ai][bj][m][0] * sc, v1 = acc[ai][bj][m][1] * sc;
                    u32x4 w; w.x = cvt_pk_bf16(v0[0], v0[1]); w.y = cvt_pk_bf16(v0[2], v0[3]); w.z = cvt_pk_bf16(v1[0], v1[1]); w.w = cvt_pk_bf16(v1[2], v1[3]);
                    *(u32x4*)(rowp + bj * HALF) = w; } }
    }
};
struct EpiResid {
    static constexpr bool PERM = false, AFTER_DRAIN = false;
    const float* xin; float* xout; int ldc; const float* gate; int gstride; int tiles_per_b;
    __device__ __forceinline__ void operator()(const f32x4 (&acc)[2][2][4][2], const Unit& u, int wr, int wc, int fr, int fq) const {
        const int row0 = u.pm * BM + wr * 64 + fr, col0 = u.pn * BM + wc * 32 + 4 * fq;
        const float* gp = gate + (size_t)(u.pm / tiles_per_b) * gstride + col0;
        f32x4 gv[2][2];
#pragma unroll
        for (int bj = 0; bj < 2; ++bj)
#pragma unroll
            for (int n = 0; n < 2; ++n) gv[bj][n] = *(const f32x4*)(gp + bj * HALF + n * 16);
#pragma unroll
        for (int ai = 0; ai < 2; ++ai)
#pragma unroll
            for (int m = 0; m < 4; ++m) { const size_t off = (size_t)(row0 + ai * HALF + m * 16) * ldc + col0;
#pragma unroll
                for (int bj = 0; bj < 2; ++bj)
#pragma unroll
                    for (int n = 0; n < 2; ++n) { const f32x4 xi = *(const f32x4*)(xin + off + bj * HALF + n * 16);
                        *(f32x4*)(xout + off + bj * HALF + n * 16) = xi + gv[bj][n] * acc[ai][bj][m][n]; }
                asm volatile("" ::: "memory"); }
    }
};
__device__ __forceinline__ float silu_f(float g) { return g * __builtin_amdgcn_rcpf(1.0f + __builtin_amdgcn_exp2f(-1.4426950408889634f * g)); }
struct EpiSwiGLU {
    static constexpr bool PERM = false, AFTER_DRAIN = false;
    bf16_t* O; int ldo;
    __device__ __forceinline__ void operator()(const f32x4 (&acc)[2][2][4][2], const Unit& u, int wr, int wc, int fr, int fq) const {
        const int row0 = u.pm * BM + wr * 64 + fr, col0 = u.pn * HALF + wc * 16 + 4 * fq;
#pragma unroll
        for (int ai = 0; ai < 2; ++ai)
#pragma unroll
            for (int m = 0; m < 4; ++m) { bf16_t* rowp = O + (size_t)(row0 + ai * HALF + m * 16) * ldo + col0;
#pragma unroll
                for (int bj = 0; bj < 2; ++bj) { const f32x4 g = acc[ai][bj][m][0], up = acc[ai][bj][m][1];
                    u32x2 w; w.x = cvt_pk_bf16(silu_f(g[0]) * up[0], silu_f(g[1]) * up[1]); w.y = cvt_pk_bf16(silu_f(g[2]) * up[2], silu_f(g[3]) * up[3]);
                    *(u32x2*)(rowp + bj * 64) = w; } }
    }
};
struct EpiSwiGLU8 {
    static constexpr bool PERM = false, AFTER_DRAIN = false;
    unsigned char* O8; int ldo; float s, so;
    __device__ __forceinline__ void operator()(const f32x4 (&acc)[2][2][4][2], const Unit& u, int wr, int wc, int fr, int fq) const {
        const int row0 = u.pm * BM + wr * 64 + fr, col0 = u.pn * HALF + wc * 16 + 4 * fq;
#pragma unroll
        for (int ai = 0; ai < 2; ++ai)
#pragma unroll
            for (int m = 0; m < 4; ++m) { const size_t off = (size_t)(row0 + ai * HALF + m * 16) * ldo + col0;
#pragma unroll
                for (int bj = 0; bj < 2; ++bj) { const f32x4 g = acc[ai][bj][m][0] * s, up = acc[ai][bj][m][1] * s;
                    const float v0 = silu_f(g[0]) * up[0], v1 = silu_f(g[1]) * up[1], v2 = silu_f(g[2]) * up[2], v3 = silu_f(g[3]) * up[3];
                    int w = 0; w = __builtin_amdgcn_cvt_pk_fp8_f32(__builtin_amdgcn_fmed3f(v0 * so, -440.f, 440.f), __builtin_amdgcn_fmed3f(v1 * so, -440.f, 440.f), w, false);
                    w = __builtin_amdgcn_cvt_pk_fp8_f32(__builtin_amdgcn_fmed3f(v2 * so, -440.f, 440.f), __builtin_amdgcn_fmed3f(v3 * so, -440.f, 440.f), w, true); *(int*)(O8 + off + bj * 64) = w; } }
    }
};
struct EpiBf16S {
    static constexpr bool PERM = true, AFTER_DRAIN = false;
    bf16_t* O; int ldc; float s;
    __device__ __forceinline__ void operator()(const f32x4 (&acc)[2][2][4][2], const Unit& u, int wr, int wc, int fr, int fq) const {
        const int row0 = u.pm * BM + wr * 64 + fr; const int col0 = u.pn * BM + wc * 32 + 8 * fq;
#pragma unroll
        for (int ai = 0; ai < 2; ++ai)
#pragma unroll
            for (int m = 0; m < 4; ++m) { bf16_t* rowp = O + (size_t)(row0 + ai * HALF + m * 16) * ldc + col0;
#pragma unroll
                for (int bj = 0; bj < 2; ++bj) { const f32x4 v0 = acc[ai][bj][m][0] * s, v1 = acc[ai][bj][m][1] * s;
                    u32x4 w; w.x = cvt_pk_bf16(v0[0], v0[1]); w.y = cvt_pk_bf16(v0[2], v0[3]); w.z = cvt_pk_bf16(v1[0], v1[1]); w.w = cvt_pk_bf16(v1[2], v1[3]);
                    *(u32x4*)(rowp + bj * HALF) = w; } }
    }
};

template <class Epi, class Sched, bool ALIGN_EPI = false, bool SP2 = false, bool F8 = false, bool FW = false>
__device__ __forceinline__ void gemm_phase(PG8_LAS unsigned char* lds, const Gemm g, const Sched& S, const Epi& E) {
    const int tid = threadIdx.x, wid = __builtin_amdgcn_readfirstlane(tid >> 6), lane = tid & 63, wr = wid >> 2, wc = wid & 3, fr = lane & 15, fq = lane >> 4;
    const int K = g.K, nt = K / BK;
    unsigned voffA[2], voffB[2];
#pragma unroll
    for (int i = 0; i < 2; ++i) { int R, C; stage_rc(tid * 16 + i * 8192, R, C); const int Rb = Epi::PERM ? ((R & ~31) + perm32(R & 31)) : R;
        voffA[i] = (unsigned)(R * g.lda + C) * 2u; voffB[i] = (unsigned)(Rb * g.ldb + C) * 2u; }
    const size_t kstep = (size_t)(BK * 2);
    const size_t hstepA = (size_t)HALF * g.lda * 2, hstepB = (size_t)HALF * g.ldb * 2;
    const size_t tstepA = 2 * hstepA, tstepB = (F8 && !FW) ? hstepB : 2 * hstepB;
    const unsigned ldsw = (unsigned)wid * 1024u;
    const int aoff = lds_byte(wr * 64 + fr, fq * 8), boff = lds_byte(wc * 32 + fr, fq * 8);
#define PG8_SA(b, h) (((b) * 2 + (h)) * HTB)
#define PG8_SB(b, h) ((4 + (b) * 2 + (h)) * HTB)
#define PG8_STAGE(bufoff, gbase, voff) do { _Pragma("unroll") for (int _i = 0; _i < 2; ++_i) \
        __builtin_amdgcn_global_load_lds((const unsigned*)((const char*)(gbase) + (voff)[_i]), (PG8_LAS unsigned*)(lds + (bufoff) + ldsw + _i * 8192), 16, 0, 0); } while (0)
#define PG8_LDA(dst, b, h) do { _Pragma("unroll") for (int m = 0; m < 4; ++m) _Pragma("unroll") for (int k = 0; k < 2; ++k) dst[m][k] = *(const PG8_LAS bf16x8*)(lds + PG8_SA(b, h) + aoff + m * 2048 + k * 1024); } while (0)
#define PG8_LDB(dst, b, h) do { if constexpr (!F8 || FW || (h) == 0) { _Pragma("unroll") for (int n = 0; n < 2; ++n) _Pragma("unroll") for (int k = 0; k < 2; ++k) dst[n][k] = *(const PG8_LAS bf16x8*)(lds + PG8_SB(b, h) + boff + n * 2048 + k * 1024); } } while (0)
#define PG8_CAT(x, y) __builtin_shufflevector(x, y, 0, 1, 2, 3, 4, 5, 6, 7, 8, 9, 10, 11, 12, 13, 14, 15)
#define PG8_MMA(ai, bj, At, Bt) do { if constexpr (!F8 || FW || (bj) == 0) { __builtin_amdgcn_s_setprio(1); \
        if constexpr (F8) { _Pragma("unroll") for (int m = 0; m < 4; ++m) _Pragma("unroll") for (int n = 0; n < 2; ++n) \
            { const v8i_ b8_ = __builtin_bit_cast(v8i_, PG8_CAT(Bt[n][0], Bt[n][1])), a8_ = __builtin_bit_cast(v8i_, PG8_CAT(At[m][0], At[m][1])); \
            if constexpr (FW) asm volatile("v_mfma_scale_f32_16x16x128_f8f6f4 %0, %1, %2, %0, %3, %3 op_sel_hi:[0,0,0]" : "+v"(acc[ai][bj][m][n]) : "v"(b8_), "v"(a8_), "v"(0x7f7f7f7f)); \
            else acc[ai][bj][m][n] = __builtin_amdgcn_mfma_scale_f32_16x16x128_f8f6f4(b8_, a8_, acc[ai][bj][m][n], 0, 0, 0, 0x7f7f7f7f, 0, 0x7f7f7f7f); } } \
        else { _Pragma("unroll") for (int m = 0; m < 4; ++m) _Pragma("unroll") for (int n = 0; n < 2; ++n) _Pragma("unroll") for (int k = 0; k < 2; ++k) \
            acc[ai][bj][m][n] = __builtin_amdgcn_mfma_f32_16x16x32_bf16(Bt[n][k], At[m][k], acc[ai][bj][m][n], 0, 0, 0); } \
        __builtin_amdgcn_s_setprio(0); } } while (0)
#define PG8_WAIT_V(n) asm volatile("s_waitcnt vmcnt(" #n ")" ::: "memory")
#define PG8_WAIT_L(n) asm volatile("s_waitcnt lgkmcnt(" #n ")" ::: "memory")
#define PG8_BAR __builtin_amdgcn_s_barrier()
#define PG8_SCHED __builtin_amdgcn_sched_barrier(0)
    Unit cur, nxt; int ui = 0;
    if (!S.next(0, cur)) return;
    f32x4 acc[2][2][4][2];
#pragma unroll
    for (int a = 0; a < 2; ++a)
#pragma unroll
        for (int b = 0; b < 2; ++b)
#pragma unroll
            for (int m = 0; m < 4; ++m)
#pragma unroll
                for (int n = 0; n < 2; ++n) acc[a][b][m][n] = (f32x4){0.f, 0.f, 0.f, 0.f};
    bf16x8 At[4][2], B0[2][2], B1[2][2];
    typedef int v8i_ __attribute__((ext_vector_type(8))); typedef short bf16x16_ __attribute__((ext_vector_type(16)));
    const char* cA = (const char*)g.A + (size_t)cur.pm * tstepA; const char* cB = (const char*)g.Bt + (size_t)cur.pb * tstepB;
    S.a_ready(cur);
    if constexpr (SP2) {
        PG8_STAGE(PG8_SB(0, 0), cB, voffB); if constexpr (!F8 || FW) PG8_STAGE(PG8_SB(0, 1), cB + hstepB, voffB); PG8_STAGE(PG8_SA(0, 0), cA, voffA); PG8_STAGE(PG8_SA(0, 1), cA + hstepA, voffA);
        if (wr == 1) PG8_BAR;
        PG8_WAIT_V(2); PG8_BAR;
        PG8_STAGE(PG8_SB(1, 0), cB + kstep, voffB); PG8_STAGE(PG8_SA(1, 0), cA + kstep, voffA); if constexpr (!F8 || FW) PG8_STAGE(PG8_SB(1, 1), cB + hstepB + kstep, voffB);
        if constexpr (F8 && !FW) PG8_WAIT_V(4); else PG8_WAIT_V(6); PG8_BAR;
    } else {
        PG8_STAGE(PG8_SB(0, 0), cB, voffB); PG8_STAGE(PG8_SA(0, 0), cA, voffA); PG8_STAGE(PG8_SB(0, 1), cB + hstepB, voffB); PG8_STAGE(PG8_SA(0, 1), cA + hstepA, voffA);
        if (wr == 1) PG8_BAR;
        PG8_WAIT_V(4); PG8_BAR;
        PG8_STAGE(PG8_SB(1, 0), cB + kstep, voffB); PG8_STAGE(PG8_SA(1, 0), cA + kstep, voffA); PG8_STAGE(PG8_SB(1, 1), cB + hstepB + kstep, voffB);
        PG8_WAIT_V(6); PG8_BAR;
    }
    for (;;) {
        const bool has_next = S.next(ui + 1, nxt);
        const char* nA = has_next ? (const char*)g.A + (size_t)nxt.pm * tstepA : cA; const char* nB = has_next ? (const char*)g.Bt + (size_t)nxt.pb * tstepB : cB;
        for (int t = 0; t < nt; t += 2) {
            const bool last = (t == nt - 2);
            const char* a1 = cA + (size_t)(t + 1) * kstep;
            const char* a2 = last ? nA : cA + (size_t)(t + 2) * kstep; const char* b2 = last ? nB : cB + (size_t)(t + 2) * kstep;
            const char* a3 = a2 + kstep; const char* b3 = b2 + kstep;
            if (last && has_next) S.a_ready(nxt);
            if constexpr (SP2) {
            PG8_LDB(B0, 0, 0); PG8_LDB(B1, 0, 1); PG8_SCHED; PG8_LDA(At, 0, 0); PG8_STAGE(PG8_SA(1, 1), a1 + hstepA, voffA);
            if constexpr (F8 && !FW) PG8_WAIT_V(6); else PG8_WAIT_V(8); PG8_WAIT_L(0); PG8_BAR; PG8_MMA(0, 0, At, B0); PG8_MMA(0, 1, At, B1); PG8_BAR; PG8_SCHED;
            PG8_LDA(At, 0, 1); PG8_STAGE(PG8_SB(0, 0), b2, voffB); if constexpr (!F8 || FW) PG8_STAGE(PG8_SB(0, 1), b2 + hstepB, voffB); PG8_STAGE(PG8_SA(0, 0), a2, voffA);
            if constexpr (F8 && !FW) PG8_WAIT_V(6); else PG8_WAIT_V(8); PG8_WAIT_L(0); PG8_BAR; PG8_MMA(1, 0, At, B0); PG8_MMA(1, 1, At, B1); PG8_BAR; PG8_SCHED;
            PG8_LDB(B0, 1, 0); PG8_LDB(B1, 1, 1); PG8_SCHED; PG8_LDA(At, 1, 0); PG8_STAGE(PG8_SA(0, 1), a2 + hstepA, voffA);
            if constexpr (F8 && !FW) PG8_WAIT_V(6); else PG8_WAIT_V(8); PG8_WAIT_L(0); PG8_BAR; PG8_MMA(0, 0, At, B0); PG8_MMA(0, 1, At, B1); PG8_BAR; PG8_SCHED;
            PG8_LDA(At, 1, 1); PG8_STAGE(PG8_SB(1, 0), b3, voffB); if constexpr (!F8 || FW) PG8_STAGE(PG8_SB(1, 1), b3 + hstepB, voffB); PG8_STAGE(PG8_SA(1, 0), a3, voffA);
            if constexpr (F8 && !FW) PG8_WAIT_V(6); else PG8_WAIT_V(8); PG8_WAIT_L(0); PG8_BAR; PG8_MMA(1, 0, At, B0); PG8_MMA(1, 1, At, B1); PG8_BAR; PG8_SCHED;
            } else {
            PG8_LDB(B0, 0, 0); PG8_SCHED; PG8_LDA(At, 0, 0); PG8_STAGE(PG8_SA(1, 1), a1 + hstepA, voffA);
            PG8_WAIT_L(8); PG8_BAR; PG8_WAIT_L(0); PG8_MMA(0, 0, At, B0); PG8_BAR; PG8_SCHED;
            PG8_LDB(B1, 0, 1); PG8_STAGE(PG8_SB(0, 0), b2, voffB);
            PG8_BAR; PG8_WAIT_L(0); PG8_MMA(0, 1, At, B1); PG8_BAR;
            PG8_LDA(At, 0, 1); PG8_STAGE(PG8_SA(0, 0), a2, voffA);
            PG8_BAR; PG8_WAIT_L(0); PG8_MMA(1, 0, At, B0); PG8_BAR; PG8_SCHED;
            PG8_STAGE(PG8_SB(0, 1), b2 + hstepB, voffB);
            PG8_WAIT_V(6); PG8_BAR; PG8_MMA(1, 1, At, B1); PG8_BAR;
            PG8_LDB(B0, 1, 0); PG8_SCHED; PG8_LDA(At, 1, 0); PG8_STAGE(PG8_SA(0, 1), a2 + hstepA, voffA);
            PG8_WAIT_L(8); PG8_BAR; PG8_WAIT_L(0); PG8_MMA(0, 0, At, B0); PG8_BAR; PG8_SCHED;
            PG8_LDB(B1, 1, 1); PG8_STAGE(PG8_SB(1, 0), b3, voffB);
            PG8_BAR; PG8_WAIT_L(0); PG8_MMA(0, 1, At, B1); PG8_BAR;
            PG8_LDA(At, 1, 1); PG8_STAGE(PG8_SA(1, 0), a3, voffA);
            PG8_BAR; PG8_WAIT_L(0); PG8_MMA(1, 0, At, B0); PG8_BAR; PG8_SCHED;
            PG8_STAGE(PG8_SB(1, 1), b3 + hstepB, voffB);
            PG8_WAIT_V(6); PG8_BAR; PG8_MMA(1, 1, At, B1); PG8_BAR;
            }
        }
        if constexpr (ALIGN_EPI) { if (wr == 0) PG8_BAR; }
        if constexpr (F8 && FW) asm volatile("s_nop 15\n\ts_nop 15" ::: "memory");
        if constexpr (!Epi::AFTER_DRAIN) { E(acc, cur, wr, wc, fr, fq); S.done(cur); }
        if (!has_next) break;
#pragma unroll
        for (int a = 0; a < 2; ++a)
#pragma unroll
            for (int b = 0; b < 2; ++b)
#pragma unroll
                for (int m = 0; m < 4; ++m)
#pragma unroll
                    for (int n = 0; n < 2; ++n) acc[a][b][m][n] = (f32x4){0.f, 0.f, 0.f, 0.f};
        cur = nxt; cA = nA; cB = nB; ++ui;
        if constexpr (ALIGN_EPI) { if (wr == 1) PG8_BAR; }
    }
    PG8_WAIT_V(0);
    if constexpr (!ALIGN_EPI) { if (wr == 0) PG8_BAR; }
    PG8_BAR;
    if constexpr (Epi::AFTER_DRAIN) { E.fused(acc, cur, wr, wc, fr, fq, lds, wid, lane); S.done(cur); }
#undef PG8_SA
#undef PG8_SB
#undef PG8_STAGE
#undef PG8_CAT
#undef PG8_LDA
#undef PG8_LDB
#undef PG8_MMA
#undef PG8_WAIT_V
#undef PG8_WAIT_L
#undef PG8_BAR
#undef PG8_SCHED
}

}

namespace fa {
#define FA_LAS __attribute__((address_space(3)))
typedef unsigned short bf16;
typedef short bf16x8 __attribute__((ext_vector_type(8)));
typedef short s16x4 __attribute__((ext_vector_type(4)));
typedef float f32x16 __attribute__((ext_vector_type(16)));
typedef float f32x4 __attribute__((ext_vector_type(4)));
typedef unsigned u32x4 __attribute__((ext_vector_type(4)));
constexpr int QB = 256, QBLK = 32, KVBLK = 64;
constexpr int SHM_K = 16384, SHM_V = 16384, SHM_K2 = 8192;
constexpr int OFF_V = 0, OFF_K = 2 * SHM_V, OFF_K2 = OFF_K + 2 * SHM_K, OFF_WS = OFF_K2 + 2 * SHM_K2, WS_PER_WAVE = 1024, OFF_TAB = OFF_WS + 8 * WS_PER_WAVE;
constexpr int TAB_PAD = 320, TAB_MAX = 4096 + TAB_PAD;
constexpr int LDS_END = OFF_TAB + TAB_MAX * 4;
constexpr int OSTG = 272;
static_assert(LDS_END <= 131072 && 8 * 32 * OSTG <= OFF_WS, "attention LDS map");
#define KSWZ(row, colB) ((row) * 256 + ((colB) ^ (((row) & 7) << 4)))
#define K2SWZ(row, colB) ((row) * 128 + ((colB) ^ (((row) & 7) << 4)))
#define SBAR() __builtin_amdgcn_sched_barrier(0)
__device__ __forceinline__ int v_st(int k, int c) { const int kk = (k & ~0xC) | ((k & 4) << 1) | ((k & 8) >> 1); return ((kk >> 3) * 4 + (c >> 5)) * 512 + ((kk & 7) * 32 + (c & 31)) * 2; }
__device__ __forceinline__ int v_rd_base(int lane) { return ((lane & 3) << 3) | (((lane >> 2) & 3) << 6) | (((lane >> 4) & 1) << 5) | (((lane >> 5) & 1) << 8); }
constexpr int v_rd_off(int d0, int ks, int half) { return d0 * 512 + ks * 4096 + half * 2048; }
__device__ __forceinline__ int crow(int r, int hi) { return (r & 3) + 8 * (r >> 2) + 4 * hi; }
typedef float f32x2c __attribute__((ext_vector_type(2)));
typedef __bf16 bf16x2c __attribute__((ext_vector_type(2)));
__device__ __forceinline__ unsigned cvtpk(float lo, float hi) { const f32x2c v = {lo, hi}; return __builtin_bit_cast(unsigned, __builtin_convertvector(v, bf16x2c)); }

struct Item {
    const bf16* Q; long qs;
    const float* rope; long ropes;
    const bf16* K; long ks; const bf16* K2; long k2s; const bf16* V; long vs;
    int P0, skv, W;
    const float* bias; int bstep;
    const unsigned long long* sel; long sels;
    bf16* O; long os;
    float* LSE; long lses;
    const bf16* M0; const bf16* M1; long ms; const bf16* G; long gs;
};

template <int VAR>
__device__ __forceinline__ void attn_block(const Item& it, unsigned char* lds_g) {
    constexpr bool HAS_BIAS = VAR != 2, HAS_SEL = VAR == 1, HAS_K2 = VAR == 2;
    constexpr float SCALE = HAS_K2 ? 0.07216878364870322f : 0.08838834764831845f, C2 = 1.4426950408889634f * SCALE, THR = 8.f;
    FA_LAS unsigned char* L = (FA_LAS unsigned char*)lds_g;
    const int tid = threadIdx.x, wid = __builtin_amdgcn_readfirstlane(tid >> 6), lane = tid & 63, r32 = lane & 31, hi = lane >> 5;
    const int W = it.W;
    const int j_lo = (it.P0 - W + 1 > 0) ? (it.P0 - W + 1) / KVBLK : 0;
    int j_hi = (it.P0 + QB - 1) / KVBLK + 1; if (j_hi > it.skv / KVBLK) j_hi = it.skv / KVBLK;
    const int NT = j_hi - j_lo;
    const int qlo = it.P0 + wid * QBLK, qm = qlo + r32 - 4 * hi;
    FA_LAS float* wsl = (FA_LAS float*)(L + OFF_WS + wid * WS_PER_WAVE); FA_LAS float* li_l = wsl; FA_LAS float* al_l = wsl + 32;
    FA_LAS float* tab = (FA_LAS float*)(L + OFF_TAB);
    const int sr = tid >> 4, sc = (tid & 15) * 8, vst0 = v_st(sr, sc), vst1 = v_st(32 + sr, sc), kws = KSWZ(sr, sc * 2);
    const int k2r = tid >> 3, k2c = (tid & 7) * 8, k2ws = K2SWZ(k2r, k2c * 2);
    const int vb0 = OFF_V + v_rd_base(lane);
    bf16x8 qr[8]; bf16x8 qr2[4];
    { const bf16* qp = it.Q + (long)(qlo + r32) * it.qs + hi * 8;
#pragma unroll
      for (int d0 = 0; d0 < 8; ++d0) qr[d0] = *(const bf16x8*)(qp + d0 * 16);
      if constexpr (HAS_K2) {
          const float* rp = it.rope + (long)(qlo + r32) * it.ropes + hi * 8;
          bf16x8 raw[4];
#pragma unroll
          for (int d0 = 0; d0 < 4; ++d0) raw[d0] = *(const bf16x8*)(qp + 128 + d0 * 16);
#pragma unroll
          for (int d0 = 0; d0 < 2; ++d0) { const f32x4 c0 = *(const f32x4*)(rp + d0 * 16), c1 = *(const f32x4*)(rp + d0 * 16 + 4), s0 = *(const f32x4*)(rp + 32 + d0 * 16), s1 = *(const f32x4*)(rp + 32 + d0 * 16 + 4);
              float o1[8], o2[8];
#pragma unroll
              for (int j = 0; j < 8; ++j) { const float x1 = __builtin_bit_cast(float, (unsigned)(unsigned short)raw[d0][j] << 16), x2 = __builtin_bit_cast(float, (unsigned)(unsigned short)raw[d0 + 2][j] << 16);
                  const float cs = j < 4 ? c0[j & 3] : c1[j & 3], sn = j < 4 ? s0[j & 3] : s1[j & 3]; o1[j] = x1 * cs - x2 * sn; o2[j] = x2 * cs + x1 * sn; }
              u32x4 w1 = {cvtpk(o1[0], o1[1]), cvtpk(o1[2], o1[3]), cvtpk(o1[4], o1[5]), cvtpk(o1[6], o1[7])}, w2 = {cvtpk(o2[0], o2[1]), cvtpk(o2[2], o2[3]), cvtpk(o2[4], o2[5]), cvtpk(o2[6], o2[7])};
              qr2[d0] = __builtin_bit_cast(bf16x8, w1); qr2[d0 + 2] = __builtin_bit_cast(bf16x8, w2); }
      }
    }
    unsigned long long selm = ~0ull;
    if constexpr (HAS_SEL) selm = __hip_atomic_load(it.sel + (long)(qlo + r32) * it.sels, __ATOMIC_RELAXED, __HIP_MEMORY_SCOPE_AGENT);
    if constexpr (HAS_BIAS) {
        int rmax = W + 320; if (rmax > 4096) rmax = 4096;
        for (int i = tid; i < rmax + TAB_PAD; i += 512) { int r = i - TAB_PAD; r = r < -64 ? -64 : r; long gi = (long)r * it.bstep; gi = gi > 4095 ? 4095 : gi; tab[i] = it.bias[gi] * (1.0f / SCALE); }
    }
    bf16x8 st_k0, st_k1, st_v0, st_v1, st_k2;
#define FA_LOAD(kb_) do { const long r0_ = (long)((kb_) + sr), r1_ = r0_ + 32; \
        st_v0 = *(const bf16x8*)(it.V + r0_ * it.vs + sc); st_v1 = *(const bf16x8*)(it.V + r1_ * it.vs + sc); \
        st_k0 = *(const bf16x8*)(it.K + r0_ * it.ks + sc); st_k1 = *(const bf16x8*)(it.K + r1_ * it.ks + sc); \
        if constexpr (HAS_K2) st_k2 = *(const bf16x8*)(it.K2 + (long)((kb_) + k2r) * it.k2s + k2c); } while (0)
#define FA_WRITE(bf_) do { *(FA_LAS bf16x8*)(L + OFF_V + (bf_) * SHM_V + vst0) = st_v0; *(FA_LAS bf16x8*)(L + OFF_V + (bf_) * SHM_V + vst1) = st_v1; \
        *(FA_LAS bf16x8*)(L + OFF_K + (bf_) * SHM_K + kws) = st_k0; *(FA_LAS bf16x8*)(L + OFF_K + (bf_) * SHM_K + kws + 32 * 256) = st_k1; \
        if constexpr (HAS_K2) *(FA_LAS bf16x8*)(L + OFF_K2 + (bf_) * SHM_K2 + k2ws) = st_k2; } while (0)
    FA_LOAD(j_lo * KVBLK);
    asm volatile("s_waitcnt vmcnt(0)" ::: "memory");
    FA_WRITE(0);
    __syncthreads();
    float m_reg = -1e30f, l_reg = 0.f; f32x16 o[4] = {};
#define FA_KBASE(t) ((j_lo + (t)) * KVBLK)
#define FA_STEP(BUF, t) do { \
        const int kb_ = FA_KBASE(t); \
        if ((t) + 1 < NT) FA_LOAD(FA_KBASE((t) + 1)); \
        bool act_ = (kb_ <= qlo + QBLK - 1) && (kb_ + KVBLK - 1 >= qlo - W + 1); \
        bool allow_ = true; \
        if constexpr (HAS_SEL) { allow_ = (bool)((selm >> (kb_ >> 6)) & 1ull); } \
        if (act_) { \
            f32x16 p0 = {}, p1 = {}; \
            { const int ka_ = OFF_K + (BUF) * SHM_K; \
              _Pragma("unroll") for (int d0 = 0; d0 < 8; ++d0) { \
                const bf16x8 b0 = *(const FA_LAS bf16x8*)(L + ka_ + KSWZ(r32, (d0 * 16 + hi * 8) * 2)); \
                const bf16x8 b1 = *(const FA_LAS bf16x8*)(L + ka_ + 32 * 256 + KSWZ(r32, (d0 * 16 + hi * 8) * 2)); \
                p0 = __builtin_amdgcn_mfma_f32_32x32x16_bf16(b0, qr[d0], p0, 0, 0, 0); p1 = __builtin_amdgcn_mfma_f32_32x32x16_bf16(b1, qr[d0], p1, 0, 0, 0); } \
              if constexpr (HAS_K2) { const int k2a_ = OFF_K2 + (BUF) * SHM_K2; \
                _Pragma("unroll") for (int d0 = 0; d0 < 4; ++d0) { \
                  const bf16x8 b0 = *(const FA_LAS bf16x8*)(L + k2a_ + K2SWZ(r32, (d0 * 16 + hi * 8) * 2)); \
                  const bf16x8 b1 = *(const FA_LAS bf16x8*)(L + k2a_ + 32 * 128 + K2SWZ(r32, (d0 * 16 + hi * 8) * 2)); \
                  p0 = __builtin_amdgcn_mfma_f32_32x32x16_bf16(b0, qr2[d0], p0, 0, 0, 0); p1 = __builtin_amdgcn_mfma_f32_32x32x16_bf16(b1, qr2[d0], p1, 0, 0, 0); } } } \
            const int dq_ = qm - kb_; \
            if constexpr (HAS_BIAS) { const FA_LAS float* tb_ = tab + (TAB_PAD + dq_ - 63); \
                _Pragma("unroll") for (int r = 0; r < 16; ++r) { const int c_ = (r & 3) + 8 * (r >> 2); p0[r] += tb_[63 - c_]; p1[r] += tb_[31 - c_]; } } \
            if (HAS_SEL || kb_ + KVBLK - 1 > qlo || kb_ <= qlo + QBLK - 1 - W) { const float NEG_ = -__builtin_inff(); const int dqm_ = allow_ ? dq_ : -0x40000000; \
                _Pragma("unroll") for (int r = 0; r < 16; ++r) { const int c_ = (r & 3) + 8 * (r >> 2); \
                    if ((unsigned)(dqm_ - c_) >= (unsigned)W) p0[r] = NEG_; if ((unsigned)(dqm_ - c_ - 32) >= (unsigned)W) p1[r] = NEG_; } } \
              \
            float pmax_ = p0[0]; _Pragma("unroll") for (int r = 1; r < 16; ++r) pmax_ = fmaxf(pmax_, p0[r]); _Pragma("unroll") for (int r = 0; r < 16; ++r) pmax_ = fmaxf(pmax_, p1[r]); \
            { auto rr_ = __builtin_amdgcn_permlane32_swap(__float_as_uint(pmax_), __float_as_uint(pmax_), false, false); pmax_ = fmaxf(__uint_as_float(rr_[0]), __uint_as_float(rr_[1])); } \
            float mn_, alpha_; \
            if (__all((pmax_ - m_reg) * SCALE <= THR)) { mn_ = m_reg; alpha_ = 1.f; } \
            else { mn_ = fmaxf(m_reg, pmax_); alpha_ = __builtin_amdgcn_exp2f((m_reg - mn_) * C2); m_reg = mn_; } \
            const float mnL_ = -mn_ * C2; float ps_ = 0.f; \
            _Pragma("unroll") for (int r = 0; r < 16; ++r) { p0[r] = __builtin_amdgcn_exp2f(fmaf(p0[r], C2, mnL_)); p1[r] = __builtin_amdgcn_exp2f(fmaf(p1[r], C2, mnL_)); ps_ += p0[r] + p1[r]; } \
            { auto rr_ = __builtin_amdgcn_permlane32_swap(__float_as_uint(ps_), __float_as_uint(ps_), false, false); ps_ = __uint_as_float(rr_[0]) + __uint_as_float(rr_[1]); } \
            l_reg = l_reg * alpha_ + ps_; \
            bf16x8 pa0, pa1, pa2, pa3; \
            FA_PK4(p0, 0, pa0); FA_PK4(p0, 8, pa1); FA_PK4(p1, 0, pa2); FA_PK4(p1, 8, pa3); \
            if (__any(alpha_ < 1.f)) { if (hi == 0) al_l[r32] = alpha_; asm volatile("s_waitcnt lgkmcnt(0)" ::: "memory"); \
                _Pragma("unroll") for (int d_ = 0; d_ < 4; ++d_) _Pragma("unroll") for (int r = 0; r < 16; ++r) o[d_][r] *= al_l[crow(r, hi)]; } \
            FA_PV_D0(BUF, 0); FA_PV_D0(BUF, 1); FA_PV_D0(BUF, 2); FA_PV_D0(BUF, 3); \
        } \
        if ((t) + 1 < NT) { asm volatile("s_waitcnt vmcnt(0)" ::: "memory"); FA_WRITE(1 - (BUF)); } \
        __syncthreads(); } while (0)
#define FA_PK4(P, B_, OUT) do { unsigned a0 = cvtpk(P[B_+0], P[B_+1]), a1 = cvtpk(P[B_+2], P[B_+3]); unsigned b0 = cvtpk(P[B_+4], P[B_+5]), b1 = cvtpk(P[B_+6], P[B_+7]); \
        auto r0 = __builtin_amdgcn_permlane32_swap(a0, b0, false, false); auto r1 = __builtin_amdgcn_permlane32_swap(a1, b1, false, false); \
        u32x4 w = {r0[0], r1[0], r0[1], r1[1]}; OUT = __builtin_bit_cast(bf16x8, w); } while (0)
#define FA_TRRD(dst, off) asm volatile("ds_read_b64_tr_b16 %0, %1 offset:%2" : "=&v"(dst) : "v"(vb0), "i"(off) : "memory")
#define FA_PV_D0(VB, d0) do { s16x4 l0, l1, l2, l3, h0, h1, h2, h3; constexpr int b_ = (VB) * SHM_V + v_rd_off(d0, 0, 0); \
        FA_TRRD(l0, b_); FA_TRRD(h0, b_ + 2048); FA_TRRD(l1, b_ + 4096); FA_TRRD(h1, b_ + 6144); FA_TRRD(l2, b_ + 8192); FA_TRRD(h2, b_ + 10240); FA_TRRD(l3, b_ + 12288); FA_TRRD(h3, b_ + 14336); \
        asm volatile("s_waitcnt lgkmcnt(0)" ::: "memory"); SBAR(); \
        o[d0] = __builtin_amdgcn_mfma_f32_32x32x16_bf16(pa0, (bf16x8){l0[0], l0[1], l0[2], l0[3], h0[0], h0[1], h0[2], h0[3]}, o[d0], 0, 0, 0); \
        o[d0] = __builtin_amdgcn_mfma_f32_32x32x16_bf16(pa1, (bf16x8){l1[0], l1[1], l1[2], l1[3], h1[0], h1[1], h1[2], h1[3]}, o[d0], 0, 0, 0); \
        o[d0] = __builtin_amdgcn_mfma_f32_32x32x16_bf16(pa2, (bf16x8){l2[0], l2[1], l2[2], l2[3], h2[0], h2[1], h2[2], h2[3]}, o[d0], 0, 0, 0); \
        o[d0] = __builtin_amdgcn_mfma_f32_32x32x16_bf16(pa3, (bf16x8){l3[0], l3[1], l3[2], l3[3], h3[0], h3[1], h3[2], h3[3]}, o[d0], 0, 0, 0); } while (0)
    for (int t = 0; t < NT; t += 2) { FA_STEP(0, t); if (t + 1 < NT) FA_STEP(1, t + 1); }
    li_l[r32] = l_reg;
    if constexpr (VAR == 1) { const bf16* gp = it.G + (long)(qlo + r32) * it.gs;
#pragma unroll
        for (int k = 0; k < 3; ++k) { const float gl = __builtin_bit_cast(float, (unsigned)gp[k] << 16); wsl[64 + 32 * k + r32] = 1.0f / (1.0f + __expf(-gl)); } }
    asm volatile("s_waitcnt lgkmcnt(0)" ::: "memory");
    if (it.LSE && hi == 0) it.LSE[(long)(qlo + r32) * it.lses] = m_reg * SCALE + __logf(l_reg);
    FA_LAS unsigned char* stg = L + wid * (32 * OSTG);
#pragma unroll
    for (int r = 0; r < 16; ++r) { const int orow = crow(r, hi); const float lv_ = li_l[orow]; float rl = lv_ > 0.f ? __builtin_amdgcn_rcpf(lv_) : 0.f; if constexpr (VAR == 1) rl *= wsl[64 + 32 + orow];
#pragma unroll
        for (int d0 = 0; d0 < 4; ++d0) { const float v = o[d0][r] * rl; const unsigned u = __builtin_bit_cast(unsigned, v); *(FA_LAS unsigned short*)(stg + orow * OSTG + (d0 * 32 + r32) * 2) = (unsigned short)((u + 0x7fffu + ((u >> 16) & 1u)) >> 16); } }
    asm volatile("s_waitcnt lgkmcnt(0)" ::: "memory");
#pragma unroll
    for (int i = 0; i < 8; ++i) { const int id = lane + 64 * i, row = id >> 4, ch = id & 15; const long qi = (long)(qlo + row);
        u32x4 w = *(const FA_LAS u32x4*)(stg + row * OSTG + ch * 16);
        if constexpr (VAR == 1) { const float g0 = wsl[64 + row], g2 = wsl[64 + 64 + row];
            const u32x4 a = *(const u32x4*)(it.M0 + qi * it.ms + ch * 8), c = *(const u32x4*)(it.M1 + qi * it.ms + ch * 8);
#pragma unroll
            for (int k = 0; k < 4; ++k) { const float lo = __builtin_bit_cast(float, w[k] << 16) + g0 * __builtin_bit_cast(float, a[k] << 16) + g2 * __builtin_bit_cast(float, c[k] << 16);
                const float hi_ = __builtin_bit_cast(float, w[k] & 0xffff0000u) + g0 * __builtin_bit_cast(float, a[k] & 0xffff0000u) + g2 * __builtin_bit_cast(float, c[k] & 0xffff0000u); w[k] = cvtpk(lo, hi_); } }
        *(u32x4*)(it.O + qi * it.os + ch * 8) = w; }
    __syncthreads();
#undef FA_LOAD
#undef FA_WRITE
#undef FA_KBASE
#undef FA_STEP
#undef FA_PK4
#undef FA_TRRD
#undef FA_PV_D0
}

struct CmpItem { const bf16* Q; long qs; const bf16* K; const bf16* V; const float* bias; int bld; int s0; bf16* O; long os; unsigned long long* sel; };
__device__ __forceinline__ void cmp_block(const CmpItem& it, unsigned char* lds_g, int imps_off) {
    constexpr float SCALE = 0.08838834764831845f, C2 = 1.4426950408889634f * SCALE;
    constexpr int OFF_TABC = 65536;
    FA_LAS unsigned char* L = (FA_LAS unsigned char*)lds_g;
    const int tid = threadIdx.x, wid = __builtin_amdgcn_readfirstlane(tid >> 6), lane = tid & 63, r32 = lane & 31, hi = lane >> 5;
    FA_LAS float* tabc = (FA_LAS float*)(L + OFF_TABC); FA_LAS float* imps = (FA_LAS float*)(L + imps_off);
    const int tokl = wid * 8 + (r32 >> 2), rh = r32 & 3, s = it.s0 + tokl;
    const int nvis = (it.s0 + 63 - 31) / 16 + 1 > 255 ? 255 : (it.s0 + 63 - 31) / 16 + 1;
    const int NT = (nvis + 63) / 64;
    const int nlim = (s - 31) >> 4;
    const int sr = tid >> 4, sc = (tid & 15) * 8, vst0 = v_st(sr, sc), vst1 = v_st(32 + sr, sc), kws = KSWZ(sr, sc * 2);
    const int vb0 = OFF_V + v_rd_base(lane);
    bf16x8 qr[8];
    { const bf16* qp = it.Q + (long)tokl * it.qs + rh * 128 + hi * 8;
#pragma unroll
      for (int d0 = 0; d0 < 8; ++d0) qr[d0] = *(const bf16x8*)(qp + d0 * 16); }
    for (int i = tid; i < 4 * 4096; i += 512) tabc[i] = it.bias[(long)(i >> 12) * it.bld + (i & 4095)] * (1.0f / SCALE);
    for (int i = tid; i < 64 * 64; i += 512) imps[i] = 0.f;
    bf16x8 st_k0, st_k1, st_v0, st_v1;
#define CM_LOADK(kb_) do { st_k0 = *(const bf16x8*)(it.K + (long)((kb_) + sr) * 128 + sc); st_k1 = *(const bf16x8*)(it.K + (long)((kb_) + 32 + sr) * 128 + sc); } while (0)
#define CM_LOADV(kb_) do { st_v0 = *(const bf16x8*)(it.V + (long)((kb_) + sr) * 128 + sc); st_v1 = *(const bf16x8*)(it.V + (long)((kb_) + 32 + sr) * 128 + sc); } while (0)
#define CM_WRITEK(bf_) do { *(FA_LAS bf16x8*)(L + OFF_K + (bf_) * SHM_K + kws) = st_k0; *(FA_LAS bf16x8*)(L + OFF_K + (bf_) * SHM_K + kws + 32 * 256) = st_k1; } while (0)
#define CM_WRITEV(bf_) do { *(FA_LAS bf16x8*)(L + OFF_V + (bf_) * SHM_V + vst0) = st_v0; *(FA_LAS bf16x8*)(L + OFF_V + (bf_) * SHM_V + vst1) = st_v1; } while (0)
#define CM_SCORES(BUF, kb_) \
        f32x16 p0 = {}, p1 = {}; \
        { const int ka_ = OFF_K + (BUF) * SHM_K; \
          _Pragma("unroll") for (int d0 = 0; d0 < 8; ++d0) { \
            const bf16x8 b0 = *(const FA_LAS bf16x8*)(L + ka_ + KSWZ(r32, (d0 * 16 + hi * 8) * 2)); \
            const bf16x8 b1 = *(const FA_LAS bf16x8*)(L + ka_ + 32 * 256 + KSWZ(r32, (d0 * 16 + hi * 8) * 2)); \
            p0 = __builtin_amdgcn_mfma_f32_32x32x16_bf16(b0, qr[d0], p0, 0, 0, 0); p1 = __builtin_amdgcn_mfma_f32_32x32x16_bf16(b1, qr[d0], p1, 0, 0, 0); } } \
        { const int nb_ = (kb_) + 4 * hi, relb_ = s - 31 - 16 * nb_; const float NEG_ = -__builtin_inff(); \
          _Pragma("unroll") for (int r = 0; r < 16; ++r) { const int c_ = (r & 3) + 8 * (r >> 2); \
            { const int rel_ = relb_ - 16 * c_; const int ix_ = rel_ < 0 ? 0 : rel_; const float bv_ = tabc[rh * 4096 + ix_]; p0[r] = (nb_ + c_ <= nlim) ? p0[r] + bv_ : NEG_; } \
            { const int rel_ = relb_ - 16 * (c_ + 32); const int ix_ = rel_ < 0 ? 0 : rel_; const float bv_ = tabc[rh * 4096 + ix_]; p1[r] = (nb_ + c_ + 32 <= nlim) ? p1[r] + bv_ : NEG_; } } }
    CM_LOADK(0); asm volatile("s_waitcnt vmcnt(0)" ::: "memory"); CM_WRITEK(0); __syncthreads();
    float m_reg = -1e30f, l_reg = 0.f;
#define CM_P1(BUF, t) do { if ((t) + 1 < NT) CM_LOADK(((t) + 1) * 64); \
        { CM_SCORES(BUF, (t) * 64) \
          float pmax_ = p0[0]; _Pragma("unroll") for (int r = 1; r < 16; ++r) pmax_ = fmaxf(pmax_, p0[r]); _Pragma("unroll") for (int r = 0; r < 16; ++r) pmax_ = fmaxf(pmax_, p1[r]); \
          { auto rr_ = __builtin_amdgcn_permlane32_swap(__float_as_uint(pmax_), __float_as_uint(pmax_), false, false); pmax_ = fmaxf(__uint_as_float(rr_[0]), __uint_as_float(rr_[1])); } \
          const float mn_ = fmaxf(m_reg, pmax_), alpha_ = __builtin_amdgcn_exp2f((m_reg - mn_) * C2), mnL_ = -mn_ * C2; float ps_ = 0.f; \
          _Pragma("unroll") for (int r = 0; r < 16; ++r) ps_ += __builtin_amdgcn_exp2f(fmaf(p0[r], C2, mnL_)) + __builtin_amdgcn_exp2f(fmaf(p1[r], C2, mnL_)); \
          { auto rr_ = __builtin_amdgcn_permlane32_swap(__float_as_uint(ps_), __float_as_uint(ps_), false, false); ps_ = __uint_as_float(rr_[0]) + __uint_as_float(rr_[1]); } \
          l_reg = l_reg * alpha_ + ps_; m_reg = mn_; } \
        if ((t) + 1 < NT) { asm volatile("s_waitcnt vmcnt(0)" ::: "memory"); CM_WRITEK(1 - (BUF)); } \
        __syncthreads(); } while (0)
    for (int t = 0; t < NT; t += 2) { CM_P1(0, t); if (t + 1 < NT) CM_P1(1, t + 1); }
    const float inv_l = l_reg > 0.f ? 1.0f / l_reg : 0.f, mL = -m_reg * C2;
    CM_LOADK(0); CM_LOADV(0); asm volatile("s_waitcnt vmcnt(0)" ::: "memory"); CM_WRITEK(0); CM_WRITEV(0); __syncthreads();
    f32x16 o[4] = {};
#define FA_PK4(P, B_, OUT) do { unsigned a0 = cvtpk(P[B_+0], P[B_+1]), a1 = cvtpk(P[B_+2], P[B_+3]); unsigned b0 = cvtpk(P[B_+4], P[B_+5]), b1 = cvtpk(P[B_+6], P[B_+7]); \
        auto r0 = __builtin_amdgcn_permlane32_swap(a0, b0, false, false); auto r1 = __builtin_amdgcn_permlane32_swap(a1, b1, false, false); \
        u32x4 w = {r0[0], r1[0], r0[1], r1[1]}; OUT = __builtin_bit_cast(bf16x8, w); } while (0)
#define FA_TRRD(dst, off) asm volatile("ds_read_b64_tr_b16 %0, %1 offset:%2" : "=&v"(dst) : "v"(vb0), "i"(off) : "memory")
#define FA_PV_D0(VB, d0) do { s16x4 l0, l1, l2, l3, h0, h1, h2, h3; constexpr int b_ = (VB) * SHM_V + v_rd_off(d0, 0, 0); \
        FA_TRRD(l0, b_); FA_TRRD(h0, b_ + 2048); FA_TRRD(l1, b_ + 4096); FA_TRRD(h1, b_ + 6144); FA_TRRD(l2, b_ + 8192); FA_TRRD(h2, b_ + 10240); FA_TRRD(l3, b_ + 12288); FA_TRRD(h3, b_ + 14336); \
        asm volatile("s_waitcnt lgkmcnt(0)" ::: "memory"); SBAR(); \
        o[d0] = __builtin_amdgcn_mfma_f32_32x32x16_bf16(pa0, (bf16x8){l0[0], l0[1], l0[2], l0[3], h0[0], h0[1], h0[2], h0[3]}, o[d0], 0, 0, 0); \
        o[d0] = __builtin_amdgcn_mfma_f32_32x32x16_bf16(pa1, (bf16x8){l1[0], l1[1], l1[2], l1[3], h1[0], h1[1], h1[2], h1[3]}, o[d0], 0, 0, 0); \
        o[d0] = __builtin_amdgcn_mfma_f32_32x32x16_bf16(pa2, (bf16x8){l2[0], l2[1], l2[2], l2[3], h2[0], h2[1], h2[2], h2[3]}, o[d0], 0, 0, 0); \
        o[d0] = __builtin_amdgcn_mfma_f32_32x32x16_bf16(pa3, (bf16x8){l3[0], l3[1], l3[2], l3[3], h3[0], h3[1], h3[2], h3[3]}, o[d0], 0, 0, 0); } while (0)
#define CM_IMP(P, half_, t) do { _Pragma("unroll") for (int q4 = 0; q4 < 4; ++q4) { \
            float A_ = (2.0f * ((P[4 * q4] + P[4 * q4 + 1]) + P[4 * q4 + 2]) + P[4 * q4 + 3]) * inv_l, B_ = P[4 * q4 + 3] * inv_l; \
            A_ += __shfl_xor(A_, 1); A_ += __shfl_xor(A_, 2); B_ += __shfl_xor(B_, 1); B_ += __shfl_xor(B_, 2); \
            const int j_ = 2 * q4 + hi + 8 * (half_) + 16 * (t); \
            if (rh == 0) { __hip_atomic_fetch_add(&imps[tokl * 64 + j_], A_, __ATOMIC_RELAXED, __HIP_MEMORY_SCOPE_WORKGROUP); \
                if (j_ + 1 < 64) __hip_atomic_fetch_add(&imps[tokl * 64 + j_ + 1], B_, __ATOMIC_RELAXED, __HIP_MEMORY_SCOPE_WORKGROUP); } } } while (0)
#define CM_P2(BUF, t) do { if ((t) + 1 < NT) { CM_LOADK(((t) + 1) * 64); CM_LOADV(((t) + 1) * 64); } \
        { CM_SCORES(BUF, (t) * 64) \
          _Pragma("unroll") for (int r = 0; r < 16; ++r) { p0[r] = __builtin_amdgcn_exp2f(fmaf(p0[r], C2, mL)); p1[r] = __builtin_amdgcn_exp2f(fmaf(p1[r], C2, mL)); } \
          CM_IMP(p0, 0, t); CM_IMP(p1, 1, t); \
          bf16x8 pa0, pa1, pa2, pa3; FA_PK4(p0, 0, pa0); FA_PK4(p0, 8, pa1); FA_PK4(p1, 0, pa2); FA_PK4(p1, 8, pa3); \
          FA_PV_D0(BUF, 0); FA_PV_D0(BUF, 1); FA_PV_D0(BUF, 2); FA_PV_D0(BUF, 3); } \
        if ((t) + 1 < NT) { asm volatile("s_waitcnt vmcnt(0)" ::: "memory"); CM_WRITEK(1 - (BUF)); CM_WRITEV(1 - (BUF)); } \
        __syncthreads(); } while (0)
    for (int t = 0; t < NT; t += 2) { CM_P2(0, t); if (t + 1 < NT) CM_P2(1, t + 1); }
    asm volatile("s_waitcnt lgkmcnt(0)" ::: "memory");
    for (int tk = 0; tk < 8; ++tk) { const int sp = it.s0 + wid * 8 + tk, blk_t = sp >> 6, j = lane;
        const float is = imps[(wid * 8 + tk) * 64 + j];
        const bool forced = (j == 0) || (j == blk_t) || (j == blk_t - 1), valid = j <= blk_t;
        const float scv = forced ? 1e9f : (valid ? is : -1.0f);
        int rank = 0;
        for (int k = 0; k < 64; ++k) { const float vk = __shfl(scv, k); rank += (vk > scv || (vk == scv && k < j)) ? 1 : 0; }
        const unsigned long long msk = __ballot(rank < 16 && scv > -0.5f);
        if (lane == 0) it.sel[(long)(wid * 8 + tk) * 2] = msk; }
    FA_LAS unsigned char* stg = L + wid * (32 * OSTG);
    FA_LAS float* li_c = imps + wid * 512;
    li_c[r32] = inv_l; asm volatile("s_waitcnt lgkmcnt(0)" ::: "memory");
#pragma unroll
    for (int r = 0; r < 16; ++r) { const int orow = crow(r, hi); const float rl = li_c[orow];
#pragma unroll
        for (int d0 = 0; d0 < 4; ++d0) { const unsigned u = __builtin_bit_cast(unsigned, o[d0][r] * rl); *(FA_LAS unsigned short*)(stg + orow * OSTG + (d0 * 32 + r32) * 2) = (unsigned short)((u + 0x7fffu + ((u >> 16) & 1u)) >> 16); } }
    asm volatile("s_waitcnt lgkmcnt(0)" ::: "memory");
#pragma unroll
    for (int i = 0; i < 8; ++i) { const int id = lane + 64 * i, row = id >> 4, ch = id & 15;
        const u32x4 w = *(const FA_LAS u32x4*)(stg + row * OSTG + ch * 16);
        *(u32x4*)(it.O + (long)(wid * 8 + (row >> 2)) * it.os + (row & 3) * 128 + ch * 8) = w; }
    __syncthreads();
#undef CM_LOADK
#undef CM_LOADV
#undef CM_WRITEK
#undef CM_WRITEV
#undef CM_SCORES
#undef CM_P1
#undef CM_P2
#undef CM_IMP
#undef FA_PK4
#undef FA_TRRD
#undef FA_PV_D0
}
}

constexpr int D = 2048, NB = 4, S = 4096, M = NB * S;
constexpr int HD = 128;
constexpr int Z0W = 3840;
constexpr int Z_NQ = 0, Z_NKV = 1024, Z_QLAT = 2560, Z_KVLAT = 3072, Z_KPE = 3584, Z_NG = 3648;
constexpr int QMW = 1536, KVMW = 2048;
constexpr int FF = 5632, FFE = 7168, NE = 8;
constexpr int Z1W = 9216;
constexpr int NSLOT = (2 * M / 256 + NE) * 256;
constexpr float RMS_EPS = 1e-6f;

constexpr size_t MiB = 1u << 20;
constexpr size_t WS_CTL = 0, CTL_ZERO_BYTES = 1 * MiB;
constexpr size_t WS_MOD = 1 * MiB;
constexpr size_t WS_BIAS = 2 * MiB;
constexpr int BIAS_LD = 4096 + 64;
constexpr size_t WS_ROPE = 3 * MiB;
constexpr size_t WS_RINV = 8 * MiB;
constexpr size_t WS_SEL = 9 * MiB;
constexpr size_t WS_KC = 10 * MiB;
constexpr size_t WS_VC = 11 * MiB;
constexpr size_t WS_ROUTE = 12 * MiB;
constexpr size_t WS_LSE = 13 * MiB;
constexpr size_t WS_KPE = 15 * MiB;
constexpr size_t WS_W1T = 17 * MiB, WS_W2T = 19 * MiB, WS_CB1 = 20 * MiB;
constexpr size_t WS_WIN0 = 21 * MiB, WS_WUQ = 36 * MiB, WS_WUKV = 38 * MiB, WS_WOUT0 = 40 * MiB, WS_WGU0 = 48 * MiB, WS_WDN0 = 92 * MiB;
constexpr size_t WS_WIN1 = 114 * MiB, WS_WOUT1 = 150 * MiB, WS_WMGU = 154 * MiB, WS_WMDN = 602 * MiB;
constexpr size_t WS_X = 826 * MiB;
constexpr size_t WS_H = 954 * MiB;
constexpr size_t WS_R = 1018 * MiB;
constexpr size_t WS_Z0 = WS_R, WS_QM = WS_R + 120 * MiB, WS_KVM = WS_R + 168 * MiB, WS_OCMP = WS_R + 232 * MiB, WS_OWIN = WS_R + 264 * MiB, WS_CAT = WS_R + 328 * MiB;
constexpr size_t WS_ACT = WS_R;
constexpr size_t WS_Z1 = WS_R, WS_OP = WS_R + 288 * MiB, WS_OM = WS_R + 384 * MiB;
constexpr size_t WS_XB = WS_R, WS_ACTB = WS_R + 136 * MiB, WS_YB = WS_R;
constexpr size_t WS_END = WS_R + 612 * MiB;
static_assert(WS_Z0 + (size_t)M * Z0W * 2 <= WS_QM && WS_QM + (size_t)M * QMW * 2 <= WS_KVM && WS_KVM + (size_t)M * KVMW * 2 <= WS_OCMP && WS_CAT + (size_t)M * 2048 * 2 <= WS_END, "L0 map");
static_assert(WS_Z1 + (size_t)M * Z1W * 2 <= WS_OM && WS_XB + (size_t)NSLOT * D * 2 <= WS_ACTB && WS_ACTB + (size_t)NSLOT * FFE * 2 <= WS_END, "L1 map");
static_assert(WS_WMDN + (size_t)NE * D * FFE * 2 <= WS_X && WS_WMGU + (size_t)NE * 2 * FFE * D * 2 <= WS_WMDN, "weights map");
constexpr int CW_BAR = 4096;
constexpr int CW_CNT = 64;
constexpr int CW_TS = 128;
constexpr int CW_Q = 8192;

constexpr int RING_BYTES = 131072;
constexpr int SMALL_OFF = RING_BYTES;
constexpr int LDSCTL_OFF = RING_BYTES + 16384, MISC_OFF = LDSCTL_OFF;
constexpr int LDS_BYTES = LDSCTL_OFF + 256;
constexpr int NWAVES = 8;

#define GAS __attribute__((address_space(1)))
#define LAS __attribute__((address_space(3)))
typedef unsigned short bf16;
typedef unsigned v4u __attribute__((ext_vector_type(4)));
typedef unsigned v2u __attribute__((ext_vector_type(2)));
typedef float f32x4 __attribute__((ext_vector_type(4)));
typedef float f32x2 __attribute__((ext_vector_type(2)));
#define LDS_WAIT() asm volatile("s_waitcnt lgkmcnt(0)" ::: "memory")
__device__ __forceinline__ unsigned f2bf(float f) { unsigned u = __builtin_bit_cast(unsigned, f); return (u + 0x7fffu + ((u >> 16) & 1u)) >> 16; }
__device__ __forceinline__ unsigned pk2(float lo, float hi) { return f2bf(lo) | (f2bf(hi) << 16); }
__device__ __forceinline__ float bf2f(unsigned short b) { return __builtin_bit_cast(float, (unsigned)b << 16); }
__device__ __forceinline__ float bflo(unsigned w) { return __builtin_bit_cast(float, w << 16); }
__device__ __forceinline__ float bfhi(unsigned w) { return __builtin_bit_cast(float, w & 0xffff0000u); }
__device__ __forceinline__ float wave_sum(float v) {
#pragma unroll
    for (int o = 1; o < 64; o <<= 1) v += __shfl_xor(v, o);
    return v;
}
__device__ __forceinline__ float wave_max(float v) {
#pragma unroll
    for (int o = 1; o < 64; o <<= 1) v = fmaxf(v, __shfl_xor(v, o));
    return v;
}

#define XB_TMO      128
#define XB_XCNT(j)  (256  + 64 * (j))
#define XB_XSUB(j)  (1280 + 64 * (j))
#define XB_XGEN(j)  (2304 + 64 * (j))
#define XB_TOP      3328
#define XB_TOPGEN   3392
#define XCD_BAR_WORDS 3456
#define XB_SPIN_CAP (1u << 22)

__device__ __forceinline__ unsigned xb_ld(unsigned* p)              { return __hip_atomic_load(p, __ATOMIC_RELAXED, __HIP_MEMORY_SCOPE_AGENT); }
__device__ __forceinline__ unsigned xb_add(unsigned* p, unsigned v) { return __hip_atomic_fetch_add(p, v, __ATOMIC_RELAXED, __HIP_MEMORY_SCOPE_AGENT); }
__device__ __forceinline__ unsigned xb_xcc_id() { return (unsigned)__builtin_amdgcn_s_getreg((3 << 11) | 20) & 0xFu; }
#define XB_SPIN(cond, bar) do { unsigned _sp = 0; while (cond) { __builtin_amdgcn_s_sleep(1); \
    if ((++_sp & 255u) == 0u) { if (xb_ld(&(bar)[XB_TMO])) break; if (_sp > XB_SPIN_CAP) { atomicAdd(&(bar)[XB_TMO], 1u); break; } } } } while (0)

struct XcdBarrier {
    unsigned* bar; unsigned x;
    volatile LAS unsigned* st;
};

__device__ __forceinline__ XcdBarrier xcd_barrier_post(unsigned* bar, volatile LAS unsigned* st) {
    XcdBarrier b; b.bar = bar; b.x = xb_xcc_id(); b.st = st;
    if (threadIdx.x == 0) (void)xb_add(&bar[XB_XCNT(b.x)], 1u);
    return b;
}
__device__ __forceinline__ void xcd_barrier_complete(unsigned* bar, unsigned x, unsigned& nloc, unsigned& nx) {
    const unsigned G = gridDim.x * gridDim.y * gridDim.z;
    unsigned sum, cnt, mine, sp = 0u;
    for (;;) {
        sum = 0u; cnt = 0u; mine = 0u;
#pragma unroll
        for (unsigned j = 0; j < 16; ++j) { const unsigned c = xb_ld(&bar[XB_XCNT(j)]); sum += c; cnt += (c > 0u) ? 1u : 0u; mine = (j == x) ? c : mine; }
        if (sum == G) break;
        __builtin_amdgcn_s_sleep(1);
        if ((++sp & 255u) == 0u) { if (xb_ld(&bar[XB_TMO])) break; if (sp > XB_SPIN_CAP) { atomicAdd(&bar[XB_TMO], 1u); break; } }
    }
    nloc = mine > 0u ? mine : 1u; nx = cnt > 0u ? cnt : 1u;
}

__device__ __forceinline__ void xcd_barrier(const XcdBarrier& b) {
    asm volatile("s_waitcnt vmcnt(0)" ::: "memory");
    __syncthreads();
    if (threadIdx.x == 0) {
        unsigned* bar = b.bar;
        __builtin_amdgcn_s_waitcnt(0);
        unsigned nloc = b.st[0], nx = b.st[1];
        if (nloc == 0u) { xcd_barrier_complete(bar, b.x, nloc, nx); b.st[0] = nloc; b.st[1] = nx; }
        const unsigned old = xb_add(&bar[XB_XSUB(b.x)], 1u);
        const unsigned gen = old / nloc;
        if (old + 1u == (gen + 1u) * nloc) {
            __builtin_amdgcn_fence(__ATOMIC_RELEASE, "agent");
            asm volatile("s_waitcnt vmcnt(0)" ::: "memory");
            const unsigned og = xb_add(&bar[XB_TOP], 1u);
            const unsigned tg = og / nx;
            if (og + 1u == (tg + 1u) * nx) xb_add(&bar[XB_TOPGEN], 1u);
            else XB_SPIN(xb_ld(&bar[XB_TOPGEN]) == tg, bar);
            __builtin_amdgcn_fence(__ATOMIC_ACQUIRE, "agent");
            xb_add(&bar[XB_XGEN(b.x)], 1u);
            asm volatile("s_waitcnt vmcnt(0)" ::: "memory");
        } else {
            XB_SPIN(xb_ld(&bar[XB_XGEN(b.x)]) == gen, bar);
            __builtin_amdgcn_fence(__ATOMIC_ACQUIRE, "agent");
            asm volatile("s_waitcnt vmcnt(0)" ::: "memory");
        }
    }
    __syncthreads();
}


struct Args { const void* in[30]; float* out; unsigned char* ws; int ph_lo, ph_hi; };
struct Frame {
    unsigned char* lds;
    int tid, lane, wave, vcu, G, gw, NGW;
    unsigned char* ws;
};

__device__ __forceinline__ int t5_bucket(int n) {
    if (n < 16) return n < 0 ? 0 : n;
    int b = 16;
    b += (n >= 22); b += (n >= 30); b += (n >= 40); b += (n >= 54); b += (n >= 73); b += (n >= 99); b += (n >= 134); b += (n >= 182);
    b += (n >= 246); b += (n >= 332); b += (n >= 450); b += (n >= 609); b += (n >= 825); b += (n >= 1117); b += (n >= 1513);
    return b;
}

__device__ __forceinline__ unsigned pk4_fp8(float a, float b, float c, float d) { int w = 0; w = __builtin_amdgcn_cvt_pk_fp8_f32(a, b, w, false); w = __builtin_amdgcn_cvt_pk_fp8_f32(c, d, w, true); return (unsigned)w; }
template <int MAP, bool OUT8 = false>
__device__ __forceinline__ void p0_transpose_item(const float* W, const float* W2, int K, int Nsrc, int Ndst, bf16* WT, const float* kscale, float* scr, int item, int lane, float oscale = 1.0f) {
    const int nblk = Ndst / 64, kb = item / nblk, nb = item % nblk, k0 = 64 * kb, n0 = 64 * nb;
    const int n4 = (lane & 15) * 4, n = n0 + n4, kr = lane >> 4;
    const float* src = W; int sc = n; bool ok = true;
    if (MAP == 1) { if (n < Z_QLAT) sc = n; else if (n < Z_NG) sc = n + 24; else if (n < Z_NG + 24) sc = n - Z_NG + 2560; else ok = false; }
    if (MAP == 2) { const int g32 = n >> 5, w = n & 31; src = (w < 16) ? W : W2; sc = g32 * 16 + (w & 15); }
    f32x4 v[16];
#pragma unroll
    for (int i = 0; i < 16; ++i) v[i] = ok ? __builtin_nontemporal_load((const f32x4*)(src + (size_t)(k0 + 4 * i + kr) * Nsrc + sc)) : (f32x4){0.f, 0.f, 0.f, 0.f};
#pragma unroll
    for (int i = 0; i < 16; ++i) { const int kk = 4 * i + kr; f32x4 t = v[i]; if (kscale) t = t * kscale[k0 + kk]; float* d = scr + kk * 65 + n4; d[0] = t.x; d[1] = t.y; d[2] = t.z; d[3] = t.w; }
    LDS_WAIT(); asm volatile("" ::: "memory");
    if constexpr (OUT8) {
        const int kg = lane & 3;
#pragma unroll
        for (int p = 0; p < 4; ++p) { const int nn = 16 * p + (lane >> 2); const float* s = scr + (16 * kg) * 65 + nn;
            v4u o; o.x = pk4_fp8(s[0 * 65] * oscale, s[1 * 65] * oscale, s[2 * 65] * oscale, s[3 * 65] * oscale); o.y = pk4_fp8(s[4 * 65] * oscale, s[5 * 65] * oscale, s[6 * 65] * oscale, s[7 * 65] * oscale);
            o.z = pk4_fp8(s[8 * 65] * oscale, s[9 * 65] * oscale, s[10 * 65] * oscale, s[11 * 65] * oscale); o.w = pk4_fp8(s[12 * 65] * oscale, s[13 * 65] * oscale, s[14 * 65] * oscale, s[15 * 65] * oscale);
            *(v4u*)((unsigned char*)WT + (size_t)(n0 + nn) * K + k0 + 16 * kg) = o; }
    } else {
    const int kg = lane & 7;
#pragma unroll
    for (int p = 0; p < 8; ++p) { const int nn = 8 * p + (lane >> 3); const float* s = scr + (8 * kg) * 65 + nn;
        v4u o; o.x = pk2(s[0 * 65], s[1 * 65]); o.y = pk2(s[2 * 65], s[3 * 65]); o.z = pk2(s[4 * 65], s[5 * 65]); o.w = pk2(s[6 * 65], s[7 * 65]);
        *(v4u*)(WT + (size_t)(n0 + nn) * K + k0 + 8 * kg) = o; }
    }
    LDS_WAIT(); asm volatile("" ::: "memory");
}
template <int MAP, bool OUT8 = false>
__device__ __forceinline__ void p0_transpose(Frame& F, const float* W, const float* W2, int K, int Nsrc, int Ndst, bf16* WT, const float* kscale, float oscale = 1.0f) {
    float* scr = (float*)(F.lds + F.wave * 16640);
    const int nitems = (K / 64) * (Ndst / 64);
    for (int it = F.gw; it < nitems; it += F.NGW) p0_transpose_item<MAP, OUT8>(W, W2, K, Nsrc, Ndst, WT, kscale, scr, it, F.lane, oscale);
}

__device__ __forceinline__ void modnorm_row(const float* xrow, const float* g, const float* sc, const float* sh, bf16* orow, int lane, f32x4 (&v)[8]) {
    const f32x4* xr = (const f32x4*)xrow + lane; float s = 0.f;
#pragma unroll
    for (int j = 0; j < 8; ++j) { v[j] = xr[64 * j]; s += (v[j].x * v[j].x + v[j].y * v[j].y) + (v[j].z * v[j].z + v[j].w * v[j].w); }
    const float rinv = 1.0f / sqrtf(wave_sum(s) * (1.f / D) + RMS_EPS);
    unsigned long long* o8 = (unsigned long long*)orow + lane;
#pragma unroll
    for (int j = 0; j < 8; ++j) { const f32x4 gg = ((const f32x4*)g)[lane + 64 * j], cc = ((const f32x4*)sc)[lane + 64 * j], hh = ((const f32x4*)sh)[lane + 64 * j];
        v[j] = (v[j] * rinv) * gg * (cc + 1.0f) + hh;
        o8[64 * j] = (unsigned long long)pk2(v[j].x, v[j].y) | ((unsigned long long)pk2(v[j].z, v[j].w) << 32); }
}
__device__ __forceinline__ void modnorm_phase(Frame& F, const float* x, const float* g, const float* mod  , int sh_idx, bf16* H) {
    for (int b = 0; b < NB; ++b) { const float* mb = mod + (size_t)b * 6 * D; const float* sc = mb + (size_t)(sh_idx + 1) * D; const float* sh = mb + (size_t)sh_idx * D;
        const int s0 = F.gw, s1 = F.gw + F.NGW;
        const f32x4* x0 = (const f32x4*)(x + ((size_t)b * S + s0) * D) + F.lane; const f32x4* x1 = (const f32x4*)(x + ((size_t)b * S + s1) * D) + F.lane;
        f32x4 v0[8], v1[8], ca[8], cc[8];
#pragma unroll
        for (int j = 0; j < 8; ++j) { v0[j] = x0[64 * j]; v1[j] = x1[64 * j]; }
#pragma unroll
        for (int j = 0; j < 8; ++j) { ca[j] = ((const f32x4*)g)[F.lane + 64 * j] * (((const f32x4*)sc)[F.lane + 64 * j] + 1.0f); cc[j] = ((const f32x4*)sh)[F.lane + 64 * j]; }
        float q0 = 0.f, q1 = 0.f;
#pragma unroll
        for (int j = 0; j < 8; ++j) { q0 += (v0[j].x * v0[j].x + v0[j].y * v0[j].y) + (v0[j].z * v0[j].z + v0[j].w * v0[j].w); q1 += (v1[j].x * v1[j].x + v1[j].y * v1[j].y) + (v1[j].z * v1[j].z + v1[j].w * v1[j].w); }
        const float r0 = 1.0f / sqrtf(wave_sum(q0) * (1.f / D) + RMS_EPS), r1 = 1.0f / sqrtf(wave_sum(q1) * (1.f / D) + RMS_EPS);
        unsigned long long* o0 = (unsigned long long*)(H + ((size_t)b * S + s0) * D) + F.lane; unsigned long long* o1 = (unsigned long long*)(H + ((size_t)b * S + s1) * D) + F.lane;
#pragma unroll
        for (int j = 0; j < 8; ++j) { const f32x4 a = (v0[j] * r0) * ca[j] + cc[j], c2 = (v1[j] * r1) * ca[j] + cc[j];
            o0[64 * j] = (unsigned long long)pk2(a.x, a.y) | ((unsigned long long)pk2(a.z, a.w) << 32); o1[64 * j] = (unsigned long long)pk2(c2.x, c2.y) | ((unsigned long long)pk2(c2.z, c2.w) << 32); }
    }
}

__device__ __forceinline__ float gelu_tanh(float x) { const float u = 0.7978845608028654f * (x + 0.044715f * x * x * x); return 0.5f * x * (1.0f + tanhf(u)); }

__global__ void __launch_bounds__(NWAVES * 64, 2) fwd(Args args) {
    extern __shared__ __attribute__((aligned(16))) unsigned char lds[];
    Frame F;
    F.lds = lds; F.ws = args.ws;
    F.tid = threadIdx.x; F.lane = F.tid & 63; F.wave = __builtin_amdgcn_readfirstlane(F.tid >> 6);
    F.G = gridDim.x; { const int bx = blockIdx.x; F.vcu = (F.G % 8 == 0) ? (bx % 8) * (F.G / 8) + bx / 8 : bx; }
    F.gw = F.vcu * NWAVES + F.wave; F.NGW = F.G * NWAVES;
    unsigned char* ws = args.ws;
    unsigned* ctl = (unsigned*)(ws + WS_CTL);
    volatile LAS unsigned* MISC = (volatile LAS unsigned*)((LAS unsigned char*)lds + MISC_OFF);
    for (int u = F.tid; u < 64; u += NWAVES * 64) MISC[u] = 0u;
    __syncthreads();
    XcdBarrier bar; bar.bar = ctl + CW_BAR; bar.x = 0; bar.st = nullptr;
    if (MK_N_LAUNCHES == 1) bar = xcd_barrier_post(ctl + CW_BAR, MISC + 8);
    const int lo = args.ph_lo, hi = args.ph_hi;
#define IN(k) (lo <= (k) && (k) < hi)
#define MOE_WSCALE 64.0f
#define MOE_ASCALE 8.0f
#define SEAM(k) do { if (IN(k) && IN((k) + 1)) xcd_barrier(bar); } while (0)

    const float* x_in = (const float*)args.in[0]; const float* c_in = (const float*)args.in[1]; const int* positions = (const int*)args.in[2];
    const float* rel_bias = (const float*)args.in[3]; const float* ada_w = (const float*)args.in[4]; const float* ada_b = (const float*)args.in[5];
    const float* mix_norm_g = (const float*)args.in[6]; const float* ffn_norm_g = (const float*)args.in[7];
    const float* ab_w_in = (const float*)args.in[8]; const float* ab_w_out = (const float*)args.in[9];
    const float* cmp_pos_k = (const float*)args.in[10]; const float* cmp_w1_k = (const float*)args.in[11]; const float* cmp_w2_k = (const float*)args.in[12];
    const float* cmp_pos_v = (const float*)args.in[13]; const float* cmp_w1_v = (const float*)args.in[14]; const float* cmp_w2_v = (const float*)args.in[15];
    const float* q_norm_g = (const float*)args.in[16]; const float* kv_norm_g = (const float*)args.in[17]; const float* w_uq = (const float*)args.in[18]; const float* w_ukv = (const float*)args.in[19];
    const float* ffn_wg = (const float*)args.in[20]; const float* ffn_wu = (const float*)args.in[21]; const float* ffn_wd = (const float*)args.in[22];
    const float* c_w_in = (const float*)args.in[23]; const float* c_w_out = (const float*)args.in[24]; const float* w_router = (const float*)args.in[25];
    const float* moe_wg = (const float*)args.in[26]; const float* moe_wu = (const float*)args.in[27]; const float* moe_wd = (const float*)args.in[28]; const float* final_g = (const float*)args.in[29];
    float* MOD = (float*)(ws + WS_MOD); float* BIAS = (float*)(ws + WS_BIAS); float* ROPE = (float*)(ws + WS_ROPE); float* RINV = (float*)(ws + WS_RINV);
    unsigned long long* SEL = (unsigned long long*)(ws + WS_SEL); bf16* KC = (bf16*)(ws + WS_KC); bf16* VC = (bf16*)(ws + WS_VC); int* ROUTE = (int*)(ws + WS_ROUTE); bf16* KPE = (bf16*)(ws + WS_KPE);
    bf16* W_IN0 = (bf16*)(ws + WS_WIN0); bf16* W_UQ = (bf16*)(ws + WS_WUQ); bf16* W_UKV = (bf16*)(ws + WS_WUKV); bf16* W_OUT0 = (bf16*)(ws + WS_WOUT0); bf16* W_GU0 = (bf16*)(ws + WS_WGU0); bf16* W_DN0 = (bf16*)(ws + WS_WDN0);
    bf16* W_IN1 = (bf16*)(ws + WS_WIN1); bf16* W_OUT1 = (bf16*)(ws + WS_WOUT1); bf16* W_MGU = (bf16*)(ws + WS_WMGU); bf16* W_MDN = (bf16*)(ws + WS_WMDN);
    float* X = (float*)(ws + WS_X); bf16* H = (bf16*)(ws + WS_H);
    bf16* Z0 = (bf16*)(ws + WS_Z0); bf16* QM = (bf16*)(ws + WS_QM); bf16* KVM = (bf16*)(ws + WS_KVM); bf16* OCMP = (bf16*)(ws + WS_OCMP); bf16* OWIN = (bf16*)(ws + WS_OWIN); bf16* CAT = (bf16*)(ws + WS_CAT);
    bf16* W1T = (bf16*)(ws + WS_W1T); bf16* W2T = (bf16*)(ws + WS_W2T); float* CB1 = (float*)(ws + WS_CB1);
    float* LSEB = (float*)(ws + WS_LSE); bf16* OP = (bf16*)(ws + WS_OP);
    bf16* ACT = (bf16*)(ws + WS_ACT); bf16* Z1 = (bf16*)(ws + WS_Z1); bf16* OM = (bf16*)(ws + WS_OM); bf16* XB = (bf16*)(ws + WS_XB); bf16* ACTB = (bf16*)(ws + WS_ACTB); bf16* YB = (bf16*)(ws + WS_YB);
    PG8_LAS unsigned char* ring = (PG8_LAS unsigned char*)lds;

    if (IN(0)) {
        for (int job = 192 + (int)blockIdx.x; job < 194; job += F.G) {
            float* red = (float*)(lds + 32768); const int c = job - 192; const float* pos = c ? cmp_pos_v : cmp_pos_k; const float* w1 = c ? cmp_w1_v : cmp_w1_k;
            float a0 = 0.f, a1 = 0.f;
#pragma unroll 8
            for (int k = 0; k < 512; ++k) { const int kk = F.wave * 512 + k; const f32x2 wv = *(const f32x2*)(w1 + (size_t)kk * 128 + 2 * F.lane); const float pv = pos[kk]; a0 += pv * wv.x; a1 += pv * wv.y; }
            red[F.wave * 128 + 2 * F.lane] = a0; red[F.wave * 128 + 2 * F.lane + 1] = a1;
            __syncthreads();
            if (F.tid < 128) { float s = 0.f;
#pragma unroll
                for (int w = 0; w < 8; ++w) s += red[w * 128 + F.tid];
                CB1[c * 128 + F.tid] = s; }
            __syncthreads();
        }
        for (int job = blockIdx.x; job < 256; job += F.G) {
            float* cs = (float*)lds; float* red = (float*)(lds + 32768);
            for (int i = F.tid; i < 4 * D; i += 512) { const float cv = c_in[i]; cs[i] = cv / (1.0f + __expf(-cv)); }
            __syncthreads();
            const int l = job >> 7, col0 = (job & 127) * 96; const bool act = F.lane < 48;
            float acc[4][2] = {};
            const float* wp = ada_w + ((size_t)l * D + (size_t)F.wave * 256) * 12288 + col0 + 2 * (act ? F.lane : 0);
#pragma unroll 8
            for (int k = 0; k < 256; ++k) { const f32x2 wv = *(const f32x2*)(wp + (size_t)k * 12288); const int kk = F.wave * 256 + k;
#pragma unroll
                for (int b = 0; b < 4; ++b) { const float cv = cs[b * D + kk]; acc[b][0] += cv * wv.x; acc[b][1] += cv * wv.y; } }
            if (act) {
#pragma unroll
                for (int b = 0; b < 4; ++b) { red[(F.wave * 4 + b) * 96 + 2 * F.lane] = acc[b][0]; red[(F.wave * 4 + b) * 96 + 2 * F.lane + 1] = acc[b][1]; } }
            __syncthreads();
            if (F.tid < 384) { const int b = F.tid / 96, cc = F.tid % 96; float s = 0.f;
#pragma unroll
              for (int w = 0; w < 8; ++w) s += red[(w * 4 + b) * 96 + cc];
              MOD[((size_t)l * 4 + b) * 12288 + col0 + cc] = s + ada_b[(size_t)l * 12288 + col0 + cc]; }
            __syncthreads();
        }
        __syncthreads();
        p0_transpose<1>(F, ab_w_in, nullptr, D, 3672, Z0W, W_IN0, nullptr);
        p0_transpose<0>(F, w_uq, nullptr, 512, QMW, QMW, W_UQ, q_norm_g);
        p0_transpose<0>(F, w_ukv, nullptr, 512, KVMW, KVMW, W_UKV, kv_norm_g);
        p0_transpose<0>(F, ab_w_out, nullptr, D, D, D, W_OUT0, nullptr);
        p0_transpose<2>(F, ffn_wg, ffn_wu, D, FF, 2 * FF, W_GU0, nullptr);
        p0_transpose<0>(F, ffn_wd, nullptr, FF, D, D, W_DN0, nullptr);
        p0_transpose<0>(F, c_w_in, nullptr, D, Z1W, Z1W, W_IN1, nullptr);
        p0_transpose<0>(F, c_w_out, nullptr, 1024, D, D, W_OUT1, nullptr);
        p0_transpose<0>(F, cmp_w1_k, nullptr, 4096, 128, 128, W1T, nullptr); p0_transpose<0>(F, cmp_w1_v, nullptr, 4096, 128, 128, W1T + 128 * 4096, nullptr);
        p0_transpose<0>(F, cmp_w2_k, nullptr, 128, 128, 128, W2T, nullptr); p0_transpose<0>(F, cmp_w2_v, nullptr, 128, 128, 128, W2T + 128 * 128, nullptr);
        for (int e = 0; e < NE; ++e) {
            p0_transpose<2, true>(F, moe_wg + (size_t)e * D * FFE, moe_wu + (size_t)e * D * FFE, D, FFE, 2 * FFE, (bf16*)((unsigned char*)W_MGU + (size_t)e * 2 * FFE * D), nullptr, MOE_WSCALE);
            p0_transpose<0, true>(F, moe_wd + (size_t)e * FFE * D, nullptr, FFE, D, D, (bf16*)((unsigned char*)W_MDN + (size_t)e * D * FFE), nullptr, MOE_WSCALE);
        }
        for (int i = F.gw * 64 + F.lane; i < 8 * BIAS_LD; i += F.NGW * 64) { const int h = i / BIAS_LD, r = i % BIAS_LD - 64; BIAS[i] = rel_bias[t5_bucket(r) * 8 + h]; }
        for (int i = F.gw * 64 + F.lane; i < M * 32; i += F.NGW * 64) { const int m = i >> 5, f = i & 31;
            const float inv_freq = powf(10000.0f, -(float)(2 * f) / 64.0f); const float ang = (float)positions[m] * inv_freq;
            ROPE[(size_t)m * 64 + f] = cosf(ang); ROPE[(size_t)m * 64 + 32 + f] = sinf(ang); }
    }
    SEAM(0);
    if (IN(1)) modnorm_phase(F, x_in, mix_norm_g, MOD, 0, H);
    SEAM(1);
    if (IN(2)) { pg8::Gemm g{H, W_IN0, D, D, D}; pg8::StaticOrder So; So.init(M, Z0W, F.G, (int)blockIdx.x); pg8::EpiBf16 E{Z0, Z0W, nullptr};
        pg8::gemm_phase<pg8::EpiBf16, pg8::StaticOrder, PG_ALIGN, PG_SP2>(ring, g, So, E); }
    SEAM(2);
    if (IN(3)) {
        for (int m = F.gw; m < M; m += F.NGW) {
            const bf16* zr = Z0 + (size_t)m * Z0W;
#pragma unroll
            for (int w = 0; w < 2; ++w) { const v4u a = *(const v4u*)(zr + (w ? Z_KVLAT : Z_QLAT) + 8 * F.lane);
                float s = bflo(a.x) * bflo(a.x) + bfhi(a.x) * bfhi(a.x) + bflo(a.y) * bflo(a.y) + bfhi(a.y) * bfhi(a.y) + bflo(a.z) * bflo(a.z) + bfhi(a.z) * bfhi(a.z) + bflo(a.w) * bflo(a.w) + bfhi(a.w) * bfhi(a.w);
                s = wave_sum(s); if (F.lane == 0) RINV[(size_t)w * M + m] = 1.0f / sqrtf(s * (1.f / 512.f) + RMS_EPS); }
            if (F.lane < 32) { const float x1 = bf2f(zr[Z_KPE + F.lane]), x2 = bf2f(zr[Z_KPE + 32 + F.lane]); const float cs = ROPE[(size_t)m * 64 + F.lane], sn = ROPE[(size_t)m * 64 + 32 + F.lane];
                KPE[(size_t)m * 64 + F.lane] = (bf16)f2bf(x1 * cs - x2 * sn); KPE[(size_t)m * 64 + 32 + F.lane] = (bf16)f2bf(x2 * cs + x1 * sn); }
        }
        __syncthreads();
        for (int job = blockIdx.x; job < 256; job += F.G) {
            typedef short bfx8 __attribute__((ext_vector_type(8)));
            const int nt = job & 15, g = (job >> 4) & 1, b = (job >> 5) & 3, c = job >> 7, n0 = nt * 16;
            const int fr = F.lane & 15, fq = F.lane >> 4; int nrow = n0 + fr; if (nrow > 254) nrow = 254;
            const bf16* arow = Z0 + ((size_t)b * S + 16 * nrow) * Z0W + Z_NKV + c * 256 + g * 128 + fq * 8;
            const bf16* w1t = W1T + (size_t)c * 128 * 4096 + (size_t)fr * 4096 + fq * 8;
            f32x4 acc[8];
#pragma unroll
            for (int i = 0; i < 8; ++i) acc[i] = (f32x4){0.f, 0.f, 0.f, 0.f};
#pragma unroll 2
            for (int ks = 0; ks < 16; ++ks) { const int kk = F.wave * 512 + ks * 32, l = kk >> 7, d0 = kk & 127;
                const bfx8 af = *(const bfx8*)(arow + (size_t)l * Z0W + d0);
#pragma unroll
                for (int i = 0; i < 8; ++i) { const bfx8 bfr = *(const bfx8*)(w1t + (size_t)i * 16 * 4096 + kk); acc[i] = __builtin_amdgcn_mfma_f32_16x16x32_bf16(af, bfr, acc[i], 0, 0, 0); } }
            float* part = (float*)lds;
#pragma unroll
            for (int i = 0; i < 8; ++i)
#pragma unroll
                for (int j = 0; j < 4; ++j) part[(F.wave * 16 + fq * 4 + j) * 128 + i * 16 + fr] = acc[i][j];
            __syncthreads();
            bf16* hid = (bf16*)(lds + 65536);
            { const int row = F.tid >> 5, c4 = (F.tid & 31) * 4; f32x4 s = *(const f32x4*)(CB1 + c * 128 + c4);
#pragma unroll
              for (int w = 0; w < 8; ++w) s += *(const f32x4*)(part + (w * 16 + row) * 128 + c4);
              *(v2u*)(hid + row * 128 + c4) = (v2u){pk2(gelu_tanh(s.x), gelu_tanh(s.y)), pk2(gelu_tanh(s.z), gelu_tanh(s.w))}; }
            __syncthreads();
            { f32x4 o4 = {0.f, 0.f, 0.f, 0.f}; const bf16* w2t = W2T + (size_t)c * 128 * 128 + (size_t)(F.wave * 16 + fr) * 128 + fq * 8;
#pragma unroll
              for (int ks = 0; ks < 4; ++ks) { const bfx8 af = *(const bfx8*)(hid + fr * 128 + ks * 32 + fq * 8); const bfx8 bfr = *(const bfx8*)(w2t + ks * 32); o4 = __builtin_amdgcn_mfma_f32_16x16x32_bf16(af, bfr, o4, 0, 0, 0); }
              bf16* outp = (c ? VC : KC) + (((size_t)b * 2 + g) * 256) * 128 + F.wave * 16 + fr;
#pragma unroll
              for (int j = 0; j < 4; ++j) { const int n = n0 + fq * 4 + j; outp[(size_t)n * 128] = n < 255 ? (bf16)f2bf(o4[j]) : (bf16)0; } }
            __syncthreads();
        }
        __syncthreads();
        for (int Lx = blockIdx.x; Lx < 512; Lx += F.G) {
            const int qb = 15 - Lx / 32, bh = Lx % 32, b = bh >> 3, h = bh & 7, g = h >> 2; const bf16* zb = Z0 + (size_t)b * S * Z0W;
            fa::Item it{}; it.Q = zb + Z_NQ + h * 128; it.qs = Z0W; it.K = zb + Z_NKV + 4 * 256 + g * 128; it.ks = Z0W; it.V = zb + Z_NKV + 5 * 256 + g * 128; it.vs = Z0W;
            it.P0 = qb * 256; it.skv = S; it.W = 512; it.bias = BIAS + (size_t)h * BIAS_LD + 64; it.bstep = 1; it.O = OWIN + (size_t)b * S * 1024 + h * 128; it.os = 1024;
            fa::attn_block<0>(it, lds);
        }
    }
    SEAM(3);
    if (IN(4)) {
        { pg8::Gemm g{Z0 + Z_QLAT, W_UQ, Z0W, 512, 512}; pg8::StaticOrder So; So.init(M, QMW, F.G, (int)blockIdx.x); pg8::EpiBf16 E{QM, QMW, RINV};
          pg8::gemm_phase<pg8::EpiBf16, pg8::StaticOrder, PG_ALIGN, PG_SP2>(ring, g, So, E); }
        __syncthreads();
        { pg8::Gemm g{Z0 + Z_KVLAT, W_UKV, Z0W, 512, 512}; pg8::StaticOrder So; So.init(M, KVMW, F.G, (int)blockIdx.x); pg8::EpiBf16 E{KVM, KVMW, RINV + M};
          pg8::gemm_phase<pg8::EpiBf16, pg8::StaticOrder, PG_ALIGN, PG_SP2>(ring, g, So, E); }
        __syncthreads();
        for (int Lx = blockIdx.x; Lx < 512; Lx += F.G) { const int tb = 63 - Lx / 8, bg = Lx % 8, b = bg >> 1, g = bg & 1;
            fa::CmpItem it; it.Q = Z0 + ((size_t)b * S + tb * 64) * Z0W + Z_NQ + g * 512; it.qs = Z0W; it.K = KC + ((size_t)b * 2 + g) * 256 * 128; it.V = VC + ((size_t)b * 2 + g) * 256 * 128;
            it.bias = BIAS + (size_t)(g * 4) * BIAS_LD + 64; it.bld = BIAS_LD; it.s0 = tb * 64; it.O = OCMP + ((size_t)b * S + tb * 64) * 1024 + g * 512; it.os = 1024; it.sel = SEL + ((size_t)b * S + tb * 64) * 2 + g;

            fa::cmp_block(it, lds, SMALL_OFF); }
    }
    SEAM(4);
    if (IN(5)) {
        for (int Lx = blockIdx.x; Lx < 256; Lx += F.G) {
            const int x = Lx / 32, bh = Lx % 32, b = bh >> 3, h = bh & 7, g = h >> 2; const bf16* zb = Z0 + (size_t)b * S * Z0W;
            for (int pass = 0; pass < 2; ++pass) { const int qb = pass ? 15 - x : x;
                fa::Item it{}; it.Q = zb + Z_NQ + h * 128; it.qs = Z0W; it.K = zb + Z_NKV + 2 * 256 + g * 128; it.ks = Z0W; it.V = zb + Z_NKV + 3 * 256 + g * 128; it.vs = Z0W;
                it.P0 = qb * 256; it.skv = S; it.W = 1 << 20; it.bias = BIAS + (size_t)h * BIAS_LD + 64; it.bstep = 1; it.sel = SEL + (size_t)b * S * 2 + g; it.sels = 2;
                it.O = CAT + (size_t)b * S * 2048 + h * 128; it.os = 2048;
                it.M0 = OCMP + (size_t)b * S * 1024 + h * 128; it.M1 = OWIN + (size_t)b * S * 1024 + h * 128; it.ms = 1024; it.G = zb + Z_NG + h * 3; it.gs = Z0W;
                fa::attn_block<1>(it, lds); }
        }
        for (int Lx = blockIdx.x; Lx < 256; Lx += F.G) {
            const int x = Lx / 32, bh = Lx % 32, b = bh >> 3, h = bh & 7;
            for (int pass = 0; pass < 2; ++pass) { const int qb = pass ? 15 - x : x;
                fa::Item it{}; it.Q = QM + (size_t)b * S * QMW + h * 192; it.qs = QMW; it.rope = ROPE + (size_t)b * S * 64; it.ropes = 64;
                it.K = KVM + (size_t)b * S * KVMW + h * 256; it.ks = KVMW; it.K2 = KPE + (size_t)b * S * 64; it.k2s = 64; it.V = KVM + (size_t)b * S * KVMW + h * 256 + 128; it.vs = KVMW;
                it.P0 = qb * 256; it.skv = S; it.W = 1 << 20; it.O = CAT + (size_t)b * S * 2048 + 1024 + h * 128; it.os = 2048;
                fa::attn_block<2>(it, lds); }
        }
    }
    SEAM(5);
    if (IN(6)) { pg8::Gemm g{CAT, W_OUT0, 2048, 2048, 2048}; pg8::StaticOrder So; So.init(M, D, F.G, (int)blockIdx.x); pg8::EpiResid E{x_in, X, D, MOD + 2 * D, 6 * D, S / 256};
        pg8::gemm_phase<pg8::EpiResid, pg8::StaticOrder, PG_ALIGN, PG_SP2>(ring, g, So, E); }
    SEAM(6);
    if (IN(7)) modnorm_phase(F, X, ffn_norm_g, MOD, 3, H);
    SEAM(7);
    if (IN(8)) { pg8::Gemm g{H, W_GU0, D, D, D}; pg8::StaticOrder So; So.init(M, 2 * FF, F.G, (int)blockIdx.x); pg8::EpiSwiGLU E{ACT, FF};
        pg8::gemm_phase<pg8::EpiSwiGLU, pg8::StaticOrder, PG_ALIGN, PG_SP2>(ring, g, So, E); }
    SEAM(8);
    if (IN(9)) { pg8::Gemm g{ACT, W_DN0, FF, FF, FF}; pg8::StaticOrder So; So.init(M, D, F.G, (int)blockIdx.x); pg8::EpiResid E{X, X, D, MOD + 5 * D, 6 * D, S / 256};
        pg8::gemm_phase<pg8::EpiResid, pg8::StaticOrder, PG_ALIGN, PG_SP2>(ring, g, So, E); }
    SEAM(9);
    if (IN(10)) modnorm_phase(F, X, mix_norm_g + D, MOD + 4 * 12288, 0, H);
    SEAM(10);
    if (IN(11)) { pg8::Gemm g{H, W_IN1, D, D, D}; pg8::StaticOrder So; So.init(M, Z1W, F.G, (int)blockIdx.x); pg8::EpiBf16 E{Z1, Z1W, nullptr};
        pg8::gemm_phase<pg8::EpiBf16, pg8::StaticOrder, PG_ALIGN, PG_SP2>(ring, g, So, E); }
    SEAM(11);
    if (IN(12)) {
        for (int Lx = blockIdx.x; Lx < 1536; Lx += F.G) {
            const int p = Lx % 3, r_ = Lx / 3, bh = r_ % 32, sub = r_ / 32, b = bh >> 3, h = bh & 7;
            const int dil = p == 0 ? 1 : (p == 1 ? 4 : 16), res = p == 0 ? 0 : (p == 1 ? (sub & 3) : sub), qb = p == 0 ? sub : (p == 1 ? (sub >> 2) : 0);
            fa::Item it{}; it.Q = Z1 + ((size_t)b * S + res) * Z1W + p * 3072 + h * 128; it.qs = (long)dil * Z1W; it.K = it.Q + 1024; it.ks = it.qs; it.V = it.Q + 2048; it.vs = it.qs;
            it.P0 = qb * 256; it.skv = S / dil; it.W = 129; it.bias = BIAS + (size_t)h * BIAS_LD + 64; it.bstep = dil;
            it.O = OP + (size_t)p * M * 1024 + ((size_t)b * S + res) * 1024 + h * 128; it.os = (long)dil * 1024; it.LSE = LSEB + (size_t)p * M * 8 + ((size_t)b * S + res) * 8 + h; it.lses = (long)dil * 8;
            fa::attn_block<0>(it, lds);
        }
    }
    SEAM(12);
    if (IN(13)) {
        for (int m = F.gw; m < M; m += F.NGW) {
            const int h = F.lane >> 3; const float l0 = LSEB[(size_t)m * 8 + h], l1 = LSEB[(size_t)(M + m) * 8 + h], l2 = LSEB[(size_t)(2 * M + m) * 8 + h];
            const v4u* p0 = (const v4u*)(OP + (size_t)m * 1024) + 2 * F.lane; const v4u* p1 = (const v4u*)(OP + (size_t)(M + m) * 1024) + 2 * F.lane; const v4u* p2 = (const v4u*)(OP + (size_t)(2 * M + m) * 1024) + 2 * F.lane;
            const v4u a0 = p0[0], b0 = p0[1], a1 = p1[0], b1 = p1[1], a2 = p2[0], b2 = p2[1];
            const float mx = fmaxf(l0, fmaxf(l1, l2)); float e0 = __expf(l0 - mx), e1 = __expf(l1 - mx), e2 = __expf(l2 - mx); const float inv = 1.0f / (e0 + e1 + e2); e0 *= inv; e1 *= inv; e2 *= inv;
            v4u oa, ob;
#pragma unroll
            for (int q = 0; q < 4; ++q) { oa[q] = pk2(e0 * bflo(a0[q]) + e1 * bflo(a1[q]) + e2 * bflo(a2[q]), e0 * bfhi(a0[q]) + e1 * bfhi(a1[q]) + e2 * bfhi(a2[q]));
                ob[q] = pk2(e0 * bflo(b0[q]) + e1 * bflo(b1[q]) + e2 * bflo(b2[q]), e0 * bfhi(b0[q]) + e1 * bfhi(b1[q]) + e2 * bfhi(b2[q])); }
            v4u* po = (v4u*)(OM + (size_t)m * 1024) + 2 * F.lane; po[0] = oa; po[1] = ob;
        }
    }
    SEAM(13);
    if (IN(14)) { pg8::Gemm g{OM, W_OUT1, 1024, 1024, 1024}; pg8::StaticOrder So; So.init(M, D, F.G, (int)blockIdx.x); pg8::EpiResid E{X, X, D, MOD + 4 * 12288 + 2 * D, 6 * D, S / 256};
        pg8::gemm_phase<pg8::EpiResid, pg8::StaticOrder, PG_ALIGN, PG_SP2>(ring, g, So, E); }
    SEAM(14);
    if (IN(15)) {
        f32x4* wl = (f32x4*)lds; int* lcnt = (int*)(lds + 65536); int* lbase = lcnt + 8; int* rinfo = lcnt + 16;
        for (int i = F.tid; i < 4096; i += 512) { const int slot = i >> 6, l = i & 63, j = slot >> 3, q = (slot >> 1) & 3, half = slot & 1; wl[i] = *(const f32x4*)(w_router + (size_t)(4 * l + 256 * j + q) * 8 + half * 4); }
        if (F.tid < 8) lcnt[F.tid] = 0;
        __syncthreads();
        for (int k = 0; k < M / 2048; ++k) { const int m = F.gw + k * F.NGW; if (m >= M) break; const int b = m / S; const float* mb = MOD + 4 * 12288 + (size_t)b * 6 * D; f32x4 v[8];
            modnorm_row(X + (size_t)m * D, ffn_norm_g + D, mb + 4 * D, mb + 3 * D, H + (size_t)m * D, F.lane, v);
            float lg[8] = {};
#pragma unroll
            for (int j = 0; j < 8; ++j)
#pragma unroll
                for (int q = 0; q < 4; ++q) { const f32x4 wa = wl[((j * 4 + q) * 2 + 0) * 64 + F.lane], wb = wl[((j * 4 + q) * 2 + 1) * 64 + F.lane]; const float hv = v[j][q];
                    lg[0] += hv * wa.x; lg[1] += hv * wa.y; lg[2] += hv * wa.z; lg[3] += hv * wa.w; lg[4] += hv * wb.x; lg[5] += hv * wb.y; lg[6] += hv * wb.z; lg[7] += hv * wb.w; }
#pragma unroll
            for (int e = 0; e < 8; ++e) lg[e] = wave_sum(lg[e]);
            int e1 = 0; float v1 = lg[0];
#pragma unroll
            for (int e = 1; e < 8; ++e) if (lg[e] > v1) { v1 = lg[e]; e1 = e; }
            int e2 = -1; float v2 = -3.0e38f;
#pragma unroll
            for (int e = 0; e < 8; ++e) if (e != e1 && lg[e] > v2) { v2 = lg[e]; e2 = e; }
            if (F.lane == 0) { const float g1 = 1.0f / (1.0f + __expf(v2 - v1)), g2 = 1.0f - g1;
                const int r1 = __hip_atomic_fetch_add(lcnt + e1, 1, __ATOMIC_RELAXED, __HIP_MEMORY_SCOPE_WORKGROUP), r2 = __hip_atomic_fetch_add(lcnt + e2, 1, __ATOMIC_RELAXED, __HIP_MEMORY_SCOPE_WORKGROUP);
                int* ri = rinfo + (F.wave * 8 + k) * 8; ri[0] = e1; ri[1] = e2; ri[2] = r1; ri[3] = r2; ri[4] = __float_as_int(g1); ri[5] = __float_as_int(g2); }
        }
        __syncthreads();
        if (F.tid < 8) lbase[F.tid] = (int)atomicAdd(ctl + CW_CNT + F.tid, (unsigned)lcnt[F.tid]);
        __syncthreads();
        if (F.lane == 0) for (int k = 0; k < M / 2048; ++k) { const int m = F.gw + k * F.NGW; if (m >= M) break; const int* ri = rinfo + (F.wave * 8 + k) * 8; int* rt = ROUTE + (size_t)m * 8;
            rt[0] = ri[0]; rt[1] = ri[1]; rt[2] = ri[2] + lbase[ri[0]]; rt[3] = ri[3] + lbase[ri[1]]; rt[4] = ri[4]; rt[5] = ri[5]; }
    }
    SEAM(15);
    if (IN(16)) {
        unsigned ts[9]; ts[0] = 0;
#pragma unroll
        for (int e = 0; e < 8; ++e) ts[e + 1] = ts[e] + (__hip_atomic_load(ctl + CW_CNT + e, __ATOMIC_RELAXED, __HIP_MEMORY_SCOPE_AGENT) + 255u) / 256u;
        if (blockIdx.x == 0 && F.tid < 9) { unsigned v = ts[0];
#pragma unroll
            for (int e = 1; e < 9; ++e) v = (F.tid == e) ? ts[e] : v;
            ctl[CW_TS + F.tid] = v; }
        for (int m = F.gw; m < M; m += F.NGW) { const int* rt = ROUTE + (size_t)m * 8; const int e1 = rt[0], e2 = rt[1]; unsigned t1 = 0, t2 = 0;
#pragma unroll
            for (int e = 0; e < 8; ++e) { t1 = (e == e1) ? ts[e] : t1; t2 = (e == e2) ? ts[e] : t2; }
            const size_t d1 = (size_t)t1 * 256 + rt[2], d2 = (size_t)t2 * 256 + rt[3];
            const v4u* src = (const v4u*)(H + (size_t)m * D) + F.lane;
            v2u* o1 = (v2u*)((unsigned char*)XB + d1 * D) + F.lane; v2u* o2 = (v2u*)((unsigned char*)XB + d2 * D) + F.lane;
#pragma unroll
            for (int j = 0; j < 4; ++j) { const v4u w = src[64 * j]; v2u q; q.x = pk4_fp8(bflo(w.x), bfhi(w.x), bflo(w.y), bfhi(w.y)); q.y = pk4_fp8(bflo(w.z), bfhi(w.z), bflo(w.w), bfhi(w.w)); o1[64 * j] = q; o2[64 * j] = q; } }
    }
    SEAM(16);
    if (IN(17)) { pg8::Gemm g{XB, W_MGU, D / 2, D / 2, D / 2}; pg8::GroupedOrder So; So.init(ctl + CW_TS, 2 * FFE / 256, F.G, (int)blockIdx.x); pg8::EpiSwiGLU8 E{(unsigned char*)ACTB, FFE, 1.0f / MOE_WSCALE, MOE_ASCALE};
        pg8::gemm_phase<pg8::EpiSwiGLU8, pg8::GroupedOrder, PG_ALIGN, PG_SP2, true, true>(ring, g, So, E); }
    SEAM(17);
    if (IN(18)) { pg8::Gemm g{ACTB, W_MDN, FFE / 2, FFE / 2, FFE / 2}; pg8::GroupedOrder So; So.init(ctl + CW_TS, D / 256, F.G, (int)blockIdx.x); pg8::EpiBf16S E{YB, D, 1.0f / (MOE_WSCALE * MOE_ASCALE)};
        pg8::gemm_phase<pg8::EpiBf16S, pg8::GroupedOrder, PG_ALIGN, PG_SP2, true, true>(ring, g, So, E); }
    SEAM(18);
    if (IN(19)) {
        unsigned ts[9]; ts[0] = 0;
#pragma unroll
        for (int e = 0; e < 8; ++e) ts[e + 1] = ctl[CW_TS + e + 1];
#pragma unroll
        for (int b = 0; b < NB; ++b) {
            const float* gf = MOD + 4 * 12288 + (size_t)b * 6 * D + 5 * D;
            const int m0 = b * S + F.gw, m1 = m0 + F.NGW;
            const int* rt0 = ROUTE + (size_t)m0 * 8; const int* rt1 = ROUTE + (size_t)m1 * 8;
            const int e10 = rt0[0], e20 = rt0[1], r10 = rt0[2], r20 = rt0[3], e11 = rt1[0], e21 = rt1[1], r11 = rt1[2], r21 = rt1[3];
            const float g10 = __int_as_float(rt0[4]), g20 = __int_as_float(rt0[5]), g11 = __int_as_float(rt1[4]), g21 = __int_as_float(rt1[5]);
            unsigned t10 = 0, t20 = 0, t11 = 0, t21 = 0;
#pragma unroll
            for (int e = 0; e < 8; ++e) { t10 = (e == e10) ? ts[e] : t10; t20 = (e == e20) ? ts[e] : t20; t11 = (e == e11) ? ts[e] : t11; t21 = (e == e21) ? ts[e] : t21; }
            const v2u* ya0 = (const v2u*)(YB + ((size_t)t10 * 256 + r10) * D) + F.lane; const v2u* yb0 = (const v2u*)(YB + ((size_t)t20 * 256 + r20) * D) + F.lane;
            const v2u* ya1 = (const v2u*)(YB + ((size_t)t11 * 256 + r11) * D) + F.lane; const v2u* yb1 = (const v2u*)(YB + ((size_t)t21 * 256 + r21) * D) + F.lane;
            const f32x4* x0 = (const f32x4*)(X + (size_t)m0 * D) + F.lane; const f32x4* x1 = (const f32x4*)(X + (size_t)m1 * D) + F.lane;
            f32x4 v0[8], v1[8]; v2u a0[8], c0[8], a1[8], c1[8];
#pragma unroll
            for (int j = 0; j < 8; ++j) { v0[j] = x0[64 * j]; v1[j] = x1[64 * j]; a0[j] = ya0[64 * j]; c0[j] = yb0[64 * j]; a1[j] = ya1[64 * j]; c1[j] = yb1[64 * j]; }
            float q0 = 0.f, q1 = 0.f;
#pragma unroll
            for (int j = 0; j < 8; ++j) { const f32x4 gg = ((const f32x4*)gf)[F.lane + 64 * j]; f32x4 y;
                y.x = g10 * bflo(a0[j].x) + g20 * bflo(c0[j].x); y.y = g10 * bfhi(a0[j].x) + g20 * bfhi(c0[j].x); y.z = g10 * bflo(a0[j].y) + g20 * bflo(c0[j].y); y.w = g10 * bfhi(a0[j].y) + g20 * bfhi(c0[j].y);
                v0[j] = v0[j] + gg * y; q0 += (v0[j].x * v0[j].x + v0[j].y * v0[j].y) + (v0[j].z * v0[j].z + v0[j].w * v0[j].w);
                y.x = g11 * bflo(a1[j].x) + g21 * bflo(c1[j].x); y.y = g11 * bfhi(a1[j].x) + g21 * bfhi(c1[j].x); y.z = g11 * bflo(a1[j].y) + g21 * bflo(c1[j].y); y.w = g11 * bfhi(a1[j].y) + g21 * bfhi(c1[j].y);
                v1[j] = v1[j] + gg * y; q1 += (v1[j].x * v1[j].x + v1[j].y * v1[j].y) + (v1[j].z * v1[j].z + v1[j].w * v1[j].w); }
            const float ri0 = 1.0f / sqrtf(wave_sum(q0) * (1.f / D) + RMS_EPS), ri1 = 1.0f / sqrtf(wave_sum(q1) * (1.f / D) + RMS_EPS);
            f32x4* o0 = (f32x4*)(args.out + (size_t)m0 * D) + F.lane; f32x4* o1 = (f32x4*)(args.out + (size_t)m1 * D) + F.lane;
#pragma unroll
            for (int j = 0; j < 8; ++j) { const f32x4 fg = ((const f32x4*)final_g)[F.lane + 64 * j]; o0[64 * j] = (v0[j] * ri0) * fg; o1[64 * j] = (v1[j] * ri1) * fg; }
        }
    }
#undef IN
#undef SEAM
}

constexpr int N_PHASES = 20;
extern "C" void kernel_launch(void* const* d_in, const int* in_sizes, int n_in, void* d_out, int out_size, void* d_ws, size_t ws_size, hipStream_t stream) {
    static int grid = 0;
    if (grid == 0) {
        if (n_in != 30 || in_sizes[0] != M * D || out_size != M * D || ws_size < WS_END) { fprintf(stderr, "kernel_launch: shape/workspace mismatch: n_in %d in0 %d out %d ws %zu (need %zu)\n", n_in, n_in > 0 ? in_sizes[0] : -1, out_size, ws_size, (size_t)WS_END); grid = -1; return; }
        int dev = 0, cus = 0, per_cu = 0;
        if (hipGetDevice(&dev) != hipSuccess || hipDeviceGetAttribute(&cus, hipDeviceAttributeMultiprocessorCount, dev) != hipSuccess) { grid = -1; return; }
        if (hipFuncSetAttribute((const void*)fwd, hipFuncAttributeMaxDynamicSharedMemorySize, LDS_BYTES) != hipSuccess) { fprintf(stderr, "kernel_launch: hipFuncSetAttribute failed\n"); grid = -1; return; }
        if (hipOccupancyMaxActiveBlocksPerMultiprocessor(&per_cu, (const void*)fwd, NWAVES * 64, LDS_BYTES) != hipSuccess || per_cu < 1) fprintf(stderr, "kernel_launch: occupancy query reports %d\n", per_cu);
        (void)hipGetLastError();
        grid = cus;
        if (grid != 256) { fprintf(stderr, "kernel_launch: built for a 256-CU device (got %d)\n", cus); grid = -1; return; }
    }
    if (grid < 0) return;
    if (hipMemsetAsync((char*)d_ws + WS_CTL, 0, CTL_ZERO_BYTES, stream) != hipSuccess) return;
    Args a{};
    for (int i = 0; i < 30; ++i) a.in[i] = d_in[i];
    a.out = (float*)d_out; a.ws = (unsigned char*)d_ws;
    if (MK_N_LAUNCHES == 1) { a.ph_lo = 0; a.ph_hi = N_PHASES; hipLaunchKernelGGL(fwd, dim3(grid), dim3(NWAVES * 64), LDS_BYTES, stream, a); }
    else { for (int p = 0; p < N_PHASES; ++p) { a.ph_lo = p; a.ph_hi = p + 1; hipLaunchKernelGGL(fwd, dim3(grid), dim3(NWAVES * 64), LDS_BYTES, stream, a); } }
    const hipError_t le = hipPeekAtLastError();
    if (le != hipSuccess) fprintf(stderr, "kernel_launch: launch failed: %s\n", hipGetErrorName(le));
}
```

```cpp
#include <hip/hip_runtime.h>
#include <cstdio>
#include <cstdint>

#define WGM_G 4
#define PG_ALIGN true
#define PG_SP2 true
#ifndef MK_N_LAUNCHES
#define MK_N_LAUNCHES 1
#endif

namespace pg8 {
#define PG8_LAS __attribute__((address_space(3)))
typedef unsigned short bf16_t;
typedef short bf16x8 __attribute__((ext_vector_type(8)));
typedef float f32x4 __attribute__((ext_vector_type(4)));
typedef float f32x2 __attribute__((ext_vector_type(2)));
typedef unsigned u32x4 __attribute__((ext_vector_type(4)));
typedef unsigned u32x2 __attribute__((ext_vector_type(2)));
constexpr int BM = 256, BK = 64, HALF = 128, HTB = HALF * BK * 2  , STAGE_BYTES = 8 * HTB, NXCD = 8, WGM = 8;

__host__ __device__ __forceinline__ int lds_byte(int r, int c) { const int st = (r >> 4) * 2 + (c >> 5), rr = r & 15, cc = c & 31, ob = rr * 64 + cc * 2; return st * 1024 + (ob ^ (((ob >> 9) & 1) << 5)); }
__host__ __device__ __forceinline__ void stage_rc(int b, int& R, int& C) { const int st = b / 1024, sb = b % 1024, swz = sb ^ (((sb >> 9) & 1) << 5); R = (st >> 1) * 16 + swz / 64; C = (st & 1) * 32 + (swz % 64) / 2; }
__host__ __device__ __forceinline__ int perm32(int rho) { const int n = rho >> 4, i = rho & 15; return 8 * (i >> 2) + 4 * n + (i & 3); }

struct Unit { int pm, pn, pb; };
struct Gemm { const bf16_t* A; const bf16_t* Bt; int lda, ldb, K; };

struct StaticOrder {
    int nM, nN, nwg, G, c;
    __host__ __device__ void init(int M, int N, int G_, int c_) { nM = M / BM; nN = N / BM; nwg = nM * nN; G = G_; c = c_; }
    __host__ __device__ bool next(int i, Unit& u) const {
        const long L = (long)i * G + c; if (L >= nwg) return false;
        int wgid = (int)L; { const int q = nwg / NXCD, r = nwg % NXCD, xcd = wgid % NXCD, off = wgid / NXCD; wgid = (xcd < r ? xcd * (q + 1) : r * (q + 1) + (xcd - r) * q) + off; }
        const int nig = WGM * nN, gid = wgid / nig, fm = gid * WGM, gsz = (nM - fm) < WGM ? (nM - fm) : WGM;
        u.pm = fm + ((wgid % nig) % gsz); u.pn = (wgid % nig) / gsz; u.pb = u.pn; return true;
    }
    __device__ __forceinline__ void a_ready(const Unit&) const {}
    __device__ __forceinline__ void done(const Unit&) const {}
};
#ifndef WGM_G
#endif
struct GroupedOrder {
    int nN, G, c; int ts[9];
    __device__ __forceinline__ void init(const unsigned* tstart, int nN_, int G_, int c_) { nN = nN_; G = G_; c = c_;
#pragma unroll
        for (int e = 0; e < 9; ++e) ts[e] = (int)tstart[e]; }
    __device__ __forceinline__ bool next(int i, Unit& u) const {
        const long L = (long)i * G + c; if (L >= (long)ts[8] * nN) return false;
        int e = 0, us = 0, te = ts[1] - ts[0], t0 = ts[0];
#pragma unroll
        for (int k = 1; k < 8; ++k) { const int s = ts[k] * nN; if (L >= s) { e = k; us = s; te = ts[k + 1] - ts[k]; t0 = ts[k]; } }
        if (te <= 0) return false;
        int wgid = (int)L - us; { const int nwg = te * nN, q = nwg / NXCD, rr = nwg % NXCD, xcd = wgid % NXCD, off = wgid / NXCD; wgid = (xcd < rr ? xcd * (q + 1) : rr * (q + 1) + (xcd - rr) * q) + off; }
        const int nig = WGM_G * nN, gid = wgid / nig, fm = gid * WGM_G, gsz = (te - fm) < WGM_G ? (te - fm) : WGM_G;
        u.pm = t0 + fm + ((wgid % nig) % gsz); u.pn = (wgid % nig) / gsz; u.pb = e * nN + u.pn; return true;
    }
    __device__ __forceinline__ void a_ready(const Unit&) const {}
    __device__ __forceinline__ void done(const Unit&) const {}
};

typedef __bf16 bf16x2c __attribute__((ext_vector_type(2)));
__device__ __forceinline__ unsigned cvt_pk_bf16(float lo, float hi) { const f32x2 v = {lo, hi}; return __builtin_bit_cast(unsigned, __builtin_convertvector(v, bf16x2c)); }

struct EpiBf16 {
    static constexpr bool PERM = true, AFTER_DRAIN = false;
    bf16_t* O; int ldc; const float* rowscale;
    __device__ __forceinline__ void operator()(const f32x4 (&acc)[2][2][4][2], const Unit& u, int wr, int wc, int fr, int fq) const {
        const int row0 = u.pm * BM + wr * 64 + fr; const int col0 = u.pn * BM + wc * 32 + 8 * fq;
#pragma unroll
        for (int ai = 0; ai < 2; ++ai)
#pragma unroll
            for (int m = 0; m < 4; ++m) { const int row = row0 + ai * HALF + m * 16; bf16_t* rowp = O + (size_t)row * ldc + col0; const float sc = rowscale ? rowscale[row] : 1.f;
#pragma unroll
                for (int bj = 0; bj < 2; ++bj) { f32x4 v0 = acc[ai][bj][m][0] * sc, v1 = acc[ai][bj][m][1] * sc;
                    u32x4 w; w.x = cvt_pk_bf16(v0[0], v0[1]); w.y = cvt_pk_bf16(v0[2], v0[3]); w.z = cvt_pk_bf16(v1[0], v1[1]); w.w = cvt_pk_bf16(v1[2], v1[3]);
                    *(u32x4*)(rowp + bj * HALF) = w; } }
    }
};
struct EpiResid {
    static constexpr bool PERM = false, AFTER_DRAIN = false;
    const float* xin; float* xout; int ldc; const float* gate; int gstride; int tiles_per_b;
    __device__ __forceinline__ void operator()(const f32x4 (&acc)[2][2][4][2], const Unit& u, int wr, int wc, int fr, int fq) const {
        const int row0 = u.pm * BM + wr * 64 + fr, col0 = u.pn * BM + wc * 32 + 4 * fq;
        const float* gp = gate + (size_t)(u.pm / tiles_per_b) * gstride + col0;
        f32x4 gv[2][2];
#pragma unroll
        for (int bj = 0; bj < 2; ++bj)
#pragma unroll
            for (int n = 0; n < 2; ++n) gv[bj][n] = *(const f32x4*)(gp + bj * HALF + n * 16);
#pragma unroll
        for (int ai = 0; ai < 2; ++ai)
#pragma unroll
            for (int m = 0; m < 4; ++m) { const size_t off = (size_t)(row0 + ai * HALF + m * 16) * ldc + col0;
#pragma unroll
                for (int bj = 0; bj < 2; ++bj)
#pragma unroll
                    for (int n = 0; n < 2; ++n) { const f32x4 xi = *(const f32x4*)(xin + off + bj * HALF + n * 16);
                        *(f32x4*)(xout + off + bj * HALF + n * 16) = xi + gv[bj][n] * acc[ai][bj][m][n]; }
                asm volatile("" ::: "memory"); }
    }
};
__device__ __forceinline__ float silu_f(float g) { return g * __builtin_amdgcn_rcpf(1.0f + __builtin_amdgcn_exp2f(-1.4426950408889634f * g)); }
struct EpiSwiGLU {
    static constexpr bool PERM = false, AFTER_DRAIN = false;
    bf16_t* O; int ldo;
    __device__ __forceinline__ void operator()(const f32x4 (&acc)[2][2][4][2], const Unit& u, int wr, int wc, int fr, int fq) const {
        const int row0 = u.pm * BM + wr * 64 + fr, col0 = u.pn * HALF + wc * 16 + 4 * fq;
#pragma unroll
        for (int ai = 0; ai < 2; ++ai)
#pragma unroll
            for (int m = 0; m < 4; ++m) { bf16_t* rowp = O + (size_t)(row0 + ai * HALF + m * 16) * ldo + col0;
#pragma unroll
                for (int bj = 0; bj < 2; ++bj) { const f32x4 g = acc[ai][bj][m][0], up = acc[ai][bj][m][1];
                    u32x2 w; w.x = cvt_pk_bf16(silu_f(g[0]) * up[0], silu_f(g[1]) * up[1]); w.y = cvt_pk_bf16(silu_f(g[2]) * up[2], silu_f(g[3]) * up[3]);
                    *(u32x2*)(rowp + bj * 64) = w; } }
    }
};
struct EpiSwiGLU8 {
    static constexpr bool PERM = false, AFTER_DRAIN = false;
    unsigned char* O8; int ldo; float s, so;
    __device__ __forceinline__ void operator()(const f32x4 (&acc)[2][2][4][2], const Unit& u, int wr, int wc, int fr, int fq) const {
        const int row0 = u.pm * BM + wr * 64 + fr, col0 = u.pn * HALF + wc * 16 + 4 * fq;
#pragma unroll
        for (int ai = 0; ai < 2; ++ai)
#pragma unroll
            for (int m = 0; m < 4; ++m) { const size_t off = (size_t)(row0 + ai * HALF + m * 16) * ldo + col0;
#pragma unroll
                for (int bj = 0; bj < 2; ++bj) { const f32x4 g = acc[ai][bj][m][0] * s, up = acc[ai][bj][m][1] * s;
                    const float v0 = silu_f(g[0]) * up[0], v1 = silu_f(g[1]) * up[1], v2 = silu_f(g[2]) * up[2], v3 = silu_f(g[3]) * up[3];
                    int w = 0; w = __builtin_amdgcn_cvt_pk_fp8_f32(__builtin_amdgcn_fmed3f(v0 * so, -440.f, 440.f), __builtin_amdgcn_fmed3f(v1 * so, -440.f, 440.f), w, false);
                    w = __builtin_amdgcn_cvt_pk_fp8_f32(__builtin_amdgcn_fmed3f(v2 * so, -440.f, 440.f), __builtin_amdgcn_fmed3f(v3 * so, -440.f, 440.f), w, true); *(int*)(O8 + off + bj * 64) = w; } }
    }
};
struct EpiBf16S {
    static constexpr bool PERM = true, AFTER_DRAIN = false;
    bf16_t* O; int ldc; float s;
    __device__ __forceinline__ void operator()(const f32x4 (&acc)[2][2][4][2], const Unit& u, int wr, int wc, int fr, int fq) const {
        const int row0 = u.pm * BM + wr * 64 + fr; const int col0 = u.pn * BM + wc * 32 + 8 * fq;
#pragma unroll
        for (int ai = 0; ai < 2; ++ai)
#pragma unroll
            for (int m = 0; m < 4; ++m) { bf16_t* rowp = O + (size_t)(row0 + ai * HALF + m * 16) * ldc + col0;
#pragma unroll
                for (int bj = 0; bj < 2; ++bj) { const f32x4 v0 = acc[ai][bj][m][0] * s, v1 = acc[ai][bj][m][1] * s;
                    u32x4 w; w.x = cvt_pk_bf16(v0[0], v0[1]); w.y = cvt_pk_bf16(v0[2], v0[3]); w.z = cvt_pk_bf16(v1[0], v1[1]); w.w = cvt_pk_bf16(v1[2], v1[3]);
                    *(u32x4*)(rowp + bj * HALF) = w; } }
    }
};

template <class Epi, class Sched, bool ALIGN_EPI = false, bool SP2 = false, bool F8 = false, bool FW = false>
__device__ __forceinline__ void gemm_phase(PG8_LAS unsigned char* lds, const Gemm g, const Sched& S, const Epi& E) {
    const int tid = threadIdx.x, wid = __builtin_amdgcn_readfirstlane(tid >> 6), lane = tid & 63, wr = wid >> 2, wc = wid & 3, fr = lane & 15, fq = lane >> 4;
    const int K = g.K, nt = K / BK;
    unsigned voffA[2], voffB[2];
#pragma unroll
    for (int i = 0; i < 2; ++i) { int R, C; stage_rc(tid * 16 + i * 8192, R, C); const int Rb = Epi::PERM ? ((R & ~31) + perm32(R & 31)) : R;
        voffA[i] = (unsigned)(R * g.lda + C) * 2u; voffB[i] = (unsigned)(Rb * g.ldb + C) * 2u; }
    const size_t kstep = (size_t)(BK * 2);
    const size_t hstepA = (size_t)HALF * g.lda * 2, hstepB = (size_t)HALF * g.ldb * 2;
    const size_t tstepA = 2 * hstepA, tstepB = (F8 && !FW) ? hstepB : 2 * hstepB;
    const unsigned ldsw = (unsigned)wid * 1024u;
    const int aoff = lds_byte(wr * 64 + fr, fq * 8), boff = lds_byte(wc * 32 + fr, fq * 8);
#define PG8_SA(b, h) (((b) * 2 + (h)) * HTB)
#define PG8_SB(b, h) ((4 + (b) * 2 + (h)) * HTB)
#define PG8_STAGE(bufoff, gbase, voff) do { _Pragma("unroll") for (int _i = 0; _i < 2; ++_i) \
        __builtin_amdgcn_global_load_lds((const unsigned*)((const char*)(gbase) + (voff)[_i]), (PG8_LAS unsigned*)(lds + (bufoff) + ldsw + _i * 8192), 16, 0, 0); } while (0)
#define PG8_LDA(dst, b, h) do { _Pragma("unroll") for (int m = 0; m < 4; ++m) _Pragma("unroll") for (int k = 0; k < 2; ++k) dst[m][k] = *(const PG8_LAS bf16x8*)(lds + PG8_SA(b, h) + aoff + m * 2048 + k * 1024); } while (0)
#define PG8_LDB(dst, b, h) do { if constexpr (!F8 || FW || (h) == 0) { _Pragma("unroll") for (int n = 0; n < 2; ++n) _Pragma("unroll") for (int k = 0; k < 2; ++k) dst[n][k] = *(const PG8_LAS bf16x8*)(lds + PG8_SB(b, h) + boff + n * 2048 + k * 1024); } } while (0)
#define PG8_CAT(x, y) __builtin_shufflevector(x, y, 0, 1, 2, 3, 4, 5, 6, 7, 8, 9, 10, 11, 12, 13, 14, 15)
#define PG8_MMA(ai, bj, At, Bt) do { if constexpr (!F8 || FW || (bj) == 0) { __builtin_amdgcn_s_setprio(1); \
        if constexpr (F8) { _Pragma("unroll") for (int m = 0; m < 4; ++m) _Pragma("unroll") for (int n = 0; n < 2; ++n) \
            { const v8i_ b8_ = __builtin_bit_cast(v8i_, PG8_CAT(Bt[n][0], Bt[n][1])), a8_ = __builtin_bit_cast(v8i_, PG8_CAT(At[m][0], At[m][1])); \
            if constexpr (FW) asm volatile("v_mfma_scale_f32_16x16x128_f8f6f4 %0, %1, %2, %0, %3, %3 op_sel_hi:[0,0,0]" : "+v"(acc[ai][bj][m][n]) : "v"(b8_), "v"(a8_), "v"(0x7f7f7f7f)); \
            else acc[ai][bj][m][n] = __builtin_amdgcn_mfma_scale_f32_16x16x128_f8f6f4(b8_, a8_, acc[ai][bj][m][n], 0, 0, 0, 0x7f7f7f7f, 0, 0x7f7f7f7f); } } \
        else { _Pragma("unroll") for (int m = 0; m < 4; ++m) _Pragma("unroll") for (int n = 0; n < 2; ++n) _Pragma("unroll") for (int k = 0; k < 2; ++k) \
            acc[ai][bj][m][n] = __builtin_amdgcn_mfma_f32_16x16x32_bf16(Bt[n][k], At[m][k], acc[ai][bj][m][n], 0, 0, 0); } \
        __builtin_amdgcn_s_setprio(0); } } while (0)
#define PG8_WAIT_V(n) asm volatile("s_waitcnt vmcnt(" #n ")" ::: "memory")
#define PG8_WAIT_L(n) asm volatile("s_waitcnt lgkmcnt(" #n ")" ::: "memory")
#define PG8_BAR __builtin_amdgcn_s_barrier()
#define PG8_SCHED __builtin_amdgcn_sched_barrier(0)
    Unit cur, nxt; int ui = 0;
    if (!S.next(0, cur)) return;
    f32x4 acc[2][2][4][2];
#pragma unroll
    for (int a = 0; a < 2; ++a)
#pragma unroll
        for (int b = 0; b < 2; ++b)
#pragma unroll
            for (int m = 0; m < 4; ++m)
#pragma unroll
                for (int n = 0; n < 2; ++n) acc[a][b][m][n] = (f32x4){0.f, 0.f, 0.f, 0.f};
    bf16x8 At[4][2], B0[2][2], B1[2][2];
    typedef int v8i_ __attribute__((ext_vector_type(8))); typedef short bf16x16_ __attribute__((ext_vector_type(16)));
    const char* cA = (const char*)g.A + (size_t)cur.pm * tstepA; const char* cB = (const char*)g.Bt + (size_t)cur.pb * tstepB;
    S.a_ready(cur);
    if constexpr (SP2) {
        PG8_STAGE(PG8_SB(0, 0), cB, voffB); if constexpr (!F8 || FW) PG8_STAGE(PG8_SB(0, 1), cB + hstepB, voffB); PG8_STAGE(PG8_SA(0, 0), cA, voffA); PG8_STAGE(PG8_SA(0, 1), cA + hstepA, voffA);
        if (wr == 1) PG8_BAR;
        PG8_WAIT_V(2); PG8_BAR;
        PG8_STAGE(PG8_SB(1, 0), cB + kstep, voffB); PG8_STAGE(PG8_SA(1, 0), cA + kstep, voffA); if constexpr (!F8 || FW) PG8_STAGE(PG8_SB(1, 1), cB + hstepB + kstep, voffB);
        if constexpr (F8 && !FW) PG8_WAIT_V(4); else PG8_WAIT_V(6); PG8_BAR;
    } else {
        PG8_STAGE(PG8_SB(0, 0), cB, voffB); PG8_STAGE(PG8_SA(0, 0), cA, voffA); PG8_STAGE(PG8_SB(0, 1), cB + hstepB, voffB); PG8_STAGE(PG8_SA(0, 1), cA + hstepA, voffA);
        if (wr == 1) PG8_BAR;
        PG8_WAIT_V(4); PG8_BAR;
        PG8_STAGE(PG8_SB(1, 0), cB + kstep, voffB); PG8_STAGE(PG8_SA(1, 0), cA + kstep, voffA); PG8_STAGE(PG8_SB(1, 1), cB + hstepB + kstep, voffB);
        PG8_WAIT_V(6); PG8_BAR;
    }
    for (;;) {
        const bool has_next = S.next(ui + 1, nxt);
        const char* nA = has_next ? (const char*)g.A + (size_t)nxt.pm * tstepA : cA; const char* nB = has_next ? (const char*)g.Bt + (size_t)nxt.pb * tstepB : cB;
        for (int t = 0; t < nt; t += 2) {
            const bool last = (t == nt - 2);
            const char* a1 = cA + (size_t)(t + 1) * kstep;
            const char* a2 = last ? nA : cA + (size_t)(t + 2) * kstep; const char* b2 = last ? nB : cB + (size_t)(t + 2) * kstep;
            const char* a3 = a2 + kstep; const char* b3 = b2 + kstep;
            if (last && has_next) S.a_ready(nxt);
            if constexpr (SP2) {
            PG8_LDB(B0, 0, 0); PG8_LDB(B1, 0, 1); PG8_SCHED; PG8_LDA(At, 0, 0); PG8_STAGE(PG8_SA(1, 1), a1 + hstepA, voffA);
            if constexpr (F8 && !FW) PG8_WAIT_V(6); else PG8_WAIT_V(8); PG8_WAIT_L(0); PG8_BAR; PG8_MMA(0, 0, At, B0); PG8_MMA(0, 1, At, B1); PG8_BAR; PG8_SCHED;
            PG8_LDA(At, 0, 1); PG8_STAGE(PG8_SB(0, 0), b2, voffB); if constexpr (!F8 || FW) PG8_STAGE(PG8_SB(0, 1), b2 + hstepB, voffB); PG8_STAGE(PG8_SA(0, 0), a2, voffA);
            if constexpr (F8 && !FW) PG8_WAIT_V(6); else PG8_WAIT_V(8); PG8_WAIT_L(0); PG8_BAR; PG8_MMA(1, 0, At, B0); PG8_MMA(1, 1, At, B1); PG8_BAR; PG8_SCHED;
            PG8_LDB(B0, 1, 0); PG8_LDB(B1, 1, 1); PG8_SCHED; PG8_LDA(At, 1, 0); PG8_STAGE(PG8_SA(0, 1), a2 + hstepA, voffA);
            if constexpr (F8 && !FW) PG8_WAIT_V(6); else PG8_WAIT_V(8); PG8_WAIT_L(0); PG8_BAR; PG8_MMA(0, 0, At, B0); PG8_MMA(0, 1, At, B1); PG8_BAR; PG8_SCHED;
            PG8_LDA(At, 1, 1); PG8_STAGE(PG8_SB(1, 0), b3, voffB); if constexpr (!F8 || FW) PG8_STAGE(PG8_SB(1, 1), b3 + hstepB, voffB); PG8_STAGE(PG8_SA(1, 0), a3, voffA);
            if constexpr (F8 && !FW) PG8_WAIT_V(6); else PG8_WAIT_V(8); PG8_WAIT_L(0); PG8_BAR; PG8_MMA(1, 0, At, B0); PG8_MMA(1, 1, At, B1); PG8_BAR; PG8_SCHED;
            } else {
            PG8_LDB(B0, 0, 0); PG8_SCHED; PG8_LDA(At, 0, 0); PG8_STAGE(PG8_SA(1, 1), a1 + hstepA, voffA);
            PG8_WAIT_L(8); PG8_BAR; PG8_WAIT_L(0); PG8_MMA(0, 0, At, B0); PG8_BAR; PG8_SCHED;
            PG8_LDB(B1, 0, 1); PG8_STAGE(PG8_SB(0, 0), b2, voffB);
            PG8_BAR; PG8_WAIT_L(0); PG8_MMA(0, 1, At, B1); PG8_BAR;
            PG8_LDA(At, 0, 1); PG8_STAGE(PG8_SA(0, 0), a2, voffA);
            PG8_BAR; PG8_WAIT_L(0); PG8_MMA(1, 0, At, B0); PG8_BAR; PG8_SCHED;
            PG8_STAGE(PG8_SB(0, 1), b2 + hstepB, voffB);
            PG8_WAIT_V(6); PG8_BAR; PG8_MMA(1, 1, At, B1); PG8_BAR;
            PG8_LDB(B0, 1, 0); PG8_SCHED; PG8_LDA(At, 1, 0); PG8_STAGE(PG8_SA(0, 1), a2 + hstepA, voffA);
            PG8_WAIT_L(8); PG8_BAR; PG8_WAIT_L(0); PG8_MMA(0, 0, At, B0); PG8_BAR; PG8_SCHED;
            PG8_LDB(B1, 1, 1); PG8_STAGE(PG8_SB(1, 0), b3, voffB);
            PG8_BAR; PG8_WAIT_L(0); PG8_MMA(0, 1, At, B1); PG8_BAR;
            PG8_LDA(At, 1, 1); PG8_STAGE(PG8_SA(1, 0), a3, voffA);
            PG8_BAR; PG8_WAIT_L(0); PG8_MMA(1, 0, At, B0); PG8_BAR; PG8_SCHED;
            PG8_STAGE(PG8_SB(1, 1), b3 + hstepB, voffB);
            PG8_WAIT_V(6); PG8_BAR; PG8_MMA(1, 1, At, B1); PG8_BAR;
            }
        }
        if constexpr (ALIGN_EPI) { if (wr == 0) PG8_BAR; }
        if constexpr (F8 && FW) asm volatile("s_nop 15\n\ts_nop 15" ::: "memory");
        if constexpr (!Epi::AFTER_DRAIN) { E(acc, cur, wr, wc, fr, fq); S.done(cur); }
        if (!has_next) break;
#pragma unroll
        for (int a = 0; a < 2; ++a)
#pragma unroll
            for (int b = 0; b < 2; ++b)
#pragma unroll
                for (int m = 0; m < 4; ++m)
#pragma unroll
                    for (int n = 0; n < 2; ++n) acc[a][b][m][n] = (f32x4){0.f, 0.f, 0.f, 0.f};
        cur = nxt; cA = nA; cB = nB; ++ui;
        if constexpr (ALIGN_EPI) { if (wr == 1) PG8_BAR; }
    }
    PG8_WAIT_V(0);
    if constexpr (!ALIGN_EPI) { if (wr == 0) PG8_BAR; }
    PG8_BAR;
    if constexpr (Epi::AFTER_DRAIN) { E.fused(acc, cur, wr, wc, fr, fq, lds, wid, lane); S.done(cur); }
#undef PG8_SA
#undef PG8_SB
#undef PG8_STAGE
#undef PG8_CAT
#undef PG8_LDA
#undef PG8_LDB
#undef PG8_MMA
#undef PG8_WAIT_V
#undef PG8_WAIT_L
#undef PG8_BAR
#undef PG8_SCHED
}

}

namespace fa {
#define FA_LAS __attribute__((address_space(3)))
typedef unsigned short bf16;
typedef short bf16x8 __attribute__((ext_vector_type(8)));
typedef short s16x4 __attribute__((ext_vector_type(4)));
typedef float f32x16 __attribute__((ext_vector_type(16)));
typedef float f32x4 __attribute__((ext_vector_type(4)));
typedef unsigned u32x4 __attribute__((ext_vector_type(4)));
constexpr int QB = 256, QBLK = 32, KVBLK = 64;
constexpr int SHM_K = 16384, SHM_V = 16384, SHM_K2 = 8192;
constexpr int OFF_V = 0, OFF_K = 2 * SHM_V, OFF_K2 = OFF_K + 2 * SHM_K, OFF_WS = OFF_K2 + 2 * SHM_K2, WS_PER_WAVE = 1024, OFF_TAB = OFF_WS + 8 * WS_PER_WAVE;
constexpr int TAB_PAD = 320, TAB_MAX = 4096 + TAB_PAD;
constexpr int LDS_END = OFF_TAB + TAB_MAX * 4;
constexpr int OSTG = 272;
static_assert(LDS_END <= 131072 && 8 * 32 * OSTG <= OFF_WS, "attention LDS map");
#define KSWZ(row, colB) ((row) * 256 + ((colB) ^ (((row) & 7) << 4)))
#define K2SWZ(row, colB) ((row) * 128 + ((colB) ^ (((row) & 7) << 4)))
#define SBAR() __builtin_amdgcn_sched_barrier(0)
__device__ __forceinline__ int v_st(int k, int c) { const int kk = (k & ~0xC) | ((k & 4) << 1) | ((k & 8) >> 1); return ((kk >> 3) * 4 + (c >> 5)) * 512 + ((kk & 7) * 32 + (c & 31)) * 2; }
__device__ __forceinline__ int v_rd_base(int lane) { return ((lane & 3) << 3) | (((lane >> 2) & 3) << 6) | (((lane >> 4) & 1) << 5) | (((lane >> 5) & 1) << 8); }
constexpr int v_rd_off(int d0, int ks, int half) { return d0 * 512 + ks * 4096 + half * 2048; }
__device__ __forceinline__ int crow(int r, int hi) { return (r & 3) + 8 * (r >> 2) + 4 * hi; }
typedef float f32x2c __attribute__((ext_vector_type(2)));
typedef __bf16 bf16x2c __attribute__((ext_vector_type(2)));
__device__ __forceinline__ unsigned cvtpk(float lo, float hi) { const f32x2c v = {lo, hi}; return __builtin_bit_cast(unsigned, __builtin_convertvector(v, bf16x2c)); }

struct Item {
    const bf16* Q; long qs;
    const float* rope; long ropes;
    const bf16* K; long ks; const bf16* K2; long k2s; const bf16* V; long vs;
    int P0, skv, W;
    const float* bias; int bstep;
    const unsigned long long* sel; long sels;
    bf16* O; long os;
    float* LSE; long lses;
    const bf16* M0; const bf16* M1; long ms; const bf16* G; long gs;
};

template <int VAR>
__device__ __forceinline__ void attn_block(const Item& it, unsigned char* lds_g) {
    constexpr bool HAS_BIAS = VAR != 2, HAS_SEL = VAR == 1, HAS_K2 = VAR == 2;
    constexpr float SCALE = HAS_K2 ? 0.07216878364870322f : 0.08838834764831845f, C2 = 1.4426950408889634f * SCALE, THR = 8.f;
    FA_LAS unsigned char* L = (FA_LAS unsigned char*)lds_g;
    const int tid = threadIdx.x, wid = __builtin_amdgcn_readfirstlane(tid >> 6), lane = tid & 63, r32 = lane & 31, hi = lane >> 5;
    const int W = it.W;
    const int j_lo = (it.P0 - W + 1 > 0) ? (it.P0 - W + 1) / KVBLK : 0;
    int j_hi = (it.P0 + QB - 1) / KVBLK + 1; if (j_hi > it.skv / KVBLK) j_hi = it.skv / KVBLK;
    const int NT = j_hi - j_lo;
    const int qlo = it.P0 + wid * QBLK, qm = qlo + r32 - 4 * hi;
    FA_LAS float* wsl = (FA_LAS float*)(L + OFF_WS + wid * WS_PER_WAVE); FA_LAS float* li_l = wsl; FA_LAS float* al_l = wsl + 32;
    FA_LAS float* tab = (FA_LAS float*)(L + OFF_TAB);
    const int sr = tid >> 4, sc = (tid & 15) * 8, vst0 = v_st(sr, sc), vst1 = v_st(32 + sr, sc), kws = KSWZ(sr, sc * 2);
    const int k2r = tid >> 3, k2c = (tid & 7) * 8, k2ws = K2SWZ(k2r, k2c * 2);
    const int vb0 = OFF_V + v_rd_base(lane);
    bf16x8 qr[8]; bf16x8 qr2[4];
    { const bf16* qp = it.Q + (long)(qlo + r32) * it.qs + hi * 8;
#pragma unroll
      for (int d0 = 0; d0 < 8; ++d0) qr[d0] = *(const bf16x8*)(qp + d0 * 16);
      if constexpr (HAS_K2) {
          const float* rp = it.rope + (long)(qlo + r32) * it.ropes + hi * 8;
          bf16x8 raw[4];
#pragma unroll
          for (int d0 = 0; d0 < 4; ++d0) raw[d0] = *(const bf16x8*)(qp + 128 + d0 * 16);
#pragma unroll
          for (int d0 = 0; d0 < 2; ++d0) { const f32x4 c0 = *(const f32x4*)(rp + d0 * 16), c1 = *(const f32x4*)(rp + d0 * 16 + 4), s0 = *(const f32x4*)(rp + 32 + d0 * 16), s1 = *(const f32x4*)(rp + 32 + d0 * 16 + 4);
              float o1[8], o2[8];
#pragma unroll
              for (int j = 0; j < 8; ++j) { const float x1 = __builtin_bit_cast(float, (unsigned)(unsigned short)raw[d0][j] << 16), x2 = __builtin_bit_cast(float, (unsigned)(unsigned short)raw[d0 + 2][j] << 16);
                  const float cs = j < 4 ? c0[j & 3] : c1[j & 3], sn = j < 4 ? s0[j & 3] : s1[j & 3]; o1[j] = x1 * cs - x2 * sn; o2[j] = x2 * cs + x1 * sn; }
              u32x4 w1 = {cvtpk(o1[0], o1[1]), cvtpk(o1[2], o1[3]), cvtpk(o1[4], o1[5]), cvtpk(o1[6], o1[7])}, w2 = {cvtpk(o2[0], o2[1]), cvtpk(o2[2], o2[3]), cvtpk(o2[4], o2[5]), cvtpk(o2[6], o2[7])};
              qr2[d0] = __builtin_bit_cast(bf16x8, w1); qr2[d0 + 2] = __builtin_bit_cast(bf16x8, w2); }
      }
    }
    unsigned long long selm = ~0ull;
    if constexpr (HAS_SEL) selm = __hip_atomic_load(it.sel + (long)(qlo + r32) * it.sels, __ATOMIC_RELAXED, __HIP_MEMORY_SCOPE_AGENT);
    if constexpr (HAS_BIAS) {
        int rmax = W + 320; if (rmax > 4096) rmax = 4096;
        for (int i = tid; i < rmax + TAB_PAD; i += 512) { int r = i - TAB_PAD; r = r < -64 ? -64 : r; long gi = (long)r * it.bstep; gi = gi > 4095 ? 4095 : gi; tab[i] = it.bias[gi] * (1.0f / SCALE); }
    }
    bf16x8 st_k0, st_k1, st_v0, st_v1, st_k2;
#define FA_LOAD(kb_) do { const long r0_ = (long)((kb_) + sr), r1_ = r0_ + 32; \
        st_v0 = *(const bf16x8*)(it.V + r0_ * it.vs + sc); st_v1 = *(const bf16x8*)(it.V + r1_ * it.vs + sc); \
        st_k0 = *(const bf16x8*)(it.K + r0_ * it.ks + sc); st_k1 = *(const bf16x8*)(it.K + r1_ * it.ks + sc); \
        if constexpr (HAS_K2) st_k2 = *(const bf16x8*)(it.K2 + (long)((kb_) + k2r) * it.k2s + k2c); } while (0)
#define FA_WRITE(bf_) do { *(FA_LAS bf16x8*)(L + OFF_V + (bf_) * SHM_V + vst0) = st_v0; *(FA_LAS bf16x8*)(L + OFF_V + (bf_) * SHM_V + vst1) = st_v1; \
        *(FA_LAS bf16x8*)(L + OFF_K + (bf_) * SHM_K + kws) = st_k0; *(FA_LAS bf16x8*)(L + OFF_K + (bf_) * SHM_K + kws + 32 * 256) = st_k1; \
        if constexpr (HAS_K2) *(FA_LAS bf16x8*)(L + OFF_K2 + (bf_) * SHM_K2 + k2ws) = st_k2; } while (0)
    FA_LOAD(j_lo * KVBLK);
    asm volatile("s_waitcnt vmcnt(0)" ::: "memory");
    FA_WRITE(0);
    __syncthreads();
    float m_reg = -1e30f, l_reg = 0.f; f32x16 o[4] = {};
#define FA_KBASE(t) ((j_lo + (t)) * KVBLK)
#define FA_STEP(BUF, t) do { \
        const int kb_ = FA_KBASE(t); \
        if ((t) + 1 < NT) FA_LOAD(FA_KBASE((t) + 1)); \
        bool act_ = (kb_ <= qlo + QBLK - 1) && (kb_ + KVBLK - 1 >= qlo - W + 1); \
        bool allow_ = true; \
        if constexpr (HAS_SEL) { allow_ = (bool)((selm >> (kb_ >> 6)) & 1ull); } \
        if (act_) { \
            f32x16 p0 = {}, p1 = {}; \
            { const int ka_ = OFF_K + (BUF) * SHM_K; \
              _Pragma("unroll") for (int d0 = 0; d0 < 8; ++d0) { \
                const bf16x8 b0 = *(const FA_LAS bf16x8*)(L + ka_ + KSWZ(r32, (d0 * 16 + hi * 8) * 2)); \
                const bf16x8 b1 = *(const FA_LAS bf16x8*)(L + ka_ + 32 * 256 + KSWZ(r32, (d0 * 16 + hi * 8) * 2)); \
                p0 = __builtin_amdgcn_mfma_f32_32x32x16_bf16(b0, qr[d0], p0, 0, 0, 0); p1 = __builtin_amdgcn_mfma_f32_32x32x16_bf16(b1, qr[d0], p1, 0, 0, 0); } \
              if constexpr (HAS_K2) { const int k2a_ = OFF_K2 + (BUF) * SHM_K2; \
                _Pragma("unroll") for (int d0 = 0; d0 < 4; ++d0) { \
                  const bf16x8 b0 = *(const FA_LAS bf16x8*)(L + k2a_ + K2SWZ(r32, (d0 * 16 + hi * 8) * 2)); \
                  const bf16x8 b1 = *(const FA_LAS bf16x8*)(L + k2a_ + 32 * 128 + K2SWZ(r32, (d0 * 16 + hi * 8) * 2)); \
                  p0 = __builtin_amdgcn_mfma_f32_32x32x16_bf16(b0, qr2[d0], p0, 0, 0, 0); p1 = __builtin_amdgcn_mfma_f32_32x32x16_bf16(b1, qr2[d0], p1, 0, 0, 0); } } } \
            const int dq_ = qm - kb_; \
            if constexpr (HAS_BIAS) { const FA_LAS float* tb_ = tab + (TAB_PAD + dq_ - 63); \
                _Pragma("unroll") for (int r = 0; r < 16; ++r) { const int c_ = (r & 3) + 8 * (r >> 2); p0[r] += tb_[63 - c_]; p1[r] += tb_[31 - c_]; } } \
            if (HAS_SEL || kb_ + KVBLK - 1 > qlo || kb_ <= qlo + QBLK - 1 - W) { const float NEG_ = -__builtin_inff(); const int dqm_ = allow_ ? dq_ : -0x40000000; \
                _Pragma("unroll") for (int r = 0; r < 16; ++r) { const int c_ = (r & 3) + 8 * (r >> 2); \
                    if ((unsigned)(dqm_ - c_) >= (unsigned)W) p0[r] = NEG_; if ((unsigned)(dqm_ - c_ - 32) >= (unsigned)W) p1[r] = NEG_; } } \
              \
            float pmax_ = p0[0]; _Pragma("unroll") for (int r = 1; r < 16; ++r) pmax_ = fmaxf(pmax_, p0[r]); _Pragma("unroll") for (int r = 0; r < 16; ++r) pmax_ = fmaxf(pmax_, p1[r]); \
            { auto rr_ = __builtin_amdgcn_permlane32_swap(__float_as_uint(pmax_), __float_as_uint(pmax_), false, false); pmax_ = fmaxf(__uint_as_float(rr_[0]), __uint_as_float(rr_[1])); } \
            float mn_, alpha_; \
            if (__all((pmax_ - m_reg) * SCALE <= THR)) { mn_ = m_reg; alpha_ = 1.f; } \
            else { mn_ = fmaxf(m_reg, pmax_); alpha_ = __builtin_amdgcn_exp2f((m_reg - mn_) * C2); m_reg = mn_; } \
            const float mnL_ = -mn_ * C2; float ps_ = 0.f; \
            _Pragma("unroll") for (int r = 0; r < 16; ++r) { p0[r] = __builtin_amdgcn_exp2f(fmaf(p0[r], C2, mnL_)); p1[r] = __builtin_amdgcn_exp2f(fmaf(p1[r], C2, mnL_)); ps_ += p0[r] + p1[r]; } \
            { auto rr_ = __builtin_amdgcn_permlane32_swap(__float_as_uint(ps_), __float_as_uint(ps_), false, false); ps_ = __uint_as_float(rr_[0]) + __uint_as_float(rr_[1]); } \
            l_reg = l_reg * alpha_ + ps_; \
            bf16x8 pa0, pa1, pa2, pa3; \
            FA_PK4(p0, 0, pa0); FA_PK4(p0, 8, pa1); FA_PK4(p1, 0, pa2); FA_PK4(p1, 8, pa3); \
            if (__any(alpha_ < 1.f)) { if (hi == 0) al_l[r32] = alpha_; asm volatile("s_waitcnt lgkmcnt(0)" ::: "memory"); \
                _Pragma("unroll") for (int d_ = 0; d_ < 4; ++d_) _Pragma("unroll") for (int r = 0; r < 16; ++r) o[d_][r] *= al_l[crow(r, hi)]; } \
            FA_PV_D0(BUF, 0); FA_PV_D0(BUF, 1); FA_PV_D0(BUF, 2); FA_PV_D0(BUF, 3); \
        } \
        if ((t) + 1 < NT) { asm volatile("s_waitcnt vmcnt(0)" ::: "memory"); FA_WRITE(1 - (BUF)); } \
        __syncthreads(); } while (0)
#define FA_PK4(P, B_, OUT) do { unsigned a0 = cvtpk(P[B_+0], P[B_+1]), a1 = cvtpk(P[B_+2], P[B_+3]); unsigned b0 = cvtpk(P[B_+4], P[B_+5]), b1 = cvtpk(P[B_+6], P[B_+7]); \
        auto r0 = __builtin_amdgcn_permlane32_swap(a0, b0, false, false); auto r1 = __builtin_amdgcn_permlane32_swap(a1, b1, false, false); \
        u32x4 w = {r0[0], r1[0], r0[1], r1[1]}; OUT = __builtin_bit_cast(bf16x8, w); } while (0)
#define FA_TRRD(dst, off) asm volatile("ds_read_b64_tr_b16 %0, %1 offset:%2" : "=&v"(dst) : "v"(vb0), "i"(off) : "memory")
#define FA_PV_D0(VB, d0) do { s16x4 l0, l1, l2, l3, h0, h1, h2, h3; constexpr int b_ = (VB) * SHM_V + v_rd_off(d0, 0, 0); \
        FA_TRRD(l0, b_); FA_TRRD(h0, b_ + 2048); FA_TRRD(l1, b_ + 4096); FA_TRRD(h1, b_ + 6144); FA_TRRD(l2, b_ + 8192); FA_TRRD(h2, b_ + 10240); FA_TRRD(l3, b_ + 12288); FA_TRRD(h3, b_ + 14336); \
        asm volatile("s_waitcnt lgkmcnt(0)" ::: "memory"); SBAR(); \
        o[d0] = __builtin_amdgcn_mfma_f32_32x32x16_bf16(pa0, (bf16x8){l0[0], l0[1], l0[2], l0[3], h0[0], h0[1], h0[2], h0[3]}, o[d0], 0, 0, 0); \
        o[d0] = __builtin_amdgcn_mfma_f32_32x32x16_bf16(pa1, (bf16x8){l1[0], l1[1], l1[2], l1[3], h1[0], h1[1], h1[2], h1[3]}, o[d0], 0, 0, 0); \
        o[d0] = __builtin_amdgcn_mfma_f32_32x32x16_bf16(pa2, (bf16x8){l2[0], l2[1], l2[2], l2[3], h2[0], h2[1], h2[2], h2[3]}, o[d0], 0, 0, 0); \
        o[d0] = __builtin_amdgcn_mfma_f32_32x32x16_bf16(pa3, (bf16x8){l3[0], l3[1], l3[2], l3[3], h3[0], h3[1], h3[2], h3[3]}, o[d0], 0, 0, 0); } while (0)
    for (int t = 0; t < NT; t += 2) { FA_STEP(0, t); if (t + 1 < NT) FA_STEP(1, t + 1); }
    li_l[r32] = l_reg;
    if constexpr (VAR == 1) { const bf16* gp = it.G + (long)(qlo + r32) * it.gs;
#pragma unroll
        for (int k = 0; k < 3; ++k) { const float gl = __builtin_bit_cast(float, (unsigned)gp[k] << 16); wsl[64 + 32 * k + r32] = 1.0f / (1.0f + __expf(-gl)); } }
    asm volatile("s_waitcnt lgkmcnt(0)" ::: "memory");
    if (it.LSE && hi == 0) it.LSE[(long)(qlo + r32) * it.lses] = m_reg * SCALE + __logf(l_reg);
    FA_LAS unsigned char* stg = L + wid * (32 * OSTG);
#pragma unroll
    for (int r = 0; r < 16; ++r) { const int orow = crow(r, hi); const float lv_ = li_l[orow]; float rl = lv_ > 0.f ? __builtin_amdgcn_rcpf(lv_) : 0.f; if constexpr (VAR == 1) rl *= wsl[64 + 32 + orow];
#pragma unroll
        for (int d0 = 0; d0 < 4; ++d0) { const float v = o[d0][r] * rl; const unsigned u = __builtin_bit_cast(unsigned, v); *(FA_LAS unsigned short*)(stg + orow * OSTG + (d0 * 32 + r32) * 2) = (unsigned short)((u + 0x7fffu + ((u >> 16) & 1u)) >> 16); } }
    asm volatile("s_waitcnt lgkmcnt(0)" ::: "memory");
#pragma unroll
    for (int i = 0; i < 8; ++i) { const int id = lane + 64 * i, row = id >> 4, ch = id & 15; const long qi = (long)(qlo + row);
        u32x4 w = *(const FA_LAS u32x4*)(stg + row * OSTG + ch * 16);
        if constexpr (VAR == 1) { const float g0 = wsl[64 + row], g2 = wsl[64 + 64 + row];
            const u32x4 a = *(const u32x4*)(it.M0 + qi * it.ms + ch * 8), c = *(const u32x4*)(it.M1 + qi * it.ms + ch * 8);
#pragma unroll
            for (int k = 0; k < 4; ++k) { const float lo = __builtin_bit_cast(float, w[k] << 16) + g0 * __builtin_bit_cast(float, a[k] << 16) + g2 * __builtin_bit_cast(float, c[k] << 16);
                const float hi_ = __builtin_bit_cast(float, w[k] & 0xffff0000u) + g0 * __builtin_bit_cast(float, a[k] & 0xffff0000u) + g2 * __builtin_bit_cast(float, c[k] & 0xffff0000u); w[k] = cvtpk(lo, hi_); } }
        *(u32x4*)(it.O + qi * it.os + ch * 8) = w; }
    __syncthreads();
#undef FA_LOAD
#undef FA_WRITE
#undef FA_KBASE
#undef FA_STEP
#undef FA_PK4
#undef FA_TRRD
#undef FA_PV_D0
}

struct CmpItem { const bf16* Q; long qs; const bf16* K; const bf16* V; const float* bias; int bld; int s0; bf16* O; long os; unsigned long long* sel; };
__device__ __forceinline__ void cmp_block(const CmpItem& it, unsigned char* lds_g, int imps_off) {
    constexpr float SCALE = 0.08838834764831845f, C2 = 1.4426950408889634f * SCALE;
    constexpr int OFF_TABC = 65536;
    FA_LAS unsigned char* L = (FA_LAS unsigned char*)lds_g;
    const int tid = threadIdx.x, wid = __builtin_amdgcn_readfirstlane(tid >> 6), lane = tid & 63, r32 = lane & 31, hi = lane >> 5;
    FA_LAS float* tabc = (FA_LAS float*)(L + OFF_TABC); FA_LAS float* imps = (FA_LAS float*)(L + imps_off);
    const int tokl = wid * 8 + (r32 >> 2), rh = r32 & 3, s = it.s0 + tokl;
    const int nvis = (it.s0 + 63 - 31) / 16 + 1 > 255 ? 255 : (it.s0 + 63 - 31) / 16 + 1;
    const int NT = (nvis + 63) / 64;
    const int nlim = (s - 31) >> 4;
    const int sr = tid >> 4, sc = (tid & 15) * 8, vst0 = v_st(sr, sc), vst1 = v_st(32 + sr, sc), kws = KSWZ(sr, sc * 2);
    const int vb0 = OFF_V + v_rd_base(lane);
    bf16x8 qr[8];
    { const bf16* qp = it.Q + (long)tokl * it.qs + rh * 128 + hi * 8;
#pragma unroll
      for (int d0 = 0; d0 < 8; ++d0) qr[d0] = *(const bf16x8*)(qp + d0 * 16); }
    for (int i = tid; i < 4 * 4096; i += 512) tabc[i] = it.bias[(long)(i >> 12) * it.bld + (i & 4095)] * (1.0f / SCALE);
    for (int i = tid; i < 64 * 64; i += 512) imps[i] = 0.f;
    bf16x8 st_k0, st_k1, st_v0, st_v1;
#define CM_LOADK(kb_) do { st_k0 = *(const bf16x8*)(it.K + (long)((kb_) + sr) * 128 + sc); st_k1 = *(const bf16x8*)(it.K + (long)((kb_) + 32 + sr) * 128 + sc); } while (0)
#define CM_LOADV(kb_) do { st_v0 = *(const bf16x8*)(it.V + (long)((kb_) + sr) * 128 + sc); st_v1 = *(const bf16x8*)(it.V + (long)((kb_) + 32 + sr) * 128 + sc); } while (0)
#define CM_WRITEK(bf_) do { *(FA_LAS bf16x8*)(L + OFF_K + (bf_) * SHM_K + kws) = st_k0; *(FA_LAS bf16x8*)(L + OFF_K + (bf_) * SHM_K + kws + 32 * 256) = st_k1; } while (0)
#define CM_WRITEV(bf_) do { *(FA_LAS bf16x8*)(L + OFF_V + (bf_) * SHM_V + vst0) = st_v0; *(FA_LAS bf16x8*)(L + OFF_V + (bf_) * SHM_V + vst1) = st_v1; } while (0)
#define CM_SCORES(BUF, kb_) \
        f32x16 p0 = {}, p1 = {}; \
        { const int ka_ = OFF_K + (BUF) * SHM_K; \
          _Pragma("unroll") for (int d0 = 0; d0 < 8; ++d0) { \
            const bf16x8 b0 = *(const FA_LAS bf16x8*)(L + ka_ + KSWZ(r32, (d0 * 16 + hi * 8) * 2)); \
            const bf16x8 b1 = *(const FA_LAS bf16x8*)(L + ka_ + 32 * 256 + KSWZ(r32, (d0 * 16 + hi * 8) * 2)); \
            p0 = __builtin_amdgcn_mfma_f32_32x32x16_bf16(b0, qr[d0], p0, 0, 0, 0); p1 = __builtin_amdgcn_mfma_f32_32x32x16_bf16(b1, qr[d0], p1, 0, 0, 0); } } \
        { const int nb_ = (kb_) + 4 * hi, relb_ = s - 31 - 16 * nb_; const float NEG_ = -__builtin_inff(); \
          _Pragma("unroll") for (int r = 0; r < 16; ++r) { const int c_ = (r & 3) + 8 * (r >> 2); \
            { const int rel_ = relb_ - 16 * c_; const int ix_ = rel_ < 0 ? 0 : rel_; const float bv_ = tabc[rh * 4096 + ix_]; p0[r] = (nb_ + c_ <= nlim) ? p0[r] + bv_ : NEG_; } \
            { const int rel_ = relb_ - 16 * (c_ + 32); const int ix_ = rel_ < 0 ? 0 : rel_; const float bv_ = tabc[rh * 4096 + ix_]; p1[r] = (nb_ + c_ + 32 <= nlim) ? p1[r] + bv_ : NEG_; } } }
    CM_LOADK(0); asm volatile("s_waitcnt vmcnt(0)" ::: "memory"); CM_WRITEK(0); __syncthreads();
    float m_reg = -1e30f, l_reg = 0.f;
#define CM_P1(BUF, t) do { if ((t) + 1 < NT) CM_LOADK(((t) + 1) * 64); \
        { CM_SCORES(BUF, (t) * 64) \
          float pmax_ = p0[0]; _Pragma("unroll") for (int r = 1; r < 16; ++r) pmax_ = fmaxf(pmax_, p0[r]); _Pragma("unroll") for (int r = 0; r < 16; ++r) pmax_ = fmaxf(pmax_, p1[r]); \
          { auto rr_ = __builtin_amdgcn_permlane32_swap(__float_as_uint(pmax_), __float_as_uint(pmax_), false, false); pmax_ = fmaxf(__uint_as_float(rr_[0]), __uint_as_float(rr_[1])); } \
          const float mn_ = fmaxf(m_reg, pmax_), alpha_ = __builtin_amdgcn_exp2f((m_reg - mn_) * C2), mnL_ = -mn_ * C2; float ps_ = 0.f; \
          _Pragma("unroll") for (int r = 0; r < 16; ++r) ps_ += __builtin_amdgcn_exp2f(fmaf(p0[r], C2, mnL_)) + __builtin_amdgcn_exp2f(fmaf(p1[r], C2, mnL_)); \
          { auto rr_ = __builtin_amdgcn_permlane32_swap(__float_as_uint(ps_), __float_as_uint(ps_), false, false); ps_ = __uint_as_float(rr_[0]) + __uint_as_float(rr_[1]); } \
          l_reg = l_reg * alpha_ + ps_; m_reg = mn_; } \
        if ((t) + 1 < NT) { asm volatile("s_waitcnt vmcnt(0)" ::: "memory"); CM_WRITEK(1 - (BUF)); } \
        __syncthreads(); } while (0)
    for (int t = 0; t < NT; t += 2) { CM_P1(0, t); if (t + 1 < NT) CM_P1(1, t + 1); }
    const float inv_l = l_reg > 0.f ? 1.0f / l_reg : 0.f, mL = -m_reg * C2;
    CM_LOADK(0); CM_LOADV(0); asm volatile("s_waitcnt vmcnt(0)" ::: "memory"); CM_WRITEK(0); CM_WRITEV(0); __syncthreads();
    f32x16 o[4] = {};
#define FA_PK4(P, B_, OUT) do { unsigned a0 = cvtpk(P[B_+0], P[B_+1]), a1 = cvtpk(P[B_+2], P[B_+3]); unsigned b0 = cvtpk(P[B_+4], P[B_+5]), b1 = cvtpk(P[B_+6], P[B_+7]); \
        auto r0 = __builtin_amdgcn_permlane32_swap(a0, b0, false, false); auto r1 = __builtin_amdgcn_permlane32_swap(a1, b1, false, false); \
        u32x4 w = {r0[0], r1[0], r0[1], r1[1]}; OUT = __builtin_bit_cast(bf16x8, w); } while (0)
#define FA_TRRD(dst, off) asm volatile("ds_read_b64_tr_b16 %0, %1 offset:%2" : "=&v"(dst) : "v"(vb0), "i"(off) : "memory")
#define FA_PV_D0(VB, d0) do { s16x4 l0, l1, l2, l3, h0, h1, h2, h3; constexpr int b_ = (VB) * SHM_V + v_rd_off(d0, 0, 0); \
        FA_TRRD(l0, b_); FA_TRRD(h0, b_ + 2048); FA_TRRD(l1, b_ + 4096); FA_TRRD(h1, b_ + 6144); FA_TRRD(l2, b_ + 8192); FA_TRRD(h2, b_ + 10240); FA_TRRD(l3, b_ + 12288); FA_TRRD(h3, b_ + 14336); \
        asm volatile("s_waitcnt lgkmcnt(0)" ::: "memory"); SBAR(); \
        o[d0] = __builtin_amdgcn_mfma_f32_32x32x16_bf16(pa0, (bf16x8){l0[0], l0[1], l0[2], l0[3], h0[0], h0[1], h0[2], h0[3]}, o[d0], 0, 0, 0); \
        o[d0] = __builtin_amdgcn_mfma_f32_32x32x16_bf16(pa1, (bf16x8){l1[0], l1[1], l1[2], l1[3], h1[0], h1[1], h1[2], h1[3]}, o[d0], 0, 0, 0); \
        o[d0] = __builtin_amdgcn_mfma_f32_32x32x16_bf16(pa2, (bf16x8){l2[0], l2[1], l2[2], l2[3], h2[0], h2[1], h2[2], h2[3]}, o[d0], 0, 0, 0); \
        o[d0] = __builtin_amdgcn_mfma_f32_32x32x16_bf16(pa3, (bf16x8){l3[0], l3[1], l3[2], l3[3], h3[0], h3[1], h3[2], h3[3]}, o[d0], 0, 0, 0); } while (0)
#define CM_IMP(P, half_, t) do { _Pragma("unroll") for (int q4 = 0; q4 < 4; ++q4) { \
            float A_ = (2.0f * ((P[4 * q4] + P[4 * q4 + 1]) + P[4 * q4 + 2]) + P[4 * q4 + 3]) * inv_l, B_ = P[4 * q4 + 3] * inv_l; \
            A_ += __shfl_xor(A_, 1); A_ += __shfl_xor(A_, 2); B_ += __shfl_xor(B_, 1); B_ += __shfl_xor(B_, 2); \
            const int j_ = 2 * q4 + hi + 8 * (half_) + 16 * (t); \
            if (rh == 0) { __hip_atomic_fetch_add(&imps[tokl * 64 + j_], A_, __ATOMIC_RELAXED, __HIP_MEMORY_SCOPE_WORKGROUP); \
                if (j_ + 1 < 64) __hip_atomic_fetch_add(&imps[tokl * 64 + j_ + 1], B_, __ATOMIC_RELAXED, __HIP_MEMORY_SCOPE_WORKGROUP); } } } while (0)
#define CM_P2(BUF, t) do { if ((t) + 1 < NT) { CM_LOADK(((t) + 1) * 64); CM_LOADV(((t) + 1) * 64); } \
        { CM_SCORES(BUF, (t) * 64) \
          _Pragma("unroll") for (int r = 0; r < 16; ++r) { p0[r] = __builtin_amdgcn_exp2f(fmaf(p0[r], C2, mL)); p1[r] = __builtin_amdgcn_exp2f(fmaf(p1[r], C2, mL)); } \
          CM_IMP(p0, 0, t); CM_IMP(p1, 1, t); \
          bf16x8 pa0, pa1, pa2, pa3; FA_PK4(p0, 0, pa0); FA_PK4(p0, 8, pa1); FA_PK4(p1, 0, pa2); FA_PK4(p1, 8, pa3); \
          FA_PV_D0(BUF, 0); FA_PV_D0(BUF, 1); FA_PV_D0(BUF, 2); FA_PV_D0(BUF, 3); } \
        if ((t) + 1 < NT) { asm volatile("s_waitcnt vmcnt(0)" ::: "memory"); CM_WRITEK(1 - (BUF)); CM_WRITEV(1 - (BUF)); } \
        __syncthreads(); } while (0)
    for (int t = 0; t < NT; t += 2) { CM_P2(0, t); if (t + 1 < NT) CM_P2(1, t + 1); }
    asm volatile("s_waitcnt lgkmcnt(0)" ::: "memory");
    for (int tk = 0; tk < 8; ++tk) { const int sp = it.s0 + wid * 8 + tk, blk_t = sp >> 6, j = lane;
        const float is = imps[(wid * 8 + tk) * 64 + j];
        const bool forced = (j == 0) || (j == blk_t) || (j == blk_t - 1), valid = j <= blk_t;
        const float scv = forced ? 1e9f : (valid ? is : -1.0f);
        int rank = 0;
        for (int k = 0; k < 64; ++k) { const float vk = __shfl(scv, k); rank += (vk > scv || (vk == scv && k < j)) ? 1 : 0; }
        const unsigned long long msk = __ballot(rank < 16 && scv > -0.5f);
        if (lane == 0) it.sel[(long)(wid * 8 + tk) * 2] = msk; }
    FA_LAS unsigned char* stg = L + wid * (32 * OSTG);
    FA_LAS float* li_c = imps + wid * 512;
    li_c[r32] = inv_l; asm volatile("s_waitcnt lgkmcnt(0)" ::: "memory");
#pragma unroll
    for (int r = 0; r < 16; ++r) { const int orow = crow(r, hi); const float rl = li_c[orow];
#pragma unroll
        for (int d0 = 0; d0 < 4; ++d0) { const unsigned u = __builtin_bit_cast(unsigned, o[d0][r] * rl); *(FA_LAS unsigned short*)(stg + orow * OSTG + (d0 * 32 + r32) * 2) = (unsigned short)((u + 0x7fffu + ((u >> 16) & 1u)) >> 16); } }
    asm volatile("s_waitcnt lgkmcnt(0)" ::: "memory");
#pragma unroll
    for (int i = 0; i < 8; ++i) { const int id = lane + 64 * i, row = id >> 4, ch = id & 15;
        const u32x4 w = *(const FA_LAS u32x4*)(stg + row * OSTG + ch * 16);
        *(u32x4*)(it.O + (long)(wid * 8 + (row >> 2)) * it.os + (row & 3) * 128 + ch * 8) = w; }
    __syncthreads();
#undef CM_LOADK
#undef CM_LOADV
#undef CM_WRITEK
#undef CM_WRITEV
#undef CM_SCORES
#undef CM_P1
#undef CM_P2
#undef CM_IMP
#undef FA_PK4
#undef FA_TRRD
#undef FA_PV_D0
}
}

constexpr int D = 2048, NB = 4, S = 4096, M = NB * S;
constexpr int HD = 128;
constexpr int Z0W = 3840;
constexpr int Z_NQ = 0, Z_NKV = 1024, Z_QLAT = 2560, Z_KVLAT = 3072, Z_KPE = 3584, Z_NG = 3648;
constexpr int QMW = 1536, KVMW = 2048;
constexpr int FF = 5632, FFE = 7168, NE = 8;
constexpr int Z1W = 9216;
constexpr int NSLOT = (2 * M / 256 + NE) * 256;
constexpr float RMS_EPS = 1e-6f;

constexpr size_t MiB = 1u << 20;
constexpr size_t WS_CTL = 0, CTL_ZERO_BYTES = 1 * MiB;
constexpr size_t WS_MOD = 1 * MiB;
constexpr size_t WS_BIAS = 2 * MiB;
constexpr int BIAS_LD = 4096 + 64;
constexpr size_t WS_ROPE = 3 * MiB;
constexpr size_t WS_RINV = 8 * MiB;
constexpr size_t WS_SEL = 9 * MiB;
constexpr size_t WS_KC = 10 * MiB;
constexpr size_t WS_VC = 11 * MiB;
constexpr size_t WS_ROUTE = 12 * MiB;
constexpr size_t WS_LSE = 13 * MiB;
constexpr size_t WS_KPE = 15 * MiB;
constexpr size_t WS_W1T = 17 * MiB, WS_W2T = 19 * MiB, WS_CB1 = 20 * MiB;
constexpr size_t WS_WIN0 = 21 * MiB, WS_WUQ = 36 * MiB, WS_WUKV = 38 * MiB, WS_WOUT0 = 40 * MiB, WS_WGU0 = 48 * MiB, WS_WDN0 = 92 * MiB;
constexpr size_t WS_WIN1 = 114 * MiB, WS_WOUT1 = 150 * MiB, WS_WMGU = 154 * MiB, WS_WMDN = 602 * MiB;
constexpr size_t WS_X = 826 * MiB;
constexpr size_t WS_H = 954 * MiB;
constexpr size_t WS_R = 1018 * MiB;
constexpr size_t WS_Z0 = WS_R, WS_QM = WS_R + 120 * MiB, WS_KVM = WS_R + 168 * MiB, WS_OCMP = WS_R + 232 * MiB, WS_OWIN = WS_R + 264 * MiB, WS_CAT = WS_R + 328 * MiB;
constexpr size_t WS_ACT = WS_R;
constexpr size_t WS_Z1 = WS_R, WS_OP = WS_R + 288 * MiB, WS_OM = WS_R + 384 * MiB;
constexpr size_t WS_XB = WS_R, WS_ACTB = WS_R + 136 * MiB, WS_YB = WS_R;
constexpr size_t WS_END = WS_R + 612 * MiB;
static_assert(WS_Z0 + (size_t)M * Z0W * 2 <= WS_QM && WS_QM + (size_t)M * QMW * 2 <= WS_KVM && WS_KVM + (size_t)M * KVMW * 2 <= WS_OCMP && WS_CAT + (size_t)M * 2048 * 2 <= WS_END, "L0 map");
static_assert(WS_Z1 + (size_t)M * Z1W * 2 <= WS_OM && WS_XB + (size_t)NSLOT * D * 2 <= WS_ACTB && WS_ACTB + (size_t)NSLOT * FFE * 2 <= WS_END, "L1 map");
static_assert(WS_WMDN + (size_t)NE * D * FFE * 2 <= WS_X && WS_WMGU + (size_t)NE * 2 * FFE * D * 2 <= WS_WMDN, "weights map");
constexpr int CW_BAR = 4096;
constexpr int CW_CNT = 64;
constexpr int CW_TS = 128;
constexpr int CW_Q = 8192;

constexpr int RING_BYTES = 131072;
constexpr int SMALL_OFF = RING_BYTES;
constexpr int LDSCTL_OFF = RING_BYTES + 16384, MISC_OFF = LDSCTL_OFF;
constexpr int LDS_BYTES = LDSCTL_OFF + 256;
constexpr int NWAVES = 8;

#define GAS __attribute__((address_space(1)))
#define LAS __attribute__((address_space(3)))
typedef unsigned short bf16;
typedef unsigned v4u __attribute__((ext_vector_type(4)));
typedef unsigned v2u __attribute__((ext_vector_type(2)));
typedef float f32x4 __attribute__((ext_vector_type(4)));
typedef float f32x2 __attribute__((ext_vector_type(2)));
#define LDS_WAIT() asm volatile("s_waitcnt lgkmcnt(0)" ::: "memory")
__device__ __forceinline__ unsigned f2bf(float f) { unsigned u = __builtin_bit_cast(unsigned, f); return (u + 0x7fffu + ((u >> 16) & 1u)) >> 16; }
__device__ __forceinline__ unsigned pk2(float lo, float hi) { return f2bf(lo) | (f2bf(hi) << 16); }
__device__ __forceinline__ float bf2f(unsigned short b) { return __builtin_bit_cast(float, (unsigned)b << 16); }
__device__ __forceinline__ float bflo(unsigned w) { return __builtin_bit_cast(float, w << 16); }
__device__ __forceinline__ float bfhi(unsigned w) { return __builtin_bit_cast(float, w & 0xffff0000u); }
__device__ __forceinline__ float wave_sum(float v) {
#pragma unroll
    for (int o = 1; o < 64; o <<= 1) v += __shfl_xor(v, o);
    return v;
}
__device__ __forceinline__ float wave_max(float v) {
#pragma unroll
    for (int o = 1; o < 64; o <<= 1) v = fmaxf(v, __shfl_xor(v, o));
    return v;
}

#define XB_TMO      128
#define XB_XCNT(j)  (256  + 64 * (j))
#define XB_XSUB(j)  (1280 + 64 * (j))
#define XB_XGEN(j)  (2304 + 64 * (j))
#define XB_TOP      3328
#define XB_TOPGEN   3392
#define XCD_BAR_WORDS 3456
#define XB_SPIN_CAP (1u << 22)

__device__ __forceinline__ unsigned xb_ld(unsigned* p)              { return __hip_atomic_load(p, __ATOMIC_RELAXED, __HIP_MEMORY_SCOPE_AGENT); }
__device__ __forceinline__ unsigned xb_add(unsigned* p, unsigned v) { return __hip_atomic_fetch_add(p, v, __ATOMIC_RELAXED, __HIP_MEMORY_SCOPE_AGENT); }
__device__ __forceinline__ unsigned xb_xcc_id() { return (unsigned)__builtin_amdgcn_s_getreg((3 << 11) | 20) & 0xFu; }
#define XB_SPIN(cond, bar) do { unsigned _sp = 0; while (cond) { __builtin_amdgcn_s_sleep(1); \
    if ((++_sp & 255u) == 0u) { if (xb_ld(&(bar)[XB_TMO])) break; if (_sp > XB_SPIN_CAP) { atomicAdd(&(bar)[XB_TMO], 1u); break; } } } } while (0)

struct XcdBarrier {
    unsigned* bar; unsigned x;
    volatile LAS unsigned* st;
};

__device__ __forceinline__ XcdBarrier xcd_barrier_post(unsigned* bar, volatile LAS unsigned* st) {
    XcdBarrier b; b.bar = bar; b.x = xb_xcc_id(); b.st = st;
    if (threadIdx.x == 0) (void)xb_add(&bar[XB_XCNT(b.x)], 1u);
    return b;
}
__device__ __forceinline__ void xcd_barrier_complete(unsigned* bar, unsigned x, unsigned& nloc, unsigned& nx) {
    const unsigned G = gridDim.x * gridDim.y * gridDim.z;
    unsigned sum, cnt, mine, sp = 0u;
    for (;;) {
        sum = 0u; cnt = 0u; mine = 0u;
#pragma unroll
        for (unsigned j = 0; j < 16; ++j) { const unsigned c = xb_ld(&bar[XB_XCNT(j)]); sum += c; cnt += (c > 0u) ? 1u : 0u; mine = (j == x) ? c : mine; }
        if (sum == G) break;
        __builtin_amdgcn_s_sleep(1);
        if ((++sp & 255u) == 0u) { if (xb_ld(&bar[XB_TMO])) break; if (sp > XB_SPIN_CAP) { atomicAdd(&bar[XB_TMO], 1u); break; } }
    }
    nloc = mine > 0u ? mine : 1u; nx = cnt > 0u ? cnt : 1u;
}

__device__ __forceinline__ void xcd_barrier(const XcdBarrier& b) {
    asm volatile("s_waitcnt vmcnt(0)" ::: "memory");
    __syncthreads();
    if (threadIdx.x == 0) {
        unsigned* bar = b.bar;
        __builtin_amdgcn_s_waitcnt(0);
        unsigned nloc = b.st[0], nx = b.st[1];
        if (nloc == 0u) { xcd_barrier_complete(bar, b.x, nloc, nx); b.st[0] = nloc; b.st[1] = nx; }
        const unsigned old = xb_add(&bar[XB_XSUB(b.x)], 1u);
        const unsigned gen = old / nloc;
        if (old + 1u == (gen + 1u) * nloc) {
            __builtin_amdgcn_fence(__ATOMIC_RELEASE, "agent");
            asm volatile("s_waitcnt vmcnt(0)" ::: "memory");
            const unsigned og = xb_add(&bar[XB_TOP], 1u);
            const unsigned tg = og / nx;
            if (og + 1u == (tg + 1u) * nx) xb_add(&bar[XB_TOPGEN], 1u);
            else XB_SPIN(xb_ld(&bar[XB_TOPGEN]) == tg, bar);
            __builtin_amdgcn_fence(__ATOMIC_ACQUIRE, "agent");
            xb_add(&bar[XB_XGEN(b.x)], 1u);
            asm volatile("s_waitcnt vmcnt(0)" ::: "memory");
        } else {
            XB_SPIN(xb_ld(&bar[XB_XGEN(b.x)]) == gen, bar);
            __builtin_amdgcn_fence(__ATOMIC_ACQUIRE, "agent");
            asm volatile("s_waitcnt vmcnt(0)" ::: "memory");
        }
    }
    __syncthreads();
}


struct Args { const void* in[30]; float* out; unsigned char* ws; int ph_lo, ph_hi; };
struct Frame {
    unsigned char* lds;
    int tid, lane, wave, vcu, G, gw, NGW;
    unsigned char* ws;
};

__device__ __forceinline__ int t5_bucket(int n) {
    if (n < 16) return n < 0 ? 0 : n;
    int b = 16;
    b += (n >= 22); b += (n >= 30); b += (n >= 40); b += (n >= 54); b += (n >= 73); b += (n >= 99); b += (n >= 134); b += (n >= 182);
    b += (n >= 246); b += (n >= 332); b += (n >= 450); b += (n >= 609); b += (n >= 825); b += (n >= 1117); b += (n >= 1513);
    return b;
}

__device__ __forceinline__ unsigned pk4_fp8(float a, float b, float c, float d) { int w = 0; w = __builtin_amdgcn_cvt_pk_fp8_f32(a, b, w, false); w = __builtin_amdgcn_cvt_pk_fp8_f32(c, d, w, true); return (unsigned)w; }
template <int MAP, bool OUT8 = false>
__device__ __forceinline__ void p0_transpose_item(const float* W, const float* W2, int K, int Nsrc, int Ndst, bf16* WT, const float* kscale, float* scr, int item, int lane, float oscale = 1.0f) {
    const int nblk = Ndst / 64, kb = item / nblk, nb = item % nblk, k0 = 64 * kb, n0 = 64 * nb;
    const int n4 = (lane & 15) * 4, n = n0 + n4, kr = lane >> 4;
    const float* src = W; int sc = n; bool ok = true;
    if (MAP == 1) { if (n < Z_QLAT) sc = n; else if (n < Z_NG) sc = n + 24; else if (n < Z_NG + 24) sc = n - Z_NG + 2560; else ok = false; }
    if (MAP == 2) { const int g32 = n >> 5, w = n & 31; src = (w < 16) ? W : W2; sc = g32 * 16 + (w & 15); }
    f32x4 v[16];
#pragma unroll
    for (int i = 0; i < 16; ++i) v[i] = ok ? __builtin_nontemporal_load((const f32x4*)(src + (size_t)(k0 + 4 * i + kr) * Nsrc + sc)) : (f32x4){0.f, 0.f, 0.f, 0.f};
#pragma unroll
    for (int i = 0; i < 16; ++i) { const int kk = 4 * i + kr; f32x4 t = v[i]; if (kscale) t = t * kscale[k0 + kk]; float* d = scr + kk * 65 + n4; d[0] = t.x; d[1] = t.y; d[2] = t.z; d[3] = t.w; }
    LDS_WAIT(); asm volatile("" ::: "memory");
    if constexpr (OUT8) {
        const int kg = lane & 3;
#pragma unroll
        for (int p = 0; p < 4; ++p) { const int nn = 16 * p + (lane >> 2); const float* s = scr + (16 * kg) * 65 + nn;
            v4u o; o.x = pk4_fp8(s[0 * 65] * oscale, s[1 * 65] * oscale, s[2 * 65] * oscale, s[3 * 65] * oscale); o.y = pk4_fp8(s[4 * 65] * oscale, s[5 * 65] * oscale, s[6 * 65] * oscale, s[7 * 65] * oscale);
            o.z = pk4_fp8(s[8 * 65] * oscale, s[9 * 65] * oscale, s[10 * 65] * oscale, s[11 * 65] * oscale); o.w = pk4_fp8(s[12 * 65] * oscale, s[13 * 65] * oscale, s[14 * 65] * oscale, s[15 * 65] * oscale);
            *(v4u*)((unsigned char*)WT + (size_t)(n0 + nn) * K + k0 + 16 * kg) = o; }
    } else {
    const int kg = lane & 7;
#pragma unroll
    for (int p = 0; p < 8; ++p) { const int nn = 8 * p + (lane >> 3); const float* s = scr + (8 * kg) * 65 + nn;
        v4u o; o.x = pk2(s[0 * 65], s[1 * 65]); o.y = pk2(s[2 * 65], s[3 * 65]); o.z = pk2(s[4 * 65], s[5 * 65]); o.w = pk2(s[6 * 65], s[7 * 65]);
        *(v4u*)(WT + (size_t)(n0 + nn) * K + k0 + 8 * kg) = o; }
    }
    LDS_WAIT(); asm volatile("" ::: "memory");
}
template <int MAP, bool OUT8 = false>
__device__ __forceinline__ void p0_transpose(Frame& F, const float* W, const float* W2, int K, int Nsrc, int Ndst, bf16* WT, const float* kscale, float oscale = 1.0f) {
    float* scr = (float*)(F.lds + F.wave * 16640);
    const int nitems = (K / 64) * (Ndst / 64);
    for (int it = F.gw; it < nitems; it += F.NGW) p0_transpose_item<MAP, OUT8>(W, W2, K, Nsrc, Ndst, WT, kscale, scr, it, F.lane, oscale);
}

__device__ __forceinline__ void modnorm_row(const float* xrow, const float* g, const float* sc, const float* sh, bf16* orow, int lane, f32x4 (&v)[8]) {
    const f32x4* xr = (const f32x4*)xrow + lane; float s = 0.f;
#pragma unroll
    for (int j = 0; j < 8; ++j) { v[j] = xr[64 * j]; s += (v[j].x * v[j].x + v[j].y * v[j].y) + (v[j].z * v[j].z + v[j].w * v[j].w); }
    const float rinv = 1.0f / sqrtf(wave_sum(s) * (1.f / D) + RMS_EPS);
    unsigned long long* o8 = (unsigned long long*)orow + lane;
#pragma unroll
    for (int j = 0; j < 8; ++j) { const f32x4 gg = ((const f32x4*)g)[lane + 64 * j], cc = ((const f32x4*)sc)[lane + 64 * j], hh = ((const f32x4*)sh)[lane + 64 * j];
        v[j] = (v[j] * rinv) * gg * (cc + 1.0f) + hh;
        o8[64 * j] = (unsigned long long)pk2(v[j].x, v[j].y) | ((unsigned long long)pk2(v[j].z, v[j].w) << 32); }
}
template <bool OUT8 = false>
__device__ __forceinline__ void modnorm_phase(Frame& F, const float* x, const float* g, const float* mod  , int sh_idx, bf16* H, float oscale = 1.0f) {
    for (int b = 0; b < NB; ++b) { const float* mb = mod + (size_t)b * 6 * D; const float* sc = mb + (size_t)(sh_idx + 1) * D; const float* sh = mb + (size_t)sh_idx * D;
        const int s0 = F.gw, s1 = F.gw + F.NGW;
        const f32x4* x0 = (const f32x4*)(x + ((size_t)b * S + s0) * D) + F.lane; const f32x4* x1 = (const f32x4*)(x + ((size_t)b * S + s1) * D) + F.lane;
        f32x4 v0[8], v1[8], ca[8], cc[8];
#pragma unroll
        for (int j = 0; j < 8; ++j) { v0[j] = x0[64 * j]; v1[j] = x1[64 * j]; }
#pragma unroll
        for (int j = 0; j < 8; ++j) { ca[j] = ((const f32x4*)g)[F.lane + 64 * j] * (((const f32x4*)sc)[F.lane + 64 * j] + 1.0f); cc[j] = ((const f32x4*)sh)[F.lane + 64 * j]; }
        float q0 = 0.f, q1 = 0.f;
#pragma unroll
        for (int j = 0; j < 8; ++j) { q0 += (v0[j].x * v0[j].x + v0[j].y * v0[j].y) + (v0[j].z * v0[j].z + v0[j].w * v0[j].w); q1 += (v1[j].x * v1[j].x + v1[j].y * v1[j].y) + (v1[j].z * v1[j].z + v1[j].w * v1[j].w); }
        const float r0 = 1.0f / sqrtf(wave_sum(q0) * (1.f / D) + RMS_EPS), r1 = 1.0f / sqrtf(wave_sum(q1) * (1.f / D) + RMS_EPS);
        if constexpr (OUT8) {
            unsigned* o0 = (unsigned*)((unsigned char*)H + ((size_t)b * S + s0) * D) + F.lane; unsigned* o1 = (unsigned*)((unsigned char*)H + ((size_t)b * S + s1) * D) + F.lane;
#pragma unroll
            for (int j = 0; j < 8; ++j) { const f32x4 a = ((v0[j] * r0) * ca[j] + cc[j]) * oscale, c2 = ((v1[j] * r1) * ca[j] + cc[j]) * oscale;
                o0[64 * j] = pk4_fp8(__builtin_amdgcn_fmed3f(a.x, -440.f, 440.f), __builtin_amdgcn_fmed3f(a.y, -440.f, 440.f), __builtin_amdgcn_fmed3f(a.z, -440.f, 440.f), __builtin_amdgcn_fmed3f(a.w, -440.f, 440.f));
                o1[64 * j] = pk4_fp8(__builtin_amdgcn_fmed3f(c2.x, -440.f, 440.f), __builtin_amdgcn_fmed3f(c2.y, -440.f, 440.f), __builtin_amdgcn_fmed3f(c2.z, -440.f, 440.f), __builtin_amdgcn_fmed3f(c2.w, -440.f, 440.f)); }
        } else {
        unsigned long long* o0 = (unsigned long long*)(H + ((size_t)b * S + s0) * D) + F.lane; unsigned long long* o1 = (unsigned long long*)(H + ((size_t)b * S + s1) * D) + F.lane;
#pragma unroll
        for (int j = 0; j < 8; ++j) { const f32x4 a = (v0[j] * r0) * ca[j] + cc[j], c2 = (v1[j] * r1) * ca[j] + cc[j];
            o0[64 * j] = (unsigned long long)pk2(a.x, a.y) | ((unsigned long long)pk2(a.z, a.w) << 32); o1[64 * j] = (unsigned long long)pk2(c2.x, c2.y) | ((unsigned long long)pk2(c2.z, c2.w) << 32); }
        }
    }
}

__device__ __forceinline__ float gelu_tanh(float x) { const float u = 0.7978845608028654f * (x + 0.044715f * x * x * x); return 0.5f * x * (1.0f + tanhf(u)); }

__global__ void __launch_bounds__(NWAVES * 64, 2) fwd(Args args) {
    extern __shared__ __attribute__((aligned(16))) unsigned char lds[];
    Frame F;
    F.lds = lds; F.ws = args.ws;
    F.tid = threadIdx.x; F.lane = F.tid & 63; F.wave = __builtin_amdgcn_readfirstlane(F.tid >> 6);
    F.G = gridDim.x; { const int bx = blockIdx.x; F.vcu = (F.G % 8 == 0) ? (bx % 8) * (F.G / 8) + bx / 8 : bx; }
    F.gw = F.vcu * NWAVES + F.wave; F.NGW = F.G * NWAVES;
    unsigned char* ws = args.ws;
    unsigned* ctl = (unsigned*)(ws + WS_CTL);
    volatile LAS unsigned* MISC = (volatile LAS unsigned*)((LAS unsigned char*)lds + MISC_OFF);
    for (int u = F.tid; u < 64; u += NWAVES * 64) MISC[u] = 0u;
    __syncthreads();
    XcdBarrier bar; bar.bar = ctl + CW_BAR; bar.x = 0; bar.st = nullptr;
    if (MK_N_LAUNCHES == 1) bar = xcd_barrier_post(ctl + CW_BAR, MISC + 8);
    const int lo = args.ph_lo, hi = args.ph_hi;
#define IN(k) (lo <= (k) && (k) < hi)
#define MOE_WSCALE 64.0f
#define MOE_ASCALE 8.0f
#define IN1_ASCALE 4.0f
#define SEAM(k) do { if (IN(k) && IN((k) + 1)) xcd_barrier(bar); } while (0)

    const float* x_in = (const float*)args.in[0]; const float* c_in = (const float*)args.in[1]; const int* positions = (const int*)args.in[2];
    const float* rel_bias = (const float*)args.in[3]; const float* ada_w = (const float*)args.in[4]; const float* ada_b = (const float*)args.in[5];
    const float* mix_norm_g = (const float*)args.in[6]; const float* ffn_norm_g = (const float*)args.in[7];
    const float* ab_w_in = (const float*)args.in[8]; const float* ab_w_out = (const float*)args.in[9];
    const float* cmp_pos_k = (const float*)args.in[10]; const float* cmp_w1_k = (const float*)args.in[11]; const float* cmp_w2_k = (const float*)args.in[12];
    const float* cmp_pos_v = (const float*)args.in[13]; const float* cmp_w1_v = (const float*)args.in[14]; const float* cmp_w2_v = (const float*)args.in[15];
    const float* q_norm_g = (const float*)args.in[16]; const float* kv_norm_g = (const float*)args.in[17]; const float* w_uq = (const float*)args.in[18]; const float* w_ukv = (const float*)args.in[19];
    const float* ffn_wg = (const float*)args.in[20]; const float* ffn_wu = (const float*)args.in[21]; const float* ffn_wd = (const float*)args.in[22];
    const float* c_w_in = (const float*)args.in[23]; const float* c_w_out = (const float*)args.in[24]; const float* w_router = (const float*)args.in[25];
    const float* moe_wg = (const float*)args.in[26]; const float* moe_wu = (const float*)args.in[27]; const float* moe_wd = (const float*)args.in[28]; const float* final_g = (const float*)args.in[29];
    float* MOD = (float*)(ws + WS_MOD); float* BIAS = (float*)(ws + WS_BIAS); float* ROPE = (float*)(ws + WS_ROPE); float* RINV = (float*)(ws + WS_RINV);
    unsigned long long* SEL = (unsigned long long*)(ws + WS_SEL); bf16* KC = (bf16*)(ws + WS_KC); bf16* VC = (bf16*)(ws + WS_VC); int* ROUTE = (int*)(ws + WS_ROUTE); bf16* KPE = (bf16*)(ws + WS_KPE);
    bf16* W_IN0 = (bf16*)(ws + WS_WIN0); bf16* W_UQ = (bf16*)(ws + WS_WUQ); bf16* W_UKV = (bf16*)(ws + WS_WUKV); bf16* W_OUT0 = (bf16*)(ws + WS_WOUT0); bf16* W_GU0 = (bf16*)(ws + WS_WGU0); bf16* W_DN0 = (bf16*)(ws + WS_WDN0);
    bf16* W_IN1 = (bf16*)(ws + WS_WIN1); bf16* W_OUT1 = (bf16*)(ws + WS_WOUT1); bf16* W_MGU = (bf16*)(ws + WS_WMGU); bf16* W_MDN = (bf16*)(ws + WS_WMDN);
    float* X = (float*)(ws + WS_X); bf16* H = (bf16*)(ws + WS_H);
    bf16* Z0 = (bf16*)(ws + WS_Z0); bf16* QM = (bf16*)(ws + WS_QM); bf16* KVM = (bf16*)(ws + WS_KVM); bf16* OCMP = (bf16*)(ws + WS_OCMP); bf16* OWIN = (bf16*)(ws + WS_OWIN); bf16* CAT = (bf16*)(ws + WS_CAT);
    bf16* W1T = (bf16*)(ws + WS_W1T); bf16* W2T = (bf16*)(ws + WS_W2T); float* CB1 = (float*)(ws + WS_CB1);
    float* LSEB = (float*)(ws + WS_LSE); bf16* OP = (bf16*)(ws + WS_OP);
    bf16* ACT = (bf16*)(ws + WS_ACT); bf16* Z1 = (bf16*)(ws + WS_Z1); bf16* OM = (bf16*)(ws + WS_OM); bf16* XB = (bf16*)(ws + WS_XB); bf16* ACTB = (bf16*)(ws + WS_ACTB); bf16* YB = (bf16*)(ws + WS_YB);
    PG8_LAS unsigned char* ring = (PG8_LAS unsigned char*)lds;

    if (IN(0)) {
        for (int job = 192 + (int)blockIdx.x; job < 194; job += F.G) {
            float* red = (float*)(lds + 32768); const int c = job - 192; const float* pos = c ? cmp_pos_v : cmp_pos_k; const float* w1 = c ? cmp_w1_v : cmp_w1_k;
            float a0 = 0.f, a1 = 0.f;
#pragma unroll 8
            for (int k = 0; k < 512; ++k) { const int kk = F.wave * 512 + k; const f32x2 wv = *(const f32x2*)(w1 + (size_t)kk * 128 + 2 * F.lane); const float pv = pos[kk]; a0 += pv * wv.x; a1 += pv * wv.y; }
            red[F.wave * 128 + 2 * F.lane] = a0; red[F.wave * 128 + 2 * F.lane + 1] = a1;
            __syncthreads();
            if (F.tid < 128) { float s = 0.f;
#pragma unroll
                for (int w = 0; w < 8; ++w) s += red[w * 128 + F.tid];
                CB1[c * 128 + F.tid] = s; }
            __syncthreads();
        }
        for (int job = blockIdx.x; job < 256; job += F.G) {
            float* cs = (float*)lds; float* red = (float*)(lds + 32768);
            for (int i = F.tid; i < 4 * D; i += 512) { const float cv = c_in[i]; cs[i] = cv / (1.0f + __expf(-cv)); }
            __syncthreads();
            const int l = job >> 7, col0 = (job & 127) * 96; const bool act = F.lane < 48;
            float acc[4][2] = {};
            const float* wp = ada_w + ((size_t)l * D + (size_t)F.wave * 256) * 12288 + col0 + 2 * (act ? F.lane : 0);
#pragma unroll 8
            for (int k = 0; k < 256; ++k) { const f32x2 wv = *(const f32x2*)(wp + (size_t)k * 12288); const int kk = F.wave * 256 + k;
#pragma unroll
                for (int b = 0; b < 4; ++b) { const float cv = cs[b * D + kk]; acc[b][0] += cv * wv.x; acc[b][1] += cv * wv.y; } }
            if (act) {
#pragma unroll
                for (int b = 0; b < 4; ++b) { red[(F.wave * 4 + b) * 96 + 2 * F.lane] = acc[b][0]; red[(F.wave * 4 + b) * 96 + 2 * F.lane + 1] = acc[b][1]; } }
            __syncthreads();
            if (F.tid < 384) { const int b = F.tid / 96, cc = F.tid % 96; float s = 0.f;
#pragma unroll
              for (int w = 0; w < 8; ++w) s += red[(w * 4 + b) * 96 + cc];
              MOD[((size_t)l * 4 + b) * 12288 + col0 + cc] = s + ada_b[(size_t)l * 12288 + col0 + cc]; }
            __syncthreads();
        }
        __syncthreads();
        p0_transpose<1>(F, ab_w_in, nullptr, D, 3672, Z0W, W_IN0, nullptr);
        p0_transpose<0>(F, w_uq, nullptr, 512, QMW, QMW, W_UQ, q_norm_g);
        p0_transpose<0>(F, w_ukv, nullptr, 512, KVMW, KVMW, W_UKV, kv_norm_g);
        p0_transpose<0>(F, ab_w_out, nullptr, D, D, D, W_OUT0, nullptr);
        p0_transpose<2>(F, ffn_wg, ffn_wu, D, FF, 2 * FF, W_GU0, nullptr);
        p0_transpose<0>(F, ffn_wd, nullptr, FF, D, D, W_DN0, nullptr);
        p0_transpose<0, true>(F, c_w_in, nullptr, D, Z1W, Z1W, W_IN1, nullptr, MOE_WSCALE);
        p0_transpose<0>(F, c_w_out, nullptr, 1024, D, D, W_OUT1, nullptr);
        p0_transpose<0>(F, cmp_w1_k, nullptr, 4096, 128, 128, W1T, nullptr); p0_transpose<0>(F, cmp_w1_v, nullptr, 4096, 128, 128, W1T + 128 * 4096, nullptr);
        p0_transpose<0>(F, cmp_w2_k, nullptr, 128, 128, 128, W2T, nullptr); p0_transpose<0>(F, cmp_w2_v, nullptr, 128, 128, 128, W2T + 128 * 128, nullptr);
        for (int e = 0; e < NE; ++e) {
            p0_transpose<2, true>(F, moe_wg + (size_t)e * D * FFE, moe_wu + (size_t)e * D * FFE, D, FFE, 2 * FFE, (bf16*)((unsigned char*)W_MGU + (size_t)e * 2 * FFE * D), nullptr, MOE_WSCALE);
            p0_transpose<0, true>(F, moe_wd + (size_t)e * FFE * D, nullptr, FFE, D, D, (bf16*)((unsigned char*)W_MDN + (size_t)e * D * FFE), nullptr, MOE_WSCALE);
        }
        for (int i = F.gw * 64 + F.lane; i < 8 * BIAS_LD; i += F.NGW * 64) { const int h = i / BIAS_LD, r = i % BIAS_LD - 64; BIAS[i] = rel_bias[t5_bucket(r) * 8 + h]; }
        for (int i = F.gw * 64 + F.lane; i < M * 32; i += F.NGW * 64) { const int m = i >> 5, f = i & 31;
            const float inv_freq = powf(10000.0f, -(float)(2 * f) / 64.0f); const float ang = (float)positions[m] * inv_freq;
            ROPE[(size_t)m * 64 + f] = cosf(ang); ROPE[(size_t)m * 64 + 32 + f] = sinf(ang); }
    }
    SEAM(0);
    if (IN(1)) modnorm_phase(F, x_in, mix_norm_g, MOD, 0, H);
    SEAM(1);
    if (IN(2)) { pg8::Gemm g{H, W_IN0, D, D, D}; pg8::StaticOrder So; So.init(M, Z0W, F.G, (int)blockIdx.x); pg8::EpiBf16 E{Z0, Z0W, nullptr};
        pg8::gemm_phase<pg8::EpiBf16, pg8::StaticOrder, PG_ALIGN, PG_SP2>(ring, g, So, E); }
    SEAM(2);
    if (IN(3)) {
        for (int m = F.gw; m < M; m += F.NGW) {
            const bf16* zr = Z0 + (size_t)m * Z0W;
#pragma unroll
            for (int w = 0; w < 2; ++w) { const v4u a = *(const v4u*)(zr + (w ? Z_KVLAT : Z_QLAT) + 8 * F.lane);
                float s = bflo(a.x) * bflo(a.x) + bfhi(a.x) * bfhi(a.x) + bflo(a.y) * bflo(a.y) + bfhi(a.y) * bfhi(a.y) + bflo(a.z) * bflo(a.z) + bfhi(a.z) * bfhi(a.z) + bflo(a.w) * bflo(a.w) + bfhi(a.w) * bfhi(a.w);
                s = wave_sum(s); if (F.lane == 0) RINV[(size_t)w * M + m] = 1.0f / sqrtf(s * (1.f / 512.f) + RMS_EPS); }
            if (F.lane < 32) { const float x1 = bf2f(zr[Z_KPE + F.lane]), x2 = bf2f(zr[Z_KPE + 32 + F.lane]); const float cs = ROPE[(size_t)m * 64 + F.lane], sn = ROPE[(size_t)m * 64 + 32 + F.lane];
                KPE[(size_t)m * 64 + F.lane] = (bf16)f2bf(x1 * cs - x2 * sn); KPE[(size_t)m * 64 + 32 + F.lane] = (bf16)f2bf(x2 * cs + x1 * sn); }
        }
        __syncthreads();
        for (int job = blockIdx.x; job < 256; job += F.G) {
            typedef short bfx8 __attribute__((ext_vector_type(8)));
            const int nt = job & 15, g = (job >> 4) & 1, b = (job >> 5) & 3, c = job >> 7, n0 = nt * 16;
            const int fr = F.lane & 15, fq = F.lane >> 4; int nrow = n0 + fr; if (nrow > 254) nrow = 254;
            const bf16* arow = Z0 + ((size_t)b * S + 16 * nrow) * Z0W + Z_NKV + c * 256 + g * 128 + fq * 8;
            const bf16* w1t = W1T + (size_t)c * 128 * 4096 + (size_t)fr * 4096 + fq * 8;
            f32x4 acc[8];
#pragma unroll
            for (int i = 0; i < 8; ++i) acc[i] = (f32x4){0.f, 0.f, 0.f, 0.f};
#pragma unroll 2
            for (int ks = 0; ks < 16; ++ks) { const int kk = F.wave * 512 + ks * 32, l = kk >> 7, d0 = kk & 127;
                const bfx8 af = *(const bfx8*)(arow + (size_t)l * Z0W + d0);
#pragma unroll
                for (int i = 0; i < 8; ++i) { const bfx8 bfr = *(const bfx8*)(w1t + (size_t)i * 16 * 4096 + kk); acc[i] = __builtin_amdgcn_mfma_f32_16x16x32_bf16(af, bfr, acc[i], 0, 0, 0); } }
            float* part = (float*)lds;
#pragma unroll
            for (int i = 0; i < 8; ++i)
#pragma unroll
                for (int j = 0; j < 4; ++j) part[(F.wave * 16 + fq * 4 + j) * 128 + i * 16 + fr] = acc[i][j];
            __syncthreads();
            bf16* hid = (bf16*)(lds + 65536);
            { const int row = F.tid >> 5, c4 = (F.tid & 31) * 4; f32x4 s = *(const f32x4*)(CB1 + c * 128 + c4);
#pragma unroll
              for (int w = 0; w < 8; ++w) s += *(const f32x4*)(part + (w * 16 + row) * 128 + c4);
              *(v2u*)(hid + row * 128 + c4) = (v2u){pk2(gelu_tanh(s.x), gelu_tanh(s.y)), pk2(gelu_tanh(s.z), gelu_tanh(s.w))}; }
            __syncthreads();
            { f32x4 o4 = {0.f, 0.f, 0.f, 0.f}; const bf16* w2t = W2T + (size_t)c * 128 * 128 + (size_t)(F.wave * 16 + fr) * 128 + fq * 8;
#pragma unroll
              for (int ks = 0; ks < 4; ++ks) { const bfx8 af = *(const bfx8*)(hid + fr * 128 + ks * 32 + fq * 8); const bfx8 bfr = *(const bfx8*)(w2t + ks * 32); o4 = __builtin_amdgcn_mfma_f32_16x16x32_bf16(af, bfr, o4, 0, 0, 0); }
              bf16* outp = (c ? VC : KC) + (((size_t)b * 2 + g) * 256) * 128 + F.wave * 16 + fr;
#pragma unroll
              for (int j = 0; j < 4; ++j) { const int n = n0 + fq * 4 + j; outp[(size_t)n * 128] = n < 255 ? (bf16)f2bf(o4[j]) : (bf16)0; } }
            __syncthreads();
        }
        __syncthreads();
        for (int Lx = blockIdx.x; Lx < 512; Lx += F.G) {
            const int qb = 15 - Lx / 32, bh = Lx % 32, b = bh >> 3, h = bh & 7, g = h >> 2; const bf16* zb = Z0 + (size_t)b * S * Z0W;
            fa::Item it{}; it.Q = zb + Z_NQ + h * 128; it.qs = Z0W; it.K = zb + Z_NKV + 4 * 256 + g * 128; it.ks = Z0W; it.V = zb + Z_NKV + 5 * 256 + g * 128; it.vs = Z0W;
            it.P0 = qb * 256; it.skv = S; it.W = 512; it.bias = BIAS + (size_t)h * BIAS_LD + 64; it.bstep = 1; it.O = OWIN + (size_t)b * S * 1024 + h * 128; it.os = 1024;
            fa::attn_block<0>(it, lds);
        }
    }
    SEAM(3);
    if (IN(4)) {
        { pg8::Gemm g{Z0 + Z_QLAT, W_UQ, Z0W, 512, 512}; pg8::StaticOrder So; So.init(M, QMW, F.G, (int)blockIdx.x); pg8::EpiBf16 E{QM, QMW, RINV};
          pg8::gemm_phase<pg8::EpiBf16, pg8::StaticOrder, PG_ALIGN, PG_SP2>(ring, g, So, E); }
        __syncthreads();
        { pg8::Gemm g{Z0 + Z_KVLAT, W_UKV, Z0W, 512, 512}; pg8::StaticOrder So; So.init(M, KVMW, F.G, (int)blockIdx.x); pg8::EpiBf16 E{KVM, KVMW, RINV + M};
          pg8::gemm_phase<pg8::EpiBf16, pg8::StaticOrder, PG_ALIGN, PG_SP2>(ring, g, So, E); }
        __syncthreads();
        for (int Lx = blockIdx.x; Lx < 512; Lx += F.G) { const int tb = 63 - Lx / 8, bg = Lx % 8, b = bg >> 1, g = bg & 1;
            fa::CmpItem it; it.Q = Z0 + ((size_t)b * S + tb * 64) * Z0W + Z_NQ + g * 512; it.qs = Z0W; it.K = KC + ((size_t)b * 2 + g) * 256 * 128; it.V = VC + ((size_t)b * 2 + g) * 256 * 128;
            it.bias = BIAS + (size_t)(g * 4) * BIAS_LD + 64; it.bld = BIAS_LD; it.s0 = tb * 64; it.O = OCMP + ((size_t)b * S + tb * 64) * 1024 + g * 512; it.os = 1024; it.sel = SEL + ((size_t)b * S + tb * 64) * 2 + g;

            fa::cmp_block(it, lds, SMALL_OFF); }
    }
    SEAM(4);
    if (IN(5)) {
        for (int Lx = blockIdx.x; Lx < 256; Lx += F.G) {
            const int x = Lx / 32, bh = Lx % 32, b = bh >> 3, h = bh & 7, g = h >> 2; const bf16* zb = Z0 + (size_t)b * S * Z0W;
            for (int pass = 0; pass < 2; ++pass) { const int qb = pass ? 15 - x : x;
                fa::Item it{}; it.Q = zb + Z_NQ + h * 128; it.qs = Z0W; it.K = zb + Z_NKV + 2 * 256 + g * 128; it.ks = Z0W; it.V = zb + Z_NKV + 3 * 256 + g * 128; it.vs = Z0W;
                it.P0 = qb * 256; it.skv = S; it.W = 1 << 20; it.bias = BIAS + (size_t)h * BIAS_LD + 64; it.bstep = 1; it.sel = SEL + (size_t)b * S * 2 + g; it.sels = 2;
                it.O = CAT + (size_t)b * S * 2048 + h * 128; it.os = 2048;
                it.M0 = OCMP + (size_t)b * S * 1024 + h * 128; it.M1 = OWIN + (size_t)b * S * 1024 + h * 128; it.ms = 1024; it.G = zb + Z_NG + h * 3; it.gs = Z0W;
                fa::attn_block<1>(it, lds); }
        }
        for (int Lx = blockIdx.x; Lx < 256; Lx += F.G) {
            const int x = Lx / 32, bh = Lx % 32, b = bh >> 3, h = bh & 7;
            for (int pass = 0; pass < 2; ++pass) { const int qb = pass ? 15 - x : x;
                fa::Item it{}; it.Q = QM + (size_t)b * S * QMW + h * 192; it.qs = QMW; it.rope = ROPE + (size_t)b * S * 64; it.ropes = 64;
                it.K = KVM + (size_t)b * S * KVMW + h * 256; it.ks = KVMW; it.K2 = KPE + (size_t)b * S * 64; it.k2s = 64; it.V = KVM + (size_t)b * S * KVMW + h * 256 + 128; it.vs = KVMW;
                it.P0 = qb * 256; it.skv = S; it.W = 1 << 20; it.O = CAT + (size_t)b * S * 2048 + 1024 + h * 128; it.os = 2048;
                fa::attn_block<2>(it, lds); }
        }
    }
    SEAM(5);
    if (IN(6)) { pg8::Gemm g{CAT, W_OUT0, 2048, 2048, 2048}; pg8::StaticOrder So; So.init(M, D, F.G, (int)blockIdx.x); pg8::EpiResid E{x_in, X, D, MOD + 2 * D, 6 * D, S / 256};
        pg8::gemm_phase<pg8::EpiResid, pg8::StaticOrder, PG_ALIGN, PG_SP2>(ring, g, So, E); }
    SEAM(6);
    if (IN(7)) modnorm_phase(F, X, ffn_norm_g, MOD, 3, H);
    SEAM(7);
    if (IN(8)) { pg8::Gemm g{H, W_GU0, D, D, D}; pg8::StaticOrder So; So.init(M, 2 * FF, F.G, (int)blockIdx.x); pg8::EpiSwiGLU E{ACT, FF};
        pg8::gemm_phase<pg8::EpiSwiGLU, pg8::StaticOrder, PG_ALIGN, PG_SP2>(ring, g, So, E); }
    SEAM(8);
    if (IN(9)) { pg8::Gemm g{ACT, W_DN0, FF, FF, FF}; pg8::StaticOrder So; So.init(M, D, F.G, (int)blockIdx.x); pg8::EpiResid E{X, X, D, MOD + 5 * D, 6 * D, S / 256};
        pg8::gemm_phase<pg8::EpiResid, pg8::StaticOrder, PG_ALIGN, PG_SP2>(ring, g, So, E); }
    SEAM(9);
    if (IN(10)) modnorm_phase<true>(F, X, mix_norm_g + D, MOD + 4 * 12288, 0, H, IN1_ASCALE);
    SEAM(10);
    if (IN(11)) { pg8::Gemm g{H, W_IN1, D / 2, D / 2, D / 2}; pg8::StaticOrder So; So.init(M, Z1W, F.G, (int)blockIdx.x); pg8::EpiBf16S E{Z1, Z1W, 1.0f / (MOE_WSCALE * IN1_ASCALE)};
        pg8::gemm_phase<pg8::EpiBf16S, pg8::StaticOrder, PG_ALIGN, PG_SP2, true, true>(ring, g, So, E); }
    SEAM(11);
    if (IN(12)) {
        for (int Lx = blockIdx.x; Lx < 1536; Lx += F.G) {
            const int p = Lx % 3, r_ = Lx / 3, bh = r_ % 32, sub = r_ / 32, b = bh >> 3, h = bh & 7;
            const int dil = p == 0 ? 1 : (p == 1 ? 4 : 16), res = p == 0 ? 0 : (p == 1 ? (sub & 3) : sub), qb = p == 0 ? sub : (p == 1 ? (sub >> 2) : 0);
            fa::Item it{}; it.Q = Z1 + ((size_t)b * S + res) * Z1W + p * 3072 + h * 128; it.qs = (long)dil * Z1W; it.K = it.Q + 1024; it.ks = it.qs; it.V = it.Q + 2048; it.vs = it.qs;
            it.P0 = qb * 256; it.skv = S / dil; it.W = 129; it.bias = BIAS + (size_t)h * BIAS_LD + 64; it.bstep = dil;
            it.O = OP + (size_t)p * M * 1024 + ((size_t)b * S + res) * 1024 + h * 128; it.os = (long)dil * 1024; it.LSE = LSEB + (size_t)p * M * 8 + ((size_t)b * S + res) * 8 + h; it.lses = (long)dil * 8;
            fa::attn_block<0>(it, lds);
        }
    }
    SEAM(12);
    if (IN(13)) {
        for (int m = F.gw; m < M; m += F.NGW) {
            const int h = F.lane >> 3; const float l0 = LSEB[(size_t)m * 8 + h], l1 = LSEB[(size_t)(M + m) * 8 + h], l2 = LSEB[(size_t)(2 * M + m) * 8 + h];
            const v4u* p0 = (const v4u*)(OP + (size_t)m * 1024) + 2 * F.lane; const v4u* p1 = (const v4u*)(OP + (size_t)(M + m) * 1024) + 2 * F.lane; const v4u* p2 = (const v4u*)(OP + (size_t)(2 * M + m) * 1024) + 2 * F.lane;
            const v4u a0 = p0[0], b0 = p0[1], a1 = p1[0], b1 = p1[1], a2 = p2[0], b2 = p2[1];
            const float mx = fmaxf(l0, fmaxf(l1, l2)); float e0 = __expf(l0 - mx), e1 = __expf(l1 - mx), e2 = __expf(l2 - mx); const float inv = 1.0f / (e0 + e1 + e2); e0 *= inv; e1 *= inv; e2 *= inv;
            v4u oa, ob;
#pragma unroll
            for (int q = 0; q < 4; ++q) { oa[q] = pk2(e0 * bflo(a0[q]) + e1 * bflo(a1[q]) + e2 * bflo(a2[q]), e0 * bfhi(a0[q]) + e1 * bfhi(a1[q]) + e2 * bfhi(a2[q]));
                ob[q] = pk2(e0 * bflo(b0[q]) + e1 * bflo(b1[q]) + e2 * bflo(b2[q]), e0 * bfhi(b0[q]) + e1 * bfhi(b1[q]) + e2 * bfhi(b2[q])); }
            v4u* po = (v4u*)(OM + (size_t)m * 1024) + 2 * F.lane; po[0] = oa; po[1] = ob;
        }
    }
    SEAM(13);
    if (IN(14)) { pg8::Gemm g{OM, W_OUT1, 1024, 1024, 1024}; pg8::StaticOrder So; So.init(M, D, F.G, (int)blockIdx.x); pg8::EpiResid E{X, X, D, MOD + 4 * 12288 + 2 * D, 6 * D, S / 256};
        pg8::gemm_phase<pg8::EpiResid, pg8::StaticOrder, PG_ALIGN, PG_SP2>(ring, g, So, E); }
    SEAM(14);
    if (IN(15)) {
        f32x4* wl = (f32x4*)lds; int* lcnt = (int*)(lds + 65536); int* lbase = lcnt + 8; int* rinfo = lcnt + 16;
        for (int i = F.tid; i < 4096; i += 512) { const int slot = i >> 6, l = i & 63, j = slot >> 3, q = (slot >> 1) & 3, half = slot & 1; wl[i] = *(const f32x4*)(w_router + (size_t)(4 * l + 256 * j + q) * 8 + half * 4); }
        if (F.tid < 8) lcnt[F.tid] = 0;
        __syncthreads();
        for (int k = 0; k < M / 2048; ++k) { const int m = F.gw + k * F.NGW; if (m >= M) break; const int b = m / S; const float* mb = MOD + 4 * 12288 + (size_t)b * 6 * D; f32x4 v[8];
            modnorm_row(X + (size_t)m * D, ffn_norm_g + D, mb + 4 * D, mb + 3 * D, H + (size_t)m * D, F.lane, v);
            float lg[8] = {};
#pragma unroll
            for (int j = 0; j < 8; ++j)
#pragma unroll
                for (int q = 0; q < 4; ++q) { const f32x4 wa = wl[((j * 4 + q) * 2 + 0) * 64 + F.lane], wb = wl[((j * 4 + q) * 2 + 1) * 64 + F.lane]; const float hv = v[j][q];
                    lg[0] += hv * wa.x; lg[1] += hv * wa.y; lg[2] += hv * wa.z; lg[3] += hv * wa.w; lg[4] += hv * wb.x; lg[5] += hv * wb.y; lg[6] += hv * wb.z; lg[7] += hv * wb.w; }
#pragma unroll
            for (int e = 0; e < 8; ++e) lg[e] = wave_sum(lg[e]);
            int e1 = 0; float v1 = lg[0];
#pragma unroll
            for (int e = 1; e < 8; ++e) if (lg[e] > v1) { v1 = lg[e]; e1 = e; }
            int e2 = -1; float v2 = -3.0e38f;
#pragma unroll
            for (int e = 0; e < 8; ++e) if (e != e1 && lg[e] > v2) { v2 = lg[e]; e2 = e; }
            if (F.lane == 0) { const float g1 = 1.0f / (1.0f + __expf(v2 - v1)), g2 = 1.0f - g1;
                const int r1 = __hip_atomic_fetch_add(lcnt + e1, 1, __ATOMIC_RELAXED, __HIP_MEMORY_SCOPE_WORKGROUP), r2 = __hip_atomic_fetch_add(lcnt + e2, 1, __ATOMIC_RELAXED, __HIP_MEMORY_SCOPE_WORKGROUP);
                int* ri = rinfo + (F.wave * 8 + k) * 8; ri[0] = e1; ri[1] = e2; ri[2] = r1; ri[3] = r2; ri[4] = __float_as_int(g1); ri[5] = __float_as_int(g2); }
        }
        __syncthreads();
        if (F.tid < 8) lbase[F.tid] = (int)atomicAdd(ctl + CW_CNT + F.tid, (unsigned)lcnt[F.tid]);
        __syncthreads();
        if (F.lane == 0) for (int k = 0; k < M / 2048; ++k) { const int m = F.gw + k * F.NGW; if (m >= M) break; const int* ri = rinfo + (F.wave * 8 + k) * 8; int* rt = ROUTE + (size_t)m * 8;
            rt[0] = ri[0]; rt[1] = ri[1]; rt[2] = ri[2] + lbase[ri[0]]; rt[3] = ri[3] + lbase[ri[1]]; rt[4] = ri[4]; rt[5] = ri[5]; }
    }
    SEAM(15);
    if (IN(16)) {
        unsigned ts[9]; ts[0] = 0;
#pragma unroll
        for (int e = 0; e < 8; ++e) ts[e + 1] = ts[e] + (__hip_atomic_load(ctl + CW_CNT + e, __ATOMIC_RELAXED, __HIP_MEMORY_SCOPE_AGENT) + 255u) / 256u;
        if (blockIdx.x == 0 && F.tid < 9) { unsigned v = ts[0];
#pragma unroll
            for (int e = 1; e < 9; ++e) v = (F.tid == e) ? ts[e] : v;
            ctl[CW_TS + F.tid] = v; }
        for (int m = F.gw; m < M; m += F.NGW) { const int* rt = ROUTE + (size_t)m * 8; const int e1 = rt[0], e2 = rt[1]; unsigned t1 = 0, t2 = 0;
#pragma unroll
            for (int e = 0; e < 8; ++e) { t1 = (e == e1) ? ts[e] : t1; t2 = (e == e2) ? ts[e] : t2; }
            const size_t d1 = (size_t)t1 * 256 + rt[2], d2 = (size_t)t2 * 256 + rt[3];
            const v4u* src = (const v4u*)(H + (size_t)m * D) + F.lane;
            v2u* o1 = (v2u*)((unsigned char*)XB + d1 * D) + F.lane; v2u* o2 = (v2u*)((unsigned char*)XB + d2 * D) + F.lane;
#pragma unroll
            for (int j = 0; j < 4; ++j) { const v4u w = src[64 * j]; v2u q; q.x = pk4_fp8(bflo(w.x), bfhi(w.x), bflo(w.y), bfhi(w.y)); q.y = pk4_fp8(bflo(w.z), bfhi(w.z), bflo(w.w), bfhi(w.w)); o1[64 * j] = q; o2[64 * j] = q; } }
    }
    SEAM(16);
    if (IN(17)) { pg8::Gemm g{XB, W_MGU, D / 2, D / 2, D / 2}; pg8::GroupedOrder So; So.init(ctl + CW_TS, 2 * FFE / 256, F.G, (int)blockIdx.x); pg8::EpiSwiGLU8 E{(unsigned char*)ACTB, FFE, 1.0f / MOE_WSCALE, MOE_ASCALE};
        pg8::gemm_phase<pg8::EpiSwiGLU8, pg8::GroupedOrder, PG_ALIGN, PG_SP2, true, true>(ring, g, So, E); }
    SEAM(17);
    if (IN(18)) { pg8::Gemm g{ACTB, W_MDN, FFE / 2, FFE / 2, FFE / 2}; pg8::GroupedOrder So; So.init(ctl + CW_TS, D / 256, F.G, (int)blockIdx.x); pg8::EpiBf16S E{YB, D, 1.0f / (MOE_WSCALE * MOE_ASCALE)};
        pg8::gemm_phase<pg8::EpiBf16S, pg8::GroupedOrder, PG_ALIGN, PG_SP2, true, true>(ring, g, So, E); }
    SEAM(18);
    if (IN(19)) {
        unsigned ts[9]; ts[0] = 0;
#pragma unroll
        for (int e = 0; e < 8; ++e) ts[e + 1] = ctl[CW_TS + e + 1];
#pragma unroll
        for (int b = 0; b < NB; ++b) {
            const float* gf = MOD + 4 * 12288 + (size_t)b * 6 * D + 5 * D;
            const int m0 = b * S + F.gw, m1 = m0 + F.NGW;
            const int* rt0 = ROUTE + (size_t)m0 * 8; const int* rt1 = ROUTE + (size_t)m1 * 8;
            const int e10 = rt0[0], e20 = rt0[1], r10 = rt0[2], r20 = rt0[3], e11 = rt1[0], e21 = rt1[1], r11 = rt1[2], r21 = rt1[3];
            const float g10 = __int_as_float(rt0[4]), g20 = __int_as_float(rt0[5]), g11 = __int_as_float(rt1[4]), g21 = __int_as_float(rt1[5]);
            unsigned t10 = 0, t20 = 0, t11 = 0, t21 = 0;
#pragma unroll
            for (int e = 0; e < 8; ++e) { t10 = (e == e10) ? ts[e] : t10; t20 = (e == e20) ? ts[e] : t20; t11 = (e == e11) ? ts[e] : t11; t21 = (e == e21) ? ts[e] : t21; }
            const v2u* ya0 = (const v2u*)(YB + ((size_t)t10 * 256 + r10) * D) + F.lane; const v2u* yb0 = (const v2u*)(YB + ((size_t)t20 * 256 + r20) * D) + F.lane;
            const v2u* ya1 = (const v2u*)(YB + ((size_t)t11 * 256 + r11) * D) + F.lane; const v2u* yb1 = (const v2u*)(YB + ((size_t)t21 * 256 + r21) * D) + F.lane;
            const f32x4* x0 = (const f32x4*)(X + (size_t)m0 * D) + F.lane; const f32x4* x1 = (const f32x4*)(X + (size_t)m1 * D) + F.lane;
            f32x4 v0[8], v1[8]; v2u a0[8], c0[8], a1[8], c1[8];
#pragma unroll
            for (int j = 0; j < 8; ++j) { v0[j] = x0[64 * j]; v1[j] = x1[64 * j]; a0[j] = ya0[64 * j]; c0[j] = yb0[64 * j]; a1[j] = ya1[64 * j]; c1[j] = yb1[64 * j]; }
            float q0 = 0.f, q1 = 0.f;
#pragma unroll
            for (int j = 0; j < 8; ++j) { const f32x4 gg = ((const f32x4*)gf)[F.lane + 64 * j]; f32x4 y;
                y.x = g10 * bflo(a0[j].x) + g20 * bflo(c0[j].x); y.y = g10 * bfhi(a0[j].x) + g20 * bfhi(c0[j].x); y.z = g10 * bflo(a0[j].y) + g20 * bflo(c0[j].y); y.w = g10 * bfhi(a0[j].y) + g20 * bfhi(c0[j].y);
                v0[j] = v0[j] + gg * y; q0 += (v0[j].x * v0[j].x + v0[j].y * v0[j].y) + (v0[j].z * v0[j].z + v0[j].w * v0[j].w);
                y.x = g11 * bflo(a1[j].x) + g21 * bflo(c1[j].x); y.y = g11 * bfhi(a1[j].x) + g21 * bfhi(c1[j].x); y.z = g11 * bflo(a1[j].y) + g21 * bflo(c1[j].y); y.w = g11 * bfhi(a1[j].y) + g21 * bfhi(c1[j].y);
                v1[j] = v1[j] + gg * y; q1 += (v1[j].x * v1[j].x + v1[j].y * v1[j].y) + (v1[j].z * v1[j].z + v1[j].w * v1[j].w); }
            const float ri0 = 1.0f / sqrtf(wave_sum(q0) * (1.f / D) + RMS_EPS), ri1 = 1.0f / sqrtf(wave_sum(q1) * (1.f / D) + RMS_EPS);
            f32x4* o0 = (f32x4*)(args.out + (size_t)m0 * D) + F.lane; f32x4* o1 = (f32x4*)(args.out + (size_t)m1 * D) + F.lane;
#pragma unroll
            for (int j = 0; j < 8; ++j) { const f32x4 fg = ((const f32x4*)final_g)[F.lane + 64 * j]; o0[64 * j] = (v0[j] * ri0) * fg; o1[64 * j] = (v1[j] * ri1) * fg; }
        }
    }
#undef IN
#undef SEAM
}

constexpr int N_PHASES = 20;
extern "C" void kernel_launch(void* const* d_in, const int* in_sizes, int n_in, void* d_out, int out_size, void* d_ws, size_t ws_size, hipStream_t stream) {
    static int grid = 0;
    if (grid == 0) {
        if (n_in != 30 || in_sizes[0] != M * D || out_size != M * D || ws_size < WS_END) { fprintf(stderr, "kernel_launch: shape/workspace mismatch: n_in %d in0 %d out %d ws %zu (need %zu)\n", n_in, n_in > 0 ? in_sizes[0] : -1, out_size, ws_size, (size_t)WS_END); grid = -1; return; }
        int dev = 0, cus = 0, per_cu = 0;
        if (hipGetDevice(&dev) != hipSuccess || hipDeviceGetAttribute(&cus, hipDeviceAttributeMultiprocessorCount, dev) != hipSuccess) { grid = -1; return; }
        if (hipFuncSetAttribute((const void*)fwd, hipFuncAttributeMaxDynamicSharedMemorySize, LDS_BYTES) != hipSuccess) { fprintf(stderr, "kernel_launch: hipFuncSetAttribute failed\n"); grid = -1; return; }
        if (hipOccupancyMaxActiveBlocksPerMultiprocessor(&per_cu, (const void*)fwd, NWAVES * 64, LDS_BYTES) != hipSuccess || per_cu < 1) fprintf(stderr, "kernel_launch: occupancy query reports %d\n", per_cu);
        (void)hipGetLastError();
        grid = cus;
        if (grid != 256) { fprintf(stderr, "kernel_launch: built for a 256-CU device (got %d)\n", cus); grid = -1; return; }
    }
    if (grid < 0) return;
    if (hipMemsetAsync((char*)d_ws + WS_CTL, 0, CTL_ZERO_BYTES, stream) != hipSuccess) return;
    Args a{};
    for (int i = 0; i < 30; ++i) a.in[i] = d_in[i];
    a.out = (float*)d_out; a.ws = (unsigned char*)d_ws;
    if (MK_N_LAUNCHES == 1) { a.ph_lo = 0; a.ph_hi = N_PHASES; hipLaunchKernelGGL(fwd, dim3(grid), dim3(NWAVES * 64), LDS_BYTES, stream, a); }
    else { for (int p = 0; p < N_PHASES; ++p) { a.ph_lo = p; a.ph_hi = p + 1; hipLaunchKernelGGL(fwd, dim3(grid), dim3(NWAVES * 64), LDS_BYTES, stream, a); } }
    const hipError_t le = hipPeekAtLastError();
    if (le != hipSuccess) fprintf(stderr, "kernel_launch: launch failed: %s\n", hipGetErrorName(le));
}
```

```cpp
#include <hip/hip_runtime.h>
#include <cstdio>
#include <cstdint>

#define WGM_G 8
#define PG_ALIGN true
#define PG_SP2 true
#ifndef MK_N_LAUNCHES
#define MK_N_LAUNCHES 1
#endif

namespace pg8 {
#define PG8_LAS __attribute__((address_space(3)))
typedef unsigned short bf16_t;
typedef short bf16x8 __attribute__((ext_vector_type(8)));
typedef float f32x4 __attribute__((ext_vector_type(4)));
typedef float f32x2 __attribute__((ext_vector_type(2)));
typedef unsigned u32x4 __attribute__((ext_vector_type(4)));
typedef unsigned u32x2 __attribute__((ext_vector_type(2)));
constexpr int BM = 256, BK = 64, HALF = 128, HTB = HALF * BK * 2  , STAGE_BYTES = 8 * HTB, NXCD = 8, WGM = 8;

__host__ __device__ __forceinline__ int lds_byte(int r, int c) { const int st = (r >> 4) * 2 + (c >> 5), rr = r & 15, cc = c & 31, ob = rr * 64 + cc * 2; return st * 1024 + (ob ^ (((ob >> 9) & 1) << 5)); }
__host__ __device__ __forceinline__ void stage_rc(int b, int& R, int& C) { const int st = b / 1024, sb = b % 1024, swz = sb ^ (((sb >> 9) & 1) << 5); R = (st >> 1) * 16 + swz / 64; C = (st & 1) * 32 + (swz % 64) / 2; }
__host__ __device__ __forceinline__ int perm32(int rho) { const int n = rho >> 4, i = rho & 15; return 8 * (i >> 2) + 4 * n + (i & 3); }

struct Unit { int pm, pn, pb; };
struct Gemm { const bf16_t* A; const bf16_t* Bt; int lda, ldb, K; };

struct StaticOrder {
    int nM, nN, nwg, G, c;
    __host__ __device__ void init(int M, int N, int G_, int c_) { nM = M / BM; nN = N / BM; nwg = nM * nN; G = G_; c = c_; }
    __host__ __device__ bool next(int i, Unit& u) const {
        const long L = (long)i * G + c; if (L >= nwg) return false;
        int wgid = (int)L; { const int q = nwg / NXCD, r = nwg % NXCD, xcd = wgid % NXCD, off = wgid / NXCD; wgid = (xcd < r ? xcd * (q + 1) : r * (q + 1) + (xcd - r) * q) + off; }
        const int nig = WGM * nN, gid = wgid / nig, fm = gid * WGM, gsz = (nM - fm) < WGM ? (nM - fm) : WGM;
        u.pm = fm + ((wgid % nig) % gsz); u.pn = (wgid % nig) / gsz; u.pb = u.pn; return true;
    }
    __device__ __forceinline__ void a_ready(const Unit&) const {}
    __device__ __forceinline__ void done(const Unit&) const {}
};
#ifndef WGM_G
#endif
struct GroupedOrder {
    int nN, G, c; int ts[9];
    __device__ __forceinline__ void init(const unsigned* tstart, int nN_, int G_, int c_) { nN = nN_; G = G_; c = c_;
#pragma unroll
        for (int e = 0; e < 9; ++e) ts[e] = (int)tstart[e]; }
    __device__ __forceinline__ bool next(int i, Unit& u) const {
        const long L = (long)i * G + c; if (L >= (long)ts[8] * nN) return false;
        int e = 0, us = 0, te = ts[1] - ts[0], t0 = ts[0];
#pragma unroll
        for (int k = 1; k < 8; ++k) { const int s = ts[k] * nN; if (L >= s) { e = k; us = s; te = ts[k + 1] - ts[k]; t0 = ts[k]; } }
        if (te <= 0) return false;
        int wgid = (int)L - us; { const int nwg = te * nN, q = nwg / NXCD, rr = nwg % NXCD, xcd = wgid % NXCD, off = wgid / NXCD; wgid = (xcd < rr ? xcd * (q + 1) : rr * (q + 1) + (xcd - rr) * q) + off; }
        const int nig = WGM_G * nN, gid = wgid / nig, fm = gid * WGM_G, gsz = (te - fm) < WGM_G ? (te - fm) : WGM_G;
        u.pm = t0 + fm + ((wgid % nig) % gsz); u.pn = (wgid % nig) / gsz; u.pb = e * nN + u.pn; return true;
    }
    __device__ __forceinline__ void a_ready(const Unit&) const {}
    __device__ __forceinline__ void done(const Unit&) const {}
};

typedef __bf16 bf16x2c __attribute__((ext_vector_type(2)));
__device__ __forceinline__ unsigned cvt_pk_bf16(float lo, float hi) { const f32x2 v = {lo, hi}; return __builtin_bit_cast(unsigned, __builtin_convertvector(v, bf16x2c)); }

struct EpiBf16 {
    static constexpr bool PERM = true, AFTER_DRAIN = false;
    bf16_t* O; int ldc; const float* rowscale;
    __device__ __forceinline__ void operator()(const f32x4 (&acc)[2][2][4][2], const Unit& u, int wr, int wc, int fr, int fq) const {
        const int row0 = u.pm * BM + wr * 64 + fr; const int col0 = u.pn * BM + wc * 32 + 8 * fq;
#pragma unroll
        for (int ai = 0; ai < 2; ++ai)
#pragma unroll
            for (int m = 0; m < 4; ++m) { const int row = row0 + ai * HALF + m * 16; bf16_t* rowp = O + (size_t)row * ldc + col0; const float sc = rowscale ? rowscale[row] : 1.f;
#pragma unroll
                for (int bj = 0; bj < 2; ++bj) { f32x4 v0 = acc[ai][bj][m][0] * sc, v1 = acc[ai][bj][m][1] * sc;
                    u32x4 w; w.x = cvt_pk_bf16(v0[0], v0[1]); w.y = cvt_pk_bf16(v0[2], v0[3]); w.z = cvt_pk_bf16(v1[0], v1[1]); w.w = cvt_pk_bf16(v1[2], v1[3]);
                    *(u32x4*)(rowp + bj * HALF) = w; } }
    }
};
struct EpiResid {
    static constexpr bool PERM = false, AFTER_DRAIN = false;
    const float* xin; float* xout; int ldc; const float* gate; int gstride; int tiles_per_b;
    __device__ __forceinline__ void operator()(const f32x4 (&acc)[2][2][4][2], const Unit& u, int wr, int wc, int fr, int fq) const {
        const int row0 = u.pm * BM + wr * 64 + fr, col0 = u.pn * BM + wc * 32 + 4 * fq;
        const float* gp = gate + (size_t)(u.pm / tiles_per_b) * gstride + col0;
        f32x4 gv[2][2];
#pragma unroll
        for (int bj = 0; bj < 2; ++bj)
#pragma unroll
            for (int n = 0; n < 2; ++n) gv[bj][n] = *(const f32x4*)(gp + bj * HALF + n * 16);
#pragma unroll
        for (int ai = 0; ai < 2; ++ai)
#pragma unroll
            for (int m = 0; m < 4; ++m) { const size_t off = (size_t)(row0 + ai * HALF + m * 16) * ldc + col0;
#pragma unroll
                for (int bj = 0; bj < 2; ++bj)
#pragma unroll
                    for (int n = 0; n < 2; ++n) { const f32x4 xi = *(const f32x4*)(xin + off + bj * HALF + n * 16);
                        *(f32x4*)(xout + off + bj * HALF + n * 16) = xi + gv[bj][n] * acc[ai][bj][m][n]; }
                asm volatile("" ::: "memory"); }
    }
};
__device__ __forceinline__ float silu_f(float g) { return g * __builtin_amdgcn_rcpf(1.0f + __builtin_amdgcn_exp2f(-1.4426950408889634f * g)); }
struct EpiSwiGLU {
    static constexpr bool PERM = false, AFTER_DRAIN = false;
    bf16_t* O; int ldo;
    __device__ __forceinline__ void operator()(const f32x4 (&acc)[2][2][4][2], const Unit& u, int wr, int wc, int fr, int fq) const {
        const int row0 = u.pm * BM + wr * 64 + fr, col0 = u.pn * HALF + wc * 16 + 4 * fq;
#pragma unroll
        for (int ai = 0; ai < 2; ++ai)
#pragma unroll
            for (int m = 0; m < 4; ++m) { bf16_t* rowp = O + (size_t)(row0 + ai * HALF + m * 16) * ldo + col0;
#pragma unroll
                for (int bj = 0; bj < 2; ++bj) { const f32x4 g = acc[ai][bj][m][0], up = acc[ai][bj][m][1];
                    u32x2 w; w.x = cvt_pk_bf16(silu_f(g[0]) * up[0], silu_f(g[1]) * up[1]); w.y = cvt_pk_bf16(silu_f(g[2]) * up[2], silu_f(g[3]) * up[3]);
                    *(u32x2*)(rowp + bj * 64) = w; } }
    }
};
struct EpiSwiGLU8 {
    static constexpr bool PERM = false, AFTER_DRAIN = false;
    unsigned char* O8; int ldo; float s, so;
    __device__ __forceinline__ void operator()(const f32x4 (&acc)[2][2][4][2], const Unit& u, int wr, int wc, int fr, int fq) const {
        const int row0 = u.pm * BM + wr * 64 + fr, col0 = u.pn * HALF + wc * 16 + 4 * fq;
#pragma unroll
        for (int ai = 0; ai < 2; ++ai)
#pragma unroll
            for (int m = 0; m < 4; ++m) { const size_t off = (size_t)(row0 + ai * HALF + m * 16) * ldo + col0;
#pragma unroll
                for (int bj = 0; bj < 2; ++bj) { const f32x4 g = acc[ai][bj][m][0] * s, up = acc[ai][bj][m][1] * s;
                    const float v0 = silu_f(g[0]) * up[0], v1 = silu_f(g[1]) * up[1], v2 = silu_f(g[2]) * up[2], v3 = silu_f(g[3]) * up[3];
                    int w = 0; w = __builtin_amdgcn_cvt_pk_fp8_f32(__builtin_amdgcn_fmed3f(v0 * so, -440.f, 440.f), __builtin_amdgcn_fmed3f(v1 * so, -440.f, 440.f), w, false);
                    w = __builtin_amdgcn_cvt_pk_fp8_f32(__builtin_amdgcn_fmed3f(v2 * so, -440.f, 440.f), __builtin_amdgcn_fmed3f(v3 * so, -440.f, 440.f), w, true); *(int*)(O8 + off + bj * 64) = w; } }
    }
};
struct EpiBf16S {
    static constexpr bool PERM = true, AFTER_DRAIN = false;
    bf16_t* O; int ldc; float s;
    __device__ __forceinline__ void operator()(const f32x4 (&acc)[2][2][4][2], const Unit& u, int wr, int wc, int fr, int fq) const {
        const int row0 = u.pm * BM + wr * 64 + fr; const int col0 = u.pn * BM + wc * 32 + 8 * fq;
#pragma unroll
        for (int ai = 0; ai < 2; ++ai)
#pragma unroll
            for (int m = 0; m < 4; ++m) { bf16_t* rowp = O + (size_t)(row0 + ai * HALF + m * 16) * ldc + col0;
#pragma unroll
                for (int bj = 0; bj < 2; ++bj) { const f32x4 v0 = acc[ai][bj][m][0] * s, v1 = acc[ai][bj][m][1] * s;
                    u32x4 w; w.x = cvt_pk_bf16(v0[0], v0[1]); w.y = cvt_pk_bf16(v0[2], v0[3]); w.z = cvt_pk_bf16(v1[0], v1[1]); w.w = cvt_pk_bf16(v1[2], v1[3]);
                    *(u32x4*)(rowp + bj * HALF) = w; } }
    }
};

template <class Epi, class Sched, bool ALIGN_EPI = false, bool SP2 = false, bool F8 = false, bool FW = false>
__device__ __forceinline__ void gemm_phase(PG8_LAS unsigned char* lds, const Gemm g, const Sched& S, const Epi& E) {
    const int tid = threadIdx.x, wid = __builtin_amdgcn_readfirstlane(tid >> 6), lane = tid & 63, wr = wid >> 2, wc = wid & 3, fr = lane & 15, fq = lane >> 4;
    const int K = g.K, nt = K / BK;
    unsigned voffA[2], voffB[2];
#pragma unroll
    for (int i = 0; i < 2; ++i) { int R, C; stage_rc(tid * 16 + i * 8192, R, C); const int Rb = Epi::PERM ? ((R & ~31) + perm32(R & 31)) : R;
        voffA[i] = (unsigned)(R * g.lda + C) * 2u; voffB[i] = (unsigned)(Rb * g.ldb + C) * 2u; }
    const size_t kstep = (size_t)(BK * 2);
    const size_t hstepA = (size_t)HALF * g.lda * 2, hstepB = (size_t)HALF * g.ldb * 2;
    const size_t tstepA = 2 * hstepA, tstepB = (F8 && !FW) ? hstepB : 2 * hstepB;
    const unsigned ldsw = (unsigned)wid * 1024u;
    const int aoff = lds_byte(wr * 64 + fr, fq * 8), boff = lds_byte(wc * 32 + fr, fq * 8);
#define PG8_SA(b, h) (((b) * 2 + (h)) * HTB)
#define PG8_SB(b, h) ((4 + (b) * 2 + (h)) * HTB)
#define PG8_STAGE(bufoff, gbase, voff) do { _Pragma("unroll") for (int _i = 0; _i < 2; ++_i) \
        __builtin_amdgcn_global_load_lds((const unsigned*)((const char*)(gbase) + (voff)[_i]), (PG8_LAS unsigned*)(lds + (bufoff) + ldsw + _i * 8192), 16, 0, 0); } while (0)
#define PG8_LDA(dst, b, h) do { _Pragma("unroll") for (int m = 0; m < 4; ++m) _Pragma("unroll") for (int k = 0; k < 2; ++k) dst[m][k] = *(const PG8_LAS bf16x8*)(lds + PG8_SA(b, h) + aoff + m * 2048 + k * 1024); } while (0)
#define PG8_LDB(dst, b, h) do { if constexpr (!F8 || FW || (h) == 0) { _Pragma("unroll") for (int n = 0; n < 2; ++n) _Pragma("unroll") for (int k = 0; k < 2; ++k) dst[n][k] = *(const PG8_LAS bf16x8*)(lds + PG8_SB(b, h) + boff + n * 2048 + k * 1024); } } while (0)
#define PG8_CAT(x, y) __builtin_shufflevector(x, y, 0, 1, 2, 3, 4, 5, 6, 7, 8, 9, 10, 11, 12, 13, 14, 15)
#define PG8_MMA(ai, bj, At, Bt) do { if constexpr (!F8 || FW || (bj) == 0) { __builtin_amdgcn_s_setprio(1); \
        if constexpr (F8) { _Pragma("unroll") for (int m = 0; m < 4; ++m) _Pragma("unroll") for (int n = 0; n < 2; ++n) \
            { const v8i_ b8_ = __builtin_bit_cast(v8i_, PG8_CAT(Bt[n][0], Bt[n][1])), a8_ = __builtin_bit_cast(v8i_, PG8_CAT(At[m][0], At[m][1])); \
            if constexpr (FW) asm volatile("v_mfma_scale_f32_16x16x128_f8f6f4 %0, %1, %2, %0, %3, %3 op_sel_hi:[0,0,0]" : "+v"(acc[ai][bj][m][n]) : "v"(b8_), "v"(a8_), "v"(0x7f7f7f7f)); \
            else acc[ai][bj][m][n] = __builtin_amdgcn_mfma_scale_f32_16x16x128_f8f6f4(b8_, a8_, acc[ai][bj][m][n], 0, 0, 0, 0x7f7f7f7f, 0, 0x7f7f7f7f); } } \
        else { _Pragma("unroll") for (int m = 0; m < 4; ++m) _Pragma("unroll") for (int n = 0; n < 2; ++n) _Pragma("unroll") for (int k = 0; k < 2; ++k) \
            acc[ai][bj][m][n] = __builtin_amdgcn_mfma_f32_16x16x32_bf16(Bt[n][k], At[m][k], acc[ai][bj][m][n], 0, 0, 0); } \
        __builtin_amdgcn_s_setprio(0); } } while (0)
#define PG8_WAIT_V(n) asm volatile("s_waitcnt vmcnt(" #n ")" ::: "memory")
#define PG8_WAIT_L(n) asm volatile("s_waitcnt lgkmcnt(" #n ")" ::: "memory")
#define PG8_BAR __builtin_amdgcn_s_barrier()
#define PG8_SCHED __builtin_amdgcn_sched_barrier(0)
    Unit cur, nxt; int ui = 0;
    if (!S.next(0, cur)) return;
    f32x4 acc[2][2][4][2];
#pragma unroll
    for (int a = 0; a < 2; ++a)
#pragma unroll
        for (int b = 0; b < 2; ++b)
#pragma unroll
            for (int m = 0; m < 4; ++m)
#pragma unroll
                for (int n = 0; n < 2; ++n) acc[a][b][m][n] = (f32x4){0.f, 0.f, 0.f, 0.f};
    bf16x8 At[4][2], B0[2][2], B1[2][2];
    typedef int v8i_ __attribute__((ext_vector_type(8))); typedef short bf16x16_ __attribute__((ext_vector_type(16)));
    const char* cA = (const char*)g.A + (size_t)cur.pm * tstepA; const char* cB = (const char*)g.Bt + (size_t)cur.pb * tstepB;
    S.a_ready(cur);
    if constexpr (SP2) {
        PG8_STAGE(PG8_SB(0, 0), cB, voffB); if constexpr (!F8 || FW) PG8_STAGE(PG8_SB(0, 1), cB + hstepB, voffB); PG8_STAGE(PG8_SA(0, 0), cA, voffA); PG8_STAGE(PG8_SA(0, 1), cA + hstepA, voffA);
        if (wr == 1) PG8_BAR;
        PG8_WAIT_V(2); PG8_BAR;
        PG8_STAGE(PG8_SB(1, 0), cB + kstep, voffB); PG8_STAGE(PG8_SA(1, 0), cA + kstep, voffA); if constexpr (!F8 || FW) PG8_STAGE(PG8_SB(1, 1), cB + hstepB + kstep, voffB);
        if constexpr (F8 && !FW) PG8_WAIT_V(4); else PG8_WAIT_V(6); PG8_BAR;
    } else {
        PG8_STAGE(PG8_SB(0, 0), cB, voffB); PG8_STAGE(PG8_SA(0, 0), cA, voffA); PG8_STAGE(PG8_SB(0, 1), cB + hstepB, voffB); PG8_STAGE(PG8_SA(0, 1), cA + hstepA, voffA);
        if (wr == 1) PG8_BAR;
        PG8_WAIT_V(4); PG8_BAR;
        PG8_STAGE(PG8_SB(1, 0), cB + kstep, voffB); PG8_STAGE(PG8_SA(1, 0), cA + kstep, voffA); PG8_STAGE(PG8_SB(1, 1), cB + hstepB + kstep, voffB);
        PG8_WAIT_V(6); PG8_BAR;
    }
    for (;;) {
        const bool has_next = S.next(ui + 1, nxt);
        const char* nA = has_next ? (const char*)g.A + (size_t)nxt.pm * tstepA : cA; const char* nB = has_next ? (const char*)g.Bt + (size_t)nxt.pb * tstepB : cB;
        for (int t = 0; t < nt; t += 2) {
            const bool last = (t == nt - 2);
            const char* a1 = cA + (size_t)(t + 1) * kstep;
            const char* a2 = last ? nA : cA + (size_t)(t + 2) * kstep; const char* b2 = last ? nB : cB + (size_t)(t + 2) * kstep;
            const char* a3 = a2 + kstep; const char* b3 = b2 + kstep;
            if (last && has_next) S.a_ready(nxt);
            if constexpr (SP2) {
            PG8_LDB(B0, 0, 0); PG8_LDB(B1, 0, 1); PG8_SCHED; PG8_LDA(At, 0, 0); PG8_STAGE(PG8_SA(1, 1), a1 + hstepA, voffA);
            if constexpr (F8 && !FW) PG8_WAIT_V(6); else PG8_WAIT_V(8); PG8_WAIT_L(0); PG8_BAR; PG8_MMA(0, 0, At, B0); PG8_MMA(0, 1, At, B1); PG8_BAR; PG8_SCHED;
            PG8_LDA(At, 0, 1); PG8_STAGE(PG8_SB(0, 0), b2, voffB); if constexpr (!F8 || FW) PG8_STAGE(PG8_SB(0, 1), b2 + hstepB, voffB); PG8_STAGE(PG8_SA(0, 0), a2, voffA);
            if constexpr (F8 && !FW) PG8_WAIT_V(6); else PG8_WAIT_V(8); PG8_WAIT_L(0); PG8_BAR; PG8_MMA(1, 0, At, B0); PG8_MMA(1, 1, At, B1); PG8_BAR; PG8_SCHED;
            PG8_LDB(B0, 1, 0); PG8_LDB(B1, 1, 1); PG8_SCHED; PG8_LDA(At, 1, 0); PG8_STAGE(PG8_SA(0, 1), a2 + hstepA, voffA);
            if constexpr (F8 && !FW) PG8_WAIT_V(6); else PG8_WAIT_V(8); PG8_WAIT_L(0); PG8_BAR; PG8_MMA(0, 0, At, B0); PG8_MMA(0, 1, At, B1); PG8_BAR; PG8_SCHED;
            PG8_LDA(At, 1, 1); PG8_STAGE(PG8_SB(1, 0), b3, voffB); if constexpr (!F8 || FW) PG8_STAGE(PG8_SB(1, 1), b3 + hstepB, voffB); PG8_STAGE(PG8_SA(1, 0), a3, voffA);
            if constexpr (F8 && !FW) PG8_WAIT_V(6); else PG8_WAIT_V(8); PG8_WAIT_L(0); PG8_BAR; PG8_MMA(1, 0, At, B0); PG8_MMA(1, 1, At, B1); PG8_BAR; PG8_SCHED;
            } else {
            PG8_LDB(B0, 0, 0); PG8_SCHED; PG8_LDA(At, 0, 0); PG8_STAGE(PG8_SA(1, 1), a1 + hstepA, voffA);
            PG8_WAIT_L(8); PG8_BAR; PG8_WAIT_L(0); PG8_MMA(0, 0, At, B0); PG8_BAR; PG8_SCHED;
            PG8_LDB(B1, 0, 1); PG8_STAGE(PG8_SB(0, 0), b2, voffB);
            PG8_BAR; PG8_WAIT_L(0); PG8_MMA(0, 1, At, B1); PG8_BAR;
            PG8_LDA(At, 0, 1); PG8_STAGE(PG8_SA(0, 0), a2, voffA);
            PG8_BAR; PG8_WAIT_L(0); PG8_MMA(1, 0, At, B0); PG8_BAR; PG8_SCHED;
            PG8_STAGE(PG8_SB(0, 1), b2 + hstepB, voffB);
            PG8_WAIT_V(6); PG8_BAR; PG8_MMA(1, 1, At, B1); PG8_BAR;
            PG8_LDB(B0, 1, 0); PG8_SCHED; PG8_LDA(At, 1, 0); PG8_STAGE(PG8_SA(0, 1), a2 + hstepA, voffA);
            PG8_WAIT_L(8); PG8_BAR; PG8_WAIT_L(0); PG8_MMA(0, 0, At, B0); PG8_BAR; PG8_SCHED;
            PG8_LDB(B1, 1, 1); PG8_STAGE(PG8_SB(1, 0), b3, voffB);
            PG8_BAR; PG8_WAIT_L(0); PG8_MMA(0, 1, At, B1); PG8_BAR;
            PG8_LDA(At, 1, 1); PG8_STAGE(PG8_SA(1, 0), a3, voffA);
            PG8_BAR; PG8_WAIT_L(0); PG8_MMA(1, 0, At, B0); PG8_BAR; PG8_SCHED;
            PG8_STAGE(PG8_SB(1, 1), b3 + hstepB, voffB);
            PG8_WAIT_V(6); PG8_BAR; PG8_MMA(1, 1, At, B1); PG8_BAR;
            }
        }
        if constexpr (ALIGN_EPI) { if (wr == 0) PG8_BAR; }
        if constexpr (F8 && FW) asm volatile("s_nop 15\n\ts_nop 15" ::: "memory");
        if constexpr (!Epi::AFTER_DRAIN) { E(acc, cur, wr, wc, fr, fq); S.done(cur); }
        if (!has_next) break;
#pragma unroll
        for (int a = 0; a < 2; ++a)
#pragma unroll
            for (int b = 0; b < 2; ++b)
#pragma unroll
                for (int m = 0; m < 4; ++m)
#pragma unroll
                    for (int n = 0; n < 2; ++n) acc[a][b][m][n] = (f32x4){0.f, 0.f, 0.f, 0.f};
        cur = nxt; cA = nA; cB = nB; ++ui;
        if constexpr (ALIGN_EPI) { if (wr == 1) PG8_BAR; }
    }
    PG8_WAIT_V(0);
    if constexpr (!ALIGN_EPI) { if (wr == 0) PG8_BAR; }
    PG8_BAR;
    if constexpr (Epi::AFTER_DRAIN) { E.fused(acc, cur, wr, wc, fr, fq, lds, wid, lane); S.done(cur); }
#undef PG8_SA
#undef PG8_SB
#undef PG8_STAGE
#undef PG8_CAT
#undef PG8_LDA
#undef PG8_LDB
#undef PG8_MMA
#undef PG8_WAIT_V
#undef PG8_WAIT_L
#undef PG8_BAR
#undef PG8_SCHED
}

}

namespace fa {
#define FA_LAS __attribute__((address_space(3)))
typedef unsigned short bf16;
typedef short bf16x8 __attribute__((ext_vector_type(8)));
typedef short s16x4 __attribute__((ext_vector_type(4)));
typedef float f32x16 __attribute__((ext_vector_type(16)));
typedef float f32x4 __attribute__((ext_vector_type(4)));
typedef unsigned u32x4 __attribute__((ext_vector_type(4)));
constexpr int QB = 256, QBLK = 32, KVBLK = 64;
constexpr int SHM_K = 16384, SHM_V = 16384, SHM_K2 = 8192;
constexpr int OFF_V = 0, OFF_K = 2 * SHM_V, OFF_K2 = OFF_K + 2 * SHM_K, OFF_WS = OFF_K2 + 2 * SHM_K2, WS_PER_WAVE = 1024, OFF_TAB = OFF_WS + 8 * WS_PER_WAVE;
constexpr int TAB_PAD = 320, TAB_MAX = 4096 + TAB_PAD;
constexpr int LDS_END = OFF_TAB + TAB_MAX * 4;
constexpr int OSTG = 272;
static_assert(LDS_END <= 131072 && 8 * 32 * OSTG <= OFF_WS, "attention LDS map");
#define KSWZ(row, colB) ((row) * 256 + ((colB) ^ (((row) & 7) << 4)))
#define K2SWZ(row, colB) ((row) * 128 + ((colB) ^ (((row) & 7) << 4)))
#define SBAR() __builtin_amdgcn_sched_barrier(0)
__device__ __forceinline__ int v_st(int k, int c) { const int kk = (k & ~0xC) | ((k & 4) << 1) | ((k & 8) >> 1); return ((kk >> 3) * 4 + (c >> 5)) * 512 + ((kk & 7) * 32 + (c & 31)) * 2; }
__device__ __forceinline__ int v_rd_base(int lane) { return ((lane & 3) << 3) | (((lane >> 2) & 3) << 6) | (((lane >> 4) & 1) << 5) | (((lane >> 5) & 1) << 8); }
constexpr int v_rd_off(int d0, int ks, int half) { return d0 * 512 + ks * 4096 + half * 2048; }
__device__ __forceinline__ int crow(int r, int hi) { return (r & 3) + 8 * (r >> 2) + 4 * hi; }
typedef float f32x2c __attribute__((ext_vector_type(2)));
typedef __bf16 bf16x2c __attribute__((ext_vector_type(2)));
__device__ __forceinline__ unsigned cvtpk(float lo, float hi) { const f32x2c v = {lo, hi}; return __builtin_bit_cast(unsigned, __builtin_convertvector(v, bf16x2c)); }

struct Item {
    const bf16* Q; long qs;
    const float* rope; long ropes;
    const bf16* K; long ks; const bf16* K2; long k2s; const bf16* V; long vs;
    int P0, skv, W;
    const float* bias; int bstep;
    const unsigned long long* sel; long sels;
    bf16* O; long os;
    float* LSE; long lses;
    const bf16* M0; const bf16* M1; long ms; const bf16* G; long gs;
};

template <int VAR>
__device__ __forceinline__ void attn_block(const Item& it, unsigned char* lds_g) {
    constexpr bool HAS_BIAS = VAR != 2, HAS_SEL = VAR == 1, HAS_K2 = VAR == 2;
    constexpr float SCALE = HAS_K2 ? 0.07216878364870322f : 0.08838834764831845f, C2 = 1.4426950408889634f * SCALE, THR = 8.f;
    FA_LAS unsigned char* L = (FA_LAS unsigned char*)lds_g;
    const int tid = threadIdx.x, wid = __builtin_amdgcn_readfirstlane(tid >> 6), lane = tid & 63, r32 = lane & 31, hi = lane >> 5;
    const int W = it.W;
    const int j_lo = (it.P0 - W + 1 > 0) ? (it.P0 - W + 1) / KVBLK : 0;
    int j_hi = (it.P0 + QB - 1) / KVBLK + 1; if (j_hi > it.skv / KVBLK) j_hi = it.skv / KVBLK;
    const int NT = j_hi - j_lo;
    const int qlo = it.P0 + wid * QBLK, qm = qlo + r32 - 4 * hi;
    FA_LAS float* wsl = (FA_LAS float*)(L + OFF_WS + wid * WS_PER_WAVE); FA_LAS float* li_l = wsl; FA_LAS float* al_l = wsl + 32;
    FA_LAS float* tab = (FA_LAS float*)(L + OFF_TAB);
    const int sr = tid >> 4, sc = (tid & 15) * 8, vst0 = v_st(sr, sc), vst1 = v_st(32 + sr, sc), kws = KSWZ(sr, sc * 2);
    const int k2r = tid >> 3, k2c = (tid & 7) * 8, k2ws = K2SWZ(k2r, k2c * 2);
    const int vb0 = OFF_V + v_rd_base(lane);
    bf16x8 qr[8]; bf16x8 qr2[4];
    { const bf16* qp = it.Q + (long)(qlo + r32) * it.qs + hi * 8;
#pragma unroll
      for (int d0 = 0; d0 < 8; ++d0) qr[d0] = *(const bf16x8*)(qp + d0 * 16);
      if constexpr (HAS_K2) {
          const float* rp = it.rope + (long)(qlo + r32) * it.ropes + hi * 8;
          bf16x8 raw[4];
#pragma unroll
          for (int d0 = 0; d0 < 4; ++d0) raw[d0] = *(const bf16x8*)(qp + 128 + d0 * 16);
#pragma unroll
          for (int d0 = 0; d0 < 2; ++d0) { const f32x4 c0 = *(const f32x4*)(rp + d0 * 16), c1 = *(const f32x4*)(rp + d0 * 16 + 4), s0 = *(const f32x4*)(rp + 32 + d0 * 16), s1 = *(const f32x4*)(rp + 32 + d0 * 16 + 4);
              float o1[8], o2[8];
#pragma unroll
              for (int j = 0; j < 8; ++j) { const float x1 = __builtin_bit_cast(float, (unsigned)(unsigned short)raw[d0][j] << 16), x2 = __builtin_bit_cast(float, (unsigned)(unsigned short)raw[d0 + 2][j] << 16);
                  const float cs = j < 4 ? c0[j & 3] : c1[j & 3], sn = j < 4 ? s0[j & 3] : s1[j & 3]; o1[j] = x1 * cs - x2 * sn; o2[j] = x2 * cs + x1 * sn; }
              u32x4 w1 = {cvtpk(o1[0], o1[1]), cvtpk(o1[2], o1[3]), cvtpk(o1[4], o1[5]), cvtpk(o1[6], o1[7])}, w2 = {cvtpk(o2[0], o2[1]), cvtpk(o2[2], o2[3]), cvtpk(o2[4], o2[5]), cvtpk(o2[6], o2[7])};
              qr2[d0] = __builtin_bit_cast(bf16x8, w1); qr2[d0 + 2] = __builtin_bit_cast(bf16x8, w2); }
      }
    }
    unsigned long long selm = ~0ull;
    if constexpr (HAS_SEL) selm = __hip_atomic_load(it.sel + (long)(qlo + r32) * it.sels, __ATOMIC_RELAXED, __HIP_MEMORY_SCOPE_AGENT);
    if constexpr (HAS_BIAS) {
        int rmax = W + 320; if (rmax > 4096) rmax = 4096;
        for (int i = tid; i < rmax + TAB_PAD; i += 512) { int r = i - TAB_PAD; r = r < -64 ? -64 : r; long gi = (long)r * it.bstep; gi = gi > 4095 ? 4095 : gi; tab[i] = it.bias[gi] * (1.0f / SCALE); }
    }
    bf16x8 st_k0, st_k1, st_v0, st_v1, st_k2;
#define FA_LOAD(kb_) do { const long r0_ = (long)((kb_) + sr), r1_ = r0_ + 32; \
        st_v0 = *(const bf16x8*)(it.V + r0_ * it.vs + sc); st_v1 = *(const bf16x8*)(it.V + r1_ * it.vs + sc); \
        st_k0 = *(const bf16x8*)(it.K + r0_ * it.ks + sc); st_k1 = *(const bf16x8*)(it.K + r1_ * it.ks + sc); \
        if constexpr (HAS_K2) st_k2 = *(const bf16x8*)(it.K2 + (long)((kb_) + k2r) * it.k2s + k2c); } while (0)
#define FA_WRITE(bf_) do { *(FA_LAS bf16x8*)(L + OFF_V + (bf_) * SHM_V + vst0) = st_v0; *(FA_LAS bf16x8*)(L + OFF_V + (bf_) * SHM_V + vst1) = st_v1; \
        *(FA_LAS bf16x8*)(L + OFF_K + (bf_) * SHM_K + kws) = st_k0; *(FA_LAS bf16x8*)(L + OFF_K + (bf_) * SHM_K + kws + 32 * 256) = st_k1; \
        if constexpr (HAS_K2) *(FA_LAS bf16x8*)(L + OFF_K2 + (bf_) * SHM_K2 + k2ws) = st_k2; } while (0)
    FA_LOAD(j_lo * KVBLK);
    asm volatile("s_waitcnt vmcnt(0)" ::: "memory");
    FA_WRITE(0);
    __syncthreads();
    float m_reg = -1e30f, l_reg = 0.f; f32x16 o[4] = {};
#define FA_KBASE(t) ((j_lo + (t)) * KVBLK)
#define FA_STEP(BUF, t) do { \
        const int kb_ = FA_KBASE(t); \
        if ((t) + 1 < NT) FA_LOAD(FA_KBASE((t) + 1)); \
        bool act_ = (kb_ <= qlo + QBLK - 1) && (kb_ + KVBLK - 1 >= qlo - W + 1); \
        bool allow_ = true; \
        if constexpr (HAS_SEL) { allow_ = (bool)((selm >> (kb_ >> 6)) & 1ull); } \
        if (act_) { \
            f32x16 p0 = {}, p1 = {}; \
            { const int ka_ = OFF_K + (BUF) * SHM_K; \
              _Pragma("unroll") for (int d0 = 0; d0 < 8; ++d0) { \
                const bf16x8 b0 = *(const FA_LAS bf16x8*)(L + ka_ + KSWZ(r32, (d0 * 16 + hi * 8) * 2)); \
                const bf16x8 b1 = *(const FA_LAS bf16x8*)(L + ka_ + 32 * 256 + KSWZ(r32, (d0 * 16 + hi * 8) * 2)); \
                p0 = __builtin_amdgcn_mfma_f32_32x32x16_bf16(b0, qr[d0], p0, 0, 0, 0); p1 = __builtin_amdgcn_mfma_f32_32x32x16_bf16(b1, qr[d0], p1, 0, 0, 0); } \
              if constexpr (HAS_K2) { const int k2a_ = OFF_K2 + (BUF) * SHM_K2; \
                _Pragma("unroll") for (int d0 = 0; d0 < 4; ++d0) { \
                  const bf16x8 b0 = *(const FA_LAS bf16x8*)(L + k2a_ + K2SWZ(r32, (d0 * 16 + hi * 8) * 2)); \
                  const bf16x8 b1 = *(const FA_LAS bf16x8*)(L + k2a_ + 32 * 128 + K2SWZ(r32, (d0 * 16 + hi * 8) * 2)); \
                  p0 = __builtin_amdgcn_mfma_f32_32x32x16_bf16(b0, qr2[d0], p0, 0, 0, 0); p1 = __builtin_amdgcn_mfma_f32_32x32x16_bf16(b1, qr2[d0], p1, 0, 0, 0); } } } \
            const int dq_ = qm - kb_; \
            if constexpr (HAS_BIAS) { const FA_LAS float* tb_ = tab + (TAB_PAD + dq_ - 63); \
                _Pragma("unroll") for (int r = 0; r < 16; ++r) { const int c_ = (r & 3) + 8 * (r >> 2); p0[r] += tb_[63 - c_]; p1[r] += tb_[31 - c_]; } } \
            if (HAS_SEL || kb_ + KVBLK - 1 > qlo || kb_ <= qlo + QBLK - 1 - W) { const float NEG_ = -__builtin_inff(); const int dqm_ = allow_ ? dq_ : -0x40000000; \
                _Pragma("unroll") for (int r = 0; r < 16; ++r) { const int c_ = (r & 3) + 8 * (r >> 2); \
                    if ((unsigned)(dqm_ - c_) >= (unsigned)W) p0[r] = NEG_; if ((unsigned)(dqm_ - c_ - 32) >= (unsigned)W) p1[r] = NEG_; } } \
              \
            float pmax_ = p0[0]; _Pragma("unroll") for (int r = 1; r < 16; ++r) pmax_ = fmaxf(pmax_, p0[r]); _Pragma("unroll") for (int r = 0; r < 16; ++r) pmax_ = fmaxf(pmax_, p1[r]); \
            { auto rr_ = __builtin_amdgcn_permlane32_swap(__float_as_uint(pmax_), __float_as_uint(pmax_), false, false); pmax_ = fmaxf(__uint_as_float(rr_[0]), __uint_as_float(rr_[1])); } \
            float mn_, alpha_; \
            if (__all((pmax_ - m_reg) * SCALE <= THR)) { mn_ = m_reg; alpha_ = 1.f; } \
            else { mn_ = fmaxf(m_reg, pmax_); alpha_ = __builtin_amdgcn_exp2f((m_reg - mn_) * C2); m_reg = mn_; } \
            const float mnL_ = -mn_ * C2; float ps_ = 0.f; \
            _Pragma("unroll") for (int r = 0; r < 16; ++r) { p0[r] = __builtin_amdgcn_exp2f(fmaf(p0[r], C2, mnL_)); p1[r] = __builtin_amdgcn_exp2f(fmaf(p1[r], C2, mnL_)); ps_ += p0[r] + p1[r]; } \
            { auto rr_ = __builtin_amdgcn_permlane32_swap(__float_as_uint(ps_), __float_as_uint(ps_), false, false); ps_ = __uint_as_float(rr_[0]) + __uint_as_float(rr_[1]); } \
            l_reg = l_reg * alpha_ + ps_; \
            bf16x8 pa0, pa1, pa2, pa3; \
            FA_PK4(p0, 0, pa0); FA_PK4(p0, 8, pa1); FA_PK4(p1, 0, pa2); FA_PK4(p1, 8, pa3); \
            if (__any(alpha_ < 1.f)) { if (hi == 0) al_l[r32] = alpha_; asm volatile("s_waitcnt lgkmcnt(0)" ::: "memory"); \
                _Pragma("unroll") for (int d_ = 0; d_ < 4; ++d_) _Pragma("unroll") for (int r = 0; r < 16; ++r) o[d_][r] *= al_l[crow(r, hi)]; } \
            FA_PV_D0(BUF, 0); FA_PV_D0(BUF, 1); FA_PV_D0(BUF, 2); FA_PV_D0(BUF, 3); \
        } \
        if ((t) + 1 < NT) { asm volatile("s_waitcnt vmcnt(0)" ::: "memory"); FA_WRITE(1 - (BUF)); } \
        __syncthreads(); } while (0)
#define FA_PK4(P, B_, OUT) do { unsigned a0 = cvtpk(P[B_+0], P[B_+1]), a1 = cvtpk(P[B_+2], P[B_+3]); unsigned b0 = cvtpk(P[B_+4], P[B_+5]), b1 = cvtpk(P[B_+6], P[B_+7]); \
        auto r0 = __builtin_amdgcn_permlane32_swap(a0, b0, false, false); auto r1 = __builtin_amdgcn_permlane32_swap(a1, b1, false, false); \
        u32x4 w = {r0[0], r1[0], r0[1], r1[1]}; OUT = __builtin_bit_cast(bf16x8, w); } while (0)
#define FA_TRRD(dst, off) asm volatile("ds_read_b64_tr_b16 %0, %1 offset:%2" : "=&v"(dst) : "v"(vb0), "i"(off) : "memory")
#define FA_PV_D0(VB, d0) do { s16x4 l0, l1, l2, l3, h0, h1, h2, h3; constexpr int b_ = (VB) * SHM_V + v_rd_off(d0, 0, 0); \
        FA_TRRD(l0, b_); FA_TRRD(h0, b_ + 2048); FA_TRRD(l1, b_ + 4096); FA_TRRD(h1, b_ + 6144); FA_TRRD(l2, b_ + 8192); FA_TRRD(h2, b_ + 10240); FA_TRRD(l3, b_ + 12288); FA_TRRD(h3, b_ + 14336); \
        asm volatile("s_waitcnt lgkmcnt(0)" ::: "memory"); SBAR(); \
        o[d0] = __builtin_amdgcn_mfma_f32_32x32x16_bf16(pa0, (bf16x8){l0[0], l0[1], l0[2], l0[3], h0[0], h0[1], h0[2], h0[3]}, o[d0], 0, 0, 0); \
        o[d0] = __builtin_amdgcn_mfma_f32_32x32x16_bf16(pa1, (bf16x8){l1[0], l1[1], l1[2], l1[3], h1[0], h1[1], h1[2], h1[3]}, o[d0], 0, 0, 0); \
        o[d0] = __builtin_amdgcn_mfma_f32_32x32x16_bf16(pa2, (bf16x8){l2[0], l2[1], l2[2], l2[3], h2[0], h2[1], h2[2], h2[3]}, o[d0], 0, 0, 0); \
        o[d0] = __builtin_amdgcn_mfma_f32_32x32x16_bf16(pa3, (bf16x8){l3[0], l3[1], l3[2], l3[3], h3[0], h3[1], h3[2], h3[3]}, o[d0], 0, 0, 0); } while (0)
    for (int t = 0; t < NT; t += 2) { FA_STEP(0, t); if (t + 1 < NT) FA_STEP(1, t + 1); }
    li_l[r32] = l_reg;
    if constexpr (VAR == 1) { const bf16* gp = it.G + (long)(qlo + r32) * it.gs;
#pragma unroll
        for (int k = 0; k < 3; ++k) { const float gl = __builtin_bit_cast(float, (unsigned)gp[k] << 16); wsl[64 + 32 * k + r32] = 1.0f / (1.0f + __expf(-gl)); } }
    asm volatile("s_waitcnt lgkmcnt(0)" ::: "memory");
    if (it.LSE && hi == 0) it.LSE[(long)(qlo + r32) * it.lses] = m_reg * SCALE + __logf(l_reg);
    FA_LAS unsigned char* stg = L + wid * (32 * OSTG);
#pragma unroll
    for (int r = 0; r < 16; ++r) { const int orow = crow(r, hi); const float lv_ = li_l[orow]; float rl = lv_ > 0.f ? __builtin_amdgcn_rcpf(lv_) : 0.f; if constexpr (VAR == 1) rl *= wsl[64 + 32 + orow];
#pragma unroll
        for (int d0 = 0; d0 < 4; ++d0) { const float v = o[d0][r] * rl; const unsigned u = __builtin_bit_cast(unsigned, v); *(FA_LAS unsigned short*)(stg + orow * OSTG + (d0 * 32 + r32) * 2) = (unsigned short)((u + 0x7fffu + ((u >> 16) & 1u)) >> 16); } }
    asm volatile("s_waitcnt lgkmcnt(0)" ::: "memory");
#pragma unroll
    for (int i = 0; i < 8; ++i) { const int id = lane + 64 * i, row = id >> 4, ch = id & 15; const long qi = (long)(qlo + row);
        u32x4 w = *(const FA_LAS u32x4*)(stg + row * OSTG + ch * 16);
        if constexpr (VAR == 1) { const float g0 = wsl[64 + row], g2 = wsl[64 + 64 + row];
            const u32x4 a = *(const u32x4*)(it.M0 + qi * it.ms + ch * 8), c = *(const u32x4*)(it.M1 + qi * it.ms + ch * 8);
#pragma unroll
            for (int k = 0; k < 4; ++k) { const float lo = __builtin_bit_cast(float, w[k] << 16) + g0 * __builtin_bit_cast(float, a[k] << 16) + g2 * __builtin_bit_cast(float, c[k] << 16);
                const float hi_ = __builtin_bit_cast(float, w[k] & 0xffff0000u) + g0 * __builtin_bit_cast(float, a[k] & 0xffff0000u) + g2 * __builtin_bit_cast(float, c[k] & 0xffff0000u); w[k] = cvtpk(lo, hi_); } }
        *(u32x4*)(it.O + qi * it.os + ch * 8) = w; }
    __syncthreads();
#undef FA_LOAD
#undef FA_WRITE
#undef FA_KBASE
#undef FA_STEP
#undef FA_PK4
#undef FA_TRRD
#undef FA_PV_D0
}

struct CmpItem { const bf16* Q; long qs; const bf16* K; const bf16* V; const float* bias; int bld; int s0; bf16* O; long os; unsigned long long* sel; };
__device__ __forceinline__ void cmp_block(const CmpItem& it, unsigned char* lds_g, int imps_off) {
    constexpr float SCALE = 0.08838834764831845f, C2 = 1.4426950408889634f * SCALE;
    constexpr int OFF_TABC = 65536;
    FA_LAS unsigned char* L = (FA_LAS unsigned char*)lds_g;
    const int tid = threadIdx.x, wid = __builtin_amdgcn_readfirstlane(tid >> 6), lane = tid & 63, r32 = lane & 31, hi = lane >> 5;
    FA_LAS float* tabc = (FA_LAS float*)(L + OFF_TABC); FA_LAS float* imps = (FA_LAS float*)(L + imps_off);
    const int tokl = wid * 8 + (r32 >> 2), rh = r32 & 3, s = it.s0 + tokl;
    const int nvis = (it.s0 + 63 - 31) / 16 + 1 > 255 ? 255 : (it.s0 + 63 - 31) / 16 + 1;
    const int NT = (nvis + 63) / 64;
    const int nlim = (s - 31) >> 4;
    const int sr = tid >> 4, sc = (tid & 15) * 8, vst0 = v_st(sr, sc), vst1 = v_st(32 + sr, sc), kws = KSWZ(sr, sc * 2);
    const int vb0 = OFF_V + v_rd_base(lane);
    bf16x8 qr[8];
    { const bf16* qp = it.Q + (long)tokl * it.qs + rh * 128 + hi * 8;
#pragma unroll
      for (int d0 = 0; d0 < 8; ++d0) qr[d0] = *(const bf16x8*)(qp + d0 * 16); }
    for (int i = tid; i < 4 * 4096; i += 512) tabc[i] = it.bias[(long)(i >> 12) * it.bld + (i & 4095)] * (1.0f / SCALE);
    for (int i = tid; i < 64 * 64; i += 512) imps[i] = 0.f;
    bf16x8 st_k0, st_k1, st_v0, st_v1;
#define CM_LOADK(kb_) do { st_k0 = *(const bf16x8*)(it.K + (long)((kb_) + sr) * 128 + sc); st_k1 = *(const bf16x8*)(it.K + (long)((kb_) + 32 + sr) * 128 + sc); } while (0)
#define CM_LOADV(kb_) do { st_v0 = *(const bf16x8*)(it.V + (long)((kb_) + sr) * 128 + sc); st_v1 = *(const bf16x8*)(it.V + (long)((kb_) + 32 + sr) * 128 + sc); } while (0)
#define CM_WRITEK(bf_) do { *(FA_LAS bf16x8*)(L + OFF_K + (bf_) * SHM_K + kws) = st_k0; *(FA_LAS bf16x8*)(L + OFF_K + (bf_) * SHM_K + kws + 32 * 256) = st_k1; } while (0)
#define CM_WRITEV(bf_) do { *(FA_LAS bf16x8*)(L + OFF_V + (bf_) * SHM_V + vst0) = st_v0; *(FA_LAS bf16x8*)(L + OFF_V + (bf_) * SHM_V + vst1) = st_v1; } while (0)
#define CM_SCORES(BUF, kb_) \
        f32x16 p0 = {}, p1 = {}; \
        { const int ka_ = OFF_K + (BUF) * SHM_K; \
          _Pragma("unroll") for (int d0 = 0; d0 < 8; ++d0) { \
            const bf16x8 b0 = *(const FA_LAS bf16x8*)(L + ka_ + KSWZ(r32, (d0 * 16 + hi * 8) * 2)); \
            const bf16x8 b1 = *(const FA_LAS bf16x8*)(L + ka_ + 32 * 256 + KSWZ(r32, (d0 * 16 + hi * 8) * 2)); \
            p0 = __builtin_amdgcn_mfma_f32_32x32x16_bf16(b0, qr[d0], p0, 0, 0, 0); p1 = __builtin_amdgcn_mfma_f32_32x32x16_bf16(b1, qr[d0], p1, 0, 0, 0); } } \
        { const int nb_ = (kb_) + 4 * hi, relb_ = s - 31 - 16 * nb_; const float NEG_ = -__builtin_inff(); \
          _Pragma("unroll") for (int r = 0; r < 16; ++r) { const int c_ = (r & 3) + 8 * (r >> 2); \
            { const int rel_ = relb_ - 16 * c_; const int ix_ = rel_ < 0 ? 0 : rel_; const float bv_ = tabc[rh * 4096 + ix_]; p0[r] = (nb_ + c_ <= nlim) ? p0[r] + bv_ : NEG_; } \
            { const int rel_ = relb_ - 16 * (c_ + 32); const int ix_ = rel_ < 0 ? 0 : rel_; const float bv_ = tabc[rh * 4096 + ix_]; p1[r] = (nb_ + c_ + 32 <= nlim) ? p1[r] + bv_ : NEG_; } } }
    CM_LOADK(0); asm volatile("s_waitcnt vmcnt(0)" ::: "memory"); CM_WRITEK(0); __syncthreads();
    float m_reg = -1e30f, l_reg = 0.f;
#define CM_P1(BUF, t) do { if ((t) + 1 < NT) CM_LOADK(((t) + 1) * 64); \
        { CM_SCORES(BUF, (t) * 64) \
          float pmax_ = p0[0]; _Pragma("unroll") for (int r = 1; r < 16; ++r) pmax_ = fmaxf(pmax_, p0[r]); _Pragma("unroll") for (int r = 0; r < 16; ++r) pmax_ = fmaxf(pmax_, p1[r]); \
          { auto rr_ = __builtin_amdgcn_permlane32_swap(__float_as_uint(pmax_), __float_as_uint(pmax_), false, false); pmax_ = fmaxf(__uint_as_float(rr_[0]), __uint_as_float(rr_[1])); } \
          const float mn_ = fmaxf(m_reg, pmax_), alpha_ = __builtin_amdgcn_exp2f((m_reg - mn_) * C2), mnL_ = -mn_ * C2; float ps_ = 0.f; \
          _Pragma("unroll") for (int r = 0; r < 16; ++r) ps_ += __builtin_amdgcn_exp2f(fmaf(p0[r], C2, mnL_)) + __builtin_amdgcn_exp2f(fmaf(p1[r], C2, mnL_)); \
          { auto rr_ = __builtin_amdgcn_permlane32_swap(__float_as_uint(ps_), __float_as_uint(ps_), false, false); ps_ = __uint_as_float(rr_[0]) + __uint_as_float(rr_[1]); } \
          l_reg = l_reg * alpha_ + ps_; m_reg = mn_; } \
        if ((t) + 1 < NT) { asm volatile("s_waitcnt vmcnt(0)" ::: "memory"); CM_WRITEK(1 - (BUF)); } \
        __syncthreads(); } while (0)
    for (int t = 0; t < NT; t += 2) { CM_P1(0, t); if (t + 1 < NT) CM_P1(1, t + 1); }
    const float inv_l = l_reg > 0.f ? 1.0f / l_reg : 0.f, mL = -m_reg * C2;
    CM_LOADK(0); CM_LOADV(0); asm volatile("s_waitcnt vmcnt(0)" ::: "memory"); CM_WRITEK(0); CM_WRITEV(0); __syncthreads();
    f32x16 o[4] = {};
#define FA_PK4(P, B_, OUT) do { unsigned a0 = cvtpk(P[B_+0], P[B_+1]), a1 = cvtpk(P[B_+2], P[B_+3]); unsigned b0 = cvtpk(P[B_+4], P[B_+5]), b1 = cvtpk(P[B_+6], P[B_+7]); \
        auto r0 = __builtin_amdgcn_permlane32_swap(a0, b0, false, false); auto r1 = __builtin_amdgcn_permlane32_swap(a1, b1, false, false); \
        u32x4 w = {r0[0], r1[0], r0[1], r1[1]}; OUT = __builtin_bit_cast(bf16x8, w); } while (0)
#define FA_TRRD(dst, off) asm volatile("ds_read_b64_tr_b16 %0, %1 offset:%2" : "=&v"(dst) : "v"(vb0), "i"(off) : "memory")
#define FA_PV_D0(VB, d0) do { s16x4 l0, l1, l2, l3, h0, h1, h2, h3; constexpr int b_ = (VB) * SHM_V + v_rd_off(d0, 0, 0); \
        FA_TRRD(l0, b_); FA_TRRD(h0, b_ + 2048); FA_TRRD(l1, b_ + 4096); FA_TRRD(h1, b_ + 6144); FA_TRRD(l2, b_ + 8192); FA_TRRD(h2, b_ + 10240); FA_TRRD(l3, b_ + 12288); FA_TRRD(h3, b_ + 14336); \
        asm volatile("s_waitcnt lgkmcnt(0)" ::: "memory"); SBAR(); \
        o[d0] = __builtin_amdgcn_mfma_f32_32x32x16_bf16(pa0, (bf16x8){l0[0], l0[1], l0[2], l0[3], h0[0], h0[1], h0[2], h0[3]}, o[d0], 0, 0, 0); \
        o[d0] = __builtin_amdgcn_mfma_f32_32x32x16_bf16(pa1, (bf16x8){l1[0], l1[1], l1[2], l1[3], h1[0], h1[1], h1[2], h1[3]}, o[d0], 0, 0, 0); \
        o[d0] = __builtin_amdgcn_mfma_f32_32x32x16_bf16(pa2, (bf16x8){l2[0], l2[1], l2[2], l2[3], h2[0], h2[1], h2[2], h2[3]}, o[d0], 0, 0, 0); \
        o[d0] = __builtin_amdgcn_mfma_f32_32x32x16_bf16(pa3, (bf16x8){l3[0], l3[1], l3[2], l3[3], h3[0], h3[1], h3[2], h3[3]}, o[d0], 0, 0, 0); } while (0)
#define CM_IMP(P, half_, t) do { _Pragma("unroll") for (int q4 = 0; q4 < 4; ++q4) { \
            float A_ = (2.0f * ((P[4 * q4] + P[4 * q4 + 1]) + P[4 * q4 + 2]) + P[4 * q4 + 3]) * inv_l, B_ = P[4 * q4 + 3] * inv_l; \
            A_ += __shfl_xor(A_, 1); A_ += __shfl_xor(A_, 2); B_ += __shfl_xor(B_, 1); B_ += __shfl_xor(B_, 2); \
            const int j_ = 2 * q4 + hi + 8 * (half_) + 16 * (t); \
            if (rh == 0) { __hip_atomic_fetch_add(&imps[tokl * 64 + j_], A_, __ATOMIC_RELAXED, __HIP_MEMORY_SCOPE_WORKGROUP); \
                if (j_ + 1 < 64) __hip_atomic_fetch_add(&imps[tokl * 64 + j_ + 1], B_, __ATOMIC_RELAXED, __HIP_MEMORY_SCOPE_WORKGROUP); } } } while (0)
#define CM_P2(BUF, t) do { if ((t) + 1 < NT) { CM_LOADK(((t) + 1) * 64); CM_LOADV(((t) + 1) * 64); } \
        { CM_SCORES(BUF, (t) * 64) \
          _Pragma("unroll") for (int r = 0; r < 16; ++r) { p0[r] = __builtin_amdgcn_exp2f(fmaf(p0[r], C2, mL)); p1[r] = __builtin_amdgcn_exp2f(fmaf(p1[r], C2, mL)); } \
          CM_IMP(p0, 0, t); CM_IMP(p1, 1, t); \
          bf16x8 pa0, pa1, pa2, pa3; FA_PK4(p0, 0, pa0); FA_PK4(p0, 8, pa1); FA_PK4(p1, 0, pa2); FA_PK4(p1, 8, pa3); \
          FA_PV_D0(BUF, 0); FA_PV_D0(BUF, 1); FA_PV_D0(BUF, 2); FA_PV_D0(BUF, 3); } \
        if ((t) + 1 < NT) { asm volatile("s_waitcnt vmcnt(0)" ::: "memory"); CM_WRITEK(1 - (BUF)); CM_WRITEV(1 - (BUF)); } \
        __syncthreads(); } while (0)
    for (int t = 0; t < NT; t += 2) { CM_P2(0, t); if (t + 1 < NT) CM_P2(1, t + 1); }
    asm volatile("s_waitcnt lgkmcnt(0)" ::: "memory");
    for (int tk = 0; tk < 8; ++tk) { const int sp = it.s0 + wid * 8 + tk, blk_t = sp >> 6, j = lane;
        const float is = imps[(wid * 8 + tk) * 64 + j];
        const bool forced = (j == 0) || (j == blk_t) || (j == blk_t - 1), valid = j <= blk_t;
        const float scv = forced ? 1e9f : (valid ? is : -1.0f);
        int rank = 0;
        for (int k = 0; k < 64; ++k) { const float vk = __shfl(scv, k); rank += (vk > scv || (vk == scv && k < j)) ? 1 : 0; }
        const unsigned long long msk = __ballot(rank < 16 && scv > -0.5f);
        if (lane == 0) it.sel[(long)(wid * 8 + tk) * 2] = msk; }
    FA_LAS unsigned char* stg = L + wid * (32 * OSTG);
    FA_LAS float* li_c = imps + wid * 512;
    li_c[r32] = inv_l; asm volatile("s_waitcnt lgkmcnt(0)" ::: "memory");
#pragma unroll
    for (int r = 0; r < 16; ++r) { const int orow = crow(r, hi); const float rl = li_c[orow];
#pragma unroll
        for (int d0 = 0; d0 < 4; ++d0) { const unsigned u = __builtin_bit_cast(unsigned, o[d0][r] * rl); *(FA_LAS unsigned short*)(stg + orow * OSTG + (d0 * 32 + r32) * 2) = (unsigned short)((u + 0x7fffu + ((u >> 16) & 1u)) >> 16); } }
    asm volatile("s_waitcnt lgkmcnt(0)" ::: "memory");
#pragma unroll
    for (int i = 0; i < 8; ++i) { const int id = lane + 64 * i, row = id >> 4, ch = id & 15;
        const u32x4 w = *(const FA_LAS u32x4*)(stg + row * OSTG + ch * 16);
        *(u32x4*)(it.O + (long)(wid * 8 + (row >> 2)) * it.os + (row & 3) * 128 + ch * 8) = w; }
    __syncthreads();
#undef CM_LOADK
#undef CM_LOADV
#undef CM_WRITEK
#undef CM_WRITEV
#undef CM_SCORES
#undef CM_P1
#undef CM_P2
#undef CM_IMP
#undef FA_PK4
#undef FA_TRRD
#undef FA_PV_D0
}
}

constexpr int D = 2048, NB = 4, S = 4096, M = NB * S;
constexpr int HD = 128;
constexpr int Z0W = 3840;
constexpr int Z_NQ = 0, Z_NKV = 1024, Z_QLAT = 2560, Z_KVLAT = 3072, Z_KPE = 3584, Z_NG = 3648;
constexpr int QMW = 1536, KVMW = 2048;
constexpr int FF = 5632, FFE = 7168, NE = 8;
constexpr int Z1W = 9216;
constexpr int NSLOT = (2 * M / 256 + NE) * 256;
constexpr float RMS_EPS = 1e-6f;

constexpr size_t MiB = 1u << 20;
constexpr size_t WS_CTL = 0, CTL_ZERO_BYTES = 1 * MiB;
constexpr size_t WS_MOD = 1 * MiB;
constexpr size_t WS_BIAS = 2 * MiB;
constexpr int BIAS_LD = 4096 + 64;
constexpr size_t WS_ROPE = 3 * MiB;
constexpr size_t WS_RINV = 8 * MiB;
constexpr size_t WS_SEL = 9 * MiB;
constexpr size_t WS_KC = 10 * MiB;
constexpr size_t WS_VC = 11 * MiB;
constexpr size_t WS_ROUTE = 12 * MiB;
constexpr size_t WS_LSE = 13 * MiB;
constexpr size_t WS_KPE = 15 * MiB;
constexpr size_t WS_W1T = 17 * MiB, WS_W2T = 19 * MiB, WS_CB1 = 20 * MiB;
constexpr size_t WS_WIN0 = 21 * MiB, WS_WUQ = 36 * MiB, WS_WUKV = 38 * MiB, WS_WOUT0 = 40 * MiB, WS_WGU0 = 48 * MiB, WS_WDN0 = 92 * MiB;
constexpr size_t WS_WIN1 = 114 * MiB, WS_WOUT1 = 150 * MiB, WS_WMGU = 154 * MiB, WS_WMDN = 602 * MiB;
constexpr size_t WS_X = 826 * MiB;
constexpr size_t WS_H = 954 * MiB;
constexpr size_t WS_R = 1018 * MiB;
constexpr size_t WS_Z0 = WS_R, WS_QM = WS_R + 120 * MiB, WS_KVM = WS_R + 168 * MiB, WS_OCMP = WS_R + 232 * MiB, WS_OWIN = WS_R + 264 * MiB, WS_CAT = WS_R + 328 * MiB;
constexpr size_t WS_ACT = WS_R;
constexpr size_t WS_Z1 = WS_R, WS_OP = WS_R + 288 * MiB, WS_OM = WS_R + 384 * MiB;
constexpr size_t WS_XB = WS_R, WS_ACTB = WS_R + 136 * MiB, WS_YB = WS_R;
constexpr size_t WS_END = WS_R + 612 * MiB;
static_assert(WS_Z0 + (size_t)M * Z0W * 2 <= WS_QM && WS_QM + (size_t)M * QMW * 2 <= WS_KVM && WS_KVM + (size_t)M * KVMW * 2 <= WS_OCMP && WS_CAT + (size_t)M * 2048 * 2 <= WS_END, "L0 map");
static_assert(WS_Z1 + (size_t)M * Z1W * 2 <= WS_OM && WS_XB + (size_t)NSLOT * D * 2 <= WS_ACTB && WS_ACTB + (size_t)NSLOT * FFE * 2 <= WS_END, "L1 map");
static_assert(WS_WMDN + (size_t)NE * D * FFE * 2 <= WS_X && WS_WMGU + (size_t)NE * 2 * FFE * D * 2 <= WS_WMDN, "weights map");
constexpr int CW_BAR = 4096;
constexpr int CW_CNT = 64;
constexpr int CW_TS = 128;
constexpr int CW_Q = 8192;

constexpr int RING_BYTES = 131072;
constexpr int SMALL_OFF = RING_BYTES;
constexpr int LDSCTL_OFF = RING_BYTES + 16384, MISC_OFF = LDSCTL_OFF;
constexpr int LDS_BYTES = LDSCTL_OFF + 256;
constexpr int NWAVES = 8;

#define GAS __attribute__((address_space(1)))
#define LAS __attribute__((address_space(3)))
typedef unsigned short bf16;
typedef unsigned v4u __attribute__((ext_vector_type(4)));
typedef unsigned v2u __attribute__((ext_vector_type(2)));
typedef float f32x4 __attribute__((ext_vector_type(4)));
typedef float f32x2 __attribute__((ext_vector_type(2)));
#define LDS_WAIT() asm volatile("s_waitcnt lgkmcnt(0)" ::: "memory")
__device__ __forceinline__ unsigned f2bf(float f) { unsigned u = __builtin_bit_cast(unsigned, f); return (u + 0x7fffu + ((u >> 16) & 1u)) >> 16; }
__device__ __forceinline__ unsigned pk2(float lo, float hi) { return f2bf(lo) | (f2bf(hi) << 16); }
__device__ __forceinline__ float bf2f(unsigned short b) { return __builtin_bit_cast(float, (unsigned)b << 16); }
__device__ __forceinline__ float bflo(unsigned w) { return __builtin_bit_cast(float, w << 16); }
__device__ __forceinline__ float bfhi(unsigned w) { return __builtin_bit_cast(float, w & 0xffff0000u); }
__device__ __forceinline__ float wave_sum(float v) {
#pragma unroll
    for (int o = 1; o < 64; o <<= 1) v += __shfl_xor(v, o);
    return v;
}
__device__ __forceinline__ float wave_max(float v) {
#pragma unroll
    for (int o = 1; o < 64; o <<= 1) v = fmaxf(v, __shfl_xor(v, o));
    return v;
}

#define XB_TMO      128
#define XB_XCNT(j)  (256  + 64 * (j))
#define XB_XSUB(j)  (1280 + 64 * (j))
#define XB_XGEN(j)  (2304 + 64 * (j))
#define XB_TOP      3328
#define XB_TOPGEN   3392
#define XCD_BAR_WORDS 3456
#define XB_SPIN_CAP (1u << 22)

__device__ __forceinline__ unsigned xb_ld(unsigned* p)              { return __hip_atomic_load(p, __ATOMIC_RELAXED, __HIP_MEMORY_SCOPE_AGENT); }
__device__ __forceinline__ unsigned xb_add(unsigned* p, unsigned v) { return __hip_atomic_fetch_add(p, v, __ATOMIC_RELAXED, __HIP_MEMORY_SCOPE_AGENT); }
__device__ __forceinline__ unsigned xb_xcc_id() { return (unsigned)__builtin_amdgcn_s_getreg((3 << 11) | 20) & 0xFu; }
#define XB_SPIN(cond, bar) do { unsigned _sp = 0; while (cond) { __builtin_amdgcn_s_sleep(1); \
    if ((++_sp & 255u) == 0u) { if (xb_ld(&(bar)[XB_TMO])) break; if (_sp > XB_SPIN_CAP) { atomicAdd(&(bar)[XB_TMO], 1u); break; } } } } while (0)

struct XcdBarrier {
    unsigned* bar; unsigned x;
    volatile LAS unsigned* st;
};

__device__ __forceinline__ XcdBarrier xcd_barrier_post(unsigned* bar, volatile LAS unsigned* st) {
    XcdBarrier b; b.bar = bar; b.x = xb_xcc_id(); b.st = st;
    if (threadIdx.x == 0) (void)xb_add(&bar[XB_XCNT(b.x)], 1u);
    return b;
}
__device__ __forceinline__ void xcd_barrier_complete(unsigned* bar, unsigned x, unsigned& nloc, unsigned& nx) {
    const unsigned G = gridDim.x * gridDim.y * gridDim.z;
    unsigned sum, cnt, mine, sp = 0u;
    for (;;) {
        sum = 0u; cnt = 0u; mine = 0u;
#pragma unroll
        for (unsigned j = 0; j < 16; ++j) { const unsigned c = xb_ld(&bar[XB_XCNT(j)]); sum += c; cnt += (c > 0u) ? 1u : 0u; mine = (j == x) ? c : mine; }
        if (sum == G) break;
        __builtin_amdgcn_s_sleep(1);
        if ((++sp & 255u) == 0u) { if (xb_ld(&bar[XB_TMO])) break; if (sp > XB_SPIN_CAP) { atomicAdd(&bar[XB_TMO], 1u); break; } }
    }
    nloc = mine > 0u ? mine : 1u; nx = cnt > 0u ? cnt : 1u;
}

__device__ __forceinline__ void xcd_barrier(const XcdBarrier& b) {
    asm volatile("s_waitcnt vmcnt(0)" ::: "memory");
    __syncthreads();
    if (threadIdx.x == 0) {
        unsigned* bar = b.bar;
        __builtin_amdgcn_s_waitcnt(0);
        unsigned nloc = b.st[0], nx = b.st[1];
        if (nloc == 0u) { xcd_barrier_complete(bar, b.x, nloc, nx); b.st[0] = nloc; b.st[1] = nx; }
        const unsigned old = xb_add(&bar[XB_XSUB(b.x)], 1u);
        const unsigned gen = old / nloc;
        if (old + 1u == (gen + 1u) * nloc) {
            __builtin_amdgcn_fence(__ATOMIC_RELEASE, "agent");
            asm volatile("s_waitcnt vmcnt(0)" ::: "memory");
            const unsigned og = xb_add(&bar[XB_TOP], 1u);
            const unsigned tg = og / nx;
            if (og + 1u == (tg + 1u) * nx) xb_add(&bar[XB_TOPGEN], 1u);
            else XB_SPIN(xb_ld(&bar[XB_TOPGEN]) == tg, bar);
            __builtin_amdgcn_fence(__ATOMIC_ACQUIRE, "agent");
            xb_add(&bar[XB_XGEN(b.x)], 1u);
            asm volatile("s_waitcnt vmcnt(0)" ::: "memory");
        } else {
            XB_SPIN(xb_ld(&bar[XB_XGEN(b.x)]) == gen, bar);
            __builtin_amdgcn_fence(__ATOMIC_ACQUIRE, "agent");
            asm volatile("s_waitcnt vmcnt(0)" ::: "memory");
        }
    }
    __syncthreads();
}


struct Args { const void* in[30]; float* out; unsigned char* ws; int ph_lo, ph_hi; };
struct Frame {
    unsigned char* lds;
    int tid, lane, wave, vcu, G, gw, NGW;
    unsigned char* ws;
};

__device__ __forceinline__ int t5_bucket(int n) {
    if (n < 16) return n < 0 ? 0 : n;
    int b = 16;
    b += (n >= 22); b += (n >= 30); b += (n >= 40); b += (n >= 54); b += (n >= 73); b += (n >= 99); b += (n >= 134); b += (n >= 182);
    b += (n >= 246); b += (n >= 332); b += (n >= 450); b += (n >= 609); b += (n >= 825); b += (n >= 1117); b += (n >= 1513);
    return b;
}

__device__ __forceinline__ unsigned pk4_fp8(float a, float b, float c, float d) { int w = 0; w = __builtin_amdgcn_cvt_pk_fp8_f32(a, b, w, false); w = __builtin_amdgcn_cvt_pk_fp8_f32(c, d, w, true); return (unsigned)w; }
template <int MAP, bool OUT8 = false>
__device__ __forceinline__ void p0_transpose_item(const float* W, const float* W2, int K, int Nsrc, int Ndst, bf16* WT, const float* kscale, float* scr, int item, int lane, float oscale = 1.0f) {
    const int nblk = Ndst / 64, kb = item / nblk, nb = item % nblk, k0 = 64 * kb, n0 = 64 * nb;
    const int n4 = (lane & 15) * 4, n = n0 + n4, kr = lane >> 4;
    const float* src = W; int sc = n; bool ok = true;
    if (MAP == 1) { if (n < Z_QLAT) sc = n; else if (n < Z_NG) sc = n + 24; else if (n < Z_NG + 24) sc = n - Z_NG + 2560; else ok = false; }
    if (MAP == 2) { const int g32 = n >> 5, w = n & 31; src = (w < 16) ? W : W2; sc = g32 * 16 + (w & 15); }
    f32x4 v[16];
#pragma unroll
    for (int i = 0; i < 16; ++i) v[i] = ok ? __builtin_nontemporal_load((const f32x4*)(src + (size_t)(k0 + 4 * i + kr) * Nsrc + sc)) : (f32x4){0.f, 0.f, 0.f, 0.f};
#pragma unroll
    for (int i = 0; i < 16; ++i) { const int kk = 4 * i + kr; f32x4 t = v[i]; if (kscale) t = t * kscale[k0 + kk]; float* d = scr + kk * 65 + n4; d[0] = t.x; d[1] = t.y; d[2] = t.z; d[3] = t.w; }
    LDS_WAIT(); asm volatile("" ::: "memory");
    if constexpr (OUT8) {
        const int kg = lane & 3;
#pragma unroll
        for (int p = 0; p < 4; ++p) { const int nn = 16 * p + (lane >> 2); const float* s = scr + (16 * kg) * 65 + nn;
            v4u o; o.x = pk4_fp8(s[0 * 65] * oscale, s[1 * 65] * oscale, s[2 * 65] * oscale, s[3 * 65] * oscale); o.y = pk4_fp8(s[4 * 65] * oscale, s[5 * 65] * oscale, s[6 * 65] * oscale, s[7 * 65] * oscale);
            o.z = pk4_fp8(s[8 * 65] * oscale, s[9 * 65] * oscale, s[10 * 65] * oscale, s[11 * 65] * oscale); o.w = pk4_fp8(s[12 * 65] * oscale, s[13 * 65] * oscale, s[14 * 65] * oscale, s[15 * 65] * oscale);
            *(v4u*)((unsigned char*)WT + (size_t)(n0 + nn) * K + k0 + 16 * kg) = o; }
    } else {
    const int kg = lane & 7;
#pragma unroll
    for (int p = 0; p < 8; ++p) { const int nn = 8 * p + (lane >> 3); const float* s = scr + (8 * kg) * 65 + nn;
        v4u o; o.x = pk2(s[0 * 65], s[1 * 65]); o.y = pk2(s[2 * 65], s[3 * 65]); o.z = pk2(s[4 * 65], s[5 * 65]); o.w = pk2(s[6 * 65], s[7 * 65]);
        *(v4u*)(WT + (size_t)(n0 + nn) * K + k0 + 8 * kg) = o; }
    }
    LDS_WAIT(); asm volatile("" ::: "memory");
}
template <int MAP, bool OUT8 = false>
__device__ __forceinline__ void p0_transpose(Frame& F, const float* W, const float* W2, int K, int Nsrc, int Ndst, bf16* WT, const float* kscale, float oscale = 1.0f) {
    float* scr = (float*)(F.lds + F.wave * 16640);
    const int nitems = (K / 64) * (Ndst / 64);
    for (int it = F.gw; it < nitems; it += F.NGW) p0_transpose_item<MAP, OUT8>(W, W2, K, Nsrc, Ndst, WT, kscale, scr, it, F.lane, oscale);
}

__device__ __forceinline__ void modnorm_row(const float* xrow, const float* g, const float* sc, const float* sh, bf16* orow, int lane, f32x4 (&v)[8]) {
    const f32x4* xr = (const f32x4*)xrow + lane; float s = 0.f;
#pragma unroll
    for (int j = 0; j < 8; ++j) { v[j] = xr[64 * j]; s += (v[j].x * v[j].x + v[j].y * v[j].y) + (v[j].z * v[j].z + v[j].w * v[j].w); }
    const float rinv = 1.0f / sqrtf(wave_sum(s) * (1.f / D) + RMS_EPS);
    unsigned long long* o8 = (unsigned long long*)orow + lane;
#pragma unroll
    for (int j = 0; j < 8; ++j) { const f32x4 gg = ((const f32x4*)g)[lane + 64 * j], cc = ((const f32x4*)sc)[lane + 64 * j], hh = ((const f32x4*)sh)[lane + 64 * j];
        v[j] = (v[j] * rinv) * gg * (cc + 1.0f) + hh;
        o8[64 * j] = (unsigned long long)pk2(v[j].x, v[j].y) | ((unsigned long long)pk2(v[j].z, v[j].w) << 32); }
}
template <bool OUT8 = false>
__device__ __forceinline__ void modnorm_phase(Frame& F, const float* x, const float* g, const float* mod  , int sh_idx, bf16* H, float oscale = 1.0f) {
    for (int b = 0; b < NB; ++b) { const float* mb = mod + (size_t)b * 6 * D; const float* sc = mb + (size_t)(sh_idx + 1) * D; const float* sh = mb + (size_t)sh_idx * D;
        const int s0 = F.gw, s1 = F.gw + F.NGW;
        const f32x4* x0 = (const f32x4*)(x + ((size_t)b * S + s0) * D) + F.lane; const f32x4* x1 = (const f32x4*)(x + ((size_t)b * S + s1) * D) + F.lane;
        f32x4 v0[8], v1[8], ca[8], cc[8];
#pragma unroll
        for (int j = 0; j < 8; ++j) { v0[j] = x0[64 * j]; v1[j] = x1[64 * j]; }
#pragma unroll
        for (int j = 0; j < 8; ++j) { ca[j] = ((const f32x4*)g)[F.lane + 64 * j] * (((const f32x4*)sc)[F.lane + 64 * j] + 1.0f); cc[j] = ((const f32x4*)sh)[F.lane + 64 * j]; }
        float q0 = 0.f, q1 = 0.f;
#pragma unroll
        for (int j = 0; j < 8; ++j) { q0 += (v0[j].x * v0[j].x + v0[j].y * v0[j].y) + (v0[j].z * v0[j].z + v0[j].w * v0[j].w); q1 += (v1[j].x * v1[j].x + v1[j].y * v1[j].y) + (v1[j].z * v1[j].z + v1[j].w * v1[j].w); }
        const float r0 = 1.0f / sqrtf(wave_sum(q0) * (1.f / D) + RMS_EPS), r1 = 1.0f / sqrtf(wave_sum(q1) * (1.f / D) + RMS_EPS);
        if constexpr (OUT8) {
            unsigned* o0 = (unsigned*)((unsigned char*)H + ((size_t)b * S + s0) * D) + F.lane; unsigned* o1 = (unsigned*)((unsigned char*)H + ((size_t)b * S + s1) * D) + F.lane;
#pragma unroll
            for (int j = 0; j < 8; ++j) { const f32x4 a = ((v0[j] * r0) * ca[j] + cc[j]) * oscale, c2 = ((v1[j] * r1) * ca[j] + cc[j]) * oscale;
                o0[64 * j] = pk4_fp8(__builtin_amdgcn_fmed3f(a.x, -440.f, 440.f), __builtin_amdgcn_fmed3f(a.y, -440.f, 440.f), __builtin_amdgcn_fmed3f(a.z, -440.f, 440.f), __builtin_amdgcn_fmed3f(a.w, -440.f, 440.f));
                o1[64 * j] = pk4_fp8(__builtin_amdgcn_fmed3f(c2.x, -440.f, 440.f), __builtin_amdgcn_fmed3f(c2.y, -440.f, 440.f), __builtin_amdgcn_fmed3f(c2.z, -440.f, 440.f), __builtin_amdgcn_fmed3f(c2.w, -440.f, 440.f)); }
        } else {
        unsigned long long* o0 = (unsigned long long*)(H + ((size_t)b * S + s0) * D) + F.lane; unsigned long long* o1 = (unsigned long long*)(H + ((size_t)b * S + s1) * D) + F.lane;
#pragma unroll
        for (int j = 0; j < 8; ++j) { const f32x4 a = (v0[j] * r0) * ca[j] + cc[j], c2 = (v1[j] * r1) * ca[j] + cc[j];
            o0[64 * j] = (unsigned long long)pk2(a.x, a.y) | ((unsigned long long)pk2(a.z, a.w) << 32); o1[64 * j] = (unsigned long long)pk2(c2.x, c2.y) | ((unsigned long long)pk2(c2.z, c2.w) << 32); }
        }
    }
}

__device__ __forceinline__ float gelu_tanh(float x) { const float u = 0.7978845608028654f * (x + 0.044715f * x * x * x); return 0.5f * x * (1.0f + tanhf(u)); }

__global__ void __launch_bounds__(NWAVES * 64, 2) fwd(Args args) {
    extern __shared__ __attribute__((aligned(16))) unsigned char lds[];
    Frame F;
    F.lds = lds; F.ws = args.ws;
    F.tid = threadIdx.x; F.lane = F.tid & 63; F.wave = __builtin_amdgcn_readfirstlane(F.tid >> 6);
    F.G = gridDim.x; { const int bx = blockIdx.x; F.vcu = (F.G % 8 == 0) ? (bx % 8) * (F.G / 8) + bx / 8 : bx; }
    F.gw = F.vcu * NWAVES + F.wave; F.NGW = F.G * NWAVES;
    unsigned char* ws = args.ws;
    unsigned* ctl = (unsigned*)(ws + WS_CTL);
    volatile LAS unsigned* MISC = (volatile LAS unsigned*)((LAS unsigned char*)lds + MISC_OFF);
    for (int u = F.tid; u < 64; u += NWAVES * 64) MISC[u] = 0u;
    __syncthreads();
    XcdBarrier bar; bar.bar = ctl + CW_BAR; bar.x = 0; bar.st = nullptr;
    if (MK_N_LAUNCHES == 1) bar = xcd_barrier_post(ctl + CW_BAR, MISC + 8);
    const int lo = args.ph_lo, hi = args.ph_hi;
#define IN(k) (lo <= (k) && (k) < hi)
#define MOE_WSCALE 64.0f
#define MOE_ASCALE 8.0f
#define IN1_ASCALE 4.0f
#define SEAM(k) do { if (IN(k) && IN((k) + 1)) xcd_barrier(bar); } while (0)

    const float* x_in = (const float*)args.in[0]; const float* c_in = (const float*)args.in[1]; const int* positions = (const int*)args.in[2];
    const float* rel_bias = (const float*)args.in[3]; const float* ada_w = (const float*)args.in[4]; const float* ada_b = (const float*)args.in[5];
    const float* mix_norm_g = (const float*)args.in[6]; const float* ffn_norm_g = (const float*)args.in[7];
    const float* ab_w_in = (const float*)args.in[8]; const float* ab_w_out = (const float*)args.in[9];
    const float* cmp_pos_k = (const float*)args.in[10]; const float* cmp_w1_k = (const float*)args.in[11]; const float* cmp_w2_k = (const float*)args.in[12];
    const float* cmp_pos_v = (const float*)args.in[13]; const float* cmp_w1_v = (const float*)args.in[14]; const float* cmp_w2_v = (const float*)args.in[15];
    const float* q_norm_g = (const float*)args.in[16]; const float* kv_norm_g = (const float*)args.in[17]; const float* w_uq = (const float*)args.in[18]; const float* w_ukv = (const float*)args.in[19];
    const float* ffn_wg = (const float*)args.in[20]; const float* ffn_wu = (const float*)args.in[21]; const float* ffn_wd = (const float*)args.in[22];
    const float* c_w_in = (const float*)args.in[23]; const float* c_w_out = (const float*)args.in[24]; const float* w_router = (const float*)args.in[25];
    const float* moe_wg = (const float*)args.in[26]; const float* moe_wu = (const float*)args.in[27]; const float* moe_wd = (const float*)args.in[28]; const float* final_g = (const float*)args.in[29];
    float* MOD = (float*)(ws + WS_MOD); float* BIAS = (float*)(ws + WS_BIAS); float* ROPE = (float*)(ws + WS_ROPE); float* RINV = (float*)(ws + WS_RINV);
    unsigned long long* SEL = (unsigned long long*)(ws + WS_SEL); bf16* KC = (bf16*)(ws + WS_KC); bf16* VC = (bf16*)(ws + WS_VC); int* ROUTE = (int*)(ws + WS_ROUTE); bf16* KPE = (bf16*)(ws + WS_KPE);
    bf16* W_IN0 = (bf16*)(ws + WS_WIN0); bf16* W_UQ = (bf16*)(ws + WS_WUQ); bf16* W_UKV = (bf16*)(ws + WS_WUKV); bf16* W_OUT0 = (bf16*)(ws + WS_WOUT0); bf16* W_GU0 = (bf16*)(ws + WS_WGU0); bf16* W_DN0 = (bf16*)(ws + WS_WDN0);
    bf16* W_IN1 = (bf16*)(ws + WS_WIN1); bf16* W_OUT1 = (bf16*)(ws + WS_WOUT1); bf16* W_MGU = (bf16*)(ws + WS_WMGU); bf16* W_MDN = (bf16*)(ws + WS_WMDN);
    float* X = (float*)(ws + WS_X); bf16* H = (bf16*)(ws + WS_H);
    bf16* Z0 = (bf16*)(ws + WS_Z0); bf16* QM = (bf16*)(ws + WS_QM); bf16* KVM = (bf16*)(ws + WS_KVM); bf16* OCMP = (bf16*)(ws + WS_OCMP); bf16* OWIN = (bf16*)(ws + WS_OWIN); bf16* CAT = (bf16*)(ws + WS_CAT);
    bf16* W1T = (bf16*)(ws + WS_W1T); bf16* W2T = (bf16*)(ws + WS_W2T); float* CB1 = (float*)(ws + WS_CB1);
    float* LSEB = (float*)(ws + WS_LSE); bf16* OP = (bf16*)(ws + WS_OP);
    bf16* ACT = (bf16*)(ws + WS_ACT); bf16* Z1 = (bf16*)(ws + WS_Z1); bf16* OM = (bf16*)(ws + WS_OM); bf16* XB = (bf16*)(ws + WS_XB); bf16* ACTB = (bf16*)(ws + WS_ACTB); bf16* YB = (bf16*)(ws + WS_YB);
    PG8_LAS unsigned char* ring = (PG8_LAS unsigned char*)lds;

    if (IN(0)) {
        for (int job = 192 + (int)blockIdx.x; job < 194; job += F.G) {
            float* red = (float*)(lds + 32768); const int c = job - 192; const float* pos = c ? cmp_pos_v : cmp_pos_k; const float* w1 = c ? cmp_w1_v : cmp_w1_k;
            float a0 = 0.f, a1 = 0.f;
#pragma unroll 8
            for (int k = 0; k < 512; ++k) { const int kk = F.wave * 512 + k; const f32x2 wv = *(const f32x2*)(w1 + (size_t)kk * 128 + 2 * F.lane); const float pv = pos[kk]; a0 += pv * wv.x; a1 += pv * wv.y; }
            red[F.wave * 128 + 2 * F.lane] = a0; red[F.wave * 128 + 2 * F.lane + 1] = a1;
            __syncthreads();
            if (F.tid < 128) { float s = 0.f;
#pragma unroll
                for (int w = 0; w < 8; ++w) s += red[w * 128 + F.tid];
                CB1[c * 128 + F.tid] = s; }
            __syncthreads();
        }
        for (int job = blockIdx.x; job < 256; job += F.G) {
            float* cs = (float*)lds; float* red = (float*)(lds + 32768);
            for (int i = F.tid; i < 4 * D; i += 512) { const float cv = c_in[i]; cs[i] = cv / (1.0f + __expf(-cv)); }
            __syncthreads();
            const int l = job >> 7, col0 = (job & 127) * 96; const bool act = F.lane < 48;
            float acc[4][2] = {};
            const float* wp = ada_w + ((size_t)l * D + (size_t)F.wave * 256) * 12288 + col0 + 2 * (act ? F.lane : 0);
#pragma unroll 8
            for (int k = 0; k < 256; ++k) { const f32x2 wv = *(const f32x2*)(wp + (size_t)k * 12288); const int kk = F.wave * 256 + k;
#pragma unroll
                for (int b = 0; b < 4; ++b) { const float cv = cs[b * D + kk]; acc[b][0] += cv * wv.x; acc[b][1] += cv * wv.y; } }
            if (act) {
#pragma unroll
                for (int b = 0; b < 4; ++b) { red[(F.wave * 4 + b) * 96 + 2 * F.lane] = acc[b][0]; red[(F.wave * 4 + b) * 96 + 2 * F.lane + 1] = acc[b][1]; } }
            __syncthreads();
            if (F.tid < 384) { const int b = F.tid / 96, cc = F.tid % 96; float s = 0.f;
#pragma unroll
              for (int w = 0; w < 8; ++w) s += red[(w * 4 + b) * 96 + cc];
              MOD[((size_t)l * 4 + b) * 12288 + col0 + cc] = s + ada_b[(size_t)l * 12288 + col0 + cc]; }
            __syncthreads();
        }
        __syncthreads();
        p0_transpose<1>(F, ab_w_in, nullptr, D, 3672, Z0W, W_IN0, nullptr);
        p0_transpose<0>(F, w_uq, nullptr, 512, QMW, QMW, W_UQ, q_norm_g);
        p0_transpose<0>(F, w_ukv, nullptr, 512, KVMW, KVMW, W_UKV, kv_norm_g);
        p0_transpose<0>(F, ab_w_out, nullptr, D, D, D, W_OUT0, nullptr);
        p0_transpose<2>(F, ffn_wg, ffn_wu, D, FF, 2 * FF, W_GU0, nullptr);
        p0_transpose<0>(F, ffn_wd, nullptr, FF, D, D, W_DN0, nullptr);
        p0_transpose<0, true>(F, c_w_in, nullptr, D, Z1W, Z1W, W_IN1, nullptr, MOE_WSCALE);
        p0_transpose<0>(F, c_w_out, nullptr, 1024, D, D, W_OUT1, nullptr);
        p0_transpose<0>(F, cmp_w1_k, nullptr, 4096, 128, 128, W1T, nullptr); p0_transpose<0>(F, cmp_w1_v, nullptr, 4096, 128, 128, W1T + 128 * 4096, nullptr);
        p0_transpose<0>(F, cmp_w2_k, nullptr, 128, 128, 128, W2T, nullptr); p0_transpose<0>(F, cmp_w2_v, nullptr, 128, 128, 128, W2T + 128 * 128, nullptr);
        for (int e = 0; e < NE; ++e) {
            p0_transpose<2, true>(F, moe_wg + (size_t)e * D * FFE, moe_wu + (size_t)e * D * FFE, D, FFE, 2 * FFE, (bf16*)((unsigned char*)W_MGU + (size_t)e * 2 * FFE * D), nullptr, MOE_WSCALE);
            p0_transpose<0, true>(F, moe_wd + (size_t)e * FFE * D, nullptr, FFE, D, D, (bf16*)((unsigned char*)W_MDN + (size_t)e * D * FFE), nullptr, MOE_WSCALE);
        }
        for (int i = F.gw * 64 + F.lane; i < 8 * BIAS_LD; i += F.NGW * 64) { const int h = i / BIAS_LD, r = i % BIAS_LD - 64; BIAS[i] = rel_bias[t5_bucket(r) * 8 + h]; }
        for (int i = F.gw * 64 + F.lane; i < M * 32; i += F.NGW * 64) { const int m = i >> 5, f = i & 31;
            const float inv_freq = powf(10000.0f, -(float)(2 * f) / 64.0f); const float ang = (float)positions[m] * inv_freq;
            ROPE[(size_t)m * 64 + f] = cosf(ang); ROPE[(size_t)m * 64 + 32 + f] = sinf(ang); }
    }
    SEAM(0);
    if (IN(1)) modnorm_phase(F, x_in, mix_norm_g, MOD, 0, H);
    SEAM(1);
    if (IN(2)) { pg8::Gemm g{H, W_IN0, D, D, D}; pg8::StaticOrder So; So.init(M, Z0W, F.G, (int)blockIdx.x); pg8::EpiBf16 E{Z0, Z0W, nullptr};
        pg8::gemm_phase<pg8::EpiBf16, pg8::StaticOrder, PG_ALIGN, PG_SP2>(ring, g, So, E); }
    SEAM(2);
    if (IN(3)) {
        for (int m = F.gw; m < M; m += F.NGW) {
            const bf16* zr = Z0 + (size_t)m * Z0W;
#pragma unroll
            for (int w = 0; w < 2; ++w) { const v4u a = *(const v4u*)(zr + (w ? Z_KVLAT : Z_QLAT) + 8 * F.lane);
                float s = bflo(a.x) * bflo(a.x) + bfhi(a.x) * bfhi(a.x) + bflo(a.y) * bflo(a.y) + bfhi(a.y) * bfhi(a.y) + bflo(a.z) * bflo(a.z) + bfhi(a.z) * bfhi(a.z) + bflo(a.w) * bflo(a.w) + bfhi(a.w) * bfhi(a.w);
                s = wave_sum(s); if (F.lane == 0) RINV[(size_t)w * M + m] = 1.0f / sqrtf(s * (1.f / 512.f) + RMS_EPS); }
            if (F.lane < 32) { const float x1 = bf2f(zr[Z_KPE + F.lane]), x2 = bf2f(zr[Z_KPE + 32 + F.lane]); const float cs = ROPE[(size_t)m * 64 + F.lane], sn = ROPE[(size_t)m * 64 + 32 + F.lane];
                KPE[(size_t)m * 64 + F.lane] = (bf16)f2bf(x1 * cs - x2 * sn); KPE[(size_t)m * 64 + 32 + F.lane] = (bf16)f2bf(x2 * cs + x1 * sn); }
        }
        __syncthreads();
        for (int job = blockIdx.x; job < 256; job += F.G) {
            typedef short bfx8 __attribute__((ext_vector_type(8)));
            const int nt = job & 15, g = (job >> 4) & 1, b = (job >> 5) & 3, c = job >> 7, n0 = nt * 16;
            const int fr = F.lane & 15, fq = F.lane >> 4; int nrow = n0 + fr; if (nrow > 254) nrow = 254;
            const bf16* arow = Z0 + ((size_t)b * S + 16 * nrow) * Z0W + Z_NKV + c * 256 + g * 128 + fq * 8;
            const bf16* w1t = W1T + (size_t)c * 128 * 4096 + (size_t)fr * 4096 + fq * 8;
            f32x4 acc[8];
#pragma unroll
            for (int i = 0; i < 8; ++i) acc[i] = (f32x4){0.f, 0.f, 0.f, 0.f};
#pragma unroll 2
            for (int ks = 0; ks < 16; ++ks) { const int kk = F.wave * 512 + ks * 32, l = kk >> 7, d0 = kk & 127;
                const bfx8 af = *(const bfx8*)(arow + (size_t)l * Z0W + d0);
#pragma unroll
                for (int i = 0; i < 8; ++i) { const bfx8 bfr = *(const bfx8*)(w1t + (size_t)i * 16 * 4096 + kk); acc[i] = __builtin_amdgcn_mfma_f32_16x16x32_bf16(af, bfr, acc[i], 0, 0, 0); } }
            float* part = (float*)lds;
#pragma unroll
            for (int i = 0; i < 8; ++i)
#pragma unroll
                for (int j = 0; j < 4; ++j) part[(F.wave * 16 + fq * 4 + j) * 128 + i * 16 + fr] = acc[i][j];
            __syncthreads();
            bf16* hid = (bf16*)(lds + 65536);
            { const int row = F.tid >> 5, c4 = (F.tid & 31) * 4; f32x4 s = *(const f32x4*)(CB1 + c * 128 + c4);
#pragma unroll
              for (int w = 0; w < 8; ++w) s += *(const f32x4*)(part + (w * 16 + row) * 128 + c4);
              *(v2u*)(hid + row * 128 + c4) = (v2u){pk2(gelu_tanh(s.x), gelu_tanh(s.y)), pk2(gelu_tanh(s.z), gelu_tanh(s.w))}; }
            __syncthreads();
            { f32x4 o4 = {0.f, 0.f, 0.f, 0.f}; const bf16* w2t = W2T + (size_t)c * 128 * 128 + (size_t)(F.wave * 16 + fr) * 128 + fq * 8;
#pragma unroll
              for (int ks = 0; ks < 4; ++ks) { const bfx8 af = *(const bfx8*)(hid + fr * 128 + ks * 32 + fq * 8); const bfx8 bfr = *(const bfx8*)(w2t + ks * 32); o4 = __builtin_amdgcn_mfma_f32_16x16x32_bf16(af, bfr, o4, 0, 0, 0); }
              bf16* outp = (c ? VC : KC) + (((size_t)b * 2 + g) * 256) * 128 + F.wave * 16 + fr;
#pragma unroll
              for (int j = 0; j < 4; ++j) { const int n = n0 + fq * 4 + j; outp[(size_t)n * 128] = n < 255 ? (bf16)f2bf(o4[j]) : (bf16)0; } }
            __syncthreads();
        }
        __syncthreads();
        for (int Lx = blockIdx.x; Lx < 512; Lx += F.G) {
            const int qb = 15 - Lx / 32, bh = Lx % 32, b = bh >> 3, h = bh & 7, g = h >> 2; const bf16* zb = Z0 + (size_t)b * S * Z0W;
            fa::Item it{}; it.Q = zb + Z_NQ + h * 128; it.qs = Z0W; it.K = zb + Z_NKV + 4 * 256 + g * 128; it.ks = Z0W; it.V = zb + Z_NKV + 5 * 256 + g * 128; it.vs = Z0W;
            it.P0 = qb * 256; it.skv = S; it.W = 512; it.bias = BIAS + (size_t)h * BIAS_LD + 64; it.bstep = 1; it.O = OWIN + (size_t)b * S * 1024 + h * 128; it.os = 1024;
            fa::attn_block<0>(it, lds);
        }
    }
    SEAM(3);
    if (IN(4)) {
        { pg8::Gemm g{Z0 + Z_QLAT, W_UQ, Z0W, 512, 512}; pg8::StaticOrder So; So.init(M, QMW, F.G, (int)blockIdx.x); pg8::EpiBf16 E{QM, QMW, RINV};
          pg8::gemm_phase<pg8::EpiBf16, pg8::StaticOrder, PG_ALIGN, PG_SP2>(ring, g, So, E); }
        __syncthreads();
        { pg8::Gemm g{Z0 + Z_KVLAT, W_UKV, Z0W, 512, 512}; pg8::StaticOrder So; So.init(M, KVMW, F.G, (int)blockIdx.x); pg8::EpiBf16 E{KVM, KVMW, RINV + M};
          pg8::gemm_phase<pg8::EpiBf16, pg8::StaticOrder, PG_ALIGN, PG_SP2>(ring, g, So, E); }
        __syncthreads();
        for (int Lx = blockIdx.x; Lx < 512; Lx += F.G) { const int tb = 63 - Lx / 8, bg = Lx % 8, b = bg >> 1, g = bg & 1;
            fa::CmpItem it; it.Q = Z0 + ((size_t)b * S + tb * 64) * Z0W + Z_NQ + g * 512; it.qs = Z0W; it.K = KC + ((size_t)b * 2 + g) * 256 * 128; it.V = VC + ((size_t)b * 2 + g) * 256 * 128;
            it.bias = BIAS + (size_t)(g * 4) * BIAS_LD + 64; it.bld = BIAS_LD; it.s0 = tb * 64; it.O = OCMP + ((size_t)b * S + tb * 64) * 1024 + g * 512; it.os = 1024; it.sel = SEL + ((size_t)b * S + tb * 64) * 2 + g;

            fa::cmp_block(it, lds, SMALL_OFF); }
    }
    SEAM(4);
    if (IN(5)) {
        for (int Lx = blockIdx.x; Lx < 256; Lx += F.G) {
            const int x = Lx / 32, bh = Lx % 32, b = bh >> 3, h = bh & 7, g = h >> 2; const bf16* zb = Z0 + (size_t)b * S * Z0W;
            for (int pass = 0; pass < 2; ++pass) { const int qb = pass ? 15 - x : x;
                fa::Item it{}; it.Q = zb + Z_NQ + h * 128; it.qs = Z0W; it.K = zb + Z_NKV + 2 * 256 + g * 128; it.ks = Z0W; it.V = zb + Z_NKV + 3 * 256 + g * 128; it.vs = Z0W;
                it.P0 = qb * 256; it.skv = S; it.W = 1 << 20; it.bias = BIAS + (size_t)h * BIAS_LD + 64; it.bstep = 1; it.sel = SEL + (size_t)b * S * 2 + g; it.sels = 2;
                it.O = CAT + (size_t)b * S * 2048 + h * 128; it.os = 2048;
                it.M0 = OCMP + (size_t)b * S * 1024 + h * 128; it.M1 = OWIN + (size_t)b * S * 1024 + h * 128; it.ms = 1024; it.G = zb + Z_NG + h * 3; it.gs = Z0W;
                fa::attn_block<1>(it, lds); }
        }
        for (int Lx = blockIdx.x; Lx < 256; Lx += F.G) {
            const int x = Lx / 32, bh = Lx % 32, b = bh >> 3, h = bh & 7;
            for (int pass = 0; pass < 2; ++pass) { const int qb = pass ? 15 - x : x;
                fa::Item it{}; it.Q = QM + (size_t)b * S * QMW + h * 192; it.qs = QMW; it.rope = ROPE + (size_t)b * S * 64; it.ropes = 64;
                it.K = KVM + (size_t)b * S * KVMW + h * 256; it.ks = KVMW; it.K2 = KPE + (size_t)b * S * 64; it.k2s = 64; it.V = KVM + (size_t)b * S * KVMW + h * 256 + 128; it.vs = KVMW;
                it.P0 = qb * 256; it.skv = S; it.W = 1 << 20; it.O = CAT + (size_t)b * S * 2048 + 1024 + h * 128; it.os = 2048;
                fa::attn_block<2>(it, lds); }
        }
    }
    SEAM(5);
    if (IN(6)) { pg8::Gemm g{CAT, W_OUT0, 2048, 2048, 2048}; pg8::StaticOrder So; So.init(M, D, F.G, (int)blockIdx.x); pg8::EpiResid E{x_in, X, D, MOD + 2 * D, 6 * D, S / 256};
        pg8::gemm_phase<pg8::EpiResid, pg8::StaticOrder, PG_ALIGN, PG_SP2>(ring, g, So, E); }
    SEAM(6);
    if (IN(7)) modnorm_phase(F, X, ffn_norm_g, MOD, 3, H);
    SEAM(7);
    if (IN(8)) { pg8::Gemm g{H, W_GU0, D, D, D}; pg8::StaticOrder So; So.init(M, 2 * FF, F.G, (int)blockIdx.x); pg8::EpiSwiGLU E{ACT, FF};
        pg8::gemm_phase<pg8::EpiSwiGLU, pg8::StaticOrder, PG_ALIGN, PG_SP2>(ring, g, So, E); }
    SEAM(8);
    if (IN(9)) { pg8::Gemm g{ACT, W_DN0, FF, FF, FF}; pg8::StaticOrder So; So.init(M, D, F.G, (int)blockIdx.x); pg8::EpiResid E{X, X, D, MOD + 5 * D, 6 * D, S / 256};
        pg8::gemm_phase<pg8::EpiResid, pg8::StaticOrder, PG_ALIGN, PG_SP2>(ring, g, So, E); }
    SEAM(9);
    if (IN(10)) modnorm_phase<true>(F, X, mix_norm_g + D, MOD + 4 * 12288, 0, H, IN1_ASCALE);
    SEAM(10);
    if (IN(11)) { pg8::Gemm g{H, W_IN1, D / 2, D / 2, D / 2}; pg8::StaticOrder So; So.init(M, Z1W, F.G, (int)blockIdx.x); pg8::EpiBf16S E{Z1, Z1W, 1.0f / (MOE_WSCALE * IN1_ASCALE)};
        pg8::gemm_phase<pg8::EpiBf16S, pg8::StaticOrder, PG_ALIGN, PG_SP2, true, true>(ring, g, So, E); }
    SEAM(11);
    if (IN(12)) {
        for (int Lx = blockIdx.x; Lx < 1536; Lx += F.G) {
            const int p = Lx % 3, r_ = Lx / 3, bh = r_ % 32, sub = r_ / 32, b = bh >> 3, h = bh & 7;
            const int dil = p == 0 ? 1 : (p == 1 ? 4 : 16), res = p == 0 ? 0 : (p == 1 ? (sub & 3) : sub), qb = p == 0 ? sub : (p == 1 ? (sub >> 2) : 0);
            fa::Item it{}; it.Q = Z1 + ((size_t)b * S + res) * Z1W + p * 3072 + h * 128; it.qs = (long)dil * Z1W; it.K = it.Q + 1024; it.ks = it.qs; it.V = it.Q + 2048; it.vs = it.qs;
            it.P0 = qb * 256; it.skv = S / dil; it.W = 129; it.bias = BIAS + (size_t)h * BIAS_LD + 64; it.bstep = dil;
            it.O = OP + (size_t)p * M * 1024 + ((size_t)b * S + res) * 1024 + h * 128; it.os = (long)dil * 1024; it.LSE = LSEB + (size_t)p * M * 8 + ((size_t)b * S + res) * 8 + h; it.lses = (long)dil * 8;
            fa::attn_block<0>(it, lds);
        }
    }
    SEAM(12);
    if (IN(13)) {
        for (int m = F.gw; m < M; m += F.NGW) {
            const int h = F.lane >> 3; const float l0 = LSEB[(size_t)m * 8 + h], l1 = LSEB[(size_t)(M + m) * 8 + h], l2 = LSEB[(size_t)(2 * M + m) * 8 + h];
            const v4u* p0 = (const v4u*)(OP + (size_t)m * 1024) + 2 * F.lane; const v4u* p1 = (const v4u*)(OP + (size_t)(M + m) * 1024) + 2 * F.lane; const v4u* p2 = (const v4u*)(OP + (size_t)(2 * M + m) * 1024) + 2 * F.lane;
            const v4u a0 = p0[0], b0 = p0[1], a1 = p1[0], b1 = p1[1], a2 = p2[0], b2 = p2[1];
            const float mx = fmaxf(l0, fmaxf(l1, l2)); float e0 = __expf(l0 - mx), e1 = __expf(l1 - mx), e2 = __expf(l2 - mx); const float inv = 1.0f / (e0 + e1 + e2); e0 *= inv; e1 *= inv; e2 *= inv;
            v4u oa, ob;
#pragma unroll
            for (int q = 0; q < 4; ++q) { oa[q] = pk2(e0 * bflo(a0[q]) + e1 * bflo(a1[q]) + e2 * bflo(a2[q]), e0 * bfhi(a0[q]) + e1 * bfhi(a1[q]) + e2 * bfhi(a2[q]));
                ob[q] = pk2(e0 * bflo(b0[q]) + e1 * bflo(b1[q]) + e2 * bflo(b2[q]), e0 * bfhi(b0[q]) + e1 * bfhi(b1[q]) + e2 * bfhi(b2[q])); }
            v4u* po = (v4u*)(OM + (size_t)m * 1024) + 2 * F.lane; po[0] = oa; po[1] = ob;
        }
    }
    SEAM(13);
    if (IN(14)) { pg8::Gemm g{OM, W_OUT1, 1024, 1024, 1024}; pg8::StaticOrder So; So.init(M, D, F.G, (int)blockIdx.x); pg8::EpiResid E{X, X, D, MOD + 4 * 12288 + 2 * D, 6 * D, S / 256};
        pg8::gemm_phase<pg8::EpiResid, pg8::StaticOrder, PG_ALIGN, PG_SP2>(ring, g, So, E); }
    SEAM(14);
    if (IN(15)) {
        f32x4* wl = (f32x4*)lds; int* lcnt = (int*)(lds + 65536); int* lbase = lcnt + 8; int* rinfo = lcnt + 16;
        for (int i = F.tid; i < 4096; i += 512) { const int slot = i >> 6, l = i & 63, j = slot >> 3, q = (slot >> 1) & 3, half = slot & 1; wl[i] = *(const f32x4*)(w_router + (size_t)(4 * l + 256 * j + q) * 8 + half * 4); }
        if (F.tid < 8) lcnt[F.tid] = 0;
        __syncthreads();
        for (int k = 0; k < M / 2048; ++k) { const int m = F.gw + k * F.NGW; if (m >= M) break; const int b = m / S; const float* mb = MOD + 4 * 12288 + (size_t)b * 6 * D; f32x4 v[8];
            modnorm_row(X + (size_t)m * D, ffn_norm_g + D, mb + 4 * D, mb + 3 * D, H + (size_t)m * D, F.lane, v);
            float lg[8] = {};
#pragma unroll
            for (int j = 0; j < 8; ++j)
#pragma unroll
                for (int q = 0; q < 4; ++q) { const f32x4 wa = wl[((j * 4 + q) * 2 + 0) * 64 + F.lane], wb = wl[((j * 4 + q) * 2 + 1) * 64 + F.lane]; const float hv = v[j][q];
                    lg[0] += hv * wa.x; lg[1] += hv * wa.y; lg[2] += hv * wa.z; lg[3] += hv * wa.w; lg[4] += hv * wb.x; lg[5] += hv * wb.y; lg[6] += hv * wb.z; lg[7] += hv * wb.w; }
#pragma unroll
            for (int e = 0; e < 8; ++e) lg[e] = wave_sum(lg[e]);
            int e1 = 0; float v1 = lg[0];
#pragma unroll
            for (int e = 1; e < 8; ++e) if (lg[e] > v1) { v1 = lg[e]; e1 = e; }
            int e2 = -1; float v2 = -3.0e38f;
#pragma unroll
            for (int e = 0; e < 8; ++e) if (e != e1 && lg[e] > v2) { v2 = lg[e]; e2 = e; }
            if (F.lane == 0) { const float g1 = 1.0f / (1.0f + __expf(v2 - v1)), g2 = 1.0f - g1;
                const int r1 = __hip_atomic_fetch_add(lcnt + e1, 1, __ATOMIC_RELAXED, __HIP_MEMORY_SCOPE_WORKGROUP), r2 = __hip_atomic_fetch_add(lcnt + e2, 1, __ATOMIC_RELAXED, __HIP_MEMORY_SCOPE_WORKGROUP);
                int* ri = rinfo + (F.wave * 8 + k) * 8; ri[0] = e1; ri[1] = e2; ri[2] = r1; ri[3] = r2; ri[4] = __float_as_int(g1); ri[5] = __float_as_int(g2); }
        }
        __syncthreads();
        if (F.tid < 8) lbase[F.tid] = (int)atomicAdd(ctl + CW_CNT + F.tid, (unsigned)lcnt[F.tid]);
        __syncthreads();
        if (F.lane == 0) for (int k = 0; k < M / 2048; ++k) { const int m = F.gw + k * F.NGW; if (m >= M) break; const int* ri = rinfo + (F.wave * 8 + k) * 8; int* rt = ROUTE + (size_t)m * 8;
            rt[0] = ri[0]; rt[1] = ri[1]; rt[2] = ri[2] + lbase[ri[0]]; rt[3] = ri[3] + lbase[ri[1]]; rt[4] = ri[4]; rt[5] = ri[5]; }
    }
    SEAM(15);
    if (IN(16)) {
        unsigned ts[9]; ts[0] = 0;
#pragma unroll
        for (int e = 0; e < 8; ++e) ts[e + 1] = ts[e] + (__hip_atomic_load(ctl + CW_CNT + e, __ATOMIC_RELAXED, __HIP_MEMORY_SCOPE_AGENT) + 255u) / 256u;
        if (blockIdx.x == 0 && F.tid < 9) { unsigned v = ts[0];
#pragma unroll
            for (int e = 1; e < 9; ++e) v = (F.tid == e) ? ts[e] : v;
            ctl[CW_TS + F.tid] = v; }
        for (int m = F.gw; m < M; m += F.NGW) { const int* rt = ROUTE + (size_t)m * 8; const int e1 = rt[0], e2 = rt[1]; unsigned t1 = 0, t2 = 0;
#pragma unroll
            for (int e = 0; e < 8; ++e) { t1 = (e == e1) ? ts[e] : t1; t2 = (e == e2) ? ts[e] : t2; }
            const size_t d1 = (size_t)t1 * 256 + rt[2], d2 = (size_t)t2 * 256 + rt[3];
            const v4u* src = (const v4u*)(H + (size_t)m * D) + F.lane;
            v2u* o1 = (v2u*)((unsigned char*)XB + d1 * D) + F.lane; v2u* o2 = (v2u*)((unsigned char*)XB + d2 * D) + F.lane;
#pragma unroll
            for (int j = 0; j < 4; ++j) { const v4u w = src[64 * j]; v2u q; q.x = pk4_fp8(bflo(w.x), bfhi(w.x), bflo(w.y), bfhi(w.y)); q.y = pk4_fp8(bflo(w.z), bfhi(w.z), bflo(w.w), bfhi(w.w)); o1[64 * j] = q; o2[64 * j] = q; } }
    }
    SEAM(16);
    if (IN(17)) { pg8::Gemm g{XB, W_MGU, D / 2, D / 2, D / 2}; pg8::GroupedOrder So; So.init(ctl + CW_TS, 2 * FFE / 256, F.G, (int)blockIdx.x); pg8::EpiSwiGLU8 E{(unsigned char*)ACTB, FFE, 1.0f / MOE_WSCALE, MOE_ASCALE};
        pg8::gemm_phase<pg8::EpiSwiGLU8, pg8::GroupedOrder, PG_ALIGN, PG_SP2, true, true>(ring, g, So, E); }
    SEAM(17);
    if (IN(18)) { pg8::Gemm g{ACTB, W_MDN, FFE / 2, FFE / 2, FFE / 2}; pg8::GroupedOrder So; So.init(ctl + CW_TS, D / 256, F.G, (int)blockIdx.x); pg8::EpiBf16S E{YB, D, 1.0f / (MOE_WSCALE * MOE_ASCALE)};
        pg8::gemm_phase<pg8::EpiBf16S, pg8::GroupedOrder, PG_ALIGN, PG_SP2, true, true>(ring, g, So, E); }
    SEAM(18);
    if (IN(19)) {
        unsigned ts[9]; ts[0] = 0;
#pragma unroll
        for (int e = 0; e < 8; ++e) ts[e + 1] = ctl[CW_TS + e + 1];
#pragma unroll
        for (int b = 0; b < NB; ++b) {
            const float* gf = MOD + 4 * 12288 + (size_t)b * 6 * D + 5 * D;
            const int m0 = b * S + F.gw, m1 = m0 + F.NGW;
            const int* rt0 = ROUTE + (size_t)m0 * 8; const int* rt1 = ROUTE + (size_t)m1 * 8;
            const int e10 = rt0[0], e20 = rt0[1], r10 = rt0[2], r20 = rt0[3], e11 = rt1[0], e21 = rt1[1], r11 = rt1[2], r21 = rt1[3];
            const float g10 = __int_as_float(rt0[4]), g20 = __int_as_float(rt0[5]), g11 = __int_as_float(rt1[4]), g21 = __int_as_float(rt1[5]);
            unsigned t10 = 0, t20 = 0, t11 = 0, t21 = 0;
#pragma unroll
            for (int e = 0; e < 8; ++e) { t10 = (e == e10) ? ts[e] : t10; t20 = (e == e20) ? ts[e] : t20; t11 = (e == e11) ? ts[e] : t11; t21 = (e == e21) ? ts[e] : t21; }
            const v2u* ya0 = (const v2u*)(YB + ((size_t)t10 * 256 + r10) * D) + F.lane; const v2u* yb0 = (const v2u*)(YB + ((size_t)t20 * 256 + r20) * D) + F.lane;
            const v2u* ya1 = (const v2u*)(YB + ((size_t)t11 * 256 + r11) * D) + F.lane; const v2u* yb1 = (const v2u*)(YB + ((size_t)t21 * 256 + r21) * D) + F.lane;
            const f32x4* x0 = (const f32x4*)(X + (size_t)m0 * D) + F.lane; const f32x4* x1 = (const f32x4*)(X + (size_t)m1 * D) + F.lane;
            f32x4 v0[8], v1[8]; v2u a0[8], c0[8], a1[8], c1[8];
#pragma unroll
            for (int j = 0; j < 8; ++j) { v0[j] = x0[64 * j]; v1[j] = x1[64 * j]; a0[j] = ya0[64 * j]; c0[j] = yb0[64 * j]; a1[j] = ya1[64 * j]; c1[j] = yb1[64 * j]; }
            float q0 = 0.f, q1 = 0.f;
#pragma unroll
            for (int j = 0; j < 8; ++j) { const f32x4 gg = ((const f32x4*)gf)[F.lane + 64 * j]; f32x4 y;
                y.x = g10 * bflo(a0[j].x) + g20 * bflo(c0[j].x); y.y = g10 * bfhi(a0[j].x) + g20 * bfhi(c0[j].x); y.z = g10 * bflo(a0[j].y) + g20 * bflo(c0[j].y); y.w = g10 * bfhi(a0[j].y) + g20 * bfhi(c0[j].y);
                v0[j] = v0[j] + gg * y; q0 += (v0[j].x * v0[j].x + v0[j].y * v0[j].y) + (v0[j].z * v0[j].z + v0[j].w * v0[j].w);
                y.x = g11 * bflo(a1[j].x) + g21 * bflo(c1[j].x); y.y = g11 * bfhi(a1[j].x) + g21 * bfhi(c1[j].x); y.z = g11 * bflo(a1[j].y) + g21 * bflo(c1[j].y); y.w = g11 * bfhi(a1[j].y) + g21 * bfhi(c1[j].y);
                v1[j] = v1[j] + gg * y; q1 += (v1[j].x * v1[j].x + v1[j].y * v1[j].y) + (v1[j].z * v1[j].z + v1[j].w * v1[j].w); }
            const float ri0 = 1.0f / sqrtf(wave_sum(q0) * (1.f / D) + RMS_EPS), ri1 = 1.0f / sqrtf(wave_sum(q1) * (1.f / D) + RMS_EPS);
            f32x4* o0 = (f32x4*)(args.out + (size_t)m0 * D) + F.lane; f32x4* o1 = (f32x4*)(args.out + (size_t)m1 * D) + F.lane;
#pragma unroll
            for (int j = 0; j < 8; ++j) { const f32x4 fg = ((const f32x4*)final_g)[F.lane + 64 * j]; o0[64 * j] = (v0[j] * ri0) * fg; o1[64 * j] = (v1[j] * ri1) * fg; }
        }
    }
#undef IN
#undef SEAM
}

constexpr int N_PHASES = 20;
extern "C" void kernel_launch(void* const* d_in, const int* in_sizes, int n_in, void* d_out, int out_size, void* d_ws, size_t ws_size, hipStream_t stream) {
    static int grid = 0;
    if (grid == 0) {
        if (n_in != 30 || in_sizes[0] != M * D || out_size != M * D || ws_size < WS_END) { fprintf(stderr, "kernel_launch: shape/workspace mismatch: n_in %d in0 %d out %d ws %zu (need %zu)\n", n_in, n_in > 0 ? in_sizes[0] : -1, out_size, ws_size, (size_t)WS_END); grid = -1; return; }
        int dev = 0, cus = 0, per_cu = 0;
        if (hipGetDevice(&dev) != hipSuccess || hipDeviceGetAttribute(&cus, hipDeviceAttributeMultiprocessorCount, dev) != hipSuccess) { grid = -1; return; }
        if (hipFuncSetAttribute((const void*)fwd, hipFuncAttributeMaxDynamicSharedMemorySize, LDS_BYTES) != hipSuccess) { fprintf(stderr, "kernel_launch: hipFuncSetAttribute failed\n"); grid = -1; return; }
        if (hipOccupancyMaxActiveBlocksPerMultiprocessor(&per_cu, (const void*)fwd, NWAVES * 64, LDS_BYTES) != hipSuccess || per_cu < 1) fprintf(stderr, "kernel_launch: occupancy query reports %d\n", per_cu);
        (void)hipGetLastError();
        grid = cus;
        if (grid != 256) { fprintf(stderr, "kernel_launch: built for a 256-CU device (got %d)\n", cus); grid = -1; return; }
    }
    if (grid < 0) return;
    if (hipMemsetAsync((char*)d_ws + WS_CTL, 0, CTL_ZERO_BYTES, stream) != hipSuccess) return;
    Args a{};
    for (int i = 0; i < 30; ++i) a.in[i] = d_in[i];
    a.out = (float*)d_out; a.ws = (unsigned char*)d_ws;
    if (MK_N_LAUNCHES == 1) { a.ph_lo = 0; a.ph_hi = N_PHASES; hipLaunchKernelGGL(fwd, dim3(grid), dim3(NWAVES * 64), LDS_BYTES, stream, a); }
    else { for (int p = 0; p < N_PHASES; ++p) { a.ph_lo = p; a.ph_hi = p + 1; hipLaunchKernelGGL(fwd, dim3(grid), dim3(NWAVES * 64), LDS_BYTES, stream, a); } }
    const hipError_t le = hipPeekAtLastError();
    if (le != hipSuccess) fprintf(stderr, "kernel_launch: launch failed: %s\n", hipGetErrorName(le));
}
```

```cpp
#include <hip/hip_runtime.h>
#include <cstdio>
#include <cstdint>

#define WGM_G 8
#define PG_ALIGN true
#define PG_SP2 true
#ifndef MK_N_LAUNCHES
#define MK_N_LAUNCHES 1
#endif

namespace pg8 {
#define PG8_LAS __attribute__((address_space(3)))
typedef unsigned short bf16_t;
typedef short bf16x8 __attribute__((ext_vector_type(8)));
typedef float f32x4 __attribute__((ext_vector_type(4)));
typedef float f32x2 __attribute__((ext_vector_type(2)));
typedef unsigned u32x4 __attribute__((ext_vector_type(4)));
typedef unsigned u32x2 __attribute__((ext_vector_type(2)));
constexpr int BM = 256, BK = 64, HALF = 128, HTB = HALF * BK * 2  , STAGE_BYTES = 8 * HTB, NXCD = 8, WGM = 8;

__host__ __device__ __forceinline__ int lds_byte(int r, int c) { const int st = (r >> 4) * 2 + (c >> 5), rr = r & 15, cc = c & 31, ob = rr * 64 + cc * 2; return st * 1024 + (ob ^ (((ob >> 9) & 1) << 5)); }
__host__ __device__ __forceinline__ void stage_rc(int b, int& R, int& C) { const int st = b / 1024, sb = b % 1024, swz = sb ^ (((sb >> 9) & 1) << 5); R = (st >> 1) * 16 + swz / 64; C = (st & 1) * 32 + (swz % 64) / 2; }
__host__ __device__ __forceinline__ int perm32(int rho) { const int n = rho >> 4, i = rho & 15; return 8 * (i >> 2) + 4 * n + (i & 3); }

struct Unit { int pm, pn, pb; };
struct Gemm { const bf16_t* A; const bf16_t* Bt; int lda, ldb, K; };

struct StaticOrder {
    int nM, nN, nwg, G, c;
    __host__ __device__ void init(int M, int N, int G_, int c_) { nM = M / BM; nN = N / BM; nwg = nM * nN; G = G_; c = c_; }
    __host__ __device__ bool next(int i, Unit& u) const {
        const long L = (long)i * G + c; if (L >= nwg) return false;
        int wgid = (int)L; { const int q = nwg / NXCD, r = nwg % NXCD, xcd = wgid % NXCD, off = wgid / NXCD; wgid = (xcd < r ? xcd * (q + 1) : r * (q + 1) + (xcd - r) * q) + off; }
        const int nig = WGM * nN, gid = wgid / nig, fm = gid * WGM, gsz = (nM - fm) < WGM ? (nM - fm) : WGM;
        u.pm = fm + ((wgid % nig) % gsz); u.pn = (wgid % nig) / gsz; u.pb = u.pn; return true;
    }
    __device__ __forceinline__ void a_ready(const Unit&) const {}
    __device__ __forceinline__ void done(const Unit&) const {}
};
#ifndef WGM_G
#endif
struct GroupedOrder {
    int nN, G, c; int ts[9];
    __device__ __forceinline__ void init(const unsigned* tstart, int nN_, int G_, int c_) { nN = nN_; G = G_; c = c_;
#pragma unroll
        for (int e = 0; e < 9; ++e) ts[e] = (int)tstart[e]; }
    __device__ __forceinline__ bool next(int i, Unit& u) const {
        const long L = (long)i * G + c; if (L >= (long)ts[8] * nN) return false;
        int e = 0, us = 0, te = ts[1] - ts[0], t0 = ts[0];
#pragma unroll
        for (int k = 1; k < 8; ++k) { const int s = ts[k] * nN; if (L >= s) { e = k; us = s; te = ts[k + 1] - ts[k]; t0 = ts[k]; } }
        if (te <= 0) return false;
        int wgid = (int)L - us; { const int nwg = te * nN, q = nwg / NXCD, rr = nwg % NXCD, xcd = wgid % NXCD, off = wgid / NXCD; wgid = (xcd < rr ? xcd * (q + 1) : rr * (q + 1) + (xcd - rr) * q) + off; }
        const int nig = WGM_G * nN, gid = wgid / nig, fm = gid * WGM_G, gsz = (te - fm) < WGM_G ? (te - fm) : WGM_G;
        u.pm = t0 + fm + ((wgid % nig) % gsz); u.pn = (wgid % nig) / gsz; u.pb = e * nN + u.pn; return true;
    }
    __device__ __forceinline__ void a_ready(const Unit&) const {}
    __device__ __forceinline__ void done(const Unit&) const {}
};

typedef __bf16 bf16x2c __attribute__((ext_vector_type(2)));
__device__ __forceinline__ unsigned cvt_pk_bf16(float lo, float hi) { const f32x2 v = {lo, hi}; return __builtin_bit_cast(unsigned, __builtin_convertvector(v, bf16x2c)); }

struct EpiBf16 {
    static constexpr bool PERM = true, AFTER_DRAIN = false;
    bf16_t* O; int ldc; const float* rowscale;
    __device__ __forceinline__ void operator()(const f32x4 (&acc)[2][2][4][2], const Unit& u, int wr, int wc, int fr, int fq) const {
        const int row0 = u.pm * BM + wr * 64 + fr; const int col0 = u.pn * BM + wc * 32 + 8 * fq;
#pragma unroll
        for (int ai = 0; ai < 2; ++ai)
#pragma unroll
            for (int m = 0; m < 4; ++m) { const int row = row0 + ai * HALF + m * 16; bf16_t* rowp = O + (size_t)row * ldc + col0; const float sc = rowscale ? rowscale[row] : 1.f;
#pragma unroll
                for (int bj = 0; bj < 2; ++bj) { f32x4 v0 = acc[ai][bj][m][0] * sc, v1 = acc[ai][bj][m][1] * sc;
                    u32x4 w; w.x = cvt_pk_bf16(v0[0], v0[1]); w.y = cvt_pk_bf16(v0[2], v0[3]); w.z = cvt_pk_bf16(v1[0], v1[1]); w.w = cvt_pk_bf16(v1[2], v1[3]);
                    *(u32x4*)(rowp + bj * HALF) = w; } }
    }
};
struct EpiResid {
    static constexpr bool PERM = false, AFTER_DRAIN = false;
    const float* xin; float* xout; int ldc; const float* gate; int gstride; int tiles_per_b;
    __device__ __forceinline__ void operator()(const f32x4 (&acc)[2][2][4][2], const Unit& u, int wr, int wc, int fr, int fq) const {
        const int row0 = u.pm * BM + wr * 64 + fr, col0 = u.pn * BM + wc * 32 + 4 * fq;
        const float* gp = gate + (size_t)(u.pm / tiles_per_b) * gstride + col0;
        f32x4 gv[2][2];
#pragma unroll
        for (int bj = 0; bj < 2; ++bj)
#pragma unroll
            for (int n = 0; n < 2; ++n) gv[bj][n] = *(const f32x4*)(gp + bj * HALF + n * 16);
#pragma unroll
        for (int ai = 0; ai < 2; ++ai)
#pragma unroll
            for (int m = 0; m < 4; ++m) { const size_t off = (size_t)(row0 + ai * HALF + m * 16) * ldc + col0;
#pragma unroll
                for (int bj = 0; bj < 2; ++bj)
#pragma unroll
                    for (int n = 0; n < 2; ++n) { const f32x4 xi = *(const f32x4*)(xin + off + bj * HALF + n * 16);
                        *(f32x4*)(xout + off + bj * HALF + n * 16) = xi + gv[bj][n] * acc[ai][bj][m][n]; }
                asm volatile("" ::: "memory"); }
    }
};
__device__ __forceinline__ float silu_f(float g) { return g * __builtin_amdgcn_rcpf(1.0f + __builtin_amdgcn_exp2f(-1.4426950408889634f * g)); }
struct EpiSwiGLU {
    static constexpr bool PERM = false, AFTER_DRAIN = false;
    bf16_t* O; int ldo;
    __device__ __forceinline__ void operator()(const f32x4 (&acc)[2][2][4][2], const Unit& u, int wr, int wc, int fr, int fq) const {
        const int row0 = u.pm * BM + wr * 64 + fr, col0 = u.pn * HALF + wc * 16 + 4 * fq;
#pragma unroll
        for (int ai = 0; ai < 2; ++ai)
#pragma unroll
            for (int m = 0; m < 4; ++m) { bf16_t* rowp = O + (size_t)(row0 + ai * HALF + m * 16) * ldo + col0;
#pragma unroll
                for (int bj = 0; bj < 2; ++bj) { const f32x4 g = acc[ai][bj][m][0], up = acc[ai][bj][m][1];
                    u32x2 w; w.x = cvt_pk_bf16(silu_f(g[0]) * up[0], silu_f(g[1]) * up[1]); w.y = cvt_pk_bf16(silu_f(g[2]) * up[2], silu_f(g[3]) * up[3]);
                    *(u32x2*)(rowp + bj * 64) = w; } }
    }
};
struct EpiSwiGLU8 {
    static constexpr bool PERM = false, AFTER_DRAIN = false;
    unsigned char* O8; int ldo; float s, so;
    __device__ __forceinline__ void operator()(const f32x4 (&acc)[2][2][4][2], const Unit& u, int wr, int wc, int fr, int fq) const {
        const int row0 = u.pm * BM + wr * 64 + fr, col0 = u.pn * HALF + wc * 16 + 4 * fq;
#pragma unroll
        for (int ai = 0; ai < 2; ++ai)
#pragma unroll
            for (int m = 0; m < 4; ++m) { const size_t off = (size_t)(row0 + ai * HALF + m * 16) * ldo + col0;
#pragma unroll
                for (int bj = 0; bj < 2; ++bj) { const f32x4 g = acc[ai][bj][m][0] * s, up = acc[ai][bj][m][1] * s;
                    const float v0 = silu_f(g[0]) * up[0], v1 = silu_f(g[1]) * up[1], v2 = silu_f(g[2]) * up[2], v3 = silu_f(g[3]) * up[3];
                    int w = 0; w = __builtin_amdgcn_cvt_pk_fp8_f32(__builtin_amdgcn_fmed3f(v0 * so, -440.f, 440.f), __builtin_amdgcn_fmed3f(v1 * so, -440.f, 440.f), w, false);
                    w = __builtin_amdgcn_cvt_pk_fp8_f32(__builtin_amdgcn_fmed3f(v2 * so, -440.f, 440.f), __builtin_amdgcn_fmed3f(v3 * so, -440.f, 440.f), w, true); *(int*)(O8 + off + bj * 64) = w; } }
    }
};
struct EpiBf16S {
    static constexpr bool PERM = true, AFTER_DRAIN = false;
    bf16_t* O; int ldc; float s;
    __device__ __forceinline__ void operator()(const f32x4 (&acc)[2][2][4][2], const Unit& u, int wr, int wc, int fr, int fq) const {
        const int row0 = u.pm * BM + wr * 64 + fr; const int col0 = u.pn * BM + wc * 32 + 8 * fq;
#pragma unroll
        for (int ai = 0; ai < 2; ++ai)
#pragma unroll
            for (int m = 0; m < 4; ++m) { bf16_t* rowp = O + (size_t)(row0 + ai * HALF + m * 16) * ldc + col0;
#pragma unroll
                for (int bj = 0; bj < 2; ++bj) { const f32x4 v0 = acc[ai][bj][m][0] * s, v1 = acc[ai][bj][m][1] * s;
                    u32x4 w; w.x = cvt_pk_bf16(v0[0], v0[1]); w.y = cvt_pk_bf16(v0[2], v0[3]); w.z = cvt_pk_bf16(v1[0], v1[1]); w.w = cvt_pk_bf16(v1[2], v1[3]);
                    *(u32x4*)(rowp + bj * HALF) = w; } }
    }
};

template <class Epi, class Sched, bool ALIGN_EPI = false, bool SP2 = false, bool F8 = false, bool FW = false>
__device__ __forceinline__ void gemm_phase(PG8_LAS unsigned char* lds, const Gemm g, const Sched& S, const Epi& E) {
    const int tid = threadIdx.x, wid = __builtin_amdgcn_readfirstlane(tid >> 6), lane = tid & 63, wr = wid >> 2, wc = wid & 3, fr = lane & 15, fq = lane >> 4;
    const int K = g.K, nt = K / BK;
    unsigned voffA[2], voffB[2];
#pragma unroll
    for (int i = 0; i < 2; ++i) { int R, C; stage_rc(tid * 16 + i * 8192, R, C); const int Rb = Epi::PERM ? ((R & ~31) + perm32(R & 31)) : R;
        voffA[i] = (unsigned)(R * g.lda + C) * 2u; voffB[i] = (unsigned)(Rb * g.ldb + C) * 2u; }
    const size_t kstep = (size_t)(BK * 2);
    const size_t hstepA = (size_t)HALF * g.lda * 2, hstepB = (size_t)HALF * g.ldb * 2;
    const size_t tstepA = 2 * hstepA, tstepB = (F8 && !FW) ? hstepB : 2 * hstepB;
    const unsigned ldsw = (unsigned)wid * 1024u;
    const int aoff = lds_byte(wr * 64 + fr, fq * 8), boff = lds_byte(wc * 32 + fr, fq * 8);
#define PG8_SA(b, h) (((b) * 2 + (h)) * HTB)
#define PG8_SB(b, h) ((4 + (b) * 2 + (h)) * HTB)
#define PG8_STAGE(bufoff, gbase, voff) do { _Pragma("unroll") for (int _i = 0; _i < 2; ++_i) \
        __builtin_amdgcn_global_load_lds((const unsigned*)((const char*)(gbase) + (voff)[_i]), (PG8_LAS unsigned*)(lds + (bufoff) + ldsw + _i * 8192), 16, 0, 0); } while (0)
#define PG8_LDA(dst, b, h) do { _Pragma("unroll") for (int m = 0; m < 4; ++m) _Pragma("unroll") for (int k = 0; k < 2; ++k) dst[m][k] = *(const PG8_LAS bf16x8*)(lds + PG8_SA(b, h) + aoff + m * 2048 + k * 1024); } while (0)
#define PG8_LDB(dst, b, h) do { if constexpr (!F8 || FW || (h) == 0) { _Pragma("unroll") for (int n = 0; n < 2; ++n) _Pragma("unroll") for (int k = 0; k < 2; ++k) dst[n][k] = *(const PG8_LAS bf16x8*)(lds + PG8_SB(b, h) + boff + n * 2048 + k * 1024); } } while (0)
#define PG8_CAT(x, y) __builtin_shufflevector(x, y, 0, 1, 2, 3, 4, 5, 6, 7, 8, 9, 10, 11, 12, 13, 14, 15)
#define PG8_MMA(ai, bj, At, Bt) do { if constexpr (!F8 || FW || (bj) == 0) { __builtin_amdgcn_s_setprio(1); \
        if constexpr (F8) { _Pragma("unroll") for (int m = 0; m < 4; ++m) _Pragma("unroll") for (int n = 0; n < 2; ++n) \
            { const v8i_ b8_ = __builtin_bit_cast(v8i_, PG8_CAT(Bt[n][0], Bt[n][1])), a8_ = __builtin_bit_cast(v8i_, PG8_CAT(At[m][0], At[m][1])); \
            if constexpr (FW) asm volatile("v_mfma_scale_f32_16x16x128_f8f6f4 %0, %1, %2, %0, %3, %3 op_sel_hi:[0,0,0]" : "+v"(acc[ai][bj][m][n]) : "v"(b8_), "v"(a8_), "v"(0x7f7f7f7f)); \
            else acc[ai][bj][m][n] = __builtin_amdgcn_mfma_scale_f32_16x16x128_f8f6f4(b8_, a8_, acc[ai][bj][m][n], 0, 0, 0, 0x7f7f7f7f, 0, 0x7f7f7f7f); } } \
        else { _Pragma("unroll") for (int m = 0; m < 4; ++m) _Pragma("unroll") for (int n = 0; n < 2; ++n) _Pragma("unroll") for (int k = 0; k < 2; ++k) \
            acc[ai][bj][m][n] = __builtin_amdgcn_mfma_f32_16x16x32_bf16(Bt[n][k], At[m][k], acc[ai][bj][m][n], 0, 0, 0); } \
        __builtin_amdgcn_s_setprio(0); } } while (0)
#define PG8_WAIT_V(n) asm volatile("s_waitcnt vmcnt(" #n ")" ::: "memory")
#define PG8_WAIT_L(n) asm volatile("s_waitcnt lgkmcnt(" #n ")" ::: "memory")
#define PG8_BAR __builtin_amdgcn_s_barrier()
#define PG8_SCHED __builtin_amdgcn_sched_barrier(0)
    Unit cur, nxt; int ui = 0;
    if (!S.next(0, cur)) return;
    f32x4 acc[2][2][4][2];
#pragma unroll
    for (int a = 0; a < 2; ++a)
#pragma unroll
        for (int b = 0; b < 2; ++b)
#pragma unroll
            for (int m = 0; m < 4; ++m)
#pragma unroll
                for (int n = 0; n < 2; ++n) acc[a][b][m][n] = (f32x4){0.f, 0.f, 0.f, 0.f};
    bf16x8 At[4][2], B0[2][2], B1[2][2];
    typedef int v8i_ __attribute__((ext_vector_type(8))); typedef short bf16x16_ __attribute__((ext_vector_type(16)));
    const char* cA = (const char*)g.A + (size_t)cur.pm * tstepA; const char* cB = (const char*)g.Bt + (size_t)cur.pb * tstepB;
    S.a_ready(cur);
    if constexpr (SP2) {
        PG8_STAGE(PG8_SB(0, 0), cB, voffB); if constexpr (!F8 || FW) PG8_STAGE(PG8_SB(0, 1), cB + hstepB, voffB); PG8_STAGE(PG8_SA(0, 0), cA, voffA); PG8_STAGE(PG8_SA(0, 1), cA + hstepA, voffA);
        if (wr == 1) PG8_BAR;
        PG8_WAIT_V(2); PG8_BAR;
        PG8_STAGE(PG8_SB(1, 0), cB + kstep, voffB); PG8_STAGE(PG8_SA(1, 0), cA + kstep, voffA); if constexpr (!F8 || FW) PG8_STAGE(PG8_SB(1, 1), cB + hstepB + kstep, voffB);
        if constexpr (F8 && !FW) PG8_WAIT_V(4); else PG8_WAIT_V(6); PG8_BAR;
    } else {
        PG8_STAGE(PG8_SB(0, 0), cB, voffB); PG8_STAGE(PG8_SA(0, 0), cA, voffA); PG8_STAGE(PG8_SB(0, 1), cB + hstepB, voffB); PG8_STAGE(PG8_SA(0, 1), cA + hstepA, voffA);
        if (wr == 1) PG8_BAR;
        PG8_WAIT_V(4); PG8_BAR;
        PG8_STAGE(PG8_SB(1, 0), cB + kstep, voffB); PG8_STAGE(PG8_SA(1, 0), cA + kstep, voffA); PG8_STAGE(PG8_SB(1, 1), cB + hstepB + kstep, voffB);
        PG8_WAIT_V(6); PG8_BAR;
    }
    for (;;) {
        const bool has_next = S.next(ui + 1, nxt);
        const char* nA = has_next ? (const char*)g.A + (size_t)nxt.pm * tstepA : cA; const char* nB = has_next ? (const char*)g.Bt + (size_t)nxt.pb * tstepB : cB;
        for (int t = 0; t < nt; t += 2) {
            const bool last = (t == nt - 2);
            const char* a1 = cA + (size_t)(t + 1) * kstep;
            const char* a2 = last ? nA : cA + (size_t)(t + 2) * kstep; const char* b2 = last ? nB : cB + (size_t)(t + 2) * kstep;
            const char* a3 = a2 + kstep; const char* b3 = b2 + kstep;
            if (last && has_next) S.a_ready(nxt);
            if constexpr (SP2) {
            PG8_LDB(B0, 0, 0); PG8_LDB(B1, 0, 1); PG8_SCHED; PG8_LDA(At, 0, 0); PG8_STAGE(PG8_SA(1, 1), a1 + hstepA, voffA);
            if constexpr (F8 && !FW) PG8_WAIT_V(6); else PG8_WAIT_V(8); PG8_WAIT_L(0); PG8_BAR; PG8_MMA(0, 0, At, B0); PG8_MMA(0, 1, At, B1); PG8_BAR; PG8_SCHED;
            PG8_LDA(At, 0, 1); PG8_STAGE(PG8_SB(0, 0), b2, voffB); if constexpr (!F8 || FW) PG8_STAGE(PG8_SB(0, 1), b2 + hstepB, voffB); PG8_STAGE(PG8_SA(0, 0), a2, voffA);
            if constexpr (F8 && !FW) PG8_WAIT_V(6); else PG8_WAIT_V(8); PG8_WAIT_L(0); PG8_BAR; PG8_MMA(1, 0, At, B0); PG8_MMA(1, 1, At, B1); PG8_BAR; PG8_SCHED;
            PG8_LDB(B0, 1, 0); PG8_LDB(B1, 1, 1); PG8_SCHED; PG8_LDA(At, 1, 0); PG8_STAGE(PG8_SA(0, 1), a2 + hstepA, voffA);
            if constexpr (F8 && !FW) PG8_WAIT_V(6); else PG8_WAIT_V(8); PG8_WAIT_L(0); PG8_BAR; PG8_MMA(0, 0, At, B0); PG8_MMA(0, 1, At, B1); PG8_BAR; PG8_SCHED;
            PG8_LDA(At, 1, 1); PG8_STAGE(PG8_SB(1, 0), b3, voffB); if constexpr (!F8 || FW) PG8_STAGE(PG8_SB(1, 1), b3 + hstepB, voffB); PG8_STAGE(PG8_SA(1, 0), a3, voffA);
            if constexpr (F8 && !FW) PG8_WAIT_V(6); else PG8_WAIT_V(8); PG8_WAIT_L(0); PG8_BAR; PG8_MMA(1, 0, At, B0); PG8_MMA(1, 1, At, B1); PG8_BAR; PG8_SCHED;
            } else {
            PG8_LDB(B0, 0, 0); PG8_SCHED; PG8_LDA(At, 0, 0); PG8_STAGE(PG8_SA(1, 1), a1 + hstepA, voffA);
            PG8_WAIT_L(8); PG8_BAR; PG8_WAIT_L(0); PG8_MMA(0, 0, At, B0); PG8_BAR; PG8_SCHED;
            PG8_LDB(B1, 0, 1); PG8_STAGE(PG8_SB(0, 0), b2, voffB);
            PG8_BAR; PG8_WAIT_L(0); PG8_MMA(0, 1, At, B1); PG8_BAR;
            PG8_LDA(At, 0, 1); PG8_STAGE(PG8_SA(0, 0), a2, voffA);
            PG8_BAR; PG8_WAIT_L(0); PG8_MMA(1, 0, At, B0); PG8_BAR; PG8_SCHED;
            PG8_STAGE(PG8_SB(0, 1), b2 + hstepB, voffB);
            PG8_WAIT_V(6); PG8_BAR; PG8_MMA(1, 1, At, B1); PG8_BAR;
            PG8_LDB(B0, 1, 0); PG8_SCHED; PG8_LDA(At, 1, 0); PG8_STAGE(PG8_SA(0, 1), a2 + hstepA, voffA);
            PG8_WAIT_L(8); PG8_BAR; PG8_WAIT_L(0); PG8_MMA(0, 0, At, B0); PG8_BAR; PG8_SCHED;
            PG8_LDB(B1, 1, 1); PG8_STAGE(PG8_SB(1, 0), b3, voffB);
            PG8_BAR; PG8_WAIT_L(0); PG8_MMA(0, 1, At, B1); PG8_BAR;
            PG8_LDA(At, 1, 1); PG8_STAGE(PG8_SA(1, 0), a3, voffA);
            PG8_BAR; PG8_WAIT_L(0); PG8_MMA(1, 0, At, B0); PG8_BAR; PG8_SCHED;
            PG8_STAGE(PG8_SB(1, 1), b3 + hstepB, voffB);
            PG8_WAIT_V(6); PG8_BAR; PG8_MMA(1, 1, At, B1); PG8_BAR;
            }
        }
        if constexpr (ALIGN_EPI) { if (wr == 0) PG8_BAR; }
        if constexpr (F8 && FW) asm volatile("s_nop 15\n\ts_nop 15" ::: "memory");
        if constexpr (!Epi::AFTER_DRAIN) { E(acc, cur, wr, wc, fr, fq); S.done(cur); }
        if (!has_next) break;
#pragma unroll
        for (int a = 0; a < 2; ++a)
#pragma unroll
            for (int b = 0; b < 2; ++b)
#pragma unroll
                for (int m = 0; m < 4; ++m)
#pragma unroll
                    for (int n = 0; n < 2; ++n) acc[a][b][m][n] = (f32x4){0.f, 0.f, 0.f, 0.f};
        cur = nxt; cA = nA; cB = nB; ++ui;
        if constexpr (ALIGN_EPI) { if (wr == 1) PG8_BAR; }
    }
    PG8_WAIT_V(0);
    if constexpr (!ALIGN_EPI) { if (wr == 0) PG8_BAR; }
    PG8_BAR;
    if constexpr (Epi::AFTER_DRAIN) { E.fused(acc, cur, wr, wc, fr, fq, lds, wid, lane); S.done(cur); }
#undef PG8_SA
#undef PG8_SB
#undef PG8_STAGE
#undef PG8_CAT
#undef PG8_LDA
#undef PG8_LDB
#undef PG8_MMA
#undef PG8_WAIT_V
#undef PG8_WAIT_L
#undef PG8_BAR
#undef PG8_SCHED
}

}

namespace fa {
#define FA_LAS __attribute__((address_space(3)))
typedef unsigned short bf16;
typedef short bf16x8 __attribute__((ext_vector_type(8)));
typedef short s16x4 __attribute__((ext_vector_type(4)));
typedef float f32x16 __attribute__((ext_vector_type(16)));
typedef float f32x4 __attribute__((ext_vector_type(4)));
typedef unsigned u32x4 __attribute__((ext_vector_type(4)));
constexpr int QB = 256, QBLK = 32, KVBLK = 64;
constexpr int SHM_K = 16384, SHM_V = 16384, SHM_K2 = 8192;
constexpr int OFF_V = 0, OFF_K = 2 * SHM_V, OFF_K2 = OFF_K + 2 * SHM_K, OFF_WS = OFF_K2 + 2 * SHM_K2, WS_PER_WAVE = 1024, OFF_TAB = OFF_WS + 8 * WS_PER_WAVE;
constexpr int TAB_PAD = 320, TAB_MAX = 4096 + TAB_PAD;
constexpr int LDS_END = OFF_TAB + TAB_MAX * 4;
constexpr int OSTG = 272;
static_assert(LDS_END <= 131072 && 8 * 32 * OSTG <= OFF_WS, "attention LDS map");
#define KSWZ(row, colB) ((row) * 256 + ((colB) ^ (((row) & 7) << 4)))
#define K2SWZ(row, colB) ((row) * 128 + ((colB) ^ (((row) & 7) << 4)))
#define SBAR() __builtin_amdgcn_sched_barrier(0)
__device__ __forceinline__ int v_st(int k, int c) { const int kk = (k & ~0xC) | ((k & 4) << 1) | ((k & 8) >> 1); return ((kk >> 3) * 4 + (c >> 5)) * 512 + ((kk & 7) * 32 + (c & 31)) * 2; }
__device__ __forceinline__ int v_rd_base(int lane) { return ((lane & 3) << 3) | (((lane >> 2) & 3) << 6) | (((lane >> 4) & 1) << 5) | (((lane >> 5) & 1) << 8); }
constexpr int v_rd_off(int d0, int ks, int half) { return d0 * 512 + ks * 4096 + half * 2048; }
__device__ __forceinline__ int crow(int r, int hi) { return (r & 3) + 8 * (r >> 2) + 4 * hi; }
typedef float f32x2c __attribute__((ext_vector_type(2)));
typedef __bf16 bf16x2c __attribute__((ext_vector_type(2)));
__device__ __forceinline__ unsigned cvtpk(float lo, float hi) { const f32x2c v = {lo, hi}; return __builtin_bit_cast(unsigned, __builtin_convertvector(v, bf16x2c)); }

struct Item {
    const bf16* Q; long qs;
    const float* rope; long ropes;
    const bf16* K; long ks; const bf16* K2; long k2s; const bf16* V; long vs;
    int P0, skv, W;
    const float* bias; int bstep;
    const unsigned long long* sel; long sels;
    bf16* O; long os;
    float* LSE; long lses;
    const bf16* M0; const bf16* M1; long ms; const bf16* G; long gs;
};

template <int VAR>
__device__ __forceinline__ void attn_block(const Item& it, unsigned char* lds_g) {
    constexpr bool HAS_BIAS = VAR != 2, HAS_SEL = VAR == 1, HAS_K2 = VAR == 2;
    constexpr float SCALE = HAS_K2 ? 0.07216878364870322f : 0.08838834764831845f, C2 = 1.4426950408889634f * SCALE, THR = 8.f;
    FA_LAS unsigned char* L = (FA_LAS unsigned char*)lds_g;
    const int tid = threadIdx.x, wid = __builtin_amdgcn_readfirstlane(tid >> 6), lane = tid & 63, r32 = lane & 31, hi = lane >> 5;
    const int W = it.W;
    const int j_lo = (it.P0 - W + 1 > 0) ? (it.P0 - W + 1) / KVBLK : 0;
    int j_hi = (it.P0 + QB - 1) / KVBLK + 1; if (j_hi > it.skv / KVBLK) j_hi = it.skv / KVBLK;
    const int NT = j_hi - j_lo;
    const int qlo = it.P0 + wid * QBLK, qm = qlo + r32 - 4 * hi;
    FA_LAS float* wsl = (FA_LAS float*)(L + OFF_WS + wid * WS_PER_WAVE); FA_LAS float* li_l = wsl; FA_LAS float* al_l = wsl + 32;
    FA_LAS float* tab = (FA_LAS float*)(L + OFF_TAB);
    const int sr = tid >> 4, sc = (tid & 15) * 8, vst0 = v_st(sr, sc), vst1 = v_st(32 + sr, sc), kws = KSWZ(sr, sc * 2);
    const int k2r = tid >> 3, k2c = (tid & 7) * 8, k2ws = K2SWZ(k2r, k2c * 2);
    const int vb0 = OFF_V + v_rd_base(lane);
    bf16x8 qr[8]; bf16x8 qr2[4];
    { const bf16* qp = it.Q + (long)(qlo + r32) * it.qs + hi * 8;
#pragma unroll
      for (int d0 = 0; d0 < 8; ++d0) qr[d0] = *(const bf16x8*)(qp + d0 * 16);
      if constexpr (HAS_K2) {
          const float* rp = it.rope + (long)(qlo + r32) * it.ropes + hi * 8;
          bf16x8 raw[4];
#pragma unroll
          for (int d0 = 0; d0 < 4; ++d0) raw[d0] = *(const bf16x8*)(qp + 128 + d0 * 16);
#pragma unroll
          for (int d0 = 0; d0 < 2; ++d0) { const f32x4 c0 = *(const f32x4*)(rp + d0 * 16), c1 = *(const f32x4*)(rp + d0 * 16 + 4), s0 = *(const f32x4*)(rp + 32 + d0 * 16), s1 = *(const f32x4*)(rp + 32 + d0 * 16 + 4);
              float o1[8], o2[8];
#pragma unroll
              for (int j = 0; j < 8; ++j) { const float x1 = __builtin_bit_cast(float, (unsigned)(unsigned short)raw[d0][j] << 16), x2 = __builtin_bit_cast(float, (unsigned)(unsigned short)raw[d0 + 2][j] << 16);
                  const float cs = j < 4 ? c0[j & 3] : c1[j & 3], sn = j < 4 ? s0[j & 3] : s1[j & 3]; o1[j] = x1 * cs - x2 * sn; o2[j] = x2 * cs + x1 * sn; }
              u32x4 w1 = {cvtpk(o1[0], o1[1]), cvtpk(o1[2], o1[3]), cvtpk(o1[4], o1[5]), cvtpk(o1[6], o1[7])}, w2 = {cvtpk(o2[0], o2[1]), cvtpk(o2[2], o2[3]), cvtpk(o2[4], o2[5]), cvtpk(o2[6], o2[7])};
              qr2[d0] = __builtin_bit_cast(bf16x8, w1); qr2[d0 + 2] = __builtin_bit_cast(bf16x8, w2); }
      }
    }
    unsigned long long selm = ~0ull;
    if constexpr (HAS_SEL) selm = __hip_atomic_load(it.sel + (long)(qlo + r32) * it.sels, __ATOMIC_RELAXED, __HIP_MEMORY_SCOPE_AGENT);
    if constexpr (HAS_BIAS) {
        int rmax = W + 320; if (rmax > 4096) rmax = 4096;
        for (int i = tid; i < rmax + TAB_PAD; i += 512) { int r = i - TAB_PAD; r = r < -64 ? -64 : r; long gi = (long)r * it.bstep; gi = gi > 4095 ? 4095 : gi; tab[i] = it.bias[gi] * (1.0f / SCALE); }
    }
    bf16x8 st_k0, st_k1, st_v0, st_v1, st_k2;
#define FA_LOAD(kb_) do { const long r0_ = (long)((kb_) + sr), r1_ = r0_ + 32; \
        st_v0 = *(const bf16x8*)(it.V + r0_ * it.vs + sc); st_v1 = *(const bf16x8*)(it.V + r1_ * it.vs + sc); \
        st_k0 = *(const bf16x8*)(it.K + r0_ * it.ks + sc); st_k1 = *(const bf16x8*)(it.K + r1_ * it.ks + sc); \
        if constexpr (HAS_K2) st_k2 = *(const bf16x8*)(it.K2 + (long)((kb_) + k2r) * it.k2s + k2c); } while (0)
#define FA_WRITE(bf_) do { *(FA_LAS bf16x8*)(L + OFF_V + (bf_) * SHM_V + vst0) = st_v0; *(FA_LAS bf16x8*)(L + OFF_V + (bf_) * SHM_V + vst1) = st_v1; \
        *(FA_LAS bf16x8*)(L + OFF_K + (bf_) * SHM_K + kws) = st_k0; *(FA_LAS bf16x8*)(L + OFF_K + (bf_) * SHM_K + kws + 32 * 256) = st_k1; \
        if constexpr (HAS_K2) *(FA_LAS bf16x8*)(L + OFF_K2 + (bf_) * SHM_K2 + k2ws) = st_k2; } while (0)
    FA_LOAD(j_lo * KVBLK);
    asm volatile("s_waitcnt vmcnt(0)" ::: "memory");
    FA_WRITE(0);
    __syncthreads();
    float m_reg = -1e30f, l_reg = 0.f; f32x16 o[4] = {};
#define FA_KBASE(t) ((j_lo + (t)) * KVBLK)
#define FA_STEP(BUF, t) do { \
        const int kb_ = FA_KBASE(t); \
        if ((t) + 1 < NT) FA_LOAD(FA_KBASE((t) + 1)); \
        bool act_ = (kb_ <= qlo + QBLK - 1) && (kb_ + KVBLK - 1 >= qlo - W + 1); \
        bool allow_ = true; \
        if constexpr (HAS_SEL) { allow_ = (bool)((selm >> (kb_ >> 6)) & 1ull); } \
        if (act_) { \
            f32x16 p0 = {}, p1 = {}; \
            { const int ka_ = OFF_K + (BUF) * SHM_K; \
              _Pragma("unroll") for (int d0 = 0; d0 < 8; ++d0) { \
                const bf16x8 b0 = *(const FA_LAS bf16x8*)(L + ka_ + KSWZ(r32, (d0 * 16 + hi * 8) * 2)); \
                const bf16x8 b1 = *(const FA_LAS bf16x8*)(L + ka_ + 32 * 256 + KSWZ(r32, (d0 * 16 + hi * 8) * 2)); \
                p0 = __builtin_amdgcn_mfma_f32_32x32x16_bf16(b0, qr[d0], p0, 0, 0, 0); p1 = __builtin_amdgcn_mfma_f32_32x32x16_bf16(b1, qr[d0], p1, 0, 0, 0); } \
              if constexpr (HAS_K2) { const int k2a_ = OFF_K2 + (BUF) * SHM_K2; \
                _Pragma("unroll") for (int d0 = 0; d0 < 4; ++d0) { \
                  const bf16x8 b0 = *(const FA_LAS bf16x8*)(L + k2a_ + K2SWZ(r32, (d0 * 16 + hi * 8) * 2)); \
                  const bf16x8 b1 = *(const FA_LAS bf16x8*)(L + k2a_ + 32 * 128 + K2SWZ(r32, (d0 * 16 + hi * 8) * 2)); \
                  p0 = __builtin_amdgcn_mfma_f32_32x32x16_bf16(b0, qr2[d0], p0, 0, 0, 0); p1 = __builtin_amdgcn_mfma_f32_32x32x16_bf16(b1, qr2[d0], p1, 0, 0, 0); } } } \
            const int dq_ = qm - kb_; \
            if constexpr (HAS_BIAS) { const FA_LAS float* tb_ = tab + (TAB_PAD + dq_ - 63); \
                _Pragma("unroll") for (int r = 0; r < 16; ++r) { const int c_ = (r & 3) + 8 * (r >> 2); p0[r] += tb_[63 - c_]; p1[r] += tb_[31 - c_]; } } \
            if (HAS_SEL || kb_ + KVBLK - 1 > qlo || kb_ <= qlo + QBLK - 1 - W) { const float NEG_ = -__builtin_inff(); const int dqm_ = allow_ ? dq_ : -0x40000000; \
                _Pragma("unroll") for (int r = 0; r < 16; ++r) { const int c_ = (r & 3) + 8 * (r >> 2); \
                    if ((unsigned)(dqm_ - c_) >= (unsigned)W) p0[r] = NEG_; if ((unsigned)(dqm_ - c_ - 32) >= (unsigned)W) p1[r] = NEG_; } } \
              \
            float pmax_ = p0[0]; _Pragma("unroll") for (int r = 1; r < 16; ++r) pmax_ = fmaxf(pmax_, p0[r]); _Pragma("unroll") for (int r = 0; r < 16; ++r) pmax_ = fmaxf(pmax_, p1[r]); \
            { auto rr_ = __builtin_amdgcn_permlane32_swap(__float_as_uint(pmax_), __float_as_uint(pmax_), false, false); pmax_ = fmaxf(__uint_as_float(rr_[0]), __uint_as_float(rr_[1])); } \
            float mn_, alpha_; \
            if (__all((pmax_ - m_reg) * SCALE <= THR)) { mn_ = m_reg; alpha_ = 1.f; } \
            else { mn_ = fmaxf(m_reg, pmax_); alpha_ = __builtin_amdgcn_exp2f((m_reg - mn_) * C2); m_reg = mn_; } \
            const float mnL_ = -mn_ * C2; float ps_ = 0.f; \
            _Pragma("unroll") for (int r = 0; r < 16; ++r) { p0[r] = __builtin_amdgcn_exp2f(fmaf(p0[r], C2, mnL_)); p1[r] = __builtin_amdgcn_exp2f(fmaf(p1[r], C2, mnL_)); ps_ += p0[r] + p1[r]; } \
            { auto rr_ = __builtin_amdgcn_permlane32_swap(__float_as_uint(ps_), __float_as_uint(ps_), false, false); ps_ = __uint_as_float(rr_[0]) + __uint_as_float(rr_[1]); } \
            l_reg = l_reg * alpha_ + ps_; \
            bf16x8 pa0, pa1, pa2, pa3; \
            FA_PK4(p0, 0, pa0); FA_PK4(p0, 8, pa1); FA_PK4(p1, 0, pa2); FA_PK4(p1, 8, pa3); \
            if (__any(alpha_ < 1.f)) { if (hi == 0) al_l[r32] = alpha_; asm volatile("s_waitcnt lgkmcnt(0)" ::: "memory"); \
                _Pragma("unroll") for (int d_ = 0; d_ < 4; ++d_) _Pragma("unroll") for (int r = 0; r < 16; ++r) o[d_][r] *= al_l[crow(r, hi)]; } \
            FA_PV_D0(BUF, 0); FA_PV_D0(BUF, 1); FA_PV_D0(BUF, 2); FA_PV_D0(BUF, 3); \
        } \
        if ((t) + 1 < NT) { asm volatile("s_waitcnt vmcnt(0)" ::: "memory"); FA_WRITE(1 - (BUF)); } \
        __syncthreads(); } while (0)
#define FA_PK4(P, B_, OUT) do { unsigned a0 = cvtpk(P[B_+0], P[B_+1]), a1 = cvtpk(P[B_+2], P[B_+3]); unsigned b0 = cvtpk(P[B_+4], P[B_+5]), b1 = cvtpk(P[B_+6], P[B_+7]); \
        auto r0 = __builtin_amdgcn_permlane32_swap(a0, b0, false, false); auto r1 = __builtin_amdgcn_permlane32_swap(a1, b1, false, false); \
        u32x4 w = {r0[0], r1[0], r0[1], r1[1]}; OUT = __builtin_bit_cast(bf16x8, w); } while (0)
#define FA_TRRD(dst, off) asm volatile("ds_read_b64_tr_b16 %0, %1 offset:%2" : "=&v"(dst) : "v"(vb0), "i"(off) : "memory")
#define FA_PV_D0(VB, d0) do { s16x4 l0, l1, l2, l3, h0, h1, h2, h3; constexpr int b_ = (VB) * SHM_V + v_rd_off(d0, 0, 0); \
        FA_TRRD(l0, b_); FA_TRRD(h0, b_ + 2048); FA_TRRD(l1, b_ + 4096); FA_TRRD(h1, b_ + 6144); FA_TRRD(l2, b_ + 8192); FA_TRRD(h2, b_ + 10240); FA_TRRD(l3, b_ + 12288); FA_TRRD(h3, b_ + 14336); \
        asm volatile("s_waitcnt lgkmcnt(0)" ::: "memory"); SBAR(); \
        o[d0] = __builtin_amdgcn_mfma_f32_32x32x16_bf16(pa0, (bf16x8){l0[0], l0[1], l0[2], l0[3], h0[0], h0[1], h0[2], h0[3]}, o[d0], 0, 0, 0); \
        o[d0] = __builtin_amdgcn_mfma_f32_32x32x16_bf16(pa1, (bf16x8){l1[0], l1[1], l1[2], l1[3], h1[0], h1[1], h1[2], h1[3]}, o[d0], 0, 0, 0); \
        o[d0] = __builtin_amdgcn_mfma_f32_32x32x16_bf16(pa2, (bf16x8){l2[0], l2[1], l2[2], l2[3], h2[0], h2[1], h2[2], h2[3]}, o[d0], 0, 0, 0); \
        o[d0] = __builtin_amdgcn_mfma_f32_32x32x16_bf16(pa3, (bf16x8){l3[0], l3[1], l3[2], l3[3], h3[0], h3[1], h3[2], h3[3]}, o[d0], 0, 0, 0); } while (0)
    for (int t = 0; t < NT; t += 2) { FA_STEP(0, t); if (t + 1 < NT) FA_STEP(1, t + 1); }
    li_l[r32] = l_reg;
    if constexpr (VAR == 1) { const bf16* gp = it.G + (long)(qlo + r32) * it.gs;
#pragma unroll
        for (int k = 0; k < 3; ++k) { const float gl = __builtin_bit_cast(float, (unsigned)gp[k] << 16); wsl[64 + 32 * k + r32] = 1.0f / (1.0f + __expf(-gl)); } }
    asm volatile("s_waitcnt lgkmcnt(0)" ::: "memory");
    if (it.LSE && hi == 0) it.LSE[(long)(qlo + r32) * it.lses] = m_reg * SCALE + __logf(l_reg);
    FA_LAS unsigned char* stg = L + wid * (32 * OSTG);
#pragma unroll
    for (int r = 0; r < 16; ++r) { const int orow = crow(r, hi); const float lv_ = li_l[orow]; float rl = lv_ > 0.f ? __builtin_amdgcn_rcpf(lv_) : 0.f; if constexpr (VAR == 1) rl *= wsl[64 + 32 + orow];
#pragma unroll
        for (int d0 = 0; d0 < 4; ++d0) { const float v = o[d0][r] * rl; const unsigned u = __builtin_bit_cast(unsigned, v); *(FA_LAS unsigned short*)(stg + orow * OSTG + (d0 * 32 + r32) * 2) = (unsigned short)((u + 0x7fffu + ((u >> 16) & 1u)) >> 16); } }
    asm volatile("s_waitcnt lgkmcnt(0)" ::: "memory");
#pragma unroll
    for (int i = 0; i < 8; ++i) { const int id = lane + 64 * i, row = id >> 4, ch = id & 15; const long qi = (long)(qlo + row);
        u32x4 w = *(const FA_LAS u32x4*)(stg + row * OSTG + ch * 16);
        if constexpr (VAR == 1) { const float g0 = wsl[64 + row], g2 = wsl[64 + 64 + row];
            const u32x4 a = *(const u32x4*)(it.M0 + qi * it.ms + ch * 8), c = *(const u32x4*)(it.M1 + qi * it.ms + ch * 8);
#pragma unroll
            for (int k = 0; k < 4; ++k) { const float lo = __builtin_bit_cast(float, w[k] << 16) + g0 * __builtin_bit_cast(float, a[k] << 16) + g2 * __builtin_bit_cast(float, c[k] << 16);
                const float hi_ = __builtin_bit_cast(float, w[k] & 0xffff0000u) + g0 * __builtin_bit_cast(float, a[k] & 0xffff0000u) + g2 * __builtin_bit_cast(float, c[k] & 0xffff0000u); w[k] = cvtpk(lo, hi_); } }
        *(u32x4*)(it.O + qi * it.os + ch * 8) = w; }
    __syncthreads();
#undef FA_LOAD
#undef FA_WRITE
#undef FA_KBASE
#undef FA_STEP
#undef FA_PK4
#undef FA_TRRD
#undef FA_PV_D0
}

struct CmpItem { const bf16* Q; long qs; const bf16* K; const bf16* V; const float* bias; int bld; int s0; bf16* O; long os; unsigned long long* sel; };
__device__ __forceinline__ void cmp_block(const CmpItem& it, unsigned char* lds_g, int imps_off) {
    constexpr float SCALE = 0.08838834764831845f, C2 = 1.4426950408889634f * SCALE;
    constexpr int OFF_TABC = 65536;
    FA_LAS unsigned char* L = (FA_LAS unsigned char*)lds_g;
    const int tid = threadIdx.x, wid = __builtin_amdgcn_readfirstlane(tid >> 6), lane = tid & 63, r32 = lane & 31, hi = lane >> 5;
    FA_LAS float* tabc = (FA_LAS float*)(L + OFF_TABC); FA_LAS float* imps = (FA_LAS float*)(L + imps_off);
    const int tokl = wid * 8 + (r32 >> 2), rh = r32 & 3, s = it.s0 + tokl;
    const int nvis = (it.s0 + 63 - 31) / 16 + 1 > 255 ? 255 : (it.s0 + 63 - 31) / 16 + 1;
    const int NT = (nvis + 63) / 64;
    const int nlim = (s - 31) >> 4;
    const int sr = tid >> 4, sc = (tid & 15) * 8, vst0 = v_st(sr, sc), vst1 = v_st(32 + sr, sc), kws = KSWZ(sr, sc * 2);
    const int vb0 = OFF_V + v_rd_base(lane);
    bf16x8 qr[8];
    { const bf16* qp = it.Q + (long)tokl * it.qs + rh * 128 + hi * 8;
#pragma unroll
      for (int d0 = 0; d0 < 8; ++d0) qr[d0] = *(const bf16x8*)(qp + d0 * 16); }
    for (int i = tid; i < 4 * 4096; i += 512) tabc[i] = it.bias[(long)(i >> 12) * it.bld + (i & 4095)] * (1.0f / SCALE);
    for (int i = tid; i < 64 * 64; i += 512) imps[i] = 0.f;
    bf16x8 st_k0, st_k1, st_v0, st_v1;
#define CM_LOADK(kb_) do { st_k0 = *(const bf16x8*)(it.K + (long)((kb_) + sr) * 128 + sc); st_k1 = *(const bf16x8*)(it.K + (long)((kb_) + 32 + sr) * 128 + sc); } while (0)
#define CM_LOADV(kb_) do { st_v0 = *(const bf16x8*)(it.V + (long)((kb_) + sr) * 128 + sc); st_v1 = *(const bf16x8*)(it.V + (long)((kb_) + 32 + sr) * 128 + sc); } while (0)
#define CM_WRITEK(bf_) do { *(FA_LAS bf16x8*)(L + OFF_K + (bf_) * SHM_K + kws) = st_k0; *(FA_LAS bf16x8*)(L + OFF_K + (bf_) * SHM_K + kws + 32 * 256) = st_k1; } while (0)
#define CM_WRITEV(bf_) do { *(FA_LAS bf16x8*)(L + OFF_V + (bf_) * SHM_V + vst0) = st_v0; *(FA_LAS bf16x8*)(L + OFF_V + (bf_) * SHM_V + vst1) = st_v1; } while (0)
#define CM_SCORES(BUF, kb_) \
        f32x16 p0 = {}, p1 = {}; \
        { const int ka_ = OFF_K + (BUF) * SHM_K; \
          _Pragma("unroll") for (int d0 = 0; d0 < 8; ++d0) { \
            const bf16x8 b0 = *(const FA_LAS bf16x8*)(L + ka_ + KSWZ(r32, (d0 * 16 + hi * 8) * 2)); \
            const bf16x8 b1 = *(const FA_LAS bf16x8*)(L + ka_ + 32 * 256 + KSWZ(r32, (d0 * 16 + hi * 8) * 2)); \
            p0 = __builtin_amdgcn_mfma_f32_32x32x16_bf16(b0, qr[d0], p0, 0, 0, 0); p1 = __builtin_amdgcn_mfma_f32_32x32x16_bf16(b1, qr[d0], p1, 0, 0, 0); } } \
        { const int nb_ = (kb_) + 4 * hi, relb_ = s - 31 - 16 * nb_; const float NEG_ = -__builtin_inff(); \
          _Pragma("unroll") for (int r = 0; r < 16; ++r) { const int c_ = (r & 3) + 8 * (r >> 2); \
            { const int rel_ = relb_ - 16 * c_; const int ix_ = rel_ < 0 ? 0 : rel_; const float bv_ = tabc[rh * 4096 + ix_]; p0[r] = (nb_ + c_ <= nlim) ? p0[r] + bv_ : NEG_; } \
            { const int rel_ = relb_ - 16 * (c_ + 32); const int ix_ = rel_ < 0 ? 0 : rel_; const float bv_ = tabc[rh * 4096 + ix_]; p1[r] = (nb_ + c_ + 32 <= nlim) ? p1[r] + bv_ : NEG_; } } }
    CM_LOADK(0); asm volatile("s_waitcnt vmcnt(0)" ::: "memory"); CM_WRITEK(0); __syncthreads();
    float m_reg = -1e30f, l_reg = 0.f;
#define CM_P1(BUF, t) do { if ((t) + 1 < NT) CM_LOADK(((t) + 1) * 64); \
        { CM_SCORES(BUF, (t) * 64) \
          float pmax_ = p0[0]; _Pragma("unroll") for (int r = 1; r < 16; ++r) pmax_ = fmaxf(pmax_, p0[r]); _Pragma("unroll") for (int r = 0; r < 16; ++r) pmax_ = fmaxf(pmax_, p1[r]); \
          { auto rr_ = __builtin_amdgcn_permlane32_swap(__float_as_uint(pmax_), __float_as_uint(pmax_), false, false); pmax_ = fmaxf(__uint_as_float(rr_[0]), __uint_as_float(rr_[1])); } \
          const float mn_ = fmaxf(m_reg, pmax_), alpha_ = __builtin_amdgcn_exp2f((m_reg - mn_) * C2), mnL_ = -mn_ * C2; float ps_ = 0.f; \
          _Pragma("unroll") for (int r = 0; r < 16; ++r) ps_ += __builtin_amdgcn_exp2f(fmaf(p0[r], C2, mnL_)) + __builtin_amdgcn_exp2f(fmaf(p1[r], C2, mnL_)); \
          { auto rr_ = __builtin_amdgcn_permlane32_swap(__float_as_uint(ps_), __float_as_uint(ps_), false, false); ps_ = __uint_as_float(rr_[0]) + __uint_as_float(rr_[1]); } \
          l_reg = l_reg * alpha_ + ps_; m_reg = mn_; } \
        if ((t) + 1 < NT) { asm volatile("s_waitcnt vmcnt(0)" ::: "memory"); CM_WRITEK(1 - (BUF)); } \
        __syncthreads(); } while (0)
    for (int t = 0; t < NT; t += 2) { CM_P1(0, t); if (t + 1 < NT) CM_P1(1, t + 1); }
    const float inv_l = l_reg > 0.f ? 1.0f / l_reg : 0.f, mL = -m_reg * C2;
    CM_LOADK(0); CM_LOADV(0); asm volatile("s_waitcnt vmcnt(0)" ::: "memory"); CM_WRITEK(0); CM_WRITEV(0); __syncthreads();
    f32x16 o[4] = {};
#define FA_PK4(P, B_, OUT) do { unsigned a0 = cvtpk(P[B_+0], P[B_+1]), a1 = cvtpk(P[B_+2], P[B_+3]); unsigned b0 = cvtpk(P[B_+4], P[B_+5]), b1 = cvtpk(P[B_+6], P[B_+7]); \
        auto r0 = __builtin_amdgcn_permlane32_swap(a0, b0, false, false); auto r1 = __builtin_amdgcn_permlane32_swap(a1, b1, false, false); \
        u32x4 w = {r0[0], r1[0], r0[1], r1[1]}; OUT = __builtin_bit_cast(bf16x8, w); } while (0)
#define FA_TRRD(dst, off) asm volatile("ds_read_b64_tr_b16 %0, %1 offset:%2" : "=&v"(dst) : "v"(vb0), "i"(off) : "memory")
#define FA_PV_D0(VB, d0) do { s16x4 l0, l1, l2, l3, h0, h1, h2, h3; constexpr int b_ = (VB) * SHM_V + v_rd_off(d0, 0, 0); \
        FA_TRRD(l0, b_); FA_TRRD(h0, b_ + 2048); FA_TRRD(l1, b_ + 4096); FA_TRRD(h1, b_ + 6144); FA_TRRD(l2, b_ + 8192); FA_TRRD(h2, b_ + 10240); FA_TRRD(l3, b_ + 12288); FA_TRRD(h3, b_ + 14336); \
        asm volatile("s_waitcnt lgkmcnt(0)" ::: "memory"); SBAR(); \
        o[d0] = __builtin_amdgcn_mfma_f32_32x32x16_bf16(pa0, (bf16x8){l0[0], l0[1], l0[2], l0[3], h0[0], h0[1], h0[2], h0[3]}, o[d0], 0, 0, 0); \
        o[d0] = __builtin_amdgcn_mfma_f32_32x32x16_bf16(pa1, (bf16x8){l1[0], l1[1], l1[2], l1[3], h1[0], h1[1], h1[2], h1[3]}, o[d0], 0, 0, 0); \
        o[d0] = __builtin_amdgcn_mfma_f32_32x32x16_bf16(pa2, (bf16x8){l2[0], l2[1], l2[2], l2[3], h2[0], h2[1], h2[2], h2[3]}, o[d0], 0, 0, 0); \
        o[d0] = __builtin_amdgcn_mfma_f32_32x32x16_bf16(pa3, (bf16x8){l3[0], l3[1], l3[2], l3[3], h3[0], h3[1], h3[2], h3[3]}, o[d0], 0, 0, 0); } while (0)
#define CM_IMP(P, half_, t) do { _Pragma("unroll") for (int q4 = 0; q4 < 4; ++q4) { \
            float A_ = (2.0f * ((P[4 * q4] + P[4 * q4 + 1]) + P[4 * q4 + 2]) + P[4 * q4 + 3]) * inv_l, B_ = P[4 * q4 + 3] * inv_l; \
            A_ += __shfl_xor(A_, 1); A_ += __shfl_xor(A_, 2); B_ += __shfl_xor(B_, 1); B_ += __shfl_xor(B_, 2); \
            const int j_ = 2 * q4 + hi + 8 * (half_) + 16 * (t); \
            if (rh == 0) { __hip_atomic_fetch_add(&imps[tokl * 64 + j_], A_, __ATOMIC_RELAXED, __HIP_MEMORY_SCOPE_WORKGROUP); \
                if (j_ + 1 < 64) __hip_atomic_fetch_add(&imps[tokl * 64 + j_ + 1], B_, __ATOMIC_RELAXED, __HIP_MEMORY_SCOPE_WORKGROUP); } } } while (0)
#define CM_P2(BUF, t) do { if ((t) + 1 < NT) { CM_LOADK(((t) + 1) * 64); CM_LOADV(((t) + 1) * 64); } \
        { CM_SCORES(BUF, (t) * 64) \
          _Pragma("unroll") for (int r = 0; r < 16; ++r) { p0[r] = __builtin_amdgcn_exp2f(fmaf(p0[r], C2, mL)); p1[r] = __builtin_amdgcn_exp2f(fmaf(p1[r], C2, mL)); } \
          CM_IMP(p0, 0, t); CM_IMP(p1, 1, t); \
          bf16x8 pa0, pa1, pa2, pa3; FA_PK4(p0, 0, pa0); FA_PK4(p0, 8, pa1); FA_PK4(p1, 0, pa2); FA_PK4(p1, 8, pa3); \
          FA_PV_D0(BUF, 0); FA_PV_D0(BUF, 1); FA_PV_D0(BUF, 2); FA_PV_D0(BUF, 3); } \
        if ((t) + 1 < NT) { asm volatile("s_waitcnt vmcnt(0)" ::: "memory"); CM_WRITEK(1 - (BUF)); CM_WRITEV(1 - (BUF)); } \
        __syncthreads(); } while (0)
    for (int t = 0; t < NT; t += 2) { CM_P2(0, t); if (t + 1 < NT) CM_P2(1, t + 1); }
    asm volatile("s_waitcnt lgkmcnt(0)" ::: "memory");
    for (int tk = 0; tk < 8; ++tk) { const int sp = it.s0 + wid * 8 + tk, blk_t = sp >> 6, j = lane;
        const float is = imps[(wid * 8 + tk) * 64 + j];
        const bool forced = (j == 0) || (j == blk_t) || (j == blk_t - 1), valid = j <= blk_t;
        const float scv = forced ? 1e9f : (valid ? is : -1.0f);
        int rank = 0;
        for (int k = 0; k < 64; ++k) { const float vk = __shfl(scv, k); rank += (vk > scv || (vk == scv && k < j)) ? 1 : 0; }
        const unsigned long long msk = __ballot(rank < 16 && scv > -0.5f);
        if (lane == 0) it.sel[(long)(wid * 8 + tk) * 2] = msk; }
    FA_LAS unsigned char* stg = L + wid * (32 * OSTG);
    FA_LAS float* li_c = imps + wid * 512;
    li_c[r32] = inv_l; asm volatile("s_waitcnt lgkmcnt(0)" ::: "memory");
#pragma unroll
    for (int r = 0; r < 16; ++r) { const int orow = crow(r, hi); const float rl = li_c[orow];
#pragma unroll
        for (int d0 = 0; d0 < 4; ++d0) { const unsigned u = __builtin_bit_cast(unsigned, o[d0][r] * rl); *(FA_LAS unsigned short*)(stg + orow * OSTG + (d0 * 32 + r32) * 2) = (unsigned short)((u + 0x7fffu + ((u >> 16) & 1u)) >> 16); } }
    asm volatile("s_waitcnt lgkmcnt(0)" ::: "memory");
#pragma unroll
    for (int i = 0; i < 8; ++i) { const int id = lane + 64 * i, row = id >> 4, ch = id & 15;
        const u32x4 w = *(const FA_LAS u32x4*)(stg + row * OSTG + ch * 16);
        *(u32x4*)(it.O + (long)(wid * 8 + (row >> 2)) * it.os + (row & 3) * 128 + ch * 8) = w; }
    __syncthreads();
#undef CM_LOADK
#undef CM_LOADV
#undef CM_WRITEK
#undef CM_WRITEV
#undef CM_SCORES
#undef CM_P1
#undef CM_P2
#undef CM_IMP
#undef FA_PK4
#undef FA_TRRD
#undef FA_PV_D0
}
}

constexpr int D = 2048, NB = 4, S = 4096, M = NB * S;
constexpr int HD = 128;
constexpr int Z0W = 3840;
constexpr int Z_NQ = 0, Z_NKV = 1024, Z_QLAT = 2560, Z_KVLAT = 3072, Z_KPE = 3584, Z_NG = 3648;
constexpr int QMW = 1536, KVMW = 2048;
constexpr int FF = 5632, FFE = 7168, NE = 8;
constexpr int Z1W = 9216;
constexpr int NSLOT = (2 * M / 256 + NE) * 256;
constexpr float RMS_EPS = 1e-6f;

constexpr size_t MiB = 1u << 20;
constexpr size_t WS_CTL = 0, CTL_ZERO_BYTES = 1 * MiB;
constexpr size_t WS_MOD = 1 * MiB;
constexpr size_t WS_BIAS = 2 * MiB;
constexpr int BIAS_LD = 4096 + 64;
constexpr size_t WS_ROPE = 3 * MiB;
constexpr size_t WS_RINV = 8 * MiB;
constexpr size_t WS_SEL = 9 * MiB;
constexpr size_t WS_KC = 10 * MiB;
constexpr size_t WS_VC = 11 * MiB;
constexpr size_t WS_ROUTE = 12 * MiB;
constexpr size_t WS_LSE = 13 * MiB;
constexpr size_t WS_KPE = 15 * MiB;
constexpr size_t WS_W1T = 17 * MiB, WS_W2T = 19 * MiB, WS_CB1 = 20 * MiB;
constexpr size_t WS_WIN0 = 21 * MiB, WS_WUQ = 36 * MiB, WS_WUKV = 38 * MiB, WS_WOUT0 = 40 * MiB, WS_WGU0 = 48 * MiB, WS_WDN0 = 92 * MiB;
constexpr size_t WS_WIN1 = 114 * MiB, WS_WOUT1 = 150 * MiB, WS_WMGU = 154 * MiB, WS_WMDN = 602 * MiB;
constexpr size_t WS_X = 826 * MiB;
constexpr size_t WS_H = 954 * MiB;
constexpr size_t WS_R = 1018 * MiB;
constexpr size_t WS_Z0 = WS_R, WS_QM = WS_R + 120 * MiB, WS_KVM = WS_R + 168 * MiB, WS_OCMP = WS_R + 232 * MiB, WS_OWIN = WS_R + 264 * MiB, WS_CAT = WS_R + 328 * MiB;
constexpr size_t WS_ACT = WS_R;
constexpr size_t WS_Z1 = WS_R, WS_OP = WS_R + 288 * MiB, WS_OM = WS_R + 384 * MiB;
constexpr size_t WS_XB = WS_R, WS_ACTB = WS_R + 136 * MiB, WS_YB = WS_R;
constexpr size_t WS_END = WS_R + 612 * MiB;
static_assert(WS_Z0 + (size_t)M * Z0W * 2 <= WS_QM && WS_QM + (size_t)M * QMW * 2 <= WS_KVM && WS_KVM + (size_t)M * KVMW * 2 <= WS_OCMP && WS_CAT + (size_t)M * 2048 * 2 <= WS_END, "L0 map");
static_assert(WS_Z1 + (size_t)M * Z1W * 2 <= WS_OM && WS_XB + (size_t)NSLOT * D * 2 <= WS_ACTB && WS_ACTB + (size_t)NSLOT * FFE * 2 <= WS_END, "L1 map");
static_assert(WS_WMDN + (size_t)NE * D * FFE * 2 <= WS_X && WS_WMGU + (size_t)NE * 2 * FFE * D * 2 <= WS_WMDN, "weights map");
constexpr int CW_BAR = 4096;
constexpr int CW_CNT = 64;
constexpr int CW_TS = 128;
constexpr int CW_Q = 8192;

constexpr int RING_BYTES = 131072;
constexpr int SMALL_OFF = RING_BYTES;
constexpr int LDSCTL_OFF = RING_BYTES + 16384, MISC_OFF = LDSCTL_OFF;
constexpr int LDS_BYTES = LDSCTL_OFF + 256;
constexpr int NWAVES = 8;

#define GAS __attribute__((address_space(1)))
#define LAS __attribute__((address_space(3)))
typedef unsigned short bf16;
typedef unsigned v4u __attribute__((ext_vector_type(4)));
typedef unsigned v2u __attribute__((ext_vector_type(2)));
typedef float f32x4 __attribute__((ext_vector_type(4)));
typedef float f32x2 __attribute__((ext_vector_type(2)));
#define LDS_WAIT() asm volatile("s_waitcnt lgkmcnt(0)" ::: "memory")
__device__ __forceinline__ unsigned f2bf(float f) { unsigned u = __builtin_bit_cast(unsigned, f); return (u + 0x7fffu + ((u >> 16) & 1u)) >> 16; }
__device__ __forceinline__ unsigned pk2(float lo, float hi) { return f2bf(lo) | (f2bf(hi) << 16); }
__device__ __forceinline__ float bf2f(unsigned short b) { return __builtin_bit_cast(float, (unsigned)b << 16); }
__device__ __forceinline__ float bflo(unsigned w) { return __builtin_bit_cast(float, w << 16); }
__device__ __forceinline__ float bfhi(unsigned w) { return __builtin_bit_cast(float, w & 0xffff0000u); }
__device__ __forceinline__ float wave_sum(float v) {
#pragma unroll
    for (int o = 1; o < 64; o <<= 1) v += __shfl_xor(v, o);
    return v;
}
__device__ __forceinline__ float wave_max(float v) {
#pragma unroll
    for (int o = 1; o < 64; o <<= 1) v = fmaxf(v, __shfl_xor(v, o));
    return v;
}

#define XB_TMO      128
#define XB_XCNT(j)  (256  + 64 * (j))
#define XB_XSUB(j)  (1280 + 64 * (j))
#define XB_XGEN(j)  (2304 + 64 * (j))
#define XB_TOP      3328
#define XB_TOPGEN   3392
#define XCD_BAR_WORDS 3456
#define XB_SPIN_CAP (1u << 22)

__device__ __forceinline__ unsigned xb_ld(unsigned* p)              { return __hip_atomic_load(p, __ATOMIC_RELAXED, __HIP_MEMORY_SCOPE_AGENT); }
__device__ __forceinline__ unsigned xb_add(unsigned* p, unsigned v) { return __hip_atomic_fetch_add(p, v, __ATOMIC_RELAXED, __HIP_MEMORY_SCOPE_AGENT); }
__device__ __forceinline__ unsigned xb_xcc_id() { return (unsigned)__builtin_amdgcn_s_getreg((3 << 11) | 20) & 0xFu; }
#define XB_SPIN(cond, bar) do { unsigned _sp = 0; while (cond) { __builtin_amdgcn_s_sleep(1); \
    if ((++_sp & 255u) == 0u) { if (xb_ld(&(bar)[XB_TMO])) break; if (_sp > XB_SPIN_CAP) { atomicAdd(&(bar)[XB_TMO], 1u); break; } } } } while (0)

struct XcdBarrier {
    unsigned* bar; unsigned x;
    volatile LAS unsigned* st;
};

__device__ __forceinline__ XcdBarrier xcd_barrier_post(unsigned* bar, volatile LAS unsigned* st) {
    XcdBarrier b; b.bar = bar; b.x = xb_xcc_id(); b.st = st;
    if (threadIdx.x == 0) (void)xb_add(&bar[XB_XCNT(b.x)], 1u);
    return b;
}
__device__ __forceinline__ void xcd_barrier_complete(unsigned* bar, unsigned x, unsigned& nloc, unsigned& nx) {
    const unsigned G = gridDim.x * gridDim.y * gridDim.z;
    unsigned sum, cnt, mine, sp = 0u;
    for (;;) {
        sum = 0u; cnt = 0u; mine = 0u;
#pragma unroll
        for (unsigned j = 0; j < 16; ++j) { const unsigned c = xb_ld(&bar[XB_XCNT(j)]); sum += c; cnt += (c > 0u) ? 1u : 0u; mine = (j == x) ? c : mine; }
        if (sum == G) break;
        __builtin_amdgcn_s_sleep(1);
        if ((++sp & 255u) == 0u) { if (xb_ld(&bar[XB_TMO])) break; if (sp > XB_SPIN_CAP) { atomicAdd(&bar[XB_TMO], 1u); break; } }
    }
    nloc = mine > 0u ? mine : 1u; nx = cnt > 0u ? cnt : 1u;
}

__device__ __forceinline__ void xcd_barrier(const XcdBarrier& b) {
    asm volatile("s_waitcnt vmcnt(0)" ::: "memory");
    __syncthreads();
    if (threadIdx.x == 0) {
        unsigned* bar = b.bar;
        __builtin_amdgcn_s_waitcnt(0);
        unsigned nloc = b.st[0], nx = b.st[1];
        if (nloc == 0u) { xcd_barrier_complete(bar, b.x, nloc, nx); b.st[0] = nloc; b.st[1] = nx; }
        const unsigned old = xb_add(&bar[XB_XSUB(b.x)], 1u);
        const unsigned gen = old / nloc;
        if (old + 1u == (gen + 1u) * nloc) {
            __builtin_amdgcn_fence(__ATOMIC_RELEASE, "agent");
            asm volatile("s_waitcnt vmcnt(0)" ::: "memory");
            const unsigned og = xb_add(&bar[XB_TOP], 1u);
            const unsigned tg = og / nx;
            if (og + 1u == (tg + 1u) * nx) xb_add(&bar[XB_TOPGEN], 1u);
            else XB_SPIN(xb_ld(&bar[XB_TOPGEN]) == tg, bar);
            __builtin_amdgcn_fence(__ATOMIC_ACQUIRE, "agent");
            xb_add(&bar[XB_XGEN(b.x)], 1u);
            asm volatile("s_waitcnt vmcnt(0)" ::: "memory");
        } else {
            XB_SPIN(xb_ld(&bar[XB_XGEN(b.x)]) == gen, bar);
            __builtin_amdgcn_fence(__ATOMIC_ACQUIRE, "agent");
            asm volatile("s_waitcnt vmcnt(0)" ::: "memory");
        }
    }
    __syncthreads();
}


struct Args { const void* in[30]; float* out; unsigned char* ws; int ph_lo, ph_hi; };
struct Frame {
    unsigned char* lds;
    int tid, lane, wave, vcu, G, gw, NGW;
    unsigned char* ws;
};

__device__ __forceinline__ int t5_bucket(int n) {
    if (n < 16) return n < 0 ? 0 : n;
    int b = 16;
    b += (n >= 22); b += (n >= 30); b += (n >= 40); b += (n >= 54); b += (n >= 73); b += (n >= 99); b += (n >= 134); b += (n >= 182);
    b += (n >= 246); b += (n >= 332); b += (n >= 450); b += (n >= 609); b += (n >= 825); b += (n >= 1117); b += (n >= 1513);
    return b;
}

__device__ __forceinline__ unsigned pk4_fp8(float a, float b, float c, float d) { int w = 0; w = __builtin_amdgcn_cvt_pk_fp8_f32(a, b, w, false); w = __builtin_amdgcn_cvt_pk_fp8_f32(c, d, w, true); return (unsigned)w; }
template <int MAP, bool OUT8 = false>
__device__ __forceinline__ void p0_transpose_item(const float* W, const float* W2, int K, int Nsrc, int Ndst, bf16* WT, const float* kscale, float* scr, int item, int lane, float oscale = 1.0f) {
    const int nblk = Ndst / 64, kb = item / nblk, nb = item % nblk, k0 = 64 * kb, n0 = 64 * nb;
    const int n4 = (lane & 15) * 4, n = n0 + n4, kr = lane >> 4;
    const float* src = W; int sc = n; bool ok = true;
    if (MAP == 1) { if (n < Z_QLAT) sc = n; else if (n < Z_NG) sc = n + 24; else if (n < Z_NG + 24) sc = n - Z_NG + 2560; else ok = false; }
    if (MAP == 2) { const int g32 = n >> 5, w = n & 31; src = (w < 16) ? W : W2; sc = g32 * 16 + (w & 15); }
    f32x4 v[16];
#pragma unroll
    for (int i = 0; i < 16; ++i) v[i] = ok ? __builtin_nontemporal_load((const f32x4*)(src + (size_t)(k0 + 4 * i + kr) * Nsrc + sc)) : (f32x4){0.f, 0.f, 0.f, 0.f};
#pragma unroll
    for (int i = 0; i < 16; ++i) { const int kk = 4 * i + kr; f32x4 t = v[i]; if (kscale) t = t * kscale[k0 + kk]; float* d = scr + kk * 65 + n4; d[0] = t.x; d[1] = t.y; d[2] = t.z; d[3] = t.w; }
    LDS_WAIT(); asm volatile("" ::: "memory");
    if constexpr (OUT8) {
        const int kg = lane & 3;
#pragma unroll
        for (int p = 0; p < 4; ++p) { const int nn = 16 * p + (lane >> 2); const float* s = scr + (16 * kg) * 65 + nn;
            v4u o; o.x = pk4_fp8(s[0 * 65] * oscale, s[1 * 65] * oscale, s[2 * 65] * oscale, s[3 * 65] * oscale); o.y = pk4_fp8(s[4 * 65] * oscale, s[5 * 65] * oscale, s[6 * 65] * oscale, s[7 * 65] * oscale);
            o.z = pk4_fp8(s[8 * 65] * oscale, s[9 * 65] * oscale, s[10 * 65] * oscale, s[11 * 65] * oscale); o.w = pk4_fp8(s[12 * 65] * oscale, s[13 * 65] * oscale, s[14 * 65] * oscale, s[15 * 65] * oscale);
            *(v4u*)((unsigned char*)WT + (size_t)(n0 + nn) * K + k0 + 16 * kg) = o; }
    } else {
    const int kg = lane & 7;
#pragma unroll
    for (int p = 0; p < 8; ++p) { const int nn = 8 * p + (lane >> 3); const float* s = scr + (8 * kg) * 65 + nn;
        v4u o; o.x = pk2(s[0 * 65], s[1 * 65]); o.y = pk2(s[2 * 65], s[3 * 65]); o.z = pk2(s[4 * 65], s[5 * 65]); o.w = pk2(s[6 * 65], s[7 * 65]);
        *(v4u*)(WT + (size_t)(n0 + nn) * K + k0 + 8 * kg) = o; }
    }
    LDS_WAIT(); asm volatile("" ::: "memory");
}
template <int MAP, bool OUT8 = false>
__device__ __forceinline__ void p0_transpose(Frame& F, const float* W, const float* W2, int K, int Nsrc, int Ndst, bf16* WT, const float* kscale, float oscale = 1.0f) {
    float* scr = (float*)(F.lds + F.wave * 16640);
    const int nitems = (K / 64) * (Ndst / 64);
    for (int it = F.gw; it < nitems; it += F.NGW) p0_transpose_item<MAP, OUT8>(W, W2, K, Nsrc, Ndst, WT, kscale, scr, it, F.lane, oscale);
}

__device__ __forceinline__ void modnorm_row(const float* xrow, const float* g, const float* sc, const float* sh, bf16* orow, int lane, f32x4 (&v)[8]) {
    const f32x4* xr = (const f32x4*)xrow + lane; float s = 0.f;
#pragma unroll
    for (int j = 0; j < 8; ++j) { v[j] = xr[64 * j]; s += (v[j].x * v[j].x + v[j].y * v[j].y) + (v[j].z * v[j].z + v[j].w * v[j].w); }
    const float rinv = 1.0f / sqrtf(wave_sum(s) * (1.f / D) + RMS_EPS);
    unsigned long long* o8 = (unsigned long long*)orow + lane;
#pragma unroll
    for (int j = 0; j < 8; ++j) { const f32x4 gg = ((const f32x4*)g)[lane + 64 * j], cc = ((const f32x4*)sc)[lane + 64 * j], hh = ((const f32x4*)sh)[lane + 64 * j];
        v[j] = (v[j] * rinv) * gg * (cc + 1.0f) + hh;
        o8[64 * j] = (unsigned long long)pk2(v[j].x, v[j].y) | ((unsigned long long)pk2(v[j].z, v[j].w) << 32); }
}
template <bool OUT8 = false>
__device__ __forceinline__ void modnorm_phase(Frame& F, const float* x, const float* g, const float* mod  , int sh_idx, bf16* H, float oscale = 1.0f) {
    for (int b = 0; b < NB; ++b) { const float* mb = mod + (size_t)b * 6 * D; const float* sc = mb + (size_t)(sh_idx + 1) * D; const float* sh = mb + (size_t)sh_idx * D;
        const int s0 = F.gw, s1 = F.gw + F.NGW;
        const f32x4* x0 = (const f32x4*)(x + ((size_t)b * S + s0) * D) + F.lane; const f32x4* x1 = (const f32x4*)(x + ((size_t)b * S + s1) * D) + F.lane;
        f32x4 v0[8], v1[8], ca[8];
#pragma unroll
        for (int j = 0; j < 8; ++j) { v0[j] = x0[64 * j]; v1[j] = x1[64 * j]; }
#pragma unroll
        for (int j = 0; j < 8; ++j) { ca[j] = ((const f32x4*)g)[F.lane + 64 * j] * (((const f32x4*)sc)[F.lane + 64 * j] + 1.0f); }
        float q0 = 0.f, q1 = 0.f;
#pragma unroll
        for (int j = 0; j < 8; ++j) { q0 += (v0[j].x * v0[j].x + v0[j].y * v0[j].y) + (v0[j].z * v0[j].z + v0[j].w * v0[j].w); q1 += (v1[j].x * v1[j].x + v1[j].y * v1[j].y) + (v1[j].z * v1[j].z + v1[j].w * v1[j].w); }
        const float r0 = 1.0f / sqrtf(wave_sum(q0) * (1.f / D) + RMS_EPS), r1 = 1.0f / sqrtf(wave_sum(q1) * (1.f / D) + RMS_EPS);
        if constexpr (OUT8) {
            unsigned* o0 = (unsigned*)((unsigned char*)H + ((size_t)b * S + s0) * D) + F.lane; unsigned* o1 = (unsigned*)((unsigned char*)H + ((size_t)b * S + s1) * D) + F.lane;
#pragma unroll
            for (int j = 0; j < 8; ++j) { const f32x4 ccj = ((const f32x4*)sh)[F.lane + 64 * j]; const f32x4 a = ((v0[j] * r0) * ca[j] + ccj) * oscale, c2 = ((v1[j] * r1) * ca[j] + ccj) * oscale;
                o0[64 * j] = pk4_fp8(__builtin_amdgcn_fmed3f(a.x, -440.f, 440.f), __builtin_amdgcn_fmed3f(a.y, -440.f, 440.f), __builtin_amdgcn_fmed3f(a.z, -440.f, 440.f), __builtin_amdgcn_fmed3f(a.w, -440.f, 440.f));
                o1[64 * j] = pk4_fp8(__builtin_amdgcn_fmed3f(c2.x, -440.f, 440.f), __builtin_amdgcn_fmed3f(c2.y, -440.f, 440.f), __builtin_amdgcn_fmed3f(c2.z, -440.f, 440.f), __builtin_amdgcn_fmed3f(c2.w, -440.f, 440.f)); }
        } else {
        unsigned long long* o0 = (unsigned long long*)(H + ((size_t)b * S + s0) * D) + F.lane; unsigned long long* o1 = (unsigned long long*)(H + ((size_t)b * S + s1) * D) + F.lane;
#pragma unroll
        for (int j = 0; j < 8; ++j) { const f32x4 ccj = ((const f32x4*)sh)[F.lane + 64 * j]; const f32x4 a = (v0[j] * r0) * ca[j] + ccj, c2 = (v1[j] * r1) * ca[j] + ccj;
            o0[64 * j] = (unsigned long long)pk2(a.x, a.y) | ((unsigned long long)pk2(a.z, a.w) << 32); o1[64 * j] = (unsigned long long)pk2(c2.x, c2.y) | ((unsigned long long)pk2(c2.z, c2.w) << 32); }
        }
    }
}

__device__ __forceinline__ float gelu_tanh(float x) { const float u = 0.7978845608028654f * (x + 0.044715f * x * x * x); return 0.5f * x * (1.0f + tanhf(u)); }

__global__ void __launch_bounds__(NWAVES * 64, 2) fwd(Args args) {
    extern __shared__ __attribute__((aligned(16))) unsigned char lds[];
    Frame F;
    F.lds = lds; F.ws = args.ws;
    F.tid = threadIdx.x; F.lane = F.tid & 63; F.wave = __builtin_amdgcn_readfirstlane(F.tid >> 6);
    F.G = gridDim.x; { const int bx = blockIdx.x; F.vcu = (F.G % 8 == 0) ? (bx % 8) * (F.G / 8) + bx / 8 : bx; }
    F.gw = F.vcu * NWAVES + F.wave; F.NGW = F.G * NWAVES;
    unsigned char* ws = args.ws;
    unsigned* ctl = (unsigned*)(ws + WS_CTL);
    volatile LAS unsigned* MISC = (volatile LAS unsigned*)((LAS unsigned char*)lds + MISC_OFF);
    for (int u = F.tid; u < 64; u += NWAVES * 64) MISC[u] = 0u;
    __syncthreads();
    XcdBarrier bar; bar.bar = ctl + CW_BAR; bar.x = 0; bar.st = nullptr;
    if (MK_N_LAUNCHES == 1) bar = xcd_barrier_post(ctl + CW_BAR, MISC + 8);
    const int lo = args.ph_lo, hi = args.ph_hi;
#define IN(k) (lo <= (k) && (k) < hi)
#define MOE_WSCALE 64.0f
#define MOE_ASCALE 8.0f
#define IN1_ASCALE 4.0f
#define SEAM(k) do { if (IN(k) && IN((k) + 1)) xcd_barrier(bar); } while (0)

    const float* x_in = (const float*)args.in[0]; const float* c_in = (const float*)args.in[1]; const int* positions = (const int*)args.in[2];
    const float* rel_bias = (const float*)args.in[3]; const float* ada_w = (const float*)args.in[4]; const float* ada_b = (const float*)args.in[5];
    const float* mix_norm_g = (const float*)args.in[6]; const float* ffn_norm_g = (const float*)args.in[7];
    const float* ab_w_in = (const float*)args.in[8]; const float* ab_w_out = (const float*)args.in[9];
    const float* cmp_pos_k = (const float*)args.in[10]; const float* cmp_w1_k = (const float*)args.in[11]; const float* cmp_w2_k = (const float*)args.in[12];
    const float* cmp_pos_v = (const float*)args.in[13]; const float* cmp_w1_v = (const float*)args.in[14]; const float* cmp_w2_v = (const float*)args.in[15];
    const float* q_norm_g = (const float*)args.in[16]; const float* kv_norm_g = (const float*)args.in[17]; const float* w_uq = (const float*)args.in[18]; const float* w_ukv = (const float*)args.in[19];
    const float* ffn_wg = (const float*)args.in[20]; const float* ffn_wu = (const float*)args.in[21]; const float* ffn_wd = (const float*)args.in[22];
    const float* c_w_in = (const float*)args.in[23]; const float* c_w_out = (const float*)args.in[24]; const float* w_router = (const float*)args.in[25];
    const float* moe_wg = (const float*)args.in[26]; const float* moe_wu = (const float*)args.in[27]; const float* moe_wd = (const float*)args.in[28]; const float* final_g = (const float*)args.in[29];
    float* MOD = (float*)(ws + WS_MOD); float* BIAS = (float*)(ws + WS_BIAS); float* ROPE = (float*)(ws + WS_ROPE); float* RINV = (float*)(ws + WS_RINV);
    unsigned long long* SEL = (unsigned long long*)(ws + WS_SEL); bf16* KC = (bf16*)(ws + WS_KC); bf16* VC = (bf16*)(ws + WS_VC); int* ROUTE = (int*)(ws + WS_ROUTE); bf16* KPE = (bf16*)(ws + WS_KPE);
    bf16* W_IN0 = (bf16*)(ws + WS_WIN0); bf16* W_UQ = (bf16*)(ws + WS_WUQ); bf16* W_UKV = (bf16*)(ws + WS_WUKV); bf16* W_OUT0 = (bf16*)(ws + WS_WOUT0); bf16* W_GU0 = (bf16*)(ws + WS_WGU0); bf16* W_DN0 = (bf16*)(ws + WS_WDN0);
    bf16* W_IN1 = (bf16*)(ws + WS_WIN1); bf16* W_OUT1 = (bf16*)(ws + WS_WOUT1); bf16* W_MGU = (bf16*)(ws + WS_WMGU); bf16* W_MDN = (bf16*)(ws + WS_WMDN);
    float* X = (float*)(ws + WS_X); bf16* H = (bf16*)(ws + WS_H);
    bf16* Z0 = (bf16*)(ws + WS_Z0); bf16* QM = (bf16*)(ws + WS_QM); bf16* KVM = (bf16*)(ws + WS_KVM); bf16* OCMP = (bf16*)(ws + WS_OCMP); bf16* OWIN = (bf16*)(ws + WS_OWIN); bf16* CAT = (bf16*)(ws + WS_CAT);
    bf16* W1T = (bf16*)(ws + WS_W1T); bf16* W2T = (bf16*)(ws + WS_W2T); float* CB1 = (float*)(ws + WS_CB1);
    float* LSEB = (float*)(ws + WS_LSE); bf16* OP = (bf16*)(ws + WS_OP);
    bf16* ACT = (bf16*)(ws + WS_ACT); bf16* Z1 = (bf16*)(ws + WS_Z1); bf16* OM = (bf16*)(ws + WS_OM); bf16* XB = (bf16*)(ws + WS_XB); bf16* ACTB = (bf16*)(ws + WS_ACTB); bf16* YB = (bf16*)(ws + WS_YB);
    PG8_LAS unsigned char* ring = (PG8_LAS unsigned char*)lds;

    if (IN(0)) {
        for (int job = 192 + (int)blockIdx.x; job < 194; job += F.G) {
            float* red = (float*)(lds + 32768); const int c = job - 192; const float* pos = c ? cmp_pos_v : cmp_pos_k; const float* w1 = c ? cmp_w1_v : cmp_w1_k;
            float a0 = 0.f, a1 = 0.f;
#pragma unroll 8
            for (int k = 0; k < 512; ++k) { const int kk = F.wave * 512 + k; const f32x2 wv = *(const f32x2*)(w1 + (size_t)kk * 128 + 2 * F.lane); const float pv = pos[kk]; a0 += pv * wv.x; a1 += pv * wv.y; }
            red[F.wave * 128 + 2 * F.lane] = a0; red[F.wave * 128 + 2 * F.lane + 1] = a1;
            __syncthreads();
            if (F.tid < 128) { float s = 0.f;
#pragma unroll
                for (int w = 0; w < 8; ++w) s += red[w * 128 + F.tid];
                CB1[c * 128 + F.tid] = s; }
            __syncthreads();
        }
        for (int job = blockIdx.x; job < 256; job += F.G) {
            float* cs = (float*)lds; float* red = (float*)(lds + 32768);
            for (int i = F.tid; i < 4 * D; i += 512) { const float cv = c_in[i]; cs[i] = cv / (1.0f + __expf(-cv)); }
            __syncthreads();
            const int l = job >> 7, col0 = (job & 127) * 96; const bool act = F.lane < 48;
            float acc[4][2] = {};
            const float* wp = ada_w + ((size_t)l * D + (size_t)F.wave * 256) * 12288 + col0 + 2 * (act ? F.lane : 0);
#pragma unroll 8
            for (int k = 0; k < 256; ++k) { const f32x2 wv = *(const f32x2*)(wp + (size_t)k * 12288); const int kk = F.wave * 256 + k;
#pragma unroll
                for (int b = 0; b < 4; ++b) { const float cv = cs[b * D + kk]; acc[b][0] += cv * wv.x; acc[b][1] += cv * wv.y; } }
            if (act) {
#pragma unroll
                for (int b = 0; b < 4; ++b) { red[(F.wave * 4 + b) * 96 + 2 * F.lane] = acc[b][0]; red[(F.wave * 4 + b) * 96 + 2 * F.lane + 1] = acc[b][1]; } }
            __syncthreads();
            if (F.tid < 384) { const int b = F.tid / 96, cc = F.tid % 96; float s = 0.f;
#pragma unroll
              for (int w = 0; w < 8; ++w) s += red[(w * 4 + b) * 96 + cc];
              MOD[((size_t)l * 4 + b) * 12288 + col0 + cc] = s + ada_b[(size_t)l * 12288 + col0 + cc]; }
            __syncthreads();
        }
        __syncthreads();
        p0_transpose<1, true>(F, ab_w_in, nullptr, D, 3672, Z0W, W_IN0, nullptr, MOE_WSCALE);
        p0_transpose<0>(F, w_uq, nullptr, 512, QMW, QMW, W_UQ, q_norm_g);
        p0_transpose<0>(F, w_ukv, nullptr, 512, KVMW, KVMW, W_UKV, kv_norm_g);
        p0_transpose<0>(F, ab_w_out, nullptr, D, D, D, W_OUT0, nullptr);
        p0_transpose<2>(F, ffn_wg, ffn_wu, D, FF, 2 * FF, W_GU0, nullptr);
        p0_transpose<0>(F, ffn_wd, nullptr, FF, D, D, W_DN0, nullptr);
        p0_transpose<0, true>(F, c_w_in, nullptr, D, Z1W, Z1W, W_IN1, nullptr, MOE_WSCALE);
        p0_transpose<0>(F, c_w_out, nullptr, 1024, D, D, W_OUT1, nullptr);
        p0_transpose<0>(F, cmp_w1_k, nullptr, 4096, 128, 128, W1T, nullptr); p0_transpose<0>(F, cmp_w1_v, nullptr, 4096, 128, 128, W1T + 128 * 4096, nullptr);
        p0_transpose<0>(F, cmp_w2_k, nullptr, 128, 128, 128, W2T, nullptr); p0_transpose<0>(F, cmp_w2_v, nullptr, 128, 128, 128, W2T + 128 * 128, nullptr);
        for (int e = 0; e < NE; ++e) {
            p0_transpose<2, true>(F, moe_wg + (size_t)e * D * FFE, moe_wu + (size_t)e * D * FFE, D, FFE, 2 * FFE, (bf16*)((unsigned char*)W_MGU + (size_t)e * 2 * FFE * D), nullptr, MOE_WSCALE);
            p0_transpose<0, true>(F, moe_wd + (size_t)e * FFE * D, nullptr, FFE, D, D, (bf16*)((unsigned char*)W_MDN + (size_t)e * D * FFE), nullptr, MOE_WSCALE);
        }
        for (int i = F.gw * 64 + F.lane; i < 8 * BIAS_LD; i += F.NGW * 64) { const int h = i / BIAS_LD, r = i % BIAS_LD - 64; BIAS[i] = rel_bias[t5_bucket(r) * 8 + h]; }
        for (int i = F.gw * 64 + F.lane; i < M * 32; i += F.NGW * 64) { const int m = i >> 5, f = i & 31;
            const float inv_freq = powf(10000.0f, -(float)(2 * f) / 64.0f); const float ang = (float)positions[m] * inv_freq;
            ROPE[(size_t)m * 64 + f] = cosf(ang); ROPE[(size_t)m * 64 + 32 + f] = sinf(ang); }
    }
    SEAM(0);
    if (IN(1)) modnorm_phase<true>(F, x_in, mix_norm_g, MOD, 0, H, IN1_ASCALE);
    SEAM(1);
    if (IN(2)) { pg8::Gemm g{H, W_IN0, D / 2, D / 2, D / 2}; pg8::StaticOrder So; So.init(M, Z0W, F.G, (int)blockIdx.x); pg8::EpiBf16S E{Z0, Z0W, 1.0f / (MOE_WSCALE * IN1_ASCALE)};
        pg8::gemm_phase<pg8::EpiBf16S, pg8::StaticOrder, PG_ALIGN, PG_SP2, true, true>(ring, g, So, E); }
    SEAM(2);
    if (IN(3)) {
        for (int m = F.gw; m < M; m += F.NGW) {
            const bf16* zr = Z0 + (size_t)m * Z0W;
#pragma unroll
            for (int w = 0; w < 2; ++w) { const v4u a = *(const v4u*)(zr + (w ? Z_KVLAT : Z_QLAT) + 8 * F.lane);
                float s = bflo(a.x) * bflo(a.x) + bfhi(a.x) * bfhi(a.x) + bflo(a.y) * bflo(a.y) + bfhi(a.y) * bfhi(a.y) + bflo(a.z) * bflo(a.z) + bfhi(a.z) * bfhi(a.z) + bflo(a.w) * bflo(a.w) + bfhi(a.w) * bfhi(a.w);
                s = wave_sum(s); if (F.lane == 0) RINV[(size_t)w * M + m] = 1.0f / sqrtf(s * (1.f / 512.f) + RMS_EPS); }
            if (F.lane < 32) { const float x1 = bf2f(zr[Z_KPE + F.lane]), x2 = bf2f(zr[Z_KPE + 32 + F.lane]); const float cs = ROPE[(size_t)m * 64 + F.lane], sn = ROPE[(size_t)m * 64 + 32 + F.lane];
                KPE[(size_t)m * 64 + F.lane] = (bf16)f2bf(x1 * cs - x2 * sn); KPE[(size_t)m * 64 + 32 + F.lane] = (bf16)f2bf(x2 * cs + x1 * sn); }
        }
        __syncthreads();
        for (int job = blockIdx.x; job < 256; job += F.G) {
            typedef short bfx8 __attribute__((ext_vector_type(8)));
            const int nt = job & 15, g = (job >> 4) & 1, b = (job >> 5) & 3, c = job >> 7, n0 = nt * 16;
            const int fr = F.lane & 15, fq = F.lane >> 4; int nrow = n0 + fr; if (nrow > 254) nrow = 254;
            const bf16* arow = Z0 + ((size_t)b * S + 16 * nrow) * Z0W + Z_NKV + c * 256 + g * 128 + fq * 8;
            const bf16* w1t = W1T + (size_t)c * 128 * 4096 + (size_t)fr * 4096 + fq * 8;
            f32x4 acc[8];
#pragma unroll
            for (int i = 0; i < 8; ++i) acc[i] = (f32x4){0.f, 0.f, 0.f, 0.f};
#pragma unroll 2
            for (int ks = 0; ks < 16; ++ks) { const int kk = F.wave * 512 + ks * 32, l = kk >> 7, d0 = kk & 127;
                const bfx8 af = *(const bfx8*)(arow + (size_t)l * Z0W + d0);
#pragma unroll
                for (int i = 0; i < 8; ++i) { const bfx8 bfr = *(const bfx8*)(w1t + (size_t)i * 16 * 4096 + kk); acc[i] = __builtin_amdgcn_mfma_f32_16x16x32_bf16(af, bfr, acc[i], 0, 0, 0); } }
            float* part = (float*)lds;
#pragma unroll
            for (int i = 0; i < 8; ++i)
#pragma unroll
                for (int j = 0; j < 4; ++j) part[(F.wave * 16 + fq * 4 + j) * 128 + i * 16 + fr] = acc[i][j];
            __syncthreads();
            bf16* hid = (bf16*)(lds + 65536);
            { const int row = F.tid >> 5, c4 = (F.tid & 31) * 4; f32x4 s = *(const f32x4*)(CB1 + c * 128 + c4);
#pragma unroll
              for (int w = 0; w < 8; ++w) s += *(const f32x4*)(part + (w * 16 + row) * 128 + c4);
              *(v2u*)(hid + row * 128 + c4) = (v2u){pk2(gelu_tanh(s.x), gelu_tanh(s.y)), pk2(gelu_tanh(s.z), gelu_tanh(s.w))}; }
            __syncthreads();
            { f32x4 o4 = {0.f, 0.f, 0.f, 0.f}; const bf16* w2t = W2T + (size_t)c * 128 * 128 + (size_t)(F.wave * 16 + fr) * 128 + fq * 8;
#pragma unroll
              for (int ks = 0; ks < 4; ++ks) { const bfx8 af = *(const bfx8*)(hid + fr * 128 + ks * 32 + fq * 8); const bfx8 bfr = *(const bfx8*)(w2t + ks * 32); o4 = __builtin_amdgcn_mfma_f32_16x16x32_bf16(af, bfr, o4, 0, 0, 0); }
              bf16* outp = (c ? VC : KC) + (((size_t)b * 2 + g) * 256) * 128 + F.wave * 16 + fr;
#pragma unroll
              for (int j = 0; j < 4; ++j) { const int n = n0 + fq * 4 + j; outp[(size_t)n * 128] = n < 255 ? (bf16)f2bf(o4[j]) : (bf16)0; } }
            __syncthreads();
        }
        __syncthreads();
        for (int Lx = blockIdx.x; Lx < 512; Lx += F.G) {
            const int qb = 15 - Lx / 32, bh = Lx % 32, b = bh >> 3, h = bh & 7, g = h >> 2; const bf16* zb = Z0 + (size_t)b * S * Z0W;
            fa::Item it{}; it.Q = zb + Z_NQ + h * 128; it.qs = Z0W; it.K = zb + Z_NKV + 4 * 256 + g * 128; it.ks = Z0W; it.V = zb + Z_NKV + 5 * 256 + g * 128; it.vs = Z0W;
            it.P0 = qb * 256; it.skv = S; it.W = 512; it.bias = BIAS + (size_t)h * BIAS_LD + 64; it.bstep = 1; it.O = OWIN + (size_t)b * S * 1024 + h * 128; it.os = 1024;
            fa::attn_block<0>(it, lds);
        }
    }
    SEAM(3);
    if (IN(4)) {
        { pg8::Gemm g{Z0 + Z_QLAT, W_UQ, Z0W, 512, 512}; pg8::StaticOrder So; So.init(M, QMW, F.G, (int)blockIdx.x); pg8::EpiBf16 E{QM, QMW, RINV};
          pg8::gemm_phase<pg8::EpiBf16, pg8::StaticOrder, PG_ALIGN, PG_SP2>(ring, g, So, E); }
        __syncthreads();
        { pg8::Gemm g{Z0 + Z_KVLAT, W_UKV, Z0W, 512, 512}; pg8::StaticOrder So; So.init(M, KVMW, F.G, (int)blockIdx.x); pg8::EpiBf16 E{KVM, KVMW, RINV + M};
          pg8::gemm_phase<pg8::EpiBf16, pg8::StaticOrder, PG_ALIGN, PG_SP2>(ring, g, So, E); }
        __syncthreads();
        for (int Lx = blockIdx.x; Lx < 512; Lx += F.G) { const int tb = 63 - Lx / 8, bg = Lx % 8, b = bg >> 1, g = bg & 1;
            fa::CmpItem it; it.Q = Z0 + ((size_t)b * S + tb * 64) * Z0W + Z_NQ + g * 512; it.qs = Z0W; it.K = KC + ((size_t)b * 2 + g) * 256 * 128; it.V = VC + ((size_t)b * 2 + g) * 256 * 128;
            it.bias = BIAS + (size_t)(g * 4) * BIAS_LD + 64; it.bld = BIAS_LD; it.s0 = tb * 64; it.O = OCMP + ((size_t)b * S + tb * 64) * 1024 + g * 512; it.os = 1024; it.sel = SEL + ((size_t)b * S + tb * 64) * 2 + g;

            fa::cmp_block(it, lds, SMALL_OFF); }
    }
    SEAM(4);
    if (IN(5)) {
        for (int Lx = blockIdx.x; Lx < 256; Lx += F.G) {
            const int x = Lx / 32, bh = Lx % 32, b = bh >> 3, h = bh & 7, g = h >> 2; const bf16* zb = Z0 + (size_t)b * S * Z0W;
            for (int pass = 0; pass < 2; ++pass) { const int qb = pass ? 15 - x : x;
                fa::Item it{}; it.Q = zb + Z_NQ + h * 128; it.qs = Z0W; it.K = zb + Z_NKV + 2 * 256 + g * 128; it.ks = Z0W; it.V = zb + Z_NKV + 3 * 256 + g * 128; it.vs = Z0W;
                it.P0 = qb * 256; it.skv = S; it.W = 1 << 20; it.bias = BIAS + (size_t)h * BIAS_LD + 64; it.bstep = 1; it.sel = SEL + (size_t)b * S * 2 + g; it.sels = 2;
                it.O = CAT + (size_t)b * S * 2048 + h * 128; it.os = 2048;
                it.M0 = OCMP + (size_t)b * S * 1024 + h * 128; it.M1 = OWIN + (size_t)b * S * 1024 + h * 128; it.ms = 1024; it.G = zb + Z_NG + h * 3; it.gs = Z0W;
                fa::attn_block<1>(it, lds); }
        }
        for (int Lx = blockIdx.x; Lx < 256; Lx += F.G) {
            const int x = Lx / 32, bh = Lx % 32, b = bh >> 3, h = bh & 7;
            for (int pass = 0; pass < 2; ++pass) { const int qb = pass ? 15 - x : x;
                fa::Item it{}; it.Q = QM + (size_t)b * S * QMW + h * 192; it.qs = QMW; it.rope = ROPE + (size_t)b * S * 64; it.ropes = 64;
                it.K = KVM + (size_t)b * S * KVMW + h * 256; it.ks = KVMW; it.K2 = KPE + (size_t)b * S * 64; it.k2s = 64; it.V = KVM + (size_t)b * S * KVMW + h * 256 + 128; it.vs = KVMW;
                it.P0 = qb * 256; it.skv = S; it.W = 1 << 20; it.O = CAT + (size_t)b * S * 2048 + 1024 + h * 128; it.os = 2048;
                fa::attn_block<2>(it, lds); }
        }
    }
    SEAM(5);
    if (IN(6)) { pg8::Gemm g{CAT, W_OUT0, 2048, 2048, 2048}; pg8::StaticOrder So; So.init(M, D, F.G, (int)blockIdx.x); pg8::EpiResid E{x_in, X, D, MOD + 2 * D, 6 * D, S / 256};
        pg8::gemm_phase<pg8::EpiResid, pg8::StaticOrder, PG_ALIGN, PG_SP2>(ring, g, So, E); }
    SEAM(6);
    if (IN(7)) modnorm_phase(F, X, ffn_norm_g, MOD, 3, H);
    SEAM(7);
    if (IN(8)) { pg8::Gemm g{H, W_GU0, D, D, D}; pg8::StaticOrder So; So.init(M, 2 * FF, F.G, (int)blockIdx.x); pg8::EpiSwiGLU E{ACT, FF};
        pg8::gemm_phase<pg8::EpiSwiGLU, pg8::StaticOrder, PG_ALIGN, PG_SP2>(ring, g, So, E); }
    SEAM(8);
    if (IN(9)) { pg8::Gemm g{ACT, W_DN0, FF, FF, FF}; pg8::StaticOrder So; So.init(M, D, F.G, (int)blockIdx.x); pg8::EpiResid E{X, X, D, MOD + 5 * D, 6 * D, S / 256};
        pg8::gemm_phase<pg8::EpiResid, pg8::StaticOrder, PG_ALIGN, PG_SP2>(ring, g, So, E); }
    SEAM(9);
    if (IN(10)) modnorm_phase<true>(F, X, mix_norm_g + D, MOD + 4 * 12288, 0, H, IN1_ASCALE);
    SEAM(10);
    if (IN(11)) { pg8::Gemm g{H, W_IN1, D / 2, D / 2, D / 2}; pg8::StaticOrder So; So.init(M, Z1W, F.G, (int)blockIdx.x); pg8::EpiBf16S E{Z1, Z1W, 1.0f / (MOE_WSCALE * IN1_ASCALE)};
        pg8::gemm_phase<pg8::EpiBf16S, pg8::StaticOrder, PG_ALIGN, PG_SP2, true, true>(ring, g, So, E); }
    SEAM(11);
    if (IN(12)) {
        for (int Lx = blockIdx.x; Lx < 1536; Lx += F.G) {
            const int p = Lx % 3, r_ = Lx / 3, bh = r_ % 32, sub = r_ / 32, b = bh >> 3, h = bh & 7;
            const int dil = p == 0 ? 1 : (p == 1 ? 4 : 16), res = p == 0 ? 0 : (p == 1 ? (sub & 3) : sub), qb = p == 0 ? sub : (p == 1 ? (sub >> 2) : 0);
            fa::Item it{}; it.Q = Z1 + ((size_t)b * S + res) * Z1W + p * 3072 + h * 128; it.qs = (long)dil * Z1W; it.K = it.Q + 1024; it.ks = it.qs; it.V = it.Q + 2048; it.vs = it.qs;
            it.P0 = qb * 256; it.skv = S / dil; it.W = 129; it.bias = BIAS + (size_t)h * BIAS_LD + 64; it.bstep = dil;
            it.O = OP + (size_t)p * M * 1024 + ((size_t)b * S + res) * 1024 + h * 128; it.os = (long)dil * 1024; it.LSE = LSEB + (size_t)p * M * 8 + ((size_t)b * S + res) * 8 + h; it.lses = (long)dil * 8;
            fa::attn_block<0>(it, lds);
        }
    }
    SEAM(12);
    if (IN(13)) {
        for (int m = F.gw; m < M; m += F.NGW) {
            const int h = F.lane >> 3; const float l0 = LSEB[(size_t)m * 8 + h], l1 = LSEB[(size_t)(M + m) * 8 + h], l2 = LSEB[(size_t)(2 * M + m) * 8 + h];
            const v4u* p0 = (const v4u*)(OP + (size_t)m * 1024) + 2 * F.lane; const v4u* p1 = (const v4u*)(OP + (size_t)(M + m) * 1024) + 2 * F.lane; const v4u* p2 = (const v4u*)(OP + (size_t)(2 * M + m) * 1024) + 2 * F.lane;
            const v4u a0 = p0[0], b0 = p0[1], a1 = p1[0], b1 = p1[1], a2 = p2[0], b2 = p2[1];
            const float mx = fmaxf(l0, fmaxf(l1, l2)); float e0 = __expf(l0 - mx), e1 = __expf(l1 - mx), e2 = __expf(l2 - mx); const float inv = 1.0f / (e0 + e1 + e2); e0 *= inv; e1 *= inv; e2 *= inv;
            v4u oa, ob;
#pragma unroll
            for (int q = 0; q < 4; ++q) { oa[q] = pk2(e0 * bflo(a0[q]) + e1 * bflo(a1[q]) + e2 * bflo(a2[q]), e0 * bfhi(a0[q]) + e1 * bfhi(a1[q]) + e2 * bfhi(a2[q]));
                ob[q] = pk2(e0 * bflo(b0[q]) + e1 * bflo(b1[q]) + e2 * bflo(b2[q]), e0 * bfhi(b0[q]) + e1 * bfhi(b1[q]) + e2 * bfhi(b2[q])); }
            v4u* po = (v4u*)(OM + (size_t)m * 1024) + 2 * F.lane; po[0] = oa; po[1] = ob;
        }
    }
    SEAM(13);
    if (IN(14)) { pg8::Gemm g{OM, W_OUT1, 1024, 1024, 1024}; pg8::StaticOrder So; So.init(M, D, F.G, (int)blockIdx.x); pg8::EpiResid E{X, X, D, MOD + 4 * 12288 + 2 * D, 6 * D, S / 256};
        pg8::gemm_phase<pg8::EpiResid, pg8::StaticOrder, PG_ALIGN, PG_SP2>(ring, g, So, E); }
    SEAM(14);
    if (IN(15)) {
        f32x4* wl = (f32x4*)lds; int* lcnt = (int*)(lds + 65536); int* lbase = lcnt + 8; int* rinfo = lcnt + 16;
        for (int i = F.tid; i < 4096; i += 512) { const int slot = i >> 6, l = i & 63, j = slot >> 3, q = (slot >> 1) & 3, half = slot & 1; wl[i] = *(const f32x4*)(w_router + (size_t)(4 * l + 256 * j + q) * 8 + half * 4); }
        if (F.tid < 8) lcnt[F.tid] = 0;
        __syncthreads();
        for (int k = 0; k < M / 2048; ++k) { const int m = F.gw + k * F.NGW; if (m >= M) break; const int b = m / S; const float* mb = MOD + 4 * 12288 + (size_t)b * 6 * D; f32x4 v[8];
            modnorm_row(X + (size_t)m * D, ffn_norm_g + D, mb + 4 * D, mb + 3 * D, H + (size_t)m * D, F.lane, v);
            float lg[8] = {};
#pragma unroll
            for (int j = 0; j < 8; ++j)
#pragma unroll
                for (int q = 0; q < 4; ++q) { const f32x4 wa = wl[((j * 4 + q) * 2 + 0) * 64 + F.lane], wb = wl[((j * 4 + q) * 2 + 1) * 64 + F.lane]; const float hv = v[j][q];
                    lg[0] += hv * wa.x; lg[1] += hv * wa.y; lg[2] += hv * wa.z; lg[3] += hv * wa.w; lg[4] += hv * wb.x; lg[5] += hv * wb.y; lg[6] += hv * wb.z; lg[7] += hv * wb.w; }
#pragma unroll
            for (int e = 0; e < 8; ++e) lg[e] = wave_sum(lg[e]);
            int e1 = 0; float v1 = lg[0];
#pragma unroll
            for (int e = 1; e < 8; ++e) if (lg[e] > v1) { v1 = lg[e]; e1 = e; }
            int e2 = -1; float v2 = -3.0e38f;
#pragma unroll
            for (int e = 0; e < 8; ++e) if (e != e1 && lg[e] > v2) { v2 = lg[e]; e2 = e; }
            if (F.lane == 0) { const float g1 = 1.0f / (1.0f + __expf(v2 - v1)), g2 = 1.0f - g1;
                const int r1 = __hip_atomic_fetch_add(lcnt + e1, 1, __ATOMIC_RELAXED, __HIP_MEMORY_SCOPE_WORKGROUP), r2 = __hip_atomic_fetch_add(lcnt + e2, 1, __ATOMIC_RELAXED, __HIP_MEMORY_SCOPE_WORKGROUP);
                int* ri = rinfo + (F.wave * 8 + k) * 8; ri[0] = e1; ri[1] = e2; ri[2] = r1; ri[3] = r2; ri[4] = __float_as_int(g1); ri[5] = __float_as_int(g2); }
        }
        __syncthreads();
        if (F.tid < 8) lbase[F.tid] = (int)atomicAdd(ctl + CW_CNT + F.tid, (unsigned)lcnt[F.tid]);
        __syncthreads();
        if (F.lane == 0) for (int k = 0; k < M / 2048; ++k) { const int m = F.gw + k * F.NGW; if (m >= M) break; const int* ri = rinfo + (F.wave * 8 + k) * 8; int* rt = ROUTE + (size_t)m * 8;
            rt[0] = ri[0]; rt[1] = ri[1]; rt[2] = ri[2] + lbase[ri[0]]; rt[3] = ri[3] + lbase[ri[1]]; rt[4] = ri[4]; rt[5] = ri[5]; }
    }
    SEAM(15);
    if (IN(16)) {
        unsigned ts[9]; ts[0] = 0;
#pragma unroll
        for (int e = 0; e < 8; ++e) ts[e + 1] = ts[e] + (__hip_atomic_load(ctl + CW_CNT + e, __ATOMIC_RELAXED, __HIP_MEMORY_SCOPE_AGENT) + 255u) / 256u;
        if (blockIdx.x == 0 && F.tid < 9) { unsigned v = ts[0];
#pragma unroll
            for (int e = 1; e < 9; ++e) v = (F.tid == e) ? ts[e] : v;
            ctl[CW_TS + F.tid] = v; }
        for (int m = F.gw; m < M; m += F.NGW) { const int* rt = ROUTE + (size_t)m * 8; const int e1 = rt[0], e2 = rt[1]; unsigned t1 = 0, t2 = 0;
#pragma unroll
            for (int e = 0; e < 8; ++e) { t1 = (e == e1) ? ts[e] : t1; t2 = (e == e2) ? ts[e] : t2; }
            const size_t d1 = (size_t)t1 * 256 + rt[2], d2 = (size_t)t2 * 256 + rt[3];
            const v4u* src = (const v4u*)(H + (size_t)m * D) + F.lane;
            v2u* o1 = (v2u*)((unsigned char*)XB + d1 * D) + F.lane; v2u* o2 = (v2u*)((unsigned char*)XB + d2 * D) + F.lane;
#pragma unroll
            for (int j = 0; j < 4; ++j) { const v4u w = src[64 * j]; v2u q; q.x = pk4_fp8(bflo(w.x), bfhi(w.x), bflo(w.y), bfhi(w.y)); q.y = pk4_fp8(bflo(w.z), bfhi(w.z), bflo(w.w), bfhi(w.w)); o1[64 * j] = q; o2[64 * j] = q; } }
    }
    SEAM(16);
    if (IN(17)) { pg8::Gemm g{XB, W_MGU, D / 2, D / 2, D / 2}; pg8::GroupedOrder So; So.init(ctl + CW_TS, 2 * FFE / 256, F.G, (int)blockIdx.x); pg8::EpiSwiGLU8 E{(unsigned char*)ACTB, FFE, 1.0f / MOE_WSCALE, MOE_ASCALE};
        pg8::gemm_phase<pg8::EpiSwiGLU8, pg8::GroupedOrder, PG_ALIGN, PG_SP2, true, true>(ring, g, So, E); }
    SEAM(17);
    if (IN(18)) { pg8::Gemm g{ACTB, W_MDN, FFE / 2, FFE / 2, FFE / 2}; pg8::GroupedOrder So; So.init(ctl + CW_TS, D / 256, F.G, (int)blockIdx.x); pg8::EpiBf16S E{YB, D, 1.0f / (MOE_WSCALE * MOE_ASCALE)};
        pg8::gemm_phase<pg8::EpiBf16S, pg8::GroupedOrder, PG_ALIGN, PG_SP2, true, true>(ring, g, So, E); }
    SEAM(18);
    if (IN(19)) {
        unsigned ts[9]; ts[0] = 0;
#pragma unroll
        for (int e = 0; e < 8; ++e) ts[e + 1] = ctl[CW_TS + e + 1];
#pragma unroll
        for (int b = 0; b < NB; ++b) {
            const float* gf = MOD + 4 * 12288 + (size_t)b * 6 * D + 5 * D;
            const int m0 = b * S + F.gw, m1 = m0 + F.NGW;
            const int* rt0 = ROUTE + (size_t)m0 * 8; const int* rt1 = ROUTE + (size_t)m1 * 8;
            const int e10 = rt0[0], e20 = rt0[1], r10 = rt0[2], r20 = rt0[3], e11 = rt1[0], e21 = rt1[1], r11 = rt1[2], r21 = rt1[3];
            const float g10 = __int_as_float(rt0[4]), g20 = __int_as_float(rt0[5]), g11 = __int_as_float(rt1[4]), g21 = __int_as_float(rt1[5]);
            unsigned t10 = 0, t20 = 0, t11 = 0, t21 = 0;
#pragma unroll
            for (int e = 0; e < 8; ++e) { t10 = (e == e10) ? ts[e] : t10; t20 = (e == e20) ? ts[e] : t20; t11 = (e == e11) ? ts[e] : t11; t21 = (e == e21) ? ts[e] : t21; }
            const v2u* ya0 = (const v2u*)(YB + ((size_t)t10 * 256 + r10) * D) + F.lane; const v2u* yb0 = (const v2u*)(YB + ((size_t)t20 * 256 + r20) * D) + F.lane;
            const v2u* ya1 = (const v2u*)(YB + ((size_t)t11 * 256 + r11) * D) + F.lane; const v2u* yb1 = (const v2u*)(YB + ((size_t)t21 * 256 + r21) * D) + F.lane;
            const f32x4* x0 = (const f32x4*)(X + (size_t)m0 * D) + F.lane; const f32x4* x1 = (const f32x4*)(X + (size_t)m1 * D) + F.lane;
            f32x4 v0[8], v1[8]; v2u a0[8], c0[8], a1[8], c1[8];
#pragma unroll
            for (int j = 0; j < 8; ++j) { v0[j] = x0[64 * j]; v1[j] = x1[64 * j]; a0[j] = ya0[64 * j]; c0[j] = yb0[64 * j]; a1[j] = ya1[64 * j]; c1[j] = yb1[64 * j]; }
            float q0 = 0.f, q1 = 0.f;
#pragma unroll
            for (int j = 0; j < 8; ++j) { const f32x4 gg = ((const f32x4*)gf)[F.lane + 64 * j]; f32x4 y;
                y.x = g10 * bflo(a0[j].x) + g20 * bflo(c0[j].x); y.y = g10 * bfhi(a0[j].x) + g20 * bfhi(c0[j].x); y.z = g10 * bflo(a0[j].y) + g20 * bflo(c0[j].y); y.w = g10 * bfhi(a0[j].y) + g20 * bfhi(c0[j].y);
                v0[j] = v0[j] + gg * y; q0 += (v0[j].x * v0[j].x + v0[j].y * v0[j].y) + (v0[j].z * v0[j].z + v0[j].w * v0[j].w);
                y.x = g11 * bflo(a1[j].x) + g21 * bflo(c1[j].x); y.y = g11 * bfhi(a1[j].x) + g21 * bfhi(c1[j].x); y.z = g11 * bflo(a1[j].y) + g21 * bflo(c1[j].y); y.w = g11 * bfhi(a1[j].y) + g21 * bfhi(c1[j].y);
                v1[j] = v1[j] + gg * y; q1 += (v1[j].x * v1[j].x + v1[j].y * v1[j].y) + (v1[j].z * v1[j].z + v1[j].w * v1[j].w); }
            const float ri0 = 1.0f / sqrtf(wave_sum(q0) * (1.f / D) + RMS_EPS), ri1 = 1.0f / sqrtf(wave_sum(q1) * (1.f / D) + RMS_EPS);
            f32x4* o0 = (f32x4*)(args.out + (size_t)m0 * D) + F.lane; f32x4* o1 = (f32x4*)(args.out + (size_t)m1 * D) + F.lane;
#pragma unroll
            for (int j = 0; j < 8; ++j) { const f32x4 fg = ((const f32x4*)final_g)[F.lane + 64 * j]; o0[64 * j] = (v0[j] * ri0) * fg; o1[64 * j] = (v1[j] * ri1) * fg; }
        }
    }
#undef IN
#undef SEAM
}

constexpr int N_PHASES = 20;
extern "C" void kernel_launch(void* const* d_in, const int* in_sizes, int n_in, void* d_out, int out_size, void* d_ws, size_t ws_size, hipStream_t stream) {
    static int grid = 0;
    if (grid == 0) {
        if (n_in != 30 || in_sizes[0] != M * D || out_size != M * D || ws_size < WS_END) { fprintf(stderr, "kernel_launch: shape/workspace mismatch: n_in %d in0 %d out %d ws %zu (need %zu)\n", n_in, n_in > 0 ? in_sizes[0] : -1, out_size, ws_size, (size_t)WS_END); grid = -1; return; }
        int dev = 0, cus = 0, per_cu = 0;
        if (hipGetDevice(&dev) != hipSuccess || hipDeviceGetAttribute(&cus, hipDeviceAttributeMultiprocessorCount, dev) != hipSuccess) { grid = -1; return; }
        if (hipFuncSetAttribute((const void*)fwd, hipFuncAttributeMaxDynamicSharedMemorySize, LDS_BYTES) != hipSuccess) { fprintf(stderr, "kernel_launch: hipFuncSetAttribute failed\n"); grid = -1; return; }
        if (hipOccupancyMaxActiveBlocksPerMultiprocessor(&per_cu, (const void*)fwd, NWAVES * 64, LDS_BYTES) != hipSuccess || per_cu < 1) fprintf(stderr, "kernel_launch: occupancy query reports %d\n", per_cu);
        (void)hipGetLastError();
        grid = cus;
        if (grid != 256) { fprintf(stderr, "kernel_launch: built for a 256-CU device (got %d)\n", cus); grid = -1; return; }
    }
    if (grid < 0) return;
    if (hipMemsetAsync((char*)d_ws + WS_CTL, 0, CTL_ZERO_BYTES, stream) != hipSuccess) return;
    Args a{};
    for (int i = 0; i < 30; ++i) a.in[i] = d_in[i];
    a.out = (float*)d_out; a.ws = (unsigned char*)d_ws;
    if (MK_N_LAUNCHES == 1) { a.ph_lo = 0; a.ph_hi = N_PHASES; hipLaunchKernelGGL(fwd, dim3(grid), dim3(NWAVES * 64), LDS_BYTES, stream, a); }
    else { for (int p = 0; p < N_PHASES; ++p) { a.ph_lo = p; a.ph_hi = p + 1; hipLaunchKernelGGL(fwd, dim3(grid), dim3(NWAVES * 64), LDS_BYTES, stream, a); } }
    const hipError_t le = hipPeekAtLastError();
    if (le != hipSuccess) fprintf(stderr, "kernel_launch: launch failed: %s\n", hipGetErrorName(le));
}
```

```cpp
#include <hip/hip_runtime.h>
#include <cstdio>
#include <cstdint>

#define WGM_G 8
#define PG_ALIGN true
#define PG_SP2 true
#ifndef MK_N_LAUNCHES
#define MK_N_LAUNCHES 1
#endif

namespace pg8 {
#define PG8_LAS __attribute__((address_space(3)))
typedef unsigned short bf16_t;
typedef short bf16x8 __attribute__((ext_vector_type(8)));
typedef float f32x4 __attribute__((ext_vector_type(4)));
typedef float f32x2 __attribute__((ext_vector_type(2)));
typedef unsigned u32x4 __attribute__((ext_vector_type(4)));
typedef unsigned u32x2 __attribute__((ext_vector_type(2)));
constexpr int BM = 256, BK = 64, HALF = 128, HTB = HALF * BK * 2  , STAGE_BYTES = 8 * HTB, NXCD = 8, WGM = 8;

__host__ __device__ __forceinline__ int lds_byte(int r, int c) { const int st = (r >> 4) * 2 + (c >> 5), rr = r & 15, cc = c & 31, ob = rr * 64 + cc * 2; return st * 1024 + (ob ^ (((ob >> 9) & 1) << 5)); }
__host__ __device__ __forceinline__ void stage_rc(int b, int& R, int& C) { const int st = b / 1024, sb = b % 1024, swz = sb ^ (((sb >> 9) & 1) << 5); R = (st >> 1) * 16 + swz / 64; C = (st & 1) * 32 + (swz % 64) / 2; }
__host__ __device__ __forceinline__ int perm32(int rho) { const int n = rho >> 4, i = rho & 15; return 8 * (i >> 2) + 4 * n + (i & 3); }

struct Unit { int pm, pn, pb; };
struct Gemm { const bf16_t* A; const bf16_t* Bt; int lda, ldb, K; };

struct StaticOrder {
    int nM, nN, nwg, G, c;
    __host__ __device__ void init(int M, int N, int G_, int c_) { nM = M / BM; nN = N / BM; nwg = nM * nN; G = G_; c = c_; }
    __host__ __device__ bool next(int i, Unit& u) const {
        const long L = (long)i * G + c; if (L >= nwg) return false;
        int wgid = (int)L; { const int q = nwg / NXCD, r = nwg % NXCD, xcd = wgid % NXCD, off = wgid / NXCD; wgid = (xcd < r ? xcd * (q + 1) : r * (q + 1) + (xcd - r) * q) + off; }
        const int nig = WGM * nN, gid = wgid / nig, fm = gid * WGM, gsz = (nM - fm) < WGM ? (nM - fm) : WGM;
        u.pm = fm + ((wgid % nig) % gsz); u.pn = (wgid % nig) / gsz; u.pb = u.pn; return true;
    }
    __device__ __forceinline__ void a_ready(const Unit&) const {}
    __device__ __forceinline__ void done(const Unit&) const {}
};
#ifndef WGM_G
#endif
struct GroupedOrder {
    int nN, G, c; int ts[9];
    __device__ __forceinline__ void init(const unsigned* tstart, int nN_, int G_, int c_) { nN = nN_; G = G_; c = c_;
#pragma unroll
        for (int e = 0; e < 9; ++e) ts[e] = (int)tstart[e]; }
    __device__ __forceinline__ bool next(int i, Unit& u) const {
        const long L = (long)i * G + c; if (L >= (long)ts[8] * nN) return false;
        int e = 0, us = 0, te = ts[1] - ts[0], t0 = ts[0];
#pragma unroll
        for (int k = 1; k < 8; ++k) { const int s = ts[k] * nN; if (L >= s) { e = k; us = s; te = ts[k + 1] - ts[k]; t0 = ts[k]; } }
        if (te <= 0) return false;
        int wgid = (int)L - us; { const int nwg = te * nN, q = nwg / NXCD, rr = nwg % NXCD, xcd = wgid % NXCD, off = wgid / NXCD; wgid = (xcd < rr ? xcd * (q + 1) : rr * (q + 1) + (xcd - rr) * q) + off; }
        const int nig = WGM_G * nN, gid = wgid / nig, fm = gid * WGM_G, gsz = (te - fm) < WGM_G ? (te - fm) : WGM_G;
        u.pm = t0 + fm + ((wgid % nig) % gsz); u.pn = (wgid % nig) / gsz; u.pb = e * nN + u.pn; return true;
    }
    __device__ __forceinline__ void a_ready(const Unit&) const {}
    __device__ __forceinline__ void done(const Unit&) const {}
};

typedef __bf16 bf16x2c __attribute__((ext_vector_type(2)));
__device__ __forceinline__ unsigned cvt_pk_bf16(float lo, float hi) { const f32x2 v = {lo, hi}; return __builtin_bit_cast(unsigned, __builtin_convertvector(v, bf16x2c)); }

struct EpiBf16 {
    static constexpr bool PERM = true, AFTER_DRAIN = false;
    bf16_t* O; int ldc; const float* rowscale;
    __device__ __forceinline__ void operator()(const f32x4 (&acc)[2][2][4][2], const Unit& u, int wr, int wc, int fr, int fq) const {
        const int row0 = u.pm * BM + wr * 64 + fr; const int col0 = u.pn * BM + wc * 32 + 8 * fq;
#pragma unroll
        for (int ai = 0; ai < 2; ++ai)
#pragma unroll
            for (int m = 0; m < 4; ++m) { const int row = row0 + ai * HALF + m * 16; bf16_t* rowp = O + (size_t)row * ldc + col0; const float sc = rowscale ? rowscale[row] : 1.f;
#pragma unroll
                for (int bj = 0; bj < 2; ++bj) { f32x4 v0 = acc[ai][bj][m][0] * sc, v1 = acc[ai][bj][m][1] * sc;
                    u32x4 w; w.x = cvt_pk_bf16(v0[0], v0[1]); w.y = cvt_pk_bf16(v0[2], v0[3]); w.z = cvt_pk_bf16(v1[0], v1[1]); w.w = cvt_pk_bf16(v1[2], v1[3]);
                    *(u32x4*)(rowp + bj * HALF) = w; } }
    }
};
struct EpiResid {
    static constexpr bool PERM = false, AFTER_DRAIN = false;
    const float* xin; float* xout; int ldc; const float* gate; int gstride; int tiles_per_b; float s = 1.0f;
    __device__ __forceinline__ void operator()(const f32x4 (&acc)[2][2][4][2], const Unit& u, int wr, int wc, int fr, int fq) const {
        const int row0 = u.pm * BM + wr * 64 + fr, col0 = u.pn * BM + wc * 32 + 4 * fq;
        const float* gp = gate + (size_t)(u.pm / tiles_per_b) * gstride + col0;
        f32x4 gv[2][2];
#pragma unroll
        for (int bj = 0; bj < 2; ++bj)
#pragma unroll
            for (int n = 0; n < 2; ++n) gv[bj][n] = *(const f32x4*)(gp + bj * HALF + n * 16) * s;
#pragma unroll
        for (int ai = 0; ai < 2; ++ai)
#pragma unroll
            for (int m = 0; m < 4; ++m) { const size_t off = (size_t)(row0 + ai * HALF + m * 16) * ldc + col0;
#pragma unroll
                for (int bj = 0; bj < 2; ++bj)
#pragma unroll
                    for (int n = 0; n < 2; ++n) { const f32x4 xi = *(const f32x4*)(xin + off + bj * HALF + n * 16);
                        *(f32x4*)(xout + off + bj * HALF + n * 16) = xi + gv[bj][n] * acc[ai][bj][m][n]; }
                asm volatile("" ::: "memory"); }
    }
};
__device__ __forceinline__ float silu_f(float g) { return g * __builtin_amdgcn_rcpf(1.0f + __builtin_amdgcn_exp2f(-1.4426950408889634f * g)); }
struct EpiSwiGLU {
    static constexpr bool PERM = false, AFTER_DRAIN = false;
    bf16_t* O; int ldo;
    __device__ __forceinline__ void operator()(const f32x4 (&acc)[2][2][4][2], const Unit& u, int wr, int wc, int fr, int fq) const {
        const int row0 = u.pm * BM + wr * 64 + fr, col0 = u.pn * HALF + wc * 16 + 4 * fq;
#pragma unroll
        for (int ai = 0; ai < 2; ++ai)
#pragma unroll
            for (int m = 0; m < 4; ++m) { bf16_t* rowp = O + (size_t)(row0 + ai * HALF + m * 16) * ldo + col0;
#pragma unroll
                for (int bj = 0; bj < 2; ++bj) { const f32x4 g = acc[ai][bj][m][0], up = acc[ai][bj][m][1];
                    u32x2 w; w.x = cvt_pk_bf16(silu_f(g[0]) * up[0], silu_f(g[1]) * up[1]); w.y = cvt_pk_bf16(silu_f(g[2]) * up[2], silu_f(g[3]) * up[3]);
                    *(u32x2*)(rowp + bj * 64) = w; } }
    }
};
struct EpiSwiGLU8 {
    static constexpr bool PERM = false, AFTER_DRAIN = false;
    unsigned char* O8; int ldo; float s, so;
    __device__ __forceinline__ void operator()(const f32x4 (&acc)[2][2][4][2], const Unit& u, int wr, int wc, int fr, int fq) const {
        const int row0 = u.pm * BM + wr * 64 + fr, col0 = u.pn * HALF + wc * 16 + 4 * fq;
#pragma unroll
        for (int ai = 0; ai < 2; ++ai)
#pragma unroll
            for (int m = 0; m < 4; ++m) { const size_t off = (size_t)(row0 + ai * HALF + m * 16) * ldo + col0;
#pragma unroll
                for (int bj = 0; bj < 2; ++bj) { const f32x4 g = acc[ai][bj][m][0] * s, up = acc[ai][bj][m][1] * s;
                    const float v0 = silu_f(g[0]) * up[0], v1 = silu_f(g[1]) * up[1], v2 = silu_f(g[2]) * up[2], v3 = silu_f(g[3]) * up[3];
                    int w = 0; w = __builtin_amdgcn_cvt_pk_fp8_f32(__builtin_amdgcn_fmed3f(v0 * so, -440.f, 440.f), __builtin_amdgcn_fmed3f(v1 * so, -440.f, 440.f), w, false);
                    w = __builtin_amdgcn_cvt_pk_fp8_f32(__builtin_amdgcn_fmed3f(v2 * so, -440.f, 440.f), __builtin_amdgcn_fmed3f(v3 * so, -440.f, 440.f), w, true); *(int*)(O8 + off + bj * 64) = w; } }
    }
};
struct EpiBf16S {
    static constexpr bool PERM = true, AFTER_DRAIN = false;
    bf16_t* O; int ldc; float s;
    __device__ __forceinline__ void operator()(const f32x4 (&acc)[2][2][4][2], const Unit& u, int wr, int wc, int fr, int fq) const {
        const int row0 = u.pm * BM + wr * 64 + fr; const int col0 = u.pn * BM + wc * 32 + 8 * fq;
#pragma unroll
        for (int ai = 0; ai < 2; ++ai)
#pragma unroll
            for (int m = 0; m < 4; ++m) { bf16_t* rowp = O + (size_t)(row0 + ai * HALF + m * 16) * ldc + col0;
#pragma unroll
                for (int bj = 0; bj < 2; ++bj) { const f32x4 v0 = acc[ai][bj][m][0] * s, v1 = acc[ai][bj][m][1] * s;
                    u32x4 w; w.x = cvt_pk_bf16(v0[0], v0[1]); w.y = cvt_pk_bf16(v0[2], v0[3]); w.z = cvt_pk_bf16(v1[0], v1[1]); w.w = cvt_pk_bf16(v1[2], v1[3]);
                    *(u32x4*)(rowp + bj * HALF) = w; } }
    }
};

template <class Epi, class Sched, bool ALIGN_EPI = false, bool SP2 = false, bool F8 = false, bool FW = false>
__device__ __forceinline__ void gemm_phase(PG8_LAS unsigned char* lds, const Gemm g, const Sched& S, const Epi& E) {
    const int tid = threadIdx.x, wid = __builtin_amdgcn_readfirstlane(tid >> 6), lane = tid & 63, wr = wid >> 2, wc = wid & 3, fr = lane & 15, fq = lane >> 4;
    const int K = g.K, nt = K / BK;
    unsigned voffA[2], voffB[2];
#pragma unroll
    for (int i = 0; i < 2; ++i) { int R, C; stage_rc(tid * 16 + i * 8192, R, C); const int Rb = Epi::PERM ? ((R & ~31) + perm32(R & 31)) : R;
        voffA[i] = (unsigned)(R * g.lda + C) * 2u; voffB[i] = (unsigned)(Rb * g.ldb + C) * 2u; }
    const size_t kstep = (size_t)(BK * 2);
    const size_t hstepA = (size_t)HALF * g.lda * 2, hstepB = (size_t)HALF * g.ldb * 2;
    const size_t tstepA = 2 * hstepA, tstepB = (F8 && !FW) ? hstepB : 2 * hstepB;
    const unsigned ldsw = (unsigned)wid * 1024u;
    const int aoff = lds_byte(wr * 64 + fr, fq * 8), boff = lds_byte(wc * 32 + fr, fq * 8);
#define PG8_SA(b, h) (((b) * 2 + (h)) * HTB)
#define PG8_SB(b, h) ((4 + (b) * 2 + (h)) * HTB)
#define PG8_STAGE(bufoff, gbase, voff) do { _Pragma("unroll") for (int _i = 0; _i < 2; ++_i) \
        __builtin_amdgcn_global_load_lds((const unsigned*)((const char*)(gbase) + (voff)[_i]), (PG8_LAS unsigned*)(lds + (bufoff) + ldsw + _i * 8192), 16, 0, 0); } while (0)
#define PG8_LDA(dst, b, h) do { _Pragma("unroll") for (int m = 0; m < 4; ++m) _Pragma("unroll") for (int k = 0; k < 2; ++k) dst[m][k] = *(const PG8_LAS bf16x8*)(lds + PG8_SA(b, h) + aoff + m * 2048 + k * 1024); } while (0)
#define PG8_LDB(dst, b, h) do { if constexpr (!F8 || FW || (h) == 0) { _Pragma("unroll") for (int n = 0; n < 2; ++n) _Pragma("unroll") for (int k = 0; k < 2; ++k) dst[n][k] = *(const PG8_LAS bf16x8*)(lds + PG8_SB(b, h) + boff + n * 2048 + k * 1024); } } while (0)
#define PG8_CAT(x, y) __builtin_shufflevector(x, y, 0, 1, 2, 3, 4, 5, 6, 7, 8, 9, 10, 11, 12, 13, 14, 15)
#define PG8_MMA(ai, bj, At, Bt) do { if constexpr (!F8 || FW || (bj) == 0) { __builtin_amdgcn_s_setprio(1); \
        if constexpr (F8) { _Pragma("unroll") for (int m = 0; m < 4; ++m) _Pragma("unroll") for (int n = 0; n < 2; ++n) \
            { const v8i_ b8_ = __builtin_bit_cast(v8i_, PG8_CAT(Bt[n][0], Bt[n][1])), a8_ = __builtin_bit_cast(v8i_, PG8_CAT(At[m][0], At[m][1])); \
            if constexpr (FW) asm volatile("v_mfma_scale_f32_16x16x128_f8f6f4 %0, %1, %2, %0, %3, %3 op_sel_hi:[0,0,0]" : "+v"(acc[ai][bj][m][n]) : "v"(b8_), "v"(a8_), "v"(0x7f7f7f7f)); \
            else acc[ai][bj][m][n] = __builtin_amdgcn_mfma_scale_f32_16x16x128_f8f6f4(b8_, a8_, acc[ai][bj][m][n], 0, 0, 0, 0x7f7f7f7f, 0, 0x7f7f7f7f); } } \
        else { _Pragma("unroll") for (int m = 0; m < 4; ++m) _Pragma("unroll") for (int n = 0; n < 2; ++n) _Pragma("unroll") for (int k = 0; k < 2; ++k) \
            acc[ai][bj][m][n] = __builtin_amdgcn_mfma_f32_16x16x32_bf16(Bt[n][k], At[m][k], acc[ai][bj][m][n], 0, 0, 0); } \
        __builtin_amdgcn_s_setprio(0); } } while (0)
#define PG8_WAIT_V(n) asm volatile("s_waitcnt vmcnt(" #n ")" ::: "memory")
#define PG8_WAIT_L(n) asm volatile("s_waitcnt lgkmcnt(" #n ")" ::: "memory")
#define PG8_BAR __builtin_amdgcn_s_barrier()
#define PG8_SCHED __builtin_amdgcn_sched_barrier(0)
    Unit cur, nxt; int ui = 0;
    if (!S.next(0, cur)) return;
    f32x4 acc[2][2][4][2];
#pragma unroll
    for (int a = 0; a < 2; ++a)
#pragma unroll
        for (int b = 0; b < 2; ++b)
#pragma unroll
            for (int m = 0; m < 4; ++m)
#pragma unroll
                for (int n = 0; n < 2; ++n) acc[a][b][m][n] = (f32x4){0.f, 0.f, 0.f, 0.f};
    bf16x8 At[4][2], B0[2][2], B1[2][2];
    typedef int v8i_ __attribute__((ext_vector_type(8))); typedef short bf16x16_ __attribute__((ext_vector_type(16)));
    const char* cA = (const char*)g.A + (size_t)cur.pm * tstepA; const char* cB = (const char*)g.Bt + (size_t)cur.pb * tstepB;
    S.a_ready(cur);
    if constexpr (SP2) {
        PG8_STAGE(PG8_SB(0, 0), cB, voffB); if constexpr (!F8 || FW) PG8_STAGE(PG8_SB(0, 1), cB + hstepB, voffB); PG8_STAGE(PG8_SA(0, 0), cA, voffA); PG8_STAGE(PG8_SA(0, 1), cA + hstepA, voffA);
        if (wr == 1) PG8_BAR;
        PG8_WAIT_V(2); PG8_BAR;
        PG8_STAGE(PG8_SB(1, 0), cB + kstep, voffB); PG8_STAGE(PG8_SA(1, 0), cA + kstep, voffA); if constexpr (!F8 || FW) PG8_STAGE(PG8_SB(1, 1), cB + hstepB + kstep, voffB);
        if constexpr (F8 && !FW) PG8_WAIT_V(4); else PG8_WAIT_V(6); PG8_BAR;
    } else {
        PG8_STAGE(PG8_SB(0, 0), cB, voffB); PG8_STAGE(PG8_SA(0, 0), cA, voffA); PG8_STAGE(PG8_SB(0, 1), cB + hstepB, voffB); PG8_STAGE(PG8_SA(0, 1), cA + hstepA, voffA);
        if (wr == 1) PG8_BAR;
        PG8_WAIT_V(4); PG8_BAR;
        PG8_STAGE(PG8_SB(1, 0), cB + kstep, voffB); PG8_STAGE(PG8_SA(1, 0), cA + kstep, voffA); PG8_STAGE(PG8_SB(1, 1), cB + hstepB + kstep, voffB);
        PG8_WAIT_V(6); PG8_BAR;
    }
    for (;;) {
        const bool has_next = S.next(ui + 1, nxt);
        const char* nA = has_next ? (const char*)g.A + (size_t)nxt.pm * tstepA : cA; const char* nB = has_next ? (const char*)g.Bt + (size_t)nxt.pb * tstepB : cB;
        for (int t = 0; t < nt; t += 2) {
            const bool last = (t == nt - 2);
            const char* a1 = cA + (size_t)(t + 1) * kstep;
            const char* a2 = last ? nA : cA + (size_t)(t + 2) * kstep; const char* b2 = last ? nB : cB + (size_t)(t + 2) * kstep;
            const char* a3 = a2 + kstep; const char* b3 = b2 + kstep;
            if (last && has_next) S.a_ready(nxt);
            if constexpr (SP2) {
            PG8_LDB(B0, 0, 0); PG8_LDB(B1, 0, 1); PG8_SCHED; PG8_LDA(At, 0, 0); PG8_STAGE(PG8_SA(1, 1), a1 + hstepA, voffA);
            if constexpr (F8 && !FW) PG8_WAIT_V(6); else PG8_WAIT_V(8); PG8_WAIT_L(0); PG8_BAR; PG8_MMA(0, 0, At, B0); PG8_MMA(0, 1, At, B1); PG8_BAR; PG8_SCHED;
            PG8_LDA(At, 0, 1); PG8_STAGE(PG8_SB(0, 0), b2, voffB); if constexpr (!F8 || FW) PG8_STAGE(PG8_SB(0, 1), b2 + hstepB, voffB); PG8_STAGE(PG8_SA(0, 0), a2, voffA);
            if constexpr (F8 && !FW) PG8_WAIT_V(6); else PG8_WAIT_V(8); PG8_WAIT_L(0); PG8_BAR; PG8_MMA(1, 0, At, B0); PG8_MMA(1, 1, At, B1); PG8_BAR; PG8_SCHED;
            PG8_LDB(B0, 1, 0); PG8_LDB(B1, 1, 1); PG8_SCHED; PG8_LDA(At, 1, 0); PG8_STAGE(PG8_SA(0, 1), a2 + hstepA, voffA);
            if constexpr (F8 && !FW) PG8_WAIT_V(6); else PG8_WAIT_V(8); PG8_WAIT_L(0); PG8_BAR; PG8_MMA(0, 0, At, B0); PG8_MMA(0, 1, At, B1); PG8_BAR; PG8_SCHED;
            PG8_LDA(At, 1, 1); PG8_STAGE(PG8_SB(1, 0), b3, voffB); if constexpr (!F8 || FW) PG8_STAGE(PG8_SB(1, 1), b3 + hstepB, voffB); PG8_STAGE(PG8_SA(1, 0), a3, voffA);
            if constexpr (F8 && !FW) PG8_WAIT_V(6); else PG8_WAIT_V(8); PG8_WAIT_L(0); PG8_BAR; PG8_MMA(1, 0, At, B0); PG8_MMA(1, 1, At, B1); PG8_BAR; PG8_SCHED;
            } else {
            PG8_LDB(B0, 0, 0); PG8_SCHED; PG8_LDA(At, 0, 0); PG8_STAGE(PG8_SA(1, 1), a1 + hstepA, voffA);
            PG8_WAIT_L(8); PG8_BAR; PG8_WAIT_L(0); PG8_MMA(0, 0, At, B0); PG8_BAR; PG8_SCHED;
            PG8_LDB(B1, 0, 1); PG8_STAGE(PG8_SB(0, 0), b2, voffB);
            PG8_BAR; PG8_WAIT_L(0); PG8_MMA(0, 1, At, B1); PG8_BAR;
            PG8_LDA(At, 0, 1); PG8_STAGE(PG8_SA(0, 0), a2, voffA);
            PG8_BAR; PG8_WAIT_L(0); PG8_MMA(1, 0, At, B0); PG8_BAR; PG8_SCHED;
            PG8_STAGE(PG8_SB(0, 1), b2 + hstepB, voffB);
            PG8_WAIT_V(6); PG8_BAR; PG8_MMA(1, 1, At, B1); PG8_BAR;
            PG8_LDB(B0, 1, 0); PG8_SCHED; PG8_LDA(At, 1, 0); PG8_STAGE(PG8_SA(0, 1), a2 + hstepA, voffA);
            PG8_WAIT_L(8); PG8_BAR; PG8_WAIT_L(0); PG8_MMA(0, 0, At, B0); PG8_BAR; PG8_SCHED;
            PG8_LDB(B1, 1, 1); PG8_STAGE(PG8_SB(1, 0), b3, voffB);
            PG8_BAR; PG8_WAIT_L(0); PG8_MMA(0, 1, At, B1); PG8_BAR;
            PG8_LDA(At, 1, 1); PG8_STAGE(PG8_SA(1, 0), a3, voffA);
            PG8_BAR; PG8_WAIT_L(0); PG8_MMA(1, 0, At, B0); PG8_BAR; PG8_SCHED;
            PG8_STAGE(PG8_SB(1, 1), b3 + hstepB, voffB);
            PG8_WAIT_V(6); PG8_BAR; PG8_MMA(1, 1, At, B1); PG8_BAR;
            }
        }
        if constexpr (ALIGN_EPI) { if (wr == 0) PG8_BAR; }
        if constexpr (F8 && FW) asm volatile("s_nop 15\n\ts_nop 15" ::: "memory");
        if constexpr (!Epi::AFTER_DRAIN) { E(acc, cur, wr, wc, fr, fq); S.done(cur); }
        if (!has_next) break;
#pragma unroll
        for (int a = 0; a < 2; ++a)
#pragma unroll
            for (int b = 0; b < 2; ++b)
#pragma unroll
                for (int m = 0; m < 4; ++m)
#pragma unroll
                    for (int n = 0; n < 2; ++n) acc[a][b][m][n] = (f32x4){0.f, 0.f, 0.f, 0.f};
        cur = nxt; cA = nA; cB = nB; ++ui;
        if constexpr (ALIGN_EPI) { if (wr == 1) PG8_BAR; }
    }
    PG8_WAIT_V(0);
    if constexpr (!ALIGN_EPI) { if (wr == 0) PG8_BAR; }
    PG8_BAR;
    if constexpr (Epi::AFTER_DRAIN) { E.fused(acc, cur, wr, wc, fr, fq, lds, wid, lane); S.done(cur); }
#undef PG8_SA
#undef PG8_SB
#undef PG8_STAGE
#undef PG8_CAT
#undef PG8_LDA
#undef PG8_LDB
#undef PG8_MMA
#undef PG8_WAIT_V
#undef PG8_WAIT_L
#undef PG8_BAR
#undef PG8_SCHED
}

}

namespace fa {
#define FA_LAS __attribute__((address_space(3)))
typedef unsigned short bf16;
typedef short bf16x8 __attribute__((ext_vector_type(8)));
typedef short s16x4 __attribute__((ext_vector_type(4)));
typedef float f32x16 __attribute__((ext_vector_type(16)));
typedef float f32x4 __attribute__((ext_vector_type(4)));
typedef unsigned u32x4 __attribute__((ext_vector_type(4)));
constexpr int QB = 256, QBLK = 32, KVBLK = 64;
constexpr int SHM_K = 16384, SHM_V = 16384, SHM_K2 = 8192;
constexpr int OFF_V = 0, OFF_K = 2 * SHM_V, OFF_K2 = OFF_K + 2 * SHM_K, OFF_WS = OFF_K2 + 2 * SHM_K2, WS_PER_WAVE = 1024, OFF_TAB = OFF_WS + 8 * WS_PER_WAVE;
constexpr int TAB_PAD = 320, TAB_MAX = 4096 + TAB_PAD;
constexpr int LDS_END = OFF_TAB + TAB_MAX * 4;
constexpr int OSTG = 272;
static_assert(LDS_END <= 131072 && 8 * 32 * OSTG <= OFF_WS, "attention LDS map");
#define KSWZ(row, colB) ((row) * 256 + ((colB) ^ (((row) & 7) << 4)))
#define K2SWZ(row, colB) ((row) * 128 + ((colB) ^ (((row) & 7) << 4)))
#define SBAR() __builtin_amdgcn_sched_barrier(0)
__device__ __forceinline__ int v_st(int k, int c) { const int kk = (k & ~0xC) | ((k & 4) << 1) | ((k & 8) >> 1); return ((kk >> 3) * 4 + (c >> 5)) * 512 + ((kk & 7) * 32 + (c & 31)) * 2; }
__device__ __forceinline__ int v_rd_base(int lane) { return ((lane & 3) << 3) | (((lane >> 2) & 3) << 6) | (((lane >> 4) & 1) << 5) | (((lane >> 5) & 1) << 8); }
constexpr int v_rd_off(int d0, int ks, int half) { return d0 * 512 + ks * 4096 + half * 2048; }
__device__ __forceinline__ int crow(int r, int hi) { return (r & 3) + 8 * (r >> 2) + 4 * hi; }
typedef float f32x2c __attribute__((ext_vector_type(2)));
typedef __bf16 bf16x2c __attribute__((ext_vector_type(2)));
__device__ __forceinline__ unsigned cvtpk(float lo, float hi) { const f32x2c v = {lo, hi}; return __builtin_bit_cast(unsigned, __builtin_convertvector(v, bf16x2c)); }

struct Item {
    const bf16* Q; long qs;
    const float* rope; long ropes;
    const bf16* K; long ks; const bf16* K2; long k2s; const bf16* V; long vs;
    int P0, skv, W;
    const float* bias; int bstep;
    const unsigned long long* sel; long sels;
    bf16* O; long os;
    float* LSE; long lses;
    const bf16* M0; const bf16* M1; long ms; const bf16* G; long gs;
};

template <int VAR>
__device__ __forceinline__ void attn_block(const Item& it, unsigned char* lds_g) {
    constexpr bool HAS_BIAS = VAR != 2, HAS_SEL = VAR == 1, HAS_K2 = VAR == 2;
    constexpr float SCALE = HAS_K2 ? 0.07216878364870322f : 0.08838834764831845f, C2 = 1.4426950408889634f * SCALE, THR = 8.f;
    FA_LAS unsigned char* L = (FA_LAS unsigned char*)lds_g;
    const int tid = threadIdx.x, wid = __builtin_amdgcn_readfirstlane(tid >> 6), lane = tid & 63, r32 = lane & 31, hi = lane >> 5;
    const int W = it.W;
    const int j_lo = (it.P0 - W + 1 > 0) ? (it.P0 - W + 1) / KVBLK : 0;
    int j_hi = (it.P0 + QB - 1) / KVBLK + 1; if (j_hi > it.skv / KVBLK) j_hi = it.skv / KVBLK;
    const int NT = j_hi - j_lo;
    const int qlo = it.P0 + wid * QBLK, qm = qlo + r32 - 4 * hi;
    FA_LAS float* wsl = (FA_LAS float*)(L + OFF_WS + wid * WS_PER_WAVE); FA_LAS float* li_l = wsl; FA_LAS float* al_l = wsl + 32;
    FA_LAS float* tab = (FA_LAS float*)(L + OFF_TAB);
    const int sr = tid >> 4, sc = (tid & 15) * 8, vst0 = v_st(sr, sc), vst1 = v_st(32 + sr, sc), kws = KSWZ(sr, sc * 2);
    const int k2r = tid >> 3, k2c = (tid & 7) * 8, k2ws = K2SWZ(k2r, k2c * 2);
    const int vb0 = OFF_V + v_rd_base(lane);
    bf16x8 qr[8]; bf16x8 qr2[4];
    { const bf16* qp = it.Q + (long)(qlo + r32) * it.qs + hi * 8;
#pragma unroll
      for (int d0 = 0; d0 < 8; ++d0) qr[d0] = *(const bf16x8*)(qp + d0 * 16);
      if constexpr (HAS_K2) {
          const float* rp = it.rope + (long)(qlo + r32) * it.ropes + hi * 8;
          bf16x8 raw[4];
#pragma unroll
          for (int d0 = 0; d0 < 4; ++d0) raw[d0] = *(const bf16x8*)(qp + 128 + d0 * 16);
#pragma unroll
          for (int d0 = 0; d0 < 2; ++d0) { const f32x4 c0 = *(const f32x4*)(rp + d0 * 16), c1 = *(const f32x4*)(rp + d0 * 16 + 4), s0 = *(const f32x4*)(rp + 32 + d0 * 16), s1 = *(const f32x4*)(rp + 32 + d0 * 16 + 4);
              float o1[8], o2[8];
#pragma unroll
              for (int j = 0; j < 8; ++j) { const float x1 = __builtin_bit_cast(float, (unsigned)(unsigned short)raw[d0][j] << 16), x2 = __builtin_bit_cast(float, (unsigned)(unsigned short)raw[d0 + 2][j] << 16);
                  const float cs = j < 4 ? c0[j & 3] : c1[j & 3], sn = j < 4 ? s0[j & 3] : s1[j & 3]; o1[j] = x1 * cs - x2 * sn; o2[j] = x2 * cs + x1 * sn; }
              u32x4 w1 = {cvtpk(o1[0], o1[1]), cvtpk(o1[2], o1[3]), cvtpk(o1[4], o1[5]), cvtpk(o1[6], o1[7])}, w2 = {cvtpk(o2[0], o2[1]), cvtpk(o2[2], o2[3]), cvtpk(o2[4], o2[5]), cvtpk(o2[6], o2[7])};
              qr2[d0] = __builtin_bit_cast(bf16x8, w1); qr2[d0 + 2] = __builtin_bit_cast(bf16x8, w2); }
      }
    }
    unsigned long long selm = ~0ull;
    if constexpr (HAS_SEL) selm = __hip_atomic_load(it.sel + (long)(qlo + r32) * it.sels, __ATOMIC_RELAXED, __HIP_MEMORY_SCOPE_AGENT);
    if constexpr (HAS_BIAS) {
        int rmax = W + 320; if (rmax > 4096) rmax = 4096;
        for (int i = tid; i < rmax + TAB_PAD; i += 512) { int r = i - TAB_PAD; r = r < -64 ? -64 : r; long gi = (long)r * it.bstep; gi = gi > 4095 ? 4095 : gi; tab[i] = it.bias[gi] * (1.0f / SCALE); }
    }
    bf16x8 st_k0, st_k1, st_v0, st_v1, st_k2;
#define FA_LOAD(kb_) do { const long r0_ = (long)((kb_) + sr), r1_ = r0_ + 32; \
        st_v0 = *(const bf16x8*)(it.V + r0_ * it.vs + sc); st_v1 = *(const bf16x8*)(it.V + r1_ * it.vs + sc); \
        st_k0 = *(const bf16x8*)(it.K + r0_ * it.ks + sc); st_k1 = *(const bf16x8*)(it.K + r1_ * it.ks + sc); \
        if constexpr (HAS_K2) st_k2 = *(const bf16x8*)(it.K2 + (long)((kb_) + k2r) * it.k2s + k2c); } while (0)
#define FA_WRITE(bf_) do { *(FA_LAS bf16x8*)(L + OFF_V + (bf_) * SHM_V + vst0) = st_v0; *(FA_LAS bf16x8*)(L + OFF_V + (bf_) * SHM_V + vst1) = st_v1; \
        *(FA_LAS bf16x8*)(L + OFF_K + (bf_) * SHM_K + kws) = st_k0; *(FA_LAS bf16x8*)(L + OFF_K + (bf_) * SHM_K + kws + 32 * 256) = st_k1; \
        if constexpr (HAS_K2) *(FA_LAS bf16x8*)(L + OFF_K2 + (bf_) * SHM_K2 + k2ws) = st_k2; } while (0)
    FA_LOAD(j_lo * KVBLK);
    asm volatile("s_waitcnt vmcnt(0)" ::: "memory");
    FA_WRITE(0);
    __syncthreads();
    float m_reg = -1e30f, l_reg = 0.f; f32x16 o[4] = {};
#define FA_KBASE(t) ((j_lo + (t)) * KVBLK)
#define FA_STEP(BUF, t) do { \
        const int kb_ = FA_KBASE(t); \
        if ((t) + 1 < NT) FA_LOAD(FA_KBASE((t) + 1)); \
        bool act_ = (kb_ <= qlo + QBLK - 1) && (kb_ + KVBLK - 1 >= qlo - W + 1); \
        bool allow_ = true; \
        if constexpr (HAS_SEL) { allow_ = (bool)((selm >> (kb_ >> 6)) & 1ull); } \
        if (act_) { \
            f32x16 p0 = {}, p1 = {}; \
            { const int ka_ = OFF_K + (BUF) * SHM_K; \
              _Pragma("unroll") for (int d0 = 0; d0 < 8; ++d0) { \
                const bf16x8 b0 = *(const FA_LAS bf16x8*)(L + ka_ + KSWZ(r32, (d0 * 16 + hi * 8) * 2)); \
                const bf16x8 b1 = *(const FA_LAS bf16x8*)(L + ka_ + 32 * 256 + KSWZ(r32, (d0 * 16 + hi * 8) * 2)); \
                p0 = __builtin_amdgcn_mfma_f32_32x32x16_bf16(b0, qr[d0], p0, 0, 0, 0); p1 = __builtin_amdgcn_mfma_f32_32x32x16_bf16(b1, qr[d0], p1, 0, 0, 0); } \
              if constexpr (HAS_K2) { const int k2a_ = OFF_K2 + (BUF) * SHM_K2; \
                _Pragma("unroll") for (int d0 = 0; d0 < 4; ++d0) { \
                  const bf16x8 b0 = *(const FA_LAS bf16x8*)(L + k2a_ + K2SWZ(r32, (d0 * 16 + hi * 8) * 2)); \
                  const bf16x8 b1 = *(const FA_LAS bf16x8*)(L + k2a_ + 32 * 128 + K2SWZ(r32, (d0 * 16 + hi * 8) * 2)); \
                  p0 = __builtin_amdgcn_mfma_f32_32x32x16_bf16(b0, qr2[d0], p0, 0, 0, 0); p1 = __builtin_amdgcn_mfma_f32_32x32x16_bf16(b1, qr2[d0], p1, 0, 0, 0); } } } \
            const int dq_ = qm - kb_; \
            if constexpr (HAS_BIAS) { const FA_LAS float* tb_ = tab + (TAB_PAD + dq_ - 63); \
                _Pragma("unroll") for (int r = 0; r < 16; ++r) { const int c_ = (r & 3) + 8 * (r >> 2); p0[r] += tb_[63 - c_]; p1[r] += tb_[31 - c_]; } } \
            if (HAS_SEL || kb_ + KVBLK - 1 > qlo || kb_ <= qlo + QBLK - 1 - W) { const float NEG_ = -__builtin_inff(); const int dqm_ = allow_ ? dq_ : -0x40000000; \
                _Pragma("unroll") for (int r = 0; r < 16; ++r) { const int c_ = (r & 3) + 8 * (r >> 2); \
                    if ((unsigned)(dqm_ - c_) >= (unsigned)W) p0[r] = NEG_; if ((unsigned)(dqm_ - c_ - 32) >= (unsigned)W) p1[r] = NEG_; } } \
              \
            float pmax_ = p0[0]; _Pragma("unroll") for (int r = 1; r < 16; ++r) pmax_ = fmaxf(pmax_, p0[r]); _Pragma("unroll") for (int r = 0; r < 16; ++r) pmax_ = fmaxf(pmax_, p1[r]); \
            { auto rr_ = __builtin_amdgcn_permlane32_swap(__float_as_uint(pmax_), __float_as_uint(pmax_), false, false); pmax_ = fmaxf(__uint_as_float(rr_[0]), __uint_as_float(rr_[1])); } \
            float mn_, alpha_; \
            if (__all((pmax_ - m_reg) * SCALE <= THR)) { mn_ = m_reg; alpha_ = 1.f; } \
            else { mn_ = fmaxf(m_reg, pmax_); alpha_ = __builtin_amdgcn_exp2f((m_reg - mn_) * C2); m_reg = mn_; } \
            const float mnL_ = -mn_ * C2; float ps_ = 0.f; \
            _Pragma("unroll") for (int r = 0; r < 16; ++r) { p0[r] = __builtin_amdgcn_exp2f(fmaf(p0[r], C2, mnL_)); p1[r] = __builtin_amdgcn_exp2f(fmaf(p1[r], C2, mnL_)); ps_ += p0[r] + p1[r]; } \
            { auto rr_ = __builtin_amdgcn_permlane32_swap(__float_as_uint(ps_), __float_as_uint(ps_), false, false); ps_ = __uint_as_float(rr_[0]) + __uint_as_float(rr_[1]); } \
            l_reg = l_reg * alpha_ + ps_; \
            bf16x8 pa0, pa1, pa2, pa3; \
            FA_PK4(p0, 0, pa0); FA_PK4(p0, 8, pa1); FA_PK4(p1, 0, pa2); FA_PK4(p1, 8, pa3); \
            if (__any(alpha_ < 1.f)) { if (hi == 0) al_l[r32] = alpha_; asm volatile("s_waitcnt lgkmcnt(0)" ::: "memory"); \
                _Pragma("unroll") for (int d_ = 0; d_ < 4; ++d_) _Pragma("unroll") for (int r = 0; r < 16; ++r) o[d_][r] *= al_l[crow(r, hi)]; } \
            FA_PV_D0(BUF, 0); FA_PV_D0(BUF, 1); FA_PV_D0(BUF, 2); FA_PV_D0(BUF, 3); \
        } \
        if ((t) + 1 < NT) { asm volatile("s_waitcnt vmcnt(0)" ::: "memory"); FA_WRITE(1 - (BUF)); } \
        __syncthreads(); } while (0)
#define FA_PK4(P, B_, OUT) do { unsigned a0 = cvtpk(P[B_+0], P[B_+1]), a1 = cvtpk(P[B_+2], P[B_+3]); unsigned b0 = cvtpk(P[B_+4], P[B_+5]), b1 = cvtpk(P[B_+6], P[B_+7]); \
        auto r0 = __builtin_amdgcn_permlane32_swap(a0, b0, false, false); auto r1 = __builtin_amdgcn_permlane32_swap(a1, b1, false, false); \
        u32x4 w = {r0[0], r1[0], r0[1], r1[1]}; OUT = __builtin_bit_cast(bf16x8, w); } while (0)
#define FA_TRRD(dst, off) asm volatile("ds_read_b64_tr_b16 %0, %1 offset:%2" : "=&v"(dst) : "v"(vb0), "i"(off) : "memory")
#define FA_PV_D0(VB, d0) do { s16x4 l0, l1, l2, l3, h0, h1, h2, h3; constexpr int b_ = (VB) * SHM_V + v_rd_off(d0, 0, 0); \
        FA_TRRD(l0, b_); FA_TRRD(h0, b_ + 2048); FA_TRRD(l1, b_ + 4096); FA_TRRD(h1, b_ + 6144); FA_TRRD(l2, b_ + 8192); FA_TRRD(h2, b_ + 10240); FA_TRRD(l3, b_ + 12288); FA_TRRD(h3, b_ + 14336); \
        asm volatile("s_waitcnt lgkmcnt(0)" ::: "memory"); SBAR(); \
        o[d0] = __builtin_amdgcn_mfma_f32_32x32x16_bf16(pa0, (bf16x8){l0[0], l0[1], l0[2], l0[3], h0[0], h0[1], h0[2], h0[3]}, o[d0], 0, 0, 0); \
        o[d0] = __builtin_amdgcn_mfma_f32_32x32x16_bf16(pa1, (bf16x8){l1[0], l1[1], l1[2], l1[3], h1[0], h1[1], h1[2], h1[3]}, o[d0], 0, 0, 0); \
        o[d0] = __builtin_amdgcn_mfma_f32_32x32x16_bf16(pa2, (bf16x8){l2[0], l2[1], l2[2], l2[3], h2[0], h2[1], h2[2], h2[3]}, o[d0], 0, 0, 0); \
        o[d0] = __builtin_amdgcn_mfma_f32_32x32x16_bf16(pa3, (bf16x8){l3[0], l3[1], l3[2], l3[3], h3[0], h3[1], h3[2], h3[3]}, o[d0], 0, 0, 0); } while (0)
    for (int t = 0; t < NT; t += 2) { FA_STEP(0, t); if (t + 1 < NT) FA_STEP(1, t + 1); }
    li_l[r32] = l_reg;
    if constexpr (VAR == 1) { const bf16* gp = it.G + (long)(qlo + r32) * it.gs;
#pragma unroll
        for (int k = 0; k < 3; ++k) { const float gl = __builtin_bit_cast(float, (unsigned)gp[k] << 16); wsl[64 + 32 * k + r32] = 1.0f / (1.0f + __expf(-gl)); } }
    asm volatile("s_waitcnt lgkmcnt(0)" ::: "memory");
    if (it.LSE && hi == 0) it.LSE[(long)(qlo + r32) * it.lses] = m_reg * SCALE + __logf(l_reg);
    FA_LAS unsigned char* stg = L + wid * (32 * OSTG);
#pragma unroll
    for (int r = 0; r < 16; ++r) { const int orow = crow(r, hi); const float lv_ = li_l[orow]; float rl = lv_ > 0.f ? __builtin_amdgcn_rcpf(lv_) : 0.f; if constexpr (VAR == 1) rl *= wsl[64 + 32 + orow];
#pragma unroll
        for (int d0 = 0; d0 < 4; ++d0) { const float v = o[d0][r] * rl; const unsigned u = __builtin_bit_cast(unsigned, v); *(FA_LAS unsigned short*)(stg + orow * OSTG + (d0 * 32 + r32) * 2) = (unsigned short)((u + 0x7fffu + ((u >> 16) & 1u)) >> 16); } }
    asm volatile("s_waitcnt lgkmcnt(0)" ::: "memory");
#pragma unroll
    for (int i = 0; i < 8; ++i) { const int id = lane + 64 * i, row = id >> 4, ch = id & 15; const long qi = (long)(qlo + row);
        u32x4 w = *(const FA_LAS u32x4*)(stg + row * OSTG + ch * 16);
        if constexpr (VAR == 1) { const float g0 = wsl[64 + row], g2 = wsl[64 + 64 + row];
            const u32x4 a = *(const u32x4*)(it.M0 + qi * it.ms + ch * 8), c = *(const u32x4*)(it.M1 + qi * it.ms + ch * 8);
#pragma unroll
            for (int k = 0; k < 4; ++k) { const float lo = __builtin_bit_cast(float, w[k] << 16) + g0 * __builtin_bit_cast(float, a[k] << 16) + g2 * __builtin_bit_cast(float, c[k] << 16);
                const float hi_ = __builtin_bit_cast(float, w[k] & 0xffff0000u) + g0 * __builtin_bit_cast(float, a[k] & 0xffff0000u) + g2 * __builtin_bit_cast(float, c[k] & 0xffff0000u); w[k] = cvtpk(lo, hi_); } }
        *(u32x4*)(it.O + qi * it.os + ch * 8) = w; }
    __syncthreads();
#undef FA_LOAD
#undef FA_WRITE
#undef FA_KBASE
#undef FA_STEP
#undef FA_PK4
#undef FA_TRRD
#undef FA_PV_D0
}

struct CmpItem { const bf16* Q; long qs; const bf16* K; const bf16* V; const float* bias; int bld; int s0; bf16* O; long os; unsigned long long* sel; };
__device__ __forceinline__ void cmp_block(const CmpItem& it, unsigned char* lds_g, int imps_off) {
    constexpr float SCALE = 0.08838834764831845f, C2 = 1.4426950408889634f * SCALE;
    constexpr int OFF_TABC = 65536;
    FA_LAS unsigned char* L = (FA_LAS unsigned char*)lds_g;
    const int tid = threadIdx.x, wid = __builtin_amdgcn_readfirstlane(tid >> 6), lane = tid & 63, r32 = lane & 31, hi = lane >> 5;
    FA_LAS float* tabc = (FA_LAS float*)(L + OFF_TABC); FA_LAS float* imps = (FA_LAS float*)(L + imps_off);
    const int tokl = wid * 8 + (r32 >> 2), rh = r32 & 3, s = it.s0 + tokl;
    const int nvis = (it.s0 + 63 - 31) / 16 + 1 > 255 ? 255 : (it.s0 + 63 - 31) / 16 + 1;
    const int NT = (nvis + 63) / 64;
    const int nlim = (s - 31) >> 4;
    const int sr = tid >> 4, sc = (tid & 15) * 8, vst0 = v_st(sr, sc), vst1 = v_st(32 + sr, sc), kws = KSWZ(sr, sc * 2);
    const int vb0 = OFF_V + v_rd_base(lane);
    bf16x8 qr[8];
    { const bf16* qp = it.Q + (long)tokl * it.qs + rh * 128 + hi * 8;
#pragma unroll
      for (int d0 = 0; d0 < 8; ++d0) qr[d0] = *(const bf16x8*)(qp + d0 * 16); }
    for (int i = tid; i < 4 * 4096; i += 512) tabc[i] = it.bias[(long)(i >> 12) * it.bld + (i & 4095)] * (1.0f / SCALE);
    for (int i = tid; i < 64 * 64; i += 512) imps[i] = 0.f;
    bf16x8 st_k0, st_k1, st_v0, st_v1;
#define CM_LOADK(kb_) do { st_k0 = *(const bf16x8*)(it.K + (long)((kb_) + sr) * 128 + sc); st_k1 = *(const bf16x8*)(it.K + (long)((kb_) + 32 + sr) * 128 + sc); } while (0)
#define CM_LOADV(kb_) do { st_v0 = *(const bf16x8*)(it.V + (long)((kb_) + sr) * 128 + sc); st_v1 = *(const bf16x8*)(it.V + (long)((kb_) + 32 + sr) * 128 + sc); } while (0)
#define CM_WRITEK(bf_) do { *(FA_LAS bf16x8*)(L + OFF_K + (bf_) * SHM_K + kws) = st_k0; *(FA_LAS bf16x8*)(L + OFF_K + (bf_) * SHM_K + kws + 32 * 256) = st_k1; } while (0)
#define CM_WRITEV(bf_) do { *(FA_LAS bf16x8*)(L + OFF_V + (bf_) * SHM_V + vst0) = st_v0; *(FA_LAS bf16x8*)(L + OFF_V + (bf_) * SHM_V + vst1) = st_v1; } while (0)
#define CM_SCORES(BUF, kb_) \
        f32x16 p0 = {}, p1 = {}; \
        { const int ka_ = OFF_K + (BUF) * SHM_K; \
          _Pragma("unroll") for (int d0 = 0; d0 < 8; ++d0) { \
            const bf16x8 b0 = *(const FA_LAS bf16x8*)(L + ka_ + KSWZ(r32, (d0 * 16 + hi * 8) * 2)); \
            const bf16x8 b1 = *(const FA_LAS bf16x8*)(L + ka_ + 32 * 256 + KSWZ(r32, (d0 * 16 + hi * 8) * 2)); \
            p0 = __builtin_amdgcn_mfma_f32_32x32x16_bf16(b0, qr[d0], p0, 0, 0, 0); p1 = __builtin_amdgcn_mfma_f32_32x32x16_bf16(b1, qr[d0], p1, 0, 0, 0); } } \
        { const int nb_ = (kb_) + 4 * hi, relb_ = s - 31 - 16 * nb_; const float NEG_ = -__builtin_inff(); \
          _Pragma("unroll") for (int r = 0; r < 16; ++r) { const int c_ = (r & 3) + 8 * (r >> 2); \
            { const int rel_ = relb_ - 16 * c_; const int ix_ = rel_ < 0 ? 0 : rel_; const float bv_ = tabc[rh * 4096 + ix_]; p0[r] = (nb_ + c_ <= nlim) ? p0[r] + bv_ : NEG_; } \
            { const int rel_ = relb_ - 16 * (c_ + 32); const int ix_ = rel_ < 0 ? 0 : rel_; const float bv_ = tabc[rh * 4096 + ix_]; p1[r] = (nb_ + c_ + 32 <= nlim) ? p1[r] + bv_ : NEG_; } } }
    CM_LOADK(0); asm volatile("s_waitcnt vmcnt(0)" ::: "memory"); CM_WRITEK(0); __syncthreads();
    float m_reg = -1e30f, l_reg = 0.f;
#define CM_P1(BUF, t) do { if ((t) + 1 < NT) CM_LOADK(((t) + 1) * 64); \
        { CM_SCORES(BUF, (t) * 64) \
          float pmax_ = p0[0]; _Pragma("unroll") for (int r = 1; r < 16; ++r) pmax_ = fmaxf(pmax_, p0[r]); _Pragma("unroll") for (int r = 0; r < 16; ++r) pmax_ = fmaxf(pmax_, p1[r]); \
          { auto rr_ = __builtin_amdgcn_permlane32_swap(__float_as_uint(pmax_), __float_as_uint(pmax_), false, false); pmax_ = fmaxf(__uint_as_float(rr_[0]), __uint_as_float(rr_[1])); } \
          const float mn_ = fmaxf(m_reg, pmax_), alpha_ = __builtin_amdgcn_exp2f((m_reg - mn_) * C2), mnL_ = -mn_ * C2; float ps_ = 0.f; \
          _Pragma("unroll") for (int r = 0; r < 16; ++r) ps_ += __builtin_amdgcn_exp2f(fmaf(p0[r], C2, mnL_)) + __builtin_amdgcn_exp2f(fmaf(p1[r], C2, mnL_)); \
          { auto rr_ = __builtin_amdgcn_permlane32_swap(__float_as_uint(ps_), __float_as_uint(ps_), false, false); ps_ = __uint_as_float(rr_[0]) + __uint_as_float(rr_[1]); } \
          l_reg = l_reg * alpha_ + ps_; m_reg = mn_; } \
        if ((t) + 1 < NT) { asm volatile("s_waitcnt vmcnt(0)" ::: "memory"); CM_WRITEK(1 - (BUF)); } \
        __syncthreads(); } while (0)
    for (int t = 0; t < NT; t += 2) { CM_P1(0, t); if (t + 1 < NT) CM_P1(1, t + 1); }
    const float inv_l = l_reg > 0.f ? 1.0f / l_reg : 0.f, mL = -m_reg * C2;
    CM_LOADK(0); CM_LOADV(0); asm volatile("s_waitcnt vmcnt(0)" ::: "memory"); CM_WRITEK(0); CM_WRITEV(0); __syncthreads();
    f32x16 o[4] = {};
#define FA_PK4(P, B_, OUT) do { unsigned a0 = cvtpk(P[B_+0], P[B_+1]), a1 = cvtpk(P[B_+2], P[B_+3]); unsigned b0 = cvtpk(P[B_+4], P[B_+5]), b1 = cvtpk(P[B_+6], P[B_+7]); \
        auto r0 = __builtin_amdgcn_permlane32_swap(a0, b0, false, false); auto r1 = __builtin_amdgcn_permlane32_swap(a1, b1, false, false); \
        u32x4 w = {r0[0], r1[0], r0[1], r1[1]}; OUT = __builtin_bit_cast(bf16x8, w); } while (0)
#define FA_TRRD(dst, off) asm volatile("ds_read_b64_tr_b16 %0, %1 offset:%2" : "=&v"(dst) : "v"(vb0), "i"(off) : "memory")
#define FA_PV_D0(VB, d0) do { s16x4 l0, l1, l2, l3, h0, h1, h2, h3; constexpr int b_ = (VB) * SHM_V + v_rd_off(d0, 0, 0); \
        FA_TRRD(l0, b_); FA_TRRD(h0, b_ + 2048); FA_TRRD(l1, b_ + 4096); FA_TRRD(h1, b_ + 6144); FA_TRRD(l2, b_ + 8192); FA_TRRD(h2, b_ + 10240); FA_TRRD(l3, b_ + 12288); FA_TRRD(h3, b_ + 14336); \
        asm volatile("s_waitcnt lgkmcnt(0)" ::: "memory"); SBAR(); \
        o[d0] = __builtin_amdgcn_mfma_f32_32x32x16_bf16(pa0, (bf16x8){l0[0], l0[1], l0[2], l0[3], h0[0], h0[1], h0[2], h0[3]}, o[d0], 0, 0, 0); \
        o[d0] = __builtin_amdgcn_mfma_f32_32x32x16_bf16(pa1, (bf16x8){l1[0], l1[1], l1[2], l1[3], h1[0], h1[1], h1[2], h1[3]}, o[d0], 0, 0, 0); \
        o[d0] = __builtin_amdgcn_mfma_f32_32x32x16_bf16(pa2, (bf16x8){l2[0], l2[1], l2[2], l2[3], h2[0], h2[1], h2[2], h2[3]}, o[d0], 0, 0, 0); \
        o[d0] = __builtin_amdgcn_mfma_f32_32x32x16_bf16(pa3, (bf16x8){l3[0], l3[1], l3[2], l3[3], h3[0], h3[1], h3[2], h3[3]}, o[d0], 0, 0, 0); } while (0)
#define CM_IMP(P, half_, t) do { _Pragma("unroll") for (int q4 = 0; q4 < 4; ++q4) { \
            float A_ = (2.0f * ((P[4 * q4] + P[4 * q4 + 1]) + P[4 * q4 + 2]) + P[4 * q4 + 3]) * inv_l, B_ = P[4 * q4 + 3] * inv_l; \
            A_ += __shfl_xor(A_, 1); A_ += __shfl_xor(A_, 2); B_ += __shfl_xor(B_, 1); B_ += __shfl_xor(B_, 2); \
            const int j_ = 2 * q4 + hi + 8 * (half_) + 16 * (t); \
            if (rh == 0) { __hip_atomic_fetch_add(&imps[tokl * 64 + j_], A_, __ATOMIC_RELAXED, __HIP_MEMORY_SCOPE_WORKGROUP); \
                if (j_ + 1 < 64) __hip_atomic_fetch_add(&imps[tokl * 64 + j_ + 1], B_, __ATOMIC_RELAXED, __HIP_MEMORY_SCOPE_WORKGROUP); } } } while (0)
#define CM_P2(BUF, t) do { if ((t) + 1 < NT) { CM_LOADK(((t) + 1) * 64); CM_LOADV(((t) + 1) * 64); } \
        { CM_SCORES(BUF, (t) * 64) \
          _Pragma("unroll") for (int r = 0; r < 16; ++r) { p0[r] = __builtin_amdgcn_exp2f(fmaf(p0[r], C2, mL)); p1[r] = __builtin_amdgcn_exp2f(fmaf(p1[r], C2, mL)); } \
          CM_IMP(p0, 0, t); CM_IMP(p1, 1, t); \
          bf16x8 pa0, pa1, pa2, pa3; FA_PK4(p0, 0, pa0); FA_PK4(p0, 8, pa1); FA_PK4(p1, 0, pa2); FA_PK4(p1, 8, pa3); \
          FA_PV_D0(BUF, 0); FA_PV_D0(BUF, 1); FA_PV_D0(BUF, 2); FA_PV_D0(BUF, 3); } \
        if ((t) + 1 < NT) { asm volatile("s_waitcnt vmcnt(0)" ::: "memory"); CM_WRITEK(1 - (BUF)); CM_WRITEV(1 - (BUF)); } \
        __syncthreads(); } while (0)
    for (int t = 0; t < NT; t += 2) { CM_P2(0, t); if (t + 1 < NT) CM_P2(1, t + 1); }
    asm volatile("s_waitcnt lgkmcnt(0)" ::: "memory");
    for (int tk = 0; tk < 8; ++tk) { const int sp = it.s0 + wid * 8 + tk, blk_t = sp >> 6, j = lane;
        const float is = imps[(wid * 8 + tk) * 64 + j];
        const bool forced = (j == 0) || (j == blk_t) || (j == blk_t - 1), valid = j <= blk_t;
        const float scv = forced ? 1e9f : (valid ? is : -1.0f);
        int rank = 0;
        for (int k = 0; k < 64; ++k) { const float vk = __shfl(scv, k); rank += (vk > scv || (vk == scv && k < j)) ? 1 : 0; }
        const unsigned long long msk = __ballot(rank < 16 && scv > -0.5f);
        if (lane == 0) it.sel[(long)(wid * 8 + tk) * 2] = msk; }
    FA_LAS unsigned char* stg = L + wid * (32 * OSTG);
    FA_LAS float* li_c = imps + wid * 512;
    li_c[r32] = inv_l; asm volatile("s_waitcnt lgkmcnt(0)" ::: "memory");
#pragma unroll
    for (int r = 0; r < 16; ++r) { const int orow = crow(r, hi); const float rl = li_c[orow];
#pragma unroll
        for (int d0 = 0; d0 < 4; ++d0) { const unsigned u = __builtin_bit_cast(unsigned, o[d0][r] * rl); *(FA_LAS unsigned short*)(stg + orow * OSTG + (d0 * 32 + r32) * 2) = (unsigned short)((u + 0x7fffu + ((u >> 16) & 1u)) >> 16); } }
    asm volatile("s_waitcnt lgkmcnt(0)" ::: "memory");
#pragma unroll
    for (int i = 0; i < 8; ++i) { const int id = lane + 64 * i, row = id >> 4, ch = id & 15;
        const u32x4 w = *(const FA_LAS u32x4*)(stg + row * OSTG + ch * 16);
        *(u32x4*)(it.O + (long)(wid * 8 + (row >> 2)) * it.os + (row & 3) * 128 + ch * 8) = w; }
    __syncthreads();
#undef CM_LOADK
#undef CM_LOADV
#undef CM_WRITEK
#undef CM_WRITEV
#undef CM_SCORES
#undef CM_P1
#undef CM_P2
#undef CM_IMP
#undef FA_PK4
#undef FA_TRRD
#undef FA_PV_D0
}
}

constexpr int D = 2048, NB = 4, S = 4096, M = NB * S;
constexpr int HD = 128;
constexpr int Z0W = 3840;
constexpr int Z_NQ = 0, Z_NKV = 1024, Z_QLAT = 2560, Z_KVLAT = 3072, Z_KPE = 3584, Z_NG = 3648;
constexpr int QMW = 1536, KVMW = 2048;
constexpr int FF = 5632, FFE = 7168, NE = 8;
constexpr int Z1W = 9216;
constexpr int NSLOT = (2 * M / 256 + NE) * 256;
constexpr float RMS_EPS = 1e-6f;

constexpr size_t MiB = 1u << 20;
constexpr size_t WS_CTL = 0, CTL_ZERO_BYTES = 1 * MiB;
constexpr size_t WS_MOD = 1 * MiB;
constexpr size_t WS_BIAS = 2 * MiB;
constexpr int BIAS_LD = 4096 + 64;
constexpr size_t WS_ROPE = 3 * MiB;
constexpr size_t WS_RINV = 8 * MiB;
constexpr size_t WS_SEL = 9 * MiB;
constexpr size_t WS_KC = 10 * MiB;
constexpr size_t WS_VC = 11 * MiB;
constexpr size_t WS_ROUTE = 12 * MiB;
constexpr size_t WS_LSE = 13 * MiB;
constexpr size_t WS_KPE = 15 * MiB;
constexpr size_t WS_W1T = 17 * MiB, WS_W2T = 19 * MiB, WS_CB1 = 20 * MiB;
constexpr size_t WS_WIN0 = 21 * MiB, WS_WUQ = 36 * MiB, WS_WUKV = 38 * MiB, WS_WOUT0 = 40 * MiB, WS_WGU0 = 48 * MiB, WS_WDN0 = 92 * MiB;
constexpr size_t WS_WIN1 = 114 * MiB, WS_WOUT1 = 150 * MiB, WS_WMGU = 154 * MiB, WS_WMDN = 602 * MiB;
constexpr size_t WS_X = 826 * MiB;
constexpr size_t WS_H = 954 * MiB;
constexpr size_t WS_R = 1018 * MiB;
constexpr size_t WS_Z0 = WS_R, WS_QM = WS_R + 120 * MiB, WS_KVM = WS_R + 168 * MiB, WS_OCMP = WS_R + 232 * MiB, WS_OWIN = WS_R + 264 * MiB, WS_CAT = WS_R + 328 * MiB;
constexpr size_t WS_ACT = WS_R;
constexpr size_t WS_Z1 = WS_R, WS_OP = WS_R + 288 * MiB, WS_OM = WS_R + 384 * MiB;
constexpr size_t WS_XB = WS_R, WS_ACTB = WS_R + 136 * MiB, WS_YB = WS_R;
constexpr size_t WS_END = WS_R + 612 * MiB;
static_assert(WS_Z0 + (size_t)M * Z0W * 2 <= WS_QM && WS_QM + (size_t)M * QMW * 2 <= WS_KVM && WS_KVM + (size_t)M * KVMW * 2 <= WS_OCMP && WS_CAT + (size_t)M * 2048 * 2 <= WS_END, "L0 map");
static_assert(WS_Z1 + (size_t)M * Z1W * 2 <= WS_OM && WS_XB + (size_t)NSLOT * D * 2 <= WS_ACTB && WS_ACTB + (size_t)NSLOT * FFE * 2 <= WS_END, "L1 map");
static_assert(WS_WMDN + (size_t)NE * D * FFE * 2 <= WS_X && WS_WMGU + (size_t)NE * 2 * FFE * D * 2 <= WS_WMDN, "weights map");
constexpr int CW_BAR = 4096;
constexpr int CW_CNT = 64;
constexpr int CW_TS = 128;
constexpr int CW_Q = 8192;

constexpr int RING_BYTES = 131072;
constexpr int SMALL_OFF = RING_BYTES;
constexpr int LDSCTL_OFF = RING_BYTES + 16384, MISC_OFF = LDSCTL_OFF;
constexpr int LDS_BYTES = LDSCTL_OFF + 256;
constexpr int NWAVES = 8;

#define GAS __attribute__((address_space(1)))
#define LAS __attribute__((address_space(3)))
typedef unsigned short bf16;
typedef unsigned v4u __attribute__((ext_vector_type(4)));
typedef unsigned v2u __attribute__((ext_vector_type(2)));
typedef float f32x4 __attribute__((ext_vector_type(4)));
typedef float f32x2 __attribute__((ext_vector_type(2)));
#define LDS_WAIT() asm volatile("s_waitcnt lgkmcnt(0)" ::: "memory")
__device__ __forceinline__ unsigned f2bf(float f) { unsigned u = __builtin_bit_cast(unsigned, f); return (u + 0x7fffu + ((u >> 16) & 1u)) >> 16; }
__device__ __forceinline__ unsigned pk2(float lo, float hi) { return f2bf(lo) | (f2bf(hi) << 16); }
__device__ __forceinline__ float bf2f(unsigned short b) { return __builtin_bit_cast(float, (unsigned)b << 16); }
__device__ __forceinline__ float bflo(unsigned w) { return __builtin_bit_cast(float, w << 16); }
__device__ __forceinline__ float bfhi(unsigned w) { return __builtin_bit_cast(float, w & 0xffff0000u); }
__device__ __forceinline__ float wave_sum(float v) {
#pragma unroll
    for (int o = 1; o < 64; o <<= 1) v += __shfl_xor(v, o);
    return v;
}
__device__ __forceinline__ float wave_max(float v) {
#pragma unroll
    for (int o = 1; o < 64; o <<= 1) v = fmaxf(v, __shfl_xor(v, o));
    return v;
}

#define XB_TMO      128
#define XB_XCNT(j)  (256  + 64 * (j))
#define XB_XSUB(j)  (1280 + 64 * (j))
#define XB_XGEN(j)  (2304 + 64 * (j))
#define XB_TOP      3328
#define XB_TOPGEN   3392
#define XCD_BAR_WORDS 3456
#define XB_SPIN_CAP (1u << 22)

__device__ __forceinline__ unsigned xb_ld(unsigned* p)              { return __hip_atomic_load(p, __ATOMIC_RELAXED, __HIP_MEMORY_SCOPE_AGENT); }
__device__ __forceinline__ unsigned xb_add(unsigned* p, unsigned v) { return __hip_atomic_fetch_add(p, v, __ATOMIC_RELAXED, __HIP_MEMORY_SCOPE_AGENT); }
__device__ __forceinline__ unsigned xb_xcc_id() { return (unsigned)__builtin_amdgcn_s_getreg((3 << 11) | 20) & 0xFu; }
#define XB_SPIN(cond, bar) do { unsigned _sp = 0; while (cond) { __builtin_amdgcn_s_sleep(1); \
    if ((++_sp & 255u) == 0u) { if (xb_ld(&(bar)[XB_TMO])) break; if (_sp > XB_SPIN_CAP) { atomicAdd(&(bar)[XB_TMO], 1u); break; } } } } while (0)

struct XcdBarrier {
    unsigned* bar; unsigned x;
    volatile LAS unsigned* st;
};

__device__ __forceinline__ XcdBarrier xcd_barrier_post(unsigned* bar, volatile LAS unsigned* st) {
    XcdBarrier b; b.bar = bar; b.x = xb_xcc_id(); b.st = st;
    if (threadIdx.x == 0) (void)xb_add(&bar[XB_XCNT(b.x)], 1u);
    return b;
}
__device__ __forceinline__ void xcd_barrier_complete(unsigned* bar, unsigned x, unsigned& nloc, unsigned& nx) {
    const unsigned G = gridDim.x * gridDim.y * gridDim.z;
    unsigned sum, cnt, mine, sp = 0u;
    for (;;) {
        sum = 0u; cnt = 0u; mine = 0u;
#pragma unroll
        for (unsigned j = 0; j < 16; ++j) { const unsigned c = xb_ld(&bar[XB_XCNT(j)]); sum += c; cnt += (c > 0u) ? 1u : 0u; mine = (j == x) ? c : mine; }
        if (sum == G) break;
        __builtin_amdgcn_s_sleep(1);
        if ((++sp & 255u) == 0u) { if (xb_ld(&bar[XB_TMO])) break; if (sp > XB_SPIN_CAP) { atomicAdd(&bar[XB_TMO], 1u); break; } }
    }
    nloc = mine > 0u ? mine : 1u; nx = cnt > 0u ? cnt : 1u;
}

__device__ __forceinline__ void xcd_barrier(const XcdBarrier& b) {
    asm volatile("s_waitcnt vmcnt(0)" ::: "memory");
    __syncthreads();
    if (threadIdx.x == 0) {
        unsigned* bar = b.bar;
        __builtin_amdgcn_s_waitcnt(0);
        unsigned nloc = b.st[0], nx = b.st[1];
        if (nloc == 0u) { xcd_barrier_complete(bar, b.x, nloc, nx); b.st[0] = nloc; b.st[1] = nx; }
        const unsigned old = xb_add(&bar[XB_XSUB(b.x)], 1u);
        const unsigned gen = old / nloc;
        if (old + 1u == (gen + 1u) * nloc) {
            __builtin_amdgcn_fence(__ATOMIC_RELEASE, "agent");
            asm volatile("s_waitcnt vmcnt(0)" ::: "memory");
            const unsigned og = xb_add(&bar[XB_TOP], 1u);
            const unsigned tg = og / nx;
            if (og + 1u == (tg + 1u) * nx) xb_add(&bar[XB_TOPGEN], 1u);
            else XB_SPIN(xb_ld(&bar[XB_TOPGEN]) == tg, bar);
            __builtin_amdgcn_fence(__ATOMIC_ACQUIRE, "agent");
            xb_add(&bar[XB_XGEN(b.x)], 1u);
            asm volatile("s_waitcnt vmcnt(0)" ::: "memory");
        } else {
            XB_SPIN(xb_ld(&bar[XB_XGEN(b.x)]) == gen, bar);
            __builtin_amdgcn_fence(__ATOMIC_ACQUIRE, "agent");
            asm volatile("s_waitcnt vmcnt(0)" ::: "memory");
        }
    }
    __syncthreads();
}


struct Args { const void* in[30]; float* out; unsigned char* ws; int ph_lo, ph_hi; };
struct Frame {
    unsigned char* lds;
    int tid, lane, wave, vcu, G, gw, NGW;
    unsigned char* ws;
};

__device__ __forceinline__ int t5_bucket(int n) {
    if (n < 16) return n < 0 ? 0 : n;
    int b = 16;
    b += (n >= 22); b += (n >= 30); b += (n >= 40); b += (n >= 54); b += (n >= 73); b += (n >= 99); b += (n >= 134); b += (n >= 182);
    b += (n >= 246); b += (n >= 332); b += (n >= 450); b += (n >= 609); b += (n >= 825); b += (n >= 1117); b += (n >= 1513);
    return b;
}

__device__ __forceinline__ unsigned pk4_fp8(float a, float b, float c, float d) { int w = 0; w = __builtin_amdgcn_cvt_pk_fp8_f32(a, b, w, false); w = __builtin_amdgcn_cvt_pk_fp8_f32(c, d, w, true); return (unsigned)w; }
template <int MAP, bool OUT8 = false>
__device__ __forceinline__ void p0_transpose_item(const float* W, const float* W2, int K, int Nsrc, int Ndst, bf16* WT, const float* kscale, float* scr, int item, int lane, float oscale = 1.0f) {
    const int nblk = Ndst / 64, kb = item / nblk, nb = item % nblk, k0 = 64 * kb, n0 = 64 * nb;
    const int n4 = (lane & 15) * 4, n = n0 + n4, kr = lane >> 4;
    const float* src = W; int sc = n; bool ok = true;
    if (MAP == 1) { if (n < Z_QLAT) sc = n; else if (n < Z_NG) sc = n + 24; else if (n < Z_NG + 24) sc = n - Z_NG + 2560; else ok = false; }
    if (MAP == 2) { const int g32 = n >> 5, w = n & 31; src = (w < 16) ? W : W2; sc = g32 * 16 + (w & 15); }
    f32x4 v[16];
#pragma unroll
    for (int i = 0; i < 16; ++i) v[i] = ok ? __builtin_nontemporal_load((const f32x4*)(src + (size_t)(k0 + 4 * i + kr) * Nsrc + sc)) : (f32x4){0.f, 0.f, 0.f, 0.f};
#pragma unroll
    for (int i = 0; i < 16; ++i) { const int kk = 4 * i + kr; f32x4 t = v[i]; if (kscale) t = t * kscale[k0 + kk]; float* d = scr + kk * 65 + n4; d[0] = t.x; d[1] = t.y; d[2] = t.z; d[3] = t.w; }
    LDS_WAIT(); asm volatile("" ::: "memory");
    if constexpr (OUT8) {
        const int kg = lane & 3;
#pragma unroll
        for (int p = 0; p < 4; ++p) { const int nn = 16 * p + (lane >> 2); const float* s = scr + (16 * kg) * 65 + nn;
            v4u o; o.x = pk4_fp8(s[0 * 65] * oscale, s[1 * 65] * oscale, s[2 * 65] * oscale, s[3 * 65] * oscale); o.y = pk4_fp8(s[4 * 65] * oscale, s[5 * 65] * oscale, s[6 * 65] * oscale, s[7 * 65] * oscale);
            o.z = pk4_fp8(s[8 * 65] * oscale, s[9 * 65] * oscale, s[10 * 65] * oscale, s[11 * 65] * oscale); o.w = pk4_fp8(s[12 * 65] * oscale, s[13 * 65] * oscale, s[14 * 65] * oscale, s[15 * 65] * oscale);
            *(v4u*)((unsigned char*)WT + (size_t)(n0 + nn) * K + k0 + 16 * kg) = o; }
    } else {
    const int kg = lane & 7;
#pragma unroll
    for (int p = 0; p < 8; ++p) { const int nn = 8 * p + (lane >> 3); const float* s = scr + (8 * kg) * 65 + nn;
        v4u o; o.x = pk2(s[0 * 65], s[1 * 65]); o.y = pk2(s[2 * 65], s[3 * 65]); o.z = pk2(s[4 * 65], s[5 * 65]); o.w = pk2(s[6 * 65], s[7 * 65]);
        *(v4u*)(WT + (size_t)(n0 + nn) * K + k0 + 8 * kg) = o; }
    }
    LDS_WAIT(); asm volatile("" ::: "memory");
}
template <int MAP, bool OUT8 = false>
__device__ __forceinline__ void p0_transpose(Frame& F, const float* W, const float* W2, int K, int Nsrc, int Ndst, bf16* WT, const float* kscale, float oscale = 1.0f) {
    float* scr = (float*)(F.lds + F.wave * 16640);
    const int nitems = (K / 64) * (Ndst / 64);
    for (int it = F.gw; it < nitems; it += F.NGW) p0_transpose_item<MAP, OUT8>(W, W2, K, Nsrc, Ndst, WT, kscale, scr, it, F.lane, oscale);
}

__device__ __forceinline__ void modnorm_row(const float* xrow, const float* g, const float* sc, const float* sh, bf16* orow, int lane, f32x4 (&v)[8]) {
    const f32x4* xr = (const f32x4*)xrow + lane; float s = 0.f;
#pragma unroll
    for (int j = 0; j < 8; ++j) { v[j] = xr[64 * j]; s += (v[j].x * v[j].x + v[j].y * v[j].y) + (v[j].z * v[j].z + v[j].w * v[j].w); }
    const float rinv = 1.0f / sqrtf(wave_sum(s) * (1.f / D) + RMS_EPS);
    unsigned long long* o8 = (unsigned long long*)orow + lane;
#pragma unroll
    for (int j = 0; j < 8; ++j) { const f32x4 gg = ((const f32x4*)g)[lane + 64 * j], cc = ((const f32x4*)sc)[lane + 64 * j], hh = ((const f32x4*)sh)[lane + 64 * j];
        v[j] = (v[j] * rinv) * gg * (cc + 1.0f) + hh;
        o8[64 * j] = (unsigned long long)pk2(v[j].x, v[j].y) | ((unsigned long long)pk2(v[j].z, v[j].w) << 32); }
}
template <bool OUT8 = false>
__device__ __forceinline__ void modnorm_phase(Frame& F, const float* x, const float* g, const float* mod  , int sh_idx, bf16* H, float oscale = 1.0f) {
    for (int b = 0; b < NB; ++b) { const float* mb = mod + (size_t)b * 6 * D; const float* sc = mb + (size_t)(sh_idx + 1) * D; const float* sh = mb + (size_t)sh_idx * D;
        const int s0 = F.gw, s1 = F.gw + F.NGW;
        const f32x4* x0 = (const f32x4*)(x + ((size_t)b * S + s0) * D) + F.lane; const f32x4* x1 = (const f32x4*)(x + ((size_t)b * S + s1) * D) + F.lane;
        f32x4 v0[8], v1[8], ca[8];
#pragma unroll
        for (int j = 0; j < 8; ++j) { v0[j] = x0[64 * j]; v1[j] = x1[64 * j]; }
#pragma unroll
        for (int j = 0; j < 8; ++j) { ca[j] = ((const f32x4*)g)[F.lane + 64 * j] * (((const f32x4*)sc)[F.lane + 64 * j] + 1.0f); }
        float q0 = 0.f, q1 = 0.f;
#pragma unroll
        for (int j = 0; j < 8; ++j) { q0 += (v0[j].x * v0[j].x + v0[j].y * v0[j].y) + (v0[j].z * v0[j].z + v0[j].w * v0[j].w); q1 += (v1[j].x * v1[j].x + v1[j].y * v1[j].y) + (v1[j].z * v1[j].z + v1[j].w * v1[j].w); }
        const float r0 = 1.0f / sqrtf(wave_sum(q0) * (1.f / D) + RMS_EPS), r1 = 1.0f / sqrtf(wave_sum(q1) * (1.f / D) + RMS_EPS);
        if constexpr (OUT8) {
            unsigned* o0 = (unsigned*)((unsigned char*)H + ((size_t)b * S + s0) * D) + F.lane; unsigned* o1 = (unsigned*)((unsigned char*)H + ((size_t)b * S + s1) * D) + F.lane;
#pragma unroll
            for (int j = 0; j < 8; ++j) { const f32x4 ccj = ((const f32x4*)sh)[F.lane + 64 * j]; const f32x4 a = ((v0[j] * r0) * ca[j] + ccj) * oscale, c2 = ((v1[j] * r1) * ca[j] + ccj) * oscale;
                o0[64 * j] = pk4_fp8(__builtin_amdgcn_fmed3f(a.x, -440.f, 440.f), __builtin_amdgcn_fmed3f(a.y, -440.f, 440.f), __builtin_amdgcn_fmed3f(a.z, -440.f, 440.f), __builtin_amdgcn_fmed3f(a.w, -440.f, 440.f));
                o1[64 * j] = pk4_fp8(__builtin_amdgcn_fmed3f(c2.x, -440.f, 440.f), __builtin_amdgcn_fmed3f(c2.y, -440.f, 440.f), __builtin_amdgcn_fmed3f(c2.z, -440.f, 440.f), __builtin_amdgcn_fmed3f(c2.w, -440.f, 440.f)); }
        } else {
        unsigned long long* o0 = (unsigned long long*)(H + ((size_t)b * S + s0) * D) + F.lane; unsigned long long* o1 = (unsigned long long*)(H + ((size_t)b * S + s1) * D) + F.lane;
#pragma unroll
        for (int j = 0; j < 8; ++j) { const f32x4 ccj = ((const f32x4*)sh)[F.lane + 64 * j]; const f32x4 a = (v0[j] * r0) * ca[j] + ccj, c2 = (v1[j] * r1) * ca[j] + ccj;
            o0[64 * j] = (unsigned long long)pk2(a.x, a.y) | ((unsigned long long)pk2(a.z, a.w) << 32); o1[64 * j] = (unsigned long long)pk2(c2.x, c2.y) | ((unsigned long long)pk2(c2.z, c2.w) << 32); }
        }
    }
}

__device__ __forceinline__ float gelu_tanh(float x) { const float u = 0.7978845608028654f * (x + 0.044715f * x * x * x); return 0.5f * x * (1.0f + tanhf(u)); }

__global__ void __launch_bounds__(NWAVES * 64, 2) fwd(Args args) {
    extern __shared__ __attribute__((aligned(16))) unsigned char lds[];
    Frame F;
    F.lds = lds; F.ws = args.ws;
    F.tid = threadIdx.x; F.lane = F.tid & 63; F.wave = __builtin_amdgcn_readfirstlane(F.tid >> 6);
    F.G = gridDim.x; { const int bx = blockIdx.x; F.vcu = (F.G % 8 == 0) ? (bx % 8) * (F.G / 8) + bx / 8 : bx; }
    F.gw = F.vcu * NWAVES + F.wave; F.NGW = F.G * NWAVES;
    unsigned char* ws = args.ws;
    unsigned* ctl = (unsigned*)(ws + WS_CTL);
    volatile LAS unsigned* MISC = (volatile LAS unsigned*)((LAS unsigned char*)lds + MISC_OFF);
    for (int u = F.tid; u < 64; u += NWAVES * 64) MISC[u] = 0u;
    __syncthreads();
    XcdBarrier bar; bar.bar = ctl + CW_BAR; bar.x = 0; bar.st = nullptr;
    if (MK_N_LAUNCHES == 1) bar = xcd_barrier_post(ctl + CW_BAR, MISC + 8);
    const int lo = args.ph_lo, hi = args.ph_hi;
#define IN(k) (lo <= (k) && (k) < hi)
#define MOE_WSCALE 64.0f
#define MOE_ASCALE 8.0f
#define IN1_ASCALE 4.0f
#define SEAM(k) do { if (IN(k) && IN((k) + 1)) xcd_barrier(bar); } while (0)

    const float* x_in = (const float*)args.in[0]; const float* c_in = (const float*)args.in[1]; const int* positions = (const int*)args.in[2];
    const float* rel_bias = (const float*)args.in[3]; const float* ada_w = (const float*)args.in[4]; const float* ada_b = (const float*)args.in[5];
    const float* mix_norm_g = (const float*)args.in[6]; const float* ffn_norm_g = (const float*)args.in[7];
    const float* ab_w_in = (const float*)args.in[8]; const float* ab_w_out = (const float*)args.in[9];
    const float* cmp_pos_k = (const float*)args.in[10]; const float* cmp_w1_k = (const float*)args.in[11]; const float* cmp_w2_k = (const float*)args.in[12];
    const float* cmp_pos_v = (const float*)args.in[13]; const float* cmp_w1_v = (const float*)args.in[14]; const float* cmp_w2_v = (const float*)args.in[15];
    const float* q_norm_g = (const float*)args.in[16]; const float* kv_norm_g = (const float*)args.in[17]; const float* w_uq = (const float*)args.in[18]; const float* w_ukv = (const float*)args.in[19];
    const float* ffn_wg = (const float*)args.in[20]; const float* ffn_wu = (const float*)args.in[21]; const float* ffn_wd = (const float*)args.in[22];
    const float* c_w_in = (const float*)args.in[23]; const float* c_w_out = (const float*)args.in[24]; const float* w_router = (const float*)args.in[25];
    const float* moe_wg = (const float*)args.in[26]; const float* moe_wu = (const float*)args.in[27]; const float* moe_wd = (const float*)args.in[28]; const float* final_g = (const float*)args.in[29];
    float* MOD = (float*)(ws + WS_MOD); float* BIAS = (float*)(ws + WS_BIAS); float* ROPE = (float*)(ws + WS_ROPE); float* RINV = (float*)(ws + WS_RINV);
    unsigned long long* SEL = (unsigned long long*)(ws + WS_SEL); bf16* KC = (bf16*)(ws + WS_KC); bf16* VC = (bf16*)(ws + WS_VC); int* ROUTE = (int*)(ws + WS_ROUTE); bf16* KPE = (bf16*)(ws + WS_KPE);
    bf16* W_IN0 = (bf16*)(ws + WS_WIN0); bf16* W_UQ = (bf16*)(ws + WS_WUQ); bf16* W_UKV = (bf16*)(ws + WS_WUKV); bf16* W_OUT0 = (bf16*)(ws + WS_WOUT0); bf16* W_GU0 = (bf16*)(ws + WS_WGU0); bf16* W_DN0 = (bf16*)(ws + WS_WDN0);
    bf16* W_IN1 = (bf16*)(ws + WS_WIN1); bf16* W_OUT1 = (bf16*)(ws + WS_WOUT1); bf16* W_MGU = (bf16*)(ws + WS_WMGU); bf16* W_MDN = (bf16*)(ws + WS_WMDN);
    float* X = (float*)(ws + WS_X); bf16* H = (bf16*)(ws + WS_H);
    bf16* Z0 = (bf16*)(ws + WS_Z0); bf16* QM = (bf16*)(ws + WS_QM); bf16* KVM = (bf16*)(ws + WS_KVM); bf16* OCMP = (bf16*)(ws + WS_OCMP); bf16* OWIN = (bf16*)(ws + WS_OWIN); bf16* CAT = (bf16*)(ws + WS_CAT);
    bf16* W1T = (bf16*)(ws + WS_W1T); bf16* W2T = (bf16*)(ws + WS_W2T); float* CB1 = (float*)(ws + WS_CB1);
    float* LSEB = (float*)(ws + WS_LSE); bf16* OP = (bf16*)(ws + WS_OP);
    bf16* ACT = (bf16*)(ws + WS_ACT); bf16* Z1 = (bf16*)(ws + WS_Z1); bf16* OM = (bf16*)(ws + WS_OM); bf16* XB = (bf16*)(ws + WS_XB); bf16* ACTB = (bf16*)(ws + WS_ACTB); bf16* YB = (bf16*)(ws + WS_YB);
    PG8_LAS unsigned char* ring = (PG8_LAS unsigned char*)lds;

    if (IN(0)) {
        for (int job = 192 + (int)blockIdx.x; job < 194; job += F.G) {
            float* red = (float*)(lds + 32768); const int c = job - 192; const float* pos = c ? cmp_pos_v : cmp_pos_k; const float* w1 = c ? cmp_w1_v : cmp_w1_k;
            float a0 = 0.f, a1 = 0.f;
#pragma unroll 8
            for (int k = 0; k < 512; ++k) { const int kk = F.wave * 512 + k; const f32x2 wv = *(const f32x2*)(w1 + (size_t)kk * 128 + 2 * F.lane); const float pv = pos[kk]; a0 += pv * wv.x; a1 += pv * wv.y; }
            red[F.wave * 128 + 2 * F.lane] = a0; red[F.wave * 128 + 2 * F.lane + 1] = a1;
            __syncthreads();
            if (F.tid < 128) { float s = 0.f;
#pragma unroll
                for (int w = 0; w < 8; ++w) s += red[w * 128 + F.tid];
                CB1[c * 128 + F.tid] = s; }
            __syncthreads();
        }
        for (int job = blockIdx.x; job < 256; job += F.G) {
            float* cs = (float*)lds; float* red = (float*)(lds + 32768);
            for (int i = F.tid; i < 4 * D; i += 512) { const float cv = c_in[i]; cs[i] = cv / (1.0f + __expf(-cv)); }
            __syncthreads();
            const int l = job >> 7, col0 = (job & 127) * 96; const bool act = F.lane < 48;
            float acc[4][2] = {};
            const float* wp = ada_w + ((size_t)l * D + (size_t)F.wave * 256) * 12288 + col0 + 2 * (act ? F.lane : 0);
#pragma unroll 8
            for (int k = 0; k < 256; ++k) { const f32x2 wv = *(const f32x2*)(wp + (size_t)k * 12288); const int kk = F.wave * 256 + k;
#pragma unroll
                for (int b = 0; b < 4; ++b) { const float cv = cs[b * D + kk]; acc[b][0] += cv * wv.x; acc[b][1] += cv * wv.y; } }
            if (act) {
#pragma unroll
                for (int b = 0; b < 4; ++b) { red[(F.wave * 4 + b) * 96 + 2 * F.lane] = acc[b][0]; red[(F.wave * 4 + b) * 96 + 2 * F.lane + 1] = acc[b][1]; } }
            __syncthreads();
            if (F.tid < 384) { const int b = F.tid / 96, cc = F.tid % 96; float s = 0.f;
#pragma unroll
              for (int w = 0; w < 8; ++w) s += red[(w * 4 + b) * 96 + cc];
              MOD[((size_t)l * 4 + b) * 12288 + col0 + cc] = s + ada_b[(size_t)l * 12288 + col0 + cc]; }
            __syncthreads();
        }
        __syncthreads();
        p0_transpose<1, true>(F, ab_w_in, nullptr, D, 3672, Z0W, W_IN0, nullptr, MOE_WSCALE);
        p0_transpose<0>(F, w_uq, nullptr, 512, QMW, QMW, W_UQ, q_norm_g);
        p0_transpose<0>(F, w_ukv, nullptr, 512, KVMW, KVMW, W_UKV, kv_norm_g);
        p0_transpose<0>(F, ab_w_out, nullptr, D, D, D, W_OUT0, nullptr);
        p0_transpose<2>(F, ffn_wg, ffn_wu, D, FF, 2 * FF, W_GU0, nullptr);
        p0_transpose<0>(F, ffn_wd, nullptr, FF, D, D, W_DN0, nullptr);
        p0_transpose<0, true>(F, c_w_in, nullptr, D, Z1W, Z1W, W_IN1, nullptr, MOE_WSCALE);
        p0_transpose<0, true>(F, c_w_out, nullptr, 1024, D, D, W_OUT1, nullptr, MOE_WSCALE);
        p0_transpose<0>(F, cmp_w1_k, nullptr, 4096, 128, 128, W1T, nullptr); p0_transpose<0>(F, cmp_w1_v, nullptr, 4096, 128, 128, W1T + 128 * 4096, nullptr);
        p0_transpose<0>(F, cmp_w2_k, nullptr, 128, 128, 128, W2T, nullptr); p0_transpose<0>(F, cmp_w2_v, nullptr, 128, 128, 128, W2T + 128 * 128, nullptr);
        for (int e = 0; e < NE; ++e) {
            p0_transpose<2, true>(F, moe_wg + (size_t)e * D * FFE, moe_wu + (size_t)e * D * FFE, D, FFE, 2 * FFE, (bf16*)((unsigned char*)W_MGU + (size_t)e * 2 * FFE * D), nullptr, MOE_WSCALE);
            p0_transpose<0, true>(F, moe_wd + (size_t)e * FFE * D, nullptr, FFE, D, D, (bf16*)((unsigned char*)W_MDN + (size_t)e * D * FFE), nullptr, MOE_WSCALE);
        }
        for (int i = F.gw * 64 + F.lane; i < 8 * BIAS_LD; i += F.NGW * 64) { const int h = i / BIAS_LD, r = i % BIAS_LD - 64; BIAS[i] = rel_bias[t5_bucket(r) * 8 + h]; }
        for (int i = F.gw * 64 + F.lane; i < M * 32; i += F.NGW * 64) { const int m = i >> 5, f = i & 31;
            const float inv_freq = powf(10000.0f, -(float)(2 * f) / 64.0f); const float ang = (float)positions[m] * inv_freq;
            ROPE[(size_t)m * 64 + f] = cosf(ang); ROPE[(size_t)m * 64 + 32 + f] = sinf(ang); }
    }
    SEAM(0);
    if (IN(1)) modnorm_phase<true>(F, x_in, mix_norm_g, MOD, 0, H, IN1_ASCALE);
    SEAM(1);
    if (IN(2)) { pg8::Gemm g{H, W_IN0, D / 2, D / 2, D / 2}; pg8::StaticOrder So; So.init(M, Z0W, F.G, (int)blockIdx.x); pg8::EpiBf16S E{Z0, Z0W, 1.0f / (MOE_WSCALE * IN1_ASCALE)};
        pg8::gemm_phase<pg8::EpiBf16S, pg8::StaticOrder, PG_ALIGN, PG_SP2, true, true>(ring, g, So, E); }
    SEAM(2);
    if (IN(3)) {
        for (int m = F.gw; m < M; m += F.NGW) {
            const bf16* zr = Z0 + (size_t)m * Z0W;
#pragma unroll
            for (int w = 0; w < 2; ++w) { const v4u a = *(const v4u*)(zr + (w ? Z_KVLAT : Z_QLAT) + 8 * F.lane);
                float s = bflo(a.x) * bflo(a.x) + bfhi(a.x) * bfhi(a.x) + bflo(a.y) * bflo(a.y) + bfhi(a.y) * bfhi(a.y) + bflo(a.z) * bflo(a.z) + bfhi(a.z) * bfhi(a.z) + bflo(a.w) * bflo(a.w) + bfhi(a.w) * bfhi(a.w);
                s = wave_sum(s); if (F.lane == 0) RINV[(size_t)w * M + m] = 1.0f / sqrtf(s * (1.f / 512.f) + RMS_EPS); }
            if (F.lane < 32) { const float x1 = bf2f(zr[Z_KPE + F.lane]), x2 = bf2f(zr[Z_KPE + 32 + F.lane]); const float cs = ROPE[(size_t)m * 64 + F.lane], sn = ROPE[(size_t)m * 64 + 32 + F.lane];
                KPE[(size_t)m * 64 + F.lane] = (bf16)f2bf(x1 * cs - x2 * sn); KPE[(size_t)m * 64 + 32 + F.lane] = (bf16)f2bf(x2 * cs + x1 * sn); }
        }
        __syncthreads();
        for (int job = blockIdx.x; job < 256; job += F.G) {
            typedef short bfx8 __attribute__((ext_vector_type(8)));
            const int nt = job & 15, g = (job >> 4) & 1, b = (job >> 5) & 3, c = job >> 7, n0 = nt * 16;
            const int fr = F.lane & 15, fq = F.lane >> 4; int nrow = n0 + fr; if (nrow > 254) nrow = 254;
            const bf16* arow = Z0 + ((size_t)b * S + 16 * nrow) * Z0W + Z_NKV + c * 256 + g * 128 + fq * 8;
            const bf16* w1t = W1T + (size_t)c * 128 * 4096 + (size_t)fr * 4096 + fq * 8;
            f32x4 acc[8];
#pragma unroll
            for (int i = 0; i < 8; ++i) acc[i] = (f32x4){0.f, 0.f, 0.f, 0.f};
#pragma unroll 2
            for (int ks = 0; ks < 16; ++ks) { const int kk = F.wave * 512 + ks * 32, l = kk >> 7, d0 = kk & 127;
                const bfx8 af = *(const bfx8*)(arow + (size_t)l * Z0W + d0);
#pragma unroll
                for (int i = 0; i < 8; ++i) { const bfx8 bfr = *(const bfx8*)(w1t + (size_t)i * 16 * 4096 + kk); acc[i] = __builtin_amdgcn_mfma_f32_16x16x32_bf16(af, bfr, acc[i], 0, 0, 0); } }
            float* part = (float*)lds;
#pragma unroll
            for (int i = 0; i < 8; ++i)
#pragma unroll
                for (int j = 0; j < 4; ++j) part[(F.wave * 16 + fq * 4 + j) * 128 + i * 16 + fr] = acc[i][j];
            __syncthreads();
            bf16* hid = (bf16*)(lds + 65536);
            { const int row = F.tid >> 5, c4 = (F.tid & 31) * 4; f32x4 s = *(const f32x4*)(CB1 + c * 128 + c4);
#pragma unroll
              for (int w = 0; w < 8; ++w) s += *(const f32x4*)(part + (w * 16 + row) * 128 + c4);
              *(v2u*)(hid + row * 128 + c4) = (v2u){pk2(gelu_tanh(s.x), gelu_tanh(s.y)), pk2(gelu_tanh(s.z), gelu_tanh(s.w))}; }
            __syncthreads();
            { f32x4 o4 = {0.f, 0.f, 0.f, 0.f}; const bf16* w2t = W2T + (size_t)c * 128 * 128 + (size_t)(F.wave * 16 + fr) * 128 + fq * 8;
#pragma unroll
              for (int ks = 0; ks < 4; ++ks) { const bfx8 af = *(const bfx8*)(hid + fr * 128 + ks * 32 + fq * 8); const bfx8 bfr = *(const bfx8*)(w2t + ks * 32); o4 = __builtin_amdgcn_mfma_f32_16x16x32_bf16(af, bfr, o4, 0, 0, 0); }
              bf16* outp = (c ? VC : KC) + (((size_t)b * 2 + g) * 256) * 128 + F.wave * 16 + fr;
#pragma unroll
              for (int j = 0; j < 4; ++j) { const int n = n0 + fq * 4 + j; outp[(size_t)n * 128] = n < 255 ? (bf16)f2bf(o4[j]) : (bf16)0; } }
            __syncthreads();
        }
        __syncthreads();
        for (int Lx = blockIdx.x; Lx < 512; Lx += F.G) {
            const int qb = 15 - Lx / 32, bh = Lx % 32, b = bh >> 3, h = bh & 7, g = h >> 2; const bf16* zb = Z0 + (size_t)b * S * Z0W;
            fa::Item it{}; it.Q = zb + Z_NQ + h * 128; it.qs = Z0W; it.K = zb + Z_NKV + 4 * 256 + g * 128; it.ks = Z0W; it.V = zb + Z_NKV + 5 * 256 + g * 128; it.vs = Z0W;
            it.P0 = qb * 256; it.skv = S; it.W = 512; it.bias = BIAS + (size_t)h * BIAS_LD + 64; it.bstep = 1; it.O = OWIN + (size_t)b * S * 1024 + h * 128; it.os = 1024;
            fa::attn_block<0>(it, lds);
        }
    }
    SEAM(3);
    if (IN(4)) {
        { pg8::Gemm g{Z0 + Z_QLAT, W_UQ, Z0W, 512, 512}; pg8::StaticOrder So; So.init(M, QMW, F.G, (int)blockIdx.x); pg8::EpiBf16 E{QM, QMW, RINV};
          pg8::gemm_phase<pg8::EpiBf16, pg8::StaticOrder, PG_ALIGN, PG_SP2>(ring, g, So, E); }
        __syncthreads();
        { pg8::Gemm g{Z0 + Z_KVLAT, W_UKV, Z0W, 512, 512}; pg8::StaticOrder So; So.init(M, KVMW, F.G, (int)blockIdx.x); pg8::EpiBf16 E{KVM, KVMW, RINV + M};
          pg8::gemm_phase<pg8::EpiBf16, pg8::StaticOrder, PG_ALIGN, PG_SP2>(ring, g, So, E); }
        __syncthreads();
        for (int Lx = blockIdx.x; Lx < 512; Lx += F.G) { const int tb = 63 - Lx / 8, bg = Lx % 8, b = bg >> 1, g = bg & 1;
            fa::CmpItem it; it.Q = Z0 + ((size_t)b * S + tb * 64) * Z0W + Z_NQ + g * 512; it.qs = Z0W; it.K = KC + ((size_t)b * 2 + g) * 256 * 128; it.V = VC + ((size_t)b * 2 + g) * 256 * 128;
            it.bias = BIAS + (size_t)(g * 4) * BIAS_LD + 64; it.bld = BIAS_LD; it.s0 = tb * 64; it.O = OCMP + ((size_t)b * S + tb * 64) * 1024 + g * 512; it.os = 1024; it.sel = SEL + ((size_t)b * S + tb * 64) * 2 + g;

            fa::cmp_block(it, lds, SMALL_OFF); }
    }
    SEAM(4);
    if (IN(5)) {
        for (int Lx = blockIdx.x; Lx < 256; Lx += F.G) {
            const int x = Lx / 32, bh = Lx % 32, b = bh >> 3, h = bh & 7, g = h >> 2; const bf16* zb = Z0 + (size_t)b * S * Z0W;
            for (int pass = 0; pass < 2; ++pass) { const int qb = pass ? 15 - x : x;
                fa::Item it{}; it.Q = zb + Z_NQ + h * 128; it.qs = Z0W; it.K = zb + Z_NKV + 2 * 256 + g * 128; it.ks = Z0W; it.V = zb + Z_NKV + 3 * 256 + g * 128; it.vs = Z0W;
                it.P0 = qb * 256; it.skv = S; it.W = 1 << 20; it.bias = BIAS + (size_t)h * BIAS_LD + 64; it.bstep = 1; it.sel = SEL + (size_t)b * S * 2 + g; it.sels = 2;
                it.O = CAT + (size_t)b * S * 2048 + h * 128; it.os = 2048;
                it.M0 = OCMP + (size_t)b * S * 1024 + h * 128; it.M1 = OWIN + (size_t)b * S * 1024 + h * 128; it.ms = 1024; it.G = zb + Z_NG + h * 3; it.gs = Z0W;
                fa::attn_block<1>(it, lds); }
        }
        for (int Lx = blockIdx.x; Lx < 256; Lx += F.G) {
            const int x = Lx / 32, bh = Lx % 32, b = bh >> 3, h = bh & 7;
            for (int pass = 0; pass < 2; ++pass) { const int qb = pass ? 15 - x : x;
                fa::Item it{}; it.Q = QM + (size_t)b * S * QMW + h * 192; it.qs = QMW; it.rope = ROPE + (size_t)b * S * 64; it.ropes = 64;
                it.K = KVM + (size_t)b * S * KVMW + h * 256; it.ks = KVMW; it.K2 = KPE + (size_t)b * S * 64; it.k2s = 64; it.V = KVM + (size_t)b * S * KVMW + h * 256 + 128; it.vs = KVMW;
                it.P0 = qb * 256; it.skv = S; it.W = 1 << 20; it.O = CAT + (size_t)b * S * 2048 + 1024 + h * 128; it.os = 2048;
                fa::attn_block<2>(it, lds); }
        }
    }
    SEAM(5);
    if (IN(6)) { pg8::Gemm g{CAT, W_OUT0, 2048, 2048, 2048}; pg8::StaticOrder So; So.init(M, D, F.G, (int)blockIdx.x); pg8::EpiResid E{x_in, X, D, MOD + 2 * D, 6 * D, S / 256};
        pg8::gemm_phase<pg8::EpiResid, pg8::StaticOrder, PG_ALIGN, PG_SP2>(ring, g, So, E); }
    SEAM(6);
    if (IN(7)) modnorm_phase(F, X, ffn_norm_g, MOD, 3, H);
    SEAM(7);
    if (IN(8)) { pg8::Gemm g{H, W_GU0, D, D, D}; pg8::StaticOrder So; So.init(M, 2 * FF, F.G, (int)blockIdx.x); pg8::EpiSwiGLU E{ACT, FF};
        pg8::gemm_phase<pg8::EpiSwiGLU, pg8::StaticOrder, PG_ALIGN, PG_SP2>(ring, g, So, E); }
    SEAM(8);
    if (IN(9)) { pg8::Gemm g{ACT, W_DN0, FF, FF, FF}; pg8::StaticOrder So; So.init(M, D, F.G, (int)blockIdx.x); pg8::EpiResid E{X, X, D, MOD + 5 * D, 6 * D, S / 256};
        pg8::gemm_phase<pg8::EpiResid, pg8::StaticOrder, PG_ALIGN, PG_SP2>(ring, g, So, E); }
    SEAM(9);
    if (IN(10)) modnorm_phase<true>(F, X, mix_norm_g + D, MOD + 4 * 12288, 0, H, IN1_ASCALE);
    SEAM(10);
    if (IN(11)) { pg8::Gemm g{H, W_IN1, D / 2, D / 2, D / 2}; pg8::StaticOrder So; So.init(M, Z1W, F.G, (int)blockIdx.x); pg8::EpiBf16S E{Z1, Z1W, 1.0f / (MOE_WSCALE * IN1_ASCALE)};
        pg8::gemm_phase<pg8::EpiBf16S, pg8::StaticOrder, PG_ALIGN, PG_SP2, true, true>(ring, g, So, E); }
    SEAM(11);
    if (IN(12)) {
        for (int Lx = blockIdx.x; Lx < 1536; Lx += F.G) {
            const int p = Lx % 3, r_ = Lx / 3, bh = r_ % 32, sub = r_ / 32, b = bh >> 3, h = bh & 7;
            const int dil = p == 0 ? 1 : (p == 1 ? 4 : 16), res = p == 0 ? 0 : (p == 1 ? (sub & 3) : sub), qb = p == 0 ? sub : (p == 1 ? (sub >> 2) : 0);
            fa::Item it{}; it.Q = Z1 + ((size_t)b * S + res) * Z1W + p * 3072 + h * 128; it.qs = (long)dil * Z1W; it.K = it.Q + 1024; it.ks = it.qs; it.V = it.Q + 2048; it.vs = it.qs;
            it.P0 = qb * 256; it.skv = S / dil; it.W = 129; it.bias = BIAS + (size_t)h * BIAS_LD + 64; it.bstep = dil;
            it.O = OP + (size_t)p * M * 1024 + ((size_t)b * S + res) * 1024 + h * 128; it.os = (long)dil * 1024; it.LSE = LSEB + (size_t)p * M * 8 + ((size_t)b * S + res) * 8 + h; it.lses = (long)dil * 8;
            fa::attn_block<0>(it, lds);
        }
    }
    SEAM(12);
    if (IN(13)) {
        for (int m = F.gw; m < M; m += F.NGW) {
            const int h = F.lane >> 3; const float l0 = LSEB[(size_t)m * 8 + h], l1 = LSEB[(size_t)(M + m) * 8 + h], l2 = LSEB[(size_t)(2 * M + m) * 8 + h];
            const v4u* p0 = (const v4u*)(OP + (size_t)m * 1024) + 2 * F.lane; const v4u* p1 = (const v4u*)(OP + (size_t)(M + m) * 1024) + 2 * F.lane; const v4u* p2 = (const v4u*)(OP + (size_t)(2 * M + m) * 1024) + 2 * F.lane;
            const v4u a0 = p0[0], b0 = p0[1], a1 = p1[0], b1 = p1[1], a2 = p2[0], b2 = p2[1];
            const float mx = fmaxf(l0, fmaxf(l1, l2)); float e0 = __expf(l0 - mx), e1 = __expf(l1 - mx), e2 = __expf(l2 - mx); const float inv = 1.0f / (e0 + e1 + e2); e0 *= inv; e1 *= inv; e2 *= inv;
            e0 *= MOE_ASCALE; e1 *= MOE_ASCALE; e2 *= MOE_ASCALE;
            float lo_[8], hi_[8];
#pragma unroll
            for (int q = 0; q < 4; ++q) { lo_[q] = e0 * bflo(a0[q]) + e1 * bflo(a1[q]) + e2 * bflo(a2[q]); hi_[q] = e0 * bfhi(a0[q]) + e1 * bfhi(a1[q]) + e2 * bfhi(a2[q]);
                lo_[4 + q] = e0 * bflo(b0[q]) + e1 * bflo(b1[q]) + e2 * bflo(b2[q]); hi_[4 + q] = e0 * bfhi(b0[q]) + e1 * bfhi(b1[q]) + e2 * bfhi(b2[q]); }
#pragma unroll
            for (int q = 0; q < 8; ++q) { lo_[q] = __builtin_amdgcn_fmed3f(lo_[q], -440.f, 440.f); hi_[q] = __builtin_amdgcn_fmed3f(hi_[q], -440.f, 440.f); }
            v4u o8; o8.x = pk4_fp8(lo_[0], hi_[0], lo_[1], hi_[1]); o8.y = pk4_fp8(lo_[2], hi_[2], lo_[3], hi_[3]); o8.z = pk4_fp8(lo_[4], hi_[4], lo_[5], hi_[5]); o8.w = pk4_fp8(lo_[6], hi_[6], lo_[7], hi_[7]);
            *((v4u*)((unsigned char*)OM + (size_t)m * 1024) + F.lane) = o8;
        }
    }
    SEAM(13);
    if (IN(14)) { pg8::Gemm g{OM, W_OUT1, 512, 512, 512}; pg8::StaticOrder So; So.init(M, D, F.G, (int)blockIdx.x); pg8::EpiResid E{X, X, D, MOD + 4 * 12288 + 2 * D, 6 * D, S / 256, 1.0f / (MOE_WSCALE * MOE_ASCALE)};
        pg8::gemm_phase<pg8::EpiResid, pg8::StaticOrder, PG_ALIGN, PG_SP2, true, true>(ring, g, So, E); }
    SEAM(14);
    if (IN(15)) {
        f32x4* wl = (f32x4*)lds; int* lcnt = (int*)(lds + 65536); int* lbase = lcnt + 8; int* rinfo = lcnt + 16;
        for (int i = F.tid; i < 4096; i += 512) { const int slot = i >> 6, l = i & 63, j = slot >> 3, q = (slot >> 1) & 3, half = slot & 1; wl[i] = *(const f32x4*)(w_router + (size_t)(4 * l + 256 * j + q) * 8 + half * 4); }
        if (F.tid < 8) lcnt[F.tid] = 0;
        __syncthreads();
        for (int k = 0; k < M / 2048; ++k) { const int m = F.gw + k * F.NGW; if (m >= M) break; const int b = m / S; const float* mb = MOD + 4 * 12288 + (size_t)b * 6 * D; f32x4 v[8];
            modnorm_row(X + (size_t)m * D, ffn_norm_g + D, mb + 4 * D, mb + 3 * D, H + (size_t)m * D, F.lane, v);
            float lg[8] = {};
#pragma unroll
            for (int j = 0; j < 8; ++j)
#pragma unroll
                for (int q = 0; q < 4; ++q) { const f32x4 wa = wl[((j * 4 + q) * 2 + 0) * 64 + F.lane], wb = wl[((j * 4 + q) * 2 + 1) * 64 + F.lane]; const float hv = v[j][q];
                    lg[0] += hv * wa.x; lg[1] += hv * wa.y; lg[2] += hv * wa.z; lg[3] += hv * wa.w; lg[4] += hv * wb.x; lg[5] += hv * wb.y; lg[6] += hv * wb.z; lg[7] += hv * wb.w; }
#pragma unroll
            for (int e = 0; e < 8; ++e) lg[e] = wave_sum(lg[e]);
            int e1 = 0; float v1 = lg[0];
#pragma unroll
            for (int e = 1; e < 8; ++e) if (lg[e] > v1) { v1 = lg[e]; e1 = e; }
            int e2 = -1; float v2 = -3.0e38f;
#pragma unroll
            for (int e = 0; e < 8; ++e) if (e != e1 && lg[e] > v2) { v2 = lg[e]; e2 = e; }
            if (F.lane == 0) { const float g1 = 1.0f / (1.0f + __expf(v2 - v1)), g2 = 1.0f - g1;
                const int r1 = __hip_atomic_fetch_add(lcnt + e1, 1, __ATOMIC_RELAXED, __HIP_MEMORY_SCOPE_WORKGROUP), r2 = __hip_atomic_fetch_add(lcnt + e2, 1, __ATOMIC_RELAXED, __HIP_MEMORY_SCOPE_WORKGROUP);
                int* ri = rinfo + (F.wave * 8 + k) * 8; ri[0] = e1; ri[1] = e2; ri[2] = r1; ri[3] = r2; ri[4] = __float_as_int(g1); ri[5] = __float_as_int(g2); }
        }
        __syncthreads();
        if (F.tid < 8) lbase[F.tid] = (int)atomicAdd(ctl + CW_CNT + F.tid, (unsigned)lcnt[F.tid]);
        __syncthreads();
        if (F.lane == 0) for (int k = 0; k < M / 2048; ++k) { const int m = F.gw + k * F.NGW; if (m >= M) break; const int* ri = rinfo + (F.wave * 8 + k) * 8; int* rt = ROUTE + (size_t)m * 8;
            rt[0] = ri[0]; rt[1] = ri[1]; rt[2] = ri[2] + lbase[ri[0]]; rt[3] = ri[3] + lbase[ri[1]]; rt[4] = ri[4]; rt[5] = ri[5]; }
    }
    SEAM(15);
    if (IN(16)) {
        unsigned ts[9]; ts[0] = 0;
#pragma unroll
        for (int e = 0; e < 8; ++e) ts[e + 1] = ts[e] + (__hip_atomic_load(ctl + CW_CNT + e, __ATOMIC_RELAXED, __HIP_MEMORY_SCOPE_AGENT) + 255u) / 256u;
        if (blockIdx.x == 0 && F.tid < 9) { unsigned v = ts[0];
#pragma unroll
            for (int e = 1; e < 9; ++e) v = (F.tid == e) ? ts[e] : v;
            ctl[CW_TS + F.tid] = v; }
        for (int m = F.gw; m < M; m += F.NGW) { const int* rt = ROUTE + (size_t)m * 8; const int e1 = rt[0], e2 = rt[1]; unsigned t1 = 0, t2 = 0;
#pragma unroll
            for (int e = 0; e < 8; ++e) { t1 = (e == e1) ? ts[e] : t1; t2 = (e == e2) ? ts[e] : t2; }
            const size_t d1 = (size_t)t1 * 256 + rt[2], d2 = (size_t)t2 * 256 + rt[3];
            const v4u* src = (const v4u*)(H + (size_t)m * D) + F.lane;
            v2u* o1 = (v2u*)((unsigned char*)XB + d1 * D) + F.lane; v2u* o2 = (v2u*)((unsigned char*)XB + d2 * D) + F.lane;
#pragma unroll
            for (int j = 0; j < 4; ++j) { const v4u w = src[64 * j]; v2u q; q.x = pk4_fp8(bflo(w.x), bfhi(w.x), bflo(w.y), bfhi(w.y)); q.y = pk4_fp8(bflo(w.z), bfhi(w.z), bflo(w.w), bfhi(w.w)); o1[64 * j] = q; o2[64 * j] = q; } }
    }
    SEAM(16);
    if (IN(17)) { pg8::Gemm g{XB, W_MGU, D / 2, D / 2, D / 2}; pg8::GroupedOrder So; So.init(ctl + CW_TS, 2 * FFE / 256, F.G, (int)blockIdx.x); pg8::EpiSwiGLU8 E{(unsigned char*)ACTB, FFE, 1.0f / MOE_WSCALE, MOE_ASCALE};
        pg8::gemm_phase<pg8::EpiSwiGLU8, pg8::GroupedOrder, PG_ALIGN, PG_SP2, true, true>(ring, g, So, E); }
    SEAM(17);
    if (IN(18)) { pg8::Gemm g{ACTB, W_MDN, FFE / 2, FFE / 2, FFE / 2}; pg8::GroupedOrder So; So.init(ctl + CW_TS, D / 256, F.G, (int)blockIdx.x); pg8::EpiBf16S E{YB, D, 1.0f / (MOE_WSCALE * MOE_ASCALE)};
        pg8::gemm_phase<pg8::EpiBf16S, pg8::GroupedOrder, PG_ALIGN, PG_SP2, true, true>(ring, g, So, E); }
    SEAM(18);
    if (IN(19)) {
        unsigned ts[9]; ts[0] = 0;
#pragma unroll
        for (int e = 0; e < 8; ++e) ts[e + 1] = ctl[CW_TS + e + 1];
#pragma unroll
        for (int b = 0; b < NB; ++b) {
            const float* gf = MOD + 4 * 12288 + (size_t)b * 6 * D + 5 * D;
            const int m0 = b * S + F.gw, m1 = m0 + F.NGW;
            const int* rt0 = ROUTE + (size_t)m0 * 8; const int* rt1 = ROUTE + (size_t)m1 * 8;
            const int e10 = rt0[0], e20 = rt0[1], r10 = rt0[2], r20 = rt0[3], e11 = rt1[0], e21 = rt1[1], r11 = rt1[2], r21 = rt1[3];
            const float g10 = __int_as_float(rt0[4]), g20 = __int_as_float(rt0[5]), g11 = __int_as_float(rt1[4]), g21 = __int_as_float(rt1[5]);
            unsigned t10 = 0, t20 = 0, t11 = 0, t21 = 0;
#pragma unroll
            for (int e = 0; e < 8; ++e) { t10 = (e == e10) ? ts[e] : t10; t20 = (e == e20) ? ts[e] : t20; t11 = (e == e11) ? ts[e] : t11; t21 = (e == e21) ? ts[e] : t21; }
            const v2u* ya0 = (const v2u*)(YB + ((size_t)t10 * 256 + r10) * D) + F.lane; const v2u* yb0 = (const v2u*)(YB + ((size_t)t20 * 256 + r20) * D) + F.lane;
            const v2u* ya1 = (const v2u*)(YB + ((size_t)t11 * 256 + r11) * D) + F.lane; const v2u* yb1 = (const v2u*)(YB + ((size_t)t21 * 256 + r21) * D) + F.lane;
            const f32x4* x0 = (const f32x4*)(X + (size_t)m0 * D) + F.lane; const f32x4* x1 = (const f32x4*)(X + (size_t)m1 * D) + F.lane;
            f32x4 v0[8], v1[8]; v2u a0[8], c0[8], a1[8], c1[8];
#pragma unroll
            for (int j = 0; j < 8; ++j) { v0[j] = x0[64 * j]; v1[j] = x1[64 * j]; a0[j] = ya0[64 * j]; c0[j] = yb0[64 * j]; a1[j] = ya1[64 * j]; c1[j] = yb1[64 * j]; }
            float q0 = 0.f, q1 = 0.f;
#pragma unroll
            for (int j = 0; j < 8; ++j) { const f32x4 gg = ((const f32x4*)gf)[F.lane + 64 * j]; f32x4 y;
                y.x = g10 * bflo(a0[j].x) + g20 * bflo(c0[j].x); y.y = g10 * bfhi(a0[j].x) + g20 * bfhi(c0[j].x); y.z = g10 * bflo(a0[j].y) + g20 * bflo(c0[j].y); y.w = g10 * bfhi(a0[j].y) + g20 * bfhi(c0[j].y);
                v0[j] = v0[j] + gg * y; q0 += (v0[j].x * v0[j].x + v0[j].y * v0[j].y) + (v0[j].z * v0[j].z + v0[j].w * v0[j].w);
                y.x = g11 * bflo(a1[j].x) + g21 * bflo(c1[j].x); y.y = g11 * bfhi(a1[j].x) + g21 * bfhi(c1[j].x); y.z = g11 * bflo(a1[j].y) + g21 * bflo(c1[j].y); y.w = g11 * bfhi(a1[j].y) + g21 * bfhi(c1[j].y);
                v1[j] = v1[j] + gg * y; q1 += (v1[j].x * v1[j].x + v1[j].y * v1[j].y) + (v1[j].z * v1[j].z + v1[j].w * v1[j].w); }
            const float ri0 = 1.0f / sqrtf(wave_sum(q0) * (1.f / D) + RMS_EPS), ri1 = 1.0f / sqrtf(wave_sum(q1) * (1.f / D) + RMS_EPS);
            f32x4* o0 = (f32x4*)(args.out + (size_t)m0 * D) + F.lane; f32x4* o1 = (f32x4*)(args.out + (size_t)m1 * D) + F.lane;
#pragma unroll
            for (int j = 0; j < 8; ++j) { const f32x4 fg = ((const f32x4*)final_g)[F.lane + 64 * j]; o0[64 * j] = (v0[j] * ri0) * fg; o1[64 * j] = (v1[j] * ri1) * fg; }
        }
    }
#undef IN
#undef SEAM
}

constexpr int N_PHASES = 20;
extern "C" void kernel_launch(void* const* d_in, const int* in_sizes, int n_in, void* d_out, int out_size, void* d_ws, size_t ws_size, hipStream_t stream) {
    static int grid = 0;
    if (grid == 0) {
        if (n_in != 30 || in_sizes[0] != M * D || out_size != M * D || ws_size < WS_END) { fprintf(stderr, "kernel_launch: shape/workspace mismatch: n_in %d in0 %d out %d ws %zu (need %zu)\n", n_in, n_in > 0 ? in_sizes[0] : -1, out_size, ws_size, (size_t)WS_END); grid = -1; return; }
        int dev = 0, cus = 0, per_cu = 0;
        if (hipGetDevice(&dev) != hipSuccess || hipDeviceGetAttribute(&cus, hipDeviceAttributeMultiprocessorCount, dev) != hipSuccess) { grid = -1; return; }
        if (hipFuncSetAttribute((const void*)fwd, hipFuncAttributeMaxDynamicSharedMemorySize, LDS_BYTES) != hipSuccess) { fprintf(stderr, "kernel_launch: hipFuncSetAttribute failed\n"); grid = -1; return; }
        if (hipOccupancyMaxActiveBlocksPerMultiprocessor(&per_cu, (const void*)fwd, NWAVES * 64, LDS_BYTES) != hipSuccess || per_cu < 1) fprintf(stderr, "kernel_launch: occupancy query reports %d\n", per_cu);
        (void)hipGetLastError();
        grid = cus;
        if (grid != 256) { fprintf(stderr, "kernel_launch: built for a 256-CU device (got %d)\n", cus); grid = -1; return; }
    }
    if (grid < 0) return;
    if (hipMemsetAsync((char*)d_ws + WS_CTL, 0, CTL_ZERO_BYTES, stream) != hipSuccess) return;
    Args a{};
    for (int i = 0; i < 30; ++i) a.in[i] = d_in[i];
    a.out = (float*)d_out; a.ws = (unsigned char*)d_ws;
    if (MK_N_LAUNCHES == 1) { a.ph_lo = 0; a.ph_hi = N_PHASES; hipLaunchKernelGGL(fwd, dim3(grid), dim3(NWAVES * 64), LDS_BYTES, stream, a); }
    else { for (int p = 0; p < N_PHASES; ++p) { a.ph_lo = p; a.ph_hi = p + 1; hipLaunchKernelGGL(fwd, dim3(grid), dim3(NWAVES * 64), LDS_BYTES, stream, a); } }
    const hipError_t le = hipPeekAtLastError();
    if (le != hipSuccess) fprintf(stderr, "kernel_launch: launch failed: %s\n", hipGetErrorName(le));
}
```

```cpp
#include <hip/hip_runtime.h>
#include <cstdio>
#include <cstdint>

#define WGM_G 8
#define PG_ALIGN true
#define PG_SP2 true
#ifndef MK_N_LAUNCHES
#define MK_N_LAUNCHES 1
#endif

namespace pg8 {
#define PG8_LAS __attribute__((address_space(3)))
typedef unsigned short bf16_t;
typedef short bf16x8 __attribute__((ext_vector_type(8)));
typedef float f32x4 __attribute__((ext_vector_type(4)));
typedef float f32x2 __attribute__((ext_vector_type(2)));
typedef unsigned u32x4 __attribute__((ext_vector_type(4)));
typedef unsigned u32x2 __attribute__((ext_vector_type(2)));
constexpr int BM = 256, BK = 64, HALF = 128, HTB = HALF * BK * 2  , STAGE_BYTES = 8 * HTB, NXCD = 8, WGM = 8;

__host__ __device__ __forceinline__ int lds_byte(int r, int c) { const int st = (r >> 4) * 2 + (c >> 5), rr = r & 15, cc = c & 31, ob = rr * 64 + cc * 2; return st * 1024 + (ob ^ (((ob >> 9) & 1) << 5)); }
__host__ __device__ __forceinline__ void stage_rc(int b, int& R, int& C) { const int st = b / 1024, sb = b % 1024, swz = sb ^ (((sb >> 9) & 1) << 5); R = (st >> 1) * 16 + swz / 64; C = (st & 1) * 32 + (swz % 64) / 2; }
__host__ __device__ __forceinline__ int perm32(int rho) { const int n = rho >> 4, i = rho & 15; return 8 * (i >> 2) + 4 * n + (i & 3); }

struct Unit { int pm, pn, pb; };
struct Gemm { const bf16_t* A; const bf16_t* Bt; int lda, ldb, K; };

struct StaticOrder {
    int nM, nN, nwg, G, c;
    __host__ __device__ void init(int M, int N, int G_, int c_) { nM = M / BM; nN = N / BM; nwg = nM * nN; G = G_; c = c_; }
    __host__ __device__ bool next(int i, Unit& u) const {
        const long L = (long)i * G + c; if (L >= nwg) return false;
        int wgid = (int)L; { const int q = nwg / NXCD, r = nwg % NXCD, xcd = wgid % NXCD, off = wgid / NXCD; wgid = (xcd < r ? xcd * (q + 1) : r * (q + 1) + (xcd - r) * q) + off; }
        const int nig = WGM * nN, gid = wgid / nig, fm = gid * WGM, gsz = (nM - fm) < WGM ? (nM - fm) : WGM;
        u.pm = fm + ((wgid % nig) % gsz); u.pn = (wgid % nig) / gsz; u.pb = u.pn; return true;
    }
    __device__ __forceinline__ void a_ready(const Unit&) const {}
    __device__ __forceinline__ void done(const Unit&) const {}
};
#ifndef WGM_G
#endif
struct GroupedOrder {
    int nN, G, c; int ts[9];
    __device__ __forceinline__ void init(const unsigned* tstart, int nN_, int G_, int c_) { nN = nN_; G = G_; c = c_;
#pragma unroll
        for (int e = 0; e < 9; ++e) ts[e] = (int)tstart[e]; }
    __device__ __forceinline__ bool next(int i, Unit& u) const {
        const long L = (long)i * G + c; if (L >= (long)ts[8] * nN) return false;
        int e = 0, us = 0, te = ts[1] - ts[0], t0 = ts[0];
#pragma unroll
        for (int k = 1; k < 8; ++k) { const int s = ts[k] * nN; if (L >= s) { e = k; us = s; te = ts[k + 1] - ts[k]; t0 = ts[k]; } }
        if (te <= 0) return false;
        int wgid = (int)L - us; { const int nwg = te * nN, q = nwg / NXCD, rr = nwg % NXCD, xcd = wgid % NXCD, off = wgid / NXCD; wgid = (xcd < rr ? xcd * (q + 1) : rr * (q + 1) + (xcd - rr) * q) + off; }
        const int nig = WGM_G * nN, gid = wgid / nig, fm = gid * WGM_G, gsz = (te - fm) < WGM_G ? (te - fm) : WGM_G;
        u.pm = t0 + fm + ((wgid % nig) % gsz); u.pn = (wgid % nig) / gsz; u.pb = e * nN + u.pn; return true;
    }
    __device__ __forceinline__ void a_ready(const Unit&) const {}
    __device__ __forceinline__ void done(const Unit&) const {}
};

typedef __bf16 bf16x2c __attribute__((ext_vector_type(2)));
__device__ __forceinline__ unsigned cvt_pk_bf16(float lo, float hi) { const f32x2 v = {lo, hi}; return __builtin_bit_cast(unsigned, __builtin_convertvector(v, bf16x2c)); }

struct EpiBf16 {
    static constexpr bool PERM = true, AFTER_DRAIN = false;
    bf16_t* O; int ldc; const float* rowscale;
    __device__ __forceinline__ void operator()(const f32x4 (&acc)[2][2][4][2], const Unit& u, int wr, int wc, int fr, int fq) const {
        const int row0 = u.pm * BM + wr * 64 + fr; const int col0 = u.pn * BM + wc * 32 + 8 * fq;
#pragma unroll
        for (int ai = 0; ai < 2; ++ai)
#pragma unroll
            for (int m = 0; m < 4; ++m) { const int row = row0 + ai * HALF + m * 16; bf16_t* rowp = O + (size_t)row * ldc + col0; const float sc = rowscale ? rowscale[row] : 1.f;
#pragma unroll
                for (int bj = 0; bj < 2; ++bj) { f32x4 v0 = acc[ai][bj][m][0] * sc, v1 = acc[ai][bj][m][1] * sc;
                    u32x4 w; w.x = cvt_pk_bf16(v0[0], v0[1]); w.y = cvt_pk_bf16(v0[2], v0[3]); w.z = cvt_pk_bf16(v1[0], v1[1]); w.w = cvt_pk_bf16(v1[2], v1[3]);
                    *(u32x4*)(rowp + bj * HALF) = w; } }
    }
};
struct EpiResid {
    static constexpr bool PERM = false, AFTER_DRAIN = false;
    const float* xin; float* xout; int ldc; const float* gate; int gstride; int tiles_per_b; float s = 1.0f;
    __device__ __forceinline__ void operator()(const f32x4 (&acc)[2][2][4][2], const Unit& u, int wr, int wc, int fr, int fq) const {
        const int row0 = u.pm * BM + wr * 64 + fr, col0 = u.pn * BM + wc * 32 + 4 * fq;
        const float* gp = gate + (size_t)(u.pm / tiles_per_b) * gstride + col0;
        f32x4 gv[2][2];
#pragma unroll
        for (int bj = 0; bj < 2; ++bj)
#pragma unroll
            for (int n = 0; n < 2; ++n) gv[bj][n] = *(const f32x4*)(gp + bj * HALF + n * 16) * s;
#pragma unroll
        for (int ai = 0; ai < 2; ++ai)
#pragma unroll
            for (int m = 0; m < 4; ++m) { const size_t off = (size_t)(row0 + ai * HALF + m * 16) * ldc + col0;
#pragma unroll
                for (int bj = 0; bj < 2; ++bj)
#pragma unroll
                    for (int n = 0; n < 2; ++n) { const f32x4 xi = *(const f32x4*)(xin + off + bj * HALF + n * 16);
                        *(f32x4*)(xout + off + bj * HALF + n * 16) = xi + gv[bj][n] * acc[ai][bj][m][n]; }
                asm volatile("" ::: "memory"); }
    }
};
__device__ __forceinline__ float silu_f(float g) { return g * __builtin_amdgcn_rcpf(1.0f + __builtin_amdgcn_exp2f(-1.4426950408889634f * g)); }
struct EpiSwiGLU {
    static constexpr bool PERM = false, AFTER_DRAIN = false;
    bf16_t* O; int ldo;
    __device__ __forceinline__ void operator()(const f32x4 (&acc)[2][2][4][2], const Unit& u, int wr, int wc, int fr, int fq) const {
        const int row0 = u.pm * BM + wr * 64 + fr, col0 = u.pn * HALF + wc * 16 + 4 * fq;
#pragma unroll
        for (int ai = 0; ai < 2; ++ai)
#pragma unroll
            for (int m = 0; m < 4; ++m) { bf16_t* rowp = O + (size_t)(row0 + ai * HALF + m * 16) * ldo + col0;
#pragma unroll
                for (int bj = 0; bj < 2; ++bj) { const f32x4 g = acc[ai][bj][m][0], up = acc[ai][bj][m][1];
                    u32x2 w; w.x = cvt_pk_bf16(silu_f(g[0]) * up[0], silu_f(g[1]) * up[1]); w.y = cvt_pk_bf16(silu_f(g[2]) * up[2], silu_f(g[3]) * up[3]);
                    *(u32x2*)(rowp + bj * 64) = w; } }
    }
};
struct EpiSwiGLU8 {
    static constexpr bool PERM = false, AFTER_DRAIN = false;
    unsigned char* O8; int ldo; float s, so;
    __device__ __forceinline__ void operator()(const f32x4 (&acc)[2][2][4][2], const Unit& u, int wr, int wc, int fr, int fq) const {
        const int row0 = u.pm * BM + wr * 64 + fr, col0 = u.pn * HALF + wc * 16 + 4 * fq;
#pragma unroll
        for (int ai = 0; ai < 2; ++ai)
#pragma unroll
            for (int m = 0; m < 4; ++m) { const size_t off = (size_t)(row0 + ai * HALF + m * 16) * ldo + col0;
#pragma unroll
                for (int bj = 0; bj < 2; ++bj) { const f32x4 g = acc[ai][bj][m][0] * s, up = acc[ai][bj][m][1] * s;
                    const float v0 = silu_f(g[0]) * up[0], v1 = silu_f(g[1]) * up[1], v2 = silu_f(g[2]) * up[2], v3 = silu_f(g[3]) * up[3];
                    int w = 0; w = __builtin_amdgcn_cvt_pk_fp8_f32(__builtin_amdgcn_fmed3f(v0 * so, -440.f, 440.f), __builtin_amdgcn_fmed3f(v1 * so, -440.f, 440.f), w, false);
                    w = __builtin_amdgcn_cvt_pk_fp8_f32(__builtin_amdgcn_fmed3f(v2 * so, -440.f, 440.f), __builtin_amdgcn_fmed3f(v3 * so, -440.f, 440.f), w, true); *(int*)(O8 + off + bj * 64) = w; } }
    }
};
struct EpiBf16S {
    static constexpr bool PERM = true, AFTER_DRAIN = false;
    bf16_t* O; int ldc; float s;
    __device__ __forceinline__ void operator()(const f32x4 (&acc)[2][2][4][2], const Unit& u, int wr, int wc, int fr, int fq) const {
        const int row0 = u.pm * BM + wr * 64 + fr; const int col0 = u.pn * BM + wc * 32 + 8 * fq;
#pragma unroll
        for (int ai = 0; ai < 2; ++ai)
#pragma unroll
            for (int m = 0; m < 4; ++m) { bf16_t* rowp = O + (size_t)(row0 + ai * HALF + m * 16) * ldc + col0;
#pragma unroll
                for (int bj = 0; bj < 2; ++bj) { const f32x4 v0 = acc[ai][bj][m][0] * s, v1 = acc[ai][bj][m][1] * s;
                    u32x4 w; w.x = cvt_pk_bf16(v0[0], v0[1]); w.y = cvt_pk_bf16(v0[2], v0[3]); w.z = cvt_pk_bf16(v1[0], v1[1]); w.w = cvt_pk_bf16(v1[2], v1[3]);
                    *(u32x4*)(rowp + bj * HALF) = w; } }
    }
};

template <class Epi, class Sched, bool ALIGN_EPI = false, bool SP2 = false, bool F8 = false, bool FW = false>
__device__ __forceinline__ void gemm_phase(PG8_LAS unsigned char* lds, const Gemm g, const Sched& S, const Epi& E) {
    const int tid = threadIdx.x, wid = __builtin_amdgcn_readfirstlane(tid >> 6), lane = tid & 63, wr = wid >> 2, wc = wid & 3, fr = lane & 15, fq = lane >> 4;
    const int K = g.K, nt = K / BK;
    unsigned voffA[2], voffB[2];
#pragma unroll
    for (int i = 0; i < 2; ++i) { int R, C; stage_rc(tid * 16 + i * 8192, R, C); const int Rb = Epi::PERM ? ((R & ~31) + perm32(R & 31)) : R;
        voffA[i] = (unsigned)(R * g.lda + C) * 2u; voffB[i] = (unsigned)(Rb * g.ldb + C) * 2u; }
    const size_t kstep = (size_t)(BK * 2);
    const size_t hstepA = (size_t)HALF * g.lda * 2, hstepB = (size_t)HALF * g.ldb * 2;
    const size_t tstepA = 2 * hstepA, tstepB = (F8 && !FW) ? hstepB : 2 * hstepB;
    const unsigned ldsw = (unsigned)wid * 1024u;
    const int aoff = lds_byte(wr * 64 + fr, fq * 8), boff = lds_byte(wc * 32 + fr, fq * 8);
#define PG8_SA(b, h) (((b) * 2 + (h)) * HTB)
#define PG8_SB(b, h) ((4 + (b) * 2 + (h)) * HTB)
#define PG8_STAGE(bufoff, gbase, voff) do { _Pragma("unroll") for (int _i = 0; _i < 2; ++_i) \
        __builtin_amdgcn_global_load_lds((const unsigned*)((const char*)(gbase) + (voff)[_i]), (PG8_LAS unsigned*)(lds + (bufoff) + ldsw + _i * 8192), 16, 0, 0); } while (0)
#define PG8_LDA(dst, b, h) do { _Pragma("unroll") for (int m = 0; m < 4; ++m) _Pragma("unroll") for (int k = 0; k < 2; ++k) dst[m][k] = *(const PG8_LAS bf16x8*)(lds + PG8_SA(b, h) + aoff + m * 2048 + k * 1024); } while (0)
#define PG8_LDB(dst, b, h) do { if constexpr (!F8 || FW || (h) == 0) { _Pragma("unroll") for (int n = 0; n < 2; ++n) _Pragma("unroll") for (int k = 0; k < 2; ++k) dst[n][k] = *(const PG8_LAS bf16x8*)(lds + PG8_SB(b, h) + boff + n * 2048 + k * 1024); } } while (0)
#define PG8_CAT(x, y) __builtin_shufflevector(x, y, 0, 1, 2, 3, 4, 5, 6, 7, 8, 9, 10, 11, 12, 13, 14, 15)
#define PG8_MMA(ai, bj, At, Bt) do { if constexpr (!F8 || FW || (bj) == 0) { __builtin_amdgcn_s_setprio(1); \
        if constexpr (F8) { _Pragma("unroll") for (int m = 0; m < 4; ++m) _Pragma("unroll") for (int n = 0; n < 2; ++n) \
            { const v8i_ b8_ = __builtin_bit_cast(v8i_, PG8_CAT(Bt[n][0], Bt[n][1])), a8_ = __builtin_bit_cast(v8i_, PG8_CAT(At[m][0], At[m][1])); \
            if constexpr (FW) asm volatile("v_mfma_scale_f32_16x16x128_f8f6f4 %0, %1, %2, %0, %3, %3 op_sel_hi:[0,0,0]" : "+v"(acc[ai][bj][m][n]) : "v"(b8_), "v"(a8_), "v"(0x7f7f7f7f)); \
            else acc[ai][bj][m][n] = __builtin_amdgcn_mfma_scale_f32_16x16x128_f8f6f4(b8_, a8_, acc[ai][bj][m][n], 0, 0, 0, 0x7f7f7f7f, 0, 0x7f7f7f7f); } } \
        else { _Pragma("unroll") for (int m = 0; m < 4; ++m) _Pragma("unroll") for (int n = 0; n < 2; ++n) _Pragma("unroll") for (int k = 0; k < 2; ++k) \
            acc[ai][bj][m][n] = __builtin_amdgcn_mfma_f32_16x16x32_bf16(Bt[n][k], At[m][k], acc[ai][bj][m][n], 0, 0, 0); } \
        __builtin_amdgcn_s_setprio(0); } } while (0)
#define PG8_WAIT_V(n) asm volatile("s_waitcnt vmcnt(" #n ")" ::: "memory")
#define PG8_WAIT_L(n) asm volatile("s_waitcnt lgkmcnt(" #n ")" ::: "memory")
#define PG8_BAR __builtin_amdgcn_s_barrier()
#define PG8_SCHED __builtin_amdgcn_sched_barrier(0)
    Unit cur, nxt; int ui = 0;
    if (!S.next(0, cur)) return;
    f32x4 acc[2][2][4][2];
#pragma unroll
    for (int a = 0; a < 2; ++a)
#pragma unroll
        for (int b = 0; b < 2; ++b)
#pragma unroll
            for (int m = 0; m < 4; ++m)
#pragma unroll
                for (int n = 0; n < 2; ++n) acc[a][b][m][n] = (f32x4){0.f, 0.f, 0.f, 0.f};
    bf16x8 At[4][2], B0[2][2], B1[2][2];
    typedef int v8i_ __attribute__((ext_vector_type(8))); typedef short bf16x16_ __attribute__((ext_vector_type(16)));
    const char* cA = (const char*)g.A + (size_t)cur.pm * tstepA; const char* cB = (const char*)g.Bt + (size_t)cur.pb * tstepB;
    S.a_ready(cur);
    if constexpr (SP2) {
        PG8_STAGE(PG8_SB(0, 0), cB, voffB); if constexpr (!F8 || FW) PG8_STAGE(PG8_SB(0, 1), cB + hstepB, voffB); PG8_STAGE(PG8_SA(0, 0), cA, voffA); PG8_STAGE(PG8_SA(0, 1), cA + hstepA, voffA);
        if (wr == 1) PG8_BAR;
        PG8_WAIT_V(2); PG8_BAR;
        PG8_STAGE(PG8_SB(1, 0), cB + kstep, voffB); PG8_STAGE(PG8_SA(1, 0), cA + kstep, voffA); if constexpr (!F8 || FW) PG8_STAGE(PG8_SB(1, 1), cB + hstepB + kstep, voffB);
        if constexpr (F8 && !FW) PG8_WAIT_V(4); else PG8_WAIT_V(6); PG8_BAR;
    } else {
        PG8_STAGE(PG8_SB(0, 0), cB, voffB); PG8_STAGE(PG8_SA(0, 0), cA, voffA); PG8_STAGE(PG8_SB(0, 1), cB + hstepB, voffB); PG8_STAGE(PG8_SA(0, 1), cA + hstepA, voffA);
        if (wr == 1) PG8_BAR;
        PG8_WAIT_V(4); PG8_BAR;
        PG8_STAGE(PG8_SB(1, 0), cB + kstep, voffB); PG8_STAGE(PG8_SA(1, 0), cA + kstep, voffA); PG8_STAGE(PG8_SB(1, 1), cB + hstepB + kstep, voffB);
        PG8_WAIT_V(6); PG8_BAR;
    }
    for (;;) {
        const bool has_next = S.next(ui + 1, nxt);
        const char* nA = has_next ? (const char*)g.A + (size_t)nxt.pm * tstepA : cA; const char* nB = has_next ? (const char*)g.Bt + (size_t)nxt.pb * tstepB : cB;
        for (int t = 0; t < nt; t += 2) {
            const bool last = (t == nt - 2);
            const char* a1 = cA + (size_t)(t + 1) * kstep;
            const char* a2 = last ? nA : cA + (size_t)(t + 2) * kstep; const char* b2 = last ? nB : cB + (size_t)(t + 2) * kstep;
            const char* a3 = a2 + kstep; const char* b3 = b2 + kstep;
            if (last && has_next) S.a_ready(nxt);
            if constexpr (SP2) {
            PG8_LDB(B0, 0, 0); PG8_LDB(B1, 0, 1); PG8_SCHED; PG8_LDA(At, 0, 0); PG8_STAGE(PG8_SA(1, 1), a1 + hstepA, voffA);
            if constexpr (F8 && !FW) PG8_WAIT_V(6); else PG8_WAIT_V(8); PG8_WAIT_L(0); PG8_BAR; PG8_MMA(0, 0, At, B0); PG8_MMA(0, 1, At, B1); PG8_BAR; PG8_SCHED;
            PG8_LDA(At, 0, 1); PG8_STAGE(PG8_SB(0, 0), b2, voffB); if constexpr (!F8 || FW) PG8_STAGE(PG8_SB(0, 1), b2 + hstepB, voffB); PG8_STAGE(PG8_SA(0, 0), a2, voffA);
            if constexpr (F8 && !FW) PG8_WAIT_V(6); else PG8_WAIT_V(8); PG8_WAIT_L(0); PG8_BAR; PG8_MMA(1, 0, At, B0); PG8_MMA(1, 1, At, B1); PG8_BAR; PG8_SCHED;
            PG8_LDB(B0, 1, 0); PG8_LDB(B1, 1, 1); PG8_SCHED; PG8_LDA(At, 1, 0); PG8_STAGE(PG8_SA(0, 1), a2 + hstepA, voffA);
            if constexpr (F8 && !FW) PG8_WAIT_V(6); else PG8_WAIT_V(8); PG8_WAIT_L(0); PG8_BAR; PG8_MMA(0, 0, At, B0); PG8_MMA(0, 1, At, B1); PG8_BAR; PG8_SCHED;
            PG8_LDA(At, 1, 1); PG8_STAGE(PG8_SB(1, 0), b3, voffB); if constexpr (!F8 || FW) PG8_STAGE(PG8_SB(1, 1), b3 + hstepB, voffB); PG8_STAGE(PG8_SA(1, 0), a3, voffA);
            if constexpr (F8 && !FW) PG8_WAIT_V(6); else PG8_WAIT_V(8); PG8_WAIT_L(0); PG8_BAR; PG8_MMA(1, 0, At, B0); PG8_MMA(1, 1, At, B1); PG8_BAR; PG8_SCHED;
            } else {
            PG8_LDB(B0, 0, 0); PG8_SCHED; PG8_LDA(At, 0, 0); PG8_STAGE(PG8_SA(1, 1), a1 + hstepA, voffA);
            PG8_WAIT_L(8); PG8_BAR; PG8_WAIT_L(0); PG8_MMA(0, 0, At, B0); PG8_BAR; PG8_SCHED;
            PG8_LDB(B1, 0, 1); PG8_STAGE(PG8_SB(0, 0), b2, voffB);
            PG8_BAR; PG8_WAIT_L(0); PG8_MMA(0, 1, At, B1); PG8_BAR;
            PG8_LDA(At, 0, 1); PG8_STAGE(PG8_SA(0, 0), a2, voffA);
            PG8_BAR; PG8_WAIT_L(0); PG8_MMA(1, 0, At, B0); PG8_BAR; PG8_SCHED;
            PG8_STAGE(PG8_SB(0, 1), b2 + hstepB, voffB);
            PG8_WAIT_V(6); PG8_BAR; PG8_MMA(1, 1, At, B1); PG8_BAR;
            PG8_LDB(B0, 1, 0); PG8_SCHED; PG8_LDA(At, 1, 0); PG8_STAGE(PG8_SA(0, 1), a2 + hstepA, voffA);
            PG8_WAIT_L(8); PG8_BAR; PG8_WAIT_L(0); PG8_MMA(0, 0, At, B0); PG8_BAR; PG8_SCHED;
            PG8_LDB(B1, 1, 1); PG8_STAGE(PG8_SB(1, 0), b3, voffB);
            PG8_BAR; PG8_WAIT_L(0); PG8_MMA(0, 1, At, B1); PG8_BAR;
            PG8_LDA(At, 1, 1); PG8_STAGE(PG8_SA(1, 0), a3, voffA);
            PG8_BAR; PG8_WAIT_L(0); PG8_MMA(1, 0, At, B0); PG8_BAR; PG8_SCHED;
            PG8_STAGE(PG8_SB(1, 1), b3 + hstepB, voffB);
            PG8_WAIT_V(6); PG8_BAR; PG8_MMA(1, 1, At, B1); PG8_BAR;
            }
        }
        if constexpr (ALIGN_EPI) { if (wr == 0) PG8_BAR; }
        if constexpr (F8 && FW) asm volatile("s_nop 15\n\ts_nop 15" ::: "memory");
        if constexpr (!Epi::AFTER_DRAIN) { E(acc, cur, wr, wc, fr, fq); S.done(cur); }
        if (!has_next) break;
#pragma unroll
        for (int a = 0; a < 2; ++a)
#pragma unroll
            for (int b = 0; b < 2; ++b)
#pragma unroll
                for (int m = 0; m < 4; ++m)
#pragma unroll
                    for (int n = 0; n < 2; ++n) acc[a][b][m][n] = (f32x4){0.f, 0.f, 0.f, 0.f};
        cur = nxt; cA = nA; cB = nB; ++ui;
        if constexpr (ALIGN_EPI) { if (wr == 1) PG8_BAR; }
    }
    PG8_WAIT_V(0);
    if constexpr (!ALIGN_EPI) { if (wr == 0) PG8_BAR; }
    PG8_BAR;
    if constexpr (Epi::AFTER_DRAIN) { E.fused(acc, cur, wr, wc, fr, fq, lds, wid, lane); S.done(cur); }
#undef PG8_SA
#undef PG8_SB
#undef PG8_STAGE
#undef PG8_CAT
#undef PG8_LDA
#undef PG8_LDB
#undef PG8_MMA
#undef PG8_WAIT_V
#undef PG8_WAIT_L
#undef PG8_BAR
#undef PG8_SCHED
}

}

namespace fa {
#define FA_LAS __attribute__((address_space(3)))
typedef unsigned short bf16;
typedef short bf16x8 __attribute__((ext_vector_type(8)));
typedef short s16x4 __attribute__((ext_vector_type(4)));
typedef float f32x16 __attribute__((ext_vector_type(16)));
typedef float f32x4 __attribute__((ext_vector_type(4)));
typedef unsigned u32x4 __attribute__((ext_vector_type(4)));
constexpr int QB = 256, QBLK = 32, KVBLK = 64;
constexpr int SHM_K = 16384, SHM_V = 16384, SHM_K2 = 8192;
constexpr int OFF_V = 0, OFF_K = 2 * SHM_V, OFF_K2 = OFF_K + 2 * SHM_K, OFF_WS = OFF_K2 + 2 * SHM_K2, WS_PER_WAVE = 1024, OFF_TAB = OFF_WS + 8 * WS_PER_WAVE;
constexpr int TAB_PAD = 320, TAB_MAX = 4096 + TAB_PAD;
constexpr int LDS_END = OFF_TAB + TAB_MAX * 4;
constexpr int OSTG = 272;
static_assert(LDS_END <= 131072 && 8 * 32 * OSTG <= OFF_WS, "attention LDS map");
#define KSWZ(row, colB) ((row) * 256 + ((colB) ^ (((row) & 7) << 4)))
#define K2SWZ(row, colB) ((row) * 128 + ((colB) ^ (((row) & 7) << 4)))
#define SBAR() __builtin_amdgcn_sched_barrier(0)
__device__ __forceinline__ int v_st(int k, int c) { const int kk = (k & ~0xC) | ((k & 4) << 1) | ((k & 8) >> 1); return ((kk >> 3) * 4 + (c >> 5)) * 512 + ((kk & 7) * 32 + (c & 31)) * 2; }
__device__ __forceinline__ int v_rd_base(int lane) { return ((lane & 3) << 3) | (((lane >> 2) & 3) << 6) | (((lane >> 4) & 1) << 5) | (((lane >> 5) & 1) << 8); }
constexpr int v_rd_off(int d0, int ks, int half) { return d0 * 512 + ks * 4096 + half * 2048; }
__device__ __forceinline__ int crow(int r, int hi) { return (r & 3) + 8 * (r >> 2) + 4 * hi; }
typedef float f32x2c __attribute__((ext_vector_type(2)));
typedef __bf16 bf16x2c __attribute__((ext_vector_type(2)));
__device__ __forceinline__ unsigned cvtpk(float lo, float hi) { const f32x2c v = {lo, hi}; return __builtin_bit_cast(unsigned, __builtin_convertvector(v, bf16x2c)); }

struct Item {
    const bf16* Q; long qs;
    const float* rope; long ropes;
    const bf16* K; long ks; const bf16* K2; long k2s; const bf16* V; long vs;
    int P0, skv, W;
    const float* bias; int bstep;
    const unsigned long long* sel; long sels;
    bf16* O; long os;
    float* LSE; long lses;
    const bf16* M0; const bf16* M1; long ms; const bf16* G; long gs;
};

template <int VAR>
__device__ __forceinline__ void attn_block(const Item& it, unsigned char* lds_g) {
    constexpr bool HAS_BIAS = VAR != 2, HAS_SEL = VAR == 1, HAS_K2 = VAR == 2;
    constexpr float SCALE = HAS_K2 ? 0.07216878364870322f : 0.08838834764831845f, C2 = 1.4426950408889634f * SCALE, THR = 8.f;
    FA_LAS unsigned char* L = (FA_LAS unsigned char*)lds_g;
    const int tid = threadIdx.x, wid = __builtin_amdgcn_readfirstlane(tid >> 6), lane = tid & 63, r32 = lane & 31, hi = lane >> 5;
    const int W = it.W;
    const int j_lo = (it.P0 - W + 1 > 0) ? (it.P0 - W + 1) / KVBLK : 0;
    int j_hi = (it.P0 + QB - 1) / KVBLK + 1; if (j_hi > it.skv / KVBLK) j_hi = it.skv / KVBLK;
    const int NT = j_hi - j_lo;
    const int qlo = it.P0 + wid * QBLK, qm = qlo + r32 - 4 * hi;
    FA_LAS float* wsl = (FA_LAS float*)(L + OFF_WS + wid * WS_PER_WAVE); FA_LAS float* li_l = wsl; FA_LAS float* al_l = wsl + 32;
    FA_LAS float* tab = (FA_LAS float*)(L + OFF_TAB);
    const int sr = tid >> 4, sc = (tid & 15) * 8, vst0 = v_st(sr, sc), vst1 = v_st(32 + sr, sc), kws = KSWZ(sr, sc * 2);
    const int k2r = tid >> 3, k2c = (tid & 7) * 8, k2ws = K2SWZ(k2r, k2c * 2);
    const int vb0 = OFF_V + v_rd_base(lane);
    bf16x8 qr[8]; bf16x8 qr2[4];
    { const bf16* qp = it.Q + (long)(qlo + r32) * it.qs + hi * 8;
#pragma unroll
      for (int d0 = 0; d0 < 8; ++d0) qr[d0] = *(const bf16x8*)(qp + d0 * 16);
      if constexpr (HAS_K2) {
          const float* rp = it.rope + (long)(qlo + r32) * it.ropes + hi * 8;
          bf16x8 raw[4];
#pragma unroll
          for (int d0 = 0; d0 < 4; ++d0) raw[d0] = *(const bf16x8*)(qp + 128 + d0 * 16);
#pragma unroll
          for (int d0 = 0; d0 < 2; ++d0) { const f32x4 c0 = *(const f32x4*)(rp + d0 * 16), c1 = *(const f32x4*)(rp + d0 * 16 + 4), s0 = *(const f32x4*)(rp + 32 + d0 * 16), s1 = *(const f32x4*)(rp + 32 + d0 * 16 + 4);
              float o1[8], o2[8];
#pragma unroll
              for (int j = 0; j < 8; ++j) { const float x1 = __builtin_bit_cast(float, (unsigned)(unsigned short)raw[d0][j] << 16), x2 = __builtin_bit_cast(float, (unsigned)(unsigned short)raw[d0 + 2][j] << 16);
                  const float cs = j < 4 ? c0[j & 3] : c1[j & 3], sn = j < 4 ? s0[j & 3] : s1[j & 3]; o1[j] = x1 * cs - x2 * sn; o2[j] = x2 * cs + x1 * sn; }
              u32x4 w1 = {cvtpk(o1[0], o1[1]), cvtpk(o1[2], o1[3]), cvtpk(o1[4], o1[5]), cvtpk(o1[6], o1[7])}, w2 = {cvtpk(o2[0], o2[1]), cvtpk(o2[2], o2[3]), cvtpk(o2[4], o2[5]), cvtpk(o2[6], o2[7])};
              qr2[d0] = __builtin_bit_cast(bf16x8, w1); qr2[d0 + 2] = __builtin_bit_cast(bf16x8, w2); }
      }
    }
    unsigned long long selm = ~0ull;
    if constexpr (HAS_SEL) selm = __hip_atomic_load(it.sel + (long)(qlo + r32) * it.sels, __ATOMIC_RELAXED, __HIP_MEMORY_SCOPE_AGENT);
    if constexpr (HAS_BIAS) {
        int rmax = W + 320; if (rmax > 4096) rmax = 4096;
        for (int i = tid; i < rmax + TAB_PAD; i += 512) { int r = i - TAB_PAD; r = r < -64 ? -64 : r; long gi = (long)r * it.bstep; gi = gi > 4095 ? 4095 : gi; tab[i] = it.bias[gi] * (1.0f / SCALE); }
    }
    bf16x8 st_k0, st_k1, st_v0, st_v1, st_k2;
#define FA_LOAD(kb_) do { const long r0_ = (long)((kb_) + sr), r1_ = r0_ + 32; \
        st_v0 = *(const bf16x8*)(it.V + r0_ * it.vs + sc); st_v1 = *(const bf16x8*)(it.V + r1_ * it.vs + sc); \
        st_k0 = *(const bf16x8*)(it.K + r0_ * it.ks + sc); st_k1 = *(const bf16x8*)(it.K + r1_ * it.ks + sc); \
        if constexpr (HAS_K2) st_k2 = *(const bf16x8*)(it.K2 + (long)((kb_) + k2r) * it.k2s + k2c); } while (0)
#define FA_WRITE(bf_) do { *(FA_LAS bf16x8*)(L + OFF_V + (bf_) * SHM_V + vst0) = st_v0; *(FA_LAS bf16x8*)(L + OFF_V + (bf_) * SHM_V + vst1) = st_v1; \
        *(FA_LAS bf16x8*)(L + OFF_K + (bf_) * SHM_K + kws) = st_k0; *(FA_LAS bf16x8*)(L + OFF_K + (bf_) * SHM_K + kws + 32 * 256) = st_k1; \
        if constexpr (HAS_K2) *(FA_LAS bf16x8*)(L + OFF_K2 + (bf_) * SHM_K2 + k2ws) = st_k2; } while (0)
    FA_LOAD(j_lo * KVBLK);
    asm volatile("s_waitcnt vmcnt(0)" ::: "memory");
    FA_WRITE(0);
    __syncthreads();
    float m_reg = -1e30f, l_reg = 0.f; f32x16 o[4] = {};
#define FA_KBASE(t) ((j_lo + (t)) * KVBLK)
#define FA_STEP(BUF, t) do { \
        const int kb_ = FA_KBASE(t); \
        if ((t) + 1 < NT) FA_LOAD(FA_KBASE((t) + 1)); \
        bool act_ = (kb_ <= qlo + QBLK - 1) && (kb_ + KVBLK - 1 >= qlo - W + 1); \
        bool allow_ = true; \
        if constexpr (HAS_SEL) { allow_ = (bool)((selm >> (kb_ >> 6)) & 1ull); } \
        if (act_) { \
            f32x16 p0 = {}, p1 = {}; \
            { const int ka_ = OFF_K + (BUF) * SHM_K; \
              _Pragma("unroll") for (int d0 = 0; d0 < 8; ++d0) { \
                const bf16x8 b0 = *(const FA_LAS bf16x8*)(L + ka_ + KSWZ(r32, (d0 * 16 + hi * 8) * 2)); \
                const bf16x8 b1 = *(const FA_LAS bf16x8*)(L + ka_ + 32 * 256 + KSWZ(r32, (d0 * 16 + hi * 8) * 2)); \
                p0 = __builtin_amdgcn_mfma_f32_32x32x16_bf16(b0, qr[d0], p0, 0, 0, 0); p1 = __builtin_amdgcn_mfma_f32_32x32x16_bf16(b1, qr[d0], p1, 0, 0, 0); } \
              if constexpr (HAS_K2) { const int k2a_ = OFF_K2 + (BUF) * SHM_K2; \
                _Pragma("unroll") for (int d0 = 0; d0 < 4; ++d0) { \
                  const bf16x8 b0 = *(const FA_LAS bf16x8*)(L + k2a_ + K2SWZ(r32, (d0 * 16 + hi * 8) * 2)); \
                  const bf16x8 b1 = *(const FA_LAS bf16x8*)(L + k2a_ + 32 * 128 + K2SWZ(r32, (d0 * 16 + hi * 8) * 2)); \
                  p0 = __builtin_amdgcn_mfma_f32_32x32x16_bf16(b0, qr2[d0], p0, 0, 0, 0); p1 = __builtin_amdgcn_mfma_f32_32x32x16_bf16(b1, qr2[d0], p1, 0, 0, 0); } } } \
            const int dq_ = qm - kb_; \
            if constexpr (HAS_BIAS) { const FA_LAS float* tb_ = tab + (TAB_PAD + dq_ - 63); \
                _Pragma("unroll") for (int r = 0; r < 16; ++r) { const int c_ = (r & 3) + 8 * (r >> 2); p0[r] += tb_[63 - c_]; p1[r] += tb_[31 - c_]; } } \
            if (HAS_SEL || kb_ + KVBLK - 1 > qlo || kb_ <= qlo + QBLK - 1 - W) { const float NEG_ = -__builtin_inff(); const int dqm_ = allow_ ? dq_ : -0x40000000; \
                _Pragma("unroll") for (int r = 0; r < 16; ++r) { const int c_ = (r & 3) + 8 * (r >> 2); \
                    if ((unsigned)(dqm_ - c_) >= (unsigned)W) p0[r] = NEG_; if ((unsigned)(dqm_ - c_ - 32) >= (unsigned)W) p1[r] = NEG_; } } \
              \
            float pmax_ = p0[0]; _Pragma("unroll") for (int r = 1; r < 16; ++r) pmax_ = fmaxf(pmax_, p0[r]); _Pragma("unroll") for (int r = 0; r < 16; ++r) pmax_ = fmaxf(pmax_, p1[r]); \
            { auto rr_ = __builtin_amdgcn_permlane32_swap(__float_as_uint(pmax_), __float_as_uint(pmax_), false, false); pmax_ = fmaxf(__uint_as_float(rr_[0]), __uint_as_float(rr_[1])); } \
            float mn_, alpha_; \
            if (__all((pmax_ - m_reg) * SCALE <= THR)) { mn_ = m_reg; alpha_ = 1.f; } \
            else { mn_ = fmaxf(m_reg, pmax_); alpha_ = __builtin_amdgcn_exp2f((m_reg - mn_) * C2); m_reg = mn_; } \
            const float mnL_ = -mn_ * C2; float ps_ = 0.f; \
            _Pragma("unroll") for (int r = 0; r < 16; ++r) { p0[r] = __builtin_amdgcn_exp2f(fmaf(p0[r], C2, mnL_)); p1[r] = __builtin_amdgcn_exp2f(fmaf(p1[r], C2, mnL_)); ps_ += p0[r] + p1[r]; } \
            { auto rr_ = __builtin_amdgcn_permlane32_swap(__float_as_uint(ps_), __float_as_uint(ps_), false, false); ps_ = __uint_as_float(rr_[0]) + __uint_as_float(rr_[1]); } \
            l_reg = l_reg * alpha_ + ps_; \
            bf16x8 pa0, pa1, pa2, pa3; \
            FA_PK4(p0, 0, pa0); FA_PK4(p0, 8, pa1); FA_PK4(p1, 0, pa2); FA_PK4(p1, 8, pa3); \
            if (__any(alpha_ < 1.f)) { if (hi == 0) al_l[r32] = alpha_; asm volatile("s_waitcnt lgkmcnt(0)" ::: "memory"); \
                _Pragma("unroll") for (int d_ = 0; d_ < 4; ++d_) _Pragma("unroll") for (int r = 0; r < 16; ++r) o[d_][r] *= al_l[crow(r, hi)]; } \
            FA_PV_D0(BUF, 0); FA_PV_D0(BUF, 1); FA_PV_D0(BUF, 2); FA_PV_D0(BUF, 3); \
        } \
        if ((t) + 1 < NT) { asm volatile("s_waitcnt vmcnt(0)" ::: "memory"); FA_WRITE(1 - (BUF)); } \
        __syncthreads(); } while (0)
#define FA_PK4(P, B_, OUT) do { unsigned a0 = cvtpk(P[B_+0], P[B_+1]), a1 = cvtpk(P[B_+2], P[B_+3]); unsigned b0 = cvtpk(P[B_+4], P[B_+5]), b1 = cvtpk(P[B_+6], P[B_+7]); \
        auto r0 = __builtin_amdgcn_permlane32_swap(a0, b0, false, false); auto r1 = __builtin_amdgcn_permlane32_swap(a1, b1, false, false); \
        u32x4 w = {r0[0], r1[0], r0[1], r1[1]}; OUT = __builtin_bit_cast(bf16x8, w); } while (0)
#define FA_TRRD(dst, off) asm volatile("ds_read_b64_tr_b16 %0, %1 offset:%2" : "=&v"(dst) : "v"(vb0), "i"(off) : "memory")
#define FA_PV_D0(VB, d0) do { s16x4 l0, l1, l2, l3, h0, h1, h2, h3; constexpr int b_ = (VB) * SHM_V + v_rd_off(d0, 0, 0); \
        FA_TRRD(l0, b_); FA_TRRD(h0, b_ + 2048); FA_TRRD(l1, b_ + 4096); FA_TRRD(h1, b_ + 6144); FA_TRRD(l2, b_ + 8192); FA_TRRD(h2, b_ + 10240); FA_TRRD(l3, b_ + 12288); FA_TRRD(h3, b_ + 14336); \
        asm volatile("s_waitcnt lgkmcnt(0)" ::: "memory"); SBAR(); \
        o[d0] = __builtin_amdgcn_mfma_f32_32x32x16_bf16(pa0, (bf16x8){l0[0], l0[1], l0[2], l0[3], h0[0], h0[1], h0[2], h0[3]}, o[d0], 0, 0, 0); \
        o[d0] = __builtin_amdgcn_mfma_f32_32x32x16_bf16(pa1, (bf16x8){l1[0], l1[1], l1[2], l1[3], h1[0], h1[1], h1[2], h1[3]}, o[d0], 0, 0, 0); \
        o[d0] = __builtin_amdgcn_mfma_f32_32x32x16_bf16(pa2, (bf16x8){l2[0], l2[1], l2[2], l2[3], h2[0], h2[1], h2[2], h2[3]}, o[d0], 0, 0, 0); \
        o[d0] = __builtin_amdgcn_mfma_f32_32x32x16_bf16(pa3, (bf16x8){l3[0], l3[1], l3[2], l3[3], h3[0], h3[1], h3[2], h3[3]}, o[d0], 0, 0, 0); } while (0)
    for (int t = 0; t < NT; t += 2) { FA_STEP(0, t); if (t + 1 < NT) FA_STEP(1, t + 1); }
    li_l[r32] = l_reg;
    if constexpr (VAR == 1) { const bf16* gp = it.G + (long)(qlo + r32) * it.gs;
#pragma unroll
        for (int k = 0; k < 3; ++k) { const float gl = __builtin_bit_cast(float, (unsigned)gp[k] << 16); wsl[64 + 32 * k + r32] = 1.0f / (1.0f + __expf(-gl)); } }
    asm volatile("s_waitcnt lgkmcnt(0)" ::: "memory");
    if (it.LSE && hi == 0) it.LSE[(long)(qlo + r32) * it.lses] = m_reg * SCALE + __logf(l_reg);
    FA_LAS unsigned char* stg = L + wid * (32 * OSTG);
#pragma unroll
    for (int r = 0; r < 16; ++r) { const int orow = crow(r, hi); const float lv_ = li_l[orow]; float rl = lv_ > 0.f ? __builtin_amdgcn_rcpf(lv_) : 0.f; if constexpr (VAR == 1) rl *= wsl[64 + 32 + orow];
#pragma unroll
        for (int d0 = 0; d0 < 4; ++d0) { const float v = o[d0][r] * rl; const unsigned u = __builtin_bit_cast(unsigned, v); *(FA_LAS unsigned short*)(stg + orow * OSTG + (d0 * 32 + r32) * 2) = (unsigned short)((u + 0x7fffu + ((u >> 16) & 1u)) >> 16); } }
    asm volatile("s_waitcnt lgkmcnt(0)" ::: "memory");
#pragma unroll
    for (int i = 0; i < 8; ++i) { const int id = lane + 64 * i, row = id >> 4, ch = id & 15; const long qi = (long)(qlo + row);
        u32x4 w = *(const FA_LAS u32x4*)(stg + row * OSTG + ch * 16);
        if constexpr (VAR == 1) { const float g0 = wsl[64 + row], g2 = wsl[64 + 64 + row];
            const u32x4 a = *(const u32x4*)(it.M0 + qi * it.ms + ch * 8), c = *(const u32x4*)(it.M1 + qi * it.ms + ch * 8);
#pragma unroll
            for (int k = 0; k < 4; ++k) { const float lo = __builtin_bit_cast(float, w[k] << 16) + g0 * __builtin_bit_cast(float, a[k] << 16) + g2 * __builtin_bit_cast(float, c[k] << 16);
                const float hi_ = __builtin_bit_cast(float, w[k] & 0xffff0000u) + g0 * __builtin_bit_cast(float, a[k] & 0xffff0000u) + g2 * __builtin_bit_cast(float, c[k] & 0xffff0000u); w[k] = cvtpk(lo, hi_); } }
        *(u32x4*)(it.O + qi * it.os + ch * 8) = w; }
    __syncthreads();
#undef FA_LOAD
#undef FA_WRITE
#undef FA_KBASE
#undef FA_STEP
#undef FA_PK4
#undef FA_TRRD
#undef FA_PV_D0
}

struct CmpItem { const bf16* Q; long qs; const bf16* K; const bf16* V; const float* bias; int bld; int s0; bf16* O; long os; unsigned long long* sel; };
__device__ __forceinline__ void cmp_block(const CmpItem& it, unsigned char* lds_g, int imps_off) {
    constexpr float SCALE = 0.08838834764831845f, C2 = 1.4426950408889634f * SCALE;
    constexpr int OFF_TABC = 65536;
    FA_LAS unsigned char* L = (FA_LAS unsigned char*)lds_g;
    const int tid = threadIdx.x, wid = __builtin_amdgcn_readfirstlane(tid >> 6), lane = tid & 63, r32 = lane & 31, hi = lane >> 5;
    FA_LAS float* tabc = (FA_LAS float*)(L + OFF_TABC); FA_LAS float* imps = (FA_LAS float*)(L + imps_off);
    const int tokl = wid * 8 + (r32 >> 2), rh = r32 & 3, s = it.s0 + tokl;
    const int nvis = (it.s0 + 63 - 31) / 16 + 1 > 255 ? 255 : (it.s0 + 63 - 31) / 16 + 1;
    const int NT = (nvis + 63) / 64;
    const int nlim = (s - 31) >> 4;
    const int sr = tid >> 4, sc = (tid & 15) * 8, vst0 = v_st(sr, sc), vst1 = v_st(32 + sr, sc), kws = KSWZ(sr, sc * 2);
    const int vb0 = OFF_V + v_rd_base(lane);
    bf16x8 qr[8];
    { const bf16* qp = it.Q + (long)tokl * it.qs + rh * 128 + hi * 8;
#pragma unroll
      for (int d0 = 0; d0 < 8; ++d0) qr[d0] = *(const bf16x8*)(qp + d0 * 16); }
    for (int i = tid; i < 4 * 4096; i += 512) tabc[i] = it.bias[(long)(i >> 12) * it.bld + (i & 4095)] * (1.0f / SCALE);
    for (int i = tid; i < 64 * 64; i += 512) imps[i] = 0.f;
    bf16x8 st_k0, st_k1, st_v0, st_v1;
#define CM_LOADK(kb_) do { st_k0 = *(const bf16x8*)(it.K + (long)((kb_) + sr) * 128 + sc); st_k1 = *(const bf16x8*)(it.K + (long)((kb_) + 32 + sr) * 128 + sc); } while (0)
#define CM_LOADV(kb_) do { st_v0 = *(const bf16x8*)(it.V + (long)((kb_) + sr) * 128 + sc); st_v1 = *(const bf16x8*)(it.V + (long)((kb_) + 32 + sr) * 128 + sc); } while (0)
#define CM_WRITEK(bf_) do { *(FA_LAS bf16x8*)(L + OFF_K + (bf_) * SHM_K + kws) = st_k0; *(FA_LAS bf16x8*)(L + OFF_K + (bf_) * SHM_K + kws + 32 * 256) = st_k1; } while (0)
#define CM_WRITEV(bf_) do { *(FA_LAS bf16x8*)(L + OFF_V + (bf_) * SHM_V + vst0) = st_v0; *(FA_LAS bf16x8*)(L + OFF_V + (bf_) * SHM_V + vst1) = st_v1; } while (0)
#define CM_SCORES(BUF, kb_) \
        f32x16 p0 = {}, p1 = {}; \
        { const int ka_ = OFF_K + (BUF) * SHM_K; \
          _Pragma("unroll") for (int d0 = 0; d0 < 8; ++d0) { \
            const bf16x8 b0 = *(const FA_LAS bf16x8*)(L + ka_ + KSWZ(r32, (d0 * 16 + hi * 8) * 2)); \
            const bf16x8 b1 = *(const FA_LAS bf16x8*)(L + ka_ + 32 * 256 + KSWZ(r32, (d0 * 16 + hi * 8) * 2)); \
            p0 = __builtin_amdgcn_mfma_f32_32x32x16_bf16(b0, qr[d0], p0, 0, 0, 0); p1 = __builtin_amdgcn_mfma_f32_32x32x16_bf16(b1, qr[d0], p1, 0, 0, 0); } } \
        { const int nb_ = (kb_) + 4 * hi, relb_ = s - 31 - 16 * nb_; const float NEG_ = -__builtin_inff(); \
          _Pragma("unroll") for (int r = 0; r < 16; ++r) { const int c_ = (r & 3) + 8 * (r >> 2); \
            { const int rel_ = relb_ - 16 * c_; const int ix_ = rel_ < 0 ? 0 : rel_; const float bv_ = tabc[rh * 4096 + ix_]; p0[r] = (nb_ + c_ <= nlim) ? p0[r] + bv_ : NEG_; } \
            { const int rel_ = relb_ - 16 * (c_ + 32); const int ix_ = rel_ < 0 ? 0 : rel_; const float bv_ = tabc[rh * 4096 + ix_]; p1[r] = (nb_ + c_ + 32 <= nlim) ? p1[r] + bv_ : NEG_; } } }
    CM_LOADK(0); asm volatile("s_waitcnt vmcnt(0)" ::: "memory"); CM_WRITEK(0); __syncthreads();
    float m_reg = -1e30f, l_reg = 0.f;
#define CM_P1(BUF, t) do { if ((t) + 1 < NT) CM_LOADK(((t) + 1) * 64); \
        { CM_SCORES(BUF, (t) * 64) \
          float pmax_ = p0[0]; _Pragma("unroll") for (int r = 1; r < 16; ++r) pmax_ = fmaxf(pmax_, p0[r]); _Pragma("unroll") for (int r = 0; r < 16; ++r) pmax_ = fmaxf(pmax_, p1[r]); \
          { auto rr_ = __builtin_amdgcn_permlane32_swap(__float_as_uint(pmax_), __float_as_uint(pmax_), false, false); pmax_ = fmaxf(__uint_as_float(rr_[0]), __uint_as_float(rr_[1])); } \
          const float mn_ = fmaxf(m_reg, pmax_), alpha_ = __builtin_amdgcn_exp2f((m_reg - mn_) * C2), mnL_ = -mn_ * C2; float ps_ = 0.f; \
          _Pragma("unroll") for (int r = 0; r < 16; ++r) ps_ += __builtin_amdgcn_exp2f(fmaf(p0[r], C2, mnL_)) + __builtin_amdgcn_exp2f(fmaf(p1[r], C2, mnL_)); \
          { auto rr_ = __builtin_amdgcn_permlane32_swap(__float_as_uint(ps_), __float_as_uint(ps_), false, false); ps_ = __uint_as_float(rr_[0]) + __uint_as_float(rr_[1]); } \
          l_reg = l_reg * alpha_ + ps_; m_reg = mn_; } \
        if ((t) + 1 < NT) { asm volatile("s_waitcnt vmcnt(0)" ::: "memory"); CM_WRITEK(1 - (BUF)); } \
        __syncthreads(); } while (0)
    for (int t = 0; t < NT; t += 2) { CM_P1(0, t); if (t + 1 < NT) CM_P1(1, t + 1); }
    const float inv_l = l_reg > 0.f ? 1.0f / l_reg : 0.f, mL = -m_reg * C2;
    CM_LOADK(0); CM_LOADV(0); asm volatile("s_waitcnt vmcnt(0)" ::: "memory"); CM_WRITEK(0); CM_WRITEV(0); __syncthreads();
    f32x16 o[4] = {};
#define FA_PK4(P, B_, OUT) do { unsigned a0 = cvtpk(P[B_+0], P[B_+1]), a1 = cvtpk(P[B_+2], P[B_+3]); unsigned b0 = cvtpk(P[B_+4], P[B_+5]), b1 = cvtpk(P[B_+6], P[B_+7]); \
        auto r0 = __builtin_amdgcn_permlane32_swap(a0, b0, false, false); auto r1 = __builtin_amdgcn_permlane32_swap(a1, b1, false, false); \
        u32x4 w = {r0[0], r1[0], r0[1], r1[1]}; OUT = __builtin_bit_cast(bf16x8, w); } while (0)
#define FA_TRRD(dst, off) asm volatile("ds_read_b64_tr_b16 %0, %1 offset:%2" : "=&v"(dst) : "v"(vb0), "i"(off) : "memory")
#define FA_PV_D0(VB, d0) do { s16x4 l0, l1, l2, l3, h0, h1, h2, h3; constexpr int b_ = (VB) * SHM_V + v_rd_off(d0, 0, 0); \
        FA_TRRD(l0, b_); FA_TRRD(h0, b_ + 2048); FA_TRRD(l1, b_ + 4096); FA_TRRD(h1, b_ + 6144); FA_TRRD(l2, b_ + 8192); FA_TRRD(h2, b_ + 10240); FA_TRRD(l3, b_ + 12288); FA_TRRD(h3, b_ + 14336); \
        asm volatile("s_waitcnt lgkmcnt(0)" ::: "memory"); SBAR(); \
        o[d0] = __builtin_amdgcn_mfma_f32_32x32x16_bf16(pa0, (bf16x8){l0[0], l0[1], l0[2], l0[3], h0[0], h0[1], h0[2], h0[3]}, o[d0], 0, 0, 0); \
        o[d0] = __builtin_amdgcn_mfma_f32_32x32x16_bf16(pa1, (bf16x8){l1[0], l1[1], l1[2], l1[3], h1[0], h1[1], h1[2], h1[3]}, o[d0], 0, 0, 0); \
        o[d0] = __builtin_amdgcn_mfma_f32_32x32x16_bf16(pa2, (bf16x8){l2[0], l2[1], l2[2], l2[3], h2[0], h2[1], h2[2], h2[3]}, o[d0], 0, 0, 0); \
        o[d0] = __builtin_amdgcn_mfma_f32_32x32x16_bf16(pa3, (bf16x8){l3[0], l3[1], l3[2], l3[3], h3[0], h3[1], h3[2], h3[3]}, o[d0], 0, 0, 0); } while (0)
#define CM_IMP(P, half_, t) do { _Pragma("unroll") for (int q4 = 0; q4 < 4; ++q4) { \
            float A_ = (2.0f * ((P[4 * q4] + P[4 * q4 + 1]) + P[4 * q4 + 2]) + P[4 * q4 + 3]) * inv_l, B_ = P[4 * q4 + 3] * inv_l; \
            A_ += __shfl_xor(A_, 1); A_ += __shfl_xor(A_, 2); B_ += __shfl_xor(B_, 1); B_ += __shfl_xor(B_, 2); \
            const int j_ = 2 * q4 + hi + 8 * (half_) + 16 * (t); \
            if (rh == 0) { __hip_atomic_fetch_add(&imps[tokl * 64 + j_], A_, __ATOMIC_RELAXED, __HIP_MEMORY_SCOPE_WORKGROUP); \
                if (j_ + 1 < 64) __hip_atomic_fetch_add(&imps[tokl * 64 + j_ + 1], B_, __ATOMIC_RELAXED, __HIP_MEMORY_SCOPE_WORKGROUP); } } } while (0)
#define CM_P2(BUF, t) do { if ((t) + 1 < NT) { CM_LOADK(((t) + 1) * 64); CM_LOADV(((t) + 1) * 64); } \
        { CM_SCORES(BUF, (t) * 64) \
          _Pragma("unroll") for (int r = 0; r < 16; ++r) { p0[r] = __builtin_amdgcn_exp2f(fmaf(p0[r], C2, mL)); p1[r] = __builtin_amdgcn_exp2f(fmaf(p1[r], C2, mL)); } \
          CM_IMP(p0, 0, t); CM_IMP(p1, 1, t); \
          bf16x8 pa0, pa1, pa2, pa3; FA_PK4(p0, 0, pa0); FA_PK4(p0, 8, pa1); FA_PK4(p1, 0, pa2); FA_PK4(p1, 8, pa3); \
          FA_PV_D0(BUF, 0); FA_PV_D0(BUF, 1); FA_PV_D0(BUF, 2); FA_PV_D0(BUF, 3); } \
        if ((t) + 1 < NT) { asm volatile("s_waitcnt vmcnt(0)" ::: "memory"); CM_WRITEK(1 - (BUF)); CM_WRITEV(1 - (BUF)); } \
        __syncthreads(); } while (0)
    for (int t = 0; t < NT; t += 2) { CM_P2(0, t); if (t + 1 < NT) CM_P2(1, t + 1); }
    asm volatile("s_waitcnt lgkmcnt(0)" ::: "memory");
    for (int tk = 0; tk < 8; ++tk) { const int sp = it.s0 + wid * 8 + tk, blk_t = sp >> 6, j = lane;
        const float is = imps[(wid * 8 + tk) * 64 + j];
        const bool forced = (j == 0) || (j == blk_t) || (j == blk_t - 1), valid = j <= blk_t;
        const float scv = forced ? 1e9f : (valid ? is : -1.0f);
        int rank = 0;
        for (int k = 0; k < 64; ++k) { const float vk = __shfl(scv, k); rank += (vk > scv || (vk == scv && k < j)) ? 1 : 0; }
        const unsigned long long msk = __ballot(rank < 16 && scv > -0.5f);
        if (lane == 0) it.sel[(long)(wid * 8 + tk) * 2] = msk; }
    FA_LAS unsigned char* stg = L + wid * (32 * OSTG);
    FA_LAS float* li_c = imps + wid * 512;
    li_c[r32] = inv_l; asm volatile("s_waitcnt lgkmcnt(0)" ::: "memory");
#pragma unroll
    for (int r = 0; r < 16; ++r) { const int orow = crow(r, hi); const float rl = li_c[orow];
#pragma unroll
        for (int d0 = 0; d0 < 4; ++d0) { const unsigned u = __builtin_bit_cast(unsigned, o[d0][r] * rl); *(FA_LAS unsigned short*)(stg + orow * OSTG + (d0 * 32 + r32) * 2) = (unsigned short)((u + 0x7fffu + ((u >> 16) & 1u)) >> 16); } }
    asm volatile("s_waitcnt lgkmcnt(0)" ::: "memory");
#pragma unroll
    for (int i = 0; i < 8; ++i) { const int id = lane + 64 * i, row = id >> 4, ch = id & 15;
        const u32x4 w = *(const FA_LAS u32x4*)(stg + row * OSTG + ch * 16);
        *(u32x4*)(it.O + (long)(wid * 8 + (row >> 2)) * it.os + (row & 3) * 128 + ch * 8) = w; }
    __syncthreads();
#undef CM_LOADK
#undef CM_LOADV
#undef CM_WRITEK
#undef CM_WRITEV
#undef CM_SCORES
#undef CM_P1
#undef CM_P2
#undef CM_IMP
#undef FA_PK4
#undef FA_TRRD
#undef FA_PV_D0
}
}

constexpr int D = 2048, NB = 4, S = 4096, M = NB * S;
constexpr int HD = 128;
constexpr int Z0W = 3840;
constexpr int Z_NQ = 0, Z_NKV = 1024, Z_QLAT = 2560, Z_KVLAT = 3072, Z_KPE = 3584, Z_NG = 3648;
constexpr int QMW = 1536, KVMW = 2048;
constexpr int FF = 5632, FFE = 7168, NE = 8;
constexpr int Z1W = 9216;
constexpr int NSLOT = (2 * M / 256 + NE) * 256;
constexpr float RMS_EPS = 1e-6f;

constexpr size_t MiB = 1u << 20;
constexpr size_t WS_CTL = 0, CTL_ZERO_BYTES = 1 * MiB;
constexpr size_t WS_MOD = 1 * MiB;
constexpr size_t WS_BIAS = 2 * MiB;
constexpr int BIAS_LD = 4096 + 64;
constexpr size_t WS_ROPE = 3 * MiB;
constexpr size_t WS_RINV = 8 * MiB;
constexpr size_t WS_SEL = 9 * MiB;
constexpr size_t WS_KC = 10 * MiB;
constexpr size_t WS_VC = 11 * MiB;
constexpr size_t WS_ROUTE = 12 * MiB;
constexpr size_t WS_LSE = 13 * MiB;
constexpr size_t WS_KPE = 15 * MiB;
constexpr size_t WS_W1T = 17 * MiB, WS_W2T = 19 * MiB, WS_CB1 = 20 * MiB;
constexpr size_t WS_WIN0 = 21 * MiB, WS_WUQ = 36 * MiB, WS_WUKV = 38 * MiB, WS_WOUT0 = 40 * MiB, WS_WGU0 = 48 * MiB, WS_WDN0 = 92 * MiB;
constexpr size_t WS_WIN1 = 114 * MiB, WS_WOUT1 = 150 * MiB, WS_WMGU = 154 * MiB, WS_WMDN = 602 * MiB;
constexpr size_t WS_X = 826 * MiB;
constexpr size_t WS_H = 954 * MiB;
constexpr size_t WS_R = 1018 * MiB;
constexpr size_t WS_Z0 = WS_R, WS_QM = WS_R + 120 * MiB, WS_KVM = WS_R + 168 * MiB, WS_OCMP = WS_R + 232 * MiB, WS_OWIN = WS_R + 264 * MiB, WS_CAT = WS_R + 328 * MiB;
constexpr size_t WS_ACT = WS_R;
constexpr size_t WS_Z1 = WS_R, WS_OP = WS_R + 288 * MiB, WS_OM = WS_R + 384 * MiB;
constexpr size_t WS_XB = WS_R, WS_ACTB = WS_R + 136 * MiB, WS_YB = WS_R;
constexpr size_t WS_END = WS_R + 612 * MiB;
static_assert(WS_Z0 + (size_t)M * Z0W * 2 <= WS_QM && WS_QM + (size_t)M * QMW * 2 <= WS_KVM && WS_KVM + (size_t)M * KVMW * 2 <= WS_OCMP && WS_CAT + (size_t)M * 2048 * 2 <= WS_END, "L0 map");
static_assert(WS_Z1 + (size_t)M * Z1W * 2 <= WS_OM && WS_XB + (size_t)NSLOT * D * 2 <= WS_ACTB && WS_ACTB + (size_t)NSLOT * FFE * 2 <= WS_END, "L1 map");
static_assert(WS_WMDN + (size_t)NE * D * FFE * 2 <= WS_X && WS_WMGU + (size_t)NE * 2 * FFE * D * 2 <= WS_WMDN, "weights map");
constexpr int CW_BAR = 4096;
constexpr int CW_CNT = 64;
constexpr int CW_TS = 128;
constexpr int CW_Q = 8192;

constexpr int RING_BYTES = 131072;
constexpr int SMALL_OFF = RING_BYTES;
constexpr int LDSCTL_OFF = RING_BYTES + 16384, MISC_OFF = LDSCTL_OFF;
constexpr int LDS_BYTES = LDSCTL_OFF + 256;
constexpr int NWAVES = 8;

#define GAS __attribute__((address_space(1)))
#define LAS __attribute__((address_space(3)))
typedef unsigned short bf16;
typedef unsigned v4u __attribute__((ext_vector_type(4)));
typedef unsigned v2u __attribute__((ext_vector_type(2)));
typedef float f32x4 __attribute__((ext_vector_type(4)));
typedef float f32x2 __attribute__((ext_vector_type(2)));
#define LDS_WAIT() asm volatile("s_waitcnt lgkmcnt(0)" ::: "memory")
__device__ __forceinline__ unsigned f2bf(float f) { unsigned u = __builtin_bit_cast(unsigned, f); return (u + 0x7fffu + ((u >> 16) & 1u)) >> 16; }
__device__ __forceinline__ unsigned pk2(float lo, float hi) { return f2bf(lo) | (f2bf(hi) << 16); }
__device__ __forceinline__ float bf2f(unsigned short b) { return __builtin_bit_cast(float, (unsigned)b << 16); }
__device__ __forceinline__ float bflo(unsigned w) { return __builtin_bit_cast(float, w << 16); }
__device__ __forceinline__ float bfhi(unsigned w) { return __builtin_bit_cast(float, w & 0xffff0000u); }
__device__ __forceinline__ float wave_sum(float v) {
#pragma unroll
    for (int o = 1; o < 64; o <<= 1) v += __shfl_xor(v, o);
    return v;
}
__device__ __forceinline__ float wave_max(float v) {
#pragma unroll
    for (int o = 1; o < 64; o <<= 1) v = fmaxf(v, __shfl_xor(v, o));
    return v;
}

#define XB_TMO      128
#define XB_XCNT(j)  (256  + 64 * (j))
#define XB_XSUB(j)  (1280 + 64 * (j))
#define XB_XGEN(j)  (2304 + 64 * (j))
#define XB_TOP      3328
#define XB_TOPGEN   3392
#define XCD_BAR_WORDS 3456
#define XB_SPIN_CAP (1u << 22)

__device__ __forceinline__ unsigned xb_ld(unsigned* p)              { return __hip_atomic_load(p, __ATOMIC_RELAXED, __HIP_MEMORY_SCOPE_AGENT); }
__device__ __forceinline__ unsigned xb_add(unsigned* p, unsigned v) { return __hip_atomic_fetch_add(p, v, __ATOMIC_RELAXED, __HIP_MEMORY_SCOPE_AGENT); }
__device__ __forceinline__ unsigned xb_xcc_id() { return (unsigned)__builtin_amdgcn_s_getreg((3 << 11) | 20) & 0xFu; }
#define XB_SPIN(cond, bar) do { unsigned _sp = 0; while (cond) { __builtin_amdgcn_s_sleep(1); \
    if ((++_sp & 255u) == 0u) { if (xb_ld(&(bar)[XB_TMO])) break; if (_sp > XB_SPIN_CAP) { atomicAdd(&(bar)[XB_TMO], 1u); break; } } } } while (0)

struct XcdBarrier {
    unsigned* bar; unsigned x;
    volatile LAS unsigned* st;
};

__device__ __forceinline__ XcdBarrier xcd_barrier_post(unsigned* bar, volatile LAS unsigned* st) {
    XcdBarrier b; b.bar = bar; b.x = xb_xcc_id(); b.st = st;
    if (threadIdx.x == 0) (void)xb_add(&bar[XB_XCNT(b.x)], 1u);
    return b;
}
__device__ __forceinline__ void xcd_barrier_complete(unsigned* bar, unsigned x, unsigned& nloc, unsigned& nx) {
    const unsigned G = gridDim.x * gridDim.y * gridDim.z;
    unsigned sum, cnt, mine, sp = 0u;
    for (;;) {
        sum = 0u; cnt = 0u; mine = 0u;
#pragma unroll
        for (unsigned j = 0; j < 16; ++j) { const unsigned c = xb_ld(&bar[XB_XCNT(j)]); sum += c; cnt += (c > 0u) ? 1u : 0u; mine = (j == x) ? c : mine; }
        if (sum == G) break;
        __builtin_amdgcn_s_sleep(1);
        if ((++sp & 255u) == 0u) { if (xb_ld(&bar[XB_TMO])) break; if (sp > XB_SPIN_CAP) { atomicAdd(&bar[XB_TMO], 1u); break; } }
    }
    nloc = mine > 0u ? mine : 1u; nx = cnt > 0u ? cnt : 1u;
}

__device__ __forceinline__ void xcd_barrier(const XcdBarrier& b) {
    asm volatile("s_waitcnt vmcnt(0)" ::: "memory");
    __syncthreads();
    if (threadIdx.x == 0) {
        unsigned* bar = b.bar;
        __builtin_amdgcn_s_waitcnt(0);
        unsigned nloc = b.st[0], nx = b.st[1];
        if (nloc == 0u) { xcd_barrier_complete(bar, b.x, nloc, nx); b.st[0] = nloc; b.st[1] = nx; }
        const unsigned old = xb_add(&bar[XB_XSUB(b.x)], 1u);
        const unsigned gen = old / nloc;
        if (old + 1u == (gen + 1u) * nloc) {
            __builtin_amdgcn_fence(__ATOMIC_RELEASE, "agent");
            asm volatile("s_waitcnt vmcnt(0)" ::: "memory");
            const unsigned og = xb_add(&bar[XB_TOP], 1u);
            const unsigned tg = og / nx;
            if (og + 1u == (tg + 1u) * nx) xb_add(&bar[XB_TOPGEN], 1u);
            else XB_SPIN(xb_ld(&bar[XB_TOPGEN]) == tg, bar);
            __builtin_amdgcn_fence(__ATOMIC_ACQUIRE, "agent");
            xb_add(&bar[XB_XGEN(b.x)], 1u);
            asm volatile("s_waitcnt vmcnt(0)" ::: "memory");
        } else {
            XB_SPIN(xb_ld(&bar[XB_XGEN(b.x)]) == gen, bar);
            __builtin_amdgcn_fence(__ATOMIC_ACQUIRE, "agent");
            asm volatile("s_waitcnt vmcnt(0)" ::: "memory");
        }
    }
    __syncthreads();
}


struct Args { const void* in[30]; float* out; unsigned char* ws; int ph_lo, ph_hi; };
struct Frame {
    unsigned char* lds;
    int tid, lane, wave, vcu, G, gw, NGW;
    unsigned char* ws;
};

__device__ __forceinline__ int t5_bucket(int n) {
    if (n < 16) return n < 0 ? 0 : n;
    int b = 16;
    b += (n >= 22); b += (n >= 30); b += (n >= 40); b += (n >= 54); b += (n >= 73); b += (n >= 99); b += (n >= 134); b += (n >= 182);
    b += (n >= 246); b += (n >= 332); b += (n >= 450); b += (n >= 609); b += (n >= 825); b += (n >= 1117); b += (n >= 1513);
    return b;
}

__device__ __forceinline__ unsigned pk4_fp8(float a, float b, float c, float d) { int w = 0; w = __builtin_amdgcn_cvt_pk_fp8_f32(a, b, w, false); w = __builtin_amdgcn_cvt_pk_fp8_f32(c, d, w, true); return (unsigned)w; }
template <int MAP, bool OUT8 = false>
__device__ __forceinline__ void p0_transpose_item(const float* W, const float* W2, int K, int Nsrc, int Ndst, bf16* WT, const float* kscale, float* scr, int item, int lane, float oscale = 1.0f) {
    const int nblk = Ndst / 64, kb = item / nblk, nb = item % nblk, k0 = 64 * kb, n0 = 64 * nb;
    const int n4 = (lane & 15) * 4, n = n0 + n4, kr = lane >> 4;
    const float* src = W; int sc = n; bool ok = true;
    if (MAP == 1) { if (n < Z_QLAT) sc = n; else if (n < Z_NG) sc = n + 24; else if (n < Z_NG + 24) sc = n - Z_NG + 2560; else ok = false; }
    if (MAP == 2) { const int g32 = n >> 5, w = n & 31; src = (w < 16) ? W : W2; sc = g32 * 16 + (w & 15); }
    f32x4 v[16];
#pragma unroll
    for (int i = 0; i < 16; ++i) v[i] = ok ? __builtin_nontemporal_load((const f32x4*)(src + (size_t)(k0 + 4 * i + kr) * Nsrc + sc)) : (f32x4){0.f, 0.f, 0.f, 0.f};
#pragma unroll
    for (int i = 0; i < 16; ++i) { const int kk = 4 * i + kr; f32x4 t = v[i]; if (kscale) t = t * kscale[k0 + kk]; float* d = scr + kk * 65 + n4; d[0] = t.x; d[1] = t.y; d[2] = t.z; d[3] = t.w; }
    LDS_WAIT(); asm volatile("" ::: "memory");
    if constexpr (OUT8) {
        const int kg = lane & 3;
#pragma unroll
        for (int p = 0; p < 4; ++p) { const int nn = 16 * p + (lane >> 2); const float* s = scr + (16 * kg) * 65 + nn;
            v4u o; o.x = pk4_fp8(s[0 * 65] * oscale, s[1 * 65] * oscale, s[2 * 65] * oscale, s[3 * 65] * oscale); o.y = pk4_fp8(s[4 * 65] * oscale, s[5 * 65] * oscale, s[6 * 65] * oscale, s[7 * 65] * oscale);
            o.z = pk4_fp8(s[8 * 65] * oscale, s[9 * 65] * oscale, s[10 * 65] * oscale, s[11 * 65] * oscale); o.w = pk4_fp8(s[12 * 65] * oscale, s[13 * 65] * oscale, s[14 * 65] * oscale, s[15 * 65] * oscale);
            *(v4u*)((unsigned char*)WT + (size_t)(n0 + nn) * K + k0 + 16 * kg) = o; }
    } else {
    const int kg = lane & 7;
#pragma unroll
    for (int p = 0; p < 8; ++p) { const int nn = 8 * p + (lane >> 3); const float* s = scr + (8 * kg) * 65 + nn;
        v4u o; o.x = pk2(s[0 * 65], s[1 * 65]); o.y = pk2(s[2 * 65], s[3 * 65]); o.z = pk2(s[4 * 65], s[5 * 65]); o.w = pk2(s[6 * 65], s[7 * 65]);
        *(v4u*)(WT + (size_t)(n0 + nn) * K + k0 + 8 * kg) = o; }
    }
    LDS_WAIT(); asm volatile("" ::: "memory");
}
template <int MAP, bool OUT8 = false>
__device__ __forceinline__ void p0_transpose(Frame& F, const float* W, const float* W2, int K, int Nsrc, int Ndst, bf16* WT, const float* kscale, float oscale = 1.0f) {
    float* scr = (float*)(F.lds + F.wave * 16640);
    const int nitems = (K / 64) * (Ndst / 64);
    for (int it = F.gw; it < nitems; it += F.NGW) p0_transpose_item<MAP, OUT8>(W, W2, K, Nsrc, Ndst, WT, kscale, scr, it, F.lane, oscale);
}

__device__ __forceinline__ void modnorm_row(const float* xrow, const float* g, const float* sc, const float* sh, bf16* orow, int lane, f32x4 (&v)[8]) {
    const f32x4* xr = (const f32x4*)xrow + lane; float s = 0.f;
#pragma unroll
    for (int j = 0; j < 8; ++j) { v[j] = xr[64 * j]; s += (v[j].x * v[j].x + v[j].y * v[j].y) + (v[j].z * v[j].z + v[j].w * v[j].w); }
    const float rinv = 1.0f / sqrtf(wave_sum(s) * (1.f / D) + RMS_EPS);
    unsigned long long* o8 = (unsigned long long*)orow + lane;
#pragma unroll
    for (int j = 0; j < 8; ++j) { const f32x4 gg = ((const f32x4*)g)[lane + 64 * j], cc = ((const f32x4*)sc)[lane + 64 * j], hh = ((const f32x4*)sh)[lane + 64 * j];
        v[j] = (v[j] * rinv) * gg * (cc + 1.0f) + hh;
        o8[64 * j] = (unsigned long long)pk2(v[j].x, v[j].y) | ((unsigned long long)pk2(v[j].z, v[j].w) << 32); }
}
template <bool OUT8 = false>
__device__ __forceinline__ void modnorm_phase(Frame& F, const float* x, const float* g, const float* mod  , int sh_idx, bf16* H, float oscale = 1.0f) {
    for (int b = 0; b < NB; ++b) { const float* mb = mod + (size_t)b * 6 * D; const float* sc = mb + (size_t)(sh_idx + 1) * D; const float* sh = mb + (size_t)sh_idx * D;
        const int s0 = F.gw, s1 = F.gw + F.NGW;
        const f32x4* x0 = (const f32x4*)(x + ((size_t)b * S + s0) * D) + F.lane; const f32x4* x1 = (const f32x4*)(x + ((size_t)b * S + s1) * D) + F.lane;
        f32x4 v0[8], v1[8], ca[8];
#pragma unroll
        for (int j = 0; j < 8; ++j) { v0[j] = x0[64 * j]; v1[j] = x1[64 * j]; }
#pragma unroll
        for (int j = 0; j < 8; ++j) { ca[j] = ((const f32x4*)g)[F.lane + 64 * j] * (((const f32x4*)sc)[F.lane + 64 * j] + 1.0f); }
        float q0 = 0.f, q1 = 0.f;
#pragma unroll
        for (int j = 0; j < 8; ++j) { q0 += (v0[j].x * v0[j].x + v0[j].y * v0[j].y) + (v0[j].z * v0[j].z + v0[j].w * v0[j].w); q1 += (v1[j].x * v1[j].x + v1[j].y * v1[j].y) + (v1[j].z * v1[j].z + v1[j].w * v1[j].w); }
        const float r0 = 1.0f / sqrtf(wave_sum(q0) * (1.f / D) + RMS_EPS), r1 = 1.0f / sqrtf(wave_sum(q1) * (1.f / D) + RMS_EPS);
        if constexpr (OUT8) {
            unsigned* o0 = (unsigned*)((unsigned char*)H + ((size_t)b * S + s0) * D) + F.lane; unsigned* o1 = (unsigned*)((unsigned char*)H + ((size_t)b * S + s1) * D) + F.lane;
#pragma unroll
            for (int j = 0; j < 8; ++j) { const f32x4 ccj = ((const f32x4*)sh)[F.lane + 64 * j]; const f32x4 a = ((v0[j] * r0) * ca[j] + ccj) * oscale, c2 = ((v1[j] * r1) * ca[j] + ccj) * oscale;
                o0[64 * j] = pk4_fp8(__builtin_amdgcn_fmed3f(a.x, -440.f, 440.f), __builtin_amdgcn_fmed3f(a.y, -440.f, 440.f), __builtin_amdgcn_fmed3f(a.z, -440.f, 440.f), __builtin_amdgcn_fmed3f(a.w, -440.f, 440.f));
                o1[64 * j] = pk4_fp8(__builtin_amdgcn_fmed3f(c2.x, -440.f, 440.f), __builtin_amdgcn_fmed3f(c2.y, -440.f, 440.f), __builtin_amdgcn_fmed3f(c2.z, -440.f, 440.f), __builtin_amdgcn_fmed3f(c2.w, -440.f, 440.f)); }
        } else {
        unsigned long long* o0 = (unsigned long long*)(H + ((size_t)b * S + s0) * D) + F.lane; unsigned long long* o1 = (unsigned long long*)(H + ((size_t)b * S + s1) * D) + F.lane;
#pragma unroll
        for (int j = 0; j < 8; ++j) { const f32x4 ccj = ((const f32x4*)sh)[F.lane + 64 * j]; const f32x4 a = (v0[j] * r0) * ca[j] + ccj, c2 = (v1[j] * r1) * ca[j] + ccj;
            o0[64 * j] = (unsigned long long)pk2(a.x, a.y) | ((unsigned long long)pk2(a.z, a.w) << 32); o1[64 * j] = (unsigned long long)pk2(c2.x, c2.y) | ((unsigned long long)pk2(c2.z, c2.w) << 32); }
        }
    }
}

__device__ __forceinline__ float gelu_tanh(float x) { const float u = 0.7978845608028654f * (x + 0.044715f * x * x * x); return 0.5f * x * (1.0f + tanhf(u)); }

__global__ void __launch_bounds__(NWAVES * 64, 2) fwd(Args args) {
    extern __shared__ __attribute__((aligned(16))) unsigned char lds[];
    Frame F;
    F.lds = lds; F.ws = args.ws;
    F.tid = threadIdx.x; F.lane = F.tid & 63; F.wave = __builtin_amdgcn_readfirstlane(F.tid >> 6);
    F.G = gridDim.x; { const int bx = blockIdx.x; F.vcu = (F.G % 8 == 0) ? (bx % 8) * (F.G / 8) + bx / 8 : bx; }
    F.gw = F.vcu * NWAVES + F.wave; F.NGW = F.G * NWAVES;
    unsigned char* ws = args.ws;
    unsigned* ctl = (unsigned*)(ws + WS_CTL);
    volatile LAS unsigned* MISC = (volatile LAS unsigned*)((LAS unsigned char*)lds + MISC_OFF);
    for (int u = F.tid; u < 64; u += NWAVES * 64) MISC[u] = 0u;
    __syncthreads();
    XcdBarrier bar; bar.bar = ctl + CW_BAR; bar.x = 0; bar.st = nullptr;
    if (MK_N_LAUNCHES == 1) bar = xcd_barrier_post(ctl + CW_BAR, MISC + 8);
    const int lo = args.ph_lo, hi = args.ph_hi;
#define IN(k) (lo <= (k) && (k) < hi)
#define MOE_WSCALE 64.0f
#define MOE_ASCALE 8.0f
#define IN1_ASCALE 4.0f
#define SEAM(k) do { if (IN(k) && IN((k) + 1)) xcd_barrier(bar); } while (0)

    const float* x_in = (const float*)args.in[0]; const float* c_in = (const float*)args.in[1]; const int* positions = (const int*)args.in[2];
    const float* rel_bias = (const float*)args.in[3]; const float* ada_w = (const float*)args.in[4]; const float* ada_b = (const float*)args.in[5];
    const float* mix_norm_g = (const float*)args.in[6]; const float* ffn_norm_g = (const float*)args.in[7];
    const float* ab_w_in = (const float*)args.in[8]; const float* ab_w_out = (const float*)args.in[9];
    const float* cmp_pos_k = (const float*)args.in[10]; const float* cmp_w1_k = (const float*)args.in[11]; const float* cmp_w2_k = (const float*)args.in[12];
    const float* cmp_pos_v = (const float*)args.in[13]; const float* cmp_w1_v = (const float*)args.in[14]; const float* cmp_w2_v = (const float*)args.in[15];
    const float* q_norm_g = (const float*)args.in[16]; const float* kv_norm_g = (const float*)args.in[17]; const float* w_uq = (const float*)args.in[18]; const float* w_ukv = (const float*)args.in[19];
    const float* ffn_wg = (const float*)args.in[20]; const float* ffn_wu = (const float*)args.in[21]; const float* ffn_wd = (const float*)args.in[22];
    const float* c_w_in = (const float*)args.in[23]; const float* c_w_out = (const float*)args.in[24]; const float* w_router = (const float*)args.in[25];
    const float* moe_wg = (const float*)args.in[26]; const float* moe_wu = (const float*)args.in[27]; const float* moe_wd = (const float*)args.in[28]; const float* final_g = (const float*)args.in[29];
    float* MOD = (float*)(ws + WS_MOD); float* BIAS = (float*)(ws + WS_BIAS); float* ROPE = (float*)(ws + WS_ROPE); float* RINV = (float*)(ws + WS_RINV);
    unsigned long long* SEL = (unsigned long long*)(ws + WS_SEL); bf16* KC = (bf16*)(ws + WS_KC); bf16* VC = (bf16*)(ws + WS_VC); int* ROUTE = (int*)(ws + WS_ROUTE); bf16* KPE = (bf16*)(ws + WS_KPE);
    bf16* W_IN0 = (bf16*)(ws + WS_WIN0); bf16* W_UQ = (bf16*)(ws + WS_WUQ); bf16* W_UKV = (bf16*)(ws + WS_WUKV); bf16* W_OUT0 = (bf16*)(ws + WS_WOUT0); bf16* W_GU0 = (bf16*)(ws + WS_WGU0); bf16* W_DN0 = (bf16*)(ws + WS_WDN0);
    bf16* W_IN1 = (bf16*)(ws + WS_WIN1); bf16* W_OUT1 = (bf16*)(ws + WS_WOUT1); bf16* W_MGU = (bf16*)(ws + WS_WMGU); bf16* W_MDN = (bf16*)(ws + WS_WMDN);
    float* X = (float*)(ws + WS_X); bf16* H = (bf16*)(ws + WS_H);
    bf16* Z0 = (bf16*)(ws + WS_Z0); bf16* QM = (bf16*)(ws + WS_QM); bf16* KVM = (bf16*)(ws + WS_KVM); bf16* OCMP = (bf16*)(ws + WS_OCMP); bf16* OWIN = (bf16*)(ws + WS_OWIN); bf16* CAT = (bf16*)(ws + WS_CAT);
    bf16* W1T = (bf16*)(ws + WS_W1T); bf16* W2T = (bf16*)(ws + WS_W2T); float* CB1 = (float*)(ws + WS_CB1);
    float* LSEB = (float*)(ws + WS_LSE); bf16* OP = (bf16*)(ws + WS_OP);
    bf16* ACT = (bf16*)(ws + WS_ACT); bf16* Z1 = (bf16*)(ws + WS_Z1); bf16* OM = (bf16*)(ws + WS_OM); bf16* XB = (bf16*)(ws + WS_XB); bf16* ACTB = (bf16*)(ws + WS_ACTB); bf16* YB = (bf16*)(ws + WS_YB);
    PG8_LAS unsigned char* ring = (PG8_LAS unsigned char*)lds;

    if (IN(0)) {
        for (int job = 192 + (int)blockIdx.x; job < 194; job += F.G) {
            float* red = (float*)(lds + 32768); const int c = job - 192; const float* pos = c ? cmp_pos_v : cmp_pos_k; const float* w1 = c ? cmp_w1_v : cmp_w1_k;
            float a0 = 0.f, a1 = 0.f;
#pragma unroll 8
            for (int k = 0; k < 512; ++k) { const int kk = F.wave * 512 + k; const f32x2 wv = *(const f32x2*)(w1 + (size_t)kk * 128 + 2 * F.lane); const float pv = pos[kk]; a0 += pv * wv.x; a1 += pv * wv.y; }
            red[F.wave * 128 + 2 * F.lane] = a0; red[F.wave * 128 + 2 * F.lane + 1] = a1;
            __syncthreads();
            if (F.tid < 128) { float s = 0.f;
#pragma unroll
                for (int w = 0; w < 8; ++w) s += red[w * 128 + F.tid];
                CB1[c * 128 + F.tid] = s; }
            __syncthreads();
        }
        for (int job = blockIdx.x; job < 256; job += F.G) {
            float* cs = (float*)lds; float* red = (float*)(lds + 32768);
            for (int i = F.tid; i < 4 * D; i += 512) { const float cv = c_in[i]; cs[i] = cv / (1.0f + __expf(-cv)); }
            __syncthreads();
            const int l = job >> 7, col0 = (job & 127) * 96; const bool act = F.lane < 48;
            float acc[4][2] = {};
            const float* wp = ada_w + ((size_t)l * D + (size_t)F.wave * 256) * 12288 + col0 + 2 * (act ? F.lane : 0);
#pragma unroll 8
            for (int k = 0; k < 256; ++k) { const f32x2 wv = *(const f32x2*)(wp + (size_t)k * 12288); const int kk = F.wave * 256 + k;
#pragma unroll
                for (int b = 0; b < 4; ++b) { const float cv = cs[b * D + kk]; acc[b][0] += cv * wv.x; acc[b][1] += cv * wv.y; } }
            if (act) {
#pragma unroll
                for (int b = 0; b < 4; ++b) { red[(F.wave * 4 + b) * 96 + 2 * F.lane] = acc[b][0]; red[(F.wave * 4 + b) * 96 + 2 * F.lane + 1] = acc[b][1]; } }
            __syncthreads();
            if (F.tid < 384) { const int b = F.tid / 96, cc = F.tid % 96; float s = 0.f;
#pragma unroll
              for (int w = 0; w < 8; ++w) s += red[(w * 4 + b) * 96 + cc];
              MOD[((size_t)l * 4 + b) * 12288 + col0 + cc] = s + ada_b[(size_t)l * 12288 + col0 + cc]; }
            __syncthreads();
        }
        __syncthreads();
        p0_transpose<1, true>(F, ab_w_in, nullptr, D, 3672, Z0W, W_IN0, nullptr, MOE_WSCALE);
        p0_transpose<0>(F, w_uq, nullptr, 512, QMW, QMW, W_UQ, q_norm_g);
        p0_transpose<0>(F, w_ukv, nullptr, 512, KVMW, KVMW, W_UKV, kv_norm_g);
        p0_transpose<0>(F, ab_w_out, nullptr, D, D, D, W_OUT0, nullptr);
        p0_transpose<2>(F, ffn_wg, ffn_wu, D, FF, 2 * FF, W_GU0, nullptr);
        p0_transpose<0, true>(F, ffn_wd, nullptr, FF, D, D, W_DN0, nullptr, MOE_WSCALE);
        p0_transpose<0, true>(F, c_w_in, nullptr, D, Z1W, Z1W, W_IN1, nullptr, MOE_WSCALE);
        p0_transpose<0, true>(F, c_w_out, nullptr, 1024, D, D, W_OUT1, nullptr, MOE_WSCALE);
        p0_transpose<0>(F, cmp_w1_k, nullptr, 4096, 128, 128, W1T, nullptr); p0_transpose<0>(F, cmp_w1_v, nullptr, 4096, 128, 128, W1T + 128 * 4096, nullptr);
        p0_transpose<0>(F, cmp_w2_k, nullptr, 128, 128, 128, W2T, nullptr); p0_transpose<0>(F, cmp_w2_v, nullptr, 128, 128, 128, W2T + 128 * 128, nullptr);
        for (int e = 0; e < NE; ++e) {
            p0_transpose<2, true>(F, moe_wg + (size_t)e * D * FFE, moe_wu + (size_t)e * D * FFE, D, FFE, 2 * FFE, (bf16*)((unsigned char*)W_MGU + (size_t)e * 2 * FFE * D), nullptr, MOE_WSCALE);
            p0_transpose<0, true>(F, moe_wd + (size_t)e * FFE * D, nullptr, FFE, D, D, (bf16*)((unsigned char*)W_MDN + (size_t)e * D * FFE), nullptr, MOE_WSCALE);
        }
        for (int i = F.gw * 64 + F.lane; i < 8 * BIAS_LD; i += F.NGW * 64) { const int h = i / BIAS_LD, r = i % BIAS_LD - 64; BIAS[i] = rel_bias[t5_bucket(r) * 8 + h]; }
        for (int i = F.gw * 64 + F.lane; i < M * 32; i += F.NGW * 64) { const int m = i >> 5, f = i & 31;
            const float inv_freq = powf(10000.0f, -(float)(2 * f) / 64.0f); const float ang = (float)positions[m] * inv_freq;
            ROPE[(size_t)m * 64 + f] = cosf(ang); ROPE[(size_t)m * 64 + 32 + f] = sinf(ang); }
    }
    SEAM(0);
    if (IN(1)) modnorm_phase<true>(F, x_in, mix_norm_g, MOD, 0, H, IN1_ASCALE);
    SEAM(1);
    if (IN(2)) { pg8::Gemm g{H, W_IN0, D / 2, D / 2, D / 2}; pg8::StaticOrder So; So.init(M, Z0W, F.G, (int)blockIdx.x); pg8::EpiBf16S E{Z0, Z0W, 1.0f / (MOE_WSCALE * IN1_ASCALE)};
        pg8::gemm_phase<pg8::EpiBf16S, pg8::StaticOrder, PG_ALIGN, PG_SP2, true, true>(ring, g, So, E); }
    SEAM(2);
    if (IN(3)) {
        for (int m = F.gw; m < M; m += F.NGW) {
            const bf16* zr = Z0 + (size_t)m * Z0W;
#pragma unroll
            for (int w = 0; w < 2; ++w) { const v4u a = *(const v4u*)(zr + (w ? Z_KVLAT : Z_QLAT) + 8 * F.lane);
                float s = bflo(a.x) * bflo(a.x) + bfhi(a.x) * bfhi(a.x) + bflo(a.y) * bflo(a.y) + bfhi(a.y) * bfhi(a.y) + bflo(a.z) * bflo(a.z) + bfhi(a.z) * bfhi(a.z) + bflo(a.w) * bflo(a.w) + bfhi(a.w) * bfhi(a.w);
                s = wave_sum(s); if (F.lane == 0) RINV[(size_t)w * M + m] = 1.0f / sqrtf(s * (1.f / 512.f) + RMS_EPS); }
            if (F.lane < 32) { const float x1 = bf2f(zr[Z_KPE + F.lane]), x2 = bf2f(zr[Z_KPE + 32 + F.lane]); const float cs = ROPE[(size_t)m * 64 + F.lane], sn = ROPE[(size_t)m * 64 + 32 + F.lane];
                KPE[(size_t)m * 64 + F.lane] = (bf16)f2bf(x1 * cs - x2 * sn); KPE[(size_t)m * 64 + 32 + F.lane] = (bf16)f2bf(x2 * cs + x1 * sn); }
        }
        __syncthreads();
        for (int job = blockIdx.x; job < 256; job += F.G) {
            typedef short bfx8 __attribute__((ext_vector_type(8)));
            const int nt = job & 15, g = (job >> 4) & 1, b = (job >> 5) & 3, c = job >> 7, n0 = nt * 16;
            const int fr = F.lane & 15, fq = F.lane >> 4; int nrow = n0 + fr; if (nrow > 254) nrow = 254;
            const bf16* arow = Z0 + ((size_t)b * S + 16 * nrow) * Z0W + Z_NKV + c * 256 + g * 128 + fq * 8;
            const bf16* w1t = W1T + (size_t)c * 128 * 4096 + (size_t)fr * 4096 + fq * 8;
            f32x4 acc[8];
#pragma unroll
            for (int i = 0; i < 8; ++i) acc[i] = (f32x4){0.f, 0.f, 0.f, 0.f};
#pragma unroll 2
            for (int ks = 0; ks < 16; ++ks) { const int kk = F.wave * 512 + ks * 32, l = kk >> 7, d0 = kk & 127;
                const bfx8 af = *(const bfx8*)(arow + (size_t)l * Z0W + d0);
#pragma unroll
                for (int i = 0; i < 8; ++i) { const bfx8 bfr = *(const bfx8*)(w1t + (size_t)i * 16 * 4096 + kk); acc[i] = __builtin_amdgcn_mfma_f32_16x16x32_bf16(af, bfr, acc[i], 0, 0, 0); } }
            float* part = (float*)lds;
#pragma unroll
            for (int i = 0; i < 8; ++i)
#pragma unroll
                for (int j = 0; j < 4; ++j) part[(F.wave * 16 + fq * 4 + j) * 128 + i * 16 + fr] = acc[i][j];
            __syncthreads();
            bf16* hid = (bf16*)(lds + 65536);
            { const int row = F.tid >> 5, c4 = (F.tid & 31) * 4; f32x4 s = *(const f32x4*)(CB1 + c * 128 + c4);
#pragma unroll
              for (int w = 0; w < 8; ++w) s += *(const f32x4*)(part + (w * 16 + row) * 128 + c4);
              *(v2u*)(hid + row * 128 + c4) = (v2u){pk2(gelu_tanh(s.x), gelu_tanh(s.y)), pk2(gelu_tanh(s.z), gelu_tanh(s.w))}; }
            __syncthreads();
            { f32x4 o4 = {0.f, 0.f, 0.f, 0.f}; const bf16* w2t = W2T + (size_t)c * 128 * 128 + (size_t)(F.wave * 16 + fr) * 128 + fq * 8;
#pragma unroll
              for (int ks = 0; ks < 4; ++ks) { const bfx8 af = *(const bfx8*)(hid + fr * 128 + ks * 32 + fq * 8); const bfx8 bfr = *(const bfx8*)(w2t + ks * 32); o4 = __builtin_amdgcn_mfma_f32_16x16x32_bf16(af, bfr, o4, 0, 0, 0); }
              bf16* outp = (c ? VC : KC) + (((size_t)b * 2 + g) * 256) * 128 + F.wave * 16 + fr;
#pragma unroll
              for (int j = 0; j < 4; ++j) { const int n = n0 + fq * 4 + j; outp[(size_t)n * 128] = n < 255 ? (bf16)f2bf(o4[j]) : (bf16)0; } }
            __syncthreads();
        }
        __syncthreads();
        for (int Lx = blockIdx.x; Lx < 512; Lx += F.G) {
            const int qb = 15 - Lx / 32, bh = Lx % 32, b = bh >> 3, h = bh & 7, g = h >> 2; const bf16* zb = Z0 + (size_t)b * S * Z0W;
            fa::Item it{}; it.Q = zb + Z_NQ + h * 128; it.qs = Z0W; it.K = zb + Z_NKV + 4 * 256 + g * 128; it.ks = Z0W; it.V = zb + Z_NKV + 5 * 256 + g * 128; it.vs = Z0W;
            it.P0 = qb * 256; it.skv = S; it.W = 512; it.bias = BIAS + (size_t)h * BIAS_LD + 64; it.bstep = 1; it.O = OWIN + (size_t)b * S * 1024 + h * 128; it.os = 1024;
            fa::attn_block<0>(it, lds);
        }
    }
    SEAM(3);
    if (IN(4)) {
        { pg8::Gemm g{Z0 + Z_QLAT, W_UQ, Z0W, 512, 512}; pg8::StaticOrder So; So.init(M, QMW, F.G, (int)blockIdx.x); pg8::EpiBf16 E{QM, QMW, RINV};
          pg8::gemm_phase<pg8::EpiBf16, pg8::StaticOrder, PG_ALIGN, PG_SP2>(ring, g, So, E); }
        __syncthreads();
        { pg8::Gemm g{Z0 + Z_KVLAT, W_UKV, Z0W, 512, 512}; pg8::StaticOrder So; So.init(M, KVMW, F.G, (int)blockIdx.x); pg8::EpiBf16 E{KVM, KVMW, RINV + M};
          pg8::gemm_phase<pg8::EpiBf16, pg8::StaticOrder, PG_ALIGN, PG_SP2>(ring, g, So, E); }
        __syncthreads();
        for (int Lx = blockIdx.x; Lx < 512; Lx += F.G) { const int tb = 63 - Lx / 8, bg = Lx % 8, b = bg >> 1, g = bg & 1;
            fa::CmpItem it; it.Q = Z0 + ((size_t)b * S + tb * 64) * Z0W + Z_NQ + g * 512; it.qs = Z0W; it.K = KC + ((size_t)b * 2 + g) * 256 * 128; it.V = VC + ((size_t)b * 2 + g) * 256 * 128;
            it.bias = BIAS + (size_t)(g * 4) * BIAS_LD + 64; it.bld = BIAS_LD; it.s0 = tb * 64; it.O = OCMP + ((size_t)b * S + tb * 64) * 1024 + g * 512; it.os = 1024; it.sel = SEL + ((size_t)b * S + tb * 64) * 2 + g;

            fa::cmp_block(it, lds, SMALL_OFF); }
    }
    SEAM(4);
    if (IN(5)) {
        for (int Lx = blockIdx.x; Lx < 256; Lx += F.G) {
            const int x = Lx / 32, bh = Lx % 32, b = bh >> 3, h = bh & 7, g = h >> 2; const bf16* zb = Z0 + (size_t)b * S * Z0W;
            for (int pass = 0; pass < 2; ++pass) { const int qb = pass ? 15 - x : x;
                fa::Item it{}; it.Q = zb + Z_NQ + h * 128; it.qs = Z0W; it.K = zb + Z_NKV + 2 * 256 + g * 128; it.ks = Z0W; it.V = zb + Z_NKV + 3 * 256 + g * 128; it.vs = Z0W;
                it.P0 = qb * 256; it.skv = S; it.W = 1 << 20; it.bias = BIAS + (size_t)h * BIAS_LD + 64; it.bstep = 1; it.sel = SEL + (size_t)b * S * 2 + g; it.sels = 2;
                it.O = CAT + (size_t)b * S * 2048 + h * 128; it.os = 2048;
                it.M0 = OCMP + (size_t)b * S * 1024 + h * 128; it.M1 = OWIN + (size_t)b * S * 1024 + h * 128; it.ms = 1024; it.G = zb + Z_NG + h * 3; it.gs = Z0W;
                fa::attn_block<1>(it, lds); }
        }
        for (int Lx = blockIdx.x; Lx < 256; Lx += F.G) {
            const int x = Lx / 32, bh = Lx % 32, b = bh >> 3, h = bh & 7;
            for (int pass = 0; pass < 2; ++pass) { const int qb = pass ? 15 - x : x;
                fa::Item it{}; it.Q = QM + (size_t)b * S * QMW + h * 192; it.qs = QMW; it.rope = ROPE + (size_t)b * S * 64; it.ropes = 64;
                it.K = KVM + (size_t)b * S * KVMW + h * 256; it.ks = KVMW; it.K2 = KPE + (size_t)b * S * 64; it.k2s = 64; it.V = KVM + (size_t)b * S * KVMW + h * 256 + 128; it.vs = KVMW;
                it.P0 = qb * 256; it.skv = S; it.W = 1 << 20; it.O = CAT + (size_t)b * S * 2048 + 1024 + h * 128; it.os = 2048;
                fa::attn_block<2>(it, lds); }
        }
    }
    SEAM(5);
    if (IN(6)) { pg8::Gemm g{CAT, W_OUT0, 2048, 2048, 2048}; pg8::StaticOrder So; So.init(M, D, F.G, (int)blockIdx.x); pg8::EpiResid E{x_in, X, D, MOD + 2 * D, 6 * D, S / 256};
        pg8::gemm_phase<pg8::EpiResid, pg8::StaticOrder, PG_ALIGN, PG_SP2>(ring, g, So, E); }
    SEAM(6);
    if (IN(7)) modnorm_phase(F, X, ffn_norm_g, MOD, 3, H);
    SEAM(7);
    if (IN(8)) { pg8::Gemm g{H, W_GU0, D, D, D}; pg8::StaticOrder So; So.init(M, 2 * FF, F.G, (int)blockIdx.x); pg8::EpiSwiGLU8 E{(unsigned char*)ACT, FF, 1.0f, MOE_ASCALE};
        pg8::gemm_phase<pg8::EpiSwiGLU8, pg8::StaticOrder, PG_ALIGN, PG_SP2>(ring, g, So, E); }
    SEAM(8);
    if (IN(9)) { pg8::Gemm g{ACT, W_DN0, FF / 2, FF / 2, FF / 2}; pg8::StaticOrder So; So.init(M, D, F.G, (int)blockIdx.x); pg8::EpiResid E{X, X, D, MOD + 5 * D, 6 * D, S / 256, 1.0f / (MOE_WSCALE * MOE_ASCALE)};
        pg8::gemm_phase<pg8::EpiResid, pg8::StaticOrder, PG_ALIGN, PG_SP2, true, true>(ring, g, So, E); }
    SEAM(9);
    if (IN(10)) modnorm_phase<true>(F, X, mix_norm_g + D, MOD + 4 * 12288, 0, H, IN1_ASCALE);
    SEAM(10);
    if (IN(11)) { pg8::Gemm g{H, W_IN1, D / 2, D / 2, D / 2}; pg8::StaticOrder So; So.init(M, Z1W, F.G, (int)blockIdx.x); pg8::EpiBf16S E{Z1, Z1W, 1.0f / (MOE_WSCALE * IN1_ASCALE)};
        pg8::gemm_phase<pg8::EpiBf16S, pg8::StaticOrder, PG_ALIGN, PG_SP2, true, true>(ring, g, So, E); }
    SEAM(11);
    if (IN(12)) {
        for (int Lx = blockIdx.x; Lx < 1536; Lx += F.G) {
            const int p = Lx % 3, r_ = Lx / 3, bh = r_ % 32, sub = r_ / 32, b = bh >> 3, h = bh & 7;
            const int dil = p == 0 ? 1 : (p == 1 ? 4 : 16), res = p == 0 ? 0 : (p == 1 ? (sub & 3) : sub), qb = p == 0 ? sub : (p == 1 ? (sub >> 2) : 0);
            fa::Item it{}; it.Q = Z1 + ((size_t)b * S + res) * Z1W + p * 3072 + h * 128; it.qs = (long)dil * Z1W; it.K = it.Q + 1024; it.ks = it.qs; it.V = it.Q + 2048; it.vs = it.qs;
            it.P0 = qb * 256; it.skv = S / dil; it.W = 129; it.bias = BIAS + (size_t)h * BIAS_LD + 64; it.bstep = dil;
            it.O = OP + (size_t)p * M * 1024 + ((size_t)b * S + res) * 1024 + h * 128; it.os = (long)dil * 1024; it.LSE = LSEB + (size_t)p * M * 8 + ((size_t)b * S + res) * 8 + h; it.lses = (long)dil * 8;
            fa::attn_block<0>(it, lds);
        }
    }
    SEAM(12);
    if (IN(13)) {
        for (int m = F.gw; m < M; m += F.NGW) {
            const int h = F.lane >> 3; const float l0 = LSEB[(size_t)m * 8 + h], l1 = LSEB[(size_t)(M + m) * 8 + h], l2 = LSEB[(size_t)(2 * M + m) * 8 + h];
            const v4u* p0 = (const v4u*)(OP + (size_t)m * 1024) + 2 * F.lane; const v4u* p1 = (const v4u*)(OP + (size_t)(M + m) * 1024) + 2 * F.lane; const v4u* p2 = (const v4u*)(OP + (size_t)(2 * M + m) * 1024) + 2 * F.lane;
            const v4u a0 = p0[0], b0 = p0[1], a1 = p1[0], b1 = p1[1], a2 = p2[0], b2 = p2[1];
            const float mx = fmaxf(l0, fmaxf(l1, l2)); float e0 = __expf(l0 - mx), e1 = __expf(l1 - mx), e2 = __expf(l2 - mx); const float inv = 1.0f / (e0 + e1 + e2); e0 *= inv; e1 *= inv; e2 *= inv;
            e0 *= MOE_ASCALE; e1 *= MOE_ASCALE; e2 *= MOE_ASCALE;
            float lo_[8], hi_[8];
#pragma unroll
            for (int q = 0; q < 4; ++q) { lo_[q] = e0 * bflo(a0[q]) + e1 * bflo(a1[q]) + e2 * bflo(a2[q]); hi_[q] = e0 * bfhi(a0[q]) + e1 * bfhi(a1[q]) + e2 * bfhi(a2[q]);
                lo_[4 + q] = e0 * bflo(b0[q]) + e1 * bflo(b1[q]) + e2 * bflo(b2[q]); hi_[4 + q] = e0 * bfhi(b0[q]) + e1 * bfhi(b1[q]) + e2 * bfhi(b2[q]); }
#pragma unroll
            for (int q = 0; q < 8; ++q) { lo_[q] = __builtin_amdgcn_fmed3f(lo_[q], -440.f, 440.f); hi_[q] = __builtin_amdgcn_fmed3f(hi_[q], -440.f, 440.f); }
            v4u o8; o8.x = pk4_fp8(lo_[0], hi_[0], lo_[1], hi_[1]); o8.y = pk4_fp8(lo_[2], hi_[2], lo_[3], hi_[3]); o8.z = pk4_fp8(lo_[4], hi_[4], lo_[5], hi_[5]); o8.w = pk4_fp8(lo_[6], hi_[6], lo_[7], hi_[7]);
            *((v4u*)((unsigned char*)OM + (size_t)m * 1024) + F.lane) = o8;
        }
    }
    SEAM(13);
    if (IN(14)) { pg8::Gemm g{OM, W_OUT1, 512, 512, 512}; pg8::StaticOrder So; So.init(M, D, F.G, (int)blockIdx.x); pg8::EpiResid E{X, X, D, MOD + 4 * 12288 + 2 * D, 6 * D, S / 256, 1.0f / (MOE_WSCALE * MOE_ASCALE)};
        pg8::gemm_phase<pg8::EpiResid, pg8::StaticOrder, PG_ALIGN, PG_SP2, true, true>(ring, g, So, E); }
    SEAM(14);
    if (IN(15)) {
        f32x4* wl = (f32x4*)lds; int* lcnt = (int*)(lds + 65536); int* lbase = lcnt + 8; int* rinfo = lcnt + 16;
        for (int i = F.tid; i < 4096; i += 512) { const int slot = i >> 6, l = i & 63, j = slot >> 3, q = (slot >> 1) & 3, half = slot & 1; wl[i] = *(const f32x4*)(w_router + (size_t)(4 * l + 256 * j + q) * 8 + half * 4); }
        if (F.tid < 8) lcnt[F.tid] = 0;
        __syncthreads();
        for (int k = 0; k < M / 2048; ++k) { const int m = F.gw + k * F.NGW; if (m >= M) break; const int b = m / S; const float* mb = MOD + 4 * 12288 + (size_t)b * 6 * D; f32x4 v[8];
            modnorm_row(X + (size_t)m * D, ffn_norm_g + D, mb + 4 * D, mb + 3 * D, H + (size_t)m * D, F.lane, v);
            float lg[8] = {};
#pragma unroll
            for (int j = 0; j < 8; ++j)
#pragma unroll
                for (int q = 0; q < 4; ++q) { const f32x4 wa = wl[((j * 4 + q) * 2 + 0) * 64 + F.lane], wb = wl[((j * 4 + q) * 2 + 1) * 64 + F.lane]; const float hv = v[j][q];
                    lg[0] += hv * wa.x; lg[1] += hv * wa.y; lg[2] += hv * wa.z; lg[3] += hv * wa.w; lg[4] += hv * wb.x; lg[5] += hv * wb.y; lg[6] += hv * wb.z; lg[7] += hv * wb.w; }
#pragma unroll
            for (int e = 0; e < 8; ++e) lg[e] = wave_sum(lg[e]);
            int e1 = 0; float v1 = lg[0];
#pragma unroll
            for (int e = 1; e < 8; ++e) if (lg[e] > v1) { v1 = lg[e]; e1 = e; }
            int e2 = -1; float v2 = -3.0e38f;
#pragma unroll
            for (int e = 0; e < 8; ++e) if (e != e1 && lg[e] > v2) { v2 = lg[e]; e2 = e; }
            if (F.lane == 0) { const float g1 = 1.0f / (1.0f + __expf(v2 - v1)), g2 = 1.0f - g1;
                const int r1 = __hip_atomic_fetch_add(lcnt + e1, 1, __ATOMIC_RELAXED, __HIP_MEMORY_SCOPE_WORKGROUP), r2 = __hip_atomic_fetch_add(lcnt + e2, 1, __ATOMIC_RELAXED, __HIP_MEMORY_SCOPE_WORKGROUP);
                int* ri = rinfo + (F.wave * 8 + k) * 8; ri[0] = e1; ri[1] = e2; ri[2] = r1; ri[3] = r2; ri[4] = __float_as_int(g1); ri[5] = __float_as_int(g2); }
        }
        __syncthreads();
        if (F.tid < 8) lbase[F.tid] = (int)atomicAdd(ctl + CW_CNT + F.tid, (unsigned)lcnt[F.tid]);
        __syncthreads();
        if (F.lane == 0) for (int k = 0; k < M / 2048; ++k) { const int m = F.gw + k * F.NGW; if (m >= M) break; const int* ri = rinfo + (F.wave * 8 + k) * 8; int* rt = ROUTE + (size_t)m * 8;
            rt[0] = ri[0]; rt[1] = ri[1]; rt[2] = ri[2] + lbase[ri[0]]; rt[3] = ri[3] + lbase[ri[1]]; rt[4] = ri[4]; rt[5] = ri[5]; }
    }
    SEAM(15);
    if (IN(16)) {
        unsigned ts[9]; ts[0] = 0;
#pragma unroll
        for (int e = 0; e < 8; ++e) ts[e + 1] = ts[e] + (__hip_atomic_load(ctl + CW_CNT + e, __ATOMIC_RELAXED, __HIP_MEMORY_SCOPE_AGENT) + 255u) / 256u;
        if (blockIdx.x == 0 && F.tid < 9) { unsigned v = ts[0];
#pragma unroll
            for (int e = 1; e < 9; ++e) v = (F.tid == e) ? ts[e] : v;
            ctl[CW_TS + F.tid] = v; }
        for (int m = F.gw; m < M; m += F.NGW) { const int* rt = ROUTE + (size_t)m * 8; const int e1 = rt[0], e2 = rt[1]; unsigned t1 = 0, t2 = 0;
#pragma unroll
            for (int e = 0; e < 8; ++e) { t1 = (e == e1) ? ts[e] : t1; t2 = (e == e2) ? ts[e] : t2; }
            const size_t d1 = (size_t)t1 * 256 + rt[2], d2 = (size_t)t2 * 256 + rt[3];
            const v4u* src = (const v4u*)(H + (size_t)m * D) + F.lane;
            v2u* o1 = (v2u*)((unsigned char*)XB + d1 * D) + F.lane; v2u* o2 = (v2u*)((unsigned char*)XB + d2 * D) + F.lane;
#pragma unroll
            for (int j = 0; j < 4; ++j) { const v4u w = src[64 * j]; v2u q; q.x = pk4_fp8(bflo(w.x), bfhi(w.x), bflo(w.y), bfhi(w.y)); q.y = pk4_fp8(bflo(w.z), bfhi(w.z), bflo(w.w), bfhi(w.w)); o1[64 * j] = q; o2[64 * j] = q; } }
    }
    SEAM(16);
    if (IN(17)) { pg8::Gemm g{XB, W_MGU, D / 2, D / 2, D / 2}; pg8::GroupedOrder So; So.init(ctl + CW_TS, 2 * FFE / 256, F.G, (int)blockIdx.x); pg8::EpiSwiGLU8 E{(unsigned char*)ACTB, FFE, 1.0f / MOE_WSCALE, MOE_ASCALE};
        pg8::gemm_phase<pg8::EpiSwiGLU8, pg8::GroupedOrder, PG_ALIGN, PG_SP2, true, true>(ring, g, So, E); }
    SEAM(17);
    if (IN(18)) { pg8::Gemm g{ACTB, W_MDN, FFE / 2, FFE / 2, FFE / 2}; pg8::GroupedOrder So; So.init(ctl + CW_TS, D / 256, F.G, (int)blockIdx.x); pg8::EpiBf16S E{YB, D, 1.0f / (MOE_WSCALE * MOE_ASCALE)};
        pg8::gemm_phase<pg8::EpiBf16S, pg8::GroupedOrder, PG_ALIGN, PG_SP2, true, true>(ring, g, So, E); }
    SEAM(18);
    if (IN(19)) {
        unsigned ts[9]; ts[0] = 0;
#pragma unroll
        for (int e = 0; e < 8; ++e) ts[e + 1] = ctl[CW_TS + e + 1];
#pragma unroll
        for (int b = 0; b < NB; ++b) {
            const float* gf = MOD + 4 * 12288 + (size_t)b * 6 * D + 5 * D;
            const int m0 = b * S + F.gw, m1 = m0 + F.NGW;
            const int* rt0 = ROUTE + (size_t)m0 * 8; const int* rt1 = ROUTE + (size_t)m1 * 8;
            const int e10 = rt0[0], e20 = rt0[1], r10 = rt0[2], r20 = rt0[3], e11 = rt1[0], e21 = rt1[1], r11 = rt1[2], r21 = rt1[3];
            const float g10 = __int_as_float(rt0[4]), g20 = __int_as_float(rt0[5]), g11 = __int_as_float(rt1[4]), g21 = __int_as_float(rt1[5]);
            unsigned t10 = 0, t20 = 0, t11 = 0, t21 = 0;
#pragma unroll
            for (int e = 0; e < 8; ++e) { t10 = (e == e10) ? ts[e] : t10; t20 = (e == e20) ? ts[e] : t20; t11 = (e == e11) ? ts[e] : t11; t21 = (e == e21) ? ts[e] : t21; }
            const v2u* ya0 = (const v2u*)(YB + ((size_t)t10 * 256 + r10) * D) + F.lane; const v2u* yb0 = (const v2u*)(YB + ((size_t)t20 * 256 + r20) * D) + F.lane;
            const v2u* ya1 = (const v2u*)(YB + ((size_t)t11 * 256 + r11) * D) + F.lane; const v2u* yb1 = (const v2u*)(YB + ((size_t)t21 * 256 + r21) * D) + F.lane;
            const f32x4* x0 = (const f32x4*)(X + (size_t)m0 * D) + F.lane; const f32x4* x1 = (const f32x4*)(X + (size_t)m1 * D) + F.lane;
            f32x4 v0[8], v1[8]; v2u a0[8], c0[8], a1[8], c1[8];
#pragma unroll
            for (int j = 0; j < 8; ++j) { v0[j] = x0[64 * j]; v1[j] = x1[64 * j]; a0[j] = ya0[64 * j]; c0[j] = yb0[64 * j]; a1[j] = ya1[64 * j]; c1[j] = yb1[64 * j]; }
            float q0 = 0.f, q1 = 0.f;
#pragma unroll
            for (int j = 0; j < 8; ++j) { const f32x4 gg = ((const f32x4*)gf)[F.lane + 64 * j]; f32x4 y;
                y.x = g10 * bflo(a0[j].x) + g20 * bflo(c0[j].x); y.y = g10 * bfhi(a0[j].x) + g20 * bfhi(c0[j].x); y.z = g10 * bflo(a0[j].y) + g20 * bflo(c0[j].y); y.w = g10 * bfhi(a0[j].y) + g20 * bfhi(c0[j].y);
                v0[j] = v0[j] + gg * y; q0 += (v0[j].x * v0[j].x + v0[j].y * v0[j].y) + (v0[j].z * v0[j].z + v0[j].w * v0[j].w);
                y.x = g11 * bflo(a1[j].x) + g21 * bflo(c1[j].x); y.y = g11 * bfhi(a1[j].x) + g21 * bfhi(c1[j].x); y.z = g11 * bflo(a1[j].y) + g21 * bflo(c1[j].y); y.w = g11 * bfhi(a1[j].y) + g21 * bfhi(c1[j].y);
                v1[j] = v1[j] + gg * y; q1 += (v1[j].x * v1[j].x + v1[j].y * v1[j].y) + (v1[j].z * v1[j].z + v1[j].w * v1[j].w); }
            const float ri0 = 1.0f / sqrtf(wave_sum(q0) * (1.f / D) + RMS_EPS), ri1 = 1.0f / sqrtf(wave_sum(q1) * (1.f / D) + RMS_EPS);
            f32x4* o0 = (f32x4*)(args.out + (size_t)m0 * D) + F.lane; f32x4* o1 = (f32x4*)(args.out + (size_t)m1 * D) + F.lane;
#pragma unroll
            for (int j = 0; j < 8; ++j) { const f32x4 fg = ((const f32x4*)final_g)[F.lane + 64 * j]; o0[64 * j] = (v0[j] * ri0) * fg; o1[64 * j] = (v1[j] * ri1) * fg; }
        }
    }
#undef IN
#undef SEAM
}

constexpr int N_PHASES = 20;
extern "C" void kernel_launch(void* const* d_in, const int* in_sizes, int n_in, void* d_out, int out_size, void* d_ws, size_t ws_size, hipStream_t stream) {
    static int grid = 0;
    if (grid == 0) {
        if (n_in != 30 || in_sizes[0] != M * D || out_size != M * D || ws_size < WS_END) { fprintf(stderr, "kernel_launch: shape/workspace mismatch: n_in %d in0 %d out %d ws %zu (need %zu)\n", n_in, n_in > 0 ? in_sizes[0] : -1, out_size, ws_size, (size_t)WS_END); grid = -1; return; }
        int dev = 0, cus = 0, per_cu = 0;
        if (hipGetDevice(&dev) != hipSuccess || hipDeviceGetAttribute(&cus, hipDeviceAttributeMultiprocessorCount, dev) != hipSuccess) { grid = -1; return; }
        if (hipFuncSetAttribute((const void*)fwd, hipFuncAttributeMaxDynamicSharedMemorySize, LDS_BYTES) != hipSuccess) { fprintf(stderr, "kernel_launch: hipFuncSetAttribute failed\n"); grid = -1; return; }
        if (hipOccupancyMaxActiveBlocksPerMultiprocessor(&per_cu, (const void*)fwd, NWAVES * 64, LDS_BYTES) != hipSuccess || per_cu < 1) fprintf(stderr, "kernel_launch: occupancy query reports %d\n", per_cu);
        (void)hipGetLastError();
        grid = cus;
        if (grid != 256) { fprintf(stderr, "kernel_launch: built for a 256-CU device (got %d)\n", cus); grid = -1; return; }
    }
    if (grid < 0) return;
    if (hipMemsetAsync((char*)d_ws + WS_CTL, 0, CTL_ZERO_BYTES, stream) != hipSuccess) return;
    Args a{};
    for (int i = 0; i < 30; ++i) a.in[i] = d_in[i];
    a.out = (float*)d_out; a.ws = (unsigned char*)d_ws;
    if (MK_N_LAUNCHES == 1) { a.ph_lo = 0; a.ph_hi = N_PHASES; hipLaunchKernelGGL(fwd, dim3(grid), dim3(NWAVES * 64), LDS_BYTES, stream, a); }
    else { for (int p = 0; p < N_PHASES; ++p) { a.ph_lo = p; a.ph_hi = p + 1; hipLaunchKernelGGL(fwd, dim3(grid), dim3(NWAVES * 64), LDS_BYTES, stream, a); } }
    const hipError_t le = hipPeekAtLastError();
    if (le != hipSuccess) fprintf(stderr, "kernel_launch: launch failed: %s\n", hipGetErrorName(le));
}
```
